# Optimizing an MI355X kernel written in HIP

```python
import math
import jax, jax.numpy as jnp
from jax import lax
import numpy as np

D_MODEL = 1024
BATCH = 8
SEQ = 2048
DEPTH = 2

HEAD_DIM = 64
ROPE_THETA = 10000.0
Q_BLOCK = 128
EPS = 1e-6
NEG = -1e30
FORCE = 1e4

NSA_HEADS = 4
NSA_CMP_LEN = 32
NSA_CMP_STRIDE = 16
NSA_SEL_LEN = 64
NSA_TOP_N = 16
NSA_WINDOW = 512

DIFF_HEADS = 4
DIFF_QK_DIM = 32
DIFF_V_DIM = 64

MLA_HEADS = 4
MLA_Q_RANK = 256
MLA_KV_RANK = 128
MLA_NOPE_DIM = 64
MLA_ROPE_DIM = 32
MLA_V_DIM = 64

SWA_HEADS = 4
SWA_KV_HEADS = 2
SWA_WINDOW = 128

MIX_WIDTH = NSA_HEADS * HEAD_DIM + DIFF_HEADS * DIFF_V_DIM + MLA_HEADS * MLA_V_DIM + SWA_HEADS * HEAD_DIM

NSA_COLS = NSA_HEADS * HEAD_DIM + 6 * HEAD_DIM + 3 * NSA_HEADS
DIFF_COLS = 2 * DIFF_HEADS * 2 * DIFF_QK_DIM + DIFF_HEADS * DIFF_V_DIM
MLA_COLS = MLA_Q_RANK + MLA_KV_RANK + MLA_ROPE_DIM
SWA_COLS = SWA_HEADS * HEAD_DIM + 2 * SWA_KV_HEADS * HEAD_DIM
IN_COLS = NSA_COLS + DIFF_COLS + MLA_COLS + SWA_COLS

PEER_HEADS = 8
PEER_N_KEYS = 128
PEER_TOPK = 16
PEER_QUERY_DIM = 256
PEER_EXPERTS = PEER_N_KEYS * PEER_N_KEYS
PEER_CHUNK = 128

kernel_name = "hybrid_nsa_diff_mla_swa_peer_adaln"


def rms_norm(x, g):
    xf = x.astype(jnp.float32)
    y = xf * lax.rsqrt(jnp.mean(xf * xf, axis=-1, keepdims=True) + EPS)
    return (y * g.astype(jnp.float32)).astype(x.dtype)


def split_cols(t, sizes):
    idx = [int(i) for i in np.cumsum(sizes)[:-1]]
    return jnp.split(t, idx, axis=-1)


def rope_tables(seq, dim):
    inv = 1.0 / (ROPE_THETA ** (jnp.arange(0, dim, 2, dtype=jnp.float32) / dim))
    ang = jnp.arange(seq, dtype=jnp.float32)[:, None] * inv[None, :]
    return jnp.cos(ang), jnp.sin(ang)


def apply_rope(x, cos, sin):
    x1, x2 = jnp.split(x, 2, axis=-1)
    c = cos[None, :, None, :].astype(x.dtype)
    s = sin[None, :, None, :].astype(x.dtype)
    return jnp.concatenate([x1 * c - x2 * s, x1 * s + x2 * c], axis=-1)


def to_blocks(t):
    b, s = t.shape[:2]
    t = t.reshape((b, s // Q_BLOCK, Q_BLOCK) + t.shape[2:])
    return jnp.moveaxis(t, 1, 0)


def from_blocks(t):
    t = jnp.moveaxis(t, 0, 1)
    return t.reshape((t.shape[0], t.shape[1] * t.shape[2]) + t.shape[3:])


def band_keys(t, window):
    s = t.shape[1]
    tp = jnp.pad(t, [(0, 0), (window, 0)] + [(0, 0)] * (t.ndim - 2))
    idx = jnp.arange(s // Q_BLOCK)[:, None] * Q_BLOCK + jnp.arange(window + Q_BLOCK)[None, :]
    return jnp.moveaxis(tp[:, idx], 1, 0)


def banded_attention(q, k, v, window, sinks=None):
    b, s, h, d = q.shape
    g = k.shape[2]
    r = h // g
    scale = d ** -0.5
    nblk = s // Q_BLOCK
    qb = to_blocks(q.reshape(b, s, g, r, d))
    kb = band_keys(k, window)
    vb = band_keys(v, window)

    def blk(args):
        qq, kk, vv, i = args
        qpos = i * Q_BLOCK + jnp.arange(Q_BLOCK)
        kpos = i * Q_BLOCK - window + jnp.arange(window + Q_BLOCK)
        dist = qpos[:, None] - kpos[None, :]
        mask = (dist >= 0) & (dist < window) & (kpos[None, :] >= 0)
        sc = jnp.einsum('bqgrd,bkgd->bgrqk', qq, kk).astype(jnp.float32) * scale
        sc = jnp.where(mask, sc, NEG)
        if sinks is None:
            p = jax.nn.softmax(sc, axis=-1)
        else:
            sk = jnp.broadcast_to(sinks.astype(jnp.float32).reshape(1, g, r, 1, 1), sc.shape[:-1] + (1,))
            p = jax.nn.softmax(jnp.concatenate([sc, sk], axis=-1), axis=-1)[..., :-1]
        return jnp.einsum('bgrqk,bkgd->bqgrd', p.astype(vv.dtype), vv)

    o = lax.map(blk, (qb, kb, vb, jnp.arange(nblk)))
    return from_blocks(o).reshape(b, s, h, d)


def nsa_mixer(cols, pos_k, pos_v, wk, wv, cos, sin):
    b, s, _ = cols.shape
    h, d = NSA_HEADS, HEAD_DIM
    q, kc, vc, ksl, vsl, kw, vw, gt = split_cols(cols, [h * d, d, d, d, d, d, d, 3 * h])
    q = apply_rope(q.reshape(b, s, h, d), cos, sin)
    kc = apply_rope(kc[:, :, None], cos, sin)[:, :, 0]
    ksl = apply_rope(ksl[:, :, None], cos, sin)[:, :, 0]
    kw = apply_rope(kw[:, :, None], cos, sin)
    gates = jax.nn.sigmoid(gt.reshape(b, s, h, 3))
    scale = d ** -0.5
    tpos = jnp.arange(s)

    n_c = (s - NSA_CMP_LEN) // NSA_CMP_STRIDE + 1
    cidx = jnp.arange(n_c)[:, None] * NSA_CMP_STRIDE + jnp.arange(NSA_CMP_LEN)[None, :]
    k_cmp = (kc[:, cidx] + pos_k).reshape(b, n_c, NSA_CMP_LEN * d) @ wk
    v_cmp = (vc[:, cidx] + pos_v).reshape(b, n_c, NSA_CMP_LEN * d) @ wv
    cmask = cidx[:, -1][None, :] <= tpos[:, None]
    sc = jnp.einsum('bqhd,bcd->bhqc', q, k_cmp).astype(jnp.float32) * scale
    p_cmp = jax.nn.softmax(jnp.where(cmask, sc, NEG), axis=-1) * cmask
    o_cmp = jnp.einsum('bhqc,bcd->bqhd', p_cmp.astype(v_cmp.dtype), v_cmp)

    n_sel = s // NSA_SEL_LEN
    top_n = min(NSA_TOP_N, n_sel)
    overlap = jax.nn.one_hot(cidx // NSA_SEL_LEN, n_sel, dtype=jnp.float32).mean(axis=1)
    imp = jnp.einsum('bhqc,cj->bqj', p_cmp, overlap)
    qblk = tpos // NSA_SEL_LEN
    jj = jnp.arange(n_sel)
    allowed = jj[None, :] <= qblk[:, None]
    forced = (jj[None, :] == 0) | (jj[None, :] == qblk[:, None]) | (jj[None, :] == qblk[:, None] - 1)
    imp = jnp.where(allowed, jnp.where(forced, FORCE, imp), NEG)
    _, sel_idx = lax.top_k(imp, top_n)
    sel_valid = sel_idx <= qblk[None, :, None]
    kb = ksl.reshape(b, n_sel, NSA_SEL_LEN, d)
    vb = vsl.reshape(b, n_sel, NSA_SEL_LEN, d)

    def sel_block(args):
        qq, ii, ok, bi = args
        qpos = bi * Q_BLOCK + jnp.arange(Q_BLOCK)
        kg = jax.vmap(lambda kk, ix: kk[ix])(kb, ii).reshape(b, Q_BLOCK, top_n * NSA_SEL_LEN, d)
        vg = jax.vmap(lambda vv, ix: vv[ix])(vb, ii).reshape(b, Q_BLOCK, top_n * NSA_SEL_LEN, d)
        kpos = (ii[..., None] * NSA_SEL_LEN + jnp.arange(NSA_SEL_LEN)).reshape(b, Q_BLOCK, -1)
        m = (kpos <= qpos[None, :, None]) & jnp.repeat(ok, NSA_SEL_LEN, axis=-1)
        ss = jnp.einsum('bqhd,bqkd->bqhk', qq, kg).astype(jnp.float32) * scale
        pp = jax.nn.softmax(jnp.where(m[:, :, None, :], ss, NEG), axis=-1)
        return jnp.einsum('bqhk,bqkd->bqhd', pp.astype(vg.dtype), vg)

    o_sel = from_blocks(lax.map(sel_block, (to_blocks(q), to_blocks(sel_idx), to_blocks(sel_valid),
                                           jnp.arange(s // Q_BLOCK))))

    o_win = banded_attention(q, kw, vw[:, :, None], NSA_WINDOW)

    o = gates[..., 0:1] * o_cmp + gates[..., 1:2] * o_sel + gates[..., 2:3] * o_win
    return o.reshape(b, s, h * d)


def diff_mixer(cols, layer, lq1, lk1, lq2, lk2, sub_g, cos, sin):
    b, s, _ = cols.shape
    h, dq, dv = DIFF_HEADS, DIFF_QK_DIM, DIFF_V_DIM
    q, k, v = split_cols(cols, [h * 2 * dq, h * 2 * dq, h * dv])
    q = apply_rope(q.reshape(b, s, h * 2, dq), cos, sin).reshape(b, s, h, 2, dq)
    k = apply_rope(k.reshape(b, s, h * 2, dq), cos, sin).reshape(b, s, h, 2, dq)
    v = v.reshape(b, s, h, dv)
    lam_init = 0.8 - 0.6 * math.exp(-0.3 * layer)
    f32 = jnp.float32
    lam = (jnp.exp(jnp.sum(lq1.astype(f32) * lk1.astype(f32)))
           - jnp.exp(jnp.sum(lq2.astype(f32) * lk2.astype(f32))) + lam_init)
    scale = dq ** -0.5
    kpos = jnp.arange(s)

    def blk(args):
        qq, i = args
        qpos = i * Q_BLOCK + jnp.arange(Q_BLOCK)
        mask = kpos[None, :] <= qpos[:, None]
        sc = jnp.einsum('bqhcd,bkhcd->bhcqk', qq, k).astype(f32) * scale
        p = jax.nn.softmax(jnp.where(mask, sc, NEG), axis=-1)
        a = p[:, :, 0] - lam * p[:, :, 1]
        return jnp.einsum('bhqk,bkhd->bqhd', a.astype(v.dtype), v)

    o = from_blocks(lax.map(blk, (to_blocks(q), jnp.arange(s // Q_BLOCK))))
    o = rms_norm(o, sub_g) * (1.0 - lam_init)
    return o.reshape(b, s, h * dv)


def mla_mixer(cols, q_norm_g, w_uq, kv_norm_g, w_ukv, cos, sin):
    b, s, _ = cols.shape
    h = MLA_HEADS
    c_q, c_kv, k_rope = split_cols(cols, [MLA_Q_RANK, MLA_KV_RANK, MLA_ROPE_DIM])
    q = (rms_norm(c_q, q_norm_g) @ w_uq).reshape(b, s, h, MLA_NOPE_DIM + MLA_ROPE_DIM)
    q_nope, q_rope = split_cols(q, [MLA_NOPE_DIM, MLA_ROPE_DIM])
    q_rope = apply_rope(q_rope, cos, sin)
    kv = (rms_norm(c_kv, kv_norm_g) @ w_ukv).reshape(b, s, h, MLA_NOPE_DIM + MLA_V_DIM)
    k_nope, v = split_cols(kv, [MLA_NOPE_DIM, MLA_V_DIM])
    k_rope = apply_rope(k_rope[:, :, None], cos, sin)[:, :, 0]
    scale = (MLA_NOPE_DIM + MLA_ROPE_DIM) ** -0.5
    kpos = jnp.arange(s)

    def blk(args):
        qn, qr, i = args
        qpos = i * Q_BLOCK + jnp.arange(Q_BLOCK)
        mask = kpos[None, :] <= qpos[:, None]
        sc = (jnp.einsum('bqhd,bkhd->bhqk', qn, k_nope)
              + jnp.einsum('bqhd,bkd->bhqk', qr, k_rope)).astype(jnp.float32) * scale
        p = jax.nn.softmax(jnp.where(mask, sc, NEG), axis=-1)
        return jnp.einsum('bhqk,bkhd->bqhd', p.astype(v.dtype), v)

    o = from_blocks(lax.map(blk, (to_blocks(q_nope), to_blocks(q_rope), jnp.arange(s // Q_BLOCK))))
    return o.reshape(b, s, h * MLA_V_DIM)


def swa_mixer(cols, sinks, cos, sin):
    b, s, _ = cols.shape
    d = HEAD_DIM
    q, k, v = split_cols(cols, [SWA_HEADS * d, SWA_KV_HEADS * d, SWA_KV_HEADS * d])
    q = apply_rope(q.reshape(b, s, SWA_HEADS, d), cos, sin)
    k = apply_rope(k.reshape(b, s, SWA_KV_HEADS, d), cos, sin)
    v = v.reshape(b, s, SWA_KV_HEADS, d)
    o = banded_attention(q, k, v, SWA_WINDOW, sinks)
    return o.reshape(b, s, SWA_HEADS * d)


def hybrid_mixer(h, layer, w_in, nsa_cmp_pos_k, nsa_cmp_pos_v, nsa_cmp_wk, nsa_cmp_wv,
                 diff_lam_q1, diff_lam_k1, diff_lam_q2, diff_lam_k2, diff_sub_g,
                 mla_q_norm_g, mla_w_uq, mla_kv_norm_g, mla_w_ukv, swa_sinks, w_out):
    s = h.shape[1]
    cols = h @ w_in
    nsa_c, diff_c, mla_c, swa_c = split_cols(cols, [NSA_COLS, DIFF_COLS, MLA_COLS, SWA_COLS])
    cos_h, sin_h = rope_tables(s, HEAD_DIM)
    cos_d, sin_d = rope_tables(s, DIFF_QK_DIM)
    cos_m, sin_m = rope_tables(s, MLA_ROPE_DIM)
    o_a = nsa_mixer(nsa_c, nsa_cmp_pos_k, nsa_cmp_pos_v, nsa_cmp_wk, nsa_cmp_wv, cos_h, sin_h)
    o_b = diff_mixer(diff_c, layer, diff_lam_q1, diff_lam_k1, diff_lam_q2, diff_lam_k2, diff_sub_g, cos_d, sin_d)
    o_c = mla_mixer(mla_c, mla_q_norm_g, mla_w_uq, mla_kv_norm_g, mla_w_ukv, cos_m, sin_m)
    o_d = swa_mixer(swa_c, swa_sinks, cos_h, sin_h)
    o = jnp.concatenate([o_a, o_b, o_c, o_d], axis=-1)
    return o @ w_out


def peer_ffn(h, w_q, sub_k1, sub_k2, u, v):
    b, s, d = h.shape
    t = b * s
    hk = PEER_HEADS * PEER_TOPK
    hf = h.reshape(t, d)
    q = (hf @ w_q).reshape(t, PEER_HEADS, 2, PEER_QUERY_DIM // 2)
    s1 = jnp.einsum('thd,kd->thk', q[:, :, 0], sub_k1).astype(jnp.float32)
    s2 = jnp.einsum('thd,kd->thk', q[:, :, 1], sub_k2).astype(jnp.float32)
    v1, i1 = lax.top_k(s1, PEER_TOPK)
    v2, i2 = lax.top_k(s2, PEER_TOPK)
    cand = (v1[..., :, None] + v2[..., None, :]).reshape(t, PEER_HEADS, PEER_TOPK * PEER_TOPK)
    cid = (i1[..., :, None] * PEER_N_KEYS + i2[..., None, :]).reshape(t, PEER_HEADS, PEER_TOPK * PEER_TOPK)
    top_s, top_j = lax.top_k(cand, PEER_TOPK)
    eid = jnp.take_along_axis(cid, top_j, axis=-1)
    gate = jax.nn.softmax(top_s, axis=-1)
    nch = t // PEER_CHUNK

    def chunk(args):
        hc, ec, gc = args
        act = jax.nn.gelu(jnp.einsum('cd,ced->ce', hc, u[ec]).astype(jnp.float32))
        w = (gc * act).astype(hc.dtype)
        return jnp.einsum('ce,ced->cd', w, v[ec])

    out = lax.map(chunk, (hf.reshape(nch, PEER_CHUNK, d), eid.reshape(nch, PEER_CHUNK, hk),
                          gate.reshape(nch, PEER_CHUNK, hk)))
    return out.reshape(b, s, d)


def setup_inputs(seed: int = 0) -> dict:
    key = jax.random.key(seed)
    ks = iter(jax.random.split(key, 40))

    def nrm(shape, scale):
        return jax.random.normal(next(ks), shape, jnp.float32) * scale

    def gain(shape):
        return 1.0 + 0.02 * jax.random.normal(next(ks), shape, jnp.float32)

    L, D = DEPTH, D_MODEL
    return {
        "x": nrm((BATCH, SEQ, D), 1.0),
        "c": nrm((BATCH, D), 1.0),
        "ada_w": nrm((L, D, 6 * D), 0.5 * D ** -0.5),
        "ada_b": nrm((L, 6 * D), 0.02),
        "norm_mix_g": gain((L, D)),
        "norm_ffn_g": gain((L, D)),
        "w_in": nrm((L, D, IN_COLS), D ** -0.5),
        "nsa_cmp_pos_k": nrm((L, NSA_CMP_LEN, HEAD_DIM), 0.1),
        "nsa_cmp_pos_v": nrm((L, NSA_CMP_LEN, HEAD_DIM), 0.1),
        "nsa_cmp_wk": nrm((L, NSA_CMP_LEN * HEAD_DIM, HEAD_DIM), (NSA_CMP_LEN * HEAD_DIM) ** -0.5),
        "nsa_cmp_wv": nrm((L, NSA_CMP_LEN * HEAD_DIM, HEAD_DIM), (NSA_CMP_LEN * HEAD_DIM) ** -0.5),
        "diff_lam_q1": nrm((L, DIFF_QK_DIM), 0.1),
        "diff_lam_k1": nrm((L, DIFF_QK_DIM), 0.1),
        "diff_lam_q2": nrm((L, DIFF_QK_DIM), 0.1),
        "diff_lam_k2": nrm((L, DIFF_QK_DIM), 0.1),
        "diff_sub_g": gain((L, DIFF_V_DIM)),
        "mla_q_norm_g": gain((L, MLA_Q_RANK)),
        "mla_w_uq": nrm((L, MLA_Q_RANK, MLA_HEADS * (MLA_NOPE_DIM + MLA_ROPE_DIM)), MLA_Q_RANK ** -0.5),
        "mla_kv_norm_g": gain((L, MLA_KV_RANK)),
        "mla_w_ukv": nrm((L, MLA_KV_RANK, MLA_HEADS * (MLA_NOPE_DIM + MLA_V_DIM)), MLA_KV_RANK ** -0.5),
        "swa_sinks": nrm((L, SWA_HEADS), 0.5),
        "w_out": nrm((L, MIX_WIDTH, D), MIX_WIDTH ** -0.5),
        "peer_w_q": nrm((L, D, PEER_HEADS * PEER_QUERY_DIM), D ** -0.5),
        "peer_sub_k1": nrm((L, PEER_N_KEYS, PEER_QUERY_DIM // 2), (PEER_QUERY_DIM // 2) ** -0.5),
        "peer_sub_k2": nrm((L, PEER_N_KEYS, PEER_QUERY_DIM // 2), (PEER_QUERY_DIM // 2) ** -0.5),
        "peer_u": nrm((L, PEER_EXPERTS, D), D ** -0.5),
        "peer_v": nrm((L, PEER_EXPERTS, D), PEER_HEADS ** -0.5),
        "final_g": gain((D,)),
    }


def reference(x, c, ada_w, ada_b, norm_mix_g, norm_ffn_g, w_in, nsa_cmp_pos_k, nsa_cmp_pos_v,
              nsa_cmp_wk, nsa_cmp_wv, diff_lam_q1, diff_lam_k1, diff_lam_q2, diff_lam_k2, diff_sub_g,
              mla_q_norm_g, mla_w_uq, mla_kv_norm_g, mla_w_ukv, swa_sinks, w_out,
              peer_w_q, peer_sub_k1, peer_sub_k2, peer_u, peer_v, final_g):
    for l in range(DEPTH):
        mod = jax.nn.silu(c) @ ada_w[l] + ada_b[l]
        sh1, sc1, g1, sh2, sc2, g2 = [m[:, None, :] for m in jnp.split(mod, 6, axis=-1)]
        h = rms_norm(x, norm_mix_g[l]) * (1.0 + sc1) + sh1
        x = x + g1 * hybrid_mixer(h, l, w_in[l], nsa_cmp_pos_k[l], nsa_cmp_pos_v[l], nsa_cmp_wk[l], nsa_cmp_wv[l],
                                  diff_lam_q1[l], diff_lam_k1[l], diff_lam_q2[l], diff_lam_k2[l], diff_sub_g[l],
                                  mla_q_norm_g[l], mla_w_uq[l], mla_kv_norm_g[l], mla_w_ukv[l], swa_sinks[l], w_out[l])
        h = rms_norm(x, norm_ffn_g[l]) * (1.0 + sc2) + sh2
        x = x + g2 * peer_ffn(h, peer_w_q[l], peer_sub_k1[l], peer_sub_k2[l], peer_u[l], peer_v[l])
    return rms_norm(x, final_g)
```

```cpp
#include <hip/hip_runtime.h>
#include <hip/hip_cooperative_groups.h>
#include <stdint.h>
#include <stdio.h>
namespace cg = cooperative_groups;

#ifndef FUSED
#define FUSED 1
#endif

#define DEV __device__ __forceinline__
typedef unsigned short bf16_t;
typedef short bf16x8 __attribute__((ext_vector_type(8)));
typedef float f32x16 __attribute__((ext_vector_type(16)));

constexpr int kB = 8, kS = 2048, kT = kB * kS, kD = 1024, LDC = 2432;
constexpr float kEps = 1e-6f;
constexpr float kNeg = -1e30f;
constexpr float kLog2e = 1.4426950408889634f;

constexpr size_t OFF_CTRL = 0;
constexpr size_t OFF_MOD  = 65536;
constexpr size_t OFF_ROPE = OFF_MOD + 2ull * 8 * 6144 * 4;
constexpr size_t OFF_MISC = OFF_ROPE + 2048ull * 96 * 4;
constexpr size_t OFF_WIN  = OFF_MISC + 4096;
constexpr size_t OFF_WOUT = OFF_WIN + 2ull * 2432 * 1024 * 2;
constexpr size_t OFF_WQ   = OFF_WOUT + 2ull * 1024 * 1024 * 2;
constexpr size_t OFF_WUQ  = OFF_WQ + 2ull * 2048 * 1024 * 2;
constexpr size_t OFF_WUKV = OFF_WUQ + 2ull * 384 * 256 * 2;
constexpr size_t OFF_WCK  = OFF_WUKV + 2ull * 512 * 128 * 2;
constexpr size_t OFF_WCV  = OFF_WCK + 2ull * 128 * 2048 * 2;
constexpr size_t OFF_SUBK = OFF_WCV + 2ull * 128 * 2048 * 2;
constexpr size_t OFF_PU   = OFF_SUBK + 2ull * 2 * 128 * 128 * 2;
constexpr size_t OFF_PV   = OFF_PU + 2ull * 16384 * 1024 * 2;
constexpr size_t OFF_XRES = OFF_PV + 2ull * 16384 * 1024 * 2;
constexpr size_t OFF_H    = OFF_XRES + (size_t)kT * 1024 * 4;
constexpr size_t OFF_RSTD = OFF_H + (size_t)kT * 1024 * 2;
constexpr size_t OFF_KCMP = OFF_RSTD + 2ull * kT * 4;
constexpr size_t OFF_EID  = OFF_KCMP + 2ull * 1024 * 64 * 2;
constexpr size_t OFF_GATE = OFF_EID + (size_t)kT * 128 * 4;
constexpr size_t OFF_QP   = OFF_GATE + (size_t)kT * 128 * 4;
constexpr size_t OFF_COLS = OFF_QP + (size_t)kT * 2048 * 2;
constexpr size_t OFF_KC   = OFF_COLS + (size_t)kT * LDC * 2;
constexpr size_t OFF_VC   = OFF_KC + (size_t)(kT + 64) * 64 * 2;
constexpr size_t OFF_VT   = OFF_VC + (size_t)(kT + 64) * 64 * 2;
constexpr size_t OFF_QMLA = OFF_VT + 8ull * 12 * 64 * 2048 * 2;
constexpr size_t OFF_KVMLA = OFF_QMLA + (size_t)kT * 384 * 2;
constexpr size_t OFF_O    = OFF_KVMLA + (size_t)kT * 512 * 2;
constexpr size_t OFF_END  = OFF_O + (size_t)kT * 1024 * 2;
constexpr size_t OFF_S1 = OFF_COLS, OFF_S2 = OFF_COLS + (size_t)kT * 8 * 128 * 4;
static_assert(OFF_S2 + (size_t)kT * 8 * 128 * 4 <= OFF_O, "alias region too small");
static_assert(OFF_END <= (512ull << 20), "workspace too large");

struct Params {
    const float *x, *c, *ada_w, *ada_b, *norm_mix_g, *norm_ffn_g, *w_in, *pos_k, *pos_v, *cmp_wk, *cmp_wv;
    const float *lq1, *lk1, *lq2, *lk2, *sub_g, *mla_qg, *mla_wuq, *mla_kvg, *mla_wukv, *sinks, *w_out;
    const float *w_q, *subk1, *subk2, *pu, *pv, *final_g;
    float* out;
    char* ws;
};

DEV int ltid() { int t = threadIdx.x; asm volatile("" : "+v"(t)); return t; }
DEV float bf2f(bf16_t v) { return __uint_as_float(((unsigned)v) << 16); }
DEV bf16_t f2bf(float f) { unsigned u = __float_as_uint(f); u += 0x7fffu + ((u >> 16) & 1u); return (bf16_t)(u >> 16); }
DEV unsigned pack2(float lo, float hi) { return (unsigned)f2bf(lo) | ((unsigned)f2bf(hi) << 16); }
DEV float lo16(unsigned u) { return __uint_as_float(u << 16); }
DEV float hi16(unsigned u) { return __uint_as_float(u & 0xffff0000u); }
DEV float wave_sum(float v) {
#pragma unroll
    for (int o = 32; o > 0; o >>= 1) v += __shfl_xor(v, o, 64);
    return v;
}
DEV f32x16 mfma32(bf16x8 a, bf16x8 b, f32x16 c) { return __builtin_amdgcn_mfma_f32_32x32x16_bf16(a, b, c, 0, 0, 0); }
DEV f32x16 zero16() { f32x16 z;
#pragma unroll
    for (int i = 0; i < 16; ++i) z[i] = 0.f;
    return z; }
DEV float gelu_tanh(float x) {
    const float u = 0.7978845608028654f * (x + 0.044715f * x * x * x);
    const float e = __expf(2.f * u);
    const float t = 1.f - 2.f / (e + 1.f);
    return 0.5f * x * (1.f + t);
}

template <class Epi>
DEV void gemm_tile(const bf16_t* __restrict__ A, int lda, const bf16_t* __restrict__ Bt, int ldb, int K, int m0, int n0, char* smem, const Epi& epi) {
    bf16_t* As = (bf16_t*)smem;
    bf16_t* Bs = As + 128 * 72;
    const int tid = ltid(), lane = tid & 63, w = tid >> 6, wm = w >> 1, wn = w & 1, ql = lane & 31, hh = lane >> 5;
    f32x16 acc[2][2];
#pragma unroll
    for (int i = 0; i < 2; ++i)
#pragma unroll
        for (int j = 0; j < 2; ++j) acc[i][j] = zero16();
    const bf16_t* Ap = A + (size_t)m0 * lda;
    const bf16_t* Bp = Bt + (size_t)n0 * ldb;
    const int lrow = tid >> 3, lck = (tid & 7) * 8;
    const bf16_t* Ag = Ap + (size_t)lrow * lda + lck;
    const bf16_t* Bg = Bp + (size_t)lrow * ldb + lck;
    const size_t a32 = (size_t)32 * lda, b32 = (size_t)32 * ldb;
    uint4 ra0 = *(const uint4*)(Ag), ra1 = *(const uint4*)(Ag + a32), ra2 = *(const uint4*)(Ag + 2 * a32), ra3 = *(const uint4*)(Ag + 3 * a32);
    uint4 rb0 = *(const uint4*)(Bg), rb1 = *(const uint4*)(Bg + b32), rb2 = *(const uint4*)(Bg + 2 * b32), rb3 = *(const uint4*)(Bg + 3 * b32);
    bf16_t* Asw = As + lrow * 72 + lck;
    bf16_t* Bsw = Bs + lrow * 72 + lck;
    for (int k0 = 0; k0 < K; k0 += 64) {
        __syncthreads();
        *(uint4*)(Asw) = ra0; *(uint4*)(Asw + 32 * 72) = ra1; *(uint4*)(Asw + 64 * 72) = ra2; *(uint4*)(Asw + 96 * 72) = ra3;
        *(uint4*)(Bsw) = rb0; *(uint4*)(Bsw + 32 * 72) = rb1; *(uint4*)(Bsw + 64 * 72) = rb2; *(uint4*)(Bsw + 96 * 72) = rb3;
        __syncthreads();
        if (k0 + 64 < K) {
            const bf16_t* Agk = Ag + k0 + 64; const bf16_t* Bgk = Bg + k0 + 64;
            ra0 = *(const uint4*)(Agk); ra1 = *(const uint4*)(Agk + a32); ra2 = *(const uint4*)(Agk + 2 * a32); ra3 = *(const uint4*)(Agk + 3 * a32);
            rb0 = *(const uint4*)(Bgk); rb1 = *(const uint4*)(Bgk + b32); rb2 = *(const uint4*)(Bgk + 2 * b32); rb3 = *(const uint4*)(Bgk + 3 * b32);
        }
#pragma unroll
        for (int ks = 0; ks < 4; ++ks) {
            bf16x8 a[2], b[2];
#pragma unroll
            for (int i = 0; i < 2; ++i) {
                a[i] = *(const bf16x8*)(As + (wm * 64 + i * 32 + ql) * 72 + ks * 16 + hh * 8);
                b[i] = *(const bf16x8*)(Bs + (wn * 64 + i * 32 + ql) * 72 + ks * 16 + hh * 8);
            }
#pragma unroll
            for (int i = 0; i < 2; ++i)
#pragma unroll
                for (int j = 0; j < 2; ++j) acc[i][j] = mfma32(a[i], b[j], acc[i][j]);
        }
    }
#pragma unroll
    for (int i = 0; i < 2; ++i)
#pragma unroll
        for (int j = 0; j < 2; ++j)
#pragma unroll
            for (int g = 0; g < 4; ++g) {
                const int m = m0 + wm * 64 + i * 32 + 8 * g + 4 * hh;
                const int n = n0 + wn * 64 + j * 32 + ql;
                epi(m, n, acc[i][j][4 * g], acc[i][j][4 * g + 1], acc[i][j][4 * g + 2], acc[i][j][4 * g + 3]);
            }
}

struct EpiBf16 {
    bf16_t* C; int ldc; const float* rowscale; const float* colbias; int nvalid;
    DEV void operator()(int m, int n, float v0, float v1, float v2, float v3) const {
        if (n >= nvalid) return;
        float bsv = colbias ? colbias[n] : 0.f;
        float s0 = 1.f, s1 = 1.f, s2 = 1.f, s3 = 1.f;
        if (rowscale) { s0 = rowscale[m]; s1 = rowscale[m + 1]; s2 = rowscale[m + 2]; s3 = rowscale[m + 3]; }
        bf16_t* p = C + (size_t)m * ldc + n;
        p[0] = f2bf(v0 * s0 + bsv); p[ldc] = f2bf(v1 * s1 + bsv); p[2 * ldc] = f2bf(v2 * s2 + bsv); p[3 * ldc] = f2bf(v3 * s3 + bsv);
    }
};
struct EpiF32 {
    float* C; int ldc;
    DEV void operator()(int m, int n, float v0, float v1, float v2, float v3) const {
        float* p = C + (size_t)m * ldc + n;
        p[0] = v0; p[ldc] = v1; p[2 * ldc] = v2; p[3 * ldc] = v3;
    }
};
struct EpiRes {
    const float* xin; float* xout; const float* gate;
    DEV void operator()(int m, int n, float v0, float v1, float v2, float v3) const {
        const float g = gate[(size_t)(m >> 11) * 6144 + n];
        const float* pi = xin + (size_t)m * 1024 + n; float* po = xout + (size_t)m * 1024 + n;
        po[0] = pi[0] + g * v0; po[1024] = pi[1024] + g * v1; po[2048] = pi[2048] + g * v2; po[3072] = pi[3072] + g * v3;
    }
};

template <class Epi>
DEV void gemm_phase(const bf16_t* A, int lda, const bf16_t* Bt, int ldb, int K, int mtiles, int ntiles, char* smem, const Epi& epi) {
    for (int tile = blockIdx.x; tile < mtiles * ntiles; tile += gridDim.x) {
        const int mt = tile / ntiles, nt = tile % ntiles;
        gemm_tile(A, lda, Bt, ldb, K, mt * 128, nt * 128, smem, epi);
    }
}

DEV int win_srccol(int n) {
    if (n < 652) return n;
    if (n < 704) return -1;
    if (n < 1888) return n - 52;
    if (n < 1920) return -1;
    return n - 84;
}
DEV void transpose_tile(const float* __restrict__ src, int ld_src, int nsrc_valid, int mode, const float* __restrict__ rowscale,
                        bf16_t* __restrict__ dst, int K, int n0, int k0, char* smem) {
    bf16_t* Ls = (bf16_t*)smem;
    const int tid = ltid();
    __syncthreads();
    const int nn = tid & 63, n = n0 + nn;
    const int sc = (mode == 1) ? win_srccol(n) : (n < nsrc_valid ? n : -1);
#pragma unroll 4
    for (int i = 0; i < 16; ++i) {
        const int kk = (tid >> 6) + 4 * i;
        float v = 0.f;
        if (sc >= 0) { v = src[(size_t)(k0 + kk) * ld_src + sc]; if (rowscale) v *= rowscale[k0 + kk]; }
        Ls[nn * 72 + kk] = f2bf(v);
    }
    __syncthreads();
#pragma unroll
    for (int i = 0; i < 2; ++i) {
        const int r = (tid >> 3) + 32 * i, ch = tid & 7;
        *(uint4*)(dst + (size_t)(n0 + r) * K + k0 + ch * 8) = *(const uint4*)(Ls + r * 72 + ch * 8);
    }
}

DEV void convert_stream(const float* __restrict__ src, bf16_t* __restrict__ dst, size_t n8) {
    const int tid = ltid();
    for (size_t i = (size_t)blockIdx.x * 256 + tid; i < n8; i += (size_t)gridDim.x * 256) {
        const float4 a = *(const float4*)(src + i * 8), b = *(const float4*)(src + i * 8 + 4);
        uint4 o; o.x = pack2(a.x, a.y); o.y = pack2(a.z, a.w); o.z = pack2(b.x, b.y); o.w = pack2(b.z, b.w);
        *(uint4*)(dst + i * 8) = o;
    }
}

constexpr int J_ROPE = 384, J_MOD = 192, J_MISC = 5;
constexpr int J_TW_L = 608 + 256 + 512 + 24 + 16 + 64 + 64;
constexpr int J_TOTAL = J_ROPE + J_MOD + J_MISC + 2 * J_TW_L;

DEV void prologue_job(const Params& p, int job, char* smem) {
    const int tid = ltid();
    char* ws = p.ws;
    if (job < J_ROPE) {
        const int idx = job * 256 + tid;
        const int s = idx / 48, j = idx % 48;
        float* rope = (float*)(ws + OFF_ROPE);
        float inv; float *pc, *ps;
        if (j < 32) { inv = exp2f(-(float)j * (13.287712379549449f / 32.f)); pc = rope + s * 32 + j; ps = rope + 2048 * 32 + s * 32 + j; }
        else { const int i = j - 32; inv = exp2f(-(float)i * (13.287712379549449f / 16.f)); pc = rope + 2048 * 64 + s * 16 + i; ps = rope + 2048 * 64 + 2048 * 16 + s * 16 + i; }
        const double a = (double)s * (double)inv;
        const double kk = rint(a * 0.15915494309189535);
        const float r = (float)fma(-kk, 6.283185307179586, a);
        *pc = cosf(r); *ps = sinf(r);
        return;
    }
    job -= J_ROPE;
    if (job < J_MOD) {
        const int l = job / 96, n0 = (job % 96) * 64;
        float* sc = (float*)smem;
        __syncthreads();
        for (int i = tid; i < 8192; i += 256) { const float v = p.c[i]; sc[i] = v / (1.f + __expf(-v)); }
        __syncthreads();
        const int kp = tid >> 6, col = tid & 63;
        float acc[8];
#pragma unroll
        for (int b = 0; b < 8; ++b) acc[b] = 0.f;
        const float* wp = p.ada_w + (size_t)l * 1024 * 6144 + n0 + col;
        for (int k = kp * 256; k < kp * 256 + 256; ++k) {
            const float wv = wp[(size_t)k * 6144];
#pragma unroll
            for (int b = 0; b < 8; ++b) acc[b] += sc[b * 1024 + k] * wv;
        }
        float* red = sc + 8192;
#pragma unroll
        for (int b = 0; b < 8; ++b) red[(kp * 8 + b) * 64 + col] = acc[b];
        __syncthreads();
        float* mod = (float*)(ws + OFF_MOD);
        for (int idx = tid; idx < 512; idx += 256) {
            const int b = idx >> 6, cl = idx & 63;
            const float v = red[(0 * 8 + b) * 64 + cl] + red[(1 * 8 + b) * 64 + cl] + red[(2 * 8 + b) * 64 + cl] + red[(3 * 8 + b) * 64 + cl];
            mod[(size_t)(l * 8 + b) * 6144 + n0 + cl] = v + p.ada_b[l * 6144 + n0 + cl];
        }
        return;
    }
    job -= J_MOD;
    if (job < J_MISC) {
        float* misc = (float*)(ws + OFF_MISC);
        if (job < 4) {
            const int l = job >> 1, kv = job & 1;
            const float* pos = (kv ? p.pos_v : p.pos_k) + l * 2048;
            const float* wsrc = (kv ? p.cmp_wv : p.cmp_wk) + (size_t)l * 2048 * 64;
            float* red = (float*)smem;
            __syncthreads();
            const int kp = tid >> 6, n = tid & 63;
            float acc = 0.f;
            for (int k = kp * 512; k < kp * 512 + 512; ++k) acc += pos[k] * wsrc[(size_t)k * 64 + n];
            red[kp * 64 + n] = acc;
            __syncthreads();
            if (tid < 64) misc[(l * 2 + kv) * 64 + tid] = red[tid] + red[64 + tid] + red[128 + tid] + red[192 + tid];
        } else if (tid < 2) {
            const int l = tid;
            float d1 = 0.f, d2 = 0.f;
            for (int i = 0; i < 32; ++i) { d1 += p.lq1[l * 32 + i] * p.lk1[l * 32 + i]; d2 += p.lq2[l * 32 + i] * p.lk2[l * 32 + i]; }
            const float lam_init = 0.8f - 0.6f * expf(-0.3f * (float)l);
            misc[256 + l] = expf(d1) - expf(d2) + lam_init;
            misc[258 + l] = 1.f - lam_init;
        }
        return;
    }
    job -= J_MISC;
    const int l = job / J_TW_L; int j = job % J_TW_L;
    if (j < 608) { transpose_tile(p.w_in + (size_t)l * 1024 * 2348, 2348, 2348, 1, nullptr, (bf16_t*)(ws + OFF_WIN) + (size_t)l * 2432 * 1024, 1024, (j / 16) * 64, (j % 16) * 64, smem); return; }
    j -= 608;
    if (j < 256) { transpose_tile(p.w_out + (size_t)l * 1024 * 1024, 1024, 1024, 0, nullptr, (bf16_t*)(ws + OFF_WOUT) + (size_t)l * 1024 * 1024, 1024, (j / 16) * 64, (j % 16) * 64, smem); return; }
    j -= 256;
    if (j < 512) { transpose_tile(p.w_q + (size_t)l * 1024 * 2048, 2048, 2048, 0, nullptr, (bf16_t*)(ws + OFF_WQ) + (size_t)l * 2048 * 1024, 1024, (j / 16) * 64, (j % 16) * 64, smem); return; }
    j -= 512;
    if (j < 24) { transpose_tile(p.mla_wuq + (size_t)l * 256 * 384, 384, 384, 0, p.mla_qg + l * 256, (bf16_t*)(ws + OFF_WUQ) + (size_t)l * 384 * 256, 256, (j / 4) * 64, (j % 4) * 64, smem); return; }
    j -= 24;
    if (j < 16) { transpose_tile(p.mla_wukv + (size_t)l * 128 * 512, 512, 512, 0, p.mla_kvg + l * 128, (bf16_t*)(ws + OFF_WUKV) + (size_t)l * 512 * 128, 128, (j / 2) * 64, (j % 2) * 64, smem); return; }
    j -= 16;
    if (j < 64) { transpose_tile(p.cmp_wk + (size_t)l * 2048 * 64, 64, 64, 0, nullptr, (bf16_t*)(ws + OFF_WCK) + (size_t)l * 128 * 2048, 2048, (j / 32) * 64, (j % 32) * 64, smem); return; }
    j -= 64;
    transpose_tile(p.cmp_wv + (size_t)l * 2048 * 64, 64, 64, 0, nullptr, (bf16_t*)(ws + OFF_WCV) + (size_t)l * 128 * 2048, 2048, (j / 32) * 64, (j % 32) * 64, smem);
}

DEV void phase_prologue(const Params& p, char* smem) {
    for (int job = blockIdx.x; job < J_TOTAL; job += gridDim.x) prologue_job(p, job, smem);
    char* ws = p.ws;
    convert_stream(p.pu, (bf16_t*)(ws + OFF_PU), 2ull * 16384 * 1024 / 8);
    convert_stream(p.pv, (bf16_t*)(ws + OFF_PV), 2ull * 16384 * 1024 / 8);
    for (int l = 0; l < 2; ++l) {
        convert_stream(p.subk1 + (size_t)l * 16384, (bf16_t*)(ws + OFF_SUBK) + (size_t)(l * 2 + 0) * 16384, 16384 / 8);
        convert_stream(p.subk2 + (size_t)l * 16384, (bf16_t*)(ws + OFF_SUBK) + (size_t)(l * 2 + 1) * 16384, 16384 / 8);
    }
}

DEV void phase_norm(const Params& p, int layer, int which) {
    const int tid = ltid(), lane = tid & 63, w = tid >> 6;
    const float* xs = (layer == 0 && which == 0) ? p.x : (const float*)(p.ws + OFF_XRES);
    const float* g = (which == 0 ? p.norm_mix_g : p.norm_ffn_g) + layer * 1024;
    const float* mod = (const float*)(p.ws + OFF_MOD) + (size_t)layer * 8 * 6144;
    bf16_t* h = (bf16_t*)(p.ws + OFF_H);
    for (int q = blockIdx.x; q < kT / 4; q += gridDim.x) {
        const int t = q * 4 + w, b = t >> 11;
        const float* xr = xs + (size_t)t * 1024;
        float4 v[4]; float ss = 0.f;
#pragma unroll
        for (int i = 0; i < 4; ++i) { v[i] = *(const float4*)(xr + i * 256 + lane * 4); ss += v[i].x * v[i].x + v[i].y * v[i].y + v[i].z * v[i].z + v[i].w * v[i].w; }
        ss = wave_sum(ss);
        const float rstd = rsqrtf(ss * (1.f / 1024.f) + kEps);
        const float* sh = mod + (size_t)b * 6144 + (which ? 3072 : 0);
        const float* sc = sh + 1024;
#pragma unroll
        for (int i = 0; i < 4; ++i) {
            const int col = i * 256 + lane * 4;
            const float4 g4 = *(const float4*)(g + col), s4 = *(const float4*)(sc + col), h4 = *(const float4*)(sh + col);
            uint2 o;
            o.x = pack2(v[i].x * rstd * g4.x * (1.f + s4.x) + h4.x, v[i].y * rstd * g4.y * (1.f + s4.y) + h4.y);
            o.y = pack2(v[i].z * rstd * g4.z * (1.f + s4.z) + h4.z, v[i].w * rstd * g4.w * (1.f + s4.w) + h4.w);
            *(uint2*)(h + (size_t)t * 1024 + col) = o;
        }
    }
}

DEV void rope8(uint4& x1, uint4& x2, const float* cs, const float* sn) {
    const float4 c0 = *(const float4*)cs, c1 = *(const float4*)(cs + 4), s0 = *(const float4*)sn, s1 = *(const float4*)(sn + 4);
    const float cc[8] = {c0.x, c0.y, c0.z, c0.w, c1.x, c1.y, c1.z, c1.w};
    const float ss[8] = {s0.x, s0.y, s0.z, s0.w, s1.x, s1.y, s1.z, s1.w};
    unsigned a[4] = {x1.x, x1.y, x1.z, x1.w}, b[4] = {x2.x, x2.y, x2.z, x2.w};
#pragma unroll
    for (int i = 0; i < 4; ++i) {
        const float a0 = lo16(a[i]), a1 = hi16(a[i]), b0 = lo16(b[i]), b1 = hi16(b[i]);
        const float o10 = a0 * cc[2 * i] - b0 * ss[2 * i], o11 = a1 * cc[2 * i + 1] - b1 * ss[2 * i + 1];
        const float o20 = a0 * ss[2 * i] + b0 * cc[2 * i], o21 = a1 * ss[2 * i + 1] + b1 * cc[2 * i + 1];
        a[i] = pack2(o10, o11); b[i] = pack2(o20, o21);
    }
    x1 = make_uint4(a[0], a[1], a[2], a[3]); x2 = make_uint4(b[0], b[1], b[2], b[3]);
}
DEV void vt_tile(const bf16_t* __restrict__ src, int ld, bf16_t* __restrict__ dst, char* smem) {
    bf16_t* Ls = (bf16_t*)smem;
    const int tid = ltid();
    __syncthreads();
#pragma unroll
    for (int i = 0; i < 2; ++i) {
        const int id = tid + 256 * i, tok = id >> 3, ch = id & 7;
        *(uint4*)(Ls + tok * 72 + ch * 8) = *(const uint4*)(src + (size_t)tok * ld + ch * 8);
    }
    __syncthreads();
#pragma unroll
    for (int i = 0; i < 2; ++i) {
        const int id = tid + 256 * i, d = id >> 3, tc = id & 7;
        unsigned short e[8];
#pragma unroll
        for (int j = 0; j < 8; ++j) e[j] = Ls[(tc * 8 + j) * 72 + d];
        uint4 o;
        o.x = (unsigned)e[0] | ((unsigned)e[1] << 16); o.y = (unsigned)e[2] | ((unsigned)e[3] << 16);
        o.z = (unsigned)e[4] | ((unsigned)e[5] << 16); o.w = (unsigned)e[6] | ((unsigned)e[7] << 16);
        *(uint4*)(dst + (size_t)d * 2048 + tc * 8) = o;
    }
}

DEV void phase_layout1(const Params& p, char* smem) {
    char* ws = p.ws;
    bf16_t* cols = (bf16_t*)(ws + OFF_COLS);
    bf16_t* kc = (bf16_t*)(ws + OFF_KC);
    bf16_t* vc = (bf16_t*)(ws + OFF_VC);
    bf16_t* VT = (bf16_t*)(ws + OFF_VT);
    float* rstd = (float*)(ws + OFF_RSTD);
    const float* rope = (const float*)(ws + OFF_ROPE);
    const float *cos64 = rope, *sin64 = rope + 2048 * 32, *cos32 = rope + 2048 * 64, *sin32 = rope + 2048 * 64 + 2048 * 16;
    const int tid = ltid();
    for (int tile = blockIdx.x; tile < kT / 64; tile += gridDim.x) {
        const int T0 = tile * 64, b = T0 >> 11, s0 = T0 & 2047;
        for (int it = tid; it < 64 * 94; it += 256) {
            const int tok = it / 94, item = it % 94;
            const int t = T0 + tok, s = s0 + tok;
            bf16_t* row = cols + (size_t)t * LDC;
            if (item < 52) {
                const int hd = item >> 2, i0 = (item & 3) * 8;
                const int base = hd < 4 ? 64 * hd : hd == 4 ? 256 : hd == 5 ? 384 : hd == 6 ? 512 : hd < 11 ? 1920 + 64 * (hd - 7) : 2176 + 64 * (hd - 11);
                uint4 x1 = *(const uint4*)(row + base + i0), x2 = *(const uint4*)(row + base + 32 + i0);
                rope8(x1, x2, cos64 + s * 32 + i0, sin64 + s * 32 + i0);
                *(uint4*)(row + base + i0) = x1; *(uint4*)(row + base + 32 + i0) = x2;
                if (hd == 4) { *(uint4*)(kc + (size_t)t * 64 + i0) = x1; *(uint4*)(kc + (size_t)t * 64 + 32 + i0) = x2; }
            } else if (item < 86) {
                const int it2 = item - 52, sub = it2 >> 1, i0 = (it2 & 1) * 8;
                const int base = sub < 8 ? 704 + 32 * sub : sub < 16 ? 960 + 32 * (sub - 8) : 1856;
                uint4 x1 = *(const uint4*)(row + base + i0), x2 = *(const uint4*)(row + base + 16 + i0);
                rope8(x1, x2, cos32 + s * 16 + i0, sin32 + s * 16 + i0);
                *(uint4*)(row + base + i0) = x1; *(uint4*)(row + base + 16 + i0) = x2;
            } else {
                const int ch = item - 86;
                *(uint4*)(vc + (size_t)t * 64 + ch * 8) = *(const uint4*)(row + 320 + ch * 8);
            }
        }
        {
            const int tok = tid >> 2, part = tid & 3, t = T0 + tok;
            const bf16_t* src = cols + (size_t)t * LDC + 1472 + (part < 3 ? part : 0) * 128;
            float ss = 0.f;
#pragma unroll 4
            for (int i = 0; i < 16; ++i) {
                const uint4 u = *(const uint4*)(src + i * 8);
                ss += lo16(u.x) * lo16(u.x) + hi16(u.x) * hi16(u.x) + lo16(u.y) * lo16(u.y) + hi16(u.y) * hi16(u.y)
                    + lo16(u.z) * lo16(u.z) + hi16(u.z) * hi16(u.z) + lo16(u.w) * lo16(u.w) + hi16(u.w) * hi16(u.w);
            }
            float vq = part < 2 ? ss : 0.f;
            vq += __shfl_xor(vq, 1, 64);
            if (part == 0) rstd[t] = rsqrtf(vq * (1.f / 256.f) + kEps);
            if (part == 2) rstd[kT + t] = rsqrtf(ss * (1.f / 128.f) + kEps);
        }
#pragma unroll 1
        for (int vh = 0; vh < 8; ++vh) {
            const int col = vh == 0 ? 448 : vh == 1 ? 576 : vh < 6 ? 1216 + 64 * (vh - 2) : 2304 + 64 * (vh - 6);
            vt_tile(cols + (size_t)T0 * LDC + col, LDC, VT + ((size_t)(b * 12 + vh) * 64) * 2048 + s0, smem);
        }
    }
}

DEV void phase_layout2(const Params& p, char* smem) {
    char* ws = p.ws;
    bf16_t* qmla = (bf16_t*)(ws + OFF_QMLA);
    const bf16_t* kvmla = (const bf16_t*)(ws + OFF_KVMLA);
    bf16_t* VT = (bf16_t*)(ws + OFF_VT);
    const float* rope = (const float*)(ws + OFF_ROPE);
    const float *cos32 = rope + 2048 * 64, *sin32 = rope + 2048 * 64 + 2048 * 16;
    const int tid = ltid();
    for (int tile = blockIdx.x; tile < kT / 64; tile += gridDim.x) {
        const int T0 = tile * 64, b = T0 >> 11, s0 = T0 & 2047;
        for (int it = tid; it < 64 * 8; it += 256) {
            const int tok = it >> 3, item = it & 7, hd = item >> 1, i0 = (item & 1) * 8;
            const int t = T0 + tok, s = s0 + tok;
            bf16_t* row = qmla + (size_t)t * 384 + hd * 96 + 64;
            uint4 x1 = *(const uint4*)(row + i0), x2 = *(const uint4*)(row + 16 + i0);
            rope8(x1, x2, cos32 + s * 16 + i0, sin32 + s * 16 + i0);
            *(uint4*)(row + i0) = x1; *(uint4*)(row + 16 + i0) = x2;
        }
#pragma unroll 1
        for (int hd = 0; hd < 4; ++hd)
            vt_tile(kvmla + (size_t)T0 * 512 + hd * 128 + 64, 512, VT + ((size_t)(b * 12 + 8 + hd) * 64) * 2048 + s0, smem);
    }
}

constexpr int SM_K = 0;
constexpr int SM_V = 18432;
constexpr int SM_IMP = SM_V + 16896;
constexpr int SM_SEL = SM_IMP + 16896;
constexpr int SM_TOTAL = SM_SEL + 1024;

struct RangeIter { int cur, end; DEV int next() { return cur < end ? cur++ : -1; } };
struct BitIter { unsigned rem; DEV int next() { if (!rem) return -1; const int k = __ffs((int)rem) - 1; rem &= rem - 1; return k; } };
struct LdRow { const bf16_t* base; int ld;
    DEV uint4 operator()(int kt, int id) const { const int row = id >> 3, part = id & 7; return *(const uint4*)(base + (size_t)(kt * 64 + row) * ld + part * 8); } };
struct LdVT { const bf16_t* base;
    DEV uint4 operator()(int kt, int id) const { const int d = id >> 3, part = id & 7; return *(const uint4*)(base + (size_t)d * 2048 + kt * 64 + part * 8); } };
struct LdMlaK { const bf16_t* kv; const bf16_t* kr;
    DEV uint4 operator()(int kt, int id) const { const int row = id / 12, part = id % 12; const size_t t = (size_t)(kt * 64 + row);
        return part < 8 ? *(const uint4*)(kv + t * 512 + part * 8) : *(const uint4*)(kr + t * LDC + (part - 8) * 8); } };

struct MaskCausal { DEV bool on(int) const { return true; } DEV bool ok(int kc, int d) const { return kc <= d; } };
template <int W> struct MaskWin { DEV bool on(int) const { return true; } DEV bool ok(int kc, int d) const { return (kc <= d) && (d - kc < W); } };
struct MaskSel { unsigned bits; DEV bool on(int kt) const { return (bits >> kt) & 1u; } DEV bool ok(int kc, int d) const { return kc <= d; } };
template <int KDIM, int NKS, int NSUB, class It, class LK, class LV, class MaskF, class SkipF>
DEV void attn_stream(It it, const LK& ldK, const LV& ldV, const MaskF& maskf, const SkipF& skipf,
                     const bf16x8* qf, f32x16 (&o)[NSUB][2], float (&m)[NSUB], float (&l)[NSUB], float scl, int tq, char* smem, int tid, int koff = 0) {
    constexpr int KCH = KDIM / 8, KSTR = KDIM + 8, NKC = (64 * KCH) / 256;
    bf16_t* Kb = (bf16_t*)(smem + SM_K);
    bf16_t* Vb = (bf16_t*)(smem + SM_V);
    const int lane = tid & 63, ql = lane & 31, hh = lane >> 5;
    uint4 rk0 = make_uint4(0, 0, 0, 0), rk1 = rk0, rk2 = rk0, rv0 = rk0, rv1 = rk0;
    int kt = it.next();
    if (kt >= 0) {
        rk0 = ldK(kt, tid); rk1 = ldK(kt, tid + 256);
        if (NKC == 3) rk2 = ldK(kt, tid + 512);
        rv0 = ldV(kt, tid); rv1 = ldV(kt, tid + 256);
    }
    while (kt >= 0) {
        __syncthreads();
        { const int id = tid, row = id / KCH, part = id % KCH; *(uint4*)(Kb + row * KSTR + part * 8) = rk0; }
        { const int id = tid + 256, row = id / KCH, part = id % KCH; *(uint4*)(Kb + row * KSTR + part * 8) = rk1; }
        if (NKC == 3) { const int id = tid + 512, row = id / KCH, part = id % KCH; *(uint4*)(Kb + row * KSTR + part * 8) = rk2; }
        { const int id = tid, row = id >> 3, part = id & 7; bf16_t* d = Vb + row * 68 + part * 8;
            *(uint2*)d = make_uint2(rv0.x, rv0.y); *(uint2*)(d + 4) = make_uint2(rv0.z, rv0.w); }
        { const int id = tid + 256, row = id >> 3, part = id & 7; bf16_t* d = Vb + row * 68 + part * 8;
            *(uint2*)d = make_uint2(rv1.x, rv1.y); *(uint2*)(d + 4) = make_uint2(rv1.z, rv1.w); }
        __syncthreads();
        const int ktn = it.next();
        if (ktn >= 0) {
            rk0 = ldK(ktn, tid); rk1 = ldK(ktn, tid + 256);
            if (NKC == 3) rk2 = ldK(ktn, tid + 512);
            rv0 = ldV(ktn, tid); rv1 = ldV(ktn, tid + 256);
        }
        if (!skipf(kt)) {
#pragma unroll
            for (int sub = 0; sub < NSUB; ++sub) {
                __builtin_amdgcn_sched_barrier(0);
                f32x16 s[2];
#pragma unroll
                for (int i = 0; i < 2; ++i) {
                    s[i] = zero16();
#pragma unroll
                    for (int ks = 0; ks < NKS; ++ks) {
                        const bf16x8 a = *(const bf16x8*)(Kb + (i * 32 + ql) * KSTR + koff + (sub * NKS + ks) * 16 + hh * 8);
                        s[i] = mfma32(a, qf[sub * NKS + ks], s[i]);
                    }
                }
                float mx = kNeg;
                const int dlim = tq - kt * 64 - 4 * hh;
                const bool on = maskf.on(kt);
#pragma unroll
                for (int i = 0; i < 2; ++i)
#pragma unroll
                    for (int r = 0; r < 16; ++r) {
                        const int kc = i * 32 + (r & 3) + 8 * (r >> 2);
                        const float v = (on && maskf.ok(kc, dlim)) ? s[i][r] * scl : kNeg;
                        s[i][r] = v; mx = fmaxf(mx, v);
                    }
                mx = fmaxf(mx, __shfl_xor(mx, 32, 64));
                const float mnew = fmaxf(m[sub], mx);
                const float alpha = __builtin_amdgcn_exp2f(m[sub] - mnew);
                m[sub] = mnew;
                float sum = 0.f;
#pragma unroll
                for (int i = 0; i < 2; ++i)
#pragma unroll
                    for (int r = 0; r < 16; ++r) { const float pv = __builtin_amdgcn_exp2f(s[i][r] - mnew); s[i][r] = pv; sum += pv; }
                l[sub] = l[sub] * alpha + sum;
#pragma unroll
                for (int dt = 0; dt < 2; ++dt)
#pragma unroll
                    for (int r = 0; r < 16; ++r) o[sub][dt][r] *= alpha;
                __builtin_amdgcn_sched_barrier(0);
#pragma unroll
                for (int ks = 0; ks < 4; ++ks) {
                    if (ks == 2) __builtin_amdgcn_sched_barrier(0);
                    const int i = ks >> 1, r0 = 8 * (ks & 1);
                    uint4 pu;
                    pu.x = pack2(s[i][r0 + 0], s[i][r0 + 1]); pu.y = pack2(s[i][r0 + 2], s[i][r0 + 3]);
                    pu.z = pack2(s[i][r0 + 4], s[i][r0 + 5]); pu.w = pack2(s[i][r0 + 6], s[i][r0 + 7]);
                    const bf16x8 pf = __builtin_bit_cast(bf16x8, pu);
#pragma unroll
                    for (int dt = 0; dt < 2; ++dt) {
                        const bf16_t* vp = Vb + (dt * 32 + ql) * 68 + ks * 16 + 4 * hh;
                        const uint2 a0 = *(const uint2*)vp, a1 = *(const uint2*)(vp + 8);
                        const bf16x8 a = __builtin_bit_cast(bf16x8, make_uint4(a0.x, a0.y, a1.x, a1.y));
                        o[sub][dt] = mfma32(a, pf, o[sub][dt]);
                    }
                }
            }
        }
        kt = ktn;
    }
}

DEV void write_o(const f32x16 (&o)[2], bf16_t* obuf, size_t row, int col0, int hh) {
#pragma unroll
    for (int dt = 0; dt < 2; ++dt)
#pragma unroll
        for (int g = 0; g < 4; ++g) {
            const int d = dt * 32 + 8 * g + 4 * hh;
            uint2 u; u.x = pack2(o[dt][4 * g], o[dt][4 * g + 1]); u.y = pack2(o[dt][4 * g + 2], o[dt][4 * g + 3]);
            *(uint2*)(obuf + row * 1024 + col0 + d) = u;
        }
}
DEV float sigmoidf(float x) { return 1.f / (1.f + __expf(-x)); }

DEV void nsa_item(const Params& p, int b, int qb, char* smem) {
    int tid = threadIdx.x; asm volatile("" : "+v"(tid));
    const int lane = tid & 63, w = tid >> 6, ql = lane & 31, hh = lane >> 5;
    char* ws = p.ws;
    const bf16_t* cols = (const bf16_t*)(ws + OFF_COLS);
    const bf16_t* VT = (const bf16_t*)(ws + OFF_VT);
    bf16_t* obuf = (bf16_t*)(ws + OFF_O);
    const int t0 = qb * 32, tq = t0 + ql;
    const size_t Tb = (size_t)b * kS;
    const bf16_t* qrow = cols + (Tb + tq) * LDC;
    bf16x8 qf[4];
#pragma unroll
    for (int ks = 0; ks < 4; ++ks) qf[ks] = *(const bf16x8*)(qrow + w * 64 + ks * 16 + hh * 8);
    const float g0 = sigmoidf(bf2f(qrow[640 + w * 3 + 0])), g1 = sigmoidf(bf2f(qrow[640 + w * 3 + 1])), g2 = sigmoidf(bf2f(qrow[640 + w * 3 + 2]));
    const float scl = 0.125f * kLog2e;
    bf16_t* Kc = (bf16_t*)(smem + SM_K);
    bf16_t* Vc = (bf16_t*)(smem + SM_V);
    float* impP = (float*)(smem + SM_IMP);
    unsigned* selm = (unsigned*)(smem + SM_SEL);
    const bf16_t* kcmp = (const bf16_t*)(ws + OFF_KCMP) + (size_t)b * 128 * 64;
    const bf16_t* vcmp = kcmp + 1024 * 64;
    __syncthreads();
#pragma unroll
    for (int i = 0; i < 4; ++i) {
        const int id = tid + 256 * i, row = id >> 3, part = id & 7;
        uint4 kk = *(const uint4*)(kcmp + row * 64 + part * 8);
        uint4 vv = *(const uint4*)(vcmp + row * 64 + part * 8);
        if (row == 127) { kk = make_uint4(0, 0, 0, 0); vv = kk; }
        *(uint4*)(Kc + row * 72 + part * 8) = kk;
        const unsigned u[4] = {vv.x, vv.y, vv.z, vv.w};
#pragma unroll
        for (int j = 0; j < 4; ++j) { Vc[(part * 8 + 2 * j) * 132 + row] = (bf16_t)(u[j] & 0xffffu); Vc[(part * 8 + 2 * j + 1) * 132 + row] = (bf16_t)(u[j] >> 16); }
    }
    __syncthreads();
    unsigned ocp[16];
    float* invs = (float*)(smem + SM_SEL) + 64;
    {
        const int cmaxv = tq >= 31 ? min((tq - 31) >> 4, 126) : -1;
        float mx = kNeg;
#pragma unroll 1
        for (int i = 0; i < 4; ++i) {
            f32x16 s = zero16();
#pragma unroll
            for (int ks = 0; ks < 4; ++ks) s = mfma32(*(const bf16x8*)(Kc + (i * 32 + ql) * 72 + ks * 16 + hh * 8), qf[ks], s);
            const int clim = cmaxv - i * 32 - 4 * hh;
#pragma unroll
            for (int r = 0; r < 16; ++r) {
                const int kc = (r & 3) + 8 * (r >> 2);
                const bool valid = (kc <= clim);
                mx = fmaxf(mx, valid ? s[r] * scl : kNeg);
            }
        }
        mx = fmaxf(mx, __shfl_xor(mx, 32, 64));
        f32x16 ocmp[2]; ocmp[0] = zero16(); ocmp[1] = zero16();
        float sum = 0.f, carprev = 0.f;
#pragma unroll 1
        for (int i = 0; i < 4; ++i) {
            f32x16 s = zero16();
#pragma unroll
            for (int ks = 0; ks < 4; ++ks) s = mfma32(*(const bf16x8*)(Kc + (i * 32 + ql) * 72 + ks * 16 + hh * 8), qf[ks], s);
            const int clim = cmaxv - i * 32 - 4 * hh;
#pragma unroll
            for (int r = 0; r < 16; ++r) {
                const int kc = (r & 3) + 8 * (r >> 2);
                const bool valid = (kc <= clim);
                const float pv = valid ? __builtin_amdgcn_exp2f(s[r] * scl - mx) : 0.f;
                s[r] = pv; sum += pv;
            }
            float own[4], car[4];
#pragma unroll
            for (int g = 0; g < 4; ++g) { own[g] = s[4 * g] + s[4 * g + 1] + s[4 * g + 2] + 0.5f * s[4 * g + 3]; car[g] = 0.5f * s[4 * g + 3]; }
#pragma unroll
            for (int g = 0; g < 4; ++g) {
                const float send = hh ? (g ? car[g > 0 ? g - 1 : 0] : carprev) : car[g];
                own[g] += __shfl_xor(send, 32, 64);
            }
            carprev = car[3];
#pragma unroll
            for (int g = 0; g < 4; ++g) impP[(w * 32 + ql) * 33 + 2 * (4 * i + g) + hh] = own[g];
#pragma unroll
            for (int sp = 0; sp < 2; ++sp) {
                const int ks = 2 * i + sp, r0 = 8 * sp;
                uint4 pu;
                pu.x = pack2(s[r0 + 0], s[r0 + 1]); pu.y = pack2(s[r0 + 2], s[r0 + 3]);
                pu.z = pack2(s[r0 + 4], s[r0 + 5]); pu.w = pack2(s[r0 + 6], s[r0 + 7]);
                const bf16x8 pf = __builtin_bit_cast(bf16x8, pu);
#pragma unroll
                for (int dt = 0; dt < 2; ++dt) {
                    const bf16_t* vp = Vc + (dt * 32 + ql) * 132 + ks * 16 + 4 * hh;
                    const uint2 a0 = *(const uint2*)vp, a1 = *(const uint2*)(vp + 8);
                    ocmp[dt] = mfma32(__builtin_bit_cast(bf16x8, make_uint4(a0.x, a0.y, a1.x, a1.y)), pf, ocmp[dt]);
                }
            }
        }
        sum += __shfl_xor(sum, 32, 64);
        const float inv = sum > 0.f ? 1.f / sum : 0.f;
        invs[w * 32 + ql] = inv;
        const float f = g0 * inv;
#pragma unroll
        for (int dt = 0; dt < 2; ++dt)
#pragma unroll
            for (int r = 0; r < 8; ++r) ocp[dt * 8 + r] = pack2(f * ocmp[dt][2 * r], f * ocmp[dt][2 * r + 1]);
    }
    __syncthreads();
    const int qblk = t0 >> 6;
    {
        const int hw = tid >> 5, j = tid & 31;
#pragma unroll 1
        for (int rr = 0; rr < 4; ++rr) {
            const int row = hw * 4 + rr;
            const float v = impP[(0 * 32 + row) * 33 + j] * invs[row] + impP[(1 * 32 + row) * 33 + j] * invs[32 + row]
                          + impP[(2 * 32 + row) * 33 + j] * invs[64 + row] + impP[(3 * 32 + row) * 33 + j] * invs[96 + row];
            bool sel;
            if (qblk < 16) sel = (j <= qblk);
            else {
                const bool cand = (j >= 1) && (j <= qblk - 2);
                const bool forced = (j == 0) || (j == qblk) || (j == qblk - 1);
                int rank = 0;
                for (int j2 = 1; j2 <= qblk - 2; ++j2) {
                    const float v2 = __shfl(v, (lane & 32) + j2, 64);
                    rank += (v2 > v || (v2 == v && j2 < j)) ? 1 : 0;
                }
                sel = forced || (cand && rank < 13);
            }
            const unsigned long long bal = __ballot(sel);
            const unsigned mk = (lane & 32) ? (unsigned)(bal >> 32) : (unsigned)bal;
            if (j == 0) selm[row] = mk;
        }
    }
    __syncthreads();
    const unsigned mysel = selm[ql];
    unsigned U = mysel;
#pragma unroll
    for (int o = 16; o > 0; o >>= 1) U |= (unsigned)__shfl_xor((int)U, o, 64);
    {
        f32x16 o1[1][2]; o1[0][0] = zero16(); o1[0][1] = zero16();
        float m1[1] = {kNeg}, l1[1] = {0.f};
        auto skipf = [&](int) { return false; };
        attn_stream<64, 4, 1>(BitIter{U}, LdRow{cols + Tb * LDC + 384, LDC}, LdVT{VT + (size_t)(b * 12 + 0) * 64 * 2048}, MaskSel{mysel}, skipf, qf, o1, m1, l1, scl, tq, smem, tid);
        const float lt = l1[0] + __shfl_xor(l1[0], 32, 64);
        const float f = g1 / lt;
#pragma unroll
        for (int dt = 0; dt < 2; ++dt)
#pragma unroll
            for (int r = 0; r < 8; ++r) ocp[dt * 8 + r] = pack2(lo16(ocp[dt * 8 + r]) + f * o1[0][dt][2 * r], hi16(ocp[dt * 8 + r]) + f * o1[0][dt][2 * r + 1]);
    }
    {
        f32x16 o1[1][2]; o1[0][0] = zero16(); o1[0][1] = zero16();
        float m1[1] = {kNeg}, l1[1] = {0.f};
        auto skipf = [&](int) { return false; };
        const int lo = t0 >= 511 ? ((t0 - 511) >> 6) : 0;
        attn_stream<64, 4, 1>(RangeIter{lo, qblk + 1}, LdRow{cols + Tb * LDC + 512, LDC}, LdVT{VT + (size_t)(b * 12 + 1) * 64 * 2048}, MaskWin<512>{}, skipf, qf, o1, m1, l1, scl, tq, smem, tid);
        const float lt = l1[0] + __shfl_xor(l1[0], 32, 64);
        const float f = g2 / lt;
#pragma unroll
        for (int dt = 0; dt < 2; ++dt)
#pragma unroll
            for (int r = 0; r < 8; ++r) { o1[0][dt][2 * r] = lo16(ocp[dt * 8 + r]) + f * o1[0][dt][2 * r]; o1[0][dt][2 * r + 1] = hi16(ocp[dt * 8 + r]) + f * o1[0][dt][2 * r + 1]; }
        write_o(o1[0], obuf, Tb + tq, w * 64, hh);
    }
}

DEV void diff_item(const Params& p, int layer, int b, int hd, int q64, char* smem) {
    int tid = threadIdx.x; asm volatile("" : "+v"(tid));
    const int lane = tid & 63, w = tid >> 6, ql = lane & 31, hh = lane >> 5;
    const int sub = w & 1, qbw = w >> 1;
    char* ws = p.ws;
    const bf16_t* cols = (const bf16_t*)(ws + OFF_COLS);
    const bf16_t* VT = (const bf16_t*)(ws + OFF_VT);
    bf16_t* obuf = (bf16_t*)(ws + OFF_O);
    const float* misc = (const float*)(ws + OFF_MISC);
    const int t0w = q64 * 64 + qbw * 32, tq = t0w + ql;
    const size_t Tb = (size_t)b * kS;
    const bf16_t* qrow = cols + (Tb + tq) * LDC + 704 + hd * 64 + sub * 32;
    bf16x8 qf[2];
#pragma unroll
    for (int ks = 0; ks < 2; ++ks) qf[ks] = *(const bf16x8*)(qrow + ks * 16 + hh * 8);
    const float scl = 0.17677669529663687f * kLog2e;
    f32x16 o1[1][2]; o1[0][0] = zero16(); o1[0][1] = zero16();
    float m1[1] = {kNeg}, l1[1] = {0.f};
    auto skipf = [&](int kt) { return kt * 64 > t0w + 31; };
    attn_stream<64, 2, 1>(RangeIter{0, q64 + 1}, LdRow{cols + Tb * LDC + 960 + hd * 64, LDC}, LdVT{VT + (size_t)(b * 12 + 2 + hd) * 64 * 2048}, MaskCausal{}, skipf, qf, o1, m1, l1, scl, tq, smem, tid, sub * 32);
    const float lam = misc[256 + layer], post = misc[258 + layer];
    const float lt = l1[0] + __shfl_xor(l1[0], 32, 64);
    float* ex = (float*)smem;
    __syncthreads();
    if (sub == 1) {
        const float f = lam / lt;
#pragma unroll
        for (int dt = 0; dt < 2; ++dt)
#pragma unroll
            for (int r = 0; r < 16; ++r) ex[((qbw * 2 + dt) * 16 + r) * 64 + lane] = o1[0][dt][r] * f;
    }
    __syncthreads();
    if (sub == 0) {
        const float f = 1.f / lt;
        float ss = 0.f;
#pragma unroll
        for (int dt = 0; dt < 2; ++dt)
#pragma unroll
            for (int r = 0; r < 16; ++r) { const float v = o1[0][dt][r] * f - ex[((qbw * 2 + dt) * 16 + r) * 64 + lane]; o1[0][dt][r] = v; ss += v * v; }
        ss += __shfl_xor(ss, 32, 64);
        const float rstd = rsqrtf(ss * (1.f / 64.f) + kEps) * post;
        const float* sg = p.sub_g + layer * 64;
#pragma unroll
        for (int dt = 0; dt < 2; ++dt)
#pragma unroll
            for (int r = 0; r < 16; ++r) { const int d = dt * 32 + (r & 3) + 8 * (r >> 2) + 4 * hh; o1[0][dt][r] *= rstd * sg[d]; }
        write_o(o1[0], obuf, Tb + tq, 256 + hd * 64, hh);
    }
}

DEV void mla_item(const Params& p, int b, int hd, int qc, char* smem) {
    int tid = threadIdx.x; asm volatile("" : "+v"(tid));
    const int lane = tid & 63, w = tid >> 6, ql = lane & 31, hh = lane >> 5;
    char* ws = p.ws;
    const bf16_t* cols = (const bf16_t*)(ws + OFF_COLS);
    const bf16_t* VT = (const bf16_t*)(ws + OFF_VT);
    const bf16_t* qmla = (const bf16_t*)(ws + OFF_QMLA);
    const bf16_t* kvmla = (const bf16_t*)(ws + OFF_KVMLA);
    bf16_t* obuf = (bf16_t*)(ws + OFF_O);
    const int t0w = qc * 128 + w * 32, tq = t0w + ql;
    const size_t Tb = (size_t)b * kS;
    const bf16_t* qrow = qmla + (Tb + tq) * 384 + hd * 96;
    bf16x8 qf[6];
#pragma unroll
    for (int ks = 0; ks < 6; ++ks) qf[ks] = *(const bf16x8*)(qrow + ks * 16 + hh * 8);
    const float scl = 0.10206207261596575f * kLog2e;
    f32x16 o1[1][2]; o1[0][0] = zero16(); o1[0][1] = zero16();
    float m1[1] = {kNeg}, l1[1] = {0.f};
    auto skipf = [&](int kt) { return kt * 64 > t0w + 31; };
    attn_stream<96, 6, 1>(RangeIter{0, 2 * qc + 2}, LdMlaK{kvmla + Tb * 512 + hd * 128, cols + Tb * LDC + 1856}, LdVT{VT + (size_t)(b * 12 + 8 + hd) * 64 * 2048}, MaskCausal{}, skipf, qf, o1, m1, l1, scl, tq, smem, tid);
    const float inv = 1.f / (l1[0] + __shfl_xor(l1[0], 32, 64));
#pragma unroll
    for (int dt = 0; dt < 2; ++dt)
#pragma unroll
        for (int r = 0; r < 16; ++r) o1[0][dt][r] *= inv;
    write_o(o1[0], obuf, Tb + tq, 512 + hd * 64, hh);
}

DEV void swa_item(const Params& p, int layer, int b, int g, int q64, char* smem) {
    int tid = threadIdx.x; asm volatile("" : "+v"(tid));
    const int lane = tid & 63, w = tid >> 6, ql = lane & 31, hh = lane >> 5;
    char* ws = p.ws;
    const bf16_t* cols = (const bf16_t*)(ws + OFF_COLS);
    const bf16_t* VT = (const bf16_t*)(ws + OFF_VT);
    bf16_t* obuf = (bf16_t*)(ws + OFF_O);
    const int head = g * 2 + (w & 1);
    const int t0w = q64 * 64 + (w >> 1) * 32, tq = t0w + ql;
    const size_t Tb = (size_t)b * kS;
    const bf16_t* qrow = cols + (Tb + tq) * LDC + 1920 + head * 64;
    bf16x8 qf[4];
#pragma unroll
    for (int ks = 0; ks < 4; ++ks) qf[ks] = *(const bf16x8*)(qrow + ks * 16 + hh * 8);
    const float scl = 0.125f * kLog2e;
    f32x16 o1[1][2]; o1[0][0] = zero16(); o1[0][1] = zero16();
    float m1[1] = {p.sinks[layer * 4 + head] * kLog2e}, l1[1] = {hh == 0 ? 1.f : 0.f};
    auto skipf = [&](int kt) { return (kt * 64 > t0w + 31) || (kt * 64 + 63 < t0w - 127); };
    const int lo = q64 >= 2 ? q64 - 2 : 0;
    attn_stream<64, 4, 1>(RangeIter{lo, q64 + 1}, LdRow{cols + Tb * LDC + 2176 + g * 64, LDC}, LdVT{VT + (size_t)(b * 12 + 6 + g) * 64 * 2048}, MaskWin<128>{}, skipf, qf, o1, m1, l1, scl, tq, smem, tid);
    const float inv = 1.f / (l1[0] + __shfl_xor(l1[0], 32, 64));
#pragma unroll
    for (int dt = 0; dt < 2; ++dt)
#pragma unroll
        for (int r = 0; r < 16; ++r) o1[0][dt][r] *= inv;
    write_o(o1[0], obuf, Tb + tq, 768 + head * 64, hh);
}

DEV void phase_attn(const Params& p, int layer, char* smem) {
    unsigned* ctr = (unsigned*)(p.ws + OFF_CTRL) + 64 + layer * 16;
    volatile int* slot = (volatile int*)(smem + SM_SEL) + 48;
    for (;;) {
        __syncthreads();
        if (ltid() == 0) *slot = (int)atomicAdd(ctr, 1u);
        __syncthreads();
        const int idx = *slot;
        if (idx >= 2560) break;
        const int level = 15 - idx / 160, r = idx % 160;
        if (r < 64) { const int b = (r & 31) >> 2; diff_item(p, layer, b, r & 3, level * 2 + (1 - (r >> 5)), smem); }
        else if (r < 96) { const int k = r - 64; mla_item(p, k >> 2, k & 3, level, smem); }
        else if (r < 128) { const int k = r - 96; nsa_item(p, k >> 2, level * 4 + (3 - (k & 3)), smem); }
        else { const int k = r - 128; swa_item(p, layer, k >> 2, (k >> 1) & 1, level * 2 + (k & 1), smem); }
    }
}

DEV unsigned fkey(float f) { const unsigned u = __float_as_uint(f); return (u & 0x80000000u) ? ~u : (u | 0x80000000u); }
DEV unsigned wave_umax(unsigned v) {
#pragma unroll
    for (int o = 32; o > 0; o >>= 1) { const unsigned t = (unsigned)__shfl_xor((int)v, o, 64); v = t > v ? t : v; }
    return v;
}
DEV void phase_topk(const Params& p) {
    const int tid = ltid(), lane = tid & 63, w = tid >> 6;
    const float* S1 = (const float*)(p.ws + OFF_S1);
    const float* S2 = (const float*)(p.ws + OFF_S2);
    int* eid = (int*)(p.ws + OFF_EID);
    float* gate = (float*)(p.ws + OFF_GATE);
    for (int q = blockIdx.x; q < kT * 8 / 4; q += gridDim.x) {
        const int row = q * 4 + w;
        const float* r1 = S1 + (size_t)row * 128;
        const float* r2 = S2 + (size_t)row * 128;
        float v1 = 0.f, v2 = 0.f; int i1 = 0, i2 = 0;
#pragma unroll
        for (int half = 0; half < 2; ++half) {
            const float* rr = half ? r2 : r1;
            unsigned k0 = (fkey(rr[lane]) & ~127u) | (unsigned)(127 - lane);
            unsigned k1 = (fkey(rr[lane + 64]) & ~127u) | (unsigned)(63 - lane);
            unsigned mine = 0u;
#pragma unroll 1
            for (int r = 0; r < 16; ++r) {
                const unsigned mx = wave_umax(k0 > k1 ? k0 : k1);
                if (k0 == mx) k0 = 0u;
                if (k1 == mx) k1 = 0u;
                if (lane == r) mine = mx;
            }
            const int idx = 127 - (int)(mine & 127u);
            const float val = rr[idx];
            if (half) { v2 = val; i2 = idx; } else { v1 = val; i1 = idx; }
        }
        const int a = lane >> 2;
        const float va = __shfl(v1, a, 64);
        unsigned ck[4];
#pragma unroll
        for (int j = 0; j < 4; ++j) {
            const int bb = (lane & 3) * 4 + j;
            const float cs = va + __shfl(v2, bb, 64);
            ck[j] = (fkey(cs) & ~255u) | (unsigned)(255 - (a * 16 + bb));
        }
        unsigned minec = 0u;
#pragma unroll 1
        for (int r = 0; r < 16; ++r) {
            unsigned lm = ck[0] > ck[1] ? ck[0] : ck[1]; const unsigned lm2 = ck[2] > ck[3] ? ck[2] : ck[3]; lm = lm > lm2 ? lm : lm2;
            const unsigned mx = wave_umax(lm);
#pragma unroll
            for (int j = 0; j < 4; ++j) if (ck[j] == mx) ck[j] = 0u;
            if (lane == r) minec = mx;
        }
        const int cidx = 255 - (int)(minec & 255u);
        const int ca = cidx >> 4, cb = cidx & 15;
        const float ts = __shfl(v1, ca, 64) + __shfl(v2, cb, 64);
        const int e = __shfl(i1, ca, 64) * 128 + __shfl(i2, cb, 64);
        const float tmax = __shfl(ts, 0, 64);
        const float ex = lane < 16 ? __expf(ts - tmax) : 0.f;
        const float sum = wave_sum(ex);
        if (lane < 16) { eid[(size_t)row * 16 + lane] = e; gate[(size_t)row * 16 + lane] = ex / sum; }
    }
}

DEV void phase_experts(const Params& p, int layer) {
    const int tid = ltid(), lane = tid & 63, w = tid >> 6;
    char* ws = p.ws;
    const bf16_t* U = (const bf16_t*)(ws + OFF_PU) + (size_t)layer * 16384 * 1024;
    const bf16_t* V = (const bf16_t*)(ws + OFF_PV) + (size_t)layer * 16384 * 1024;
    bf16_t* h = (bf16_t*)(ws + OFF_H);
    float* xres = (float*)(ws + OFF_XRES);
    const int* eid = (const int*)(ws + OFF_EID);
    const float* gate = (const float*)(ws + OFF_GATE);
    const float* mod = (const float*)(ws + OFF_MOD);
    for (int q = blockIdx.x; q < kT / 4; q += gridDim.x) {
        const int t = q * 4 + w, b = t >> 11;
        float hf[16];
        {
            const uint4 h0 = *(const uint4*)(h + (size_t)t * 1024 + lane * 8), h1 = *(const uint4*)(h + (size_t)t * 1024 + 512 + lane * 8);
            hf[0] = lo16(h0.x); hf[1] = hi16(h0.x); hf[2] = lo16(h0.y); hf[3] = hi16(h0.y); hf[4] = lo16(h0.z); hf[5] = hi16(h0.z); hf[6] = lo16(h0.w); hf[7] = hi16(h0.w);
            hf[8] = lo16(h1.x); hf[9] = hi16(h1.x); hf[10] = lo16(h1.y); hf[11] = hi16(h1.y); hf[12] = lo16(h1.z); hf[13] = hi16(h1.z); hf[14] = lo16(h1.w); hf[15] = hi16(h1.w);
        }
        const int e0 = eid[(size_t)t * 128 + lane], e1 = eid[(size_t)t * 128 + 64 + lane];
        const float ga = gate[(size_t)t * 128 + lane], gb = gate[(size_t)t * 128 + 64 + lane];
        float out[16];
#pragma unroll
        for (int j = 0; j < 16; ++j) out[j] = 0.f;
#pragma unroll 4
        for (int e = 0; e < 128; ++e) {
            const int ex = __builtin_amdgcn_readlane(e < 64 ? e0 : e1, e & 63);
            const float gt = __int_as_float(__builtin_amdgcn_readlane(__float_as_int(e < 64 ? ga : gb), e & 63));
            const bf16_t* ur = U + (size_t)ex * 1024;
            const bf16_t* vr = V + (size_t)ex * 1024;
            const uint4 u0 = *(const uint4*)(ur + lane * 8), u1 = *(const uint4*)(ur + 512 + lane * 8);
            const uint4 w0 = *(const uint4*)(vr + lane * 8), w1 = *(const uint4*)(vr + 512 + lane * 8);
            float d = hf[0] * lo16(u0.x) + hf[1] * hi16(u0.x) + hf[2] * lo16(u0.y) + hf[3] * hi16(u0.y)
                    + hf[4] * lo16(u0.z) + hf[5] * hi16(u0.z) + hf[6] * lo16(u0.w) + hf[7] * hi16(u0.w)
                    + hf[8] * lo16(u1.x) + hf[9] * hi16(u1.x) + hf[10] * lo16(u1.y) + hf[11] * hi16(u1.y)
                    + hf[12] * lo16(u1.z) + hf[13] * hi16(u1.z) + hf[14] * lo16(u1.w) + hf[15] * hi16(u1.w);
            d = wave_sum(d);
            const float wg = gt * gelu_tanh(d);
            out[0] += wg * lo16(w0.x); out[1] += wg * hi16(w0.x); out[2] += wg * lo16(w0.y); out[3] += wg * hi16(w0.y);
            out[4] += wg * lo16(w0.z); out[5] += wg * hi16(w0.z); out[6] += wg * lo16(w0.w); out[7] += wg * hi16(w0.w);
            out[8] += wg * lo16(w1.x); out[9] += wg * hi16(w1.x); out[10] += wg * lo16(w1.y); out[11] += wg * hi16(w1.y);
            out[12] += wg * lo16(w1.z); out[13] += wg * hi16(w1.z); out[14] += wg * lo16(w1.w); out[15] += wg * hi16(w1.w);
        }
        const float* g2 = mod + (size_t)(layer * 8 + b) * 6144 + 5120;
        float xn[16]; float ss = 0.f;
#pragma unroll
        for (int c = 0; c < 2; ++c) {
            const int col = c * 512 + lane * 8;
            const float4 xa = *(const float4*)(xres + (size_t)t * 1024 + col), xb = *(const float4*)(xres + (size_t)t * 1024 + col + 4);
            const float4 ga4 = *(const float4*)(g2 + col), gb4 = *(const float4*)(g2 + col + 4);
            xn[c * 8 + 0] = xa.x + ga4.x * out[c * 8 + 0]; xn[c * 8 + 1] = xa.y + ga4.y * out[c * 8 + 1];
            xn[c * 8 + 2] = xa.z + ga4.z * out[c * 8 + 2]; xn[c * 8 + 3] = xa.w + ga4.w * out[c * 8 + 3];
            xn[c * 8 + 4] = xb.x + gb4.x * out[c * 8 + 4]; xn[c * 8 + 5] = xb.y + gb4.y * out[c * 8 + 5];
            xn[c * 8 + 6] = xb.z + gb4.z * out[c * 8 + 6]; xn[c * 8 + 7] = xb.w + gb4.w * out[c * 8 + 7];
        }
#pragma unroll
        for (int j = 0; j < 16; ++j) ss += xn[j] * xn[j];
        ss = wave_sum(ss);
        const float rstd = rsqrtf(ss * (1.f / 1024.f) + kEps);
        if (layer == 0) {
            const float* g = p.norm_mix_g + 1024;
            const float* sh = mod + (size_t)(8 + b) * 6144;
            const float* sc = sh + 1024;
#pragma unroll
            for (int c = 0; c < 2; ++c) {
                const int col = c * 512 + lane * 8;
                *(float4*)(xres + (size_t)t * 1024 + col) = make_float4(xn[c * 8], xn[c * 8 + 1], xn[c * 8 + 2], xn[c * 8 + 3]);
                *(float4*)(xres + (size_t)t * 1024 + col + 4) = make_float4(xn[c * 8 + 4], xn[c * 8 + 5], xn[c * 8 + 6], xn[c * 8 + 7]);
                float hv[8];
#pragma unroll
                for (int j = 0; j < 8; ++j) hv[j] = xn[c * 8 + j] * rstd * g[col + j] * (1.f + sc[col + j]) + sh[col + j];
                uint4 o; o.x = pack2(hv[0], hv[1]); o.y = pack2(hv[2], hv[3]); o.z = pack2(hv[4], hv[5]); o.w = pack2(hv[6], hv[7]);
                *(uint4*)(h + (size_t)t * 1024 + col) = o;
            }
        } else {
#pragma unroll
            for (int c = 0; c < 2; ++c) {
                const int col = c * 512 + lane * 8;
                const float4 fa = *(const float4*)(p.final_g + col), fb = *(const float4*)(p.final_g + col + 4);
                *(float4*)(p.out + (size_t)t * 1024 + col) = make_float4(xn[c * 8] * rstd * fa.x, xn[c * 8 + 1] * rstd * fa.y, xn[c * 8 + 2] * rstd * fa.z, xn[c * 8 + 3] * rstd * fa.w);
                *(float4*)(p.out + (size_t)t * 1024 + col + 4) = make_float4(xn[c * 8 + 4] * rstd * fb.x, xn[c * 8 + 5] * rstd * fb.y, xn[c * 8 + 6] * rstd * fb.z, xn[c * 8 + 7] * rstd * fb.w);
            }
        }
    }
}

DEV void phase_gemm_in(const Params& p, int layer, char* smem) {
    char* ws = p.ws;
    EpiBf16 epi{(bf16_t*)(ws + OFF_COLS), LDC, nullptr, nullptr, LDC};
    gemm_phase((const bf16_t*)(ws + OFF_H), 1024, (const bf16_t*)(ws + OFF_WIN) + (size_t)layer * 2432 * 1024, 1024, 1024, kT / 128, LDC / 128, smem, epi);
}
DEV void phase_gemm_mid(const Params& p, int layer, char* smem) {
    char* ws = p.ws;
    const float* misc = (const float*)(ws + OFF_MISC);
    const float* rstd = (const float*)(ws + OFF_RSTD);
    const bf16_t* cols = (const bf16_t*)(ws + OFF_COLS);
    for (int tile = blockIdx.x; tile < 16 + 384 + 512; tile += gridDim.x) {
        if (tile < 8) {
            EpiBf16 epi{(bf16_t*)(ws + OFF_KCMP), 64, nullptr, misc + (layer * 2 + 0) * 64, 64};
            gemm_tile((const bf16_t*)(ws + OFF_KC), 1024, (const bf16_t*)(ws + OFF_WCK) + (size_t)layer * 128 * 2048, 2048, 2048, tile * 128, 0, smem, epi);
        } else if (tile < 16) {
            EpiBf16 epi{(bf16_t*)(ws + OFF_KCMP) + 1024 * 64, 64, nullptr, misc + (layer * 2 + 1) * 64, 64};
            gemm_tile((const bf16_t*)(ws + OFF_VC), 1024, (const bf16_t*)(ws + OFF_WCV) + (size_t)layer * 128 * 2048, 2048, 2048, (tile - 8) * 128, 0, smem, epi);
        } else if (tile < 16 + 384) {
            const int tt = tile - 16;
            EpiBf16 epi{(bf16_t*)(ws + OFF_QMLA), 384, rstd, nullptr, 384};
            gemm_tile(cols + 1472, LDC, (const bf16_t*)(ws + OFF_WUQ) + (size_t)layer * 384 * 256, 256, 256, (tt / 3) * 128, (tt % 3) * 128, smem, epi);
        } else {
            const int tt = tile - 16 - 384;
            EpiBf16 epi{(bf16_t*)(ws + OFF_KVMLA), 512, rstd + kT, nullptr, 512};
            gemm_tile(cols + 1728, LDC, (const bf16_t*)(ws + OFF_WUKV) + (size_t)layer * 512 * 128, 128, 128, (tt / 4) * 128, (tt % 4) * 128, smem, epi);
        }
    }
}
DEV void phase_gemm_out(const Params& p, int layer, char* smem) {
    char* ws = p.ws;
    EpiRes epi{layer == 0 ? p.x : (const float*)(ws + OFF_XRES), (float*)(ws + OFF_XRES), (const float*)(ws + OFF_MOD) + (size_t)layer * 8 * 6144 + 2048};
    gemm_phase((const bf16_t*)(ws + OFF_O), 1024, (const bf16_t*)(ws + OFF_WOUT) + (size_t)layer * 1024 * 1024, 1024, 1024, kT / 128, 8, smem, epi);
}
DEV void phase_gemm_wq(const Params& p, int layer, char* smem) {
    char* ws = p.ws;
    EpiBf16 epi{(bf16_t*)(ws + OFF_QP), 2048, nullptr, nullptr, 2048};
    gemm_phase((const bf16_t*)(ws + OFF_H), 1024, (const bf16_t*)(ws + OFF_WQ) + (size_t)layer * 2048 * 1024, 1024, 1024, kT / 128, 16, smem, epi);
}
DEV void phase_scores(const Params& p, int layer, char* smem) {
    char* ws = p.ws;
    for (int tile = blockIdx.x; tile < 2048; tile += gridDim.x) {
        const int c = tile >> 10, mt = tile & 1023;
        EpiF32 epi{(float*)(ws + (c ? OFF_S2 : OFF_S1)), 128};
        gemm_tile((const bf16_t*)(ws + OFF_QP) + c * 128, 256, (const bf16_t*)(ws + OFF_SUBK) + (size_t)(layer * 2 + c) * 16384, 128, 128, mt * 128, 0, smem, epi);
    }
}

constexpr int NPHASE = 13;
DEV void run_phase(const Params& p, int ph, int layer, char* smem) {
    switch (ph) {
        case 0: phase_prologue(p, smem); break;
        case 1: phase_norm(p, layer, 0); break;
        case 2: phase_gemm_in(p, layer, smem); break;
        case 3: phase_layout1(p, smem); break;
        case 4: phase_gemm_mid(p, layer, smem); break;
        case 5: phase_layout2(p, smem); break;
        case 6: phase_attn(p, layer, smem); break;
        case 7: phase_gemm_out(p, layer, smem); break;
        case 8: phase_norm(p, layer, 1); break;
        case 9: phase_gemm_wq(p, layer, smem); break;
        case 10: phase_scores(p, layer, smem); break;
        case 11: phase_topk(p); break;
        case 12: phase_experts(p, layer); break;
        default: break;
    }
}

#if !FUSED
template <int PH>
__global__ void __launch_bounds__(256, 2) k_phase(Params p, int layer) {
    __shared__ __attribute__((aligned(16))) char smem[SM_TOTAL];
    run_phase(p, PH, layer, smem);
}
template <int PH> static void launch_phase(const Params& p, int layer, hipStream_t stream) { k_phase<PH><<<512, 256, 0, stream>>>(p, layer); }
static void launch_ph(int ph, const Params& p, int layer, hipStream_t stream) {
    switch (ph) {
        case 0: launch_phase<0>(p, layer, stream); break;
        case 1: launch_phase<1>(p, layer, stream); break;
        case 2: launch_phase<2>(p, layer, stream); break;
        case 3: launch_phase<3>(p, layer, stream); break;
        case 4: launch_phase<4>(p, layer, stream); break;
        case 5: launch_phase<5>(p, layer, stream); break;
        case 6: launch_phase<6>(p, layer, stream); break;
        case 7: launch_phase<7>(p, layer, stream); break;
        case 8: launch_phase<8>(p, layer, stream); break;
        case 9: launch_phase<9>(p, layer, stream); break;
        case 10: launch_phase<10>(p, layer, stream); break;
        case 11: launch_phase<11>(p, layer, stream); break;
        case 12: launch_phase<12>(p, layer, stream); break;
    }
}
#else
__global__ void __launch_bounds__(256, 2) k_mega(Params p) {
    __shared__ __attribute__((aligned(16))) char smem[SM_TOTAL];
    cg::grid_group grid = cg::this_grid();
    run_phase(p, 0, 0, smem);
    grid.sync();
    run_phase(p, 1, 0, smem);
    grid.sync();
#pragma unroll 1
    for (int l = 0; l < 2; ++l) {
#pragma unroll 1
        for (int ph = 2; ph < NPHASE; ++ph) {
            run_phase(p, ph, l, smem);
            if (!(l == 1 && ph == NPHASE - 1)) grid.sync();
        }
    }
}
#endif

extern "C" void kernel_launch(void* const* d_in, const int* in_sizes, int n_in, void* d_out, int out_size, void* d_ws, size_t ws_size, hipStream_t stream) {
    Params p{};
    const float** pp = (const float**)&p;
    for (int i = 0; i < 28; ++i) pp[i] = (const float*)d_in[i];
    p.out = (float*)d_out;
    p.ws = (char*)d_ws;
    if (ws_size < OFF_END) fprintf(stderr, "workspace too small: %zu < %zu\n", ws_size, (size_t)OFF_END);
    (void)hipMemsetAsync(d_ws, 0, 65536, stream);
#if !FUSED
    launch_ph(0, p, 0, stream);
    launch_ph(1, p, 0, stream);
    for (int l = 0; l < 2; ++l)
        for (int ph = 2; ph < NPHASE; ++ph) launch_ph(ph, p, l, stream);
#else
    static int grid_blocks = 0;
    if (!grid_blocks) {
        int dev = 0, cus = 0, per_cu = 0;
        (void)hipGetDevice(&dev);
        (void)hipDeviceGetAttribute(&cus, hipDeviceAttributeMultiprocessorCount, dev);
        (void)hipOccupancyMaxActiveBlocksPerMultiprocessor(&per_cu, (const void*)k_mega, 256, 0);
        if (per_cu > 2) per_cu = 2;
        if (per_cu < 1) per_cu = 1;
        grid_blocks = cus * per_cu;
    }
    void* args[] = {&p};
    hipError_t e = hipLaunchCooperativeKernel((const void*)k_mega, dim3(grid_blocks), dim3(256), args, 0, stream);
    if (e != hipSuccess) fprintf(stderr, "cooperative launch failed: %s (grid %d)\n", hipGetErrorString(e), grid_blocks);
#endif
}
```

```cpp
#include <hip/hip_runtime.h>
#include <hip/hip_cooperative_groups.h>
#include <stdint.h>
#include <stdio.h>
namespace cg = cooperative_groups;

#ifndef FUSED
#define FUSED 1
#endif

#define DEV __device__ __forceinline__
typedef unsigned short bf16_t;
typedef short bf16x8 __attribute__((ext_vector_type(8)));
typedef float f32x16 __attribute__((ext_vector_type(16)));

constexpr int kB = 8, kS = 2048, kT = kB * kS, kD = 1024, LDC = 2432;
constexpr float kEps = 1e-6f;
constexpr float kNeg = -1e30f;
constexpr float kLog2e = 1.4426950408889634f;

constexpr size_t OFF_CTRL = 0;
constexpr size_t OFF_MOD  = 65536;
constexpr size_t OFF_ROPE = OFF_MOD + 2ull * 8 * 6144 * 4;
constexpr size_t OFF_MISC = OFF_ROPE + 2048ull * 96 * 4;
constexpr size_t OFF_WIN  = OFF_MISC + 4096;
constexpr size_t OFF_WOUT = OFF_WIN + 2ull * 2432 * 1024 * 2;
constexpr size_t OFF_WQ   = OFF_WOUT + 2ull * 1024 * 1024 * 2;
constexpr size_t OFF_WUQ  = OFF_WQ + 2ull * 2048 * 1024 * 2;
constexpr size_t OFF_WUKV = OFF_WUQ + 2ull * 384 * 256 * 2;
constexpr size_t OFF_WCK  = OFF_WUKV + 2ull * 512 * 128 * 2;
constexpr size_t OFF_WCV  = OFF_WCK + 2ull * 128 * 2048 * 2;
constexpr size_t OFF_SUBK = OFF_WCV + 2ull * 128 * 2048 * 2;
constexpr size_t OFF_PU   = OFF_SUBK + 2ull * 2 * 128 * 128 * 2;
constexpr size_t OFF_PV   = OFF_PU + 2ull * 16384 * 1024 * 2;
constexpr size_t OFF_XRES = OFF_PV + 2ull * 16384 * 1024 * 2;
constexpr size_t OFF_H    = OFF_XRES + (size_t)kT * 1024 * 4;
constexpr size_t OFF_RSTD = OFF_H + (size_t)kT * 1024 * 2;
constexpr size_t OFF_KCMP = OFF_RSTD + 2ull * kT * 4;
constexpr size_t OFF_EID  = OFF_KCMP + 2ull * 1024 * 64 * 2;
constexpr size_t OFF_GATE = OFF_EID + (size_t)kT * 128 * 4;
constexpr size_t OFF_QP   = OFF_GATE + (size_t)kT * 128 * 4;
constexpr size_t OFF_COLS = OFF_QP + (size_t)kT * 2048 * 2;
constexpr size_t OFF_KC   = OFF_COLS + (size_t)kT * LDC * 2;
constexpr size_t OFF_VC   = OFF_KC + (size_t)(kT + 64) * 64 * 2;
constexpr size_t OFF_VT   = OFF_VC + (size_t)(kT + 64) * 64 * 2;
constexpr size_t OFF_QMLA = OFF_VT + 8ull * 12 * 64 * 2048 * 2;
constexpr size_t OFF_KVMLA = OFF_QMLA + (size_t)kT * 384 * 2;
constexpr size_t OFF_O    = OFF_KVMLA + (size_t)kT * 512 * 2;
constexpr size_t OFF_END  = OFF_O + (size_t)kT * 1024 * 2;
constexpr size_t OFF_S1 = OFF_COLS, OFF_S2 = OFF_COLS + (size_t)kT * 8 * 128 * 4;
static_assert(OFF_S2 + (size_t)kT * 8 * 128 * 4 <= OFF_O, "alias region too small");
static_assert(OFF_END <= (512ull << 20), "workspace too large");

struct Params {
    const float *x, *c, *ada_w, *ada_b, *norm_mix_g, *norm_ffn_g, *w_in, *pos_k, *pos_v, *cmp_wk, *cmp_wv;
    const float *lq1, *lk1, *lq2, *lk2, *sub_g, *mla_qg, *mla_wuq, *mla_kvg, *mla_wukv, *sinks, *w_out;
    const float *w_q, *subk1, *subk2, *pu, *pv, *final_g;
    float* out;
    char* ws;
};

DEV int ltid() { int t = threadIdx.x; asm volatile("" : "+v"(t)); return t; }
DEV float bf2f(bf16_t v) { return __uint_as_float(((unsigned)v) << 16); }
DEV bf16_t f2bf(float f) { unsigned u = __float_as_uint(f); u += 0x7fffu + ((u >> 16) & 1u); return (bf16_t)(u >> 16); }
DEV unsigned pack2(float lo, float hi) { return (unsigned)f2bf(lo) | ((unsigned)f2bf(hi) << 16); }
DEV float lo16(unsigned u) { return __uint_as_float(u << 16); }
DEV float hi16(unsigned u) { return __uint_as_float(u & 0xffff0000u); }
DEV float wave_sum(float v) {
#pragma unroll
    for (int o = 32; o > 0; o >>= 1) v += __shfl_xor(v, o, 64);
    return v;
}
DEV f32x16 mfma32(bf16x8 a, bf16x8 b, f32x16 c) { return __builtin_amdgcn_mfma_f32_32x32x16_bf16(a, b, c, 0, 0, 0); }
DEV f32x16 zero16() { f32x16 z;
#pragma unroll
    for (int i = 0; i < 16; ++i) z[i] = 0.f;
    return z; }
DEV float gelu_tanh(float x) {
    const float u = 0.7978845608028654f * (x + 0.044715f * x * x * x);
    const float e = __expf(2.f * u);
    const float t = 1.f - 2.f / (e + 1.f);
    return 0.5f * x * (1.f + t);
}

template <class Epi>
DEV void gemm_tile(const bf16_t* __restrict__ A, int lda, const bf16_t* __restrict__ Bt, int ldb, int K, int m0, int n0, char* smem, const Epi& epi) {
    bf16_t* As = (bf16_t*)smem;
    bf16_t* Bs = As + 128 * 72;
    const int tid = ltid(), lane = tid & 63, w = tid >> 6, wm = w >> 1, wn = w & 1, ql = lane & 31, hh = lane >> 5;
    f32x16 acc[2][2];
#pragma unroll
    for (int i = 0; i < 2; ++i)
#pragma unroll
        for (int j = 0; j < 2; ++j) acc[i][j] = zero16();
    const bf16_t* Ap = A + (size_t)m0 * lda;
    const bf16_t* Bp = Bt + (size_t)n0 * ldb;
    const int lrow = tid >> 3, lck = (tid & 7) * 8;
    const bf16_t* Ag = Ap + (size_t)lrow * lda + lck;
    const bf16_t* Bg = Bp + (size_t)lrow * ldb + lck;
    const size_t a32 = (size_t)32 * lda, b32 = (size_t)32 * ldb;
    uint4 ra0 = *(const uint4*)(Ag), ra1 = *(const uint4*)(Ag + a32), ra2 = *(const uint4*)(Ag + 2 * a32), ra3 = *(const uint4*)(Ag + 3 * a32);
    uint4 rb0 = *(const uint4*)(Bg), rb1 = *(const uint4*)(Bg + b32), rb2 = *(const uint4*)(Bg + 2 * b32), rb3 = *(const uint4*)(Bg + 3 * b32);
    bf16_t* Asw = As + lrow * 72 + lck;
    bf16_t* Bsw = Bs + lrow * 72 + lck;
    for (int k0 = 0; k0 < K; k0 += 64) {
        __syncthreads();
        *(uint4*)(Asw) = ra0; *(uint4*)(Asw + 32 * 72) = ra1; *(uint4*)(Asw + 64 * 72) = ra2; *(uint4*)(Asw + 96 * 72) = ra3;
        *(uint4*)(Bsw) = rb0; *(uint4*)(Bsw + 32 * 72) = rb1; *(uint4*)(Bsw + 64 * 72) = rb2; *(uint4*)(Bsw + 96 * 72) = rb3;
        __syncthreads();
        if (k0 + 64 < K) {
            const bf16_t* Agk = Ag + k0 + 64; const bf16_t* Bgk = Bg + k0 + 64;
            ra0 = *(const uint4*)(Agk); ra1 = *(const uint4*)(Agk + a32); ra2 = *(const uint4*)(Agk + 2 * a32); ra3 = *(const uint4*)(Agk + 3 * a32);
            rb0 = *(const uint4*)(Bgk); rb1 = *(const uint4*)(Bgk + b32); rb2 = *(const uint4*)(Bgk + 2 * b32); rb3 = *(const uint4*)(Bgk + 3 * b32);
        }
#pragma unroll
        for (int ks = 0; ks < 4; ++ks) {
            bf16x8 a[2], b[2];
#pragma unroll
            for (int i = 0; i < 2; ++i) {
                a[i] = *(const bf16x8*)(As + (wm * 64 + i * 32 + ql) * 72 + ks * 16 + hh * 8);
                b[i] = *(const bf16x8*)(Bs + (wn * 64 + i * 32 + ql) * 72 + ks * 16 + hh * 8);
            }
#pragma unroll
            for (int i = 0; i < 2; ++i)
#pragma unroll
                for (int j = 0; j < 2; ++j) acc[i][j] = mfma32(a[i], b[j], acc[i][j]);
        }
    }
#pragma unroll
    for (int i = 0; i < 2; ++i)
#pragma unroll
        for (int j = 0; j < 2; ++j)
#pragma unroll
            for (int g = 0; g < 4; ++g) {
                const int m = m0 + wm * 64 + i * 32 + 8 * g + 4 * hh;
                const int n = n0 + wn * 64 + j * 32 + ql;
                epi(m, n, acc[i][j][4 * g], acc[i][j][4 * g + 1], acc[i][j][4 * g + 2], acc[i][j][4 * g + 3]);
            }
}

struct EpiBf16 {
    bf16_t* C; int ldc; const float* rowscale; const float* colbias; int nvalid;
    DEV void operator()(int m, int n, float v0, float v1, float v2, float v3) const {
        if (n >= nvalid) return;
        float bsv = colbias ? colbias[n] : 0.f;
        float s0 = 1.f, s1 = 1.f, s2 = 1.f, s3 = 1.f;
        if (rowscale) { s0 = rowscale[m]; s1 = rowscale[m + 1]; s2 = rowscale[m + 2]; s3 = rowscale[m + 3]; }
        bf16_t* p = C + (size_t)m * ldc + n;
        p[0] = f2bf(v0 * s0 + bsv); p[ldc] = f2bf(v1 * s1 + bsv); p[2 * ldc] = f2bf(v2 * s2 + bsv); p[3 * ldc] = f2bf(v3 * s3 + bsv);
    }
};
struct EpiF32 {
    float* C; int ldc;
    DEV void operator()(int m, int n, float v0, float v1, float v2, float v3) const {
        float* p = C + (size_t)m * ldc + n;
        p[0] = v0; p[ldc] = v1; p[2 * ldc] = v2; p[3 * ldc] = v3;
    }
};
struct EpiRes {
    const float* xin; float* xout; const float* gate;
    DEV void operator()(int m, int n, float v0, float v1, float v2, float v3) const {
        const float g = gate[(size_t)(m >> 11) * 6144 + n];
        const float* pi = xin + (size_t)m * 1024 + n; float* po = xout + (size_t)m * 1024 + n;
        po[0] = pi[0] + g * v0; po[1024] = pi[1024] + g * v1; po[2048] = pi[2048] + g * v2; po[3072] = pi[3072] + g * v3;
    }
};

template <class Epi>
DEV void gemm_phase(const bf16_t* A, int lda, const bf16_t* Bt, int ldb, int K, int mtiles, int ntiles, char* smem, const Epi& epi) {
    for (int tile = blockIdx.x; tile < mtiles * ntiles; tile += gridDim.x) {
        const int mt = tile / ntiles, nt = tile % ntiles;
        gemm_tile(A, lda, Bt, ldb, K, mt * 128, nt * 128, smem, epi);
    }
}

DEV int win_srccol(int n) {
    if (n < 652) return n;
    if (n < 704) return -1;
    if (n < 1888) return n - 52;
    if (n < 1920) return -1;
    return n - 84;
}
DEV void transpose_tile(const float* __restrict__ src, int ld_src, int nsrc_valid, int mode, const float* __restrict__ rowscale,
                        bf16_t* __restrict__ dst, int K, int n0, int k0, char* smem) {
    bf16_t* Ls = (bf16_t*)smem;
    const int tid = ltid();
    __syncthreads();
    const int nn = tid & 63, n = n0 + nn;
    const int sc = (mode == 1) ? win_srccol(n) : (n < nsrc_valid ? n : -1);
#pragma unroll 4
    for (int i = 0; i < 16; ++i) {
        const int kk = (tid >> 6) + 4 * i;
        float v = 0.f;
        if (sc >= 0) { v = src[(size_t)(k0 + kk) * ld_src + sc]; if (rowscale) v *= rowscale[k0 + kk]; }
        Ls[nn * 72 + kk] = f2bf(v);
    }
    __syncthreads();
#pragma unroll
    for (int i = 0; i < 2; ++i) {
        const int r = (tid >> 3) + 32 * i, ch = tid & 7;
        *(uint4*)(dst + (size_t)(n0 + r) * K + k0 + ch * 8) = *(const uint4*)(Ls + r * 72 + ch * 8);
    }
}

DEV void convert_stream(const float* __restrict__ src, bf16_t* __restrict__ dst, size_t n8) {
    const int tid = ltid();
    for (size_t i = (size_t)blockIdx.x * 256 + tid; i < n8; i += (size_t)gridDim.x * 256) {
        const float4 a = *(const float4*)(src + i * 8), b = *(const float4*)(src + i * 8 + 4);
        uint4 o; o.x = pack2(a.x, a.y); o.y = pack2(a.z, a.w); o.z = pack2(b.x, b.y); o.w = pack2(b.z, b.w);
        *(uint4*)(dst + i * 8) = o;
    }
}

constexpr int J_ROPE = 384, J_MOD = 192, J_MISC = 5;
constexpr int J_TW_L = 608 + 256 + 512 + 24 + 16 + 64 + 64;
constexpr int J_TOTAL = J_ROPE + J_MOD + J_MISC + 2 * J_TW_L;

DEV void prologue_job(const Params& p, int job, char* smem) {
    const int tid = ltid();
    char* ws = p.ws;
    if (job < J_ROPE) {
        const int idx = job * 256 + tid;
        const int s = idx / 48, j = idx % 48;
        float* rope = (float*)(ws + OFF_ROPE);
        float inv; float *pc, *ps;
        if (j < 32) { inv = exp2f(-(float)j * (13.287712379549449f / 32.f)); pc = rope + s * 32 + j; ps = rope + 2048 * 32 + s * 32 + j; }
        else { const int i = j - 32; inv = exp2f(-(float)i * (13.287712379549449f / 16.f)); pc = rope + 2048 * 64 + s * 16 + i; ps = rope + 2048 * 64 + 2048 * 16 + s * 16 + i; }
        const double a = (double)s * (double)inv;
        const double kk = rint(a * 0.15915494309189535);
        const float r = (float)fma(-kk, 6.283185307179586, a);
        *pc = cosf(r); *ps = sinf(r);
        return;
    }
    job -= J_ROPE;
    if (job < J_MOD) {
        const int l = job / 96, n0 = (job % 96) * 64;
        float* sc = (float*)smem;
        __syncthreads();
        for (int i = tid; i < 8192; i += 256) { const float v = p.c[i]; sc[i] = v / (1.f + __expf(-v)); }
        __syncthreads();
        const int kp = tid >> 6, col = tid & 63;
        float acc[8];
#pragma unroll
        for (int b = 0; b < 8; ++b) acc[b] = 0.f;
        const float* wp = p.ada_w + (size_t)l * 1024 * 6144 + n0 + col;
        for (int k = kp * 256; k < kp * 256 + 256; ++k) {
            const float wv = wp[(size_t)k * 6144];
#pragma unroll
            for (int b = 0; b < 8; ++b) acc[b] += sc[b * 1024 + k] * wv;
        }
        float* red = sc + 8192;
#pragma unroll
        for (int b = 0; b < 8; ++b) red[(kp * 8 + b) * 64 + col] = acc[b];
        __syncthreads();
        float* mod = (float*)(ws + OFF_MOD);
        for (int idx = tid; idx < 512; idx += 256) {
            const int b = idx >> 6, cl = idx & 63;
            const float v = red[(0 * 8 + b) * 64 + cl] + red[(1 * 8 + b) * 64 + cl] + red[(2 * 8 + b) * 64 + cl] + red[(3 * 8 + b) * 64 + cl];
            mod[(size_t)(l * 8 + b) * 6144 + n0 + cl] = v + p.ada_b[l * 6144 + n0 + cl];
        }
        return;
    }
    job -= J_MOD;
    if (job < J_MISC) {
        float* misc = (float*)(ws + OFF_MISC);
        if (job < 4) {
            const int l = job >> 1, kv = job & 1;
            const float* pos = (kv ? p.pos_v : p.pos_k) + l * 2048;
            const float* wsrc = (kv ? p.cmp_wv : p.cmp_wk) + (size_t)l * 2048 * 64;
            float* red = (float*)smem;
            __syncthreads();
            const int kp = tid >> 6, n = tid & 63;
            float acc = 0.f;
            for (int k = kp * 512; k < kp * 512 + 512; ++k) acc += pos[k] * wsrc[(size_t)k * 64 + n];
            red[kp * 64 + n] = acc;
            __syncthreads();
            if (tid < 64) misc[(l * 2 + kv) * 64 + tid] = red[tid] + red[64 + tid] + red[128 + tid] + red[192 + tid];
        } else if (tid < 2) {
            const int l = tid;
            float d1 = 0.f, d2 = 0.f;
            for (int i = 0; i < 32; ++i) { d1 += p.lq1[l * 32 + i] * p.lk1[l * 32 + i]; d2 += p.lq2[l * 32 + i] * p.lk2[l * 32 + i]; }
            const float lam_init = 0.8f - 0.6f * expf(-0.3f * (float)l);
            misc[256 + l] = expf(d1) - expf(d2) + lam_init;
            misc[258 + l] = 1.f - lam_init;
        }
        return;
    }
    job -= J_MISC;
    const int l = job / J_TW_L; int j = job % J_TW_L;
    if (j < 608) { transpose_tile(p.w_in + (size_t)l * 1024 * 2348, 2348, 2348, 1, nullptr, (bf16_t*)(ws + OFF_WIN) + (size_t)l * 2432 * 1024, 1024, (j / 16) * 64, (j % 16) * 64, smem); return; }
    j -= 608;
    if (j < 256) { transpose_tile(p.w_out + (size_t)l * 1024 * 1024, 1024, 1024, 0, nullptr, (bf16_t*)(ws + OFF_WOUT) + (size_t)l * 1024 * 1024, 1024, (j / 16) * 64, (j % 16) * 64, smem); return; }
    j -= 256;
    if (j < 512) { transpose_tile(p.w_q + (size_t)l * 1024 * 2048, 2048, 2048, 0, nullptr, (bf16_t*)(ws + OFF_WQ) + (size_t)l * 2048 * 1024, 1024, (j / 16) * 64, (j % 16) * 64, smem); return; }
    j -= 512;
    if (j < 24) { transpose_tile(p.mla_wuq + (size_t)l * 256 * 384, 384, 384, 0, p.mla_qg + l * 256, (bf16_t*)(ws + OFF_WUQ) + (size_t)l * 384 * 256, 256, (j / 4) * 64, (j % 4) * 64, smem); return; }
    j -= 24;
    if (j < 16) { transpose_tile(p.mla_wukv + (size_t)l * 128 * 512, 512, 512, 0, p.mla_kvg + l * 128, (bf16_t*)(ws + OFF_WUKV) + (size_t)l * 512 * 128, 128, (j / 2) * 64, (j % 2) * 64, smem); return; }
    j -= 16;
    if (j < 64) { transpose_tile(p.cmp_wk + (size_t)l * 2048 * 64, 64, 64, 0, nullptr, (bf16_t*)(ws + OFF_WCK) + (size_t)l * 128 * 2048, 2048, (j / 32) * 64, (j % 32) * 64, smem); return; }
    j -= 64;
    transpose_tile(p.cmp_wv + (size_t)l * 2048 * 64, 64, 64, 0, nullptr, (bf16_t*)(ws + OFF_WCV) + (size_t)l * 128 * 2048, 2048, (j / 32) * 64, (j % 32) * 64, smem);
}

DEV void phase_prologue(const Params& p, char* smem) {
    for (int job = blockIdx.x; job < J_TOTAL; job += gridDim.x) prologue_job(p, job, smem);
    char* ws = p.ws;
    convert_stream(p.pu, (bf16_t*)(ws + OFF_PU), 2ull * 16384 * 1024 / 8);
    convert_stream(p.pv, (bf16_t*)(ws + OFF_PV), 2ull * 16384 * 1024 / 8);
    for (int l = 0; l < 2; ++l) {
        convert_stream(p.subk1 + (size_t)l * 16384, (bf16_t*)(ws + OFF_SUBK) + (size_t)(l * 2 + 0) * 16384, 16384 / 8);
        convert_stream(p.subk2 + (size_t)l * 16384, (bf16_t*)(ws + OFF_SUBK) + (size_t)(l * 2 + 1) * 16384, 16384 / 8);
    }
}

DEV void phase_norm(const Params& p, int layer, int which) {
    const int tid = ltid(), lane = tid & 63, w = tid >> 6;
    const float* xs = (layer == 0 && which == 0) ? p.x : (const float*)(p.ws + OFF_XRES);
    const float* g = (which == 0 ? p.norm_mix_g : p.norm_ffn_g) + layer * 1024;
    const float* mod = (const float*)(p.ws + OFF_MOD) + (size_t)layer * 8 * 6144;
    bf16_t* h = (bf16_t*)(p.ws + OFF_H);
    for (int q = blockIdx.x; q < kT / 4; q += gridDim.x) {
        const int t = q * 4 + w, b = t >> 11;
        const float* xr = xs + (size_t)t * 1024;
        float4 v[4]; float ss = 0.f;
#pragma unroll
        for (int i = 0; i < 4; ++i) { v[i] = *(const float4*)(xr + i * 256 + lane * 4); ss += v[i].x * v[i].x + v[i].y * v[i].y + v[i].z * v[i].z + v[i].w * v[i].w; }
        ss = wave_sum(ss);
        const float rstd = rsqrtf(ss * (1.f / 1024.f) + kEps);
        const float* sh = mod + (size_t)b * 6144 + (which ? 3072 : 0);
        const float* sc = sh + 1024;
#pragma unroll
        for (int i = 0; i < 4; ++i) {
            const int col = i * 256 + lane * 4;
            const float4 g4 = *(const float4*)(g + col), s4 = *(const float4*)(sc + col), h4 = *(const float4*)(sh + col);
            uint2 o;
            o.x = pack2(v[i].x * rstd * g4.x * (1.f + s4.x) + h4.x, v[i].y * rstd * g4.y * (1.f + s4.y) + h4.y);
            o.y = pack2(v[i].z * rstd * g4.z * (1.f + s4.z) + h4.z, v[i].w * rstd * g4.w * (1.f + s4.w) + h4.w);
            *(uint2*)(h + (size_t)t * 1024 + col) = o;
        }
    }
}

DEV void rope8(uint4& x1, uint4& x2, const float* cs, const float* sn) {
    const float4 c0 = *(const float4*)cs, c1 = *(const float4*)(cs + 4), s0 = *(const float4*)sn, s1 = *(const float4*)(sn + 4);
    const float cc[8] = {c0.x, c0.y, c0.z, c0.w, c1.x, c1.y, c1.z, c1.w};
    const float ss[8] = {s0.x, s0.y, s0.z, s0.w, s1.x, s1.y, s1.z, s1.w};
    unsigned a[4] = {x1.x, x1.y, x1.z, x1.w}, b[4] = {x2.x, x2.y, x2.z, x2.w};
#pragma unroll
    for (int i = 0; i < 4; ++i) {
        const float a0 = lo16(a[i]), a1 = hi16(a[i]), b0 = lo16(b[i]), b1 = hi16(b[i]);
        const float o10 = a0 * cc[2 * i] - b0 * ss[2 * i], o11 = a1 * cc[2 * i + 1] - b1 * ss[2 * i + 1];
        const float o20 = a0 * ss[2 * i] + b0 * cc[2 * i], o21 = a1 * ss[2 * i + 1] + b1 * cc[2 * i + 1];
        a[i] = pack2(o10, o11); b[i] = pack2(o20, o21);
    }
    x1 = make_uint4(a[0], a[1], a[2], a[3]); x2 = make_uint4(b[0], b[1], b[2], b[3]);
}
DEV void vt_tile(const bf16_t* __restrict__ src, int ld, bf16_t* __restrict__ dst, char* smem) {
    bf16_t* Ls = (bf16_t*)smem;
    const int tid = ltid();
    __syncthreads();
#pragma unroll
    for (int i = 0; i < 2; ++i) {
        const int id = tid + 256 * i, tok = id >> 3, ch = id & 7;
        *(uint4*)(Ls + tok * 72 + ch * 8) = *(const uint4*)(src + (size_t)tok * ld + ch * 8);
    }
    __syncthreads();
#pragma unroll
    for (int i = 0; i < 2; ++i) {
        const int id = tid + 256 * i, d = id >> 3, tc = id & 7;
        unsigned short e[8];
#pragma unroll
        for (int j = 0; j < 8; ++j) e[j] = Ls[(tc * 8 + j) * 72 + d];
        uint4 o;
        o.x = (unsigned)e[0] | ((unsigned)e[1] << 16); o.y = (unsigned)e[2] | ((unsigned)e[3] << 16);
        o.z = (unsigned)e[4] | ((unsigned)e[5] << 16); o.w = (unsigned)e[6] | ((unsigned)e[7] << 16);
        *(uint4*)(dst + (size_t)d * 2048 + tc * 8) = o;
    }
}

DEV void phase_layout1(const Params& p, char* smem) {
    char* ws = p.ws;
    bf16_t* cols = (bf16_t*)(ws + OFF_COLS);
    bf16_t* kc = (bf16_t*)(ws + OFF_KC);
    bf16_t* vc = (bf16_t*)(ws + OFF_VC);
    bf16_t* VT = (bf16_t*)(ws + OFF_VT);
    float* rstd = (float*)(ws + OFF_RSTD);
    const float* rope = (const float*)(ws + OFF_ROPE);
    const float *cos64 = rope, *sin64 = rope + 2048 * 32, *cos32 = rope + 2048 * 64, *sin32 = rope + 2048 * 64 + 2048 * 16;
    const int tid = ltid();
    for (int tile = blockIdx.x; tile < kT / 64; tile += gridDim.x) {
        const int T0 = tile * 64, b = T0 >> 11, s0 = T0 & 2047;
        for (int it = tid; it < 64 * 94; it += 256) {
            const int tok = it / 94, item = it % 94;
            const int t = T0 + tok, s = s0 + tok;
            bf16_t* row = cols + (size_t)t * LDC;
            if (item < 52) {
                const int hd = item >> 2, i0 = (item & 3) * 8;
                const int base = hd < 4 ? 64 * hd : hd == 4 ? 256 : hd == 5 ? 384 : hd == 6 ? 512 : hd < 11 ? 1920 + 64 * (hd - 7) : 2176 + 64 * (hd - 11);
                uint4 x1 = *(const uint4*)(row + base + i0), x2 = *(const uint4*)(row + base + 32 + i0);
                rope8(x1, x2, cos64 + s * 32 + i0, sin64 + s * 32 + i0);
                *(uint4*)(row + base + i0) = x1; *(uint4*)(row + base + 32 + i0) = x2;
                if (hd == 4) { *(uint4*)(kc + (size_t)t * 64 + i0) = x1; *(uint4*)(kc + (size_t)t * 64 + 32 + i0) = x2; }
            } else if (item < 86) {
                const int it2 = item - 52, sub = it2 >> 1, i0 = (it2 & 1) * 8;
                const int base = sub < 8 ? 704 + 32 * sub : sub < 16 ? 960 + 32 * (sub - 8) : 1856;
                uint4 x1 = *(const uint4*)(row + base + i0), x2 = *(const uint4*)(row + base + 16 + i0);
                rope8(x1, x2, cos32 + s * 16 + i0, sin32 + s * 16 + i0);
                *(uint4*)(row + base + i0) = x1; *(uint4*)(row + base + 16 + i0) = x2;
            } else {
                const int ch = item - 86;
                *(uint4*)(vc + (size_t)t * 64 + ch * 8) = *(const uint4*)(row + 320 + ch * 8);
            }
        }
        {
            const int tok = tid >> 2, part = tid & 3, t = T0 + tok;
            const bf16_t* src = cols + (size_t)t * LDC + 1472 + (part < 3 ? part : 0) * 128;
            float ss = 0.f;
#pragma unroll 4
            for (int i = 0; i < 16; ++i) {
                const uint4 u = *(const uint4*)(src + i * 8);
                ss += lo16(u.x) * lo16(u.x) + hi16(u.x) * hi16(u.x) + lo16(u.y) * lo16(u.y) + hi16(u.y) * hi16(u.y)
                    + lo16(u.z) * lo16(u.z) + hi16(u.z) * hi16(u.z) + lo16(u.w) * lo16(u.w) + hi16(u.w) * hi16(u.w);
            }
            float vq = part < 2 ? ss : 0.f;
            vq += __shfl_xor(vq, 1, 64);
            if (part == 0) rstd[t] = rsqrtf(vq * (1.f / 256.f) + kEps);
            if (part == 2) rstd[kT + t] = rsqrtf(ss * (1.f / 128.f) + kEps);
        }
#pragma unroll 1
        for (int vh = 0; vh < 8; ++vh) {
            const int col = vh == 0 ? 448 : vh == 1 ? 576 : vh < 6 ? 1216 + 64 * (vh - 2) : 2304 + 64 * (vh - 6);
            vt_tile(cols + (size_t)T0 * LDC + col, LDC, VT + ((size_t)(b * 12 + vh) * 64) * 2048 + s0, smem);
        }
    }
}

DEV void phase_layout2(const Params& p, char* smem) {
    char* ws = p.ws;
    bf16_t* qmla = (bf16_t*)(ws + OFF_QMLA);
    const bf16_t* kvmla = (const bf16_t*)(ws + OFF_KVMLA);
    bf16_t* VT = (bf16_t*)(ws + OFF_VT);
    const float* rope = (const float*)(ws + OFF_ROPE);
    const float *cos32 = rope + 2048 * 64, *sin32 = rope + 2048 * 64 + 2048 * 16;
    const int tid = ltid();
    for (int tile = blockIdx.x; tile < kT / 64; tile += gridDim.x) {
        const int T0 = tile * 64, b = T0 >> 11, s0 = T0 & 2047;
        for (int it = tid; it < 64 * 8; it += 256) {
            const int tok = it >> 3, item = it & 7, hd = item >> 1, i0 = (item & 1) * 8;
            const int t = T0 + tok, s = s0 + tok;
            bf16_t* row = qmla + (size_t)t * 384 + hd * 96 + 64;
            uint4 x1 = *(const uint4*)(row + i0), x2 = *(const uint4*)(row + 16 + i0);
            rope8(x1, x2, cos32 + s * 16 + i0, sin32 + s * 16 + i0);
            *(uint4*)(row + i0) = x1; *(uint4*)(row + 16 + i0) = x2;
        }
#pragma unroll 1
        for (int hd = 0; hd < 4; ++hd)
            vt_tile(kvmla + (size_t)T0 * 512 + hd * 128 + 64, 512, VT + ((size_t)(b * 12 + 8 + hd) * 64) * 2048 + s0, smem);
    }
}

constexpr int SM_K = 0;
constexpr int SM_V = 18432;
constexpr int SM_IMP = SM_V + 16896;
constexpr int SM_SEL = SM_IMP + 16896;
constexpr int SM_TOTAL = SM_SEL + 1024;

struct RangeIter { int cur, end; DEV int next() { return cur < end ? cur++ : -1; } };
struct BitIter { unsigned rem; DEV int next() { if (!rem) return -1; const int k = __ffs((int)rem) - 1; rem &= rem - 1; return k; } };
struct LdRow { const bf16_t* base; int ld;
    DEV uint4 operator()(int kt, int id) const { const int row = id >> 3, part = id & 7; return *(const uint4*)(base + (size_t)(kt * 64 + row) * ld + part * 8); } };
struct LdVT { const bf16_t* base;
    DEV uint4 operator()(int kt, int id) const { const int d = id >> 3, part = id & 7; return *(const uint4*)(base + (size_t)d * 2048 + kt * 64 + part * 8); } };
struct LdMlaK { const bf16_t* kv; const bf16_t* kr;
    DEV uint4 operator()(int kt, int id) const { const int row = id / 12, part = id % 12; const size_t t = (size_t)(kt * 64 + row);
        return part < 8 ? *(const uint4*)(kv + t * 512 + part * 8) : *(const uint4*)(kr + t * LDC + (part - 8) * 8); } };

struct MaskCausal { DEV bool on(int) const { return true; } DEV bool ok(int kc, int d) const { return kc <= d; } };
template <int W> struct MaskWin { DEV bool on(int) const { return true; } DEV bool ok(int kc, int d) const { return (kc <= d) && (d - kc < W); } };
struct MaskSel { unsigned bits; DEV bool on(int kt) const { return (bits >> kt) & 1u; } DEV bool ok(int kc, int d) const { return kc <= d; } };
template <int KDIM, int NKS, int NSUB, class It, class LK, class LV, class MaskF, class SkipF>
DEV void attn_stream(It it, const LK& ldK, const LV& ldV, const MaskF& maskf, const SkipF& skipf,
                     const bf16x8* qf, f32x16 (&o)[NSUB][2], float (&m)[NSUB], float (&l)[NSUB], float scl, int tq, char* smem, int tid, int koff = 0) {
    constexpr int KCH = KDIM / 8, KSTR = KDIM + 8, NKC = (64 * KCH) / 256;
    bf16_t* Kb = (bf16_t*)(smem + SM_K);
    bf16_t* Vb = (bf16_t*)(smem + SM_V);
    const int lane = tid & 63, ql = lane & 31, hh = lane >> 5;
    uint4 rk0 = make_uint4(0, 0, 0, 0), rk1 = rk0, rk2 = rk0, rv0 = rk0, rv1 = rk0;
    int kt = it.next();
    if (kt >= 0) {
        rk0 = ldK(kt, tid); rk1 = ldK(kt, tid + 256);
        if (NKC == 3) rk2 = ldK(kt, tid + 512);
        rv0 = ldV(kt, tid); rv1 = ldV(kt, tid + 256);
    }
    while (kt >= 0) {
        __syncthreads();
        { const int id = tid, row = id / KCH, part = id % KCH; *(uint4*)(Kb + row * KSTR + part * 8) = rk0; }
        { const int id = tid + 256, row = id / KCH, part = id % KCH; *(uint4*)(Kb + row * KSTR + part * 8) = rk1; }
        if (NKC == 3) { const int id = tid + 512, row = id / KCH, part = id % KCH; *(uint4*)(Kb + row * KSTR + part * 8) = rk2; }
        { const int id = tid, row = id >> 3, part = id & 7; bf16_t* d = Vb + row * 68 + part * 8;
            *(uint2*)d = make_uint2(rv0.x, rv0.y); *(uint2*)(d + 4) = make_uint2(rv0.z, rv0.w); }
        { const int id = tid + 256, row = id >> 3, part = id & 7; bf16_t* d = Vb + row * 68 + part * 8;
            *(uint2*)d = make_uint2(rv1.x, rv1.y); *(uint2*)(d + 4) = make_uint2(rv1.z, rv1.w); }
        __syncthreads();
        const int ktn = it.next();
        if (ktn >= 0) {
            rk0 = ldK(ktn, tid); rk1 = ldK(ktn, tid + 256);
            if (NKC == 3) rk2 = ldK(ktn, tid + 512);
            rv0 = ldV(ktn, tid); rv1 = ldV(ktn, tid + 256);
        }
        if (!skipf(kt)) {
#pragma unroll
            for (int sub = 0; sub < NSUB; ++sub) {
                __builtin_amdgcn_sched_barrier(0);
                f32x16 s[2];
#pragma unroll
                for (int i = 0; i < 2; ++i) {
                    s[i] = zero16();
#pragma unroll
                    for (int ks = 0; ks < NKS; ++ks) {
                        const bf16x8 a = *(const bf16x8*)(Kb + (i * 32 + ql) * KSTR + koff + (sub * NKS + ks) * 16 + hh * 8);
                        s[i] = mfma32(a, qf[sub * NKS + ks], s[i]);
                    }
                }
                float mx = kNeg;
                const int dlim = tq - kt * 64 - 4 * hh;
                const bool on = maskf.on(kt);
#pragma unroll
                for (int i = 0; i < 2; ++i)
#pragma unroll
                    for (int r = 0; r < 16; ++r) {
                        const int kc = i * 32 + (r & 3) + 8 * (r >> 2);
                        const float v = (on && maskf.ok(kc, dlim)) ? s[i][r] * scl : kNeg;
                        s[i][r] = v; mx = fmaxf(mx, v);
                    }
                mx = fmaxf(mx, __shfl_xor(mx, 32, 64));
                const float mnew = fmaxf(m[sub], mx);
                const float alpha = __builtin_amdgcn_exp2f(m[sub] - mnew);
                m[sub] = mnew;
                float sum = 0.f;
#pragma unroll
                for (int i = 0; i < 2; ++i)
#pragma unroll
                    for (int r = 0; r < 16; ++r) { const float pv = __builtin_amdgcn_exp2f(s[i][r] - mnew); s[i][r] = pv; sum += pv; }
                l[sub] = l[sub] * alpha + sum;
#pragma unroll
                for (int dt = 0; dt < 2; ++dt)
#pragma unroll
                    for (int r = 0; r < 16; ++r) o[sub][dt][r] *= alpha;
                __builtin_amdgcn_sched_barrier(0);
#pragma unroll
                for (int ks = 0; ks < 4; ++ks) {
                    if (ks == 2) __builtin_amdgcn_sched_barrier(0);
                    const int i = ks >> 1, r0 = 8 * (ks & 1);
                    uint4 pu;
                    pu.x = pack2(s[i][r0 + 0], s[i][r0 + 1]); pu.y = pack2(s[i][r0 + 2], s[i][r0 + 3]);
                    pu.z = pack2(s[i][r0 + 4], s[i][r0 + 5]); pu.w = pack2(s[i][r0 + 6], s[i][r0 + 7]);
                    const bf16x8 pf = __builtin_bit_cast(bf16x8, pu);
#pragma unroll
                    for (int dt = 0; dt < 2; ++dt) {
                        const bf16_t* vp = Vb + (dt * 32 + ql) * 68 + ks * 16 + 4 * hh;
                        const uint2 a0 = *(const uint2*)vp, a1 = *(const uint2*)(vp + 8);
                        const bf16x8 a = __builtin_bit_cast(bf16x8, make_uint4(a0.x, a0.y, a1.x, a1.y));
                        o[sub][dt] = mfma32(a, pf, o[sub][dt]);
                    }
                }
            }
        }
        kt = ktn;
    }
}

DEV void write_o(const f32x16 (&o)[2], bf16_t* obuf, size_t row, int col0, int hh) {
#pragma unroll
    for (int dt = 0; dt < 2; ++dt)
#pragma unroll
        for (int g = 0; g < 4; ++g) {
            const int d = dt * 32 + 8 * g + 4 * hh;
            uint2 u; u.x = pack2(o[dt][4 * g], o[dt][4 * g + 1]); u.y = pack2(o[dt][4 * g + 2], o[dt][4 * g + 3]);
            *(uint2*)(obuf + row * 1024 + col0 + d) = u;
        }
}
DEV float sigmoidf(float x) { return 1.f / (1.f + __expf(-x)); }

DEV void nsa_item(const Params& p, int b, int qb, char* smem) {
    int tid = threadIdx.x; asm volatile("" : "+v"(tid));
    const int lane = tid & 63, w = tid >> 6, ql = lane & 31, hh = lane >> 5;
    char* ws = p.ws;
    const bf16_t* cols = (const bf16_t*)(ws + OFF_COLS);
    const bf16_t* VT = (const bf16_t*)(ws + OFF_VT);
    bf16_t* obuf = (bf16_t*)(ws + OFF_O);
    const int t0 = qb * 32, tq = t0 + ql;
    const size_t Tb = (size_t)b * kS;
    const bf16_t* qrow = cols + (Tb + tq) * LDC;
    bf16x8 qf[4];
#pragma unroll
    for (int ks = 0; ks < 4; ++ks) qf[ks] = *(const bf16x8*)(qrow + w * 64 + ks * 16 + hh * 8);
    const float g0 = sigmoidf(bf2f(qrow[640 + w * 3 + 0])), g1 = sigmoidf(bf2f(qrow[640 + w * 3 + 1])), g2 = sigmoidf(bf2f(qrow[640 + w * 3 + 2]));
    const float scl = 0.125f * kLog2e;
    bf16_t* Kc = (bf16_t*)(smem + SM_K);
    bf16_t* Vc = (bf16_t*)(smem + SM_V);
    float* impP = (float*)(smem + SM_IMP);
    unsigned* selm = (unsigned*)(smem + SM_SEL);
    const bf16_t* kcmp = (const bf16_t*)(ws + OFF_KCMP) + (size_t)b * 128 * 64;
    const bf16_t* vcmp = kcmp + 1024 * 64;
    __syncthreads();
#pragma unroll
    for (int i = 0; i < 4; ++i) {
        const int id = tid + 256 * i, row = id >> 3, part = id & 7;
        uint4 kk = *(const uint4*)(kcmp + row * 64 + part * 8);
        uint4 vv = *(const uint4*)(vcmp + row * 64 + part * 8);
        if (row == 127) { kk = make_uint4(0, 0, 0, 0); vv = kk; }
        *(uint4*)(Kc + row * 72 + part * 8) = kk;
        const unsigned u[4] = {vv.x, vv.y, vv.z, vv.w};
#pragma unroll
        for (int j = 0; j < 4; ++j) { Vc[(part * 8 + 2 * j) * 132 + row] = (bf16_t)(u[j] & 0xffffu); Vc[(part * 8 + 2 * j + 1) * 132 + row] = (bf16_t)(u[j] >> 16); }
    }
    __syncthreads();
    unsigned ocp[16];
    float* invs = (float*)(smem + SM_SEL) + 64;
    {
        const int cmaxv = tq >= 31 ? min((tq - 31) >> 4, 126) : -1;
        float mx = kNeg;
#pragma unroll 1
        for (int i = 0; i < 4; ++i) {
            f32x16 s = zero16();
#pragma unroll
            for (int ks = 0; ks < 4; ++ks) s = mfma32(*(const bf16x8*)(Kc + (i * 32 + ql) * 72 + ks * 16 + hh * 8), qf[ks], s);
            const int clim = cmaxv - i * 32 - 4 * hh;
#pragma unroll
            for (int r = 0; r < 16; ++r) {
                const int kc = (r & 3) + 8 * (r >> 2);
                const bool valid = (kc <= clim);
                mx = fmaxf(mx, valid ? s[r] * scl : kNeg);
            }
        }
        mx = fmaxf(mx, __shfl_xor(mx, 32, 64));
        f32x16 ocmp[2]; ocmp[0] = zero16(); ocmp[1] = zero16();
        float sum = 0.f, carprev = 0.f;
#pragma unroll 1
        for (int i = 0; i < 4; ++i) {
            f32x16 s = zero16();
#pragma unroll
            for (int ks = 0; ks < 4; ++ks) s = mfma32(*(const bf16x8*)(Kc + (i * 32 + ql) * 72 + ks * 16 + hh * 8), qf[ks], s);
            const int clim = cmaxv - i * 32 - 4 * hh;
#pragma unroll
            for (int r = 0; r < 16; ++r) {
                const int kc = (r & 3) + 8 * (r >> 2);
                const bool valid = (kc <= clim);
                const float pv = valid ? __builtin_amdgcn_exp2f(s[r] * scl - mx) : 0.f;
                s[r] = pv; sum += pv;
            }
            float own[4], car[4];
#pragma unroll
            for (int g = 0; g < 4; ++g) { own[g] = s[4 * g] + s[4 * g + 1] + s[4 * g + 2] + 0.5f * s[4 * g + 3]; car[g] = 0.5f * s[4 * g + 3]; }
#pragma unroll
            for (int g = 0; g < 4; ++g) {
                const float send = hh ? (g ? car[g > 0 ? g - 1 : 0] : carprev) : car[g];
                own[g] += __shfl_xor(send, 32, 64);
            }
            carprev = car[3];
#pragma unroll
            for (int g = 0; g < 4; ++g) impP[(w * 32 + ql) * 33 + 2 * (4 * i + g) + hh] = own[g];
#pragma unroll
            for (int sp = 0; sp < 2; ++sp) {
                const int ks = 2 * i + sp, r0 = 8 * sp;
                uint4 pu;
                pu.x = pack2(s[r0 + 0], s[r0 + 1]); pu.y = pack2(s[r0 + 2], s[r0 + 3]);
                pu.z = pack2(s[r0 + 4], s[r0 + 5]); pu.w = pack2(s[r0 + 6], s[r0 + 7]);
                const bf16x8 pf = __builtin_bit_cast(bf16x8, pu);
#pragma unroll
                for (int dt = 0; dt < 2; ++dt) {
                    const bf16_t* vp = Vc + (dt * 32 + ql) * 132 + ks * 16 + 4 * hh;
                    const uint2 a0 = *(const uint2*)vp, a1 = *(const uint2*)(vp + 8);
                    ocmp[dt] = mfma32(__builtin_bit_cast(bf16x8, make_uint4(a0.x, a0.y, a1.x, a1.y)), pf, ocmp[dt]);
                }
            }
        }
        sum += __shfl_xor(sum, 32, 64);
        const float inv = sum > 0.f ? 1.f / sum : 0.f;
        invs[w * 32 + ql] = inv;
        const float f = g0 * inv;
#pragma unroll
        for (int dt = 0; dt < 2; ++dt)
#pragma unroll
            for (int r = 0; r < 8; ++r) ocp[dt * 8 + r] = pack2(f * ocmp[dt][2 * r], f * ocmp[dt][2 * r + 1]);
    }
    __syncthreads();
    const int qblk = t0 >> 6;
    {
        const int hw = tid >> 5, j = tid & 31;
#pragma unroll 1
        for (int rr = 0; rr < 4; ++rr) {
            const int row = hw * 4 + rr;
            const float v = impP[(0 * 32 + row) * 33 + j] * invs[row] + impP[(1 * 32 + row) * 33 + j] * invs[32 + row]
                          + impP[(2 * 32 + row) * 33 + j] * invs[64 + row] + impP[(3 * 32 + row) * 33 + j] * invs[96 + row];
            bool sel;
            if (qblk < 16) sel = (j <= qblk);
            else {
                const bool cand = (j >= 1) && (j <= qblk - 2);
                const bool forced = (j == 0) || (j == qblk) || (j == qblk - 1);
                int rank = 0;
                for (int j2 = 1; j2 <= qblk - 2; ++j2) {
                    const float v2 = __shfl(v, (lane & 32) + j2, 64);
                    rank += (v2 > v || (v2 == v && j2 < j)) ? 1 : 0;
                }
                sel = forced || (cand && rank < 13);
            }
            const unsigned long long bal = __ballot(sel);
            const unsigned mk = (lane & 32) ? (unsigned)(bal >> 32) : (unsigned)bal;
            if (j == 0) selm[row] = mk;
        }
    }
    __syncthreads();
    const unsigned mysel = selm[ql];
    unsigned U = mysel;
#pragma unroll
    for (int o = 16; o > 0; o >>= 1) U |= (unsigned)__shfl_xor((int)U, o, 64);
    {
        f32x16 o1[1][2]; o1[0][0] = zero16(); o1[0][1] = zero16();
        float m1[1] = {kNeg}, l1[1] = {0.f};
        auto skipf = [&](int) { return false; };
        attn_stream<64, 4, 1>(BitIter{U}, LdRow{cols + Tb * LDC + 384, LDC}, LdVT{VT + (size_t)(b * 12 + 0) * 64 * 2048}, MaskSel{mysel}, skipf, qf, o1, m1, l1, scl, tq, smem, tid);
        const float lt = l1[0] + __shfl_xor(l1[0], 32, 64);
        const float f = g1 / lt;
#pragma unroll
        for (int dt = 0; dt < 2; ++dt)
#pragma unroll
            for (int r = 0; r < 8; ++r) ocp[dt * 8 + r] = pack2(lo16(ocp[dt * 8 + r]) + f * o1[0][dt][2 * r], hi16(ocp[dt * 8 + r]) + f * o1[0][dt][2 * r + 1]);
    }
    {
        f32x16 o1[1][2]; o1[0][0] = zero16(); o1[0][1] = zero16();
        float m1[1] = {kNeg}, l1[1] = {0.f};
        auto skipf = [&](int) { return false; };
        const int lo = t0 >= 511 ? ((t0 - 511) >> 6) : 0;
        attn_stream<64, 4, 1>(RangeIter{lo, qblk + 1}, LdRow{cols + Tb * LDC + 512, LDC}, LdVT{VT + (size_t)(b * 12 + 1) * 64 * 2048}, MaskWin<512>{}, skipf, qf, o1, m1, l1, scl, tq, smem, tid);
        const float lt = l1[0] + __shfl_xor(l1[0], 32, 64);
        const float f = g2 / lt;
#pragma unroll
        for (int dt = 0; dt < 2; ++dt)
#pragma unroll
            for (int r = 0; r < 8; ++r) { o1[0][dt][2 * r] = lo16(ocp[dt * 8 + r]) + f * o1[0][dt][2 * r]; o1[0][dt][2 * r + 1] = hi16(ocp[dt * 8 + r]) + f * o1[0][dt][2 * r + 1]; }
        write_o(o1[0], obuf, Tb + tq, w * 64, hh);
    }
}

DEV void diff_item(const Params& p, int layer, int b, int hd, int q64, char* smem) {
    int tid = threadIdx.x; asm volatile("" : "+v"(tid));
    const int lane = tid & 63, w = tid >> 6, ql = lane & 31, hh = lane >> 5;
    const int sub = w & 1, qbw = w >> 1;
    char* ws = p.ws;
    const bf16_t* cols = (const bf16_t*)(ws + OFF_COLS);
    const bf16_t* VT = (const bf16_t*)(ws + OFF_VT);
    bf16_t* obuf = (bf16_t*)(ws + OFF_O);
    const float* misc = (const float*)(ws + OFF_MISC);
    const int t0w = q64 * 64 + qbw * 32, tq = t0w + ql;
    const size_t Tb = (size_t)b * kS;
    const bf16_t* qrow = cols + (Tb + tq) * LDC + 704 + hd * 64 + sub * 32;
    bf16x8 qf[2];
#pragma unroll
    for (int ks = 0; ks < 2; ++ks) qf[ks] = *(const bf16x8*)(qrow + ks * 16 + hh * 8);
    const float scl = 0.17677669529663687f * kLog2e;
    f32x16 o1[1][2]; o1[0][0] = zero16(); o1[0][1] = zero16();
    float m1[1] = {kNeg}, l1[1] = {0.f};
    auto skipf = [&](int kt) { return kt * 64 > t0w + 31; };
    attn_stream<64, 2, 1>(RangeIter{0, q64 + 1}, LdRow{cols + Tb * LDC + 960 + hd * 64, LDC}, LdVT{VT + (size_t)(b * 12 + 2 + hd) * 64 * 2048}, MaskCausal{}, skipf, qf, o1, m1, l1, scl, tq, smem, tid, sub * 32);
    const float lam = misc[256 + layer], post = misc[258 + layer];
    const float lt = l1[0] + __shfl_xor(l1[0], 32, 64);
    float* ex = (float*)smem;
    __syncthreads();
    if (sub == 1) {
        const float f = lam / lt;
#pragma unroll
        for (int dt = 0; dt < 2; ++dt)
#pragma unroll
            for (int r = 0; r < 16; ++r) ex[((qbw * 2 + dt) * 16 + r) * 64 + lane] = o1[0][dt][r] * f;
    }
    __syncthreads();
    if (sub == 0) {
        const float f = 1.f / lt;
        float ss = 0.f;
#pragma unroll
        for (int dt = 0; dt < 2; ++dt)
#pragma unroll
            for (int r = 0; r < 16; ++r) { const float v = o1[0][dt][r] * f - ex[((qbw * 2 + dt) * 16 + r) * 64 + lane]; o1[0][dt][r] = v; ss += v * v; }
        ss += __shfl_xor(ss, 32, 64);
        const float rstd = rsqrtf(ss * (1.f / 64.f) + kEps) * post;
        const float* sg = p.sub_g + layer * 64;
#pragma unroll
        for (int dt = 0; dt < 2; ++dt)
#pragma unroll
            for (int r = 0; r < 16; ++r) { const int d = dt * 32 + (r & 3) + 8 * (r >> 2) + 4 * hh; o1[0][dt][r] *= rstd * sg[d]; }
        write_o(o1[0], obuf, Tb + tq, 256 + hd * 64, hh);
    }
}

DEV void mla_item(const Params& p, int b, int hd, int qc, char* smem) {
    int tid = threadIdx.x; asm volatile("" : "+v"(tid));
    const int lane = tid & 63, w = tid >> 6, ql = lane & 31, hh = lane >> 5;
    char* ws = p.ws;
    const bf16_t* cols = (const bf16_t*)(ws + OFF_COLS);
    const bf16_t* VT = (const bf16_t*)(ws + OFF_VT);
    const bf16_t* qmla = (const bf16_t*)(ws + OFF_QMLA);
    const bf16_t* kvmla = (const bf16_t*)(ws + OFF_KVMLA);
    bf16_t* obuf = (bf16_t*)(ws + OFF_O);
    const int t0w = qc * 128 + w * 32, tq = t0w + ql;
    const size_t Tb = (size_t)b * kS;
    const bf16_t* qrow = qmla + (Tb + tq) * 384 + hd * 96;
    bf16x8 qf[6];
#pragma unroll
    for (int ks = 0; ks < 6; ++ks) qf[ks] = *(const bf16x8*)(qrow + ks * 16 + hh * 8);
    const float scl = 0.10206207261596575f * kLog2e;
    f32x16 o1[1][2]; o1[0][0] = zero16(); o1[0][1] = zero16();
    float m1[1] = {kNeg}, l1[1] = {0.f};
    auto skipf = [&](int kt) { return kt * 64 > t0w + 31; };
    attn_stream<96, 6, 1>(RangeIter{0, 2 * qc + 2}, LdMlaK{kvmla + Tb * 512 + hd * 128, cols + Tb * LDC + 1856}, LdVT{VT + (size_t)(b * 12 + 8 + hd) * 64 * 2048}, MaskCausal{}, skipf, qf, o1, m1, l1, scl, tq, smem, tid);
    const float inv = 1.f / (l1[0] + __shfl_xor(l1[0], 32, 64));
#pragma unroll
    for (int dt = 0; dt < 2; ++dt)
#pragma unroll
        for (int r = 0; r < 16; ++r) o1[0][dt][r] *= inv;
    write_o(o1[0], obuf, Tb + tq, 512 + hd * 64, hh);
}

DEV void swa_item(const Params& p, int layer, int b, int g, int q64, char* smem) {
    int tid = threadIdx.x; asm volatile("" : "+v"(tid));
    const int lane = tid & 63, w = tid >> 6, ql = lane & 31, hh = lane >> 5;
    char* ws = p.ws;
    const bf16_t* cols = (const bf16_t*)(ws + OFF_COLS);
    const bf16_t* VT = (const bf16_t*)(ws + OFF_VT);
    bf16_t* obuf = (bf16_t*)(ws + OFF_O);
    const int head = g * 2 + (w & 1);
    const int t0w = q64 * 64 + (w >> 1) * 32, tq = t0w + ql;
    const size_t Tb = (size_t)b * kS;
    const bf16_t* qrow = cols + (Tb + tq) * LDC + 1920 + head * 64;
    bf16x8 qf[4];
#pragma unroll
    for (int ks = 0; ks < 4; ++ks) qf[ks] = *(const bf16x8*)(qrow + ks * 16 + hh * 8);
    const float scl = 0.125f * kLog2e;
    f32x16 o1[1][2]; o1[0][0] = zero16(); o1[0][1] = zero16();
    float m1[1] = {p.sinks[layer * 4 + head] * kLog2e}, l1[1] = {hh == 0 ? 1.f : 0.f};
    auto skipf = [&](int kt) { return (kt * 64 > t0w + 31) || (kt * 64 + 63 < t0w - 127); };
    const int lo = q64 >= 2 ? q64 - 2 : 0;
    attn_stream<64, 4, 1>(RangeIter{lo, q64 + 1}, LdRow{cols + Tb * LDC + 2176 + g * 64, LDC}, LdVT{VT + (size_t)(b * 12 + 6 + g) * 64 * 2048}, MaskWin<128>{}, skipf, qf, o1, m1, l1, scl, tq, smem, tid);
    const float inv = 1.f / (l1[0] + __shfl_xor(l1[0], 32, 64));
#pragma unroll
    for (int dt = 0; dt < 2; ++dt)
#pragma unroll
        for (int r = 0; r < 16; ++r) o1[0][dt][r] *= inv;
    write_o(o1[0], obuf, Tb + tq, 768 + head * 64, hh);
}

DEV void phase_attn(const Params& p, int layer, char* smem) {
    unsigned* ctr = (unsigned*)(p.ws + OFF_CTRL) + 64 + layer * 16;
    volatile int* slot = (volatile int*)(smem + SM_SEL) + 48;
    for (;;) {
        __syncthreads();
        if (ltid() == 0) *slot = (int)atomicAdd(ctr, 1u);
        __syncthreads();
        const int idx = *slot;
        if (idx >= 2560) break;
        const int level = 15 - idx / 160, r = idx % 160;
        if (r < 64) { const int b = (r & 31) >> 2; diff_item(p, layer, b, r & 3, level * 2 + (1 - (r >> 5)), smem); }
        else if (r < 96) { const int k = r - 64; mla_item(p, k >> 2, k & 3, level, smem); }
        else if (r < 128) { const int k = r - 96; nsa_item(p, k >> 2, level * 4 + (3 - (k & 3)), smem); }
        else { const int k = r - 128; swa_item(p, layer, k >> 2, (k >> 1) & 1, level * 2 + (k & 1), smem); }
    }
}

DEV unsigned fkey(float f) { const unsigned u = __float_as_uint(f); return (u & 0x80000000u) ? ~u : (u | 0x80000000u); }
DEV unsigned wave_umax(unsigned v) {
#pragma unroll
    for (int o = 32; o > 0; o >>= 1) { const unsigned t = (unsigned)__shfl_xor((int)v, o, 64); v = t > v ? t : v; }
    return v;
}
DEV void phase_topk(const Params& p) {
    const int tid = ltid(), lane = tid & 63, w = tid >> 6;
    const float* S1 = (const float*)(p.ws + OFF_S1);
    const float* S2 = (const float*)(p.ws + OFF_S2);
    int* eid = (int*)(p.ws + OFF_EID);
    float* gate = (float*)(p.ws + OFF_GATE);
    for (int q = blockIdx.x; q < kT * 8 / 4; q += gridDim.x) {
        const int row = q * 4 + w;
        const float* r1 = S1 + (size_t)row * 128;
        const float* r2 = S2 + (size_t)row * 128;
        float v1 = 0.f, v2 = 0.f; int i1 = 0, i2 = 0;
#pragma unroll
        for (int half = 0; half < 2; ++half) {
            const float* rr = half ? r2 : r1;
            unsigned k0 = (fkey(rr[lane]) & ~127u) | (unsigned)(127 - lane);
            unsigned k1 = (fkey(rr[lane + 64]) & ~127u) | (unsigned)(63 - lane);
            unsigned mine = 0u;
#pragma unroll 1
            for (int r = 0; r < 16; ++r) {
                const unsigned mx = wave_umax(k0 > k1 ? k0 : k1);
                if (k0 == mx) k0 = 0u;
                if (k1 == mx) k1 = 0u;
                if (lane == r) mine = mx;
            }
            const int idx = 127 - (int)(mine & 127u);
            const float val = rr[idx];
            if (half) { v2 = val; i2 = idx; } else { v1 = val; i1 = idx; }
        }
        const int a = lane >> 2;
        const float va = __shfl(v1, a, 64);
        unsigned ck[4];
#pragma unroll
        for (int j = 0; j < 4; ++j) {
            const int bb = (lane & 3) * 4 + j;
            const float cs = va + __shfl(v2, bb, 64);
            ck[j] = (fkey(cs) & ~255u) | (unsigned)(255 - (a * 16 + bb));
        }
        unsigned minec = 0u;
#pragma unroll 1
        for (int r = 0; r < 16; ++r) {
            unsigned lm = ck[0] > ck[1] ? ck[0] : ck[1]; const unsigned lm2 = ck[2] > ck[3] ? ck[2] : ck[3]; lm = lm > lm2 ? lm : lm2;
            const unsigned mx = wave_umax(lm);
#pragma unroll
            for (int j = 0; j < 4; ++j) if (ck[j] == mx) ck[j] = 0u;
            if (lane == r) minec = mx;
        }
        const int cidx = 255 - (int)(minec & 255u);
        const int ca = cidx >> 4, cb = cidx & 15;
        const float ts = __shfl(v1, ca, 64) + __shfl(v2, cb, 64);
        const int e = __shfl(i1, ca, 64) * 128 + __shfl(i2, cb, 64);
        const float tmax = __shfl(ts, 0, 64);
        const float ex = lane < 16 ? __expf(ts - tmax) : 0.f;
        const float sum = wave_sum(ex);
        if (lane < 16) { eid[(size_t)row * 16 + lane] = e; gate[(size_t)row * 16 + lane] = ex / sum; }
    }
}

DEV void phase_experts(const Params& p, int layer) {
    const int tid = ltid(), lane = tid & 63, w = tid >> 6;
    char* ws = p.ws;
    const bf16_t* U = (const bf16_t*)(ws + OFF_PU) + (size_t)layer * 16384 * 1024;
    const bf16_t* V = (const bf16_t*)(ws + OFF_PV) + (size_t)layer * 16384 * 1024;
    bf16_t* h = (bf16_t*)(ws + OFF_H);
    float* xres = (float*)(ws + OFF_XRES);
    const int* eid = (const int*)(ws + OFF_EID);
    const float* gate = (const float*)(ws + OFF_GATE);
    const float* mod = (const float*)(ws + OFF_MOD);
    for (int q = blockIdx.x; q < kT / 4; q += gridDim.x) {
        const int t = q * 4 + w, b = t >> 11;
        float hf[16];
        {
            const uint4 h0 = *(const uint4*)(h + (size_t)t * 1024 + lane * 8), h1 = *(const uint4*)(h + (size_t)t * 1024 + 512 + lane * 8);
            hf[0] = lo16(h0.x); hf[1] = hi16(h0.x); hf[2] = lo16(h0.y); hf[3] = hi16(h0.y); hf[4] = lo16(h0.z); hf[5] = hi16(h0.z); hf[6] = lo16(h0.w); hf[7] = hi16(h0.w);
            hf[8] = lo16(h1.x); hf[9] = hi16(h1.x); hf[10] = lo16(h1.y); hf[11] = hi16(h1.y); hf[12] = lo16(h1.z); hf[13] = hi16(h1.z); hf[14] = lo16(h1.w); hf[15] = hi16(h1.w);
        }
        const int e0 = eid[(size_t)t * 128 + lane], e1 = eid[(size_t)t * 128 + 64 + lane];
        const float ga = gate[(size_t)t * 128 + lane], gb = gate[(size_t)t * 128 + 64 + lane];
        float out[16];
#pragma unroll
        for (int j = 0; j < 16; ++j) out[j] = 0.f;
#pragma unroll 4
        for (int e = 0; e < 128; ++e) {
            const int ex = __builtin_amdgcn_readlane(e < 64 ? e0 : e1, e & 63);
            const float gt = __int_as_float(__builtin_amdgcn_readlane(__float_as_int(e < 64 ? ga : gb), e & 63));
            const bf16_t* ur = U + (size_t)ex * 1024;
            const bf16_t* vr = V + (size_t)ex * 1024;
            const uint4 u0 = *(const uint4*)(ur + lane * 8), u1 = *(const uint4*)(ur + 512 + lane * 8);
            const uint4 w0 = *(const uint4*)(vr + lane * 8), w1 = *(const uint4*)(vr + 512 + lane * 8);
            float d = hf[0] * lo16(u0.x) + hf[1] * hi16(u0.x) + hf[2] * lo16(u0.y) + hf[3] * hi16(u0.y)
                    + hf[4] * lo16(u0.z) + hf[5] * hi16(u0.z) + hf[6] * lo16(u0.w) + hf[7] * hi16(u0.w)
                    + hf[8] * lo16(u1.x) + hf[9] * hi16(u1.x) + hf[10] * lo16(u1.y) + hf[11] * hi16(u1.y)
                    + hf[12] * lo16(u1.z) + hf[13] * hi16(u1.z) + hf[14] * lo16(u1.w) + hf[15] * hi16(u1.w);
            d = wave_sum(d);
            const float wg = gt * gelu_tanh(d);
            out[0] += wg * lo16(w0.x); out[1] += wg * hi16(w0.x); out[2] += wg * lo16(w0.y); out[3] += wg * hi16(w0.y);
            out[4] += wg * lo16(w0.z); out[5] += wg * hi16(w0.z); out[6] += wg * lo16(w0.w); out[7] += wg * hi16(w0.w);
            out[8] += wg * lo16(w1.x); out[9] += wg * hi16(w1.x); out[10] += wg * lo16(w1.y); out[11] += wg * hi16(w1.y);
            out[12] += wg * lo16(w1.z); out[13] += wg * hi16(w1.z); out[14] += wg * lo16(w1.w); out[15] += wg * hi16(w1.w);
        }
        const float* g2 = mod + (size_t)(layer * 8 + b) * 6144 + 5120;
        float xn[16]; float ss = 0.f;
#pragma unroll
        for (int c = 0; c < 2; ++c) {
            const int col = c * 512 + lane * 8;
            const float4 xa = *(const float4*)(xres + (size_t)t * 1024 + col), xb = *(const float4*)(xres + (size_t)t * 1024 + col + 4);
            const float4 ga4 = *(const float4*)(g2 + col), gb4 = *(const float4*)(g2 + col + 4);
            xn[c * 8 + 0] = xa.x + ga4.x * out[c * 8 + 0]; xn[c * 8 + 1] = xa.y + ga4.y * out[c * 8 + 1];
            xn[c * 8 + 2] = xa.z + ga4.z * out[c * 8 + 2]; xn[c * 8 + 3] = xa.w + ga4.w * out[c * 8 + 3];
            xn[c * 8 + 4] = xb.x + gb4.x * out[c * 8 + 4]; xn[c * 8 + 5] = xb.y + gb4.y * out[c * 8 + 5];
            xn[c * 8 + 6] = xb.z + gb4.z * out[c * 8 + 6]; xn[c * 8 + 7] = xb.w + gb4.w * out[c * 8 + 7];
        }
#pragma unroll
        for (int j = 0; j < 16; ++j) ss += xn[j] * xn[j];
        ss = wave_sum(ss);
        const float rstd = rsqrtf(ss * (1.f / 1024.f) + kEps);
        if (layer == 0) {
            const float* g = p.norm_mix_g + 1024;
            const float* sh = mod + (size_t)(8 + b) * 6144;
            const float* sc = sh + 1024;
#pragma unroll
            for (int c = 0; c < 2; ++c) {
                const int col = c * 512 + lane * 8;
                *(float4*)(xres + (size_t)t * 1024 + col) = make_float4(xn[c * 8], xn[c * 8 + 1], xn[c * 8 + 2], xn[c * 8 + 3]);
                *(float4*)(xres + (size_t)t * 1024 + col + 4) = make_float4(xn[c * 8 + 4], xn[c * 8 + 5], xn[c * 8 + 6], xn[c * 8 + 7]);
                float hv[8];
#pragma unroll
                for (int j = 0; j < 8; ++j) hv[j] = xn[c * 8 + j] * rstd * g[col + j] * (1.f + sc[col + j]) + sh[col + j];
                uint4 o; o.x = pack2(hv[0], hv[1]); o.y = pack2(hv[2], hv[3]); o.z = pack2(hv[4], hv[5]); o.w = pack2(hv[6], hv[7]);
                *(uint4*)(h + (size_t)t * 1024 + col) = o;
            }
        } else {
#pragma unroll
            for (int c = 0; c < 2; ++c) {
                const int col = c * 512 + lane * 8;
                const float4 fa = *(const float4*)(p.final_g + col), fb = *(const float4*)(p.final_g + col + 4);
                *(float4*)(p.out + (size_t)t * 1024 + col) = make_float4(xn[c * 8] * rstd * fa.x, xn[c * 8 + 1] * rstd * fa.y, xn[c * 8 + 2] * rstd * fa.z, xn[c * 8 + 3] * rstd * fa.w);
                *(float4*)(p.out + (size_t)t * 1024 + col + 4) = make_float4(xn[c * 8 + 4] * rstd * fb.x, xn[c * 8 + 5] * rstd * fb.y, xn[c * 8 + 6] * rstd * fb.z, xn[c * 8 + 7] * rstd * fb.w);
            }
        }
    }
}

DEV void phase_gemm_in(const Params& p, int layer, char* smem) {
    char* ws = p.ws;
    EpiBf16 epi{(bf16_t*)(ws + OFF_COLS), LDC, nullptr, nullptr, LDC};
    gemm_phase((const bf16_t*)(ws + OFF_H), 1024, (const bf16_t*)(ws + OFF_WIN) + (size_t)layer * 2432 * 1024, 1024, 1024, kT / 128, LDC / 128, smem, epi);
}
DEV void phase_gemm_mid(const Params& p, int layer, char* smem) {
    char* ws = p.ws;
    const float* misc = (const float*)(ws + OFF_MISC);
    const float* rstd = (const float*)(ws + OFF_RSTD);
    const bf16_t* cols = (const bf16_t*)(ws + OFF_COLS);
    for (int tile = blockIdx.x; tile < 16 + 384 + 512; tile += gridDim.x) {
        if (tile < 8) {
            EpiBf16 epi{(bf16_t*)(ws + OFF_KCMP), 64, nullptr, misc + (layer * 2 + 0) * 64, 64};
            gemm_tile((const bf16_t*)(ws + OFF_KC), 1024, (const bf16_t*)(ws + OFF_WCK) + (size_t)layer * 128 * 2048, 2048, 2048, tile * 128, 0, smem, epi);
        } else if (tile < 16) {
            EpiBf16 epi{(bf16_t*)(ws + OFF_KCMP) + 1024 * 64, 64, nullptr, misc + (layer * 2 + 1) * 64, 64};
            gemm_tile((const bf16_t*)(ws + OFF_VC), 1024, (const bf16_t*)(ws + OFF_WCV) + (size_t)layer * 128 * 2048, 2048, 2048, (tile - 8) * 128, 0, smem, epi);
        } else if (tile < 16 + 384) {
            const int tt = tile - 16;
            EpiBf16 epi{(bf16_t*)(ws + OFF_QMLA), 384, rstd, nullptr, 384};
            gemm_tile(cols + 1472, LDC, (const bf16_t*)(ws + OFF_WUQ) + (size_t)layer * 384 * 256, 256, 256, (tt / 3) * 128, (tt % 3) * 128, smem, epi);
        } else {
            const int tt = tile - 16 - 384;
            EpiBf16 epi{(bf16_t*)(ws + OFF_KVMLA), 512, rstd + kT, nullptr, 512};
            gemm_tile(cols + 1728, LDC, (const bf16_t*)(ws + OFF_WUKV) + (size_t)layer * 512 * 128, 128, 128, (tt / 4) * 128, (tt % 4) * 128, smem, epi);
        }
    }
}
DEV void phase_gemm_out(const Params& p, int layer, char* smem) {
    char* ws = p.ws;
    EpiRes epi{layer == 0 ? p.x : (const float*)(ws + OFF_XRES), (float*)(ws + OFF_XRES), (const float*)(ws + OFF_MOD) + (size_t)layer * 8 * 6144 + 2048};
    gemm_phase((const bf16_t*)(ws + OFF_O), 1024, (const bf16_t*)(ws + OFF_WOUT) + (size_t)layer * 1024 * 1024, 1024, 1024, kT / 128, 8, smem, epi);
}
DEV void phase_gemm_wq(const Params& p, int layer, char* smem) {
    char* ws = p.ws;
    EpiBf16 epi{(bf16_t*)(ws + OFF_QP), 2048, nullptr, nullptr, 2048};
    gemm_phase((const bf16_t*)(ws + OFF_H), 1024, (const bf16_t*)(ws + OFF_WQ) + (size_t)layer * 2048 * 1024, 1024, 1024, kT / 128, 16, smem, epi);
}
DEV void phase_scores(const Params& p, int layer, char* smem) {
    char* ws = p.ws;
    for (int tile = blockIdx.x; tile < 2048; tile += gridDim.x) {
        const int c = tile >> 10, mt = tile & 1023;
        EpiF32 epi{(float*)(ws + (c ? OFF_S2 : OFF_S1)), 128};
        gemm_tile((const bf16_t*)(ws + OFF_QP) + c * 128, 256, (const bf16_t*)(ws + OFF_SUBK) + (size_t)(layer * 2 + c) * 16384, 128, 128, mt * 128, 0, smem, epi);
    }
}


#define XB_TMO      128
#define XB_XCNT(j)  (256  + 64 * (j))
#define XB_XSUB(j)  (1280 + 64 * (j))
#define XB_XGEN(j)  (2304 + 64 * (j))
#define XB_TOP      3328
#define XB_TOPGEN   3392
#define XB_SPIN_CAP (1u << 22)
#define LAS __attribute__((address_space(3)))
DEV unsigned xb_ld(unsigned* p) { return __hip_atomic_load(p, __ATOMIC_RELAXED, __HIP_MEMORY_SCOPE_AGENT); }
DEV unsigned xb_add(unsigned* p, unsigned v) { return __hip_atomic_fetch_add(p, v, __ATOMIC_RELAXED, __HIP_MEMORY_SCOPE_AGENT); }
DEV unsigned xb_xcc_id() { return (unsigned)__builtin_amdgcn_s_getreg((3 << 11) | 20) & 0xFu; }
#define XB_SPIN(cond, bar) do { unsigned _sp = 0; while (cond) { __builtin_amdgcn_s_sleep(1); \
    if ((++_sp & 255u) == 0u) { if (xb_ld(&(bar)[XB_TMO])) break; if (_sp > XB_SPIN_CAP) { atomicAdd(&(bar)[XB_TMO], 1u); break; } } } } while (0)
struct XcdBarrier { unsigned* bar; unsigned x; volatile LAS unsigned* st; };
DEV XcdBarrier xcd_barrier_post(unsigned* bar, volatile LAS unsigned* st) {
    XcdBarrier b; b.bar = bar; b.x = xb_xcc_id(); b.st = st;
    if (threadIdx.x == 0) (void)xb_add(&bar[XB_XCNT(b.x)], 1u);
    return b;
}
DEV void xcd_barrier_complete(unsigned* bar, unsigned x, unsigned& nloc, unsigned& nx) {
    const unsigned G = gridDim.x * gridDim.y * gridDim.z;
    unsigned sum, cnt, mine, sp = 0u;
    for (;;) {
        sum = 0u; cnt = 0u; mine = 0u;
#pragma unroll
        for (unsigned j = 0; j < 16; ++j) { const unsigned c = xb_ld(&bar[XB_XCNT(j)]); sum += c; cnt += (c > 0u) ? 1u : 0u; mine = (j == x) ? c : mine; }
        if (sum == G) break;
        __builtin_amdgcn_s_sleep(1);
        if ((++sp & 255u) == 0u) { if (xb_ld(&bar[XB_TMO])) break; if (sp > XB_SPIN_CAP) { atomicAdd(&bar[XB_TMO], 1u); break; } }
    }
    nloc = mine > 0u ? mine : 1u; nx = cnt > 0u ? cnt : 1u;
}
DEV void xcd_barrier(const XcdBarrier& b) {
    asm volatile("s_waitcnt vmcnt(0)" ::: "memory");
    __syncthreads();
    if (threadIdx.x == 0) {
        unsigned* bar = b.bar;
        __builtin_amdgcn_s_waitcnt(0);
        unsigned nloc = b.st[0], nx = b.st[1];
        if (nloc == 0u) { xcd_barrier_complete(bar, b.x, nloc, nx); b.st[0] = nloc; b.st[1] = nx; }
        const unsigned old = xb_add(&bar[XB_XSUB(b.x)], 1u);
        const unsigned gen = old / nloc;
        if (old + 1u == (gen + 1u) * nloc) {
            __builtin_amdgcn_fence(__ATOMIC_RELEASE, "agent");
            asm volatile("s_waitcnt vmcnt(0)" ::: "memory");
            const unsigned og = xb_add(&bar[XB_TOP], 1u);
            const unsigned tg = og / nx;
            if (og + 1u == (tg + 1u) * nx) xb_add(&bar[XB_TOPGEN], 1u);
            else XB_SPIN(xb_ld(&bar[XB_TOPGEN]) == tg, bar);
            __builtin_amdgcn_fence(__ATOMIC_ACQUIRE, "agent");
            xb_add(&bar[XB_XGEN(b.x)], 1u);
            asm volatile("s_waitcnt vmcnt(0)" ::: "memory");
        } else {
            XB_SPIN(xb_ld(&bar[XB_XGEN(b.x)]) == gen, bar);
            __builtin_amdgcn_fence(__ATOMIC_ACQUIRE, "agent");
            asm volatile("s_waitcnt vmcnt(0)" ::: "memory");
        }
    }
    __syncthreads();
}

constexpr int NPHASE = 13;
DEV void run_phase(const Params& p, int ph, int layer, char* smem) {
    switch (ph) {
        case 0: phase_prologue(p, smem); break;
        case 1: phase_norm(p, layer, 0); break;
        case 2: phase_gemm_in(p, layer, smem); break;
        case 3: phase_layout1(p, smem); break;
        case 4: phase_gemm_mid(p, layer, smem); break;
        case 5: phase_layout2(p, smem); break;
        case 6: phase_attn(p, layer, smem); break;
        case 7: phase_gemm_out(p, layer, smem); break;
        case 8: phase_norm(p, layer, 1); break;
        case 9: phase_gemm_wq(p, layer, smem); break;
        case 10: phase_scores(p, layer, smem); break;
        case 11: phase_topk(p); break;
        case 12: phase_experts(p, layer); break;
        default: break;
    }
}

#if !FUSED
template <int PH>
__global__ void __launch_bounds__(256, 2) k_phase(Params p, int layer) {
    __shared__ __attribute__((aligned(16))) char smem[SM_TOTAL];
    run_phase(p, PH, layer, smem);
}
template <int PH> static void launch_phase(const Params& p, int layer, hipStream_t stream) { k_phase<PH><<<512, 256, 0, stream>>>(p, layer); }
static void launch_ph(int ph, const Params& p, int layer, hipStream_t stream) {
    switch (ph) {
        case 0: launch_phase<0>(p, layer, stream); break;
        case 1: launch_phase<1>(p, layer, stream); break;
        case 2: launch_phase<2>(p, layer, stream); break;
        case 3: launch_phase<3>(p, layer, stream); break;
        case 4: launch_phase<4>(p, layer, stream); break;
        case 5: launch_phase<5>(p, layer, stream); break;
        case 6: launch_phase<6>(p, layer, stream); break;
        case 7: launch_phase<7>(p, layer, stream); break;
        case 8: launch_phase<8>(p, layer, stream); break;
        case 9: launch_phase<9>(p, layer, stream); break;
        case 10: launch_phase<10>(p, layer, stream); break;
        case 11: launch_phase<11>(p, layer, stream); break;
        case 12: launch_phase<12>(p, layer, stream); break;
    }
}
#else
__global__ void __launch_bounds__(256, 2) k_mega(Params p) {
    __shared__ __attribute__((aligned(16))) char smem[SM_TOTAL];
    cg::grid_group grid = cg::this_grid();
    volatile LAS unsigned* st = (volatile LAS unsigned*)(smem + SM_SEL + 768);
    if (threadIdx.x == 0) { st[0] = 0u; st[1] = 0u; }
    __syncthreads();
    const XcdBarrier xb = xcd_barrier_post((unsigned*)p.ws, st);
    run_phase(p, 0, 0, smem);
    grid.sync();
    run_phase(p, 1, 0, smem);
    xcd_barrier(xb);
#pragma unroll 1
    for (int l = 0; l < 2; ++l) {
#pragma unroll 1
        for (int ph = 2; ph < NPHASE; ++ph) {
            run_phase(p, ph, l, smem);
            if (!(l == 1 && ph == NPHASE - 1)) xcd_barrier(xb);
        }
    }
}
#endif

extern "C" void kernel_launch(void* const* d_in, const int* in_sizes, int n_in, void* d_out, int out_size, void* d_ws, size_t ws_size, hipStream_t stream) {
    Params p{};
    const float** pp = (const float**)&p;
    for (int i = 0; i < 28; ++i) pp[i] = (const float*)d_in[i];
    p.out = (float*)d_out;
    p.ws = (char*)d_ws;
    if (ws_size < OFF_END) fprintf(stderr, "workspace too small: %zu < %zu\n", ws_size, (size_t)OFF_END);
    (void)hipMemsetAsync(d_ws, 0, 65536, stream);
#if !FUSED
    launch_ph(0, p, 0, stream);
    launch_ph(1, p, 0, stream);
    for (int l = 0; l < 2; ++l)
        for (int ph = 2; ph < NPHASE; ++ph) launch_ph(ph, p, l, stream);
#else
    static int grid_blocks = 0;
    if (!grid_blocks) {
        int dev = 0, cus = 0, per_cu = 0;
        (void)hipGetDevice(&dev);
        (void)hipDeviceGetAttribute(&cus, hipDeviceAttributeMultiprocessorCount, dev);
        (void)hipOccupancyMaxActiveBlocksPerMultiprocessor(&per_cu, (const void*)k_mega, 256, 0);
        if (per_cu > 2) per_cu = 2;
        if (per_cu < 1) per_cu = 1;
        grid_blocks = cus * per_cu;
    }
    void* args[] = {&p};
    hipError_t e = hipLaunchCooperativeKernel((const void*)k_mega, dim3(grid_blocks), dim3(256), args, 0, stream);
    if (e != hipSuccess) fprintf(stderr, "cooperative launch failed: %s (grid %d)\n", hipGetErrorString(e), grid_blocks);
#endif
}
```

```cpp
#include <hip/hip_runtime.h>
#include <hip/hip_cooperative_groups.h>
#include <stdint.h>
#include <stdio.h>
namespace cg = cooperative_groups;

#ifndef FUSED
#define FUSED 1
#endif
#ifndef PROBE_PH
#define PROBE_PH -1
#define PROBE_L 1
#define PROBE_REP 0
#endif

#define DEV __device__ __forceinline__
typedef unsigned short bf16_t;
typedef short bf16x8 __attribute__((ext_vector_type(8)));
typedef float f32x16 __attribute__((ext_vector_type(16)));

constexpr int kB = 8, kS = 2048, kT = kB * kS, kD = 1024, LDC = 2432;
constexpr float kEps = 1e-6f;
constexpr float kNeg = -1e30f;
constexpr float kLog2e = 1.4426950408889634f;
constexpr float kScaleU = 256.f, kScaleV = 32.f;

constexpr size_t OFF_CTRL = 0;
constexpr size_t OFF_MOD  = 65536;
constexpr size_t OFF_ROPE = OFF_MOD + 2ull * 8 * 6144 * 4;
constexpr size_t OFF_MISC = OFF_ROPE + 2048ull * 96 * 4;
constexpr size_t OFF_WIN  = OFF_MISC + 4096;
constexpr size_t OFF_WOUT = OFF_WIN + 2ull * 2432 * 1024 * 2;
constexpr size_t OFF_WQ   = OFF_WOUT + 2ull * 1024 * 1024 * 2;
constexpr size_t OFF_WUQ  = OFF_WQ + 2ull * 2048 * 1024 * 2;
constexpr size_t OFF_WUKV = OFF_WUQ + 2ull * 384 * 256 * 2;
constexpr size_t OFF_WCK  = OFF_WUKV + 2ull * 512 * 128 * 2;
constexpr size_t OFF_WCV  = OFF_WCK + 2ull * 128 * 2048 * 2;
constexpr size_t OFF_SUBK = OFF_WCV + 2ull * 128 * 2048 * 2;
constexpr size_t OFF_PU   = OFF_SUBK + 2ull * 2 * 128 * 128 * 2;
constexpr size_t OFF_PV   = OFF_PU + 2ull * 16384 * 1024;
constexpr size_t OFF_XRES = OFF_PV + 2ull * 16384 * 1024;
constexpr size_t OFF_H    = OFF_XRES + (size_t)kT * 1024 * 4;
constexpr size_t OFF_RSTD = OFF_H + (size_t)kT * 1024 * 2;
constexpr size_t OFF_KCMP = OFF_RSTD + 2ull * kT * 4;
constexpr size_t OFF_EID  = OFF_KCMP + 2ull * 1024 * 64 * 2;
constexpr size_t OFF_GATE = OFF_EID + (size_t)kT * 128 * 4;
constexpr size_t OFF_QP   = OFF_GATE + (size_t)kT * 128 * 4;
constexpr size_t OFF_COLS = OFF_QP + (size_t)kT * 2048 * 2;
constexpr size_t OFF_KC   = OFF_COLS + (size_t)kT * LDC * 2;
constexpr size_t OFF_VC   = OFF_KC + (size_t)(kT + 64) * 64 * 2;
constexpr size_t OFF_VT   = OFF_VC + (size_t)(kT + 64) * 64 * 2;
constexpr size_t OFF_QMLA = OFF_VT + 8ull * 12 * 64 * 2048 * 2;
constexpr size_t OFF_KVMLA = OFF_QMLA + (size_t)kT * 384 * 2;
constexpr size_t OFF_O    = OFF_KVMLA + (size_t)kT * 512 * 2;
constexpr size_t OFF_END  = OFF_O + (size_t)kT * 1024 * 2;
constexpr size_t OFF_S1 = OFF_COLS, OFF_S2 = OFF_COLS + (size_t)kT * 8 * 128 * 4;
static_assert(OFF_S2 + (size_t)kT * 8 * 128 * 4 <= OFF_O, "alias region too small");
static_assert(OFF_END <= (512ull << 20), "workspace too large");

struct Params {
    const float *x, *c, *ada_w, *ada_b, *norm_mix_g, *norm_ffn_g, *w_in, *pos_k, *pos_v, *cmp_wk, *cmp_wv;
    const float *lq1, *lk1, *lq2, *lk2, *sub_g, *mla_qg, *mla_wuq, *mla_kvg, *mla_wukv, *sinks, *w_out;
    const float *w_q, *subk1, *subk2, *pu, *pv, *final_g;
    float* out;
    char* ws;
};

DEV int ltid() { int t = threadIdx.x; asm volatile("" : "+v"(t)); return t; }
DEV float bf2f(bf16_t v) { return __uint_as_float(((unsigned)v) << 16); }
DEV bf16_t f2bf(float f) { unsigned u = __float_as_uint(f); u += 0x7fffu + ((u >> 16) & 1u); return (bf16_t)(u >> 16); }
DEV unsigned pack2(float lo, float hi) { return (unsigned)f2bf(lo) | ((unsigned)f2bf(hi) << 16); }
DEV float lo16(unsigned u) { return __uint_as_float(u << 16); }
DEV float hi16(unsigned u) { return __uint_as_float(u & 0xffff0000u); }
DEV float wave_sum(float v) {
#pragma unroll
    for (int o = 32; o > 0; o >>= 1) v += __shfl_xor(v, o, 64);
    return v;
}
DEV f32x16 mfma32(bf16x8 a, bf16x8 b, f32x16 c) { return __builtin_amdgcn_mfma_f32_32x32x16_bf16(a, b, c, 0, 0, 0); }
DEV f32x16 zero16() { f32x16 z;
#pragma unroll
    for (int i = 0; i < 16; ++i) z[i] = 0.f;
    return z; }
DEV float gelu_tanh(float x) {
    const float u = 0.7978845608028654f * (x + 0.044715f * x * x * x);
    const float e = __expf(2.f * u);
    const float t = 1.f - 2.f / (e + 1.f);
    return 0.5f * x * (1.f + t);
}

template <class Epi>
DEV void gemm_tile(const bf16_t* __restrict__ A, int lda, const bf16_t* __restrict__ Bt, int ldb, int K, int m0, int n0, char* smem, const Epi& epi) {
    bf16_t* As = (bf16_t*)smem;
    bf16_t* Bs = As + 128 * 72;
    const int tid = ltid(), lane = tid & 63, w = tid >> 6, wm = w >> 1, wn = w & 1, ql = lane & 31, hh = lane >> 5;
    f32x16 acc[2][2];
#pragma unroll
    for (int i = 0; i < 2; ++i)
#pragma unroll
        for (int j = 0; j < 2; ++j) acc[i][j] = zero16();
    const bf16_t* Ap = A + (size_t)m0 * lda;
    const bf16_t* Bp = Bt + (size_t)n0 * ldb;
    const int lrow = tid >> 3, lck = (tid & 7) * 8;
    const bf16_t* Ag = Ap + (size_t)lrow * lda + lck;
    const bf16_t* Bg = Bp + (size_t)lrow * ldb + lck;
    const size_t a32 = (size_t)32 * lda, b32 = (size_t)32 * ldb;
    uint4 ra0 = *(const uint4*)(Ag), ra1 = *(const uint4*)(Ag + a32), ra2 = *(const uint4*)(Ag + 2 * a32), ra3 = *(const uint4*)(Ag + 3 * a32);
    uint4 rb0 = *(const uint4*)(Bg), rb1 = *(const uint4*)(Bg + b32), rb2 = *(const uint4*)(Bg + 2 * b32), rb3 = *(const uint4*)(Bg + 3 * b32);
    bf16_t* Asw = As + lrow * 72 + lck;
    bf16_t* Bsw = Bs + lrow * 72 + lck;
    for (int k0 = 0; k0 < K; k0 += 64) {
        __syncthreads();
        *(uint4*)(Asw) = ra0; *(uint4*)(Asw + 32 * 72) = ra1; *(uint4*)(Asw + 64 * 72) = ra2; *(uint4*)(Asw + 96 * 72) = ra3;
        *(uint4*)(Bsw) = rb0; *(uint4*)(Bsw + 32 * 72) = rb1; *(uint4*)(Bsw + 64 * 72) = rb2; *(uint4*)(Bsw + 96 * 72) = rb3;
        __syncthreads();
        if (k0 + 64 < K) {
            const bf16_t* Agk = Ag + k0 + 64; const bf16_t* Bgk = Bg + k0 + 64;
            ra0 = *(const uint4*)(Agk); ra1 = *(const uint4*)(Agk + a32); ra2 = *(const uint4*)(Agk + 2 * a32); ra3 = *(const uint4*)(Agk + 3 * a32);
            rb0 = *(const uint4*)(Bgk); rb1 = *(const uint4*)(Bgk + b32); rb2 = *(const uint4*)(Bgk + 2 * b32); rb3 = *(const uint4*)(Bgk + 3 * b32);
        }
#pragma unroll
        for (int ks = 0; ks < 4; ++ks) {
            bf16x8 a[2], b[2];
#pragma unroll
            for (int i = 0; i < 2; ++i) {
                a[i] = *(const bf16x8*)(As + (wm * 64 + i * 32 + ql) * 72 + ks * 16 + hh * 8);
                b[i] = *(const bf16x8*)(Bs + (wn * 64 + i * 32 + ql) * 72 + ks * 16 + hh * 8);
            }
#pragma unroll
            for (int i = 0; i < 2; ++i)
#pragma unroll
                for (int j = 0; j < 2; ++j) acc[i][j] = mfma32(a[i], b[j], acc[i][j]);
        }
    }
#pragma unroll
    for (int i = 0; i < 2; ++i)
#pragma unroll
        for (int j = 0; j < 2; ++j)
#pragma unroll
            for (int g = 0; g < 4; ++g) {
                const int m = m0 + wm * 64 + i * 32 + 8 * g + 4 * hh;
                const int n = n0 + wn * 64 + j * 32 + ql;
                epi(m, n, acc[i][j][4 * g], acc[i][j][4 * g + 1], acc[i][j][4 * g + 2], acc[i][j][4 * g + 3]);
            }
}

struct EpiBf16 {
    bf16_t* C; int ldc; const float* rowscale; const float* colbias; int nvalid;
    DEV void operator()(int m, int n, float v0, float v1, float v2, float v3) const {
        if (n >= nvalid) return;
        float bsv = colbias ? colbias[n] : 0.f;
        float s0 = 1.f, s1 = 1.f, s2 = 1.f, s3 = 1.f;
        if (rowscale) { s0 = rowscale[m]; s1 = rowscale[m + 1]; s2 = rowscale[m + 2]; s3 = rowscale[m + 3]; }
        bf16_t* p = C + (size_t)m * ldc + n;
        p[0] = f2bf(v0 * s0 + bsv); p[ldc] = f2bf(v1 * s1 + bsv); p[2 * ldc] = f2bf(v2 * s2 + bsv); p[3 * ldc] = f2bf(v3 * s3 + bsv);
    }
};
struct EpiF32 {
    float* C; int ldc;
    DEV void operator()(int m, int n, float v0, float v1, float v2, float v3) const {
        float* p = C + (size_t)m * ldc + n;
        p[0] = v0; p[ldc] = v1; p[2 * ldc] = v2; p[3 * ldc] = v3;
    }
};
struct EpiRes {
    const float* xin; float* xout; const float* gate;
    DEV void operator()(int m, int n, float v0, float v1, float v2, float v3) const {
        const float g = gate[(size_t)(m >> 11) * 6144 + n];
        const float* pi = xin + (size_t)m * 1024 + n; float* po = xout + (size_t)m * 1024 + n;
        po[0] = pi[0] + g * v0; po[1024] = pi[1024] + g * v1; po[2048] = pi[2048] + g * v2; po[3072] = pi[3072] + g * v3;
    }
};

template <class Epi>
DEV void gemm_phase(const bf16_t* A, int lda, const bf16_t* Bt, int ldb, int K, int mtiles, int ntiles, char* smem, const Epi& epi) {
    for (int tile = blockIdx.x; tile < mtiles * ntiles; tile += gridDim.x) {
        const int mt = tile / ntiles, nt = tile % ntiles;
        gemm_tile(A, lda, Bt, ldb, K, mt * 128, nt * 128, smem, epi);
    }
}

DEV int win_srccol(int n) {
    if (n < 652) return n;
    if (n < 704) return -1;
    if (n < 1888) return n - 52;
    if (n < 1920) return -1;
    return n - 84;
}
DEV void transpose_tile(const float* __restrict__ src, int ld_src, int nsrc_valid, int mode, const float* __restrict__ rowscale,
                        bf16_t* __restrict__ dst, int K, int n0, int k0, char* smem) {
    bf16_t* Ls = (bf16_t*)smem;
    const int tid = ltid();
    __syncthreads();
    const int nn = tid & 63, n = n0 + nn;
    const int sc = (mode == 1) ? win_srccol(n) : (n < nsrc_valid ? n : -1);
#pragma unroll 4
    for (int i = 0; i < 16; ++i) {
        const int kk = (tid >> 6) + 4 * i;
        float v = 0.f;
        if (sc >= 0) { v = src[(size_t)(k0 + kk) * ld_src + sc]; if (rowscale) v *= rowscale[k0 + kk]; }
        Ls[nn * 72 + kk] = f2bf(v);
    }
    __syncthreads();
#pragma unroll
    for (int i = 0; i < 2; ++i) {
        const int r = (tid >> 3) + 32 * i, ch = tid & 7;
        *(uint4*)(dst + (size_t)(n0 + r) * K + k0 + ch * 8) = *(const uint4*)(Ls + r * 72 + ch * 8);
    }
}

DEV void convert_stream(const float* __restrict__ src, bf16_t* __restrict__ dst, size_t n8) {
    const int tid = ltid();
    for (size_t i = (size_t)blockIdx.x * 256 + tid; i < n8; i += (size_t)gridDim.x * 256) {
        const float4 a = *(const float4*)(src + i * 8), b = *(const float4*)(src + i * 8 + 4);
        uint4 o; o.x = pack2(a.x, a.y); o.y = pack2(a.z, a.w); o.z = pack2(b.x, b.y); o.w = pack2(b.z, b.w);
        *(uint4*)(dst + i * 8) = o;
    }
}

DEV void convert_fp8_stream(const float* __restrict__ src, unsigned char* __restrict__ dst, size_t n16, float scale) {
    const int tid = ltid();
    for (size_t i = (size_t)blockIdx.x * 256 + tid; i < n16; i += (size_t)gridDim.x * 256) {
        const float4 a = *(const float4*)(src + i * 16), b = *(const float4*)(src + i * 16 + 4), c = *(const float4*)(src + i * 16 + 8), d = *(const float4*)(src + i * 16 + 12);
        const float v[16] = {a.x, a.y, a.z, a.w, b.x, b.y, b.z, b.w, c.x, c.y, c.z, c.w, d.x, d.y, d.z, d.w};
        unsigned o[4];
#pragma unroll
        for (int j = 0; j < 4; ++j) {
            unsigned w = 0u;
            w = __builtin_amdgcn_cvt_pk_fp8_f32(fminf(fmaxf(v[4 * j] * scale, -440.f), 440.f), fminf(fmaxf(v[4 * j + 1] * scale, -440.f), 440.f), w, false);
            w = __builtin_amdgcn_cvt_pk_fp8_f32(fminf(fmaxf(v[4 * j + 2] * scale, -440.f), 440.f), fminf(fmaxf(v[4 * j + 3] * scale, -440.f), 440.f), w, true);
            o[j] = w;
        }
        *(uint4*)(dst + i * 16) = make_uint4(o[0], o[1], o[2], o[3]);
    }
}

constexpr int J_ROPE = 384, J_MOD = 192, J_MISC = 5;
constexpr int J_TW_L = 608 + 256 + 512 + 24 + 16 + 64 + 64;
constexpr int J_TOTAL = J_ROPE + J_MOD + J_MISC + 2 * J_TW_L;

DEV void prologue_job(const Params& p, int job, char* smem) {
    const int tid = ltid();
    char* ws = p.ws;
    if (job < J_ROPE) {
        const int idx = job * 256 + tid;
        const int s = idx / 48, j = idx % 48;
        float* rope = (float*)(ws + OFF_ROPE);
        float inv; float *pc, *ps;
        if (j < 32) { inv = exp2f(-(float)j * (13.287712379549449f / 32.f)); pc = rope + s * 32 + j; ps = rope + 2048 * 32 + s * 32 + j; }
        else { const int i = j - 32; inv = exp2f(-(float)i * (13.287712379549449f / 16.f)); pc = rope + 2048 * 64 + s * 16 + i; ps = rope + 2048 * 64 + 2048 * 16 + s * 16 + i; }
        const double a = (double)s * (double)inv;
        const double kk = rint(a * 0.15915494309189535);
        const float r = (float)fma(-kk, 6.283185307179586, a);
        *pc = cosf(r); *ps = sinf(r);
        return;
    }
    job -= J_ROPE;
    if (job < J_MOD) {
        const int l = job / 96, n0 = (job % 96) * 64;
        float* sc = (float*)smem;
        __syncthreads();
        for (int i = tid; i < 8192; i += 256) { const float v = p.c[i]; sc[i] = v / (1.f + __expf(-v)); }
        __syncthreads();
        const int kp = tid >> 6, col = tid & 63;
        float acc[8];
#pragma unroll
        for (int b = 0; b < 8; ++b) acc[b] = 0.f;
        const float* wp = p.ada_w + (size_t)l * 1024 * 6144 + n0 + col;
        for (int k = kp * 256; k < kp * 256 + 256; ++k) {
            const float wv = wp[(size_t)k * 6144];
#pragma unroll
            for (int b = 0; b < 8; ++b) acc[b] += sc[b * 1024 + k] * wv;
        }
        float* red = sc + 8192;
#pragma unroll
        for (int b = 0; b < 8; ++b) red[(kp * 8 + b) * 64 + col] = acc[b];
        __syncthreads();
        float* mod = (float*)(ws + OFF_MOD);
        for (int idx = tid; idx < 512; idx += 256) {
            const int b = idx >> 6, cl = idx & 63;
            const float v = red[(0 * 8 + b) * 64 + cl] + red[(1 * 8 + b) * 64 + cl] + red[(2 * 8 + b) * 64 + cl] + red[(3 * 8 + b) * 64 + cl];
            mod[(size_t)(l * 8 + b) * 6144 + n0 + cl] = v + p.ada_b[l * 6144 + n0 + cl];
        }
        return;
    }
    job -= J_MOD;
    if (job < J_MISC) {
        float* misc = (float*)(ws + OFF_MISC);
        if (job < 4) {
            const int l = job >> 1, kv = job & 1;
            const float* pos = (kv ? p.pos_v : p.pos_k) + l * 2048;
            const float* wsrc = (kv ? p.cmp_wv : p.cmp_wk) + (size_t)l * 2048 * 64;
            float* red = (float*)smem;
            __syncthreads();
            const int kp = tid >> 6, n = tid & 63;
            float acc = 0.f;
            for (int k = kp * 512; k < kp * 512 + 512; ++k) acc += pos[k] * wsrc[(size_t)k * 64 + n];
            red[kp * 64 + n] = acc;
            __syncthreads();
            if (tid < 64) misc[(l * 2 + kv) * 64 + tid] = red[tid] + red[64 + tid] + red[128 + tid] + red[192 + tid];
        } else if (tid < 2) {
            const int l = tid;
            float d1 = 0.f, d2 = 0.f;
            for (int i = 0; i < 32; ++i) { d1 += p.lq1[l * 32 + i] * p.lk1[l * 32 + i]; d2 += p.lq2[l * 32 + i] * p.lk2[l * 32 + i]; }
            const float lam_init = 0.8f - 0.6f * expf(-0.3f * (float)l);
            misc[256 + l] = expf(d1) - expf(d2) + lam_init;
            misc[258 + l] = 1.f - lam_init;
        }
        return;
    }
    job -= J_MISC;
    const int l = job / J_TW_L; int j = job % J_TW_L;
    if (j < 608) { transpose_tile(p.w_in + (size_t)l * 1024 * 2348, 2348, 2348, 1, nullptr, (bf16_t*)(ws + OFF_WIN) + (size_t)l * 2432 * 1024, 1024, (j / 16) * 64, (j % 16) * 64, smem); return; }
    j -= 608;
    if (j < 256) { transpose_tile(p.w_out + (size_t)l * 1024 * 1024, 1024, 1024, 0, nullptr, (bf16_t*)(ws + OFF_WOUT) + (size_t)l * 1024 * 1024, 1024, (j / 16) * 64, (j % 16) * 64, smem); return; }
    j -= 256;
    if (j < 512) { transpose_tile(p.w_q + (size_t)l * 1024 * 2048, 2048, 2048, 0, nullptr, (bf16_t*)(ws + OFF_WQ) + (size_t)l * 2048 * 1024, 1024, (j / 16) * 64, (j % 16) * 64, smem); return; }
    j -= 512;
    if (j < 24) { transpose_tile(p.mla_wuq + (size_t)l * 256 * 384, 384, 384, 0, p.mla_qg + l * 256, (bf16_t*)(ws + OFF_WUQ) + (size_t)l * 384 * 256, 256, (j / 4) * 64, (j % 4) * 64, smem); return; }
    j -= 24;
    if (j < 16) { transpose_tile(p.mla_wukv + (size_t)l * 128 * 512, 512, 512, 0, p.mla_kvg + l * 128, (bf16_t*)(ws + OFF_WUKV) + (size_t)l * 512 * 128, 128, (j / 2) * 64, (j % 2) * 64, smem); return; }
    j -= 16;
    if (j < 64) { transpose_tile(p.cmp_wk + (size_t)l * 2048 * 64, 64, 64, 0, nullptr, (bf16_t*)(ws + OFF_WCK) + (size_t)l * 128 * 2048, 2048, (j / 32) * 64, (j % 32) * 64, smem); return; }
    j -= 64;
    transpose_tile(p.cmp_wv + (size_t)l * 2048 * 64, 64, 64, 0, nullptr, (bf16_t*)(ws + OFF_WCV) + (size_t)l * 128 * 2048, 2048, (j / 32) * 64, (j % 32) * 64, smem);
}

DEV void phase_prologue(const Params& p, char* smem) {
    for (int job = blockIdx.x; job < J_TOTAL; job += gridDim.x) prologue_job(p, job, smem);
    char* ws = p.ws;
    convert_fp8_stream(p.pu, (unsigned char*)(ws + OFF_PU), 2ull * 16384 * 1024 / 16, kScaleU);
    convert_fp8_stream(p.pv, (unsigned char*)(ws + OFF_PV), 2ull * 16384 * 1024 / 16, kScaleV);
    for (int l = 0; l < 2; ++l) {
        convert_stream(p.subk1 + (size_t)l * 16384, (bf16_t*)(ws + OFF_SUBK) + (size_t)(l * 2 + 0) * 16384, 16384 / 8);
        convert_stream(p.subk2 + (size_t)l * 16384, (bf16_t*)(ws + OFF_SUBK) + (size_t)(l * 2 + 1) * 16384, 16384 / 8);
    }
}

DEV void phase_norm(const Params& p, int layer, int which) {
    const int tid = ltid(), lane = tid & 63, w = tid >> 6;
    const float* xs = (layer == 0 && which == 0) ? p.x : (const float*)(p.ws + OFF_XRES);
    const float* g = (which == 0 ? p.norm_mix_g : p.norm_ffn_g) + layer * 1024;
    const float* mod = (const float*)(p.ws + OFF_MOD) + (size_t)layer * 8 * 6144;
    bf16_t* h = (bf16_t*)(p.ws + OFF_H);
    for (int q = blockIdx.x; q < kT / 4; q += gridDim.x) {
        const int t = q * 4 + w, b = t >> 11;
        const float* xr = xs + (size_t)t * 1024;
        float4 v[4]; float ss = 0.f;
#pragma unroll
        for (int i = 0; i < 4; ++i) { v[i] = *(const float4*)(xr + i * 256 + lane * 4); ss += v[i].x * v[i].x + v[i].y * v[i].y + v[i].z * v[i].z + v[i].w * v[i].w; }
        ss = wave_sum(ss);
        const float rstd = rsqrtf(ss * (1.f / 1024.f) + kEps);
        const float* sh = mod + (size_t)b * 6144 + (which ? 3072 : 0);
        const float* sc = sh + 1024;
#pragma unroll
        for (int i = 0; i < 4; ++i) {
            const int col = i * 256 + lane * 4;
            const float4 g4 = *(const float4*)(g + col), s4 = *(const float4*)(sc + col), h4 = *(const float4*)(sh + col);
            uint2 o;
            o.x = pack2(v[i].x * rstd * g4.x * (1.f + s4.x) + h4.x, v[i].y * rstd * g4.y * (1.f + s4.y) + h4.y);
            o.y = pack2(v[i].z * rstd * g4.z * (1.f + s4.z) + h4.z, v[i].w * rstd * g4.w * (1.f + s4.w) + h4.w);
            *(uint2*)(h + (size_t)t * 1024 + col) = o;
        }
    }
}

DEV void rope8(uint4& x1, uint4& x2, const float* cs, const float* sn) {
    const float4 c0 = *(const float4*)cs, c1 = *(const float4*)(cs + 4), s0 = *(const float4*)sn, s1 = *(const float4*)(sn + 4);
    const float cc[8] = {c0.x, c0.y, c0.z, c0.w, c1.x, c1.y, c1.z, c1.w};
    const float ss[8] = {s0.x, s0.y, s0.z, s0.w, s1.x, s1.y, s1.z, s1.w};
    unsigned a[4] = {x1.x, x1.y, x1.z, x1.w}, b[4] = {x2.x, x2.y, x2.z, x2.w};
#pragma unroll
    for (int i = 0; i < 4; ++i) {
        const float a0 = lo16(a[i]), a1 = hi16(a[i]), b0 = lo16(b[i]), b1 = hi16(b[i]);
        const float o10 = a0 * cc[2 * i] - b0 * ss[2 * i], o11 = a1 * cc[2 * i + 1] - b1 * ss[2 * i + 1];
        const float o20 = a0 * ss[2 * i] + b0 * cc[2 * i], o21 = a1 * ss[2 * i + 1] + b1 * cc[2 * i + 1];
        a[i] = pack2(o10, o11); b[i] = pack2(o20, o21);
    }
    x1 = make_uint4(a[0], a[1], a[2], a[3]); x2 = make_uint4(b[0], b[1], b[2], b[3]);
}
DEV void vt_tile(const bf16_t* __restrict__ src, int ld, bf16_t* __restrict__ dst, char* smem) {
    bf16_t* Ls = (bf16_t*)smem;
    const int tid = ltid();
    __syncthreads();
#pragma unroll
    for (int i = 0; i < 2; ++i) {
        const int id = tid + 256 * i, tok = id >> 3, ch = id & 7;
        *(uint4*)(Ls + tok * 72 + ch * 8) = *(const uint4*)(src + (size_t)tok * ld + ch * 8);
    }
    __syncthreads();
#pragma unroll
    for (int i = 0; i < 2; ++i) {
        const int id = tid + 256 * i, d = id >> 3, tc = id & 7;
        unsigned short e[8];
#pragma unroll
        for (int j = 0; j < 8; ++j) e[j] = Ls[(tc * 8 + j) * 72 + d];
        uint4 o;
        o.x = (unsigned)e[0] | ((unsigned)e[1] << 16); o.y = (unsigned)e[2] | ((unsigned)e[3] << 16);
        o.z = (unsigned)e[4] | ((unsigned)e[5] << 16); o.w = (unsigned)e[6] | ((unsigned)e[7] << 16);
        *(uint4*)(dst + (size_t)d * 2048 + tc * 8) = o;
    }
}

DEV void phase_layout1(const Params& p, char* smem) {
    char* ws = p.ws;
    bf16_t* cols = (bf16_t*)(ws + OFF_COLS);
    bf16_t* kc = (bf16_t*)(ws + OFF_KC);
    bf16_t* vc = (bf16_t*)(ws + OFF_VC);
    bf16_t* VT = (bf16_t*)(ws + OFF_VT);
    float* rstd = (float*)(ws + OFF_RSTD);
    const float* rope = (const float*)(ws + OFF_ROPE);
    const float *cos64 = rope, *sin64 = rope + 2048 * 32, *cos32 = rope + 2048 * 64, *sin32 = rope + 2048 * 64 + 2048 * 16;
    const int tid = ltid();
    for (int tile = blockIdx.x; tile < kT / 64; tile += gridDim.x) {
        const int T0 = tile * 64, b = T0 >> 11, s0 = T0 & 2047;
        for (int it = tid; it < 64 * 94; it += 256) {
            const int tok = it / 94, item = it % 94;
            const int t = T0 + tok, s = s0 + tok;
            bf16_t* row = cols + (size_t)t * LDC;
            if (item < 52) {
                const int hd = item >> 2, i0 = (item & 3) * 8;
                const int base = hd < 4 ? 64 * hd : hd == 4 ? 256 : hd == 5 ? 384 : hd == 6 ? 512 : hd < 11 ? 1920 + 64 * (hd - 7) : 2176 + 64 * (hd - 11);
                uint4 x1 = *(const uint4*)(row + base + i0), x2 = *(const uint4*)(row + base + 32 + i0);
                rope8(x1, x2, cos64 + s * 32 + i0, sin64 + s * 32 + i0);
                *(uint4*)(row + base + i0) = x1; *(uint4*)(row + base + 32 + i0) = x2;
                if (hd == 4) { *(uint4*)(kc + (size_t)t * 64 + i0) = x1; *(uint4*)(kc + (size_t)t * 64 + 32 + i0) = x2; }
            } else if (item < 86) {
                const int it2 = item - 52, sub = it2 >> 1, i0 = (it2 & 1) * 8;
                const int base = sub < 8 ? 704 + 32 * sub : sub < 16 ? 960 + 32 * (sub - 8) : 1856;
                uint4 x1 = *(const uint4*)(row + base + i0), x2 = *(const uint4*)(row + base + 16 + i0);
                rope8(x1, x2, cos32 + s * 16 + i0, sin32 + s * 16 + i0);
                *(uint4*)(row + base + i0) = x1; *(uint4*)(row + base + 16 + i0) = x2;
            } else {
                const int ch = item - 86;
                *(uint4*)(vc + (size_t)t * 64 + ch * 8) = *(const uint4*)(row + 320 + ch * 8);
            }
        }
        {
            const int tok = tid >> 2, part = tid & 3, t = T0 + tok;
            const bf16_t* src = cols + (size_t)t * LDC + 1472 + (part < 3 ? part : 0) * 128;
            float ss = 0.f;
#pragma unroll 4
            for (int i = 0; i < 16; ++i) {
                const uint4 u = *(const uint4*)(src + i * 8);
                ss += lo16(u.x) * lo16(u.x) + hi16(u.x) * hi16(u.x) + lo16(u.y) * lo16(u.y) + hi16(u.y) * hi16(u.y)
                    + lo16(u.z) * lo16(u.z) + hi16(u.z) * hi16(u.z) + lo16(u.w) * lo16(u.w) + hi16(u.w) * hi16(u.w);
            }
            float vq = part < 2 ? ss : 0.f;
            vq += __shfl_xor(vq, 1, 64);
            if (part == 0) rstd[t] = rsqrtf(vq * (1.f / 256.f) + kEps);
            if (part == 2) rstd[kT + t] = rsqrtf(ss * (1.f / 128.f) + kEps);
        }
#pragma unroll 1
        for (int vh = 0; vh < 8; ++vh) {
            const int col = vh == 0 ? 448 : vh == 1 ? 576 : vh < 6 ? 1216 + 64 * (vh - 2) : 2304 + 64 * (vh - 6);
            vt_tile(cols + (size_t)T0 * LDC + col, LDC, VT + ((size_t)(b * 12 + vh) * 64) * 2048 + s0, smem);
        }
    }
}

DEV void phase_layout2(const Params& p, char* smem) {
    char* ws = p.ws;
    bf16_t* qmla = (bf16_t*)(ws + OFF_QMLA);
    const bf16_t* kvmla = (const bf16_t*)(ws + OFF_KVMLA);
    bf16_t* VT = (bf16_t*)(ws + OFF_VT);
    const float* rope = (const float*)(ws + OFF_ROPE);
    const float *cos32 = rope + 2048 * 64, *sin32 = rope + 2048 * 64 + 2048 * 16;
    const int tid = ltid();
    for (int tile = blockIdx.x; tile < kT / 64; tile += gridDim.x) {
        const int T0 = tile * 64, b = T0 >> 11, s0 = T0 & 2047;
        for (int it = tid; it < 64 * 8; it += 256) {
            const int tok = it >> 3, item = it & 7, hd = item >> 1, i0 = (item & 1) * 8;
            const int t = T0 + tok, s = s0 + tok;
            bf16_t* row = qmla + (size_t)t * 384 + hd * 96 + 64;
            uint4 x1 = *(const uint4*)(row + i0), x2 = *(const uint4*)(row + 16 + i0);
            rope8(x1, x2, cos32 + s * 16 + i0, sin32 + s * 16 + i0);
            *(uint4*)(row + i0) = x1; *(uint4*)(row + 16 + i0) = x2;
        }
#pragma unroll 1
        for (int hd = 0; hd < 4; ++hd)
            vt_tile(kvmla + (size_t)T0 * 512 + hd * 128 + 64, 512, VT + ((size_t)(b * 12 + 8 + hd) * 64) * 2048 + s0, smem);
    }
}

constexpr int SM_K = 0;
constexpr int SM_V = 18432;
constexpr int SM_IMP = SM_V + 16896;
constexpr int SM_SEL = SM_IMP + 16896;
constexpr int SM_TOTAL = SM_SEL + 1024;

struct RangeIter { int cur, end; DEV int next() { return cur < end ? cur++ : -1; } };
struct BitIter { unsigned rem; DEV int next() { if (!rem) return -1; const int k = __ffs((int)rem) - 1; rem &= rem - 1; return k; } };
struct LdRow { const bf16_t* base; int ld;
    DEV uint4 operator()(int kt, int id) const { const int row = id >> 3, part = id & 7; return *(const uint4*)(base + (size_t)(kt * 64 + row) * ld + part * 8); } };
struct LdVT { const bf16_t* base;
    DEV uint4 operator()(int kt, int id) const { const int d = id >> 3, part = id & 7; return *(const uint4*)(base + (size_t)d * 2048 + kt * 64 + part * 8); } };
struct LdMlaK { const bf16_t* kv; const bf16_t* kr;
    DEV uint4 operator()(int kt, int id) const { const int row = id / 12, part = id % 12; const size_t t = (size_t)(kt * 64 + row);
        return part < 8 ? *(const uint4*)(kv + t * 512 + part * 8) : *(const uint4*)(kr + t * LDC + (part - 8) * 8); } };

struct MaskCausal { DEV bool on(int) const { return true; } DEV bool ok(int kc, int d) const { return kc <= d; } };
template <int W> struct MaskWin { DEV bool on(int) const { return true; } DEV bool ok(int kc, int d) const { return (kc <= d) && (d - kc < W); } };
struct MaskSel { unsigned bits; DEV bool on(int kt) const { return (bits >> kt) & 1u; } DEV bool ok(int kc, int d) const { return kc <= d; } };
template <int KDIM, int NKS, int NSUB, class It, class LK, class LV, class MaskF, class SkipF>
DEV void attn_stream(It it, const LK& ldK, const LV& ldV, const MaskF& maskf, const SkipF& skipf,
                     const bf16x8* qf, f32x16 (&o)[NSUB][2], float (&m)[NSUB], float (&l)[NSUB], float scl, int tq, char* smem, int tid, int koff = 0) {
    constexpr int KCH = KDIM / 8, KSTR = KDIM + 8, NKC = (64 * KCH) / 256;
    bf16_t* Kb = (bf16_t*)(smem + SM_K);
    bf16_t* Vb = (bf16_t*)(smem + SM_V);
    const int lane = tid & 63, ql = lane & 31, hh = lane >> 5;
    uint4 rk0 = make_uint4(0, 0, 0, 0), rk1 = rk0, rk2 = rk0, rv0 = rk0, rv1 = rk0;
    int kt = it.next();
    if (kt >= 0) {
        rk0 = ldK(kt, tid); rk1 = ldK(kt, tid + 256);
        if (NKC == 3) rk2 = ldK(kt, tid + 512);
        rv0 = ldV(kt, tid); rv1 = ldV(kt, tid + 256);
    }
    while (kt >= 0) {
        __syncthreads();
        { const int id = tid, row = id / KCH, part = id % KCH; *(uint4*)(Kb + row * KSTR + part * 8) = rk0; }
        { const int id = tid + 256, row = id / KCH, part = id % KCH; *(uint4*)(Kb + row * KSTR + part * 8) = rk1; }
        if (NKC == 3) { const int id = tid + 512, row = id / KCH, part = id % KCH; *(uint4*)(Kb + row * KSTR + part * 8) = rk2; }
        { const int id = tid, row = id >> 3, part = id & 7; bf16_t* d = Vb + row * 68 + part * 8;
            *(uint2*)d = make_uint2(rv0.x, rv0.y); *(uint2*)(d + 4) = make_uint2(rv0.z, rv0.w); }
        { const int id = tid + 256, row = id >> 3, part = id & 7; bf16_t* d = Vb + row * 68 + part * 8;
            *(uint2*)d = make_uint2(rv1.x, rv1.y); *(uint2*)(d + 4) = make_uint2(rv1.z, rv1.w); }
        __syncthreads();
        const int ktn = it.next();
        if (ktn >= 0) {
            rk0 = ldK(ktn, tid); rk1 = ldK(ktn, tid + 256);
            if (NKC == 3) rk2 = ldK(ktn, tid + 512);
            rv0 = ldV(ktn, tid); rv1 = ldV(ktn, tid + 256);
        }
        if (!skipf(kt)) {
#pragma unroll
            for (int sub = 0; sub < NSUB; ++sub) {
                __builtin_amdgcn_sched_barrier(0);
                f32x16 s[2];
#pragma unroll
                for (int i = 0; i < 2; ++i) {
                    s[i] = zero16();
#pragma unroll
                    for (int ks = 0; ks < NKS; ++ks) {
                        const bf16x8 a = *(const bf16x8*)(Kb + (i * 32 + ql) * KSTR + koff + (sub * NKS + ks) * 16 + hh * 8);
                        s[i] = mfma32(a, qf[sub * NKS + ks], s[i]);
                    }
                }
                float mx = kNeg;
                const int dlim = tq - kt * 64 - 4 * hh;
                const bool on = maskf.on(kt);
#pragma unroll
                for (int i = 0; i < 2; ++i)
#pragma unroll
                    for (int r = 0; r < 16; ++r) {
                        const int kc = i * 32 + (r & 3) + 8 * (r >> 2);
                        const float v = (on && maskf.ok(kc, dlim)) ? s[i][r] * scl : kNeg;
                        s[i][r] = v; mx = fmaxf(mx, v);
                    }
                mx = fmaxf(mx, __shfl_xor(mx, 32, 64));
                const float mnew = fmaxf(m[sub], mx);
                const float alpha = __builtin_amdgcn_exp2f(m[sub] - mnew);
                m[sub] = mnew;
                float sum = 0.f;
#pragma unroll
                for (int i = 0; i < 2; ++i)
#pragma unroll
                    for (int r = 0; r < 16; ++r) { const float pv = __builtin_amdgcn_exp2f(s[i][r] - mnew); s[i][r] = pv; sum += pv; }
                l[sub] = l[sub] * alpha + sum;
#pragma unroll
                for (int dt = 0; dt < 2; ++dt)
#pragma unroll
                    for (int r = 0; r < 16; ++r) o[sub][dt][r] *= alpha;
                __builtin_amdgcn_sched_barrier(0);
#pragma unroll
                for (int ks = 0; ks < 4; ++ks) {
                    if (ks == 2) __builtin_amdgcn_sched_barrier(0);
                    const int i = ks >> 1, r0 = 8 * (ks & 1);
                    uint4 pu;
                    pu.x = pack2(s[i][r0 + 0], s[i][r0 + 1]); pu.y = pack2(s[i][r0 + 2], s[i][r0 + 3]);
                    pu.z = pack2(s[i][r0 + 4], s[i][r0 + 5]); pu.w = pack2(s[i][r0 + 6], s[i][r0 + 7]);
                    const bf16x8 pf = __builtin_bit_cast(bf16x8, pu);
#pragma unroll
                    for (int dt = 0; dt < 2; ++dt) {
                        const bf16_t* vp = Vb + (dt * 32 + ql) * 68 + ks * 16 + 4 * hh;
                        const uint2 a0 = *(const uint2*)vp, a1 = *(const uint2*)(vp + 8);
                        const bf16x8 a = __builtin_bit_cast(bf16x8, make_uint4(a0.x, a0.y, a1.x, a1.y));
                        o[sub][dt] = mfma32(a, pf, o[sub][dt]);
                    }
                }
            }
        }
        kt = ktn;
    }
}

DEV void write_o(const f32x16 (&o)[2], bf16_t* obuf, size_t row, int col0, int hh) {
#pragma unroll
    for (int dt = 0; dt < 2; ++dt)
#pragma unroll
        for (int g = 0; g < 4; ++g) {
            const int d = dt * 32 + 8 * g + 4 * hh;
            uint2 u; u.x = pack2(o[dt][4 * g], o[dt][4 * g + 1]); u.y = pack2(o[dt][4 * g + 2], o[dt][4 * g + 3]);
            *(uint2*)(obuf + row * 1024 + col0 + d) = u;
        }
}
DEV float sigmoidf(float x) { return 1.f / (1.f + __expf(-x)); }

DEV void nsa_item(const Params& p, int b, int qb, char* smem) {
    int tid = threadIdx.x; asm volatile("" : "+v"(tid));
    const int lane = tid & 63, w = tid >> 6, ql = lane & 31, hh = lane >> 5;
    char* ws = p.ws;
    const bf16_t* cols = (const bf16_t*)(ws + OFF_COLS);
    const bf16_t* VT = (const bf16_t*)(ws + OFF_VT);
    bf16_t* obuf = (bf16_t*)(ws + OFF_O);
    const int t0 = qb * 32, tq = t0 + ql;
    const size_t Tb = (size_t)b * kS;
    const bf16_t* qrow = cols + (Tb + tq) * LDC;
    bf16x8 qf[4];
#pragma unroll
    for (int ks = 0; ks < 4; ++ks) qf[ks] = *(const bf16x8*)(qrow + w * 64 + ks * 16 + hh * 8);
    const float g0 = sigmoidf(bf2f(qrow[640 + w * 3 + 0])), g1 = sigmoidf(bf2f(qrow[640 + w * 3 + 1])), g2 = sigmoidf(bf2f(qrow[640 + w * 3 + 2]));
    const float scl = 0.125f * kLog2e;
    bf16_t* Kc = (bf16_t*)(smem + SM_K);
    bf16_t* Vc = (bf16_t*)(smem + SM_V);
    float* impP = (float*)(smem + SM_IMP);
    unsigned* selm = (unsigned*)(smem + SM_SEL);
    const bf16_t* kcmp = (const bf16_t*)(ws + OFF_KCMP) + (size_t)b * 128 * 64;
    const bf16_t* vcmp = kcmp + 1024 * 64;
    __syncthreads();
#pragma unroll
    for (int i = 0; i < 4; ++i) {
        const int id = tid + 256 * i, row = id >> 3, part = id & 7;
        uint4 kk = *(const uint4*)(kcmp + row * 64 + part * 8);
        uint4 vv = *(const uint4*)(vcmp + row * 64 + part * 8);
        if (row == 127) { kk = make_uint4(0, 0, 0, 0); vv = kk; }
        *(uint4*)(Kc + row * 72 + part * 8) = kk;
        const unsigned u[4] = {vv.x, vv.y, vv.z, vv.w};
#pragma unroll
        for (int j = 0; j < 4; ++j) { Vc[(part * 8 + 2 * j) * 132 + row] = (bf16_t)(u[j] & 0xffffu); Vc[(part * 8 + 2 * j + 1) * 132 + row] = (bf16_t)(u[j] >> 16); }
    }
    __syncthreads();
    unsigned ocp[16];
    float* invs = (float*)(smem + SM_SEL) + 64;
    {
        const int cmaxv = tq >= 31 ? min((tq - 31) >> 4, 126) : -1;
        float mx = kNeg;
#pragma unroll 1
        for (int i = 0; i < 4; ++i) {
            f32x16 s = zero16();
#pragma unroll
            for (int ks = 0; ks < 4; ++ks) s = mfma32(*(const bf16x8*)(Kc + (i * 32 + ql) * 72 + ks * 16 + hh * 8), qf[ks], s);
            const int clim = cmaxv - i * 32 - 4 * hh;
#pragma unroll
            for (int r = 0; r < 16; ++r) {
                const int kc = (r & 3) + 8 * (r >> 2);
                const bool valid = (kc <= clim);
                mx = fmaxf(mx, valid ? s[r] * scl : kNeg);
            }
        }
        mx = fmaxf(mx, __shfl_xor(mx, 32, 64));
        f32x16 ocmp[2]; ocmp[0] = zero16(); ocmp[1] = zero16();
        float sum = 0.f, carprev = 0.f;
#pragma unroll 1
        for (int i = 0; i < 4; ++i) {
            f32x16 s = zero16();
#pragma unroll
            for (int ks = 0; ks < 4; ++ks) s = mfma32(*(const bf16x8*)(Kc + (i * 32 + ql) * 72 + ks * 16 + hh * 8), qf[ks], s);
            const int clim = cmaxv - i * 32 - 4 * hh;
#pragma unroll
            for (int r = 0; r < 16; ++r) {
                const int kc = (r & 3) + 8 * (r >> 2);
                const bool valid = (kc <= clim);
                const float pv = valid ? __builtin_amdgcn_exp2f(s[r] * scl - mx) : 0.f;
                s[r] = pv; sum += pv;
            }
            float own[4], car[4];
#pragma unroll
            for (int g = 0; g < 4; ++g) { own[g] = s[4 * g] + s[4 * g + 1] + s[4 * g + 2] + 0.5f * s[4 * g + 3]; car[g] = 0.5f * s[4 * g + 3]; }
#pragma unroll
            for (int g = 0; g < 4; ++g) {
                const float send = hh ? (g ? car[g > 0 ? g - 1 : 0] : carprev) : car[g];
                own[g] += __shfl_xor(send, 32, 64);
            }
            carprev = car[3];
#pragma unroll
            for (int g = 0; g < 4; ++g) impP[(w * 32 + ql) * 33 + 2 * (4 * i + g) + hh] = own[g];
#pragma unroll
            for (int sp = 0; sp < 2; ++sp) {
                const int ks = 2 * i + sp, r0 = 8 * sp;
                uint4 pu;
                pu.x = pack2(s[r0 + 0], s[r0 + 1]); pu.y = pack2(s[r0 + 2], s[r0 + 3]);
                pu.z = pack2(s[r0 + 4], s[r0 + 5]); pu.w = pack2(s[r0 + 6], s[r0 + 7]);
                const bf16x8 pf = __builtin_bit_cast(bf16x8, pu);
#pragma unroll
                for (int dt = 0; dt < 2; ++dt) {
                    const bf16_t* vp = Vc + (dt * 32 + ql) * 132 + ks * 16 + 4 * hh;
                    const uint2 a0 = *(const uint2*)vp, a1 = *(const uint2*)(vp + 8);
                    ocmp[dt] = mfma32(__builtin_bit_cast(bf16x8, make_uint4(a0.x, a0.y, a1.x, a1.y)), pf, ocmp[dt]);
                }
            }
        }
        sum += __shfl_xor(sum, 32, 64);
        const float inv = sum > 0.f ? 1.f / sum : 0.f;
        invs[w * 32 + ql] = inv;
        const float f = g0 * inv;
#pragma unroll
        for (int dt = 0; dt < 2; ++dt)
#pragma unroll
            for (int r = 0; r < 8; ++r) ocp[dt * 8 + r] = pack2(f * ocmp[dt][2 * r], f * ocmp[dt][2 * r + 1]);
    }
    __syncthreads();
    const int qblk = t0 >> 6;
    {
        const int hw = tid >> 5, j = tid & 31;
#pragma unroll 1
        for (int rr = 0; rr < 4; ++rr) {
            const int row = hw * 4 + rr;
            const float v = impP[(0 * 32 + row) * 33 + j] * invs[row] + impP[(1 * 32 + row) * 33 + j] * invs[32 + row]
                          + impP[(2 * 32 + row) * 33 + j] * invs[64 + row] + impP[(3 * 32 + row) * 33 + j] * invs[96 + row];
            bool sel;
            if (qblk < 16) sel = (j <= qblk);
            else {
                const bool cand = (j >= 1) && (j <= qblk - 2);
                const bool forced = (j == 0) || (j == qblk) || (j == qblk - 1);
                int rank = 0;
                for (int j2 = 1; j2 <= qblk - 2; ++j2) {
                    const float v2 = __shfl(v, (lane & 32) + j2, 64);
                    rank += (v2 > v || (v2 == v && j2 < j)) ? 1 : 0;
                }
                sel = forced || (cand && rank < 13);
            }
            const unsigned long long bal = __ballot(sel);
            const unsigned mk = (lane & 32) ? (unsigned)(bal >> 32) : (unsigned)bal;
            if (j == 0) selm[row] = mk;
        }
    }
    __syncthreads();
    const unsigned mysel = selm[ql];
    unsigned U = mysel;
#pragma unroll
    for (int o = 16; o > 0; o >>= 1) U |= (unsigned)__shfl_xor((int)U, o, 64);
    {
        f32x16 o1[1][2]; o1[0][0] = zero16(); o1[0][1] = zero16();
        float m1[1] = {kNeg}, l1[1] = {0.f};
        auto skipf = [&](int) { return false; };
        attn_stream<64, 4, 1>(BitIter{U}, LdRow{cols + Tb * LDC + 384, LDC}, LdVT{VT + (size_t)(b * 12 + 0) * 64 * 2048}, MaskSel{mysel}, skipf, qf, o1, m1, l1, scl, tq, smem, tid);
        const float lt = l1[0] + __shfl_xor(l1[0], 32, 64);
        const float f = g1 / lt;
#pragma unroll
        for (int dt = 0; dt < 2; ++dt)
#pragma unroll
            for (int r = 0; r < 8; ++r) ocp[dt * 8 + r] = pack2(lo16(ocp[dt * 8 + r]) + f * o1[0][dt][2 * r], hi16(ocp[dt * 8 + r]) + f * o1[0][dt][2 * r + 1]);
    }
    {
        f32x16 o1[1][2]; o1[0][0] = zero16(); o1[0][1] = zero16();
        float m1[1] = {kNeg}, l1[1] = {0.f};
        auto skipf = [&](int) { return false; };
        const int lo = t0 >= 511 ? ((t0 - 511) >> 6) : 0;
        attn_stream<64, 4, 1>(RangeIter{lo, qblk + 1}, LdRow{cols + Tb * LDC + 512, LDC}, LdVT{VT + (size_t)(b * 12 + 1) * 64 * 2048}, MaskWin<512>{}, skipf, qf, o1, m1, l1, scl, tq, smem, tid);
        const float lt = l1[0] + __shfl_xor(l1[0], 32, 64);
        const float f = g2 / lt;
#pragma unroll
        for (int dt = 0; dt < 2; ++dt)
#pragma unroll
            for (int r = 0; r < 8; ++r) { o1[0][dt][2 * r] = lo16(ocp[dt * 8 + r]) + f * o1[0][dt][2 * r]; o1[0][dt][2 * r + 1] = hi16(ocp[dt * 8 + r]) + f * o1[0][dt][2 * r + 1]; }
        write_o(o1[0], obuf, Tb + tq, w * 64, hh);
    }
}

DEV void diff_item(const Params& p, int layer, int b, int hd, int q64, char* smem) {
    int tid = threadIdx.x; asm volatile("" : "+v"(tid));
    const int lane = tid & 63, w = tid >> 6, ql = lane & 31, hh = lane >> 5;
    const int sub = w & 1, qbw = w >> 1;
    char* ws = p.ws;
    const bf16_t* cols = (const bf16_t*)(ws + OFF_COLS);
    const bf16_t* VT = (const bf16_t*)(ws + OFF_VT);
    bf16_t* obuf = (bf16_t*)(ws + OFF_O);
    const float* misc = (const float*)(ws + OFF_MISC);
    const int t0w = q64 * 64 + qbw * 32, tq = t0w + ql;
    const size_t Tb = (size_t)b * kS;
    const bf16_t* qrow = cols + (Tb + tq) * LDC + 704 + hd * 64 + sub * 32;
    bf16x8 qf[2];
#pragma unroll
    for (int ks = 0; ks < 2; ++ks) qf[ks] = *(const bf16x8*)(qrow + ks * 16 + hh * 8);
    const float scl = 0.17677669529663687f * kLog2e;
    f32x16 o1[1][2]; o1[0][0] = zero16(); o1[0][1] = zero16();
    float m1[1] = {kNeg}, l1[1] = {0.f};
    auto skipf = [&](int kt) { return kt * 64 > t0w + 31; };
    attn_stream<64, 2, 1>(RangeIter{0, q64 + 1}, LdRow{cols + Tb * LDC + 960 + hd * 64, LDC}, LdVT{VT + (size_t)(b * 12 + 2 + hd) * 64 * 2048}, MaskCausal{}, skipf, qf, o1, m1, l1, scl, tq, smem, tid, sub * 32);
    const float lam = misc[256 + layer], post = misc[258 + layer];
    const float lt = l1[0] + __shfl_xor(l1[0], 32, 64);
    float* ex = (float*)smem;
    __syncthreads();
    if (sub == 1) {
        const float f = lam / lt;
#pragma unroll
        for (int dt = 0; dt < 2; ++dt)
#pragma unroll
            for (int r = 0; r < 16; ++r) ex[((qbw * 2 + dt) * 16 + r) * 64 + lane] = o1[0][dt][r] * f;
    }
    __syncthreads();
    if (sub == 0) {
        const float f = 1.f / lt;
        float ss = 0.f;
#pragma unroll
        for (int dt = 0; dt < 2; ++dt)
#pragma unroll
            for (int r = 0; r < 16; ++r) { const float v = o1[0][dt][r] * f - ex[((qbw * 2 + dt) * 16 + r) * 64 + lane]; o1[0][dt][r] = v; ss += v * v; }
        ss += __shfl_xor(ss, 32, 64);
        const float rstd = rsqrtf(ss * (1.f / 64.f) + kEps) * post;
        const float* sg = p.sub_g + layer * 64;
#pragma unroll
        for (int dt = 0; dt < 2; ++dt)
#pragma unroll
            for (int r = 0; r < 16; ++r) { const int d = dt * 32 + (r & 3) + 8 * (r >> 2) + 4 * hh; o1[0][dt][r] *= rstd * sg[d]; }
        write_o(o1[0], obuf, Tb + tq, 256 + hd * 64, hh);
    }
}

DEV void mla_item(const Params& p, int b, int hd, int qc, char* smem) {
    int tid = threadIdx.x; asm volatile("" : "+v"(tid));
    const int lane = tid & 63, w = tid >> 6, ql = lane & 31, hh = lane >> 5;
    char* ws = p.ws;
    const bf16_t* cols = (const bf16_t*)(ws + OFF_COLS);
    const bf16_t* VT = (const bf16_t*)(ws + OFF_VT);
    const bf16_t* qmla = (const bf16_t*)(ws + OFF_QMLA);
    const bf16_t* kvmla = (const bf16_t*)(ws + OFF_KVMLA);
    bf16_t* obuf = (bf16_t*)(ws + OFF_O);
    const int t0w = qc * 128 + w * 32, tq = t0w + ql;
    const size_t Tb = (size_t)b * kS;
    const bf16_t* qrow = qmla + (Tb + tq) * 384 + hd * 96;
    bf16x8 qf[6];
#pragma unroll
    for (int ks = 0; ks < 6; ++ks) qf[ks] = *(const bf16x8*)(qrow + ks * 16 + hh * 8);
    const float scl = 0.10206207261596575f * kLog2e;
    f32x16 o1[1][2]; o1[0][0] = zero16(); o1[0][1] = zero16();
    float m1[1] = {kNeg}, l1[1] = {0.f};
    auto skipf = [&](int kt) { return kt * 64 > t0w + 31; };
    attn_stream<96, 6, 1>(RangeIter{0, 2 * qc + 2}, LdMlaK{kvmla + Tb * 512 + hd * 128, cols + Tb * LDC + 1856}, LdVT{VT + (size_t)(b * 12 + 8 + hd) * 64 * 2048}, MaskCausal{}, skipf, qf, o1, m1, l1, scl, tq, smem, tid);
    const float inv = 1.f / (l1[0] + __shfl_xor(l1[0], 32, 64));
#pragma unroll
    for (int dt = 0; dt < 2; ++dt)
#pragma unroll
        for (int r = 0; r < 16; ++r) o1[0][dt][r] *= inv;
    write_o(o1[0], obuf, Tb + tq, 512 + hd * 64, hh);
}

DEV void swa_item(const Params& p, int layer, int b, int g, int q64, char* smem) {
    int tid = threadIdx.x; asm volatile("" : "+v"(tid));
    const int lane = tid & 63, w = tid >> 6, ql = lane & 31, hh = lane >> 5;
    char* ws = p.ws;
    const bf16_t* cols = (const bf16_t*)(ws + OFF_COLS);
    const bf16_t* VT = (const bf16_t*)(ws + OFF_VT);
    bf16_t* obuf = (bf16_t*)(ws + OFF_O);
    const int head = g * 2 + (w & 1);
    const int t0w = q64 * 64 + (w >> 1) * 32, tq = t0w + ql;
    const size_t Tb = (size_t)b * kS;
    const bf16_t* qrow = cols + (Tb + tq) * LDC + 1920 + head * 64;
    bf16x8 qf[4];
#pragma unroll
    for (int ks = 0; ks < 4; ++ks) qf[ks] = *(const bf16x8*)(qrow + ks * 16 + hh * 8);
    const float scl = 0.125f * kLog2e;
    f32x16 o1[1][2]; o1[0][0] = zero16(); o1[0][1] = zero16();
    float m1[1] = {p.sinks[layer * 4 + head] * kLog2e}, l1[1] = {hh == 0 ? 1.f : 0.f};
    auto skipf = [&](int kt) { return (kt * 64 > t0w + 31) || (kt * 64 + 63 < t0w - 127); };
    const int lo = q64 >= 2 ? q64 - 2 : 0;
    attn_stream<64, 4, 1>(RangeIter{lo, q64 + 1}, LdRow{cols + Tb * LDC + 2176 + g * 64, LDC}, LdVT{VT + (size_t)(b * 12 + 6 + g) * 64 * 2048}, MaskWin<128>{}, skipf, qf, o1, m1, l1, scl, tq, smem, tid);
    const float inv = 1.f / (l1[0] + __shfl_xor(l1[0], 32, 64));
#pragma unroll
    for (int dt = 0; dt < 2; ++dt)
#pragma unroll
        for (int r = 0; r < 16; ++r) o1[0][dt][r] *= inv;
    write_o(o1[0], obuf, Tb + tq, 768 + head * 64, hh);
}

DEV void phase_attn(const Params& p, int layer, char* smem, int rep = 0) {
    unsigned* ctr = (unsigned*)(p.ws + OFF_CTRL) + 64 + layer * 16 + rep;
    volatile int* slot = (volatile int*)(smem + SM_SEL) + 48;
    for (;;) {
        __syncthreads();
        if (ltid() == 0) *slot = (int)atomicAdd(ctr, 1u);
        __syncthreads();
        const int idx = *slot;
        if (idx >= 2560) break;
        const int level = 15 - idx / 160, r = idx % 160;
        if (r < 64) { const int b = (r & 31) >> 2; diff_item(p, layer, b, r & 3, level * 2 + (1 - (r >> 5)), smem); }
        else if (r < 96) { const int k = r - 64; mla_item(p, k >> 2, k & 3, level, smem); }
        else if (r < 128) { const int k = r - 96; nsa_item(p, k >> 2, level * 4 + (3 - (k & 3)), smem); }
        else { const int k = r - 128; swa_item(p, layer, k >> 2, (k >> 1) & 1, level * 2 + (k & 1), smem); }
    }
}

DEV unsigned fkey(float f) { const unsigned u = __float_as_uint(f); return (u & 0x80000000u) ? ~u : (u | 0x80000000u); }
DEV float funkey(unsigned k) { return __uint_as_float((k & 0x80000000u) ? (k & 0x7fffffffu) : ~k); }
DEV void ins16(unsigned (&L)[16], unsigned x) {
#pragma unroll
    for (int i = 0; i < 16; ++i) { const unsigned hi = L[i] > x ? L[i] : x; x = L[i] > x ? x : L[i]; L[i] = hi; }
}
DEV void phase_topk(const Params& p, char* smem) {
    const int tid = ltid();
    const float* S1 = (const float*)(p.ws + OFF_S1);
    const float* S2 = (const float*)(p.ws + OFF_S2);
    int* eid = (int*)(p.ws + OFF_EID);
    float* gate = (float*)(p.ws + OFF_GATE);
    unsigned char* ib = (unsigned char*)smem + tid * 32;
    for (int blk = blockIdx.x; blk < kT * 8 / 256; blk += gridDim.x) {
        const size_t row = (size_t)blk * 256 + tid;
        unsigned L1[16], L2[16];
#pragma unroll
        for (int i = 0; i < 16; ++i) { L1[i] = 0u; L2[i] = 0u; }
#pragma unroll 4
        for (int k = 0; k < 128; ++k) {
            const float a = S1[(size_t)k * (kT * 8) + row], b = S2[(size_t)k * (kT * 8) + row];
            ins16(L1, (fkey(a) & ~127u) | (unsigned)(127 - k));
            ins16(L2, (fkey(b) & ~127u) | (unsigned)(127 - k));
        }
        float v1[16], v2[16];
        __syncthreads();
#pragma unroll
        for (int i = 0; i < 16; ++i) {
            v1[i] = funkey(L1[i] & ~127u); v2[i] = funkey(L2[i] & ~127u);
            ib[i] = (unsigned char)(127u - (L1[i] & 127u)); ib[16 + i] = (unsigned char)(127u - (L2[i] & 127u));
        }
        unsigned C[16];
#pragma unroll
        for (int i = 0; i < 16; ++i) C[i] = 0u;
#pragma unroll
        for (int a = 0; a < 16; ++a)
#pragma unroll
            for (int b = 0; b < 16; ++b)
                if ((a + 1) * (b + 1) <= 16) ins16(C, (fkey(v1[a] + v2[b]) & ~255u) | (unsigned)(255 - (a * 16 + b)));
        float ts[16]; float sum = 0.f;
        const float tmax = funkey(C[0] & ~255u);
#pragma unroll
        for (int i = 0; i < 16; ++i) { ts[i] = __expf(funkey(C[i] & ~255u) - tmax); sum += ts[i]; }
        const float inv = 1.f / sum;
        int ev[16];
#pragma unroll
        for (int i = 0; i < 16; ++i) { const unsigned ci = 255u - (C[i] & 255u); ev[i] = (int)ib[ci >> 4] * 128 + (int)ib[16 + (ci & 15u)]; }
#pragma unroll
        for (int i = 0; i < 4; ++i) {
            *(int4*)(eid + row * 16 + 4 * i) = make_int4(ev[4 * i], ev[4 * i + 1], ev[4 * i + 2], ev[4 * i + 3]);
            *(float4*)(gate + row * 16 + 4 * i) = make_float4(ts[4 * i] * inv, ts[4 * i + 1] * inv, ts[4 * i + 2] * inv, ts[4 * i + 3] * inv);
        }
    }
}

DEV float row_sum_dpp(float v) {
    v += __int_as_float(__builtin_amdgcn_update_dpp(0, __float_as_int(v), 0xB1, 0xF, 0xF, true));
    v += __int_as_float(__builtin_amdgcn_update_dpp(0, __float_as_int(v), 0x4E, 0xF, 0xF, true));
    v += __int_as_float(__builtin_amdgcn_update_dpp(0, __float_as_int(v), 0x141, 0xF, 0xF, true));
    v += __int_as_float(__builtin_amdgcn_update_dpp(0, __float_as_int(v), 0x140, 0xF, 0xF, true));
    return v;
}
DEV float wave_sum_dpp(float v) {
    v = row_sum_dpp(v);
    const float r0 = __int_as_float(__builtin_amdgcn_readlane(__float_as_int(v), 0)), r1 = __int_as_float(__builtin_amdgcn_readlane(__float_as_int(v), 16));
    const float r2 = __int_as_float(__builtin_amdgcn_readlane(__float_as_int(v), 32)), r3 = __int_as_float(__builtin_amdgcn_readlane(__float_as_int(v), 48));
    return (r0 + r1) + (r2 + r3);
}
typedef float f32x2 __attribute__((ext_vector_type(2)));
DEV void phase_experts(const Params& p, int layer) {
    const int tid = ltid(), lane = tid & 63, w = tid >> 6;
    char* ws = p.ws;
    const unsigned char* U = (const unsigned char*)(ws + OFF_PU) + (size_t)layer * 16384 * 1024;
    const unsigned char* V = (const unsigned char*)(ws + OFF_PV) + (size_t)layer * 16384 * 1024;
    bf16_t* h = (bf16_t*)(ws + OFF_H);
    float* xres = (float*)(ws + OFF_XRES);
    const int* eid = (const int*)(ws + OFF_EID);
    const float* gate = (const float*)(ws + OFF_GATE);
    const float* mod = (const float*)(ws + OFF_MOD);
    for (int q = blockIdx.x; q < kT / 4; q += gridDim.x) {
        const int t = q * 4 + w, b = t >> 11;
        float hf[16];
        {
            const uint4 h0 = *(const uint4*)(h + (size_t)t * 1024 + lane * 16), h1 = *(const uint4*)(h + (size_t)t * 1024 + lane * 16 + 8);
            hf[0] = lo16(h0.x); hf[1] = hi16(h0.x); hf[2] = lo16(h0.y); hf[3] = hi16(h0.y); hf[4] = lo16(h0.z); hf[5] = hi16(h0.z); hf[6] = lo16(h0.w); hf[7] = hi16(h0.w);
            hf[8] = lo16(h1.x); hf[9] = hi16(h1.x); hf[10] = lo16(h1.y); hf[11] = hi16(h1.y); hf[12] = lo16(h1.z); hf[13] = hi16(h1.z); hf[14] = lo16(h1.w); hf[15] = hi16(h1.w);
        }
        const int e0 = eid[(size_t)t * 128 + lane], e1 = eid[(size_t)t * 128 + 64 + lane];
        const float ga = gate[(size_t)t * 128 + lane], gb = gate[(size_t)t * 128 + 64 + lane];
        float out[16];
#pragma unroll
        for (int j = 0; j < 16; ++j) out[j] = 0.f;
#pragma unroll 4
        for (int e = 0; e < 128; ++e) {
            const int ex = __builtin_amdgcn_readlane(e < 64 ? e0 : e1, e & 63);
            const float gt = __int_as_float(__builtin_amdgcn_readlane(__float_as_int(e < 64 ? ga : gb), e & 63));
            const uint4 uu = *(const uint4*)(U + (size_t)ex * 1024 + lane * 16);
            const uint4 vv = *(const uint4*)(V + (size_t)ex * 1024 + lane * 16);
            const unsigned ua[4] = {uu.x, uu.y, uu.z, uu.w}, va[4] = {vv.x, vv.y, vv.z, vv.w};
            float d = 0.f;
#pragma unroll
            for (int j = 0; j < 4; ++j) {
                const f32x2 lo = __builtin_amdgcn_cvt_pk_f32_fp8((int)ua[j], false), hi = __builtin_amdgcn_cvt_pk_f32_fp8((int)ua[j], true);
                d += hf[4 * j] * lo.x + hf[4 * j + 1] * lo.y + hf[4 * j + 2] * hi.x + hf[4 * j + 3] * hi.y;
            }
            d = wave_sum_dpp(d) * (1.f / kScaleU);
            const float wg = gt * gelu_tanh(d) * (1.f / kScaleV);
#pragma unroll
            for (int j = 0; j < 4; ++j) {
                const f32x2 lo = __builtin_amdgcn_cvt_pk_f32_fp8((int)va[j], false), hi = __builtin_amdgcn_cvt_pk_f32_fp8((int)va[j], true);
                out[4 * j] += wg * lo.x; out[4 * j + 1] += wg * lo.y; out[4 * j + 2] += wg * hi.x; out[4 * j + 3] += wg * hi.y;
            }
        }
        const float* g2 = mod + (size_t)(layer * 8 + b) * 6144 + 5120;
        float xn[16]; float ss = 0.f;
#pragma unroll
        for (int c = 0; c < 4; ++c) {
            const int col = lane * 16 + c * 4;
            const float4 xa = *(const float4*)(xres + (size_t)t * 1024 + col), g4 = *(const float4*)(g2 + col);
            xn[c * 4 + 0] = xa.x + g4.x * out[c * 4 + 0]; xn[c * 4 + 1] = xa.y + g4.y * out[c * 4 + 1];
            xn[c * 4 + 2] = xa.z + g4.z * out[c * 4 + 2]; xn[c * 4 + 3] = xa.w + g4.w * out[c * 4 + 3];
        }
#pragma unroll
        for (int j = 0; j < 16; ++j) ss += xn[j] * xn[j];
        ss = wave_sum_dpp(ss);
        const float rstd = rsqrtf(ss * (1.f / 1024.f) + kEps);
        if (layer == 0) {
            const float* g = p.norm_mix_g + 1024;
            const float* sh = mod + (size_t)(8 + b) * 6144;
            const float* sc = sh + 1024;
            float hv[16];
#pragma unroll
            for (int c = 0; c < 4; ++c) {
                const int col = lane * 16 + c * 4;
                *(float4*)(xres + (size_t)t * 1024 + col) = make_float4(xn[c * 4], xn[c * 4 + 1], xn[c * 4 + 2], xn[c * 4 + 3]);
                const float4 g4 = *(const float4*)(g + col), s4 = *(const float4*)(sc + col), h4 = *(const float4*)(sh + col);
                hv[c * 4 + 0] = xn[c * 4 + 0] * rstd * g4.x * (1.f + s4.x) + h4.x; hv[c * 4 + 1] = xn[c * 4 + 1] * rstd * g4.y * (1.f + s4.y) + h4.y;
                hv[c * 4 + 2] = xn[c * 4 + 2] * rstd * g4.z * (1.f + s4.z) + h4.z; hv[c * 4 + 3] = xn[c * 4 + 3] * rstd * g4.w * (1.f + s4.w) + h4.w;
            }
            *(uint4*)(h + (size_t)t * 1024 + lane * 16) = make_uint4(pack2(hv[0], hv[1]), pack2(hv[2], hv[3]), pack2(hv[4], hv[5]), pack2(hv[6], hv[7]));
            *(uint4*)(h + (size_t)t * 1024 + lane * 16 + 8) = make_uint4(pack2(hv[8], hv[9]), pack2(hv[10], hv[11]), pack2(hv[12], hv[13]), pack2(hv[14], hv[15]));
        } else {
#pragma unroll
            for (int c = 0; c < 4; ++c) {
                const int col = lane * 16 + c * 4;
                const float4 f4 = *(const float4*)(p.final_g + col);
                *(float4*)(p.out + (size_t)t * 1024 + col) = make_float4(xn[c * 4] * rstd * f4.x, xn[c * 4 + 1] * rstd * f4.y, xn[c * 4 + 2] * rstd * f4.z, xn[c * 4 + 3] * rstd * f4.w);
            }
        }
    }
}

DEV void phase_gemm_in(const Params& p, int layer, char* smem) {
    char* ws = p.ws;
    EpiBf16 epi{(bf16_t*)(ws + OFF_COLS), LDC, nullptr, nullptr, LDC};
    gemm_phase((const bf16_t*)(ws + OFF_H), 1024, (const bf16_t*)(ws + OFF_WIN) + (size_t)layer * 2432 * 1024, 1024, 1024, kT / 128, LDC / 128, smem, epi);
}
DEV void phase_gemm_mid(const Params& p, int layer, char* smem) {
    char* ws = p.ws;
    const float* misc = (const float*)(ws + OFF_MISC);
    const float* rstd = (const float*)(ws + OFF_RSTD);
    const bf16_t* cols = (const bf16_t*)(ws + OFF_COLS);
    for (int tile = blockIdx.x; tile < 16 + 384 + 512; tile += gridDim.x) {
        if (tile < 8) {
            EpiBf16 epi{(bf16_t*)(ws + OFF_KCMP), 64, nullptr, misc + (layer * 2 + 0) * 64, 64};
            gemm_tile((const bf16_t*)(ws + OFF_KC), 1024, (const bf16_t*)(ws + OFF_WCK) + (size_t)layer * 128 * 2048, 2048, 2048, tile * 128, 0, smem, epi);
        } else if (tile < 16) {
            EpiBf16 epi{(bf16_t*)(ws + OFF_KCMP) + 1024 * 64, 64, nullptr, misc + (layer * 2 + 1) * 64, 64};
            gemm_tile((const bf16_t*)(ws + OFF_VC), 1024, (const bf16_t*)(ws + OFF_WCV) + (size_t)layer * 128 * 2048, 2048, 2048, (tile - 8) * 128, 0, smem, epi);
        } else if (tile < 16 + 384) {
            const int tt = tile - 16;
            EpiBf16 epi{(bf16_t*)(ws + OFF_QMLA), 384, rstd, nullptr, 384};
            gemm_tile(cols + 1472, LDC, (const bf16_t*)(ws + OFF_WUQ) + (size_t)layer * 384 * 256, 256, 256, (tt / 3) * 128, (tt % 3) * 128, smem, epi);
        } else {
            const int tt = tile - 16 - 384;
            EpiBf16 epi{(bf16_t*)(ws + OFF_KVMLA), 512, rstd + kT, nullptr, 512};
            gemm_tile(cols + 1728, LDC, (const bf16_t*)(ws + OFF_WUKV) + (size_t)layer * 512 * 128, 128, 128, (tt / 4) * 128, (tt % 4) * 128, smem, epi);
        }
    }
}
DEV void phase_gemm_out(const Params& p, int layer, char* smem) {
    char* ws = p.ws;
    EpiRes epi{layer == 0 ? p.x : (const float*)(ws + OFF_XRES), (float*)(ws + OFF_XRES), (const float*)(ws + OFF_MOD) + (size_t)layer * 8 * 6144 + 2048};
    gemm_phase((const bf16_t*)(ws + OFF_O), 1024, (const bf16_t*)(ws + OFF_WOUT) + (size_t)layer * 1024 * 1024, 1024, 1024, kT / 128, 8, smem, epi);
}
DEV void phase_gemm_wq(const Params& p, int layer, char* smem) {
    char* ws = p.ws;
    EpiBf16 epi{(bf16_t*)(ws + OFF_QP), 2048, nullptr, nullptr, 2048};
    gemm_phase((const bf16_t*)(ws + OFF_H), 1024, (const bf16_t*)(ws + OFF_WQ) + (size_t)layer * 2048 * 1024, 1024, 1024, kT / 128, 16, smem, epi);
}
DEV void phase_scores(const Params& p, int layer, char* smem) {
    char* ws = p.ws;
    for (int tile = blockIdx.x; tile < 2048; tile += gridDim.x) {
        const int c = tile >> 10, nt = tile & 1023;
        EpiF32 epi{(float*)(ws + (c ? OFF_S2 : OFF_S1)), kT * 8};
        gemm_tile((const bf16_t*)(ws + OFF_SUBK) + (size_t)(layer * 2 + c) * 16384, 128, (const bf16_t*)(ws + OFF_QP) + c * 128, 256, 128, 0, nt * 128, smem, epi);
    }
}

#define XB_TMO      128
#define XB_XCNT(j)  (256  + 64 * (j))
#define XB_XSUB(j)  (1280 + 64 * (j))
#define XB_XGEN(j)  (2304 + 64 * (j))
#define XB_TOP      3328
#define XB_TOPGEN   3392
#define XB_SPIN_CAP (1u << 22)
#define LAS __attribute__((address_space(3)))
DEV unsigned xb_ld(unsigned* p) { return __hip_atomic_load(p, __ATOMIC_RELAXED, __HIP_MEMORY_SCOPE_AGENT); }
DEV unsigned xb_add(unsigned* p, unsigned v) { return __hip_atomic_fetch_add(p, v, __ATOMIC_RELAXED, __HIP_MEMORY_SCOPE_AGENT); }
DEV unsigned xb_xcc_id() { return (unsigned)__builtin_amdgcn_s_getreg((3 << 11) | 20) & 0xFu; }
#define XB_SPIN(cond, bar) do { unsigned _sp = 0; while (cond) { __builtin_amdgcn_s_sleep(1); \
    if ((++_sp & 255u) == 0u) { if (xb_ld(&(bar)[XB_TMO])) break; if (_sp > XB_SPIN_CAP) { atomicAdd(&(bar)[XB_TMO], 1u); break; } } } } while (0)
struct XcdBarrier { unsigned* bar; unsigned x; volatile LAS unsigned* st; };
DEV XcdBarrier xcd_barrier_post(unsigned* bar, volatile LAS unsigned* st) {
    XcdBarrier b; b.bar = bar; b.x = xb_xcc_id(); b.st = st;
    if (threadIdx.x == 0) (void)xb_add(&bar[XB_XCNT(b.x)], 1u);
    return b;
}
DEV void xcd_barrier_complete(unsigned* bar, unsigned x, unsigned& nloc, unsigned& nx) {
    const unsigned G = gridDim.x * gridDim.y * gridDim.z;
    unsigned sum, cnt, mine, sp = 0u;
    for (;;) {
        sum = 0u; cnt = 0u; mine = 0u;
#pragma unroll
        for (unsigned j = 0; j < 16; ++j) { const unsigned c = xb_ld(&bar[XB_XCNT(j)]); sum += c; cnt += (c > 0u) ? 1u : 0u; mine = (j == x) ? c : mine; }
        if (sum == G) break;
        __builtin_amdgcn_s_sleep(1);
        if ((++sp & 255u) == 0u) { if (xb_ld(&bar[XB_TMO])) break; if (sp > XB_SPIN_CAP) { atomicAdd(&bar[XB_TMO], 1u); break; } }
    }
    nloc = mine > 0u ? mine : 1u; nx = cnt > 0u ? cnt : 1u;
}
DEV void xcd_barrier(const XcdBarrier& b) {
    asm volatile("s_waitcnt vmcnt(0)" ::: "memory");
    __syncthreads();
    if (threadIdx.x == 0) {
        unsigned* bar = b.bar;
        __builtin_amdgcn_s_waitcnt(0);
        unsigned nloc = b.st[0], nx = b.st[1];
        if (nloc == 0u) { xcd_barrier_complete(bar, b.x, nloc, nx); b.st[0] = nloc; b.st[1] = nx; }
        const unsigned old = xb_add(&bar[XB_XSUB(b.x)], 1u);
        const unsigned gen = old / nloc;
        if (old + 1u == (gen + 1u) * nloc) {
            __builtin_amdgcn_fence(__ATOMIC_RELEASE, "agent");
            asm volatile("s_waitcnt vmcnt(0)" ::: "memory");
            const unsigned og = xb_add(&bar[XB_TOP], 1u);
            const unsigned tg = og / nx;
            if (og + 1u == (tg + 1u) * nx) xb_add(&bar[XB_TOPGEN], 1u);
            else XB_SPIN(xb_ld(&bar[XB_TOPGEN]) == tg, bar);
            __builtin_amdgcn_fence(__ATOMIC_ACQUIRE, "agent");
            xb_add(&bar[XB_XGEN(b.x)], 1u);
            asm volatile("s_waitcnt vmcnt(0)" ::: "memory");
        } else {
            XB_SPIN(xb_ld(&bar[XB_XGEN(b.x)]) == gen, bar);
            __builtin_amdgcn_fence(__ATOMIC_ACQUIRE, "agent");
            asm volatile("s_waitcnt vmcnt(0)" ::: "memory");
        }
    }
    __syncthreads();
}

constexpr int NPHASE = 13;
DEV void run_phase(const Params& p, int ph, int layer, char* smem, int rep = 0) {
    switch (ph) {
        case 0: phase_prologue(p, smem); break;
        case 1: phase_norm(p, layer, 0); break;
        case 2: phase_gemm_in(p, layer, smem); break;
        case 3: phase_layout1(p, smem); break;
        case 4: phase_gemm_mid(p, layer, smem); break;
        case 5: phase_layout2(p, smem); break;
        case 6: phase_attn(p, layer, smem, rep); break;
        case 7: phase_gemm_out(p, layer, smem); break;
        case 8: phase_norm(p, layer, 1); break;
        case 9: phase_gemm_wq(p, layer, smem); break;
        case 10: phase_scores(p, layer, smem); break;
        case 11: phase_topk(p, smem); break;
        case 12: phase_experts(p, layer); break;
        default: break;
    }
}

#if !FUSED
template <int PH>
__global__ void __launch_bounds__(256, 2) k_phase(Params p, int layer) {
    __shared__ __attribute__((aligned(16))) char smem[SM_TOTAL];
    run_phase(p, PH, layer, smem);
}
template <int PH> static void launch_phase(const Params& p, int layer, hipStream_t stream) { k_phase<PH><<<512, 256, 0, stream>>>(p, layer); }
static void launch_ph(int ph, const Params& p, int layer, hipStream_t stream) {
    switch (ph) {
        case 0: launch_phase<0>(p, layer, stream); break;
        case 1: launch_phase<1>(p, layer, stream); break;
        case 2: launch_phase<2>(p, layer, stream); break;
        case 3: launch_phase<3>(p, layer, stream); break;
        case 4: launch_phase<4>(p, layer, stream); break;
        case 5: launch_phase<5>(p, layer, stream); break;
        case 6: launch_phase<6>(p, layer, stream); break;
        case 7: launch_phase<7>(p, layer, stream); break;
        case 8: launch_phase<8>(p, layer, stream); break;
        case 9: launch_phase<9>(p, layer, stream); break;
        case 10: launch_phase<10>(p, layer, stream); break;
        case 11: launch_phase<11>(p, layer, stream); break;
        case 12: launch_phase<12>(p, layer, stream); break;
    }
}
#else
__global__ void __launch_bounds__(256, 2) k_mega(Params p) {
    __shared__ __attribute__((aligned(16))) char smem[SM_TOTAL];
    cg::grid_group grid = cg::this_grid();
    volatile LAS unsigned* st = (volatile LAS unsigned*)(smem + SM_SEL + 768);
    if (threadIdx.x == 0) { st[0] = 0u; st[1] = 0u; }
    __syncthreads();
    const XcdBarrier xb = xcd_barrier_post((unsigned*)p.ws, st);
    run_phase(p, 0, 0, smem);
    grid.sync();
    run_phase(p, 1, 0, smem);
    xcd_barrier(xb);
#pragma unroll 1
    for (int l = 0; l < 2; ++l) {
#pragma unroll 1
        for (int ph = 2; ph < NPHASE; ++ph) {
            run_phase(p, ph, l, smem);
#if PROBE_REP > 0
            if (ph == PROBE_PH && l == PROBE_L) {
#pragma unroll 1
                for (int r = 1; r <= PROBE_REP; ++r) { xcd_barrier(xb); run_phase(p, ph, l, smem, r); }
            }
#endif
            if (!(l == 1 && ph == NPHASE - 1)) xcd_barrier(xb);
        }
    }
}
#endif

extern "C" void kernel_launch(void* const* d_in, const int* in_sizes, int n_in, void* d_out, int out_size, void* d_ws, size_t ws_size, hipStream_t stream) {
    Params p{};
    const float** pp = (const float**)&p;
    for (int i = 0; i < 28; ++i) pp[i] = (const float*)d_in[i];
    p.out = (float*)d_out;
    p.ws = (char*)d_ws;
    if (ws_size < OFF_END) fprintf(stderr, "workspace too small: %zu < %zu\n", ws_size, (size_t)OFF_END);
    (void)hipMemsetAsync(d_ws, 0, 65536, stream);
#if !FUSED
    launch_ph(0, p, 0, stream);
    launch_ph(1, p, 0, stream);
    for (int l = 0; l < 2; ++l)
        for (int ph = 2; ph < NPHASE; ++ph) launch_ph(ph, p, l, stream);
#else
    static int grid_blocks = 0;
    if (!grid_blocks) {
        int dev = 0, cus = 0, per_cu = 0;
        (void)hipGetDevice(&dev);
        (void)hipDeviceGetAttribute(&cus, hipDeviceAttributeMultiprocessorCount, dev);
        (void)hipOccupancyMaxActiveBlocksPerMultiprocessor(&per_cu, (const void*)k_mega, 256, 0);
        if (per_cu > 2) per_cu = 2;
        if (per_cu < 1) per_cu = 1;
        grid_blocks = cus * per_cu;
    }
    void* args[] = {&p};
    hipError_t e = hipLaunchCooperativeKernel((const void*)k_mega, dim3(grid_blocks), dim3(256), args, 0, stream);
    if (e != hipSuccess) fprintf(stderr, "cooperative launch failed: %s (grid %d)\n", hipGetErrorString(e), grid_blocks);
#endif
}
```

```cpp
#include <hip/hip_runtime.h>
#include <hip/hip_cooperative_groups.h>
#include <stdint.h>
#include <stdio.h>
namespace cg = cooperative_groups;

#ifndef FUSED
#define FUSED 1
#endif
#ifndef PROBE_PH
#define PROBE_PH -1
#define PROBE_L 1
#define PROBE_REP 0
#endif

#define DEV __device__ __forceinline__
typedef unsigned short bf16_t;
typedef short bf16x8 __attribute__((ext_vector_type(8)));
typedef float f32x16 __attribute__((ext_vector_type(16)));

constexpr int kB = 8, kS = 2048, kT = kB * kS, kD = 1024, LDC = 2432;
constexpr float kEps = 1e-6f;
constexpr float kNeg = -1e30f;
constexpr float kLog2e = 1.4426950408889634f;
constexpr float kScaleU = 256.f, kScaleV = 32.f;

constexpr size_t OFF_CTRL = 0;
constexpr size_t OFF_MOD  = 65536;
constexpr size_t OFF_ROPE = OFF_MOD + 2ull * 8 * 6144 * 4;
constexpr size_t OFF_MISC = OFF_ROPE + 2048ull * 96 * 4;
constexpr size_t OFF_WIN  = OFF_MISC + 4096;
constexpr size_t OFF_WOUT = OFF_WIN + 2ull * 2432 * 1024 * 2;
constexpr size_t OFF_WQ   = OFF_WOUT + 2ull * 1024 * 1024 * 2;
constexpr size_t OFF_WUQ  = OFF_WQ + 2ull * 2048 * 1024 * 2;
constexpr size_t OFF_WUKV = OFF_WUQ + 2ull * 384 * 256 * 2;
constexpr size_t OFF_WCK  = OFF_WUKV + 2ull * 512 * 128 * 2;
constexpr size_t OFF_WCV  = OFF_WCK + 2ull * 128 * 2048 * 2;
constexpr size_t OFF_SUBK = OFF_WCV + 2ull * 128 * 2048 * 2;
constexpr size_t OFF_PU   = OFF_SUBK + 2ull * 2 * 128 * 128 * 2;
constexpr size_t OFF_PV   = OFF_PU + 2ull * 16384 * 1024;
constexpr size_t OFF_XRES = OFF_PV + 2ull * 16384 * 1024;
constexpr size_t OFF_H    = OFF_XRES + (size_t)kT * 1024 * 4;
constexpr size_t OFF_H8   = OFF_H + (size_t)kT * 1024 * 2;
constexpr size_t OFF_RSTD = OFF_H8 + (size_t)kT * 1024;
constexpr size_t OFF_KCMP = OFF_RSTD + 2ull * kT * 4;
constexpr size_t OFF_EID  = OFF_KCMP + 2ull * 1024 * 64 * 2;
constexpr size_t OFF_GATE = OFF_EID + (size_t)kT * 128 * 4;
constexpr size_t OFF_QP   = OFF_GATE + (size_t)kT * 128 * 4;
constexpr size_t OFF_COLS = OFF_QP + (size_t)kT * 2048 * 2;
constexpr size_t OFF_KC   = OFF_COLS + (size_t)kT * LDC * 2;
constexpr size_t OFF_VC   = OFF_KC + (size_t)(kT + 64) * 64 * 2;
constexpr size_t OFF_VT   = OFF_VC + (size_t)(kT + 64) * 64 * 2;
constexpr size_t OFF_QMLA = OFF_VT + 8ull * 12 * 64 * 2048 * 2;
constexpr size_t OFF_KVMLA = OFF_QMLA + (size_t)kT * 384 * 2;
constexpr size_t OFF_O    = OFF_KVMLA + (size_t)kT * 512 * 2;
constexpr size_t OFF_END  = OFF_O + (size_t)kT * 1024 * 2;
constexpr size_t OFF_S1 = OFF_COLS, OFF_S2 = OFF_COLS + (size_t)kT * 8 * 128 * 4;
static_assert(OFF_S2 + (size_t)kT * 8 * 128 * 4 <= OFF_O, "alias region too small");
static_assert(OFF_END <= (512ull << 20), "workspace too large");

struct Params {
    const float *x, *c, *ada_w, *ada_b, *norm_mix_g, *norm_ffn_g, *w_in, *pos_k, *pos_v, *cmp_wk, *cmp_wv;
    const float *lq1, *lk1, *lq2, *lk2, *sub_g, *mla_qg, *mla_wuq, *mla_kvg, *mla_wukv, *sinks, *w_out;
    const float *w_q, *subk1, *subk2, *pu, *pv, *final_g;
    float* out;
    char* ws;
};

DEV int ltid() { int t = threadIdx.x; asm volatile("" : "+v"(t)); return t; }
DEV float bf2f(bf16_t v) { return __uint_as_float(((unsigned)v) << 16); }
DEV bf16_t f2bf(float f) { unsigned u = __float_as_uint(f); u += 0x7fffu + ((u >> 16) & 1u); return (bf16_t)(u >> 16); }
DEV unsigned pack2(float lo, float hi) { return (unsigned)f2bf(lo) | ((unsigned)f2bf(hi) << 16); }
DEV float lo16(unsigned u) { return __uint_as_float(u << 16); }
DEV float hi16(unsigned u) { return __uint_as_float(u & 0xffff0000u); }
DEV float wave_sum(float v) {
#pragma unroll
    for (int o = 32; o > 0; o >>= 1) v += __shfl_xor(v, o, 64);
    return v;
}
DEV float xor32f(float v, int lane) { return __int_as_float(__builtin_amdgcn_ds_bpermute((lane ^ 32) << 2, __float_as_int(v))); }
DEV float lanef(float v, int src) { return __int_as_float(__builtin_amdgcn_ds_bpermute(src << 2, __float_as_int(v))); }
DEV f32x16 mfma32(bf16x8 a, bf16x8 b, f32x16 c) { return __builtin_amdgcn_mfma_f32_32x32x16_bf16(a, b, c, 0, 0, 0); }
DEV f32x16 zero16() { f32x16 z;
#pragma unroll
    for (int i = 0; i < 16; ++i) z[i] = 0.f;
    return z; }
DEV float gelu_tanh(float x) {
    const float u = 0.7978845608028654f * (x + 0.044715f * x * x * x);
    const float e = __expf(2.f * u);
    const float t = 1.f - 2.f / (e + 1.f);
    return 0.5f * x * (1.f + t);
}

template <class Epi>
DEV void gemm_tile(const bf16_t* __restrict__ A, int lda, const bf16_t* __restrict__ Bt, int ldb, int K, int m0, int n0, char* smem, const Epi& epi) {
    bf16_t* As = (bf16_t*)smem;
    bf16_t* Bs = As + 128 * 72;
    const int tid = ltid(), lane = tid & 63, w = tid >> 6, wm = w >> 1, wn = w & 1, ql = lane & 31, hh = lane >> 5;
    f32x16 acc[2][2];
#pragma unroll
    for (int i = 0; i < 2; ++i)
#pragma unroll
        for (int j = 0; j < 2; ++j) acc[i][j] = zero16();
    const bf16_t* Ap = A + (size_t)m0 * lda;
    const bf16_t* Bp = Bt + (size_t)n0 * ldb;
    const int lrow = tid >> 3, lck = (tid & 7) * 8;
    const bf16_t* Ag = Ap + (size_t)lrow * lda + lck;
    const bf16_t* Bg = Bp + (size_t)lrow * ldb + lck;
    const size_t a32 = (size_t)32 * lda, b32 = (size_t)32 * ldb;
    uint4 ra0 = *(const uint4*)(Ag), ra1 = *(const uint4*)(Ag + a32), ra2 = *(const uint4*)(Ag + 2 * a32), ra3 = *(const uint4*)(Ag + 3 * a32);
    uint4 rb0 = *(const uint4*)(Bg), rb1 = *(const uint4*)(Bg + b32), rb2 = *(const uint4*)(Bg + 2 * b32), rb3 = *(const uint4*)(Bg + 3 * b32);
    bf16_t* Asw = As + lrow * 72 + lck;
    bf16_t* Bsw = Bs + lrow * 72 + lck;
    for (int k0 = 0; k0 < K; k0 += 64) {
        __syncthreads();
        *(uint4*)(Asw) = ra0; *(uint4*)(Asw + 32 * 72) = ra1; *(uint4*)(Asw + 64 * 72) = ra2; *(uint4*)(Asw + 96 * 72) = ra3;
        *(uint4*)(Bsw) = rb0; *(uint4*)(Bsw + 32 * 72) = rb1; *(uint4*)(Bsw + 64 * 72) = rb2; *(uint4*)(Bsw + 96 * 72) = rb3;
        __syncthreads();
        if (k0 + 64 < K) {
            const bf16_t* Agk = Ag + k0 + 64; const bf16_t* Bgk = Bg + k0 + 64;
            ra0 = *(const uint4*)(Agk); ra1 = *(const uint4*)(Agk + a32); ra2 = *(const uint4*)(Agk + 2 * a32); ra3 = *(const uint4*)(Agk + 3 * a32);
            rb0 = *(const uint4*)(Bgk); rb1 = *(const uint4*)(Bgk + b32); rb2 = *(const uint4*)(Bgk + 2 * b32); rb3 = *(const uint4*)(Bgk + 3 * b32);
        }
#pragma unroll
        for (int ks = 0; ks < 4; ++ks) {
            bf16x8 a[2], b[2];
#pragma unroll
            for (int i = 0; i < 2; ++i) {
                a[i] = *(const bf16x8*)(As + (wm * 64 + i * 32 + ql) * 72 + ks * 16 + hh * 8);
                b[i] = *(const bf16x8*)(Bs + (wn * 64 + i * 32 + ql) * 72 + ks * 16 + hh * 8);
            }
#pragma unroll
            for (int i = 0; i < 2; ++i)
#pragma unroll
                for (int j = 0; j < 2; ++j) acc[i][j] = mfma32(a[i], b[j], acc[i][j]);
        }
    }
#pragma unroll
    for (int i = 0; i < 2; ++i)
#pragma unroll
        for (int j = 0; j < 2; ++j)
#pragma unroll
            for (int g = 0; g < 4; ++g) {
                const int m = m0 + wm * 64 + i * 32 + 8 * g + 4 * hh;
                const int n = n0 + wn * 64 + j * 32 + ql;
                epi(m, n, acc[i][j][4 * g], acc[i][j][4 * g + 1], acc[i][j][4 * g + 2], acc[i][j][4 * g + 3]);
            }
}

struct EpiBf16 {
    bf16_t* C; int ldc; const float* rowscale; const float* colbias; int nvalid;
    DEV void operator()(int m, int n, float v0, float v1, float v2, float v3) const {
        if (n >= nvalid) return;
        float bsv = colbias ? colbias[n] : 0.f;
        float s0 = 1.f, s1 = 1.f, s2 = 1.f, s3 = 1.f;
        if (rowscale) { s0 = rowscale[m]; s1 = rowscale[m + 1]; s2 = rowscale[m + 2]; s3 = rowscale[m + 3]; }
        bf16_t* p = C + (size_t)m * ldc + n;
        p[0] = f2bf(v0 * s0 + bsv); p[ldc] = f2bf(v1 * s1 + bsv); p[2 * ldc] = f2bf(v2 * s2 + bsv); p[3 * ldc] = f2bf(v3 * s3 + bsv);
    }
};
struct EpiF32 {
    float* C; int ldc;
    DEV void operator()(int m, int n, float v0, float v1, float v2, float v3) const {
        float* p = C + (size_t)m * ldc + n;
        p[0] = v0; p[ldc] = v1; p[2 * ldc] = v2; p[3 * ldc] = v3;
    }
};
struct EpiRes {
    const float* xin; float* xout; const float* gate;
    DEV void operator()(int m, int n, float v0, float v1, float v2, float v3) const {
        const float g = gate[(size_t)(m >> 11) * 6144 + n];
        const float* pi = xin + (size_t)m * 1024 + n; float* po = xout + (size_t)m * 1024 + n;
        po[0] = pi[0] + g * v0; po[1024] = pi[1024] + g * v1; po[2048] = pi[2048] + g * v2; po[3072] = pi[3072] + g * v3;
    }
};

template <class Epi>
DEV void gemm_phase(const bf16_t* A, int lda, const bf16_t* Bt, int ldb, int K, int mtiles, int ntiles, char* smem, const Epi& epi) {
    for (int tile = blockIdx.x; tile < mtiles * ntiles; tile += gridDim.x) {
        const int mt = tile / ntiles, nt = tile % ntiles;
        gemm_tile(A, lda, Bt, ldb, K, mt * 128, nt * 128, smem, epi);
    }
}

DEV int win_srccol(int n) {
    if (n < 652) return n;
    if (n < 704) return -1;
    if (n < 1888) return n - 52;
    if (n < 1920) return -1;
    return n - 84;
}
DEV void transpose_tile(const float* __restrict__ src, int ld_src, int nsrc_valid, int mode, const float* __restrict__ rowscale,
                        bf16_t* __restrict__ dst, int K, int n0, int k0, char* smem) {
    bf16_t* Ls = (bf16_t*)smem;
    const int tid = ltid();
    __syncthreads();
    const int nn = tid & 63, n = n0 + nn;
    const int sc = (mode == 1) ? win_srccol(n) : (n < nsrc_valid ? n : -1);
#pragma unroll 4
    for (int i = 0; i < 16; ++i) {
        const int kk = (tid >> 6) + 4 * i;
        float v = 0.f;
        if (sc >= 0) { v = src[(size_t)(k0 + kk) * ld_src + sc]; if (rowscale) v *= rowscale[k0 + kk]; }
        Ls[nn * 72 + kk] = f2bf(v);
    }
    __syncthreads();
#pragma unroll
    for (int i = 0; i < 2; ++i) {
        const int r = (tid >> 3) + 32 * i, ch = tid & 7;
        *(uint4*)(dst + (size_t)(n0 + r) * K + k0 + ch * 8) = *(const uint4*)(Ls + r * 72 + ch * 8);
    }
}

DEV void convert_stream(const float* __restrict__ src, bf16_t* __restrict__ dst, size_t n8) {
    const int tid = ltid();
    for (size_t i = (size_t)blockIdx.x * 256 + tid; i < n8; i += (size_t)gridDim.x * 256) {
        const float4 a = *(const float4*)(src + i * 8), b = *(const float4*)(src + i * 8 + 4);
        uint4 o; o.x = pack2(a.x, a.y); o.y = pack2(a.z, a.w); o.z = pack2(b.x, b.y); o.w = pack2(b.z, b.w);
        *(uint4*)(dst + i * 8) = o;
    }
}

DEV void convert_fp8_stream(const float* __restrict__ src, unsigned char* __restrict__ dst, size_t n16, float scale) {
    const int tid = ltid();
    for (size_t i = (size_t)blockIdx.x * 256 + tid; i < n16; i += (size_t)gridDim.x * 256) {
        const float4 a = *(const float4*)(src + i * 16), b = *(const float4*)(src + i * 16 + 4), c = *(const float4*)(src + i * 16 + 8), d = *(const float4*)(src + i * 16 + 12);
        const float v[16] = {a.x, a.y, a.z, a.w, b.x, b.y, b.z, b.w, c.x, c.y, c.z, c.w, d.x, d.y, d.z, d.w};
        unsigned o[4];
#pragma unroll
        for (int j = 0; j < 4; ++j) {
            unsigned w = 0u;
            w = __builtin_amdgcn_cvt_pk_fp8_f32(fminf(fmaxf(v[4 * j] * scale, -440.f), 440.f), fminf(fmaxf(v[4 * j + 1] * scale, -440.f), 440.f), w, false);
            w = __builtin_amdgcn_cvt_pk_fp8_f32(fminf(fmaxf(v[4 * j + 2] * scale, -440.f), 440.f), fminf(fmaxf(v[4 * j + 3] * scale, -440.f), 440.f), w, true);
            o[j] = w;
        }
        const size_t rowg = i >> 6; const int c16 = (int)(i & 63);
        const size_t l = rowg >> 14, row = rowg & 16383;
        *(uint4*)(dst + (((l * 8 + (c16 >> 3)) * 16384 + row) << 7) + (c16 & 7) * 16) = make_uint4(o[0], o[1], o[2], o[3]);
    }
}

constexpr int J_ROPE = 384, J_MOD = 192, J_MISC = 5;
constexpr int J_TW_L = 608 + 256 + 512 + 24 + 16 + 64 + 64;
constexpr int J_TOTAL = J_ROPE + J_MOD + J_MISC + 2 * J_TW_L;

DEV void prologue_job(const Params& p, int job, char* smem) {
    const int tid = ltid();
    char* ws = p.ws;
    if (job < J_ROPE) {
        const int idx = job * 256 + tid;
        const int s = idx / 48, j = idx % 48;
        float* rope = (float*)(ws + OFF_ROPE);
        float inv; float *pc, *ps;
        if (j < 32) { inv = exp2f(-(float)j * (13.287712379549449f / 32.f)); pc = rope + s * 32 + j; ps = rope + 2048 * 32 + s * 32 + j; }
        else { const int i = j - 32; inv = exp2f(-(float)i * (13.287712379549449f / 16.f)); pc = rope + 2048 * 64 + s * 16 + i; ps = rope + 2048 * 64 + 2048 * 16 + s * 16 + i; }
        const double a = (double)s * (double)inv;
        const double kk = rint(a * 0.15915494309189535);
        const float r = (float)fma(-kk, 6.283185307179586, a);
        *pc = cosf(r); *ps = sinf(r);
        return;
    }
    job -= J_ROPE;
    if (job < J_MOD) {
        const int l = job / 96, n0 = (job % 96) * 64;
        float* sc = (float*)smem;
        __syncthreads();
        for (int i = tid; i < 8192; i += 256) { const float v = p.c[i]; sc[i] = v / (1.f + __expf(-v)); }
        __syncthreads();
        const int kp = tid >> 6, col = tid & 63;
        float acc[8];
#pragma unroll
        for (int b = 0; b < 8; ++b) acc[b] = 0.f;
        const float* wp = p.ada_w + (size_t)l * 1024 * 6144 + n0 + col;
        for (int k = kp * 256; k < kp * 256 + 256; ++k) {
            const float wv = wp[(size_t)k * 6144];
#pragma unroll
            for (int b = 0; b < 8; ++b) acc[b] += sc[b * 1024 + k] * wv;
        }
        float* red = sc + 8192;
#pragma unroll
        for (int b = 0; b < 8; ++b) red[(kp * 8 + b) * 64 + col] = acc[b];
        __syncthreads();
        float* mod = (float*)(ws + OFF_MOD);
        for (int idx = tid; idx < 512; idx += 256) {
            const int b = idx >> 6, cl = idx & 63;
            const float v = red[(0 * 8 + b) * 64 + cl] + red[(1 * 8 + b) * 64 + cl] + red[(2 * 8 + b) * 64 + cl] + red[(3 * 8 + b) * 64 + cl];
            mod[(size_t)(l * 8 + b) * 6144 + n0 + cl] = v + p.ada_b[l * 6144 + n0 + cl];
        }
        return;
    }
    job -= J_MOD;
    if (job < J_MISC) {
        float* misc = (float*)(ws + OFF_MISC);
        if (job < 4) {
            const int l = job >> 1, kv = job & 1;
            const float* pos = (kv ? p.pos_v : p.pos_k) + l * 2048;
            const float* wsrc = (kv ? p.cmp_wv : p.cmp_wk) + (size_t)l * 2048 * 64;
            float* red = (float*)smem;
            __syncthreads();
            const int kp = tid >> 6, n = tid & 63;
            float acc = 0.f;
            for (int k = kp * 512; k < kp * 512 + 512; ++k) acc += pos[k] * wsrc[(size_t)k * 64 + n];
            red[kp * 64 + n] = acc;
            __syncthreads();
            if (tid < 64) misc[(l * 2 + kv) * 64 + tid] = red[tid] + red[64 + tid] + red[128 + tid] + red[192 + tid];
        } else if (tid < 2) {
            const int l = tid;
            float d1 = 0.f, d2 = 0.f;
            for (int i = 0; i < 32; ++i) { d1 += p.lq1[l * 32 + i] * p.lk1[l * 32 + i]; d2 += p.lq2[l * 32 + i] * p.lk2[l * 32 + i]; }
            const float lam_init = 0.8f - 0.6f * expf(-0.3f * (float)l);
            misc[256 + l] = expf(d1) - expf(d2) + lam_init;
            misc[258 + l] = 1.f - lam_init;
        }
        return;
    }
    job -= J_MISC;
    const int l = job / J_TW_L; int j = job % J_TW_L;
    if (j < 608) { transpose_tile(p.w_in + (size_t)l * 1024 * 2348, 2348, 2348, 1, nullptr, (bf16_t*)(ws + OFF_WIN) + (size_t)l * 2432 * 1024, 1024, (j / 16) * 64, (j % 16) * 64, smem); return; }
    j -= 608;
    if (j < 256) { transpose_tile(p.w_out + (size_t)l * 1024 * 1024, 1024, 1024, 0, nullptr, (bf16_t*)(ws + OFF_WOUT) + (size_t)l * 1024 * 1024, 1024, (j / 16) * 64, (j % 16) * 64, smem); return; }
    j -= 256;
    if (j < 512) { transpose_tile(p.w_q + (size_t)l * 1024 * 2048, 2048, 2048, 0, nullptr, (bf16_t*)(ws + OFF_WQ) + (size_t)l * 2048 * 1024, 1024, (j / 16) * 64, (j % 16) * 64, smem); return; }
    j -= 512;
    if (j < 24) { transpose_tile(p.mla_wuq + (size_t)l * 256 * 384, 384, 384, 0, p.mla_qg + l * 256, (bf16_t*)(ws + OFF_WUQ) + (size_t)l * 384 * 256, 256, (j / 4) * 64, (j % 4) * 64, smem); return; }
    j -= 24;
    if (j < 16) { transpose_tile(p.mla_wukv + (size_t)l * 128 * 512, 512, 512, 0, p.mla_kvg + l * 128, (bf16_t*)(ws + OFF_WUKV) + (size_t)l * 512 * 128, 128, (j / 2) * 64, (j % 2) * 64, smem); return; }
    j -= 16;
    if (j < 64) { transpose_tile(p.cmp_wk + (size_t)l * 2048 * 64, 64, 64, 0, nullptr, (bf16_t*)(ws + OFF_WCK) + (size_t)l * 128 * 2048, 2048, (j / 32) * 64, (j % 32) * 64, smem); return; }
    j -= 64;
    transpose_tile(p.cmp_wv + (size_t)l * 2048 * 64, 64, 64, 0, nullptr, (bf16_t*)(ws + OFF_WCV) + (size_t)l * 128 * 2048, 2048, (j / 32) * 64, (j % 32) * 64, smem);
}

DEV void phase_prologue(const Params& p, char* smem) {
    for (int job = blockIdx.x; job < J_TOTAL; job += gridDim.x) prologue_job(p, job, smem);
    char* ws = p.ws;
    convert_fp8_stream(p.pu, (unsigned char*)(ws + OFF_PU), 2ull * 16384 * 1024 / 16, kScaleU);
    convert_fp8_stream(p.pv, (unsigned char*)(ws + OFF_PV), 2ull * 16384 * 1024 / 16, kScaleV);
    for (int l = 0; l < 2; ++l) {
        convert_stream(p.subk1 + (size_t)l * 16384, (bf16_t*)(ws + OFF_SUBK) + (size_t)(l * 2 + 0) * 16384, 16384 / 8);
        convert_stream(p.subk2 + (size_t)l * 16384, (bf16_t*)(ws + OFF_SUBK) + (size_t)(l * 2 + 1) * 16384, 16384 / 8);
    }
}

DEV void phase_norm(const Params& p, int layer, int which) {
    const int tid = ltid(), lane = tid & 63, w = tid >> 6;
    const float* xs = (layer == 0 && which == 0) ? p.x : (const float*)(p.ws + OFF_XRES);
    const float* g = (which == 0 ? p.norm_mix_g : p.norm_ffn_g) + layer * 1024;
    const float* mod = (const float*)(p.ws + OFF_MOD) + (size_t)layer * 8 * 6144;
    bf16_t* h = (bf16_t*)(p.ws + OFF_H);
    for (int q = blockIdx.x; q < kT / 4; q += gridDim.x) {
        const int t = q * 4 + w, b = t >> 11;
        const float* xr = xs + (size_t)t * 1024;
        float4 v[4]; float ss = 0.f;
#pragma unroll
        for (int i = 0; i < 4; ++i) { v[i] = *(const float4*)(xr + i * 256 + lane * 4); ss += v[i].x * v[i].x + v[i].y * v[i].y + v[i].z * v[i].z + v[i].w * v[i].w; }
        ss = wave_sum(ss);
        const float rstd = rsqrtf(ss * (1.f / 1024.f) + kEps);
        const float* sh = mod + (size_t)b * 6144 + (which ? 3072 : 0);
        const float* sc = sh + 1024;
#pragma unroll
        for (int i = 0; i < 4; ++i) {
            const int col = i * 256 + lane * 4;
            const float4 g4 = *(const float4*)(g + col), s4 = *(const float4*)(sc + col), h4 = *(const float4*)(sh + col);
            const float o0 = v[i].x * rstd * g4.x * (1.f + s4.x) + h4.x, o1 = v[i].y * rstd * g4.y * (1.f + s4.y) + h4.y;
            const float o2 = v[i].z * rstd * g4.z * (1.f + s4.z) + h4.z, o3 = v[i].w * rstd * g4.w * (1.f + s4.w) + h4.w;
            uint2 o; o.x = pack2(o0, o1); o.y = pack2(o2, o3);
            *(uint2*)(h + (size_t)t * 1024 + col) = o;
            if (which) {
                unsigned w8 = 0u;
                w8 = __builtin_amdgcn_cvt_pk_fp8_f32(fminf(fmaxf(o0, -440.f), 440.f), fminf(fmaxf(o1, -440.f), 440.f), w8, false);
                w8 = __builtin_amdgcn_cvt_pk_fp8_f32(fminf(fmaxf(o2, -440.f), 440.f), fminf(fmaxf(o3, -440.f), 440.f), w8, true);
                *(unsigned*)((unsigned char*)(p.ws + OFF_H8) + (size_t)t * 1024 + col) = w8;
            }
        }
    }
}

DEV void rope8(uint4& x1, uint4& x2, const float* cs, const float* sn) {
    const float4 c0 = *(const float4*)cs, c1 = *(const float4*)(cs + 4), s0 = *(const float4*)sn, s1 = *(const float4*)(sn + 4);
    const float cc[8] = {c0.x, c0.y, c0.z, c0.w, c1.x, c1.y, c1.z, c1.w};
    const float ss[8] = {s0.x, s0.y, s0.z, s0.w, s1.x, s1.y, s1.z, s1.w};
    unsigned a[4] = {x1.x, x1.y, x1.z, x1.w}, b[4] = {x2.x, x2.y, x2.z, x2.w};
#pragma unroll
    for (int i = 0; i < 4; ++i) {
        const float a0 = lo16(a[i]), a1 = hi16(a[i]), b0 = lo16(b[i]), b1 = hi16(b[i]);
        const float o10 = a0 * cc[2 * i] - b0 * ss[2 * i], o11 = a1 * cc[2 * i + 1] - b1 * ss[2 * i + 1];
        const float o20 = a0 * ss[2 * i] + b0 * cc[2 * i], o21 = a1 * ss[2 * i + 1] + b1 * cc[2 * i + 1];
        a[i] = pack2(o10, o11); b[i] = pack2(o20, o21);
    }
    x1 = make_uint4(a[0], a[1], a[2], a[3]); x2 = make_uint4(b[0], b[1], b[2], b[3]);
}
DEV void vt_tile(const bf16_t* __restrict__ src, int ld, bf16_t* __restrict__ dst, char* smem) {
    bf16_t* Ls = (bf16_t*)smem;
    const int tid = ltid();
    __syncthreads();
#pragma unroll
    for (int i = 0; i < 2; ++i) {
        const int id = tid + 256 * i, tok = id >> 3, ch = id & 7;
        *(uint4*)(Ls + tok * 72 + ch * 8) = *(const uint4*)(src + (size_t)tok * ld + ch * 8);
    }
    __syncthreads();
#pragma unroll
    for (int i = 0; i < 2; ++i) {
        const int id = tid + 256 * i, d = id >> 3, tc = id & 7;
        unsigned short e[8];
#pragma unroll
        for (int j = 0; j < 8; ++j) e[j] = Ls[(tc * 8 + j) * 72 + d];
        uint4 o;
        o.x = (unsigned)e[0] | ((unsigned)e[1] << 16); o.y = (unsigned)e[2] | ((unsigned)e[3] << 16);
        o.z = (unsigned)e[4] | ((unsigned)e[5] << 16); o.w = (unsigned)e[6] | ((unsigned)e[7] << 16);
        *(uint4*)(dst + (size_t)d * 2048 + tc * 8) = o;
    }
}

DEV void phase_layout1(const Params& p, char* smem) {
    char* ws = p.ws;
    bf16_t* cols = (bf16_t*)(ws + OFF_COLS);
    bf16_t* kc = (bf16_t*)(ws + OFF_KC);
    bf16_t* vc = (bf16_t*)(ws + OFF_VC);
    bf16_t* VT = (bf16_t*)(ws + OFF_VT);
    float* rstd = (float*)(ws + OFF_RSTD);
    const float* rope = (const float*)(ws + OFF_ROPE);
    const float *cos64 = rope, *sin64 = rope + 2048 * 32, *cos32 = rope + 2048 * 64, *sin32 = rope + 2048 * 64 + 2048 * 16;
    const int tid = ltid();
    for (int tile = blockIdx.x; tile < kT / 64; tile += gridDim.x) {
        const int T0 = tile * 64, b = T0 >> 11, s0 = T0 & 2047;
        for (int it = tid; it < 64 * 94; it += 256) {
            const int tok = it / 94, item = it % 94;
            const int t = T0 + tok, s = s0 + tok;
            bf16_t* row = cols + (size_t)t * LDC;
            if (item < 52) {
                const int hd = item >> 2, i0 = (item & 3) * 8;
                const int base = hd < 4 ? 64 * hd : hd == 4 ? 256 : hd == 5 ? 384 : hd == 6 ? 512 : hd < 11 ? 1920 + 64 * (hd - 7) : 2176 + 64 * (hd - 11);
                uint4 x1 = *(const uint4*)(row + base + i0), x2 = *(const uint4*)(row + base + 32 + i0);
                rope8(x1, x2, cos64 + s * 32 + i0, sin64 + s * 32 + i0);
                *(uint4*)(row + base + i0) = x1; *(uint4*)(row + base + 32 + i0) = x2;
                if (hd == 4) { *(uint4*)(kc + (size_t)t * 64 + i0) = x1; *(uint4*)(kc + (size_t)t * 64 + 32 + i0) = x2; }
            } else if (item < 86) {
                const int it2 = item - 52, sub = it2 >> 1, i0 = (it2 & 1) * 8;
                const int base = sub < 8 ? 704 + 32 * sub : sub < 16 ? 960 + 32 * (sub - 8) : 1856;
                uint4 x1 = *(const uint4*)(row + base + i0), x2 = *(const uint4*)(row + base + 16 + i0);
                rope8(x1, x2, cos32 + s * 16 + i0, sin32 + s * 16 + i0);
                *(uint4*)(row + base + i0) = x1; *(uint4*)(row + base + 16 + i0) = x2;
            } else {
                const int ch = item - 86;
                *(uint4*)(vc + (size_t)t * 64 + ch * 8) = *(const uint4*)(row + 320 + ch * 8);
            }
        }
        {
            const int tok = tid >> 2, part = tid & 3, t = T0 + tok;
            const bf16_t* src = cols + (size_t)t * LDC + 1472 + (part < 3 ? part : 0) * 128;
            float ss = 0.f;
#pragma unroll 4
            for (int i = 0; i < 16; ++i) {
                const uint4 u = *(const uint4*)(src + i * 8);
                ss += lo16(u.x) * lo16(u.x) + hi16(u.x) * hi16(u.x) + lo16(u.y) * lo16(u.y) + hi16(u.y) * hi16(u.y)
                    + lo16(u.z) * lo16(u.z) + hi16(u.z) * hi16(u.z) + lo16(u.w) * lo16(u.w) + hi16(u.w) * hi16(u.w);
            }
            float vq = part < 2 ? ss : 0.f;
            vq += __shfl_xor(vq, 1, 64);
            if (part == 0) rstd[t] = rsqrtf(vq * (1.f / 256.f) + kEps);
            if (part == 2) rstd[kT + t] = rsqrtf(ss * (1.f / 128.f) + kEps);
        }
#pragma unroll 1
        for (int vh = 0; vh < 8; ++vh) {
            const int col = vh == 0 ? 448 : vh == 1 ? 576 : vh < 6 ? 1216 + 64 * (vh - 2) : 2304 + 64 * (vh - 6);
            vt_tile(cols + (size_t)T0 * LDC + col, LDC, VT + ((size_t)(b * 12 + vh) * 64) * 2048 + s0, smem);
        }
    }
}

DEV void phase_layout2(const Params& p, char* smem) {
    char* ws = p.ws;
    bf16_t* qmla = (bf16_t*)(ws + OFF_QMLA);
    const bf16_t* kvmla = (const bf16_t*)(ws + OFF_KVMLA);
    bf16_t* VT = (bf16_t*)(ws + OFF_VT);
    const float* rope = (const float*)(ws + OFF_ROPE);
    const float *cos32 = rope + 2048 * 64, *sin32 = rope + 2048 * 64 + 2048 * 16;
    const int tid = ltid();
    for (int tile = blockIdx.x; tile < kT / 64; tile += gridDim.x) {
        const int T0 = tile * 64, b = T0 >> 11, s0 = T0 & 2047;
        for (int it = tid; it < 64 * 8; it += 256) {
            const int tok = it >> 3, item = it & 7, hd = item >> 1, i0 = (item & 1) * 8;
            const int t = T0 + tok, s = s0 + tok;
            bf16_t* row = qmla + (size_t)t * 384 + hd * 96 + 64;
            uint4 x1 = *(const uint4*)(row + i0), x2 = *(const uint4*)(row + 16 + i0);
            rope8(x1, x2, cos32 + s * 16 + i0, sin32 + s * 16 + i0);
            *(uint4*)(row + i0) = x1; *(uint4*)(row + 16 + i0) = x2;
        }
#pragma unroll 1
        for (int hd = 0; hd < 4; ++hd)
            vt_tile(kvmla + (size_t)T0 * 512 + hd * 128 + 64, 512, VT + ((size_t)(b * 12 + 8 + hd) * 64) * 2048 + s0, smem);
    }
}

constexpr int SM_K = 0;
constexpr int SM_V = 18432;
constexpr int SM_IMP = SM_V + 16896;
constexpr int SM_SEL = SM_IMP + 16896;
constexpr int SM_TOTAL = SM_SEL + 1024;

struct RangeIter { int cur, end; DEV int next() { return cur < end ? cur++ : -1; } };
struct BitIter { unsigned rem; DEV int next() { if (!rem) return -1; const int k = __ffs((int)rem) - 1; rem &= rem - 1; return k; } };
struct LdRow { const bf16_t* base; int ld;
    DEV uint4 operator()(int kt, int id) const { const int row = id >> 3, part = id & 7; return *(const uint4*)(base + (size_t)(kt * 64 + row) * ld + part * 8); } };
struct LdVT { const bf16_t* base;
    DEV uint4 operator()(int kt, int id) const { const int d = id >> 3, part = id & 7; return *(const uint4*)(base + (size_t)d * 2048 + kt * 64 + part * 8); } };
struct LdMlaK { const bf16_t* kv; const bf16_t* kr;
    DEV uint4 operator()(int kt, int id) const { const int row = id / 12, part = id % 12; const size_t t = (size_t)(kt * 64 + row);
        return part < 8 ? *(const uint4*)(kv + t * 512 + part * 8) : *(const uint4*)(kr + t * LDC + (part - 8) * 8); } };

struct MaskCausal { DEV bool on(int) const { return true; } DEV bool ok(int kc, int d) const { return kc <= d; } };
template <int W> struct MaskWin { DEV bool on(int) const { return true; } DEV bool ok(int kc, int d) const { return (kc <= d) && (d - kc < W); } };
struct MaskSel { unsigned bits; DEV bool on(int kt) const { return (bits >> kt) & 1u; } DEV bool ok(int kc, int d) const { return kc <= d; } };
template <int KDIM, int NKS, int NSUB, class It, class LK, class LV, class MaskF, class SkipF>
DEV void attn_stream(It it, const LK& ldK, const LV& ldV, const MaskF& maskf, const SkipF& skipf,
                     const bf16x8* qf, f32x16 (&o)[NSUB][2], float (&m)[NSUB], float (&l)[NSUB], float scl, int tq, char* smem, int tid, int koff = 0) {
    constexpr int KCH = KDIM / 8, KSTR = KDIM + 8, NKC = (64 * KCH) / 256;
    bf16_t* Kb = (bf16_t*)(smem + SM_K);
    bf16_t* Vb = (bf16_t*)(smem + SM_V);
    const int lane = tid & 63, ql = lane & 31, hh = lane >> 5;
    uint4 rk0 = make_uint4(0, 0, 0, 0), rk1 = rk0, rk2 = rk0, rv0 = rk0, rv1 = rk0;
    int kt = it.next();
    if (kt >= 0) {
        rk0 = ldK(kt, tid); rk1 = ldK(kt, tid + 256);
        if (NKC == 3) rk2 = ldK(kt, tid + 512);
        rv0 = ldV(kt, tid); rv1 = ldV(kt, tid + 256);
    }
    while (kt >= 0) {
        __syncthreads();
        { const int id = tid, row = id / KCH, part = id % KCH; *(uint4*)(Kb + row * KSTR + part * 8) = rk0; }
        { const int id = tid + 256, row = id / KCH, part = id % KCH; *(uint4*)(Kb + row * KSTR + part * 8) = rk1; }
        if (NKC == 3) { const int id = tid + 512, row = id / KCH, part = id % KCH; *(uint4*)(Kb + row * KSTR + part * 8) = rk2; }
        { const int id = tid, row = id >> 3, part = id & 7; bf16_t* d = Vb + row * 68 + part * 8;
            *(uint2*)d = make_uint2(rv0.x, rv0.y); *(uint2*)(d + 4) = make_uint2(rv0.z, rv0.w); }
        { const int id = tid + 256, row = id >> 3, part = id & 7; bf16_t* d = Vb + row * 68 + part * 8;
            *(uint2*)d = make_uint2(rv1.x, rv1.y); *(uint2*)(d + 4) = make_uint2(rv1.z, rv1.w); }
        __syncthreads();
        const int ktn = it.next();
        if (ktn >= 0) {
            rk0 = ldK(ktn, tid); rk1 = ldK(ktn, tid + 256);
            if (NKC == 3) rk2 = ldK(ktn, tid + 512);
            rv0 = ldV(ktn, tid); rv1 = ldV(ktn, tid + 256);
        }
        if (!skipf(kt)) {
#pragma unroll
            for (int sub = 0; sub < NSUB; ++sub) {
                __builtin_amdgcn_sched_barrier(0);
                f32x16 s[2];
#pragma unroll
                for (int i = 0; i < 2; ++i) {
                    s[i] = zero16();
#pragma unroll
                    for (int ks = 0; ks < NKS; ++ks) {
                        const bf16x8 a = *(const bf16x8*)(Kb + (i * 32 + ql) * KSTR + koff + (sub * NKS + ks) * 16 + hh * 8);
                        s[i] = mfma32(a, qf[sub * NKS + ks], s[i]);
                    }
                }
                float mx = kNeg;
                const int dlim = tq - kt * 64 - 4 * hh;
                const bool on = maskf.on(kt);
#pragma unroll
                for (int i = 0; i < 2; ++i)
#pragma unroll
                    for (int r = 0; r < 16; ++r) {
                        const int kc = i * 32 + (r & 3) + 8 * (r >> 2);
                        const float v = (on && maskf.ok(kc, dlim)) ? s[i][r] * scl : kNeg;
                        s[i][r] = v; mx = fmaxf(mx, v);
                    }
                mx = fmaxf(mx, xor32f(mx, lane));
                const float mnew = fmaxf(m[sub], mx);
                const float alpha = __builtin_amdgcn_exp2f(m[sub] - mnew);
                m[sub] = mnew;
                float sum = 0.f;
#pragma unroll
                for (int i = 0; i < 2; ++i)
#pragma unroll
                    for (int r = 0; r < 16; ++r) { const float pv = __builtin_amdgcn_exp2f(s[i][r] - mnew); s[i][r] = pv; sum += pv; }
                l[sub] = l[sub] * alpha + sum;
#pragma unroll
                for (int dt = 0; dt < 2; ++dt)
#pragma unroll
                    for (int r = 0; r < 16; ++r) o[sub][dt][r] *= alpha;
                __builtin_amdgcn_sched_barrier(0);
#pragma unroll
                for (int ks = 0; ks < 4; ++ks) {
                    if (ks == 2) __builtin_amdgcn_sched_barrier(0);
                    const int i = ks >> 1, r0 = 8 * (ks & 1);
                    uint4 pu;
                    pu.x = pack2(s[i][r0 + 0], s[i][r0 + 1]); pu.y = pack2(s[i][r0 + 2], s[i][r0 + 3]);
                    pu.z = pack2(s[i][r0 + 4], s[i][r0 + 5]); pu.w = pack2(s[i][r0 + 6], s[i][r0 + 7]);
                    const bf16x8 pf = __builtin_bit_cast(bf16x8, pu);
#pragma unroll
                    for (int dt = 0; dt < 2; ++dt) {
                        const bf16_t* vp = Vb + (dt * 32 + ql) * 68 + ks * 16 + 4 * hh;
                        const uint2 a0 = *(const uint2*)vp, a1 = *(const uint2*)(vp + 8);
                        const bf16x8 a = __builtin_bit_cast(bf16x8, make_uint4(a0.x, a0.y, a1.x, a1.y));
                        o[sub][dt] = mfma32(a, pf, o[sub][dt]);
                    }
                }
            }
        }
        kt = ktn;
    }
}

DEV void write_o(const f32x16 (&o)[2], bf16_t* obuf, size_t row, int col0, int hh) {
#pragma unroll
    for (int dt = 0; dt < 2; ++dt)
#pragma unroll
        for (int g = 0; g < 4; ++g) {
            const int d = dt * 32 + 8 * g + 4 * hh;
            uint2 u; u.x = pack2(o[dt][4 * g], o[dt][4 * g + 1]); u.y = pack2(o[dt][4 * g + 2], o[dt][4 * g + 3]);
            *(uint2*)(obuf + row * 1024 + col0 + d) = u;
        }
}
DEV float sigmoidf(float x) { return 1.f / (1.f + __expf(-x)); }

DEV void nsa_item(const Params& p, int b, int qb, char* smem) {
    int tid = threadIdx.x; asm volatile("" : "+v"(tid));
    const int lane = tid & 63, w = tid >> 6, ql = lane & 31, hh = lane >> 5;
    char* ws = p.ws;
    const bf16_t* cols = (const bf16_t*)(ws + OFF_COLS);
    const bf16_t* VT = (const bf16_t*)(ws + OFF_VT);
    bf16_t* obuf = (bf16_t*)(ws + OFF_O);
    const int t0 = qb * 32, tq = t0 + ql;
    const size_t Tb = (size_t)b * kS;
    const bf16_t* qrow = cols + (Tb + tq) * LDC;
    bf16x8 qf[4];
#pragma unroll
    for (int ks = 0; ks < 4; ++ks) qf[ks] = *(const bf16x8*)(qrow + w * 64 + ks * 16 + hh * 8);
    const float g0 = sigmoidf(bf2f(qrow[640 + w * 3 + 0])), g1 = sigmoidf(bf2f(qrow[640 + w * 3 + 1])), g2 = sigmoidf(bf2f(qrow[640 + w * 3 + 2]));
    const float scl = 0.125f * kLog2e;
    bf16_t* Kc = (bf16_t*)(smem + SM_K);
    bf16_t* Vc = (bf16_t*)(smem + SM_V);
    float* impP = (float*)(smem + SM_IMP);
    unsigned* selm = (unsigned*)(smem + SM_SEL);
    const bf16_t* kcmp = (const bf16_t*)(ws + OFF_KCMP) + (size_t)b * 128 * 64;
    const bf16_t* vcmp = kcmp + 1024 * 64;
    __syncthreads();
#pragma unroll
    for (int i = 0; i < 4; ++i) {
        const int id = tid + 256 * i, row = id >> 3, part = id & 7;
        uint4 kk = *(const uint4*)(kcmp + row * 64 + part * 8);
        uint4 vv = *(const uint4*)(vcmp + row * 64 + part * 8);
        if (row == 127) { kk = make_uint4(0, 0, 0, 0); vv = kk; }
        *(uint4*)(Kc + row * 72 + part * 8) = kk;
        const unsigned u[4] = {vv.x, vv.y, vv.z, vv.w};
#pragma unroll
        for (int j = 0; j < 4; ++j) { Vc[(part * 8 + 2 * j) * 132 + row] = (bf16_t)(u[j] & 0xffffu); Vc[(part * 8 + 2 * j + 1) * 132 + row] = (bf16_t)(u[j] >> 16); }
    }
    __syncthreads();
    unsigned ocp[16];
    float* invs = (float*)(smem + SM_SEL) + 64;
    {
        const int cmaxv = tq >= 31 ? min((tq - 31) >> 4, 126) : -1;
        float mx = kNeg;
#pragma unroll 1
        for (int i = 0; i < 4; ++i) {
            f32x16 s = zero16();
#pragma unroll
            for (int ks = 0; ks < 4; ++ks) s = mfma32(*(const bf16x8*)(Kc + (i * 32 + ql) * 72 + ks * 16 + hh * 8), qf[ks], s);
            const int clim = cmaxv - i * 32 - 4 * hh;
#pragma unroll
            for (int r = 0; r < 16; ++r) {
                const int kc = (r & 3) + 8 * (r >> 2);
                const bool valid = (kc <= clim);
                mx = fmaxf(mx, valid ? s[r] * scl : kNeg);
            }
        }
        mx = fmaxf(mx, xor32f(mx, lane));
        f32x16 ocmp[2]; ocmp[0] = zero16(); ocmp[1] = zero16();
        float sum = 0.f, carprev = 0.f;
#pragma unroll 1
        for (int i = 0; i < 4; ++i) {
            f32x16 s = zero16();
#pragma unroll
            for (int ks = 0; ks < 4; ++ks) s = mfma32(*(const bf16x8*)(Kc + (i * 32 + ql) * 72 + ks * 16 + hh * 8), qf[ks], s);
            const int clim = cmaxv - i * 32 - 4 * hh;
#pragma unroll
            for (int r = 0; r < 16; ++r) {
                const int kc = (r & 3) + 8 * (r >> 2);
                const bool valid = (kc <= clim);
                const float pv = valid ? __builtin_amdgcn_exp2f(s[r] * scl - mx) : 0.f;
                s[r] = pv; sum += pv;
            }
            float own[4], car[4];
#pragma unroll
            for (int g = 0; g < 4; ++g) { own[g] = s[4 * g] + s[4 * g + 1] + s[4 * g + 2] + 0.5f * s[4 * g + 3]; car[g] = 0.5f * s[4 * g + 3]; }
#pragma unroll
            for (int g = 0; g < 4; ++g) {
                const float send = hh ? (g ? car[g > 0 ? g - 1 : 0] : carprev) : car[g];
                own[g] += xor32f(send, lane);
            }
            carprev = car[3];
#pragma unroll
            for (int g = 0; g < 4; ++g) impP[(w * 32 + ql) * 33 + 2 * (4 * i + g) + hh] = own[g];
#pragma unroll
            for (int sp = 0; sp < 2; ++sp) {
                const int ks = 2 * i + sp, r0 = 8 * sp;
                uint4 pu;
                pu.x = pack2(s[r0 + 0], s[r0 + 1]); pu.y = pack2(s[r0 + 2], s[r0 + 3]);
                pu.z = pack2(s[r0 + 4], s[r0 + 5]); pu.w = pack2(s[r0 + 6], s[r0 + 7]);
                const bf16x8 pf = __builtin_bit_cast(bf16x8, pu);
#pragma unroll
                for (int dt = 0; dt < 2; ++dt) {
                    const bf16_t* vp = Vc + (dt * 32 + ql) * 132 + ks * 16 + 4 * hh;
                    const uint2 a0 = *(const uint2*)vp, a1 = *(const uint2*)(vp + 8);
                    ocmp[dt] = mfma32(__builtin_bit_cast(bf16x8, make_uint4(a0.x, a0.y, a1.x, a1.y)), pf, ocmp[dt]);
                }
            }
        }
        sum += xor32f(sum, lane);
        const float inv = sum > 0.f ? 1.f / sum : 0.f;
        invs[w * 32 + ql] = inv;
        const float f = g0 * inv;
#pragma unroll
        for (int dt = 0; dt < 2; ++dt)
#pragma unroll
            for (int r = 0; r < 8; ++r) ocp[dt * 8 + r] = pack2(f * ocmp[dt][2 * r], f * ocmp[dt][2 * r + 1]);
    }
    __syncthreads();
    const int qblk = t0 >> 6;
    {
        const int hw = tid >> 5, j = tid & 31;
#pragma unroll 1
        for (int rr = 0; rr < 4; ++rr) {
            const int row = hw * 4 + rr;
            const float v = impP[(0 * 32 + row) * 33 + j] * invs[row] + impP[(1 * 32 + row) * 33 + j] * invs[32 + row]
                          + impP[(2 * 32 + row) * 33 + j] * invs[64 + row] + impP[(3 * 32 + row) * 33 + j] * invs[96 + row];
            bool sel;
            if (qblk < 16) sel = (j <= qblk);
            else {
                const bool cand = (j >= 1) && (j <= qblk - 2);
                const bool forced = (j == 0) || (j == qblk) || (j == qblk - 1);
                int rank = 0;
                for (int j2 = 1; j2 <= qblk - 2; ++j2) {
                    const float v2 = lanef(v, (lane & 32) + j2);
                    rank += (v2 > v || (v2 == v && j2 < j)) ? 1 : 0;
                }
                sel = forced || (cand && rank < 13);
            }
            const unsigned long long bal = __ballot(sel);
            const unsigned mk = (lane & 32) ? (unsigned)(bal >> 32) : (unsigned)bal;
            if (j == 0) selm[row] = mk;
        }
    }
    __syncthreads();
    const unsigned mysel = selm[ql];
    unsigned U = mysel;
#pragma unroll
    for (int o = 16; o > 0; o >>= 1) U |= (unsigned)__builtin_amdgcn_ds_bpermute((lane ^ o) << 2, (int)U);
    {
        f32x16 o1[1][2]; o1[0][0] = zero16(); o1[0][1] = zero16();
        float m1[1] = {kNeg}, l1[1] = {0.f};
        auto skipf = [&](int) { return false; };
        attn_stream<64, 4, 1>(BitIter{U}, LdRow{cols + Tb * LDC + 384, LDC}, LdVT{VT + (size_t)(b * 12 + 0) * 64 * 2048}, MaskSel{mysel}, skipf, qf, o1, m1, l1, scl, tq, smem, tid);
        const float lt = l1[0] + xor32f(l1[0], lane);
        const float f = g1 / lt;
#pragma unroll
        for (int dt = 0; dt < 2; ++dt)
#pragma unroll
            for (int r = 0; r < 8; ++r) ocp[dt * 8 + r] = pack2(lo16(ocp[dt * 8 + r]) + f * o1[0][dt][2 * r], hi16(ocp[dt * 8 + r]) + f * o1[0][dt][2 * r + 1]);
    }
    {
        f32x16 o1[1][2]; o1[0][0] = zero16(); o1[0][1] = zero16();
        float m1[1] = {kNeg}, l1[1] = {0.f};
        auto skipf = [&](int) { return false; };
        const int lo = t0 >= 511 ? ((t0 - 511) >> 6) : 0;
        attn_stream<64, 4, 1>(RangeIter{lo, qblk + 1}, LdRow{cols + Tb * LDC + 512, LDC}, LdVT{VT + (size_t)(b * 12 + 1) * 64 * 2048}, MaskWin<512>{}, skipf, qf, o1, m1, l1, scl, tq, smem, tid);
        const float lt = l1[0] + xor32f(l1[0], lane);
        const float f = g2 / lt;
#pragma unroll
        for (int dt = 0; dt < 2; ++dt)
#pragma unroll
            for (int r = 0; r < 8; ++r) { o1[0][dt][2 * r] = lo16(ocp[dt * 8 + r]) + f * o1[0][dt][2 * r]; o1[0][dt][2 * r + 1] = hi16(ocp[dt * 8 + r]) + f * o1[0][dt][2 * r + 1]; }
        write_o(o1[0], obuf, Tb + tq, w * 64, hh);
    }
}

DEV void diff_item(const Params& p, int layer, int b, int hd, int q64, char* smem) {
    int tid = threadIdx.x; asm volatile("" : "+v"(tid));
    const int lane = tid & 63, w = tid >> 6, ql = lane & 31, hh = lane >> 5;
    const int sub = w & 1, qbw = w >> 1;
    char* ws = p.ws;
    const bf16_t* cols = (const bf16_t*)(ws + OFF_COLS);
    const bf16_t* VT = (const bf16_t*)(ws + OFF_VT);
    bf16_t* obuf = (bf16_t*)(ws + OFF_O);
    const float* misc = (const float*)(ws + OFF_MISC);
    const int t0w = q64 * 64 + qbw * 32, tq = t0w + ql;
    const size_t Tb = (size_t)b * kS;
    const bf16_t* qrow = cols + (Tb + tq) * LDC + 704 + hd * 64 + sub * 32;
    bf16x8 qf[2];
#pragma unroll
    for (int ks = 0; ks < 2; ++ks) qf[ks] = *(const bf16x8*)(qrow + ks * 16 + hh * 8);
    const float scl = 0.17677669529663687f * kLog2e;
    f32x16 o1[1][2]; o1[0][0] = zero16(); o1[0][1] = zero16();
    float m1[1] = {kNeg}, l1[1] = {0.f};
    auto skipf = [&](int kt) { return kt * 64 > t0w + 31; };
    attn_stream<64, 2, 1>(RangeIter{0, q64 + 1}, LdRow{cols + Tb * LDC + 960 + hd * 64, LDC}, LdVT{VT + (size_t)(b * 12 + 2 + hd) * 64 * 2048}, MaskCausal{}, skipf, qf, o1, m1, l1, scl, tq, smem, tid, sub * 32);
    const float lam = misc[256 + layer], post = misc[258 + layer];
    const float lt = l1[0] + xor32f(l1[0], lane);
    float* ex = (float*)smem;
    __syncthreads();
    if (sub == 1) {
        const float f = lam / lt;
#pragma unroll
        for (int dt = 0; dt < 2; ++dt)
#pragma unroll
            for (int r = 0; r < 16; ++r) ex[((qbw * 2 + dt) * 16 + r) * 64 + lane] = o1[0][dt][r] * f;
    }
    __syncthreads();
    if (sub == 0) {
        const float f = 1.f / lt;
        float ss = 0.f;
#pragma unroll
        for (int dt = 0; dt < 2; ++dt)
#pragma unroll
            for (int r = 0; r < 16; ++r) { const float v = o1[0][dt][r] * f - ex[((qbw * 2 + dt) * 16 + r) * 64 + lane]; o1[0][dt][r] = v; ss += v * v; }
        ss += xor32f(ss, lane);
        const float rstd = rsqrtf(ss * (1.f / 64.f) + kEps) * post;
        const float* sg = p.sub_g + layer * 64;
#pragma unroll
        for (int dt = 0; dt < 2; ++dt)
#pragma unroll
            for (int r = 0; r < 16; ++r) { const int d = dt * 32 + (r & 3) + 8 * (r >> 2) + 4 * hh; o1[0][dt][r] *= rstd * sg[d]; }
        write_o(o1[0], obuf, Tb + tq, 256 + hd * 64, hh);
    }
}

DEV void mla_item(const Params& p, int b, int hd, int qc, char* smem) {
    int tid = threadIdx.x; asm volatile("" : "+v"(tid));
    const int lane = tid & 63, w = tid >> 6, ql = lane & 31, hh = lane >> 5;
    char* ws = p.ws;
    const bf16_t* cols = (const bf16_t*)(ws + OFF_COLS);
    const bf16_t* VT = (const bf16_t*)(ws + OFF_VT);
    const bf16_t* qmla = (const bf16_t*)(ws + OFF_QMLA);
    const bf16_t* kvmla = (const bf16_t*)(ws + OFF_KVMLA);
    bf16_t* obuf = (bf16_t*)(ws + OFF_O);
    const int t0w = qc * 128 + w * 32, tq = t0w + ql;
    const size_t Tb = (size_t)b * kS;
    const bf16_t* qrow = qmla + (Tb + tq) * 384 + hd * 96;
    bf16x8 qf[6];
#pragma unroll
    for (int ks = 0; ks < 6; ++ks) qf[ks] = *(const bf16x8*)(qrow + ks * 16 + hh * 8);
    const float scl = 0.10206207261596575f * kLog2e;
    f32x16 o1[1][2]; o1[0][0] = zero16(); o1[0][1] = zero16();
    float m1[1] = {kNeg}, l1[1] = {0.f};
    auto skipf = [&](int kt) { return kt * 64 > t0w + 31; };
    attn_stream<96, 6, 1>(RangeIter{0, 2 * qc + 2}, LdMlaK{kvmla + Tb * 512 + hd * 128, cols + Tb * LDC + 1856}, LdVT{VT + (size_t)(b * 12 + 8 + hd) * 64 * 2048}, MaskCausal{}, skipf, qf, o1, m1, l1, scl, tq, smem, tid);
    const float inv = 1.f / (l1[0] + xor32f(l1[0], lane));
#pragma unroll
    for (int dt = 0; dt < 2; ++dt)
#pragma unroll
        for (int r = 0; r < 16; ++r) o1[0][dt][r] *= inv;
    write_o(o1[0], obuf, Tb + tq, 512 + hd * 64, hh);
}

DEV void swa_item(const Params& p, int layer, int b, int g, int q64, char* smem) {
    int tid = threadIdx.x; asm volatile("" : "+v"(tid));
    const int lane = tid & 63, w = tid >> 6, ql = lane & 31, hh = lane >> 5;
    char* ws = p.ws;
    const bf16_t* cols = (const bf16_t*)(ws + OFF_COLS);
    const bf16_t* VT = (const bf16_t*)(ws + OFF_VT);
    bf16_t* obuf = (bf16_t*)(ws + OFF_O);
    const int head = g * 2 + (w & 1);
    const int t0w = q64 * 64 + (w >> 1) * 32, tq = t0w + ql;
    const size_t Tb = (size_t)b * kS;
    const bf16_t* qrow = cols + (Tb + tq) * LDC + 1920 + head * 64;
    bf16x8 qf[4];
#pragma unroll
    for (int ks = 0; ks < 4; ++ks) qf[ks] = *(const bf16x8*)(qrow + ks * 16 + hh * 8);
    const float scl = 0.125f * kLog2e;
    f32x16 o1[1][2]; o1[0][0] = zero16(); o1[0][1] = zero16();
    float m1[1] = {p.sinks[layer * 4 + head] * kLog2e}, l1[1] = {hh == 0 ? 1.f : 0.f};
    auto skipf = [&](int kt) { return (kt * 64 > t0w + 31) || (kt * 64 + 63 < t0w - 127); };
    const int lo = q64 >= 2 ? q64 - 2 : 0;
    attn_stream<64, 4, 1>(RangeIter{lo, q64 + 1}, LdRow{cols + Tb * LDC + 2176 + g * 64, LDC}, LdVT{VT + (size_t)(b * 12 + 6 + g) * 64 * 2048}, MaskWin<128>{}, skipf, qf, o1, m1, l1, scl, tq, smem, tid);
    const float inv = 1.f / (l1[0] + xor32f(l1[0], lane));
#pragma unroll
    for (int dt = 0; dt < 2; ++dt)
#pragma unroll
        for (int r = 0; r < 16; ++r) o1[0][dt][r] *= inv;
    write_o(o1[0], obuf, Tb + tq, 768 + head * 64, hh);
}

DEV void phase_attn(const Params& p, int layer, char* smem, int rep = 0) {
    unsigned* ctr = (unsigned*)(p.ws + OFF_CTRL) + 64 + layer * 16 + rep;
    volatile int* slot = (volatile int*)(smem + SM_SEL) + 48;
    for (;;) {
        __syncthreads();
        if (ltid() == 0) *slot = (int)atomicAdd(ctr, 1u);
        __syncthreads();
        const int idx = __builtin_amdgcn_readfirstlane(*slot);
        if (idx >= 2560) break;
        const int level = 15 - idx / 160, r = idx % 160;
        if (r < 64) { const int b = (r & 31) >> 2; diff_item(p, layer, b, r & 3, level * 2 + (1 - (r >> 5)), smem); }
        else if (r < 96) { const int k = r - 64; mla_item(p, k >> 2, k & 3, level, smem); }
        else if (r < 128) { const int k = r - 96; nsa_item(p, k >> 2, level * 4 + (3 - (k & 3)), smem); }
        else { const int k = r - 128; swa_item(p, layer, k >> 2, (k >> 1) & 1, level * 2 + (k & 1), smem); }
    }
}

#define XB_TMO      128
#define XB_XCNT(j)  (256  + 64 * (j))
#define XB_XSUB(j)  (1280 + 64 * (j))
#define XB_XGEN(j)  (2304 + 64 * (j))
#define XB_TOP      3328
#define XB_TOPGEN   3392
#define XB_SPIN_CAP (1u << 22)
#define LAS __attribute__((address_space(3)))
DEV unsigned xb_ld(unsigned* p) { return __hip_atomic_load(p, __ATOMIC_RELAXED, __HIP_MEMORY_SCOPE_AGENT); }
DEV unsigned xb_add(unsigned* p, unsigned v) { return __hip_atomic_fetch_add(p, v, __ATOMIC_RELAXED, __HIP_MEMORY_SCOPE_AGENT); }
DEV unsigned xb_xcc_id() { return (unsigned)__builtin_amdgcn_s_getreg((3 << 11) | 20) & 0xFu; }
#define XB_SPIN(cond, bar) do { unsigned _sp = 0; while (cond) { __builtin_amdgcn_s_sleep(1); \
    if ((++_sp & 255u) == 0u) { if (xb_ld(&(bar)[XB_TMO])) break; if (_sp > XB_SPIN_CAP) { atomicAdd(&(bar)[XB_TMO], 1u); break; } } } } while (0)
struct XcdBarrier { unsigned* bar; unsigned x; volatile LAS unsigned* st; };
DEV XcdBarrier xcd_barrier_post(unsigned* bar, volatile LAS unsigned* st) {
    XcdBarrier b; b.bar = bar; b.x = xb_xcc_id(); b.st = st;
    if (threadIdx.x == 0) st[2] = xb_add(&bar[XB_XCNT(b.x)], 1u);
    return b;
}
DEV void xcd_barrier_complete(unsigned* bar, unsigned x, unsigned& nloc, unsigned& nx) {
    const unsigned G = gridDim.x * gridDim.y * gridDim.z;
    unsigned sum, cnt, mine, sp = 0u;
    for (;;) {
        sum = 0u; cnt = 0u; mine = 0u;
#pragma unroll
        for (unsigned j = 0; j < 16; ++j) { const unsigned c = xb_ld(&bar[XB_XCNT(j)]); sum += c; cnt += (c > 0u) ? 1u : 0u; mine = (j == x) ? c : mine; }
        if (sum == G) break;
        __builtin_amdgcn_s_sleep(1);
        if ((++sp & 255u) == 0u) { if (xb_ld(&bar[XB_TMO])) break; if (sp > XB_SPIN_CAP) { atomicAdd(&bar[XB_TMO], 1u); break; } }
    }
    nloc = mine > 0u ? mine : 1u; nx = cnt > 0u ? cnt : 1u;
}
DEV void xcd_barrier(const XcdBarrier& b) {
    asm volatile("s_waitcnt vmcnt(0)" ::: "memory");
    __syncthreads();
    if (threadIdx.x == 0) {
        unsigned* bar = b.bar;
        asm volatile("" : "+v"(bar));
        __builtin_amdgcn_s_waitcnt(0);
        unsigned nloc = b.st[0], nx = b.st[1];
        if (nloc == 0u) { xcd_barrier_complete(bar, b.x, nloc, nx); b.st[0] = nloc; b.st[1] = nx; }
        const unsigned old = xb_add(&bar[XB_XSUB(b.x)], 1u);
        const unsigned gen = old / nloc;
        if (old + 1u == (gen + 1u) * nloc) {
            __builtin_amdgcn_fence(__ATOMIC_RELEASE, "agent");
            asm volatile("s_waitcnt vmcnt(0)" ::: "memory");
            const unsigned og = xb_add(&bar[XB_TOP], 1u);
            const unsigned tg = og / nx;
            if (og + 1u == (tg + 1u) * nx) xb_add(&bar[XB_TOPGEN], 1u);
            else XB_SPIN(xb_ld(&bar[XB_TOPGEN]) == tg, bar);
            __builtin_amdgcn_fence(__ATOMIC_ACQUIRE, "agent");
            xb_add(&bar[XB_XGEN(b.x)], 1u);
            asm volatile("s_waitcnt vmcnt(0)" ::: "memory");
        } else {
            XB_SPIN(xb_ld(&bar[XB_XGEN(b.x)]) == gen, bar);
            __builtin_amdgcn_fence(__ATOMIC_ACQUIRE, "agent");
            asm volatile("s_waitcnt vmcnt(0)" ::: "memory");
        }
    }
    __syncthreads();
}

DEV unsigned fkey(float f) { const unsigned u = __float_as_uint(f); return (u & 0x80000000u) ? ~u : (u | 0x80000000u); }
DEV float funkey(unsigned k) { return __uint_as_float((k & 0x80000000u) ? (k & 0x7fffffffu) : ~k); }
DEV void ins16(unsigned (&L)[16], unsigned x) {
#pragma unroll
    for (int i = 0; i < 16; ++i) { const unsigned hi = L[i] > x ? L[i] : x; x = L[i] > x ? x : L[i]; L[i] = hi; }
}
DEV void phase_topk(const Params& p, char* smem) {
    const int tid = ltid();
    const float* S1 = (const float*)(p.ws + OFF_S1);
    const float* S2 = (const float*)(p.ws + OFF_S2);
    int* eid = (int*)(p.ws + OFF_EID);
    float* gate = (float*)(p.ws + OFF_GATE);
    unsigned char* ib = (unsigned char*)smem + tid * 32;
    for (int blk = blockIdx.x; blk < kT * 8 / 256; blk += gridDim.x) {
        const size_t row = (size_t)blk * 256 + tid;
        unsigned L1[16], L2[16];
#pragma unroll
        for (int i = 0; i < 16; ++i) { L1[i] = 0u; L2[i] = 0u; }
#pragma unroll 4
        for (int k = 0; k < 128; ++k) {
            const float a = S1[(size_t)k * (kT * 8) + row], b = S2[(size_t)k * (kT * 8) + row];
            ins16(L1, (fkey(a) & ~127u) | (unsigned)(127 - k));
            ins16(L2, (fkey(b) & ~127u) | (unsigned)(127 - k));
        }
        float v1[16], v2[16];
        __syncthreads();
#pragma unroll
        for (int i = 0; i < 16; ++i) {
            v1[i] = funkey(L1[i] & ~127u); v2[i] = funkey(L2[i] & ~127u);
            ib[i] = (unsigned char)(127u - (L1[i] & 127u)); ib[16 + i] = (unsigned char)(127u - (L2[i] & 127u));
        }
        unsigned C[16];
#pragma unroll
        for (int i = 0; i < 16; ++i) C[i] = 0u;
#pragma unroll
        for (int a = 0; a < 16; ++a)
#pragma unroll
            for (int b = 0; b < 16; ++b)
                if ((a + 1) * (b + 1) <= 16) ins16(C, (fkey(v1[a] + v2[b]) & ~255u) | (unsigned)(255 - (a * 16 + b)));
        float ts[16]; float sum = 0.f;
        const float tmax = funkey(C[0] & ~255u);
#pragma unroll
        for (int i = 0; i < 16; ++i) { ts[i] = __expf(funkey(C[i] & ~255u) - tmax); sum += ts[i]; }
        const float inv = 1.f / sum;
        int ev[16];
#pragma unroll
        for (int i = 0; i < 16; ++i) { const unsigned ci = 255u - (C[i] & 255u); ev[i] = (int)ib[ci >> 4] * 128 + (int)ib[16 + (ci & 15u)]; }
#pragma unroll
        for (int i = 0; i < 4; ++i) {
            *(int4*)(eid + row * 16 + 4 * i) = make_int4(ev[4 * i], ev[4 * i + 1], ev[4 * i + 2], ev[4 * i + 3]);
            *(float4*)(gate + row * 16 + 4 * i) = make_float4(ts[4 * i] * inv, ts[4 * i + 1] * inv, ts[4 * i + 2] * inv, ts[4 * i + 3] * inv);
        }
    }
}

DEV float row_sum_dpp(float v) {
    v += __int_as_float(__builtin_amdgcn_update_dpp(0, __float_as_int(v), 0xB1, 0xF, 0xF, true));
    v += __int_as_float(__builtin_amdgcn_update_dpp(0, __float_as_int(v), 0x4E, 0xF, 0xF, true));
    v += __int_as_float(__builtin_amdgcn_update_dpp(0, __float_as_int(v), 0x141, 0xF, 0xF, true));
    v += __int_as_float(__builtin_amdgcn_update_dpp(0, __float_as_int(v), 0x140, 0xF, 0xF, true));
    return v;
}
DEV float wave_sum_dpp(float v) {
    v = row_sum_dpp(v);
    const float r0 = __int_as_float(__builtin_amdgcn_readlane(__float_as_int(v), 0)), r1 = __int_as_float(__builtin_amdgcn_readlane(__float_as_int(v), 16));
    const float r2 = __int_as_float(__builtin_amdgcn_readlane(__float_as_int(v), 32)), r3 = __int_as_float(__builtin_amdgcn_readlane(__float_as_int(v), 48));
    return (r0 + r1) + (r2 + r3);
}
typedef float f32x2 __attribute__((ext_vector_type(2)));
typedef float f32x4 __attribute__((ext_vector_type(4)));

struct SliceMap { int virt, nx, nloc, rank; };
DEV SliceMap slice_map(const Params& p, char* smem) {
    unsigned* bar = (unsigned*)p.ws;
    const unsigned x = xb_xcc_id();
    int virt = 0, nx = 0, nloc = 1;
#pragma unroll
    for (unsigned j = 0; j < 16; ++j) {
        const unsigned c = xb_ld(&bar[XB_XCNT(j)]);
        if (c > 0u) { if (j < x) ++virt; ++nx; }
        if (j == x) nloc = (int)c;
    }
    SliceMap m;
    m.virt = __builtin_amdgcn_readfirstlane(virt); m.nx = __builtin_amdgcn_readfirstlane(nx > 0 ? nx : 1); m.nloc = __builtin_amdgcn_readfirstlane(nloc > 0 ? nloc : 1);
    m.rank = __builtin_amdgcn_readfirstlane((int)((volatile LAS unsigned*)(smem + SM_SEL + 768))[2]);
    return m;
}

#ifndef UVAR
#define UVAR 0
#endif
typedef _Float16 half2_t __attribute__((ext_vector_type(2)));
DEV void phase_peer_u(const Params& p, int layer, char* smem, int rep = 0) {
    const int tid = ltid(), lane = tid & 63, w = tid >> 6, n16 = lane & 15, kg = lane >> 4;
    char* ws = p.ws;
    const SliceMap sm = slice_map(p, smem);
    const unsigned char* h8 = (const unsigned char*)(ws + OFF_H8);
    const int* eid = (const int*)(ws + OFF_EID);
    float* part = (float*)(ws + OFF_S1) + (rep ? (size_t)8 * kT * 128 : 0);
    int* ids_l = (int*)(smem + w * 9216);
    unsigned char* h8_l = (unsigned char*)(smem + w * 9216 + 4096);
    const int nk = sm.rank < 512 ? (512 - sm.rank + sm.nloc - 1) / sm.nloc : 0;
    for (int s = sm.virt; s < 8; s += sm.nx) {
        if (nk == 0) break;
        const unsigned char* U = (const unsigned char*)(ws + OFF_PU) + (((size_t)layer * 8 + s) * 16384 << 7) + kg * 32;
        uint4 ri0, ri1, ri2, ri3, rh;
        auto load_oct = [&](int k) {
            const size_t o = (size_t)(sm.rank + k * sm.nloc) * 4 + w;
            const uint4* ip = (const uint4*)(eid + o * 1024) + lane;
            ri0 = ip[0]; ri1 = ip[64]; ri2 = ip[128]; ri3 = ip[192];
            rh = *(const uint4*)(h8 + (o * 8 + (lane >> 3)) * 1024 + s * 128 + (lane & 7) * 16);
        };
        auto store_oct = [&]() {
            uint4* il = (uint4*)ids_l + lane;
            il[0] = ri0; il[64] = ri1; il[128] = ri2; il[192] = ri3;
            *(uint4*)(h8_l + lane * 16) = rh;
        };
        load_oct(0); store_oct();
#pragma unroll 1
        for (int k = 0; k < nk; ++k) {
            if (k + 1 < nk) load_oct(k + 1);
            const size_t o = (size_t)(sm.rank + k * sm.nloc) * 4 + w;
            float* pp = part + ((size_t)s * kT + o * 8) * 128 + lane;
            uint4 ga0[8], ga1[8], gb0[8], gb1[8];
            auto issue = [&](uint4 (&g0)[8], uint4 (&g1)[8], int tk) {
#pragma unroll
                for (int bb = 0; bb < 8; ++bb) {
                    const int e = ids_l[tk * 128 + bb * 16 + n16];
                    const unsigned char* rowp = U + ((size_t)e << 7);
                    g0[bb] = *(const uint4*)rowp; g1[bb] = *(const uint4*)(rowp + 16);
                }
            };
            auto compute = [&](const uint4 (&g0)[8], const uint4 (&g1)[8], int tk) {
                const uint4 a0 = *(const uint4*)(h8_l + tk * 128 + kg * 32), a1 = *(const uint4*)(h8_l + tk * 128 + kg * 32 + 16);
                float r[8];
#pragma unroll
                for (int bb = 0; bb < 8; ++bb) {
                    f32x4 acc = {0.f, 0.f, 0.f, 0.f};
                    acc = __builtin_amdgcn_mfma_f32_16x16x32_fp8_fp8((long)(((unsigned long long)a0.y << 32) | a0.x), (long)(((unsigned long long)g0[bb].y << 32) | g0[bb].x), acc, 0, 0, 0);
                    acc = __builtin_amdgcn_mfma_f32_16x16x32_fp8_fp8((long)(((unsigned long long)a0.w << 32) | a0.z), (long)(((unsigned long long)g0[bb].w << 32) | g0[bb].z), acc, 0, 0, 0);
                    acc = __builtin_amdgcn_mfma_f32_16x16x32_fp8_fp8((long)(((unsigned long long)a1.y << 32) | a1.x), (long)(((unsigned long long)g1[bb].y << 32) | g1[bb].x), acc, 0, 0, 0);
                    acc = __builtin_amdgcn_mfma_f32_16x16x32_fp8_fp8((long)(((unsigned long long)a1.w << 32) | a1.z), (long)(((unsigned long long)g1[bb].w << 32) | g1[bb].z), acc, 0, 0, 0);
                    r[bb] = acc[0];
                }
                const float v0 = kg == 0 ? r[0] : kg == 1 ? r[1] : kg == 2 ? r[2] : r[3];
                const float v1 = kg == 0 ? r[4] : kg == 1 ? r[5] : kg == 2 ? r[6] : r[7];
                pp[tk * 128] = v0; pp[tk * 128 + 64] = v1;
            };
            issue(ga0, ga1, 0);
#pragma unroll
            for (int tk = 0; tk < 8; tk += 2) {
                issue(gb0, gb1, tk + 1);
                compute(ga0, ga1, tk);
                if (tk + 2 < 8) issue(ga0, ga1, tk + 2);
                compute(gb0, gb1, tk + 1);
            }
            if (k + 1 < nk) store_oct();
        }
    }
}

DEV void phase_peer_comb(const Params& p, int rep = 0) {
    const int tid = ltid();
    const float* part = (const float*)(p.ws + OFF_S1);
    float* gate = (float*)(p.ws + OFF_GATE);
    for (size_t i = (size_t)blockIdx.x * 256 + tid; i < (size_t)kT * 128 / 4; i += (size_t)gridDim.x * 256) {
        float4 a = *(const float4*)(part + i * 4);
#pragma unroll
        for (int x = 1; x < 8; ++x) { const float4 b = *(const float4*)(part + (size_t)x * kT * 128 + i * 4); a.x += b.x; a.y += b.y; a.z += b.z; a.w += b.w; }
        const float4 g = *(const float4*)(gate + i * 4);
        float4 o;
        o.x = g.x * gelu_tanh(a.x * (1.f / kScaleU)); o.y = g.y * gelu_tanh(a.y * (1.f / kScaleU));
        o.z = g.z * gelu_tanh(a.z * (1.f / kScaleU)); o.w = g.w * gelu_tanh(a.w * (1.f / kScaleU));
        if (rep == 0) *(float4*)(gate + i * 4) = o;
    }
}

DEV void phase_peer_v(const Params& p, int layer, char* smem, int rep = 0) {
    const int tid = ltid(), lane = tid & 63, w = tid >> 6, l8 = lane & 7, grp = lane >> 3;
    char* ws = p.ws;
    const SliceMap sm = slice_map(p, smem);
    float* xres = (float*)(ws + OFF_XRES);
    const int* eid = (const int*)(ws + OFF_EID);
    const float* wbuf = (const float*)(ws + OFF_GATE);
    const float* mod = (const float*)(ws + OFF_MOD);
    int* ids_l = (int*)(smem + w * 9216);
    float* w_l = (float*)(smem + w * 9216 + 4096);
    const int nk = sm.rank < 512 ? (512 - sm.rank + sm.nloc - 1) / sm.nloc : 0;
    for (int s = sm.virt; s < 8; s += sm.nx) {
        if (nk == 0) break;
        const unsigned char* V = (const unsigned char*)(ws + OFF_PV) + (((size_t)layer * 8 + s) * 16384 << 7) + l8 * 16;
        uint4 ri0, ri1, ri2, ri3, rw0, rw1, rw2, rw3;
        auto load_oct = [&](int k) {
            const size_t o = (size_t)(sm.rank + k * sm.nloc) * 4 + w;
            const uint4* ip = (const uint4*)(eid + o * 1024) + lane;
            const uint4* wp = (const uint4*)(wbuf + o * 1024) + lane;
            ri0 = ip[0]; ri1 = ip[64]; ri2 = ip[128]; ri3 = ip[192];
            rw0 = wp[0]; rw1 = wp[64]; rw2 = wp[128]; rw3 = wp[192];
        };
        auto store_oct = [&]() {
            uint4* il = (uint4*)ids_l + lane; uint4* wl = (uint4*)w_l + lane;
            il[0] = ri0; il[64] = ri1; il[128] = ri2; il[192] = ri3;
            wl[0] = rw0; wl[64] = rw1; wl[128] = rw2; wl[192] = rw3;
        };
        load_oct(0); store_oct();
#pragma unroll 1
        for (int k = 0; k < nk; ++k) {
            if (k + 1 < nk) load_oct(k + 1);
            const size_t o = (size_t)(sm.rank + k * sm.nloc) * 4 + w;
            const size_t t = o * 8 + grp;
            const int b = (int)(t >> 11);
            float* xp = xres + t * 1024 + s * 128 + l8 * 16;
            const float* g2 = mod + (size_t)(layer * 8 + b) * 6144 + 5120 + s * 128 + l8 * 16;
            float4 xa[4];
#pragma unroll
            for (int c = 0; c < 4; ++c) xa[c] = *(const float4*)(xp + c * 4);
            half2_t out[8];
#pragma unroll
            for (int j = 0; j < 8; ++j) out[j] = (half2_t){(_Float16)0.f, (_Float16)0.f};
            uint4 va[8], vb[8];
            auto issue = [&](uint4 (&v)[8], int c) {
                const int4 i0 = *(const int4*)(ids_l + grp * 128 + c * 8), i1 = *(const int4*)(ids_l + grp * 128 + c * 8 + 4);
                const int e[8] = {i0.x, i0.y, i0.z, i0.w, i1.x, i1.y, i1.z, i1.w};
#pragma unroll
                for (int j = 0; j < 8; ++j) v[j] = *(const uint4*)(V + ((size_t)e[j] << 7));
            };
            auto compute = [&](const uint4 (&v)[8], int c) {
                const float4 w0 = *(const float4*)(w_l + grp * 128 + c * 8), w1 = *(const float4*)(w_l + grp * 128 + c * 8 + 4);
                const float wf[8] = {w0.x, w0.y, w0.z, w0.w, w1.x, w1.y, w1.z, w1.w};
#pragma unroll
                for (int j = 0; j < 8; ++j) {
                    const _Float16 wh = (_Float16)wf[j];
                    const half2_t ww = {wh, wh};
                    const unsigned d[4] = {v[j].x, v[j].y, v[j].z, v[j].w};
#pragma unroll
                    for (int q = 0; q < 4; ++q) {
                        const half2_t lo = __builtin_amdgcn_cvt_scalef32_pk_f16_fp8(d[q], 1.0f, false);
                        const half2_t hi = __builtin_amdgcn_cvt_scalef32_pk_f16_fp8(d[q], 1.0f, true);
                        out[2 * q] = __builtin_elementwise_fma(ww, lo, out[2 * q]);
                        out[2 * q + 1] = __builtin_elementwise_fma(ww, hi, out[2 * q + 1]);
                    }
                }
            };
            issue(va, 0);
#pragma unroll
            for (int c = 0; c < 16; c += 2) {
                issue(vb, c + 1);
                compute(va, c);
                if (c + 2 < 16) issue(va, c + 2);
                compute(vb, c + 1);
            }
            if (rep == 0 || (float)out[0].x == 12345.678f) {
#pragma unroll
                for (int c = 0; c < 4; ++c) {
                    const float4 g4 = *(const float4*)(g2 + c * 4);
                    xa[c].x += g4.x * (float)out[2 * c].x * (1.f / kScaleV); xa[c].y += g4.y * (float)out[2 * c].y * (1.f / kScaleV);
                    xa[c].z += g4.z * (float)out[2 * c + 1].x * (1.f / kScaleV); xa[c].w += g4.w * (float)out[2 * c + 1].y * (1.f / kScaleV);
                    *(float4*)(xp + c * 4) = xa[c];
                }
            }
            if (k + 1 < nk) store_oct();
        }
    }
}

DEV void phase_final(const Params& p) {
    const int tid = ltid(), lane = tid & 63, w = tid >> 6;
    const float* xs = (const float*)(p.ws + OFF_XRES);
    for (int q = blockIdx.x; q < kT / 4; q += gridDim.x) {
        const int t = q * 4 + w;
        const float* xr = xs + (size_t)t * 1024;
        float4 v[4]; float ss = 0.f;
#pragma unroll
        for (int i = 0; i < 4; ++i) { v[i] = *(const float4*)(xr + i * 256 + lane * 4); ss += v[i].x * v[i].x + v[i].y * v[i].y + v[i].z * v[i].z + v[i].w * v[i].w; }
        ss = wave_sum(ss);
        const float rstd = rsqrtf(ss * (1.f / 1024.f) + kEps);
#pragma unroll
        for (int i = 0; i < 4; ++i) {
            const int col = i * 256 + lane * 4;
            const float4 g4 = *(const float4*)(p.final_g + col);
            *(float4*)(p.out + (size_t)t * 1024 + col) = make_float4(v[i].x * rstd * g4.x, v[i].y * rstd * g4.y, v[i].z * rstd * g4.z, v[i].w * rstd * g4.w);
        }
    }
}

DEV void phase_gemm_in(const Params& p, int layer, char* smem) {
    char* ws = p.ws;
    EpiBf16 epi{(bf16_t*)(ws + OFF_COLS), LDC, nullptr, nullptr, LDC};
    gemm_phase((const bf16_t*)(ws + OFF_H), 1024, (const bf16_t*)(ws + OFF_WIN) + (size_t)layer * 2432 * 1024, 1024, 1024, kT / 128, LDC / 128, smem, epi);
}
DEV void phase_gemm_mid(const Params& p, int layer, char* smem) {
    char* ws = p.ws;
    const float* misc = (const float*)(ws + OFF_MISC);
    const float* rstd = (const float*)(ws + OFF_RSTD);
    const bf16_t* cols = (const bf16_t*)(ws + OFF_COLS);
    for (int tile = blockIdx.x; tile < 16 + 384 + 512; tile += gridDim.x) {
        if (tile < 8) {
            EpiBf16 epi{(bf16_t*)(ws + OFF_KCMP), 64, nullptr, misc + (layer * 2 + 0) * 64, 64};
            gemm_tile((const bf16_t*)(ws + OFF_KC), 1024, (const bf16_t*)(ws + OFF_WCK) + (size_t)layer * 128 * 2048, 2048, 2048, tile * 128, 0, smem, epi);
        } else if (tile < 16) {
            EpiBf16 epi{(bf16_t*)(ws + OFF_KCMP) + 1024 * 64, 64, nullptr, misc + (layer * 2 + 1) * 64, 64};
            gemm_tile((const bf16_t*)(ws + OFF_VC), 1024, (const bf16_t*)(ws + OFF_WCV) + (size_t)layer * 128 * 2048, 2048, 2048, (tile - 8) * 128, 0, smem, epi);
        } else if (tile < 16 + 384) {
            const int tt = tile - 16;
            EpiBf16 epi{(bf16_t*)(ws + OFF_QMLA), 384, rstd, nullptr, 384};
            gemm_tile(cols + 1472, LDC, (const bf16_t*)(ws + OFF_WUQ) + (size_t)layer * 384 * 256, 256, 256, (tt / 3) * 128, (tt % 3) * 128, smem, epi);
        } else {
            const int tt = tile - 16 - 384;
            EpiBf16 epi{(bf16_t*)(ws + OFF_KVMLA), 512, rstd + kT, nullptr, 512};
            gemm_tile(cols + 1728, LDC, (const bf16_t*)(ws + OFF_WUKV) + (size_t)layer * 512 * 128, 128, 128, (tt / 4) * 128, (tt % 4) * 128, smem, epi);
        }
    }
}
DEV void phase_gemm_out(const Params& p, int layer, char* smem) {
    char* ws = p.ws;
    EpiRes epi{layer == 0 ? p.x : (const float*)(ws + OFF_XRES), (float*)(ws + OFF_XRES), (const float*)(ws + OFF_MOD) + (size_t)layer * 8 * 6144 + 2048};
    gemm_phase((const bf16_t*)(ws + OFF_O), 1024, (const bf16_t*)(ws + OFF_WOUT) + (size_t)layer * 1024 * 1024, 1024, 1024, kT / 128, 8, smem, epi);
}
DEV void phase_gemm_wq(const Params& p, int layer, char* smem) {
    char* ws = p.ws;
    EpiBf16 epi{(bf16_t*)(ws + OFF_QP), 2048, nullptr, nullptr, 2048};
    gemm_phase((const bf16_t*)(ws + OFF_H), 1024, (const bf16_t*)(ws + OFF_WQ) + (size_t)layer * 2048 * 1024, 1024, 1024, kT / 128, 16, smem, epi);
}
DEV void phase_scores(const Params& p, int layer, char* smem) {
    char* ws = p.ws;
    for (int tile = blockIdx.x; tile < 2048; tile += gridDim.x) {
        const int c = tile >> 10, nt = tile & 1023;
        EpiF32 epi{(float*)(ws + (c ? OFF_S2 : OFF_S1)), kT * 8};
        gemm_tile((const bf16_t*)(ws + OFF_SUBK) + (size_t)(layer * 2 + c) * 16384, 128, (const bf16_t*)(ws + OFF_QP) + c * 128, 256, 128, 0, nt * 128, smem, epi);
    }
}

constexpr int NPHASE = 16;
DEV void run_phase(const Params& p, int ph, int layer, char* smem, int rep = 0) {
    switch (ph) {
        case 0: phase_prologue(p, smem); break;
        case 1: phase_norm(p, layer, 0); break;
        case 2: phase_gemm_in(p, layer, smem); break;
        case 3: phase_layout1(p, smem); break;
        case 4: phase_gemm_mid(p, layer, smem); break;
        case 5: phase_layout2(p, smem); break;
        case 6: phase_attn(p, layer, smem, rep); break;
        case 7: phase_gemm_out(p, layer, smem); break;
        case 8: phase_norm(p, layer, 1); break;
        case 9: phase_gemm_wq(p, layer, smem); break;
        case 10: phase_scores(p, layer, smem); break;
        case 11: phase_topk(p, smem); break;
        case 12: phase_peer_u(p, layer, smem, rep); break;
        case 13: phase_peer_comb(p, rep); break;
        case 14: phase_peer_v(p, layer, smem, rep); break;
        case 15: if (layer == 0) phase_norm(p, 1, 0); else phase_final(p); break;
        default: break;
    }
}

#if !FUSED
template <int PH>
__global__ void __launch_bounds__(256, 2) k_phase(Params p, int layer) {
    __shared__ __attribute__((aligned(16))) char smem[SM_TOTAL];
    run_phase(p, PH, layer, smem);
}
template <int PH> static void launch_phase(const Params& p, int layer, hipStream_t stream) { k_phase<PH><<<512, 256, 0, stream>>>(p, layer); }
static void launch_ph(int ph, const Params& p, int layer, hipStream_t stream) {
    switch (ph) {
        case 0: launch_phase<0>(p, layer, stream); break;
        case 1: launch_phase<1>(p, layer, stream); break;
        case 2: launch_phase<2>(p, layer, stream); break;
        case 3: launch_phase<3>(p, layer, stream); break;
        case 4: launch_phase<4>(p, layer, stream); break;
        case 5: launch_phase<5>(p, layer, stream); break;
        case 6: launch_phase<6>(p, layer, stream); break;
        case 7: launch_phase<7>(p, layer, stream); break;
        case 8: launch_phase<8>(p, layer, stream); break;
        case 9: launch_phase<9>(p, layer, stream); break;
        case 10: launch_phase<10>(p, layer, stream); break;
        case 11: launch_phase<11>(p, layer, stream); break;
        case 12: launch_phase<12>(p, layer, stream); break;
    }
}
#else
__global__ void __launch_bounds__(256, 2) k_mega(Params p) {
    __shared__ __attribute__((aligned(16))) char smem[SM_TOTAL];
    cg::grid_group grid = cg::this_grid();
    volatile LAS unsigned* st = (volatile LAS unsigned*)(smem + SM_SEL + 768);
    if (threadIdx.x == 0) { st[0] = 0u; st[1] = 0u; st[2] = 0u; }
    __syncthreads();
    const XcdBarrier xb = xcd_barrier_post((unsigned*)p.ws, st);
    run_phase(p, 0, 0, smem);
    grid.sync();
    run_phase(p, 1, 0, smem);
    xcd_barrier(xb);
#if PROBE_REP > 0
#define PROBE_STEP(PH, L) if ((PH) == PROBE_PH && (L) == PROBE_L) { _Pragma("unroll 1") for (int r = 1; r <= PROBE_REP; ++r) { xcd_barrier(xb); run_phase(p, PH, L, smem, r); } }
#else
#define PROBE_STEP(PH, L)
#endif
#define STEP(PH, L) run_phase(p, PH, L, smem); PROBE_STEP(PH, L) xcd_barrier(xb);
#define LAYER(L) STEP(2, L) STEP(3, L) STEP(4, L) STEP(5, L) STEP(6, L) STEP(7, L) STEP(8, L) STEP(9, L) STEP(10, L) STEP(11, L) STEP(12, L) STEP(13, L) STEP(14, L)
    LAYER(0)
    STEP(15, 0)
    LAYER(1)
    run_phase(p, 15, 1, smem);
}
#endif

extern "C" void kernel_launch(void* const* d_in, const int* in_sizes, int n_in, void* d_out, int out_size, void* d_ws, size_t ws_size, hipStream_t stream) {
    Params p{};
    const float** pp = (const float**)&p;
    for (int i = 0; i < 28; ++i) pp[i] = (const float*)d_in[i];
    p.out = (float*)d_out;
    p.ws = (char*)d_ws;
    if (ws_size < OFF_END) fprintf(stderr, "workspace too small: %zu < %zu\n", ws_size, (size_t)OFF_END);
    (void)hipMemsetAsync(d_ws, 0, 65536, stream);
#if !FUSED
    launch_ph(0, p, 0, stream);
    launch_ph(1, p, 0, stream);
    for (int l = 0; l < 2; ++l)
        for (int ph = 2; ph < NPHASE; ++ph) launch_ph(ph, p, l, stream);
#else
    static int grid_blocks = 0;
    if (!grid_blocks) {
        int dev = 0, cus = 0, per_cu = 0;
        (void)hipGetDevice(&dev);
        (void)hipDeviceGetAttribute(&cus, hipDeviceAttributeMultiprocessorCount, dev);
        (void)hipOccupancyMaxActiveBlocksPerMultiprocessor(&per_cu, (const void*)k_mega, 256, 0);
        if (per_cu > 2) per_cu = 2;
        if (per_cu < 1) per_cu = 1;
        grid_blocks = cus * per_cu;
    }
    void* args[] = {&p};
    hipError_t e = hipLaunchCooperativeKernel((const void*)k_mega, dim3(grid_blocks), dim3(256), args, 0, stream);
    if (e != hipSuccess) fprintf(stderr, "cooperative launch failed: %s (grid %d)\n", hipGetErrorString(e), grid_blocks);
#endif
}
```

```cpp
#include <hip/hip_runtime.h>
#include <hip/hip_cooperative_groups.h>
#include <stdint.h>
#include <stdio.h>
namespace cg = cooperative_groups;

#ifndef FUSED
#define FUSED 1
#endif
#ifndef TS_A
#define TS_A -1
#define TS_B -1
#endif
#ifndef PROBE_PH
#define PROBE_PH -1
#define PROBE_L 1
#define PROBE_REP 0
#endif

#define DEV __device__ __forceinline__
#define LAS __attribute__((address_space(3)))
typedef unsigned short bf16_t;
typedef short bf16x8 __attribute__((ext_vector_type(8)));
typedef float f32x16 __attribute__((ext_vector_type(16)));

constexpr int kB = 8, kS = 2048, kT = kB * kS, kD = 1024, LDC = 2432;
constexpr float kEps = 1e-6f;
constexpr float kNeg = -1e30f;
constexpr float kLog2e = 1.4426950408889634f;
constexpr float kScaleU = 256.f, kScaleV = 32.f;

constexpr size_t OFF_CTRL = 0;
constexpr size_t OFF_MOD  = 65536;
constexpr size_t OFF_ROPE = OFF_MOD + 2ull * 8 * 6144 * 4;
constexpr size_t OFF_MISC = OFF_ROPE + 2048ull * 96 * 4;
constexpr size_t OFF_WIN  = OFF_MISC + 4096;
constexpr size_t OFF_WOUT = OFF_WIN + 2ull * 2432 * 1024 * 2;
constexpr size_t OFF_WQ   = OFF_WOUT + 2ull * 1024 * 1024 * 2;
constexpr size_t OFF_WUQ  = OFF_WQ + 2ull * 2048 * 1024 * 2;
constexpr size_t OFF_WUKV = OFF_WUQ + 2ull * 384 * 256 * 2;
constexpr size_t OFF_WCK  = OFF_WUKV + 2ull * 512 * 128 * 2;
constexpr size_t OFF_WCV  = OFF_WCK + 2ull * 128 * 2048 * 2;
constexpr size_t OFF_SUBK = OFF_WCV + 2ull * 128 * 2048 * 2;
constexpr size_t OFF_PU   = OFF_SUBK + 2ull * 2 * 128 * 128 * 2;
constexpr size_t OFF_PV   = OFF_PU + 2ull * 16384 * 1024;
constexpr size_t OFF_XRES = OFF_PV + 2ull * 16384 * 1024;
constexpr size_t OFF_H    = OFF_XRES + (size_t)kT * 1024 * 4;
constexpr size_t OFF_H8   = OFF_H + (size_t)kT * 1024 * 2;
constexpr size_t OFF_RSTD = OFF_H8 + (size_t)kT * 1024;
constexpr size_t OFF_KCMP = OFF_RSTD + 2ull * kT * 4;
constexpr size_t OFF_EID  = OFF_KCMP + 2ull * 1024 * 64 * 2;
constexpr size_t OFF_GATE = OFF_EID + (size_t)kT * 128 * 4;
constexpr size_t OFF_QP   = OFF_GATE + (size_t)kT * 128 * 4;
constexpr size_t OFF_COLS = OFF_QP + (size_t)kT * 2048 * 2;
constexpr size_t OFF_KC   = OFF_COLS + (size_t)kT * LDC * 2;
constexpr size_t OFF_VC   = OFF_KC + (size_t)(kT + 64) * 64 * 2;
constexpr size_t OFF_VT   = OFF_VC + (size_t)(kT + 64) * 64 * 2;
constexpr size_t OFF_QMLA = OFF_VT + 8ull * 12 * 64 * 2048 * 2;
constexpr size_t OFF_KVMLA = OFF_QMLA + (size_t)kT * 384 * 2;
constexpr size_t OFF_O    = OFF_KVMLA + (size_t)kT * 512 * 2;
constexpr size_t OFF_END  = OFF_O + (size_t)kT * 1024 * 2;
constexpr size_t OFF_S1 = OFF_COLS, OFF_S2 = OFF_COLS + (size_t)kT * 8 * 128 * 4;
static_assert(OFF_S2 + (size_t)kT * 8 * 128 * 4 <= OFF_O, "alias region too small");
static_assert(OFF_END <= (512ull << 20), "workspace too large");

struct Params {
    const float *x, *c, *ada_w, *ada_b, *norm_mix_g, *norm_ffn_g, *w_in, *pos_k, *pos_v, *cmp_wk, *cmp_wv;
    const float *lq1, *lk1, *lq2, *lk2, *sub_g, *mla_qg, *mla_wuq, *mla_kvg, *mla_wukv, *sinks, *w_out;
    const float *w_q, *subk1, *subk2, *pu, *pv, *final_g;
    float* out;
    char* ws;
};

DEV int ltid() { int t = threadIdx.x; asm volatile("" : "+v"(t)); return t; }
DEV float bf2f(bf16_t v) { return __uint_as_float(((unsigned)v) << 16); }
DEV bf16_t f2bf(float f) { unsigned u = __float_as_uint(f); u += 0x7fffu + ((u >> 16) & 1u); return (bf16_t)(u >> 16); }
DEV unsigned pack2(float lo, float hi) { return (unsigned)f2bf(lo) | ((unsigned)f2bf(hi) << 16); }
DEV float lo16(unsigned u) { return __uint_as_float(u << 16); }
DEV float hi16(unsigned u) { return __uint_as_float(u & 0xffff0000u); }
DEV float wave_sum(float v) {
#pragma unroll
    for (int o = 32; o > 0; o >>= 1) v += __shfl_xor(v, o, 64);
    return v;
}
DEV float xor32f(float v, int lane) { return __int_as_float(__builtin_amdgcn_ds_bpermute((lane ^ 32) << 2, __float_as_int(v))); }
DEV float lanef(float v, int src) { return __int_as_float(__builtin_amdgcn_ds_bpermute(src << 2, __float_as_int(v))); }
DEV f32x16 mfma32(bf16x8 a, bf16x8 b, f32x16 c) { return __builtin_amdgcn_mfma_f32_32x32x16_bf16(a, b, c, 0, 0, 0); }
DEV f32x16 zero16() { f32x16 z;
#pragma unroll
    for (int i = 0; i < 16; ++i) z[i] = 0.f;
    return z; }
DEV float gelu_tanh(float x) {
    const float u = 0.7978845608028654f * (x + 0.044715f * x * x * x);
    const float e = __expf(2.f * u);
    const float t = 1.f - 2.f / (e + 1.f);
    return 0.5f * x * (1.f + t);
}

template <class Epi>
DEV void gemm_tile(const bf16_t* __restrict__ A, int lda, const bf16_t* __restrict__ Bt, int ldb, int K, int m0, int n0, char* smem, const Epi& epi) {
    const int tid = ltid(), lane = tid & 63, w = tid >> 6, wm = w >> 1, wn = w & 1, ql = lane & 31, hh = lane >> 5;
    f32x16 acc[2][2];
#pragma unroll
    for (int i = 0; i < 2; ++i)
#pragma unroll
        for (int j = 0; j < 2; ++j) acc[i][j] = zero16();
    const int srow = lane >> 3, spos = lane & 7;
    const int c0 = spos ^ ((srow >> 1) & 7), c1 = spos ^ ((4 + (srow >> 1)) & 7);
    const bf16_t* Ag0 = A + (size_t)(m0 + w * 32 + srow) * lda + c0 * 8;
    const bf16_t* Ag1 = A + (size_t)(m0 + w * 32 + 8 + srow) * lda + c1 * 8;
    const bf16_t* Bg0 = Bt + (size_t)(n0 + w * 32 + srow) * ldb + c0 * 8;
    const bf16_t* Bg1 = Bt + (size_t)(n0 + w * 32 + 8 + srow) * ldb + c1 * 8;
    const size_t a16 = (size_t)16 * lda, b16 = (size_t)16 * ldb;
    auto stage = [&](int kt, int buf) __attribute__((always_inline)) {
        char* sa = smem + buf * 32768 + w * 4096;
        char* sb = sa + 16384;
        const int ko = kt * 64;
        __builtin_amdgcn_global_load_lds((const unsigned*)(Ag0 + ko), (LAS unsigned*)(sa), 16, 0, 0);
        __builtin_amdgcn_global_load_lds((const unsigned*)(Ag1 + ko), (LAS unsigned*)(sa + 1024), 16, 0, 0);
        __builtin_amdgcn_global_load_lds((const unsigned*)(Ag0 + a16 + ko), (LAS unsigned*)(sa + 2048), 16, 0, 0);
        __builtin_amdgcn_global_load_lds((const unsigned*)(Ag1 + a16 + ko), (LAS unsigned*)(sa + 3072), 16, 0, 0);
        __builtin_amdgcn_global_load_lds((const unsigned*)(Bg0 + ko), (LAS unsigned*)(sb), 16, 0, 0);
        __builtin_amdgcn_global_load_lds((const unsigned*)(Bg1 + ko), (LAS unsigned*)(sb + 1024), 16, 0, 0);
        __builtin_amdgcn_global_load_lds((const unsigned*)(Bg0 + b16 + ko), (LAS unsigned*)(sb + 2048), 16, 0, 0);
        __builtin_amdgcn_global_load_lds((const unsigned*)(Bg1 + b16 + ko), (LAS unsigned*)(sb + 3072), 16, 0, 0);
    };
    const int key = (ql >> 1) & 7;
    const int arow = (wm * 64 + ql) * 128, brow = (wn * 64 + ql) * 128;
    const int nk = K >> 6;
    __syncthreads();
    stage(0, 0);
    for (int kt = 0; kt < nk; ++kt) {
        asm volatile("s_waitcnt vmcnt(0)" ::: "memory");
        __syncthreads();
        if (kt + 1 < nk) stage(kt + 1, (kt + 1) & 1);
        const char* As = smem + (kt & 1) * 32768;
        const char* Bs = As + 16384;
#pragma unroll
        for (int ks = 0; ks < 4; ++ks) {
            const int co = ((ks * 2 + hh) ^ key) << 4;
            bf16x8 a[2], b[2];
#pragma unroll
            for (int i = 0; i < 2; ++i) {
                a[i] = *(const bf16x8*)(As + arow + i * 4096 + co);
                b[i] = *(const bf16x8*)(Bs + brow + i * 4096 + co);
            }
#pragma unroll
            for (int i = 0; i < 2; ++i)
#pragma unroll
                for (int j = 0; j < 2; ++j) acc[i][j] = mfma32(a[i], b[j], acc[i][j]);
        }
    }
#pragma unroll
    for (int i = 0; i < 2; ++i)
#pragma unroll
        for (int j = 0; j < 2; ++j)
#pragma unroll
            for (int g = 0; g < 4; ++g) {
                const int m = m0 + wm * 64 + i * 32 + 8 * g + 4 * hh;
                const int n = n0 + wn * 64 + j * 32 + ql;
                epi(m, n, acc[i][j][4 * g], acc[i][j][4 * g + 1], acc[i][j][4 * g + 2], acc[i][j][4 * g + 3]);
            }
}

struct EpiBf16 {
    bf16_t* C; int ldc; const float* rowscale; const float* colbias; int nvalid;
    DEV void operator()(int m, int n, float v0, float v1, float v2, float v3) const {
        if (n >= nvalid) return;
        float bsv = colbias ? colbias[n] : 0.f;
        float s0 = 1.f, s1 = 1.f, s2 = 1.f, s3 = 1.f;
        if (rowscale) { s0 = rowscale[m]; s1 = rowscale[m + 1]; s2 = rowscale[m + 2]; s3 = rowscale[m + 3]; }
        bf16_t* p = C + (size_t)m * ldc + n;
        p[0] = f2bf(v0 * s0 + bsv); p[ldc] = f2bf(v1 * s1 + bsv); p[2 * ldc] = f2bf(v2 * s2 + bsv); p[3 * ldc] = f2bf(v3 * s3 + bsv);
    }
};
struct EpiF32 {
    float* C; int ldc;
    DEV void operator()(int m, int n, float v0, float v1, float v2, float v3) const {
        float* p = C + (size_t)m * ldc + n;
        p[0] = v0; p[ldc] = v1; p[2 * ldc] = v2; p[3 * ldc] = v3;
    }
};
struct EpiRes {
    const float* xin; float* xout; const float* gate;
    DEV void operator()(int m, int n, float v0, float v1, float v2, float v3) const {
        const float g = gate[(size_t)(m >> 11) * 6144 + n];
        const float* pi = xin + (size_t)m * 1024 + n; float* po = xout + (size_t)m * 1024 + n;
        po[0] = pi[0] + g * v0; po[1024] = pi[1024] + g * v1; po[2048] = pi[2048] + g * v2; po[3072] = pi[3072] + g * v3;
    }
};

template <class Epi>
DEV void gemm_phase(const bf16_t* A, int lda, const bf16_t* Bt, int ldb, int K, int mtiles, int ntiles, char* smem, const Epi& epi) {
    for (int tile = blockIdx.x; tile < mtiles * ntiles; tile += gridDim.x) {
        const int mt = tile / ntiles, nt = tile % ntiles;
        gemm_tile(A, lda, Bt, ldb, K, mt * 128, nt * 128, smem, epi);
    }
}

DEV int win_srccol(int n) {
    if (n < 652) return n;
    if (n < 704) return -1;
    if (n < 1888) return n - 52;
    if (n < 1920) return -1;
    return n - 84;
}
DEV void transpose_tile(const float* __restrict__ src, int ld_src, int nsrc_valid, int mode, const float* __restrict__ rowscale,
                        bf16_t* __restrict__ dst, int K, int n0, int k0, char* smem) {
    bf16_t* Ls = (bf16_t*)smem;
    const int tid = ltid();
    __syncthreads();
    const int nn = tid & 63, n = n0 + nn;
    const int sc = (mode == 1) ? win_srccol(n) : (n < nsrc_valid ? n : -1);
#pragma unroll 4
    for (int i = 0; i < 16; ++i) {
        const int kk = (tid >> 6) + 4 * i;
        float v = 0.f;
        if (sc >= 0) { v = src[(size_t)(k0 + kk) * ld_src + sc]; if (rowscale) v *= rowscale[k0 + kk]; }
        Ls[nn * 72 + kk] = f2bf(v);
    }
    __syncthreads();
#pragma unroll
    for (int i = 0; i < 2; ++i) {
        const int r = (tid >> 3) + 32 * i, ch = tid & 7;
        *(uint4*)(dst + (size_t)(n0 + r) * K + k0 + ch * 8) = *(const uint4*)(Ls + r * 72 + ch * 8);
    }
}

DEV void convert_stream(const float* __restrict__ src, bf16_t* __restrict__ dst, size_t n8) {
    const int tid = ltid();
    for (size_t i = (size_t)blockIdx.x * 256 + tid; i < n8; i += (size_t)gridDim.x * 256) {
        const float4 a = *(const float4*)(src + i * 8), b = *(const float4*)(src + i * 8 + 4);
        uint4 o; o.x = pack2(a.x, a.y); o.y = pack2(a.z, a.w); o.z = pack2(b.x, b.y); o.w = pack2(b.z, b.w);
        *(uint4*)(dst + i * 8) = o;
    }
}

DEV void convert_fp8_stream(const float* __restrict__ src, unsigned char* __restrict__ dst, size_t n16, float scale) {
    const int tid = ltid();
    const size_t stride = (size_t)gridDim.x * 256;
    for (size_t i0 = (size_t)blockIdx.x * 256 + tid; i0 < n16; i0 += stride * 4) {
        float4 q[4][4];
#pragma unroll
        for (int u = 0; u < 4; ++u) {
            const size_t i = i0 + u * stride < n16 ? i0 + u * stride : i0;
#pragma unroll
            for (int c = 0; c < 4; ++c) q[u][c] = *(const float4*)(src + i * 16 + c * 4);
        }
#pragma unroll
        for (int u = 0; u < 4; ++u) {
            const size_t i = i0 + u * stride;
            if (i >= n16) break;
            unsigned o[4];
#pragma unroll
            for (int j = 0; j < 4; ++j) {
                const float4 v = q[u][j];
                unsigned w = 0u;
                w = __builtin_amdgcn_cvt_pk_fp8_f32(fminf(fmaxf(v.x * scale, -440.f), 440.f), fminf(fmaxf(v.y * scale, -440.f), 440.f), w, false);
                w = __builtin_amdgcn_cvt_pk_fp8_f32(fminf(fmaxf(v.z * scale, -440.f), 440.f), fminf(fmaxf(v.w * scale, -440.f), 440.f), w, true);
                o[j] = w;
            }
            const size_t rowg = i >> 6; const int c16 = (int)(i & 63);
            const size_t l = rowg >> 14, row = rowg & 16383;
            *(uint4*)(dst + (((l * 8 + (c16 >> 3)) * 16384 + row) << 7) + (c16 & 7) * 16) = make_uint4(o[0], o[1], o[2], o[3]);
        }
    }
}

constexpr int J_ROPE = 384, J_MOD = 192, J_MISC = 5;
constexpr int J_TW_L = 608 + 256 + 512 + 24 + 16 + 64 + 64;
constexpr int J_TOTAL = J_ROPE + J_MOD + J_MISC + 2 * J_TW_L;

DEV void prologue_job(const Params& p, int job, char* smem) {
    const int tid = ltid();
    char* ws = p.ws;
    if (job < J_ROPE) {
        const int idx = job * 256 + tid;
        const int s = idx / 48, j = idx % 48;
        float* rope = (float*)(ws + OFF_ROPE);
        float inv; float *pc, *ps;
        if (j < 32) { inv = exp2f(-(float)j * (13.287712379549449f / 32.f)); pc = rope + s * 32 + j; ps = rope + 2048 * 32 + s * 32 + j; }
        else { const int i = j - 32; inv = exp2f(-(float)i * (13.287712379549449f / 16.f)); pc = rope + 2048 * 64 + s * 16 + i; ps = rope + 2048 * 64 + 2048 * 16 + s * 16 + i; }
        const double a = (double)s * (double)inv;
        const double kk = rint(a * 0.15915494309189535);
        const float r = (float)fma(-kk, 6.283185307179586, a);
        *pc = cosf(r); *ps = sinf(r);
        return;
    }
    job -= J_ROPE;
    if (job < J_MOD) {
        const int l = job / 96, n0 = (job % 96) * 64;
        float* sc = (float*)smem;
        __syncthreads();
        for (int i = tid; i < 8192; i += 256) { const float v = p.c[i]; sc[i] = v / (1.f + __expf(-v)); }
        __syncthreads();
        const int kp = tid >> 6, col = tid & 63;
        float acc[8];
#pragma unroll
        for (int b = 0; b < 8; ++b) acc[b] = 0.f;
        const float* wp = p.ada_w + (size_t)l * 1024 * 6144 + n0 + col;
        for (int k = kp * 256; k < kp * 256 + 256; ++k) {
            const float wv = wp[(size_t)k * 6144];
#pragma unroll
            for (int b = 0; b < 8; ++b) acc[b] += sc[b * 1024 + k] * wv;
        }
        float* red = sc + 8192;
#pragma unroll
        for (int b = 0; b < 8; ++b) red[(kp * 8 + b) * 64 + col] = acc[b];
        __syncthreads();
        float* mod = (float*)(ws + OFF_MOD);
        for (int idx = tid; idx < 512; idx += 256) {
            const int b = idx >> 6, cl = idx & 63;
            const float v = red[(0 * 8 + b) * 64 + cl] + red[(1 * 8 + b) * 64 + cl] + red[(2 * 8 + b) * 64 + cl] + red[(3 * 8 + b) * 64 + cl];
            mod[(size_t)(l * 8 + b) * 6144 + n0 + cl] = v + p.ada_b[l * 6144 + n0 + cl];
        }
        return;
    }
    job -= J_MOD;
    if (job < J_MISC) {
        float* misc = (float*)(ws + OFF_MISC);
        if (job < 4) {
            const int l = job >> 1, kv = job & 1;
            const float* pos = (kv ? p.pos_v : p.pos_k) + l * 2048;
            const float* wsrc = (kv ? p.cmp_wv : p.cmp_wk) + (size_t)l * 2048 * 64;
            float* red = (float*)smem;
            __syncthreads();
            const int kp = tid >> 6, n = tid & 63;
            float acc = 0.f;
            for (int k = kp * 512; k < kp * 512 + 512; ++k) acc += pos[k] * wsrc[(size_t)k * 64 + n];
            red[kp * 64 + n] = acc;
            __syncthreads();
            if (tid < 64) misc[(l * 2 + kv) * 64 + tid] = red[tid] + red[64 + tid] + red[128 + tid] + red[192 + tid];
        } else if (tid < 2) {
            const int l = tid;
            float d1 = 0.f, d2 = 0.f;
            for (int i = 0; i < 32; ++i) { d1 += p.lq1[l * 32 + i] * p.lk1[l * 32 + i]; d2 += p.lq2[l * 32 + i] * p.lk2[l * 32 + i]; }
            const float lam_init = 0.8f - 0.6f * expf(-0.3f * (float)l);
            misc[256 + l] = expf(d1) - expf(d2) + lam_init;
            misc[258 + l] = 1.f - lam_init;
        }
        return;
    }
    job -= J_MISC;
    const int l = job / J_TW_L; int j = job % J_TW_L;
    if (j < 608) { transpose_tile(p.w_in + (size_t)l * 1024 * 2348, 2348, 2348, 1, nullptr, (bf16_t*)(ws + OFF_WIN) + (size_t)l * 2432 * 1024, 1024, (j / 16) * 64, (j % 16) * 64, smem); return; }
    j -= 608;
    if (j < 256) { transpose_tile(p.w_out + (size_t)l * 1024 * 1024, 1024, 1024, 0, nullptr, (bf16_t*)(ws + OFF_WOUT) + (size_t)l * 1024 * 1024, 1024, (j / 16) * 64, (j % 16) * 64, smem); return; }
    j -= 256;
    if (j < 512) { transpose_tile(p.w_q + (size_t)l * 1024 * 2048, 2048, 2048, 0, nullptr, (bf16_t*)(ws + OFF_WQ) + (size_t)l * 2048 * 1024, 1024, (j / 16) * 64, (j % 16) * 64, smem); return; }
    j -= 512;
    if (j < 24) { transpose_tile(p.mla_wuq + (size_t)l * 256 * 384, 384, 384, 0, p.mla_qg + l * 256, (bf16_t*)(ws + OFF_WUQ) + (size_t)l * 384 * 256, 256, (j / 4) * 64, (j % 4) * 64, smem); return; }
    j -= 24;
    if (j < 16) { transpose_tile(p.mla_wukv + (size_t)l * 128 * 512, 512, 512, 0, p.mla_kvg + l * 128, (bf16_t*)(ws + OFF_WUKV) + (size_t)l * 512 * 128, 128, (j / 2) * 64, (j % 2) * 64, smem); return; }
    j -= 16;
    if (j < 64) { transpose_tile(p.cmp_wk + (size_t)l * 2048 * 64, 64, 64, 0, nullptr, (bf16_t*)(ws + OFF_WCK) + (size_t)l * 128 * 2048, 2048, (j / 32) * 64, (j % 32) * 64, smem); return; }
    j -= 64;
    transpose_tile(p.cmp_wv + (size_t)l * 2048 * 64, 64, 64, 0, nullptr, (bf16_t*)(ws + OFF_WCV) + (size_t)l * 128 * 2048, 2048, (j / 32) * 64, (j % 32) * 64, smem);
}

DEV void phase_prologue(const Params& p, char* smem) {
    for (int job = blockIdx.x; job < J_TOTAL; job += gridDim.x) prologue_job(p, job, smem);
    char* ws = p.ws;
    convert_fp8_stream(p.pu, (unsigned char*)(ws + OFF_PU), 2ull * 16384 * 1024 / 16, kScaleU);
    convert_fp8_stream(p.pv, (unsigned char*)(ws + OFF_PV), 2ull * 16384 * 1024 / 16, kScaleV);
    for (int l = 0; l < 2; ++l) {
        convert_stream(p.subk1 + (size_t)l * 16384, (bf16_t*)(ws + OFF_SUBK) + (size_t)(l * 2 + 0) * 16384, 16384 / 8);
        convert_stream(p.subk2 + (size_t)l * 16384, (bf16_t*)(ws + OFF_SUBK) + (size_t)(l * 2 + 1) * 16384, 16384 / 8);
    }
}

DEV void phase_norm(const Params& p, int layer, int which) {
    const int tid = ltid(), lane = tid & 63, w = tid >> 6;
    const float* xs = (layer == 0 && which == 0) ? p.x : (const float*)(p.ws + OFF_XRES);
    const float* g = (which == 0 ? p.norm_mix_g : p.norm_ffn_g) + layer * 1024;
    const float* mod = (const float*)(p.ws + OFF_MOD) + (size_t)layer * 8 * 6144;
    bf16_t* h = (bf16_t*)(p.ws + OFF_H);
    for (int q = blockIdx.x; q < kT / 4; q += gridDim.x) {
        const int t = q * 4 + w, b = t >> 11;
        const float* xr = xs + (size_t)t * 1024;
        float4 v[4]; float ss = 0.f;
#pragma unroll
        for (int i = 0; i < 4; ++i) { v[i] = *(const float4*)(xr + i * 256 + lane * 4); ss += v[i].x * v[i].x + v[i].y * v[i].y + v[i].z * v[i].z + v[i].w * v[i].w; }
        ss = wave_sum(ss);
        const float rstd = rsqrtf(ss * (1.f / 1024.f) + kEps);
        const float* sh = mod + (size_t)b * 6144 + (which ? 3072 : 0);
        const float* sc = sh + 1024;
#pragma unroll
        for (int i = 0; i < 4; ++i) {
            const int col = i * 256 + lane * 4;
            const float4 g4 = *(const float4*)(g + col), s4 = *(const float4*)(sc + col), h4 = *(const float4*)(sh + col);
            const float o0 = v[i].x * rstd * g4.x * (1.f + s4.x) + h4.x, o1 = v[i].y * rstd * g4.y * (1.f + s4.y) + h4.y;
            const float o2 = v[i].z * rstd * g4.z * (1.f + s4.z) + h4.z, o3 = v[i].w * rstd * g4.w * (1.f + s4.w) + h4.w;
            uint2 o; o.x = pack2(o0, o1); o.y = pack2(o2, o3);
            *(uint2*)(h + (size_t)t * 1024 + col) = o;
            if (which) {
                unsigned w8 = 0u;
                w8 = __builtin_amdgcn_cvt_pk_fp8_f32(fminf(fmaxf(o0, -440.f), 440.f), fminf(fmaxf(o1, -440.f), 440.f), w8, false);
                w8 = __builtin_amdgcn_cvt_pk_fp8_f32(fminf(fmaxf(o2, -440.f), 440.f), fminf(fmaxf(o3, -440.f), 440.f), w8, true);
                *(unsigned*)((unsigned char*)(p.ws + OFF_H8) + (size_t)t * 1024 + col) = w8;
            }
        }
    }
}

DEV void rope8(uint4& x1, uint4& x2, const float* cs, const float* sn) {
    const float4 c0 = *(const float4*)cs, c1 = *(const float4*)(cs + 4), s0 = *(const float4*)sn, s1 = *(const float4*)(sn + 4);
    const float cc[8] = {c0.x, c0.y, c0.z, c0.w, c1.x, c1.y, c1.z, c1.w};
    const float ss[8] = {s0.x, s0.y, s0.z, s0.w, s1.x, s1.y, s1.z, s1.w};
    unsigned a[4] = {x1.x, x1.y, x1.z, x1.w}, b[4] = {x2.x, x2.y, x2.z, x2.w};
#pragma unroll
    for (int i = 0; i < 4; ++i) {
        const float a0 = lo16(a[i]), a1 = hi16(a[i]), b0 = lo16(b[i]), b1 = hi16(b[i]);
        const float o10 = a0 * cc[2 * i] - b0 * ss[2 * i], o11 = a1 * cc[2 * i + 1] - b1 * ss[2 * i + 1];
        const float o20 = a0 * ss[2 * i] + b0 * cc[2 * i], o21 = a1 * ss[2 * i + 1] + b1 * cc[2 * i + 1];
        a[i] = pack2(o10, o11); b[i] = pack2(o20, o21);
    }
    x1 = make_uint4(a[0], a[1], a[2], a[3]); x2 = make_uint4(b[0], b[1], b[2], b[3]);
}
DEV void vt_tile(const bf16_t* __restrict__ src, int ld, bf16_t* __restrict__ dst, char* smem) {
    bf16_t* Ls = (bf16_t*)smem;
    const int tid = ltid();
    __syncthreads();
#pragma unroll
    for (int i = 0; i < 2; ++i) {
        const int id = tid + 256 * i, tok = id >> 3, ch = id & 7;
        *(uint4*)(Ls + tok * 72 + ch * 8) = *(const uint4*)(src + (size_t)tok * ld + ch * 8);
    }
    __syncthreads();
#pragma unroll
    for (int i = 0; i < 2; ++i) {
        const int id = tid + 256 * i, d = id >> 3, tc = id & 7;
        unsigned short e[8];
#pragma unroll
        for (int j = 0; j < 8; ++j) e[j] = Ls[(tc * 8 + j) * 72 + d];
        uint4 o;
        o.x = (unsigned)e[0] | ((unsigned)e[1] << 16); o.y = (unsigned)e[2] | ((unsigned)e[3] << 16);
        o.z = (unsigned)e[4] | ((unsigned)e[5] << 16); o.w = (unsigned)e[6] | ((unsigned)e[7] << 16);
        *(uint4*)(dst + (size_t)d * 2048 + tc * 8) = o;
    }
}

DEV void phase_layout1(const Params& p, char* smem) {
    char* ws = p.ws;
    bf16_t* cols = (bf16_t*)(ws + OFF_COLS);
    bf16_t* kc = (bf16_t*)(ws + OFF_KC);
    bf16_t* vc = (bf16_t*)(ws + OFF_VC);
    bf16_t* VT = (bf16_t*)(ws + OFF_VT);
    float* rstd = (float*)(ws + OFF_RSTD);
    const float* rope = (const float*)(ws + OFF_ROPE);
    const float *cos64 = rope, *sin64 = rope + 2048 * 32, *cos32 = rope + 2048 * 64, *sin32 = rope + 2048 * 64 + 2048 * 16;
    const int tid = ltid();
    for (int tile = blockIdx.x; tile < kT / 64; tile += gridDim.x) {
        const int T0 = tile * 64, b = T0 >> 11, s0 = T0 & 2047;
        for (int it = tid; it < 64 * 94; it += 256) {
            const int tok = it / 94, item = it % 94;
            const int t = T0 + tok, s = s0 + tok;
            bf16_t* row = cols + (size_t)t * LDC;
            if (item < 52) {
                const int hd = item >> 2, i0 = (item & 3) * 8;
                const int base = hd < 4 ? 64 * hd : hd == 4 ? 256 : hd == 5 ? 384 : hd == 6 ? 512 : hd < 11 ? 1920 + 64 * (hd - 7) : 2176 + 64 * (hd - 11);
                uint4 x1 = *(const uint4*)(row + base + i0), x2 = *(const uint4*)(row + base + 32 + i0);
                rope8(x1, x2, cos64 + s * 32 + i0, sin64 + s * 32 + i0);
                *(uint4*)(row + base + i0) = x1; *(uint4*)(row + base + 32 + i0) = x2;
                if (hd == 4) { *(uint4*)(kc + (size_t)t * 64 + i0) = x1; *(uint4*)(kc + (size_t)t * 64 + 32 + i0) = x2; }
            } else if (item < 86) {
                const int it2 = item - 52, sub = it2 >> 1, i0 = (it2 & 1) * 8;
                const int base = sub < 8 ? 704 + 32 * sub : sub < 16 ? 960 + 32 * (sub - 8) : 1856;
                uint4 x1 = *(const uint4*)(row + base + i0), x2 = *(const uint4*)(row + base + 16 + i0);
                rope8(x1, x2, cos32 + s * 16 + i0, sin32 + s * 16 + i0);
                *(uint4*)(row + base + i0) = x1; *(uint4*)(row + base + 16 + i0) = x2;
            } else {
                const int ch = item - 86;
                *(uint4*)(vc + (size_t)t * 64 + ch * 8) = *(const uint4*)(row + 320 + ch * 8);
            }
        }
        {
            const int tok = tid >> 2, part = tid & 3, t = T0 + tok;
            const bf16_t* src = cols + (size_t)t * LDC + 1472 + (part < 3 ? part : 0) * 128;
            float ss = 0.f;
#pragma unroll 4
            for (int i = 0; i < 16; ++i) {
                const uint4 u = *(const uint4*)(src + i * 8);
                ss += lo16(u.x) * lo16(u.x) + hi16(u.x) * hi16(u.x) + lo16(u.y) * lo16(u.y) + hi16(u.y) * hi16(u.y)
                    + lo16(u.z) * lo16(u.z) + hi16(u.z) * hi16(u.z) + lo16(u.w) * lo16(u.w) + hi16(u.w) * hi16(u.w);
            }
            float vq = part < 2 ? ss : 0.f;
            vq += __shfl_xor(vq, 1, 64);
            if (part == 0) rstd[t] = rsqrtf(vq * (1.f / 256.f) + kEps);
            if (part == 2) rstd[kT + t] = rsqrtf(ss * (1.f / 128.f) + kEps);
        }
#pragma unroll 1
        for (int vh = 0; vh < 8; ++vh) {
            const int col = vh == 0 ? 448 : vh == 1 ? 576 : vh < 6 ? 1216 + 64 * (vh - 2) : 2304 + 64 * (vh - 6);
            vt_tile(cols + (size_t)T0 * LDC + col, LDC, VT + ((size_t)(b * 12 + vh) * 64) * 2048 + s0, smem);
        }
    }
}

DEV void phase_layout2(const Params& p, char* smem) {
    char* ws = p.ws;
    bf16_t* qmla = (bf16_t*)(ws + OFF_QMLA);
    const bf16_t* kvmla = (const bf16_t*)(ws + OFF_KVMLA);
    bf16_t* VT = (bf16_t*)(ws + OFF_VT);
    const float* rope = (const float*)(ws + OFF_ROPE);
    const float *cos32 = rope + 2048 * 64, *sin32 = rope + 2048 * 64 + 2048 * 16;
    const int tid = ltid();
    for (int tile = blockIdx.x; tile < kT / 64; tile += gridDim.x) {
        const int T0 = tile * 64, b = T0 >> 11, s0 = T0 & 2047;
        for (int it = tid; it < 64 * 8; it += 256) {
            const int tok = it >> 3, item = it & 7, hd = item >> 1, i0 = (item & 1) * 8;
            const int t = T0 + tok, s = s0 + tok;
            bf16_t* row = qmla + (size_t)t * 384 + hd * 96 + 64;
            uint4 x1 = *(const uint4*)(row + i0), x2 = *(const uint4*)(row + 16 + i0);
            rope8(x1, x2, cos32 + s * 16 + i0, sin32 + s * 16 + i0);
            *(uint4*)(row + i0) = x1; *(uint4*)(row + 16 + i0) = x2;
        }
#pragma unroll 1
        for (int hd = 0; hd < 4; ++hd)
            vt_tile(kvmla + (size_t)T0 * 512 + hd * 128 + 64, 512, VT + ((size_t)(b * 12 + 8 + hd) * 64) * 2048 + s0, smem);
    }
}

constexpr int SM_K = 0;
constexpr int SM_V = 18432;
constexpr int SM_IMP = SM_V + 16896;
constexpr int SM_SEL = SM_IMP + 16896;
constexpr int SM_CTRL = 65536;
constexpr int SM_TOTAL = SM_CTRL + 256;
constexpr int SM_ATTN_END = SM_SEL + 1024;

struct RangeIter { int cur, end; DEV int next() { return cur < end ? cur++ : -1; } };
struct BitIter { unsigned rem; DEV int next() { if (!rem) return -1; const int k = __ffs((int)rem) - 1; rem &= rem - 1; return k; } };
struct LdRow { const bf16_t* base; int ld;
    DEV uint4 operator()(int kt, int id) const { const int row = id >> 3, part = id & 7; return *(const uint4*)(base + (size_t)(kt * 64 + row) * ld + part * 8); } };
struct LdVT { const bf16_t* base;
    DEV uint4 operator()(int kt, int id) const { const int d = id >> 3, part = id & 7; return *(const uint4*)(base + (size_t)d * 2048 + kt * 64 + part * 8); } };
struct LdMlaK { const bf16_t* kv; const bf16_t* kr;
    DEV uint4 operator()(int kt, int id) const { const int row = id / 12, part = id % 12; const size_t t = (size_t)(kt * 64 + row);
        return part < 8 ? *(const uint4*)(kv + t * 512 + part * 8) : *(const uint4*)(kr + t * LDC + (part - 8) * 8); } };

struct MaskCausal { DEV bool on(int) const { return true; } DEV bool ok(int kc, int d) const { return kc <= d; } };
template <int W> struct MaskWin { DEV bool on(int) const { return true; } DEV bool ok(int kc, int d) const { return (kc <= d) && (d - kc < W); } };
struct MaskSel { unsigned bits; DEV bool on(int kt) const { return (bits >> kt) & 1u; } DEV bool ok(int kc, int d) const { return kc <= d; } };
template <int KDIM, int NKS, int NSUB, class It, class LK, class LV, class MaskF, class SkipF>
DEV void attn_stream(It it, const LK& ldK, const LV& ldV, const MaskF& maskf, const SkipF& skipf,
                     const bf16x8* qf, f32x16 (&o)[NSUB][2], float (&m)[NSUB], float (&l)[NSUB], float scl, int tq, char* smem, int tid, int koff = 0) {
    constexpr int KCH = KDIM / 8, KSTR = KDIM + 8, NKC = (64 * KCH) / 256;
    bf16_t* Kb = (bf16_t*)(smem + SM_K);
    bf16_t* Vb = (bf16_t*)(smem + SM_V);
    const int lane = tid & 63, ql = lane & 31, hh = lane >> 5;
    uint4 rk0 = make_uint4(0, 0, 0, 0), rk1 = rk0, rk2 = rk0, rv0 = rk0, rv1 = rk0;
    int kt = it.next();
    if (kt >= 0) {
        rk0 = ldK(kt, tid); rk1 = ldK(kt, tid + 256);
        if (NKC == 3) rk2 = ldK(kt, tid + 512);
        rv0 = ldV(kt, tid); rv1 = ldV(kt, tid + 256);
    }
    while (kt >= 0) {
        __syncthreads();
        { const int id = tid, row = id / KCH, part = id % KCH; *(uint4*)(Kb + row * KSTR + part * 8) = rk0; }
        { const int id = tid + 256, row = id / KCH, part = id % KCH; *(uint4*)(Kb + row * KSTR + part * 8) = rk1; }
        if (NKC == 3) { const int id = tid + 512, row = id / KCH, part = id % KCH; *(uint4*)(Kb + row * KSTR + part * 8) = rk2; }
        { const int id = tid, row = id >> 3, part = id & 7; bf16_t* d = Vb + row * 68 + part * 8;
            *(uint2*)d = make_uint2(rv0.x, rv0.y); *(uint2*)(d + 4) = make_uint2(rv0.z, rv0.w); }
        { const int id = tid + 256, row = id >> 3, part = id & 7; bf16_t* d = Vb + row * 68 + part * 8;
            *(uint2*)d = make_uint2(rv1.x, rv1.y); *(uint2*)(d + 4) = make_uint2(rv1.z, rv1.w); }
        __syncthreads();
        const int ktn = it.next();
        if (ktn >= 0) {
            rk0 = ldK(ktn, tid); rk1 = ldK(ktn, tid + 256);
            if (NKC == 3) rk2 = ldK(ktn, tid + 512);
            rv0 = ldV(ktn, tid); rv1 = ldV(ktn, tid + 256);
        }
        if (!skipf(kt)) {
#pragma unroll
            for (int sub = 0; sub < NSUB; ++sub) {
                __builtin_amdgcn_sched_barrier(0);
                f32x16 s[2];
#pragma unroll
                for (int i = 0; i < 2; ++i) {
                    s[i] = zero16();
#pragma unroll
                    for (int ks = 0; ks < NKS; ++ks) {
                        const bf16x8 a = *(const bf16x8*)(Kb + (i * 32 + ql) * KSTR + koff + (sub * NKS + ks) * 16 + hh * 8);
                        s[i] = mfma32(a, qf[sub * NKS + ks], s[i]);
                    }
                }
                float mx = kNeg;
                const int dlim = tq - kt * 64 - 4 * hh;
                const bool on = maskf.on(kt);
#pragma unroll
                for (int i = 0; i < 2; ++i)
#pragma unroll
                    for (int r = 0; r < 16; ++r) {
                        const int kc = i * 32 + (r & 3) + 8 * (r >> 2);
                        const float v = (on && maskf.ok(kc, dlim)) ? s[i][r] * scl : kNeg;
                        s[i][r] = v; mx = fmaxf(mx, v);
                    }
                mx = fmaxf(mx, xor32f(mx, lane));
                const float mnew = fmaxf(m[sub], mx);
                const float alpha = __builtin_amdgcn_exp2f(m[sub] - mnew);
                m[sub] = mnew;
                float sum = 0.f;
#pragma unroll
                for (int i = 0; i < 2; ++i)
#pragma unroll
                    for (int r = 0; r < 16; ++r) { const float pv = __builtin_amdgcn_exp2f(s[i][r] - mnew); s[i][r] = pv; sum += pv; }
                l[sub] = l[sub] * alpha + sum;
#pragma unroll
                for (int dt = 0; dt < 2; ++dt)
#pragma unroll
                    for (int r = 0; r < 16; ++r) o[sub][dt][r] *= alpha;
                __builtin_amdgcn_sched_barrier(0);
#pragma unroll
                for (int ks = 0; ks < 4; ++ks) {
                    if (ks == 2) __builtin_amdgcn_sched_barrier(0);
                    const int i = ks >> 1, r0 = 8 * (ks & 1);
                    uint4 pu;
                    pu.x = pack2(s[i][r0 + 0], s[i][r0 + 1]); pu.y = pack2(s[i][r0 + 2], s[i][r0 + 3]);
                    pu.z = pack2(s[i][r0 + 4], s[i][r0 + 5]); pu.w = pack2(s[i][r0 + 6], s[i][r0 + 7]);
                    const bf16x8 pf = __builtin_bit_cast(bf16x8, pu);
#pragma unroll
                    for (int dt = 0; dt < 2; ++dt) {
                        const bf16_t* vp = Vb + (dt * 32 + ql) * 68 + ks * 16 + 4 * hh;
                        const uint2 a0 = *(const uint2*)vp, a1 = *(const uint2*)(vp + 8);
                        const bf16x8 a = __builtin_bit_cast(bf16x8, make_uint4(a0.x, a0.y, a1.x, a1.y));
                        o[sub][dt] = mfma32(a, pf, o[sub][dt]);
                    }
                }
            }
        }
        kt = ktn;
    }
}

DEV void write_o(const f32x16 (&o)[2], bf16_t* obuf, size_t row, int col0, int hh) {
#pragma unroll
    for (int dt = 0; dt < 2; ++dt)
#pragma unroll
        for (int g = 0; g < 4; ++g) {
            const int d = dt * 32 + 8 * g + 4 * hh;
            uint2 u; u.x = pack2(o[dt][4 * g], o[dt][4 * g + 1]); u.y = pack2(o[dt][4 * g + 2], o[dt][4 * g + 3]);
            *(uint2*)(obuf + row * 1024 + col0 + d) = u;
        }
}
DEV float sigmoidf(float x) { return 1.f / (1.f + __expf(-x)); }

DEV void nsa_item(const Params& p, int b, int qb, char* smem) {
    int tid = threadIdx.x; asm volatile("" : "+v"(tid));
    const int lane = tid & 63, w = tid >> 6, ql = lane & 31, hh = lane >> 5;
    char* ws = p.ws;
    const bf16_t* cols = (const bf16_t*)(ws + OFF_COLS);
    const bf16_t* VT = (const bf16_t*)(ws + OFF_VT);
    bf16_t* obuf = (bf16_t*)(ws + OFF_O);
    const int t0 = qb * 32, tq = t0 + ql;
    const size_t Tb = (size_t)b * kS;
    const bf16_t* qrow = cols + (Tb + tq) * LDC;
    bf16x8 qf[4];
#pragma unroll
    for (int ks = 0; ks < 4; ++ks) qf[ks] = *(const bf16x8*)(qrow + w * 64 + ks * 16 + hh * 8);
    const float g0 = sigmoidf(bf2f(qrow[640 + w * 3 + 0])), g1 = sigmoidf(bf2f(qrow[640 + w * 3 + 1])), g2 = sigmoidf(bf2f(qrow[640 + w * 3 + 2]));
    const float scl = 0.125f * kLog2e;
    bf16_t* Kc = (bf16_t*)(smem + SM_K);
    bf16_t* Vc = (bf16_t*)(smem + SM_V);
    float* impP = (float*)(smem + SM_IMP);
    unsigned* selm = (unsigned*)(smem + SM_SEL);
    const bf16_t* kcmp = (const bf16_t*)(ws + OFF_KCMP) + (size_t)b * 128 * 64;
    const bf16_t* vcmp = kcmp + 1024 * 64;
    __syncthreads();
#pragma unroll
    for (int i = 0; i < 4; ++i) {
        const int id = tid + 256 * i, row = id >> 3, part = id & 7;
        uint4 kk = *(const uint4*)(kcmp + row * 64 + part * 8);
        uint4 vv = *(const uint4*)(vcmp + row * 64 + part * 8);
        if (row == 127) { kk = make_uint4(0, 0, 0, 0); vv = kk; }
        *(uint4*)(Kc + row * 72 + part * 8) = kk;
        const unsigned u[4] = {vv.x, vv.y, vv.z, vv.w};
#pragma unroll
        for (int j = 0; j < 4; ++j) { Vc[(part * 8 + 2 * j) * 132 + row] = (bf16_t)(u[j] & 0xffffu); Vc[(part * 8 + 2 * j + 1) * 132 + row] = (bf16_t)(u[j] >> 16); }
    }
    __syncthreads();
    unsigned ocp[16];
    float* invs = (float*)(smem + SM_SEL) + 64;
    {
        const int cmaxv = tq >= 31 ? min((tq - 31) >> 4, 126) : -1;
        float mx = kNeg;
#pragma unroll 1
        for (int i = 0; i < 4; ++i) {
            f32x16 s = zero16();
#pragma unroll
            for (int ks = 0; ks < 4; ++ks) s = mfma32(*(const bf16x8*)(Kc + (i * 32 + ql) * 72 + ks * 16 + hh * 8), qf[ks], s);
            const int clim = cmaxv - i * 32 - 4 * hh;
#pragma unroll
            for (int r = 0; r < 16; ++r) {
                const int kc = (r & 3) + 8 * (r >> 2);
                const bool valid = (kc <= clim);
                mx = fmaxf(mx, valid ? s[r] * scl : kNeg);
            }
        }
        mx = fmaxf(mx, xor32f(mx, lane));
        f32x16 ocmp[2]; ocmp[0] = zero16(); ocmp[1] = zero16();
        float sum = 0.f, carprev = 0.f;
#pragma unroll 1
        for (int i = 0; i < 4; ++i) {
            f32x16 s = zero16();
#pragma unroll
            for (int ks = 0; ks < 4; ++ks) s = mfma32(*(const bf16x8*)(Kc + (i * 32 + ql) * 72 + ks * 16 + hh * 8), qf[ks], s);
            const int clim = cmaxv - i * 32 - 4 * hh;
#pragma unroll
            for (int r = 0; r < 16; ++r) {
                const int kc = (r & 3) + 8 * (r >> 2);
                const bool valid = (kc <= clim);
                const float pv = valid ? __builtin_amdgcn_exp2f(s[r] * scl - mx) : 0.f;
                s[r] = pv; sum += pv;
            }
            float own[4], car[4];
#pragma unroll
            for (int g = 0; g < 4; ++g) { own[g] = s[4 * g] + s[4 * g + 1] + s[4 * g + 2] + 0.5f * s[4 * g + 3]; car[g] = 0.5f * s[4 * g + 3]; }
#pragma unroll
            for (int g = 0; g < 4; ++g) {
                const float send = hh ? (g ? car[g > 0 ? g - 1 : 0] : carprev) : car[g];
                own[g] += xor32f(send, lane);
            }
            carprev = car[3];
#pragma unroll
            for (int g = 0; g < 4; ++g) impP[(w * 32 + ql) * 33 + 2 * (4 * i + g) + hh] = own[g];
#pragma unroll
            for (int sp = 0; sp < 2; ++sp) {
                const int ks = 2 * i + sp, r0 = 8 * sp;
                uint4 pu;
                pu.x = pack2(s[r0 + 0], s[r0 + 1]); pu.y = pack2(s[r0 + 2], s[r0 + 3]);
                pu.z = pack2(s[r0 + 4], s[r0 + 5]); pu.w = pack2(s[r0 + 6], s[r0 + 7]);
                const bf16x8 pf = __builtin_bit_cast(bf16x8, pu);
#pragma unroll
                for (int dt = 0; dt < 2; ++dt) {
                    const bf16_t* vp = Vc + (dt * 32 + ql) * 132 + ks * 16 + 4 * hh;
                    const uint2 a0 = *(const uint2*)vp, a1 = *(const uint2*)(vp + 8);
                    ocmp[dt] = mfma32(__builtin_bit_cast(bf16x8, make_uint4(a0.x, a0.y, a1.x, a1.y)), pf, ocmp[dt]);
                }
            }
        }
        sum += xor32f(sum, lane);
        const float inv = sum > 0.f ? 1.f / sum : 0.f;
        invs[w * 32 + ql] = inv;
        const float f = g0 * inv;
#pragma unroll
        for (int dt = 0; dt < 2; ++dt)
#pragma unroll
            for (int r = 0; r < 8; ++r) ocp[dt * 8 + r] = pack2(f * ocmp[dt][2 * r], f * ocmp[dt][2 * r + 1]);
    }
    __syncthreads();
    const int qblk = t0 >> 6;
    {
        const int hw = tid >> 5, j = tid & 31;
#pragma unroll 1
        for (int rr = 0; rr < 4; ++rr) {
            const int row = hw * 4 + rr;
            const float v = impP[(0 * 32 + row) * 33 + j] * invs[row] + impP[(1 * 32 + row) * 33 + j] * invs[32 + row]
                          + impP[(2 * 32 + row) * 33 + j] * invs[64 + row] + impP[(3 * 32 + row) * 33 + j] * invs[96 + row];
            bool sel;
            if (qblk < 16) sel = (j <= qblk);
            else {
                const bool cand = (j >= 1) && (j <= qblk - 2);
                const bool forced = (j == 0) || (j == qblk) || (j == qblk - 1);
                int rank = 0;
                for (int j2 = 1; j2 <= qblk - 2; ++j2) {
                    const float v2 = lanef(v, (lane & 32) + j2);
                    rank += (v2 > v || (v2 == v && j2 < j)) ? 1 : 0;
                }
                sel = forced || (cand && rank < 13);
            }
            const unsigned long long bal = __ballot(sel);
            const unsigned mk = (lane & 32) ? (unsigned)(bal >> 32) : (unsigned)bal;
            if (j == 0) selm[row] = mk;
        }
    }
    __syncthreads();
    const unsigned mysel = selm[ql];
    unsigned U = mysel;
#pragma unroll
    for (int o = 16; o > 0; o >>= 1) U |= (unsigned)__builtin_amdgcn_ds_bpermute((lane ^ o) << 2, (int)U);
    {
        f32x16 o1[1][2]; o1[0][0] = zero16(); o1[0][1] = zero16();
        float m1[1] = {kNeg}, l1[1] = {0.f};
        auto skipf = [&](int) __attribute__((always_inline)) { return false; };
        attn_stream<64, 4, 1>(BitIter{U}, LdRow{cols + Tb * LDC + 384, LDC}, LdVT{VT + (size_t)(b * 12 + 0) * 64 * 2048}, MaskSel{mysel}, skipf, qf, o1, m1, l1, scl, tq, smem, tid);
        const float lt = l1[0] + xor32f(l1[0], lane);
        const float f = g1 / lt;
#pragma unroll
        for (int dt = 0; dt < 2; ++dt)
#pragma unroll
            for (int r = 0; r < 8; ++r) ocp[dt * 8 + r] = pack2(lo16(ocp[dt * 8 + r]) + f * o1[0][dt][2 * r], hi16(ocp[dt * 8 + r]) + f * o1[0][dt][2 * r + 1]);
    }
    {
        f32x16 o1[1][2]; o1[0][0] = zero16(); o1[0][1] = zero16();
        float m1[1] = {kNeg}, l1[1] = {0.f};
        auto skipf = [&](int) __attribute__((always_inline)) { return false; };
        const int lo = t0 >= 511 ? ((t0 - 511) >> 6) : 0;
        attn_stream<64, 4, 1>(RangeIter{lo, qblk + 1}, LdRow{cols + Tb * LDC + 512, LDC}, LdVT{VT + (size_t)(b * 12 + 1) * 64 * 2048}, MaskWin<512>{}, skipf, qf, o1, m1, l1, scl, tq, smem, tid);
        const float lt = l1[0] + xor32f(l1[0], lane);
        const float f = g2 / lt;
#pragma unroll
        for (int dt = 0; dt < 2; ++dt)
#pragma unroll
            for (int r = 0; r < 8; ++r) { o1[0][dt][2 * r] = lo16(ocp[dt * 8 + r]) + f * o1[0][dt][2 * r]; o1[0][dt][2 * r + 1] = hi16(ocp[dt * 8 + r]) + f * o1[0][dt][2 * r + 1]; }
        write_o(o1[0], obuf, Tb + tq, w * 64, hh);
    }
}

DEV void diff_item(const Params& p, int layer, int b, int hd, int q64, char* smem) {
    int tid = threadIdx.x; asm volatile("" : "+v"(tid));
    const int lane = tid & 63, w = tid >> 6, ql = lane & 31, hh = lane >> 5;
    const int sub = w & 1, qbw = w >> 1;
    char* ws = p.ws;
    const bf16_t* cols = (const bf16_t*)(ws + OFF_COLS);
    const bf16_t* VT = (const bf16_t*)(ws + OFF_VT);
    bf16_t* obuf = (bf16_t*)(ws + OFF_O);
    const float* misc = (const float*)(ws + OFF_MISC);
    const int t0w = q64 * 64 + qbw * 32, tq = t0w + ql;
    const size_t Tb = (size_t)b * kS;
    const bf16_t* qrow = cols + (Tb + tq) * LDC + 704 + hd * 64 + sub * 32;
    bf16x8 qf[2];
#pragma unroll
    for (int ks = 0; ks < 2; ++ks) qf[ks] = *(const bf16x8*)(qrow + ks * 16 + hh * 8);
    const float scl = 0.17677669529663687f * kLog2e;
    f32x16 o1[1][2]; o1[0][0] = zero16(); o1[0][1] = zero16();
    float m1[1] = {kNeg}, l1[1] = {0.f};
    auto skipf = [&](int kt) __attribute__((always_inline)) { return kt * 64 > t0w + 31; };
    attn_stream<64, 2, 1>(RangeIter{0, q64 + 1}, LdRow{cols + Tb * LDC + 960 + hd * 64, LDC}, LdVT{VT + (size_t)(b * 12 + 2 + hd) * 64 * 2048}, MaskCausal{}, skipf, qf, o1, m1, l1, scl, tq, smem, tid, sub * 32);
    const float lam = misc[256 + layer], post = misc[258 + layer];
    const float lt = l1[0] + xor32f(l1[0], lane);
    float* ex = (float*)smem;
    __syncthreads();
    if (sub == 1) {
        const float f = lam / lt;
#pragma unroll
        for (int dt = 0; dt < 2; ++dt)
#pragma unroll
            for (int r = 0; r < 16; ++r) ex[((qbw * 2 + dt) * 16 + r) * 64 + lane] = o1[0][dt][r] * f;
    }
    __syncthreads();
    if (sub == 0) {
        const float f = 1.f / lt;
        float ss = 0.f;
#pragma unroll
        for (int dt = 0; dt < 2; ++dt)
#pragma unroll
            for (int r = 0; r < 16; ++r) { const float v = o1[0][dt][r] * f - ex[((qbw * 2 + dt) * 16 + r) * 64 + lane]; o1[0][dt][r] = v; ss += v * v; }
        ss += xor32f(ss, lane);
        const float rstd = rsqrtf(ss * (1.f / 64.f) + kEps) * post;
        const float* sg = p.sub_g + layer * 64;
#pragma unroll
        for (int dt = 0; dt < 2; ++dt)
#pragma unroll
            for (int r = 0; r < 16; ++r) { const int d = dt * 32 + (r & 3) + 8 * (r >> 2) + 4 * hh; o1[0][dt][r] *= rstd * sg[d]; }
        write_o(o1[0], obuf, Tb + tq, 256 + hd * 64, hh);
    }
}

DEV void mla_item(const Params& p, int b, int hd, int qc, char* smem) {
    int tid = threadIdx.x; asm volatile("" : "+v"(tid));
    const int lane = tid & 63, w = tid >> 6, ql = lane & 31, hh = lane >> 5;
    char* ws = p.ws;
    const bf16_t* cols = (const bf16_t*)(ws + OFF_COLS);
    const bf16_t* VT = (const bf16_t*)(ws + OFF_VT);
    const bf16_t* qmla = (const bf16_t*)(ws + OFF_QMLA);
    const bf16_t* kvmla = (const bf16_t*)(ws + OFF_KVMLA);
    bf16_t* obuf = (bf16_t*)(ws + OFF_O);
    const int t0w = qc * 128 + w * 32, tq = t0w + ql;
    const size_t Tb = (size_t)b * kS;
    const bf16_t* qrow = qmla + (Tb + tq) * 384 + hd * 96;
    bf16x8 qf[6];
#pragma unroll
    for (int ks = 0; ks < 6; ++ks) qf[ks] = *(const bf16x8*)(qrow + ks * 16 + hh * 8);
    const float scl = 0.10206207261596575f * kLog2e;
    f32x16 o1[1][2]; o1[0][0] = zero16(); o1[0][1] = zero16();
    float m1[1] = {kNeg}, l1[1] = {0.f};
    auto skipf = [&](int kt) __attribute__((always_inline)) { return kt * 64 > t0w + 31; };
    attn_stream<96, 6, 1>(RangeIter{0, 2 * qc + 2}, LdMlaK{kvmla + Tb * 512 + hd * 128, cols + Tb * LDC + 1856}, LdVT{VT + (size_t)(b * 12 + 8 + hd) * 64 * 2048}, MaskCausal{}, skipf, qf, o1, m1, l1, scl, tq, smem, tid);
    const float inv = 1.f / (l1[0] + xor32f(l1[0], lane));
#pragma unroll
    for (int dt = 0; dt < 2; ++dt)
#pragma unroll
        for (int r = 0; r < 16; ++r) o1[0][dt][r] *= inv;
    write_o(o1[0], obuf, Tb + tq, 512 + hd * 64, hh);
}

DEV void swa_item(const Params& p, int layer, int b, int g, int q64, char* smem) {
    int tid = threadIdx.x; asm volatile("" : "+v"(tid));
    const int lane = tid & 63, w = tid >> 6, ql = lane & 31, hh = lane >> 5;
    char* ws = p.ws;
    const bf16_t* cols = (const bf16_t*)(ws + OFF_COLS);
    const bf16_t* VT = (const bf16_t*)(ws + OFF_VT);
    bf16_t* obuf = (bf16_t*)(ws + OFF_O);
    const int head = g * 2 + (w & 1);
    const int t0w = q64 * 64 + (w >> 1) * 32, tq = t0w + ql;
    const size_t Tb = (size_t)b * kS;
    const bf16_t* qrow = cols + (Tb + tq) * LDC + 1920 + head * 64;
    bf16x8 qf[4];
#pragma unroll
    for (int ks = 0; ks < 4; ++ks) qf[ks] = *(const bf16x8*)(qrow + ks * 16 + hh * 8);
    const float scl = 0.125f * kLog2e;
    f32x16 o1[1][2]; o1[0][0] = zero16(); o1[0][1] = zero16();
    float m1[1] = {p.sinks[layer * 4 + head] * kLog2e}, l1[1] = {hh == 0 ? 1.f : 0.f};
    auto skipf = [&](int kt) __attribute__((always_inline)) { return (kt * 64 > t0w + 31) || (kt * 64 + 63 < t0w - 127); };
    const int lo = q64 >= 2 ? q64 - 2 : 0;
    attn_stream<64, 4, 1>(RangeIter{lo, q64 + 1}, LdRow{cols + Tb * LDC + 2176 + g * 64, LDC}, LdVT{VT + (size_t)(b * 12 + 6 + g) * 64 * 2048}, MaskWin<128>{}, skipf, qf, o1, m1, l1, scl, tq, smem, tid);
    const float inv = 1.f / (l1[0] + xor32f(l1[0], lane));
#pragma unroll
    for (int dt = 0; dt < 2; ++dt)
#pragma unroll
        for (int r = 0; r < 16; ++r) o1[0][dt][r] *= inv;
    write_o(o1[0], obuf, Tb + tq, 768 + head * 64, hh);
}

DEV void phase_attn(const Params& p, int layer, char* smem, int rep = 0) {
    unsigned* ctr = (unsigned*)(p.ws + OFF_CTRL) + 64 + layer * 16 + rep;
    volatile int* slot = (volatile int*)(smem + SM_SEL) + 48;
    for (;;) {
        __syncthreads();
        if (ltid() == 0) *slot = (int)atomicAdd(ctr, 1u);
        __syncthreads();
        const int idx = __builtin_amdgcn_readfirstlane(*slot);
        if (idx >= 2560) break;
        const int level = 15 - idx / 160, r = idx % 160;
        if (r < 64) { const int b = (r & 31) >> 2; diff_item(p, layer, b, r & 3, level * 2 + (1 - (r >> 5)), smem); }
        else if (r < 96) { const int k = r - 64; mla_item(p, k >> 2, k & 3, level, smem); }
        else if (r < 128) { const int k = r - 96; nsa_item(p, k >> 2, level * 4 + (3 - (k & 3)), smem); }
        else { const int k = r - 128; swa_item(p, layer, k >> 2, (k >> 1) & 1, level * 2 + (k & 1), smem); }
    }
}

#define XB_TMO      128
#define XB_XCNT(j)  (256  + 64 * (j))
#define XB_XSUB(j)  (1280 + 64 * (j))
#define XB_XGEN(j)  (2304 + 64 * (j))
#define XB_TOP      3328
#define XB_TOPGEN   3392
#define XB_SPIN_CAP (1u << 22)
DEV unsigned xb_ld(unsigned* p) { return __hip_atomic_load(p, __ATOMIC_RELAXED, __HIP_MEMORY_SCOPE_AGENT); }
DEV unsigned xb_add(unsigned* p, unsigned v) { return __hip_atomic_fetch_add(p, v, __ATOMIC_RELAXED, __HIP_MEMORY_SCOPE_AGENT); }
DEV unsigned xb_xcc_id() { return (unsigned)__builtin_amdgcn_s_getreg((3 << 11) | 20) & 0xFu; }
#define XB_SPIN(cond, bar) do { unsigned _sp = 0; while (cond) { __builtin_amdgcn_s_sleep(1); \
    if ((++_sp & 255u) == 0u) { if (xb_ld(&(bar)[XB_TMO])) break; if (_sp > XB_SPIN_CAP) { atomicAdd(&(bar)[XB_TMO], 1u); break; } } } } while (0)
struct XcdBarrier { unsigned* bar; unsigned x; volatile LAS unsigned* st; };
DEV XcdBarrier xcd_barrier_post(unsigned* bar, volatile LAS unsigned* st) {
    XcdBarrier b; b.bar = bar; b.x = xb_xcc_id(); b.st = st;
    if (threadIdx.x == 0) st[2] = xb_add(&bar[XB_XCNT(b.x)], 1u);
    return b;
}
DEV void xcd_barrier_complete(unsigned* bar, unsigned x, unsigned& nloc, unsigned& nx) {
    const unsigned G = gridDim.x * gridDim.y * gridDim.z;
    unsigned sum, cnt, mine, sp = 0u;
    for (;;) {
        sum = 0u; cnt = 0u; mine = 0u;
#pragma unroll
        for (unsigned j = 0; j < 16; ++j) { const unsigned c = xb_ld(&bar[XB_XCNT(j)]); sum += c; cnt += (c > 0u) ? 1u : 0u; mine = (j == x) ? c : mine; }
        if (sum == G) break;
        __builtin_amdgcn_s_sleep(1);
        if ((++sp & 255u) == 0u) { if (xb_ld(&bar[XB_TMO])) break; if (sp > XB_SPIN_CAP) { atomicAdd(&bar[XB_TMO], 1u); break; } }
    }
    nloc = mine > 0u ? mine : 1u; nx = cnt > 0u ? cnt : 1u;
}
DEV void xcd_barrier(const XcdBarrier& b) {
    asm volatile("s_waitcnt vmcnt(0)" ::: "memory");
    __syncthreads();
    if (threadIdx.x == 0) {
        unsigned* bar = b.bar;
        asm volatile("" : "+v"(bar));
        __builtin_amdgcn_s_waitcnt(0);
        unsigned nloc = b.st[0], nx = b.st[1];
        if (nloc == 0u) { xcd_barrier_complete(bar, b.x, nloc, nx); b.st[0] = nloc; b.st[1] = nx; }
        const unsigned old = xb_add(&bar[XB_XSUB(b.x)], 1u);
        const unsigned gen = old / nloc;
        if (old + 1u == (gen + 1u) * nloc) {
            __builtin_amdgcn_fence(__ATOMIC_RELEASE, "agent");
            asm volatile("s_waitcnt vmcnt(0)" ::: "memory");
            const unsigned og = xb_add(&bar[XB_TOP], 1u);
            const unsigned tg = og / nx;
            if (og + 1u == (tg + 1u) * nx) xb_add(&bar[XB_TOPGEN], 1u);
            else XB_SPIN(xb_ld(&bar[XB_TOPGEN]) == tg, bar);
            __builtin_amdgcn_fence(__ATOMIC_ACQUIRE, "agent");
            xb_add(&bar[XB_XGEN(b.x)], 1u);
            asm volatile("s_waitcnt vmcnt(0)" ::: "memory");
        } else {
            XB_SPIN(xb_ld(&bar[XB_XGEN(b.x)]) == gen, bar);
            __builtin_amdgcn_fence(__ATOMIC_ACQUIRE, "agent");
            asm volatile("s_waitcnt vmcnt(0)" ::: "memory");
        }
    }
    __syncthreads();
}

DEV unsigned fkey(float f) { const unsigned u = __float_as_uint(f); return (u & 0x80000000u) ? ~u : (u | 0x80000000u); }
DEV float funkey(unsigned k) { return __uint_as_float((k & 0x80000000u) ? (k & 0x7fffffffu) : ~k); }
DEV void ins16(unsigned (&L)[16], unsigned x) {
#pragma unroll
    for (int i = 0; i < 16; ++i) { const unsigned hi = L[i] > x ? L[i] : x; x = L[i] > x ? x : L[i]; L[i] = hi; }
}
DEV void phase_topk(const Params& p, char* smem) {
    const int tid = ltid();
    const float* S1 = (const float*)(p.ws + OFF_S1);
    const float* S2 = (const float*)(p.ws + OFF_S2);
    int* eid = (int*)(p.ws + OFF_EID);
    float* gate = (float*)(p.ws + OFF_GATE);
    unsigned char* ib = (unsigned char*)smem + tid * 32;
    for (int blk = blockIdx.x; blk < kT * 8 / 256; blk += gridDim.x) {
        const size_t row = (size_t)blk * 256 + tid;
        unsigned L1[16], L2[16];
#pragma unroll
        for (int i = 0; i < 16; ++i) { L1[i] = 0u; L2[i] = 0u; }
#pragma unroll 4
        for (int k = 0; k < 128; ++k) {
            const float a = S1[(size_t)k * (kT * 8) + row], b = S2[(size_t)k * (kT * 8) + row];
            ins16(L1, (fkey(a) & ~127u) | (unsigned)(127 - k));
            ins16(L2, (fkey(b) & ~127u) | (unsigned)(127 - k));
        }
        float v1[16], v2[16];
        __syncthreads();
#pragma unroll
        for (int i = 0; i < 16; ++i) {
            v1[i] = funkey(L1[i] & ~127u); v2[i] = funkey(L2[i] & ~127u);
            ib[i] = (unsigned char)(127u - (L1[i] & 127u)); ib[16 + i] = (unsigned char)(127u - (L2[i] & 127u));
        }
        unsigned C[16];
#pragma unroll
        for (int i = 0; i < 16; ++i) C[i] = 0u;
#pragma unroll
        for (int a = 0; a < 16; ++a)
#pragma unroll
            for (int b = 0; b < 16; ++b)
                if ((a + 1) * (b + 1) <= 16) ins16(C, (fkey(v1[a] + v2[b]) & ~255u) | (unsigned)(255 - (a * 16 + b)));
        float ts[16]; float sum = 0.f;
        const float tmax = funkey(C[0] & ~255u);
#pragma unroll
        for (int i = 0; i < 16; ++i) { ts[i] = __expf(funkey(C[i] & ~255u) - tmax); sum += ts[i]; }
        const float inv = 1.f / sum;
        int ev[16];
#pragma unroll
        for (int i = 0; i < 16; ++i) { const unsigned ci = 255u - (C[i] & 255u); ev[i] = (int)ib[ci >> 4] * 128 + (int)ib[16 + (ci & 15u)]; }
#pragma unroll
        for (int i = 0; i < 4; ++i) {
            *(int4*)(eid + row * 16 + 4 * i) = make_int4(ev[4 * i], ev[4 * i + 1], ev[4 * i + 2], ev[4 * i + 3]);
            *(float4*)(gate + row * 16 + 4 * i) = make_float4(ts[4 * i] * inv, ts[4 * i + 1] * inv, ts[4 * i + 2] * inv, ts[4 * i + 3] * inv);
        }
    }
}

DEV float row_sum_dpp(float v) {
    v += __int_as_float(__builtin_amdgcn_update_dpp(0, __float_as_int(v), 0xB1, 0xF, 0xF, true));
    v += __int_as_float(__builtin_amdgcn_update_dpp(0, __float_as_int(v), 0x4E, 0xF, 0xF, true));
    v += __int_as_float(__builtin_amdgcn_update_dpp(0, __float_as_int(v), 0x141, 0xF, 0xF, true));
    v += __int_as_float(__builtin_amdgcn_update_dpp(0, __float_as_int(v), 0x140, 0xF, 0xF, true));
    return v;
}
DEV float wave_sum_dpp(float v) {
    v = row_sum_dpp(v);
    const float r0 = __int_as_float(__builtin_amdgcn_readlane(__float_as_int(v), 0)), r1 = __int_as_float(__builtin_amdgcn_readlane(__float_as_int(v), 16));
    const float r2 = __int_as_float(__builtin_amdgcn_readlane(__float_as_int(v), 32)), r3 = __int_as_float(__builtin_amdgcn_readlane(__float_as_int(v), 48));
    return (r0 + r1) + (r2 + r3);
}
typedef float f32x2 __attribute__((ext_vector_type(2)));
typedef float f32x4 __attribute__((ext_vector_type(4)));

struct SliceMap { int virt, nx, nloc, rank; };
DEV SliceMap slice_map(const Params& p, char* smem) {
    unsigned* bar = (unsigned*)p.ws;
    const unsigned x = xb_xcc_id();
    int virt = 0, nx = 0, nloc = 1;
#pragma unroll
    for (unsigned j = 0; j < 16; ++j) {
        const unsigned c = xb_ld(&bar[XB_XCNT(j)]);
        if (c > 0u) { if (j < x) ++virt; ++nx; }
        if (j == x) nloc = (int)c;
    }
    SliceMap m;
    m.virt = __builtin_amdgcn_readfirstlane(virt); m.nx = __builtin_amdgcn_readfirstlane(nx > 0 ? nx : 1); m.nloc = __builtin_amdgcn_readfirstlane(nloc > 0 ? nloc : 1);
    m.rank = __builtin_amdgcn_readfirstlane((int)((volatile LAS unsigned*)(smem + SM_CTRL))[2]);
    return m;
}

#ifndef UVAR
#define UVAR 0
#endif
typedef _Float16 half2_t __attribute__((ext_vector_type(2)));
DEV void phase_peer_u(const Params& p, int layer, char* smem, int rep = 0) {
    const int tid = ltid(), lane = tid & 63, w = tid >> 6, n16 = lane & 15, kg = lane >> 4;
    char* ws = p.ws;
    const SliceMap sm = slice_map(p, smem);
    const unsigned char* h8 = (const unsigned char*)(ws + OFF_H8);
    const int* eid = (const int*)(ws + OFF_EID);
    float* part = (float*)(ws + OFF_S1) + (rep ? (size_t)8 * kT * 128 : 0);
    int* ids_l = (int*)(smem + w * 9216);
    unsigned char* h8_l = (unsigned char*)(smem + w * 9216 + 4096);
    const int nk = sm.rank < 512 ? (512 - sm.rank + sm.nloc - 1) / sm.nloc : 0;
    for (int s = sm.virt; s < 8; s += sm.nx) {
        if (nk == 0) break;
        const unsigned char* U = (const unsigned char*)(ws + OFF_PU) + (((size_t)layer * 8 + s) * 16384 << 7) + kg * 32;
        uint4 ri0, ri1, ri2, ri3, rh;
        auto load_oct = [&](int k) __attribute__((always_inline)) {
            const size_t o = (size_t)(sm.rank + k * sm.nloc) * 4 + w;
            const uint4* ip = (const uint4*)(eid + o * 1024) + lane;
            ri0 = ip[0]; ri1 = ip[64]; ri2 = ip[128]; ri3 = ip[192];
            rh = *(const uint4*)(h8 + (o * 8 + (lane >> 3)) * 1024 + s * 128 + (lane & 7) * 16);
        };
        auto store_oct = [&]() __attribute__((always_inline)) {
            uint4* il = (uint4*)ids_l + lane;
            il[0] = ri0; il[64] = ri1; il[128] = ri2; il[192] = ri3;
            *(uint4*)(h8_l + lane * 16) = rh;
        };
        load_oct(0); store_oct();
#pragma unroll 1
        for (int k = 0; k < nk; ++k) {
            if (k + 1 < nk) load_oct(k + 1);
            const size_t o = (size_t)(sm.rank + k * sm.nloc) * 4 + w;
            float* pp = part + ((size_t)s * kT + o * 8) * 128 + lane;
            uint4 ga0[8], ga1[8], gb0[8], gb1[8];
            auto issue = [&](uint4 (&g0)[8], uint4 (&g1)[8], int tk) __attribute__((always_inline)) {
#pragma unroll
                for (int bb = 0; bb < 8; ++bb) {
                    const int e = ids_l[tk * 128 + bb * 16 + n16];
                    const unsigned char* rowp = U + ((size_t)e << 7);
                    g0[bb] = *(const uint4*)rowp; g1[bb] = *(const uint4*)(rowp + 16);
                }
            };
            auto compute = [&](const uint4 (&g0)[8], const uint4 (&g1)[8], int tk) __attribute__((always_inline)) {
                const uint4 a0 = *(const uint4*)(h8_l + tk * 128 + kg * 32), a1 = *(const uint4*)(h8_l + tk * 128 + kg * 32 + 16);
                float r[8];
#pragma unroll
                for (int bb = 0; bb < 8; ++bb) {
                    f32x4 acc = {0.f, 0.f, 0.f, 0.f};
                    acc = __builtin_amdgcn_mfma_f32_16x16x32_fp8_fp8((long)(((unsigned long long)a0.y << 32) | a0.x), (long)(((unsigned long long)g0[bb].y << 32) | g0[bb].x), acc, 0, 0, 0);
                    acc = __builtin_amdgcn_mfma_f32_16x16x32_fp8_fp8((long)(((unsigned long long)a0.w << 32) | a0.z), (long)(((unsigned long long)g0[bb].w << 32) | g0[bb].z), acc, 0, 0, 0);
                    acc = __builtin_amdgcn_mfma_f32_16x16x32_fp8_fp8((long)(((unsigned long long)a1.y << 32) | a1.x), (long)(((unsigned long long)g1[bb].y << 32) | g1[bb].x), acc, 0, 0, 0);
                    acc = __builtin_amdgcn_mfma_f32_16x16x32_fp8_fp8((long)(((unsigned long long)a1.w << 32) | a1.z), (long)(((unsigned long long)g1[bb].w << 32) | g1[bb].z), acc, 0, 0, 0);
                    r[bb] = acc[0];
                }
                const float v0 = kg == 0 ? r[0] : kg == 1 ? r[1] : kg == 2 ? r[2] : r[3];
                const float v1 = kg == 0 ? r[4] : kg == 1 ? r[5] : kg == 2 ? r[6] : r[7];
                pp[tk * 128] = v0; pp[tk * 128 + 64] = v1;
            };
            issue(ga0, ga1, 0);
#pragma unroll
            for (int tk = 0; tk < 8; tk += 2) {
                issue(gb0, gb1, tk + 1);
                __builtin_amdgcn_sched_barrier(0);
                compute(ga0, ga1, tk);
                __builtin_amdgcn_sched_barrier(0);
                if (tk + 2 < 8) issue(ga0, ga1, tk + 2);
                __builtin_amdgcn_sched_barrier(0);
                compute(gb0, gb1, tk + 1);
                __builtin_amdgcn_sched_barrier(0);
            }
            if (k + 1 < nk) store_oct();
        }
    }
}

DEV void phase_peer_comb(const Params& p, int rep = 0) {
    const int tid = ltid();
    const float* part = (const float*)(p.ws + OFF_S1);
    float* gate = (float*)(p.ws + OFF_GATE);
    for (size_t i = (size_t)blockIdx.x * 256 + tid; i < (size_t)kT * 128 / 4; i += (size_t)gridDim.x * 256) {
        float4 a = *(const float4*)(part + i * 4);
#pragma unroll
        for (int x = 1; x < 8; ++x) { const float4 b = *(const float4*)(part + (size_t)x * kT * 128 + i * 4); a.x += b.x; a.y += b.y; a.z += b.z; a.w += b.w; }
        const float4 g = *(const float4*)(gate + i * 4);
        float4 o;
        o.x = g.x * gelu_tanh(a.x * (1.f / kScaleU)); o.y = g.y * gelu_tanh(a.y * (1.f / kScaleU));
        o.z = g.z * gelu_tanh(a.z * (1.f / kScaleU)); o.w = g.w * gelu_tanh(a.w * (1.f / kScaleU));
        if (rep == 0) *(float4*)(gate + i * 4) = o;
    }
}

DEV void phase_peer_v(const Params& p, int layer, char* smem, int rep = 0) {
    const int tid = ltid(), lane = tid & 63, w = tid >> 6, l8 = lane & 7, grp = lane >> 3;
    char* ws = p.ws;
    const SliceMap sm = slice_map(p, smem);
    float* xres = (float*)(ws + OFF_XRES);
    const int* eid = (const int*)(ws + OFF_EID);
    const float* wbuf = (const float*)(ws + OFF_GATE);
    const float* mod = (const float*)(ws + OFF_MOD);
    int* ids_l = (int*)(smem + w * 9216);
    float* w_l = (float*)(smem + w * 9216 + 4096);
    const int nk = sm.rank < 512 ? (512 - sm.rank + sm.nloc - 1) / sm.nloc : 0;
    for (int s = sm.virt; s < 8; s += sm.nx) {
        if (nk == 0) break;
        const unsigned char* V = (const unsigned char*)(ws + OFF_PV) + (((size_t)layer * 8 + s) * 16384 << 7) + l8 * 16;
        uint4 ri0, ri1, ri2, ri3, rw0, rw1, rw2, rw3;
        auto load_oct = [&](int k) __attribute__((always_inline)) {
            const size_t o = (size_t)(sm.rank + k * sm.nloc) * 4 + w;
            const uint4* ip = (const uint4*)(eid + o * 1024) + lane;
            const uint4* wp = (const uint4*)(wbuf + o * 1024) + lane;
            ri0 = ip[0]; ri1 = ip[64]; ri2 = ip[128]; ri3 = ip[192];
            rw0 = wp[0]; rw1 = wp[64]; rw2 = wp[128]; rw3 = wp[192];
        };
        auto store_oct = [&]() __attribute__((always_inline)) {
            uint4* il = (uint4*)ids_l + lane; uint4* wl = (uint4*)w_l + lane;
            il[0] = ri0; il[64] = ri1; il[128] = ri2; il[192] = ri3;
            wl[0] = rw0; wl[64] = rw1; wl[128] = rw2; wl[192] = rw3;
        };
        load_oct(0); store_oct();
#pragma unroll 1
        for (int k = 0; k < nk; ++k) {
            if (k + 1 < nk) load_oct(k + 1);
            const size_t o = (size_t)(sm.rank + k * sm.nloc) * 4 + w;
            const size_t t = o * 8 + grp;
            const int b = (int)(t >> 11);
            float* xp = xres + t * 1024 + s * 128 + l8 * 16;
            const float* g2 = mod + (size_t)(layer * 8 + b) * 6144 + 5120 + s * 128 + l8 * 16;
            float4 xa[4];
#pragma unroll
            for (int c = 0; c < 4; ++c) xa[c] = *(const float4*)(xp + c * 4);
            half2_t out[8];
#pragma unroll
            for (int j = 0; j < 8; ++j) out[j] = (half2_t){(_Float16)0.f, (_Float16)0.f};
            uint4 va[8], vb[8];
            auto issue = [&](uint4 (&v)[8], int c) __attribute__((always_inline)) {
                const int4 i0 = *(const int4*)(ids_l + grp * 128 + c * 8), i1 = *(const int4*)(ids_l + grp * 128 + c * 8 + 4);
                const int e[8] = {i0.x, i0.y, i0.z, i0.w, i1.x, i1.y, i1.z, i1.w};
#pragma unroll
                for (int j = 0; j < 8; ++j) v[j] = *(const uint4*)(V + ((size_t)e[j] << 7));
            };
            auto compute = [&](const uint4 (&v)[8], int c) __attribute__((always_inline)) {
                const float4 w0 = *(const float4*)(w_l + grp * 128 + c * 8), w1 = *(const float4*)(w_l + grp * 128 + c * 8 + 4);
                const float wf[8] = {w0.x, w0.y, w0.z, w0.w, w1.x, w1.y, w1.z, w1.w};
#pragma unroll
                for (int j = 0; j < 8; ++j) {
                    const _Float16 wh = (_Float16)wf[j];
                    const half2_t ww = {wh, wh};
                    const unsigned d[4] = {v[j].x, v[j].y, v[j].z, v[j].w};
#pragma unroll
                    for (int q = 0; q < 4; ++q) {
                        const half2_t lo = __builtin_amdgcn_cvt_scalef32_pk_f16_fp8(d[q], 1.0f, false);
                        const half2_t hi = __builtin_amdgcn_cvt_scalef32_pk_f16_fp8(d[q], 1.0f, true);
                        out[2 * q] = __builtin_elementwise_fma(ww, lo, out[2 * q]);
                        out[2 * q + 1] = __builtin_elementwise_fma(ww, hi, out[2 * q + 1]);
                    }
                    __builtin_amdgcn_sched_barrier(0);
                }
            };
            issue(va, 0);
#pragma unroll
            for (int c = 0; c < 16; c += 2) {
                issue(vb, c + 1);
                __builtin_amdgcn_sched_barrier(0);
                compute(va, c);
                __builtin_amdgcn_sched_barrier(0);
                if (c + 2 < 16) issue(va, c + 2);
                __builtin_amdgcn_sched_barrier(0);
                compute(vb, c + 1);
                __builtin_amdgcn_sched_barrier(0);
            }
            if (rep == 0 || (float)out[0].x == 12345.678f) {
#pragma unroll
                for (int c = 0; c < 4; ++c) {
                    const float4 g4 = *(const float4*)(g2 + c * 4);
                    xa[c].x += g4.x * (float)out[2 * c].x * (1.f / kScaleV); xa[c].y += g4.y * (float)out[2 * c].y * (1.f / kScaleV);
                    xa[c].z += g4.z * (float)out[2 * c + 1].x * (1.f / kScaleV); xa[c].w += g4.w * (float)out[2 * c + 1].y * (1.f / kScaleV);
                    *(float4*)(xp + c * 4) = xa[c];
                }
            }
            if (k + 1 < nk) store_oct();
        }
    }
}

DEV void phase_final(const Params& p) {
    const int tid = ltid(), lane = tid & 63, w = tid >> 6;
    const float* xs = (const float*)(p.ws + OFF_XRES);
    for (int q = blockIdx.x; q < kT / 4; q += gridDim.x) {
        const int t = q * 4 + w;
        const float* xr = xs + (size_t)t * 1024;
        float4 v[4]; float ss = 0.f;
#pragma unroll
        for (int i = 0; i < 4; ++i) { v[i] = *(const float4*)(xr + i * 256 + lane * 4); ss += v[i].x * v[i].x + v[i].y * v[i].y + v[i].z * v[i].z + v[i].w * v[i].w; }
        ss = wave_sum(ss);
        const float rstd = rsqrtf(ss * (1.f / 1024.f) + kEps);
#pragma unroll
        for (int i = 0; i < 4; ++i) {
            const int col = i * 256 + lane * 4;
            const float4 g4 = *(const float4*)(p.final_g + col);
            *(float4*)(p.out + (size_t)t * 1024 + col) = make_float4(v[i].x * rstd * g4.x, v[i].y * rstd * g4.y, v[i].z * rstd * g4.z, v[i].w * rstd * g4.w);
        }
    }
}

DEV void phase_gemm_in(const Params& p, int layer, char* smem) {
    char* ws = p.ws;
    EpiBf16 epi{(bf16_t*)(ws + OFF_COLS), LDC, nullptr, nullptr, LDC};
    gemm_phase((const bf16_t*)(ws + OFF_H), 1024, (const bf16_t*)(ws + OFF_WIN) + (size_t)layer * 2432 * 1024, 1024, 1024, kT / 128, LDC / 128, smem, epi);
}
DEV void phase_gemm_mid(const Params& p, int layer, char* smem) {
    char* ws = p.ws;
    const float* misc = (const float*)(ws + OFF_MISC);
    const float* rstd = (const float*)(ws + OFF_RSTD);
    const bf16_t* cols = (const bf16_t*)(ws + OFF_COLS);
    for (int tile = blockIdx.x; tile < 16 + 384 + 512; tile += gridDim.x) {
        if (tile < 8) {
            EpiBf16 epi{(bf16_t*)(ws + OFF_KCMP), 64, nullptr, misc + (layer * 2 + 0) * 64, 64};
            gemm_tile((const bf16_t*)(ws + OFF_KC), 1024, (const bf16_t*)(ws + OFF_WCK) + (size_t)layer * 128 * 2048, 2048, 2048, tile * 128, 0, smem, epi);
        } else if (tile < 16) {
            EpiBf16 epi{(bf16_t*)(ws + OFF_KCMP) + 1024 * 64, 64, nullptr, misc + (layer * 2 + 1) * 64, 64};
            gemm_tile((const bf16_t*)(ws + OFF_VC), 1024, (const bf16_t*)(ws + OFF_WCV) + (size_t)layer * 128 * 2048, 2048, 2048, (tile - 8) * 128, 0, smem, epi);
        } else if (tile < 16 + 384) {
            const int tt = tile - 16;
            EpiBf16 epi{(bf16_t*)(ws + OFF_QMLA), 384, rstd, nullptr, 384};
            gemm_tile(cols + 1472, LDC, (const bf16_t*)(ws + OFF_WUQ) + (size_t)layer * 384 * 256, 256, 256, (tt / 3) * 128, (tt % 3) * 128, smem, epi);
        } else {
            const int tt = tile - 16 - 384;
            EpiBf16 epi{(bf16_t*)(ws + OFF_KVMLA), 512, rstd + kT, nullptr, 512};
            gemm_tile(cols + 1728, LDC, (const bf16_t*)(ws + OFF_WUKV) + (size_t)layer * 512 * 128, 128, 128, (tt / 4) * 128, (tt % 4) * 128, smem, epi);
        }
    }
}
DEV void phase_gemm_out(const Params& p, int layer, char* smem) {
    char* ws = p.ws;
    EpiRes epi{layer == 0 ? p.x : (const float*)(ws + OFF_XRES), (float*)(ws + OFF_XRES), (const float*)(ws + OFF_MOD) + (size_t)layer * 8 * 6144 + 2048};
    gemm_phase((const bf16_t*)(ws + OFF_O), 1024, (const bf16_t*)(ws + OFF_WOUT) + (size_t)layer * 1024 * 1024, 1024, 1024, kT / 128, 8, smem, epi);
}
DEV void phase_gemm_wq(const Params& p, int layer, char* smem) {
    char* ws = p.ws;
    EpiBf16 epi{(bf16_t*)(ws + OFF_QP), 2048, nullptr, nullptr, 2048};
    gemm_phase((const bf16_t*)(ws + OFF_H), 1024, (const bf16_t*)(ws + OFF_WQ) + (size_t)layer * 2048 * 1024, 1024, 1024, kT / 128, 16, smem, epi);
}
DEV void phase_scores(const Params& p, int layer, char* smem) {
    char* ws = p.ws;
    for (int tile = blockIdx.x; tile < 2048; tile += gridDim.x) {
        const int c = tile >> 10, nt = tile & 1023;
        EpiF32 epi{(float*)(ws + (c ? OFF_S2 : OFF_S1)), kT * 8};
        gemm_tile((const bf16_t*)(ws + OFF_SUBK) + (size_t)(layer * 2 + c) * 16384, 128, (const bf16_t*)(ws + OFF_QP) + c * 128, 256, 128, 0, nt * 128, smem, epi);
    }
}

constexpr int NPHASE = 16;
DEV void run_phase(const Params& p, int ph, int layer, char* smem, int rep = 0) {
    switch (ph) {
        case 0: phase_prologue(p, smem); break;
        case 1: phase_norm(p, layer, 0); break;
        case 2: phase_gemm_in(p, layer, smem); break;
        case 3: phase_layout1(p, smem); break;
        case 4: phase_gemm_mid(p, layer, smem); break;
        case 5: phase_layout2(p, smem); break;
        case 6: phase_attn(p, layer, smem, rep); break;
        case 7: phase_gemm_out(p, layer, smem); break;
        case 8: phase_norm(p, layer, 1); break;
        case 9: phase_gemm_wq(p, layer, smem); break;
        case 10: phase_scores(p, layer, smem); break;
        case 11: phase_topk(p, smem); break;
        case 12: phase_peer_u(p, layer, smem, rep); break;
        case 13: phase_peer_comb(p, rep); break;
        case 14: phase_peer_v(p, layer, smem, rep); break;
        case 15: if (layer == 0) phase_norm(p, 1, 0); else phase_final(p); break;
        default: break;
    }
}

#if !FUSED
template <int PH>
__global__ void __launch_bounds__(256, 2) k_phase(Params p, int layer) {
    __shared__ __attribute__((aligned(16))) char smem[SM_TOTAL];
    run_phase(p, PH, layer, smem);
}
template <int PH> static void launch_phase(const Params& p, int layer, hipStream_t stream) { k_phase<PH><<<512, 256, 0, stream>>>(p, layer); }
static void launch_ph(int ph, const Params& p, int layer, hipStream_t stream) {
    switch (ph) {
        case 0: launch_phase<0>(p, layer, stream); break;
        case 1: launch_phase<1>(p, layer, stream); break;
        case 2: launch_phase<2>(p, layer, stream); break;
        case 3: launch_phase<3>(p, layer, stream); break;
        case 4: launch_phase<4>(p, layer, stream); break;
        case 5: launch_phase<5>(p, layer, stream); break;
        case 6: launch_phase<6>(p, layer, stream); break;
        case 7: launch_phase<7>(p, layer, stream); break;
        case 8: launch_phase<8>(p, layer, stream); break;
        case 9: launch_phase<9>(p, layer, stream); break;
        case 10: launch_phase<10>(p, layer, stream); break;
        case 11: launch_phase<11>(p, layer, stream); break;
        case 12: launch_phase<12>(p, layer, stream); break;
    }
}
#else
#if TS_A >= 0
#define TSTAMP(I) if (blockIdx.x == 0 && threadIdx.x == 0) ((unsigned long long*)(p.ws + 32768))[I] = __builtin_amdgcn_s_memrealtime();
#else
#define TSTAMP(I)
#endif
__global__ void __launch_bounds__(256, 2) k_mega(Params p) {
    extern __shared__ __attribute__((aligned(1024))) char smem[];
    cg::grid_group grid = cg::this_grid();
    volatile LAS unsigned* st = (volatile LAS unsigned*)(smem + SM_CTRL);
    if (threadIdx.x == 0) { st[0] = 0u; st[1] = 0u; st[2] = 0u; }
    __syncthreads();
    const XcdBarrier xb = xcd_barrier_post((unsigned*)p.ws, st);
    TSTAMP(0)
    run_phase(p, 0, 0, smem);
    if (p.out == nullptr) grid.sync();
    xcd_barrier(xb);
    TSTAMP(1)
    run_phase(p, 1, 0, smem);
    xcd_barrier(xb);
    TSTAMP(2)
#define STEP(PH, L) { run_phase(p, PH, L, smem, 0); xcd_barrier(xb); TSTAMP(2 + (L) * 16 + (PH)) }
#define LAYER(L) STEP(2, L) STEP(3, L) STEP(4, L) STEP(5, L) STEP(6, L) STEP(7, L) STEP(8, L) STEP(9, L) STEP(10, L) STEP(11, L) STEP(12, L) STEP(13, L) STEP(14, L)
    LAYER(0)
    STEP(15, 0)
    LAYER(1)
    run_phase(p, 15, 1, smem);
#if TS_A >= 0
    TSTAMP(2 + 16 + 15)
    __syncthreads();
    if (blockIdx.x == 0 && threadIdx.x == 0) {
        const unsigned long long* ts = (const unsigned long long*)(p.ws + 32768);
        p.out[0] += (float)(ts[TS_B] - ts[TS_A]) * 0.001f;
    }
#endif
}
#endif

extern "C" void kernel_launch(void* const* d_in, const int* in_sizes, int n_in, void* d_out, int out_size, void* d_ws, size_t ws_size, hipStream_t stream) {
    Params p{};
    const float** pp = (const float**)&p;
    for (int i = 0; i < 28; ++i) pp[i] = (const float*)d_in[i];
    p.out = (float*)d_out;
    p.ws = (char*)d_ws;
    if (ws_size < OFF_END) fprintf(stderr, "workspace too small: %zu < %zu\n", ws_size, (size_t)OFF_END);
    (void)hipMemsetAsync(d_ws, 0, 65536, stream);
#if !FUSED
    launch_ph(0, p, 0, stream);
    launch_ph(1, p, 0, stream);
    for (int l = 0; l < 2; ++l)
        for (int ph = 2; ph < NPHASE; ++ph) launch_ph(ph, p, l, stream);
#else
    static int grid_blocks = 0;
    if (!grid_blocks) {
        int dev = 0, cus = 0, per_cu = 0;
        (void)hipGetDevice(&dev);
        (void)hipDeviceGetAttribute(&cus, hipDeviceAttributeMultiprocessorCount, dev);
        (void)hipFuncSetAttribute((const void*)k_mega, hipFuncAttributeMaxDynamicSharedMemorySize, SM_TOTAL);
        (void)hipOccupancyMaxActiveBlocksPerMultiprocessor(&per_cu, (const void*)k_mega, 256, SM_TOTAL);
        if (per_cu > 2) per_cu = 2;
        if (per_cu < 1) per_cu = 1;
        grid_blocks = cus * per_cu;
    }
    void* args[] = {&p};
    hipError_t e = hipLaunchCooperativeKernel((const void*)k_mega, dim3(grid_blocks), dim3(256), args, SM_TOTAL, stream);
    if (e != hipSuccess) fprintf(stderr, "cooperative launch failed: %s (grid %d)\n", hipGetErrorString(e), grid_blocks);
#endif
}
```

```cpp
#include <hip/hip_runtime.h>
#include <hip/hip_cooperative_groups.h>
#include <stdint.h>
#include <stdio.h>
namespace cg = cooperative_groups;

#ifndef FUSED
#define FUSED 1
#endif
#ifndef TS_A
#define TS_A -1
#define TS_B -1
#endif
#ifndef PROBE_PH
#define PROBE_PH -1
#define PROBE_L 1
#define PROBE_REP 0
#endif

#define DEV __device__ __forceinline__
#define LAS __attribute__((address_space(3)))
typedef unsigned short bf16_t;
typedef short bf16x8 __attribute__((ext_vector_type(8)));
typedef float f32x16 __attribute__((ext_vector_type(16)));

constexpr int kB = 8, kS = 2048, kT = kB * kS, kD = 1024, LDC = 2432;
constexpr float kEps = 1e-6f;
constexpr float kNeg = -1e30f;
constexpr float kLog2e = 1.4426950408889634f;
constexpr float kScaleU = 256.f, kScaleV = 32.f;

constexpr size_t OFF_CTRL = 0;
constexpr size_t OFF_MOD  = 65536;
constexpr size_t OFF_ROPE = OFF_MOD + 2ull * 8 * 6144 * 4;
constexpr size_t OFF_MISC = OFF_ROPE + 2048ull * 96 * 4;
constexpr size_t OFF_WIN  = OFF_MISC + 4096;
constexpr size_t OFF_WOUT = OFF_WIN + 2ull * 2432 * 1024 * 2;
constexpr size_t OFF_WQ   = OFF_WOUT + 2ull * 1024 * 1024 * 2;
constexpr size_t OFF_WUQ  = OFF_WQ + 2ull * 2048 * 1024 * 2;
constexpr size_t OFF_WUKV = OFF_WUQ + 2ull * 384 * 256 * 2;
constexpr size_t OFF_WCK  = OFF_WUKV + 2ull * 512 * 128 * 2;
constexpr size_t OFF_WCV  = OFF_WCK + 2ull * 128 * 2048 * 2;
constexpr size_t OFF_SUBK = OFF_WCV + 2ull * 128 * 2048 * 2;
constexpr size_t OFF_PU   = OFF_SUBK + 2ull * 2 * 128 * 128 * 2;
constexpr size_t OFF_PV   = OFF_PU + 2ull * 16384 * 1024;
constexpr size_t OFF_XRES = OFF_PV + 2ull * 16384 * 1024;
constexpr size_t OFF_H    = OFF_XRES + (size_t)kT * 1024 * 4;
constexpr size_t OFF_H8   = OFF_H + (size_t)kT * 1024 * 2;
constexpr size_t OFF_RSTD = OFF_H8 + (size_t)kT * 1024;
constexpr size_t OFF_KCMP = OFF_RSTD + 2ull * kT * 4;
constexpr size_t OFF_EID  = OFF_KCMP + 2ull * 1024 * 64 * 2;
constexpr size_t OFF_GATE = OFF_EID + (size_t)kT * 128 * 4;
constexpr size_t OFF_QP   = OFF_GATE + (size_t)kT * 128 * 4;
constexpr size_t OFF_COLS = OFF_QP + (size_t)kT * 2048 * 2;
constexpr size_t OFF_KC   = OFF_COLS + (size_t)kT * LDC * 2;
constexpr size_t OFF_VC   = OFF_KC + (size_t)(kT + 64) * 64 * 2;
constexpr size_t OFF_VT   = OFF_VC + (size_t)(kT + 64) * 64 * 2;
constexpr size_t OFF_QMLA = OFF_VT + 8ull * 12 * 64 * 2048 * 2;
constexpr size_t OFF_KVMLA = OFF_QMLA + (size_t)kT * 384 * 2;
constexpr size_t OFF_O    = OFF_KVMLA + (size_t)kT * 512 * 2;
constexpr size_t OFF_END  = OFF_O + (size_t)kT * 1024 * 2;
constexpr size_t OFF_S1 = OFF_COLS, OFF_S2 = OFF_COLS + (size_t)kT * 8 * 128 * 4;
static_assert(OFF_S2 + (size_t)kT * 8 * 128 * 4 <= OFF_O, "alias region too small");
static_assert(OFF_END <= (512ull << 20), "workspace too large");

struct Params {
    const float *x, *c, *ada_w, *ada_b, *norm_mix_g, *norm_ffn_g, *w_in, *pos_k, *pos_v, *cmp_wk, *cmp_wv;
    const float *lq1, *lk1, *lq2, *lk2, *sub_g, *mla_qg, *mla_wuq, *mla_kvg, *mla_wukv, *sinks, *w_out;
    const float *w_q, *subk1, *subk2, *pu, *pv, *final_g;
    float* out;
    char* ws;
};

DEV int ltid() { int t = threadIdx.x; asm volatile("" : "+v"(t)); return t; }
DEV float bf2f(bf16_t v) { return __uint_as_float(((unsigned)v) << 16); }
DEV bf16_t f2bf(float f) { unsigned u = __float_as_uint(f); u += 0x7fffu + ((u >> 16) & 1u); return (bf16_t)(u >> 16); }
DEV unsigned pack2(float lo, float hi) { return (unsigned)f2bf(lo) | ((unsigned)f2bf(hi) << 16); }
DEV float lo16(unsigned u) { return __uint_as_float(u << 16); }
DEV float hi16(unsigned u) { return __uint_as_float(u & 0xffff0000u); }
DEV float wave_sum(float v) {
#pragma unroll
    for (int o = 32; o > 0; o >>= 1) v += __shfl_xor(v, o, 64);
    return v;
}
DEV float xor32f(float v, int lane) { return __int_as_float(__builtin_amdgcn_ds_bpermute((lane ^ 32) << 2, __float_as_int(v))); }
DEV float lanef(float v, int src) { return __int_as_float(__builtin_amdgcn_ds_bpermute(src << 2, __float_as_int(v))); }
DEV f32x16 mfma32(bf16x8 a, bf16x8 b, f32x16 c) { return __builtin_amdgcn_mfma_f32_32x32x16_bf16(a, b, c, 0, 0, 0); }
DEV f32x16 zero16() { f32x16 z;
#pragma unroll
    for (int i = 0; i < 16; ++i) z[i] = 0.f;
    return z; }
DEV float gelu_tanh(float x) {
    const float u = 0.7978845608028654f * (x + 0.044715f * x * x * x);
    const float e = __expf(2.f * u);
    const float t = 1.f - 2.f / (e + 1.f);
    return 0.5f * x * (1.f + t);
}

template <class Epi>
DEV void gemm_tile(const bf16_t* __restrict__ A, int lda, const bf16_t* __restrict__ Bt, int ldb, int K, int m0, int n0, char* smem, const Epi& epi) {
    const int tid = ltid(), lane = tid & 63, w = tid >> 6, wm = w >> 1, wn = w & 1, ql = lane & 31, hh = lane >> 5;
    f32x16 acc[2][2];
#pragma unroll
    for (int i = 0; i < 2; ++i)
#pragma unroll
        for (int j = 0; j < 2; ++j) acc[i][j] = zero16();
    const int srow = lane >> 3, spos = lane & 7;
    const int c0 = spos ^ ((srow >> 1) & 7), c1 = spos ^ ((4 + (srow >> 1)) & 7);
    const bf16_t* Ag0 = A + (size_t)(m0 + w * 32 + srow) * lda + c0 * 8;
    const bf16_t* Ag1 = A + (size_t)(m0 + w * 32 + 8 + srow) * lda + c1 * 8;
    const bf16_t* Bg0 = Bt + (size_t)(n0 + w * 32 + srow) * ldb + c0 * 8;
    const bf16_t* Bg1 = Bt + (size_t)(n0 + w * 32 + 8 + srow) * ldb + c1 * 8;
    const size_t a16 = (size_t)16 * lda, b16 = (size_t)16 * ldb;
    auto stage = [&](int kt, int buf) __attribute__((always_inline)) {
        char* sa = smem + buf * 32768 + w * 4096;
        char* sb = sa + 16384;
        const int ko = kt * 64;
        __builtin_amdgcn_global_load_lds((const unsigned*)(Ag0 + ko), (LAS unsigned*)(sa), 16, 0, 0);
        __builtin_amdgcn_global_load_lds((const unsigned*)(Ag1 + ko), (LAS unsigned*)(sa + 1024), 16, 0, 0);
        __builtin_amdgcn_global_load_lds((const unsigned*)(Ag0 + a16 + ko), (LAS unsigned*)(sa + 2048), 16, 0, 0);
        __builtin_amdgcn_global_load_lds((const unsigned*)(Ag1 + a16 + ko), (LAS unsigned*)(sa + 3072), 16, 0, 0);
        __builtin_amdgcn_global_load_lds((const unsigned*)(Bg0 + ko), (LAS unsigned*)(sb), 16, 0, 0);
        __builtin_amdgcn_global_load_lds((const unsigned*)(Bg1 + ko), (LAS unsigned*)(sb + 1024), 16, 0, 0);
        __builtin_amdgcn_global_load_lds((const unsigned*)(Bg0 + b16 + ko), (LAS unsigned*)(sb + 2048), 16, 0, 0);
        __builtin_amdgcn_global_load_lds((const unsigned*)(Bg1 + b16 + ko), (LAS unsigned*)(sb + 3072), 16, 0, 0);
    };
    const int key = (ql >> 1) & 7;
    const int arow = (wm * 64 + ql) * 128, brow = (wn * 64 + ql) * 128;
    const int nk = K >> 6;
    __syncthreads();
    stage(0, 0);
    for (int kt = 0; kt < nk; ++kt) {
        asm volatile("s_waitcnt vmcnt(0)" ::: "memory");
        __syncthreads();
        if (kt + 1 < nk) stage(kt + 1, (kt + 1) & 1);
        const char* As = smem + (kt & 1) * 32768;
        const char* Bs = As + 16384;
#pragma unroll
        for (int ks = 0; ks < 4; ++ks) {
            const int co = ((ks * 2 + hh) ^ key) << 4;
            bf16x8 a[2], b[2];
#pragma unroll
            for (int i = 0; i < 2; ++i) {
                a[i] = *(const bf16x8*)(As + arow + i * 4096 + co);
                b[i] = *(const bf16x8*)(Bs + brow + i * 4096 + co);
            }
#pragma unroll
            for (int i = 0; i < 2; ++i)
#pragma unroll
                for (int j = 0; j < 2; ++j) acc[i][j] = mfma32(a[i], b[j], acc[i][j]);
        }
    }
    __syncthreads();
    float* Cs = (float*)smem;
#pragma unroll
    for (int i = 0; i < 2; ++i)
#pragma unroll
        for (int j = 0; j < 2; ++j)
#pragma unroll
            for (int r = 0; r < 16; ++r)
                Cs[(wm * 64 + i * 32 + (r & 3) + 8 * (r >> 2) + 4 * hh) * 128 + wn * 64 + j * 32 + ql] = acc[i][j][r];
    __syncthreads();
    epi.tile(m0, n0, Cs, tid);
}

struct EpiBf16 {
    bf16_t* C; int ldc; const float* rowscale; const float* colbias; int nvalid;
    DEV void tile(int m0, int n0, const float* Cs, int tid) const {
#pragma unroll
        for (int it = 0; it < 8; ++it) {
            const int id = tid + 256 * it, r = id >> 4, c8 = (id & 15) * 8;
            if (n0 + c8 >= nvalid) continue;
            float4 a = *(const float4*)(Cs + r * 128 + c8), b = *(const float4*)(Cs + r * 128 + c8 + 4);
            if (rowscale) { const float sc = rowscale[m0 + r]; a.x *= sc; a.y *= sc; a.z *= sc; a.w *= sc; b.x *= sc; b.y *= sc; b.z *= sc; b.w *= sc; }
            if (colbias) { const float4 ba = *(const float4*)(colbias + n0 + c8), bb = *(const float4*)(colbias + n0 + c8 + 4);
                a.x += ba.x; a.y += ba.y; a.z += ba.z; a.w += ba.w; b.x += bb.x; b.y += bb.y; b.z += bb.z; b.w += bb.w; }
            *(uint4*)(C + (size_t)(m0 + r) * ldc + n0 + c8) = make_uint4(pack2(a.x, a.y), pack2(a.z, a.w), pack2(b.x, b.y), pack2(b.z, b.w));
        }
    }
};
struct EpiF32 {
    float* C; int ldc;
    DEV void tile(int m0, int n0, const float* Cs, int tid) const {
#pragma unroll
        for (int it = 0; it < 16; ++it) {
            const int id = tid + 256 * it, r = id >> 5, c4 = (id & 31) * 4;
            *(float4*)(C + (size_t)(m0 + r) * ldc + n0 + c4) = *(const float4*)(Cs + r * 128 + c4);
        }
    }
};
struct EpiRes {
    const float* xin; float* xout; const float* gate;
    DEV void tile(int m0, int n0, const float* Cs, int tid) const {
        const float* g = gate + (size_t)(m0 >> 11) * 6144 + n0;
#pragma unroll
        for (int it = 0; it < 16; ++it) {
            const int id = tid + 256 * it, r = id >> 5, c4 = (id & 31) * 4;
            const float4 v = *(const float4*)(Cs + r * 128 + c4), g4 = *(const float4*)(g + c4);
            float4 x = *(const float4*)(xin + (size_t)(m0 + r) * 1024 + n0 + c4);
            x.x += g4.x * v.x; x.y += g4.y * v.y; x.z += g4.z * v.z; x.w += g4.w * v.w;
            *(float4*)(xout + (size_t)(m0 + r) * 1024 + n0 + c4) = x;
        }
    }
};

template <class Epi>
DEV void gemm_phase(const bf16_t* A, int lda, const bf16_t* Bt, int ldb, int K, int mtiles, int ntiles, char* smem, const Epi& epi) {
    for (int tile = blockIdx.x; tile < mtiles * ntiles; tile += gridDim.x) {
        const int mt = tile / ntiles, nt = tile % ntiles;
        gemm_tile(A, lda, Bt, ldb, K, mt * 128, nt * 128, smem, epi);
    }
}

DEV int win_srccol(int n) {
    if (n < 652) return n;
    if (n < 704) return -1;
    if (n < 1888) return n - 52;
    if (n < 1920) return -1;
    return n - 84;
}
DEV void transpose_tile(const float* __restrict__ src, int ld_src, int nsrc_valid, int mode, const float* __restrict__ rowscale,
                        bf16_t* __restrict__ dst, int K, int n0, int k0, char* smem) {
    bf16_t* Ls = (bf16_t*)smem;
    const int tid = ltid();
    __syncthreads();
    const int nn = tid & 63, n = n0 + nn;
    const int sc = (mode == 1) ? win_srccol(n) : (n < nsrc_valid ? n : -1);
#pragma unroll 4
    for (int i = 0; i < 16; ++i) {
        const int kk = (tid >> 6) + 4 * i;
        float v = 0.f;
        if (sc >= 0) { v = src[(size_t)(k0 + kk) * ld_src + sc]; if (rowscale) v *= rowscale[k0 + kk]; }
        Ls[nn * 72 + kk] = f2bf(v);
    }
    __syncthreads();
#pragma unroll
    for (int i = 0; i < 2; ++i) {
        const int r = (tid >> 3) + 32 * i, ch = tid & 7;
        *(uint4*)(dst + (size_t)(n0 + r) * K + k0 + ch * 8) = *(const uint4*)(Ls + r * 72 + ch * 8);
    }
}

DEV void convert_stream(const float* __restrict__ src, bf16_t* __restrict__ dst, size_t n8) {
    const int tid = ltid();
    for (size_t i = (size_t)blockIdx.x * 256 + tid; i < n8; i += (size_t)gridDim.x * 256) {
        const float4 a = *(const float4*)(src + i * 8), b = *(const float4*)(src + i * 8 + 4);
        uint4 o; o.x = pack2(a.x, a.y); o.y = pack2(a.z, a.w); o.z = pack2(b.x, b.y); o.w = pack2(b.z, b.w);
        *(uint4*)(dst + i * 8) = o;
    }
}

DEV void convert_fp8_stream(const float* __restrict__ src, unsigned char* __restrict__ dst, size_t n16, float scale) {
    const int tid = ltid();
    const size_t stride = (size_t)gridDim.x * 256;
    for (size_t i0 = (size_t)blockIdx.x * 256 + tid; i0 < n16; i0 += stride * 4) {
        float4 q[4][4];
#pragma unroll
        for (int u = 0; u < 4; ++u) {
            const size_t i = i0 + u * stride < n16 ? i0 + u * stride : i0;
#pragma unroll
            for (int c = 0; c < 4; ++c) q[u][c] = *(const float4*)(src + i * 16 + c * 4);
        }
#pragma unroll
        for (int u = 0; u < 4; ++u) {
            const size_t i = i0 + u * stride;
            if (i >= n16) break;
            unsigned o[4];
#pragma unroll
            for (int j = 0; j < 4; ++j) {
                const float4 v = q[u][j];
                unsigned w = 0u;
                w = __builtin_amdgcn_cvt_pk_fp8_f32(fminf(fmaxf(v.x * scale, -440.f), 440.f), fminf(fmaxf(v.y * scale, -440.f), 440.f), w, false);
                w = __builtin_amdgcn_cvt_pk_fp8_f32(fminf(fmaxf(v.z * scale, -440.f), 440.f), fminf(fmaxf(v.w * scale, -440.f), 440.f), w, true);
                o[j] = w;
            }
            const size_t rowg = i >> 6; const int c16 = (int)(i & 63);
            const size_t l = rowg >> 14, row = rowg & 16383;
            *(uint4*)(dst + (((l * 8 + (c16 >> 3)) * 16384 + row) << 7) + (c16 & 7) * 16) = make_uint4(o[0], o[1], o[2], o[3]);
        }
    }
}

constexpr int J_ROPE = 384, J_MOD = 192, J_MISC = 5;
constexpr int J_TW_L = 608 + 256 + 512 + 24 + 16 + 64 + 64;
constexpr int J_TOTAL = J_ROPE + J_MOD + J_MISC + 2 * J_TW_L;

DEV void prologue_job(const Params& p, int job, char* smem) {
    const int tid = ltid();
    char* ws = p.ws;
    if (job < J_ROPE) {
        const int idx = job * 256 + tid;
        const int s = idx / 48, j = idx % 48;
        float* rope = (float*)(ws + OFF_ROPE);
        float inv; float *pc, *ps;
        if (j < 32) { inv = exp2f(-(float)j * (13.287712379549449f / 32.f)); pc = rope + s * 32 + j; ps = rope + 2048 * 32 + s * 32 + j; }
        else { const int i = j - 32; inv = exp2f(-(float)i * (13.287712379549449f / 16.f)); pc = rope + 2048 * 64 + s * 16 + i; ps = rope + 2048 * 64 + 2048 * 16 + s * 16 + i; }
        const double a = (double)s * (double)inv;
        const double kk = rint(a * 0.15915494309189535);
        const float r = (float)fma(-kk, 6.283185307179586, a);
        *pc = cosf(r); *ps = sinf(r);
        return;
    }
    job -= J_ROPE;
    if (job < J_MOD) {
        const int l = job / 96, n0 = (job % 96) * 64;
        float* sc = (float*)smem;
        __syncthreads();
        for (int i = tid; i < 8192; i += 256) { const float v = p.c[i]; sc[i] = v / (1.f + __expf(-v)); }
        __syncthreads();
        const int kp = tid >> 6, col = tid & 63;
        float acc[8];
#pragma unroll
        for (int b = 0; b < 8; ++b) acc[b] = 0.f;
        const float* wp = p.ada_w + (size_t)l * 1024 * 6144 + n0 + col;
        for (int k = kp * 256; k < kp * 256 + 256; ++k) {
            const float wv = wp[(size_t)k * 6144];
#pragma unroll
            for (int b = 0; b < 8; ++b) acc[b] += sc[b * 1024 + k] * wv;
        }
        float* red = sc + 8192;
#pragma unroll
        for (int b = 0; b < 8; ++b) red[(kp * 8 + b) * 64 + col] = acc[b];
        __syncthreads();
        float* mod = (float*)(ws + OFF_MOD);
        for (int idx = tid; idx < 512; idx += 256) {
            const int b = idx >> 6, cl = idx & 63;
            const float v = red[(0 * 8 + b) * 64 + cl] + red[(1 * 8 + b) * 64 + cl] + red[(2 * 8 + b) * 64 + cl] + red[(3 * 8 + b) * 64 + cl];
            mod[(size_t)(l * 8 + b) * 6144 + n0 + cl] = v + p.ada_b[l * 6144 + n0 + cl];
        }
        return;
    }
    job -= J_MOD;
    if (job < J_MISC) {
        float* misc = (float*)(ws + OFF_MISC);
        if (job < 4) {
            const int l = job >> 1, kv = job & 1;
            const float* pos = (kv ? p.pos_v : p.pos_k) + l * 2048;
            const float* wsrc = (kv ? p.cmp_wv : p.cmp_wk) + (size_t)l * 2048 * 64;
            float* red = (float*)smem;
            __syncthreads();
            const int kp = tid >> 6, n = tid & 63;
            float acc = 0.f;
            for (int k = kp * 512; k < kp * 512 + 512; ++k) acc += pos[k] * wsrc[(size_t)k * 64 + n];
            red[kp * 64 + n] = acc;
            __syncthreads();
            if (tid < 64) misc[(l * 2 + kv) * 64 + tid] = red[tid] + red[64 + tid] + red[128 + tid] + red[192 + tid];
        } else if (tid < 2) {
            const int l = tid;
            float d1 = 0.f, d2 = 0.f;
            for (int i = 0; i < 32; ++i) { d1 += p.lq1[l * 32 + i] * p.lk1[l * 32 + i]; d2 += p.lq2[l * 32 + i] * p.lk2[l * 32 + i]; }
            const float lam_init = 0.8f - 0.6f * expf(-0.3f * (float)l);
            misc[256 + l] = expf(d1) - expf(d2) + lam_init;
            misc[258 + l] = 1.f - lam_init;
        }
        return;
    }
    job -= J_MISC;
    const int l = job / J_TW_L; int j = job % J_TW_L;
    if (j < 608) { transpose_tile(p.w_in + (size_t)l * 1024 * 2348, 2348, 2348, 1, nullptr, (bf16_t*)(ws + OFF_WIN) + (size_t)l * 2432 * 1024, 1024, (j / 16) * 64, (j % 16) * 64, smem); return; }
    j -= 608;
    if (j < 256) { transpose_tile(p.w_out + (size_t)l * 1024 * 1024, 1024, 1024, 0, nullptr, (bf16_t*)(ws + OFF_WOUT) + (size_t)l * 1024 * 1024, 1024, (j / 16) * 64, (j % 16) * 64, smem); return; }
    j -= 256;
    if (j < 512) { transpose_tile(p.w_q + (size_t)l * 1024 * 2048, 2048, 2048, 0, nullptr, (bf16_t*)(ws + OFF_WQ) + (size_t)l * 2048 * 1024, 1024, (j / 16) * 64, (j % 16) * 64, smem); return; }
    j -= 512;
    if (j < 24) { transpose_tile(p.mla_wuq + (size_t)l * 256 * 384, 384, 384, 0, p.mla_qg + l * 256, (bf16_t*)(ws + OFF_WUQ) + (size_t)l * 384 * 256, 256, (j / 4) * 64, (j % 4) * 64, smem); return; }
    j -= 24;
    if (j < 16) { transpose_tile(p.mla_wukv + (size_t)l * 128 * 512, 512, 512, 0, p.mla_kvg + l * 128, (bf16_t*)(ws + OFF_WUKV) + (size_t)l * 512 * 128, 128, (j / 2) * 64, (j % 2) * 64, smem); return; }
    j -= 16;
    if (j < 64) { transpose_tile(p.cmp_wk + (size_t)l * 2048 * 64, 64, 64, 0, nullptr, (bf16_t*)(ws + OFF_WCK) + (size_t)l * 128 * 2048, 2048, (j / 32) * 64, (j % 32) * 64, smem); return; }
    j -= 64;
    transpose_tile(p.cmp_wv + (size_t)l * 2048 * 64, 64, 64, 0, nullptr, (bf16_t*)(ws + OFF_WCV) + (size_t)l * 128 * 2048, 2048, (j / 32) * 64, (j % 32) * 64, smem);
}

DEV void phase_prologue(const Params& p, char* smem) {
    for (int job = blockIdx.x; job < J_TOTAL; job += gridDim.x) prologue_job(p, job, smem);
    char* ws = p.ws;
    convert_fp8_stream(p.pu, (unsigned char*)(ws + OFF_PU), 2ull * 16384 * 1024 / 16, kScaleU);
    convert_fp8_stream(p.pv, (unsigned char*)(ws + OFF_PV), 2ull * 16384 * 1024 / 16, kScaleV);
    for (int l = 0; l < 2; ++l) {
        convert_stream(p.subk1 + (size_t)l * 16384, (bf16_t*)(ws + OFF_SUBK) + (size_t)(l * 2 + 0) * 16384, 16384 / 8);
        convert_stream(p.subk2 + (size_t)l * 16384, (bf16_t*)(ws + OFF_SUBK) + (size_t)(l * 2 + 1) * 16384, 16384 / 8);
    }
}

DEV void phase_norm(const Params& p, int layer, int which) {
    const int tid = ltid(), lane = tid & 63, w = tid >> 6;
    const float* xs = (layer == 0 && which == 0) ? p.x : (const float*)(p.ws + OFF_XRES);
    const float* g = (which == 0 ? p.norm_mix_g : p.norm_ffn_g) + layer * 1024;
    const float* mod = (const float*)(p.ws + OFF_MOD) + (size_t)layer * 8 * 6144;
    bf16_t* h = (bf16_t*)(p.ws + OFF_H);
    for (int q = blockIdx.x; q < kT / 4; q += gridDim.x) {
        const int t = q * 4 + w, b = t >> 11;
        const float* xr = xs + (size_t)t * 1024;
        float4 v[4]; float ss = 0.f;
#pragma unroll
        for (int i = 0; i < 4; ++i) { v[i] = *(const float4*)(xr + i * 256 + lane * 4); ss += v[i].x * v[i].x + v[i].y * v[i].y + v[i].z * v[i].z + v[i].w * v[i].w; }
        ss = wave_sum(ss);
        const float rstd = rsqrtf(ss * (1.f / 1024.f) + kEps);
        const float* sh = mod + (size_t)b * 6144 + (which ? 3072 : 0);
        const float* sc = sh + 1024;
#pragma unroll
        for (int i = 0; i < 4; ++i) {
            const int col = i * 256 + lane * 4;
            const float4 g4 = *(const float4*)(g + col), s4 = *(const float4*)(sc + col), h4 = *(const float4*)(sh + col);
            const float o0 = v[i].x * rstd * g4.x * (1.f + s4.x) + h4.x, o1 = v[i].y * rstd * g4.y * (1.f + s4.y) + h4.y;
            const float o2 = v[i].z * rstd * g4.z * (1.f + s4.z) + h4.z, o3 = v[i].w * rstd * g4.w * (1.f + s4.w) + h4.w;
            uint2 o; o.x = pack2(o0, o1); o.y = pack2(o2, o3);
            *(uint2*)(h + (size_t)t * 1024 + col) = o;
        }
    }
}

DEV void rope8(uint4& x1, uint4& x2, const float* cs, const float* sn) {
    const float4 c0 = *(const float4*)cs, c1 = *(const float4*)(cs + 4), s0 = *(const float4*)sn, s1 = *(const float4*)(sn + 4);
    const float cc[8] = {c0.x, c0.y, c0.z, c0.w, c1.x, c1.y, c1.z, c1.w};
    const float ss[8] = {s0.x, s0.y, s0.z, s0.w, s1.x, s1.y, s1.z, s1.w};
    unsigned a[4] = {x1.x, x1.y, x1.z, x1.w}, b[4] = {x2.x, x2.y, x2.z, x2.w};
#pragma unroll
    for (int i = 0; i < 4; ++i) {
        const float a0 = lo16(a[i]), a1 = hi16(a[i]), b0 = lo16(b[i]), b1 = hi16(b[i]);
        const float o10 = a0 * cc[2 * i] - b0 * ss[2 * i], o11 = a1 * cc[2 * i + 1] - b1 * ss[2 * i + 1];
        const float o20 = a0 * ss[2 * i] + b0 * cc[2 * i], o21 = a1 * ss[2 * i + 1] + b1 * cc[2 * i + 1];
        a[i] = pack2(o10, o11); b[i] = pack2(o20, o21);
    }
    x1 = make_uint4(a[0], a[1], a[2], a[3]); x2 = make_uint4(b[0], b[1], b[2], b[3]);
}
DEV void vt_tile(const bf16_t* __restrict__ src, int ld, bf16_t* __restrict__ dst, char* smem) {
    bf16_t* Ls = (bf16_t*)smem;
    const int tid = ltid();
    __syncthreads();
#pragma unroll
    for (int i = 0; i < 2; ++i) {
        const int id = tid + 256 * i, tok = id >> 3, ch = id & 7;
        *(uint4*)(Ls + tok * 72 + ch * 8) = *(const uint4*)(src + (size_t)tok * ld + ch * 8);
    }
    __syncthreads();
#pragma unroll
    for (int i = 0; i < 2; ++i) {
        const int id = tid + 256 * i, d = id >> 3, tc = id & 7;
        unsigned short e[8];
#pragma unroll
        for (int j = 0; j < 8; ++j) e[j] = Ls[(tc * 8 + j) * 72 + d];
        uint4 o;
        o.x = (unsigned)e[0] | ((unsigned)e[1] << 16); o.y = (unsigned)e[2] | ((unsigned)e[3] << 16);
        o.z = (unsigned)e[4] | ((unsigned)e[5] << 16); o.w = (unsigned)e[6] | ((unsigned)e[7] << 16);
        *(uint4*)(dst + (size_t)d * 2048 + tc * 8) = o;
    }
}

DEV void phase_layout1(const Params& p, char* smem) {
    char* ws = p.ws;
    bf16_t* cols = (bf16_t*)(ws + OFF_COLS);
    bf16_t* kc = (bf16_t*)(ws + OFF_KC);
    bf16_t* vc = (bf16_t*)(ws + OFF_VC);
    bf16_t* VT = (bf16_t*)(ws + OFF_VT);
    float* rstd = (float*)(ws + OFF_RSTD);
    const float* rope = (const float*)(ws + OFF_ROPE);
    const float *cos64 = rope, *sin64 = rope + 2048 * 32, *cos32 = rope + 2048 * 64, *sin32 = rope + 2048 * 64 + 2048 * 16;
    const int tid = ltid();
    for (int tile = blockIdx.x; tile < kT / 64; tile += gridDim.x) {
        const int T0 = tile * 64, b = T0 >> 11, s0 = T0 & 2047;
        for (int it = tid; it < 64 * 94; it += 256) {
            const int tok = it / 94, item = it % 94;
            const int t = T0 + tok, s = s0 + tok;
            bf16_t* row = cols + (size_t)t * LDC;
            if (item < 52) {
                const int hd = item >> 2, i0 = (item & 3) * 8;
                const int base = hd < 4 ? 64 * hd : hd == 4 ? 256 : hd == 5 ? 384 : hd == 6 ? 512 : hd < 11 ? 1920 + 64 * (hd - 7) : 2176 + 64 * (hd - 11);
                uint4 x1 = *(const uint4*)(row + base + i0), x2 = *(const uint4*)(row + base + 32 + i0);
                rope8(x1, x2, cos64 + s * 32 + i0, sin64 + s * 32 + i0);
                *(uint4*)(row + base + i0) = x1; *(uint4*)(row + base + 32 + i0) = x2;
                if (hd == 4) { *(uint4*)(kc + (size_t)t * 64 + i0) = x1; *(uint4*)(kc + (size_t)t * 64 + 32 + i0) = x2; }
            } else if (item < 86) {
                const int it2 = item - 52, sub = it2 >> 1, i0 = (it2 & 1) * 8;
                const int base = sub < 8 ? 704 + 32 * sub : sub < 16 ? 960 + 32 * (sub - 8) : 1856;
                uint4 x1 = *(const uint4*)(row + base + i0), x2 = *(const uint4*)(row + base + 16 + i0);
                rope8(x1, x2, cos32 + s * 16 + i0, sin32 + s * 16 + i0);
                *(uint4*)(row + base + i0) = x1; *(uint4*)(row + base + 16 + i0) = x2;
            } else {
                const int ch = item - 86;
                *(uint4*)(vc + (size_t)t * 64 + ch * 8) = *(const uint4*)(row + 320 + ch * 8);
            }
        }
        {
            const int tok = tid >> 2, part = tid & 3, t = T0 + tok;
            const bf16_t* src = cols + (size_t)t * LDC + 1472 + (part < 3 ? part : 0) * 128;
            float ss = 0.f;
#pragma unroll 4
            for (int i = 0; i < 16; ++i) {
                const uint4 u = *(const uint4*)(src + i * 8);
                ss += lo16(u.x) * lo16(u.x) + hi16(u.x) * hi16(u.x) + lo16(u.y) * lo16(u.y) + hi16(u.y) * hi16(u.y)
                    + lo16(u.z) * lo16(u.z) + hi16(u.z) * hi16(u.z) + lo16(u.w) * lo16(u.w) + hi16(u.w) * hi16(u.w);
            }
            float vq = part < 2 ? ss : 0.f;
            vq += __shfl_xor(vq, 1, 64);
            if (part == 0) rstd[t] = rsqrtf(vq * (1.f / 256.f) + kEps);
            if (part == 2) rstd[kT + t] = rsqrtf(ss * (1.f / 128.f) + kEps);
        }
#pragma unroll 1
        for (int vh = 0; vh < 8; ++vh) {
            const int col = vh == 0 ? 448 : vh == 1 ? 576 : vh < 6 ? 1216 + 64 * (vh - 2) : 2304 + 64 * (vh - 6);
            vt_tile(cols + (size_t)T0 * LDC + col, LDC, VT + ((size_t)(b * 12 + vh) * 64) * 2048 + s0, smem);
        }
    }
}

DEV void phase_layout2(const Params& p, char* smem) {
    char* ws = p.ws;
    bf16_t* qmla = (bf16_t*)(ws + OFF_QMLA);
    const bf16_t* kvmla = (const bf16_t*)(ws + OFF_KVMLA);
    bf16_t* VT = (bf16_t*)(ws + OFF_VT);
    const float* rope = (const float*)(ws + OFF_ROPE);
    const float *cos32 = rope + 2048 * 64, *sin32 = rope + 2048 * 64 + 2048 * 16;
    const int tid = ltid();
    for (int tile = blockIdx.x; tile < kT / 64; tile += gridDim.x) {
        const int T0 = tile * 64, b = T0 >> 11, s0 = T0 & 2047;
        for (int it = tid; it < 64 * 8; it += 256) {
            const int tok = it >> 3, item = it & 7, hd = item >> 1, i0 = (item & 1) * 8;
            const int t = T0 + tok, s = s0 + tok;
            bf16_t* row = qmla + (size_t)t * 384 + hd * 96 + 64;
            uint4 x1 = *(const uint4*)(row + i0), x2 = *(const uint4*)(row + 16 + i0);
            rope8(x1, x2, cos32 + s * 16 + i0, sin32 + s * 16 + i0);
            *(uint4*)(row + i0) = x1; *(uint4*)(row + 16 + i0) = x2;
        }
#pragma unroll 1
        for (int hd = 0; hd < 4; ++hd)
            vt_tile(kvmla + (size_t)T0 * 512 + hd * 128 + 64, 512, VT + ((size_t)(b * 12 + 8 + hd) * 64) * 2048 + s0, smem);
    }
}

constexpr int SM_K = 0;
constexpr int SM_V = 18432;
constexpr int SM_IMP = SM_V + 16896;
constexpr int SM_SEL = SM_IMP + 16896;
constexpr int SM_CTRL = 65536;
constexpr int SM_TOTAL = SM_CTRL + 256;
constexpr int SM_ATTN_END = SM_SEL + 1024;

struct RangeIter { int cur, end; DEV int next() { return cur < end ? cur++ : -1; } };
struct BitIter { unsigned rem; DEV int next() { if (!rem) return -1; const int k = __ffs((int)rem) - 1; rem &= rem - 1; return k; } };
struct LdRow { const bf16_t* base; int ld;
    DEV uint4 operator()(int kt, int id) const { const int row = id >> 3, part = id & 7; return *(const uint4*)(base + (size_t)(kt * 64 + row) * ld + part * 8); } };
struct LdVT { const bf16_t* base;
    DEV uint4 operator()(int kt, int id) const { const int d = id >> 3, part = id & 7; return *(const uint4*)(base + (size_t)d * 2048 + kt * 64 + part * 8); } };
struct LdMlaK { const bf16_t* kv; const bf16_t* kr;
    DEV uint4 operator()(int kt, int id) const { const int row = id / 12, part = id % 12; const size_t t = (size_t)(kt * 64 + row);
        return part < 8 ? *(const uint4*)(kv + t * 512 + part * 8) : *(const uint4*)(kr + t * LDC + (part - 8) * 8); } };

struct MaskCausal { DEV bool on(int) const { return true; } DEV bool ok(int kc, int d) const { return kc <= d; } };
template <int W> struct MaskWin { DEV bool on(int) const { return true; } DEV bool ok(int kc, int d) const { return (kc <= d) && (d - kc < W); } };
struct MaskSel { unsigned bits; DEV bool on(int kt) const { return (bits >> kt) & 1u; } DEV bool ok(int kc, int d) const { return kc <= d; } };
template <int KDIM, int NKS, int NSUB, class It, class LK, class LV, class MaskF, class SkipF>
DEV void attn_stream(It it, const LK& ldK, const LV& ldV, const MaskF& maskf, const SkipF& skipf,
                     const bf16x8* qf, f32x16 (&o)[NSUB][2], float (&m)[NSUB], float (&l)[NSUB], float scl, int tq, char* smem, int tid, int koff = 0) {
    constexpr int KCH = KDIM / 8, KSTR = KDIM + 8, NKC = (64 * KCH) / 256;
    bf16_t* Kb = (bf16_t*)(smem + SM_K);
    bf16_t* Vb = (bf16_t*)(smem + SM_V);
    const int lane = tid & 63, ql = lane & 31, hh = lane >> 5;
    uint4 rk0 = make_uint4(0, 0, 0, 0), rk1 = rk0, rk2 = rk0, rv0 = rk0, rv1 = rk0;
    int kt = it.next();
    if (kt >= 0) {
        rk0 = ldK(kt, tid); rk1 = ldK(kt, tid + 256);
        if (NKC == 3) rk2 = ldK(kt, tid + 512);
        rv0 = ldV(kt, tid); rv1 = ldV(kt, tid + 256);
    }
    while (kt >= 0) {
        __syncthreads();
        { const int id = tid, row = id / KCH, part = id % KCH; *(uint4*)(Kb + row * KSTR + part * 8) = rk0; }
        { const int id = tid + 256, row = id / KCH, part = id % KCH; *(uint4*)(Kb + row * KSTR + part * 8) = rk1; }
        if (NKC == 3) { const int id = tid + 512, row = id / KCH, part = id % KCH; *(uint4*)(Kb + row * KSTR + part * 8) = rk2; }
        { const int id = tid, row = id >> 3, part = id & 7; bf16_t* d = Vb + row * 68 + part * 8;
            *(uint2*)d = make_uint2(rv0.x, rv0.y); *(uint2*)(d + 4) = make_uint2(rv0.z, rv0.w); }
        { const int id = tid + 256, row = id >> 3, part = id & 7; bf16_t* d = Vb + row * 68 + part * 8;
            *(uint2*)d = make_uint2(rv1.x, rv1.y); *(uint2*)(d + 4) = make_uint2(rv1.z, rv1.w); }
        __syncthreads();
        const int ktn = it.next();
        if (ktn >= 0) {
            rk0 = ldK(ktn, tid); rk1 = ldK(ktn, tid + 256);
            if (NKC == 3) rk2 = ldK(ktn, tid + 512);
            rv0 = ldV(ktn, tid); rv1 = ldV(ktn, tid + 256);
        }
        if (!skipf(kt)) {
#pragma unroll
            for (int sub = 0; sub < NSUB; ++sub) {
                __builtin_amdgcn_sched_barrier(0);
                f32x16 s[2];
#pragma unroll
                for (int i = 0; i < 2; ++i) {
                    s[i] = zero16();
#pragma unroll
                    for (int ks = 0; ks < NKS; ++ks) {
                        const bf16x8 a = *(const bf16x8*)(Kb + (i * 32 + ql) * KSTR + koff + (sub * NKS + ks) * 16 + hh * 8);
                        s[i] = mfma32(a, qf[sub * NKS + ks], s[i]);
                    }
                }
                float mx = kNeg;
                const int dlim = tq - kt * 64 - 4 * hh;
                const bool on = maskf.on(kt);
#pragma unroll
                for (int i = 0; i < 2; ++i)
#pragma unroll
                    for (int r = 0; r < 16; ++r) {
                        const int kc = i * 32 + (r & 3) + 8 * (r >> 2);
                        const float v = (on && maskf.ok(kc, dlim)) ? s[i][r] * scl : kNeg;
                        s[i][r] = v; mx = fmaxf(mx, v);
                    }
                mx = fmaxf(mx, xor32f(mx, lane));
                const float mnew = fmaxf(m[sub], mx);
                const float alpha = __builtin_amdgcn_exp2f(m[sub] - mnew);
                m[sub] = mnew;
                float sum = 0.f;
#pragma unroll
                for (int i = 0; i < 2; ++i)
#pragma unroll
                    for (int r = 0; r < 16; ++r) { const float pv = __builtin_amdgcn_exp2f(s[i][r] - mnew); s[i][r] = pv; sum += pv; }
                l[sub] = l[sub] * alpha + sum;
#pragma unroll
                for (int dt = 0; dt < 2; ++dt)
#pragma unroll
                    for (int r = 0; r < 16; ++r) o[sub][dt][r] *= alpha;
                __builtin_amdgcn_sched_barrier(0);
#pragma unroll
                for (int ks = 0; ks < 4; ++ks) {
                    if (ks == 2) __builtin_amdgcn_sched_barrier(0);
                    const int i = ks >> 1, r0 = 8 * (ks & 1);
                    uint4 pu;
                    pu.x = pack2(s[i][r0 + 0], s[i][r0 + 1]); pu.y = pack2(s[i][r0 + 2], s[i][r0 + 3]);
                    pu.z = pack2(s[i][r0 + 4], s[i][r0 + 5]); pu.w = pack2(s[i][r0 + 6], s[i][r0 + 7]);
                    const bf16x8 pf = __builtin_bit_cast(bf16x8, pu);
#pragma unroll
                    for (int dt = 0; dt < 2; ++dt) {
                        const bf16_t* vp = Vb + (dt * 32 + ql) * 68 + ks * 16 + 4 * hh;
                        const uint2 a0 = *(const uint2*)vp, a1 = *(const uint2*)(vp + 8);
                        const bf16x8 a = __builtin_bit_cast(bf16x8, make_uint4(a0.x, a0.y, a1.x, a1.y));
                        o[sub][dt] = mfma32(a, pf, o[sub][dt]);
                    }
                }
            }
        }
        kt = ktn;
    }
}

DEV void write_o(const f32x16 (&o)[2], bf16_t* obuf, size_t row, int col0, int hh) {
#pragma unroll
    for (int dt = 0; dt < 2; ++dt)
#pragma unroll
        for (int g = 0; g < 4; ++g) {
            const int d = dt * 32 + 8 * g + 4 * hh;
            uint2 u; u.x = pack2(o[dt][4 * g], o[dt][4 * g + 1]); u.y = pack2(o[dt][4 * g + 2], o[dt][4 * g + 3]);
            *(uint2*)(obuf + row * 1024 + col0 + d) = u;
        }
}
DEV float sigmoidf(float x) { return 1.f / (1.f + __expf(-x)); }

DEV void nsa_item(const Params& p, int b, int qb, char* smem) {
    int tid = threadIdx.x; asm volatile("" : "+v"(tid));
    const int lane = tid & 63, w = tid >> 6, ql = lane & 31, hh = lane >> 5;
    char* ws = p.ws;
    const bf16_t* cols = (const bf16_t*)(ws + OFF_COLS);
    const bf16_t* VT = (const bf16_t*)(ws + OFF_VT);
    bf16_t* obuf = (bf16_t*)(ws + OFF_O);
    const int t0 = qb * 32, tq = t0 + ql;
    const size_t Tb = (size_t)b * kS;
    const bf16_t* qrow = cols + (Tb + tq) * LDC;
    bf16x8 qf[4];
#pragma unroll
    for (int ks = 0; ks < 4; ++ks) qf[ks] = *(const bf16x8*)(qrow + w * 64 + ks * 16 + hh * 8);
    const float g0 = sigmoidf(bf2f(qrow[640 + w * 3 + 0])), g1 = sigmoidf(bf2f(qrow[640 + w * 3 + 1])), g2 = sigmoidf(bf2f(qrow[640 + w * 3 + 2]));
    const float scl = 0.125f * kLog2e;
    bf16_t* Kc = (bf16_t*)(smem + SM_K);
    bf16_t* Vc = (bf16_t*)(smem + SM_V);
    float* impP = (float*)(smem + SM_IMP);
    unsigned* selm = (unsigned*)(smem + SM_SEL);
    const bf16_t* kcmp = (const bf16_t*)(ws + OFF_KCMP) + (size_t)b * 128 * 64;
    const bf16_t* vcmp = kcmp + 1024 * 64;
    __syncthreads();
#pragma unroll
    for (int i = 0; i < 4; ++i) {
        const int id = tid + 256 * i, row = id >> 3, part = id & 7;
        uint4 kk = *(const uint4*)(kcmp + row * 64 + part * 8);
        uint4 vv = *(const uint4*)(vcmp + row * 64 + part * 8);
        if (row == 127) { kk = make_uint4(0, 0, 0, 0); vv = kk; }
        *(uint4*)(Kc + row * 72 + part * 8) = kk;
        const unsigned u[4] = {vv.x, vv.y, vv.z, vv.w};
#pragma unroll
        for (int j = 0; j < 4; ++j) { Vc[(part * 8 + 2 * j) * 132 + row] = (bf16_t)(u[j] & 0xffffu); Vc[(part * 8 + 2 * j + 1) * 132 + row] = (bf16_t)(u[j] >> 16); }
    }
    __syncthreads();
    unsigned ocp[16];
    float* invs = (float*)(smem + SM_SEL) + 64;
    {
        const int cmaxv = tq >= 31 ? min((tq - 31) >> 4, 126) : -1;
        float mx = kNeg;
#pragma unroll 1
        for (int i = 0; i < 4; ++i) {
            f32x16 s = zero16();
#pragma unroll
            for (int ks = 0; ks < 4; ++ks) s = mfma32(*(const bf16x8*)(Kc + (i * 32 + ql) * 72 + ks * 16 + hh * 8), qf[ks], s);
            const int clim = cmaxv - i * 32 - 4 * hh;
#pragma unroll
            for (int r = 0; r < 16; ++r) {
                const int kc = (r & 3) + 8 * (r >> 2);
                const bool valid = (kc <= clim);
                mx = fmaxf(mx, valid ? s[r] * scl : kNeg);
            }
        }
        mx = fmaxf(mx, xor32f(mx, lane));
        f32x16 ocmp[2]; ocmp[0] = zero16(); ocmp[1] = zero16();
        float sum = 0.f, carprev = 0.f;
#pragma unroll 1
        for (int i = 0; i < 4; ++i) {
            f32x16 s = zero16();
#pragma unroll
            for (int ks = 0; ks < 4; ++ks) s = mfma32(*(const bf16x8*)(Kc + (i * 32 + ql) * 72 + ks * 16 + hh * 8), qf[ks], s);
            const int clim = cmaxv - i * 32 - 4 * hh;
#pragma unroll
            for (int r = 0; r < 16; ++r) {
                const int kc = (r & 3) + 8 * (r >> 2);
                const bool valid = (kc <= clim);
                const float pv = valid ? __builtin_amdgcn_exp2f(s[r] * scl - mx) : 0.f;
                s[r] = pv; sum += pv;
            }
            float own[4], car[4];
#pragma unroll
            for (int g = 0; g < 4; ++g) { own[g] = s[4 * g] + s[4 * g + 1] + s[4 * g + 2] + 0.5f * s[4 * g + 3]; car[g] = 0.5f * s[4 * g + 3]; }
#pragma unroll
            for (int g = 0; g < 4; ++g) {
                const float send = hh ? (g ? car[g > 0 ? g - 1 : 0] : carprev) : car[g];
                own[g] += xor32f(send, lane);
            }
            carprev = car[3];
#pragma unroll
            for (int g = 0; g < 4; ++g) impP[(w * 32 + ql) * 33 + 2 * (4 * i + g) + hh] = own[g];
#pragma unroll
            for (int sp = 0; sp < 2; ++sp) {
                const int ks = 2 * i + sp, r0 = 8 * sp;
                uint4 pu;
                pu.x = pack2(s[r0 + 0], s[r0 + 1]); pu.y = pack2(s[r0 + 2], s[r0 + 3]);
                pu.z = pack2(s[r0 + 4], s[r0 + 5]); pu.w = pack2(s[r0 + 6], s[r0 + 7]);
                const bf16x8 pf = __builtin_bit_cast(bf16x8, pu);
#pragma unroll
                for (int dt = 0; dt < 2; ++dt) {
                    const bf16_t* vp = Vc + (dt * 32 + ql) * 132 + ks * 16 + 4 * hh;
                    const uint2 a0 = *(const uint2*)vp, a1 = *(const uint2*)(vp + 8);
                    ocmp[dt] = mfma32(__builtin_bit_cast(bf16x8, make_uint4(a0.x, a0.y, a1.x, a1.y)), pf, ocmp[dt]);
                }
            }
        }
        sum += xor32f(sum, lane);
        const float inv = sum > 0.f ? 1.f / sum : 0.f;
        invs[w * 32 + ql] = inv;
        const float f = g0 * inv;
#pragma unroll
        for (int dt = 0; dt < 2; ++dt)
#pragma unroll
            for (int r = 0; r < 8; ++r) ocp[dt * 8 + r] = pack2(f * ocmp[dt][2 * r], f * ocmp[dt][2 * r + 1]);
    }
    __syncthreads();
    const int qblk = t0 >> 6;
    {
        const int hw = tid >> 5, j = tid & 31;
#pragma unroll 1
        for (int rr = 0; rr < 4; ++rr) {
            const int row = hw * 4 + rr;
            const float v = impP[(0 * 32 + row) * 33 + j] * invs[row] + impP[(1 * 32 + row) * 33 + j] * invs[32 + row]
                          + impP[(2 * 32 + row) * 33 + j] * invs[64 + row] + impP[(3 * 32 + row) * 33 + j] * invs[96 + row];
            bool sel;
            if (qblk < 16) sel = (j <= qblk);
            else {
                const bool cand = (j >= 1) && (j <= qblk - 2);
                const bool forced = (j == 0) || (j == qblk) || (j == qblk - 1);
                int rank = 0;
                for (int j2 = 1; j2 <= qblk - 2; ++j2) {
                    const float v2 = lanef(v, (lane & 32) + j2);
                    rank += (v2 > v || (v2 == v && j2 < j)) ? 1 : 0;
                }
                sel = forced || (cand && rank < 13);
            }
            const unsigned long long bal = __ballot(sel);
            const unsigned mk = (lane & 32) ? (unsigned)(bal >> 32) : (unsigned)bal;
            if (j == 0) selm[row] = mk;
        }
    }
    __syncthreads();
    const unsigned mysel = selm[ql];
    unsigned U = mysel;
#pragma unroll
    for (int o = 16; o > 0; o >>= 1) U |= (unsigned)__builtin_amdgcn_ds_bpermute((lane ^ o) << 2, (int)U);
    {
        f32x16 o1[1][2]; o1[0][0] = zero16(); o1[0][1] = zero16();
        float m1[1] = {kNeg}, l1[1] = {0.f};
        auto skipf = [&](int) __attribute__((always_inline)) { return false; };
        attn_stream<64, 4, 1>(BitIter{U}, LdRow{cols + Tb * LDC + 384, LDC}, LdVT{VT + (size_t)(b * 12 + 0) * 64 * 2048}, MaskSel{mysel}, skipf, qf, o1, m1, l1, scl, tq, smem, tid);
        const float lt = l1[0] + xor32f(l1[0], lane);
        const float f = g1 / lt;
#pragma unroll
        for (int dt = 0; dt < 2; ++dt)
#pragma unroll
            for (int r = 0; r < 8; ++r) ocp[dt * 8 + r] = pack2(lo16(ocp[dt * 8 + r]) + f * o1[0][dt][2 * r], hi16(ocp[dt * 8 + r]) + f * o1[0][dt][2 * r + 1]);
    }
    {
        f32x16 o1[1][2]; o1[0][0] = zero16(); o1[0][1] = zero16();
        float m1[1] = {kNeg}, l1[1] = {0.f};
        auto skipf = [&](int) __attribute__((always_inline)) { return false; };
        const int lo = t0 >= 511 ? ((t0 - 511) >> 6) : 0;
        attn_stream<64, 4, 1>(RangeIter{lo, qblk + 1}, LdRow{cols + Tb * LDC + 512, LDC}, LdVT{VT + (size_t)(b * 12 + 1) * 64 * 2048}, MaskWin<512>{}, skipf, qf, o1, m1, l1, scl, tq, smem, tid);
        const float lt = l1[0] + xor32f(l1[0], lane);
        const float f = g2 / lt;
#pragma unroll
        for (int dt = 0; dt < 2; ++dt)
#pragma unroll
            for (int r = 0; r < 8; ++r) { o1[0][dt][2 * r] = lo16(ocp[dt * 8 + r]) + f * o1[0][dt][2 * r]; o1[0][dt][2 * r + 1] = hi16(ocp[dt * 8 + r]) + f * o1[0][dt][2 * r + 1]; }
        write_o(o1[0], obuf, Tb + tq, w * 64, hh);
    }
}

DEV void diff_item(const Params& p, int layer, int b, int hd, int q64, char* smem) {
    int tid = threadIdx.x; asm volatile("" : "+v"(tid));
    const int lane = tid & 63, w = tid >> 6, ql = lane & 31, hh = lane >> 5;
    const int sub = w & 1, qbw = w >> 1;
    char* ws = p.ws;
    const bf16_t* cols = (const bf16_t*)(ws + OFF_COLS);
    const bf16_t* VT = (const bf16_t*)(ws + OFF_VT);
    bf16_t* obuf = (bf16_t*)(ws + OFF_O);
    const float* misc = (const float*)(ws + OFF_MISC);
    const int t0w = q64 * 64 + qbw * 32, tq = t0w + ql;
    const size_t Tb = (size_t)b * kS;
    const bf16_t* qrow = cols + (Tb + tq) * LDC + 704 + hd * 64 + sub * 32;
    bf16x8 qf[2];
#pragma unroll
    for (int ks = 0; ks < 2; ++ks) qf[ks] = *(const bf16x8*)(qrow + ks * 16 + hh * 8);
    const float scl = 0.17677669529663687f * kLog2e;
    f32x16 o1[1][2]; o1[0][0] = zero16(); o1[0][1] = zero16();
    float m1[1] = {kNeg}, l1[1] = {0.f};
    auto skipf = [&](int kt) __attribute__((always_inline)) { return kt * 64 > t0w + 31; };
    attn_stream<64, 2, 1>(RangeIter{0, q64 + 1}, LdRow{cols + Tb * LDC + 960 + hd * 64, LDC}, LdVT{VT + (size_t)(b * 12 + 2 + hd) * 64 * 2048}, MaskCausal{}, skipf, qf, o1, m1, l1, scl, tq, smem, tid, sub * 32);
    const float lam = misc[256 + layer], post = misc[258 + layer];
    const float lt = l1[0] + xor32f(l1[0], lane);
    float* ex = (float*)smem;
    __syncthreads();
    if (sub == 1) {
        const float f = lam / lt;
#pragma unroll
        for (int dt = 0; dt < 2; ++dt)
#pragma unroll
            for (int r = 0; r < 16; ++r) ex[((qbw * 2 + dt) * 16 + r) * 64 + lane] = o1[0][dt][r] * f;
    }
    __syncthreads();
    if (sub == 0) {
        const float f = 1.f / lt;
        float ss = 0.f;
#pragma unroll
        for (int dt = 0; dt < 2; ++dt)
#pragma unroll
            for (int r = 0; r < 16; ++r) { const float v = o1[0][dt][r] * f - ex[((qbw * 2 + dt) * 16 + r) * 64 + lane]; o1[0][dt][r] = v; ss += v * v; }
        ss += xor32f(ss, lane);
        const float rstd = rsqrtf(ss * (1.f / 64.f) + kEps) * post;
        const float* sg = p.sub_g + layer * 64;
#pragma unroll
        for (int dt = 0; dt < 2; ++dt)
#pragma unroll
            for (int r = 0; r < 16; ++r) { const int d = dt * 32 + (r & 3) + 8 * (r >> 2) + 4 * hh; o1[0][dt][r] *= rstd * sg[d]; }
        write_o(o1[0], obuf, Tb + tq, 256 + hd * 64, hh);
    }
}

DEV void mla_item(const Params& p, int b, int hd, int qc, char* smem) {
    int tid = threadIdx.x; asm volatile("" : "+v"(tid));
    const int lane = tid & 63, w = tid >> 6, ql = lane & 31, hh = lane >> 5;
    char* ws = p.ws;
    const bf16_t* cols = (const bf16_t*)(ws + OFF_COLS);
    const bf16_t* VT = (const bf16_t*)(ws + OFF_VT);
    const bf16_t* qmla = (const bf16_t*)(ws + OFF_QMLA);
    const bf16_t* kvmla = (const bf16_t*)(ws + OFF_KVMLA);
    bf16_t* obuf = (bf16_t*)(ws + OFF_O);
    const int t0w = qc * 128 + w * 32, tq = t0w + ql;
    const size_t Tb = (size_t)b * kS;
    const bf16_t* qrow = qmla + (Tb + tq) * 384 + hd * 96;
    bf16x8 qf[6];
#pragma unroll
    for (int ks = 0; ks < 6; ++ks) qf[ks] = *(const bf16x8*)(qrow + ks * 16 + hh * 8);
    const float scl = 0.10206207261596575f * kLog2e;
    f32x16 o1[1][2]; o1[0][0] = zero16(); o1[0][1] = zero16();
    float m1[1] = {kNeg}, l1[1] = {0.f};
    auto skipf = [&](int kt) __attribute__((always_inline)) { return kt * 64 > t0w + 31; };
    attn_stream<96, 6, 1>(RangeIter{0, 2 * qc + 2}, LdMlaK{kvmla + Tb * 512 + hd * 128, cols + Tb * LDC + 1856}, LdVT{VT + (size_t)(b * 12 + 8 + hd) * 64 * 2048}, MaskCausal{}, skipf, qf, o1, m1, l1, scl, tq, smem, tid);
    const float inv = 1.f / (l1[0] + xor32f(l1[0], lane));
#pragma unroll
    for (int dt = 0; dt < 2; ++dt)
#pragma unroll
        for (int r = 0; r < 16; ++r) o1[0][dt][r] *= inv;
    write_o(o1[0], obuf, Tb + tq, 512 + hd * 64, hh);
}

DEV void swa_item(const Params& p, int layer, int b, int g, int q64, char* smem) {
    int tid = threadIdx.x; asm volatile("" : "+v"(tid));
    const int lane = tid & 63, w = tid >> 6, ql = lane & 31, hh = lane >> 5;
    char* ws = p.ws;
    const bf16_t* cols = (const bf16_t*)(ws + OFF_COLS);
    const bf16_t* VT = (const bf16_t*)(ws + OFF_VT);
    bf16_t* obuf = (bf16_t*)(ws + OFF_O);
    const int head = g * 2 + (w & 1);
    const int t0w = q64 * 64 + (w >> 1) * 32, tq = t0w + ql;
    const size_t Tb = (size_t)b * kS;
    const bf16_t* qrow = cols + (Tb + tq) * LDC + 1920 + head * 64;
    bf16x8 qf[4];
#pragma unroll
    for (int ks = 0; ks < 4; ++ks) qf[ks] = *(const bf16x8*)(qrow + ks * 16 + hh * 8);
    const float scl = 0.125f * kLog2e;
    f32x16 o1[1][2]; o1[0][0] = zero16(); o1[0][1] = zero16();
    float m1[1] = {p.sinks[layer * 4 + head] * kLog2e}, l1[1] = {hh == 0 ? 1.f : 0.f};
    auto skipf = [&](int kt) __attribute__((always_inline)) { return (kt * 64 > t0w + 31) || (kt * 64 + 63 < t0w - 127); };
    const int lo = q64 >= 2 ? q64 - 2 : 0;
    attn_stream<64, 4, 1>(RangeIter{lo, q64 + 1}, LdRow{cols + Tb * LDC + 2176 + g * 64, LDC}, LdVT{VT + (size_t)(b * 12 + 6 + g) * 64 * 2048}, MaskWin<128>{}, skipf, qf, o1, m1, l1, scl, tq, smem, tid);
    const float inv = 1.f / (l1[0] + xor32f(l1[0], lane));
#pragma unroll
    for (int dt = 0; dt < 2; ++dt)
#pragma unroll
        for (int r = 0; r < 16; ++r) o1[0][dt][r] *= inv;
    write_o(o1[0], obuf, Tb + tq, 768 + head * 64, hh);
}

DEV void phase_attn(const Params& p, int layer, char* smem, int rep = 0) {
    unsigned* ctr = (unsigned*)(p.ws + OFF_CTRL) + 64 + layer * 16 + rep;
    volatile int* slot = (volatile int*)(smem + SM_SEL) + 48;
    for (;;) {
        __syncthreads();
        if (ltid() == 0) *slot = (int)atomicAdd(ctr, 1u);
        __syncthreads();
        const int idx = __builtin_amdgcn_readfirstlane(*slot);
        if (idx >= 2560) break;
        const int level = 15 - idx / 160, r = idx % 160;
        if (r < 64) { const int b = (r & 31) >> 2; diff_item(p, layer, b, r & 3, level * 2 + (1 - (r >> 5)), smem); }
        else if (r < 96) { const int k = r - 64; mla_item(p, k >> 2, k & 3, level, smem); }
        else if (r < 128) { const int k = r - 96; nsa_item(p, k >> 2, level * 4 + (3 - (k & 3)), smem); }
        else { const int k = r - 128; swa_item(p, layer, k >> 2, (k >> 1) & 1, level * 2 + (k & 1), smem); }
    }
}

#define XB_TMO      128
#define XB_XCNT(j)  (256  + 64 * (j))
#define XB_XSUB(j)  (1280 + 64 * (j))
#define XB_XGEN(j)  (2304 + 64 * (j))
#define XB_TOP      3328
#define XB_TOPGEN   3392
#define XB_SPIN_CAP (1u << 22)
DEV unsigned xb_ld(unsigned* p) { return __hip_atomic_load(p, __ATOMIC_RELAXED, __HIP_MEMORY_SCOPE_AGENT); }
DEV unsigned xb_add(unsigned* p, unsigned v) { return __hip_atomic_fetch_add(p, v, __ATOMIC_RELAXED, __HIP_MEMORY_SCOPE_AGENT); }
DEV unsigned xb_xcc_id() { return (unsigned)__builtin_amdgcn_s_getreg((3 << 11) | 20) & 0xFu; }
#define XB_SPIN(cond, bar) do { unsigned _sp = 0; while (cond) { __builtin_amdgcn_s_sleep(1); \
    if ((++_sp & 255u) == 0u) { if (xb_ld(&(bar)[XB_TMO])) break; if (_sp > XB_SPIN_CAP) { atomicAdd(&(bar)[XB_TMO], 1u); break; } } } } while (0)
struct XcdBarrier { unsigned* bar; unsigned x; volatile LAS unsigned* st; };
DEV XcdBarrier xcd_barrier_post(unsigned* bar, volatile LAS unsigned* st) {
    XcdBarrier b; b.bar = bar; b.x = xb_xcc_id(); b.st = st;
    if (threadIdx.x == 0) st[2] = xb_add(&bar[XB_XCNT(b.x)], 1u);
    return b;
}
DEV void xcd_barrier_complete(unsigned* bar, unsigned x, unsigned& nloc, unsigned& nx) {
    const unsigned G = gridDim.x * gridDim.y * gridDim.z;
    unsigned sum, cnt, mine, sp = 0u;
    for (;;) {
        sum = 0u; cnt = 0u; mine = 0u;
#pragma unroll
        for (unsigned j = 0; j < 16; ++j) { const unsigned c = xb_ld(&bar[XB_XCNT(j)]); sum += c; cnt += (c > 0u) ? 1u : 0u; mine = (j == x) ? c : mine; }
        if (sum == G) break;
        __builtin_amdgcn_s_sleep(1);
        if ((++sp & 255u) == 0u) { if (xb_ld(&bar[XB_TMO])) break; if (sp > XB_SPIN_CAP) { atomicAdd(&bar[XB_TMO], 1u); break; } }
    }
    nloc = mine > 0u ? mine : 1u; nx = cnt > 0u ? cnt : 1u;
}
DEV void xcd_barrier(const XcdBarrier& b) {
    asm volatile("s_waitcnt vmcnt(0)" ::: "memory");
    __syncthreads();
    if (threadIdx.x == 0) {
        unsigned* bar = b.bar;
        asm volatile("" : "+v"(bar));
        __builtin_amdgcn_s_waitcnt(0);
        unsigned nloc = b.st[0], nx = b.st[1];
        if (nloc == 0u) { xcd_barrier_complete(bar, b.x, nloc, nx); b.st[0] = nloc; b.st[1] = nx; }
        const unsigned old = xb_add(&bar[XB_XSUB(b.x)], 1u);
        const unsigned gen = old / nloc;
        if (old + 1u == (gen + 1u) * nloc) {
            __builtin_amdgcn_fence(__ATOMIC_RELEASE, "agent");
            asm volatile("s_waitcnt vmcnt(0)" ::: "memory");
            const unsigned og = xb_add(&bar[XB_TOP], 1u);
            const unsigned tg = og / nx;
            if (og + 1u == (tg + 1u) * nx) xb_add(&bar[XB_TOPGEN], 1u);
            else XB_SPIN(xb_ld(&bar[XB_TOPGEN]) == tg, bar);
            __builtin_amdgcn_fence(__ATOMIC_ACQUIRE, "agent");
            xb_add(&bar[XB_XGEN(b.x)], 1u);
            asm volatile("s_waitcnt vmcnt(0)" ::: "memory");
        } else {
            XB_SPIN(xb_ld(&bar[XB_XGEN(b.x)]) == gen, bar);
            __builtin_amdgcn_fence(__ATOMIC_ACQUIRE, "agent");
            asm volatile("s_waitcnt vmcnt(0)" ::: "memory");
        }
    }
    __syncthreads();
}

DEV unsigned fkey(float f) { const unsigned u = __float_as_uint(f); return (u & 0x80000000u) ? ~u : (u | 0x80000000u); }
DEV float funkey(unsigned k) { return __uint_as_float((k & 0x80000000u) ? (k & 0x7fffffffu) : ~k); }
DEV void ins16(unsigned (&L)[16], unsigned x) {
#pragma unroll
    for (int i = 0; i < 16; ++i) { const unsigned hi = L[i] > x ? L[i] : x; x = L[i] > x ? x : L[i]; L[i] = hi; }
}
DEV void phase_topk(const Params& p, char* smem) {
    const int tid = ltid();
    const float* S1 = (const float*)(p.ws + OFF_S1);
    const float* S2 = (const float*)(p.ws + OFF_S2);
    int* eid = (int*)(p.ws + OFF_EID);
    float* gate = (float*)(p.ws + OFF_GATE);
    unsigned char* ib = (unsigned char*)smem + tid * 32;
    for (int blk = blockIdx.x; blk < kT * 8 / 256; blk += gridDim.x) {
        const size_t row = (size_t)blk * 256 + tid;
        unsigned L1[16], L2[16];
#pragma unroll
        for (int i = 0; i < 16; ++i) { L1[i] = 0u; L2[i] = 0u; }
#pragma unroll 4
        for (int k = 0; k < 128; ++k) {
            const float a = S1[(size_t)k * (kT * 8) + row], b = S2[(size_t)k * (kT * 8) + row];
            ins16(L1, (fkey(a) & ~127u) | (unsigned)(127 - k));
            ins16(L2, (fkey(b) & ~127u) | (unsigned)(127 - k));
        }
        float v1[16], v2[16];
        __syncthreads();
#pragma unroll
        for (int i = 0; i < 16; ++i) {
            v1[i] = funkey(L1[i] & ~127u); v2[i] = funkey(L2[i] & ~127u);
            ib[i] = (unsigned char)(127u - (L1[i] & 127u)); ib[16 + i] = (unsigned char)(127u - (L2[i] & 127u));
        }
        unsigned C[16];
#pragma unroll
        for (int i = 0; i < 16; ++i) C[i] = 0u;
#pragma unroll
        for (int a = 0; a < 16; ++a)
#pragma unroll
            for (int b = 0; b < 16; ++b)
                if ((a + 1) * (b + 1) <= 16) ins16(C, (fkey(v1[a] + v2[b]) & ~255u) | (unsigned)(255 - (a * 16 + b)));
        float ts[16]; float sum = 0.f;
        const float tmax = funkey(C[0] & ~255u);
#pragma unroll
        for (int i = 0; i < 16; ++i) { ts[i] = __expf(funkey(C[i] & ~255u) - tmax); sum += ts[i]; }
        const float inv = 1.f / sum;
        int ev[16];
#pragma unroll
        for (int i = 0; i < 16; ++i) { const unsigned ci = 255u - (C[i] & 255u); ev[i] = (int)ib[ci >> 4] * 128 + (int)ib[16 + (ci & 15u)]; }
#pragma unroll
        for (int i = 0; i < 4; ++i) {
            *(int4*)(eid + row * 16 + 4 * i) = make_int4(ev[4 * i], ev[4 * i + 1], ev[4 * i + 2], ev[4 * i + 3]);
            *(float4*)(gate + row * 16 + 4 * i) = make_float4(ts[4 * i] * inv, ts[4 * i + 1] * inv, ts[4 * i + 2] * inv, ts[4 * i + 3] * inv);
        }
    }
}

DEV float row_sum_dpp(float v) {
    v += __int_as_float(__builtin_amdgcn_update_dpp(0, __float_as_int(v), 0xB1, 0xF, 0xF, true));
    v += __int_as_float(__builtin_amdgcn_update_dpp(0, __float_as_int(v), 0x4E, 0xF, 0xF, true));
    v += __int_as_float(__builtin_amdgcn_update_dpp(0, __float_as_int(v), 0x141, 0xF, 0xF, true));
    v += __int_as_float(__builtin_amdgcn_update_dpp(0, __float_as_int(v), 0x140, 0xF, 0xF, true));
    return v;
}
DEV float wave_sum_dpp(float v) {
    v = row_sum_dpp(v);
    const float r0 = __int_as_float(__builtin_amdgcn_readlane(__float_as_int(v), 0)), r1 = __int_as_float(__builtin_amdgcn_readlane(__float_as_int(v), 16));
    const float r2 = __int_as_float(__builtin_amdgcn_readlane(__float_as_int(v), 32)), r3 = __int_as_float(__builtin_amdgcn_readlane(__float_as_int(v), 48));
    return (r0 + r1) + (r2 + r3);
}
typedef float f32x2 __attribute__((ext_vector_type(2)));
typedef float f32x4 __attribute__((ext_vector_type(4)));

struct SliceMap { int virt, nx, nloc, rank; };
DEV SliceMap slice_map(const Params& p, char* smem) {
    unsigned* bar = (unsigned*)p.ws;
    const unsigned x = xb_xcc_id();
    int virt = 0, nx = 0, nloc = 1;
#pragma unroll
    for (unsigned j = 0; j < 16; ++j) {
        const unsigned c = xb_ld(&bar[XB_XCNT(j)]);
        if (c > 0u) { if (j < x) ++virt; ++nx; }
        if (j == x) nloc = (int)c;
    }
    SliceMap m;
    m.virt = __builtin_amdgcn_readfirstlane(virt); m.nx = __builtin_amdgcn_readfirstlane(nx > 0 ? nx : 1); m.nloc = __builtin_amdgcn_readfirstlane(nloc > 0 ? nloc : 1);
    m.rank = __builtin_amdgcn_readfirstlane((int)((volatile LAS unsigned*)(smem + SM_CTRL))[2]);
    return m;
}

typedef _Float16 half2_t __attribute__((ext_vector_type(2)));
DEV void phase_peer_u(const Params& p, int layer, char* smem, int rep = 0) {
    const int tid = ltid(), lane = tid & 63, w = tid >> 6, l8 = lane & 7, grp = lane >> 3;
    char* ws = p.ws;
    const SliceMap sm = slice_map(p, smem);
    const bf16_t* h = (const bf16_t*)(ws + OFF_H);
    const int* eid = (const int*)(ws + OFF_EID);
    float* part = (float*)(ws + OFF_S1) + (rep ? (size_t)8 * kT * 128 : 0);
    int* ids_l = (int*)(smem + w * 9216);
    const int nk = sm.rank < 512 ? (512 - sm.rank + sm.nloc - 1) / sm.nloc : 0;
    for (int s = sm.virt; s < 8; s += sm.nx) {
        if (nk == 0) break;
        const unsigned char* U = (const unsigned char*)(ws + OFF_PU) + (((size_t)layer * 8 + s) * 16384 << 7) + l8 * 16;
        uint4 ri0, ri1, ri2, ri3, rh0, rh1;
        auto load_oct = [&](int k) __attribute__((always_inline)) {
            const size_t o = (size_t)(sm.rank + k * sm.nloc) * 4 + w;
            const uint4* ip = (const uint4*)(eid + o * 1024) + lane;
            ri0 = ip[0]; ri1 = ip[64]; ri2 = ip[128]; ri3 = ip[192];
            const bf16_t* hp = h + (o * 8 + grp) * 1024 + s * 128 + l8 * 16;
            rh0 = *(const uint4*)hp; rh1 = *(const uint4*)(hp + 8);
        };
        half2_t hh[8];
        auto store_oct = [&]() __attribute__((always_inline)) {
            uint4* il = (uint4*)ids_l + lane;
            il[0] = ri0; il[64] = ri1; il[128] = ri2; il[192] = ri3;
            const unsigned hu[8] = {rh0.x, rh0.y, rh0.z, rh0.w, rh1.x, rh1.y, rh1.z, rh1.w};
#pragma unroll
            for (int i = 0; i < 8; ++i) hh[i] = (half2_t){(_Float16)lo16(hu[i]), (_Float16)hi16(hu[i])};
        };
        load_oct(0); store_oct();
#pragma unroll 1
        for (int k = 0; k < nk; ++k) {
            if (k + 1 < nk) load_oct(k + 1);
            const size_t o = (size_t)(sm.rank + k * sm.nloc) * 4 + w;
            float* pp = part + ((size_t)s * kT + o * 8 + grp) * 128 + l8;
            uint4 va[8], vb[8];
            auto issue = [&](uint4 (&v)[8], int c) __attribute__((always_inline)) {
                const int4 i0 = *(const int4*)(ids_l + grp * 128 + c * 8), i1 = *(const int4*)(ids_l + grp * 128 + c * 8 + 4);
                const int e[8] = {i0.x, i0.y, i0.z, i0.w, i1.x, i1.y, i1.z, i1.w};
#pragma unroll
                for (int j = 0; j < 8; ++j) v[j] = *(const uint4*)(U + ((size_t)e[j] << 7));
            };
            auto compute = [&](const uint4 (&v)[8], int c) __attribute__((always_inline)) {
                float res = 0.f;
#pragma unroll
                for (int j = 0; j < 8; ++j) {
                    const unsigned d[4] = {v[j].x, v[j].y, v[j].z, v[j].w};
                    float acc = 0.f;
#pragma unroll
                    for (int q = 0; q < 4; ++q) {
                        const half2_t lo = __builtin_amdgcn_cvt_scalef32_pk_f16_fp8(d[q], 1.0f, false);
                        const half2_t hi = __builtin_amdgcn_cvt_scalef32_pk_f16_fp8(d[q], 1.0f, true);
                        acc = __builtin_amdgcn_fdot2(lo, hh[2 * q], acc, false);
                        acc = __builtin_amdgcn_fdot2(hi, hh[2 * q + 1], acc, false);
                    }
                    acc += __int_as_float(__builtin_amdgcn_update_dpp(0, __float_as_int(acc), 0xB1, 0xF, 0xF, true));
                    acc += __int_as_float(__builtin_amdgcn_update_dpp(0, __float_as_int(acc), 0x4E, 0xF, 0xF, true));
                    acc += __int_as_float(__builtin_amdgcn_update_dpp(0, __float_as_int(acc), 0x141, 0xF, 0xF, true));
                    res = (l8 == j) ? acc : res;
                    __builtin_amdgcn_sched_barrier(0);
                }
                pp[c * 8] = res;
            };
            issue(va, 0);
#pragma unroll
            for (int c = 0; c < 16; c += 2) {
                issue(vb, c + 1);
                __builtin_amdgcn_sched_barrier(0);
                compute(va, c);
                __builtin_amdgcn_sched_barrier(0);
                if (c + 2 < 16) issue(va, c + 2);
                __builtin_amdgcn_sched_barrier(0);
                compute(vb, c + 1);
                __builtin_amdgcn_sched_barrier(0);
            }
            if (k + 1 < nk) store_oct();
        }
    }
}

DEV void phase_peer_comb(const Params& p, int rep = 0) {
    const int tid = ltid();
    const float* part = (const float*)(p.ws + OFF_S1);
    float* gate = (float*)(p.ws + OFF_GATE);
    for (size_t i = (size_t)blockIdx.x * 256 + tid; i < (size_t)kT * 128 / 4; i += (size_t)gridDim.x * 256) {
        float4 a = *(const float4*)(part + i * 4);
#pragma unroll
        for (int x = 1; x < 8; ++x) { const float4 b = *(const float4*)(part + (size_t)x * kT * 128 + i * 4); a.x += b.x; a.y += b.y; a.z += b.z; a.w += b.w; }
        const float4 g = *(const float4*)(gate + i * 4);
        float4 o;
        o.x = g.x * gelu_tanh(a.x * (1.f / kScaleU)); o.y = g.y * gelu_tanh(a.y * (1.f / kScaleU));
        o.z = g.z * gelu_tanh(a.z * (1.f / kScaleU)); o.w = g.w * gelu_tanh(a.w * (1.f / kScaleU));
        if (rep == 0) *(float4*)(gate + i * 4) = o;
    }
}

DEV void phase_peer_v(const Params& p, int layer, char* smem, int rep = 0) {
    const int tid = ltid(), lane = tid & 63, w = tid >> 6, l8 = lane & 7, grp = lane >> 3;
    char* ws = p.ws;
    const SliceMap sm = slice_map(p, smem);
    float* xres = (float*)(ws + OFF_XRES);
    const int* eid = (const int*)(ws + OFF_EID);
    const float* wbuf = (const float*)(ws + OFF_GATE);
    const float* mod = (const float*)(ws + OFF_MOD);
    int* ids_l = (int*)(smem + w * 9216);
    float* w_l = (float*)(smem + w * 9216 + 4096);
    const int nk = sm.rank < 512 ? (512 - sm.rank + sm.nloc - 1) / sm.nloc : 0;
    for (int s = sm.virt; s < 8; s += sm.nx) {
        if (nk == 0) break;
        const unsigned char* V = (const unsigned char*)(ws + OFF_PV) + (((size_t)layer * 8 + s) * 16384 << 7) + l8 * 16;
        uint4 ri0, ri1, ri2, ri3, rw0, rw1, rw2, rw3;
        auto load_oct = [&](int k) __attribute__((always_inline)) {
            const size_t o = (size_t)(sm.rank + k * sm.nloc) * 4 + w;
            const uint4* ip = (const uint4*)(eid + o * 1024) + lane;
            const uint4* wp = (const uint4*)(wbuf + o * 1024) + lane;
            ri0 = ip[0]; ri1 = ip[64]; ri2 = ip[128]; ri3 = ip[192];
            rw0 = wp[0]; rw1 = wp[64]; rw2 = wp[128]; rw3 = wp[192];
        };
        auto store_oct = [&]() __attribute__((always_inline)) {
            uint4* il = (uint4*)ids_l + lane; uint4* wl = (uint4*)w_l + lane;
            il[0] = ri0; il[64] = ri1; il[128] = ri2; il[192] = ri3;
            wl[0] = rw0; wl[64] = rw1; wl[128] = rw2; wl[192] = rw3;
        };
        load_oct(0); store_oct();
#pragma unroll 1
        for (int k = 0; k < nk; ++k) {
            if (k + 1 < nk) load_oct(k + 1);
            const size_t o = (size_t)(sm.rank + k * sm.nloc) * 4 + w;
            const size_t t = o * 8 + grp;
            const int b = (int)(t >> 11);
            float* xp = xres + t * 1024 + s * 128 + l8 * 16;
            const float* g2 = mod + (size_t)(layer * 8 + b) * 6144 + 5120 + s * 128 + l8 * 16;
            float4 xa[4];
#pragma unroll
            for (int c = 0; c < 4; ++c) xa[c] = *(const float4*)(xp + c * 4);
            half2_t out[8];
#pragma unroll
            for (int j = 0; j < 8; ++j) out[j] = (half2_t){(_Float16)0.f, (_Float16)0.f};
            uint4 va[8], vb[8];
            auto issue = [&](uint4 (&v)[8], int c) __attribute__((always_inline)) {
                const int4 i0 = *(const int4*)(ids_l + grp * 128 + c * 8), i1 = *(const int4*)(ids_l + grp * 128 + c * 8 + 4);
                const int e[8] = {i0.x, i0.y, i0.z, i0.w, i1.x, i1.y, i1.z, i1.w};
#pragma unroll
                for (int j = 0; j < 8; ++j) v[j] = *(const uint4*)(V + ((size_t)e[j] << 7));
            };
            auto compute = [&](const uint4 (&v)[8], int c) __attribute__((always_inline)) {
                const float4 w0 = *(const float4*)(w_l + grp * 128 + c * 8), w1 = *(const float4*)(w_l + grp * 128 + c * 8 + 4);
                const float wf[8] = {w0.x, w0.y, w0.z, w0.w, w1.x, w1.y, w1.z, w1.w};
#pragma unroll
                for (int j = 0; j < 8; ++j) {
                    const _Float16 wh = (_Float16)wf[j];
                    const half2_t ww = {wh, wh};
                    const unsigned d[4] = {v[j].x, v[j].y, v[j].z, v[j].w};
#pragma unroll
                    for (int q = 0; q < 4; ++q) {
                        const half2_t lo = __builtin_amdgcn_cvt_scalef32_pk_f16_fp8(d[q], 1.0f, false);
                        const half2_t hi = __builtin_amdgcn_cvt_scalef32_pk_f16_fp8(d[q], 1.0f, true);
                        out[2 * q] = __builtin_elementwise_fma(ww, lo, out[2 * q]);
                        out[2 * q + 1] = __builtin_elementwise_fma(ww, hi, out[2 * q + 1]);
                    }
                    __builtin_amdgcn_sched_barrier(0);
                }
            };
            issue(va, 0);
#pragma unroll
            for (int c = 0; c < 16; c += 2) {
                issue(vb, c + 1);
                __builtin_amdgcn_sched_barrier(0);
                compute(va, c);
                __builtin_amdgcn_sched_barrier(0);
                if (c + 2 < 16) issue(va, c + 2);
                __builtin_amdgcn_sched_barrier(0);
                compute(vb, c + 1);
                __builtin_amdgcn_sched_barrier(0);
            }
            if (rep == 0 || (float)out[0].x == 12345.678f) {
#pragma unroll
                for (int c = 0; c < 4; ++c) {
                    const float4 g4 = *(const float4*)(g2 + c * 4);
                    xa[c].x += g4.x * (float)out[2 * c].x * (1.f / kScaleV); xa[c].y += g4.y * (float)out[2 * c].y * (1.f / kScaleV);
                    xa[c].z += g4.z * (float)out[2 * c + 1].x * (1.f / kScaleV); xa[c].w += g4.w * (float)out[2 * c + 1].y * (1.f / kScaleV);
                    *(float4*)(xp + c * 4) = xa[c];
                }
            }
            if (k + 1 < nk) store_oct();
        }
    }
}

DEV void phase_final(const Params& p) {
    const int tid = ltid(), lane = tid & 63, w = tid >> 6;
    const float* xs = (const float*)(p.ws + OFF_XRES);
    for (int q = blockIdx.x; q < kT / 4; q += gridDim.x) {
        const int t = q * 4 + w;
        const float* xr = xs + (size_t)t * 1024;
        float4 v[4]; float ss = 0.f;
#pragma unroll
        for (int i = 0; i < 4; ++i) { v[i] = *(const float4*)(xr + i * 256 + lane * 4); ss += v[i].x * v[i].x + v[i].y * v[i].y + v[i].z * v[i].z + v[i].w * v[i].w; }
        ss = wave_sum(ss);
        const float rstd = rsqrtf(ss * (1.f / 1024.f) + kEps);
#pragma unroll
        for (int i = 0; i < 4; ++i) {
            const int col = i * 256 + lane * 4;
            const float4 g4 = *(const float4*)(p.final_g + col);
            *(float4*)(p.out + (size_t)t * 1024 + col) = make_float4(v[i].x * rstd * g4.x, v[i].y * rstd * g4.y, v[i].z * rstd * g4.z, v[i].w * rstd * g4.w);
        }
    }
}

DEV void phase_gemm_in(const Params& p, int layer, char* smem) {
    char* ws = p.ws;
    EpiBf16 epi{(bf16_t*)(ws + OFF_COLS), LDC, nullptr, nullptr, LDC};
    gemm_phase((const bf16_t*)(ws + OFF_H), 1024, (const bf16_t*)(ws + OFF_WIN) + (size_t)layer * 2432 * 1024, 1024, 1024, kT / 128, LDC / 128, smem, epi);
}
DEV void phase_gemm_mid(const Params& p, int layer, char* smem) {
    char* ws = p.ws;
    const float* misc = (const float*)(ws + OFF_MISC);
    const float* rstd = (const float*)(ws + OFF_RSTD);
    const bf16_t* cols = (const bf16_t*)(ws + OFF_COLS);
    for (int tile = blockIdx.x; tile < 16 + 384 + 512; tile += gridDim.x) {
        if (tile < 8) {
            EpiBf16 epi{(bf16_t*)(ws + OFF_KCMP), 64, nullptr, misc + (layer * 2 + 0) * 64, 64};
            gemm_tile((const bf16_t*)(ws + OFF_KC), 1024, (const bf16_t*)(ws + OFF_WCK) + (size_t)layer * 128 * 2048, 2048, 2048, tile * 128, 0, smem, epi);
        } else if (tile < 16) {
            EpiBf16 epi{(bf16_t*)(ws + OFF_KCMP) + 1024 * 64, 64, nullptr, misc + (layer * 2 + 1) * 64, 64};
            gemm_tile((const bf16_t*)(ws + OFF_VC), 1024, (const bf16_t*)(ws + OFF_WCV) + (size_t)layer * 128 * 2048, 2048, 2048, (tile - 8) * 128, 0, smem, epi);
        } else if (tile < 16 + 384) {
            const int tt = tile - 16;
            EpiBf16 epi{(bf16_t*)(ws + OFF_QMLA), 384, rstd, nullptr, 384};
            gemm_tile(cols + 1472, LDC, (const bf16_t*)(ws + OFF_WUQ) + (size_t)layer * 384 * 256, 256, 256, (tt / 3) * 128, (tt % 3) * 128, smem, epi);
        } else {
            const int tt = tile - 16 - 384;
            EpiBf16 epi{(bf16_t*)(ws + OFF_KVMLA), 512, rstd + kT, nullptr, 512};
            gemm_tile(cols + 1728, LDC, (const bf16_t*)(ws + OFF_WUKV) + (size_t)layer * 512 * 128, 128, 128, (tt / 4) * 128, (tt % 4) * 128, smem, epi);
        }
    }
}
DEV void phase_gemm_out(const Params& p, int layer, char* smem) {
    char* ws = p.ws;
    EpiRes epi{layer == 0 ? p.x : (const float*)(ws + OFF_XRES), (float*)(ws + OFF_XRES), (const float*)(ws + OFF_MOD) + (size_t)layer * 8 * 6144 + 2048};
    gemm_phase((const bf16_t*)(ws + OFF_O), 1024, (const bf16_t*)(ws + OFF_WOUT) + (size_t)layer * 1024 * 1024, 1024, 1024, kT / 128, 8, smem, epi);
}
DEV void phase_gemm_wq(const Params& p, int layer, char* smem) {
    char* ws = p.ws;
    EpiBf16 epi{(bf16_t*)(ws + OFF_QP), 2048, nullptr, nullptr, 2048};
    gemm_phase((const bf16_t*)(ws + OFF_H), 1024, (const bf16_t*)(ws + OFF_WQ) + (size_t)layer * 2048 * 1024, 1024, 1024, kT / 128, 16, smem, epi);
}
DEV void phase_scores(const Params& p, int layer, char* smem) {
    char* ws = p.ws;
    for (int tile = blockIdx.x; tile < 2048; tile += gridDim.x) {
        const int c = tile >> 10, nt = tile & 1023;
        EpiF32 epi{(float*)(ws + (c ? OFF_S2 : OFF_S1)), kT * 8};
        gemm_tile((const bf16_t*)(ws + OFF_SUBK) + (size_t)(layer * 2 + c) * 16384, 128, (const bf16_t*)(ws + OFF_QP) + c * 128, 256, 128, 0, nt * 128, smem, epi);
    }
}

constexpr int NPHASE = 16;
DEV void run_phase(const Params& p, int ph, int layer, char* smem, int rep = 0) {
    switch (ph) {
        case 0: phase_prologue(p, smem); break;
        case 1: phase_norm(p, layer, 0); break;
        case 2: phase_gemm_in(p, layer, smem); break;
        case 3: phase_layout1(p, smem); break;
        case 4: phase_gemm_mid(p, layer, smem); break;
        case 5: phase_layout2(p, smem); break;
        case 6: phase_attn(p, layer, smem, rep); break;
        case 7: phase_gemm_out(p, layer, smem); break;
        case 8: phase_norm(p, layer, 1); break;
        case 9: phase_gemm_wq(p, layer, smem); break;
        case 10: phase_scores(p, layer, smem); break;
        case 11: phase_topk(p, smem); break;
        case 12: phase_peer_u(p, layer, smem, rep); break;
        case 13: phase_peer_comb(p, rep); break;
        case 14: phase_peer_v(p, layer, smem, rep); break;
        case 15: if (layer == 0) phase_norm(p, 1, 0); else phase_final(p); break;
        default: break;
    }
}

#if !FUSED
template <int PH>
__global__ void __launch_bounds__(256, 2) k_phase(Params p, int layer) {
    __shared__ __attribute__((aligned(16))) char smem[SM_TOTAL];
    run_phase(p, PH, layer, smem);
}
template <int PH> static void launch_phase(const Params& p, int layer, hipStream_t stream) { k_phase<PH><<<512, 256, 0, stream>>>(p, layer); }
static void launch_ph(int ph, const Params& p, int layer, hipStream_t stream) {
    switch (ph) {
        case 0: launch_phase<0>(p, layer, stream); break;
        case 1: launch_phase<1>(p, layer, stream); break;
        case 2: launch_phase<2>(p, layer, stream); break;
        case 3: launch_phase<3>(p, layer, stream); break;
        case 4: launch_phase<4>(p, layer, stream); break;
        case 5: launch_phase<5>(p, layer, stream); break;
        case 6: launch_phase<6>(p, layer, stream); break;
        case 7: launch_phase<7>(p, layer, stream); break;
        case 8: launch_phase<8>(p, layer, stream); break;
        case 9: launch_phase<9>(p, layer, stream); break;
        case 10: launch_phase<10>(p, layer, stream); break;
        case 11: launch_phase<11>(p, layer, stream); break;
        case 12: launch_phase<12>(p, layer, stream); break;
    }
}
#else
#if TS_A >= 0
#define TSTAMP(I) if (blockIdx.x == 0 && threadIdx.x == 0) ((unsigned long long*)(p.ws + 32768))[I] = __builtin_amdgcn_s_memrealtime();
#else
#define TSTAMP(I)
#endif
__global__ void __launch_bounds__(256, 2) k_mega(Params p) {
    extern __shared__ __attribute__((aligned(1024))) char smem[];
    cg::grid_group grid = cg::this_grid();
    volatile LAS unsigned* st = (volatile LAS unsigned*)(smem + SM_CTRL);
    if (threadIdx.x == 0) { st[0] = 0u; st[1] = 0u; st[2] = 0u; }
    __syncthreads();
    const XcdBarrier xb = xcd_barrier_post((unsigned*)p.ws, st);
    TSTAMP(0)
    run_phase(p, 0, 0, smem);
    if (p.out == nullptr) grid.sync();
    xcd_barrier(xb);
    TSTAMP(1)
    run_phase(p, 1, 0, smem);
    xcd_barrier(xb);
    TSTAMP(2)
#define STEP(PH, L) { run_phase(p, PH, L, smem, 0); xcd_barrier(xb); TSTAMP(2 + (L) * 16 + (PH)) }
#define LAYER(L) STEP(2, L) STEP(3, L) STEP(4, L) STEP(5, L) STEP(6, L) STEP(7, L) STEP(8, L) STEP(9, L) STEP(10, L) STEP(11, L) STEP(12, L) STEP(13, L) STEP(14, L)
    LAYER(0)
    STEP(15, 0)
    LAYER(1)
    run_phase(p, 15, 1, smem);
#if TS_A >= 0
    TSTAMP(2 + 16 + 15)
    __syncthreads();
    if (blockIdx.x == 0 && threadIdx.x == 0) {
        const unsigned long long* ts = (const unsigned long long*)(p.ws + 32768);
        p.out[0] += (float)(ts[TS_B] - ts[TS_A]) * 0.001f;
    }
#endif
}
#endif

extern "C" void kernel_launch(void* const* d_in, const int* in_sizes, int n_in, void* d_out, int out_size, void* d_ws, size_t ws_size, hipStream_t stream) {
    Params p{};
    const float** pp = (const float**)&p;
    for (int i = 0; i < 28; ++i) pp[i] = (const float*)d_in[i];
    p.out = (float*)d_out;
    p.ws = (char*)d_ws;
    if (ws_size < OFF_END) fprintf(stderr, "workspace too small: %zu < %zu\n", ws_size, (size_t)OFF_END);
    (void)hipMemsetAsync(d_ws, 0, 65536, stream);
#if !FUSED
    launch_ph(0, p, 0, stream);
    launch_ph(1, p, 0, stream);
    for (int l = 0; l < 2; ++l)
        for (int ph = 2; ph < NPHASE; ++ph) launch_ph(ph, p, l, stream);
#else
    static int grid_blocks = 0;
    if (!grid_blocks) {
        int dev = 0, cus = 0, per_cu = 0;
        (void)hipGetDevice(&dev);
        (void)hipDeviceGetAttribute(&cus, hipDeviceAttributeMultiprocessorCount, dev);
        (void)hipFuncSetAttribute((const void*)k_mega, hipFuncAttributeMaxDynamicSharedMemorySize, SM_TOTAL);
        (void)hipOccupancyMaxActiveBlocksPerMultiprocessor(&per_cu, (const void*)k_mega, 256, SM_TOTAL);
        if (per_cu > 2) per_cu = 2;
        if (per_cu < 1) per_cu = 1;
        grid_blocks = cus * per_cu;
    }
    void* args[] = {&p};
    hipError_t e = hipLaunchCooperativeKernel((const void*)k_mega, dim3(grid_blocks), dim3(256), args, SM_TOTAL, stream);
    if (e != hipSuccess) fprintf(stderr, "cooperative launch failed: %s (grid %d)\n", hipGetErrorString(e), grid_blocks);
#endif
}
```

```cpp
#include <hip/hip_runtime.h>
#include <hip/hip_cooperative_groups.h>
#include <stdint.h>
#include <stdio.h>
namespace cg = cooperative_groups;

#ifndef FUSED
#define FUSED 1
#endif
#ifndef TS_A
#define TS_A -1
#define TS_B -1
#endif
#ifndef PROBE_PH
#define PROBE_PH -1
#define PROBE_L 1
#define PROBE_REP 0
#endif

#define DEV __device__ __forceinline__
#define LAS __attribute__((address_space(3)))
typedef unsigned short bf16_t;
typedef short bf16x8 __attribute__((ext_vector_type(8)));
typedef float f32x16 __attribute__((ext_vector_type(16)));

constexpr int kB = 8, kS = 2048, kT = kB * kS, kD = 1024, LDC = 2432;
constexpr float kEps = 1e-6f;
constexpr float kNeg = -1e30f;
constexpr float kLog2e = 1.4426950408889634f;
constexpr float kScaleU = 256.f, kScaleV = 32.f;

constexpr size_t OFF_CTRL = 0;
constexpr size_t OFF_MOD  = 65536;
constexpr size_t OFF_ROPE = OFF_MOD + 2ull * 8 * 6144 * 4;
constexpr size_t OFF_MISC = OFF_ROPE + 2048ull * 96 * 4;
constexpr size_t OFF_WIN  = OFF_MISC + 4096;
constexpr size_t OFF_WOUT = OFF_WIN + 2ull * 2432 * 1024 * 2;
constexpr size_t OFF_WQ   = OFF_WOUT + 2ull * 1024 * 1024 * 2;
constexpr size_t OFF_WUQ  = OFF_WQ + 2ull * 2048 * 1024 * 2;
constexpr size_t OFF_WUKV = OFF_WUQ + 2ull * 384 * 256 * 2;
constexpr size_t OFF_WCK  = OFF_WUKV + 2ull * 512 * 128 * 2;
constexpr size_t OFF_WCV  = OFF_WCK + 2ull * 128 * 2048 * 2;
constexpr size_t OFF_SUBK = OFF_WCV + 2ull * 128 * 2048 * 2;
constexpr size_t OFF_PU   = OFF_SUBK + 2ull * 2 * 128 * 128 * 2;
constexpr size_t OFF_PV   = OFF_PU + 2ull * 16384 * 1024;
constexpr size_t OFF_XRES = OFF_PV + 2ull * 16384 * 1024;
constexpr size_t OFF_H    = OFF_XRES + (size_t)kT * 1024 * 4;
constexpr size_t OFF_H8   = OFF_H + (size_t)kT * 1024 * 2;
constexpr size_t OFF_RSTD = OFF_H8 + (size_t)kT * 1024;
constexpr size_t OFF_KCMP = OFF_RSTD + 2ull * kT * 4;
constexpr size_t OFF_EID  = OFF_KCMP + 2ull * 1024 * 64 * 2;
constexpr size_t OFF_GATE = OFF_EID + (size_t)kT * 128 * 4;
constexpr size_t OFF_QP   = OFF_GATE + (size_t)kT * 128 * 4;
constexpr size_t OFF_COLS = OFF_QP + (size_t)kT * 2048 * 2;
constexpr size_t OFF_KC   = OFF_COLS + (size_t)kT * LDC * 2;
constexpr size_t OFF_VC   = OFF_KC + (size_t)(kT + 64) * 64 * 2;
constexpr size_t OFF_VT   = OFF_VC + (size_t)(kT + 64) * 64 * 2;
constexpr size_t OFF_QMLA = OFF_VT + 8ull * 12 * 64 * 2048 * 2;
constexpr size_t OFF_KVMLA = OFF_QMLA + (size_t)kT * 384 * 2;
constexpr size_t OFF_O    = OFF_KVMLA + (size_t)kT * 512 * 2;
constexpr size_t OFF_END  = OFF_O + (size_t)kT * 1024 * 2;
constexpr size_t OFF_S1 = OFF_COLS, OFF_S2 = OFF_COLS + (size_t)kT * 8 * 128 * 4;
static_assert(OFF_S2 + (size_t)kT * 8 * 128 * 4 <= OFF_O, "alias region too small");
static_assert(OFF_END <= (512ull << 20), "workspace too large");

struct Params {
    const float *x, *c, *ada_w, *ada_b, *norm_mix_g, *norm_ffn_g, *w_in, *pos_k, *pos_v, *cmp_wk, *cmp_wv;
    const float *lq1, *lk1, *lq2, *lk2, *sub_g, *mla_qg, *mla_wuq, *mla_kvg, *mla_wukv, *sinks, *w_out;
    const float *w_q, *subk1, *subk2, *pu, *pv, *final_g;
    float* out;
    char* ws;
};

DEV int ltid() { int t = threadIdx.x; asm volatile("" : "+v"(t)); return t; }
DEV float bf2f(bf16_t v) { return __uint_as_float(((unsigned)v) << 16); }
DEV bf16_t f2bf(float f) { unsigned u = __float_as_uint(f); u += 0x7fffu + ((u >> 16) & 1u); return (bf16_t)(u >> 16); }
DEV unsigned pack2(float lo, float hi) { return (unsigned)f2bf(lo) | ((unsigned)f2bf(hi) << 16); }
DEV float lo16(unsigned u) { return __uint_as_float(u << 16); }
DEV float hi16(unsigned u) { return __uint_as_float(u & 0xffff0000u); }
DEV float wave_sum(float v) {
#pragma unroll
    for (int o = 32; o > 0; o >>= 1) v += __shfl_xor(v, o, 64);
    return v;
}
DEV float xor32f(float v, int lane) { return __int_as_float(__builtin_amdgcn_ds_bpermute((lane ^ 32) << 2, __float_as_int(v))); }
DEV float lanef(float v, int src) { return __int_as_float(__builtin_amdgcn_ds_bpermute(src << 2, __float_as_int(v))); }
DEV f32x16 mfma32(bf16x8 a, bf16x8 b, f32x16 c) { return __builtin_amdgcn_mfma_f32_32x32x16_bf16(a, b, c, 0, 0, 0); }
DEV f32x16 zero16() { f32x16 z;
#pragma unroll
    for (int i = 0; i < 16; ++i) z[i] = 0.f;
    return z; }
DEV float gelu_tanh(float x) {
    const float u = 0.7978845608028654f * (x + 0.044715f * x * x * x);
    const float e = __expf(2.f * u);
    const float t = 1.f - 2.f / (e + 1.f);
    return 0.5f * x * (1.f + t);
}

template <class Epi>
DEV void gemm_tile(const bf16_t* __restrict__ A, int lda, const bf16_t* __restrict__ Bt, int ldb, int K, int m0, int n0, char* smem, const Epi& epi) {
    const int tid = ltid(), lane = tid & 63, w = tid >> 6, wm = w >> 1, wn = w & 1, ql = lane & 31, hh = lane >> 5;
    f32x16 acc[2][2];
#pragma unroll
    for (int i = 0; i < 2; ++i)
#pragma unroll
        for (int j = 0; j < 2; ++j) acc[i][j] = zero16();
    const int srow = lane >> 3, spos = lane & 7;
    const int c0 = spos ^ ((srow >> 1) & 7), c1 = spos ^ ((4 + (srow >> 1)) & 7);
    const bf16_t* Ag0 = A + (size_t)(m0 + w * 32 + srow) * lda + c0 * 8;
    const bf16_t* Ag1 = A + (size_t)(m0 + w * 32 + 8 + srow) * lda + c1 * 8;
    const bf16_t* Bg0 = Bt + (size_t)(n0 + w * 32 + srow) * ldb + c0 * 8;
    const bf16_t* Bg1 = Bt + (size_t)(n0 + w * 32 + 8 + srow) * ldb + c1 * 8;
    const size_t a16 = (size_t)16 * lda, b16 = (size_t)16 * ldb;
    auto stage = [&](int kt, int buf) __attribute__((always_inline)) {
        char* sa = smem + buf * 32768 + w * 4096;
        char* sb = sa + 16384;
        const int ko = kt * 64;
        __builtin_amdgcn_global_load_lds((const unsigned*)(Ag0 + ko), (LAS unsigned*)(sa), 16, 0, 0);
        __builtin_amdgcn_global_load_lds((const unsigned*)(Ag1 + ko), (LAS unsigned*)(sa + 1024), 16, 0, 0);
        __builtin_amdgcn_global_load_lds((const unsigned*)(Ag0 + a16 + ko), (LAS unsigned*)(sa + 2048), 16, 0, 0);
        __builtin_amdgcn_global_load_lds((const unsigned*)(Ag1 + a16 + ko), (LAS unsigned*)(sa + 3072), 16, 0, 0);
        __builtin_amdgcn_global_load_lds((const unsigned*)(Bg0 + ko), (LAS unsigned*)(sb), 16, 0, 0);
        __builtin_amdgcn_global_load_lds((const unsigned*)(Bg1 + ko), (LAS unsigned*)(sb + 1024), 16, 0, 0);
        __builtin_amdgcn_global_load_lds((const unsigned*)(Bg0 + b16 + ko), (LAS unsigned*)(sb + 2048), 16, 0, 0);
        __builtin_amdgcn_global_load_lds((const unsigned*)(Bg1 + b16 + ko), (LAS unsigned*)(sb + 3072), 16, 0, 0);
    };
    const int key = (ql >> 1) & 7;
    const int arow = (wm * 64 + ql) * 128, brow = (wn * 64 + ql) * 128;
    const int nk = K >> 6;
    __syncthreads();
    stage(0, 0);
    for (int kt = 0; kt < nk; ++kt) {
        asm volatile("s_waitcnt vmcnt(0)" ::: "memory");
        __syncthreads();
        if (kt + 1 < nk) stage(kt + 1, (kt + 1) & 1);
        const char* As = smem + (kt & 1) * 32768;
        const char* Bs = As + 16384;
#pragma unroll
        for (int ks = 0; ks < 4; ++ks) {
            const int co = ((ks * 2 + hh) ^ key) << 4;
            bf16x8 a[2], b[2];
#pragma unroll
            for (int i = 0; i < 2; ++i) {
                a[i] = *(const bf16x8*)(As + arow + i * 4096 + co);
                b[i] = *(const bf16x8*)(Bs + brow + i * 4096 + co);
            }
#pragma unroll
            for (int i = 0; i < 2; ++i)
#pragma unroll
                for (int j = 0; j < 2; ++j) acc[i][j] = mfma32(a[i], b[j], acc[i][j]);
        }
    }
    __syncthreads();
    float* Cs = (float*)smem;
#pragma unroll
    for (int i = 0; i < 2; ++i)
#pragma unroll
        for (int j = 0; j < 2; ++j)
#pragma unroll
            for (int r = 0; r < 16; ++r)
                Cs[(wm * 64 + i * 32 + (r & 3) + 8 * (r >> 2) + 4 * hh) * 128 + wn * 64 + j * 32 + ql] = acc[i][j][r];
    __syncthreads();
    epi.tile(m0, n0, Cs, tid);
}

struct EpiBf16 {
    bf16_t* C; int ldc; const float* rowscale; const float* colbias; int nvalid;
    DEV void tile(int m0, int n0, const float* Cs, int tid) const {
#pragma unroll
        for (int it = 0; it < 8; ++it) {
            const int id = tid + 256 * it, r = id >> 4, c8 = (id & 15) * 8;
            if (n0 + c8 >= nvalid) continue;
            float4 a = *(const float4*)(Cs + r * 128 + c8), b = *(const float4*)(Cs + r * 128 + c8 + 4);
            if (rowscale) { const float sc = rowscale[m0 + r]; a.x *= sc; a.y *= sc; a.z *= sc; a.w *= sc; b.x *= sc; b.y *= sc; b.z *= sc; b.w *= sc; }
            if (colbias) { const float4 ba = *(const float4*)(colbias + n0 + c8), bb = *(const float4*)(colbias + n0 + c8 + 4);
                a.x += ba.x; a.y += ba.y; a.z += ba.z; a.w += ba.w; b.x += bb.x; b.y += bb.y; b.z += bb.z; b.w += bb.w; }
            *(uint4*)(C + (size_t)(m0 + r) * ldc + n0 + c8) = make_uint4(pack2(a.x, a.y), pack2(a.z, a.w), pack2(b.x, b.y), pack2(b.z, b.w));
        }
    }
};
struct EpiF32 {
    float* C; int ldc;
    DEV void tile(int m0, int n0, const float* Cs, int tid) const {
#pragma unroll
        for (int it = 0; it < 16; ++it) {
            const int id = tid + 256 * it, r = id >> 5, c4 = (id & 31) * 4;
            *(float4*)(C + (size_t)(m0 + r) * ldc + n0 + c4) = *(const float4*)(Cs + r * 128 + c4);
        }
    }
};
struct EpiRes {
    const float* xin; float* xout; const float* gate;
    DEV void tile(int m0, int n0, const float* Cs, int tid) const {
        const float* g = gate + (size_t)(m0 >> 11) * 6144 + n0;
#pragma unroll
        for (int it = 0; it < 16; ++it) {
            const int id = tid + 256 * it, r = id >> 5, c4 = (id & 31) * 4;
            const float4 v = *(const float4*)(Cs + r * 128 + c4), g4 = *(const float4*)(g + c4);
            float4 x = *(const float4*)(xin + (size_t)(m0 + r) * 1024 + n0 + c4);
            x.x += g4.x * v.x; x.y += g4.y * v.y; x.z += g4.z * v.z; x.w += g4.w * v.w;
            *(float4*)(xout + (size_t)(m0 + r) * 1024 + n0 + c4) = x;
        }
    }
};

template <class Epi>
DEV void gemm_phase(const bf16_t* A, int lda, const bf16_t* Bt, int ldb, int K, int mtiles, int ntiles, char* smem, const Epi& epi) {
    for (int tile = blockIdx.x; tile < mtiles * ntiles; tile += gridDim.x) {
        const int mt = tile / ntiles, nt = tile % ntiles;
        gemm_tile(A, lda, Bt, ldb, K, mt * 128, nt * 128, smem, epi);
    }
}

DEV int win_srccol(int n) {
    if (n < 652) return n;
    if (n < 704) return -1;
    if (n < 1888) return n - 52;
    if (n < 1920) return -1;
    return n - 84;
}
DEV void transpose_tile(const float* __restrict__ src, int ld_src, int nsrc_valid, int mode, const float* __restrict__ rowscale,
                        bf16_t* __restrict__ dst, int K, int n0, int k0, char* smem) {
    bf16_t* Ls = (bf16_t*)smem;
    const int tid = ltid();
    __syncthreads();
    const int nn = tid & 63, n = n0 + nn;
    const int sc = (mode == 1) ? win_srccol(n) : (n < nsrc_valid ? n : -1);
#pragma unroll 4
    for (int i = 0; i < 16; ++i) {
        const int kk = (tid >> 6) + 4 * i;
        float v = 0.f;
        if (sc >= 0) { v = src[(size_t)(k0 + kk) * ld_src + sc]; if (rowscale) v *= rowscale[k0 + kk]; }
        Ls[nn * 72 + kk] = f2bf(v);
    }
    __syncthreads();
#pragma unroll
    for (int i = 0; i < 2; ++i) {
        const int r = (tid >> 3) + 32 * i, ch = tid & 7;
        *(uint4*)(dst + (size_t)(n0 + r) * K + k0 + ch * 8) = *(const uint4*)(Ls + r * 72 + ch * 8);
    }
}

DEV void convert_stream(const float* __restrict__ src, bf16_t* __restrict__ dst, size_t n8) {
    const int tid = ltid();
    for (size_t i = (size_t)blockIdx.x * 256 + tid; i < n8; i += (size_t)gridDim.x * 256) {
        const float4 a = *(const float4*)(src + i * 8), b = *(const float4*)(src + i * 8 + 4);
        uint4 o; o.x = pack2(a.x, a.y); o.y = pack2(a.z, a.w); o.z = pack2(b.x, b.y); o.w = pack2(b.z, b.w);
        *(uint4*)(dst + i * 8) = o;
    }
}

DEV void convert_fp8_stream(const float* __restrict__ src, unsigned char* __restrict__ dst, size_t n16, float scale) {
    const int tid = ltid();
    const size_t stride = (size_t)gridDim.x * 256;
    for (size_t i0 = (size_t)blockIdx.x * 256 + tid; i0 < n16; i0 += stride * 4) {
        float4 q[4][4];
#pragma unroll
        for (int u = 0; u < 4; ++u) {
            const size_t i = i0 + u * stride < n16 ? i0 + u * stride : i0;
#pragma unroll
            for (int c = 0; c < 4; ++c) q[u][c] = *(const float4*)(src + i * 16 + c * 4);
        }
#pragma unroll
        for (int u = 0; u < 4; ++u) {
            const size_t i = i0 + u * stride;
            if (i >= n16) break;
            unsigned o[4];
#pragma unroll
            for (int j = 0; j < 4; ++j) {
                const float4 v = q[u][j];
                unsigned w = 0u;
                w = __builtin_amdgcn_cvt_pk_fp8_f32(fminf(fmaxf(v.x * scale, -440.f), 440.f), fminf(fmaxf(v.y * scale, -440.f), 440.f), w, false);
                w = __builtin_amdgcn_cvt_pk_fp8_f32(fminf(fmaxf(v.z * scale, -440.f), 440.f), fminf(fmaxf(v.w * scale, -440.f), 440.f), w, true);
                o[j] = w;
            }
            const size_t rowg = i >> 6; const int c16 = (int)(i & 63);
            const size_t l = rowg >> 14, row = rowg & 16383;
            *(uint4*)(dst + (((l * 8 + (c16 >> 3)) * 16384 + row) << 7) + (c16 & 7) * 16) = make_uint4(o[0], o[1], o[2], o[3]);
        }
    }
}

constexpr int J_ROPE = 384, J_MOD = 192, J_MISC = 5;
constexpr int J_TW_L = 608 + 256 + 512 + 24 + 16 + 64 + 64;
constexpr int J_TOTAL = J_ROPE + J_MOD + J_MISC + 2 * J_TW_L;

DEV void prologue_job(const Params& p, int job, char* smem) {
    const int tid = ltid();
    char* ws = p.ws;
    if (job < J_MISC) {
        float* misc = (float*)(ws + OFF_MISC);
        if (job < 4) {
            const int l = job >> 1, kv = job & 1;
            const float* pos = (kv ? p.pos_v : p.pos_k) + l * 2048;
            const float* wsrc = (kv ? p.cmp_wv : p.cmp_wk) + (size_t)l * 2048 * 64;
            float* red = (float*)smem;
            __syncthreads();
            const int kp = tid >> 6, n = tid & 63;
            float acc = 0.f;
            for (int k0 = kp * 512; k0 < kp * 512 + 512; k0 += 16) {
                float wv[16];
#pragma unroll
                for (int u = 0; u < 16; ++u) wv[u] = wsrc[(size_t)(k0 + u) * 64 + n];
#pragma unroll
                for (int u = 0; u < 16; ++u) acc += pos[k0 + u] * wv[u];
            }
            red[kp * 64 + n] = acc;
            __syncthreads();
            if (tid < 64) misc[(l * 2 + kv) * 64 + tid] = red[tid] + red[64 + tid] + red[128 + tid] + red[192 + tid];
        } else if (tid < 2) {
            const int l = tid;
            float d1 = 0.f, d2 = 0.f;
            for (int i = 0; i < 32; ++i) { d1 += p.lq1[l * 32 + i] * p.lk1[l * 32 + i]; d2 += p.lq2[l * 32 + i] * p.lk2[l * 32 + i]; }
            const float lam_init = 0.8f - 0.6f * expf(-0.3f * (float)l);
            misc[256 + l] = expf(d1) - expf(d2) + lam_init;
            misc[258 + l] = 1.f - lam_init;
        }
        return;
    }
    job -= J_MISC;
    if (job < J_MOD) {
        const int l = job / 96, n0 = (job % 96) * 64;
        float* sc = (float*)smem;
        __syncthreads();
        for (int i = tid; i < 8192; i += 256) { const float v = p.c[i]; sc[i] = v / (1.f + __expf(-v)); }
        __syncthreads();
        const int kp = tid >> 6, col = tid & 63;
        float acc[8];
#pragma unroll
        for (int b = 0; b < 8; ++b) acc[b] = 0.f;
        const float* wp = p.ada_w + (size_t)l * 1024 * 6144 + n0 + col;
        for (int k0 = kp * 256; k0 < kp * 256 + 256; k0 += 16) {
            float wv[16];
#pragma unroll
            for (int u = 0; u < 16; ++u) wv[u] = wp[(size_t)(k0 + u) * 6144];
#pragma unroll
            for (int u = 0; u < 16; ++u)
#pragma unroll
                for (int b = 0; b < 8; ++b) acc[b] += sc[b * 1024 + k0 + u] * wv[u];
        }
        float* red = sc + 8192;
#pragma unroll
        for (int b = 0; b < 8; ++b) red[(kp * 8 + b) * 64 + col] = acc[b];
        __syncthreads();
        float* mod = (float*)(ws + OFF_MOD);
        for (int idx = tid; idx < 512; idx += 256) {
            const int b = idx >> 6, cl = idx & 63;
            const float v = red[(0 * 8 + b) * 64 + cl] + red[(1 * 8 + b) * 64 + cl] + red[(2 * 8 + b) * 64 + cl] + red[(3 * 8 + b) * 64 + cl];
            mod[(size_t)(l * 8 + b) * 6144 + n0 + cl] = v + p.ada_b[l * 6144 + n0 + cl];
        }
        return;
    }
    job -= J_MOD;
    if (job < J_ROPE) {
        const int idx = job * 256 + tid;
        const int s = idx / 48, j = idx % 48;
        float* rope = (float*)(ws + OFF_ROPE);
        float inv; float *pc, *ps;
        if (j < 32) { inv = exp2f(-(float)j * (13.287712379549449f / 32.f)); pc = rope + s * 32 + j; ps = rope + 2048 * 32 + s * 32 + j; }
        else { const int i = j - 32; inv = exp2f(-(float)i * (13.287712379549449f / 16.f)); pc = rope + 2048 * 64 + s * 16 + i; ps = rope + 2048 * 64 + 2048 * 16 + s * 16 + i; }
        const double a = (double)s * (double)inv;
        const double kk = rint(a * 0.15915494309189535);
        const float r = (float)fma(-kk, 6.283185307179586, a);
        *pc = cosf(r); *ps = sinf(r);
        return;
    }
    job -= J_ROPE;
    const int l = job / J_TW_L; int j = job % J_TW_L;
    if (j < 608) { transpose_tile(p.w_in + (size_t)l * 1024 * 2348, 2348, 2348, 1, nullptr, (bf16_t*)(ws + OFF_WIN) + (size_t)l * 2432 * 1024, 1024, (j / 16) * 64, (j % 16) * 64, smem); return; }
    j -= 608;
    if (j < 256) { transpose_tile(p.w_out + (size_t)l * 1024 * 1024, 1024, 1024, 0, nullptr, (bf16_t*)(ws + OFF_WOUT) + (size_t)l * 1024 * 1024, 1024, (j / 16) * 64, (j % 16) * 64, smem); return; }
    j -= 256;
    if (j < 512) { transpose_tile(p.w_q + (size_t)l * 1024 * 2048, 2048, 2048, 0, nullptr, (bf16_t*)(ws + OFF_WQ) + (size_t)l * 2048 * 1024, 1024, (j / 16) * 64, (j % 16) * 64, smem); return; }
    j -= 512;
    if (j < 24) { transpose_tile(p.mla_wuq + (size_t)l * 256 * 384, 384, 384, 0, p.mla_qg + l * 256, (bf16_t*)(ws + OFF_WUQ) + (size_t)l * 384 * 256, 256, (j / 4) * 64, (j % 4) * 64, smem); return; }
    j -= 24;
    if (j < 16) { transpose_tile(p.mla_wukv + (size_t)l * 128 * 512, 512, 512, 0, p.mla_kvg + l * 128, (bf16_t*)(ws + OFF_WUKV) + (size_t)l * 512 * 128, 128, (j / 2) * 64, (j % 2) * 64, smem); return; }
    j -= 16;
    if (j < 64) { transpose_tile(p.cmp_wk + (size_t)l * 2048 * 64, 64, 64, 0, nullptr, (bf16_t*)(ws + OFF_WCK) + (size_t)l * 128 * 2048, 2048, (j / 32) * 64, (j % 32) * 64, smem); return; }
    j -= 64;
    transpose_tile(p.cmp_wv + (size_t)l * 2048 * 64, 64, 64, 0, nullptr, (bf16_t*)(ws + OFF_WCV) + (size_t)l * 128 * 2048, 2048, (j / 32) * 64, (j % 32) * 64, smem);
}

#if TS_A >= 0
#define PSTAMP(I) if (blockIdx.x == 0 && threadIdx.x == 0) ((unsigned long long*)(p.ws + 32768))[I] = __builtin_amdgcn_s_memrealtime();
#else
#define PSTAMP(I)
#endif
DEV void phase_prologue(const Params& p, char* smem) {
    for (int job = blockIdx.x; job < J_TOTAL; job += gridDim.x) { prologue_job(p, job, smem); if (job < 512) { PSTAMP(40) } }
    PSTAMP(42)
    char* ws = p.ws;
    convert_fp8_stream(p.pu, (unsigned char*)(ws + OFF_PU), 2ull * 16384 * 1024 / 16, kScaleU);
    PSTAMP(43)
    convert_fp8_stream(p.pv, (unsigned char*)(ws + OFF_PV), 2ull * 16384 * 1024 / 16, kScaleV);
    PSTAMP(44)
    for (int l = 0; l < 2; ++l) {
        convert_stream(p.subk1 + (size_t)l * 16384, (bf16_t*)(ws + OFF_SUBK) + (size_t)(l * 2 + 0) * 16384, 16384 / 8);
        convert_stream(p.subk2 + (size_t)l * 16384, (bf16_t*)(ws + OFF_SUBK) + (size_t)(l * 2 + 1) * 16384, 16384 / 8);
    }
}

DEV void phase_norm(const Params& p, int layer, int which) {
    const int tid = ltid(), lane = tid & 63, w = tid >> 6;
    const float* xs = (layer == 0 && which == 0) ? p.x : (const float*)(p.ws + OFF_XRES);
    const float* g = (which == 0 ? p.norm_mix_g : p.norm_ffn_g) + layer * 1024;
    const float* mod = (const float*)(p.ws + OFF_MOD) + (size_t)layer * 8 * 6144;
    bf16_t* h = (bf16_t*)(p.ws + OFF_H);
    for (int q = blockIdx.x; q < kT / 4; q += gridDim.x) {
        const int t = q * 4 + w, b = t >> 11;
        const float* xr = xs + (size_t)t * 1024;
        float4 v[4]; float ss = 0.f;
#pragma unroll
        for (int i = 0; i < 4; ++i) { v[i] = *(const float4*)(xr + i * 256 + lane * 4); ss += v[i].x * v[i].x + v[i].y * v[i].y + v[i].z * v[i].z + v[i].w * v[i].w; }
        ss = wave_sum(ss);
        const float rstd = rsqrtf(ss * (1.f / 1024.f) + kEps);
        const float* sh = mod + (size_t)b * 6144 + (which ? 3072 : 0);
        const float* sc = sh + 1024;
#pragma unroll
        for (int i = 0; i < 4; ++i) {
            const int col = i * 256 + lane * 4;
            const float4 g4 = *(const float4*)(g + col), s4 = *(const float4*)(sc + col), h4 = *(const float4*)(sh + col);
            const float o0 = v[i].x * rstd * g4.x * (1.f + s4.x) + h4.x, o1 = v[i].y * rstd * g4.y * (1.f + s4.y) + h4.y;
            const float o2 = v[i].z * rstd * g4.z * (1.f + s4.z) + h4.z, o3 = v[i].w * rstd * g4.w * (1.f + s4.w) + h4.w;
            uint2 o; o.x = pack2(o0, o1); o.y = pack2(o2, o3);
            *(uint2*)(h + (size_t)t * 1024 + col) = o;
        }
    }
}

DEV void rope8(uint4& x1, uint4& x2, const float* cs, const float* sn) {
    const float4 c0 = *(const float4*)cs, c1 = *(const float4*)(cs + 4), s0 = *(const float4*)sn, s1 = *(const float4*)(sn + 4);
    const float cc[8] = {c0.x, c0.y, c0.z, c0.w, c1.x, c1.y, c1.z, c1.w};
    const float ss[8] = {s0.x, s0.y, s0.z, s0.w, s1.x, s1.y, s1.z, s1.w};
    unsigned a[4] = {x1.x, x1.y, x1.z, x1.w}, b[4] = {x2.x, x2.y, x2.z, x2.w};
#pragma unroll
    for (int i = 0; i < 4; ++i) {
        const float a0 = lo16(a[i]), a1 = hi16(a[i]), b0 = lo16(b[i]), b1 = hi16(b[i]);
        const float o10 = a0 * cc[2 * i] - b0 * ss[2 * i], o11 = a1 * cc[2 * i + 1] - b1 * ss[2 * i + 1];
        const float o20 = a0 * ss[2 * i] + b0 * cc[2 * i], o21 = a1 * ss[2 * i + 1] + b1 * cc[2 * i + 1];
        a[i] = pack2(o10, o11); b[i] = pack2(o20, o21);
    }
    x1 = make_uint4(a[0], a[1], a[2], a[3]); x2 = make_uint4(b[0], b[1], b[2], b[3]);
}
DEV void vt_tile(const bf16_t* __restrict__ src, int ld, bf16_t* __restrict__ dst, char* smem) {
    bf16_t* Ls = (bf16_t*)smem;
    const int tid = ltid();
    __syncthreads();
#pragma unroll
    for (int i = 0; i < 2; ++i) {
        const int id = tid + 256 * i, tok = id >> 3, ch = id & 7;
        *(uint4*)(Ls + tok * 72 + ch * 8) = *(const uint4*)(src + (size_t)tok * ld + ch * 8);
    }
    __syncthreads();
#pragma unroll
    for (int i = 0; i < 2; ++i) {
        const int id = tid + 256 * i, d = id >> 3, tc = id & 7;
        unsigned short e[8];
#pragma unroll
        for (int j = 0; j < 8; ++j) e[j] = Ls[(tc * 8 + j) * 72 + d];
        uint4 o;
        o.x = (unsigned)e[0] | ((unsigned)e[1] << 16); o.y = (unsigned)e[2] | ((unsigned)e[3] << 16);
        o.z = (unsigned)e[4] | ((unsigned)e[5] << 16); o.w = (unsigned)e[6] | ((unsigned)e[7] << 16);
        *(uint4*)(dst + (size_t)d * 2048 + tc * 8) = o;
    }
}

DEV void phase_layout1(const Params& p, char* smem) {
    char* ws = p.ws;
    bf16_t* cols = (bf16_t*)(ws + OFF_COLS);
    bf16_t* kc = (bf16_t*)(ws + OFF_KC);
    bf16_t* vc = (bf16_t*)(ws + OFF_VC);
    bf16_t* VT = (bf16_t*)(ws + OFF_VT);
    float* rstd = (float*)(ws + OFF_RSTD);
    const float* rope = (const float*)(ws + OFF_ROPE);
    const float *cos64 = rope, *sin64 = rope + 2048 * 32, *cos32 = rope + 2048 * 64, *sin32 = rope + 2048 * 64 + 2048 * 16;
    const int tid = ltid();
    for (int tile = blockIdx.x; tile < kT / 64; tile += gridDim.x) {
        const int T0 = tile * 64, b = T0 >> 11, s0 = T0 & 2047;
        for (int it = tid; it < 64 * 94; it += 256) {
            const int tok = it / 94, item = it % 94;
            const int t = T0 + tok, s = s0 + tok;
            bf16_t* row = cols + (size_t)t * LDC;
            if (item < 52) {
                const int hd = item >> 2, i0 = (item & 3) * 8;
                const int base = hd < 4 ? 64 * hd : hd == 4 ? 256 : hd == 5 ? 384 : hd == 6 ? 512 : hd < 11 ? 1920 + 64 * (hd - 7) : 2176 + 64 * (hd - 11);
                uint4 x1 = *(const uint4*)(row + base + i0), x2 = *(const uint4*)(row + base + 32 + i0);
                rope8(x1, x2, cos64 + s * 32 + i0, sin64 + s * 32 + i0);
                *(uint4*)(row + base + i0) = x1; *(uint4*)(row + base + 32 + i0) = x2;
                if (hd == 4) { *(uint4*)(kc + (size_t)t * 64 + i0) = x1; *(uint4*)(kc + (size_t)t * 64 + 32 + i0) = x2; }
            } else if (item < 86) {
                const int it2 = item - 52, sub = it2 >> 1, i0 = (it2 & 1) * 8;
                const int base = sub < 8 ? 704 + 32 * sub : sub < 16 ? 960 + 32 * (sub - 8) : 1856;
                uint4 x1 = *(const uint4*)(row + base + i0), x2 = *(const uint4*)(row + base + 16 + i0);
                rope8(x1, x2, cos32 + s * 16 + i0, sin32 + s * 16 + i0);
                *(uint4*)(row + base + i0) = x1; *(uint4*)(row + base + 16 + i0) = x2;
            } else {
                const int ch = item - 86;
                *(uint4*)(vc + (size_t)t * 64 + ch * 8) = *(const uint4*)(row + 320 + ch * 8);
            }
        }
        {
            const int tok = tid >> 2, part = tid & 3, t = T0 + tok;
            const bf16_t* src = cols + (size_t)t * LDC + 1472 + (part < 3 ? part : 0) * 128;
            float ss = 0.f;
#pragma unroll 4
            for (int i = 0; i < 16; ++i) {
                const uint4 u = *(const uint4*)(src + i * 8);
                ss += lo16(u.x) * lo16(u.x) + hi16(u.x) * hi16(u.x) + lo16(u.y) * lo16(u.y) + hi16(u.y) * hi16(u.y)
                    + lo16(u.z) * lo16(u.z) + hi16(u.z) * hi16(u.z) + lo16(u.w) * lo16(u.w) + hi16(u.w) * hi16(u.w);
            }
            float vq = part < 2 ? ss : 0.f;
            vq += __shfl_xor(vq, 1, 64);
            if (part == 0) rstd[t] = rsqrtf(vq * (1.f / 256.f) + kEps);
            if (part == 2) rstd[kT + t] = rsqrtf(ss * (1.f / 128.f) + kEps);
        }
#pragma unroll 1
        for (int vh = 0; vh < 8; ++vh) {
            const int col = vh == 0 ? 448 : vh == 1 ? 576 : vh < 6 ? 1216 + 64 * (vh - 2) : 2304 + 64 * (vh - 6);
            vt_tile(cols + (size_t)T0 * LDC + col, LDC, VT + ((size_t)(b * 12 + vh) * 64) * 2048 + s0, smem);
        }
    }
}

DEV void phase_layout2(const Params& p, char* smem) {
    char* ws = p.ws;
    bf16_t* qmla = (bf16_t*)(ws + OFF_QMLA);
    const bf16_t* kvmla = (const bf16_t*)(ws + OFF_KVMLA);
    bf16_t* VT = (bf16_t*)(ws + OFF_VT);
    const float* rope = (const float*)(ws + OFF_ROPE);
    const float *cos32 = rope + 2048 * 64, *sin32 = rope + 2048 * 64 + 2048 * 16;
    const int tid = ltid();
    for (int tile = blockIdx.x; tile < kT / 64; tile += gridDim.x) {
        const int T0 = tile * 64, b = T0 >> 11, s0 = T0 & 2047;
        for (int it = tid; it < 64 * 8; it += 256) {
            const int tok = it >> 3, item = it & 7, hd = item >> 1, i0 = (item & 1) * 8;
            const int t = T0 + tok, s = s0 + tok;
            bf16_t* row = qmla + (size_t)t * 384 + hd * 96 + 64;
            uint4 x1 = *(const uint4*)(row + i0), x2 = *(const uint4*)(row + 16 + i0);
            rope8(x1, x2, cos32 + s * 16 + i0, sin32 + s * 16 + i0);
            *(uint4*)(row + i0) = x1; *(uint4*)(row + 16 + i0) = x2;
        }
#pragma unroll 1
        for (int hd = 0; hd < 4; ++hd)
            vt_tile(kvmla + (size_t)T0 * 512 + hd * 128 + 64, 512, VT + ((size_t)(b * 12 + 8 + hd) * 64) * 2048 + s0, smem);
    }
}

constexpr int SM_K = 0;
constexpr int SM_V = 18432;
constexpr int SM_IMP = SM_V + 16896;
constexpr int SM_SEL = SM_IMP + 16896;
constexpr int SM_CTRL = 65536;
constexpr int SM_TOTAL = SM_CTRL + 256;
constexpr int SM_ATTN_END = SM_SEL + 1024;

struct RangeIter { int cur, end; DEV int next() { return cur < end ? cur++ : -1; } };
struct BitIter { unsigned rem; DEV int next() { if (!rem) return -1; const int k = __ffs((int)rem) - 1; rem &= rem - 1; return k; } };
struct LdRow { const bf16_t* base; int ld;
    DEV uint4 operator()(int kt, int id) const { const int row = id >> 3, part = id & 7; return *(const uint4*)(base + (size_t)(kt * 64 + row) * ld + part * 8); } };
struct LdVT { const bf16_t* base;
    DEV uint4 operator()(int kt, int id) const { const int d = id >> 3, part = id & 7; return *(const uint4*)(base + (size_t)d * 2048 + kt * 64 + part * 8); } };
struct LdMlaK { const bf16_t* kv; const bf16_t* kr;
    DEV uint4 operator()(int kt, int id) const { const int row = id / 12, part = id % 12; const size_t t = (size_t)(kt * 64 + row);
        return part < 8 ? *(const uint4*)(kv + t * 512 + part * 8) : *(const uint4*)(kr + t * LDC + (part - 8) * 8); } };

struct MaskCausal { DEV bool on(int) const { return true; } DEV bool ok(int kc, int d) const { return kc <= d; } };
template <int W> struct MaskWin { DEV bool on(int) const { return true; } DEV bool ok(int kc, int d) const { return (kc <= d) && (d - kc < W); } };
struct MaskSel { unsigned bits; DEV bool on(int kt) const { return (bits >> kt) & 1u; } DEV bool ok(int kc, int d) const { return kc <= d; } };
template <int KDIM, int NKS, int NSUB, class It, class LK, class LV, class MaskF, class SkipF>
DEV void attn_stream(It it, const LK& ldK, const LV& ldV, const MaskF& maskf, const SkipF& skipf,
                     const bf16x8* qf, f32x16 (&o)[NSUB][2], float (&m)[NSUB], float (&l)[NSUB], float scl, int tq, char* smem, int tid, int koff = 0) {
    constexpr int KCH = KDIM / 8, KSTR = KDIM + 8, NKC = (64 * KCH) / 256;
    bf16_t* Kb = (bf16_t*)(smem + SM_K);
    bf16_t* Vb = (bf16_t*)(smem + SM_V);
    const int lane = tid & 63, ql = lane & 31, hh = lane >> 5;
    uint4 rk0 = make_uint4(0, 0, 0, 0), rk1 = rk0, rk2 = rk0, rv0 = rk0, rv1 = rk0;
    int kt = it.next();
    if (kt >= 0) {
        rk0 = ldK(kt, tid); rk1 = ldK(kt, tid + 256);
        if (NKC == 3) rk2 = ldK(kt, tid + 512);
        rv0 = ldV(kt, tid); rv1 = ldV(kt, tid + 256);
    }
    while (kt >= 0) {
        __syncthreads();
        { const int id = tid, row = id / KCH, part = id % KCH; *(uint4*)(Kb + row * KSTR + part * 8) = rk0; }
        { const int id = tid + 256, row = id / KCH, part = id % KCH; *(uint4*)(Kb + row * KSTR + part * 8) = rk1; }
        if (NKC == 3) { const int id = tid + 512, row = id / KCH, part = id % KCH; *(uint4*)(Kb + row * KSTR + part * 8) = rk2; }
        { const int id = tid, row = id >> 3, part = id & 7; bf16_t* d = Vb + row * 68 + part * 8;
            *(uint2*)d = make_uint2(rv0.x, rv0.y); *(uint2*)(d + 4) = make_uint2(rv0.z, rv0.w); }
        { const int id = tid + 256, row = id >> 3, part = id & 7; bf16_t* d = Vb + row * 68 + part * 8;
            *(uint2*)d = make_uint2(rv1.x, rv1.y); *(uint2*)(d + 4) = make_uint2(rv1.z, rv1.w); }
        __syncthreads();
        const int ktn = it.next();
        if (ktn >= 0) {
            rk0 = ldK(ktn, tid); rk1 = ldK(ktn, tid + 256);
            if (NKC == 3) rk2 = ldK(ktn, tid + 512);
            rv0 = ldV(ktn, tid); rv1 = ldV(ktn, tid + 256);
        }
        if (!skipf(kt)) {
#pragma unroll
            for (int sub = 0; sub < NSUB; ++sub) {
                __builtin_amdgcn_sched_barrier(0);
                f32x16 s[2];
#pragma unroll
                for (int i = 0; i < 2; ++i) {
                    s[i] = zero16();
#pragma unroll
                    for (int ks = 0; ks < NKS; ++ks) {
                        const bf16x8 a = *(const bf16x8*)(Kb + (i * 32 + ql) * KSTR + koff + (sub * NKS + ks) * 16 + hh * 8);
                        s[i] = mfma32(a, qf[sub * NKS + ks], s[i]);
                    }
                }
                float mx = kNeg;
                const int dlim = tq - kt * 64 - 4 * hh;
                const bool on = maskf.on(kt);
#pragma unroll
                for (int i = 0; i < 2; ++i)
#pragma unroll
                    for (int r = 0; r < 16; ++r) {
                        const int kc = i * 32 + (r & 3) + 8 * (r >> 2);
                        const float v = (on && maskf.ok(kc, dlim)) ? s[i][r] * scl : kNeg;
                        s[i][r] = v; mx = fmaxf(mx, v);
                    }
                mx = fmaxf(mx, xor32f(mx, lane));
                const float mnew = fmaxf(m[sub], mx);
                const float alpha = __builtin_amdgcn_exp2f(m[sub] - mnew);
                m[sub] = mnew;
                float sum = 0.f;
#pragma unroll
                for (int i = 0; i < 2; ++i)
#pragma unroll
                    for (int r = 0; r < 16; ++r) { const float pv = __builtin_amdgcn_exp2f(s[i][r] - mnew); s[i][r] = pv; sum += pv; }
                l[sub] = l[sub] * alpha + sum;
#pragma unroll
                for (int dt = 0; dt < 2; ++dt)
#pragma unroll
                    for (int r = 0; r < 16; ++r) o[sub][dt][r] *= alpha;
                __builtin_amdgcn_sched_barrier(0);
#pragma unroll
                for (int ks = 0; ks < 4; ++ks) {
                    if (ks == 2) __builtin_amdgcn_sched_barrier(0);
                    const int i = ks >> 1, r0 = 8 * (ks & 1);
                    uint4 pu;
                    pu.x = pack2(s[i][r0 + 0], s[i][r0 + 1]); pu.y = pack2(s[i][r0 + 2], s[i][r0 + 3]);
                    pu.z = pack2(s[i][r0 + 4], s[i][r0 + 5]); pu.w = pack2(s[i][r0 + 6], s[i][r0 + 7]);
                    const bf16x8 pf = __builtin_bit_cast(bf16x8, pu);
#pragma unroll
                    for (int dt = 0; dt < 2; ++dt) {
                        const bf16_t* vp = Vb + (dt * 32 + ql) * 68 + ks * 16 + 4 * hh;
                        const uint2 a0 = *(const uint2*)vp, a1 = *(const uint2*)(vp + 8);
                        const bf16x8 a = __builtin_bit_cast(bf16x8, make_uint4(a0.x, a0.y, a1.x, a1.y));
                        o[sub][dt] = mfma32(a, pf, o[sub][dt]);
                    }
                }
            }
        }
        kt = ktn;
    }
}

DEV void write_o(const f32x16 (&o)[2], bf16_t* obuf, size_t row, int col0, int hh) {
#pragma unroll
    for (int dt = 0; dt < 2; ++dt)
#pragma unroll
        for (int g = 0; g < 4; ++g) {
            const int d = dt * 32 + 8 * g + 4 * hh;
            uint2 u; u.x = pack2(o[dt][4 * g], o[dt][4 * g + 1]); u.y = pack2(o[dt][4 * g + 2], o[dt][4 * g + 3]);
            *(uint2*)(obuf + row * 1024 + col0 + d) = u;
        }
}
DEV float sigmoidf(float x) { return 1.f / (1.f + __expf(-x)); }

DEV void nsa_item(const Params& p, int b, int qb, char* smem) {
    int tid = threadIdx.x; asm volatile("" : "+v"(tid));
    const int lane = tid & 63, w = tid >> 6, ql = lane & 31, hh = lane >> 5;
    char* ws = p.ws;
    const bf16_t* cols = (const bf16_t*)(ws + OFF_COLS);
    const bf16_t* VT = (const bf16_t*)(ws + OFF_VT);
    bf16_t* obuf = (bf16_t*)(ws + OFF_O);
    const int t0 = qb * 32, tq = t0 + ql;
    const size_t Tb = (size_t)b * kS;
    const bf16_t* qrow = cols + (Tb + tq) * LDC;
    bf16x8 qf[4];
#pragma unroll
    for (int ks = 0; ks < 4; ++ks) qf[ks] = *(const bf16x8*)(qrow + w * 64 + ks * 16 + hh * 8);
    const float g0 = sigmoidf(bf2f(qrow[640 + w * 3 + 0])), g1 = sigmoidf(bf2f(qrow[640 + w * 3 + 1])), g2 = sigmoidf(bf2f(qrow[640 + w * 3 + 2]));
    const float scl = 0.125f * kLog2e;
    bf16_t* Kc = (bf16_t*)(smem + SM_K);
    bf16_t* Vc = (bf16_t*)(smem + SM_V);
    float* impP = (float*)(smem + SM_IMP);
    unsigned* selm = (unsigned*)(smem + SM_SEL);
    const bf16_t* kcmp = (const bf16_t*)(ws + OFF_KCMP) + (size_t)b * 128 * 64;
    const bf16_t* vcmp = kcmp + 1024 * 64;
    __syncthreads();
#pragma unroll
    for (int i = 0; i < 4; ++i) {
        const int id = tid + 256 * i, row = id >> 3, part = id & 7;
        uint4 kk = *(const uint4*)(kcmp + row * 64 + part * 8);
        uint4 vv = *(const uint4*)(vcmp + row * 64 + part * 8);
        if (row == 127) { kk = make_uint4(0, 0, 0, 0); vv = kk; }
        *(uint4*)(Kc + row * 72 + part * 8) = kk;
        const unsigned u[4] = {vv.x, vv.y, vv.z, vv.w};
#pragma unroll
        for (int j = 0; j < 4; ++j) { Vc[(part * 8 + 2 * j) * 132 + row] = (bf16_t)(u[j] & 0xffffu); Vc[(part * 8 + 2 * j + 1) * 132 + row] = (bf16_t)(u[j] >> 16); }
    }
    __syncthreads();
    unsigned ocp[16];
    float* invs = (float*)(smem + SM_SEL) + 64;
    {
        const int cmaxv = tq >= 31 ? min((tq - 31) >> 4, 126) : -1;
        float mx = kNeg;
#pragma unroll 1
        for (int i = 0; i < 4; ++i) {
            f32x16 s = zero16();
#pragma unroll
            for (int ks = 0; ks < 4; ++ks) s = mfma32(*(const bf16x8*)(Kc + (i * 32 + ql) * 72 + ks * 16 + hh * 8), qf[ks], s);
            const int clim = cmaxv - i * 32 - 4 * hh;
#pragma unroll
            for (int r = 0; r < 16; ++r) {
                const int kc = (r & 3) + 8 * (r >> 2);
                const bool valid = (kc <= clim);
                mx = fmaxf(mx, valid ? s[r] * scl : kNeg);
            }
        }
        mx = fmaxf(mx, xor32f(mx, lane));
        f32x16 ocmp[2]; ocmp[0] = zero16(); ocmp[1] = zero16();
        float sum = 0.f, carprev = 0.f;
#pragma unroll 1
        for (int i = 0; i < 4; ++i) {
            f32x16 s = zero16();
#pragma unroll
            for (int ks = 0; ks < 4; ++ks) s = mfma32(*(const bf16x8*)(Kc + (i * 32 + ql) * 72 + ks * 16 + hh * 8), qf[ks], s);
            const int clim = cmaxv - i * 32 - 4 * hh;
#pragma unroll
            for (int r = 0; r < 16; ++r) {
                const int kc = (r & 3) + 8 * (r >> 2);
                const bool valid = (kc <= clim);
                const float pv = valid ? __builtin_amdgcn_exp2f(s[r] * scl - mx) : 0.f;
                s[r] = pv; sum += pv;
            }
            float own[4], car[4];
#pragma unroll
            for (int g = 0; g < 4; ++g) { own[g] = s[4 * g] + s[4 * g + 1] + s[4 * g + 2] + 0.5f * s[4 * g + 3]; car[g] = 0.5f * s[4 * g + 3]; }
#pragma unroll
            for (int g = 0; g < 4; ++g) {
                const float send = hh ? (g ? car[g > 0 ? g - 1 : 0] : carprev) : car[g];
                own[g] += xor32f(send, lane);
            }
            carprev = car[3];
#pragma unroll
            for (int g = 0; g < 4; ++g) impP[(w * 32 + ql) * 33 + 2 * (4 * i + g) + hh] = own[g];
#pragma unroll
            for (int sp = 0; sp < 2; ++sp) {
                const int ks = 2 * i + sp, r0 = 8 * sp;
                uint4 pu;
                pu.x = pack2(s[r0 + 0], s[r0 + 1]); pu.y = pack2(s[r0 + 2], s[r0 + 3]);
                pu.z = pack2(s[r0 + 4], s[r0 + 5]); pu.w = pack2(s[r0 + 6], s[r0 + 7]);
                const bf16x8 pf = __builtin_bit_cast(bf16x8, pu);
#pragma unroll
                for (int dt = 0; dt < 2; ++dt) {
                    const bf16_t* vp = Vc + (dt * 32 + ql) * 132 + ks * 16 + 4 * hh;
                    const uint2 a0 = *(const uint2*)vp, a1 = *(const uint2*)(vp + 8);
                    ocmp[dt] = mfma32(__builtin_bit_cast(bf16x8, make_uint4(a0.x, a0.y, a1.x, a1.y)), pf, ocmp[dt]);
                }
            }
        }
        sum += xor32f(sum, lane);
        const float inv = sum > 0.f ? 1.f / sum : 0.f;
        invs[w * 32 + ql] = inv;
        const float f = g0 * inv;
#pragma unroll
        for (int dt = 0; dt < 2; ++dt)
#pragma unroll
            for (int r = 0; r < 8; ++r) ocp[dt * 8 + r] = pack2(f * ocmp[dt][2 * r], f * ocmp[dt][2 * r + 1]);
    }
    __syncthreads();
    const int qblk = t0 >> 6;
    {
        const int hw = tid >> 5, j = tid & 31;
#pragma unroll 1
        for (int rr = 0; rr < 4; ++rr) {
            const int row = hw * 4 + rr;
            const float v = impP[(0 * 32 + row) * 33 + j] * invs[row] + impP[(1 * 32 + row) * 33 + j] * invs[32 + row]
                          + impP[(2 * 32 + row) * 33 + j] * invs[64 + row] + impP[(3 * 32 + row) * 33 + j] * invs[96 + row];
            bool sel;
            if (qblk < 16) sel = (j <= qblk);
            else {
                const bool cand = (j >= 1) && (j <= qblk - 2);
                const bool forced = (j == 0) || (j == qblk) || (j == qblk - 1);
                int rank = 0;
                for (int j2 = 1; j2 <= qblk - 2; ++j2) {
                    const float v2 = lanef(v, (lane & 32) + j2);
                    rank += (v2 > v || (v2 == v && j2 < j)) ? 1 : 0;
                }
                sel = forced || (cand && rank < 13);
            }
            const unsigned long long bal = __ballot(sel);
            const unsigned mk = (lane & 32) ? (unsigned)(bal >> 32) : (unsigned)bal;
            if (j == 0) selm[row] = mk;
        }
    }
    __syncthreads();
    const unsigned mysel = selm[ql];
    unsigned U = mysel;
#pragma unroll
    for (int o = 16; o > 0; o >>= 1) U |= (unsigned)__builtin_amdgcn_ds_bpermute((lane ^ o) << 2, (int)U);
    {
        f32x16 o1[1][2]; o1[0][0] = zero16(); o1[0][1] = zero16();
        float m1[1] = {kNeg}, l1[1] = {0.f};
        auto skipf = [&](int) __attribute__((always_inline)) { return false; };
        attn_stream<64, 4, 1>(BitIter{U}, LdRow{cols + Tb * LDC + 384, LDC}, LdVT{VT + (size_t)(b * 12 + 0) * 64 * 2048}, MaskSel{mysel}, skipf, qf, o1, m1, l1, scl, tq, smem, tid);
        const float lt = l1[0] + xor32f(l1[0], lane);
        const float f = g1 / lt;
#pragma unroll
        for (int dt = 0; dt < 2; ++dt)
#pragma unroll
            for (int r = 0; r < 8; ++r) ocp[dt * 8 + r] = pack2(lo16(ocp[dt * 8 + r]) + f * o1[0][dt][2 * r], hi16(ocp[dt * 8 + r]) + f * o1[0][dt][2 * r + 1]);
    }
    {
        f32x16 o1[1][2]; o1[0][0] = zero16(); o1[0][1] = zero16();
        float m1[1] = {kNeg}, l1[1] = {0.f};
        auto skipf = [&](int) __attribute__((always_inline)) { return false; };
        const int lo = t0 >= 511 ? ((t0 - 511) >> 6) : 0;
        attn_stream<64, 4, 1>(RangeIter{lo, qblk + 1}, LdRow{cols + Tb * LDC + 512, LDC}, LdVT{VT + (size_t)(b * 12 + 1) * 64 * 2048}, MaskWin<512>{}, skipf, qf, o1, m1, l1, scl, tq, smem, tid);
        const float lt = l1[0] + xor32f(l1[0], lane);
        const float f = g2 / lt;
#pragma unroll
        for (int dt = 0; dt < 2; ++dt)
#pragma unroll
            for (int r = 0; r < 8; ++r) { o1[0][dt][2 * r] = lo16(ocp[dt * 8 + r]) + f * o1[0][dt][2 * r]; o1[0][dt][2 * r + 1] = hi16(ocp[dt * 8 + r]) + f * o1[0][dt][2 * r + 1]; }
        write_o(o1[0], obuf, Tb + tq, w * 64, hh);
    }
}

DEV void diff_item(const Params& p, int layer, int b, int hd, int q64, char* smem) {
    int tid = threadIdx.x; asm volatile("" : "+v"(tid));
    const int lane = tid & 63, w = tid >> 6, ql = lane & 31, hh = lane >> 5;
    const int sub = w & 1, qbw = w >> 1;
    char* ws = p.ws;
    const bf16_t* cols = (const bf16_t*)(ws + OFF_COLS);
    const bf16_t* VT = (const bf16_t*)(ws + OFF_VT);
    bf16_t* obuf = (bf16_t*)(ws + OFF_O);
    const float* misc = (const float*)(ws + OFF_MISC);
    const int t0w = q64 * 64 + qbw * 32, tq = t0w + ql;
    const size_t Tb = (size_t)b * kS;
    const bf16_t* qrow = cols + (Tb + tq) * LDC + 704 + hd * 64 + sub * 32;
    bf16x8 qf[2];
#pragma unroll
    for (int ks = 0; ks < 2; ++ks) qf[ks] = *(const bf16x8*)(qrow + ks * 16 + hh * 8);
    const float scl = 0.17677669529663687f * kLog2e;
    f32x16 o1[1][2]; o1[0][0] = zero16(); o1[0][1] = zero16();
    float m1[1] = {kNeg}, l1[1] = {0.f};
    auto skipf = [&](int kt) __attribute__((always_inline)) { return kt * 64 > t0w + 31; };
    attn_stream<64, 2, 1>(RangeIter{0, q64 + 1}, LdRow{cols + Tb * LDC + 960 + hd * 64, LDC}, LdVT{VT + (size_t)(b * 12 + 2 + hd) * 64 * 2048}, MaskCausal{}, skipf, qf, o1, m1, l1, scl, tq, smem, tid, sub * 32);
    const float lam = misc[256 + layer], post = misc[258 + layer];
    const float lt = l1[0] + xor32f(l1[0], lane);
    float* ex = (float*)smem;
    __syncthreads();
    if (sub == 1) {
        const float f = lam / lt;
#pragma unroll
        for (int dt = 0; dt < 2; ++dt)
#pragma unroll
            for (int r = 0; r < 16; ++r) ex[((qbw * 2 + dt) * 16 + r) * 64 + lane] = o1[0][dt][r] * f;
    }
    __syncthreads();
    if (sub == 0) {
        const float f = 1.f / lt;
        float ss = 0.f;
#pragma unroll
        for (int dt = 0; dt < 2; ++dt)
#pragma unroll
            for (int r = 0; r < 16; ++r) { const float v = o1[0][dt][r] * f - ex[((qbw * 2 + dt) * 16 + r) * 64 + lane]; o1[0][dt][r] = v; ss += v * v; }
        ss += xor32f(ss, lane);
        const float rstd = rsqrtf(ss * (1.f / 64.f) + kEps) * post;
        const float* sg = p.sub_g + layer * 64;
#pragma unroll
        for (int dt = 0; dt < 2; ++dt)
#pragma unroll
            for (int r = 0; r < 16; ++r) { const int d = dt * 32 + (r & 3) + 8 * (r >> 2) + 4 * hh; o1[0][dt][r] *= rstd * sg[d]; }
        write_o(o1[0], obuf, Tb + tq, 256 + hd * 64, hh);
    }
}

DEV void mla_item(const Params& p, int b, int hd, int qc, char* smem) {
    int tid = threadIdx.x; asm volatile("" : "+v"(tid));
    const int lane = tid & 63, w = tid >> 6, ql = lane & 31, hh = lane >> 5;
    char* ws = p.ws;
    const bf16_t* cols = (const bf16_t*)(ws + OFF_COLS);
    const bf16_t* VT = (const bf16_t*)(ws + OFF_VT);
    const bf16_t* qmla = (const bf16_t*)(ws + OFF_QMLA);
    const bf16_t* kvmla = (const bf16_t*)(ws + OFF_KVMLA);
    bf16_t* obuf = (bf16_t*)(ws + OFF_O);
    const int t0w = qc * 128 + w * 32, tq = t0w + ql;
    const size_t Tb = (size_t)b * kS;
    const bf16_t* qrow = qmla + (Tb + tq) * 384 + hd * 96;
    bf16x8 qf[6];
#pragma unroll
    for (int ks = 0; ks < 6; ++ks) qf[ks] = *(const bf16x8*)(qrow + ks * 16 + hh * 8);
    const float scl = 0.10206207261596575f * kLog2e;
    f32x16 o1[1][2]; o1[0][0] = zero16(); o1[0][1] = zero16();
    float m1[1] = {kNeg}, l1[1] = {0.f};
    auto skipf = [&](int kt) __attribute__((always_inline)) { return kt * 64 > t0w + 31; };
    attn_stream<96, 6, 1>(RangeIter{0, 2 * qc + 2}, LdMlaK{kvmla + Tb * 512 + hd * 128, cols + Tb * LDC + 1856}, LdVT{VT + (size_t)(b * 12 + 8 + hd) * 64 * 2048}, MaskCausal{}, skipf, qf, o1, m1, l1, scl, tq, smem, tid);
    const float inv = 1.f / (l1[0] + xor32f(l1[0], lane));
#pragma unroll
    for (int dt = 0; dt < 2; ++dt)
#pragma unroll
        for (int r = 0; r < 16; ++r) o1[0][dt][r] *= inv;
    write_o(o1[0], obuf, Tb + tq, 512 + hd * 64, hh);
}

DEV void swa_item(const Params& p, int layer, int b, int g, int q64, char* smem) {
    int tid = threadIdx.x; asm volatile("" : "+v"(tid));
    const int lane = tid & 63, w = tid >> 6, ql = lane & 31, hh = lane >> 5;
    char* ws = p.ws;
    const bf16_t* cols = (const bf16_t*)(ws + OFF_COLS);
    const bf16_t* VT = (const bf16_t*)(ws + OFF_VT);
    bf16_t* obuf = (bf16_t*)(ws + OFF_O);
    const int head = g * 2 + (w & 1);
    const int t0w = q64 * 64 + (w >> 1) * 32, tq = t0w + ql;
    const size_t Tb = (size_t)b * kS;
    const bf16_t* qrow = cols + (Tb + tq) * LDC + 1920 + head * 64;
    bf16x8 qf[4];
#pragma unroll
    for (int ks = 0; ks < 4; ++ks) qf[ks] = *(const bf16x8*)(qrow + ks * 16 + hh * 8);
    const float scl = 0.125f * kLog2e;
    f32x16 o1[1][2]; o1[0][0] = zero16(); o1[0][1] = zero16();
    float m1[1] = {p.sinks[layer * 4 + head] * kLog2e}, l1[1] = {hh == 0 ? 1.f : 0.f};
    auto skipf = [&](int kt) __attribute__((always_inline)) { return (kt * 64 > t0w + 31) || (kt * 64 + 63 < t0w - 127); };
    const int lo = q64 >= 2 ? q64 - 2 : 0;
    attn_stream<64, 4, 1>(RangeIter{lo, q64 + 1}, LdRow{cols + Tb * LDC + 2176 + g * 64, LDC}, LdVT{VT + (size_t)(b * 12 + 6 + g) * 64 * 2048}, MaskWin<128>{}, skipf, qf, o1, m1, l1, scl, tq, smem, tid);
    const float inv = 1.f / (l1[0] + xor32f(l1[0], lane));
#pragma unroll
    for (int dt = 0; dt < 2; ++dt)
#pragma unroll
        for (int r = 0; r < 16; ++r) o1[0][dt][r] *= inv;
    write_o(o1[0], obuf, Tb + tq, 768 + head * 64, hh);
}

DEV void phase_attn(const Params& p, int layer, char* smem, int rep = 0) {
    unsigned* ctr = (unsigned*)(p.ws + OFF_CTRL) + 64 + layer * 16 + rep;
    volatile int* slot = (volatile int*)(smem + SM_SEL) + 48;
    for (;;) {
        __syncthreads();
        if (ltid() == 0) *slot = (int)atomicAdd(ctr, 1u);
        __syncthreads();
        const int idx = __builtin_amdgcn_readfirstlane(*slot);
        if (idx >= 2560) break;
        const int level = 15 - idx / 160, r = idx % 160;
        if (r < 64) { const int b = (r & 31) >> 2; diff_item(p, layer, b, r & 3, level * 2 + (1 - (r >> 5)), smem); }
        else if (r < 96) { const int k = r - 64; mla_item(p, k >> 2, k & 3, level, smem); }
        else if (r < 128) { const int k = r - 96; nsa_item(p, k >> 2, level * 4 + (3 - (k & 3)), smem); }
        else { const int k = r - 128; swa_item(p, layer, k >> 2, (k >> 1) & 1, level * 2 + (k & 1), smem); }
    }
}

#define XB_TMO      128
#define XB_XCNT(j)  (256  + 64 * (j))
#define XB_XSUB(j)  (1280 + 64 * (j))
#define XB_XGEN(j)  (2304 + 64 * (j))
#define XB_TOP      3328
#define XB_TOPGEN   3392
#define XB_SPIN_CAP (1u << 22)
DEV unsigned xb_ld(unsigned* p) { return __hip_atomic_load(p, __ATOMIC_RELAXED, __HIP_MEMORY_SCOPE_AGENT); }
DEV unsigned xb_add(unsigned* p, unsigned v) { return __hip_atomic_fetch_add(p, v, __ATOMIC_RELAXED, __HIP_MEMORY_SCOPE_AGENT); }
DEV unsigned xb_xcc_id() { return (unsigned)__builtin_amdgcn_s_getreg((3 << 11) | 20) & 0xFu; }
#define XB_SPIN(cond, bar) do { unsigned _sp = 0; while (cond) { __builtin_amdgcn_s_sleep(1); \
    if ((++_sp & 255u) == 0u) { if (xb_ld(&(bar)[XB_TMO])) break; if (_sp > XB_SPIN_CAP) { atomicAdd(&(bar)[XB_TMO], 1u); break; } } } } while (0)
struct XcdBarrier { unsigned* bar; unsigned x; volatile LAS unsigned* st; };
DEV XcdBarrier xcd_barrier_post(unsigned* bar, volatile LAS unsigned* st) {
    XcdBarrier b; b.bar = bar; b.x = xb_xcc_id(); b.st = st;
    if (threadIdx.x == 0) st[2] = xb_add(&bar[XB_XCNT(b.x)], 1u);
    return b;
}
DEV void xcd_barrier_complete(unsigned* bar, unsigned x, unsigned& nloc, unsigned& nx) {
    const unsigned G = gridDim.x * gridDim.y * gridDim.z;
    unsigned sum, cnt, mine, sp = 0u;
    for (;;) {
        sum = 0u; cnt = 0u; mine = 0u;
#pragma unroll
        for (unsigned j = 0; j < 16; ++j) { const unsigned c = xb_ld(&bar[XB_XCNT(j)]); sum += c; cnt += (c > 0u) ? 1u : 0u; mine = (j == x) ? c : mine; }
        if (sum == G) break;
        __builtin_amdgcn_s_sleep(1);
        if ((++sp & 255u) == 0u) { if (xb_ld(&bar[XB_TMO])) break; if (sp > XB_SPIN_CAP) { atomicAdd(&bar[XB_TMO], 1u); break; } }
    }
    nloc = mine > 0u ? mine : 1u; nx = cnt > 0u ? cnt : 1u;
}
DEV void xcd_barrier(const XcdBarrier& b) {
    asm volatile("s_waitcnt vmcnt(0)" ::: "memory");
    __syncthreads();
    if (threadIdx.x == 0) {
        unsigned* bar = b.bar;
        asm volatile("" : "+v"(bar));
        __builtin_amdgcn_s_waitcnt(0);
        unsigned nloc = b.st[0], nx = b.st[1];
        if (nloc == 0u) { xcd_barrier_complete(bar, b.x, nloc, nx); b.st[0] = nloc; b.st[1] = nx; }
        const unsigned old = xb_add(&bar[XB_XSUB(b.x)], 1u);
        const unsigned gen = old / nloc;
        if (old + 1u == (gen + 1u) * nloc) {
            __builtin_amdgcn_fence(__ATOMIC_RELEASE, "agent");
            asm volatile("s_waitcnt vmcnt(0)" ::: "memory");
            const unsigned og = xb_add(&bar[XB_TOP], 1u);
            const unsigned tg = og / nx;
            if (og + 1u == (tg + 1u) * nx) xb_add(&bar[XB_TOPGEN], 1u);
            else XB_SPIN(xb_ld(&bar[XB_TOPGEN]) == tg, bar);
            __builtin_amdgcn_fence(__ATOMIC_ACQUIRE, "agent");
            xb_add(&bar[XB_XGEN(b.x)], 1u);
            asm volatile("s_waitcnt vmcnt(0)" ::: "memory");
        } else {
            XB_SPIN(xb_ld(&bar[XB_XGEN(b.x)]) == gen, bar);
            __builtin_amdgcn_fence(__ATOMIC_ACQUIRE, "agent");
            asm volatile("s_waitcnt vmcnt(0)" ::: "memory");
        }
    }
    __syncthreads();
}

DEV unsigned fkey(float f) { const unsigned u = __float_as_uint(f); return (u & 0x80000000u) ? ~u : (u | 0x80000000u); }
DEV float funkey(unsigned k) { return __uint_as_float((k & 0x80000000u) ? (k & 0x7fffffffu) : ~k); }
DEV void ins16(unsigned (&L)[16], unsigned x) {
#pragma unroll
    for (int i = 0; i < 16; ++i) { const unsigned hi = L[i] > x ? L[i] : x; x = L[i] > x ? x : L[i]; L[i] = hi; }
}
DEV void phase_topk(const Params& p, char* smem) {
    const int tid = ltid();
    const float* S1 = (const float*)(p.ws + OFF_S1);
    const float* S2 = (const float*)(p.ws + OFF_S2);
    int* eid = (int*)(p.ws + OFF_EID);
    float* gate = (float*)(p.ws + OFF_GATE);
    unsigned char* ib = (unsigned char*)smem + tid * 32;
    for (int blk = blockIdx.x; blk < kT * 8 / 256; blk += gridDim.x) {
        const size_t row = (size_t)blk * 256 + tid;
        unsigned L1[16], L2[16];
#pragma unroll
        for (int i = 0; i < 16; ++i) { L1[i] = 0u; L2[i] = 0u; }
#pragma unroll 4
        for (int k = 0; k < 128; ++k) {
            const float a = S1[(size_t)k * (kT * 8) + row], b = S2[(size_t)k * (kT * 8) + row];
            ins16(L1, (fkey(a) & ~127u) | (unsigned)(127 - k));
            ins16(L2, (fkey(b) & ~127u) | (unsigned)(127 - k));
        }
        float v1[16], v2[16];
        __syncthreads();
#pragma unroll
        for (int i = 0; i < 16; ++i) {
            v1[i] = funkey(L1[i] & ~127u); v2[i] = funkey(L2[i] & ~127u);
            ib[i] = (unsigned char)(127u - (L1[i] & 127u)); ib[16 + i] = (unsigned char)(127u - (L2[i] & 127u));
        }
        unsigned C[16];
#pragma unroll
        for (int i = 0; i < 16; ++i) C[i] = 0u;
#pragma unroll
        for (int a = 0; a < 16; ++a)
#pragma unroll
            for (int b = 0; b < 16; ++b)
                if ((a + 1) * (b + 1) <= 16) ins16(C, (fkey(v1[a] + v2[b]) & ~255u) | (unsigned)(255 - (a * 16 + b)));
        float ts[16]; float sum = 0.f;
        const float tmax = funkey(C[0] & ~255u);
#pragma unroll
        for (int i = 0; i < 16; ++i) { ts[i] = __expf(funkey(C[i] & ~255u) - tmax); sum += ts[i]; }
        const float inv = 1.f / sum;
        int ev[16];
#pragma unroll
        for (int i = 0; i < 16; ++i) { const unsigned ci = 255u - (C[i] & 255u); ev[i] = (int)ib[ci >> 4] * 128 + (int)ib[16 + (ci & 15u)]; }
#pragma unroll
        for (int i = 0; i < 4; ++i) {
            *(int4*)(eid + row * 16 + 4 * i) = make_int4(ev[4 * i], ev[4 * i + 1], ev[4 * i + 2], ev[4 * i + 3]);
            *(float4*)(gate + row * 16 + 4 * i) = make_float4(ts[4 * i] * inv, ts[4 * i + 1] * inv, ts[4 * i + 2] * inv, ts[4 * i + 3] * inv);
        }
    }
}

DEV float row_sum_dpp(float v) {
    v += __int_as_float(__builtin_amdgcn_update_dpp(0, __float_as_int(v), 0xB1, 0xF, 0xF, true));
    v += __int_as_float(__builtin_amdgcn_update_dpp(0, __float_as_int(v), 0x4E, 0xF, 0xF, true));
    v += __int_as_float(__builtin_amdgcn_update_dpp(0, __float_as_int(v), 0x141, 0xF, 0xF, true));
    v += __int_as_float(__builtin_amdgcn_update_dpp(0, __float_as_int(v), 0x140, 0xF, 0xF, true));
    return v;
}
DEV float wave_sum_dpp(float v) {
    v = row_sum_dpp(v);
    const float r0 = __int_as_float(__builtin_amdgcn_readlane(__float_as_int(v), 0)), r1 = __int_as_float(__builtin_amdgcn_readlane(__float_as_int(v), 16));
    const float r2 = __int_as_float(__builtin_amdgcn_readlane(__float_as_int(v), 32)), r3 = __int_as_float(__builtin_amdgcn_readlane(__float_as_int(v), 48));
    return (r0 + r1) + (r2 + r3);
}
typedef float f32x2 __attribute__((ext_vector_type(2)));
typedef float f32x4 __attribute__((ext_vector_type(4)));

struct SliceMap { int virt, nx, nloc, rank; };
DEV SliceMap slice_map(const Params& p, char* smem) {
    unsigned* bar = (unsigned*)p.ws;
    const unsigned x = xb_xcc_id();
    int virt = 0, nx = 0, nloc = 1;
#pragma unroll
    for (unsigned j = 0; j < 16; ++j) {
        const unsigned c = xb_ld(&bar[XB_XCNT(j)]);
        if (c > 0u) { if (j < x) ++virt; ++nx; }
        if (j == x) nloc = (int)c;
    }
    SliceMap m;
    m.virt = __builtin_amdgcn_readfirstlane(virt); m.nx = __builtin_amdgcn_readfirstlane(nx > 0 ? nx : 1); m.nloc = __builtin_amdgcn_readfirstlane(nloc > 0 ? nloc : 1);
    m.rank = __builtin_amdgcn_readfirstlane((int)((volatile LAS unsigned*)(smem + SM_CTRL))[2]);
    return m;
}

typedef _Float16 half2_t __attribute__((ext_vector_type(2)));
DEV void phase_peer_u(const Params& p, int layer, char* smem, int rep = 0) {
    const int tid = ltid(), lane = tid & 63, w = tid >> 6, l8 = lane & 7, grp = lane >> 3;
    char* ws = p.ws;
    const SliceMap sm = slice_map(p, smem);
    const bf16_t* h = (const bf16_t*)(ws + OFF_H);
    const int* eid = (const int*)(ws + OFF_EID);
    float* part = (float*)(ws + OFF_S1) + (rep ? (size_t)8 * kT * 128 : 0);
    int* ids_l = (int*)(smem + w * 9216);
    const int nk = sm.rank < 512 ? (512 - sm.rank + sm.nloc - 1) / sm.nloc : 0;
    for (int s = sm.virt; s < 8; s += sm.nx) {
        if (nk == 0) break;
        const unsigned char* U = (const unsigned char*)(ws + OFF_PU) + (((size_t)layer * 8 + s) * 16384 << 7) + l8 * 16;
        uint4 ri0, ri1, ri2, ri3, rh0, rh1;
        auto load_oct = [&](int k) __attribute__((always_inline)) {
            const size_t o = (size_t)(sm.rank + k * sm.nloc) * 4 + w;
            const uint4* ip = (const uint4*)(eid + o * 1024) + lane;
            ri0 = ip[0]; ri1 = ip[64]; ri2 = ip[128]; ri3 = ip[192];
            const bf16_t* hp = h + (o * 8 + grp) * 1024 + s * 128 + l8 * 16;
            rh0 = *(const uint4*)hp; rh1 = *(const uint4*)(hp + 8);
        };
        half2_t hh[8];
        auto store_oct = [&]() __attribute__((always_inline)) {
            uint4* il = (uint4*)ids_l + lane;
            il[0] = ri0; il[64] = ri1; il[128] = ri2; il[192] = ri3;
            const unsigned hu[8] = {rh0.x, rh0.y, rh0.z, rh0.w, rh1.x, rh1.y, rh1.z, rh1.w};
#pragma unroll
            for (int i = 0; i < 8; ++i) hh[i] = (half2_t){(_Float16)lo16(hu[i]), (_Float16)hi16(hu[i])};
        };
        load_oct(0); store_oct();
#pragma unroll 1
        for (int k = 0; k < nk; ++k) {
            if (k + 1 < nk) load_oct(k + 1);
            const size_t o = (size_t)(sm.rank + k * sm.nloc) * 4 + w;
            float* pp = part + ((size_t)s * kT + o * 8 + grp) * 128 + l8;
            uint4 va[8], vb[8];
            auto issue = [&](uint4 (&v)[8], int c) __attribute__((always_inline)) {
                const int4 i0 = *(const int4*)(ids_l + grp * 128 + c * 8), i1 = *(const int4*)(ids_l + grp * 128 + c * 8 + 4);
                const int e[8] = {i0.x, i0.y, i0.z, i0.w, i1.x, i1.y, i1.z, i1.w};
#pragma unroll
                for (int j = 0; j < 8; ++j) v[j] = *(const uint4*)(U + ((size_t)e[j] << 7));
            };
            auto compute = [&](const uint4 (&v)[8], int c) __attribute__((always_inline)) {
                float res = 0.f;
#pragma unroll
                for (int j = 0; j < 8; ++j) {
                    const unsigned d[4] = {v[j].x, v[j].y, v[j].z, v[j].w};
                    float acc = 0.f;
#pragma unroll
                    for (int q = 0; q < 4; ++q) {
                        const half2_t lo = __builtin_amdgcn_cvt_scalef32_pk_f16_fp8(d[q], 1.0f, false);
                        const half2_t hi = __builtin_amdgcn_cvt_scalef32_pk_f16_fp8(d[q], 1.0f, true);
                        acc = __builtin_amdgcn_fdot2(lo, hh[2 * q], acc, false);
                        acc = __builtin_amdgcn_fdot2(hi, hh[2 * q + 1], acc, false);
                    }
                    acc += __int_as_float(__builtin_amdgcn_update_dpp(0, __float_as_int(acc), 0xB1, 0xF, 0xF, true));
                    acc += __int_as_float(__builtin_amdgcn_update_dpp(0, __float_as_int(acc), 0x4E, 0xF, 0xF, true));
                    acc += __int_as_float(__builtin_amdgcn_update_dpp(0, __float_as_int(acc), 0x141, 0xF, 0xF, true));
                    res = (l8 == j) ? acc : res;
                    __builtin_amdgcn_sched_barrier(0);
                }
                pp[c * 8] = res;
            };
            issue(va, 0);
#pragma unroll
            for (int c = 0; c < 16; c += 2) {
                issue(vb, c + 1);
                __builtin_amdgcn_sched_barrier(0);
                compute(va, c);
                __builtin_amdgcn_sched_barrier(0);
                if (c + 2 < 16) issue(va, c + 2);
                __builtin_amdgcn_sched_barrier(0);
                compute(vb, c + 1);
                __builtin_amdgcn_sched_barrier(0);
            }
            if (k + 1 < nk) store_oct();
        }
    }
}

DEV void phase_peer_comb(const Params& p, int rep = 0) {
    const int tid = ltid();
    const float* part = (const float*)(p.ws + OFF_S1);
    float* gate = (float*)(p.ws + OFF_GATE);
    for (size_t i = (size_t)blockIdx.x * 256 + tid; i < (size_t)kT * 128 / 4; i += (size_t)gridDim.x * 256) {
        float4 a = *(const float4*)(part + i * 4);
#pragma unroll
        for (int x = 1; x < 8; ++x) { const float4 b = *(const float4*)(part + (size_t)x * kT * 128 + i * 4); a.x += b.x; a.y += b.y; a.z += b.z; a.w += b.w; }
        const float4 g = *(const float4*)(gate + i * 4);
        float4 o;
        o.x = g.x * gelu_tanh(a.x * (1.f / kScaleU)); o.y = g.y * gelu_tanh(a.y * (1.f / kScaleU));
        o.z = g.z * gelu_tanh(a.z * (1.f / kScaleU)); o.w = g.w * gelu_tanh(a.w * (1.f / kScaleU));
        if (rep == 0) *(float4*)(gate + i * 4) = o;
    }
}

DEV void phase_peer_v(const Params& p, int layer, char* smem, int rep = 0) {
    const int tid = ltid(), lane = tid & 63, w = tid >> 6, l8 = lane & 7, grp = lane >> 3;
    char* ws = p.ws;
    const SliceMap sm = slice_map(p, smem);
    float* xres = (float*)(ws + OFF_XRES);
    const int* eid = (const int*)(ws + OFF_EID);
    const float* wbuf = (const float*)(ws + OFF_GATE);
    const float* mod = (const float*)(ws + OFF_MOD);
    int* ids_l = (int*)(smem + w * 9216);
    float* w_l = (float*)(smem + w * 9216 + 4096);
    const int nk = sm.rank < 512 ? (512 - sm.rank + sm.nloc - 1) / sm.nloc : 0;
    for (int s = sm.virt; s < 8; s += sm.nx) {
        if (nk == 0) break;
        const unsigned char* V = (const unsigned char*)(ws + OFF_PV) + (((size_t)layer * 8 + s) * 16384 << 7) + l8 * 16;
        uint4 ri0, ri1, ri2, ri3, rw0, rw1, rw2, rw3;
        auto load_oct = [&](int k) __attribute__((always_inline)) {
            const size_t o = (size_t)(sm.rank + k * sm.nloc) * 4 + w;
            const uint4* ip = (const uint4*)(eid + o * 1024) + lane;
            const uint4* wp = (const uint4*)(wbuf + o * 1024) + lane;
            ri0 = ip[0]; ri1 = ip[64]; ri2 = ip[128]; ri3 = ip[192];
            rw0 = wp[0]; rw1 = wp[64]; rw2 = wp[128]; rw3 = wp[192];
        };
        auto store_oct = [&]() __attribute__((always_inline)) {
            uint4* il = (uint4*)ids_l + lane; uint4* wl = (uint4*)w_l + lane;
            il[0] = ri0; il[64] = ri1; il[128] = ri2; il[192] = ri3;
            wl[0] = rw0; wl[64] = rw1; wl[128] = rw2; wl[192] = rw3;
        };
        load_oct(0); store_oct();
#pragma unroll 1
        for (int k = 0; k < nk; ++k) {
            if (k + 1 < nk) load_oct(k + 1);
            const size_t o = (size_t)(sm.rank + k * sm.nloc) * 4 + w;
            const size_t t = o * 8 + grp;
            const int b = (int)(t >> 11);
            float* xp = xres + t * 1024 + s * 128 + l8 * 16;
            const float* g2 = mod + (size_t)(layer * 8 + b) * 6144 + 5120 + s * 128 + l8 * 16;
            float4 xa[4];
#pragma unroll
            for (int c = 0; c < 4; ++c) xa[c] = *(const float4*)(xp + c * 4);
            half2_t out[8];
#pragma unroll
            for (int j = 0; j < 8; ++j) out[j] = (half2_t){(_Float16)0.f, (_Float16)0.f};
            uint4 va[8], vb[8];
            auto issue = [&](uint4 (&v)[8], int c) __attribute__((always_inline)) {
                const int4 i0 = *(const int4*)(ids_l + grp * 128 + c * 8), i1 = *(const int4*)(ids_l + grp * 128 + c * 8 + 4);
                const int e[8] = {i0.x, i0.y, i0.z, i0.w, i1.x, i1.y, i1.z, i1.w};
#pragma unroll
                for (int j = 0; j < 8; ++j) v[j] = *(const uint4*)(V + ((size_t)e[j] << 7));
            };
            auto compute = [&](const uint4 (&v)[8], int c) __attribute__((always_inline)) {
                const float4 w0 = *(const float4*)(w_l + grp * 128 + c * 8), w1 = *(const float4*)(w_l + grp * 128 + c * 8 + 4);
                const float wf[8] = {w0.x, w0.y, w0.z, w0.w, w1.x, w1.y, w1.z, w1.w};
#pragma unroll
                for (int j = 0; j < 8; ++j) {
                    const _Float16 wh = (_Float16)wf[j];
                    const half2_t ww = {wh, wh};
                    const unsigned d[4] = {v[j].x, v[j].y, v[j].z, v[j].w};
#pragma unroll
                    for (int q = 0; q < 4; ++q) {
                        const half2_t lo = __builtin_amdgcn_cvt_scalef32_pk_f16_fp8(d[q], 1.0f, false);
                        const half2_t hi = __builtin_amdgcn_cvt_scalef32_pk_f16_fp8(d[q], 1.0f, true);
                        out[2 * q] = __builtin_elementwise_fma(ww, lo, out[2 * q]);
                        out[2 * q + 1] = __builtin_elementwise_fma(ww, hi, out[2 * q + 1]);
                    }
                    __builtin_amdgcn_sched_barrier(0);
                }
            };
            issue(va, 0);
#pragma unroll
            for (int c = 0; c < 16; c += 2) {
                issue(vb, c + 1);
                __builtin_amdgcn_sched_barrier(0);
                compute(va, c);
                __builtin_amdgcn_sched_barrier(0);
                if (c + 2 < 16) issue(va, c + 2);
                __builtin_amdgcn_sched_barrier(0);
                compute(vb, c + 1);
                __builtin_amdgcn_sched_barrier(0);
            }
            if (rep == 0 || (float)out[0].x == 12345.678f) {
#pragma unroll
                for (int c = 0; c < 4; ++c) {
                    const float4 g4 = *(const float4*)(g2 + c * 4);
                    xa[c].x += g4.x * (float)out[2 * c].x * (1.f / kScaleV); xa[c].y += g4.y * (float)out[2 * c].y * (1.f / kScaleV);
                    xa[c].z += g4.z * (float)out[2 * c + 1].x * (1.f / kScaleV); xa[c].w += g4.w * (float)out[2 * c + 1].y * (1.f / kScaleV);
                    *(float4*)(xp + c * 4) = xa[c];
                }
            }
            if (k + 1 < nk) store_oct();
        }
    }
}

DEV void phase_final(const Params& p) {
    const int tid = ltid(), lane = tid & 63, w = tid >> 6;
    const float* xs = (const float*)(p.ws + OFF_XRES);
    for (int q = blockIdx.x; q < kT / 4; q += gridDim.x) {
        const int t = q * 4 + w;
        const float* xr = xs + (size_t)t * 1024;
        float4 v[4]; float ss = 0.f;
#pragma unroll
        for (int i = 0; i < 4; ++i) { v[i] = *(const float4*)(xr + i * 256 + lane * 4); ss += v[i].x * v[i].x + v[i].y * v[i].y + v[i].z * v[i].z + v[i].w * v[i].w; }
        ss = wave_sum(ss);
        const float rstd = rsqrtf(ss * (1.f / 1024.f) + kEps);
#pragma unroll
        for (int i = 0; i < 4; ++i) {
            const int col = i * 256 + lane * 4;
            const float4 g4 = *(const float4*)(p.final_g + col);
            *(float4*)(p.out + (size_t)t * 1024 + col) = make_float4(v[i].x * rstd * g4.x, v[i].y * rstd * g4.y, v[i].z * rstd * g4.z, v[i].w * rstd * g4.w);
        }
    }
}

DEV void phase_gemm_in(const Params& p, int layer, char* smem) {
    char* ws = p.ws;
    EpiBf16 epi{(bf16_t*)(ws + OFF_COLS), LDC, nullptr, nullptr, LDC};
    gemm_phase((const bf16_t*)(ws + OFF_H), 1024, (const bf16_t*)(ws + OFF_WIN) + (size_t)layer * 2432 * 1024, 1024, 1024, kT / 128, LDC / 128, smem, epi);
}
DEV void phase_gemm_mid(const Params& p, int layer, char* smem) {
    char* ws = p.ws;
    const float* misc = (const float*)(ws + OFF_MISC);
    const float* rstd = (const float*)(ws + OFF_RSTD);
    const bf16_t* cols = (const bf16_t*)(ws + OFF_COLS);
    for (int tile = blockIdx.x; tile < 16 + 384 + 512; tile += gridDim.x) {
        if (tile < 8) {
            EpiBf16 epi{(bf16_t*)(ws + OFF_KCMP), 64, nullptr, misc + (layer * 2 + 0) * 64, 64};
            gemm_tile((const bf16_t*)(ws + OFF_KC), 1024, (const bf16_t*)(ws + OFF_WCK) + (size_t)layer * 128 * 2048, 2048, 2048, tile * 128, 0, smem, epi);
        } else if (tile < 16) {
            EpiBf16 epi{(bf16_t*)(ws + OFF_KCMP) + 1024 * 64, 64, nullptr, misc + (layer * 2 + 1) * 64, 64};
            gemm_tile((const bf16_t*)(ws + OFF_VC), 1024, (const bf16_t*)(ws + OFF_WCV) + (size_t)layer * 128 * 2048, 2048, 2048, (tile - 8) * 128, 0, smem, epi);
        } else if (tile < 16 + 384) {
            const int tt = tile - 16;
            EpiBf16 epi{(bf16_t*)(ws + OFF_QMLA), 384, rstd, nullptr, 384};
            gemm_tile(cols + 1472, LDC, (const bf16_t*)(ws + OFF_WUQ) + (size_t)layer * 384 * 256, 256, 256, (tt / 3) * 128, (tt % 3) * 128, smem, epi);
        } else {
            const int tt = tile - 16 - 384;
            EpiBf16 epi{(bf16_t*)(ws + OFF_KVMLA), 512, rstd + kT, nullptr, 512};
            gemm_tile(cols + 1728, LDC, (const bf16_t*)(ws + OFF_WUKV) + (size_t)layer * 512 * 128, 128, 128, (tt / 4) * 128, (tt % 4) * 128, smem, epi);
        }
    }
}
DEV void phase_gemm_out(const Params& p, int layer, char* smem) {
    char* ws = p.ws;
    EpiRes epi{layer == 0 ? p.x : (const float*)(ws + OFF_XRES), (float*)(ws + OFF_XRES), (const float*)(ws + OFF_MOD) + (size_t)layer * 8 * 6144 + 2048};
    gemm_phase((const bf16_t*)(ws + OFF_O), 1024, (const bf16_t*)(ws + OFF_WOUT) + (size_t)layer * 1024 * 1024, 1024, 1024, kT / 128, 8, smem, epi);
}
DEV void phase_gemm_wq(const Params& p, int layer, char* smem) {
    char* ws = p.ws;
    EpiBf16 epi{(bf16_t*)(ws + OFF_QP), 2048, nullptr, nullptr, 2048};
    gemm_phase((const bf16_t*)(ws + OFF_H), 1024, (const bf16_t*)(ws + OFF_WQ) + (size_t)layer * 2048 * 1024, 1024, 1024, kT / 128, 16, smem, epi);
}
DEV void phase_scores(const Params& p, int layer, char* smem) {
    char* ws = p.ws;
    for (int tile = blockIdx.x; tile < 2048; tile += gridDim.x) {
        const int c = tile >> 10, nt = tile & 1023;
        EpiF32 epi{(float*)(ws + (c ? OFF_S2 : OFF_S1)), kT * 8};
        gemm_tile((const bf16_t*)(ws + OFF_SUBK) + (size_t)(layer * 2 + c) * 16384, 128, (const bf16_t*)(ws + OFF_QP) + c * 128, 256, 128, 0, nt * 128, smem, epi);
    }
}

constexpr int NPHASE = 16;
DEV void run_phase(const Params& p, int ph, int layer, char* smem, int rep = 0) {
    switch (ph) {
        case 0: phase_prologue(p, smem); break;
        case 1: phase_norm(p, layer, 0); break;
        case 2: phase_gemm_in(p, layer, smem); break;
        case 3: phase_layout1(p, smem); break;
        case 4: phase_gemm_mid(p, layer, smem); break;
        case 5: phase_layout2(p, smem); break;
        case 6: phase_attn(p, layer, smem, rep); break;
        case 7: phase_gemm_out(p, layer, smem); break;
        case 8: phase_norm(p, layer, 1); break;
        case 9: phase_gemm_wq(p, layer, smem); break;
        case 10: phase_scores(p, layer, smem); break;
        case 11: phase_topk(p, smem); break;
        case 12: phase_peer_u(p, layer, smem, rep); break;
        case 13: phase_peer_comb(p, rep); break;
        case 14: phase_peer_v(p, layer, smem, rep); break;
        case 15: if (layer == 0) phase_norm(p, 1, 0); else phase_final(p); break;
        default: break;
    }
}

#if !FUSED
template <int PH>
__global__ void __launch_bounds__(256, 2) k_phase(Params p, int layer) {
    __shared__ __attribute__((aligned(16))) char smem[SM_TOTAL];
    run_phase(p, PH, layer, smem);
}
template <int PH> static void launch_phase(const Params& p, int layer, hipStream_t stream) { k_phase<PH><<<512, 256, 0, stream>>>(p, layer); }
static void launch_ph(int ph, const Params& p, int layer, hipStream_t stream) {
    switch (ph) {
        case 0: launch_phase<0>(p, layer, stream); break;
        case 1: launch_phase<1>(p, layer, stream); break;
        case 2: launch_phase<2>(p, layer, stream); break;
        case 3: launch_phase<3>(p, layer, stream); break;
        case 4: launch_phase<4>(p, layer, stream); break;
        case 5: launch_phase<5>(p, layer, stream); break;
        case 6: launch_phase<6>(p, layer, stream); break;
        case 7: launch_phase<7>(p, layer, stream); break;
        case 8: launch_phase<8>(p, layer, stream); break;
        case 9: launch_phase<9>(p, layer, stream); break;
        case 10: launch_phase<10>(p, layer, stream); break;
        case 11: launch_phase<11>(p, layer, stream); break;
        case 12: launch_phase<12>(p, layer, stream); break;
    }
}
#else
#if TS_A >= 0
#define TSTAMP(I) if (blockIdx.x == 0 && threadIdx.x == 0) ((unsigned long long*)(p.ws + 32768))[I] = __builtin_amdgcn_s_memrealtime();
#else
#define TSTAMP(I)
#endif
__global__ void __launch_bounds__(256, 2) k_mega(Params p) {
    extern __shared__ __attribute__((aligned(1024))) char smem[];
    cg::grid_group grid = cg::this_grid();
    volatile LAS unsigned* st = (volatile LAS unsigned*)(smem + SM_CTRL);
    if (threadIdx.x == 0) { st[0] = 0u; st[1] = 0u; st[2] = 0u; }
    __syncthreads();
    const XcdBarrier xb = xcd_barrier_post((unsigned*)p.ws, st);
    TSTAMP(0)
    run_phase(p, 0, 0, smem);
    if (p.out == nullptr) grid.sync();
    xcd_barrier(xb);
    TSTAMP(1)
    run_phase(p, 1, 0, smem);
    xcd_barrier(xb);
    TSTAMP(2)
#define STEP(PH, L) { run_phase(p, PH, L, smem, 0); xcd_barrier(xb); TSTAMP(2 + (L) * 16 + (PH)) }
#define LAYER(L) STEP(2, L) STEP(3, L) STEP(4, L) STEP(5, L) STEP(6, L) STEP(7, L) STEP(8, L) STEP(9, L) STEP(10, L) STEP(11, L) STEP(12, L) STEP(13, L) STEP(14, L)
    LAYER(0)
    STEP(15, 0)
    LAYER(1)
    run_phase(p, 15, 1, smem);
#if TS_A >= 0
    TSTAMP(2 + 16 + 15)
    __syncthreads();
    if (blockIdx.x == 0 && threadIdx.x == 0) {
        const unsigned long long* ts = (const unsigned long long*)(p.ws + 32768);
        p.out[0] += (float)(ts[TS_B] - ts[TS_A]) * 0.001f;
    }
#endif
}
#endif

extern "C" void kernel_launch(void* const* d_in, const int* in_sizes, int n_in, void* d_out, int out_size, void* d_ws, size_t ws_size, hipStream_t stream) {
    Params p{};
    const float** pp = (const float**)&p;
    for (int i = 0; i < 28; ++i) pp[i] = (const float*)d_in[i];
    p.out = (float*)d_out;
    p.ws = (char*)d_ws;
    if (ws_size < OFF_END) fprintf(stderr, "workspace too small: %zu < %zu\n", ws_size, (size_t)OFF_END);
    (void)hipMemsetAsync(d_ws, 0, 65536, stream);
#if !FUSED
    launch_ph(0, p, 0, stream);
    launch_ph(1, p, 0, stream);
    for (int l = 0; l < 2; ++l)
        for (int ph = 2; ph < NPHASE; ++ph) launch_ph(ph, p, l, stream);
#else
    static int grid_blocks = 0;
    if (!grid_blocks) {
        int dev = 0, cus = 0, per_cu = 0;
        (void)hipGetDevice(&dev);
        (void)hipDeviceGetAttribute(&cus, hipDeviceAttributeMultiprocessorCount, dev);
        (void)hipFuncSetAttribute((const void*)k_mega, hipFuncAttributeMaxDynamicSharedMemorySize, SM_TOTAL);
        (void)hipOccupancyMaxActiveBlocksPerMultiprocessor(&per_cu, (const void*)k_mega, 256, SM_TOTAL);
        if (per_cu > 2) per_cu = 2;
        if (per_cu < 1) per_cu = 1;
        grid_blocks = cus * per_cu;
    }
    void* args[] = {&p};
    hipError_t e = hipLaunchCooperativeKernel((const void*)k_mega, dim3(grid_blocks), dim3(256), args, SM_TOTAL, stream);
    if (e != hipSuccess) fprintf(stderr, "cooperative launch failed: %s (grid %d)\n", hipGetErrorString(e), grid_blocks);
#endif
}
```

```cpp
#include <hip/hip_runtime.h>
#include <hip/hip_cooperative_groups.h>
#include <stdint.h>
#include <stdio.h>
namespace cg = cooperative_groups;

#ifndef FUSED
#define FUSED 1
#endif
#ifndef TS_A
#define TS_A -1
#define TS_B -1
#endif
#ifndef PROBE_PH
#define PROBE_PH -1
#define PROBE_L 1
#define PROBE_REP 0
#endif

#define DEV __device__ __forceinline__
#define LAS __attribute__((address_space(3)))
typedef unsigned short bf16_t;
typedef short bf16x8 __attribute__((ext_vector_type(8)));
typedef float f32x16 __attribute__((ext_vector_type(16)));

constexpr int kB = 8, kS = 2048, kT = kB * kS, kD = 1024, LDC = 2432;
constexpr float kEps = 1e-6f;
constexpr float kNeg = -1e30f;
constexpr float kLog2e = 1.4426950408889634f;
constexpr float kScaleU = 256.f, kScaleV = 32.f;

constexpr size_t OFF_CTRL = 0;
constexpr size_t OFF_MOD  = 65536;
constexpr size_t OFF_ROPE = OFF_MOD + 2ull * 8 * 6144 * 4;
constexpr size_t OFF_MISC = OFF_ROPE + 2048ull * 96 * 4;
constexpr size_t OFF_WIN  = OFF_MISC + 4096;
constexpr size_t OFF_WOUT = OFF_WIN + 2ull * 2432 * 1024 * 2;
constexpr size_t OFF_WQ   = OFF_WOUT + 2ull * 1024 * 1024 * 2;
constexpr size_t OFF_WUQ  = OFF_WQ + 2ull * 2048 * 1024 * 2;
constexpr size_t OFF_WUKV = OFF_WUQ + 2ull * 384 * 256 * 2;
constexpr size_t OFF_WCK  = OFF_WUKV + 2ull * 512 * 128 * 2;
constexpr size_t OFF_WCV  = OFF_WCK + 2ull * 128 * 2048 * 2;
constexpr size_t OFF_SUBK = OFF_WCV + 2ull * 128 * 2048 * 2;
constexpr size_t OFF_PU   = OFF_SUBK + 2ull * 2 * 128 * 128 * 2;
constexpr size_t OFF_PV   = OFF_PU + 2ull * 16384 * 1024;
constexpr size_t OFF_XRES = OFF_PV + 2ull * 16384 * 1024;
constexpr size_t OFF_H    = OFF_XRES + (size_t)kT * 1024 * 4;
constexpr size_t OFF_H8   = OFF_H + (size_t)kT * 1024 * 2;
constexpr size_t OFF_RSTD = OFF_H8 + (size_t)kT * 1024;
constexpr size_t OFF_KCMP = OFF_RSTD + 2ull * kT * 4;
constexpr size_t OFF_EID  = OFF_KCMP + 2ull * 1024 * 64 * 2;
constexpr size_t OFF_GATE = OFF_EID + (size_t)kT * 128 * 4;
constexpr size_t OFF_QP   = OFF_GATE + (size_t)kT * 128 * 4;
constexpr size_t OFF_COLS = OFF_QP + (size_t)kT * 2048 * 2;
constexpr size_t OFF_KC   = OFF_COLS + (size_t)kT * LDC * 2;
constexpr size_t OFF_VC   = OFF_KC + (size_t)(kT + 64) * 64 * 2;
constexpr size_t OFF_VT   = OFF_VC + (size_t)(kT + 64) * 64 * 2;
constexpr size_t OFF_QMLA = OFF_VT + 8ull * 12 * 64 * 2048 * 2;
constexpr size_t OFF_KVMLA = OFF_QMLA + (size_t)kT * 384 * 2;
constexpr size_t OFF_O    = OFF_KVMLA + (size_t)kT * 512 * 2;
constexpr size_t OFF_END  = OFF_O + (size_t)kT * 1024 * 2;
constexpr size_t OFF_S1 = OFF_COLS, OFF_S2 = OFF_COLS + (size_t)kT * 8 * 128 * 4;
static_assert(OFF_S2 + (size_t)kT * 8 * 128 * 4 <= OFF_O, "alias region too small");
static_assert(OFF_END <= (512ull << 20), "workspace too large");

struct Params {
    const float *x, *c, *ada_w, *ada_b, *norm_mix_g, *norm_ffn_g, *w_in, *pos_k, *pos_v, *cmp_wk, *cmp_wv;
    const float *lq1, *lk1, *lq2, *lk2, *sub_g, *mla_qg, *mla_wuq, *mla_kvg, *mla_wukv, *sinks, *w_out;
    const float *w_q, *subk1, *subk2, *pu, *pv, *final_g;
    float* out;
    char* ws;
};

DEV int ltid() { int t = threadIdx.x; asm volatile("" : "+v"(t)); return t; }
DEV float bf2f(bf16_t v) { return __uint_as_float(((unsigned)v) << 16); }
DEV bf16_t f2bf(float f) { unsigned u = __float_as_uint(f); u += 0x7fffu + ((u >> 16) & 1u); return (bf16_t)(u >> 16); }
DEV unsigned pack2(float lo, float hi) { unsigned r; asm("v_cvt_pk_bf16_f32 %0, %1, %2" : "=v"(r) : "v"(lo), "v"(hi)); return r; }
DEV float lo16(unsigned u) { return __uint_as_float(u << 16); }
DEV float hi16(unsigned u) { return __uint_as_float(u & 0xffff0000u); }
DEV float wave_sum(float v) {
#pragma unroll
    for (int o = 32; o > 0; o >>= 1) v += __shfl_xor(v, o, 64);
    return v;
}
DEV float xor32f(float v, int lane) { return __int_as_float(__builtin_amdgcn_ds_bpermute((lane ^ 32) << 2, __float_as_int(v))); }
DEV float lanef(float v, int src) { return __int_as_float(__builtin_amdgcn_ds_bpermute(src << 2, __float_as_int(v))); }
DEV f32x16 mfma32(bf16x8 a, bf16x8 b, f32x16 c) { return __builtin_amdgcn_mfma_f32_32x32x16_bf16(a, b, c, 0, 0, 0); }
DEV f32x16 zero16() { f32x16 z;
#pragma unroll
    for (int i = 0; i < 16; ++i) z[i] = 0.f;
    return z; }
DEV float gelu_tanh(float x) {
    const float u = 0.7978845608028654f * (x + 0.044715f * x * x * x);
    const float e = __expf(2.f * u);
    const float t = 1.f - 2.f / (e + 1.f);
    return 0.5f * x * (1.f + t);
}

template <class Epi>
DEV void gemm_tile(const bf16_t* __restrict__ A, int lda, const bf16_t* __restrict__ Bt, int ldb, int K, int m0, int n0, char* smem, const Epi& epi) {
    const int tid = ltid(), lane = tid & 63, w = tid >> 6, wm = w >> 1, wn = w & 1, ql = lane & 31, hh = lane >> 5;
    f32x16 acc[2][2];
#pragma unroll
    for (int i = 0; i < 2; ++i)
#pragma unroll
        for (int j = 0; j < 2; ++j) acc[i][j] = zero16();
    const int srow = lane >> 3, spos = lane & 7;
    const int c0 = spos ^ ((srow >> 1) & 7), c1 = spos ^ ((4 + (srow >> 1)) & 7);
    const bf16_t* Ag0 = A + (size_t)(m0 + w * 32 + srow) * lda + c0 * 8;
    const bf16_t* Ag1 = A + (size_t)(m0 + w * 32 + 8 + srow) * lda + c1 * 8;
    const bf16_t* Bg0 = Bt + (size_t)(n0 + w * 32 + srow) * ldb + c0 * 8;
    const bf16_t* Bg1 = Bt + (size_t)(n0 + w * 32 + 8 + srow) * ldb + c1 * 8;
    const size_t a16 = (size_t)16 * lda, b16 = (size_t)16 * ldb;
    auto stage = [&](int kt, int buf) __attribute__((always_inline)) {
        char* sa = smem + buf * 32768 + w * 4096;
        char* sb = sa + 16384;
        const int ko = kt * 64;
        __builtin_amdgcn_global_load_lds((const unsigned*)(Ag0 + ko), (LAS unsigned*)(sa), 16, 0, 0);
        __builtin_amdgcn_global_load_lds((const unsigned*)(Ag1 + ko), (LAS unsigned*)(sa + 1024), 16, 0, 0);
        __builtin_amdgcn_global_load_lds((const unsigned*)(Ag0 + a16 + ko), (LAS unsigned*)(sa + 2048), 16, 0, 0);
        __builtin_amdgcn_global_load_lds((const unsigned*)(Ag1 + a16 + ko), (LAS unsigned*)(sa + 3072), 16, 0, 0);
        __builtin_amdgcn_global_load_lds((const unsigned*)(Bg0 + ko), (LAS unsigned*)(sb), 16, 0, 0);
        __builtin_amdgcn_global_load_lds((const unsigned*)(Bg1 + ko), (LAS unsigned*)(sb + 1024), 16, 0, 0);
        __builtin_amdgcn_global_load_lds((const unsigned*)(Bg0 + b16 + ko), (LAS unsigned*)(sb + 2048), 16, 0, 0);
        __builtin_amdgcn_global_load_lds((const unsigned*)(Bg1 + b16 + ko), (LAS unsigned*)(sb + 3072), 16, 0, 0);
    };
    const int key = (ql >> 1) & 7;
    const int arow = (wm * 64 + ql) * 128, brow = (wn * 64 + ql) * 128;
    const int nk = K >> 6;
    __syncthreads();
    stage(0, 0);
    for (int kt = 0; kt < nk; ++kt) {
        asm volatile("s_waitcnt vmcnt(0)" ::: "memory");
        __syncthreads();
        if (kt + 1 < nk) stage(kt + 1, (kt + 1) & 1);
        const char* As = smem + (kt & 1) * 32768;
        const char* Bs = As + 16384;
#pragma unroll
        for (int ks = 0; ks < 4; ++ks) {
            const int co = ((ks * 2 + hh) ^ key) << 4;
            bf16x8 a[2], b[2];
#pragma unroll
            for (int i = 0; i < 2; ++i) {
                a[i] = *(const bf16x8*)(As + arow + i * 4096 + co);
                b[i] = *(const bf16x8*)(Bs + brow + i * 4096 + co);
            }
#pragma unroll
            for (int i = 0; i < 2; ++i)
#pragma unroll
                for (int j = 0; j < 2; ++j) acc[i][j] = mfma32(a[i], b[j], acc[i][j]);
        }
    }
    __syncthreads();
    float* Cs = (float*)smem;
#pragma unroll
    for (int i = 0; i < 2; ++i)
#pragma unroll
        for (int j = 0; j < 2; ++j)
#pragma unroll
            for (int r = 0; r < 16; ++r)
                Cs[(wm * 64 + i * 32 + (r & 3) + 8 * (r >> 2) + 4 * hh) * 128 + wn * 64 + j * 32 + ql] = acc[i][j][r];
    __syncthreads();
    epi.tile(m0, n0, Cs, tid);
}

struct EpiBf16 {
    bf16_t* C; int ldc; const float* rowscale; const float* colbias; int nvalid;
    DEV void tile(int m0, int n0, const float* Cs, int tid) const {
#pragma unroll
        for (int it = 0; it < 8; ++it) {
            const int id = tid + 256 * it, r = id >> 4, c8 = (id & 15) * 8;
            if (n0 + c8 >= nvalid) continue;
            float4 a = *(const float4*)(Cs + r * 128 + c8), b = *(const float4*)(Cs + r * 128 + c8 + 4);
            if (rowscale) { const float sc = rowscale[m0 + r]; a.x *= sc; a.y *= sc; a.z *= sc; a.w *= sc; b.x *= sc; b.y *= sc; b.z *= sc; b.w *= sc; }
            if (colbias) { const float4 ba = *(const float4*)(colbias + n0 + c8), bb = *(const float4*)(colbias + n0 + c8 + 4);
                a.x += ba.x; a.y += ba.y; a.z += ba.z; a.w += ba.w; b.x += bb.x; b.y += bb.y; b.z += bb.z; b.w += bb.w; }
            *(uint4*)(C + (size_t)(m0 + r) * ldc + n0 + c8) = make_uint4(pack2(a.x, a.y), pack2(a.z, a.w), pack2(b.x, b.y), pack2(b.z, b.w));
        }
    }
};
struct EpiF32 {
    float* C; int ldc;
    DEV void tile(int m0, int n0, const float* Cs, int tid) const {
#pragma unroll
        for (int it = 0; it < 16; ++it) {
            const int id = tid + 256 * it, r = id >> 5, c4 = (id & 31) * 4;
            *(float4*)(C + (size_t)(m0 + r) * ldc + n0 + c4) = *(const float4*)(Cs + r * 128 + c4);
        }
    }
};
struct EpiRes {
    const float* xin; float* xout; const float* gate;
    DEV void tile(int m0, int n0, const float* Cs, int tid) const {
        const float* g = gate + (size_t)(m0 >> 11) * 6144 + n0;
#pragma unroll
        for (int it = 0; it < 16; ++it) {
            const int id = tid + 256 * it, r = id >> 5, c4 = (id & 31) * 4;
            const float4 v = *(const float4*)(Cs + r * 128 + c4), g4 = *(const float4*)(g + c4);
            float4 x = *(const float4*)(xin + (size_t)(m0 + r) * 1024 + n0 + c4);
            x.x += g4.x * v.x; x.y += g4.y * v.y; x.z += g4.z * v.z; x.w += g4.w * v.w;
            *(float4*)(xout + (size_t)(m0 + r) * 1024 + n0 + c4) = x;
        }
    }
};

template <class Epi>
DEV void gemm_phase(const bf16_t* A, int lda, const bf16_t* Bt, int ldb, int K, int mtiles, int ntiles, char* smem, const Epi& epi) {
    for (int tile = blockIdx.x; tile < mtiles * ntiles; tile += gridDim.x) {
        const int mt = tile / ntiles, nt = tile % ntiles;
        gemm_tile(A, lda, Bt, ldb, K, mt * 128, nt * 128, smem, epi);
    }
}

DEV int win_srccol(int n) {
    if (n < 652) return n;
    if (n < 704) return -1;
    if (n < 1888) return n - 52;
    if (n < 1920) return -1;
    return n - 84;
}
DEV void transpose_tile(const float* __restrict__ src, int ld_src, int nsrc_valid, int mode, const float* __restrict__ rowscale,
                        bf16_t* __restrict__ dst, int K, int n0, int k0, char* smem) {
    bf16_t* Ls = (bf16_t*)smem;
    const int tid = ltid();
    __syncthreads();
    const int nn = tid & 63, n = n0 + nn;
    const int sc = (mode == 1) ? win_srccol(n) : (n < nsrc_valid ? n : -1);
#pragma unroll 4
    for (int i = 0; i < 16; ++i) {
        const int kk = (tid >> 6) + 4 * i;
        float v = 0.f;
        if (sc >= 0) { v = src[(size_t)(k0 + kk) * ld_src + sc]; if (rowscale) v *= rowscale[k0 + kk]; }
        Ls[nn * 72 + kk] = f2bf(v);
    }
    __syncthreads();
#pragma unroll
    for (int i = 0; i < 2; ++i) {
        const int r = (tid >> 3) + 32 * i, ch = tid & 7;
        *(uint4*)(dst + (size_t)(n0 + r) * K + k0 + ch * 8) = *(const uint4*)(Ls + r * 72 + ch * 8);
    }
}

DEV void convert_stream(const float* __restrict__ src, bf16_t* __restrict__ dst, size_t n8) {
    const int tid = ltid();
    for (size_t i = (size_t)blockIdx.x * 256 + tid; i < n8; i += (size_t)gridDim.x * 256) {
        const float4 a = *(const float4*)(src + i * 8), b = *(const float4*)(src + i * 8 + 4);
        uint4 o; o.x = pack2(a.x, a.y); o.y = pack2(a.z, a.w); o.z = pack2(b.x, b.y); o.w = pack2(b.z, b.w);
        *(uint4*)(dst + i * 8) = o;
    }
}

DEV void convert_fp8_stream(const float* __restrict__ src, unsigned char* __restrict__ dst, size_t n16, float scale) {
    const int tid = ltid();
    const size_t stride = (size_t)gridDim.x * 256;
    for (size_t i0 = (size_t)blockIdx.x * 256 + tid; i0 < n16; i0 += stride * 4) {
        float4 q[4][4];
#pragma unroll
        for (int u = 0; u < 4; ++u) {
            const size_t i = i0 + u * stride < n16 ? i0 + u * stride : i0;
#pragma unroll
            for (int c = 0; c < 4; ++c) q[u][c] = *(const float4*)(src + i * 16 + c * 4);
        }
#pragma unroll
        for (int u = 0; u < 4; ++u) {
            const size_t i = i0 + u * stride;
            if (i >= n16) break;
            unsigned o[4];
#pragma unroll
            for (int j = 0; j < 4; ++j) {
                const float4 v = q[u][j];
                unsigned w = 0u;
                w = __builtin_amdgcn_cvt_pk_fp8_f32(fminf(fmaxf(v.x * scale, -440.f), 440.f), fminf(fmaxf(v.y * scale, -440.f), 440.f), w, false);
                w = __builtin_amdgcn_cvt_pk_fp8_f32(fminf(fmaxf(v.z * scale, -440.f), 440.f), fminf(fmaxf(v.w * scale, -440.f), 440.f), w, true);
                o[j] = w;
            }
            const size_t rowg = i >> 6; const int c16 = (int)(i & 63);
            const size_t l = rowg >> 14, row = rowg & 16383;
            *(uint4*)(dst + (((l * 8 + (c16 >> 3)) * 16384 + row) << 7) + (c16 & 7) * 16) = make_uint4(o[0], o[1], o[2], o[3]);
        }
    }
}

constexpr int J_ROPE = 384, J_MOD = 192, J_MISC = 5;
constexpr int J_TW_L = 608 + 256 + 512 + 24 + 16 + 64 + 64;
constexpr int J_TOTAL = J_ROPE + J_MOD + J_MISC + 2 * J_TW_L;

DEV void prologue_job(const Params& p, int job, char* smem) {
    const int tid = ltid();
    char* ws = p.ws;
    if (job < J_MISC) {
        float* misc = (float*)(ws + OFF_MISC);
        if (job < 4) {
            const int l = job >> 1, kv = job & 1;
            const float* pos = (kv ? p.pos_v : p.pos_k) + l * 2048;
            const float* wsrc = (kv ? p.cmp_wv : p.cmp_wk) + (size_t)l * 2048 * 64;
            float* red = (float*)smem;
            __syncthreads();
            const int kp = tid >> 6, n = tid & 63;
            float acc = 0.f;
            for (int k0 = kp * 512; k0 < kp * 512 + 512; k0 += 16) {
                float wv[16];
#pragma unroll
                for (int u = 0; u < 16; ++u) wv[u] = wsrc[(size_t)(k0 + u) * 64 + n];
#pragma unroll
                for (int u = 0; u < 16; ++u) acc += pos[k0 + u] * wv[u];
            }
            red[kp * 64 + n] = acc;
            __syncthreads();
            if (tid < 64) misc[(l * 2 + kv) * 64 + tid] = red[tid] + red[64 + tid] + red[128 + tid] + red[192 + tid];
        } else if (tid < 2) {
            const int l = tid;
            float d1 = 0.f, d2 = 0.f;
            for (int i = 0; i < 32; ++i) { d1 += p.lq1[l * 32 + i] * p.lk1[l * 32 + i]; d2 += p.lq2[l * 32 + i] * p.lk2[l * 32 + i]; }
            const float lam_init = 0.8f - 0.6f * expf(-0.3f * (float)l);
            misc[256 + l] = expf(d1) - expf(d2) + lam_init;
            misc[258 + l] = 1.f - lam_init;
        }
        return;
    }
    job -= J_MISC;
    if (job < J_MOD) {
        const int l = job / 96, n0 = (job % 96) * 64;
        float* sc = (float*)smem;
        __syncthreads();
        for (int i = tid; i < 8192; i += 256) { const float v = p.c[i]; sc[i] = v / (1.f + __expf(-v)); }
        __syncthreads();
        const int kp = tid >> 6, col = tid & 63;
        float acc[8];
#pragma unroll
        for (int b = 0; b < 8; ++b) acc[b] = 0.f;
        const float* wp = p.ada_w + (size_t)l * 1024 * 6144 + n0 + col;
        for (int k0 = kp * 256; k0 < kp * 256 + 256; k0 += 16) {
            float wv[16];
#pragma unroll
            for (int u = 0; u < 16; ++u) wv[u] = wp[(size_t)(k0 + u) * 6144];
#pragma unroll
            for (int u = 0; u < 16; ++u)
#pragma unroll
                for (int b = 0; b < 8; ++b) acc[b] += sc[b * 1024 + k0 + u] * wv[u];
        }
        float* red = sc + 8192;
#pragma unroll
        for (int b = 0; b < 8; ++b) red[(kp * 8 + b) * 64 + col] = acc[b];
        __syncthreads();
        float* mod = (float*)(ws + OFF_MOD);
        for (int idx = tid; idx < 512; idx += 256) {
            const int b = idx >> 6, cl = idx & 63;
            const float v = red[(0 * 8 + b) * 64 + cl] + red[(1 * 8 + b) * 64 + cl] + red[(2 * 8 + b) * 64 + cl] + red[(3 * 8 + b) * 64 + cl];
            mod[(size_t)(l * 8 + b) * 6144 + n0 + cl] = v + p.ada_b[l * 6144 + n0 + cl];
        }
        return;
    }
    job -= J_MOD;
    if (job < J_ROPE) {
        const int idx = job * 256 + tid;
        const int s = idx / 48, j = idx % 48;
        float* rope = (float*)(ws + OFF_ROPE);
        float inv; float *pc, *ps;
        if (j < 32) { inv = exp2f(-(float)j * (13.287712379549449f / 32.f)); pc = rope + s * 32 + j; ps = rope + 2048 * 32 + s * 32 + j; }
        else { const int i = j - 32; inv = exp2f(-(float)i * (13.287712379549449f / 16.f)); pc = rope + 2048 * 64 + s * 16 + i; ps = rope + 2048 * 64 + 2048 * 16 + s * 16 + i; }
        const double a = (double)s * (double)inv;
        const double kk = rint(a * 0.15915494309189535);
        const float r = (float)fma(-kk, 6.283185307179586, a);
        *pc = cosf(r); *ps = sinf(r);
        return;
    }
    job -= J_ROPE;
    const int l = job / J_TW_L; int j = job % J_TW_L;
    if (j < 608) { transpose_tile(p.w_in + (size_t)l * 1024 * 2348, 2348, 2348, 1, nullptr, (bf16_t*)(ws + OFF_WIN) + (size_t)l * 2432 * 1024, 1024, (j / 16) * 64, (j % 16) * 64, smem); return; }
    j -= 608;
    if (j < 256) { transpose_tile(p.w_out + (size_t)l * 1024 * 1024, 1024, 1024, 0, nullptr, (bf16_t*)(ws + OFF_WOUT) + (size_t)l * 1024 * 1024, 1024, (j / 16) * 64, (j % 16) * 64, smem); return; }
    j -= 256;
    if (j < 512) { transpose_tile(p.w_q + (size_t)l * 1024 * 2048, 2048, 2048, 0, nullptr, (bf16_t*)(ws + OFF_WQ) + (size_t)l * 2048 * 1024, 1024, (j / 16) * 64, (j % 16) * 64, smem); return; }
    j -= 512;
    if (j < 24) { transpose_tile(p.mla_wuq + (size_t)l * 256 * 384, 384, 384, 0, p.mla_qg + l * 256, (bf16_t*)(ws + OFF_WUQ) + (size_t)l * 384 * 256, 256, (j / 4) * 64, (j % 4) * 64, smem); return; }
    j -= 24;
    if (j < 16) { transpose_tile(p.mla_wukv + (size_t)l * 128 * 512, 512, 512, 0, p.mla_kvg + l * 128, (bf16_t*)(ws + OFF_WUKV) + (size_t)l * 512 * 128, 128, (j / 2) * 64, (j % 2) * 64, smem); return; }
    j -= 16;
    if (j < 64) { transpose_tile(p.cmp_wk + (size_t)l * 2048 * 64, 64, 64, 0, nullptr, (bf16_t*)(ws + OFF_WCK) + (size_t)l * 128 * 2048, 2048, (j / 32) * 64, (j % 32) * 64, smem); return; }
    j -= 64;
    transpose_tile(p.cmp_wv + (size_t)l * 2048 * 64, 64, 64, 0, nullptr, (bf16_t*)(ws + OFF_WCV) + (size_t)l * 128 * 2048, 2048, (j / 32) * 64, (j % 32) * 64, smem);
}

#if TS_A >= 0
#define PSTAMP(I) if (blockIdx.x == 0 && threadIdx.x == 0) ((unsigned long long*)(p.ws + 32768))[I] = __builtin_amdgcn_s_memrealtime();
#else
#define PSTAMP(I)
#endif
DEV void phase_prologue(const Params& p, char* smem) {
    for (int job = blockIdx.x; job < J_TOTAL; job += gridDim.x) { prologue_job(p, job, smem); if (job < 512) { PSTAMP(40) } }
    PSTAMP(42)
    char* ws = p.ws;
    convert_fp8_stream(p.pu, (unsigned char*)(ws + OFF_PU), 2ull * 16384 * 1024 / 16, kScaleU);
    PSTAMP(43)
    convert_fp8_stream(p.pv, (unsigned char*)(ws + OFF_PV), 2ull * 16384 * 1024 / 16, kScaleV);
    PSTAMP(44)
    for (int l = 0; l < 2; ++l) {
        convert_stream(p.subk1 + (size_t)l * 16384, (bf16_t*)(ws + OFF_SUBK) + (size_t)(l * 2 + 0) * 16384, 16384 / 8);
        convert_stream(p.subk2 + (size_t)l * 16384, (bf16_t*)(ws + OFF_SUBK) + (size_t)(l * 2 + 1) * 16384, 16384 / 8);
    }
}

DEV void phase_norm(const Params& p, int layer, int which) {
    const int tid = ltid(), lane = tid & 63, w = tid >> 6;
    const float* xs = (layer == 0 && which == 0) ? p.x : (const float*)(p.ws + OFF_XRES);
    const float* g = (which == 0 ? p.norm_mix_g : p.norm_ffn_g) + layer * 1024;
    const float* mod = (const float*)(p.ws + OFF_MOD) + (size_t)layer * 8 * 6144;
    bf16_t* h = (bf16_t*)(p.ws + OFF_H);
    for (int q = blockIdx.x; q < kT / 4; q += gridDim.x) {
        const int t = q * 4 + w, b = t >> 11;
        const float* xr = xs + (size_t)t * 1024;
        float4 v[4]; float ss = 0.f;
#pragma unroll
        for (int i = 0; i < 4; ++i) { v[i] = *(const float4*)(xr + i * 256 + lane * 4); ss += v[i].x * v[i].x + v[i].y * v[i].y + v[i].z * v[i].z + v[i].w * v[i].w; }
        ss = wave_sum(ss);
        const float rstd = rsqrtf(ss * (1.f / 1024.f) + kEps);
        const float* sh = mod + (size_t)b * 6144 + (which ? 3072 : 0);
        const float* sc = sh + 1024;
#pragma unroll
        for (int i = 0; i < 4; ++i) {
            const int col = i * 256 + lane * 4;
            const float4 g4 = *(const float4*)(g + col), s4 = *(const float4*)(sc + col), h4 = *(const float4*)(sh + col);
            const float o0 = v[i].x * rstd * g4.x * (1.f + s4.x) + h4.x, o1 = v[i].y * rstd * g4.y * (1.f + s4.y) + h4.y;
            const float o2 = v[i].z * rstd * g4.z * (1.f + s4.z) + h4.z, o3 = v[i].w * rstd * g4.w * (1.f + s4.w) + h4.w;
            uint2 o; o.x = pack2(o0, o1); o.y = pack2(o2, o3);
            *(uint2*)(h + (size_t)t * 1024 + col) = o;
        }
    }
}

DEV void rope8(uint4& x1, uint4& x2, const float* cs, const float* sn) {
    const float4 c0 = *(const float4*)cs, c1 = *(const float4*)(cs + 4), s0 = *(const float4*)sn, s1 = *(const float4*)(sn + 4);
    const float cc[8] = {c0.x, c0.y, c0.z, c0.w, c1.x, c1.y, c1.z, c1.w};
    const float ss[8] = {s0.x, s0.y, s0.z, s0.w, s1.x, s1.y, s1.z, s1.w};
    unsigned a[4] = {x1.x, x1.y, x1.z, x1.w}, b[4] = {x2.x, x2.y, x2.z, x2.w};
#pragma unroll
    for (int i = 0; i < 4; ++i) {
        const float a0 = lo16(a[i]), a1 = hi16(a[i]), b0 = lo16(b[i]), b1 = hi16(b[i]);
        const float o10 = a0 * cc[2 * i] - b0 * ss[2 * i], o11 = a1 * cc[2 * i + 1] - b1 * ss[2 * i + 1];
        const float o20 = a0 * ss[2 * i] + b0 * cc[2 * i], o21 = a1 * ss[2 * i + 1] + b1 * cc[2 * i + 1];
        a[i] = pack2(o10, o11); b[i] = pack2(o20, o21);
    }
    x1 = make_uint4(a[0], a[1], a[2], a[3]); x2 = make_uint4(b[0], b[1], b[2], b[3]);
}
DEV void vt_tile(const bf16_t* __restrict__ src, int ld, bf16_t* __restrict__ dst, char* smem) {
    bf16_t* Ls = (bf16_t*)smem;
    const int tid = ltid();
    __syncthreads();
#pragma unroll
    for (int i = 0; i < 2; ++i) {
        const int id = tid + 256 * i, tok = id >> 3, ch = id & 7;
        *(uint4*)(Ls + tok * 72 + ch * 8) = *(const uint4*)(src + (size_t)tok * ld + ch * 8);
    }
    __syncthreads();
#pragma unroll
    for (int i = 0; i < 2; ++i) {
        const int id = tid + 256 * i, d = id >> 3, tc = id & 7;
        unsigned short e[8];
#pragma unroll
        for (int j = 0; j < 8; ++j) e[j] = Ls[(tc * 8 + j) * 72 + d];
        uint4 o;
        o.x = (unsigned)e[0] | ((unsigned)e[1] << 16); o.y = (unsigned)e[2] | ((unsigned)e[3] << 16);
        o.z = (unsigned)e[4] | ((unsigned)e[5] << 16); o.w = (unsigned)e[6] | ((unsigned)e[7] << 16);
        *(uint4*)(dst + (size_t)d * 2048 + tc * 8) = o;
    }
}

DEV void phase_layout1(const Params& p, char* smem) {
    char* ws = p.ws;
    bf16_t* cols = (bf16_t*)(ws + OFF_COLS);
    bf16_t* kc = (bf16_t*)(ws + OFF_KC);
    bf16_t* vc = (bf16_t*)(ws + OFF_VC);
    bf16_t* VT = (bf16_t*)(ws + OFF_VT);
    float* rstd = (float*)(ws + OFF_RSTD);
    const float* rope = (const float*)(ws + OFF_ROPE);
    const float *cos64 = rope, *sin64 = rope + 2048 * 32, *cos32 = rope + 2048 * 64, *sin32 = rope + 2048 * 64 + 2048 * 16;
    const int tid = ltid();
    for (int tile = blockIdx.x; tile < kT / 64; tile += gridDim.x) {
        const int T0 = tile * 64, b = T0 >> 11, s0 = T0 & 2047;
        for (int it = tid; it < 64 * 94; it += 256) {
            const int tok = it / 94, item = it % 94;
            const int t = T0 + tok, s = s0 + tok;
            bf16_t* row = cols + (size_t)t * LDC;
            if (item < 52) {
                const int hd = item >> 2, i0 = (item & 3) * 8;
                const int base = hd < 4 ? 64 * hd : hd == 4 ? 256 : hd == 5 ? 384 : hd == 6 ? 512 : hd < 11 ? 1920 + 64 * (hd - 7) : 2176 + 64 * (hd - 11);
                uint4 x1 = *(const uint4*)(row + base + i0), x2 = *(const uint4*)(row + base + 32 + i0);
                rope8(x1, x2, cos64 + s * 32 + i0, sin64 + s * 32 + i0);
                *(uint4*)(row + base + i0) = x1; *(uint4*)(row + base + 32 + i0) = x2;
                if (hd == 4) { *(uint4*)(kc + (size_t)t * 64 + i0) = x1; *(uint4*)(kc + (size_t)t * 64 + 32 + i0) = x2; }
            } else if (item < 86) {
                const int it2 = item - 52, sub = it2 >> 1, i0 = (it2 & 1) * 8;
                const int base = sub < 8 ? 704 + 32 * sub : sub < 16 ? 960 + 32 * (sub - 8) : 1856;
                uint4 x1 = *(const uint4*)(row + base + i0), x2 = *(const uint4*)(row + base + 16 + i0);
                rope8(x1, x2, cos32 + s * 16 + i0, sin32 + s * 16 + i0);
                *(uint4*)(row + base + i0) = x1; *(uint4*)(row + base + 16 + i0) = x2;
            } else {
                const int ch = item - 86;
                *(uint4*)(vc + (size_t)t * 64 + ch * 8) = *(const uint4*)(row + 320 + ch * 8);
            }
        }
        {
            const int tok = tid >> 2, part = tid & 3, t = T0 + tok;
            const bf16_t* src = cols + (size_t)t * LDC + 1472 + (part < 3 ? part : 0) * 128;
            float ss = 0.f;
#pragma unroll 4
            for (int i = 0; i < 16; ++i) {
                const uint4 u = *(const uint4*)(src + i * 8);
                ss += lo16(u.x) * lo16(u.x) + hi16(u.x) * hi16(u.x) + lo16(u.y) * lo16(u.y) + hi16(u.y) * hi16(u.y)
                    + lo16(u.z) * lo16(u.z) + hi16(u.z) * hi16(u.z) + lo16(u.w) * lo16(u.w) + hi16(u.w) * hi16(u.w);
            }
            float vq = part < 2 ? ss : 0.f;
            vq += __shfl_xor(vq, 1, 64);
            if (part == 0) rstd[t] = rsqrtf(vq * (1.f / 256.f) + kEps);
            if (part == 2) rstd[kT + t] = rsqrtf(ss * (1.f / 128.f) + kEps);
        }
#pragma unroll 1
        for (int vh = 0; vh < 8; ++vh) {
            const int col = vh == 0 ? 448 : vh == 1 ? 576 : vh < 6 ? 1216 + 64 * (vh - 2) : 2304 + 64 * (vh - 6);
            vt_tile(cols + (size_t)T0 * LDC + col, LDC, VT + ((size_t)(b * 12 + vh) * 64) * 2048 + s0, smem);
        }
    }
}

DEV void phase_layout2(const Params& p, char* smem) {
    char* ws = p.ws;
    bf16_t* qmla = (bf16_t*)(ws + OFF_QMLA);
    const bf16_t* kvmla = (const bf16_t*)(ws + OFF_KVMLA);
    bf16_t* VT = (bf16_t*)(ws + OFF_VT);
    const float* rope = (const float*)(ws + OFF_ROPE);
    const float *cos32 = rope + 2048 * 64, *sin32 = rope + 2048 * 64 + 2048 * 16;
    const int tid = ltid();
    for (int tile = blockIdx.x; tile < kT / 64; tile += gridDim.x) {
        const int T0 = tile * 64, b = T0 >> 11, s0 = T0 & 2047;
        for (int it = tid; it < 64 * 8; it += 256) {
            const int tok = it >> 3, item = it & 7, hd = item >> 1, i0 = (item & 1) * 8;
            const int t = T0 + tok, s = s0 + tok;
            bf16_t* row = qmla + (size_t)t * 384 + hd * 96 + 64;
            uint4 x1 = *(const uint4*)(row + i0), x2 = *(const uint4*)(row + 16 + i0);
            rope8(x1, x2, cos32 + s * 16 + i0, sin32 + s * 16 + i0);
            *(uint4*)(row + i0) = x1; *(uint4*)(row + 16 + i0) = x2;
        }
#pragma unroll 1
        for (int hd = 0; hd < 4; ++hd)
            vt_tile(kvmla + (size_t)T0 * 512 + hd * 128 + 64, 512, VT + ((size_t)(b * 12 + 8 + hd) * 64) * 2048 + s0, smem);
    }
}

constexpr int SM_K = 0;
constexpr int SM_V = 18432;
constexpr int SM_IMP = SM_V + 16896;
constexpr int SM_SEL = SM_IMP + 16896;
constexpr int SM_CTRL = 65536;
constexpr int SM_TOTAL = SM_CTRL + 256;
constexpr int SM_ATTN_END = SM_SEL + 1024;

struct RangeIter { int cur, end; DEV int next() { return cur < end ? cur++ : -1; } };
struct BitIter { unsigned rem; DEV int next() { if (!rem) return -1; const int k = __ffs((int)rem) - 1; rem &= rem - 1; return k; } };
struct LdRow { const bf16_t* base; int ld;
    DEV uint4 operator()(int kt, int id) const { const int row = id >> 3, part = id & 7; return *(const uint4*)(base + (size_t)(kt * 64 + row) * ld + part * 8); } };
struct LdVT { const bf16_t* base;
    DEV uint4 operator()(int kt, int id) const { const int d = id >> 3, part = id & 7; return *(const uint4*)(base + (size_t)d * 2048 + kt * 64 + part * 8); } };
struct LdMlaK { const bf16_t* kv; const bf16_t* kr;
    DEV uint4 operator()(int kt, int id) const { const int row = id / 12, part = id % 12; const size_t t = (size_t)(kt * 64 + row);
        return part < 8 ? *(const uint4*)(kv + t * 512 + part * 8) : *(const uint4*)(kr + t * LDC + (part - 8) * 8); } };

struct MaskCausal { DEV bool on(int) const { return true; } DEV bool ok(int kc, int d) const { return kc <= d; }
    DEV bool full(int kt, int t0w) const { return kt * 64 + 63 <= t0w; } };
template <int W> struct MaskWin { DEV bool on(int) const { return true; } DEV bool ok(int kc, int d) const { return (kc <= d) && (d - kc < W); }
    DEV bool full(int kt, int t0w) const { return (kt * 64 + 63 <= t0w) && (t0w + 31 - kt * 64 < W); } };
struct MaskSel { unsigned bits, allbits; DEV bool on(int kt) const { return (bits >> kt) & 1u; } DEV bool ok(int kc, int d) const { return kc <= d; }
    DEV bool full(int kt, int t0w) const { return ((allbits >> kt) & 1u) && (kt * 64 + 63 <= t0w); } };
template <int KDIM, int NKS, int NSUB, class It, class LK, class LV, class MaskF, class SkipF>
DEV void attn_stream(It it, const LK& ldK, const LV& ldV, const MaskF& maskf, const SkipF& skipf,
                     const bf16x8* qf, f32x16 (&o)[NSUB][2], float (&m)[NSUB], float (&l)[NSUB], float scl, int tq, int t0w, char* smem, int tid, int koff = 0) {
    constexpr int KCH = KDIM / 8, KSTR = KDIM + 8, NKC = (64 * KCH) / 256;
    bf16_t* Kb = (bf16_t*)(smem + SM_K);
    bf16_t* Vb = (bf16_t*)(smem + SM_V);
    const int lane = tid & 63, ql = lane & 31, hh = lane >> 5;
    uint4 rk0 = make_uint4(0, 0, 0, 0), rk1 = rk0, rk2 = rk0, rv0 = rk0, rv1 = rk0;
    int kt = it.next();
    if (kt >= 0) {
        rk0 = ldK(kt, tid); rk1 = ldK(kt, tid + 256);
        if (NKC == 3) rk2 = ldK(kt, tid + 512);
        rv0 = ldV(kt, tid); rv1 = ldV(kt, tid + 256);
    }
    while (kt >= 0) {
        __syncthreads();
        { const int id = tid, row = id / KCH, part = id % KCH; *(uint4*)(Kb + row * KSTR + part * 8) = rk0; }
        { const int id = tid + 256, row = id / KCH, part = id % KCH; *(uint4*)(Kb + row * KSTR + part * 8) = rk1; }
        if (NKC == 3) { const int id = tid + 512, row = id / KCH, part = id % KCH; *(uint4*)(Kb + row * KSTR + part * 8) = rk2; }
        { const int id = tid, row = id >> 3, part = id & 7; bf16_t* d = Vb + row * 68 + part * 8;
            *(uint2*)d = make_uint2(rv0.x, rv0.y); *(uint2*)(d + 4) = make_uint2(rv0.z, rv0.w); }
        { const int id = tid + 256, row = id >> 3, part = id & 7; bf16_t* d = Vb + row * 68 + part * 8;
            *(uint2*)d = make_uint2(rv1.x, rv1.y); *(uint2*)(d + 4) = make_uint2(rv1.z, rv1.w); }
        __syncthreads();
        const int ktn = it.next();
        if (ktn >= 0) {
            rk0 = ldK(ktn, tid); rk1 = ldK(ktn, tid + 256);
            if (NKC == 3) rk2 = ldK(ktn, tid + 512);
            rv0 = ldV(ktn, tid); rv1 = ldV(ktn, tid + 256);
        }
        if (!skipf(kt)) {
#pragma unroll
            for (int sub = 0; sub < NSUB; ++sub) {
                __builtin_amdgcn_sched_barrier(0);
                f32x16 s[2];
#pragma unroll
                for (int i = 0; i < 2; ++i) {
                    s[i] = zero16();
#pragma unroll
                    for (int ks = 0; ks < NKS; ++ks) {
                        const bf16x8 a = *(const bf16x8*)(Kb + (i * 32 + ql) * KSTR + koff + (sub * NKS + ks) * 16 + hh * 8);
                        s[i] = mfma32(a, qf[sub * NKS + ks], s[i]);
                    }
                }
                float mx = kNeg;
                if (!maskf.full(kt, t0w)) {
                    const int dlim = tq - kt * 64 - 4 * hh;
                    const bool on = maskf.on(kt);
#pragma unroll
                    for (int i = 0; i < 2; ++i)
#pragma unroll
                        for (int r = 0; r < 16; ++r) {
                            const int kc = i * 32 + (r & 3) + 8 * (r >> 2);
                            s[i][r] = (on && maskf.ok(kc, dlim)) ? s[i][r] : kNeg;
                        }
                }
#pragma unroll
                for (int i = 0; i < 2; ++i)
#pragma unroll
                    for (int r = 0; r < 16; ++r) mx = fmaxf(mx, s[i][r]);
                mx = fmaxf(mx, xor32f(mx, lane));
                const float mnew = fmaxf(m[sub], mx);
                const float alpha = __builtin_amdgcn_exp2f((m[sub] - mnew) * scl);
                m[sub] = mnew;
                const float negm = mnew > -1e29f ? -mnew * scl : 0.f;
                float sum = 0.f;
#pragma unroll
                for (int i = 0; i < 2; ++i)
#pragma unroll
                    for (int r = 0; r < 16; ++r) { const float pv = __builtin_amdgcn_exp2f(__builtin_fmaf(s[i][r], scl, negm)); s[i][r] = pv; sum += pv; }
                l[sub] = l[sub] * alpha + sum;
#pragma unroll
                for (int dt = 0; dt < 2; ++dt)
#pragma unroll
                    for (int r = 0; r < 16; ++r) o[sub][dt][r] *= alpha;
                __builtin_amdgcn_sched_barrier(0);
#pragma unroll
                for (int ks = 0; ks < 4; ++ks) {
                    if (ks == 2) __builtin_amdgcn_sched_barrier(0);
                    const int i = ks >> 1, r0 = 8 * (ks & 1);
                    uint4 pu;
                    pu.x = pack2(s[i][r0 + 0], s[i][r0 + 1]); pu.y = pack2(s[i][r0 + 2], s[i][r0 + 3]);
                    pu.z = pack2(s[i][r0 + 4], s[i][r0 + 5]); pu.w = pack2(s[i][r0 + 6], s[i][r0 + 7]);
                    const bf16x8 pf = __builtin_bit_cast(bf16x8, pu);
#pragma unroll
                    for (int dt = 0; dt < 2; ++dt) {
                        const bf16_t* vp = Vb + (dt * 32 + ql) * 68 + ks * 16 + 4 * hh;
                        const uint2 a0 = *(const uint2*)vp, a1 = *(const uint2*)(vp + 8);
                        const bf16x8 a = __builtin_bit_cast(bf16x8, make_uint4(a0.x, a0.y, a1.x, a1.y));
                        o[sub][dt] = mfma32(a, pf, o[sub][dt]);
                    }
                }
            }
        }
        kt = ktn;
    }
}

DEV void write_o(const f32x16 (&o)[2], bf16_t* obuf, size_t row, int col0, int hh) {
#pragma unroll
    for (int dt = 0; dt < 2; ++dt)
#pragma unroll
        for (int g = 0; g < 4; ++g) {
            const int d = dt * 32 + 8 * g + 4 * hh;
            uint2 u; u.x = pack2(o[dt][4 * g], o[dt][4 * g + 1]); u.y = pack2(o[dt][4 * g + 2], o[dt][4 * g + 3]);
            *(uint2*)(obuf + row * 1024 + col0 + d) = u;
        }
}
DEV float sigmoidf(float x) { return 1.f / (1.f + __expf(-x)); }

DEV void nsa_item(const Params& p, int b, int qb, char* smem) {
    int tid = threadIdx.x; asm volatile("" : "+v"(tid));
    const int lane = tid & 63, w = tid >> 6, ql = lane & 31, hh = lane >> 5;
    char* ws = p.ws;
    const bf16_t* cols = (const bf16_t*)(ws + OFF_COLS);
    const bf16_t* VT = (const bf16_t*)(ws + OFF_VT);
    bf16_t* obuf = (bf16_t*)(ws + OFF_O);
    const int t0 = qb * 32, tq = t0 + ql;
    const size_t Tb = (size_t)b * kS;
    const bf16_t* qrow = cols + (Tb + tq) * LDC;
    bf16x8 qf[4];
#pragma unroll
    for (int ks = 0; ks < 4; ++ks) qf[ks] = *(const bf16x8*)(qrow + w * 64 + ks * 16 + hh * 8);
    const float g0 = sigmoidf(bf2f(qrow[640 + w * 3 + 0])), g1 = sigmoidf(bf2f(qrow[640 + w * 3 + 1])), g2 = sigmoidf(bf2f(qrow[640 + w * 3 + 2]));
    const float scl = 0.125f * kLog2e;
    bf16_t* Kc = (bf16_t*)(smem + SM_K);
    bf16_t* Vc = (bf16_t*)(smem + SM_V);
    float* impP = (float*)(smem + SM_IMP);
    unsigned* selm = (unsigned*)(smem + SM_SEL);
    const bf16_t* kcmp = (const bf16_t*)(ws + OFF_KCMP) + (size_t)b * 128 * 64;
    const bf16_t* vcmp = kcmp + 1024 * 64;
    __syncthreads();
#pragma unroll
    for (int i = 0; i < 4; ++i) {
        const int id = tid + 256 * i, row = id >> 3, part = id & 7;
        uint4 kk = *(const uint4*)(kcmp + row * 64 + part * 8);
        uint4 vv = *(const uint4*)(vcmp + row * 64 + part * 8);
        if (row == 127) { kk = make_uint4(0, 0, 0, 0); vv = kk; }
        *(uint4*)(Kc + row * 72 + part * 8) = kk;
        const unsigned u[4] = {vv.x, vv.y, vv.z, vv.w};
#pragma unroll
        for (int j = 0; j < 4; ++j) { Vc[(part * 8 + 2 * j) * 132 + row] = (bf16_t)(u[j] & 0xffffu); Vc[(part * 8 + 2 * j + 1) * 132 + row] = (bf16_t)(u[j] >> 16); }
    }
    __syncthreads();
    unsigned ocp[16];
    float* invs = (float*)(smem + SM_SEL) + 64;
    {
        const int cmaxv = tq >= 31 ? min((tq - 31) >> 4, 126) : -1;
        float mx = kNeg;
#pragma unroll 1
        for (int i = 0; i < 4; ++i) {
            f32x16 s = zero16();
#pragma unroll
            for (int ks = 0; ks < 4; ++ks) s = mfma32(*(const bf16x8*)(Kc + (i * 32 + ql) * 72 + ks * 16 + hh * 8), qf[ks], s);
            const int clim = cmaxv - i * 32 - 4 * hh;
#pragma unroll
            for (int r = 0; r < 16; ++r) {
                const int kc = (r & 3) + 8 * (r >> 2);
                const bool valid = (kc <= clim);
                mx = fmaxf(mx, valid ? s[r] * scl : kNeg);
            }
        }
        mx = fmaxf(mx, xor32f(mx, lane));
        f32x16 ocmp[2]; ocmp[0] = zero16(); ocmp[1] = zero16();
        float sum = 0.f, carprev = 0.f;
#pragma unroll 1
        for (int i = 0; i < 4; ++i) {
            f32x16 s = zero16();
#pragma unroll
            for (int ks = 0; ks < 4; ++ks) s = mfma32(*(const bf16x8*)(Kc + (i * 32 + ql) * 72 + ks * 16 + hh * 8), qf[ks], s);
            const int clim = cmaxv - i * 32 - 4 * hh;
#pragma unroll
            for (int r = 0; r < 16; ++r) {
                const int kc = (r & 3) + 8 * (r >> 2);
                const bool valid = (kc <= clim);
                const float pv = valid ? __builtin_amdgcn_exp2f(s[r] * scl - mx) : 0.f;
                s[r] = pv; sum += pv;
            }
            float own[4], car[4];
#pragma unroll
            for (int g = 0; g < 4; ++g) { own[g] = s[4 * g] + s[4 * g + 1] + s[4 * g + 2] + 0.5f * s[4 * g + 3]; car[g] = 0.5f * s[4 * g + 3]; }
#pragma unroll
            for (int g = 0; g < 4; ++g) {
                const float send = hh ? (g ? car[g > 0 ? g - 1 : 0] : carprev) : car[g];
                own[g] += xor32f(send, lane);
            }
            carprev = car[3];
#pragma unroll
            for (int g = 0; g < 4; ++g) impP[(w * 32 + ql) * 33 + 2 * (4 * i + g) + hh] = own[g];
#pragma unroll
            for (int sp = 0; sp < 2; ++sp) {
                const int ks = 2 * i + sp, r0 = 8 * sp;
                uint4 pu;
                pu.x = pack2(s[r0 + 0], s[r0 + 1]); pu.y = pack2(s[r0 + 2], s[r0 + 3]);
                pu.z = pack2(s[r0 + 4], s[r0 + 5]); pu.w = pack2(s[r0 + 6], s[r0 + 7]);
                const bf16x8 pf = __builtin_bit_cast(bf16x8, pu);
#pragma unroll
                for (int dt = 0; dt < 2; ++dt) {
                    const bf16_t* vp = Vc + (dt * 32 + ql) * 132 + ks * 16 + 4 * hh;
                    const uint2 a0 = *(const uint2*)vp, a1 = *(const uint2*)(vp + 8);
                    ocmp[dt] = mfma32(__builtin_bit_cast(bf16x8, make_uint4(a0.x, a0.y, a1.x, a1.y)), pf, ocmp[dt]);
                }
            }
        }
        sum += xor32f(sum, lane);
        const float inv = sum > 0.f ? 1.f / sum : 0.f;
        invs[w * 32 + ql] = inv;
        const float f = g0 * inv;
#pragma unroll
        for (int dt = 0; dt < 2; ++dt)
#pragma unroll
            for (int r = 0; r < 8; ++r) ocp[dt * 8 + r] = pack2(f * ocmp[dt][2 * r], f * ocmp[dt][2 * r + 1]);
    }
    __syncthreads();
    const int qblk = t0 >> 6;
    {
        const int hw = tid >> 5, j = tid & 31;
#pragma unroll 1
        for (int rr = 0; rr < 4; ++rr) {
            const int row = hw * 4 + rr;
            const float v = impP[(0 * 32 + row) * 33 + j] * invs[row] + impP[(1 * 32 + row) * 33 + j] * invs[32 + row]
                          + impP[(2 * 32 + row) * 33 + j] * invs[64 + row] + impP[(3 * 32 + row) * 33 + j] * invs[96 + row];
            bool sel;
            if (qblk < 16) sel = (j <= qblk);
            else {
                const bool cand = (j >= 1) && (j <= qblk - 2);
                const bool forced = (j == 0) || (j == qblk) || (j == qblk - 1);
                int rank = 0;
                for (int j2 = 1; j2 <= qblk - 2; ++j2) {
                    const float v2 = lanef(v, (lane & 32) + j2);
                    rank += (v2 > v || (v2 == v && j2 < j)) ? 1 : 0;
                }
                sel = forced || (cand && rank < 13);
            }
            const unsigned long long bal = __ballot(sel);
            const unsigned mk = (lane & 32) ? (unsigned)(bal >> 32) : (unsigned)bal;
            if (j == 0) selm[row] = mk;
        }
    }
    __syncthreads();
    const unsigned mysel = selm[ql];
    unsigned U = mysel, Uall = mysel;
#pragma unroll
    for (int o = 16; o > 0; o >>= 1) { U |= (unsigned)__builtin_amdgcn_ds_bpermute((lane ^ o) << 2, (int)U); Uall &= (unsigned)__builtin_amdgcn_ds_bpermute((lane ^ o) << 2, (int)Uall); }
    Uall = (unsigned)__builtin_amdgcn_readfirstlane((int)Uall);
    {
        f32x16 o1[1][2]; o1[0][0] = zero16(); o1[0][1] = zero16();
        float m1[1] = {kNeg}, l1[1] = {0.f};
        auto skipf = [&](int) __attribute__((always_inline)) { return false; };
        attn_stream<64, 4, 1>(BitIter{U}, LdRow{cols + Tb * LDC + 384, LDC}, LdVT{VT + (size_t)(b * 12 + 0) * 64 * 2048}, MaskSel{mysel, Uall}, skipf, qf, o1, m1, l1, scl, tq, __builtin_amdgcn_readfirstlane(t0), smem, tid);
        const float lt = l1[0] + xor32f(l1[0], lane);
        const float f = g1 / lt;
#pragma unroll
        for (int dt = 0; dt < 2; ++dt)
#pragma unroll
            for (int r = 0; r < 8; ++r) ocp[dt * 8 + r] = pack2(lo16(ocp[dt * 8 + r]) + f * o1[0][dt][2 * r], hi16(ocp[dt * 8 + r]) + f * o1[0][dt][2 * r + 1]);
    }
    {
        f32x16 o1[1][2]; o1[0][0] = zero16(); o1[0][1] = zero16();
        float m1[1] = {kNeg}, l1[1] = {0.f};
        auto skipf = [&](int) __attribute__((always_inline)) { return false; };
        const int lo = t0 >= 511 ? ((t0 - 511) >> 6) : 0;
        attn_stream<64, 4, 1>(RangeIter{lo, qblk + 1}, LdRow{cols + Tb * LDC + 512, LDC}, LdVT{VT + (size_t)(b * 12 + 1) * 64 * 2048}, MaskWin<512>{}, skipf, qf, o1, m1, l1, scl, tq, __builtin_amdgcn_readfirstlane(t0), smem, tid);
        const float lt = l1[0] + xor32f(l1[0], lane);
        const float f = g2 / lt;
#pragma unroll
        for (int dt = 0; dt < 2; ++dt)
#pragma unroll
            for (int r = 0; r < 8; ++r) { o1[0][dt][2 * r] = lo16(ocp[dt * 8 + r]) + f * o1[0][dt][2 * r]; o1[0][dt][2 * r + 1] = hi16(ocp[dt * 8 + r]) + f * o1[0][dt][2 * r + 1]; }
        write_o(o1[0], obuf, Tb + tq, w * 64, hh);
    }
}

DEV void diff_item(const Params& p, int layer, int b, int hd, int q64, char* smem) {
    int tid = threadIdx.x; asm volatile("" : "+v"(tid));
    const int lane = tid & 63, w = tid >> 6, ql = lane & 31, hh = lane >> 5;
    const int sub = w & 1, qbw = w >> 1;
    char* ws = p.ws;
    const bf16_t* cols = (const bf16_t*)(ws + OFF_COLS);
    const bf16_t* VT = (const bf16_t*)(ws + OFF_VT);
    bf16_t* obuf = (bf16_t*)(ws + OFF_O);
    const float* misc = (const float*)(ws + OFF_MISC);
    const int t0w = q64 * 64 + qbw * 32, tq = t0w + ql;
    const size_t Tb = (size_t)b * kS;
    const bf16_t* qrow = cols + (Tb + tq) * LDC + 704 + hd * 64 + sub * 32;
    bf16x8 qf[2];
#pragma unroll
    for (int ks = 0; ks < 2; ++ks) qf[ks] = *(const bf16x8*)(qrow + ks * 16 + hh * 8);
    const float scl = 0.17677669529663687f * kLog2e;
    f32x16 o1[1][2]; o1[0][0] = zero16(); o1[0][1] = zero16();
    float m1[1] = {kNeg}, l1[1] = {0.f};
    auto skipf = [&](int kt) __attribute__((always_inline)) { return kt * 64 > t0w + 31; };
    attn_stream<64, 2, 1>(RangeIter{0, q64 + 1}, LdRow{cols + Tb * LDC + 960 + hd * 64, LDC}, LdVT{VT + (size_t)(b * 12 + 2 + hd) * 64 * 2048}, MaskCausal{}, skipf, qf, o1, m1, l1, scl, tq, __builtin_amdgcn_readfirstlane(t0w), smem, tid, sub * 32);
    const float lam = misc[256 + layer], post = misc[258 + layer];
    const float lt = l1[0] + xor32f(l1[0], lane);
    float* ex = (float*)smem;
    __syncthreads();
    if (sub == 1) {
        const float f = lam / lt;
#pragma unroll
        for (int dt = 0; dt < 2; ++dt)
#pragma unroll
            for (int r = 0; r < 16; ++r) ex[((qbw * 2 + dt) * 16 + r) * 64 + lane] = o1[0][dt][r] * f;
    }
    __syncthreads();
    if (sub == 0) {
        const float f = 1.f / lt;
        float ss = 0.f;
#pragma unroll
        for (int dt = 0; dt < 2; ++dt)
#pragma unroll
            for (int r = 0; r < 16; ++r) { const float v = o1[0][dt][r] * f - ex[((qbw * 2 + dt) * 16 + r) * 64 + lane]; o1[0][dt][r] = v; ss += v * v; }
        ss += xor32f(ss, lane);
        const float rstd = rsqrtf(ss * (1.f / 64.f) + kEps) * post;
        const float* sg = p.sub_g + layer * 64;
#pragma unroll
        for (int dt = 0; dt < 2; ++dt)
#pragma unroll
            for (int r = 0; r < 16; ++r) { const int d = dt * 32 + (r & 3) + 8 * (r >> 2) + 4 * hh; o1[0][dt][r] *= rstd * sg[d]; }
        write_o(o1[0], obuf, Tb + tq, 256 + hd * 64, hh);
    }
}

DEV void mla_item(const Params& p, int b, int hd, int qc, char* smem) {
    int tid = threadIdx.x; asm volatile("" : "+v"(tid));
    const int lane = tid & 63, w = tid >> 6, ql = lane & 31, hh = lane >> 5;
    char* ws = p.ws;
    const bf16_t* cols = (const bf16_t*)(ws + OFF_COLS);
    const bf16_t* VT = (const bf16_t*)(ws + OFF_VT);
    const bf16_t* qmla = (const bf16_t*)(ws + OFF_QMLA);
    const bf16_t* kvmla = (const bf16_t*)(ws + OFF_KVMLA);
    bf16_t* obuf = (bf16_t*)(ws + OFF_O);
    const int t0w = qc * 128 + w * 32, tq = t0w + ql;
    const size_t Tb = (size_t)b * kS;
    const bf16_t* qrow = qmla + (Tb + tq) * 384 + hd * 96;
    bf16x8 qf[6];
#pragma unroll
    for (int ks = 0; ks < 6; ++ks) qf[ks] = *(const bf16x8*)(qrow + ks * 16 + hh * 8);
    const float scl = 0.10206207261596575f * kLog2e;
    f32x16 o1[1][2]; o1[0][0] = zero16(); o1[0][1] = zero16();
    float m1[1] = {kNeg}, l1[1] = {0.f};
    auto skipf = [&](int kt) __attribute__((always_inline)) { return kt * 64 > t0w + 31; };
    attn_stream<96, 6, 1>(RangeIter{0, 2 * qc + 2}, LdMlaK{kvmla + Tb * 512 + hd * 128, cols + Tb * LDC + 1856}, LdVT{VT + (size_t)(b * 12 + 8 + hd) * 64 * 2048}, MaskCausal{}, skipf, qf, o1, m1, l1, scl, tq, __builtin_amdgcn_readfirstlane(t0w), smem, tid);
    const float inv = 1.f / (l1[0] + xor32f(l1[0], lane));
#pragma unroll
    for (int dt = 0; dt < 2; ++dt)
#pragma unroll
        for (int r = 0; r < 16; ++r) o1[0][dt][r] *= inv;
    write_o(o1[0], obuf, Tb + tq, 512 + hd * 64, hh);
}

DEV void swa_item(const Params& p, int layer, int b, int g, int q64, char* smem) {
    int tid = threadIdx.x; asm volatile("" : "+v"(tid));
    const int lane = tid & 63, w = tid >> 6, ql = lane & 31, hh = lane >> 5;
    char* ws = p.ws;
    const bf16_t* cols = (const bf16_t*)(ws + OFF_COLS);
    const bf16_t* VT = (const bf16_t*)(ws + OFF_VT);
    bf16_t* obuf = (bf16_t*)(ws + OFF_O);
    const int head = g * 2 + (w & 1);
    const int t0w = q64 * 64 + (w >> 1) * 32, tq = t0w + ql;
    const size_t Tb = (size_t)b * kS;
    const bf16_t* qrow = cols + (Tb + tq) * LDC + 1920 + head * 64;
    bf16x8 qf[4];
#pragma unroll
    for (int ks = 0; ks < 4; ++ks) qf[ks] = *(const bf16x8*)(qrow + ks * 16 + hh * 8);
    const float scl = 0.125f * kLog2e;
    f32x16 o1[1][2]; o1[0][0] = zero16(); o1[0][1] = zero16();
    float m1[1] = {p.sinks[layer * 4 + head] * 8.f}, l1[1] = {hh == 0 ? 1.f : 0.f};
    auto skipf = [&](int kt) __attribute__((always_inline)) { return (kt * 64 > t0w + 31) || (kt * 64 + 63 < t0w - 127); };
    const int lo = q64 >= 2 ? q64 - 2 : 0;
    attn_stream<64, 4, 1>(RangeIter{lo, q64 + 1}, LdRow{cols + Tb * LDC + 2176 + g * 64, LDC}, LdVT{VT + (size_t)(b * 12 + 6 + g) * 64 * 2048}, MaskWin<128>{}, skipf, qf, o1, m1, l1, scl, tq, __builtin_amdgcn_readfirstlane(t0w), smem, tid);
    const float inv = 1.f / (l1[0] + xor32f(l1[0], lane));
#pragma unroll
    for (int dt = 0; dt < 2; ++dt)
#pragma unroll
        for (int r = 0; r < 16; ++r) o1[0][dt][r] *= inv;
    write_o(o1[0], obuf, Tb + tq, 768 + head * 64, hh);
}

DEV void phase_attn(const Params& p, int layer, char* smem, int rep = 0) {
    unsigned* ctr = (unsigned*)(p.ws + OFF_CTRL) + 64 + layer * 16 + rep;
    volatile int* slot = (volatile int*)(smem + SM_SEL) + 48;
    for (;;) {
        __syncthreads();
        if (ltid() == 0) *slot = (int)atomicAdd(ctr, 1u);
        __syncthreads();
        const int idx = __builtin_amdgcn_readfirstlane(*slot);
        if (idx >= 2560) break;
        const int level = 15 - idx / 160, r = idx % 160;
        if (r < 64) { const int b = (r & 31) >> 2; diff_item(p, layer, b, r & 3, level * 2 + (1 - (r >> 5)), smem); }
        else if (r < 96) { const int k = r - 64; mla_item(p, k >> 2, k & 3, level, smem); }
        else if (r < 128) { const int k = r - 96; nsa_item(p, k >> 2, level * 4 + (3 - (k & 3)), smem); }
        else { const int k = r - 128; swa_item(p, layer, k >> 2, (k >> 1) & 1, level * 2 + (k & 1), smem); }
    }
}

#define XB_TMO      128
#define XB_XCNT(j)  (256  + 64 * (j))
#define XB_XSUB(j)  (1280 + 64 * (j))
#define XB_XGEN(j)  (2304 + 64 * (j))
#define XB_TOP      3328
#define XB_TOPGEN   3392
#define XB_SPIN_CAP (1u << 22)
DEV unsigned xb_ld(unsigned* p) { return __hip_atomic_load(p, __ATOMIC_RELAXED, __HIP_MEMORY_SCOPE_AGENT); }
DEV unsigned xb_add(unsigned* p, unsigned v) { return __hip_atomic_fetch_add(p, v, __ATOMIC_RELAXED, __HIP_MEMORY_SCOPE_AGENT); }
DEV unsigned xb_xcc_id() { return (unsigned)__builtin_amdgcn_s_getreg((3 << 11) | 20) & 0xFu; }
#define XB_SPIN(cond, bar) do { unsigned _sp = 0; while (cond) { __builtin_amdgcn_s_sleep(1); \
    if ((++_sp & 255u) == 0u) { if (xb_ld(&(bar)[XB_TMO])) break; if (_sp > XB_SPIN_CAP) { atomicAdd(&(bar)[XB_TMO], 1u); break; } } } } while (0)
struct XcdBarrier { unsigned* bar; unsigned x; volatile LAS unsigned* st; };
DEV XcdBarrier xcd_barrier_post(unsigned* bar, volatile LAS unsigned* st) {
    XcdBarrier b; b.bar = bar; b.x = xb_xcc_id(); b.st = st;
    if (threadIdx.x == 0) st[2] = xb_add(&bar[XB_XCNT(b.x)], 1u);
    return b;
}
DEV void xcd_barrier_complete(unsigned* bar, unsigned x, unsigned& nloc, unsigned& nx) {
    const unsigned G = gridDim.x * gridDim.y * gridDim.z;
    unsigned sum, cnt, mine, sp = 0u;
    for (;;) {
        sum = 0u; cnt = 0u; mine = 0u;
#pragma unroll
        for (unsigned j = 0; j < 16; ++j) { const unsigned c = xb_ld(&bar[XB_XCNT(j)]); sum += c; cnt += (c > 0u) ? 1u : 0u; mine = (j == x) ? c : mine; }
        if (sum == G) break;
        __builtin_amdgcn_s_sleep(1);
        if ((++sp & 255u) == 0u) { if (xb_ld(&bar[XB_TMO])) break; if (sp > XB_SPIN_CAP) { atomicAdd(&bar[XB_TMO], 1u); break; } }
    }
    nloc = mine > 0u ? mine : 1u; nx = cnt > 0u ? cnt : 1u;
}
DEV void xcd_barrier(const XcdBarrier& b) {
    asm volatile("s_waitcnt vmcnt(0)" ::: "memory");
    __syncthreads();
    if (threadIdx.x == 0) {
        unsigned* bar = b.bar;
        asm volatile("" : "+v"(bar));
        __builtin_amdgcn_s_waitcnt(0);
        unsigned nloc = b.st[0], nx = b.st[1];
        if (nloc == 0u) { xcd_barrier_complete(bar, b.x, nloc, nx); b.st[0] = nloc; b.st[1] = nx; }
        const unsigned old = xb_add(&bar[XB_XSUB(b.x)], 1u);
        const unsigned gen = old / nloc;
        if (old + 1u == (gen + 1u) * nloc) {
            __builtin_amdgcn_fence(__ATOMIC_RELEASE, "agent");
            asm volatile("s_waitcnt vmcnt(0)" ::: "memory");
            const unsigned og = xb_add(&bar[XB_TOP], 1u);
            const unsigned tg = og / nx;
            if (og + 1u == (tg + 1u) * nx) xb_add(&bar[XB_TOPGEN], 1u);
            else XB_SPIN(xb_ld(&bar[XB_TOPGEN]) == tg, bar);
            __builtin_amdgcn_fence(__ATOMIC_ACQUIRE, "agent");
            xb_add(&bar[XB_XGEN(b.x)], 1u);
            asm volatile("s_waitcnt vmcnt(0)" ::: "memory");
        } else {
            XB_SPIN(xb_ld(&bar[XB_XGEN(b.x)]) == gen, bar);
            __builtin_amdgcn_fence(__ATOMIC_ACQUIRE, "agent");
            asm volatile("s_waitcnt vmcnt(0)" ::: "memory");
        }
    }
    __syncthreads();
}

DEV unsigned fkey(float f) { const unsigned u = __float_as_uint(f); return (u & 0x80000000u) ? ~u : (u | 0x80000000u); }
DEV float funkey(unsigned k) { return __uint_as_float((k & 0x80000000u) ? (k & 0x7fffffffu) : ~k); }
DEV void ins16(unsigned (&L)[16], unsigned x) {
#pragma unroll
    for (int i = 0; i < 16; ++i) { const unsigned hi = L[i] > x ? L[i] : x; x = L[i] > x ? x : L[i]; L[i] = hi; }
}
DEV void phase_topk(const Params& p, char* smem) {
    const int tid = ltid();
    const float* S1 = (const float*)(p.ws + OFF_S1);
    const float* S2 = (const float*)(p.ws + OFF_S2);
    int* eid = (int*)(p.ws + OFF_EID);
    float* gate = (float*)(p.ws + OFF_GATE);
    unsigned char* ib = (unsigned char*)smem + tid * 32;
    for (int blk = blockIdx.x; blk < kT * 8 / 256; blk += gridDim.x) {
        const size_t row = (size_t)blk * 256 + tid;
        unsigned L1[16], L2[16];
#pragma unroll
        for (int i = 0; i < 16; ++i) { L1[i] = 0u; L2[i] = 0u; }
#pragma unroll 4
        for (int k = 0; k < 128; ++k) {
            const float a = S1[(size_t)k * (kT * 8) + row], b = S2[(size_t)k * (kT * 8) + row];
            ins16(L1, (fkey(a) & ~127u) | (unsigned)(127 - k));
            ins16(L2, (fkey(b) & ~127u) | (unsigned)(127 - k));
        }
        float v1[16], v2[16];
        __syncthreads();
#pragma unroll
        for (int i = 0; i < 16; ++i) {
            v1[i] = funkey(L1[i] & ~127u); v2[i] = funkey(L2[i] & ~127u);
            ib[i] = (unsigned char)(127u - (L1[i] & 127u)); ib[16 + i] = (unsigned char)(127u - (L2[i] & 127u));
        }
        unsigned C[16];
#pragma unroll
        for (int i = 0; i < 16; ++i) C[i] = 0u;
#pragma unroll
        for (int a = 0; a < 16; ++a)
#pragma unroll
            for (int b = 0; b < 16; ++b)
                if ((a + 1) * (b + 1) <= 16) ins16(C, (fkey(v1[a] + v2[b]) & ~255u) | (unsigned)(255 - (a * 16 + b)));
        float ts[16]; float sum = 0.f;
        const float tmax = funkey(C[0] & ~255u);
#pragma unroll
        for (int i = 0; i < 16; ++i) { ts[i] = __expf(funkey(C[i] & ~255u) - tmax); sum += ts[i]; }
        const float inv = 1.f / sum;
        int ev[16];
#pragma unroll
        for (int i = 0; i < 16; ++i) { const unsigned ci = 255u - (C[i] & 255u); ev[i] = (int)ib[ci >> 4] * 128 + (int)ib[16 + (ci & 15u)]; }
#pragma unroll
        for (int i = 0; i < 4; ++i) {
            *(int4*)(eid + row * 16 + 4 * i) = make_int4(ev[4 * i], ev[4 * i + 1], ev[4 * i + 2], ev[4 * i + 3]);
            *(float4*)(gate + row * 16 + 4 * i) = make_float4(ts[4 * i] * inv, ts[4 * i + 1] * inv, ts[4 * i + 2] * inv, ts[4 * i + 3] * inv);
        }
    }
}

DEV float row_sum_dpp(float v) {
    v += __int_as_float(__builtin_amdgcn_update_dpp(0, __float_as_int(v), 0xB1, 0xF, 0xF, true));
    v += __int_as_float(__builtin_amdgcn_update_dpp(0, __float_as_int(v), 0x4E, 0xF, 0xF, true));
    v += __int_as_float(__builtin_amdgcn_update_dpp(0, __float_as_int(v), 0x141, 0xF, 0xF, true));
    v += __int_as_float(__builtin_amdgcn_update_dpp(0, __float_as_int(v), 0x140, 0xF, 0xF, true));
    return v;
}
DEV float wave_sum_dpp(float v) {
    v = row_sum_dpp(v);
    const float r0 = __int_as_float(__builtin_amdgcn_readlane(__float_as_int(v), 0)), r1 = __int_as_float(__builtin_amdgcn_readlane(__float_as_int(v), 16));
    const float r2 = __int_as_float(__builtin_amdgcn_readlane(__float_as_int(v), 32)), r3 = __int_as_float(__builtin_amdgcn_readlane(__float_as_int(v), 48));
    return (r0 + r1) + (r2 + r3);
}
typedef float f32x2 __attribute__((ext_vector_type(2)));
typedef float f32x4 __attribute__((ext_vector_type(4)));

struct SliceMap { int virt, nx, nloc, rank; };
DEV SliceMap slice_map(const Params& p, char* smem) {
    unsigned* bar = (unsigned*)p.ws;
    const unsigned x = xb_xcc_id();
    int virt = 0, nx = 0, nloc = 1;
#pragma unroll
    for (unsigned j = 0; j < 16; ++j) {
        const unsigned c = xb_ld(&bar[XB_XCNT(j)]);
        if (c > 0u) { if (j < x) ++virt; ++nx; }
        if (j == x) nloc = (int)c;
    }
    SliceMap m;
    m.virt = __builtin_amdgcn_readfirstlane(virt); m.nx = __builtin_amdgcn_readfirstlane(nx > 0 ? nx : 1); m.nloc = __builtin_amdgcn_readfirstlane(nloc > 0 ? nloc : 1);
    m.rank = __builtin_amdgcn_readfirstlane((int)((volatile LAS unsigned*)(smem + SM_CTRL))[2]);
    return m;
}

typedef _Float16 half2_t __attribute__((ext_vector_type(2)));
DEV void phase_peer_u(const Params& p, int layer, char* smem, int rep = 0) {
    const int tid = ltid(), lane = tid & 63, w = tid >> 6, l8 = lane & 7, grp = lane >> 3;
    char* ws = p.ws;
    const SliceMap sm = slice_map(p, smem);
    const bf16_t* h = (const bf16_t*)(ws + OFF_H);
    const int* eid = (const int*)(ws + OFF_EID);
    float* part = (float*)(ws + OFF_S1) + (rep ? (size_t)8 * kT * 128 : 0);
    int* ids_l = (int*)(smem + w * 9216);
    const int nk = sm.rank < 512 ? (512 - sm.rank + sm.nloc - 1) / sm.nloc : 0;
    for (int s = sm.virt; s < 8; s += sm.nx) {
        if (nk == 0) break;
        const unsigned char* U = (const unsigned char*)(ws + OFF_PU) + (((size_t)layer * 8 + s) * 16384 << 7) + l8 * 16;
        uint4 ri0, ri1, ri2, ri3, rh0, rh1;
        auto load_oct = [&](int k) __attribute__((always_inline)) {
            const size_t o = (size_t)(sm.rank + k * sm.nloc) * 4 + w;
            const uint4* ip = (const uint4*)(eid + o * 1024) + lane;
            ri0 = ip[0]; ri1 = ip[64]; ri2 = ip[128]; ri3 = ip[192];
            const bf16_t* hp = h + (o * 8 + grp) * 1024 + s * 128 + l8 * 16;
            rh0 = *(const uint4*)hp; rh1 = *(const uint4*)(hp + 8);
        };
        half2_t hh[8];
        auto store_oct = [&]() __attribute__((always_inline)) {
            uint4* il = (uint4*)ids_l + lane;
            il[0] = ri0; il[64] = ri1; il[128] = ri2; il[192] = ri3;
            const unsigned hu[8] = {rh0.x, rh0.y, rh0.z, rh0.w, rh1.x, rh1.y, rh1.z, rh1.w};
#pragma unroll
            for (int i = 0; i < 8; ++i) hh[i] = (half2_t){(_Float16)lo16(hu[i]), (_Float16)hi16(hu[i])};
        };
        load_oct(0); store_oct();
#pragma unroll 1
        for (int k = 0; k < nk; ++k) {
            if (k + 1 < nk) load_oct(k + 1);
            const size_t o = (size_t)(sm.rank + k * sm.nloc) * 4 + w;
            float* pp = part + ((size_t)s * kT + o * 8 + grp) * 128 + l8;
            uint4 va[8], vb[8];
            auto issue = [&](uint4 (&v)[8], int c) __attribute__((always_inline)) {
                const int4 i0 = *(const int4*)(ids_l + grp * 128 + c * 8), i1 = *(const int4*)(ids_l + grp * 128 + c * 8 + 4);
                const int e[8] = {i0.x, i0.y, i0.z, i0.w, i1.x, i1.y, i1.z, i1.w};
#pragma unroll
                for (int j = 0; j < 8; ++j) v[j] = *(const uint4*)(U + ((size_t)e[j] << 7));
            };
            auto compute = [&](const uint4 (&v)[8], int c) __attribute__((always_inline)) {
                float res = 0.f;
#pragma unroll
                for (int j = 0; j < 8; ++j) {
                    const unsigned d[4] = {v[j].x, v[j].y, v[j].z, v[j].w};
                    float acc = 0.f;
#pragma unroll
                    for (int q = 0; q < 4; ++q) {
                        const half2_t lo = __builtin_amdgcn_cvt_scalef32_pk_f16_fp8(d[q], 1.0f, false);
                        const half2_t hi = __builtin_amdgcn_cvt_scalef32_pk_f16_fp8(d[q], 1.0f, true);
                        acc = __builtin_amdgcn_fdot2(lo, hh[2 * q], acc, false);
                        acc = __builtin_amdgcn_fdot2(hi, hh[2 * q + 1], acc, false);
                    }
                    acc += __int_as_float(__builtin_amdgcn_update_dpp(0, __float_as_int(acc), 0xB1, 0xF, 0xF, true));
                    acc += __int_as_float(__builtin_amdgcn_update_dpp(0, __float_as_int(acc), 0x4E, 0xF, 0xF, true));
                    acc += __int_as_float(__builtin_amdgcn_update_dpp(0, __float_as_int(acc), 0x141, 0xF, 0xF, true));
                    res = (l8 == j) ? acc : res;
                    __builtin_amdgcn_sched_barrier(0);
                }
                pp[c * 8] = res;
            };
            issue(va, 0);
#pragma unroll
            for (int c = 0; c < 16; c += 2) {
                issue(vb, c + 1);
                __builtin_amdgcn_sched_barrier(0);
                compute(va, c);
                __builtin_amdgcn_sched_barrier(0);
                if (c + 2 < 16) issue(va, c + 2);
                __builtin_amdgcn_sched_barrier(0);
                compute(vb, c + 1);
                __builtin_amdgcn_sched_barrier(0);
            }
            if (k + 1 < nk) store_oct();
        }
    }
}

DEV void phase_peer_comb(const Params& p, int rep = 0) {
    const int tid = ltid();
    const float* part = (const float*)(p.ws + OFF_S1);
    float* gate = (float*)(p.ws + OFF_GATE);
    for (size_t i = (size_t)blockIdx.x * 256 + tid; i < (size_t)kT * 128 / 4; i += (size_t)gridDim.x * 256) {
        float4 a = *(const float4*)(part + i * 4);
#pragma unroll
        for (int x = 1; x < 8; ++x) { const float4 b = *(const float4*)(part + (size_t)x * kT * 128 + i * 4); a.x += b.x; a.y += b.y; a.z += b.z; a.w += b.w; }
        const float4 g = *(const float4*)(gate + i * 4);
        float4 o;
        o.x = g.x * gelu_tanh(a.x * (1.f / kScaleU)); o.y = g.y * gelu_tanh(a.y * (1.f / kScaleU));
        o.z = g.z * gelu_tanh(a.z * (1.f / kScaleU)); o.w = g.w * gelu_tanh(a.w * (1.f / kScaleU));
        if (rep == 0) *(float4*)(gate + i * 4) = o;
    }
}

DEV void phase_peer_v(const Params& p, int layer, char* smem, int rep = 0) {
    const int tid = ltid(), lane = tid & 63, w = tid >> 6, l8 = lane & 7, grp = lane >> 3;
    char* ws = p.ws;
    const SliceMap sm = slice_map(p, smem);
    float* xres = (float*)(ws + OFF_XRES);
    const int* eid = (const int*)(ws + OFF_EID);
    const float* wbuf = (const float*)(ws + OFF_GATE);
    const float* mod = (const float*)(ws + OFF_MOD);
    int* ids_l = (int*)(smem + w * 9216);
    float* w_l = (float*)(smem + w * 9216 + 4096);
    const int nk = sm.rank < 512 ? (512 - sm.rank + sm.nloc - 1) / sm.nloc : 0;
    for (int s = sm.virt; s < 8; s += sm.nx) {
        if (nk == 0) break;
        const unsigned char* V = (const unsigned char*)(ws + OFF_PV) + (((size_t)layer * 8 + s) * 16384 << 7) + l8 * 16;
        uint4 ri0, ri1, ri2, ri3, rw0, rw1, rw2, rw3;
        auto load_oct = [&](int k) __attribute__((always_inline)) {
            const size_t o = (size_t)(sm.rank + k * sm.nloc) * 4 + w;
            const uint4* ip = (const uint4*)(eid + o * 1024) + lane;
            const uint4* wp = (const uint4*)(wbuf + o * 1024) + lane;
            ri0 = ip[0]; ri1 = ip[64]; ri2 = ip[128]; ri3 = ip[192];
            rw0 = wp[0]; rw1 = wp[64]; rw2 = wp[128]; rw3 = wp[192];
        };
        auto store_oct = [&]() __attribute__((always_inline)) {
            uint4* il = (uint4*)ids_l + lane; uint4* wl = (uint4*)w_l + lane;
            il[0] = ri0; il[64] = ri1; il[128] = ri2; il[192] = ri3;
            wl[0] = rw0; wl[64] = rw1; wl[128] = rw2; wl[192] = rw3;
        };
        load_oct(0); store_oct();
#pragma unroll 1
        for (int k = 0; k < nk; ++k) {
            if (k + 1 < nk) load_oct(k + 1);
            const size_t o = (size_t)(sm.rank + k * sm.nloc) * 4 + w;
            const size_t t = o * 8 + grp;
            const int b = (int)(t >> 11);
            float* xp = xres + t * 1024 + s * 128 + l8 * 16;
            const float* g2 = mod + (size_t)(layer * 8 + b) * 6144 + 5120 + s * 128 + l8 * 16;
            float4 xa[4];
#pragma unroll
            for (int c = 0; c < 4; ++c) xa[c] = *(const float4*)(xp + c * 4);
            half2_t out[8];
#pragma unroll
            for (int j = 0; j < 8; ++j) out[j] = (half2_t){(_Float16)0.f, (_Float16)0.f};
            uint4 va[8], vb[8];
            auto issue = [&](uint4 (&v)[8], int c) __attribute__((always_inline)) {
                const int4 i0 = *(const int4*)(ids_l + grp * 128 + c * 8), i1 = *(const int4*)(ids_l + grp * 128 + c * 8 + 4);
                const int e[8] = {i0.x, i0.y, i0.z, i0.w, i1.x, i1.y, i1.z, i1.w};
#pragma unroll
                for (int j = 0; j < 8; ++j) v[j] = *(const uint4*)(V + ((size_t)e[j] << 7));
            };
            auto compute = [&](const uint4 (&v)[8], int c) __attribute__((always_inline)) {
                const float4 w0 = *(const float4*)(w_l + grp * 128 + c * 8), w1 = *(const float4*)(w_l + grp * 128 + c * 8 + 4);
                const float wf[8] = {w0.x, w0.y, w0.z, w0.w, w1.x, w1.y, w1.z, w1.w};
#pragma unroll
                for (int j = 0; j < 8; ++j) {
                    const _Float16 wh = (_Float16)wf[j];
                    const half2_t ww = {wh, wh};
                    const unsigned d[4] = {v[j].x, v[j].y, v[j].z, v[j].w};
#pragma unroll
                    for (int q = 0; q < 4; ++q) {
                        const half2_t lo = __builtin_amdgcn_cvt_scalef32_pk_f16_fp8(d[q], 1.0f, false);
                        const half2_t hi = __builtin_amdgcn_cvt_scalef32_pk_f16_fp8(d[q], 1.0f, true);
                        out[2 * q] = __builtin_elementwise_fma(ww, lo, out[2 * q]);
                        out[2 * q + 1] = __builtin_elementwise_fma(ww, hi, out[2 * q + 1]);
                    }
                    __builtin_amdgcn_sched_barrier(0);
                }
            };
            issue(va, 0);
#pragma unroll
            for (int c = 0; c < 16; c += 2) {
                issue(vb, c + 1);
                __builtin_amdgcn_sched_barrier(0);
                compute(va, c);
                __builtin_amdgcn_sched_barrier(0);
                if (c + 2 < 16) issue(va, c + 2);
                __builtin_amdgcn_sched_barrier(0);
                compute(vb, c + 1);
                __builtin_amdgcn_sched_barrier(0);
            }
            if (rep == 0 || (float)out[0].x == 12345.678f) {
#pragma unroll
                for (int c = 0; c < 4; ++c) {
                    const float4 g4 = *(const float4*)(g2 + c * 4);
                    xa[c].x += g4.x * (float)out[2 * c].x * (1.f / kScaleV); xa[c].y += g4.y * (float)out[2 * c].y * (1.f / kScaleV);
                    xa[c].z += g4.z * (float)out[2 * c + 1].x * (1.f / kScaleV); xa[c].w += g4.w * (float)out[2 * c + 1].y * (1.f / kScaleV);
                    *(float4*)(xp + c * 4) = xa[c];
                }
            }
            if (k + 1 < nk) store_oct();
        }
    }
}

DEV void phase_final(const Params& p) {
    const int tid = ltid(), lane = tid & 63, w = tid >> 6;
    const float* xs = (const float*)(p.ws + OFF_XRES);
    for (int q = blockIdx.x; q < kT / 4; q += gridDim.x) {
        const int t = q * 4 + w;
        const float* xr = xs + (size_t)t * 1024;
        float4 v[4]; float ss = 0.f;
#pragma unroll
        for (int i = 0; i < 4; ++i) { v[i] = *(const float4*)(xr + i * 256 + lane * 4); ss += v[i].x * v[i].x + v[i].y * v[i].y + v[i].z * v[i].z + v[i].w * v[i].w; }
        ss = wave_sum(ss);
        const float rstd = rsqrtf(ss * (1.f / 1024.f) + kEps);
#pragma unroll
        for (int i = 0; i < 4; ++i) {
            const int col = i * 256 + lane * 4;
            const float4 g4 = *(const float4*)(p.final_g + col);
            *(float4*)(p.out + (size_t)t * 1024 + col) = make_float4(v[i].x * rstd * g4.x, v[i].y * rstd * g4.y, v[i].z * rstd * g4.z, v[i].w * rstd * g4.w);
        }
    }
}

DEV void phase_gemm_in(const Params& p, int layer, char* smem) {
    char* ws = p.ws;
    EpiBf16 epi{(bf16_t*)(ws + OFF_COLS), LDC, nullptr, nullptr, LDC};
    gemm_phase((const bf16_t*)(ws + OFF_H), 1024, (const bf16_t*)(ws + OFF_WIN) + (size_t)layer * 2432 * 1024, 1024, 1024, kT / 128, LDC / 128, smem, epi);
}
DEV void phase_gemm_mid(const Params& p, int layer, char* smem) {
    char* ws = p.ws;
    const float* misc = (const float*)(ws + OFF_MISC);
    const float* rstd = (const float*)(ws + OFF_RSTD);
    const bf16_t* cols = (const bf16_t*)(ws + OFF_COLS);
    for (int tile = blockIdx.x; tile < 16 + 384 + 512; tile += gridDim.x) {
        if (tile < 8) {
            EpiBf16 epi{(bf16_t*)(ws + OFF_KCMP), 64, nullptr, misc + (layer * 2 + 0) * 64, 64};
            gemm_tile((const bf16_t*)(ws + OFF_KC), 1024, (const bf16_t*)(ws + OFF_WCK) + (size_t)layer * 128 * 2048, 2048, 2048, tile * 128, 0, smem, epi);
        } else if (tile < 16) {
            EpiBf16 epi{(bf16_t*)(ws + OFF_KCMP) + 1024 * 64, 64, nullptr, misc + (layer * 2 + 1) * 64, 64};
            gemm_tile((const bf16_t*)(ws + OFF_VC), 1024, (const bf16_t*)(ws + OFF_WCV) + (size_t)layer * 128 * 2048, 2048, 2048, (tile - 8) * 128, 0, smem, epi);
        } else if (tile < 16 + 384) {
            const int tt = tile - 16;
            EpiBf16 epi{(bf16_t*)(ws + OFF_QMLA), 384, rstd, nullptr, 384};
            gemm_tile(cols + 1472, LDC, (const bf16_t*)(ws + OFF_WUQ) + (size_t)layer * 384 * 256, 256, 256, (tt / 3) * 128, (tt % 3) * 128, smem, epi);
        } else {
            const int tt = tile - 16 - 384;
            EpiBf16 epi{(bf16_t*)(ws + OFF_KVMLA), 512, rstd + kT, nullptr, 512};
            gemm_tile(cols + 1728, LDC, (const bf16_t*)(ws + OFF_WUKV) + (size_t)layer * 512 * 128, 128, 128, (tt / 4) * 128, (tt % 4) * 128, smem, epi);
        }
    }
}
DEV void phase_gemm_out(const Params& p, int layer, char* smem) {
    char* ws = p.ws;
    EpiRes epi{layer == 0 ? p.x : (const float*)(ws + OFF_XRES), (float*)(ws + OFF_XRES), (const float*)(ws + OFF_MOD) + (size_t)layer * 8 * 6144 + 2048};
    gemm_phase((const bf16_t*)(ws + OFF_O), 1024, (const bf16_t*)(ws + OFF_WOUT) + (size_t)layer * 1024 * 1024, 1024, 1024, kT / 128, 8, smem, epi);
}
DEV void phase_gemm_wq(const Params& p, int layer, char* smem) {
    char* ws = p.ws;
    EpiBf16 epi{(bf16_t*)(ws + OFF_QP), 2048, nullptr, nullptr, 2048};
    gemm_phase((const bf16_t*)(ws + OFF_H), 1024, (const bf16_t*)(ws + OFF_WQ) + (size_t)layer * 2048 * 1024, 1024, 1024, kT / 128, 16, smem, epi);
}
DEV void phase_scores(const Params& p, int layer, char* smem) {
    char* ws = p.ws;
    for (int tile = blockIdx.x; tile < 2048; tile += gridDim.x) {
        const int c = tile >> 10, nt = tile & 1023;
        EpiF32 epi{(float*)(ws + (c ? OFF_S2 : OFF_S1)), kT * 8};
        gemm_tile((const bf16_t*)(ws + OFF_SUBK) + (size_t)(layer * 2 + c) * 16384, 128, (const bf16_t*)(ws + OFF_QP) + c * 128, 256, 128, 0, nt * 128, smem, epi);
    }
}

constexpr int NPHASE = 16;
DEV void run_phase(const Params& p, int ph, int layer, char* smem, int rep = 0) {
    switch (ph) {
        case 0: phase_prologue(p, smem); break;
        case 1: phase_norm(p, layer, 0); break;
        case 2: phase_gemm_in(p, layer, smem); break;
        case 3: phase_layout1(p, smem); break;
        case 4: phase_gemm_mid(p, layer, smem); break;
        case 5: phase_layout2(p, smem); break;
        case 6: phase_attn(p, layer, smem, rep); break;
        case 7: phase_gemm_out(p, layer, smem); break;
        case 8: phase_norm(p, layer, 1); break;
        case 9: phase_gemm_wq(p, layer, smem); break;
        case 10: phase_scores(p, layer, smem); break;
        case 11: phase_topk(p, smem); break;
        case 12: phase_peer_u(p, layer, smem, rep); break;
        case 13: phase_peer_comb(p, rep); break;
        case 14: phase_peer_v(p, layer, smem, rep); break;
        case 15: if (layer == 0) phase_norm(p, 1, 0); else phase_final(p); break;
        default: break;
    }
}

#if !FUSED
template <int PH>
__global__ void __launch_bounds__(256, 2) k_phase(Params p, int layer) {
    __shared__ __attribute__((aligned(16))) char smem[SM_TOTAL];
    run_phase(p, PH, layer, smem);
}
template <int PH> static void launch_phase(const Params& p, int layer, hipStream_t stream) { k_phase<PH><<<512, 256, 0, stream>>>(p, layer); }
static void launch_ph(int ph, const Params& p, int layer, hipStream_t stream) {
    switch (ph) {
        case 0: launch_phase<0>(p, layer, stream); break;
        case 1: launch_phase<1>(p, layer, stream); break;
        case 2: launch_phase<2>(p, layer, stream); break;
        case 3: launch_phase<3>(p, layer, stream); break;
        case 4: launch_phase<4>(p, layer, stream); break;
        case 5: launch_phase<5>(p, layer, stream); break;
        case 6: launch_phase<6>(p, layer, stream); break;
        case 7: launch_phase<7>(p, layer, stream); break;
        case 8: launch_phase<8>(p, layer, stream); break;
        case 9: launch_phase<9>(p, layer, stream); break;
        case 10: launch_phase<10>(p, layer, stream); break;
        case 11: launch_phase<11>(p, layer, stream); break;
        case 12: launch_phase<12>(p, layer, stream); break;
    }
}
#else
#if TS_A >= 0
#define TSTAMP(I) if (blockIdx.x == 0 && threadIdx.x == 0) ((unsigned long long*)(p.ws + 32768))[I] = __builtin_amdgcn_s_memrealtime();
#else
#define TSTAMP(I)
#endif
__global__ void __launch_bounds__(256, 2) k_mega(Params p) {
    extern __shared__ __attribute__((aligned(1024))) char smem[];
    cg::grid_group grid = cg::this_grid();
    volatile LAS unsigned* st = (volatile LAS unsigned*)(smem + SM_CTRL);
    if (threadIdx.x == 0) { st[0] = 0u; st[1] = 0u; st[2] = 0u; }
    __syncthreads();
    const XcdBarrier xb = xcd_barrier_post((unsigned*)p.ws, st);
    TSTAMP(0)
    run_phase(p, 0, 0, smem);
    if (p.out == nullptr) grid.sync();
    xcd_barrier(xb);
    TSTAMP(1)
    run_phase(p, 1, 0, smem);
    xcd_barrier(xb);
    TSTAMP(2)
#define STEP(PH, L) { run_phase(p, PH, L, smem, 0); xcd_barrier(xb); TSTAMP(2 + (L) * 16 + (PH)) }
#define LAYER(L) STEP(2, L) STEP(3, L) STEP(4, L) STEP(5, L) STEP(6, L) STEP(7, L) STEP(8, L) STEP(9, L) STEP(10, L) STEP(11, L) STEP(12, L) STEP(13, L) STEP(14, L)
    LAYER(0)
    STEP(15, 0)
    LAYER(1)
    run_phase(p, 15, 1, smem);
#if TS_A >= 0
    TSTAMP(2 + 16 + 15)
    __syncthreads();
    if (blockIdx.x == 0 && threadIdx.x == 0) {
        const unsigned long long* ts = (const unsigned long long*)(p.ws + 32768);
        p.out[0] += (float)(ts[TS_B] - ts[TS_A]) * 0.001f;
    }
#endif
}
#endif

extern "C" void kernel_launch(void* const* d_in, const int* in_sizes, int n_in, void* d_out, int out_size, void* d_ws, size_t ws_size, hipStream_t stream) {
    Params p{};
    const float** pp = (const float**)&p;
    for (int i = 0; i < 28; ++i) pp[i] = (const float*)d_in[i];
    p.out = (float*)d_out;
    p.ws = (char*)d_ws;
    if (ws_size < OFF_END) fprintf(stderr, "workspace too small: %zu < %zu\n", ws_size, (size_t)OFF_END);
    (void)hipMemsetAsync(d_ws, 0, 65536, stream);
#if !FUSED
    launch_ph(0, p, 0, stream);
    launch_ph(1, p, 0, stream);
    for (int l = 0; l < 2; ++l)
        for (int ph = 2; ph < NPHASE; ++ph) launch_ph(ph, p, l, stream);
#else
    static int grid_blocks = 0;
    if (!grid_blocks) {
        int dev = 0, cus = 0, per_cu = 0;
        (void)hipGetDevice(&dev);
        (void)hipDeviceGetAttribute(&cus, hipDeviceAttributeMultiprocessorCount, dev);
        (void)hipFuncSetAttribute((const void*)k_mega, hipFuncAttributeMaxDynamicSharedMemorySize, SM_TOTAL);
        (void)hipOccupancyMaxActiveBlocksPerMultiprocessor(&per_cu, (const void*)k_mega, 256, SM_TOTAL);
        if (per_cu > 2) per_cu = 2;
        if (per_cu < 1) per_cu = 1;
        grid_blocks = cus * per_cu;
    }
    void* args[] = {&p};
    hipError_t e = hipLaunchCooperativeKernel((const void*)k_mega, dim3(grid_blocks), dim3(256), args, SM_TOTAL, stream);
    if (e != hipSuccess) fprintf(stderr, "cooperative launch failed: %s (grid %d)\n", hipGetErrorString(e), grid_blocks);
#endif
}
```

```cpp
#include <hip/hip_runtime.h>
#include <hip/hip_cooperative_groups.h>
#include <stdint.h>
#include <stdio.h>
namespace cg = cooperative_groups;

#ifndef FUSED
#define FUSED 1
#endif
#ifndef TS_A
#define TS_A -1
#define TS_B -1
#endif
#ifndef PROBE_PH
#define PROBE_PH -1
#define PROBE_L 1
#define PROBE_REP 0
#endif

#define DEV __device__ __forceinline__
#define LAS __attribute__((address_space(3)))
typedef unsigned short bf16_t;
typedef short bf16x8 __attribute__((ext_vector_type(8)));
typedef float f32x16 __attribute__((ext_vector_type(16)));

constexpr int kB = 8, kS = 2048, kT = kB * kS, kD = 1024, LDC = 2432;
constexpr float kEps = 1e-6f;
constexpr float kNeg = -1e30f;
constexpr float kLog2e = 1.4426950408889634f;
constexpr float kScaleU = 256.f, kScaleV = 32.f;

constexpr size_t OFF_CTRL = 0;
constexpr size_t OFF_MOD  = 65536;
constexpr size_t OFF_ROPE = OFF_MOD + 2ull * 8 * 6144 * 4;
constexpr size_t OFF_MISC = OFF_ROPE + 2048ull * 96 * 4;
constexpr size_t OFF_WIN  = OFF_MISC + 4096;
constexpr size_t OFF_WOUT = OFF_WIN + 2ull * 2432 * 1024 * 2;
constexpr size_t OFF_WQ   = OFF_WOUT + 2ull * 1024 * 1024 * 2;
constexpr size_t OFF_WUQ  = OFF_WQ + 2ull * 2048 * 1024 * 2;
constexpr size_t OFF_WUKV = OFF_WUQ + 2ull * 384 * 256 * 2;
constexpr size_t OFF_WCK  = OFF_WUKV + 2ull * 512 * 128 * 2;
constexpr size_t OFF_WCV  = OFF_WCK + 2ull * 128 * 2048 * 2;
constexpr size_t OFF_SUBK = OFF_WCV + 2ull * 128 * 2048 * 2;
constexpr size_t OFF_PU   = OFF_SUBK + 2ull * 2 * 128 * 128 * 2;
constexpr size_t OFF_PV   = OFF_PU + 2ull * 16384 * 1024;
constexpr size_t OFF_XRES = OFF_PV + 2ull * 16384 * 1024;
constexpr size_t OFF_H    = OFF_XRES + (size_t)kT * 1024 * 4;
constexpr size_t OFF_H8   = OFF_H + (size_t)kT * 1024 * 2;
constexpr size_t OFF_RSTD = OFF_H8 + (size_t)kT * 1024;
constexpr size_t OFF_KCMP = OFF_RSTD + 2ull * kT * 4;
constexpr size_t OFF_EID  = OFF_KCMP + 2ull * 1024 * 64 * 2;
constexpr size_t OFF_GATE = OFF_EID + (size_t)kT * 128 * 4;
constexpr size_t OFF_QP   = OFF_GATE + (size_t)kT * 128 * 4;
constexpr size_t OFF_COLS = OFF_QP + (size_t)kT * 2048 * 2;
constexpr size_t OFF_KC   = OFF_COLS + (size_t)kT * LDC * 2;
constexpr size_t OFF_VC   = OFF_KC + (size_t)(kT + 64) * 64 * 2;
constexpr size_t OFF_VT   = OFF_VC + (size_t)(kT + 64) * 64 * 2;
constexpr size_t OFF_QMLA = OFF_VT + 8ull * 12 * 64 * 2048 * 2;
constexpr size_t OFF_KVMLA = OFF_QMLA + (size_t)kT * 384 * 2;
constexpr size_t OFF_O    = OFF_KVMLA + (size_t)kT * 512 * 2;
constexpr size_t OFF_END  = OFF_O + (size_t)kT * 1024 * 2;
constexpr size_t OFF_S1 = OFF_COLS, OFF_S2 = OFF_COLS + (size_t)kT * 8 * 128 * 4;
static_assert(OFF_S2 + (size_t)kT * 8 * 128 * 4 <= OFF_O, "alias region too small");
static_assert(OFF_END <= (512ull << 20), "workspace too large");

struct Params {
    const float *x, *c, *ada_w, *ada_b, *norm_mix_g, *norm_ffn_g, *w_in, *pos_k, *pos_v, *cmp_wk, *cmp_wv;
    const float *lq1, *lk1, *lq2, *lk2, *sub_g, *mla_qg, *mla_wuq, *mla_kvg, *mla_wukv, *sinks, *w_out;
    const float *w_q, *subk1, *subk2, *pu, *pv, *final_g;
    float* out;
    char* ws;
};

DEV int ltid() { int t = threadIdx.x; asm volatile("" : "+v"(t)); return t; }
DEV float bf2f(bf16_t v) { return __uint_as_float(((unsigned)v) << 16); }
DEV bf16_t f2bf(float f) { unsigned u = __float_as_uint(f); u += 0x7fffu + ((u >> 16) & 1u); return (bf16_t)(u >> 16); }
DEV unsigned pack2(float lo, float hi) { unsigned r; asm("v_cvt_pk_bf16_f32 %0, %1, %2" : "=v"(r) : "v"(lo), "v"(hi)); return r; }
DEV float lo16(unsigned u) { return __uint_as_float(u << 16); }
DEV float hi16(unsigned u) { return __uint_as_float(u & 0xffff0000u); }
DEV float wave_sum(float v) {
#pragma unroll
    for (int o = 32; o > 0; o >>= 1) v += __shfl_xor(v, o, 64);
    return v;
}
DEV float xor32f(float v, int lane) { return __int_as_float(__builtin_amdgcn_ds_bpermute((lane ^ 32) << 2, __float_as_int(v))); }
DEV float lanef(float v, int src) { return __int_as_float(__builtin_amdgcn_ds_bpermute(src << 2, __float_as_int(v))); }
DEV f32x16 mfma32(bf16x8 a, bf16x8 b, f32x16 c) { return __builtin_amdgcn_mfma_f32_32x32x16_bf16(a, b, c, 0, 0, 0); }
DEV f32x16 zero16() { f32x16 z;
#pragma unroll
    for (int i = 0; i < 16; ++i) z[i] = 0.f;
    return z; }
DEV float gelu_tanh(float x) {
    const float u = 0.7978845608028654f * (x + 0.044715f * x * x * x);
    const float e = __expf(2.f * u);
    const float t = 1.f - 2.f / (e + 1.f);
    return 0.5f * x * (1.f + t);
}

template <class Epi>
DEV void gemm_tile(const bf16_t* __restrict__ A, int lda, const bf16_t* __restrict__ Bt, int ldb, int K, int m0, int n0, char* smem, const Epi& epi) {
    const int tid = ltid(), lane = tid & 63, w = tid >> 6, wm = w >> 1, wn = w & 1, ql = lane & 31, hh = lane >> 5;
    f32x16 acc[2][2];
#pragma unroll
    for (int i = 0; i < 2; ++i)
#pragma unroll
        for (int j = 0; j < 2; ++j) acc[i][j] = zero16();
    const int srow = lane >> 3, spos = lane & 7;
    const int c0 = spos ^ ((srow >> 1) & 7), c1 = spos ^ ((4 + (srow >> 1)) & 7);
    const bf16_t* Ag0 = A + (size_t)(m0 + w * 32 + srow) * lda + c0 * 8;
    const bf16_t* Ag1 = A + (size_t)(m0 + w * 32 + 8 + srow) * lda + c1 * 8;
    const bf16_t* Bg0 = Bt + (size_t)(n0 + w * 32 + srow) * ldb + c0 * 8;
    const bf16_t* Bg1 = Bt + (size_t)(n0 + w * 32 + 8 + srow) * ldb + c1 * 8;
    const size_t a16 = (size_t)16 * lda, b16 = (size_t)16 * ldb;
    auto stage = [&](int kt, int buf) __attribute__((always_inline)) {
        char* sa = smem + buf * 32768 + w * 4096;
        char* sb = sa + 16384;
        const int ko = kt * 64;
        __builtin_amdgcn_global_load_lds((const unsigned*)(Ag0 + ko), (LAS unsigned*)(sa), 16, 0, 0);
        __builtin_amdgcn_global_load_lds((const unsigned*)(Ag1 + ko), (LAS unsigned*)(sa + 1024), 16, 0, 0);
        __builtin_amdgcn_global_load_lds((const unsigned*)(Ag0 + a16 + ko), (LAS unsigned*)(sa + 2048), 16, 0, 0);
        __builtin_amdgcn_global_load_lds((const unsigned*)(Ag1 + a16 + ko), (LAS unsigned*)(sa + 3072), 16, 0, 0);
        __builtin_amdgcn_global_load_lds((const unsigned*)(Bg0 + ko), (LAS unsigned*)(sb), 16, 0, 0);
        __builtin_amdgcn_global_load_lds((const unsigned*)(Bg1 + ko), (LAS unsigned*)(sb + 1024), 16, 0, 0);
        __builtin_amdgcn_global_load_lds((const unsigned*)(Bg0 + b16 + ko), (LAS unsigned*)(sb + 2048), 16, 0, 0);
        __builtin_amdgcn_global_load_lds((const unsigned*)(Bg1 + b16 + ko), (LAS unsigned*)(sb + 3072), 16, 0, 0);
    };
    const int key = (ql >> 1) & 7;
    const int arow = (wm * 64 + ql) * 128, brow = (wn * 64 + ql) * 128;
    const int nk = K >> 6;
    __syncthreads();
    stage(0, 0);
    for (int kt = 0; kt < nk; ++kt) {
        asm volatile("s_waitcnt vmcnt(0)" ::: "memory");
        __syncthreads();
        if (kt + 1 < nk) stage(kt + 1, (kt + 1) & 1);
        const char* As = smem + (kt & 1) * 32768;
        const char* Bs = As + 16384;
#pragma unroll
        for (int ks = 0; ks < 4; ++ks) {
            const int co = ((ks * 2 + hh) ^ key) << 4;
            bf16x8 a[2], b[2];
#pragma unroll
            for (int i = 0; i < 2; ++i) {
                a[i] = *(const bf16x8*)(As + arow + i * 4096 + co);
                b[i] = *(const bf16x8*)(Bs + brow + i * 4096 + co);
            }
#pragma unroll
            for (int i = 0; i < 2; ++i)
#pragma unroll
                for (int j = 0; j < 2; ++j) acc[i][j] = mfma32(a[i], b[j], acc[i][j]);
        }
    }
    __syncthreads();
    float* Cs = (float*)smem;
#pragma unroll
    for (int i = 0; i < 2; ++i)
#pragma unroll
        for (int j = 0; j < 2; ++j)
#pragma unroll
            for (int r = 0; r < 16; ++r)
                Cs[(wm * 64 + i * 32 + (r & 3) + 8 * (r >> 2) + 4 * hh) * 128 + wn * 64 + j * 32 + ql] = acc[i][j][r];
    __syncthreads();
    epi.tile(m0, n0, Cs, tid);
}

struct EpiBf16 {
    bf16_t* C; int ldc; const float* rowscale; const float* colbias; int nvalid;
    DEV void tile(int m0, int n0, const float* Cs, int tid) const {
#pragma unroll
        for (int it = 0; it < 8; ++it) {
            const int id = tid + 256 * it, r = id >> 4, c8 = (id & 15) * 8;
            if (n0 + c8 >= nvalid) continue;
            float4 a = *(const float4*)(Cs + r * 128 + c8), b = *(const float4*)(Cs + r * 128 + c8 + 4);
            if (rowscale) { const float sc = rowscale[m0 + r]; a.x *= sc; a.y *= sc; a.z *= sc; a.w *= sc; b.x *= sc; b.y *= sc; b.z *= sc; b.w *= sc; }
            if (colbias) { const float4 ba = *(const float4*)(colbias + n0 + c8), bb = *(const float4*)(colbias + n0 + c8 + 4);
                a.x += ba.x; a.y += ba.y; a.z += ba.z; a.w += ba.w; b.x += bb.x; b.y += bb.y; b.z += bb.z; b.w += bb.w; }
            *(uint4*)(C + (size_t)(m0 + r) * ldc + n0 + c8) = make_uint4(pack2(a.x, a.y), pack2(a.z, a.w), pack2(b.x, b.y), pack2(b.z, b.w));
        }
    }
};
struct EpiF32 {
    float* C; int ldc;
    DEV void tile(int m0, int n0, const float* Cs, int tid) const {
#pragma unroll
        for (int it = 0; it < 16; ++it) {
            const int id = tid + 256 * it, r = id >> 5, c4 = (id & 31) * 4;
            *(float4*)(C + (size_t)(m0 + r) * ldc + n0 + c4) = *(const float4*)(Cs + r * 128 + c4);
        }
    }
};
struct EpiRes {
    const float* xin; float* xout; const float* gate;
    DEV void tile(int m0, int n0, const float* Cs, int tid) const {
        const float* g = gate + (size_t)(m0 >> 11) * 6144 + n0;
#pragma unroll
        for (int it = 0; it < 16; ++it) {
            const int id = tid + 256 * it, r = id >> 5, c4 = (id & 31) * 4;
            const float4 v = *(const float4*)(Cs + r * 128 + c4), g4 = *(const float4*)(g + c4);
            float4 x = *(const float4*)(xin + (size_t)(m0 + r) * 1024 + n0 + c4);
            x.x += g4.x * v.x; x.y += g4.y * v.y; x.z += g4.z * v.z; x.w += g4.w * v.w;
            *(float4*)(xout + (size_t)(m0 + r) * 1024 + n0 + c4) = x;
        }
    }
};

template <class Epi>
DEV void gemm_phase(const bf16_t* A, int lda, const bf16_t* Bt, int ldb, int K, int mtiles, int ntiles, char* smem, const Epi& epi) {
    for (int tile = blockIdx.x; tile < mtiles * ntiles; tile += gridDim.x) {
        const int mt = tile / ntiles, nt = tile % ntiles;
        gemm_tile(A, lda, Bt, ldb, K, mt * 128, nt * 128, smem, epi);
    }
}

DEV int win_srccol(int n) {
    if (n < 652) return n;
    if (n < 704) return -1;
    if (n < 1888) return n - 52;
    if (n < 1920) return -1;
    return n - 84;
}
DEV void transpose_tile(const float* __restrict__ src, int ld_src, int nsrc_valid, int mode, const float* __restrict__ rowscale,
                        bf16_t* __restrict__ dst, int K, int n0, int k0, char* smem) {
    bf16_t* Ls = (bf16_t*)smem;
    const int tid = ltid();
    __syncthreads();
    const int nn = tid & 63, n = n0 + nn;
    const int sc = (mode == 1) ? win_srccol(n) : (n < nsrc_valid ? n : -1);
#pragma unroll 4
    for (int i = 0; i < 16; ++i) {
        const int kk = (tid >> 6) + 4 * i;
        float v = 0.f;
        if (sc >= 0) { v = src[(size_t)(k0 + kk) * ld_src + sc]; if (rowscale) v *= rowscale[k0 + kk]; }
        Ls[nn * 72 + kk] = f2bf(v);
    }
    __syncthreads();
#pragma unroll
    for (int i = 0; i < 2; ++i) {
        const int r = (tid >> 3) + 32 * i, ch = tid & 7;
        *(uint4*)(dst + (size_t)(n0 + r) * K + k0 + ch * 8) = *(const uint4*)(Ls + r * 72 + ch * 8);
    }
}

DEV void convert_stream(const float* __restrict__ src, bf16_t* __restrict__ dst, size_t n8) {
    const int tid = ltid();
    for (size_t i = (size_t)blockIdx.x * 256 + tid; i < n8; i += (size_t)gridDim.x * 256) {
        const float4 a = *(const float4*)(src + i * 8), b = *(const float4*)(src + i * 8 + 4);
        uint4 o; o.x = pack2(a.x, a.y); o.y = pack2(a.z, a.w); o.z = pack2(b.x, b.y); o.w = pack2(b.z, b.w);
        *(uint4*)(dst + i * 8) = o;
    }
}

DEV void convert_fp8_stream(const float* __restrict__ src, unsigned char* __restrict__ dst, size_t n16, float scale) {
    const int tid = ltid();
    const size_t stride = (size_t)gridDim.x * 256;
    for (size_t i0 = (size_t)blockIdx.x * 256 + tid; i0 < n16; i0 += stride * 4) {
        float4 q[4][4];
#pragma unroll
        for (int u = 0; u < 4; ++u) {
            const size_t i = i0 + u * stride < n16 ? i0 + u * stride : i0;
#pragma unroll
            for (int c = 0; c < 4; ++c) q[u][c] = *(const float4*)(src + i * 16 + c * 4);
        }
#pragma unroll
        for (int u = 0; u < 4; ++u) {
            const size_t i = i0 + u * stride;
            if (i >= n16) break;
            unsigned o[4];
#pragma unroll
            for (int j = 0; j < 4; ++j) {
                const float4 v = q[u][j];
                unsigned w = 0u;
                w = __builtin_amdgcn_cvt_pk_fp8_f32(fminf(fmaxf(v.x * scale, -440.f), 440.f), fminf(fmaxf(v.y * scale, -440.f), 440.f), w, false);
                w = __builtin_amdgcn_cvt_pk_fp8_f32(fminf(fmaxf(v.z * scale, -440.f), 440.f), fminf(fmaxf(v.w * scale, -440.f), 440.f), w, true);
                o[j] = w;
            }
            const size_t rowg = i >> 6; const int c16 = (int)(i & 63);
            const size_t l = rowg >> 14, row = rowg & 16383;
            *(uint4*)(dst + (((l * 8 + (c16 >> 3)) * 16384 + row) << 7) + (c16 & 7) * 16) = make_uint4(o[0], o[1], o[2], o[3]);
        }
    }
}

constexpr int J_ROPE = 384, J_MOD = 192, J_MISC = 5;
constexpr int J_TW_L = 608 + 256 + 512 + 24 + 16 + 64 + 64;
constexpr int J_TOTAL = J_ROPE + J_MOD + J_MISC + 2 * J_TW_L;

DEV void prologue_job(const Params& p, int job, char* smem) {
    const int tid = ltid();
    char* ws = p.ws;
    if (job < J_MISC) {
        float* misc = (float*)(ws + OFF_MISC);
        if (job < 4) {
            const int l = job >> 1, kv = job & 1;
            const float* pos = (kv ? p.pos_v : p.pos_k) + l * 2048;
            const float* wsrc = (kv ? p.cmp_wv : p.cmp_wk) + (size_t)l * 2048 * 64;
            float* red = (float*)smem;
            __syncthreads();
            const int kp = tid >> 6, n = tid & 63;
            float acc = 0.f;
            for (int k0 = kp * 512; k0 < kp * 512 + 512; k0 += 16) {
                float wv[16];
#pragma unroll
                for (int u = 0; u < 16; ++u) wv[u] = wsrc[(size_t)(k0 + u) * 64 + n];
#pragma unroll
                for (int u = 0; u < 16; ++u) acc += pos[k0 + u] * wv[u];
            }
            red[kp * 64 + n] = acc;
            __syncthreads();
            if (tid < 64) misc[(l * 2 + kv) * 64 + tid] = red[tid] + red[64 + tid] + red[128 + tid] + red[192 + tid];
        } else if (tid < 2) {
            const int l = tid;
            float d1 = 0.f, d2 = 0.f;
            for (int i = 0; i < 32; ++i) { d1 += p.lq1[l * 32 + i] * p.lk1[l * 32 + i]; d2 += p.lq2[l * 32 + i] * p.lk2[l * 32 + i]; }
            const float lam_init = 0.8f - 0.6f * expf(-0.3f * (float)l);
            misc[256 + l] = expf(d1) - expf(d2) + lam_init;
            misc[258 + l] = 1.f - lam_init;
        }
        return;
    }
    job -= J_MISC;
    if (job < J_MOD) {
        const int l = job / 96, n0 = (job % 96) * 64;
        float* sc = (float*)smem;
        __syncthreads();
        for (int i = tid; i < 8192; i += 256) { const float v = p.c[i]; sc[i] = v / (1.f + __expf(-v)); }
        __syncthreads();
        const int kp = tid >> 6, col = tid & 63;
        float acc[8];
#pragma unroll
        for (int b = 0; b < 8; ++b) acc[b] = 0.f;
        const float* wp = p.ada_w + (size_t)l * 1024 * 6144 + n0 + col;
        for (int k0 = kp * 256; k0 < kp * 256 + 256; k0 += 16) {
            float wv[16];
#pragma unroll
            for (int u = 0; u < 16; ++u) wv[u] = wp[(size_t)(k0 + u) * 6144];
#pragma unroll
            for (int u = 0; u < 16; ++u)
#pragma unroll
                for (int b = 0; b < 8; ++b) acc[b] += sc[b * 1024 + k0 + u] * wv[u];
        }
        float* red = sc + 8192;
#pragma unroll
        for (int b = 0; b < 8; ++b) red[(kp * 8 + b) * 64 + col] = acc[b];
        __syncthreads();
        float* mod = (float*)(ws + OFF_MOD);
        for (int idx = tid; idx < 512; idx += 256) {
            const int b = idx >> 6, cl = idx & 63;
            const float v = red[(0 * 8 + b) * 64 + cl] + red[(1 * 8 + b) * 64 + cl] + red[(2 * 8 + b) * 64 + cl] + red[(3 * 8 + b) * 64 + cl];
            mod[(size_t)(l * 8 + b) * 6144 + n0 + cl] = v + p.ada_b[l * 6144 + n0 + cl];
        }
        return;
    }
    job -= J_MOD;
    if (job < J_ROPE) {
        const int idx = job * 256 + tid;
        const int s = idx / 48, j = idx % 48;
        float* rope = (float*)(ws + OFF_ROPE);
        float inv; float *pc, *ps;
        if (j < 32) { inv = exp2f(-(float)j * (13.287712379549449f / 32.f)); pc = rope + s * 32 + j; ps = rope + 2048 * 32 + s * 32 + j; }
        else { const int i = j - 32; inv = exp2f(-(float)i * (13.287712379549449f / 16.f)); pc = rope + 2048 * 64 + s * 16 + i; ps = rope + 2048 * 64 + 2048 * 16 + s * 16 + i; }
        const double a = (double)s * (double)inv;
        const double kk = rint(a * 0.15915494309189535);
        const float r = (float)fma(-kk, 6.283185307179586, a);
        *pc = cosf(r); *ps = sinf(r);
        return;
    }
    job -= J_ROPE;
    const int l = job / J_TW_L; int j = job % J_TW_L;
    if (j < 608) { transpose_tile(p.w_in + (size_t)l * 1024 * 2348, 2348, 2348, 1, nullptr, (bf16_t*)(ws + OFF_WIN) + (size_t)l * 2432 * 1024, 1024, (j / 16) * 64, (j % 16) * 64, smem); return; }
    j -= 608;
    if (j < 256) { transpose_tile(p.w_out + (size_t)l * 1024 * 1024, 1024, 1024, 0, nullptr, (bf16_t*)(ws + OFF_WOUT) + (size_t)l * 1024 * 1024, 1024, (j / 16) * 64, (j % 16) * 64, smem); return; }
    j -= 256;
    if (j < 512) { transpose_tile(p.w_q + (size_t)l * 1024 * 2048, 2048, 2048, 0, nullptr, (bf16_t*)(ws + OFF_WQ) + (size_t)l * 2048 * 1024, 1024, (j / 16) * 64, (j % 16) * 64, smem); return; }
    j -= 512;
    if (j < 24) { transpose_tile(p.mla_wuq + (size_t)l * 256 * 384, 384, 384, 0, p.mla_qg + l * 256, (bf16_t*)(ws + OFF_WUQ) + (size_t)l * 384 * 256, 256, (j / 4) * 64, (j % 4) * 64, smem); return; }
    j -= 24;
    if (j < 16) { transpose_tile(p.mla_wukv + (size_t)l * 128 * 512, 512, 512, 0, p.mla_kvg + l * 128, (bf16_t*)(ws + OFF_WUKV) + (size_t)l * 512 * 128, 128, (j / 2) * 64, (j % 2) * 64, smem); return; }
    j -= 16;
    if (j < 64) { transpose_tile(p.cmp_wk + (size_t)l * 2048 * 64, 64, 64, 0, nullptr, (bf16_t*)(ws + OFF_WCK) + (size_t)l * 128 * 2048, 2048, (j / 32) * 64, (j % 32) * 64, smem); return; }
    j -= 64;
    transpose_tile(p.cmp_wv + (size_t)l * 2048 * 64, 64, 64, 0, nullptr, (bf16_t*)(ws + OFF_WCV) + (size_t)l * 128 * 2048, 2048, (j / 32) * 64, (j % 32) * 64, smem);
}

#if TS_A >= 0
#define PSTAMP(I) if (blockIdx.x == 0 && threadIdx.x == 0) ((unsigned long long*)(p.ws + 32768))[I] = __builtin_amdgcn_s_memrealtime();
#else
#define PSTAMP(I)
#endif
DEV void phase_prologue(const Params& p, char* smem) {
    for (int job = blockIdx.x; job < J_TOTAL; job += gridDim.x) { prologue_job(p, job, smem); if (job < 512) { PSTAMP(40) } }
    PSTAMP(42)
    char* ws = p.ws;
    convert_fp8_stream(p.pu, (unsigned char*)(ws + OFF_PU), 2ull * 16384 * 1024 / 16, kScaleU);
    PSTAMP(43)
    convert_fp8_stream(p.pv, (unsigned char*)(ws + OFF_PV), 2ull * 16384 * 1024 / 16, kScaleV);
    PSTAMP(44)
    for (int l = 0; l < 2; ++l) {
        convert_stream(p.subk1 + (size_t)l * 16384, (bf16_t*)(ws + OFF_SUBK) + (size_t)(l * 2 + 0) * 16384, 16384 / 8);
        convert_stream(p.subk2 + (size_t)l * 16384, (bf16_t*)(ws + OFF_SUBK) + (size_t)(l * 2 + 1) * 16384, 16384 / 8);
    }
}

DEV void phase_norm(const Params& p, int layer, int which) {
    const int tid = ltid(), lane = tid & 63, w = tid >> 6;
    const float* xs = (layer == 0 && which == 0) ? p.x : (const float*)(p.ws + OFF_XRES);
    const float* g = (which == 0 ? p.norm_mix_g : p.norm_ffn_g) + layer * 1024;
    const float* mod = (const float*)(p.ws + OFF_MOD) + (size_t)layer * 8 * 6144;
    bf16_t* h = (bf16_t*)(p.ws + OFF_H);
    for (int q = blockIdx.x; q < kT / 4; q += gridDim.x) {
        const int t = q * 4 + w, b = t >> 11;
        const float* xr = xs + (size_t)t * 1024;
        float4 v[4]; float ss = 0.f;
#pragma unroll
        for (int i = 0; i < 4; ++i) { v[i] = *(const float4*)(xr + i * 256 + lane * 4); ss += v[i].x * v[i].x + v[i].y * v[i].y + v[i].z * v[i].z + v[i].w * v[i].w; }
        ss = wave_sum(ss);
        const float rstd = rsqrtf(ss * (1.f / 1024.f) + kEps);
        const float* sh = mod + (size_t)b * 6144 + (which ? 3072 : 0);
        const float* sc = sh + 1024;
#pragma unroll
        for (int i = 0; i < 4; ++i) {
            const int col = i * 256 + lane * 4;
            const float4 g4 = *(const float4*)(g + col), s4 = *(const float4*)(sc + col), h4 = *(const float4*)(sh + col);
            const float o0 = v[i].x * rstd * g4.x * (1.f + s4.x) + h4.x, o1 = v[i].y * rstd * g4.y * (1.f + s4.y) + h4.y;
            const float o2 = v[i].z * rstd * g4.z * (1.f + s4.z) + h4.z, o3 = v[i].w * rstd * g4.w * (1.f + s4.w) + h4.w;
            uint2 o; o.x = pack2(o0, o1); o.y = pack2(o2, o3);
            *(uint2*)(h + (size_t)t * 1024 + col) = o;
        }
    }
}

DEV void rope8(uint4& x1, uint4& x2, const float* cs, const float* sn) {
    const float4 c0 = *(const float4*)cs, c1 = *(const float4*)(cs + 4), s0 = *(const float4*)sn, s1 = *(const float4*)(sn + 4);
    const float cc[8] = {c0.x, c0.y, c0.z, c0.w, c1.x, c1.y, c1.z, c1.w};
    const float ss[8] = {s0.x, s0.y, s0.z, s0.w, s1.x, s1.y, s1.z, s1.w};
    unsigned a[4] = {x1.x, x1.y, x1.z, x1.w}, b[4] = {x2.x, x2.y, x2.z, x2.w};
#pragma unroll
    for (int i = 0; i < 4; ++i) {
        const float a0 = lo16(a[i]), a1 = hi16(a[i]), b0 = lo16(b[i]), b1 = hi16(b[i]);
        const float o10 = a0 * cc[2 * i] - b0 * ss[2 * i], o11 = a1 * cc[2 * i + 1] - b1 * ss[2 * i + 1];
        const float o20 = a0 * ss[2 * i] + b0 * cc[2 * i], o21 = a1 * ss[2 * i + 1] + b1 * cc[2 * i + 1];
        a[i] = pack2(o10, o11); b[i] = pack2(o20, o21);
    }
    x1 = make_uint4(a[0], a[1], a[2], a[3]); x2 = make_uint4(b[0], b[1], b[2], b[3]);
}
DEV void vt_tile(const bf16_t* __restrict__ src, int ld, bf16_t* __restrict__ dst, char* smem) {
    bf16_t* Ls = (bf16_t*)smem;
    const int tid = ltid();
    __syncthreads();
#pragma unroll
    for (int i = 0; i < 2; ++i) {
        const int id = tid + 256 * i, tok = id >> 3, ch = id & 7;
        *(uint4*)(Ls + tok * 72 + ch * 8) = *(const uint4*)(src + (size_t)tok * ld + ch * 8);
    }
    __syncthreads();
#pragma unroll
    for (int i = 0; i < 2; ++i) {
        const int id = tid + 256 * i, d = id >> 3, tc = id & 7;
        unsigned short e[8];
#pragma unroll
        for (int j = 0; j < 8; ++j) e[j] = Ls[(tc * 8 + j) * 72 + d];
        uint4 o;
        o.x = (unsigned)e[0] | ((unsigned)e[1] << 16); o.y = (unsigned)e[2] | ((unsigned)e[3] << 16);
        o.z = (unsigned)e[4] | ((unsigned)e[5] << 16); o.w = (unsigned)e[6] | ((unsigned)e[7] << 16);
        *(uint4*)(dst + (size_t)d * 2048 + tc * 8) = o;
    }
}

DEV void phase_layout1(const Params& p, char* smem) {
    char* ws = p.ws;
    bf16_t* cols = (bf16_t*)(ws + OFF_COLS);
    bf16_t* kc = (bf16_t*)(ws + OFF_KC);
    bf16_t* vc = (bf16_t*)(ws + OFF_VC);
    bf16_t* VT = (bf16_t*)(ws + OFF_VT);
    float* rstd = (float*)(ws + OFF_RSTD);
    const float* rope = (const float*)(ws + OFF_ROPE);
    const float *cos64 = rope, *sin64 = rope + 2048 * 32, *cos32 = rope + 2048 * 64, *sin32 = rope + 2048 * 64 + 2048 * 16;
    const int tid = ltid();
    for (int tile = blockIdx.x; tile < kT / 64; tile += gridDim.x) {
        const int T0 = tile * 64, b = T0 >> 11, s0 = T0 & 2047;
        for (int it = tid; it < 64 * 94; it += 256) {
            const int tok = it / 94, item = it % 94;
            const int t = T0 + tok, s = s0 + tok;
            bf16_t* row = cols + (size_t)t * LDC;
            if (item < 52) {
                const int hd = item >> 2, i0 = (item & 3) * 8;
                const int base = hd < 4 ? 64 * hd : hd == 4 ? 256 : hd == 5 ? 384 : hd == 6 ? 512 : hd < 11 ? 1920 + 64 * (hd - 7) : 2176 + 64 * (hd - 11);
                uint4 x1 = *(const uint4*)(row + base + i0), x2 = *(const uint4*)(row + base + 32 + i0);
                rope8(x1, x2, cos64 + s * 32 + i0, sin64 + s * 32 + i0);
                *(uint4*)(row + base + i0) = x1; *(uint4*)(row + base + 32 + i0) = x2;
                if (hd == 4) { *(uint4*)(kc + (size_t)t * 64 + i0) = x1; *(uint4*)(kc + (size_t)t * 64 + 32 + i0) = x2; }
            } else if (item < 86) {
                const int it2 = item - 52, sub = it2 >> 1, i0 = (it2 & 1) * 8;
                const int base = sub < 8 ? 704 + 32 * sub : sub < 16 ? 960 + 32 * (sub - 8) : 1856;
                uint4 x1 = *(const uint4*)(row + base + i0), x2 = *(const uint4*)(row + base + 16 + i0);
                rope8(x1, x2, cos32 + s * 16 + i0, sin32 + s * 16 + i0);
                *(uint4*)(row + base + i0) = x1; *(uint4*)(row + base + 16 + i0) = x2;
            } else {
                const int ch = item - 86;
                *(uint4*)(vc + (size_t)t * 64 + ch * 8) = *(const uint4*)(row + 320 + ch * 8);
            }
        }
        {
            const int tok = tid >> 2, part = tid & 3, t = T0 + tok;
            const bf16_t* src = cols + (size_t)t * LDC + 1472 + (part < 3 ? part : 0) * 128;
            float ss = 0.f;
#pragma unroll 4
            for (int i = 0; i < 16; ++i) {
                const uint4 u = *(const uint4*)(src + i * 8);
                ss += lo16(u.x) * lo16(u.x) + hi16(u.x) * hi16(u.x) + lo16(u.y) * lo16(u.y) + hi16(u.y) * hi16(u.y)
                    + lo16(u.z) * lo16(u.z) + hi16(u.z) * hi16(u.z) + lo16(u.w) * lo16(u.w) + hi16(u.w) * hi16(u.w);
            }
            float vq = part < 2 ? ss : 0.f;
            vq += __shfl_xor(vq, 1, 64);
            if (part == 0) rstd[t] = rsqrtf(vq * (1.f / 256.f) + kEps);
            if (part == 2) rstd[kT + t] = rsqrtf(ss * (1.f / 128.f) + kEps);
        }
#pragma unroll 1
        for (int vh = 0; vh < 8; ++vh) {
            const int col = vh == 0 ? 448 : vh == 1 ? 576 : vh < 6 ? 1216 + 64 * (vh - 2) : 2304 + 64 * (vh - 6);
            vt_tile(cols + (size_t)T0 * LDC + col, LDC, VT + ((size_t)(b * 12 + vh) * 64) * 2048 + s0, smem);
        }
    }
}

DEV void phase_layout2(const Params& p, char* smem) {
    char* ws = p.ws;
    bf16_t* qmla = (bf16_t*)(ws + OFF_QMLA);
    const bf16_t* kvmla = (const bf16_t*)(ws + OFF_KVMLA);
    bf16_t* VT = (bf16_t*)(ws + OFF_VT);
    const float* rope = (const float*)(ws + OFF_ROPE);
    const float *cos32 = rope + 2048 * 64, *sin32 = rope + 2048 * 64 + 2048 * 16;
    const int tid = ltid();
    for (int tile = blockIdx.x; tile < kT / 64; tile += gridDim.x) {
        const int T0 = tile * 64, b = T0 >> 11, s0 = T0 & 2047;
        for (int it = tid; it < 64 * 8; it += 256) {
            const int tok = it >> 3, item = it & 7, hd = item >> 1, i0 = (item & 1) * 8;
            const int t = T0 + tok, s = s0 + tok;
            bf16_t* row = qmla + (size_t)t * 384 + hd * 96 + 64;
            uint4 x1 = *(const uint4*)(row + i0), x2 = *(const uint4*)(row + 16 + i0);
            rope8(x1, x2, cos32 + s * 16 + i0, sin32 + s * 16 + i0);
            *(uint4*)(row + i0) = x1; *(uint4*)(row + 16 + i0) = x2;
        }
#pragma unroll 1
        for (int hd = 0; hd < 4; ++hd)
            vt_tile(kvmla + (size_t)T0 * 512 + hd * 128 + 64, 512, VT + ((size_t)(b * 12 + 8 + hd) * 64) * 2048 + s0, smem);
    }
}

constexpr int SM_K = 0;
constexpr int SM_V = 18432;
constexpr int SM_IMP = SM_V + 16896;
constexpr int SM_SEL = SM_IMP + 16896;
constexpr int SM_CTRL = 65536;
constexpr int SM_TOTAL = SM_CTRL + 256;
constexpr int SM_ATTN_END = SM_SEL + 1024;

struct RangeIter { int cur, end; DEV int next() { return cur < end ? cur++ : -1; } };
struct BitIter { unsigned rem; DEV int next() { if (!rem) return -1; const int k = __ffs((int)rem) - 1; rem &= rem - 1; return k; } };
struct LdRow { const bf16_t* base; int ld;
    DEV uint4 operator()(int kt, int id) const { const int row = id >> 3, part = id & 7; return *(const uint4*)(base + (size_t)(kt * 64 + row) * ld + part * 8); } };
struct LdVT { const bf16_t* base;
    DEV uint4 operator()(int kt, int id) const { const int d = id >> 3, part = id & 7; return *(const uint4*)(base + (size_t)d * 2048 + kt * 64 + part * 8); } };
struct LdMlaK { const bf16_t* kv; const bf16_t* kr;
    DEV uint4 operator()(int kt, int id) const { const int row = id / 12, part = id % 12; const size_t t = (size_t)(kt * 64 + row);
        return part < 8 ? *(const uint4*)(kv + t * 512 + part * 8) : *(const uint4*)(kr + t * LDC + (part - 8) * 8); } };

struct MaskCausal { DEV bool on(int) const { return true; } DEV bool ok(int kc, int d) const { return kc <= d; }
    DEV bool full(int kt, int t0w) const { return kt * 64 + 63 <= t0w; } };
template <int W> struct MaskWin { DEV bool on(int) const { return true; } DEV bool ok(int kc, int d) const { return (kc <= d) && (d - kc < W); }
    DEV bool full(int kt, int t0w) const { return (kt * 64 + 63 <= t0w) && (t0w + 31 - kt * 64 < W); } };
struct MaskSel { unsigned bits, allbits; DEV bool on(int kt) const { return (bits >> kt) & 1u; } DEV bool ok(int kc, int d) const { return kc <= d; }
    DEV bool full(int kt, int t0w) const { return ((allbits >> kt) & 1u) && (kt * 64 + 63 <= t0w); } };
template <int KDIM, int NKS, int NSUB, class It, class LK, class LV, class MaskF, class SkipF>
DEV void attn_stream(It it, const LK& ldK, const LV& ldV, const MaskF& maskf, const SkipF& skipf,
                     const bf16x8* qf, f32x16 (&o)[NSUB][2], float (&m)[NSUB], float (&l)[NSUB], float scl, int tq, int t0w, char* smem, int tid, int koff = 0) {
    constexpr int KCH = KDIM / 8, KSTR = KDIM + 8, NKC = (64 * KCH) / 256;
    bf16_t* Kb = (bf16_t*)(smem + SM_K);
    bf16_t* Vb = (bf16_t*)(smem + SM_V);
    const int lane = tid & 63, ql = lane & 31, hh = lane >> 5;
    uint4 rk0 = make_uint4(0, 0, 0, 0), rk1 = rk0, rk2 = rk0, rv0 = rk0, rv1 = rk0;
    int kt = it.next();
    if (kt >= 0) {
        rk0 = ldK(kt, tid); rk1 = ldK(kt, tid + 256);
        if (NKC == 3) rk2 = ldK(kt, tid + 512);
        rv0 = ldV(kt, tid); rv1 = ldV(kt, tid + 256);
    }
    while (kt >= 0) {
        __syncthreads();
        { const int id = tid, row = id / KCH, part = id % KCH; *(uint4*)(Kb + row * KSTR + part * 8) = rk0; }
        { const int id = tid + 256, row = id / KCH, part = id % KCH; *(uint4*)(Kb + row * KSTR + part * 8) = rk1; }
        if (NKC == 3) { const int id = tid + 512, row = id / KCH, part = id % KCH; *(uint4*)(Kb + row * KSTR + part * 8) = rk2; }
        { const int id = tid, row = id >> 3, part = id & 7; bf16_t* d = Vb + row * 68 + part * 8;
            *(uint2*)d = make_uint2(rv0.x, rv0.y); *(uint2*)(d + 4) = make_uint2(rv0.z, rv0.w); }
        { const int id = tid + 256, row = id >> 3, part = id & 7; bf16_t* d = Vb + row * 68 + part * 8;
            *(uint2*)d = make_uint2(rv1.x, rv1.y); *(uint2*)(d + 4) = make_uint2(rv1.z, rv1.w); }
        __syncthreads();
        const int ktn = it.next();
        if (ktn >= 0) {
            rk0 = ldK(ktn, tid); rk1 = ldK(ktn, tid + 256);
            if (NKC == 3) rk2 = ldK(ktn, tid + 512);
            rv0 = ldV(ktn, tid); rv1 = ldV(ktn, tid + 256);
        }
        if (!skipf(kt)) {
#pragma unroll
            for (int sub = 0; sub < NSUB; ++sub) {
                __builtin_amdgcn_sched_barrier(0);
                f32x16 s[2];
#pragma unroll
                for (int i = 0; i < 2; ++i) {
                    s[i] = zero16();
#pragma unroll
                    for (int ks = 0; ks < NKS; ++ks) {
                        const bf16x8 a = *(const bf16x8*)(Kb + (i * 32 + ql) * KSTR + koff + (sub * NKS + ks) * 16 + hh * 8);
                        s[i] = mfma32(a, qf[sub * NKS + ks], s[i]);
                    }
                }
                float mx = kNeg;
                if (!maskf.full(kt, t0w)) {
                    const int dlim = tq - kt * 64 - 4 * hh;
                    const bool on = maskf.on(kt);
#pragma unroll
                    for (int i = 0; i < 2; ++i)
#pragma unroll
                        for (int r = 0; r < 16; ++r) {
                            const int kc = i * 32 + (r & 3) + 8 * (r >> 2);
                            s[i][r] = (on && maskf.ok(kc, dlim)) ? s[i][r] : kNeg;
                        }
                }
#pragma unroll
                for (int i = 0; i < 2; ++i)
#pragma unroll
                    for (int r = 0; r < 16; ++r) mx = fmaxf(mx, s[i][r]);
                mx = fmaxf(mx, xor32f(mx, lane));
                const float mnew = fmaxf(m[sub], mx);
                const float alpha = __builtin_amdgcn_exp2f((m[sub] - mnew) * scl);
                m[sub] = mnew;
                const float negm = mnew > -1e29f ? -mnew * scl : 0.f;
                float sum = 0.f;
#pragma unroll
                for (int i = 0; i < 2; ++i)
#pragma unroll
                    for (int r = 0; r < 16; ++r) { const float pv = __builtin_amdgcn_exp2f(__builtin_fmaf(s[i][r], scl, negm)); s[i][r] = pv; sum += pv; }
                l[sub] = l[sub] * alpha + sum;
#pragma unroll
                for (int dt = 0; dt < 2; ++dt)
#pragma unroll
                    for (int r = 0; r < 16; ++r) o[sub][dt][r] *= alpha;
                __builtin_amdgcn_sched_barrier(0);
#pragma unroll
                for (int ks = 0; ks < 4; ++ks) {
                    if (ks == 2) __builtin_amdgcn_sched_barrier(0);
                    const int i = ks >> 1, r0 = 8 * (ks & 1);
                    uint4 pu;
                    pu.x = pack2(s[i][r0 + 0], s[i][r0 + 1]); pu.y = pack2(s[i][r0 + 2], s[i][r0 + 3]);
                    pu.z = pack2(s[i][r0 + 4], s[i][r0 + 5]); pu.w = pack2(s[i][r0 + 6], s[i][r0 + 7]);
                    const bf16x8 pf = __builtin_bit_cast(bf16x8, pu);
#pragma unroll
                    for (int dt = 0; dt < 2; ++dt) {
                        const bf16_t* vp = Vb + (dt * 32 + ql) * 68 + ks * 16 + 4 * hh;
                        const uint2 a0 = *(const uint2*)vp, a1 = *(const uint2*)(vp + 8);
                        const bf16x8 a = __builtin_bit_cast(bf16x8, make_uint4(a0.x, a0.y, a1.x, a1.y));
                        o[sub][dt] = mfma32(a, pf, o[sub][dt]);
                    }
                }
            }
        }
        kt = ktn;
    }
}

DEV void write_o(const f32x16 (&o)[2], bf16_t* obuf, size_t row, int col0, int hh) {
#pragma unroll
    for (int dt = 0; dt < 2; ++dt)
#pragma unroll
        for (int g = 0; g < 4; ++g) {
            const int d = dt * 32 + 8 * g + 4 * hh;
            uint2 u; u.x = pack2(o[dt][4 * g], o[dt][4 * g + 1]); u.y = pack2(o[dt][4 * g + 2], o[dt][4 * g + 3]);
            *(uint2*)(obuf + row * 1024 + col0 + d) = u;
        }
}
DEV float sigmoidf(float x) { return 1.f / (1.f + __expf(-x)); }

DEV void nsa_item(const Params& p, int b, int qb, char* smem) {
    int tid = threadIdx.x; asm volatile("" : "+v"(tid));
    const int lane = tid & 63, w = tid >> 6, ql = lane & 31, hh = lane >> 5;
    char* ws = p.ws;
    const bf16_t* cols = (const bf16_t*)(ws + OFF_COLS);
    const bf16_t* VT = (const bf16_t*)(ws + OFF_VT);
    bf16_t* obuf = (bf16_t*)(ws + OFF_O);
    const int t0 = qb * 32, tq = t0 + ql;
    const size_t Tb = (size_t)b * kS;
    const bf16_t* qrow = cols + (Tb + tq) * LDC;
    bf16x8 qf[4];
#pragma unroll
    for (int ks = 0; ks < 4; ++ks) qf[ks] = *(const bf16x8*)(qrow + w * 64 + ks * 16 + hh * 8);
    const float g0 = sigmoidf(bf2f(qrow[640 + w * 3 + 0])), g1 = sigmoidf(bf2f(qrow[640 + w * 3 + 1])), g2 = sigmoidf(bf2f(qrow[640 + w * 3 + 2]));
    const float scl = 0.125f * kLog2e;
    bf16_t* Kc = (bf16_t*)(smem + SM_K);
    bf16_t* Vc = (bf16_t*)(smem + SM_V);
    float* impP = (float*)(smem + SM_IMP);
    unsigned* selm = (unsigned*)(smem + SM_SEL);
    const bf16_t* kcmp = (const bf16_t*)(ws + OFF_KCMP) + (size_t)b * 128 * 64;
    const bf16_t* vcmp = kcmp + 1024 * 64;
    __syncthreads();
#pragma unroll
    for (int i = 0; i < 4; ++i) {
        const int id = tid + 256 * i, row = id >> 3, part = id & 7;
        uint4 kk = *(const uint4*)(kcmp + row * 64 + part * 8);
        uint4 vv = *(const uint4*)(vcmp + row * 64 + part * 8);
        if (row == 127) { kk = make_uint4(0, 0, 0, 0); vv = kk; }
        *(uint4*)(Kc + row * 72 + part * 8) = kk;
        const unsigned u[4] = {vv.x, vv.y, vv.z, vv.w};
#pragma unroll
        for (int j = 0; j < 4; ++j) { Vc[(part * 8 + 2 * j) * 132 + row] = (bf16_t)(u[j] & 0xffffu); Vc[(part * 8 + 2 * j + 1) * 132 + row] = (bf16_t)(u[j] >> 16); }
    }
    __syncthreads();
    unsigned ocp[16];
    float* invs = (float*)(smem + SM_SEL) + 64;
    {
        const int cmaxv = tq >= 31 ? min((tq - 31) >> 4, 126) : -1;
        float mx = kNeg;
#pragma unroll 1
        for (int i = 0; i < 4; ++i) {
            f32x16 s = zero16();
#pragma unroll
            for (int ks = 0; ks < 4; ++ks) s = mfma32(*(const bf16x8*)(Kc + (i * 32 + ql) * 72 + ks * 16 + hh * 8), qf[ks], s);
            const int clim = cmaxv - i * 32 - 4 * hh;
#pragma unroll
            for (int r = 0; r < 16; ++r) {
                const int kc = (r & 3) + 8 * (r >> 2);
                const bool valid = (kc <= clim);
                mx = fmaxf(mx, valid ? s[r] * scl : kNeg);
            }
        }
        mx = fmaxf(mx, xor32f(mx, lane));
        f32x16 ocmp[2]; ocmp[0] = zero16(); ocmp[1] = zero16();
        float sum = 0.f, carprev = 0.f;
#pragma unroll 1
        for (int i = 0; i < 4; ++i) {
            f32x16 s = zero16();
#pragma unroll
            for (int ks = 0; ks < 4; ++ks) s = mfma32(*(const bf16x8*)(Kc + (i * 32 + ql) * 72 + ks * 16 + hh * 8), qf[ks], s);
            const int clim = cmaxv - i * 32 - 4 * hh;
#pragma unroll
            for (int r = 0; r < 16; ++r) {
                const int kc = (r & 3) + 8 * (r >> 2);
                const bool valid = (kc <= clim);
                const float pv = valid ? __builtin_amdgcn_exp2f(s[r] * scl - mx) : 0.f;
                s[r] = pv; sum += pv;
            }
            float own[4], car[4];
#pragma unroll
            for (int g = 0; g < 4; ++g) { own[g] = s[4 * g] + s[4 * g + 1] + s[4 * g + 2] + 0.5f * s[4 * g + 3]; car[g] = 0.5f * s[4 * g + 3]; }
#pragma unroll
            for (int g = 0; g < 4; ++g) {
                const float send = hh ? (g ? car[g > 0 ? g - 1 : 0] : carprev) : car[g];
                own[g] += xor32f(send, lane);
            }
            carprev = car[3];
#pragma unroll
            for (int g = 0; g < 4; ++g) impP[(w * 32 + ql) * 33 + 2 * (4 * i + g) + hh] = own[g];
#pragma unroll
            for (int sp = 0; sp < 2; ++sp) {
                const int ks = 2 * i + sp, r0 = 8 * sp;
                uint4 pu;
                pu.x = pack2(s[r0 + 0], s[r0 + 1]); pu.y = pack2(s[r0 + 2], s[r0 + 3]);
                pu.z = pack2(s[r0 + 4], s[r0 + 5]); pu.w = pack2(s[r0 + 6], s[r0 + 7]);
                const bf16x8 pf = __builtin_bit_cast(bf16x8, pu);
#pragma unroll
                for (int dt = 0; dt < 2; ++dt) {
                    const bf16_t* vp = Vc + (dt * 32 + ql) * 132 + ks * 16 + 4 * hh;
                    const uint2 a0 = *(const uint2*)vp, a1 = *(const uint2*)(vp + 8);
                    ocmp[dt] = mfma32(__builtin_bit_cast(bf16x8, make_uint4(a0.x, a0.y, a1.x, a1.y)), pf, ocmp[dt]);
                }
            }
        }
        sum += xor32f(sum, lane);
        const float inv = sum > 0.f ? 1.f / sum : 0.f;
        invs[w * 32 + ql] = inv;
        const float f = g0 * inv;
#pragma unroll
        for (int dt = 0; dt < 2; ++dt)
#pragma unroll
            for (int r = 0; r < 8; ++r) ocp[dt * 8 + r] = pack2(f * ocmp[dt][2 * r], f * ocmp[dt][2 * r + 1]);
    }
    __syncthreads();
    const int qblk = t0 >> 6;
    {
        const int hw = tid >> 5, j = tid & 31;
#pragma unroll 1
        for (int rr = 0; rr < 4; ++rr) {
            const int row = hw * 4 + rr;
            const float v = impP[(0 * 32 + row) * 33 + j] * invs[row] + impP[(1 * 32 + row) * 33 + j] * invs[32 + row]
                          + impP[(2 * 32 + row) * 33 + j] * invs[64 + row] + impP[(3 * 32 + row) * 33 + j] * invs[96 + row];
            bool sel;
            if (qblk < 16) sel = (j <= qblk);
            else {
                const bool cand = (j >= 1) && (j <= qblk - 2);
                const bool forced = (j == 0) || (j == qblk) || (j == qblk - 1);
                int rank = 0;
                for (int j2 = 1; j2 <= qblk - 2; ++j2) {
                    const float v2 = lanef(v, (lane & 32) + j2);
                    rank += (v2 > v || (v2 == v && j2 < j)) ? 1 : 0;
                }
                sel = forced || (cand && rank < 13);
            }
            const unsigned long long bal = __ballot(sel);
            const unsigned mk = (lane & 32) ? (unsigned)(bal >> 32) : (unsigned)bal;
            if (j == 0) selm[row] = mk;
        }
    }
    __syncthreads();
    const unsigned mysel = selm[ql];
    unsigned U = mysel, Uall = mysel;
#pragma unroll
    for (int o = 16; o > 0; o >>= 1) { U |= (unsigned)__builtin_amdgcn_ds_bpermute((lane ^ o) << 2, (int)U); Uall &= (unsigned)__builtin_amdgcn_ds_bpermute((lane ^ o) << 2, (int)Uall); }
    Uall = (unsigned)__builtin_amdgcn_readfirstlane((int)Uall);
    {
        f32x16 o1[1][2]; o1[0][0] = zero16(); o1[0][1] = zero16();
        float m1[1] = {kNeg}, l1[1] = {0.f};
        auto skipf = [&](int) __attribute__((always_inline)) { return false; };
        attn_stream<64, 4, 1>(BitIter{U}, LdRow{cols + Tb * LDC + 384, LDC}, LdVT{VT + (size_t)(b * 12 + 0) * 64 * 2048}, MaskSel{mysel, Uall}, skipf, qf, o1, m1, l1, scl, tq, __builtin_amdgcn_readfirstlane(t0), smem, tid);
        const float lt = l1[0] + xor32f(l1[0], lane);
        const float f = g1 / lt;
#pragma unroll
        for (int dt = 0; dt < 2; ++dt)
#pragma unroll
            for (int r = 0; r < 8; ++r) ocp[dt * 8 + r] = pack2(lo16(ocp[dt * 8 + r]) + f * o1[0][dt][2 * r], hi16(ocp[dt * 8 + r]) + f * o1[0][dt][2 * r + 1]);
    }
    {
        f32x16 o1[1][2]; o1[0][0] = zero16(); o1[0][1] = zero16();
        float m1[1] = {kNeg}, l1[1] = {0.f};
        auto skipf = [&](int) __attribute__((always_inline)) { return false; };
        const int lo = t0 >= 511 ? ((t0 - 511) >> 6) : 0;
        attn_stream<64, 4, 1>(RangeIter{lo, qblk + 1}, LdRow{cols + Tb * LDC + 512, LDC}, LdVT{VT + (size_t)(b * 12 + 1) * 64 * 2048}, MaskWin<512>{}, skipf, qf, o1, m1, l1, scl, tq, __builtin_amdgcn_readfirstlane(t0), smem, tid);
        const float lt = l1[0] + xor32f(l1[0], lane);
        const float f = g2 / lt;
#pragma unroll
        for (int dt = 0; dt < 2; ++dt)
#pragma unroll
            for (int r = 0; r < 8; ++r) { o1[0][dt][2 * r] = lo16(ocp[dt * 8 + r]) + f * o1[0][dt][2 * r]; o1[0][dt][2 * r + 1] = hi16(ocp[dt * 8 + r]) + f * o1[0][dt][2 * r + 1]; }
        write_o(o1[0], obuf, Tb + tq, w * 64, hh);
    }
}

DEV void diff_item(const Params& p, int layer, int b, int hd, int q64, char* smem) {
    int tid = threadIdx.x; asm volatile("" : "+v"(tid));
    const int lane = tid & 63, w = tid >> 6, ql = lane & 31, hh = lane >> 5;
    const int sub = w & 1, qbw = w >> 1;
    char* ws = p.ws;
    const bf16_t* cols = (const bf16_t*)(ws + OFF_COLS);
    const bf16_t* VT = (const bf16_t*)(ws + OFF_VT);
    bf16_t* obuf = (bf16_t*)(ws + OFF_O);
    const float* misc = (const float*)(ws + OFF_MISC);
    const int t0w = q64 * 64 + qbw * 32, tq = t0w + ql;
    const size_t Tb = (size_t)b * kS;
    const bf16_t* qrow = cols + (Tb + tq) * LDC + 704 + hd * 64 + sub * 32;
    bf16x8 qf[2];
#pragma unroll
    for (int ks = 0; ks < 2; ++ks) qf[ks] = *(const bf16x8*)(qrow + ks * 16 + hh * 8);
    const float scl = 0.17677669529663687f * kLog2e;
    f32x16 o1[1][2]; o1[0][0] = zero16(); o1[0][1] = zero16();
    float m1[1] = {kNeg}, l1[1] = {0.f};
    auto skipf = [&](int kt) __attribute__((always_inline)) { return kt * 64 > t0w + 31; };
    attn_stream<64, 2, 1>(RangeIter{0, q64 + 1}, LdRow{cols + Tb * LDC + 960 + hd * 64, LDC}, LdVT{VT + (size_t)(b * 12 + 2 + hd) * 64 * 2048}, MaskCausal{}, skipf, qf, o1, m1, l1, scl, tq, __builtin_amdgcn_readfirstlane(t0w), smem, tid, sub * 32);
    const float lam = misc[256 + layer], post = misc[258 + layer];
    const float lt = l1[0] + xor32f(l1[0], lane);
    float* ex = (float*)smem;
    __syncthreads();
    if (sub == 1) {
        const float f = lam / lt;
#pragma unroll
        for (int dt = 0; dt < 2; ++dt)
#pragma unroll
            for (int r = 0; r < 16; ++r) ex[((qbw * 2 + dt) * 16 + r) * 64 + lane] = o1[0][dt][r] * f;
    }
    __syncthreads();
    if (sub == 0) {
        const float f = 1.f / lt;
        float ss = 0.f;
#pragma unroll
        for (int dt = 0; dt < 2; ++dt)
#pragma unroll
            for (int r = 0; r < 16; ++r) { const float v = o1[0][dt][r] * f - ex[((qbw * 2 + dt) * 16 + r) * 64 + lane]; o1[0][dt][r] = v; ss += v * v; }
        ss += xor32f(ss, lane);
        const float rstd = rsqrtf(ss * (1.f / 64.f) + kEps) * post;
        const float* sg = p.sub_g + layer * 64;
#pragma unroll
        for (int dt = 0; dt < 2; ++dt)
#pragma unroll
            for (int r = 0; r < 16; ++r) { const int d = dt * 32 + (r & 3) + 8 * (r >> 2) + 4 * hh; o1[0][dt][r] *= rstd * sg[d]; }
        write_o(o1[0], obuf, Tb + tq, 256 + hd * 64, hh);
    }
}

DEV void mla_item(const Params& p, int b, int hd, int qc, char* smem) {
    int tid = threadIdx.x; asm volatile("" : "+v"(tid));
    const int lane = tid & 63, w = tid >> 6, ql = lane & 31, hh = lane >> 5;
    char* ws = p.ws;
    const bf16_t* cols = (const bf16_t*)(ws + OFF_COLS);
    const bf16_t* VT = (const bf16_t*)(ws + OFF_VT);
    const bf16_t* qmla = (const bf16_t*)(ws + OFF_QMLA);
    const bf16_t* kvmla = (const bf16_t*)(ws + OFF_KVMLA);
    bf16_t* obuf = (bf16_t*)(ws + OFF_O);
    const int t0w = qc * 128 + w * 32, tq = t0w + ql;
    const size_t Tb = (size_t)b * kS;
    const bf16_t* qrow = qmla + (Tb + tq) * 384 + hd * 96;
    bf16x8 qf[6];
#pragma unroll
    for (int ks = 0; ks < 6; ++ks) qf[ks] = *(const bf16x8*)(qrow + ks * 16 + hh * 8);
    const float scl = 0.10206207261596575f * kLog2e;
    f32x16 o1[1][2]; o1[0][0] = zero16(); o1[0][1] = zero16();
    float m1[1] = {kNeg}, l1[1] = {0.f};
    auto skipf = [&](int kt) __attribute__((always_inline)) { return kt * 64 > t0w + 31; };
    attn_stream<96, 6, 1>(RangeIter{0, 2 * qc + 2}, LdMlaK{kvmla + Tb * 512 + hd * 128, cols + Tb * LDC + 1856}, LdVT{VT + (size_t)(b * 12 + 8 + hd) * 64 * 2048}, MaskCausal{}, skipf, qf, o1, m1, l1, scl, tq, __builtin_amdgcn_readfirstlane(t0w), smem, tid);
    const float inv = 1.f / (l1[0] + xor32f(l1[0], lane));
#pragma unroll
    for (int dt = 0; dt < 2; ++dt)
#pragma unroll
        for (int r = 0; r < 16; ++r) o1[0][dt][r] *= inv;
    write_o(o1[0], obuf, Tb + tq, 512 + hd * 64, hh);
}

DEV void swa_item(const Params& p, int layer, int b, int g, int q64, char* smem) {
    int tid = threadIdx.x; asm volatile("" : "+v"(tid));
    const int lane = tid & 63, w = tid >> 6, ql = lane & 31, hh = lane >> 5;
    char* ws = p.ws;
    const bf16_t* cols = (const bf16_t*)(ws + OFF_COLS);
    const bf16_t* VT = (const bf16_t*)(ws + OFF_VT);
    bf16_t* obuf = (bf16_t*)(ws + OFF_O);
    const int head = g * 2 + (w & 1);
    const int t0w = q64 * 64 + (w >> 1) * 32, tq = t0w + ql;
    const size_t Tb = (size_t)b * kS;
    const bf16_t* qrow = cols + (Tb + tq) * LDC + 1920 + head * 64;
    bf16x8 qf[4];
#pragma unroll
    for (int ks = 0; ks < 4; ++ks) qf[ks] = *(const bf16x8*)(qrow + ks * 16 + hh * 8);
    const float scl = 0.125f * kLog2e;
    f32x16 o1[1][2]; o1[0][0] = zero16(); o1[0][1] = zero16();
    float m1[1] = {p.sinks[layer * 4 + head] * 8.f}, l1[1] = {hh == 0 ? 1.f : 0.f};
    auto skipf = [&](int kt) __attribute__((always_inline)) { return (kt * 64 > t0w + 31) || (kt * 64 + 63 < t0w - 127); };
    const int lo = q64 >= 2 ? q64 - 2 : 0;
    attn_stream<64, 4, 1>(RangeIter{lo, q64 + 1}, LdRow{cols + Tb * LDC + 2176 + g * 64, LDC}, LdVT{VT + (size_t)(b * 12 + 6 + g) * 64 * 2048}, MaskWin<128>{}, skipf, qf, o1, m1, l1, scl, tq, __builtin_amdgcn_readfirstlane(t0w), smem, tid);
    const float inv = 1.f / (l1[0] + xor32f(l1[0], lane));
#pragma unroll
    for (int dt = 0; dt < 2; ++dt)
#pragma unroll
        for (int r = 0; r < 16; ++r) o1[0][dt][r] *= inv;
    write_o(o1[0], obuf, Tb + tq, 768 + head * 64, hh);
}

DEV void phase_attn(const Params& p, int layer, char* smem, int rep = 0) {
    unsigned* ctr = (unsigned*)(p.ws + OFF_CTRL) + 64 + layer * 16 + rep;
    volatile int* slot = (volatile int*)(smem + SM_SEL) + 48;
    for (;;) {
        __syncthreads();
        if (ltid() == 0) *slot = (int)atomicAdd(ctr, 1u);
        __syncthreads();
        const int idx = __builtin_amdgcn_readfirstlane(*slot);
        if (idx >= 2560) break;
        const int level = 15 - idx / 160, r = idx % 160;
        if (r < 64) { const int b = (r & 31) >> 2; diff_item(p, layer, b, r & 3, level * 2 + (1 - (r >> 5)), smem); }
        else if (r < 96) { const int k = r - 64; mla_item(p, k >> 2, k & 3, level, smem); }
        else if (r < 128) { const int k = r - 96; nsa_item(p, k >> 2, level * 4 + (3 - (k & 3)), smem); }
        else { const int k = r - 128; swa_item(p, layer, k >> 2, (k >> 1) & 1, level * 2 + (k & 1), smem); }
    }
}

#define XB_TMO      128
#define XB_XCNT(j)  (256  + 64 * (j))
#define XB_XSUB(j)  (1280 + 64 * (j))
#define XB_XGEN(j)  (2304 + 64 * (j))
#define XB_TOP      3328
#define XB_TOPGEN   3392
#define XB_SPIN_CAP (1u << 22)
DEV unsigned xb_ld(unsigned* p) { return __hip_atomic_load(p, __ATOMIC_RELAXED, __HIP_MEMORY_SCOPE_AGENT); }
DEV unsigned xb_add(unsigned* p, unsigned v) { return __hip_atomic_fetch_add(p, v, __ATOMIC_RELAXED, __HIP_MEMORY_SCOPE_AGENT); }
DEV unsigned xb_xcc_id() { return (unsigned)__builtin_amdgcn_s_getreg((3 << 11) | 20) & 0xFu; }
#define XB_SPIN(cond, bar) do { unsigned _sp = 0; while (cond) { __builtin_amdgcn_s_sleep(1); \
    if ((++_sp & 255u) == 0u) { if (xb_ld(&(bar)[XB_TMO])) break; if (_sp > XB_SPIN_CAP) { atomicAdd(&(bar)[XB_TMO], 1u); break; } } } } while (0)
struct XcdBarrier { unsigned* bar; unsigned x; volatile LAS unsigned* st; };
DEV XcdBarrier xcd_barrier_post(unsigned* bar, volatile LAS unsigned* st) {
    XcdBarrier b; b.bar = bar; b.x = xb_xcc_id(); b.st = st;
    if (threadIdx.x == 0) st[2] = xb_add(&bar[XB_XCNT(b.x)], 1u);
    return b;
}
DEV void xcd_barrier_complete(unsigned* bar, unsigned x, unsigned& nloc, unsigned& nx) {
    const unsigned G = gridDim.x * gridDim.y * gridDim.z;
    unsigned sum, cnt, mine, sp = 0u;
    for (;;) {
        sum = 0u; cnt = 0u; mine = 0u;
#pragma unroll
        for (unsigned j = 0; j < 16; ++j) { const unsigned c = xb_ld(&bar[XB_XCNT(j)]); sum += c; cnt += (c > 0u) ? 1u : 0u; mine = (j == x) ? c : mine; }
        if (sum == G) break;
        __builtin_amdgcn_s_sleep(1);
        if ((++sp & 255u) == 0u) { if (xb_ld(&bar[XB_TMO])) break; if (sp > XB_SPIN_CAP) { atomicAdd(&bar[XB_TMO], 1u); break; } }
    }
    nloc = mine > 0u ? mine : 1u; nx = cnt > 0u ? cnt : 1u;
}
DEV void xcd_barrier(const XcdBarrier& b) {
    asm volatile("s_waitcnt vmcnt(0)" ::: "memory");
    __syncthreads();
    if (threadIdx.x == 0) {
        unsigned* bar = b.bar;
        asm volatile("" : "+v"(bar));
        __builtin_amdgcn_s_waitcnt(0);
        unsigned nloc = b.st[0], nx = b.st[1];
        if (nloc == 0u) { xcd_barrier_complete(bar, b.x, nloc, nx); b.st[0] = nloc; b.st[1] = nx; }
        const unsigned old = xb_add(&bar[XB_XSUB(b.x)], 1u);
        const unsigned gen = old / nloc;
        if (old + 1u == (gen + 1u) * nloc) {
            __builtin_amdgcn_fence(__ATOMIC_RELEASE, "agent");
            asm volatile("s_waitcnt vmcnt(0)" ::: "memory");
            const unsigned og = xb_add(&bar[XB_TOP], 1u);
            const unsigned tg = og / nx;
            if (og + 1u == (tg + 1u) * nx) xb_add(&bar[XB_TOPGEN], 1u);
            else XB_SPIN(xb_ld(&bar[XB_TOPGEN]) == tg, bar);
            __builtin_amdgcn_fence(__ATOMIC_ACQUIRE, "agent");
            xb_add(&bar[XB_XGEN(b.x)], 1u);
            asm volatile("s_waitcnt vmcnt(0)" ::: "memory");
        } else {
            XB_SPIN(xb_ld(&bar[XB_XGEN(b.x)]) == gen, bar);
            __builtin_amdgcn_fence(__ATOMIC_ACQUIRE, "agent");
            asm volatile("s_waitcnt vmcnt(0)" ::: "memory");
        }
    }
    __syncthreads();
}

DEV unsigned fkey(float f) { const unsigned u = __float_as_uint(f); return (u & 0x80000000u) ? ~u : (u | 0x80000000u); }
DEV float funkey(unsigned k) { return __uint_as_float((k & 0x80000000u) ? (k & 0x7fffffffu) : ~k); }
DEV void ins16(unsigned (&L)[16], unsigned x) {
#pragma unroll
    for (int i = 0; i < 16; ++i) { const unsigned hi = L[i] > x ? L[i] : x; x = L[i] > x ? x : L[i]; L[i] = hi; }
}
DEV void phase_topk(const Params& p, char* smem) {
    const int tid = ltid();
    const float* S1 = (const float*)(p.ws + OFF_S1);
    const float* S2 = (const float*)(p.ws + OFF_S2);
    int* eid = (int*)(p.ws + OFF_EID);
    float* gate = (float*)(p.ws + OFF_GATE);
    unsigned char* ib = (unsigned char*)smem + tid * 32;
    for (int blk = blockIdx.x; blk < kT * 8 / 256; blk += gridDim.x) {
        const size_t row = (size_t)blk * 256 + tid;
        unsigned L1[16], L2[16];
#pragma unroll
        for (int i = 0; i < 16; ++i) { L1[i] = 0u; L2[i] = 0u; }
#pragma unroll 4
        for (int k = 0; k < 128; ++k) {
            const float a = S1[(size_t)k * (kT * 8) + row], b = S2[(size_t)k * (kT * 8) + row];
            ins16(L1, (fkey(a) & ~127u) | (unsigned)(127 - k));
            ins16(L2, (fkey(b) & ~127u) | (unsigned)(127 - k));
        }
        float v1[16], v2[16];
        __syncthreads();
#pragma unroll
        for (int i = 0; i < 16; ++i) {
            v1[i] = funkey(L1[i] & ~127u); v2[i] = funkey(L2[i] & ~127u);
            ib[i] = (unsigned char)(127u - (L1[i] & 127u)); ib[16 + i] = (unsigned char)(127u - (L2[i] & 127u));
        }
        unsigned C[16];
#pragma unroll
        for (int i = 0; i < 16; ++i) C[i] = 0u;
#pragma unroll
        for (int a = 0; a < 16; ++a)
#pragma unroll
            for (int b = 0; b < 16; ++b)
                if ((a + 1) * (b + 1) <= 16) ins16(C, (fkey(v1[a] + v2[b]) & ~255u) | (unsigned)(255 - (a * 16 + b)));
        float ts[16]; float sum = 0.f;
        const float tmax = funkey(C[0] & ~255u);
#pragma unroll
        for (int i = 0; i < 16; ++i) { ts[i] = __expf(funkey(C[i] & ~255u) - tmax); sum += ts[i]; }
        const float inv = 1.f / sum;
        int ev[16];
#pragma unroll
        for (int i = 0; i < 16; ++i) { const unsigned ci = 255u - (C[i] & 255u); ev[i] = (int)ib[ci >> 4] * 128 + (int)ib[16 + (ci & 15u)]; }
#pragma unroll
        for (int i = 0; i < 4; ++i) {
            *(int4*)(eid + row * 16 + 4 * i) = make_int4(ev[4 * i], ev[4 * i + 1], ev[4 * i + 2], ev[4 * i + 3]);
            *(float4*)(gate + row * 16 + 4 * i) = make_float4(ts[4 * i] * inv, ts[4 * i + 1] * inv, ts[4 * i + 2] * inv, ts[4 * i + 3] * inv);
        }
    }
}

struct EpiTop16 {
    unsigned (&L)[16];
    DEV void tile(int, int, const float* Cs, int tid) const {
        const int r = tid & 127, hk = tid >> 7;
        unsigned T[16];
#pragma unroll
        for (int i = 0; i < 16; ++i) T[i] = 0u;
#pragma unroll 4
        for (int k = 0; k < 64; ++k) {
            const int key = hk * 64 + k;
            ins16(T, (fkey(Cs[key * 128 + r]) & ~127u) | (unsigned)(127 - key));
        }
        __syncthreads();
        unsigned* X = (unsigned*)Cs;
        if (hk) {
#pragma unroll
            for (int i = 0; i < 16; ++i) X[r * 17 + i] = T[i];
        }
        __syncthreads();
        if (!hk) {
#pragma unroll
            for (int i = 0; i < 16; ++i) ins16(T, X[r * 17 + i]);
        }
#pragma unroll
        for (int i = 0; i < 16; ++i) L[i] = T[i];
    }
};
DEV void phase_route(const Params& p, int layer, char* smem) {
    char* ws = p.ws;
    int* eid = (int*)(ws + OFF_EID);
    float* gate = (float*)(ws + OFF_GATE);
    const bf16_t* qp = (const bf16_t*)(ws + OFF_QP);
    const bf16_t* subk = (const bf16_t*)(ws + OFF_SUBK) + (size_t)(layer * 2) * 16384;
    for (int nt = blockIdx.x; nt < kT * 8 / 128; nt += gridDim.x) {
        unsigned L1[16], L2[16];
        { EpiTop16 e1{L1}; gemm_tile(subk, 128, qp, 256, 128, 0, nt * 128, smem, e1); }
        { EpiTop16 e2{L2}; gemm_tile(subk + 16384, 128, qp + 128, 256, 128, 0, nt * 128, smem, e2); }
        const int tid = ltid();
        __syncthreads();
        if (tid < 128) {
            const size_t row = (size_t)nt * 128 + tid;
            unsigned char* ib = (unsigned char*)smem + tid * 32;
            float v1[16], v2[16];
#pragma unroll
            for (int i = 0; i < 16; ++i) {
                v1[i] = funkey(L1[i] & ~127u); v2[i] = funkey(L2[i] & ~127u);
                ib[i] = (unsigned char)(127u - (L1[i] & 127u)); ib[16 + i] = (unsigned char)(127u - (L2[i] & 127u));
            }
            unsigned C[16];
#pragma unroll
            for (int i = 0; i < 16; ++i) C[i] = 0u;
#pragma unroll
            for (int a = 0; a < 16; ++a)
#pragma unroll
                for (int b = 0; b < 16; ++b)
                    if ((a + 1) * (b + 1) <= 16) ins16(C, (fkey(v1[a] + v2[b]) & ~255u) | (unsigned)(255 - (a * 16 + b)));
            float ts[16]; float sum = 0.f;
            const float tmax = funkey(C[0] & ~255u);
#pragma unroll
            for (int i = 0; i < 16; ++i) { ts[i] = __expf(funkey(C[i] & ~255u) - tmax); sum += ts[i]; }
            const float inv = 1.f / sum;
            int ev[16];
#pragma unroll
            for (int i = 0; i < 16; ++i) { const unsigned ci = 255u - (C[i] & 255u); ev[i] = (int)ib[ci >> 4] * 128 + (int)ib[16 + (ci & 15u)]; }
#pragma unroll
            for (int i = 0; i < 4; ++i) {
                *(int4*)(eid + row * 16 + 4 * i) = make_int4(ev[4 * i], ev[4 * i + 1], ev[4 * i + 2], ev[4 * i + 3]);
                *(float4*)(gate + row * 16 + 4 * i) = make_float4(ts[4 * i] * inv, ts[4 * i + 1] * inv, ts[4 * i + 2] * inv, ts[4 * i + 3] * inv);
            }
        }
    }
}

DEV float row_sum_dpp(float v) {
    v += __int_as_float(__builtin_amdgcn_update_dpp(0, __float_as_int(v), 0xB1, 0xF, 0xF, true));
    v += __int_as_float(__builtin_amdgcn_update_dpp(0, __float_as_int(v), 0x4E, 0xF, 0xF, true));
    v += __int_as_float(__builtin_amdgcn_update_dpp(0, __float_as_int(v), 0x141, 0xF, 0xF, true));
    v += __int_as_float(__builtin_amdgcn_update_dpp(0, __float_as_int(v), 0x140, 0xF, 0xF, true));
    return v;
}
DEV float wave_sum_dpp(float v) {
    v = row_sum_dpp(v);
    const float r0 = __int_as_float(__builtin_amdgcn_readlane(__float_as_int(v), 0)), r1 = __int_as_float(__builtin_amdgcn_readlane(__float_as_int(v), 16));
    const float r2 = __int_as_float(__builtin_amdgcn_readlane(__float_as_int(v), 32)), r3 = __int_as_float(__builtin_amdgcn_readlane(__float_as_int(v), 48));
    return (r0 + r1) + (r2 + r3);
}
typedef float f32x2 __attribute__((ext_vector_type(2)));
typedef float f32x4 __attribute__((ext_vector_type(4)));

struct SliceMap { int virt, nx, nloc, rank; };
DEV SliceMap slice_map(const Params& p, char* smem) {
    unsigned* bar = (unsigned*)p.ws;
    const unsigned x = xb_xcc_id();
    int virt = 0, nx = 0, nloc = 1;
#pragma unroll
    for (unsigned j = 0; j < 16; ++j) {
        const unsigned c = xb_ld(&bar[XB_XCNT(j)]);
        if (c > 0u) { if (j < x) ++virt; ++nx; }
        if (j == x) nloc = (int)c;
    }
    SliceMap m;
    m.virt = __builtin_amdgcn_readfirstlane(virt); m.nx = __builtin_amdgcn_readfirstlane(nx > 0 ? nx : 1); m.nloc = __builtin_amdgcn_readfirstlane(nloc > 0 ? nloc : 1);
    m.rank = __builtin_amdgcn_readfirstlane((int)((volatile LAS unsigned*)(smem + SM_CTRL))[2]);
    return m;
}

typedef _Float16 half2_t __attribute__((ext_vector_type(2)));
DEV void phase_peer_u(const Params& p, int layer, char* smem, int rep = 0) {
    const int tid = ltid(), lane = tid & 63, w = tid >> 6, l8 = lane & 7, grp = lane >> 3;
    char* ws = p.ws;
    const SliceMap sm = slice_map(p, smem);
    const bf16_t* h = (const bf16_t*)(ws + OFF_H);
    const int* eid = (const int*)(ws + OFF_EID);
    float* part = (float*)(ws + OFF_S1) + (rep ? (size_t)8 * kT * 128 : 0);
    int* ids_l = (int*)(smem + w * 9216);
    const int nk = sm.rank < 512 ? (512 - sm.rank + sm.nloc - 1) / sm.nloc : 0;
    for (int s = sm.virt; s < 8; s += sm.nx) {
        if (nk == 0) break;
        const unsigned char* U = (const unsigned char*)(ws + OFF_PU) + (((size_t)layer * 8 + s) * 16384 << 7) + l8 * 16;
        uint4 ri0, ri1, ri2, ri3, rh0, rh1;
        auto load_oct = [&](int k) __attribute__((always_inline)) {
            const size_t o = (size_t)(sm.rank + k * sm.nloc) * 4 + w;
            const uint4* ip = (const uint4*)(eid + o * 1024) + lane;
            ri0 = ip[0]; ri1 = ip[64]; ri2 = ip[128]; ri3 = ip[192];
            const bf16_t* hp = h + (o * 8 + grp) * 1024 + s * 128 + l8 * 16;
            rh0 = *(const uint4*)hp; rh1 = *(const uint4*)(hp + 8);
        };
        half2_t hh[8];
        auto store_oct = [&]() __attribute__((always_inline)) {
            uint4* il = (uint4*)ids_l + lane;
            il[0] = ri0; il[64] = ri1; il[128] = ri2; il[192] = ri3;
            const unsigned hu[8] = {rh0.x, rh0.y, rh0.z, rh0.w, rh1.x, rh1.y, rh1.z, rh1.w};
#pragma unroll
            for (int i = 0; i < 8; ++i) hh[i] = (half2_t){(_Float16)lo16(hu[i]), (_Float16)hi16(hu[i])};
        };
        load_oct(0); store_oct();
#pragma unroll 1
        for (int k = 0; k < nk; ++k) {
            if (k + 1 < nk) load_oct(k + 1);
            const size_t o = (size_t)(sm.rank + k * sm.nloc) * 4 + w;
            float* pp = part + ((size_t)s * kT + o * 8 + grp) * 128 + l8;
            uint4 va[8], vb[8];
            auto issue = [&](uint4 (&v)[8], int c) __attribute__((always_inline)) {
                const int4 i0 = *(const int4*)(ids_l + grp * 128 + c * 8), i1 = *(const int4*)(ids_l + grp * 128 + c * 8 + 4);
                const int e[8] = {i0.x, i0.y, i0.z, i0.w, i1.x, i1.y, i1.z, i1.w};
#pragma unroll
                for (int j = 0; j < 8; ++j) v[j] = *(const uint4*)(U + ((size_t)e[j] << 7));
            };
            auto compute = [&](const uint4 (&v)[8], int c) __attribute__((always_inline)) {
                float res = 0.f;
#pragma unroll
                for (int j = 0; j < 8; ++j) {
                    const unsigned d[4] = {v[j].x, v[j].y, v[j].z, v[j].w};
                    float acc = 0.f;
#pragma unroll
                    for (int q = 0; q < 4; ++q) {
                        const half2_t lo = __builtin_amdgcn_cvt_scalef32_pk_f16_fp8(d[q], 1.0f, false);
                        const half2_t hi = __builtin_amdgcn_cvt_scalef32_pk_f16_fp8(d[q], 1.0f, true);
                        acc = __builtin_amdgcn_fdot2(lo, hh[2 * q], acc, false);
                        acc = __builtin_amdgcn_fdot2(hi, hh[2 * q + 1], acc, false);
                    }
                    acc += __int_as_float(__builtin_amdgcn_update_dpp(0, __float_as_int(acc), 0xB1, 0xF, 0xF, true));
                    acc += __int_as_float(__builtin_amdgcn_update_dpp(0, __float_as_int(acc), 0x4E, 0xF, 0xF, true));
                    acc += __int_as_float(__builtin_amdgcn_update_dpp(0, __float_as_int(acc), 0x141, 0xF, 0xF, true));
                    res = (l8 == j) ? acc : res;
                    __builtin_amdgcn_sched_barrier(0);
                }
                pp[c * 8] = res;
            };
            issue(va, 0);
#pragma unroll
            for (int c = 0; c < 16; c += 2) {
                issue(vb, c + 1);
                __builtin_amdgcn_sched_barrier(0);
                compute(va, c);
                __builtin_amdgcn_sched_barrier(0);
                if (c + 2 < 16) issue(va, c + 2);
                __builtin_amdgcn_sched_barrier(0);
                compute(vb, c + 1);
                __builtin_amdgcn_sched_barrier(0);
            }
            if (k + 1 < nk) store_oct();
        }
    }
}

DEV void phase_peer_comb(const Params& p, int rep = 0) {
    const int tid = ltid();
    const float* part = (const float*)(p.ws + OFF_S1);
    float* gate = (float*)(p.ws + OFF_GATE);
    for (size_t i = (size_t)blockIdx.x * 256 + tid; i < (size_t)kT * 128 / 4; i += (size_t)gridDim.x * 256) {
        float4 a = *(const float4*)(part + i * 4);
#pragma unroll
        for (int x = 1; x < 8; ++x) { const float4 b = *(const float4*)(part + (size_t)x * kT * 128 + i * 4); a.x += b.x; a.y += b.y; a.z += b.z; a.w += b.w; }
        const float4 g = *(const float4*)(gate + i * 4);
        float4 o;
        o.x = g.x * gelu_tanh(a.x * (1.f / kScaleU)); o.y = g.y * gelu_tanh(a.y * (1.f / kScaleU));
        o.z = g.z * gelu_tanh(a.z * (1.f / kScaleU)); o.w = g.w * gelu_tanh(a.w * (1.f / kScaleU));
        if (rep == 0) *(float4*)(gate + i * 4) = o;
    }
}

DEV void phase_peer_v(const Params& p, int layer, char* smem, int rep = 0) {
    const int tid = ltid(), lane = tid & 63, w = tid >> 6, l8 = lane & 7, grp = lane >> 3;
    char* ws = p.ws;
    const SliceMap sm = slice_map(p, smem);
    float* xres = (float*)(ws + OFF_XRES);
    const int* eid = (const int*)(ws + OFF_EID);
    const float* wbuf = (const float*)(ws + OFF_GATE);
    const float* mod = (const float*)(ws + OFF_MOD);
    int* ids_l = (int*)(smem + w * 9216);
    float* w_l = (float*)(smem + w * 9216 + 4096);
    const int nk = sm.rank < 512 ? (512 - sm.rank + sm.nloc - 1) / sm.nloc : 0;
    for (int s = sm.virt; s < 8; s += sm.nx) {
        if (nk == 0) break;
        const unsigned char* V = (const unsigned char*)(ws + OFF_PV) + (((size_t)layer * 8 + s) * 16384 << 7) + l8 * 16;
        uint4 ri0, ri1, ri2, ri3, rw0, rw1, rw2, rw3;
        auto load_oct = [&](int k) __attribute__((always_inline)) {
            const size_t o = (size_t)(sm.rank + k * sm.nloc) * 4 + w;
            const uint4* ip = (const uint4*)(eid + o * 1024) + lane;
            const uint4* wp = (const uint4*)(wbuf + o * 1024) + lane;
            ri0 = ip[0]; ri1 = ip[64]; ri2 = ip[128]; ri3 = ip[192];
            rw0 = wp[0]; rw1 = wp[64]; rw2 = wp[128]; rw3 = wp[192];
        };
        auto store_oct = [&]() __attribute__((always_inline)) {
            uint4* il = (uint4*)ids_l + lane; uint4* wl = (uint4*)w_l + lane;
            il[0] = ri0; il[64] = ri1; il[128] = ri2; il[192] = ri3;
            wl[0] = rw0; wl[64] = rw1; wl[128] = rw2; wl[192] = rw3;
        };
        load_oct(0); store_oct();
#pragma unroll 1
        for (int k = 0; k < nk; ++k) {
            if (k + 1 < nk) load_oct(k + 1);
            const size_t o = (size_t)(sm.rank + k * sm.nloc) * 4 + w;
            const size_t t = o * 8 + grp;
            const int b = (int)(t >> 11);
            float* xp = xres + t * 1024 + s * 128 + l8 * 16;
            const float* g2 = mod + (size_t)(layer * 8 + b) * 6144 + 5120 + s * 128 + l8 * 16;
            float4 xa[4];
#pragma unroll
            for (int c = 0; c < 4; ++c) xa[c] = *(const float4*)(xp + c * 4);
            half2_t out[8];
#pragma unroll
            for (int j = 0; j < 8; ++j) out[j] = (half2_t){(_Float16)0.f, (_Float16)0.f};
            uint4 va[8], vb[8];
            auto issue = [&](uint4 (&v)[8], int c) __attribute__((always_inline)) {
                const int4 i0 = *(const int4*)(ids_l + grp * 128 + c * 8), i1 = *(const int4*)(ids_l + grp * 128 + c * 8 + 4);
                const int e[8] = {i0.x, i0.y, i0.z, i0.w, i1.x, i1.y, i1.z, i1.w};
#pragma unroll
                for (int j = 0; j < 8; ++j) v[j] = *(const uint4*)(V + ((size_t)e[j] << 7));
            };
            auto compute = [&](const uint4 (&v)[8], int c) __attribute__((always_inline)) {
                const float4 w0 = *(const float4*)(w_l + grp * 128 + c * 8), w1 = *(const float4*)(w_l + grp * 128 + c * 8 + 4);
                const float wf[8] = {w0.x, w0.y, w0.z, w0.w, w1.x, w1.y, w1.z, w1.w};
#pragma unroll
                for (int j = 0; j < 8; ++j) {
                    const _Float16 wh = (_Float16)wf[j];
                    const half2_t ww = {wh, wh};
                    const unsigned d[4] = {v[j].x, v[j].y, v[j].z, v[j].w};
#pragma unroll
                    for (int q = 0; q < 4; ++q) {
                        const half2_t lo = __builtin_amdgcn_cvt_scalef32_pk_f16_fp8(d[q], 1.0f, false);
                        const half2_t hi = __builtin_amdgcn_cvt_scalef32_pk_f16_fp8(d[q], 1.0f, true);
                        out[2 * q] = __builtin_elementwise_fma(ww, lo, out[2 * q]);
                        out[2 * q + 1] = __builtin_elementwise_fma(ww, hi, out[2 * q + 1]);
                    }
                    __builtin_amdgcn_sched_barrier(0);
                }
            };
            issue(va, 0);
#pragma unroll
            for (int c = 0; c < 16; c += 2) {
                issue(vb, c + 1);
                __builtin_amdgcn_sched_barrier(0);
                compute(va, c);
                __builtin_amdgcn_sched_barrier(0);
                if (c + 2 < 16) issue(va, c + 2);
                __builtin_amdgcn_sched_barrier(0);
                compute(vb, c + 1);
                __builtin_amdgcn_sched_barrier(0);
            }
            if (rep == 0 || (float)out[0].x == 12345.678f) {
#pragma unroll
                for (int c = 0; c < 4; ++c) {
                    const float4 g4 = *(const float4*)(g2 + c * 4);
                    xa[c].x += g4.x * (float)out[2 * c].x * (1.f / kScaleV); xa[c].y += g4.y * (float)out[2 * c].y * (1.f / kScaleV);
                    xa[c].z += g4.z * (float)out[2 * c + 1].x * (1.f / kScaleV); xa[c].w += g4.w * (float)out[2 * c + 1].y * (1.f / kScaleV);
                    *(float4*)(xp + c * 4) = xa[c];
                }
            }
            if (k + 1 < nk) store_oct();
        }
    }
}

DEV void phase_final(const Params& p) {
    const int tid = ltid(), lane = tid & 63, w = tid >> 6;
    const float* xs = (const float*)(p.ws + OFF_XRES);
    for (int q = blockIdx.x; q < kT / 4; q += gridDim.x) {
        const int t = q * 4 + w;
        const float* xr = xs + (size_t)t * 1024;
        float4 v[4]; float ss = 0.f;
#pragma unroll
        for (int i = 0; i < 4; ++i) { v[i] = *(const float4*)(xr + i * 256 + lane * 4); ss += v[i].x * v[i].x + v[i].y * v[i].y + v[i].z * v[i].z + v[i].w * v[i].w; }
        ss = wave_sum(ss);
        const float rstd = rsqrtf(ss * (1.f / 1024.f) + kEps);
#pragma unroll
        for (int i = 0; i < 4; ++i) {
            const int col = i * 256 + lane * 4;
            const float4 g4 = *(const float4*)(p.final_g + col);
            *(float4*)(p.out + (size_t)t * 1024 + col) = make_float4(v[i].x * rstd * g4.x, v[i].y * rstd * g4.y, v[i].z * rstd * g4.z, v[i].w * rstd * g4.w);
        }
    }
}

DEV void phase_gemm_in(const Params& p, int layer, char* smem) {
    char* ws = p.ws;
    EpiBf16 epi{(bf16_t*)(ws + OFF_COLS), LDC, nullptr, nullptr, LDC};
    gemm_phase((const bf16_t*)(ws + OFF_H), 1024, (const bf16_t*)(ws + OFF_WIN) + (size_t)layer * 2432 * 1024, 1024, 1024, kT / 128, LDC / 128, smem, epi);
}
DEV void phase_gemm_mid(const Params& p, int layer, char* smem) {
    char* ws = p.ws;
    const float* misc = (const float*)(ws + OFF_MISC);
    const float* rstd = (const float*)(ws + OFF_RSTD);
    const bf16_t* cols = (const bf16_t*)(ws + OFF_COLS);
    for (int tile = blockIdx.x; tile < 16 + 384 + 512; tile += gridDim.x) {
        if (tile < 8) {
            EpiBf16 epi{(bf16_t*)(ws + OFF_KCMP), 64, nullptr, misc + (layer * 2 + 0) * 64, 64};
            gemm_tile((const bf16_t*)(ws + OFF_KC), 1024, (const bf16_t*)(ws + OFF_WCK) + (size_t)layer * 128 * 2048, 2048, 2048, tile * 128, 0, smem, epi);
        } else if (tile < 16) {
            EpiBf16 epi{(bf16_t*)(ws + OFF_KCMP) + 1024 * 64, 64, nullptr, misc + (layer * 2 + 1) * 64, 64};
            gemm_tile((const bf16_t*)(ws + OFF_VC), 1024, (const bf16_t*)(ws + OFF_WCV) + (size_t)layer * 128 * 2048, 2048, 2048, (tile - 8) * 128, 0, smem, epi);
        } else if (tile < 16 + 384) {
            const int tt = tile - 16;
            EpiBf16 epi{(bf16_t*)(ws + OFF_QMLA), 384, rstd, nullptr, 384};
            gemm_tile(cols + 1472, LDC, (const bf16_t*)(ws + OFF_WUQ) + (size_t)layer * 384 * 256, 256, 256, (tt / 3) * 128, (tt % 3) * 128, smem, epi);
        } else {
            const int tt = tile - 16 - 384;
            EpiBf16 epi{(bf16_t*)(ws + OFF_KVMLA), 512, rstd + kT, nullptr, 512};
            gemm_tile(cols + 1728, LDC, (const bf16_t*)(ws + OFF_WUKV) + (size_t)layer * 512 * 128, 128, 128, (tt / 4) * 128, (tt % 4) * 128, smem, epi);
        }
    }
}
DEV void phase_gemm_out(const Params& p, int layer, char* smem) {
    char* ws = p.ws;
    EpiRes epi{layer == 0 ? p.x : (const float*)(ws + OFF_XRES), (float*)(ws + OFF_XRES), (const float*)(ws + OFF_MOD) + (size_t)layer * 8 * 6144 + 2048};
    gemm_phase((const bf16_t*)(ws + OFF_O), 1024, (const bf16_t*)(ws + OFF_WOUT) + (size_t)layer * 1024 * 1024, 1024, 1024, kT / 128, 8, smem, epi);
}
DEV void phase_gemm_wq(const Params& p, int layer, char* smem) {
    char* ws = p.ws;
    EpiBf16 epi{(bf16_t*)(ws + OFF_QP), 2048, nullptr, nullptr, 2048};
    gemm_phase((const bf16_t*)(ws + OFF_H), 1024, (const bf16_t*)(ws + OFF_WQ) + (size_t)layer * 2048 * 1024, 1024, 1024, kT / 128, 16, smem, epi);
}
DEV void phase_scores(const Params& p, int layer, char* smem) {
    char* ws = p.ws;
    for (int tile = blockIdx.x; tile < 2048; tile += gridDim.x) {
        const int c = tile >> 10, nt = tile & 1023;
        EpiF32 epi{(float*)(ws + (c ? OFF_S2 : OFF_S1)), kT * 8};
        gemm_tile((const bf16_t*)(ws + OFF_SUBK) + (size_t)(layer * 2 + c) * 16384, 128, (const bf16_t*)(ws + OFF_QP) + c * 128, 256, 128, 0, nt * 128, smem, epi);
    }
}

constexpr int NPHASE = 16;
DEV void run_phase(const Params& p, int ph, int layer, char* smem, int rep = 0) {
    switch (ph) {
        case 0: phase_prologue(p, smem); break;
        case 1: phase_norm(p, layer, 0); break;
        case 2: phase_gemm_in(p, layer, smem); break;
        case 3: phase_layout1(p, smem); break;
        case 4: phase_gemm_mid(p, layer, smem); break;
        case 5: phase_layout2(p, smem); break;
        case 6: phase_attn(p, layer, smem, rep); break;
        case 7: phase_gemm_out(p, layer, smem); break;
        case 8: phase_norm(p, layer, 1); break;
        case 9: phase_gemm_wq(p, layer, smem); break;
        case 10: phase_route(p, layer, smem); break;
        case 11: phase_topk(p, smem); break;
        case 12: phase_peer_u(p, layer, smem, rep); break;
        case 13: phase_peer_comb(p, rep); break;
        case 14: phase_peer_v(p, layer, smem, rep); break;
        case 15: if (layer == 0) phase_norm(p, 1, 0); else phase_final(p); break;
        default: break;
    }
}

#if !FUSED
template <int PH>
__global__ void __launch_bounds__(256, 2) k_phase(Params p, int layer) {
    __shared__ __attribute__((aligned(16))) char smem[SM_TOTAL];
    run_phase(p, PH, layer, smem);
}
template <int PH> static void launch_phase(const Params& p, int layer, hipStream_t stream) { k_phase<PH><<<512, 256, 0, stream>>>(p, layer); }
static void launch_ph(int ph, const Params& p, int layer, hipStream_t stream) {
    switch (ph) {
        case 0: launch_phase<0>(p, layer, stream); break;
        case 1: launch_phase<1>(p, layer, stream); break;
        case 2: launch_phase<2>(p, layer, stream); break;
        case 3: launch_phase<3>(p, layer, stream); break;
        case 4: launch_phase<4>(p, layer, stream); break;
        case 5: launch_phase<5>(p, layer, stream); break;
        case 6: launch_phase<6>(p, layer, stream); break;
        case 7: launch_phase<7>(p, layer, stream); break;
        case 8: launch_phase<8>(p, layer, stream); break;
        case 9: launch_phase<9>(p, layer, stream); break;
        case 10: launch_phase<10>(p, layer, stream); break;
        case 11: launch_phase<11>(p, layer, stream); break;
        case 12: launch_phase<12>(p, layer, stream); break;
    }
}
#else
#if TS_A >= 0
#define TSTAMP(I) if (blockIdx.x == 0 && threadIdx.x == 0) ((unsigned long long*)(p.ws + 32768))[I] = __builtin_amdgcn_s_memrealtime();
#else
#define TSTAMP(I)
#endif
__global__ void __launch_bounds__(256, 2) k_mega(Params p) {
    extern __shared__ __attribute__((aligned(1024))) char smem[];
    cg::grid_group grid = cg::this_grid();
    volatile LAS unsigned* st = (volatile LAS unsigned*)(smem + SM_CTRL);
    if (threadIdx.x == 0) { st[0] = 0u; st[1] = 0u; st[2] = 0u; }
    __syncthreads();
    const XcdBarrier xb = xcd_barrier_post((unsigned*)p.ws, st);
    TSTAMP(0)
    run_phase(p, 0, 0, smem);
    if (p.out == nullptr) grid.sync();
    xcd_barrier(xb);
    TSTAMP(1)
    run_phase(p, 1, 0, smem);
    xcd_barrier(xb);
    TSTAMP(2)
#define STEP(PH, L) { run_phase(p, PH, L, smem, 0); xcd_barrier(xb); TSTAMP(2 + (L) * 16 + (PH)) }
#define LAYER(L) STEP(2, L) STEP(3, L) STEP(4, L) STEP(5, L) STEP(6, L) STEP(7, L) STEP(8, L) STEP(9, L) STEP(10, L) STEP(12, L) STEP(13, L) STEP(14, L)
    LAYER(0)
    STEP(15, 0)
    LAYER(1)
    run_phase(p, 15, 1, smem);
#if TS_A >= 0
    TSTAMP(2 + 16 + 15)
    __syncthreads();
    if (blockIdx.x == 0 && threadIdx.x == 0) {
        const unsigned long long* ts = (const unsigned long long*)(p.ws + 32768);
        p.out[0] += (float)(ts[TS_B] - ts[TS_A]) * 0.001f;
    }
#endif
}
#endif

extern "C" void kernel_launch(void* const* d_in, const int* in_sizes, int n_in, void* d_out, int out_size, void* d_ws, size_t ws_size, hipStream_t stream) {
    Params p{};
    const float** pp = (const float**)&p;
    for (int i = 0; i < 28; ++i) pp[i] = (const float*)d_in[i];
    p.out = (float*)d_out;
    p.ws = (char*)d_ws;
    if (ws_size < OFF_END) fprintf(stderr, "workspace too small: %zu < %zu\n", ws_size, (size_t)OFF_END);
    (void)hipMemsetAsync(d_ws, 0, 65536, stream);
#if !FUSED
    launch_ph(0, p, 0, stream);
    launch_ph(1, p, 0, stream);
    for (int l = 0; l < 2; ++l)
        for (int ph = 2; ph < NPHASE; ++ph) launch_ph(ph, p, l, stream);
#else
    static int grid_blocks = 0;
    if (!grid_blocks) {
        int dev = 0, cus = 0, per_cu = 0;
        (void)hipGetDevice(&dev);
        (void)hipDeviceGetAttribute(&cus, hipDeviceAttributeMultiprocessorCount, dev);
        (void)hipFuncSetAttribute((const void*)k_mega, hipFuncAttributeMaxDynamicSharedMemorySize, SM_TOTAL);
        (void)hipOccupancyMaxActiveBlocksPerMultiprocessor(&per_cu, (const void*)k_mega, 256, SM_TOTAL);
        if (per_cu > 2) per_cu = 2;
        if (per_cu < 1) per_cu = 1;
        grid_blocks = cus * per_cu;
    }
    void* args[] = {&p};
    hipError_t e = hipLaunchCooperativeKernel((const void*)k_mega, dim3(grid_blocks), dim3(256), args, SM_TOTAL, stream);
    if (e != hipSuccess) fprintf(stderr, "cooperative launch failed: %s (grid %d)\n", hipGetErrorString(e), grid_blocks);
#endif
}
```

```cpp
#include <hip/hip_runtime.h>
#include <hip/hip_cooperative_groups.h>
#include <stdint.h>
#include <stdio.h>
namespace cg = cooperative_groups;

#ifndef FUSED
#define FUSED 1
#endif
#ifndef TS_A
#define TS_A -1
#define TS_B -1
#endif
#ifndef PROBE_PH
#define PROBE_PH -1
#define PROBE_L 1
#define PROBE_REP 0
#endif

#define DEV __device__ __forceinline__
#define LAS __attribute__((address_space(3)))
typedef unsigned short bf16_t;
typedef short bf16x8 __attribute__((ext_vector_type(8)));
typedef float f32x16 __attribute__((ext_vector_type(16)));

constexpr int kB = 8, kS = 2048, kT = kB * kS, kD = 1024, LDC = 2432;
constexpr float kEps = 1e-6f;
constexpr float kNeg = -1e30f;
constexpr float kLog2e = 1.4426950408889634f;
constexpr float kScaleU = 256.f, kScaleV = 32.f;

constexpr size_t OFF_CTRL = 0;
constexpr size_t OFF_MOD  = 65536;
constexpr size_t OFF_ROPE = OFF_MOD + 2ull * 8 * 6144 * 4;
constexpr size_t OFF_MISC = OFF_ROPE + 2048ull * 96 * 4;
constexpr size_t OFF_WIN  = OFF_MISC + 4096;
constexpr size_t OFF_WOUT = OFF_WIN + 2ull * 2432 * 1024 * 2;
constexpr size_t OFF_WQ   = OFF_WOUT + 2ull * 1024 * 1024 * 2;
constexpr size_t OFF_WUQ  = OFF_WQ + 2ull * 2048 * 1024 * 2;
constexpr size_t OFF_WUKV = OFF_WUQ + 2ull * 384 * 256 * 2;
constexpr size_t OFF_WCK  = OFF_WUKV + 2ull * 512 * 128 * 2;
constexpr size_t OFF_WCV  = OFF_WCK + 2ull * 128 * 2048 * 2;
constexpr size_t OFF_SUBK = OFF_WCV + 2ull * 128 * 2048 * 2;
constexpr size_t OFF_PU   = OFF_SUBK + 2ull * 2 * 128 * 128 * 2;
constexpr size_t OFF_PV   = OFF_PU + 2ull * 16384 * 1024;
constexpr size_t OFF_XRES = OFF_PV + 2ull * 16384 * 1024;
constexpr size_t OFF_H    = OFF_XRES + (size_t)kT * 1024 * 4;
constexpr size_t OFF_H8   = OFF_H + (size_t)kT * 1024 * 2;
constexpr size_t OFF_RSTD = OFF_H8 + (size_t)kT * 1024;
constexpr size_t OFF_KCMP = OFF_RSTD + 2ull * kT * 4;
constexpr size_t OFF_EID  = OFF_KCMP + 2ull * 1024 * 64 * 2;
constexpr size_t OFF_GATE = OFF_EID + (size_t)kT * 128 * 4;
constexpr size_t OFF_QP   = OFF_GATE + (size_t)kT * 128 * 4;
constexpr size_t OFF_COLS = OFF_QP + (size_t)kT * 2048 * 2;
constexpr size_t OFF_KC   = OFF_COLS + (size_t)kT * LDC * 2;
constexpr size_t OFF_VC   = OFF_KC + (size_t)(kT + 64) * 64 * 2;
constexpr size_t OFF_VT   = OFF_VC + (size_t)(kT + 64) * 64 * 2;
constexpr size_t OFF_QMLA = OFF_VT + 8ull * 12 * 64 * 2048 * 2;
constexpr size_t OFF_KVMLA = OFF_QMLA + (size_t)kT * 384 * 2;
constexpr size_t OFF_O    = OFF_KVMLA + (size_t)kT * 512 * 2;
constexpr size_t OFF_END  = OFF_O + (size_t)kT * 1024 * 2;
constexpr size_t OFF_S1 = OFF_COLS, OFF_S2 = OFF_COLS + (size_t)kT * 8 * 128 * 4;
static_assert(OFF_S2 + (size_t)kT * 8 * 128 * 4 <= OFF_O, "alias region too small");
static_assert(OFF_END <= (512ull << 20), "workspace too large");

struct Params {
    const float *x, *c, *ada_w, *ada_b, *norm_mix_g, *norm_ffn_g, *w_in, *pos_k, *pos_v, *cmp_wk, *cmp_wv;
    const float *lq1, *lk1, *lq2, *lk2, *sub_g, *mla_qg, *mla_wuq, *mla_kvg, *mla_wukv, *sinks, *w_out;
    const float *w_q, *subk1, *subk2, *pu, *pv, *final_g;
    float* out;
    char* ws;
};

DEV int ltid() { int t = threadIdx.x; asm volatile("" : "+v"(t)); return t; }
DEV float bf2f(bf16_t v) { return __uint_as_float(((unsigned)v) << 16); }
DEV bf16_t f2bf(float f) { unsigned u = __float_as_uint(f); u += 0x7fffu + ((u >> 16) & 1u); return (bf16_t)(u >> 16); }
DEV unsigned pack2(float lo, float hi) { unsigned r; asm("v_cvt_pk_bf16_f32 %0, %1, %2" : "=v"(r) : "v"(lo), "v"(hi)); return r; }
DEV float lo16(unsigned u) { return __uint_as_float(u << 16); }
DEV float hi16(unsigned u) { return __uint_as_float(u & 0xffff0000u); }
DEV float wave_sum(float v) {
#pragma unroll
    for (int o = 32; o > 0; o >>= 1) v += __shfl_xor(v, o, 64);
    return v;
}
DEV float xor32f(float v, int lane) { return __int_as_float(__builtin_amdgcn_ds_bpermute((lane ^ 32) << 2, __float_as_int(v))); }
DEV float lanef(float v, int src) { return __int_as_float(__builtin_amdgcn_ds_bpermute(src << 2, __float_as_int(v))); }
DEV f32x16 mfma32(bf16x8 a, bf16x8 b, f32x16 c) { return __builtin_amdgcn_mfma_f32_32x32x16_bf16(a, b, c, 0, 0, 0); }
DEV f32x16 zero16() { f32x16 z;
#pragma unroll
    for (int i = 0; i < 16; ++i) z[i] = 0.f;
    return z; }
DEV float gelu_tanh(float x) {
    const float u = 0.7978845608028654f * (x + 0.044715f * x * x * x);
    const float e = __expf(2.f * u);
    const float t = 1.f - 2.f / (e + 1.f);
    return 0.5f * x * (1.f + t);
}

template <class Epi>
DEV void gemm_tile(const bf16_t* __restrict__ A, int lda, const bf16_t* __restrict__ Bt, int ldb, int K, int m0, int n0, char* smem, const Epi& epi) {
    const int tid = ltid(), lane = tid & 63, w = tid >> 6, wm = w >> 1, wn = w & 1, ql = lane & 31, hh = lane >> 5;
    f32x16 acc[2][2];
#pragma unroll
    for (int i = 0; i < 2; ++i)
#pragma unroll
        for (int j = 0; j < 2; ++j) acc[i][j] = zero16();
    const int srow = lane >> 3, spos = lane & 7;
    const int c0 = spos ^ ((srow >> 1) & 7), c1 = spos ^ ((4 + (srow >> 1)) & 7);
    const bf16_t* Ag0 = A + (size_t)(m0 + w * 32 + srow) * lda + c0 * 8;
    const bf16_t* Ag1 = A + (size_t)(m0 + w * 32 + 8 + srow) * lda + c1 * 8;
    const bf16_t* Bg0 = Bt + (size_t)(n0 + w * 32 + srow) * ldb + c0 * 8;
    const bf16_t* Bg1 = Bt + (size_t)(n0 + w * 32 + 8 + srow) * ldb + c1 * 8;
    const size_t a16 = (size_t)16 * lda, b16 = (size_t)16 * ldb;
    auto stage = [&](int kt, int buf) __attribute__((always_inline)) {
        char* sa = smem + buf * 32768 + w * 4096;
        char* sb = sa + 16384;
        const int ko = kt * 64;
        __builtin_amdgcn_global_load_lds((const unsigned*)(Ag0 + ko), (LAS unsigned*)(sa), 16, 0, 0);
        __builtin_amdgcn_global_load_lds((const unsigned*)(Ag1 + ko), (LAS unsigned*)(sa + 1024), 16, 0, 0);
        __builtin_amdgcn_global_load_lds((const unsigned*)(Ag0 + a16 + ko), (LAS unsigned*)(sa + 2048), 16, 0, 0);
        __builtin_amdgcn_global_load_lds((const unsigned*)(Ag1 + a16 + ko), (LAS unsigned*)(sa + 3072), 16, 0, 0);
        __builtin_amdgcn_global_load_lds((const unsigned*)(Bg0 + ko), (LAS unsigned*)(sb), 16, 0, 0);
        __builtin_amdgcn_global_load_lds((const unsigned*)(Bg1 + ko), (LAS unsigned*)(sb + 1024), 16, 0, 0);
        __builtin_amdgcn_global_load_lds((const unsigned*)(Bg0 + b16 + ko), (LAS unsigned*)(sb + 2048), 16, 0, 0);
        __builtin_amdgcn_global_load_lds((const unsigned*)(Bg1 + b16 + ko), (LAS unsigned*)(sb + 3072), 16, 0, 0);
    };
    const int key = (ql >> 1) & 7;
    const int arow = (wm * 64 + ql) * 128, brow = (wn * 64 + ql) * 128;
    const int nk = K >> 6;
    __syncthreads();
    stage(0, 0);
    for (int kt = 0; kt < nk; ++kt) {
        asm volatile("s_waitcnt vmcnt(0)" ::: "memory");
        __syncthreads();
        if (kt + 1 < nk) stage(kt + 1, (kt + 1) & 1);
        const char* As = smem + (kt & 1) * 32768;
        const char* Bs = As + 16384;
#pragma unroll
        for (int ks = 0; ks < 4; ++ks) {
            const int co = ((ks * 2 + hh) ^ key) << 4;
            bf16x8 a[2], b[2];
#pragma unroll
            for (int i = 0; i < 2; ++i) {
                a[i] = *(const bf16x8*)(As + arow + i * 4096 + co);
                b[i] = *(const bf16x8*)(Bs + brow + i * 4096 + co);
            }
#pragma unroll
            for (int i = 0; i < 2; ++i)
#pragma unroll
                for (int j = 0; j < 2; ++j) acc[i][j] = mfma32(a[i], b[j], acc[i][j]);
        }
    }
    __syncthreads();
    float* Cs = (float*)smem;
#pragma unroll
    for (int i = 0; i < 2; ++i)
#pragma unroll
        for (int j = 0; j < 2; ++j)
#pragma unroll
            for (int r = 0; r < 16; ++r)
                Cs[(wm * 64 + i * 32 + (r & 3) + 8 * (r >> 2) + 4 * hh) * 128 + wn * 64 + j * 32 + ql] = acc[i][j][r];
    __syncthreads();
    epi.tile(m0, n0, Cs, tid);
}

struct EpiBf16 {
    bf16_t* C; int ldc; const float* rowscale; const float* colbias; int nvalid;
    DEV void tile(int m0, int n0, const float* Cs, int tid) const {
#pragma unroll
        for (int it = 0; it < 8; ++it) {
            const int id = tid + 256 * it, r = id >> 4, c8 = (id & 15) * 8;
            if (n0 + c8 >= nvalid) continue;
            float4 a = *(const float4*)(Cs + r * 128 + c8), b = *(const float4*)(Cs + r * 128 + c8 + 4);
            if (rowscale) { const float sc = rowscale[m0 + r]; a.x *= sc; a.y *= sc; a.z *= sc; a.w *= sc; b.x *= sc; b.y *= sc; b.z *= sc; b.w *= sc; }
            if (colbias) { const float4 ba = *(const float4*)(colbias + n0 + c8), bb = *(const float4*)(colbias + n0 + c8 + 4);
                a.x += ba.x; a.y += ba.y; a.z += ba.z; a.w += ba.w; b.x += bb.x; b.y += bb.y; b.z += bb.z; b.w += bb.w; }
            *(uint4*)(C + (size_t)(m0 + r) * ldc + n0 + c8) = make_uint4(pack2(a.x, a.y), pack2(a.z, a.w), pack2(b.x, b.y), pack2(b.z, b.w));
        }
    }
};
struct EpiF32 {
    float* C; int ldc;
    DEV void tile(int m0, int n0, const float* Cs, int tid) const {
#pragma unroll
        for (int it = 0; it < 16; ++it) {
            const int id = tid + 256 * it, r = id >> 5, c4 = (id & 31) * 4;
            *(float4*)(C + (size_t)(m0 + r) * ldc + n0 + c4) = *(const float4*)(Cs + r * 128 + c4);
        }
    }
};
struct EpiRes {
    const float* xin; float* xout; const float* gate;
    DEV void tile(int m0, int n0, const float* Cs, int tid) const {
        const float* g = gate + (size_t)(m0 >> 11) * 6144 + n0;
#pragma unroll
        for (int it = 0; it < 16; ++it) {
            const int id = tid + 256 * it, r = id >> 5, c4 = (id & 31) * 4;
            const float4 v = *(const float4*)(Cs + r * 128 + c4), g4 = *(const float4*)(g + c4);
            float4 x = *(const float4*)(xin + (size_t)(m0 + r) * 1024 + n0 + c4);
            x.x += g4.x * v.x; x.y += g4.y * v.y; x.z += g4.z * v.z; x.w += g4.w * v.w;
            *(float4*)(xout + (size_t)(m0 + r) * 1024 + n0 + c4) = x;
        }
    }
};

template <class Epi>
DEV void gemm_phase(const bf16_t* A, int lda, const bf16_t* Bt, int ldb, int K, int mtiles, int ntiles, char* smem, const Epi& epi) {
    for (int tile = blockIdx.x; tile < mtiles * ntiles; tile += gridDim.x) {
        const int mt = tile / ntiles, nt = tile % ntiles;
        gemm_tile(A, lda, Bt, ldb, K, mt * 128, nt * 128, smem, epi);
    }
}

DEV int win_srccol(int n) {
    if (n < 652) return n;
    if (n < 704) return -1;
    if (n < 1888) return n - 52;
    if (n < 1920) return -1;
    return n - 84;
}
DEV void transpose_tile(const float* __restrict__ src, int ld_src, int nsrc_valid, int mode, const float* __restrict__ rowscale,
                        bf16_t* __restrict__ dst, int K, int n0, int k0, char* smem) {
    bf16_t* Ls = (bf16_t*)smem;
    const int tid = ltid();
    __syncthreads();
    const int nn = tid & 63, n = n0 + nn;
    const int sc = (mode == 1) ? win_srccol(n) : (n < nsrc_valid ? n : -1);
#pragma unroll 4
    for (int i = 0; i < 16; ++i) {
        const int kk = (tid >> 6) + 4 * i;
        float v = 0.f;
        if (sc >= 0) { v = src[(size_t)(k0 + kk) * ld_src + sc]; if (rowscale) v *= rowscale[k0 + kk]; }
        Ls[nn * 72 + kk] = f2bf(v);
    }
    __syncthreads();
#pragma unroll
    for (int i = 0; i < 2; ++i) {
        const int r = (tid >> 3) + 32 * i, ch = tid & 7;
        *(uint4*)(dst + (size_t)(n0 + r) * K + k0 + ch * 8) = *(const uint4*)(Ls + r * 72 + ch * 8);
    }
}

DEV void convert_stream(const float* __restrict__ src, bf16_t* __restrict__ dst, size_t n8) {
    const int tid = ltid();
    for (size_t i = (size_t)blockIdx.x * 256 + tid; i < n8; i += (size_t)gridDim.x * 256) {
        const float4 a = *(const float4*)(src + i * 8), b = *(const float4*)(src + i * 8 + 4);
        uint4 o; o.x = pack2(a.x, a.y); o.y = pack2(a.z, a.w); o.z = pack2(b.x, b.y); o.w = pack2(b.z, b.w);
        *(uint4*)(dst + i * 8) = o;
    }
}

DEV void convert_fp8_stream(const float* __restrict__ src, unsigned char* __restrict__ dst, size_t n16, float scale) {
    const int tid = ltid();
    const size_t stride = (size_t)gridDim.x * 256;
    for (size_t i0 = (size_t)blockIdx.x * 256 + tid; i0 < n16; i0 += stride * 4) {
        float4 q[4][4];
#pragma unroll
        for (int u = 0; u < 4; ++u) {
            const size_t i = i0 + u * stride < n16 ? i0 + u * stride : i0;
#pragma unroll
            for (int c = 0; c < 4; ++c) q[u][c] = *(const float4*)(src + i * 16 + c * 4);
        }
#pragma unroll
        for (int u = 0; u < 4; ++u) {
            const size_t i = i0 + u * stride;
            if (i >= n16) break;
            unsigned o[4];
#pragma unroll
            for (int j = 0; j < 4; ++j) {
                const float4 v = q[u][j];
                unsigned w = 0u;
                w = __builtin_amdgcn_cvt_pk_fp8_f32(fminf(fmaxf(v.x * scale, -440.f), 440.f), fminf(fmaxf(v.y * scale, -440.f), 440.f), w, false);
                w = __builtin_amdgcn_cvt_pk_fp8_f32(fminf(fmaxf(v.z * scale, -440.f), 440.f), fminf(fmaxf(v.w * scale, -440.f), 440.f), w, true);
                o[j] = w;
            }
            const size_t rowg = i >> 6; const int c16 = (int)(i & 63);
            const size_t l = rowg >> 14, row = rowg & 16383;
            *(uint4*)(dst + (((l * 8 + (c16 >> 3)) * 16384 + row) << 7) + (c16 & 7) * 16) = make_uint4(o[0], o[1], o[2], o[3]);
        }
    }
}

constexpr int J_ROPE = 384, J_MOD = 192, J_MISC = 5;
constexpr int J_TW_L = 608 + 256 + 512 + 24 + 16 + 64 + 64;
constexpr int J_TOTAL = J_ROPE + J_MOD + J_MISC + 2 * J_TW_L;

DEV void prologue_job(const Params& p, int job, char* smem) {
    const int tid = ltid();
    char* ws = p.ws;
    if (job < J_MISC) {
        float* misc = (float*)(ws + OFF_MISC);
        if (job < 4) {
            const int l = job >> 1, kv = job & 1;
            const float* pos = (kv ? p.pos_v : p.pos_k) + l * 2048;
            const float* wsrc = (kv ? p.cmp_wv : p.cmp_wk) + (size_t)l * 2048 * 64;
            float* red = (float*)smem;
            __syncthreads();
            const int kp = tid >> 6, n = tid & 63;
            float acc = 0.f;
            for (int k0 = kp * 512; k0 < kp * 512 + 512; k0 += 16) {
                float wv[16];
#pragma unroll
                for (int u = 0; u < 16; ++u) wv[u] = wsrc[(size_t)(k0 + u) * 64 + n];
#pragma unroll
                for (int u = 0; u < 16; ++u) acc += pos[k0 + u] * wv[u];
            }
            red[kp * 64 + n] = acc;
            __syncthreads();
            if (tid < 64) misc[(l * 2 + kv) * 64 + tid] = red[tid] + red[64 + tid] + red[128 + tid] + red[192 + tid];
        } else if (tid < 2) {
            const int l = tid;
            float d1 = 0.f, d2 = 0.f;
            for (int i = 0; i < 32; ++i) { d1 += p.lq1[l * 32 + i] * p.lk1[l * 32 + i]; d2 += p.lq2[l * 32 + i] * p.lk2[l * 32 + i]; }
            const float lam_init = 0.8f - 0.6f * expf(-0.3f * (float)l);
            misc[256 + l] = expf(d1) - expf(d2) + lam_init;
            misc[258 + l] = 1.f - lam_init;
        }
        return;
    }
    job -= J_MISC;
    if (job < J_MOD) {
        const int l = job / 96, n0 = (job % 96) * 64;
        float* sc = (float*)smem;
        __syncthreads();
        for (int i = tid; i < 8192; i += 256) { const float v = p.c[i]; sc[i] = v / (1.f + __expf(-v)); }
        __syncthreads();
        const int kp = tid >> 6, col = tid & 63;
        float acc[8];
#pragma unroll
        for (int b = 0; b < 8; ++b) acc[b] = 0.f;
        const float* wp = p.ada_w + (size_t)l * 1024 * 6144 + n0 + col;
        for (int k0 = kp * 256; k0 < kp * 256 + 256; k0 += 16) {
            float wv[16];
#pragma unroll
            for (int u = 0; u < 16; ++u) wv[u] = wp[(size_t)(k0 + u) * 6144];
#pragma unroll
            for (int u = 0; u < 16; ++u)
#pragma unroll
                for (int b = 0; b < 8; ++b) acc[b] += sc[b * 1024 + k0 + u] * wv[u];
        }
        float* red = sc + 8192;
#pragma unroll
        for (int b = 0; b < 8; ++b) red[(kp * 8 + b) * 64 + col] = acc[b];
        __syncthreads();
        float* mod = (float*)(ws + OFF_MOD);
        for (int idx = tid; idx < 512; idx += 256) {
            const int b = idx >> 6, cl = idx & 63;
            const float v = red[(0 * 8 + b) * 64 + cl] + red[(1 * 8 + b) * 64 + cl] + red[(2 * 8 + b) * 64 + cl] + red[(3 * 8 + b) * 64 + cl];
            mod[(size_t)(l * 8 + b) * 6144 + n0 + cl] = v + p.ada_b[l * 6144 + n0 + cl];
        }
        return;
    }
    job -= J_MOD;
    if (job < J_ROPE) {
        const int idx = job * 256 + tid;
        const int s = idx / 48, j = idx % 48;
        float* rope = (float*)(ws + OFF_ROPE);
        float inv; float *pc, *ps;
        if (j < 32) { inv = exp2f(-(float)j * (13.287712379549449f / 32.f)); pc = rope + s * 32 + j; ps = rope + 2048 * 32 + s * 32 + j; }
        else { const int i = j - 32; inv = exp2f(-(float)i * (13.287712379549449f / 16.f)); pc = rope + 2048 * 64 + s * 16 + i; ps = rope + 2048 * 64 + 2048 * 16 + s * 16 + i; }
        const double a = (double)s * (double)inv;
        const double kk = rint(a * 0.15915494309189535);
        const float r = (float)fma(-kk, 6.283185307179586, a);
        *pc = cosf(r); *ps = sinf(r);
        return;
    }
    job -= J_ROPE;
    const int l = job / J_TW_L; int j = job % J_TW_L;
    if (j < 608) { transpose_tile(p.w_in + (size_t)l * 1024 * 2348, 2348, 2348, 1, nullptr, (bf16_t*)(ws + OFF_WIN) + (size_t)l * 2432 * 1024, 1024, (j / 16) * 64, (j % 16) * 64, smem); return; }
    j -= 608;
    if (j < 256) { transpose_tile(p.w_out + (size_t)l * 1024 * 1024, 1024, 1024, 0, nullptr, (bf16_t*)(ws + OFF_WOUT) + (size_t)l * 1024 * 1024, 1024, (j / 16) * 64, (j % 16) * 64, smem); return; }
    j -= 256;
    if (j < 512) { transpose_tile(p.w_q + (size_t)l * 1024 * 2048, 2048, 2048, 0, nullptr, (bf16_t*)(ws + OFF_WQ) + (size_t)l * 2048 * 1024, 1024, (j / 16) * 64, (j % 16) * 64, smem); return; }
    j -= 512;
    if (j < 24) { transpose_tile(p.mla_wuq + (size_t)l * 256 * 384, 384, 384, 0, p.mla_qg + l * 256, (bf16_t*)(ws + OFF_WUQ) + (size_t)l * 384 * 256, 256, (j / 4) * 64, (j % 4) * 64, smem); return; }
    j -= 24;
    if (j < 16) { transpose_tile(p.mla_wukv + (size_t)l * 128 * 512, 512, 512, 0, p.mla_kvg + l * 128, (bf16_t*)(ws + OFF_WUKV) + (size_t)l * 512 * 128, 128, (j / 2) * 64, (j % 2) * 64, smem); return; }
    j -= 16;
    if (j < 64) { transpose_tile(p.cmp_wk + (size_t)l * 2048 * 64, 64, 64, 0, nullptr, (bf16_t*)(ws + OFF_WCK) + (size_t)l * 128 * 2048, 2048, (j / 32) * 64, (j % 32) * 64, smem); return; }
    j -= 64;
    transpose_tile(p.cmp_wv + (size_t)l * 2048 * 64, 64, 64, 0, nullptr, (bf16_t*)(ws + OFF_WCV) + (size_t)l * 128 * 2048, 2048, (j / 32) * 64, (j % 32) * 64, smem);
}

#if TS_A >= 0
#define PSTAMP(I) if (blockIdx.x == 0 && threadIdx.x == 0) ((unsigned long long*)(p.ws + 32768))[I] = __builtin_amdgcn_s_memrealtime();
#else
#define PSTAMP(I)
#endif
DEV void phase_prologue(const Params& p, char* smem) {
    for (int job = blockIdx.x; job < J_TOTAL; job += gridDim.x) { prologue_job(p, job, smem); if (job < 512) { PSTAMP(40) } }
    PSTAMP(42)
    char* ws = p.ws;
    convert_fp8_stream(p.pu, (unsigned char*)(ws + OFF_PU), 2ull * 16384 * 1024 / 16, kScaleU);
    PSTAMP(43)
    convert_fp8_stream(p.pv, (unsigned char*)(ws + OFF_PV), 2ull * 16384 * 1024 / 16, kScaleV);
    PSTAMP(44)
    for (int l = 0; l < 2; ++l) {
        convert_stream(p.subk1 + (size_t)l * 16384, (bf16_t*)(ws + OFF_SUBK) + (size_t)(l * 2 + 0) * 16384, 16384 / 8);
        convert_stream(p.subk2 + (size_t)l * 16384, (bf16_t*)(ws + OFF_SUBK) + (size_t)(l * 2 + 1) * 16384, 16384 / 8);
    }
}

DEV void phase_norm(const Params& p, int layer, int which) {
    const int tid = ltid(), lane = tid & 63, w = tid >> 6;
    const float* xs = (layer == 0 && which == 0) ? p.x : (const float*)(p.ws + OFF_XRES);
    const float* g = (which == 0 ? p.norm_mix_g : p.norm_ffn_g) + layer * 1024;
    const float* mod = (const float*)(p.ws + OFF_MOD) + (size_t)layer * 8 * 6144;
    bf16_t* h = (bf16_t*)(p.ws + OFF_H);
    float4 g4[4];
#pragma unroll
    for (int i = 0; i < 4; ++i) g4[i] = *(const float4*)(g + i * 256 + lane * 4);
    for (int q0 = blockIdx.x; q0 < kT / 4; q0 += gridDim.x * 4) {
        float4 v[4][4];
#pragma unroll
        for (int u = 0; u < 4; ++u) {
            const int q = q0 + u * gridDim.x < kT / 4 ? q0 + u * gridDim.x : q0;
            const float* xr = xs + (size_t)(q * 4 + w) * 1024;
#pragma unroll
            for (int i = 0; i < 4; ++i) v[u][i] = *(const float4*)(xr + i * 256 + lane * 4);
        }
#pragma unroll
        for (int u = 0; u < 4; ++u) {
            const int q = q0 + u * gridDim.x;
            if (q >= kT / 4) break;
            const int t = q * 4 + w, b = t >> 11;
            float ss = 0.f;
#pragma unroll
            for (int i = 0; i < 4; ++i) ss += v[u][i].x * v[u][i].x + v[u][i].y * v[u][i].y + v[u][i].z * v[u][i].z + v[u][i].w * v[u][i].w;
            ss = wave_sum(ss);
            const float rstd = rsqrtf(ss * (1.f / 1024.f) + kEps);
            const float* sh = mod + (size_t)b * 6144 + (which ? 3072 : 0);
            const float* sc = sh + 1024;
#pragma unroll
            for (int i = 0; i < 4; ++i) {
                const int col = i * 256 + lane * 4;
                const float4 s4 = *(const float4*)(sc + col), h4 = *(const float4*)(sh + col);
                const float o0 = v[u][i].x * rstd * g4[i].x * (1.f + s4.x) + h4.x, o1 = v[u][i].y * rstd * g4[i].y * (1.f + s4.y) + h4.y;
                const float o2 = v[u][i].z * rstd * g4[i].z * (1.f + s4.z) + h4.z, o3 = v[u][i].w * rstd * g4[i].w * (1.f + s4.w) + h4.w;
                uint2 o; o.x = pack2(o0, o1); o.y = pack2(o2, o3);
                *(uint2*)(h + (size_t)t * 1024 + col) = o;
            }
        }
    }
}

DEV void rope8(uint4& x1, uint4& x2, const float (&cc)[8], const float (&ss)[8]) {
    unsigned a[4] = {x1.x, x1.y, x1.z, x1.w}, b[4] = {x2.x, x2.y, x2.z, x2.w};
#pragma unroll
    for (int i = 0; i < 4; ++i) {
        const float a0 = lo16(a[i]), a1 = hi16(a[i]), b0 = lo16(b[i]), b1 = hi16(b[i]);
        const float o10 = a0 * cc[2 * i] - b0 * ss[2 * i], o11 = a1 * cc[2 * i + 1] - b1 * ss[2 * i + 1];
        const float o20 = a0 * ss[2 * i] + b0 * cc[2 * i], o21 = a1 * ss[2 * i + 1] + b1 * cc[2 * i + 1];
        a[i] = pack2(o10, o11); b[i] = pack2(o20, o21);
    }
    x1 = make_uint4(a[0], a[1], a[2], a[3]); x2 = make_uint4(b[0], b[1], b[2], b[3]);
}
DEV void vt_tile(const bf16_t* __restrict__ src, int ld, bf16_t* __restrict__ dst, char* smem) {
    bf16_t* Ls = (bf16_t*)smem;
    const int tid = ltid();
    __syncthreads();
#pragma unroll
    for (int i = 0; i < 2; ++i) {
        const int id = tid + 256 * i, tok = id >> 3, ch = id & 7;
        *(uint4*)(Ls + tok * 72 + ch * 8) = *(const uint4*)(src + (size_t)tok * ld + ch * 8);
    }
    __syncthreads();
#pragma unroll
    for (int i = 0; i < 2; ++i) {
        const int id = tid + 256 * i, d = id & 63, tc = id >> 6;
        unsigned short e[8];
#pragma unroll
        for (int j = 0; j < 8; ++j) e[j] = Ls[(tc * 8 + j) * 72 + d];
        uint4 o;
        o.x = (unsigned)e[0] | ((unsigned)e[1] << 16); o.y = (unsigned)e[2] | ((unsigned)e[3] << 16);
        o.z = (unsigned)e[4] | ((unsigned)e[5] << 16); o.w = (unsigned)e[6] | ((unsigned)e[7] << 16);
        *(uint4*)(dst + (size_t)d * 2048 + tc * 8) = o;
    }
}

DEV void phase_layout1(const Params& p, char* smem) {
    char* ws = p.ws;
    bf16_t* cols = (bf16_t*)(ws + OFF_COLS);
    bf16_t* kc = (bf16_t*)(ws + OFF_KC);
    bf16_t* vc = (bf16_t*)(ws + OFF_VC);
    bf16_t* VT = (bf16_t*)(ws + OFF_VT);
    float* rstd = (float*)(ws + OFF_RSTD);
    const float* rope = (const float*)(ws + OFF_ROPE);
    const float *cos64 = rope, *sin64 = rope + 2048 * 32, *cos32 = rope + 2048 * 64, *sin32 = rope + 2048 * 64 + 2048 * 16;
    const int tid = ltid();
    for (int unit = blockIdx.x; unit < 2 * (kT / 64); unit += gridDim.x) {
        const int tile = unit >> 1, part01 = unit & 1;
        const int T0 = tile * 64, b = T0 >> 11, s0 = T0 & 2047;
        if (part01 == 0) {
            for (int it0 = tid; it0 < 64 * 86; it0 += 1024) {
                uint4 x1[4], x2[4]; float4 cs[4][2], sn[4][2]; bf16_t* p1[4]; bf16_t* p2[4]; bf16_t* kq[4];
#pragma unroll
                for (int u = 0; u < 4; ++u) {
                    const int it = it0 + u * 256 < 64 * 86 ? it0 + u * 256 : it0;
                    const int tok = it / 86, item = it % 86;
                    const int t = T0 + tok, sq = s0 + tok;
                    bf16_t* row = cols + (size_t)t * LDC;
                    kq[u] = nullptr;
                    const float *cp, *sp;
                    if (item < 52) {
                        const int hd = item >> 2, i0 = (item & 3) * 8;
                        const int base = hd < 4 ? 64 * hd : hd == 4 ? 256 : hd == 5 ? 384 : hd == 6 ? 512 : hd < 11 ? 1920 + 64 * (hd - 7) : 2176 + 64 * (hd - 11);
                        p1[u] = row + base + i0; p2[u] = row + base + 32 + i0;
                        cp = cos64 + sq * 32 + i0; sp = sin64 + sq * 32 + i0;
                        if (hd == 4) kq[u] = kc + (size_t)t * 64 + i0;
                    } else {
                        const int it2 = item - 52, sub = it2 >> 1, i0 = (it2 & 1) * 8;
                        const int base = sub < 8 ? 704 + 32 * sub : sub < 16 ? 960 + 32 * (sub - 8) : 1856;
                        p1[u] = row + base + i0; p2[u] = row + base + 16 + i0;
                        cp = cos32 + sq * 16 + i0; sp = sin32 + sq * 16 + i0;
                    }
                    x1[u] = *(const uint4*)p1[u]; x2[u] = *(const uint4*)p2[u];
                    cs[u][0] = *(const float4*)cp; cs[u][1] = *(const float4*)(cp + 4);
                    sn[u][0] = *(const float4*)sp; sn[u][1] = *(const float4*)(sp + 4);
                }
#pragma unroll
                for (int u = 0; u < 4; ++u) {
                    if (it0 + u * 256 >= 64 * 86) break;
                    const float cc[8] = {cs[u][0].x, cs[u][0].y, cs[u][0].z, cs[u][0].w, cs[u][1].x, cs[u][1].y, cs[u][1].z, cs[u][1].w};
                    const float ss[8] = {sn[u][0].x, sn[u][0].y, sn[u][0].z, sn[u][0].w, sn[u][1].x, sn[u][1].y, sn[u][1].z, sn[u][1].w};
                    rope8(x1[u], x2[u], cc, ss);
                    *(uint4*)p1[u] = x1[u]; *(uint4*)p2[u] = x2[u];
                    if (kq[u]) { *(uint4*)kq[u] = x1[u]; *(uint4*)(kq[u] + 32) = x2[u]; }
                }
            }
            {
                const uint4 c0 = *(const uint4*)(cols + (size_t)(T0 + (tid >> 3)) * LDC + 320 + (tid & 7) * 8);
                const uint4 c1 = *(const uint4*)(cols + (size_t)(T0 + 32 + (tid >> 3)) * LDC + 320 + (tid & 7) * 8);
                *(uint4*)(vc + (size_t)(T0 + (tid >> 3)) * 64 + (tid & 7) * 8) = c0;
                *(uint4*)(vc + (size_t)(T0 + 32 + (tid >> 3)) * 64 + (tid & 7) * 8) = c1;
            }
        }
        if (part01 == 0) continue;
        {
            const int tok = tid >> 2, part = tid & 3, t = T0 + tok;
            const bf16_t* src = cols + (size_t)t * LDC + 1472 + (part < 3 ? part : 0) * 128;
            float ss = 0.f;
#pragma unroll 4
            for (int i = 0; i < 16; ++i) {
                const uint4 u = *(const uint4*)(src + i * 8);
                ss += lo16(u.x) * lo16(u.x) + hi16(u.x) * hi16(u.x) + lo16(u.y) * lo16(u.y) + hi16(u.y) * hi16(u.y)
                    + lo16(u.z) * lo16(u.z) + hi16(u.z) * hi16(u.z) + lo16(u.w) * lo16(u.w) + hi16(u.w) * hi16(u.w);
            }
            float vq = part < 2 ? ss : 0.f;
            vq += __shfl_xor(vq, 1, 64);
            if (part == 0) rstd[t] = rsqrtf(vq * (1.f / 256.f) + kEps);
            if (part == 2) rstd[kT + t] = rsqrtf(ss * (1.f / 128.f) + kEps);
        }
#pragma unroll 1
        for (int vh = 0; vh < 8; ++vh) {
            const int col = vh == 0 ? 448 : vh == 1 ? 576 : vh < 6 ? 1216 + 64 * (vh - 2) : 2304 + 64 * (vh - 6);
            vt_tile(cols + (size_t)T0 * LDC + col, LDC, VT + ((size_t)(b * 12 + vh) * 64) * 2048 + s0, smem);
        }
    }
}

DEV void phase_layout2(const Params& p, int layer, char* smem) {
    char* ws = p.ws;
    bf16_t* qmla = (bf16_t*)(ws + OFF_QMLA);
    const bf16_t* kvmla = (const bf16_t*)(ws + OFF_KVMLA);
    bf16_t* VT = (bf16_t*)(ws + OFF_VT);
    const float* rope = (const float*)(ws + OFF_ROPE);
    const float *cos32 = rope + 2048 * 64, *sin32 = rope + 2048 * 64 + 2048 * 16;
    const int tid = ltid();
    for (int tile = blockIdx.x; tile < kT / 64 + 64; tile += gridDim.x) {
        if (tile >= kT / 64) {
            const int idx = (tile - kT / 64) * 2048 + tid * 8;
            const int kv = idx >> 16, m = (idx >> 6) & 1023, n = idx & 63;
            const float* pp = (const float*)(ws + OFF_QP) + ((size_t)(kv * 8) * 1024 + m) * 128 + n;
            const float* bias = (const float*)(ws + OFF_MISC) + (layer * 2 + kv) * 64 + n;
            float4 a = *(const float4*)bias, c = *(const float4*)(bias + 4);
#pragma unroll
            for (int ks = 0; ks < 8; ++ks) {
                const float4 x = *(const float4*)(pp + (size_t)ks * 1024 * 128), y = *(const float4*)(pp + (size_t)ks * 1024 * 128 + 4);
                a.x += x.x; a.y += x.y; a.z += x.z; a.w += x.w; c.x += y.x; c.y += y.y; c.z += y.z; c.w += y.w;
            }
            *(uint4*)((bf16_t*)(ws + OFF_KCMP) + (size_t)kv * 1024 * 64 + m * 64 + n) = make_uint4(pack2(a.x, a.y), pack2(a.z, a.w), pack2(c.x, c.y), pack2(c.z, c.w));
            continue;
        }
        const int T0 = tile * 64, b = T0 >> 11, s0 = T0 & 2047;
        for (int it = tid; it < 64 * 8; it += 256) {
            const int tok = it >> 3, item = it & 7, hd = item >> 1, i0 = (item & 1) * 8;
            const int t = T0 + tok, s = s0 + tok;
            bf16_t* row = qmla + (size_t)t * 384 + hd * 96 + 64;
            uint4 x1 = *(const uint4*)(row + i0), x2 = *(const uint4*)(row + 16 + i0);
            const float* cp = cos32 + s * 16 + i0; const float* sp = sin32 + s * 16 + i0;
            const float4 c0 = *(const float4*)cp, c1 = *(const float4*)(cp + 4), q0 = *(const float4*)sp, q1 = *(const float4*)(sp + 4);
            const float cc[8] = {c0.x, c0.y, c0.z, c0.w, c1.x, c1.y, c1.z, c1.w}, ss[8] = {q0.x, q0.y, q0.z, q0.w, q1.x, q1.y, q1.z, q1.w};
            rope8(x1, x2, cc, ss);
            *(uint4*)(row + i0) = x1; *(uint4*)(row + 16 + i0) = x2;
        }
#pragma unroll 1
        for (int hd = 0; hd < 4; ++hd)
            vt_tile(kvmla + (size_t)T0 * 512 + hd * 128 + 64, 512, VT + ((size_t)(b * 12 + 8 + hd) * 64) * 2048 + s0, smem);
    }
}

constexpr int SM_K = 0;
constexpr int SM_V = 26624;
constexpr int SM_IMP = SM_V + 17408;
constexpr int SM_SEL = SM_IMP + 16896;
constexpr int SM_CTRL = 65536;
constexpr int SM_TOTAL = SM_CTRL + 256;
constexpr int SM_ATTN_END = SM_SEL + 1024;

struct RangeIter { int cur, end; DEV int next() { return cur < end ? cur++ : -1; } };
struct BitIter { unsigned rem; DEV int next() { if (!rem) return -1; const int k = __ffs((int)rem) - 1; rem &= rem - 1; return k; } };
struct LdRow { const bf16_t* base; int ld;
    DEV uint4 operator()(int kt, int id) const { const int row = id >> 3, part = id & 7; return *(const uint4*)(base + (size_t)(kt * 64 + row) * ld + part * 8); } };
struct LdVT { const bf16_t* base;
    DEV uint4 operator()(int kt, int id) const { const int d = id >> 3, part = id & 7; return *(const uint4*)(base + (size_t)d * 2048 + kt * 64 + part * 8); } };
struct LdMlaK { const bf16_t* kv; const bf16_t* kr;
    DEV uint4 operator()(int kt, int id) const { const int row = id / 12, part = id % 12; const size_t t = (size_t)(kt * 64 + row);
        return part < 8 ? *(const uint4*)(kv + t * 512 + part * 8) : *(const uint4*)(kr + t * LDC + (part - 8) * 8); } };

struct MaskCausal { DEV bool on(int) const { return true; } DEV bool ok(int kc, int d) const { return kc <= d; }
    DEV bool full(int kt, int t0w) const { return kt * 64 + 63 <= t0w; } };
template <int W> struct MaskWin { DEV bool on(int) const { return true; } DEV bool ok(int kc, int d) const { return (kc <= d) && (d - kc < W); }
    DEV bool full(int kt, int t0w) const { return (kt * 64 + 63 <= t0w) && (t0w + 31 - kt * 64 < W); } };
struct MaskSel { unsigned bits, allbits; DEV bool on(int kt) const { return (bits >> kt) & 1u; } DEV bool ok(int kc, int d) const { return kc <= d; }
    DEV bool full(int kt, int t0w) const { return ((allbits >> kt) & 1u) && (kt * 64 + 63 <= t0w); } };
template <int KDIM, int NKS, int NSUB, class It, class LK, class LV, class MaskF, class SkipF>
DEV void attn_stream(It it, const LK& ldK, const LV& ldV, const MaskF& maskf, const SkipF& skipf,
                     const bf16x8* qf, f32x16 (&o)[NSUB][2], float (&m)[NSUB], float (&l)[NSUB], float scl, int tq, int t0w, char* smem, int tid, int koff = 0) {
    constexpr int KCH = KDIM / 8, KSTR = KDIM + 8, NKC = (64 * KCH) / 256;
    constexpr int KBUF = 64 * 104, VBUF = 64 * 68;
    bf16_t* Kb = (bf16_t*)(smem + SM_K);
    bf16_t* Vb = (bf16_t*)(smem + SM_V);
    const int lane = tid & 63, ql = lane & 31, hh = lane >> 5;
    const uint4 z4 = make_uint4(0, 0, 0, 0);
    uint4 ak0 = z4, ak1 = z4, ak2 = z4, av0 = z4, av1 = z4, bk0 = z4, bk1 = z4, bk2 = z4, bv0 = z4, bv1 = z4;
    auto loadA = [&](int kt) __attribute__((always_inline)) { ak0 = ldK(kt, tid); ak1 = ldK(kt, tid + 256); if (NKC == 3) ak2 = ldK(kt, tid + 512); av0 = ldV(kt, tid); av1 = ldV(kt, tid + 256); };
    auto loadB = [&](int kt) __attribute__((always_inline)) { bk0 = ldK(kt, tid); bk1 = ldK(kt, tid + 256); if (NKC == 3) bk2 = ldK(kt, tid + 512); bv0 = ldV(kt, tid); bv1 = ldV(kt, tid + 256); };
    auto stK = [&](bf16_t* kb, const uint4& r, int id) __attribute__((always_inline)) { const int row = id / KCH, part = id % KCH; *(uint4*)(kb + row * KSTR + part * 8) = r; };
    auto stV = [&](bf16_t* vb, const uint4& r, int id) __attribute__((always_inline)) { const int row = id >> 3, part = id & 7; bf16_t* d = vb + row * 68 + part * 8;
        *(uint2*)d = make_uint2(r.x, r.y); *(uint2*)(d + 4) = make_uint2(r.z, r.w); };
    auto compute = [&](int kt, const bf16_t* Kt, const bf16_t* Vt) __attribute__((always_inline)) {
        if (skipf(kt)) return;
#pragma unroll
        for (int sub = 0; sub < NSUB; ++sub) {
            __builtin_amdgcn_sched_barrier(0);
            f32x16 s[2];
#pragma unroll
            for (int i = 0; i < 2; ++i) {
                s[i] = zero16();
#pragma unroll
                for (int ks = 0; ks < NKS; ++ks) {
                    const bf16x8 a = *(const bf16x8*)(Kt + (i * 32 + ql) * KSTR + koff + (sub * NKS + ks) * 16 + hh * 8);
                    s[i] = mfma32(a, qf[sub * NKS + ks], s[i]);
                }
            }
            float mx = kNeg;
            if (!maskf.full(kt, t0w)) {
                const int dlim = tq - kt * 64 - 4 * hh;
                const bool on = maskf.on(kt);
#pragma unroll
                for (int i = 0; i < 2; ++i)
#pragma unroll
                    for (int r = 0; r < 16; ++r) {
                        const int kc = i * 32 + (r & 3) + 8 * (r >> 2);
                        s[i][r] = (on && maskf.ok(kc, dlim)) ? s[i][r] : kNeg;
                    }
            }
#pragma unroll
            for (int i = 0; i < 2; ++i)
#pragma unroll
                for (int r = 0; r < 16; ++r) mx = fmaxf(mx, s[i][r]);
            mx = fmaxf(mx, xor32f(mx, lane));
            const float mnew = fmaxf(m[sub], mx);
            const float alpha = __builtin_amdgcn_exp2f((m[sub] - mnew) * scl);
            m[sub] = mnew;
            const float negm = mnew > -1e29f ? -mnew * scl : 0.f;
            float sum = 0.f;
#pragma unroll
            for (int i = 0; i < 2; ++i)
#pragma unroll
                for (int r = 0; r < 16; ++r) { const float pv = __builtin_amdgcn_exp2f(__builtin_fmaf(s[i][r], scl, negm)); s[i][r] = pv; sum += pv; }
            l[sub] = l[sub] * alpha + sum;
#pragma unroll
            for (int dt = 0; dt < 2; ++dt)
#pragma unroll
                for (int r = 0; r < 16; ++r) o[sub][dt][r] *= alpha;
            __builtin_amdgcn_sched_barrier(0);
#pragma unroll
            for (int ks = 0; ks < 4; ++ks) {
                if (ks == 2) __builtin_amdgcn_sched_barrier(0);
                const int i = ks >> 1, r0 = 8 * (ks & 1);
                uint4 pu;
                pu.x = pack2(s[i][r0 + 0], s[i][r0 + 1]); pu.y = pack2(s[i][r0 + 2], s[i][r0 + 3]);
                pu.z = pack2(s[i][r0 + 4], s[i][r0 + 5]); pu.w = pack2(s[i][r0 + 6], s[i][r0 + 7]);
                const bf16x8 pf = __builtin_bit_cast(bf16x8, pu);
#pragma unroll
                for (int dt = 0; dt < 2; ++dt) {
                    const bf16_t* vp = Vt + (dt * 32 + ql) * 68 + ks * 16 + 4 * hh;
                    const uint2 a0 = *(const uint2*)vp, a1 = *(const uint2*)(vp + 8);
                    const bf16x8 a = __builtin_bit_cast(bf16x8, make_uint4(a0.x, a0.y, a1.x, a1.y));
                    o[sub][dt] = mfma32(a, pf, o[sub][dt]);
                }
            }
        }
    };
    int ka = it.next();
    int kb = ka >= 0 ? it.next() : -1;
    if (ka >= 0) loadA(ka);
    if (kb >= 0) loadB(kb);
    while (ka >= 0) {
        __syncthreads();
        stK(Kb, ak0, tid); stK(Kb, ak1, tid + 256); if (NKC == 3) stK(Kb, ak2, tid + 512);
        stV(Vb, av0, tid); stV(Vb, av1, tid + 256);
        if (kb >= 0) {
            stK(Kb + KBUF, bk0, tid); stK(Kb + KBUF, bk1, tid + 256); if (NKC == 3) stK(Kb + KBUF, bk2, tid + 512);
            stV(Vb + VBUF, bv0, tid); stV(Vb + VBUF, bv1, tid + 256);
        }
        __syncthreads();
        const int na = it.next();
        const int nb = na >= 0 ? it.next() : -1;
        if (na >= 0) loadA(na);
        if (nb >= 0) loadB(nb);
        compute(ka, Kb, Vb);
        if (kb >= 0) compute(kb, Kb + KBUF, Vb + VBUF);
        ka = na; kb = nb;
    }
}

DEV void write_o(const f32x16 (&o)[2], bf16_t* obuf, size_t row, int col0, int hh) {
#pragma unroll
    for (int dt = 0; dt < 2; ++dt)
#pragma unroll
        for (int g = 0; g < 4; ++g) {
            const int d = dt * 32 + 8 * g + 4 * hh;
            uint2 u; u.x = pack2(o[dt][4 * g], o[dt][4 * g + 1]); u.y = pack2(o[dt][4 * g + 2], o[dt][4 * g + 3]);
            *(uint2*)(obuf + row * 1024 + col0 + d) = u;
        }
}
DEV float sigmoidf(float x) { return 1.f / (1.f + __expf(-x)); }

DEV void nsa_item(const Params& p, int b, int qb, char* smem) {
    int tid = threadIdx.x; asm volatile("" : "+v"(tid));
    const int lane = tid & 63, w = tid >> 6, ql = lane & 31, hh = lane >> 5;
    char* ws = p.ws;
    const bf16_t* cols = (const bf16_t*)(ws + OFF_COLS);
    const bf16_t* VT = (const bf16_t*)(ws + OFF_VT);
    bf16_t* obuf = (bf16_t*)(ws + OFF_O);
    const int t0 = qb * 32, tq = t0 + ql;
    const size_t Tb = (size_t)b * kS;
    const bf16_t* qrow = cols + (Tb + tq) * LDC;
    bf16x8 qf[4];
#pragma unroll
    for (int ks = 0; ks < 4; ++ks) qf[ks] = *(const bf16x8*)(qrow + w * 64 + ks * 16 + hh * 8);
    const float g0 = sigmoidf(bf2f(qrow[640 + w * 3 + 0])), g1 = sigmoidf(bf2f(qrow[640 + w * 3 + 1])), g2 = sigmoidf(bf2f(qrow[640 + w * 3 + 2]));
    const float scl = 0.125f * kLog2e;
    bf16_t* Kc = (bf16_t*)(smem + SM_K);
    bf16_t* Vc = (bf16_t*)(smem + SM_V);
    float* impP = (float*)(smem + SM_IMP);
    unsigned* selm = (unsigned*)(smem + SM_SEL);
    const bf16_t* kcmp = (const bf16_t*)(ws + OFF_KCMP) + (size_t)b * 128 * 64;
    const bf16_t* vcmp = kcmp + 1024 * 64;
    __syncthreads();
#pragma unroll
    for (int i = 0; i < 4; ++i) {
        const int id = tid + 256 * i, row = id >> 3, part = id & 7;
        uint4 kk = *(const uint4*)(kcmp + row * 64 + part * 8);
        uint4 vv = *(const uint4*)(vcmp + row * 64 + part * 8);
        if (row == 127) { kk = make_uint4(0, 0, 0, 0); vv = kk; }
        *(uint4*)(Kc + row * 72 + part * 8) = kk;
        const unsigned u[4] = {vv.x, vv.y, vv.z, vv.w};
#pragma unroll
        for (int j = 0; j < 4; ++j) { Vc[(part * 8 + 2 * j) * 132 + row] = (bf16_t)(u[j] & 0xffffu); Vc[(part * 8 + 2 * j + 1) * 132 + row] = (bf16_t)(u[j] >> 16); }
    }
    __syncthreads();
    unsigned ocp[16];
    float* invs = (float*)(smem + SM_SEL) + 64;
    {
        const int cmaxv = tq >= 31 ? min((tq - 31) >> 4, 126) : -1;
        float mx = kNeg;
#pragma unroll 1
        for (int i = 0; i < 4; ++i) {
            f32x16 s = zero16();
#pragma unroll
            for (int ks = 0; ks < 4; ++ks) s = mfma32(*(const bf16x8*)(Kc + (i * 32 + ql) * 72 + ks * 16 + hh * 8), qf[ks], s);
            const int clim = cmaxv - i * 32 - 4 * hh;
#pragma unroll
            for (int r = 0; r < 16; ++r) {
                const int kc = (r & 3) + 8 * (r >> 2);
                const bool valid = (kc <= clim);
                mx = fmaxf(mx, valid ? s[r] * scl : kNeg);
            }
        }
        mx = fmaxf(mx, xor32f(mx, lane));
        f32x16 ocmp[2]; ocmp[0] = zero16(); ocmp[1] = zero16();
        float sum = 0.f, carprev = 0.f;
#pragma unroll 1
        for (int i = 0; i < 4; ++i) {
            f32x16 s = zero16();
#pragma unroll
            for (int ks = 0; ks < 4; ++ks) s = mfma32(*(const bf16x8*)(Kc + (i * 32 + ql) * 72 + ks * 16 + hh * 8), qf[ks], s);
            const int clim = cmaxv - i * 32 - 4 * hh;
#pragma unroll
            for (int r = 0; r < 16; ++r) {
                const int kc = (r & 3) + 8 * (r >> 2);
                const bool valid = (kc <= clim);
                const float pv = valid ? __builtin_amdgcn_exp2f(s[r] * scl - mx) : 0.f;
                s[r] = pv; sum += pv;
            }
            float own[4], car[4];
#pragma unroll
            for (int g = 0; g < 4; ++g) { own[g] = s[4 * g] + s[4 * g + 1] + s[4 * g + 2] + 0.5f * s[4 * g + 3]; car[g] = 0.5f * s[4 * g + 3]; }
#pragma unroll
            for (int g = 0; g < 4; ++g) {
                const float send = hh ? (g ? car[g > 0 ? g - 1 : 0] : carprev) : car[g];
                own[g] += xor32f(send, lane);
            }
            carprev = car[3];
#pragma unroll
            for (int g = 0; g < 4; ++g) impP[(w * 32 + ql) * 33 + 2 * (4 * i + g) + hh] = own[g];
#pragma unroll
            for (int sp = 0; sp < 2; ++sp) {
                const int ks = 2 * i + sp, r0 = 8 * sp;
                uint4 pu;
                pu.x = pack2(s[r0 + 0], s[r0 + 1]); pu.y = pack2(s[r0 + 2], s[r0 + 3]);
                pu.z = pack2(s[r0 + 4], s[r0 + 5]); pu.w = pack2(s[r0 + 6], s[r0 + 7]);
                const bf16x8 pf = __builtin_bit_cast(bf16x8, pu);
#pragma unroll
                for (int dt = 0; dt < 2; ++dt) {
                    const bf16_t* vp = Vc + (dt * 32 + ql) * 132 + ks * 16 + 4 * hh;
                    const uint2 a0 = *(const uint2*)vp, a1 = *(const uint2*)(vp + 8);
                    ocmp[dt] = mfma32(__builtin_bit_cast(bf16x8, make_uint4(a0.x, a0.y, a1.x, a1.y)), pf, ocmp[dt]);
                }
            }
        }
        sum += xor32f(sum, lane);
        const float inv = sum > 0.f ? 1.f / sum : 0.f;
        invs[w * 32 + ql] = inv;
        const float f = g0 * inv;
#pragma unroll
        for (int dt = 0; dt < 2; ++dt)
#pragma unroll
            for (int r = 0; r < 8; ++r) ocp[dt * 8 + r] = pack2(f * ocmp[dt][2 * r], f * ocmp[dt][2 * r + 1]);
    }
    __syncthreads();
    const int qblk = t0 >> 6;
    {
        const int hw = tid >> 5, j = tid & 31;
#pragma unroll 1
        for (int rr = 0; rr < 4; ++rr) {
            const int row = hw * 4 + rr;
            const float v = impP[(0 * 32 + row) * 33 + j] * invs[row] + impP[(1 * 32 + row) * 33 + j] * invs[32 + row]
                          + impP[(2 * 32 + row) * 33 + j] * invs[64 + row] + impP[(3 * 32 + row) * 33 + j] * invs[96 + row];
            bool sel;
            if (qblk < 16) sel = (j <= qblk);
            else {
                const bool cand = (j >= 1) && (j <= qblk - 2);
                const bool forced = (j == 0) || (j == qblk) || (j == qblk - 1);
                int rank = 0;
                for (int j2 = 1; j2 <= qblk - 2; ++j2) {
                    const float v2 = lanef(v, (lane & 32) + j2);
                    rank += (v2 > v || (v2 == v && j2 < j)) ? 1 : 0;
                }
                sel = forced || (cand && rank < 13);
            }
            const unsigned long long bal = __ballot(sel);
            const unsigned mk = (lane & 32) ? (unsigned)(bal >> 32) : (unsigned)bal;
            if (j == 0) selm[row] = mk;
        }
    }
    __syncthreads();
    const unsigned mysel = selm[ql];
    unsigned U = mysel, Uall = mysel;
#pragma unroll
    for (int o = 16; o > 0; o >>= 1) { U |= (unsigned)__builtin_amdgcn_ds_bpermute((lane ^ o) << 2, (int)U); Uall &= (unsigned)__builtin_amdgcn_ds_bpermute((lane ^ o) << 2, (int)Uall); }
    Uall = (unsigned)__builtin_amdgcn_readfirstlane((int)Uall);
    {
        f32x16 o1[1][2]; o1[0][0] = zero16(); o1[0][1] = zero16();
        float m1[1] = {kNeg}, l1[1] = {0.f};
        auto skipf = [&](int) __attribute__((always_inline)) { return false; };
        attn_stream<64, 4, 1>(BitIter{U}, LdRow{cols + Tb * LDC + 384, LDC}, LdVT{VT + (size_t)(b * 12 + 0) * 64 * 2048}, MaskSel{mysel, Uall}, skipf, qf, o1, m1, l1, scl, tq, __builtin_amdgcn_readfirstlane(t0), smem, tid);
        const float lt = l1[0] + xor32f(l1[0], lane);
        const float f = g1 / lt;
#pragma unroll
        for (int dt = 0; dt < 2; ++dt)
#pragma unroll
            for (int r = 0; r < 8; ++r) ocp[dt * 8 + r] = pack2(lo16(ocp[dt * 8 + r]) + f * o1[0][dt][2 * r], hi16(ocp[dt * 8 + r]) + f * o1[0][dt][2 * r + 1]);
    }
    {
        f32x16 o1[1][2]; o1[0][0] = zero16(); o1[0][1] = zero16();
        float m1[1] = {kNeg}, l1[1] = {0.f};
        auto skipf = [&](int) __attribute__((always_inline)) { return false; };
        const int lo = t0 >= 511 ? ((t0 - 511) >> 6) : 0;
        attn_stream<64, 4, 1>(RangeIter{lo, qblk + 1}, LdRow{cols + Tb * LDC + 512, LDC}, LdVT{VT + (size_t)(b * 12 + 1) * 64 * 2048}, MaskWin<512>{}, skipf, qf, o1, m1, l1, scl, tq, __builtin_amdgcn_readfirstlane(t0), smem, tid);
        const float lt = l1[0] + xor32f(l1[0], lane);
        const float f = g2 / lt;
#pragma unroll
        for (int dt = 0; dt < 2; ++dt)
#pragma unroll
            for (int r = 0; r < 8; ++r) { o1[0][dt][2 * r] = lo16(ocp[dt * 8 + r]) + f * o1[0][dt][2 * r]; o1[0][dt][2 * r + 1] = hi16(ocp[dt * 8 + r]) + f * o1[0][dt][2 * r + 1]; }
        write_o(o1[0], obuf, Tb + tq, w * 64, hh);
    }
}

DEV void diff_item(const Params& p, int layer, int b, int hd, int q64, char* smem) {
    int tid = threadIdx.x; asm volatile("" : "+v"(tid));
    const int lane = tid & 63, w = tid >> 6, ql = lane & 31, hh = lane >> 5;
    const int sub = w & 1, qbw = w >> 1;
    char* ws = p.ws;
    const bf16_t* cols = (const bf16_t*)(ws + OFF_COLS);
    const bf16_t* VT = (const bf16_t*)(ws + OFF_VT);
    bf16_t* obuf = (bf16_t*)(ws + OFF_O);
    const float* misc = (const float*)(ws + OFF_MISC);
    const int t0w = q64 * 64 + qbw * 32, tq = t0w + ql;
    const size_t Tb = (size_t)b * kS;
    const bf16_t* qrow = cols + (Tb + tq) * LDC + 704 + hd * 64 + sub * 32;
    bf16x8 qf[2];
#pragma unroll
    for (int ks = 0; ks < 2; ++ks) qf[ks] = *(const bf16x8*)(qrow + ks * 16 + hh * 8);
    const float scl = 0.17677669529663687f * kLog2e;
    f32x16 o1[1][2]; o1[0][0] = zero16(); o1[0][1] = zero16();
    float m1[1] = {kNeg}, l1[1] = {0.f};
    auto skipf = [&](int kt) __attribute__((always_inline)) { return kt * 64 > t0w + 31; };
    attn_stream<64, 2, 1>(RangeIter{0, q64 + 1}, LdRow{cols + Tb * LDC + 960 + hd * 64, LDC}, LdVT{VT + (size_t)(b * 12 + 2 + hd) * 64 * 2048}, MaskCausal{}, skipf, qf, o1, m1, l1, scl, tq, __builtin_amdgcn_readfirstlane(t0w), smem, tid, sub * 32);
    const float lam = misc[256 + layer], post = misc[258 + layer];
    const float lt = l1[0] + xor32f(l1[0], lane);
    float* ex = (float*)smem;
    __syncthreads();
    if (sub == 1) {
        const float f = lam / lt;
#pragma unroll
        for (int dt = 0; dt < 2; ++dt)
#pragma unroll
            for (int r = 0; r < 16; ++r) ex[((qbw * 2 + dt) * 16 + r) * 64 + lane] = o1[0][dt][r] * f;
    }
    __syncthreads();
    if (sub == 0) {
        const float f = 1.f / lt;
        float ss = 0.f;
#pragma unroll
        for (int dt = 0; dt < 2; ++dt)
#pragma unroll
            for (int r = 0; r < 16; ++r) { const float v = o1[0][dt][r] * f - ex[((qbw * 2 + dt) * 16 + r) * 64 + lane]; o1[0][dt][r] = v; ss += v * v; }
        ss += xor32f(ss, lane);
        const float rstd = rsqrtf(ss * (1.f / 64.f) + kEps) * post;
        const float* sg = p.sub_g + layer * 64;
#pragma unroll
        for (int dt = 0; dt < 2; ++dt)
#pragma unroll
            for (int r = 0; r < 16; ++r) { const int d = dt * 32 + (r & 3) + 8 * (r >> 2) + 4 * hh; o1[0][dt][r] *= rstd * sg[d]; }
        write_o(o1[0], obuf, Tb + tq, 256 + hd * 64, hh);
    }
}

DEV void mla_item(const Params& p, int b, int hd, int qc, char* smem) {
    int tid = threadIdx.x; asm volatile("" : "+v"(tid));
    const int lane = tid & 63, w = tid >> 6, ql = lane & 31, hh = lane >> 5;
    char* ws = p.ws;
    const bf16_t* cols = (const bf16_t*)(ws + OFF_COLS);
    const bf16_t* VT = (const bf16_t*)(ws + OFF_VT);
    const bf16_t* qmla = (const bf16_t*)(ws + OFF_QMLA);
    const bf16_t* kvmla = (const bf16_t*)(ws + OFF_KVMLA);
    bf16_t* obuf = (bf16_t*)(ws + OFF_O);
    const int t0w = qc * 128 + w * 32, tq = t0w + ql;
    const size_t Tb = (size_t)b * kS;
    const bf16_t* qrow = qmla + (Tb + tq) * 384 + hd * 96;
    bf16x8 qf[6];
#pragma unroll
    for (int ks = 0; ks < 6; ++ks) qf[ks] = *(const bf16x8*)(qrow + ks * 16 + hh * 8);
    const float scl = 0.10206207261596575f * kLog2e;
    f32x16 o1[1][2]; o1[0][0] = zero16(); o1[0][1] = zero16();
    float m1[1] = {kNeg}, l1[1] = {0.f};
    auto skipf = [&](int kt) __attribute__((always_inline)) { return kt * 64 > t0w + 31; };
    attn_stream<96, 6, 1>(RangeIter{0, 2 * qc + 2}, LdMlaK{kvmla + Tb * 512 + hd * 128, cols + Tb * LDC + 1856}, LdVT{VT + (size_t)(b * 12 + 8 + hd) * 64 * 2048}, MaskCausal{}, skipf, qf, o1, m1, l1, scl, tq, __builtin_amdgcn_readfirstlane(t0w), smem, tid);
    const float inv = 1.f / (l1[0] + xor32f(l1[0], lane));
#pragma unroll
    for (int dt = 0; dt < 2; ++dt)
#pragma unroll
        for (int r = 0; r < 16; ++r) o1[0][dt][r] *= inv;
    write_o(o1[0], obuf, Tb + tq, 512 + hd * 64, hh);
}

DEV void swa_item(const Params& p, int layer, int b, int g, int q64, char* smem) {
    int tid = threadIdx.x; asm volatile("" : "+v"(tid));
    const int lane = tid & 63, w = tid >> 6, ql = lane & 31, hh = lane >> 5;
    char* ws = p.ws;
    const bf16_t* cols = (const bf16_t*)(ws + OFF_COLS);
    const bf16_t* VT = (const bf16_t*)(ws + OFF_VT);
    bf16_t* obuf = (bf16_t*)(ws + OFF_O);
    const int head = g * 2 + (w & 1);
    const int t0w = q64 * 64 + (w >> 1) * 32, tq = t0w + ql;
    const size_t Tb = (size_t)b * kS;
    const bf16_t* qrow = cols + (Tb + tq) * LDC + 1920 + head * 64;
    bf16x8 qf[4];
#pragma unroll
    for (int ks = 0; ks < 4; ++ks) qf[ks] = *(const bf16x8*)(qrow + ks * 16 + hh * 8);
    const float scl = 0.125f * kLog2e;
    f32x16 o1[1][2]; o1[0][0] = zero16(); o1[0][1] = zero16();
    float m1[1] = {p.sinks[layer * 4 + head] * 8.f}, l1[1] = {hh == 0 ? 1.f : 0.f};
    auto skipf = [&](int kt) __attribute__((always_inline)) { return (kt * 64 > t0w + 31) || (kt * 64 + 63 < t0w - 127); };
    const int lo = q64 >= 2 ? q64 - 2 : 0;
    attn_stream<64, 4, 1>(RangeIter{lo, q64 + 1}, LdRow{cols + Tb * LDC + 2176 + g * 64, LDC}, LdVT{VT + (size_t)(b * 12 + 6 + g) * 64 * 2048}, MaskWin<128>{}, skipf, qf, o1, m1, l1, scl, tq, __builtin_amdgcn_readfirstlane(t0w), smem, tid);
    const float inv = 1.f / (l1[0] + xor32f(l1[0], lane));
#pragma unroll
    for (int dt = 0; dt < 2; ++dt)
#pragma unroll
        for (int r = 0; r < 16; ++r) o1[0][dt][r] *= inv;
    write_o(o1[0], obuf, Tb + tq, 768 + head * 64, hh);
}

DEV void phase_attn(const Params& p, int layer, char* smem, int rep = 0) {
    unsigned* ctr = (unsigned*)(p.ws + OFF_CTRL) + 64 + layer * 16 + rep;
    volatile int* slot = (volatile int*)(smem + SM_SEL) + 48;
    for (;;) {
        __syncthreads();
        if (ltid() == 0) *slot = (int)atomicAdd(ctr, 1u);
        __syncthreads();
        const int idx = __builtin_amdgcn_readfirstlane(*slot);
        if (idx >= 2560) break;
        const int level = 15 - idx / 160, r = idx % 160;
#if TS_A >= 0
        const unsigned long long tsa = __builtin_amdgcn_s_memrealtime();
#endif
        if (r < 64) { const int b = (r & 31) >> 2; diff_item(p, layer, b, r & 3, level * 2 + (1 - (r >> 5)), smem); }
        else if (r < 96) { const int k = r - 64; mla_item(p, k >> 2, k & 3, level, smem); }
        else if (r < 128) { const int k = r - 96; nsa_item(p, k >> 2, level * 4 + (3 - (k & 3)), smem); }
        else { const int k = r - 128; swa_item(p, layer, k >> 2, (k >> 1) & 1, level * 2 + (k & 1), smem); }
#if TS_A >= 0
        if (threadIdx.x == 0 && layer == 1) {
            const int ty = r < 64 ? 0 : r < 96 ? 1 : r < 128 ? 2 : 3;
            unsigned long long* ts = (unsigned long long*)(p.ws + 32768);
            atomicAdd(&ts[60 + ty], (unsigned long long)(__builtin_amdgcn_s_memrealtime() - tsa));
        }
#endif
    }
}

#define XB_TMO      128
#define XB_XCNT(j)  (256  + 64 * (j))
#define XB_XSUB(j)  (1280 + 64 * (j))
#define XB_XGEN(j)  (2304 + 64 * (j))
#define XB_TOP      3328
#define XB_TOPGEN   3392
#define XB_SPIN_CAP (1u << 22)
DEV unsigned xb_ld(unsigned* p) { return __hip_atomic_load(p, __ATOMIC_RELAXED, __HIP_MEMORY_SCOPE_AGENT); }
DEV unsigned xb_add(unsigned* p, unsigned v) { return __hip_atomic_fetch_add(p, v, __ATOMIC_RELAXED, __HIP_MEMORY_SCOPE_AGENT); }
DEV unsigned xb_xcc_id() { return (unsigned)__builtin_amdgcn_s_getreg((3 << 11) | 20) & 0xFu; }
#define XB_SPIN(cond, bar) do { unsigned _sp = 0; while (cond) { __builtin_amdgcn_s_sleep(1); \
    if ((++_sp & 255u) == 0u) { if (xb_ld(&(bar)[XB_TMO])) break; if (_sp > XB_SPIN_CAP) { atomicAdd(&(bar)[XB_TMO], 1u); break; } } } } while (0)
struct XcdBarrier { unsigned* bar; unsigned x; volatile LAS unsigned* st; };
DEV XcdBarrier xcd_barrier_post(unsigned* bar, volatile LAS unsigned* st) {
    XcdBarrier b; b.bar = bar; b.x = xb_xcc_id(); b.st = st;
    if (threadIdx.x == 0) st[2] = xb_add(&bar[XB_XCNT(b.x)], 1u);
    return b;
}
DEV void xcd_barrier_complete(unsigned* bar, unsigned x, unsigned& nloc, unsigned& nx) {
    const unsigned G = gridDim.x * gridDim.y * gridDim.z;
    unsigned sum, cnt, mine, sp = 0u;
    for (;;) {
        sum = 0u; cnt = 0u; mine = 0u;
#pragma unroll
        for (unsigned j = 0; j < 16; ++j) { const unsigned c = xb_ld(&bar[XB_XCNT(j)]); sum += c; cnt += (c > 0u) ? 1u : 0u; mine = (j == x) ? c : mine; }
        if (sum == G) break;
        __builtin_amdgcn_s_sleep(1);
        if ((++sp & 255u) == 0u) { if (xb_ld(&bar[XB_TMO])) break; if (sp > XB_SPIN_CAP) { atomicAdd(&bar[XB_TMO], 1u); break; } }
    }
    nloc = mine > 0u ? mine : 1u; nx = cnt > 0u ? cnt : 1u;
}
DEV void xcd_barrier(const XcdBarrier& b) {
    asm volatile("s_waitcnt vmcnt(0)" ::: "memory");
    __syncthreads();
    if (threadIdx.x == 0) {
        unsigned* bar = b.bar;
        asm volatile("" : "+v"(bar));
        __builtin_amdgcn_s_waitcnt(0);
        unsigned nloc = b.st[0], nx = b.st[1];
        if (nloc == 0u) { xcd_barrier_complete(bar, b.x, nloc, nx); b.st[0] = nloc; b.st[1] = nx; }
        const unsigned old = xb_add(&bar[XB_XSUB(b.x)], 1u);
        const unsigned gen = old / nloc;
        if (old + 1u == (gen + 1u) * nloc) {
            __builtin_amdgcn_fence(__ATOMIC_RELEASE, "agent");
            asm volatile("s_waitcnt vmcnt(0)" ::: "memory");
            const unsigned og = xb_add(&bar[XB_TOP], 1u);
            const unsigned tg = og / nx;
            if (og + 1u == (tg + 1u) * nx) xb_add(&bar[XB_TOPGEN], 1u);
            else XB_SPIN(xb_ld(&bar[XB_TOPGEN]) == tg, bar);
            __builtin_amdgcn_fence(__ATOMIC_ACQUIRE, "agent");
            xb_add(&bar[XB_XGEN(b.x)], 1u);
            asm volatile("s_waitcnt vmcnt(0)" ::: "memory");
        } else {
            XB_SPIN(xb_ld(&bar[XB_XGEN(b.x)]) == gen, bar);
            __builtin_amdgcn_fence(__ATOMIC_ACQUIRE, "agent");
            asm volatile("s_waitcnt vmcnt(0)" ::: "memory");
        }
    }
    __syncthreads();
}

DEV unsigned fkey(float f) { const unsigned u = __float_as_uint(f); return (u & 0x80000000u) ? ~u : (u | 0x80000000u); }
DEV float funkey(unsigned k) { return __uint_as_float((k & 0x80000000u) ? (k & 0x7fffffffu) : ~k); }
DEV void ins16(unsigned (&L)[16], unsigned x) {
#pragma unroll
    for (int i = 15; i >= 1; --i) { unsigned r; asm("v_med3_u32 %0, %1, %2, %3" : "=v"(r) : "v"(L[i - 1]), "v"(L[i]), "v"(x)); L[i] = r; }
    L[0] = L[0] > x ? L[0] : x;
}
DEV void phase_topk(const Params& p, char* smem) {
    const int tid = ltid();
    const float* S1 = (const float*)(p.ws + OFF_S1);
    const float* S2 = (const float*)(p.ws + OFF_S2);
    int* eid = (int*)(p.ws + OFF_EID);
    float* gate = (float*)(p.ws + OFF_GATE);
    unsigned char* ib = (unsigned char*)smem + tid * 32;
    for (int blk = blockIdx.x; blk < kT * 8 / 256; blk += gridDim.x) {
        const size_t row = (size_t)blk * 256 + tid;
        unsigned L1[16], L2[16];
#pragma unroll
        for (int i = 0; i < 16; ++i) { L1[i] = 0u; L2[i] = 0u; }
#pragma unroll 4
        for (int k = 0; k < 128; ++k) {
            const float a = S1[(size_t)k * (kT * 8) + row], b = S2[(size_t)k * (kT * 8) + row];
            ins16(L1, (fkey(a) & ~127u) | (unsigned)(127 - k));
            ins16(L2, (fkey(b) & ~127u) | (unsigned)(127 - k));
        }
        float v1[16], v2[16];
        __syncthreads();
#pragma unroll
        for (int i = 0; i < 16; ++i) {
            v1[i] = funkey(L1[i] & ~127u); v2[i] = funkey(L2[i] & ~127u);
            ib[i] = (unsigned char)(127u - (L1[i] & 127u)); ib[16 + i] = (unsigned char)(127u - (L2[i] & 127u));
        }
        unsigned C[16];
#pragma unroll
        for (int i = 0; i < 16; ++i) C[i] = 0u;
#pragma unroll
        for (int a = 0; a < 16; ++a)
#pragma unroll
            for (int b = 0; b < 16; ++b)
                if ((a + 1) * (b + 1) <= 16) ins16(C, (fkey(v1[a] + v2[b]) & ~255u) | (unsigned)(255 - (a * 16 + b)));
        float ts[16]; float sum = 0.f;
        const float tmax = funkey(C[0] & ~255u);
#pragma unroll
        for (int i = 0; i < 16; ++i) { ts[i] = __expf(funkey(C[i] & ~255u) - tmax); sum += ts[i]; }
        const float inv = 1.f / sum;
        int ev[16];
#pragma unroll
        for (int i = 0; i < 16; ++i) { const unsigned ci = 255u - (C[i] & 255u); ev[i] = (int)ib[ci >> 4] * 128 + (int)ib[16 + (ci & 15u)]; }
#pragma unroll
        for (int i = 0; i < 4; ++i) {
            *(int4*)(eid + row * 16 + 4 * i) = make_int4(ev[4 * i], ev[4 * i + 1], ev[4 * i + 2], ev[4 * i + 3]);
            *(float4*)(gate + row * 16 + 4 * i) = make_float4(ts[4 * i] * inv, ts[4 * i + 1] * inv, ts[4 * i + 2] * inv, ts[4 * i + 3] * inv);
        }
    }
}

struct EpiTop16 {
    unsigned (&L)[16];
    DEV void tile(int, int, const float* Cs, int tid) const {
        const int r = tid & 127, hk = tid >> 7;
        unsigned T[16];
#pragma unroll
        for (int i = 0; i < 16; ++i) T[i] = 0u;
#pragma unroll 4
        for (int k = 0; k < 64; ++k) {
            const int key = hk * 64 + k;
            ins16(T, (fkey(Cs[key * 128 + r]) & ~127u) | (unsigned)(127 - key));
        }
        __syncthreads();
        unsigned* X = (unsigned*)Cs;
        if (hk) {
#pragma unroll
            for (int i = 0; i < 16; ++i) X[r * 17 + i] = T[i];
        }
        __syncthreads();
        if (!hk) {
#pragma unroll
            for (int i = 0; i < 16; ++i) ins16(T, X[r * 17 + i]);
        }
#pragma unroll
        for (int i = 0; i < 16; ++i) L[i] = T[i];
    }
};
DEV void phase_route(const Params& p, int layer, char* smem) {
    char* ws = p.ws;
    int* eid = (int*)(ws + OFF_EID);
    float* gate = (float*)(ws + OFF_GATE);
    const bf16_t* qp = (const bf16_t*)(ws + OFF_QP);
    const bf16_t* subk = (const bf16_t*)(ws + OFF_SUBK) + (size_t)(layer * 2) * 16384;
    for (int nt = blockIdx.x; nt < kT * 8 / 128; nt += gridDim.x) {
        unsigned L1[16], L2[16];
        { EpiTop16 e1{L1}; gemm_tile(subk, 128, qp, 256, 128, 0, nt * 128, smem, e1); }
        { EpiTop16 e2{L2}; gemm_tile(subk + 16384, 128, qp + 128, 256, 128, 0, nt * 128, smem, e2); }
        const int tid = ltid();
        __syncthreads();
        if (tid < 128) {
            const size_t row = (size_t)nt * 128 + tid;
            unsigned char* ib = (unsigned char*)smem + tid * 32;
            float v1[16], v2[16];
#pragma unroll
            for (int i = 0; i < 16; ++i) {
                v1[i] = funkey(L1[i] & ~127u); v2[i] = funkey(L2[i] & ~127u);
                ib[i] = (unsigned char)(127u - (L1[i] & 127u)); ib[16 + i] = (unsigned char)(127u - (L2[i] & 127u));
            }
            unsigned C[16];
#pragma unroll
            for (int i = 0; i < 16; ++i) C[i] = 0u;
#pragma unroll
            for (int a = 0; a < 16; ++a)
#pragma unroll
                for (int b = 0; b < 16; ++b)
                    if ((a + 1) * (b + 1) <= 16) ins16(C, (fkey(v1[a] + v2[b]) & ~255u) | (unsigned)(255 - (a * 16 + b)));
            float ts[16]; float sum = 0.f;
            const float tmax = funkey(C[0] & ~255u);
#pragma unroll
            for (int i = 0; i < 16; ++i) { ts[i] = __expf(funkey(C[i] & ~255u) - tmax); sum += ts[i]; }
            const float inv = 1.f / sum;
            int ev[16];
#pragma unroll
            for (int i = 0; i < 16; ++i) { const unsigned ci = 255u - (C[i] & 255u); ev[i] = (int)ib[ci >> 4] * 128 + (int)ib[16 + (ci & 15u)]; }
#pragma unroll
            for (int i = 0; i < 4; ++i) {
                *(int4*)(eid + row * 16 + 4 * i) = make_int4(ev[4 * i], ev[4 * i + 1], ev[4 * i + 2], ev[4 * i + 3]);
                *(float4*)(gate + row * 16 + 4 * i) = make_float4(ts[4 * i] * inv, ts[4 * i + 1] * inv, ts[4 * i + 2] * inv, ts[4 * i + 3] * inv);
            }
        }
    }
}

DEV float row_sum_dpp(float v) {
    v += __int_as_float(__builtin_amdgcn_update_dpp(0, __float_as_int(v), 0xB1, 0xF, 0xF, true));
    v += __int_as_float(__builtin_amdgcn_update_dpp(0, __float_as_int(v), 0x4E, 0xF, 0xF, true));
    v += __int_as_float(__builtin_amdgcn_update_dpp(0, __float_as_int(v), 0x141, 0xF, 0xF, true));
    v += __int_as_float(__builtin_amdgcn_update_dpp(0, __float_as_int(v), 0x140, 0xF, 0xF, true));
    return v;
}
DEV float wave_sum_dpp(float v) {
    v = row_sum_dpp(v);
    const float r0 = __int_as_float(__builtin_amdgcn_readlane(__float_as_int(v), 0)), r1 = __int_as_float(__builtin_amdgcn_readlane(__float_as_int(v), 16));
    const float r2 = __int_as_float(__builtin_amdgcn_readlane(__float_as_int(v), 32)), r3 = __int_as_float(__builtin_amdgcn_readlane(__float_as_int(v), 48));
    return (r0 + r1) + (r2 + r3);
}
typedef float f32x2 __attribute__((ext_vector_type(2)));
typedef float f32x4 __attribute__((ext_vector_type(4)));

struct SliceMap { int virt, nx, nloc, rank; };
DEV SliceMap slice_map(const Params& p, char* smem) {
    unsigned* bar = (unsigned*)p.ws;
    const unsigned x = xb_xcc_id();
    int virt = 0, nx = 0, nloc = 1;
#pragma unroll
    for (unsigned j = 0; j < 16; ++j) {
        const unsigned c = xb_ld(&bar[XB_XCNT(j)]);
        if (c > 0u) { if (j < x) ++virt; ++nx; }
        if (j == x) nloc = (int)c;
    }
    SliceMap m;
    m.virt = __builtin_amdgcn_readfirstlane(virt); m.nx = __builtin_amdgcn_readfirstlane(nx > 0 ? nx : 1); m.nloc = __builtin_amdgcn_readfirstlane(nloc > 0 ? nloc : 1);
    m.rank = __builtin_amdgcn_readfirstlane((int)((volatile LAS unsigned*)(smem + SM_CTRL))[2]);
    return m;
}

typedef _Float16 half2_t __attribute__((ext_vector_type(2)));
DEV void phase_peer_u(const Params& p, int layer, char* smem, int rep = 0) {
    const int tid = ltid(), lane = tid & 63, w = tid >> 6, l8 = lane & 7, grp = lane >> 3;
    char* ws = p.ws;
    const SliceMap sm = slice_map(p, smem);
    const bf16_t* h = (const bf16_t*)(ws + OFF_H);
    const int* eid = (const int*)(ws + OFF_EID);
    float* part = (float*)(ws + OFF_S1) + (rep ? (size_t)8 * kT * 128 : 0);
    int* ids_l = (int*)(smem + w * 9216);
    const int nk = sm.rank < 512 ? (512 - sm.rank + sm.nloc - 1) / sm.nloc : 0;
    for (int s = sm.virt; s < 8; s += sm.nx) {
        if (nk == 0) break;
        const unsigned char* U = (const unsigned char*)(ws + OFF_PU) + (((size_t)layer * 8 + s) * 16384 << 7) + l8 * 16;
        uint4 ri0, ri1, ri2, ri3, rh0, rh1;
        auto load_oct = [&](int k) __attribute__((always_inline)) {
            const size_t o = (size_t)(sm.rank + k * sm.nloc) * 4 + w;
            const uint4* ip = (const uint4*)(eid + o * 1024) + lane;
            ri0 = ip[0]; ri1 = ip[64]; ri2 = ip[128]; ri3 = ip[192];
            const bf16_t* hp = h + (o * 8 + grp) * 1024 + s * 128 + l8 * 16;
            rh0 = *(const uint4*)hp; rh1 = *(const uint4*)(hp + 8);
        };
        half2_t hh[8];
        auto store_oct = [&]() __attribute__((always_inline)) {
            uint4* il = (uint4*)ids_l + lane;
            il[0] = ri0; il[64] = ri1; il[128] = ri2; il[192] = ri3;
            const unsigned hu[8] = {rh0.x, rh0.y, rh0.z, rh0.w, rh1.x, rh1.y, rh1.z, rh1.w};
#pragma unroll
            for (int i = 0; i < 8; ++i) hh[i] = (half2_t){(_Float16)lo16(hu[i]), (_Float16)hi16(hu[i])};
        };
        load_oct(0); store_oct();
#pragma unroll 1
        for (int k = 0; k < nk; ++k) {
            if (k + 1 < nk) load_oct(k + 1);
            const size_t o = (size_t)(sm.rank + k * sm.nloc) * 4 + w;
            float* pp = part + ((size_t)s * kT + o * 8 + grp) * 128 + l8;
            uint4 va[8], vb[8];
            auto issue = [&](uint4 (&v)[8], int c) __attribute__((always_inline)) {
                const int4 i0 = *(const int4*)(ids_l + grp * 128 + c * 8), i1 = *(const int4*)(ids_l + grp * 128 + c * 8 + 4);
                const int e[8] = {i0.x, i0.y, i0.z, i0.w, i1.x, i1.y, i1.z, i1.w};
#pragma unroll
                for (int j = 0; j < 8; ++j) v[j] = *(const uint4*)(U + ((size_t)e[j] << 7));
            };
            auto compute = [&](const uint4 (&v)[8], int c) __attribute__((always_inline)) {
                float res = 0.f;
#pragma unroll
                for (int j = 0; j < 8; ++j) {
                    const unsigned d[4] = {v[j].x, v[j].y, v[j].z, v[j].w};
                    float acc = 0.f;
#pragma unroll
                    for (int q = 0; q < 4; ++q) {
                        const half2_t lo = __builtin_amdgcn_cvt_scalef32_pk_f16_fp8(d[q], 1.0f, false);
                        const half2_t hi = __builtin_amdgcn_cvt_scalef32_pk_f16_fp8(d[q], 1.0f, true);
                        acc = __builtin_amdgcn_fdot2(lo, hh[2 * q], acc, false);
                        acc = __builtin_amdgcn_fdot2(hi, hh[2 * q + 1], acc, false);
                    }
                    acc += __int_as_float(__builtin_amdgcn_update_dpp(0, __float_as_int(acc), 0xB1, 0xF, 0xF, true));
                    acc += __int_as_float(__builtin_amdgcn_update_dpp(0, __float_as_int(acc), 0x4E, 0xF, 0xF, true));
                    acc += __int_as_float(__builtin_amdgcn_update_dpp(0, __float_as_int(acc), 0x141, 0xF, 0xF, true));
                    res = (l8 == j) ? acc : res;
                    __builtin_amdgcn_sched_barrier(0);
                }
                pp[c * 8] = res;
            };
            issue(va, 0);
#pragma unroll
            for (int c = 0; c < 16; c += 2) {
                issue(vb, c + 1);
                __builtin_amdgcn_sched_barrier(0);
                compute(va, c);
                __builtin_amdgcn_sched_barrier(0);
                if (c + 2 < 16) issue(va, c + 2);
                __builtin_amdgcn_sched_barrier(0);
                compute(vb, c + 1);
                __builtin_amdgcn_sched_barrier(0);
            }
            if (k + 1 < nk) store_oct();
        }
    }
}

DEV void phase_peer_comb(const Params& p, int rep = 0) {
    const int tid = ltid();
    const float* part = (const float*)(p.ws + OFF_S1);
    float* gate = (float*)(p.ws + OFF_GATE);
    for (size_t i = (size_t)blockIdx.x * 256 + tid; i < (size_t)kT * 128 / 4; i += (size_t)gridDim.x * 256) {
        float4 a = *(const float4*)(part + i * 4);
#pragma unroll
        for (int x = 1; x < 8; ++x) { const float4 b = *(const float4*)(part + (size_t)x * kT * 128 + i * 4); a.x += b.x; a.y += b.y; a.z += b.z; a.w += b.w; }
        const float4 g = *(const float4*)(gate + i * 4);
        float4 o;
        o.x = g.x * gelu_tanh(a.x * (1.f / kScaleU)); o.y = g.y * gelu_tanh(a.y * (1.f / kScaleU));
        o.z = g.z * gelu_tanh(a.z * (1.f / kScaleU)); o.w = g.w * gelu_tanh(a.w * (1.f / kScaleU));
        if (rep == 0) *(float4*)(gate + i * 4) = o;
    }
}

DEV void phase_peer_v(const Params& p, int layer, char* smem, int rep = 0) {
    const int tid = ltid(), lane = tid & 63, w = tid >> 6, l8 = lane & 7, grp = lane >> 3;
    char* ws = p.ws;
    const SliceMap sm = slice_map(p, smem);
    float* xres = (float*)(ws + OFF_XRES);
    const int* eid = (const int*)(ws + OFF_EID);
    const float* wbuf = (const float*)(ws + OFF_GATE);
    const float* mod = (const float*)(ws + OFF_MOD);
    int* ids_l = (int*)(smem + w * 9216);
    float* w_l = (float*)(smem + w * 9216 + 4096);
    const int nk = sm.rank < 512 ? (512 - sm.rank + sm.nloc - 1) / sm.nloc : 0;
    for (int s = sm.virt; s < 8; s += sm.nx) {
        if (nk == 0) break;
        const unsigned char* V = (const unsigned char*)(ws + OFF_PV) + (((size_t)layer * 8 + s) * 16384 << 7) + l8 * 16;
        uint4 ri0, ri1, ri2, ri3, rw0, rw1, rw2, rw3;
        auto load_oct = [&](int k) __attribute__((always_inline)) {
            const size_t o = (size_t)(sm.rank + k * sm.nloc) * 4 + w;
            const uint4* ip = (const uint4*)(eid + o * 1024) + lane;
            const uint4* wp = (const uint4*)(wbuf + o * 1024) + lane;
            ri0 = ip[0]; ri1 = ip[64]; ri2 = ip[128]; ri3 = ip[192];
            rw0 = wp[0]; rw1 = wp[64]; rw2 = wp[128]; rw3 = wp[192];
        };
        auto store_oct = [&]() __attribute__((always_inline)) {
            uint4* il = (uint4*)ids_l + lane; uint4* wl = (uint4*)w_l + lane;
            il[0] = ri0; il[64] = ri1; il[128] = ri2; il[192] = ri3;
            wl[0] = rw0; wl[64] = rw1; wl[128] = rw2; wl[192] = rw3;
        };
        load_oct(0); store_oct();
#pragma unroll 1
        for (int k = 0; k < nk; ++k) {
            if (k + 1 < nk) load_oct(k + 1);
            const size_t o = (size_t)(sm.rank + k * sm.nloc) * 4 + w;
            const size_t t = o * 8 + grp;
            const int b = (int)(t >> 11);
            float* xp = xres + t * 1024 + s * 128 + l8 * 16;
            const float* g2 = mod + (size_t)(layer * 8 + b) * 6144 + 5120 + s * 128 + l8 * 16;
            float4 xa[4];
#pragma unroll
            for (int c = 0; c < 4; ++c) xa[c] = *(const float4*)(xp + c * 4);
            half2_t out[8];
#pragma unroll
            for (int j = 0; j < 8; ++j) out[j] = (half2_t){(_Float16)0.f, (_Float16)0.f};
            uint4 va[8], vb[8];
            auto issue = [&](uint4 (&v)[8], int c) __attribute__((always_inline)) {
                const int4 i0 = *(const int4*)(ids_l + grp * 128 + c * 8), i1 = *(const int4*)(ids_l + grp * 128 + c * 8 + 4);
                const int e[8] = {i0.x, i0.y, i0.z, i0.w, i1.x, i1.y, i1.z, i1.w};
#pragma unroll
                for (int j = 0; j < 8; ++j) v[j] = *(const uint4*)(V + ((size_t)e[j] << 7));
            };
            auto compute = [&](const uint4 (&v)[8], int c) __attribute__((always_inline)) {
                const float4 w0 = *(const float4*)(w_l + grp * 128 + c * 8), w1 = *(const float4*)(w_l + grp * 128 + c * 8 + 4);
                const float wf[8] = {w0.x, w0.y, w0.z, w0.w, w1.x, w1.y, w1.z, w1.w};
#pragma unroll
                for (int j = 0; j < 8; ++j) {
                    const _Float16 wh = (_Float16)wf[j];
                    const half2_t ww = {wh, wh};
                    const unsigned d[4] = {v[j].x, v[j].y, v[j].z, v[j].w};
#pragma unroll
                    for (int q = 0; q < 4; ++q) {
                        const half2_t lo = __builtin_amdgcn_cvt_scalef32_pk_f16_fp8(d[q], 1.0f, false);
                        const half2_t hi = __builtin_amdgcn_cvt_scalef32_pk_f16_fp8(d[q], 1.0f, true);
                        out[2 * q] = __builtin_elementwise_fma(ww, lo, out[2 * q]);
                        out[2 * q + 1] = __builtin_elementwise_fma(ww, hi, out[2 * q + 1]);
                    }
                    __builtin_amdgcn_sched_barrier(0);
                }
            };
            issue(va, 0);
#pragma unroll
            for (int c = 0; c < 16; c += 2) {
                issue(vb, c + 1);
                __builtin_amdgcn_sched_barrier(0);
                compute(va, c);
                __builtin_amdgcn_sched_barrier(0);
                if (c + 2 < 16) issue(va, c + 2);
                __builtin_amdgcn_sched_barrier(0);
                compute(vb, c + 1);
                __builtin_amdgcn_sched_barrier(0);
            }
            if (rep == 0 || (float)out[0].x == 12345.678f) {
#pragma unroll
                for (int c = 0; c < 4; ++c) {
                    const float4 g4 = *(const float4*)(g2 + c * 4);
                    xa[c].x += g4.x * (float)out[2 * c].x * (1.f / kScaleV); xa[c].y += g4.y * (float)out[2 * c].y * (1.f / kScaleV);
                    xa[c].z += g4.z * (float)out[2 * c + 1].x * (1.f / kScaleV); xa[c].w += g4.w * (float)out[2 * c + 1].y * (1.f / kScaleV);
                    *(float4*)(xp + c * 4) = xa[c];
                }
            }
            if (k + 1 < nk) store_oct();
        }
    }
}

DEV void phase_final(const Params& p) {
    const int tid = ltid(), lane = tid & 63, w = tid >> 6;
    const float* xs = (const float*)(p.ws + OFF_XRES);
    float4 g4[4];
#pragma unroll
    for (int i = 0; i < 4; ++i) g4[i] = *(const float4*)(p.final_g + i * 256 + lane * 4);
    for (int q0 = blockIdx.x; q0 < kT / 4; q0 += gridDim.x * 4) {
        float4 v[4][4];
#pragma unroll
        for (int u = 0; u < 4; ++u) {
            const int q = q0 + u * gridDim.x < kT / 4 ? q0 + u * gridDim.x : q0;
            const float* xr = xs + (size_t)(q * 4 + w) * 1024;
#pragma unroll
            for (int i = 0; i < 4; ++i) v[u][i] = *(const float4*)(xr + i * 256 + lane * 4);
        }
#pragma unroll
        for (int u = 0; u < 4; ++u) {
            const int q = q0 + u * gridDim.x;
            if (q >= kT / 4) break;
            const int t = q * 4 + w;
            float ss = 0.f;
#pragma unroll
            for (int i = 0; i < 4; ++i) ss += v[u][i].x * v[u][i].x + v[u][i].y * v[u][i].y + v[u][i].z * v[u][i].z + v[u][i].w * v[u][i].w;
            ss = wave_sum(ss);
            const float rstd = rsqrtf(ss * (1.f / 1024.f) + kEps);
#pragma unroll
            for (int i = 0; i < 4; ++i) {
                const int col = i * 256 + lane * 4;
                *(float4*)(p.out + (size_t)t * 1024 + col) = make_float4(v[u][i].x * rstd * g4[i].x, v[u][i].y * rstd * g4[i].y, v[u][i].z * rstd * g4[i].z, v[u][i].w * rstd * g4[i].w);
            }
        }
    }
}

DEV void phase_gemm_in(const Params& p, int layer, char* smem) {
    char* ws = p.ws;
    EpiBf16 epi{(bf16_t*)(ws + OFF_COLS), LDC, nullptr, nullptr, LDC};
    gemm_phase((const bf16_t*)(ws + OFF_H), 1024, (const bf16_t*)(ws + OFF_WIN) + (size_t)layer * 2432 * 1024, 1024, 1024, kT / 128, LDC / 128, smem, epi);
}
DEV void phase_gemm_mid(const Params& p, int layer, char* smem) {
    char* ws = p.ws;
    const float* misc = (const float*)(ws + OFF_MISC);
    const float* rstd = (const float*)(ws + OFF_RSTD);
    const bf16_t* cols = (const bf16_t*)(ws + OFF_COLS);
    for (int tile = blockIdx.x; tile < 128 + 384 + 512; tile += gridDim.x) {
        if (tile < 128) {
            const int kv = tile >> 6, mt = (tile >> 3) & 7, ks = tile & 7;
            EpiF32 epi{(float*)(ws + OFF_QP) + (size_t)(kv * 8 + ks) * 1024 * 128, 128};
            gemm_tile((const bf16_t*)(ws + (kv ? OFF_VC : OFF_KC)) + ks * 256, 1024,
                      (const bf16_t*)(ws + (kv ? OFF_WCV : OFF_WCK)) + (size_t)layer * 128 * 2048 + ks * 256, 2048, 256, mt * 128, 0, smem, epi);
        } else if (tile < 128 + 384) {
            const int tt = tile - 128;
            EpiBf16 epi{(bf16_t*)(ws + OFF_QMLA), 384, rstd, nullptr, 384};
            gemm_tile(cols + 1472, LDC, (const bf16_t*)(ws + OFF_WUQ) + (size_t)layer * 384 * 256, 256, 256, (tt / 3) * 128, (tt % 3) * 128, smem, epi);
        } else {
            const int tt = tile - 128 - 384;
            EpiBf16 epi{(bf16_t*)(ws + OFF_KVMLA), 512, rstd + kT, nullptr, 512};
            gemm_tile(cols + 1728, LDC, (const bf16_t*)(ws + OFF_WUKV) + (size_t)layer * 512 * 128, 128, 128, (tt / 4) * 128, (tt % 4) * 128, smem, epi);
        }
    }
}
DEV void phase_gemm_out(const Params& p, int layer, char* smem) {
    char* ws = p.ws;
    EpiRes epi{layer == 0 ? p.x : (const float*)(ws + OFF_XRES), (float*)(ws + OFF_XRES), (const float*)(ws + OFF_MOD) + (size_t)layer * 8 * 6144 + 2048};
    gemm_phase((const bf16_t*)(ws + OFF_O), 1024, (const bf16_t*)(ws + OFF_WOUT) + (size_t)layer * 1024 * 1024, 1024, 1024, kT / 128, 8, smem, epi);
}
DEV void phase_gemm_wq(const Params& p, int layer, char* smem) {
    char* ws = p.ws;
    EpiBf16 epi{(bf16_t*)(ws + OFF_QP), 2048, nullptr, nullptr, 2048};
    gemm_phase((const bf16_t*)(ws + OFF_H), 1024, (const bf16_t*)(ws + OFF_WQ) + (size_t)layer * 2048 * 1024, 1024, 1024, kT / 128, 16, smem, epi);
}
DEV void phase_scores(const Params& p, int layer, char* smem) {
    char* ws = p.ws;
    for (int tile = blockIdx.x; tile < 2048; tile += gridDim.x) {
        const int c = tile >> 10, nt = tile & 1023;
        EpiF32 epi{(float*)(ws + (c ? OFF_S2 : OFF_S1)), kT * 8};
        gemm_tile((const bf16_t*)(ws + OFF_SUBK) + (size_t)(layer * 2 + c) * 16384, 128, (const bf16_t*)(ws + OFF_QP) + c * 128, 256, 128, 0, nt * 128, smem, epi);
    }
}

constexpr int NPHASE = 16;
DEV void run_phase(const Params& p, int ph, int layer, char* smem, int rep = 0) {
    switch (ph) {
        case 0: phase_prologue(p, smem); break;
        case 1: phase_norm(p, layer, 0); break;
        case 2: phase_gemm_in(p, layer, smem); break;
        case 3: phase_layout1(p, smem); break;
        case 4: phase_gemm_mid(p, layer, smem); break;
        case 5: phase_layout2(p, layer, smem); break;
        case 6: phase_attn(p, layer, smem, rep); break;
        case 7: phase_gemm_out(p, layer, smem); break;
        case 8: phase_norm(p, layer, 1); break;
        case 9: phase_gemm_wq(p, layer, smem); break;
        case 10: phase_route(p, layer, smem); break;
        case 11: phase_topk(p, smem); break;
        case 12: phase_peer_u(p, layer, smem, rep); break;
        case 13: phase_peer_comb(p, rep); break;
        case 14: phase_peer_v(p, layer, smem, rep); break;
        case 15: if (layer == 0) phase_norm(p, 1, 0); else phase_final(p); break;
        default: break;
    }
}

#if !FUSED
template <int PH>
__global__ void __launch_bounds__(256, 2) k_phase(Params p, int layer) {
    __shared__ __attribute__((aligned(16))) char smem[SM_TOTAL];
    run_phase(p, PH, layer, smem);
}
template <int PH> static void launch_phase(const Params& p, int layer, hipStream_t stream) { k_phase<PH><<<512, 256, 0, stream>>>(p, layer); }
static void launch_ph(int ph, const Params& p, int layer, hipStream_t stream) {
    switch (ph) {
        case 0: launch_phase<0>(p, layer, stream); break;
        case 1: launch_phase<1>(p, layer, stream); break;
        case 2: launch_phase<2>(p, layer, stream); break;
        case 3: launch_phase<3>(p, layer, stream); break;
        case 4: launch_phase<4>(p, layer, stream); break;
        case 5: launch_phase<5>(p, layer, stream); break;
        case 6: launch_phase<6>(p, layer, stream); break;
        case 7: launch_phase<7>(p, layer, stream); break;
        case 8: launch_phase<8>(p, layer, stream); break;
        case 9: launch_phase<9>(p, layer, stream); break;
        case 10: launch_phase<10>(p, layer, stream); break;
        case 11: launch_phase<11>(p, layer, stream); break;
        case 12: launch_phase<12>(p, layer, stream); break;
    }
}
#else
#if TS_A >= 0
#define TSTAMP(I) if (blockIdx.x == 0 && threadIdx.x == 0) ((unsigned long long*)(p.ws + 32768))[I] = __builtin_amdgcn_s_memrealtime();
#else
#define TSTAMP(I)
#endif
__global__ void __launch_bounds__(256, 2) k_mega(Params p) {
    extern __shared__ __attribute__((aligned(1024))) char smem[];
    cg::grid_group grid = cg::this_grid();
    volatile LAS unsigned* st = (volatile LAS unsigned*)(smem + SM_CTRL);
    if (threadIdx.x == 0) { st[0] = 0u; st[1] = 0u; st[2] = 0u; }
    __syncthreads();
    const XcdBarrier xb = xcd_barrier_post((unsigned*)p.ws, st);
    TSTAMP(0)
    run_phase(p, 0, 0, smem);
    if (p.out == nullptr) grid.sync();
    xcd_barrier(xb);
    TSTAMP(1)
    run_phase(p, 1, 0, smem);
    xcd_barrier(xb);
    TSTAMP(2)
#define STEP(PH, L) { run_phase(p, PH, L, smem, 0); xcd_barrier(xb); TSTAMP(2 + (L) * 16 + (PH)) }
#define LAYER(L) STEP(2, L) STEP(3, L) STEP(4, L) STEP(5, L) STEP(6, L) STEP(7, L) STEP(8, L) STEP(9, L) STEP(10, L) STEP(12, L) STEP(13, L) STEP(14, L)
    LAYER(0)
    STEP(15, 0)
    LAYER(1)
    run_phase(p, 15, 1, smem);
#if TS_A >= 0
    TSTAMP(2 + 16 + 15)
    __syncthreads();
    if (blockIdx.x == 0 && threadIdx.x == 0) {
        const unsigned long long* ts = (const unsigned long long*)(p.ws + 32768);
        p.out[0] += (TS_A == 50) ? (float)ts[TS_B] * (0.01f / 512.f / 10.f) : (float)(ts[TS_B] - ts[TS_A]) * 0.001f;
    }
#endif
}
#endif

extern "C" void kernel_launch(void* const* d_in, const int* in_sizes, int n_in, void* d_out, int out_size, void* d_ws, size_t ws_size, hipStream_t stream) {
    Params p{};
    const float** pp = (const float**)&p;
    for (int i = 0; i < 28; ++i) pp[i] = (const float*)d_in[i];
    p.out = (float*)d_out;
    p.ws = (char*)d_ws;
    if (ws_size < OFF_END) fprintf(stderr, "workspace too small: %zu < %zu\n", ws_size, (size_t)OFF_END);
    (void)hipMemsetAsync(d_ws, 0, 65536, stream);
#if !FUSED
    launch_ph(0, p, 0, stream);
    launch_ph(1, p, 0, stream);
    for (int l = 0; l < 2; ++l)
        for (int ph = 2; ph < NPHASE; ++ph) launch_ph(ph, p, l, stream);
#else
    static int grid_blocks = 0;
    if (!grid_blocks) {
        int dev = 0, cus = 0, per_cu = 0;
        (void)hipGetDevice(&dev);
        (void)hipDeviceGetAttribute(&cus, hipDeviceAttributeMultiprocessorCount, dev);
        (void)hipFuncSetAttribute((const void*)k_mega, hipFuncAttributeMaxDynamicSharedMemorySize, SM_TOTAL);
        (void)hipOccupancyMaxActiveBlocksPerMultiprocessor(&per_cu, (const void*)k_mega, 256, SM_TOTAL);
        if (per_cu > 2) per_cu = 2;
        if (per_cu < 1) per_cu = 1;
        grid_blocks = cus * per_cu;
    }
    void* args[] = {&p};
    hipError_t e = hipLaunchCooperativeKernel((const void*)k_mega, dim3(grid_blocks), dim3(256), args, SM_TOTAL, stream);
    if (e != hipSuccess) fprintf(stderr, "cooperative launch failed: %s (grid %d)\n", hipGetErrorString(e), grid_blocks);
#endif
}
```

```cpp
#include <hip/hip_runtime.h>
#include <hip/hip_cooperative_groups.h>
#include <stdint.h>
#include <stdio.h>
namespace cg = cooperative_groups;

#ifndef FUSED
#define FUSED 1
#endif
#ifndef TS_A
#define TS_A -1
#define TS_B -1
#endif
#ifndef PROBE_PH
#define PROBE_PH -1
#define PROBE_L 1
#define PROBE_REP 0
#endif

#define DEV __device__ __forceinline__
#define LAS __attribute__((address_space(3)))
typedef unsigned short bf16_t;
typedef short bf16x8 __attribute__((ext_vector_type(8)));
typedef float f32x16 __attribute__((ext_vector_type(16)));

constexpr int kB = 8, kS = 2048, kT = kB * kS, kD = 1024, LDC = 2432;
constexpr float kEps = 1e-6f;
constexpr float kNeg = -1e30f;
constexpr float kLog2e = 1.4426950408889634f;
constexpr float kScaleU = 256.f, kScaleV = 32.f;

constexpr size_t OFF_CTRL = 0;
constexpr size_t OFF_MOD  = 65536;
constexpr size_t OFF_ROPE = OFF_MOD + 2ull * 8 * 6144 * 4;
constexpr size_t OFF_MISC = OFF_ROPE + 2048ull * 96 * 4;
constexpr size_t OFF_WIN  = OFF_MISC + 4096;
constexpr size_t OFF_WOUT = OFF_WIN + 2ull * 2432 * 1024 * 2;
constexpr size_t OFF_WQ   = OFF_WOUT + 2ull * 1024 * 1024 * 2;
constexpr size_t OFF_WUQ  = OFF_WQ + 2ull * 2048 * 1024 * 2;
constexpr size_t OFF_WUKV = OFF_WUQ + 2ull * 384 * 256 * 2;
constexpr size_t OFF_WCK  = OFF_WUKV + 2ull * 512 * 128 * 2;
constexpr size_t OFF_WCV  = OFF_WCK + 2ull * 128 * 2048 * 2;
constexpr size_t OFF_SUBK = OFF_WCV + 2ull * 128 * 2048 * 2;
constexpr size_t OFF_PU   = OFF_SUBK + 2ull * 2 * 128 * 128 * 2;
constexpr size_t OFF_PV   = OFF_PU + 2ull * 16384 * 1024;
constexpr size_t OFF_XRES = OFF_PV + 2ull * 16384 * 1024;
constexpr size_t OFF_H    = OFF_XRES + (size_t)kT * 1024 * 4;
constexpr size_t OFF_H8   = OFF_H + (size_t)kT * 1024 * 2;
constexpr size_t OFF_RSTD = OFF_H8 + (size_t)kT * 1024;
constexpr size_t OFF_KCMP = OFF_RSTD + 2ull * kT * 4;
constexpr size_t OFF_EID  = OFF_KCMP + 2ull * 1024 * 64 * 2;
constexpr size_t OFF_GATE = OFF_EID + (size_t)kT * 128 * 4;
constexpr size_t OFF_QP   = OFF_GATE + (size_t)kT * 128 * 4;
constexpr size_t OFF_COLS = OFF_QP + (size_t)kT * 2048 * 2;
constexpr size_t OFF_KC   = OFF_COLS + (size_t)kT * LDC * 2;
constexpr size_t OFF_VC   = OFF_KC + (size_t)(kT + 64) * 64 * 2;
constexpr size_t OFF_VT   = OFF_VC + (size_t)(kT + 64) * 64 * 2;
constexpr size_t OFF_QMLA = OFF_VT + 8ull * 12 * 64 * 2048 * 2;
constexpr size_t OFF_KVMLA = OFF_QMLA + (size_t)kT * 384 * 2;
constexpr size_t OFF_O    = OFF_KVMLA + (size_t)kT * 512 * 2;
constexpr size_t OFF_END  = OFF_O + (size_t)kT * 1024 * 2;
constexpr size_t OFF_S1 = OFF_COLS, OFF_S2 = OFF_COLS + (size_t)kT * 8 * 128 * 4;
static_assert(OFF_S2 + (size_t)kT * 8 * 128 * 4 <= OFF_O, "alias region too small");
static_assert(OFF_END <= (512ull << 20), "workspace too large");

struct Params {
    const float *x, *c, *ada_w, *ada_b, *norm_mix_g, *norm_ffn_g, *w_in, *pos_k, *pos_v, *cmp_wk, *cmp_wv;
    const float *lq1, *lk1, *lq2, *lk2, *sub_g, *mla_qg, *mla_wuq, *mla_kvg, *mla_wukv, *sinks, *w_out;
    const float *w_q, *subk1, *subk2, *pu, *pv, *final_g;
    float* out;
    char* ws;
};

DEV int ltid() { int t = threadIdx.x; asm volatile("" : "+v"(t)); return t; }
DEV float bf2f(bf16_t v) { return __uint_as_float(((unsigned)v) << 16); }
DEV bf16_t f2bf(float f) { unsigned u = __float_as_uint(f); u += 0x7fffu + ((u >> 16) & 1u); return (bf16_t)(u >> 16); }
DEV unsigned pack2(float lo, float hi) { unsigned r; asm("v_cvt_pk_bf16_f32 %0, %1, %2" : "=v"(r) : "v"(lo), "v"(hi)); return r; }
DEV float lo16(unsigned u) { return __uint_as_float(u << 16); }
DEV float hi16(unsigned u) { return __uint_as_float(u & 0xffff0000u); }
DEV float wave_sum(float v) {
#pragma unroll
    for (int o = 32; o > 0; o >>= 1) v += __shfl_xor(v, o, 64);
    return v;
}
DEV float xor32f(float v, int lane) { return __int_as_float(__builtin_amdgcn_ds_bpermute((lane ^ 32) << 2, __float_as_int(v))); }
DEV float lanef(float v, int src) { return __int_as_float(__builtin_amdgcn_ds_bpermute(src << 2, __float_as_int(v))); }
DEV f32x16 mfma32(bf16x8 a, bf16x8 b, f32x16 c) { return __builtin_amdgcn_mfma_f32_32x32x16_bf16(a, b, c, 0, 0, 0); }
DEV f32x16 zero16() { f32x16 z;
#pragma unroll
    for (int i = 0; i < 16; ++i) z[i] = 0.f;
    return z; }
DEV float gelu_tanh(float x) {
    const float u = 0.7978845608028654f * (x + 0.044715f * x * x * x);
    const float e = __expf(2.f * u);
    const float t = 1.f - 2.f / (e + 1.f);
    return 0.5f * x * (1.f + t);
}

template <class Epi>
DEV void gemm_tile(const bf16_t* __restrict__ A, int lda, const bf16_t* __restrict__ Bt, int ldb, int K, int m0, int n0, char* smem, const Epi& epi) {
    const int tid = ltid(), lane = tid & 63, w = tid >> 6, wm = w >> 1, wn = w & 1, ql = lane & 31, hh = lane >> 5;
    f32x16 acc[2][2];
#pragma unroll
    for (int i = 0; i < 2; ++i)
#pragma unroll
        for (int j = 0; j < 2; ++j) acc[i][j] = zero16();
    const int srow = lane >> 3, spos = lane & 7;
    const int c0 = spos ^ ((srow >> 1) & 7), c1 = spos ^ ((4 + (srow >> 1)) & 7);
    const bf16_t* Ag0 = A + (size_t)(m0 + w * 32 + srow) * lda + c0 * 8;
    const bf16_t* Ag1 = A + (size_t)(m0 + w * 32 + 8 + srow) * lda + c1 * 8;
    const bf16_t* Bg0 = Bt + (size_t)(n0 + w * 32 + srow) * ldb + c0 * 8;
    const bf16_t* Bg1 = Bt + (size_t)(n0 + w * 32 + 8 + srow) * ldb + c1 * 8;
    const size_t a16 = (size_t)16 * lda, b16 = (size_t)16 * ldb;
    auto stage = [&](int kt, int buf) __attribute__((always_inline)) {
        char* sa = smem + buf * 32768 + w * 4096;
        char* sb = sa + 16384;
        const int ko = kt * 64;
        __builtin_amdgcn_global_load_lds((const unsigned*)(Ag0 + ko), (LAS unsigned*)(sa), 16, 0, 0);
        __builtin_amdgcn_global_load_lds((const unsigned*)(Ag1 + ko), (LAS unsigned*)(sa + 1024), 16, 0, 0);
        __builtin_amdgcn_global_load_lds((const unsigned*)(Ag0 + a16 + ko), (LAS unsigned*)(sa + 2048), 16, 0, 0);
        __builtin_amdgcn_global_load_lds((const unsigned*)(Ag1 + a16 + ko), (LAS unsigned*)(sa + 3072), 16, 0, 0);
        __builtin_amdgcn_global_load_lds((const unsigned*)(Bg0 + ko), (LAS unsigned*)(sb), 16, 0, 0);
        __builtin_amdgcn_global_load_lds((const unsigned*)(Bg1 + ko), (LAS unsigned*)(sb + 1024), 16, 0, 0);
        __builtin_amdgcn_global_load_lds((const unsigned*)(Bg0 + b16 + ko), (LAS unsigned*)(sb + 2048), 16, 0, 0);
        __builtin_amdgcn_global_load_lds((const unsigned*)(Bg1 + b16 + ko), (LAS unsigned*)(sb + 3072), 16, 0, 0);
    };
    const int key = (ql >> 1) & 7;
    const int arow = (wm * 64 + ql) * 128, brow = (wn * 64 + ql) * 128;
    const int nk = K >> 6;
    __syncthreads();
    stage(0, 0);
    for (int kt = 0; kt < nk; ++kt) {
        asm volatile("s_waitcnt vmcnt(0)" ::: "memory");
        __syncthreads();
        if (kt + 1 < nk) stage(kt + 1, (kt + 1) & 1);
        const char* As = smem + (kt & 1) * 32768;
        const char* Bs = As + 16384;
#pragma unroll
        for (int ks = 0; ks < 4; ++ks) {
            const int co = ((ks * 2 + hh) ^ key) << 4;
            bf16x8 a[2], b[2];
#pragma unroll
            for (int i = 0; i < 2; ++i) {
                a[i] = *(const bf16x8*)(As + arow + i * 4096 + co);
                b[i] = *(const bf16x8*)(Bs + brow + i * 4096 + co);
            }
#pragma unroll
            for (int i = 0; i < 2; ++i)
#pragma unroll
                for (int j = 0; j < 2; ++j) acc[i][j] = mfma32(a[i], b[j], acc[i][j]);
        }
    }
    __syncthreads();
    float* Cs = (float*)smem;
#pragma unroll
    for (int i = 0; i < 2; ++i)
#pragma unroll
        for (int j = 0; j < 2; ++j)
#pragma unroll
            for (int r = 0; r < 16; ++r)
                Cs[(wm * 64 + i * 32 + (r & 3) + 8 * (r >> 2) + 4 * hh) * 128 + wn * 64 + j * 32 + ql] = acc[i][j][r];
    __syncthreads();
    epi.tile(m0, n0, Cs, tid);
}

struct EpiBf16 {
    bf16_t* C; int ldc; const float* rowscale; const float* colbias; int nvalid;
    DEV void tile(int m0, int n0, const float* Cs, int tid) const {
#pragma unroll
        for (int it = 0; it < 8; ++it) {
            const int id = tid + 256 * it, r = id >> 4, c8 = (id & 15) * 8;
            if (n0 + c8 >= nvalid) continue;
            float4 a = *(const float4*)(Cs + r * 128 + c8), b = *(const float4*)(Cs + r * 128 + c8 + 4);
            if (rowscale) { const float sc = rowscale[m0 + r]; a.x *= sc; a.y *= sc; a.z *= sc; a.w *= sc; b.x *= sc; b.y *= sc; b.z *= sc; b.w *= sc; }
            if (colbias) { const float4 ba = *(const float4*)(colbias + n0 + c8), bb = *(const float4*)(colbias + n0 + c8 + 4);
                a.x += ba.x; a.y += ba.y; a.z += ba.z; a.w += ba.w; b.x += bb.x; b.y += bb.y; b.z += bb.z; b.w += bb.w; }
            *(uint4*)(C + (size_t)(m0 + r) * ldc + n0 + c8) = make_uint4(pack2(a.x, a.y), pack2(a.z, a.w), pack2(b.x, b.y), pack2(b.z, b.w));
        }
    }
};
struct EpiF32 {
    float* C; int ldc;
    DEV void tile(int m0, int n0, const float* Cs, int tid) const {
#pragma unroll
        for (int it = 0; it < 16; ++it) {
            const int id = tid + 256 * it, r = id >> 5, c4 = (id & 31) * 4;
            *(float4*)(C + (size_t)(m0 + r) * ldc + n0 + c4) = *(const float4*)(Cs + r * 128 + c4);
        }
    }
};
struct EpiRes {
    const float* xin; float* xout; const float* gate;
    DEV void tile(int m0, int n0, const float* Cs, int tid) const {
        const float* g = gate + (size_t)(m0 >> 11) * 6144 + n0;
#pragma unroll
        for (int it = 0; it < 16; ++it) {
            const int id = tid + 256 * it, r = id >> 5, c4 = (id & 31) * 4;
            const float4 v = *(const float4*)(Cs + r * 128 + c4), g4 = *(const float4*)(g + c4);
            float4 x = *(const float4*)(xin + (size_t)(m0 + r) * 1024 + n0 + c4);
            x.x += g4.x * v.x; x.y += g4.y * v.y; x.z += g4.z * v.z; x.w += g4.w * v.w;
            *(float4*)(xout + (size_t)(m0 + r) * 1024 + n0 + c4) = x;
        }
    }
};

template <class Epi>
DEV void gemm_phase(const bf16_t* A, int lda, const bf16_t* Bt, int ldb, int K, int mtiles, int ntiles, char* smem, const Epi& epi) {
    for (int tile = blockIdx.x; tile < mtiles * ntiles; tile += gridDim.x) {
        const int mt = tile / ntiles, nt = tile % ntiles;
        gemm_tile(A, lda, Bt, ldb, K, mt * 128, nt * 128, smem, epi);
    }
}

DEV int win_srccol(int n) {
    if (n < 652) return n;
    if (n < 704) return -1;
    if (n < 1888) return n - 52;
    if (n < 1920) return -1;
    return n - 84;
}
DEV void transpose_tile(const float* __restrict__ src, int ld_src, int nsrc_valid, int mode, const float* __restrict__ rowscale,
                        bf16_t* __restrict__ dst, int K, int n0, int k0, char* smem) {
    bf16_t* Ls = (bf16_t*)smem;
    const int tid = ltid();
    __syncthreads();
    const int nn = tid & 63, n = n0 + nn;
    const int sc = (mode == 1) ? win_srccol(n) : (n < nsrc_valid ? n : -1);
#pragma unroll 4
    for (int i = 0; i < 16; ++i) {
        const int kk = (tid >> 6) + 4 * i;
        float v = 0.f;
        if (sc >= 0) { v = src[(size_t)(k0 + kk) * ld_src + sc]; if (rowscale) v *= rowscale[k0 + kk]; }
        Ls[nn * 72 + kk] = f2bf(v);
    }
    __syncthreads();
#pragma unroll
    for (int i = 0; i < 2; ++i) {
        const int r = (tid >> 3) + 32 * i, ch = tid & 7;
        *(uint4*)(dst + (size_t)(n0 + r) * K + k0 + ch * 8) = *(const uint4*)(Ls + r * 72 + ch * 8);
    }
}

DEV void convert_stream(const float* __restrict__ src, bf16_t* __restrict__ dst, size_t n8) {
    const int tid = ltid();
    for (size_t i = (size_t)blockIdx.x * 256 + tid; i < n8; i += (size_t)gridDim.x * 256) {
        const float4 a = *(const float4*)(src + i * 8), b = *(const float4*)(src + i * 8 + 4);
        uint4 o; o.x = pack2(a.x, a.y); o.y = pack2(a.z, a.w); o.z = pack2(b.x, b.y); o.w = pack2(b.z, b.w);
        *(uint4*)(dst + i * 8) = o;
    }
}

DEV void convert_fp8_stream(const float* __restrict__ src, unsigned char* __restrict__ dst, size_t n16, float scale) {
    const int tid = ltid();
    const size_t stride = (size_t)gridDim.x * 256;
    for (size_t i0 = (size_t)blockIdx.x * 256 + tid; i0 < n16; i0 += stride * 4) {
        float4 q[4][4];
#pragma unroll
        for (int u = 0; u < 4; ++u) {
            const size_t i = i0 + u * stride < n16 ? i0 + u * stride : i0;
#pragma unroll
            for (int c = 0; c < 4; ++c) q[u][c] = *(const float4*)(src + i * 16 + c * 4);
        }
#pragma unroll
        for (int u = 0; u < 4; ++u) {
            const size_t i = i0 + u * stride;
            if (i >= n16) break;
            unsigned o[4];
#pragma unroll
            for (int j = 0; j < 4; ++j) {
                const float4 v = q[u][j];
                unsigned w = 0u;
                w = __builtin_amdgcn_cvt_pk_fp8_f32(fminf(fmaxf(v.x * scale, -440.f), 440.f), fminf(fmaxf(v.y * scale, -440.f), 440.f), w, false);
                w = __builtin_amdgcn_cvt_pk_fp8_f32(fminf(fmaxf(v.z * scale, -440.f), 440.f), fminf(fmaxf(v.w * scale, -440.f), 440.f), w, true);
                o[j] = w;
            }
            const size_t rowg = i >> 6; const int c16 = (int)(i & 63);
            const size_t l = rowg >> 14, row = rowg & 16383;
            *(uint4*)(dst + (((l * 8 + (c16 >> 3)) * 16384 + row) << 7) + (c16 & 7) * 16) = make_uint4(o[0], o[1], o[2], o[3]);
        }
    }
}

constexpr int J_ROPE = 384, J_MOD = 192, J_MISC = 5;
constexpr int J_TW_L = 608 + 256 + 512 + 24 + 16 + 64 + 64;
constexpr int J_TOTAL = J_ROPE + J_MOD + J_MISC + 2 * J_TW_L;

DEV void prologue_job(const Params& p, int job, char* smem) {
    const int tid = ltid();
    char* ws = p.ws;
    if (job < J_MISC) {
        float* misc = (float*)(ws + OFF_MISC);
        if (job < 4) {
            const int l = job >> 1, kv = job & 1;
            const float* pos = (kv ? p.pos_v : p.pos_k) + l * 2048;
            const float* wsrc = (kv ? p.cmp_wv : p.cmp_wk) + (size_t)l * 2048 * 64;
            float* red = (float*)smem;
            __syncthreads();
            const int kp = tid >> 6, n = tid & 63;
            float acc = 0.f;
            for (int k0 = kp * 512; k0 < kp * 512 + 512; k0 += 16) {
                float wv[16];
#pragma unroll
                for (int u = 0; u < 16; ++u) wv[u] = wsrc[(size_t)(k0 + u) * 64 + n];
#pragma unroll
                for (int u = 0; u < 16; ++u) acc += pos[k0 + u] * wv[u];
            }
            red[kp * 64 + n] = acc;
            __syncthreads();
            if (tid < 64) misc[(l * 2 + kv) * 64 + tid] = red[tid] + red[64 + tid] + red[128 + tid] + red[192 + tid];
        } else if (tid < 2) {
            const int l = tid;
            float d1 = 0.f, d2 = 0.f;
            for (int i = 0; i < 32; ++i) { d1 += p.lq1[l * 32 + i] * p.lk1[l * 32 + i]; d2 += p.lq2[l * 32 + i] * p.lk2[l * 32 + i]; }
            const float lam_init = 0.8f - 0.6f * expf(-0.3f * (float)l);
            misc[256 + l] = expf(d1) - expf(d2) + lam_init;
            misc[258 + l] = 1.f - lam_init;
        }
        return;
    }
    job -= J_MISC;
    if (job < J_MOD) {
        const int l = job / 96, n0 = (job % 96) * 64;
        float* sc = (float*)smem;
        __syncthreads();
        for (int i = tid; i < 8192; i += 256) { const float v = p.c[i]; sc[i] = v / (1.f + __expf(-v)); }
        __syncthreads();
        const int kp = tid >> 6, col = tid & 63;
        float acc[8];
#pragma unroll
        for (int b = 0; b < 8; ++b) acc[b] = 0.f;
        const float* wp = p.ada_w + (size_t)l * 1024 * 6144 + n0 + col;
        for (int k0 = kp * 256; k0 < kp * 256 + 256; k0 += 16) {
            float wv[16];
#pragma unroll
            for (int u = 0; u < 16; ++u) wv[u] = wp[(size_t)(k0 + u) * 6144];
#pragma unroll
            for (int u = 0; u < 16; ++u)
#pragma unroll
                for (int b = 0; b < 8; ++b) acc[b] += sc[b * 1024 + k0 + u] * wv[u];
        }
        float* red = sc + 8192;
#pragma unroll
        for (int b = 0; b < 8; ++b) red[(kp * 8 + b) * 64 + col] = acc[b];
        __syncthreads();
        float* mod = (float*)(ws + OFF_MOD);
        for (int idx = tid; idx < 512; idx += 256) {
            const int b = idx >> 6, cl = idx & 63;
            const float v = red[(0 * 8 + b) * 64 + cl] + red[(1 * 8 + b) * 64 + cl] + red[(2 * 8 + b) * 64 + cl] + red[(3 * 8 + b) * 64 + cl];
            mod[(size_t)(l * 8 + b) * 6144 + n0 + cl] = v + p.ada_b[l * 6144 + n0 + cl];
        }
        return;
    }
    job -= J_MOD;
    if (job < J_ROPE) {
        const int idx = job * 256 + tid;
        const int s = idx / 48, j = idx % 48;
        float* rope = (float*)(ws + OFF_ROPE);
        float inv; float *pc, *ps;
        if (j < 32) { inv = exp2f(-(float)j * (13.287712379549449f / 32.f)); pc = rope + s * 32 + j; ps = rope + 2048 * 32 + s * 32 + j; }
        else { const int i = j - 32; inv = exp2f(-(float)i * (13.287712379549449f / 16.f)); pc = rope + 2048 * 64 + s * 16 + i; ps = rope + 2048 * 64 + 2048 * 16 + s * 16 + i; }
        const double a = (double)s * (double)inv;
        const double kk = rint(a * 0.15915494309189535);
        const float r = (float)fma(-kk, 6.283185307179586, a);
        *pc = cosf(r); *ps = sinf(r);
        return;
    }
    job -= J_ROPE;
    const int l = job / J_TW_L; int j = job % J_TW_L;
    if (j < 608) { transpose_tile(p.w_in + (size_t)l * 1024 * 2348, 2348, 2348, 1, nullptr, (bf16_t*)(ws + OFF_WIN) + (size_t)l * 2432 * 1024, 1024, (j / 16) * 64, (j % 16) * 64, smem); return; }
    j -= 608;
    if (j < 256) { transpose_tile(p.w_out + (size_t)l * 1024 * 1024, 1024, 1024, 0, nullptr, (bf16_t*)(ws + OFF_WOUT) + (size_t)l * 1024 * 1024, 1024, (j / 16) * 64, (j % 16) * 64, smem); return; }
    j -= 256;
    if (j < 512) { transpose_tile(p.w_q + (size_t)l * 1024 * 2048, 2048, 2048, 0, nullptr, (bf16_t*)(ws + OFF_WQ) + (size_t)l * 2048 * 1024, 1024, (j / 16) * 64, (j % 16) * 64, smem); return; }
    j -= 512;
    if (j < 24) { transpose_tile(p.mla_wuq + (size_t)l * 256 * 384, 384, 384, 0, p.mla_qg + l * 256, (bf16_t*)(ws + OFF_WUQ) + (size_t)l * 384 * 256, 256, (j / 4) * 64, (j % 4) * 64, smem); return; }
    j -= 24;
    if (j < 16) { transpose_tile(p.mla_wukv + (size_t)l * 128 * 512, 512, 512, 0, p.mla_kvg + l * 128, (bf16_t*)(ws + OFF_WUKV) + (size_t)l * 512 * 128, 128, (j / 2) * 64, (j % 2) * 64, smem); return; }
    j -= 16;
    if (j < 64) { transpose_tile(p.cmp_wk + (size_t)l * 2048 * 64, 64, 64, 0, nullptr, (bf16_t*)(ws + OFF_WCK) + (size_t)l * 128 * 2048, 2048, (j / 32) * 64, (j % 32) * 64, smem); return; }
    j -= 64;
    transpose_tile(p.cmp_wv + (size_t)l * 2048 * 64, 64, 64, 0, nullptr, (bf16_t*)(ws + OFF_WCV) + (size_t)l * 128 * 2048, 2048, (j / 32) * 64, (j % 32) * 64, smem);
}

#if TS_A >= 0
#define PSTAMP(I) if (blockIdx.x == 0 && threadIdx.x == 0) ((unsigned long long*)(p.ws + 32768))[I] = __builtin_amdgcn_s_memrealtime();
#else
#define PSTAMP(I)
#endif
DEV void phase_prologue(const Params& p, char* smem) {
    for (int job = blockIdx.x; job < J_TOTAL; job += gridDim.x) { prologue_job(p, job, smem); if (job < 512) { PSTAMP(40) } }
    PSTAMP(42)
    char* ws = p.ws;
    convert_fp8_stream(p.pu, (unsigned char*)(ws + OFF_PU), 2ull * 16384 * 1024 / 16, kScaleU);
    PSTAMP(43)
    convert_fp8_stream(p.pv, (unsigned char*)(ws + OFF_PV), 2ull * 16384 * 1024 / 16, kScaleV);
    PSTAMP(44)
    for (int l = 0; l < 2; ++l) {
        convert_stream(p.subk1 + (size_t)l * 16384, (bf16_t*)(ws + OFF_SUBK) + (size_t)(l * 2 + 0) * 16384, 16384 / 8);
        convert_stream(p.subk2 + (size_t)l * 16384, (bf16_t*)(ws + OFF_SUBK) + (size_t)(l * 2 + 1) * 16384, 16384 / 8);
    }
}

DEV void phase_norm(const Params& p, int layer, int which) {
    const int tid = ltid(), lane = tid & 63, w = tid >> 6;
    const float* xs = (layer == 0 && which == 0) ? p.x : (const float*)(p.ws + OFF_XRES);
    const float* g = (which == 0 ? p.norm_mix_g : p.norm_ffn_g) + layer * 1024;
    const float* mod = (const float*)(p.ws + OFF_MOD) + (size_t)layer * 8 * 6144;
    bf16_t* h = (bf16_t*)(p.ws + OFF_H);
    float4 g4[4];
#pragma unroll
    for (int i = 0; i < 4; ++i) g4[i] = *(const float4*)(g + i * 256 + lane * 4);
    for (int q0 = blockIdx.x; q0 < kT / 4; q0 += gridDim.x * 4) {
        float4 v[4][4];
#pragma unroll
        for (int u = 0; u < 4; ++u) {
            const int q = q0 + u * gridDim.x < kT / 4 ? q0 + u * gridDim.x : q0;
            const float* xr = xs + (size_t)(q * 4 + w) * 1024;
#pragma unroll
            for (int i = 0; i < 4; ++i) v[u][i] = *(const float4*)(xr + i * 256 + lane * 4);
        }
#pragma unroll
        for (int u = 0; u < 4; ++u) {
            const int q = q0 + u * gridDim.x;
            if (q >= kT / 4) break;
            const int t = q * 4 + w, b = t >> 11;
            float ss = 0.f;
#pragma unroll
            for (int i = 0; i < 4; ++i) ss += v[u][i].x * v[u][i].x + v[u][i].y * v[u][i].y + v[u][i].z * v[u][i].z + v[u][i].w * v[u][i].w;
            ss = wave_sum(ss);
            const float rstd = rsqrtf(ss * (1.f / 1024.f) + kEps);
            const float* sh = mod + (size_t)b * 6144 + (which ? 3072 : 0);
            const float* sc = sh + 1024;
#pragma unroll
            for (int i = 0; i < 4; ++i) {
                const int col = i * 256 + lane * 4;
                const float4 s4 = *(const float4*)(sc + col), h4 = *(const float4*)(sh + col);
                const float o0 = v[u][i].x * rstd * g4[i].x * (1.f + s4.x) + h4.x, o1 = v[u][i].y * rstd * g4[i].y * (1.f + s4.y) + h4.y;
                const float o2 = v[u][i].z * rstd * g4[i].z * (1.f + s4.z) + h4.z, o3 = v[u][i].w * rstd * g4[i].w * (1.f + s4.w) + h4.w;
                uint2 o; o.x = pack2(o0, o1); o.y = pack2(o2, o3);
                *(uint2*)(h + (size_t)t * 1024 + col) = o;
            }
        }
    }
}

DEV void rope8(uint4& x1, uint4& x2, const float (&cc)[8], const float (&ss)[8]) {
    unsigned a[4] = {x1.x, x1.y, x1.z, x1.w}, b[4] = {x2.x, x2.y, x2.z, x2.w};
#pragma unroll
    for (int i = 0; i < 4; ++i) {
        const float a0 = lo16(a[i]), a1 = hi16(a[i]), b0 = lo16(b[i]), b1 = hi16(b[i]);
        const float o10 = a0 * cc[2 * i] - b0 * ss[2 * i], o11 = a1 * cc[2 * i + 1] - b1 * ss[2 * i + 1];
        const float o20 = a0 * ss[2 * i] + b0 * cc[2 * i], o21 = a1 * ss[2 * i + 1] + b1 * cc[2 * i + 1];
        a[i] = pack2(o10, o11); b[i] = pack2(o20, o21);
    }
    x1 = make_uint4(a[0], a[1], a[2], a[3]); x2 = make_uint4(b[0], b[1], b[2], b[3]);
}
DEV void vt_tile(const bf16_t* __restrict__ src, int ld, bf16_t* __restrict__ dst, char* smem) {
    bf16_t* Ls = (bf16_t*)smem;
    const int tid = ltid();
    __syncthreads();
#pragma unroll
    for (int i = 0; i < 2; ++i) {
        const int id = tid + 256 * i, tok = id >> 3, ch = id & 7;
        *(uint4*)(Ls + tok * 72 + ch * 8) = *(const uint4*)(src + (size_t)tok * ld + ch * 8);
    }
    __syncthreads();
#pragma unroll
    for (int i = 0; i < 2; ++i) {
        const int id = tid + 256 * i, d = id & 63, tc = id >> 6;
        unsigned short e[8];
#pragma unroll
        for (int j = 0; j < 8; ++j) e[j] = Ls[(tc * 8 + j) * 72 + d];
        uint4 o;
        o.x = (unsigned)e[0] | ((unsigned)e[1] << 16); o.y = (unsigned)e[2] | ((unsigned)e[3] << 16);
        o.z = (unsigned)e[4] | ((unsigned)e[5] << 16); o.w = (unsigned)e[6] | ((unsigned)e[7] << 16);
        *(uint4*)(dst + (size_t)d * 2048 + tc * 8) = o;
    }
}

DEV void phase_layout1(const Params& p, char* smem) {
    char* ws = p.ws;
    bf16_t* cols = (bf16_t*)(ws + OFF_COLS);
    bf16_t* kc = (bf16_t*)(ws + OFF_KC);
    bf16_t* vc = (bf16_t*)(ws + OFF_VC);
    bf16_t* VT = (bf16_t*)(ws + OFF_VT);
    float* rstd = (float*)(ws + OFF_RSTD);
    const float* rope = (const float*)(ws + OFF_ROPE);
    const float *cos64 = rope, *sin64 = rope + 2048 * 32, *cos32 = rope + 2048 * 64, *sin32 = rope + 2048 * 64 + 2048 * 16;
    const int tid = ltid();
    for (int unit = blockIdx.x; unit < 2 * (kT / 64); unit += gridDim.x) {
        const int tile = unit >> 1, part01 = unit & 1;
        const int T0 = tile * 64, b = T0 >> 11, s0 = T0 & 2047;
        if (part01 == 0) {
            for (int it0 = tid; it0 < 64 * 86; it0 += 1024) {
                uint4 x1[4], x2[4]; float4 cs[4][2], sn[4][2]; bf16_t* p1[4]; bf16_t* p2[4]; bf16_t* kq[4];
#pragma unroll
                for (int u = 0; u < 4; ++u) {
                    const int it = it0 + u * 256 < 64 * 86 ? it0 + u * 256 : it0;
                    const int tok = it / 86, item = it % 86;
                    const int t = T0 + tok, sq = s0 + tok;
                    bf16_t* row = cols + (size_t)t * LDC;
                    kq[u] = nullptr;
                    const float *cp, *sp;
                    if (item < 52) {
                        const int hd = item >> 2, i0 = (item & 3) * 8;
                        const int base = hd < 4 ? 64 * hd : hd == 4 ? 256 : hd == 5 ? 384 : hd == 6 ? 512 : hd < 11 ? 1920 + 64 * (hd - 7) : 2176 + 64 * (hd - 11);
                        p1[u] = row + base + i0; p2[u] = row + base + 32 + i0;
                        cp = cos64 + sq * 32 + i0; sp = sin64 + sq * 32 + i0;
                        if (hd == 4) kq[u] = kc + (size_t)t * 64 + i0;
                    } else {
                        const int it2 = item - 52, sub = it2 >> 1, i0 = (it2 & 1) * 8;
                        const int base = sub < 8 ? 704 + 32 * sub : sub < 16 ? 960 + 32 * (sub - 8) : 1856;
                        p1[u] = row + base + i0; p2[u] = row + base + 16 + i0;
                        cp = cos32 + sq * 16 + i0; sp = sin32 + sq * 16 + i0;
                    }
                    x1[u] = *(const uint4*)p1[u]; x2[u] = *(const uint4*)p2[u];
                    cs[u][0] = *(const float4*)cp; cs[u][1] = *(const float4*)(cp + 4);
                    sn[u][0] = *(const float4*)sp; sn[u][1] = *(const float4*)(sp + 4);
                }
#pragma unroll
                for (int u = 0; u < 4; ++u) {
                    if (it0 + u * 256 >= 64 * 86) break;
                    const float cc[8] = {cs[u][0].x, cs[u][0].y, cs[u][0].z, cs[u][0].w, cs[u][1].x, cs[u][1].y, cs[u][1].z, cs[u][1].w};
                    const float ss[8] = {sn[u][0].x, sn[u][0].y, sn[u][0].z, sn[u][0].w, sn[u][1].x, sn[u][1].y, sn[u][1].z, sn[u][1].w};
                    rope8(x1[u], x2[u], cc, ss);
                    *(uint4*)p1[u] = x1[u]; *(uint4*)p2[u] = x2[u];
                    if (kq[u]) { *(uint4*)kq[u] = x1[u]; *(uint4*)(kq[u] + 32) = x2[u]; }
                }
            }
            {
                const uint4 c0 = *(const uint4*)(cols + (size_t)(T0 + (tid >> 3)) * LDC + 320 + (tid & 7) * 8);
                const uint4 c1 = *(const uint4*)(cols + (size_t)(T0 + 32 + (tid >> 3)) * LDC + 320 + (tid & 7) * 8);
                *(uint4*)(vc + (size_t)(T0 + (tid >> 3)) * 64 + (tid & 7) * 8) = c0;
                *(uint4*)(vc + (size_t)(T0 + 32 + (tid >> 3)) * 64 + (tid & 7) * 8) = c1;
            }
        }
        if (part01 == 0) continue;
        {
            const int tok = tid >> 2, part = tid & 3, t = T0 + tok;
            const bf16_t* src = cols + (size_t)t * LDC + 1472 + (part < 3 ? part : 0) * 128;
            float ss = 0.f;
#pragma unroll 4
            for (int i = 0; i < 16; ++i) {
                const uint4 u = *(const uint4*)(src + i * 8);
                ss += lo16(u.x) * lo16(u.x) + hi16(u.x) * hi16(u.x) + lo16(u.y) * lo16(u.y) + hi16(u.y) * hi16(u.y)
                    + lo16(u.z) * lo16(u.z) + hi16(u.z) * hi16(u.z) + lo16(u.w) * lo16(u.w) + hi16(u.w) * hi16(u.w);
            }
            float vq = part < 2 ? ss : 0.f;
            vq += __shfl_xor(vq, 1, 64);
            if (part == 0) rstd[t] = rsqrtf(vq * (1.f / 256.f) + kEps);
            if (part == 2) rstd[kT + t] = rsqrtf(ss * (1.f / 128.f) + kEps);
        }
#pragma unroll 1
        for (int vh = 0; vh < 8; ++vh) {
            const int col = vh == 0 ? 448 : vh == 1 ? 576 : vh < 6 ? 1216 + 64 * (vh - 2) : 2304 + 64 * (vh - 6);
            vt_tile(cols + (size_t)T0 * LDC + col, LDC, VT + ((size_t)(b * 12 + vh) * 64) * 2048 + s0, smem);
        }
    }
}

DEV void phase_layout2(const Params& p, int layer, char* smem) {
    char* ws = p.ws;
    bf16_t* qmla = (bf16_t*)(ws + OFF_QMLA);
    const bf16_t* kvmla = (const bf16_t*)(ws + OFF_KVMLA);
    bf16_t* VT = (bf16_t*)(ws + OFF_VT);
    const float* rope = (const float*)(ws + OFF_ROPE);
    const float *cos32 = rope + 2048 * 64, *sin32 = rope + 2048 * 64 + 2048 * 16;
    const int tid = ltid();
    for (int tile = blockIdx.x; tile < kT / 64 + 64; tile += gridDim.x) {
        if (tile >= kT / 64) {
            const int idx = (tile - kT / 64) * 2048 + tid * 8;
            const int kv = idx >> 16, m = (idx >> 6) & 1023, n = idx & 63;
            const float* pp = (const float*)(ws + OFF_QP) + ((size_t)(kv * 8) * 1024 + m) * 128 + n;
            const float* bias = (const float*)(ws + OFF_MISC) + (layer * 2 + kv) * 64 + n;
            float4 a = *(const float4*)bias, c = *(const float4*)(bias + 4);
#pragma unroll
            for (int ks = 0; ks < 8; ++ks) {
                const float4 x = *(const float4*)(pp + (size_t)ks * 1024 * 128), y = *(const float4*)(pp + (size_t)ks * 1024 * 128 + 4);
                a.x += x.x; a.y += x.y; a.z += x.z; a.w += x.w; c.x += y.x; c.y += y.y; c.z += y.z; c.w += y.w;
            }
            *(uint4*)((bf16_t*)(ws + OFF_KCMP) + (size_t)kv * 1024 * 64 + m * 64 + n) = make_uint4(pack2(a.x, a.y), pack2(a.z, a.w), pack2(c.x, c.y), pack2(c.z, c.w));
            continue;
        }
        const int T0 = tile * 64, b = T0 >> 11, s0 = T0 & 2047;
        for (int it = tid; it < 64 * 8; it += 256) {
            const int tok = it >> 3, item = it & 7, hd = item >> 1, i0 = (item & 1) * 8;
            const int t = T0 + tok, s = s0 + tok;
            bf16_t* row = qmla + (size_t)t * 384 + hd * 96 + 64;
            uint4 x1 = *(const uint4*)(row + i0), x2 = *(const uint4*)(row + 16 + i0);
            const float* cp = cos32 + s * 16 + i0; const float* sp = sin32 + s * 16 + i0;
            const float4 c0 = *(const float4*)cp, c1 = *(const float4*)(cp + 4), q0 = *(const float4*)sp, q1 = *(const float4*)(sp + 4);
            const float cc[8] = {c0.x, c0.y, c0.z, c0.w, c1.x, c1.y, c1.z, c1.w}, ss[8] = {q0.x, q0.y, q0.z, q0.w, q1.x, q1.y, q1.z, q1.w};
            rope8(x1, x2, cc, ss);
            *(uint4*)(row + i0) = x1; *(uint4*)(row + 16 + i0) = x2;
        }
#pragma unroll 1
        for (int hd = 0; hd < 4; ++hd)
            vt_tile(kvmla + (size_t)T0 * 512 + hd * 128 + 64, 512, VT + ((size_t)(b * 12 + 8 + hd) * 64) * 2048 + s0, smem);
    }
}

constexpr int SM_K = 0;
constexpr int SM_V = 26624;
constexpr int SM_IMP = SM_V + 17408;
constexpr int SM_SEL = SM_IMP + 16896;
constexpr int SM_CTRL = 65536;
constexpr int SM_TOTAL = SM_CTRL + 256 + 512;
constexpr int SM_ATTN_END = SM_SEL + 1024;

struct RangeIter { int cur, end; DEV int next() { return cur < end ? cur++ : -1; } };
struct BitIter { unsigned rem; DEV int next() { if (!rem) return -1; const int k = __ffs((int)rem) - 1; rem &= rem - 1; return k; } };
struct LdRow { const bf16_t* base; int ld;
    DEV uint4 operator()(int kt, int id) const { const int row = id >> 3, part = id & 7; return *(const uint4*)(base + (size_t)(kt * 64 + row) * ld + part * 8); } };
struct LdVT { const bf16_t* base;
    DEV uint4 operator()(int kt, int id) const { const int d = id >> 3, part = id & 7; return *(const uint4*)(base + (size_t)d * 2048 + kt * 64 + part * 8); } };
struct LdMlaK { const bf16_t* kv; const bf16_t* kr;
    DEV uint4 operator()(int kt, int id) const { const int row = id / 12, part = id % 12; const size_t t = (size_t)(kt * 64 + row);
        return part < 8 ? *(const uint4*)(kv + t * 512 + part * 8) : *(const uint4*)(kr + t * LDC + (part - 8) * 8); } };

struct MaskCausal { DEV bool on(int) const { return true; } DEV bool ok(int kc, int d) const { return kc <= d; }
    DEV bool full(int kt, int t0w) const { return kt * 64 + 63 <= t0w; } };
template <int W> struct MaskWin { DEV bool on(int) const { return true; } DEV bool ok(int kc, int d) const { return (kc <= d) && (d - kc < W); }
    DEV bool full(int kt, int t0w) const { return (kt * 64 + 63 <= t0w) && (t0w + 31 - kt * 64 < W); } };
struct MaskSel { unsigned bits, allbits; DEV bool on(int kt) const { return (bits >> kt) & 1u; } DEV bool ok(int kc, int d) const { return kc <= d; }
    DEV bool full(int kt, int t0w) const { return ((allbits >> kt) & 1u) && (kt * 64 + 63 <= t0w); } };
template <int KDIM, int NKS, int NSUB, bool QG, class It, class LK, class LV, class MaskF, class SkipF>
DEV void attn_stream(It it, const LK& ldK, const LV& ldV, const MaskF& maskf, const SkipF& skipf,
                     const bf16x8* qf, f32x16 (&o)[NSUB][2], float (&m)[NSUB], float (&l)[NSUB], float scl, int tq, int t0w, char* smem, int tid, int koff = 0) {
    constexpr int KCH = KDIM / 8, KSTR = KDIM + 8, NKC = (64 * KCH) / 256;
    constexpr int KBUF = 64 * 104, VBUF = 64 * 68;
    bf16_t* Kb = (bf16_t*)(smem + SM_K);
    bf16_t* Vb = (bf16_t*)(smem + SM_V);
    const int lane = tid & 63, ql = lane & 31, hh = lane >> 5;
    const uint4 z4 = make_uint4(0, 0, 0, 0);
    uint4 ak0 = z4, ak1 = z4, ak2 = z4, av0 = z4, av1 = z4, bk0 = z4, bk1 = z4, bk2 = z4, bv0 = z4, bv1 = z4;
    auto loadA = [&](int kt) __attribute__((always_inline)) { ak0 = ldK(kt, tid); ak1 = ldK(kt, tid + 256); if (NKC == 3) ak2 = ldK(kt, tid + 512); av0 = ldV(kt, tid); av1 = ldV(kt, tid + 256); };
    auto loadB = [&](int kt) __attribute__((always_inline)) { bk0 = ldK(kt, tid); bk1 = ldK(kt, tid + 256); if (NKC == 3) bk2 = ldK(kt, tid + 512); bv0 = ldV(kt, tid); bv1 = ldV(kt, tid + 256); };
    auto stK = [&](bf16_t* kb, const uint4& r, int id) __attribute__((always_inline)) { const int row = id / KCH, part = id % KCH; *(uint4*)(kb + row * KSTR + part * 8) = r; };
    auto stV = [&](bf16_t* vb, const uint4& r, int id) __attribute__((always_inline)) { const int row = id >> 3, part = id & 7; bf16_t* d = vb + row * 68 + part * 8;
        *(uint2*)d = make_uint2(r.x, r.y); *(uint2*)(d + 4) = make_uint2(r.z, r.w); };
    auto compute = [&](int kt, const bf16_t* Kt, const bf16_t* Vt) __attribute__((always_inline)) {
        if (skipf(kt)) return;
#pragma unroll
        for (int sub = 0; sub < NSUB; ++sub) {
            const int tqs = tq + (QG ? 32 * sub : 0), t0s = t0w + (QG ? 32 * sub : 0);
            if (QG && kt * 64 > t0s + 31) continue;
            __builtin_amdgcn_sched_barrier(0);
            f32x16 s[2];
#pragma unroll
            for (int i = 0; i < 2; ++i) {
                s[i] = zero16();
#pragma unroll
                for (int ks = 0; ks < NKS; ++ks) {
                    const bf16x8 a = *(const bf16x8*)(Kt + (i * 32 + ql) * KSTR + koff + ((QG ? 0 : sub * NKS) + ks) * 16 + hh * 8);
                    s[i] = mfma32(a, qf[sub * NKS + ks], s[i]);
                }
            }
            float mx = kNeg;
            if (!maskf.full(kt, t0s)) {
                const int dlim = tqs - kt * 64 - 4 * hh;
                const bool on = maskf.on(kt);
#pragma unroll
                for (int i = 0; i < 2; ++i)
#pragma unroll
                    for (int r = 0; r < 16; ++r) {
                        const int kc = i * 32 + (r & 3) + 8 * (r >> 2);
                        s[i][r] = (on && maskf.ok(kc, dlim)) ? s[i][r] : kNeg;
                    }
            }
#pragma unroll
            for (int i = 0; i < 2; ++i)
#pragma unroll
                for (int r = 0; r < 16; ++r) mx = fmaxf(mx, s[i][r]);
            mx = fmaxf(mx, xor32f(mx, lane));
            const float mnew = fmaxf(m[sub], mx);
            const float alpha = __builtin_amdgcn_exp2f((m[sub] - mnew) * scl);
            m[sub] = mnew;
            const float negm = mnew > -1e29f ? -mnew * scl : 0.f;
            float sum = 0.f;
#pragma unroll
            for (int i = 0; i < 2; ++i)
#pragma unroll
                for (int r = 0; r < 16; ++r) { const float pv = __builtin_amdgcn_exp2f(__builtin_fmaf(s[i][r], scl, negm)); s[i][r] = pv; sum += pv; }
            l[sub] = l[sub] * alpha + sum;
#pragma unroll
            for (int dt = 0; dt < 2; ++dt)
#pragma unroll
                for (int r = 0; r < 16; ++r) o[sub][dt][r] *= alpha;
            __builtin_amdgcn_sched_barrier(0);
#pragma unroll
            for (int ks = 0; ks < 4; ++ks) {
                if (ks == 2) __builtin_amdgcn_sched_barrier(0);
                const int i = ks >> 1, r0 = 8 * (ks & 1);
                uint4 pu;
                pu.x = pack2(s[i][r0 + 0], s[i][r0 + 1]); pu.y = pack2(s[i][r0 + 2], s[i][r0 + 3]);
                pu.z = pack2(s[i][r0 + 4], s[i][r0 + 5]); pu.w = pack2(s[i][r0 + 6], s[i][r0 + 7]);
                const bf16x8 pf = __builtin_bit_cast(bf16x8, pu);
#pragma unroll
                for (int dt = 0; dt < 2; ++dt) {
                    const bf16_t* vp = Vt + (dt * 32 + ql) * 68 + ks * 16 + 4 * hh;
                    const uint2 a0 = *(const uint2*)vp, a1 = *(const uint2*)(vp + 8);
                    const bf16x8 a = __builtin_bit_cast(bf16x8, make_uint4(a0.x, a0.y, a1.x, a1.y));
                    o[sub][dt] = mfma32(a, pf, o[sub][dt]);
                }
            }
        }
    };
    int ka = it.next();
    int kb = ka >= 0 ? it.next() : -1;
    if (ka >= 0) loadA(ka);
    if (kb >= 0) loadB(kb);
    while (ka >= 0) {
        __syncthreads();
        stK(Kb, ak0, tid); stK(Kb, ak1, tid + 256); if (NKC == 3) stK(Kb, ak2, tid + 512);
        stV(Vb, av0, tid); stV(Vb, av1, tid + 256);
        if (kb >= 0) {
            stK(Kb + KBUF, bk0, tid); stK(Kb + KBUF, bk1, tid + 256); if (NKC == 3) stK(Kb + KBUF, bk2, tid + 512);
            stV(Vb + VBUF, bv0, tid); stV(Vb + VBUF, bv1, tid + 256);
        }
        __syncthreads();
        const int na = it.next();
        const int nb = na >= 0 ? it.next() : -1;
        if (na >= 0) loadA(na);
        if (nb >= 0) loadB(nb);
        compute(ka, Kb, Vb);
        if (kb >= 0) compute(kb, Kb + KBUF, Vb + VBUF);
        ka = na; kb = nb;
    }
}

DEV void write_o(const f32x16 (&o)[2], bf16_t* obuf, size_t row, int col0, int hh) {
#pragma unroll
    for (int dt = 0; dt < 2; ++dt)
#pragma unroll
        for (int g = 0; g < 4; ++g) {
            const int d = dt * 32 + 8 * g + 4 * hh;
            uint2 u; u.x = pack2(o[dt][4 * g], o[dt][4 * g + 1]); u.y = pack2(o[dt][4 * g + 2], o[dt][4 * g + 3]);
            *(uint2*)(obuf + row * 1024 + col0 + d) = u;
        }
}
DEV float sigmoidf(float x) { return 1.f / (1.f + __expf(-x)); }

DEV void nsa_item(const Params& p, int b, int qb, char* smem) {
    int tid = threadIdx.x; asm volatile("" : "+v"(tid));
    const int lane = tid & 63, w = tid >> 6, ql = lane & 31, hh = lane >> 5;
    char* ws = p.ws;
    const bf16_t* cols = (const bf16_t*)(ws + OFF_COLS);
    const bf16_t* VT = (const bf16_t*)(ws + OFF_VT);
    bf16_t* obuf = (bf16_t*)(ws + OFF_O);
    const int t0 = qb * 32, tq = t0 + ql;
    const size_t Tb = (size_t)b * kS;
    const bf16_t* qrow = cols + (Tb + tq) * LDC;
    bf16x8 qf[4];
#pragma unroll
    for (int ks = 0; ks < 4; ++ks) qf[ks] = *(const bf16x8*)(qrow + w * 64 + ks * 16 + hh * 8);
    const float g0 = sigmoidf(bf2f(qrow[640 + w * 3 + 0])), g1 = sigmoidf(bf2f(qrow[640 + w * 3 + 1])), g2 = sigmoidf(bf2f(qrow[640 + w * 3 + 2]));
    const float scl = 0.125f * kLog2e;
    bf16_t* Kc = (bf16_t*)(smem + SM_K);
    bf16_t* Vc = (bf16_t*)(smem + SM_V);
    float* impP = (float*)(smem + SM_IMP);
    unsigned* selm = (unsigned*)(smem + SM_SEL);
    const bf16_t* kcmp = (const bf16_t*)(ws + OFF_KCMP) + (size_t)b * 128 * 64;
    const bf16_t* vcmp = kcmp + 1024 * 64;
    __syncthreads();
#pragma unroll
    for (int i = 0; i < 4; ++i) {
        const int id = tid + 256 * i, row = id >> 3, part = id & 7;
        uint4 kk = *(const uint4*)(kcmp + row * 64 + part * 8);
        uint4 vv = *(const uint4*)(vcmp + row * 64 + part * 8);
        if (row == 127) { kk = make_uint4(0, 0, 0, 0); vv = kk; }
        *(uint4*)(Kc + row * 72 + part * 8) = kk;
        const unsigned u[4] = {vv.x, vv.y, vv.z, vv.w};
#pragma unroll
        for (int j = 0; j < 4; ++j) { Vc[(part * 8 + 2 * j) * 132 + row] = (bf16_t)(u[j] & 0xffffu); Vc[(part * 8 + 2 * j + 1) * 132 + row] = (bf16_t)(u[j] >> 16); }
    }
    __syncthreads();
    unsigned ocp[16];
    float* invs = (float*)(smem + SM_SEL) + 64;
    {
        const int cmaxv = tq >= 31 ? min((tq - 31) >> 4, 126) : -1;
        float mx = kNeg;
#pragma unroll 1
        for (int i = 0; i < 4; ++i) {
            f32x16 s = zero16();
#pragma unroll
            for (int ks = 0; ks < 4; ++ks) s = mfma32(*(const bf16x8*)(Kc + (i * 32 + ql) * 72 + ks * 16 + hh * 8), qf[ks], s);
            const int clim = cmaxv - i * 32 - 4 * hh;
#pragma unroll
            for (int r = 0; r < 16; ++r) {
                const int kc = (r & 3) + 8 * (r >> 2);
                const bool valid = (kc <= clim);
                mx = fmaxf(mx, valid ? s[r] * scl : kNeg);
            }
        }
        mx = fmaxf(mx, xor32f(mx, lane));
        f32x16 ocmp[2]; ocmp[0] = zero16(); ocmp[1] = zero16();
        float sum = 0.f, carprev = 0.f;
#pragma unroll 1
        for (int i = 0; i < 4; ++i) {
            f32x16 s = zero16();
#pragma unroll
            for (int ks = 0; ks < 4; ++ks) s = mfma32(*(const bf16x8*)(Kc + (i * 32 + ql) * 72 + ks * 16 + hh * 8), qf[ks], s);
            const int clim = cmaxv - i * 32 - 4 * hh;
#pragma unroll
            for (int r = 0; r < 16; ++r) {
                const int kc = (r & 3) + 8 * (r >> 2);
                const bool valid = (kc <= clim);
                const float pv = valid ? __builtin_amdgcn_exp2f(s[r] * scl - mx) : 0.f;
                s[r] = pv; sum += pv;
            }
            float own[4], car[4];
#pragma unroll
            for (int g = 0; g < 4; ++g) { own[g] = s[4 * g] + s[4 * g + 1] + s[4 * g + 2] + 0.5f * s[4 * g + 3]; car[g] = 0.5f * s[4 * g + 3]; }
#pragma unroll
            for (int g = 0; g < 4; ++g) {
                const float send = hh ? (g ? car[g > 0 ? g - 1 : 0] : carprev) : car[g];
                own[g] += xor32f(send, lane);
            }
            carprev = car[3];
#pragma unroll
            for (int g = 0; g < 4; ++g) impP[(w * 32 + ql) * 33 + 2 * (4 * i + g) + hh] = own[g];
#pragma unroll
            for (int sp = 0; sp < 2; ++sp) {
                const int ks = 2 * i + sp, r0 = 8 * sp;
                uint4 pu;
                pu.x = pack2(s[r0 + 0], s[r0 + 1]); pu.y = pack2(s[r0 + 2], s[r0 + 3]);
                pu.z = pack2(s[r0 + 4], s[r0 + 5]); pu.w = pack2(s[r0 + 6], s[r0 + 7]);
                const bf16x8 pf = __builtin_bit_cast(bf16x8, pu);
#pragma unroll
                for (int dt = 0; dt < 2; ++dt) {
                    const bf16_t* vp = Vc + (dt * 32 + ql) * 132 + ks * 16 + 4 * hh;
                    const uint2 a0 = *(const uint2*)vp, a1 = *(const uint2*)(vp + 8);
                    ocmp[dt] = mfma32(__builtin_bit_cast(bf16x8, make_uint4(a0.x, a0.y, a1.x, a1.y)), pf, ocmp[dt]);
                }
            }
        }
        sum += xor32f(sum, lane);
        const float inv = sum > 0.f ? 1.f / sum : 0.f;
        invs[w * 32 + ql] = inv;
        const float f = g0 * inv;
#pragma unroll
        for (int dt = 0; dt < 2; ++dt)
#pragma unroll
            for (int r = 0; r < 8; ++r) ocp[dt * 8 + r] = pack2(f * ocmp[dt][2 * r], f * ocmp[dt][2 * r + 1]);
    }
    __syncthreads();
    const int qblk = t0 >> 6;
    {
        const int hw = tid >> 5, j = tid & 31;
#pragma unroll 1
        for (int rr = 0; rr < 4; ++rr) {
            const int row = hw * 4 + rr;
            const float v = impP[(0 * 32 + row) * 33 + j] * invs[row] + impP[(1 * 32 + row) * 33 + j] * invs[32 + row]
                          + impP[(2 * 32 + row) * 33 + j] * invs[64 + row] + impP[(3 * 32 + row) * 33 + j] * invs[96 + row];
            bool sel;
            if (qblk < 16) sel = (j <= qblk);
            else {
                const bool cand = (j >= 1) && (j <= qblk - 2);
                const bool forced = (j == 0) || (j == qblk) || (j == qblk - 1);
                int rank = 0;
                for (int j2 = 1; j2 <= qblk - 2; ++j2) {
                    const float v2 = lanef(v, (lane & 32) + j2);
                    rank += (v2 > v || (v2 == v && j2 < j)) ? 1 : 0;
                }
                sel = forced || (cand && rank < 13);
            }
            const unsigned long long bal = __ballot(sel);
            const unsigned mk = (lane & 32) ? (unsigned)(bal >> 32) : (unsigned)bal;
            if (j == 0) selm[row] = mk;
        }
    }
    __syncthreads();
    const unsigned mysel = selm[ql];
    unsigned U = mysel, Uall = mysel;
#pragma unroll
    for (int o = 16; o > 0; o >>= 1) { U |= (unsigned)__builtin_amdgcn_ds_bpermute((lane ^ o) << 2, (int)U); Uall &= (unsigned)__builtin_amdgcn_ds_bpermute((lane ^ o) << 2, (int)Uall); }
    Uall = (unsigned)__builtin_amdgcn_readfirstlane((int)Uall);
    {
        f32x16 o1[1][2]; o1[0][0] = zero16(); o1[0][1] = zero16();
        float m1[1] = {kNeg}, l1[1] = {0.f};
        auto skipf = [&](int) __attribute__((always_inline)) { return false; };
        attn_stream<64, 4, 1, false>(BitIter{U}, LdRow{cols + Tb * LDC + 384, LDC}, LdVT{VT + (size_t)(b * 12 + 0) * 64 * 2048}, MaskSel{mysel, Uall}, skipf, qf, o1, m1, l1, scl, tq, __builtin_amdgcn_readfirstlane(t0), smem, tid);
        const float lt = l1[0] + xor32f(l1[0], lane);
        const float f = g1 / lt;
#pragma unroll
        for (int dt = 0; dt < 2; ++dt)
#pragma unroll
            for (int r = 0; r < 8; ++r) ocp[dt * 8 + r] = pack2(lo16(ocp[dt * 8 + r]) + f * o1[0][dt][2 * r], hi16(ocp[dt * 8 + r]) + f * o1[0][dt][2 * r + 1]);
    }
    {
        f32x16 o1[1][2]; o1[0][0] = zero16(); o1[0][1] = zero16();
        float m1[1] = {kNeg}, l1[1] = {0.f};
        auto skipf = [&](int) __attribute__((always_inline)) { return false; };
        const int lo = t0 >= 511 ? ((t0 - 511) >> 6) : 0;
        attn_stream<64, 4, 1, false>(RangeIter{lo, qblk + 1}, LdRow{cols + Tb * LDC + 512, LDC}, LdVT{VT + (size_t)(b * 12 + 1) * 64 * 2048}, MaskWin<512>{}, skipf, qf, o1, m1, l1, scl, tq, __builtin_amdgcn_readfirstlane(t0), smem, tid);
        const float lt = l1[0] + xor32f(l1[0], lane);
        const float f = g2 / lt;
#pragma unroll
        for (int dt = 0; dt < 2; ++dt)
#pragma unroll
            for (int r = 0; r < 8; ++r) { o1[0][dt][2 * r] = lo16(ocp[dt * 8 + r]) + f * o1[0][dt][2 * r]; o1[0][dt][2 * r + 1] = hi16(ocp[dt * 8 + r]) + f * o1[0][dt][2 * r + 1]; }
        write_o(o1[0], obuf, Tb + tq, w * 64, hh);
    }
}

DEV void diff_item(const Params& p, int layer, int b, int hd, int qc, char* smem) {
    int tid = threadIdx.x; asm volatile("" : "+v"(tid));
    const int lane = tid & 63, w = tid >> 6, ql = lane & 31, hh = lane >> 5;
    const int sub = w & 1, qh = w >> 1;
    char* ws = p.ws;
    const bf16_t* cols = (const bf16_t*)(ws + OFF_COLS);
    const bf16_t* VT = (const bf16_t*)(ws + OFF_VT);
    bf16_t* obuf = (bf16_t*)(ws + OFF_O);
    const float* misc = (const float*)(ws + OFF_MISC);
    const int t0w = qc * 128 + qh * 64, tq = t0w + ql;
    const size_t Tb = (size_t)b * kS;
    bf16x8 qf[4];
#pragma unroll
    for (int g = 0; g < 2; ++g)
#pragma unroll
        for (int ks = 0; ks < 2; ++ks) qf[g * 2 + ks] = *(const bf16x8*)(cols + (Tb + tq + 32 * g) * LDC + 704 + hd * 64 + sub * 32 + ks * 16 + hh * 8);
    const float scl = 0.17677669529663687f * kLog2e;
    f32x16 o2[2][2];
#pragma unroll
    for (int g = 0; g < 2; ++g) { o2[g][0] = zero16(); o2[g][1] = zero16(); }
    float m2[2] = {kNeg, kNeg}, l2[2] = {0.f, 0.f};
    auto skipf = [&](int kt) __attribute__((always_inline)) { return kt * 64 > t0w + 63; };
    attn_stream<64, 2, 2, true>(RangeIter{0, 2 * qc + 2}, LdRow{cols + Tb * LDC + 960 + hd * 64, LDC}, LdVT{VT + (size_t)(b * 12 + 2 + hd) * 64 * 2048}, MaskCausal{}, skipf, qf, o2, m2, l2, scl, tq, __builtin_amdgcn_readfirstlane(t0w), smem, tid, sub * 32);
    const float lam = misc[256 + layer], post = misc[258 + layer];
    float* ex = (float*)smem;
    __syncthreads();
#pragma unroll
    for (int g = 0; g < 2; ++g) {
        const float lt = l2[g] + xor32f(l2[g], lane);
        if (sub == 1) {
            const float f = lam / lt;
#pragma unroll
            for (int dt = 0; dt < 2; ++dt)
#pragma unroll
                for (int r = 0; r < 16; ++r) ex[(((qh * 2 + g) * 2 + dt) * 16 + r) * 64 + lane] = o2[g][dt][r] * f;
        } else {
            const float f = 1.f / lt;
#pragma unroll
            for (int dt = 0; dt < 2; ++dt)
#pragma unroll
                for (int r = 0; r < 16; ++r) o2[g][dt][r] *= f;
        }
    }
    __syncthreads();
    if (sub == 0) {
        const float* sg = p.sub_g + layer * 64;
#pragma unroll
        for (int g = 0; g < 2; ++g) {
            float ss = 0.f;
#pragma unroll
            for (int dt = 0; dt < 2; ++dt)
#pragma unroll
                for (int r = 0; r < 16; ++r) { const float v = o2[g][dt][r] - ex[(((qh * 2 + g) * 2 + dt) * 16 + r) * 64 + lane]; o2[g][dt][r] = v; ss += v * v; }
            ss += xor32f(ss, lane);
            const float rstd = rsqrtf(ss * (1.f / 64.f) + kEps) * post;
#pragma unroll
            for (int dt = 0; dt < 2; ++dt)
#pragma unroll
                for (int r = 0; r < 16; ++r) { const int d = dt * 32 + (r & 3) + 8 * (r >> 2) + 4 * hh; o2[g][dt][r] *= rstd * sg[d]; }
            write_o(o2[g], obuf, Tb + tq + 32 * g, 256 + hd * 64, hh);
        }
    }
}

DEV void mla_item(const Params& p, int b, int hd, int qc, char* smem) {
    int tid = threadIdx.x; asm volatile("" : "+v"(tid));
    const int lane = tid & 63, w = tid >> 6, ql = lane & 31, hh = lane >> 5;
    char* ws = p.ws;
    const bf16_t* cols = (const bf16_t*)(ws + OFF_COLS);
    const bf16_t* VT = (const bf16_t*)(ws + OFF_VT);
    const bf16_t* qmla = (const bf16_t*)(ws + OFF_QMLA);
    const bf16_t* kvmla = (const bf16_t*)(ws + OFF_KVMLA);
    bf16_t* obuf = (bf16_t*)(ws + OFF_O);
    const int t0w = qc * 128 + w * 32, tq = t0w + ql;
    const size_t Tb = (size_t)b * kS;
    const bf16_t* qrow = qmla + (Tb + tq) * 384 + hd * 96;
    bf16x8 qf[6];
#pragma unroll
    for (int ks = 0; ks < 6; ++ks) qf[ks] = *(const bf16x8*)(qrow + ks * 16 + hh * 8);
    const float scl = 0.10206207261596575f * kLog2e;
    f32x16 o1[1][2]; o1[0][0] = zero16(); o1[0][1] = zero16();
    float m1[1] = {kNeg}, l1[1] = {0.f};
    auto skipf = [&](int kt) __attribute__((always_inline)) { return kt * 64 > t0w + 31; };
    attn_stream<96, 6, 1, false>(RangeIter{0, 2 * qc + 2}, LdMlaK{kvmla + Tb * 512 + hd * 128, cols + Tb * LDC + 1856}, LdVT{VT + (size_t)(b * 12 + 8 + hd) * 64 * 2048}, MaskCausal{}, skipf, qf, o1, m1, l1, scl, tq, __builtin_amdgcn_readfirstlane(t0w), smem, tid);
    const float inv = 1.f / (l1[0] + xor32f(l1[0], lane));
#pragma unroll
    for (int dt = 0; dt < 2; ++dt)
#pragma unroll
        for (int r = 0; r < 16; ++r) o1[0][dt][r] *= inv;
    write_o(o1[0], obuf, Tb + tq, 512 + hd * 64, hh);
}

DEV void swa_item(const Params& p, int layer, int b, int g, int q64, char* smem) {
    int tid = threadIdx.x; asm volatile("" : "+v"(tid));
    const int lane = tid & 63, w = tid >> 6, ql = lane & 31, hh = lane >> 5;
    char* ws = p.ws;
    const bf16_t* cols = (const bf16_t*)(ws + OFF_COLS);
    const bf16_t* VT = (const bf16_t*)(ws + OFF_VT);
    bf16_t* obuf = (bf16_t*)(ws + OFF_O);
    const int head = g * 2 + (w & 1);
    const int t0w = q64 * 64 + (w >> 1) * 32, tq = t0w + ql;
    const size_t Tb = (size_t)b * kS;
    const bf16_t* qrow = cols + (Tb + tq) * LDC + 1920 + head * 64;
    bf16x8 qf[4];
#pragma unroll
    for (int ks = 0; ks < 4; ++ks) qf[ks] = *(const bf16x8*)(qrow + ks * 16 + hh * 8);
    const float scl = 0.125f * kLog2e;
    f32x16 o1[1][2]; o1[0][0] = zero16(); o1[0][1] = zero16();
    float m1[1] = {p.sinks[layer * 4 + head] * 8.f}, l1[1] = {hh == 0 ? 1.f : 0.f};
    auto skipf = [&](int kt) __attribute__((always_inline)) { return (kt * 64 > t0w + 31) || (kt * 64 + 63 < t0w - 127); };
    const int lo = q64 >= 2 ? q64 - 2 : 0;
    attn_stream<64, 4, 1, false>(RangeIter{lo, q64 + 1}, LdRow{cols + Tb * LDC + 2176 + g * 64, LDC}, LdVT{VT + (size_t)(b * 12 + 6 + g) * 64 * 2048}, MaskWin<128>{}, skipf, qf, o1, m1, l1, scl, tq, __builtin_amdgcn_readfirstlane(t0w), smem, tid);
    const float inv = 1.f / (l1[0] + xor32f(l1[0], lane));
#pragma unroll
    for (int dt = 0; dt < 2; ++dt)
#pragma unroll
        for (int r = 0; r < 16; ++r) o1[0][dt][r] *= inv;
    write_o(o1[0], obuf, Tb + tq, 768 + head * 64, hh);
}

DEV void phase_attn(const Params& p, int layer, char* smem, int rep = 0) {
    unsigned* ctr = (unsigned*)(p.ws + OFF_CTRL) + 64 + layer * 16 + rep;
    volatile int* slot = (volatile int*)(smem + SM_SEL) + 48;
    for (;;) {
        __syncthreads();
        if (ltid() == 0) *slot = (int)atomicAdd(ctr, 1u);
        __syncthreads();
        const int idx = __builtin_amdgcn_readfirstlane(*slot);
        if (idx >= 2048) break;
        const int level = 15 - (idx >> 7), r = idx & 127;
#if TS_A >= 0
        const unsigned long long tsa = __builtin_amdgcn_s_memrealtime();
#endif
        if (r < 32) { diff_item(p, layer, r >> 2, r & 3, level, smem); }
        else if (r < 64) { const int k = r - 32; mla_item(p, k >> 2, k & 3, level, smem); }
        else if (r < 96) { const int k = r - 64; nsa_item(p, k >> 2, level * 4 + (3 - (k & 3)), smem); }
        else { const int k = r - 96; swa_item(p, layer, k >> 2, (k >> 1) & 1, level * 2 + (k & 1), smem); }
#if TS_A >= 0
        if (threadIdx.x == 0 && layer == 1) {
            const int ty = r >> 5;
            unsigned long long* ts = (unsigned long long*)(p.ws + 32768);
            atomicAdd(&ts[60 + ty], (unsigned long long)(__builtin_amdgcn_s_memrealtime() - tsa));
        }
#endif
    }
}

#define XB_TMO      128
#define XB_XCNT(j)  (256  + 64 * (j))
#define XB_XSUB(j)  (1280 + 64 * (j))
#define XB_XGEN(j)  (2304 + 64 * (j))
#define XB_TOP      3328
#define XB_TOPGEN   3392
#define XB_SPIN_CAP (1u << 22)
DEV unsigned xb_ld(unsigned* p) { return __hip_atomic_load(p, __ATOMIC_RELAXED, __HIP_MEMORY_SCOPE_AGENT); }
DEV unsigned xb_add(unsigned* p, unsigned v) { return __hip_atomic_fetch_add(p, v, __ATOMIC_RELAXED, __HIP_MEMORY_SCOPE_AGENT); }
DEV unsigned xb_xcc_id() { return (unsigned)__builtin_amdgcn_s_getreg((3 << 11) | 20) & 0xFu; }
#define XB_SPIN(cond, bar) do { unsigned _sp = 0; while (cond) { __builtin_amdgcn_s_sleep(1); \
    if ((++_sp & 255u) == 0u) { if (xb_ld(&(bar)[XB_TMO])) break; if (_sp > XB_SPIN_CAP) { atomicAdd(&(bar)[XB_TMO], 1u); break; } } } } while (0)
struct XcdBarrier { unsigned* bar; unsigned x; volatile LAS unsigned* st; };
DEV XcdBarrier xcd_barrier_post(unsigned* bar, volatile LAS unsigned* st) {
    XcdBarrier b; b.bar = bar; b.x = xb_xcc_id(); b.st = st;
    if (threadIdx.x == 0) st[2] = xb_add(&bar[XB_XCNT(b.x)], 1u);
    return b;
}
DEV void xcd_barrier_complete(unsigned* bar, unsigned x, unsigned& nloc, unsigned& nx) {
    const unsigned G = gridDim.x * gridDim.y * gridDim.z;
    unsigned sum, cnt, mine, sp = 0u;
    for (;;) {
        sum = 0u; cnt = 0u; mine = 0u;
#pragma unroll
        for (unsigned j = 0; j < 16; ++j) { const unsigned c = xb_ld(&bar[XB_XCNT(j)]); sum += c; cnt += (c > 0u) ? 1u : 0u; mine = (j == x) ? c : mine; }
        if (sum == G) break;
        __builtin_amdgcn_s_sleep(1);
        if ((++sp & 255u) == 0u) { if (xb_ld(&bar[XB_TMO])) break; if (sp > XB_SPIN_CAP) { atomicAdd(&bar[XB_TMO], 1u); break; } }
    }
    nloc = mine > 0u ? mine : 1u; nx = cnt > 0u ? cnt : 1u;
}
DEV void xcd_barrier(const XcdBarrier& b) {
    asm volatile("s_waitcnt vmcnt(0)" ::: "memory");
    __syncthreads();
    if (threadIdx.x == 0) {
        unsigned* bar = b.bar;
        asm volatile("" : "+v"(bar));
        __builtin_amdgcn_s_waitcnt(0);
        unsigned nloc = b.st[0], nx = b.st[1];
        if (nloc == 0u) { xcd_barrier_complete(bar, b.x, nloc, nx); b.st[0] = nloc; b.st[1] = nx; }
        const unsigned old = xb_add(&bar[XB_XSUB(b.x)], 1u);
        const unsigned gen = old / nloc;
        if (old + 1u == (gen + 1u) * nloc) {
            __builtin_amdgcn_fence(__ATOMIC_RELEASE, "agent");
            asm volatile("s_waitcnt vmcnt(0)" ::: "memory");
            const unsigned og = xb_add(&bar[XB_TOP], 1u);
            const unsigned tg = og / nx;
            if (og + 1u == (tg + 1u) * nx) xb_add(&bar[XB_TOPGEN], 1u);
            else XB_SPIN(xb_ld(&bar[XB_TOPGEN]) == tg, bar);
            __builtin_amdgcn_fence(__ATOMIC_ACQUIRE, "agent");
            xb_add(&bar[XB_XGEN(b.x)], 1u);
            asm volatile("s_waitcnt vmcnt(0)" ::: "memory");
        } else {
            XB_SPIN(xb_ld(&bar[XB_XGEN(b.x)]) == gen, bar);
            __builtin_amdgcn_fence(__ATOMIC_ACQUIRE, "agent");
            asm volatile("s_waitcnt vmcnt(0)" ::: "memory");
        }
    }
    __syncthreads();
}

DEV unsigned fkey(float f) { const unsigned u = __float_as_uint(f); return (u & 0x80000000u) ? ~u : (u | 0x80000000u); }
DEV float funkey(unsigned k) { return __uint_as_float((k & 0x80000000u) ? (k & 0x7fffffffu) : ~k); }
DEV void ins16(unsigned (&L)[16], unsigned x) {
#pragma unroll
    for (int i = 15; i >= 1; --i) { unsigned r; asm("v_med3_u32 %0, %1, %2, %3" : "=v"(r) : "v"(L[i - 1]), "v"(L[i]), "v"(x)); L[i] = r; }
    L[0] = L[0] > x ? L[0] : x;
}
DEV void phase_topk(const Params& p, char* smem) {
    const int tid = ltid();
    const float* S1 = (const float*)(p.ws + OFF_S1);
    const float* S2 = (const float*)(p.ws + OFF_S2);
    int* eid = (int*)(p.ws + OFF_EID);
    float* gate = (float*)(p.ws + OFF_GATE);
    unsigned char* ib = (unsigned char*)smem + tid * 32;
    for (int blk = blockIdx.x; blk < kT * 8 / 256; blk += gridDim.x) {
        const size_t row = (size_t)blk * 256 + tid;
        unsigned L1[16], L2[16];
#pragma unroll
        for (int i = 0; i < 16; ++i) { L1[i] = 0u; L2[i] = 0u; }
#pragma unroll 4
        for (int k = 0; k < 128; ++k) {
            const float a = S1[(size_t)k * (kT * 8) + row], b = S2[(size_t)k * (kT * 8) + row];
            ins16(L1, (fkey(a) & ~127u) | (unsigned)(127 - k));
            ins16(L2, (fkey(b) & ~127u) | (unsigned)(127 - k));
        }
        float v1[16], v2[16];
        __syncthreads();
#pragma unroll
        for (int i = 0; i < 16; ++i) {
            v1[i] = funkey(L1[i] & ~127u); v2[i] = funkey(L2[i] & ~127u);
            ib[i] = (unsigned char)(127u - (L1[i] & 127u)); ib[16 + i] = (unsigned char)(127u - (L2[i] & 127u));
        }
        unsigned C[16];
#pragma unroll
        for (int i = 0; i < 16; ++i) C[i] = 0u;
#pragma unroll
        for (int a = 0; a < 16; ++a)
#pragma unroll
            for (int b = 0; b < 16; ++b)
                if ((a + 1) * (b + 1) <= 16) ins16(C, (fkey(v1[a] + v2[b]) & ~255u) | (unsigned)(255 - (a * 16 + b)));
        float ts[16]; float sum = 0.f;
        const float tmax = funkey(C[0] & ~255u);
#pragma unroll
        for (int i = 0; i < 16; ++i) { ts[i] = __expf(funkey(C[i] & ~255u) - tmax); sum += ts[i]; }
        const float inv = 1.f / sum;
        int ev[16];
#pragma unroll
        for (int i = 0; i < 16; ++i) { const unsigned ci = 255u - (C[i] & 255u); ev[i] = (int)ib[ci >> 4] * 128 + (int)ib[16 + (ci & 15u)]; }
#pragma unroll
        for (int i = 0; i < 4; ++i) {
            *(int4*)(eid + row * 16 + 4 * i) = make_int4(ev[4 * i], ev[4 * i + 1], ev[4 * i + 2], ev[4 * i + 3]);
            *(float4*)(gate + row * 16 + 4 * i) = make_float4(ts[4 * i] * inv, ts[4 * i + 1] * inv, ts[4 * i + 2] * inv, ts[4 * i + 3] * inv);
        }
    }
}

struct EpiTop16 {
    unsigned (&L)[16];
    DEV void tile(int, int, const float* Cs, int tid) const {
        const int r = tid & 127, hk = tid >> 7;
        unsigned T[16];
#pragma unroll
        for (int i = 0; i < 16; ++i) T[i] = 0u;
#pragma unroll 4
        for (int k = 0; k < 64; ++k) {
            const int key = hk * 64 + k;
            ins16(T, (fkey(Cs[key * 128 + r]) & ~127u) | (unsigned)(127 - key));
        }
        __syncthreads();
        unsigned* X = (unsigned*)Cs;
        if (hk) {
#pragma unroll
            for (int i = 0; i < 16; ++i) X[r * 17 + i] = T[i];
        }
        __syncthreads();
        if (!hk) {
#pragma unroll
            for (int i = 0; i < 16; ++i) ins16(T, X[r * 17 + i]);
        }
#pragma unroll
        for (int i = 0; i < 16; ++i) L[i] = T[i];
    }
};
DEV void phase_route(const Params& p, int layer, char* smem) {
    char* ws = p.ws;
    int* eid = (int*)(ws + OFF_EID);
    float* gate = (float*)(ws + OFF_GATE);
    const bf16_t* qp = (const bf16_t*)(ws + OFF_QP);
    const bf16_t* subk = (const bf16_t*)(ws + OFF_SUBK) + (size_t)(layer * 2) * 16384;
    for (int nt = blockIdx.x; nt < kT * 8 / 128; nt += gridDim.x) {
        unsigned L1[16], L2[16];
        { EpiTop16 e1{L1}; gemm_tile(subk, 128, qp, 256, 128, 0, nt * 128, smem, e1); }
        { EpiTop16 e2{L2}; gemm_tile(subk + 16384, 128, qp + 128, 256, 128, 0, nt * 128, smem, e2); }
        const int tid = ltid();
        __syncthreads();
        if (tid < 128) {
            const size_t row = (size_t)nt * 128 + tid;
            unsigned char* ib = (unsigned char*)smem + tid * 32;
            float v1[16], v2[16];
#pragma unroll
            for (int i = 0; i < 16; ++i) {
                v1[i] = funkey(L1[i] & ~127u); v2[i] = funkey(L2[i] & ~127u);
                ib[i] = (unsigned char)(127u - (L1[i] & 127u)); ib[16 + i] = (unsigned char)(127u - (L2[i] & 127u));
            }
            unsigned C[16];
#pragma unroll
            for (int i = 0; i < 16; ++i) C[i] = 0u;
#pragma unroll
            for (int a = 0; a < 16; ++a)
#pragma unroll
                for (int b = 0; b < 16; ++b)
                    if ((a + 1) * (b + 1) <= 16) ins16(C, (fkey(v1[a] + v2[b]) & ~255u) | (unsigned)(255 - (a * 16 + b)));
            float ts[16]; float sum = 0.f;
            const float tmax = funkey(C[0] & ~255u);
#pragma unroll
            for (int i = 0; i < 16; ++i) { ts[i] = __expf(funkey(C[i] & ~255u) - tmax); sum += ts[i]; }
            const float inv = 1.f / sum;
            int ev[16];
#pragma unroll
            for (int i = 0; i < 16; ++i) { const unsigned ci = 255u - (C[i] & 255u); ev[i] = (int)ib[ci >> 4] * 128 + (int)ib[16 + (ci & 15u)]; }
#pragma unroll
            for (int i = 0; i < 4; ++i) {
                *(int4*)(eid + row * 16 + 4 * i) = make_int4(ev[4 * i], ev[4 * i + 1], ev[4 * i + 2], ev[4 * i + 3]);
                *(float4*)(gate + row * 16 + 4 * i) = make_float4(ts[4 * i] * inv, ts[4 * i + 1] * inv, ts[4 * i + 2] * inv, ts[4 * i + 3] * inv);
            }
        }
    }
}

DEV float row_sum_dpp(float v) {
    v += __int_as_float(__builtin_amdgcn_update_dpp(0, __float_as_int(v), 0xB1, 0xF, 0xF, true));
    v += __int_as_float(__builtin_amdgcn_update_dpp(0, __float_as_int(v), 0x4E, 0xF, 0xF, true));
    v += __int_as_float(__builtin_amdgcn_update_dpp(0, __float_as_int(v), 0x141, 0xF, 0xF, true));
    v += __int_as_float(__builtin_amdgcn_update_dpp(0, __float_as_int(v), 0x140, 0xF, 0xF, true));
    return v;
}
DEV float wave_sum_dpp(float v) {
    v = row_sum_dpp(v);
    const float r0 = __int_as_float(__builtin_amdgcn_readlane(__float_as_int(v), 0)), r1 = __int_as_float(__builtin_amdgcn_readlane(__float_as_int(v), 16));
    const float r2 = __int_as_float(__builtin_amdgcn_readlane(__float_as_int(v), 32)), r3 = __int_as_float(__builtin_amdgcn_readlane(__float_as_int(v), 48));
    return (r0 + r1) + (r2 + r3);
}
typedef float f32x2 __attribute__((ext_vector_type(2)));
typedef float f32x4 __attribute__((ext_vector_type(4)));

struct SliceMap { int virt, nx, nloc, rank; };
DEV SliceMap slice_map(const Params& p, char* smem) {
    unsigned* bar = (unsigned*)p.ws;
    const unsigned x = xb_xcc_id();
    int virt = 0, nx = 0, nloc = 1;
#pragma unroll
    for (unsigned j = 0; j < 16; ++j) {
        const unsigned c = xb_ld(&bar[XB_XCNT(j)]);
        if (c > 0u) { if (j < x) ++virt; ++nx; }
        if (j == x) nloc = (int)c;
    }
    SliceMap m;
    m.virt = __builtin_amdgcn_readfirstlane(virt); m.nx = __builtin_amdgcn_readfirstlane(nx > 0 ? nx : 1); m.nloc = __builtin_amdgcn_readfirstlane(nloc > 0 ? nloc : 1);
    m.rank = __builtin_amdgcn_readfirstlane((int)((volatile LAS unsigned*)(smem + SM_CTRL))[2]);
    return m;
}

typedef _Float16 half2_t __attribute__((ext_vector_type(2)));
DEV void phase_peer_u(const Params& p, int layer, char* smem, int rep = 0) {
    const int tid = ltid(), lane = tid & 63, w = tid >> 6, l8 = lane & 7, grp = lane >> 3;
    char* ws = p.ws;
    const SliceMap sm = slice_map(p, smem);
    const bf16_t* h = (const bf16_t*)(ws + OFF_H);
    const int* eid = (const int*)(ws + OFF_EID);
    float* part = (float*)(ws + OFF_S1) + (rep ? (size_t)8 * kT * 128 : 0);
    int* ids_l = (int*)(smem + w * 9216);
    const int nk = sm.rank < 512 ? (512 - sm.rank + sm.nloc - 1) / sm.nloc : 0;
    for (int s = sm.virt; s < 8; s += sm.nx) {
        if (nk == 0) break;
        const unsigned char* U = (const unsigned char*)(ws + OFF_PU) + (((size_t)layer * 8 + s) * 16384 << 7) + l8 * 16;
        uint4 ri0, ri1, ri2, ri3, rh0, rh1;
        auto load_oct = [&](int k) __attribute__((always_inline)) {
            const size_t o = (size_t)(sm.rank + k * sm.nloc) * 4 + w;
            const uint4* ip = (const uint4*)(eid + o * 1024) + lane;
            ri0 = ip[0]; ri1 = ip[64]; ri2 = ip[128]; ri3 = ip[192];
            const bf16_t* hp = h + (o * 8 + grp) * 1024 + s * 128 + l8 * 16;
            rh0 = *(const uint4*)hp; rh1 = *(const uint4*)(hp + 8);
        };
        half2_t hh[8];
        auto store_oct = [&]() __attribute__((always_inline)) {
            uint4* il = (uint4*)ids_l + lane;
            il[0] = ri0; il[64] = ri1; il[128] = ri2; il[192] = ri3;
            const unsigned hu[8] = {rh0.x, rh0.y, rh0.z, rh0.w, rh1.x, rh1.y, rh1.z, rh1.w};
#pragma unroll
            for (int i = 0; i < 8; ++i) hh[i] = (half2_t){(_Float16)lo16(hu[i]), (_Float16)hi16(hu[i])};
        };
        load_oct(0); store_oct();
#pragma unroll 1
        for (int k = 0; k < nk; ++k) {
            if (k + 1 < nk) load_oct(k + 1);
            const size_t o = (size_t)(sm.rank + k * sm.nloc) * 4 + w;
            float* pp = part + ((size_t)s * kT + o * 8 + grp) * 128 + l8;
            uint4 va[8], vb[8];
            auto issue = [&](uint4 (&v)[8], int c) __attribute__((always_inline)) {
                const int4 i0 = *(const int4*)(ids_l + grp * 128 + c * 8), i1 = *(const int4*)(ids_l + grp * 128 + c * 8 + 4);
                const int e[8] = {i0.x, i0.y, i0.z, i0.w, i1.x, i1.y, i1.z, i1.w};
#pragma unroll
                for (int j = 0; j < 8; ++j) v[j] = *(const uint4*)(U + ((size_t)e[j] << 7));
            };
            auto compute = [&](const uint4 (&v)[8], int c) __attribute__((always_inline)) {
                float res = 0.f;
#pragma unroll
                for (int j = 0; j < 8; ++j) {
                    const unsigned d[4] = {v[j].x, v[j].y, v[j].z, v[j].w};
                    float acc = 0.f;
#pragma unroll
                    for (int q = 0; q < 4; ++q) {
                        const half2_t lo = __builtin_amdgcn_cvt_scalef32_pk_f16_fp8(d[q], 1.0f, false);
                        const half2_t hi = __builtin_amdgcn_cvt_scalef32_pk_f16_fp8(d[q], 1.0f, true);
                        acc = __builtin_amdgcn_fdot2(lo, hh[2 * q], acc, false);
                        acc = __builtin_amdgcn_fdot2(hi, hh[2 * q + 1], acc, false);
                    }
                    acc += __int_as_float(__builtin_amdgcn_update_dpp(0, __float_as_int(acc), 0xB1, 0xF, 0xF, true));
                    acc += __int_as_float(__builtin_amdgcn_update_dpp(0, __float_as_int(acc), 0x4E, 0xF, 0xF, true));
                    acc += __int_as_float(__builtin_amdgcn_update_dpp(0, __float_as_int(acc), 0x141, 0xF, 0xF, true));
                    res = (l8 == j) ? acc : res;
                    __builtin_amdgcn_sched_barrier(0);
                }
                pp[c * 8] = res;
            };
            issue(va, 0);
#pragma unroll
            for (int c = 0; c < 16; c += 2) {
                issue(vb, c + 1);
                __builtin_amdgcn_sched_barrier(0);
                compute(va, c);
                __builtin_amdgcn_sched_barrier(0);
                if (c + 2 < 16) issue(va, c + 2);
                __builtin_amdgcn_sched_barrier(0);
                compute(vb, c + 1);
                __builtin_amdgcn_sched_barrier(0);
            }
            if (k + 1 < nk) store_oct();
        }
    }
}

DEV void phase_peer_comb(const Params& p, int rep = 0) {
    const int tid = ltid();
    const float* part = (const float*)(p.ws + OFF_S1);
    float* gate = (float*)(p.ws + OFF_GATE);
    for (size_t i = (size_t)blockIdx.x * 256 + tid; i < (size_t)kT * 128 / 4; i += (size_t)gridDim.x * 256) {
        float4 a = *(const float4*)(part + i * 4);
#pragma unroll
        for (int x = 1; x < 8; ++x) { const float4 b = *(const float4*)(part + (size_t)x * kT * 128 + i * 4); a.x += b.x; a.y += b.y; a.z += b.z; a.w += b.w; }
        const float4 g = *(const float4*)(gate + i * 4);
        float4 o;
        o.x = g.x * gelu_tanh(a.x * (1.f / kScaleU)); o.y = g.y * gelu_tanh(a.y * (1.f / kScaleU));
        o.z = g.z * gelu_tanh(a.z * (1.f / kScaleU)); o.w = g.w * gelu_tanh(a.w * (1.f / kScaleU));
        if (rep == 0) *(float4*)(gate + i * 4) = o;
    }
}

DEV void phase_peer_v(const Params& p, int layer, char* smem, int rep = 0) {
    const int tid = ltid(), lane = tid & 63, w = tid >> 6, l8 = lane & 7, grp = lane >> 3;
    char* ws = p.ws;
    const SliceMap sm = slice_map(p, smem);
    float* xres = (float*)(ws + OFF_XRES);
    const int* eid = (const int*)(ws + OFF_EID);
    const float* wbuf = (const float*)(ws + OFF_GATE);
    const float* mod = (const float*)(ws + OFF_MOD);
    int* ids_l = (int*)(smem + w * 9216);
    float* w_l = (float*)(smem + w * 9216 + 4096);
    const int nk = sm.rank < 512 ? (512 - sm.rank + sm.nloc - 1) / sm.nloc : 0;
    for (int s = sm.virt; s < 8; s += sm.nx) {
        if (nk == 0) break;
        const unsigned char* V = (const unsigned char*)(ws + OFF_PV) + (((size_t)layer * 8 + s) * 16384 << 7) + l8 * 16;
        uint4 ri0, ri1, ri2, ri3, rw0, rw1, rw2, rw3;
        auto load_oct = [&](int k) __attribute__((always_inline)) {
            const size_t o = (size_t)(sm.rank + k * sm.nloc) * 4 + w;
            const uint4* ip = (const uint4*)(eid + o * 1024) + lane;
            const uint4* wp = (const uint4*)(wbuf + o * 1024) + lane;
            ri0 = ip[0]; ri1 = ip[64]; ri2 = ip[128]; ri3 = ip[192];
            rw0 = wp[0]; rw1 = wp[64]; rw2 = wp[128]; rw3 = wp[192];
        };
        auto store_oct = [&]() __attribute__((always_inline)) {
            uint4* il = (uint4*)ids_l + lane; uint4* wl = (uint4*)w_l + lane;
            il[0] = ri0; il[64] = ri1; il[128] = ri2; il[192] = ri3;
            wl[0] = rw0; wl[64] = rw1; wl[128] = rw2; wl[192] = rw3;
        };
        load_oct(0); store_oct();
#pragma unroll 1
        for (int k = 0; k < nk; ++k) {
            if (k + 1 < nk) load_oct(k + 1);
            const size_t o = (size_t)(sm.rank + k * sm.nloc) * 4 + w;
            const size_t t = o * 8 + grp;
            const int b = (int)(t >> 11);
            float* xp = xres + t * 1024 + s * 128 + l8 * 16;
            const float* g2 = mod + (size_t)(layer * 8 + b) * 6144 + 5120 + s * 128 + l8 * 16;
            float4 xa[4];
#pragma unroll
            for (int c = 0; c < 4; ++c) xa[c] = *(const float4*)(xp + c * 4);
            half2_t out[8];
#pragma unroll
            for (int j = 0; j < 8; ++j) out[j] = (half2_t){(_Float16)0.f, (_Float16)0.f};
            uint4 va[8], vb[8];
            auto issue = [&](uint4 (&v)[8], int c) __attribute__((always_inline)) {
                const int4 i0 = *(const int4*)(ids_l + grp * 128 + c * 8), i1 = *(const int4*)(ids_l + grp * 128 + c * 8 + 4);
                const int e[8] = {i0.x, i0.y, i0.z, i0.w, i1.x, i1.y, i1.z, i1.w};
#pragma unroll
                for (int j = 0; j < 8; ++j) v[j] = *(const uint4*)(V + ((size_t)e[j] << 7));
            };
            auto compute = [&](const uint4 (&v)[8], int c) __attribute__((always_inline)) {
                const float4 w0 = *(const float4*)(w_l + grp * 128 + c * 8), w1 = *(const float4*)(w_l + grp * 128 + c * 8 + 4);
                const float wf[8] = {w0.x, w0.y, w0.z, w0.w, w1.x, w1.y, w1.z, w1.w};
#pragma unroll
                for (int j = 0; j < 8; ++j) {
                    const _Float16 wh = (_Float16)wf[j];
                    const half2_t ww = {wh, wh};
                    const unsigned d[4] = {v[j].x, v[j].y, v[j].z, v[j].w};
#pragma unroll
                    for (int q = 0; q < 4; ++q) {
                        const half2_t lo = __builtin_amdgcn_cvt_scalef32_pk_f16_fp8(d[q], 1.0f, false);
                        const half2_t hi = __builtin_amdgcn_cvt_scalef32_pk_f16_fp8(d[q], 1.0f, true);
                        out[2 * q] = __builtin_elementwise_fma(ww, lo, out[2 * q]);
                        out[2 * q + 1] = __builtin_elementwise_fma(ww, hi, out[2 * q + 1]);
                    }
                    __builtin_amdgcn_sched_barrier(0);
                }
            };
            issue(va, 0);
#pragma unroll
            for (int c = 0; c < 16; c += 2) {
                issue(vb, c + 1);
                __builtin_amdgcn_sched_barrier(0);
                compute(va, c);
                __builtin_amdgcn_sched_barrier(0);
                if (c + 2 < 16) issue(va, c + 2);
                __builtin_amdgcn_sched_barrier(0);
                compute(vb, c + 1);
                __builtin_amdgcn_sched_barrier(0);
            }
            if (rep == 0 || (float)out[0].x == 12345.678f) {
#pragma unroll
                for (int c = 0; c < 4; ++c) {
                    const float4 g4 = *(const float4*)(g2 + c * 4);
                    xa[c].x += g4.x * (float)out[2 * c].x * (1.f / kScaleV); xa[c].y += g4.y * (float)out[2 * c].y * (1.f / kScaleV);
                    xa[c].z += g4.z * (float)out[2 * c + 1].x * (1.f / kScaleV); xa[c].w += g4.w * (float)out[2 * c + 1].y * (1.f / kScaleV);
                    *(float4*)(xp + c * 4) = xa[c];
                }
            }
            if (k + 1 < nk) store_oct();
        }
    }
}

DEV void phase_final(const Params& p) {
    const int tid = ltid(), lane = tid & 63, w = tid >> 6;
    const float* xs = (const float*)(p.ws + OFF_XRES);
    float4 g4[4];
#pragma unroll
    for (int i = 0; i < 4; ++i) g4[i] = *(const float4*)(p.final_g + i * 256 + lane * 4);
    for (int q0 = blockIdx.x; q0 < kT / 4; q0 += gridDim.x * 4) {
        float4 v[4][4];
#pragma unroll
        for (int u = 0; u < 4; ++u) {
            const int q = q0 + u * gridDim.x < kT / 4 ? q0 + u * gridDim.x : q0;
            const float* xr = xs + (size_t)(q * 4 + w) * 1024;
#pragma unroll
            for (int i = 0; i < 4; ++i) v[u][i] = *(const float4*)(xr + i * 256 + lane * 4);
        }
#pragma unroll
        for (int u = 0; u < 4; ++u) {
            const int q = q0 + u * gridDim.x;
            if (q >= kT / 4) break;
            const int t = q * 4 + w;
            float ss = 0.f;
#pragma unroll
            for (int i = 0; i < 4; ++i) ss += v[u][i].x * v[u][i].x + v[u][i].y * v[u][i].y + v[u][i].z * v[u][i].z + v[u][i].w * v[u][i].w;
            ss = wave_sum(ss);
            const float rstd = rsqrtf(ss * (1.f / 1024.f) + kEps);
#pragma unroll
            for (int i = 0; i < 4; ++i) {
                const int col = i * 256 + lane * 4;
                *(float4*)(p.out + (size_t)t * 1024 + col) = make_float4(v[u][i].x * rstd * g4[i].x, v[u][i].y * rstd * g4[i].y, v[u][i].z * rstd * g4[i].z, v[u][i].w * rstd * g4[i].w);
            }
        }
    }
}

DEV uint4 pack8f(const float (&e)[8]) { return make_uint4(pack2(e[0], e[1]), pack2(e[2], e[3]), pack2(e[4], e[5]), pack2(e[6], e[7])); }
DEV float4 rope4(float4 v, int lane, bool is64, bool low, float4 c, float4 sn) {
    const int pl = (lane ^ (is64 ? 8 : 4)) << 2;
    float4 o;
    o.x = __int_as_float(__builtin_amdgcn_ds_bpermute(pl, __float_as_int(v.x))); o.y = __int_as_float(__builtin_amdgcn_ds_bpermute(pl, __float_as_int(v.y)));
    o.z = __int_as_float(__builtin_amdgcn_ds_bpermute(pl, __float_as_int(v.z))); o.w = __int_as_float(__builtin_amdgcn_ds_bpermute(pl, __float_as_int(v.w)));
    float4 r;
    r.x = v.x * c.x + (low ? -o.x : o.x) * sn.x; r.y = v.y * c.y + (low ? -o.y : o.y) * sn.y;
    r.z = v.z * c.z + (low ? -o.z : o.z) * sn.z; r.w = v.w * c.w + (low ? -o.w : o.w) * sn.w;
    return r;
}
struct EpiIn {
    char* ws;
    DEV void tile(int m0, int n0, const float* Cs, int tid) const {
        const int lane = tid & 63, w = tid >> 6, g16 = lane >> 4, c4 = lane & 15;
        bf16_t* cols = (bf16_t*)(ws + OFF_COLS);
        bf16_t* VT = (bf16_t*)(ws + OFF_VT);
        const float* rope = (const float*)(ws + OFF_ROPE);
        const float *cos64 = rope, *sin64 = rope + 2048 * 32, *cos32 = rope + 2048 * 64, *sin32 = rope + 2048 * 64 + 2048 * 16;
        const int b = m0 >> 11, s0 = m0 & 2047;
#pragma unroll 1
        for (int h = 0; h < 2; ++h) {
            const int cb = n0 + 64 * h;
            int vh = -1;
            if (cb == 448) vh = 0; else if (cb == 576) vh = 1; else if (cb >= 1216 && cb < 1472) vh = 2 + ((cb - 1216) >> 6); else if (cb >= 2304) vh = 6 + ((cb - 2304) >> 6);
            if (vh >= 0) {
                bf16_t* dst = VT + ((size_t)(b * 12 + vh) * 64 + lane) * 2048 + s0;
#pragma unroll
                for (int q = 0; q < 4; ++q) {
                    const int tc = w + 4 * q;
                    float e[8];
#pragma unroll
                    for (int j = 0; j < 8; ++j) e[j] = Cs[(tc * 8 + j) * 128 + h * 64 + lane];
                    *(uint4*)(dst + tc * 8) = pack8f(e);
                }
                continue;
            }
            const bool r64 = cb < 320 || cb == 384 || cb == 512 || (cb >= 1920 && cb < 2304);
            const bool r32 = (cb >= 704 && cb < 1216) || cb == 1856;
            bf16_t* dbase; int dld;
            if (cb == 256) { dbase = (bf16_t*)(ws + OFF_KC); dld = 64; } else if (cb == 320) { dbase = (bf16_t*)(ws + OFF_VC); dld = 64; } else { dbase = cols + cb; dld = LDC; }
            float4 cc[8], sn[8];
            if (r64 || r32) {
                const int i = (c4 * 4) & (r64 ? 31 : 15);
#pragma unroll
                for (int it = 0; it < 8; ++it) {
                    const int sq = s0 + it * 16 + w * 4 + g16;
                    cc[it] = *(const float4*)((r64 ? cos64 + sq * 32 : cos32 + sq * 16) + i);
                    sn[it] = *(const float4*)((r64 ? sin64 + sq * 32 : sin32 + sq * 16) + i);
                }
            }
#pragma unroll
            for (int it = 0; it < 8; ++it) {
                const int r = it * 16 + w * 4 + g16;
                float4 v = *(const float4*)(Cs + r * 128 + h * 64 + c4 * 4);
                if (r64 || r32) v = rope4(v, lane, r64, !(c4 & (r64 ? 8 : 4)), cc[it], sn[it]);
                *(uint2*)(dbase + (size_t)(m0 + r) * dld + c4 * 4) = make_uint2(pack2(v.x, v.y), pack2(v.z, v.w));
            }
        }
    }
};
DEV void mla_rstd_tile(const bf16_t* src  , int ncols, float* rsl, int tid) {
    const int lane = tid & 63, w = tid >> 6, g16 = lane >> 4, c4 = lane & 15;
#pragma unroll 2
    for (int it = 0; it < 8; ++it) {
        const int r = it * 16 + w * 4 + g16;
        const bf16_t* rp = src + (size_t)r * LDC + c4 * (ncols >> 4);
        float ss = 0.f;
        const uint4 u = *(const uint4*)rp;
        ss += lo16(u.x) * lo16(u.x) + hi16(u.x) * hi16(u.x) + lo16(u.y) * lo16(u.y) + hi16(u.y) * hi16(u.y)
            + lo16(u.z) * lo16(u.z) + hi16(u.z) * hi16(u.z) + lo16(u.w) * lo16(u.w) + hi16(u.w) * hi16(u.w);
        if (ncols == 256) {
            const uint4 u2 = *(const uint4*)(rp + 8);
            ss += lo16(u2.x) * lo16(u2.x) + hi16(u2.x) * hi16(u2.x) + lo16(u2.y) * lo16(u2.y) + hi16(u2.y) * hi16(u2.y)
                + lo16(u2.z) * lo16(u2.z) + hi16(u2.z) * hi16(u2.z) + lo16(u2.w) * lo16(u2.w) + hi16(u2.w) * hi16(u2.w);
        }
        ss = row_sum_dpp(ss);
        if (c4 == 0) rsl[r] = rsqrtf(ss / (float)ncols + kEps);
    }
}
struct EpiMlaQ {
    char* ws; const float* rsl;
    DEV void tile(int m0, int n0, const float* Cs, int tid) const {
        const int lane = tid & 63, w = tid >> 6, g16 = lane >> 4, c4 = lane & 15;
        bf16_t* qmla = (bf16_t*)(ws + OFF_QMLA);
        const float* rope = (const float*)(ws + OFF_ROPE);
        const float *cos32 = rope + 2048 * 64, *sin32 = rope + 2048 * 64 + 2048 * 16;
        const int s0 = m0 & 2047;
#pragma unroll 1
        for (int h = 0; h < 2; ++h) {
            const int col = n0 + 64 * h + c4 * 4;
            const bool isrope = ((col >> 5) % 3) == 2;
            float4 cc[8], sn[8];
#pragma unroll
            for (int it = 0; it < 8; ++it) {
                const int sq = s0 + it * 16 + w * 4 + g16, i = (c4 * 4) & 15;
                cc[it] = *(const float4*)(cos32 + sq * 16 + i); sn[it] = *(const float4*)(sin32 + sq * 16 + i);
            }
#pragma unroll
            for (int it = 0; it < 8; ++it) {
                const int r = it * 16 + w * 4 + g16;
                float4 v = *(const float4*)(Cs + r * 128 + h * 64 + c4 * 4);
                const float sc = rsl[r];
                v.x *= sc; v.y *= sc; v.z *= sc; v.w *= sc;
                const float4 vr = rope4(v, lane, false, !(c4 & 4), cc[it], sn[it]);
                if (isrope) v = vr;
                *(uint2*)(qmla + (size_t)(m0 + r) * 384 + col) = make_uint2(pack2(v.x, v.y), pack2(v.z, v.w));
            }
        }
    }
};
struct EpiMlaKV {
    char* ws; const float* rsl;
    DEV void tile(int m0, int n0, const float* Cs, int tid) const {
        const int lane = tid & 63, w = tid >> 6, g16 = lane >> 4, c4 = lane & 15;
        bf16_t* kvmla = (bf16_t*)(ws + OFF_KVMLA);
        bf16_t* VT = (bf16_t*)(ws + OFF_VT);
        const int b = m0 >> 11, s0 = m0 & 2047, hd = n0 >> 7;
#pragma unroll 2
        for (int it = 0; it < 8; ++it) {
            const int r = it * 16 + w * 4 + g16;
            float4 v = *(const float4*)(Cs + r * 128 + c4 * 4);
            const float sc = rsl[r];
            *(uint2*)(kvmla + (size_t)(m0 + r) * 512 + n0 + c4 * 4) = make_uint2(pack2(v.x * sc, v.y * sc), pack2(v.z * sc, v.w * sc));
        }
        bf16_t* dst = VT + ((size_t)(b * 12 + 8 + hd) * 64 + lane) * 2048 + s0;
#pragma unroll
        for (int q = 0; q < 4; ++q) {
            const int tc = w + 4 * q;
            float e[8];
#pragma unroll
            for (int j = 0; j < 8; ++j) e[j] = Cs[(tc * 8 + j) * 128 + 64 + lane] * rsl[tc * 8 + j];
            *(uint4*)(dst + tc * 8) = pack8f(e);
        }
    }
};

DEV void phase_gemm_in(const Params& p, int layer, char* smem) {
    char* ws = p.ws;
    EpiIn epi{ws};
    gemm_phase((const bf16_t*)(ws + OFF_H), 1024, (const bf16_t*)(ws + OFF_WIN) + (size_t)layer * 2432 * 1024, 1024, 1024, kT / 128, LDC / 128, smem, epi);
}
DEV void phase_gemm_mid(const Params& p, int layer, char* smem) {
    char* ws = p.ws;
    const float* misc = (const float*)(ws + OFF_MISC);
    const bf16_t* cols = (const bf16_t*)(ws + OFF_COLS);
    float* rsl = (float*)(smem + SM_CTRL + 256);
    for (int tile = blockIdx.x; tile < 16 + 384 + 512; tile += gridDim.x) {
        if (tile < 8) {
            EpiBf16 epi{(bf16_t*)(ws + OFF_KCMP), 64, nullptr, misc + (layer * 2 + 0) * 64, 64};
            gemm_tile((const bf16_t*)(ws + OFF_KC), 1024, (const bf16_t*)(ws + OFF_WCK) + (size_t)layer * 128 * 2048, 2048, 2048, tile * 128, 0, smem, epi);
        } else if (tile < 16) {
            EpiBf16 epi{(bf16_t*)(ws + OFF_KCMP) + 1024 * 64, 64, nullptr, misc + (layer * 2 + 1) * 64, 64};
            gemm_tile((const bf16_t*)(ws + OFF_VC), 1024, (const bf16_t*)(ws + OFF_WCV) + (size_t)layer * 128 * 2048, 2048, 2048, (tile - 8) * 128, 0, smem, epi);
        } else if (tile < 16 + 384) {
            const int tt = tile - 16, m0 = (tt / 3) * 128;
            __syncthreads();
            mla_rstd_tile(cols + (size_t)m0 * LDC + 1472, 256, rsl, ltid());
            EpiMlaQ epi{ws, rsl};
            gemm_tile(cols + 1472, LDC, (const bf16_t*)(ws + OFF_WUQ) + (size_t)layer * 384 * 256, 256, 256, m0, (tt % 3) * 128, smem, epi);
        } else {
            const int tt = tile - 16 - 384, m0 = (tt / 4) * 128;
            __syncthreads();
            mla_rstd_tile(cols + (size_t)m0 * LDC + 1728, 128, rsl, ltid());
            EpiMlaKV epi{ws, rsl};
            gemm_tile(cols + 1728, LDC, (const bf16_t*)(ws + OFF_WUKV) + (size_t)layer * 512 * 128, 128, 128, m0, (tt % 4) * 128, smem, epi);
        }
    }
}
DEV void phase_gemm_out(const Params& p, int layer, char* smem) {
    char* ws = p.ws;
    EpiRes epi{layer == 0 ? p.x : (const float*)(ws + OFF_XRES), (float*)(ws + OFF_XRES), (const float*)(ws + OFF_MOD) + (size_t)layer * 8 * 6144 + 2048};
    gemm_phase((const bf16_t*)(ws + OFF_O), 1024, (const bf16_t*)(ws + OFF_WOUT) + (size_t)layer * 1024 * 1024, 1024, 1024, kT / 128, 8, smem, epi);
}
DEV void phase_gemm_wq(const Params& p, int layer, char* smem) {
    char* ws = p.ws;
    EpiBf16 epi{(bf16_t*)(ws + OFF_QP), 2048, nullptr, nullptr, 2048};
    gemm_phase((const bf16_t*)(ws + OFF_H), 1024, (const bf16_t*)(ws + OFF_WQ) + (size_t)layer * 2048 * 1024, 1024, 1024, kT / 128, 16, smem, epi);
}
DEV void phase_scores(const Params& p, int layer, char* smem) {
    char* ws = p.ws;
    for (int tile = blockIdx.x; tile < 2048; tile += gridDim.x) {
        const int c = tile >> 10, nt = tile & 1023;
        EpiF32 epi{(float*)(ws + (c ? OFF_S2 : OFF_S1)), kT * 8};
        gemm_tile((const bf16_t*)(ws + OFF_SUBK) + (size_t)(layer * 2 + c) * 16384, 128, (const bf16_t*)(ws + OFF_QP) + c * 128, 256, 128, 0, nt * 128, smem, epi);
    }
}

constexpr int NPHASE = 16;
DEV void run_phase(const Params& p, int ph, int layer, char* smem, int rep = 0) {
    switch (ph) {
        case 0: phase_prologue(p, smem); break;
        case 1: phase_norm(p, layer, 0); break;
        case 2: phase_gemm_in(p, layer, smem); break;
        case 3: phase_layout1(p, smem); break;
        case 4: phase_gemm_mid(p, layer, smem); break;
        case 5: phase_layout2(p, layer, smem); break;
        case 6: phase_attn(p, layer, smem, rep); break;
        case 7: phase_gemm_out(p, layer, smem); break;
        case 8: phase_norm(p, layer, 1); break;
        case 9: phase_gemm_wq(p, layer, smem); break;
        case 10: phase_route(p, layer, smem); break;
        case 11: phase_topk(p, smem); break;
        case 12: phase_peer_u(p, layer, smem, rep); break;
        case 13: phase_peer_comb(p, rep); break;
        case 14: phase_peer_v(p, layer, smem, rep); break;
        case 15: if (layer == 0) phase_norm(p, 1, 0); else phase_final(p); break;
        default: break;
    }
}

#if !FUSED
template <int PH>
__global__ void __launch_bounds__(256, 2) k_phase(Params p, int layer) {
    __shared__ __attribute__((aligned(16))) char smem[SM_TOTAL];
    run_phase(p, PH, layer, smem);
}
template <int PH> static void launch_phase(const Params& p, int layer, hipStream_t stream) { k_phase<PH><<<512, 256, 0, stream>>>(p, layer); }
static void launch_ph(int ph, const Params& p, int layer, hipStream_t stream) {
    switch (ph) {
        case 0: launch_phase<0>(p, layer, stream); break;
        case 1: launch_phase<1>(p, layer, stream); break;
        case 2: launch_phase<2>(p, layer, stream); break;
        case 3: launch_phase<3>(p, layer, stream); break;
        case 4: launch_phase<4>(p, layer, stream); break;
        case 5: launch_phase<5>(p, layer, stream); break;
        case 6: launch_phase<6>(p, layer, stream); break;
        case 7: launch_phase<7>(p, layer, stream); break;
        case 8: launch_phase<8>(p, layer, stream); break;
        case 9: launch_phase<9>(p, layer, stream); break;
        case 10: launch_phase<10>(p, layer, stream); break;
        case 11: launch_phase<11>(p, layer, stream); break;
        case 12: launch_phase<12>(p, layer, stream); break;
    }
}
#else
#if TS_A >= 0
#define TSTAMP(I) if (blockIdx.x == 0 && threadIdx.x == 0) ((unsigned long long*)(p.ws + 32768))[I] = __builtin_amdgcn_s_memrealtime();
#else
#define TSTAMP(I)
#endif
__global__ void __launch_bounds__(256, 2) k_mega(Params p) {
    extern __shared__ __attribute__((aligned(1024))) char smem[];
    cg::grid_group grid = cg::this_grid();
    volatile LAS unsigned* st = (volatile LAS unsigned*)(smem + SM_CTRL);
    if (threadIdx.x == 0) { st[0] = 0u; st[1] = 0u; st[2] = 0u; }
    __syncthreads();
    const XcdBarrier xb = xcd_barrier_post((unsigned*)p.ws, st);
    TSTAMP(0)
    run_phase(p, 0, 0, smem);
    if (p.out == nullptr) grid.sync();
    xcd_barrier(xb);
    TSTAMP(1)
    run_phase(p, 1, 0, smem);
    xcd_barrier(xb);
    TSTAMP(2)
#define STEP(PH, L) { run_phase(p, PH, L, smem, 0); xcd_barrier(xb); TSTAMP(2 + (L) * 16 + (PH)) }
#define LAYER(L) STEP(2, L) STEP(4, L) STEP(6, L) STEP(7, L) STEP(8, L) STEP(9, L) STEP(10, L) STEP(12, L) STEP(13, L) STEP(14, L)
    LAYER(0)
    STEP(15, 0)
    LAYER(1)
    run_phase(p, 15, 1, smem);
#if TS_A >= 0
    TSTAMP(2 + 16 + 15)
    __syncthreads();
    if (blockIdx.x == 0 && threadIdx.x == 0) {
        const unsigned long long* ts = (const unsigned long long*)(p.ws + 32768);
        p.out[0] += (TS_A == 50) ? (float)ts[TS_B] * (0.01f / 512.f / 10.f) : (float)(ts[TS_B] - ts[TS_A]) * 0.001f;
    }
#endif
}
#endif

extern "C" void kernel_launch(void* const* d_in, const int* in_sizes, int n_in, void* d_out, int out_size, void* d_ws, size_t ws_size, hipStream_t stream) {
    Params p{};
    const float** pp = (const float**)&p;
    for (int i = 0; i < 28; ++i) pp[i] = (const float*)d_in[i];
    p.out = (float*)d_out;
    p.ws = (char*)d_ws;
    if (ws_size < OFF_END) fprintf(stderr, "workspace too small: %zu < %zu\n", ws_size, (size_t)OFF_END);
    (void)hipMemsetAsync(d_ws, 0, 65536, stream);
#if !FUSED
    launch_ph(0, p, 0, stream);
    launch_ph(1, p, 0, stream);
    for (int l = 0; l < 2; ++l)
        for (int ph = 2; ph < NPHASE; ++ph) launch_ph(ph, p, l, stream);
#else
    static int grid_blocks = 0;
    if (!grid_blocks) {
        int dev = 0, cus = 0, per_cu = 0;
        (void)hipGetDevice(&dev);
        (void)hipDeviceGetAttribute(&cus, hipDeviceAttributeMultiprocessorCount, dev);
        (void)hipFuncSetAttribute((const void*)k_mega, hipFuncAttributeMaxDynamicSharedMemorySize, SM_TOTAL);
        (void)hipOccupancyMaxActiveBlocksPerMultiprocessor(&per_cu, (const void*)k_mega, 256, SM_TOTAL);
        if (per_cu > 2) per_cu = 2;
        if (per_cu < 1) per_cu = 1;
        grid_blocks = cus * per_cu;
    }
    void* args[] = {&p};
    hipError_t e = hipLaunchCooperativeKernel((const void*)k_mega, dim3(grid_blocks), dim3(256), args, SM_TOTAL, stream);
    if (e != hipSuccess) fprintf(stderr, "cooperative launch failed: %s (grid %d)\n", hipGetErrorString(e), grid_blocks);
#endif
}
```

```cpp
#include <hip/hip_runtime.h>
#include <hip/hip_cooperative_groups.h>
#include <stdint.h>
#include <stdio.h>
namespace cg = cooperative_groups;

#ifndef FUSED
#define FUSED 1
#endif
#ifndef TS_A
#define TS_A -1
#define TS_B -1
#endif
#ifndef PROBE_PH
#define PROBE_PH -1
#define PROBE_L 1
#define PROBE_REP 0
#endif

#define DEV __device__ __forceinline__
#define LAS __attribute__((address_space(3)))
typedef unsigned short bf16_t;
typedef short bf16x8 __attribute__((ext_vector_type(8)));
typedef float f32x16 __attribute__((ext_vector_type(16)));

constexpr int kB = 8, kS = 2048, kT = kB * kS, kD = 1024, LDC = 2432;
constexpr float kEps = 1e-6f;
constexpr float kNeg = -1e30f;
constexpr float kLog2e = 1.4426950408889634f;
constexpr float kScaleU = 256.f, kScaleV = 32.f;

constexpr size_t OFF_CTRL = 0;
constexpr size_t OFF_MOD  = 65536;
constexpr size_t OFF_ROPE = OFF_MOD + 2ull * 8 * 6144 * 4;
constexpr size_t OFF_MISC = OFF_ROPE + 2048ull * 96 * 4;
constexpr size_t OFF_WIN  = OFF_MISC + 4096;
constexpr size_t OFF_WOUT = OFF_WIN + 2ull * 2432 * 1024 * 2;
constexpr size_t OFF_WQ   = OFF_WOUT + 2ull * 1024 * 1024 * 2;
constexpr size_t OFF_WUQ  = OFF_WQ + 2ull * 2048 * 1024 * 2;
constexpr size_t OFF_WUKV = OFF_WUQ + 2ull * 384 * 256 * 2;
constexpr size_t OFF_WCK  = OFF_WUKV + 2ull * 512 * 128 * 2;
constexpr size_t OFF_WCV  = OFF_WCK + 2ull * 128 * 2048 * 2;
constexpr size_t OFF_SUBK = OFF_WCV + 2ull * 128 * 2048 * 2;
constexpr size_t OFF_PU   = OFF_SUBK + 2ull * 2 * 128 * 128 * 2;
constexpr size_t OFF_PV   = OFF_PU + 2ull * 16384 * 1024;
constexpr size_t OFF_XRES = OFF_PV + 2ull * 16384 * 1024;
constexpr size_t OFF_H    = OFF_XRES + (size_t)kT * 1024 * 4;
constexpr size_t OFF_H8   = OFF_H + (size_t)kT * 1024 * 2;
constexpr size_t OFF_RSTD = OFF_H8 + (size_t)kT * 1024;
constexpr size_t OFF_KCMP = OFF_RSTD + 2ull * kT * 4;
constexpr size_t OFF_EID  = OFF_KCMP + 2ull * 1024 * 64 * 2;
constexpr size_t OFF_GATE = OFF_EID + (size_t)kT * 128 * 4;
constexpr size_t OFF_QP   = OFF_GATE + (size_t)kT * 128 * 4;
constexpr size_t OFF_COLS = OFF_QP + (size_t)kT * 2048 * 2;
constexpr size_t OFF_KC   = OFF_COLS + (size_t)kT * LDC * 2;
constexpr size_t OFF_VC   = OFF_KC + (size_t)(kT + 64) * 64 * 2;
constexpr size_t OFF_VT   = OFF_VC + (size_t)(kT + 64) * 64 * 2;
constexpr size_t OFF_QMLA = OFF_VT + 8ull * 12 * 64 * 2048 * 2;
constexpr size_t OFF_KVMLA = OFF_QMLA + (size_t)kT * 384 * 2;
constexpr size_t OFF_O    = OFF_KVMLA + (size_t)kT * 512 * 2;
constexpr size_t OFF_END  = OFF_O + (size_t)kT * 1024 * 2;
constexpr size_t OFF_S1 = OFF_COLS, OFF_S2 = OFF_COLS + (size_t)kT * 8 * 128 * 4;
static_assert(OFF_S2 + (size_t)kT * 8 * 128 * 4 <= OFF_O, "alias region too small");
static_assert(OFF_END <= (512ull << 20), "workspace too large");

struct Params {
    const float *x, *c, *ada_w, *ada_b, *norm_mix_g, *norm_ffn_g, *w_in, *pos_k, *pos_v, *cmp_wk, *cmp_wv;
    const float *lq1, *lk1, *lq2, *lk2, *sub_g, *mla_qg, *mla_wuq, *mla_kvg, *mla_wukv, *sinks, *w_out;
    const float *w_q, *subk1, *subk2, *pu, *pv, *final_g;
    float* out;
    char* ws;
};

DEV int ltid() { int t = threadIdx.x; asm volatile("" : "+v"(t)); return t; }
DEV float bf2f(bf16_t v) { return __uint_as_float(((unsigned)v) << 16); }
DEV bf16_t f2bf(float f) { unsigned u = __float_as_uint(f); u += 0x7fffu + ((u >> 16) & 1u); return (bf16_t)(u >> 16); }
DEV unsigned pack2(float lo, float hi) { unsigned r; asm("v_cvt_pk_bf16_f32 %0, %1, %2" : "=v"(r) : "v"(lo), "v"(hi)); return r; }
DEV float lo16(unsigned u) { return __uint_as_float(u << 16); }
DEV float hi16(unsigned u) { return __uint_as_float(u & 0xffff0000u); }
DEV float wave_sum(float v) {
#pragma unroll
    for (int o = 32; o > 0; o >>= 1) v += __shfl_xor(v, o, 64);
    return v;
}
DEV float xor32f(float v, int lane) { return __int_as_float(__builtin_amdgcn_ds_bpermute((lane ^ 32) << 2, __float_as_int(v))); }
DEV float lanef(float v, int src) { return __int_as_float(__builtin_amdgcn_ds_bpermute(src << 2, __float_as_int(v))); }
DEV f32x16 mfma32(bf16x8 a, bf16x8 b, f32x16 c) { return __builtin_amdgcn_mfma_f32_32x32x16_bf16(a, b, c, 0, 0, 0); }
DEV f32x16 zero16() { f32x16 z;
#pragma unroll
    for (int i = 0; i < 16; ++i) z[i] = 0.f;
    return z; }
DEV float gelu_tanh(float x) {
    const float u = 0.7978845608028654f * (x + 0.044715f * x * x * x);
    const float e = __expf(2.f * u);
    const float t = 1.f - 2.f / (e + 1.f);
    return 0.5f * x * (1.f + t);
}

template <class Epi>
DEV void gemm_tile(const bf16_t* __restrict__ A, int lda, const bf16_t* __restrict__ Bt, int ldb, int K, int m0, int n0, char* smem, const Epi& epi) {
    const int tid = ltid(), lane = tid & 63, w = tid >> 6, wm = w >> 1, wn = w & 1, ql = lane & 31, hh = lane >> 5;
    f32x16 acc[2][2];
#pragma unroll
    for (int i = 0; i < 2; ++i)
#pragma unroll
        for (int j = 0; j < 2; ++j) acc[i][j] = zero16();
    const int srow = lane >> 3, spos = lane & 7;
    const int c0 = spos ^ ((srow >> 1) & 7), c1 = spos ^ ((4 + (srow >> 1)) & 7);
    const bf16_t* Ag0 = A + (size_t)(m0 + w * 32 + srow) * lda + c0 * 8;
    const bf16_t* Ag1 = A + (size_t)(m0 + w * 32 + 8 + srow) * lda + c1 * 8;
    const bf16_t* Bg0 = Bt + (size_t)(n0 + w * 32 + srow) * ldb + c0 * 8;
    const bf16_t* Bg1 = Bt + (size_t)(n0 + w * 32 + 8 + srow) * ldb + c1 * 8;
    const size_t a16 = (size_t)16 * lda, b16 = (size_t)16 * ldb;
    auto stage = [&](int kt, int buf) __attribute__((always_inline)) {
        char* sa = smem + buf * 32768 + w * 4096;
        char* sb = sa + 16384;
        const int ko = kt * 64;
        __builtin_amdgcn_global_load_lds((const unsigned*)(Ag0 + ko), (LAS unsigned*)(sa), 16, 0, 0);
        __builtin_amdgcn_global_load_lds((const unsigned*)(Ag1 + ko), (LAS unsigned*)(sa + 1024), 16, 0, 0);
        __builtin_amdgcn_global_load_lds((const unsigned*)(Ag0 + a16 + ko), (LAS unsigned*)(sa + 2048), 16, 0, 0);
        __builtin_amdgcn_global_load_lds((const unsigned*)(Ag1 + a16 + ko), (LAS unsigned*)(sa + 3072), 16, 0, 0);
        __builtin_amdgcn_global_load_lds((const unsigned*)(Bg0 + ko), (LAS unsigned*)(sb), 16, 0, 0);
        __builtin_amdgcn_global_load_lds((const unsigned*)(Bg1 + ko), (LAS unsigned*)(sb + 1024), 16, 0, 0);
        __builtin_amdgcn_global_load_lds((const unsigned*)(Bg0 + b16 + ko), (LAS unsigned*)(sb + 2048), 16, 0, 0);
        __builtin_amdgcn_global_load_lds((const unsigned*)(Bg1 + b16 + ko), (LAS unsigned*)(sb + 3072), 16, 0, 0);
    };
    const int key = (ql >> 1) & 7;
    const int arow = (wm * 64 + ql) * 128, brow = (wn * 64 + ql) * 128;
    const int nk = K >> 6;
    __syncthreads();
    stage(0, 0);
    for (int kt = 0; kt < nk; ++kt) {
        asm volatile("s_waitcnt vmcnt(0)" ::: "memory");
        __syncthreads();
        if (kt + 1 < nk) stage(kt + 1, (kt + 1) & 1);
        const char* As = smem + (kt & 1) * 32768;
        const char* Bs = As + 16384;
#pragma unroll
        for (int ks = 0; ks < 4; ++ks) {
            const int co = ((ks * 2 + hh) ^ key) << 4;
            bf16x8 a[2], b[2];
#pragma unroll
            for (int i = 0; i < 2; ++i) {
                a[i] = *(const bf16x8*)(As + arow + i * 4096 + co);
                b[i] = *(const bf16x8*)(Bs + brow + i * 4096 + co);
            }
#pragma unroll
            for (int i = 0; i < 2; ++i)
#pragma unroll
                for (int j = 0; j < 2; ++j) acc[i][j] = mfma32(a[i], b[j], acc[i][j]);
        }
    }
    __syncthreads();
    float* Cs = (float*)smem;
#pragma unroll
    for (int i = 0; i < 2; ++i)
#pragma unroll
        for (int j = 0; j < 2; ++j)
#pragma unroll
            for (int r = 0; r < 16; ++r)
                Cs[(wm * 64 + i * 32 + (r & 3) + 8 * (r >> 2) + 4 * hh) * 128 + wn * 64 + j * 32 + ql] = acc[i][j][r];
    __syncthreads();
    epi.tile(m0, n0, Cs, tid);
}

struct EpiBf16 {
    bf16_t* C; int ldc; const float* rowscale; const float* colbias; int nvalid;
    DEV void tile(int m0, int n0, const float* Cs, int tid) const {
#pragma unroll
        for (int it = 0; it < 8; ++it) {
            const int id = tid + 256 * it, r = id >> 4, c8 = (id & 15) * 8;
            if (n0 + c8 >= nvalid) continue;
            float4 a = *(const float4*)(Cs + r * 128 + c8), b = *(const float4*)(Cs + r * 128 + c8 + 4);
            if (rowscale) { const float sc = rowscale[m0 + r]; a.x *= sc; a.y *= sc; a.z *= sc; a.w *= sc; b.x *= sc; b.y *= sc; b.z *= sc; b.w *= sc; }
            if (colbias) { const float4 ba = *(const float4*)(colbias + n0 + c8), bb = *(const float4*)(colbias + n0 + c8 + 4);
                a.x += ba.x; a.y += ba.y; a.z += ba.z; a.w += ba.w; b.x += bb.x; b.y += bb.y; b.z += bb.z; b.w += bb.w; }
            *(uint4*)(C + (size_t)(m0 + r) * ldc + n0 + c8) = make_uint4(pack2(a.x, a.y), pack2(a.z, a.w), pack2(b.x, b.y), pack2(b.z, b.w));
        }
    }
};
struct EpiF32 {
    float* C; int ldc;
    DEV void tile(int m0, int n0, const float* Cs, int tid) const {
#pragma unroll
        for (int it = 0; it < 16; ++it) {
            const int id = tid + 256 * it, r = id >> 5, c4 = (id & 31) * 4;
            *(float4*)(C + (size_t)(m0 + r) * ldc + n0 + c4) = *(const float4*)(Cs + r * 128 + c4);
        }
    }
};
struct EpiRes {
    const float* xin; float* xout; const float* gate;
    DEV void tile(int m0, int n0, const float* Cs, int tid) const {
        const float* g = gate + (size_t)(m0 >> 11) * 6144 + n0;
#pragma unroll
        for (int it = 0; it < 16; ++it) {
            const int id = tid + 256 * it, r = id >> 5, c4 = (id & 31) * 4;
            const float4 v = *(const float4*)(Cs + r * 128 + c4), g4 = *(const float4*)(g + c4);
            float4 x = *(const float4*)(xin + (size_t)(m0 + r) * 1024 + n0 + c4);
            x.x += g4.x * v.x; x.y += g4.y * v.y; x.z += g4.z * v.z; x.w += g4.w * v.w;
            *(float4*)(xout + (size_t)(m0 + r) * 1024 + n0 + c4) = x;
        }
    }
};

template <class Epi>
DEV void gemm_phase(const bf16_t* A, int lda, const bf16_t* Bt, int ldb, int K, int mtiles, int ntiles, char* smem, const Epi& epi) {
    for (int tile = blockIdx.x; tile < mtiles * ntiles; tile += gridDim.x) {
        const int mt = tile / ntiles, nt = tile % ntiles;
        gemm_tile(A, lda, Bt, ldb, K, mt * 128, nt * 128, smem, epi);
    }
}

DEV int win_srccol(int n) {
    if (n < 652) return n;
    if (n < 704) return -1;
    if (n < 1888) return n - 52;
    if (n < 1920) return -1;
    return n - 84;
}
DEV void transpose_tile(const float* __restrict__ src, int ld_src, int nsrc_valid, int mode, const float* __restrict__ rowscale,
                        bf16_t* __restrict__ dst, int K, int n0, int k0, char* smem) {
    bf16_t* Ls = (bf16_t*)smem;
    const int tid = ltid();
    __syncthreads();
    const int nn = tid & 63, n = n0 + nn;
    const int sc = (mode == 1) ? win_srccol(n) : (mode == 2) ? (n & 63) : (n < nsrc_valid ? n : -1);
    const int kshift = (mode == 2 && n >= 64) ? 1024 : 0;
#pragma unroll 4
    for (int i = 0; i < 16; ++i) {
        const int kk = (tid >> 6) + 4 * i;
        float v = 0.f;
        if (sc >= 0) { v = src[(size_t)(k0 + kk + kshift) * ld_src + sc]; if (rowscale) v *= rowscale[k0 + kk]; }
        Ls[nn * 72 + kk] = f2bf(v);
    }
    __syncthreads();
#pragma unroll
    for (int i = 0; i < 2; ++i) {
        const int r = (tid >> 3) + 32 * i, ch = tid & 7;
        *(uint4*)(dst + (size_t)(n0 + r) * K + k0 + ch * 8) = *(const uint4*)(Ls + r * 72 + ch * 8);
    }
}

DEV void convert_stream(const float* __restrict__ src, bf16_t* __restrict__ dst, size_t n8) {
    const int tid = ltid();
    for (size_t i = (size_t)blockIdx.x * 256 + tid; i < n8; i += (size_t)gridDim.x * 256) {
        const float4 a = *(const float4*)(src + i * 8), b = *(const float4*)(src + i * 8 + 4);
        uint4 o; o.x = pack2(a.x, a.y); o.y = pack2(a.z, a.w); o.z = pack2(b.x, b.y); o.w = pack2(b.z, b.w);
        *(uint4*)(dst + i * 8) = o;
    }
}

DEV void convert_fp8_stream(const float* __restrict__ src, unsigned char* __restrict__ dst, size_t n16, float scale) {
    const int tid = ltid();
    const size_t stride = (size_t)gridDim.x * 256;
    for (size_t i0 = (size_t)blockIdx.x * 256 + tid; i0 < n16; i0 += stride * 4) {
        float4 q[4][4];
#pragma unroll
        for (int u = 0; u < 4; ++u) {
            const size_t i = i0 + u * stride < n16 ? i0 + u * stride : i0;
#pragma unroll
            for (int c = 0; c < 4; ++c) q[u][c] = *(const float4*)(src + i * 16 + c * 4);
        }
#pragma unroll
        for (int u = 0; u < 4; ++u) {
            const size_t i = i0 + u * stride;
            if (i >= n16) break;
            unsigned o[4];
#pragma unroll
            for (int j = 0; j < 4; ++j) {
                const float4 v = q[u][j];
                unsigned w = 0u;
                w = __builtin_amdgcn_cvt_pk_fp8_f32(fminf(fmaxf(v.x * scale, -440.f), 440.f), fminf(fmaxf(v.y * scale, -440.f), 440.f), w, false);
                w = __builtin_amdgcn_cvt_pk_fp8_f32(fminf(fmaxf(v.z * scale, -440.f), 440.f), fminf(fmaxf(v.w * scale, -440.f), 440.f), w, true);
                o[j] = w;
            }
            const size_t rowg = i >> 6; const int c16 = (int)(i & 63);
            const size_t l = rowg >> 14, row = rowg & 16383;
            *(uint4*)(dst + (((l * 8 + (c16 >> 3)) * 16384 + row) << 7) + (c16 & 7) * 16) = make_uint4(o[0], o[1], o[2], o[3]);
        }
    }
}

constexpr int J_ROPE = 384, J_MOD = 192, J_MISC = 5;
constexpr int J_TW_L = 608 + 256 + 512 + 24 + 16 + 64 + 64;
constexpr int J_TOTAL = J_ROPE + J_MOD + J_MISC + 2 * J_TW_L;

DEV void prologue_job(const Params& p, int job, char* smem) {
    const int tid = ltid();
    char* ws = p.ws;
    if (job < J_MISC) {
        float* misc = (float*)(ws + OFF_MISC);
        if (job < 4) {
            const int l = job >> 1, kv = job & 1;
            const float* pos = (kv ? p.pos_v : p.pos_k) + l * 2048;
            const float* wsrc = (kv ? p.cmp_wv : p.cmp_wk) + (size_t)l * 2048 * 64;
            float* red = (float*)smem;
            __syncthreads();
            const int kp = tid >> 6, n = tid & 63;
            float acc = 0.f;
            for (int k0 = kp * 512; k0 < kp * 512 + 512; k0 += 16) {
                float wv[16];
#pragma unroll
                for (int u = 0; u < 16; ++u) wv[u] = wsrc[(size_t)(k0 + u) * 64 + n];
#pragma unroll
                for (int u = 0; u < 16; ++u) acc += pos[k0 + u] * wv[u];
            }
            red[kp * 64 + n] = acc;
            __syncthreads();
            if (tid < 64) misc[(l * 2 + kv) * 64 + tid] = red[tid] + red[64 + tid] + red[128 + tid] + red[192 + tid];
        } else if (tid < 2) {
            const int l = tid;
            float d1 = 0.f, d2 = 0.f;
            for (int i = 0; i < 32; ++i) { d1 += p.lq1[l * 32 + i] * p.lk1[l * 32 + i]; d2 += p.lq2[l * 32 + i] * p.lk2[l * 32 + i]; }
            const float lam_init = 0.8f - 0.6f * expf(-0.3f * (float)l);
            misc[256 + l] = expf(d1) - expf(d2) + lam_init;
            misc[258 + l] = 1.f - lam_init;
        }
        return;
    }
    job -= J_MISC;
    if (job < J_MOD) {
        const int l = job / 96, n0 = (job % 96) * 64;
        float* sc = (float*)smem;
        __syncthreads();
        for (int i = tid; i < 8192; i += 256) { const float v = p.c[i]; sc[i] = v / (1.f + __expf(-v)); }
        __syncthreads();
        const int kp = tid >> 6, col = tid & 63;
        float acc[8];
#pragma unroll
        for (int b = 0; b < 8; ++b) acc[b] = 0.f;
        const float* wp = p.ada_w + (size_t)l * 1024 * 6144 + n0 + col;
        for (int k0 = kp * 256; k0 < kp * 256 + 256; k0 += 16) {
            float wv[16];
#pragma unroll
            for (int u = 0; u < 16; ++u) wv[u] = wp[(size_t)(k0 + u) * 6144];
#pragma unroll
            for (int u = 0; u < 16; ++u)
#pragma unroll
                for (int b = 0; b < 8; ++b) acc[b] += sc[b * 1024 + k0 + u] * wv[u];
        }
        float* red = sc + 8192;
#pragma unroll
        for (int b = 0; b < 8; ++b) red[(kp * 8 + b) * 64 + col] = acc[b];
        __syncthreads();
        float* mod = (float*)(ws + OFF_MOD);
        for (int idx = tid; idx < 512; idx += 256) {
            const int b = idx >> 6, cl = idx & 63;
            const float v = red[(0 * 8 + b) * 64 + cl] + red[(1 * 8 + b) * 64 + cl] + red[(2 * 8 + b) * 64 + cl] + red[(3 * 8 + b) * 64 + cl];
            mod[(size_t)(l * 8 + b) * 6144 + n0 + cl] = v + p.ada_b[l * 6144 + n0 + cl];
        }
        return;
    }
    job -= J_MOD;
    if (job < J_ROPE) {
        const int idx = job * 256 + tid;
        const int s = idx / 48, j = idx % 48;
        float* rope = (float*)(ws + OFF_ROPE);
        float inv; float *pc, *ps;
        if (j < 32) { inv = exp2f(-(float)j * (13.287712379549449f / 32.f)); pc = rope + s * 32 + j; ps = rope + 2048 * 32 + s * 32 + j; }
        else { const int i = j - 32; inv = exp2f(-(float)i * (13.287712379549449f / 16.f)); pc = rope + 2048 * 64 + s * 16 + i; ps = rope + 2048 * 64 + 2048 * 16 + s * 16 + i; }
        const double a = (double)s * (double)inv;
        const double kk = rint(a * 0.15915494309189535);
        const float r = (float)fma(-kk, 6.283185307179586, a);
        *pc = cosf(r); *ps = sinf(r);
        return;
    }
    job -= J_ROPE;
    const int l = job / J_TW_L; int j = job % J_TW_L;
    if (j < 608) { transpose_tile(p.w_in + (size_t)l * 1024 * 2348, 2348, 2348, 1, nullptr, (bf16_t*)(ws + OFF_WIN) + (size_t)l * 2432 * 1024, 1024, (j / 16) * 64, (j % 16) * 64, smem); return; }
    j -= 608;
    if (j < 256) { transpose_tile(p.w_out + (size_t)l * 1024 * 1024, 1024, 1024, 0, nullptr, (bf16_t*)(ws + OFF_WOUT) + (size_t)l * 1024 * 1024, 1024, (j / 16) * 64, (j % 16) * 64, smem); return; }
    j -= 256;
    if (j < 512) { transpose_tile(p.w_q + (size_t)l * 1024 * 2048, 2048, 2048, 0, nullptr, (bf16_t*)(ws + OFF_WQ) + (size_t)l * 2048 * 1024, 1024, (j / 16) * 64, (j % 16) * 64, smem); return; }
    j -= 512;
    if (j < 24) { transpose_tile(p.mla_wuq + (size_t)l * 256 * 384, 384, 384, 0, p.mla_qg + l * 256, (bf16_t*)(ws + OFF_WUQ) + (size_t)l * 384 * 256, 256, (j / 4) * 64, (j % 4) * 64, smem); return; }
    j -= 24;
    if (j < 16) { transpose_tile(p.mla_wukv + (size_t)l * 128 * 512, 512, 512, 0, p.mla_kvg + l * 128, (bf16_t*)(ws + OFF_WUKV) + (size_t)l * 512 * 128, 128, (j / 2) * 64, (j % 2) * 64, smem); return; }
    j -= 16;
    if (j < 64) { if (j < 32) transpose_tile(p.cmp_wk + (size_t)l * 2048 * 64, 64, 64, 2, nullptr, (bf16_t*)(ws + OFF_WCK) + (size_t)l * 128 * 2048, 1024, (j / 16) * 64, (j % 16) * 64, smem); return; }
    j -= 64;
    if (j < 32) transpose_tile(p.cmp_wv + (size_t)l * 2048 * 64, 64, 64, 2, nullptr, (bf16_t*)(ws + OFF_WCV) + (size_t)l * 128 * 2048, 1024, (j / 16) * 64, (j % 16) * 64, smem);
}

#if TS_A >= 0
#define PSTAMP(I) if (blockIdx.x == 0 && threadIdx.x == 0) ((unsigned long long*)(p.ws + 32768))[I] = __builtin_amdgcn_s_memrealtime();
#else
#define PSTAMP(I)
#endif
DEV void phase_prologue(const Params& p, char* smem) {
    for (int job = blockIdx.x; job < J_TOTAL; job += gridDim.x) { prologue_job(p, job, smem); if (job < 512) { PSTAMP(40) } }
    PSTAMP(42)
    char* ws = p.ws;
    convert_fp8_stream(p.pu, (unsigned char*)(ws + OFF_PU), 2ull * 16384 * 1024 / 16, kScaleU);
    PSTAMP(43)
    convert_fp8_stream(p.pv, (unsigned char*)(ws + OFF_PV), 2ull * 16384 * 1024 / 16, kScaleV);
    PSTAMP(44)
    for (int l = 0; l < 2; ++l) {
        convert_stream(p.subk1 + (size_t)l * 16384, (bf16_t*)(ws + OFF_SUBK) + (size_t)(l * 2 + 0) * 16384, 16384 / 8);
        convert_stream(p.subk2 + (size_t)l * 16384, (bf16_t*)(ws + OFF_SUBK) + (size_t)(l * 2 + 1) * 16384, 16384 / 8);
    }
}

DEV void phase_norm(const Params& p, int layer, int which) {
    const int tid = ltid(), lane = tid & 63, w = tid >> 6;
    const float* xs = (layer == 0 && which == 0) ? p.x : (const float*)(p.ws + OFF_XRES);
    const float* g = (which == 0 ? p.norm_mix_g : p.norm_ffn_g) + layer * 1024;
    const float* mod = (const float*)(p.ws + OFF_MOD) + (size_t)layer * 8 * 6144;
    bf16_t* h = (bf16_t*)(p.ws + OFF_H);
    float4 g4[4];
#pragma unroll
    for (int i = 0; i < 4; ++i) g4[i] = *(const float4*)(g + i * 256 + lane * 4);
    for (int q0 = blockIdx.x; q0 < kT / 4; q0 += gridDim.x * 4) {
        float4 v[4][4];
#pragma unroll
        for (int u = 0; u < 4; ++u) {
            const int q = q0 + u * gridDim.x < kT / 4 ? q0 + u * gridDim.x : q0;
            const float* xr = xs + (size_t)(q * 4 + w) * 1024;
#pragma unroll
            for (int i = 0; i < 4; ++i) v[u][i] = *(const float4*)(xr + i * 256 + lane * 4);
        }
#pragma unroll
        for (int u = 0; u < 4; ++u) {
            const int q = q0 + u * gridDim.x;
            if (q >= kT / 4) break;
            const int t = q * 4 + w, b = t >> 11;
            float ss = 0.f;
#pragma unroll
            for (int i = 0; i < 4; ++i) ss += v[u][i].x * v[u][i].x + v[u][i].y * v[u][i].y + v[u][i].z * v[u][i].z + v[u][i].w * v[u][i].w;
            ss = wave_sum(ss);
            const float rstd = rsqrtf(ss * (1.f / 1024.f) + kEps);
            const float* sh = mod + (size_t)b * 6144 + (which ? 3072 : 0);
            const float* sc = sh + 1024;
#pragma unroll
            for (int i = 0; i < 4; ++i) {
                const int col = i * 256 + lane * 4;
                const float4 s4 = *(const float4*)(sc + col), h4 = *(const float4*)(sh + col);
                const float o0 = v[u][i].x * rstd * g4[i].x * (1.f + s4.x) + h4.x, o1 = v[u][i].y * rstd * g4[i].y * (1.f + s4.y) + h4.y;
                const float o2 = v[u][i].z * rstd * g4[i].z * (1.f + s4.z) + h4.z, o3 = v[u][i].w * rstd * g4[i].w * (1.f + s4.w) + h4.w;
                uint2 o; o.x = pack2(o0, o1); o.y = pack2(o2, o3);
                *(uint2*)(h + (size_t)t * 1024 + col) = o;
            }
        }
    }
}

DEV void rope8(uint4& x1, uint4& x2, const float (&cc)[8], const float (&ss)[8]) {
    unsigned a[4] = {x1.x, x1.y, x1.z, x1.w}, b[4] = {x2.x, x2.y, x2.z, x2.w};
#pragma unroll
    for (int i = 0; i < 4; ++i) {
        const float a0 = lo16(a[i]), a1 = hi16(a[i]), b0 = lo16(b[i]), b1 = hi16(b[i]);
        const float o10 = a0 * cc[2 * i] - b0 * ss[2 * i], o11 = a1 * cc[2 * i + 1] - b1 * ss[2 * i + 1];
        const float o20 = a0 * ss[2 * i] + b0 * cc[2 * i], o21 = a1 * ss[2 * i + 1] + b1 * cc[2 * i + 1];
        a[i] = pack2(o10, o11); b[i] = pack2(o20, o21);
    }
    x1 = make_uint4(a[0], a[1], a[2], a[3]); x2 = make_uint4(b[0], b[1], b[2], b[3]);
}
DEV void vt_tile(const bf16_t* __restrict__ src, int ld, bf16_t* __restrict__ dst, char* smem) {
    bf16_t* Ls = (bf16_t*)smem;
    const int tid = ltid();
    __syncthreads();
#pragma unroll
    for (int i = 0; i < 2; ++i) {
        const int id = tid + 256 * i, tok = id >> 3, ch = id & 7;
        *(uint4*)(Ls + tok * 72 + ch * 8) = *(const uint4*)(src + (size_t)tok * ld + ch * 8);
    }
    __syncthreads();
#pragma unroll
    for (int i = 0; i < 2; ++i) {
        const int id = tid + 256 * i, d = id & 63, tc = id >> 6;
        unsigned short e[8];
#pragma unroll
        for (int j = 0; j < 8; ++j) e[j] = Ls[(tc * 8 + j) * 72 + d];
        uint4 o;
        o.x = (unsigned)e[0] | ((unsigned)e[1] << 16); o.y = (unsigned)e[2] | ((unsigned)e[3] << 16);
        o.z = (unsigned)e[4] | ((unsigned)e[5] << 16); o.w = (unsigned)e[6] | ((unsigned)e[7] << 16);
        *(uint4*)(dst + (size_t)d * 2048 + tc * 8) = o;
    }
}

DEV void phase_layout1(const Params& p, char* smem) {
    char* ws = p.ws;
    bf16_t* cols = (bf16_t*)(ws + OFF_COLS);
    bf16_t* kc = (bf16_t*)(ws + OFF_KC);
    bf16_t* vc = (bf16_t*)(ws + OFF_VC);
    bf16_t* VT = (bf16_t*)(ws + OFF_VT);
    float* rstd = (float*)(ws + OFF_RSTD);
    const float* rope = (const float*)(ws + OFF_ROPE);
    const float *cos64 = rope, *sin64 = rope + 2048 * 32, *cos32 = rope + 2048 * 64, *sin32 = rope + 2048 * 64 + 2048 * 16;
    const int tid = ltid();
    for (int unit = blockIdx.x; unit < 2 * (kT / 64); unit += gridDim.x) {
        const int tile = unit >> 1, part01 = unit & 1;
        const int T0 = tile * 64, b = T0 >> 11, s0 = T0 & 2047;
        if (part01 == 0) {
            for (int it0 = tid; it0 < 64 * 86; it0 += 1024) {
                uint4 x1[4], x2[4]; float4 cs[4][2], sn[4][2]; bf16_t* p1[4]; bf16_t* p2[4]; bf16_t* kq[4];
#pragma unroll
                for (int u = 0; u < 4; ++u) {
                    const int it = it0 + u * 256 < 64 * 86 ? it0 + u * 256 : it0;
                    const int tok = it / 86, item = it % 86;
                    const int t = T0 + tok, sq = s0 + tok;
                    bf16_t* row = cols + (size_t)t * LDC;
                    kq[u] = nullptr;
                    const float *cp, *sp;
                    if (item < 52) {
                        const int hd = item >> 2, i0 = (item & 3) * 8;
                        const int base = hd < 4 ? 64 * hd : hd == 4 ? 256 : hd == 5 ? 384 : hd == 6 ? 512 : hd < 11 ? 1920 + 64 * (hd - 7) : 2176 + 64 * (hd - 11);
                        p1[u] = row + base + i0; p2[u] = row + base + 32 + i0;
                        cp = cos64 + sq * 32 + i0; sp = sin64 + sq * 32 + i0;
                        if (hd == 4) kq[u] = kc + (size_t)t * 64 + i0;
                    } else {
                        const int it2 = item - 52, sub = it2 >> 1, i0 = (it2 & 1) * 8;
                        const int base = sub < 8 ? 704 + 32 * sub : sub < 16 ? 960 + 32 * (sub - 8) : 1856;
                        p1[u] = row + base + i0; p2[u] = row + base + 16 + i0;
                        cp = cos32 + sq * 16 + i0; sp = sin32 + sq * 16 + i0;
                    }
                    x1[u] = *(const uint4*)p1[u]; x2[u] = *(const uint4*)p2[u];
                    cs[u][0] = *(const float4*)cp; cs[u][1] = *(const float4*)(cp + 4);
                    sn[u][0] = *(const float4*)sp; sn[u][1] = *(const float4*)(sp + 4);
                }
#pragma unroll
                for (int u = 0; u < 4; ++u) {
                    if (it0 + u * 256 >= 64 * 86) break;
                    const float cc[8] = {cs[u][0].x, cs[u][0].y, cs[u][0].z, cs[u][0].w, cs[u][1].x, cs[u][1].y, cs[u][1].z, cs[u][1].w};
                    const float ss[8] = {sn[u][0].x, sn[u][0].y, sn[u][0].z, sn[u][0].w, sn[u][1].x, sn[u][1].y, sn[u][1].z, sn[u][1].w};
                    rope8(x1[u], x2[u], cc, ss);
                    *(uint4*)p1[u] = x1[u]; *(uint4*)p2[u] = x2[u];
                    if (kq[u]) { *(uint4*)kq[u] = x1[u]; *(uint4*)(kq[u] + 32) = x2[u]; }
                }
            }
            {
                const uint4 c0 = *(const uint4*)(cols + (size_t)(T0 + (tid >> 3)) * LDC + 320 + (tid & 7) * 8);
                const uint4 c1 = *(const uint4*)(cols + (size_t)(T0 + 32 + (tid >> 3)) * LDC + 320 + (tid & 7) * 8);
                *(uint4*)(vc + (size_t)(T0 + (tid >> 3)) * 64 + (tid & 7) * 8) = c0;
                *(uint4*)(vc + (size_t)(T0 + 32 + (tid >> 3)) * 64 + (tid & 7) * 8) = c1;
            }
        }
        if (part01 == 0) continue;
        {
            const int tok = tid >> 2, part = tid & 3, t = T0 + tok;
            const bf16_t* src = cols + (size_t)t * LDC + 1472 + (part < 3 ? part : 0) * 128;
            float ss = 0.f;
#pragma unroll 4
            for (int i = 0; i < 16; ++i) {
                const uint4 u = *(const uint4*)(src + i * 8);
                ss += lo16(u.x) * lo16(u.x) + hi16(u.x) * hi16(u.x) + lo16(u.y) * lo16(u.y) + hi16(u.y) * hi16(u.y)
                    + lo16(u.z) * lo16(u.z) + hi16(u.z) * hi16(u.z) + lo16(u.w) * lo16(u.w) + hi16(u.w) * hi16(u.w);
            }
            float vq = part < 2 ? ss : 0.f;
            vq += __shfl_xor(vq, 1, 64);
            if (part == 0) rstd[t] = rsqrtf(vq * (1.f / 256.f) + kEps);
            if (part == 2) rstd[kT + t] = rsqrtf(ss * (1.f / 128.f) + kEps);
        }
#pragma unroll 1
        for (int vh = 0; vh < 8; ++vh) {
            const int col = vh == 0 ? 448 : vh == 1 ? 576 : vh < 6 ? 1216 + 64 * (vh - 2) : 2304 + 64 * (vh - 6);
            vt_tile(cols + (size_t)T0 * LDC + col, LDC, VT + ((size_t)(b * 12 + vh) * 64) * 2048 + s0, smem);
        }
    }
}

DEV void phase_layout2(const Params& p, int layer, char* smem) {
    char* ws = p.ws;
    bf16_t* qmla = (bf16_t*)(ws + OFF_QMLA);
    const bf16_t* kvmla = (const bf16_t*)(ws + OFF_KVMLA);
    bf16_t* VT = (bf16_t*)(ws + OFF_VT);
    const float* rope = (const float*)(ws + OFF_ROPE);
    const float *cos32 = rope + 2048 * 64, *sin32 = rope + 2048 * 64 + 2048 * 16;
    const int tid = ltid();
    for (int tile = blockIdx.x; tile < kT / 64 + 64; tile += gridDim.x) {
        if (tile >= kT / 64) {
            const int idx = (tile - kT / 64) * 2048 + tid * 8;
            const int kv = idx >> 16, m = (idx >> 6) & 1023, n = idx & 63;
            const float* pp = (const float*)(ws + OFF_QP) + ((size_t)(kv * 8) * 1024 + m) * 128 + n;
            const float* bias = (const float*)(ws + OFF_MISC) + (layer * 2 + kv) * 64 + n;
            float4 a = *(const float4*)bias, c = *(const float4*)(bias + 4);
#pragma unroll
            for (int ks = 0; ks < 8; ++ks) {
                const float4 x = *(const float4*)(pp + (size_t)ks * 1024 * 128), y = *(const float4*)(pp + (size_t)ks * 1024 * 128 + 4);
                a.x += x.x; a.y += x.y; a.z += x.z; a.w += x.w; c.x += y.x; c.y += y.y; c.z += y.z; c.w += y.w;
            }
            *(uint4*)((bf16_t*)(ws + OFF_KCMP) + (size_t)kv * 1024 * 64 + m * 64 + n) = make_uint4(pack2(a.x, a.y), pack2(a.z, a.w), pack2(c.x, c.y), pack2(c.z, c.w));
            continue;
        }
        const int T0 = tile * 64, b = T0 >> 11, s0 = T0 & 2047;
        for (int it = tid; it < 64 * 8; it += 256) {
            const int tok = it >> 3, item = it & 7, hd = item >> 1, i0 = (item & 1) * 8;
            const int t = T0 + tok, s = s0 + tok;
            bf16_t* row = qmla + (size_t)t * 384 + hd * 96 + 64;
            uint4 x1 = *(const uint4*)(row + i0), x2 = *(const uint4*)(row + 16 + i0);
            const float* cp = cos32 + s * 16 + i0; const float* sp = sin32 + s * 16 + i0;
            const float4 c0 = *(const float4*)cp, c1 = *(const float4*)(cp + 4), q0 = *(const float4*)sp, q1 = *(const float4*)(sp + 4);
            const float cc[8] = {c0.x, c0.y, c0.z, c0.w, c1.x, c1.y, c1.z, c1.w}, ss[8] = {q0.x, q0.y, q0.z, q0.w, q1.x, q1.y, q1.z, q1.w};
            rope8(x1, x2, cc, ss);
            *(uint4*)(row + i0) = x1; *(uint4*)(row + 16 + i0) = x2;
        }
#pragma unroll 1
        for (int hd = 0; hd < 4; ++hd)
            vt_tile(kvmla + (size_t)T0 * 512 + hd * 128 + 64, 512, VT + ((size_t)(b * 12 + 8 + hd) * 64) * 2048 + s0, smem);
    }
}

constexpr int SM_K = 0;
constexpr int SM_V = 26624;
constexpr int SM_IMP = SM_V + 17408;
constexpr int SM_SEL = SM_IMP + 16896;
constexpr int SM_CTRL = 65536;
constexpr int SM_TOTAL = SM_CTRL + 256 + 512;
constexpr int SM_ATTN_END = SM_SEL + 1024;

struct RangeIter { int cur, end; DEV int next() { return cur < end ? cur++ : -1; } };
struct BitIter { unsigned rem; DEV int next() { if (!rem) return -1; const int k = __ffs((int)rem) - 1; rem &= rem - 1; return k; } };
struct LdRow { const bf16_t* base; int ld;
    DEV uint4 operator()(int kt, int id) const { const int row = id >> 3, part = id & 7; return *(const uint4*)(base + (size_t)(kt * 64 + row) * ld + part * 8); } };
struct LdVT { const bf16_t* base;
    DEV uint4 operator()(int kt, int id) const { const int d = id >> 3, part = id & 7; return *(const uint4*)(base + (size_t)d * 2048 + kt * 64 + part * 8); } };
struct LdMlaK { const bf16_t* kv; const bf16_t* kr;
    DEV uint4 operator()(int kt, int id) const { const int row = id / 12, part = id % 12; const size_t t = (size_t)(kt * 64 + row);
        return part < 8 ? *(const uint4*)(kv + t * 512 + part * 8) : *(const uint4*)(kr + t * LDC + (part - 8) * 8); } };

struct MaskCausal { DEV bool on(int) const { return true; } DEV bool ok(int kc, int d) const { return kc <= d; }
    DEV bool full(int kt, int t0w) const { return kt * 64 + 63 <= t0w; } };
template <int W> struct MaskWin { DEV bool on(int) const { return true; } DEV bool ok(int kc, int d) const { return (kc <= d) && (d - kc < W); }
    DEV bool full(int kt, int t0w) const { return (kt * 64 + 63 <= t0w) && (t0w + 31 - kt * 64 < W); } };
struct MaskSel { unsigned bits, allbits; DEV bool on(int kt) const { return (bits >> kt) & 1u; } DEV bool ok(int kc, int d) const { return kc <= d; }
    DEV bool full(int kt, int t0w) const { return ((allbits >> kt) & 1u) && (kt * 64 + 63 <= t0w); } };
template <int KDIM, int NKS, int NSUB, bool QG, class It, class LK, class LV, class MaskF, class SkipF>
DEV void attn_stream(It it, const LK& ldK, const LV& ldV, const MaskF& maskf, const SkipF& skipf,
                     const bf16x8* qf, f32x16 (&o)[NSUB][2], float (&m)[NSUB], float (&l)[NSUB], float scl, int tq, int t0w, char* smem, int tid, int koff = 0) {
    constexpr int KCH = KDIM / 8, KSTR = KDIM + 8, NKC = (64 * KCH) / 256;
    constexpr int KBUF = 64 * 104, VBUF = 64 * 68;
    bf16_t* Kb = (bf16_t*)(smem + SM_K);
    bf16_t* Vb = (bf16_t*)(smem + SM_V);
    const int lane = tid & 63, ql = lane & 31, hh = lane >> 5;
    const uint4 z4 = make_uint4(0, 0, 0, 0);
    uint4 ak0 = z4, ak1 = z4, ak2 = z4, av0 = z4, av1 = z4, bk0 = z4, bk1 = z4, bk2 = z4, bv0 = z4, bv1 = z4;
    auto loadA = [&](int kt) __attribute__((always_inline)) { ak0 = ldK(kt, tid); ak1 = ldK(kt, tid + 256); if (NKC == 3) ak2 = ldK(kt, tid + 512); av0 = ldV(kt, tid); av1 = ldV(kt, tid + 256); };
    auto loadB = [&](int kt) __attribute__((always_inline)) { bk0 = ldK(kt, tid); bk1 = ldK(kt, tid + 256); if (NKC == 3) bk2 = ldK(kt, tid + 512); bv0 = ldV(kt, tid); bv1 = ldV(kt, tid + 256); };
    auto stK = [&](bf16_t* kb, const uint4& r, int id) __attribute__((always_inline)) { const int row = id / KCH, part = id % KCH; *(uint4*)(kb + row * KSTR + part * 8) = r; };
    auto stV = [&](bf16_t* vb, const uint4& r, int id) __attribute__((always_inline)) { const int row = id >> 3, part = id & 7; bf16_t* d = vb + row * 68 + part * 8;
        *(uint2*)d = make_uint2(r.x, r.y); *(uint2*)(d + 4) = make_uint2(r.z, r.w); };
    auto compute = [&](int kt, const bf16_t* Kt, const bf16_t* Vt) __attribute__((always_inline)) {
        if (skipf(kt)) return;
#pragma unroll
        for (int sub = 0; sub < NSUB; ++sub) {
            const int tqs = tq + (QG ? 32 * sub : 0), t0s = t0w + (QG ? 32 * sub : 0);
            if (QG && kt * 64 > t0s + 31) continue;
            __builtin_amdgcn_sched_barrier(0);
            f32x16 s[2];
#pragma unroll
            for (int i = 0; i < 2; ++i) {
                s[i] = zero16();
#pragma unroll
                for (int ks = 0; ks < NKS; ++ks) {
                    const bf16x8 a = *(const bf16x8*)(Kt + (i * 32 + ql) * KSTR + koff + ((QG ? 0 : sub * NKS) + ks) * 16 + hh * 8);
                    s[i] = mfma32(a, qf[sub * NKS + ks], s[i]);
                }
            }
            float mx = kNeg;
            if (!maskf.full(kt, t0s)) {
                const int dlim = tqs - kt * 64 - 4 * hh;
                const bool on = maskf.on(kt);
#pragma unroll
                for (int i = 0; i < 2; ++i)
#pragma unroll
                    for (int r = 0; r < 16; ++r) {
                        const int kc = i * 32 + (r & 3) + 8 * (r >> 2);
                        s[i][r] = (on && maskf.ok(kc, dlim)) ? s[i][r] : kNeg;
                    }
            }
#pragma unroll
            for (int i = 0; i < 2; ++i)
#pragma unroll
                for (int r = 0; r < 16; ++r) mx = fmaxf(mx, s[i][r]);
            mx = fmaxf(mx, xor32f(mx, lane));
            const float mnew = fmaxf(m[sub], mx);
            const float alpha = __builtin_amdgcn_exp2f((m[sub] - mnew) * scl);
            m[sub] = mnew;
            const float negm = mnew > -1e29f ? -mnew * scl : 0.f;
            float sum = 0.f;
#pragma unroll
            for (int i = 0; i < 2; ++i)
#pragma unroll
                for (int r = 0; r < 16; ++r) { const float pv = __builtin_amdgcn_exp2f(__builtin_fmaf(s[i][r], scl, negm)); s[i][r] = pv; sum += pv; }
            l[sub] = l[sub] * alpha + sum;
            if (__builtin_amdgcn_ballot_w64(alpha != 1.f)) {
#pragma unroll
                for (int dt = 0; dt < 2; ++dt)
#pragma unroll
                    for (int r = 0; r < 16; ++r) o[sub][dt][r] *= alpha;
            }
            __builtin_amdgcn_sched_barrier(0);
#pragma unroll
            for (int ks = 0; ks < 4; ++ks) {
                if (ks == 2) __builtin_amdgcn_sched_barrier(0);
                const int i = ks >> 1, r0 = 8 * (ks & 1);
                uint4 pu;
                pu.x = pack2(s[i][r0 + 0], s[i][r0 + 1]); pu.y = pack2(s[i][r0 + 2], s[i][r0 + 3]);
                pu.z = pack2(s[i][r0 + 4], s[i][r0 + 5]); pu.w = pack2(s[i][r0 + 6], s[i][r0 + 7]);
                const bf16x8 pf = __builtin_bit_cast(bf16x8, pu);
#pragma unroll
                for (int dt = 0; dt < 2; ++dt) {
                    const bf16_t* vp = Vt + (dt * 32 + ql) * 68 + ks * 16 + 4 * hh;
                    const uint2 a0 = *(const uint2*)vp, a1 = *(const uint2*)(vp + 8);
                    const bf16x8 a = __builtin_bit_cast(bf16x8, make_uint4(a0.x, a0.y, a1.x, a1.y));
                    o[sub][dt] = mfma32(a, pf, o[sub][dt]);
                }
            }
        }
    };
    int ka = it.next();
    int kb = ka >= 0 ? it.next() : -1;
    if (ka >= 0) loadA(ka);
    if (kb >= 0) loadB(kb);
    while (ka >= 0) {
        __syncthreads();
        stK(Kb, ak0, tid); stK(Kb, ak1, tid + 256); if (NKC == 3) stK(Kb, ak2, tid + 512);
        stV(Vb, av0, tid); stV(Vb, av1, tid + 256);
        if (kb >= 0) {
            stK(Kb + KBUF, bk0, tid); stK(Kb + KBUF, bk1, tid + 256); if (NKC == 3) stK(Kb + KBUF, bk2, tid + 512);
            stV(Vb + VBUF, bv0, tid); stV(Vb + VBUF, bv1, tid + 256);
        }
        __syncthreads();
        const int na = it.next();
        const int nb = na >= 0 ? it.next() : -1;
        if (na >= 0) loadA(na);
        if (nb >= 0) loadB(nb);
        compute(ka, Kb, Vb);
        if (kb >= 0) compute(kb, Kb + KBUF, Vb + VBUF);
        ka = na; kb = nb;
    }
}

DEV void write_o(const f32x16 (&o)[2], bf16_t* obuf, size_t row, int col0, int hh) {
#pragma unroll
    for (int dt = 0; dt < 2; ++dt)
#pragma unroll
        for (int g = 0; g < 4; ++g) {
            const int d = dt * 32 + 8 * g + 4 * hh;
            uint2 u; u.x = pack2(o[dt][4 * g], o[dt][4 * g + 1]); u.y = pack2(o[dt][4 * g + 2], o[dt][4 * g + 3]);
            *(uint2*)(obuf + row * 1024 + col0 + d) = u;
        }
}
DEV float sigmoidf(float x) { return 1.f / (1.f + __expf(-x)); }

DEV void nsa_item(const Params& p, int layer, int b, int qb, char* smem) {
    int tid = threadIdx.x; asm volatile("" : "+v"(tid));
    const int lane = tid & 63, w = tid >> 6, ql = lane & 31, hh = lane >> 5;
    char* ws = p.ws;
    const bf16_t* cols = (const bf16_t*)(ws + OFF_COLS);
    const bf16_t* VT = (const bf16_t*)(ws + OFF_VT);
    bf16_t* obuf = (bf16_t*)(ws + OFF_O);
    const int t0 = qb * 32, tq = t0 + ql;
    const size_t Tb = (size_t)b * kS;
    const bf16_t* qrow = cols + (Tb + tq) * LDC;
    bf16x8 qf[4];
#pragma unroll
    for (int ks = 0; ks < 4; ++ks) qf[ks] = *(const bf16x8*)(qrow + w * 64 + ks * 16 + hh * 8);
    const float g0 = sigmoidf(bf2f(qrow[640 + w * 3 + 0])), g1 = sigmoidf(bf2f(qrow[640 + w * 3 + 1])), g2 = sigmoidf(bf2f(qrow[640 + w * 3 + 2]));
    const float scl = 0.125f * kLog2e;
    bf16_t* Kc = (bf16_t*)(smem + SM_K);
    bf16_t* Vc = (bf16_t*)(smem + SM_V);
    float* impP = (float*)(smem + SM_IMP);
    unsigned* selm = (unsigned*)(smem + SM_SEL);
    const float* gk = (const float*)(ws + OFF_QP) + (size_t)b * 128 * 128;
    const float* gv = gk + (size_t)1024 * 128;
    const float* bias = (const float*)(ws + OFF_MISC) + layer * 128;
    __syncthreads();
#pragma unroll
    for (int i = 0; i < 4; ++i) {
        const int id = tid + 256 * i, row = id >> 3, part = id & 7;
        const int row1 = row < 127 ? row + 1 : row;
        const float* a = gk + (size_t)row * 128 + part * 8;  const float* a2 = gk + (size_t)row1 * 128 + 64 + part * 8;
        const float* c = gv + (size_t)row * 128 + part * 8;  const float* c2 = gv + (size_t)row1 * 128 + 64 + part * 8;
        const float4 k0 = *(const float4*)a, k1 = *(const float4*)(a + 4), k2 = *(const float4*)a2, k3 = *(const float4*)(a2 + 4);
        const float4 v0 = *(const float4*)c, v1 = *(const float4*)(c + 4), v2 = *(const float4*)c2, v3 = *(const float4*)(c2 + 4);
        const float4 bk0 = *(const float4*)(bias + part * 8), bk1 = *(const float4*)(bias + part * 8 + 4);
        const float4 bv0 = *(const float4*)(bias + 64 + part * 8), bv1 = *(const float4*)(bias + 64 + part * 8 + 4);
        uint4 kk = make_uint4(pack2(k0.x + k2.x + bk0.x, k0.y + k2.y + bk0.y), pack2(k0.z + k2.z + bk0.z, k0.w + k2.w + bk0.w),
                              pack2(k1.x + k3.x + bk1.x, k1.y + k3.y + bk1.y), pack2(k1.z + k3.z + bk1.z, k1.w + k3.w + bk1.w));
        uint4 vv = make_uint4(pack2(v0.x + v2.x + bv0.x, v0.y + v2.y + bv0.y), pack2(v0.z + v2.z + bv0.z, v0.w + v2.w + bv0.w),
                              pack2(v1.x + v3.x + bv1.x, v1.y + v3.y + bv1.y), pack2(v1.z + v3.z + bv1.z, v1.w + v3.w + bv1.w));
        if (row == 127) { kk = make_uint4(0, 0, 0, 0); vv = kk; }
        *(uint4*)(Kc + row * 72 + part * 8) = kk;
        const unsigned u[4] = {vv.x, vv.y, vv.z, vv.w};
#pragma unroll
        for (int j = 0; j < 4; ++j) { Vc[(part * 8 + 2 * j) * 132 + row] = (bf16_t)(u[j] & 0xffffu); Vc[(part * 8 + 2 * j + 1) * 132 + row] = (bf16_t)(u[j] >> 16); }
    }
    __syncthreads();
    unsigned ocp[16];
    float* invs = (float*)(smem + SM_SEL) + 64;
    {
        const int cmaxv = tq >= 31 ? min((tq - 31) >> 4, 126) : -1;
        float mx = kNeg;
#pragma unroll 1
        for (int i = 0; i < 4; ++i) {
            f32x16 s = zero16();
#pragma unroll
            for (int ks = 0; ks < 4; ++ks) s = mfma32(*(const bf16x8*)(Kc + (i * 32 + ql) * 72 + ks * 16 + hh * 8), qf[ks], s);
            const int clim = cmaxv - i * 32 - 4 * hh;
#pragma unroll
            for (int r = 0; r < 16; ++r) {
                const int kc = (r & 3) + 8 * (r >> 2);
                const bool valid = (kc <= clim);
                mx = fmaxf(mx, valid ? s[r] * scl : kNeg);
            }
        }
        mx = fmaxf(mx, xor32f(mx, lane));
        f32x16 ocmp[2]; ocmp[0] = zero16(); ocmp[1] = zero16();
        float sum = 0.f, carprev = 0.f;
#pragma unroll 1
        for (int i = 0; i < 4; ++i) {
            f32x16 s = zero16();
#pragma unroll
            for (int ks = 0; ks < 4; ++ks) s = mfma32(*(const bf16x8*)(Kc + (i * 32 + ql) * 72 + ks * 16 + hh * 8), qf[ks], s);
            const int clim = cmaxv - i * 32 - 4 * hh;
#pragma unroll
            for (int r = 0; r < 16; ++r) {
                const int kc = (r & 3) + 8 * (r >> 2);
                const bool valid = (kc <= clim);
                const float pv = valid ? __builtin_amdgcn_exp2f(s[r] * scl - mx) : 0.f;
                s[r] = pv; sum += pv;
            }
            float own[4], car[4];
#pragma unroll
            for (int g = 0; g < 4; ++g) { own[g] = s[4 * g] + s[4 * g + 1] + s[4 * g + 2] + 0.5f * s[4 * g + 3]; car[g] = 0.5f * s[4 * g + 3]; }
#pragma unroll
            for (int g = 0; g < 4; ++g) {
                const float send = hh ? (g ? car[g > 0 ? g - 1 : 0] : carprev) : car[g];
                own[g] += xor32f(send, lane);
            }
            carprev = car[3];
#pragma unroll
            for (int g = 0; g < 4; ++g) impP[(w * 32 + ql) * 33 + 2 * (4 * i + g) + hh] = own[g];
#pragma unroll
            for (int sp = 0; sp < 2; ++sp) {
                const int ks = 2 * i + sp, r0 = 8 * sp;
                uint4 pu;
                pu.x = pack2(s[r0 + 0], s[r0 + 1]); pu.y = pack2(s[r0 + 2], s[r0 + 3]);
                pu.z = pack2(s[r0 + 4], s[r0 + 5]); pu.w = pack2(s[r0 + 6], s[r0 + 7]);
                const bf16x8 pf = __builtin_bit_cast(bf16x8, pu);
#pragma unroll
                for (int dt = 0; dt < 2; ++dt) {
                    const bf16_t* vp = Vc + (dt * 32 + ql) * 132 + ks * 16 + 4 * hh;
                    const uint2 a0 = *(const uint2*)vp, a1 = *(const uint2*)(vp + 8);
                    ocmp[dt] = mfma32(__builtin_bit_cast(bf16x8, make_uint4(a0.x, a0.y, a1.x, a1.y)), pf, ocmp[dt]);
                }
            }
        }
        sum += xor32f(sum, lane);
        const float inv = sum > 0.f ? 1.f / sum : 0.f;
        invs[w * 32 + ql] = inv;
        const float f = g0 * inv;
#pragma unroll
        for (int dt = 0; dt < 2; ++dt)
#pragma unroll
            for (int r = 0; r < 8; ++r) ocp[dt * 8 + r] = pack2(f * ocmp[dt][2 * r], f * ocmp[dt][2 * r + 1]);
    }
    __syncthreads();
    const int qblk = t0 >> 6;
    {
        const int hw = tid >> 5, j = tid & 31;
#pragma unroll 1
        for (int rr = 0; rr < 4; ++rr) {
            const int row = hw * 4 + rr;
            const float v = impP[(0 * 32 + row) * 33 + j] * invs[row] + impP[(1 * 32 + row) * 33 + j] * invs[32 + row]
                          + impP[(2 * 32 + row) * 33 + j] * invs[64 + row] + impP[(3 * 32 + row) * 33 + j] * invs[96 + row];
            bool sel;
            if (qblk < 16) sel = (j <= qblk);
            else {
                const bool cand = (j >= 1) && (j <= qblk - 2);
                const bool forced = (j == 0) || (j == qblk) || (j == qblk - 1);
                int rank = 0;
                for (int j2 = 1; j2 <= qblk - 2; ++j2) {
                    const float v2 = lanef(v, (lane & 32) + j2);
                    rank += (v2 > v || (v2 == v && j2 < j)) ? 1 : 0;
                }
                sel = forced || (cand && rank < 13);
            }
            const unsigned long long bal = __ballot(sel);
            const unsigned mk = (lane & 32) ? (unsigned)(bal >> 32) : (unsigned)bal;
            if (j == 0) selm[row] = mk;
        }
    }
    __syncthreads();
    const unsigned mysel = selm[ql];
    unsigned U = mysel, Uall = mysel;
#pragma unroll
    for (int o = 16; o > 0; o >>= 1) { U |= (unsigned)__builtin_amdgcn_ds_bpermute((lane ^ o) << 2, (int)U); Uall &= (unsigned)__builtin_amdgcn_ds_bpermute((lane ^ o) << 2, (int)Uall); }
    Uall = (unsigned)__builtin_amdgcn_readfirstlane((int)Uall);
    {
        f32x16 o1[1][2]; o1[0][0] = zero16(); o1[0][1] = zero16();
        float m1[1] = {kNeg}, l1[1] = {0.f};
        auto skipf = [&](int) __attribute__((always_inline)) { return false; };
        attn_stream<64, 4, 1, false>(BitIter{U}, LdRow{cols + Tb * LDC + 384, LDC}, LdVT{VT + (size_t)(b * 12 + 0) * 64 * 2048}, MaskSel{mysel, Uall}, skipf, qf, o1, m1, l1, scl, tq, __builtin_amdgcn_readfirstlane(t0), smem, tid);
        const float lt = l1[0] + xor32f(l1[0], lane);
        const float f = g1 / lt;
#pragma unroll
        for (int dt = 0; dt < 2; ++dt)
#pragma unroll
            for (int r = 0; r < 8; ++r) ocp[dt * 8 + r] = pack2(lo16(ocp[dt * 8 + r]) + f * o1[0][dt][2 * r], hi16(ocp[dt * 8 + r]) + f * o1[0][dt][2 * r + 1]);
    }
    {
        f32x16 o1[1][2]; o1[0][0] = zero16(); o1[0][1] = zero16();
        float m1[1] = {kNeg}, l1[1] = {0.f};
        auto skipf = [&](int) __attribute__((always_inline)) { return false; };
        const int lo = t0 >= 511 ? ((t0 - 511) >> 6) : 0;
        attn_stream<64, 4, 1, false>(RangeIter{lo, qblk + 1}, LdRow{cols + Tb * LDC + 512, LDC}, LdVT{VT + (size_t)(b * 12 + 1) * 64 * 2048}, MaskWin<512>{}, skipf, qf, o1, m1, l1, scl, tq, __builtin_amdgcn_readfirstlane(t0), smem, tid);
        const float lt = l1[0] + xor32f(l1[0], lane);
        const float f = g2 / lt;
#pragma unroll
        for (int dt = 0; dt < 2; ++dt)
#pragma unroll
            for (int r = 0; r < 8; ++r) { o1[0][dt][2 * r] = lo16(ocp[dt * 8 + r]) + f * o1[0][dt][2 * r]; o1[0][dt][2 * r + 1] = hi16(ocp[dt * 8 + r]) + f * o1[0][dt][2 * r + 1]; }
        write_o(o1[0], obuf, Tb + tq, w * 64, hh);
    }
}

DEV void diff_item(const Params& p, int layer, int b, int hd, int qc, char* smem) {
    int tid = threadIdx.x; asm volatile("" : "+v"(tid));
    const int lane = tid & 63, w = tid >> 6, ql = lane & 31, hh = lane >> 5;
    const int sub = w & 1, qh = w >> 1;
    char* ws = p.ws;
    const bf16_t* cols = (const bf16_t*)(ws + OFF_COLS);
    const bf16_t* VT = (const bf16_t*)(ws + OFF_VT);
    bf16_t* obuf = (bf16_t*)(ws + OFF_O);
    const float* misc = (const float*)(ws + OFF_MISC);
    const int t0w = qc * 128 + qh * 64, tq = t0w + ql;
    const size_t Tb = (size_t)b * kS;
    bf16x8 qf[4];
#pragma unroll
    for (int g = 0; g < 2; ++g)
#pragma unroll
        for (int ks = 0; ks < 2; ++ks) qf[g * 2 + ks] = *(const bf16x8*)(cols + (Tb + tq + 32 * g) * LDC + 704 + hd * 64 + sub * 32 + ks * 16 + hh * 8);
    const float scl = 0.17677669529663687f * kLog2e;
    f32x16 o2[2][2];
#pragma unroll
    for (int g = 0; g < 2; ++g) { o2[g][0] = zero16(); o2[g][1] = zero16(); }
    float m2[2] = {kNeg, kNeg}, l2[2] = {0.f, 0.f};
    auto skipf = [&](int kt) __attribute__((always_inline)) { return kt * 64 > t0w + 63; };
    attn_stream<64, 2, 2, true>(RangeIter{0, 2 * qc + 2}, LdRow{cols + Tb * LDC + 960 + hd * 64, LDC}, LdVT{VT + (size_t)(b * 12 + 2 + hd) * 64 * 2048}, MaskCausal{}, skipf, qf, o2, m2, l2, scl, tq, __builtin_amdgcn_readfirstlane(t0w), smem, tid, sub * 32);
    const float lam = misc[256 + layer], post = misc[258 + layer];
    float* ex = (float*)smem;
    __syncthreads();
#pragma unroll
    for (int g = 0; g < 2; ++g) {
        const float lt = l2[g] + xor32f(l2[g], lane);
        if (sub == 1) {
            const float f = lam / lt;
#pragma unroll
            for (int dt = 0; dt < 2; ++dt)
#pragma unroll
                for (int r = 0; r < 16; ++r) ex[(((qh * 2 + g) * 2 + dt) * 16 + r) * 64 + lane] = o2[g][dt][r] * f;
        } else {
            const float f = 1.f / lt;
#pragma unroll
            for (int dt = 0; dt < 2; ++dt)
#pragma unroll
                for (int r = 0; r < 16; ++r) o2[g][dt][r] *= f;
        }
    }
    __syncthreads();
    if (sub == 0) {
        const float* sg = p.sub_g + layer * 64;
#pragma unroll
        for (int g = 0; g < 2; ++g) {
            float ss = 0.f;
#pragma unroll
            for (int dt = 0; dt < 2; ++dt)
#pragma unroll
                for (int r = 0; r < 16; ++r) { const float v = o2[g][dt][r] - ex[(((qh * 2 + g) * 2 + dt) * 16 + r) * 64 + lane]; o2[g][dt][r] = v; ss += v * v; }
            ss += xor32f(ss, lane);
            const float rstd = rsqrtf(ss * (1.f / 64.f) + kEps) * post;
#pragma unroll
            for (int dt = 0; dt < 2; ++dt)
#pragma unroll
                for (int r = 0; r < 16; ++r) { const int d = dt * 32 + (r & 3) + 8 * (r >> 2) + 4 * hh; o2[g][dt][r] *= rstd * sg[d]; }
            write_o(o2[g], obuf, Tb + tq + 32 * g, 256 + hd * 64, hh);
        }
    }
}

DEV void mla_item(const Params& p, int b, int hd, int qc, char* smem) {
    int tid = threadIdx.x; asm volatile("" : "+v"(tid));
    const int lane = tid & 63, w = tid >> 6, ql = lane & 31, hh = lane >> 5;
    char* ws = p.ws;
    const bf16_t* cols = (const bf16_t*)(ws + OFF_COLS);
    const bf16_t* VT = (const bf16_t*)(ws + OFF_VT);
    const bf16_t* qmla = (const bf16_t*)(ws + OFF_QMLA);
    const bf16_t* kvmla = (const bf16_t*)(ws + OFF_KVMLA);
    bf16_t* obuf = (bf16_t*)(ws + OFF_O);
    const int t0w = qc * 128 + w * 32, tq = t0w + ql;
    const size_t Tb = (size_t)b * kS;
    const bf16_t* qrow = qmla + (Tb + tq) * 384 + hd * 96;
    bf16x8 qf[6];
#pragma unroll
    for (int ks = 0; ks < 6; ++ks) qf[ks] = *(const bf16x8*)(qrow + ks * 16 + hh * 8);
    const float scl = 0.10206207261596575f * kLog2e;
    f32x16 o1[1][2]; o1[0][0] = zero16(); o1[0][1] = zero16();
    float m1[1] = {kNeg}, l1[1] = {0.f};
    auto skipf = [&](int kt) __attribute__((always_inline)) { return kt * 64 > t0w + 31; };
    attn_stream<96, 6, 1, false>(RangeIter{0, 2 * qc + 2}, LdMlaK{kvmla + Tb * 512 + hd * 128, cols + Tb * LDC + 1856}, LdVT{VT + (size_t)(b * 12 + 8 + hd) * 64 * 2048}, MaskCausal{}, skipf, qf, o1, m1, l1, scl, tq, __builtin_amdgcn_readfirstlane(t0w), smem, tid);
    const float inv = 1.f / (l1[0] + xor32f(l1[0], lane));
#pragma unroll
    for (int dt = 0; dt < 2; ++dt)
#pragma unroll
        for (int r = 0; r < 16; ++r) o1[0][dt][r] *= inv;
    write_o(o1[0], obuf, Tb + tq, 512 + hd * 64, hh);
}

DEV void swa_item(const Params& p, int layer, int b, int g, int q64, char* smem) {
    int tid = threadIdx.x; asm volatile("" : "+v"(tid));
    const int lane = tid & 63, w = tid >> 6, ql = lane & 31, hh = lane >> 5;
    char* ws = p.ws;
    const bf16_t* cols = (const bf16_t*)(ws + OFF_COLS);
    const bf16_t* VT = (const bf16_t*)(ws + OFF_VT);
    bf16_t* obuf = (bf16_t*)(ws + OFF_O);
    const int head = g * 2 + (w & 1);
    const int t0w = q64 * 64 + (w >> 1) * 32, tq = t0w + ql;
    const size_t Tb = (size_t)b * kS;
    const bf16_t* qrow = cols + (Tb + tq) * LDC + 1920 + head * 64;
    bf16x8 qf[4];
#pragma unroll
    for (int ks = 0; ks < 4; ++ks) qf[ks] = *(const bf16x8*)(qrow + ks * 16 + hh * 8);
    const float scl = 0.125f * kLog2e;
    f32x16 o1[1][2]; o1[0][0] = zero16(); o1[0][1] = zero16();
    float m1[1] = {p.sinks[layer * 4 + head] * 8.f}, l1[1] = {hh == 0 ? 1.f : 0.f};
    auto skipf = [&](int kt) __attribute__((always_inline)) { return (kt * 64 > t0w + 31) || (kt * 64 + 63 < t0w - 127); };
    const int lo = q64 >= 2 ? q64 - 2 : 0;
    attn_stream<64, 4, 1, false>(RangeIter{lo, q64 + 1}, LdRow{cols + Tb * LDC + 2176 + g * 64, LDC}, LdVT{VT + (size_t)(b * 12 + 6 + g) * 64 * 2048}, MaskWin<128>{}, skipf, qf, o1, m1, l1, scl, tq, __builtin_amdgcn_readfirstlane(t0w), smem, tid);
    const float inv = 1.f / (l1[0] + xor32f(l1[0], lane));
#pragma unroll
    for (int dt = 0; dt < 2; ++dt)
#pragma unroll
        for (int r = 0; r < 16; ++r) o1[0][dt][r] *= inv;
    write_o(o1[0], obuf, Tb + tq, 768 + head * 64, hh);
}

DEV void phase_attn(const Params& p, int layer, char* smem, int rep = 0) {
    unsigned* ctr = (unsigned*)(p.ws + OFF_CTRL) + 64 + layer * 16 + rep;
    volatile int* slot = (volatile int*)(smem + SM_SEL) + 48;
    for (;;) {
        __syncthreads();
        if (ltid() == 0) *slot = (int)atomicAdd(ctr, 1u);
        __syncthreads();
        const int idx = __builtin_amdgcn_readfirstlane(*slot);
        if (idx >= 2048) break;
        const int level = 15 - (idx >> 7), r = idx & 127;
#if TS_A >= 0
        const unsigned long long tsa = __builtin_amdgcn_s_memrealtime();
#endif
        if (r < 32) { diff_item(p, layer, r >> 2, r & 3, level, smem); }
        else if (r < 64) { const int k = r - 32; mla_item(p, k >> 2, k & 3, level, smem); }
        else if (r < 96) { const int k = r - 64; nsa_item(p, layer, k >> 2, level * 4 + (3 - (k & 3)), smem); }
        else { const int k = r - 96; swa_item(p, layer, k >> 2, (k >> 1) & 1, level * 2 + (k & 1), smem); }
#if TS_A >= 0
        if (threadIdx.x == 0 && layer == 1) {
            const int ty = r >> 5;
            unsigned long long* ts = (unsigned long long*)(p.ws + 32768);
            atomicAdd(&ts[60 + ty], (unsigned long long)(__builtin_amdgcn_s_memrealtime() - tsa));
        }
#endif
    }
}

#define XB_TMO      128
#define XB_XCNT(j)  (256  + 64 * (j))
#define XB_XSUB(j)  (1280 + 64 * (j))
#define XB_XGEN(j)  (2304 + 64 * (j))
#define XB_TOP      3328
#define XB_TOPGEN   3392
#define XB_SPIN_CAP (1u << 22)
DEV unsigned xb_ld(unsigned* p) { return __hip_atomic_load(p, __ATOMIC_RELAXED, __HIP_MEMORY_SCOPE_AGENT); }
DEV unsigned xb_add(unsigned* p, unsigned v) { return __hip_atomic_fetch_add(p, v, __ATOMIC_RELAXED, __HIP_MEMORY_SCOPE_AGENT); }
DEV unsigned xb_xcc_id() { return (unsigned)__builtin_amdgcn_s_getreg((3 << 11) | 20) & 0xFu; }
#define XB_SPIN(cond, bar) do { unsigned _sp = 0; while (cond) { __builtin_amdgcn_s_sleep(1); \
    if ((++_sp & 255u) == 0u) { if (xb_ld(&(bar)[XB_TMO])) break; if (_sp > XB_SPIN_CAP) { atomicAdd(&(bar)[XB_TMO], 1u); break; } } } } while (0)
struct XcdBarrier { unsigned* bar; unsigned x; volatile LAS unsigned* st; };
DEV XcdBarrier xcd_barrier_post(unsigned* bar, volatile LAS unsigned* st) {
    XcdBarrier b; b.bar = bar; b.x = xb_xcc_id(); b.st = st;
    if (threadIdx.x == 0) st[2] = xb_add(&bar[XB_XCNT(b.x)], 1u);
    return b;
}
DEV void xcd_barrier_complete(unsigned* bar, unsigned x, unsigned& nloc, unsigned& nx) {
    const unsigned G = gridDim.x * gridDim.y * gridDim.z;
    unsigned sum, cnt, mine, sp = 0u;
    for (;;) {
        sum = 0u; cnt = 0u; mine = 0u;
#pragma unroll
        for (unsigned j = 0; j < 16; ++j) { const unsigned c = xb_ld(&bar[XB_XCNT(j)]); sum += c; cnt += (c > 0u) ? 1u : 0u; mine = (j == x) ? c : mine; }
        if (sum == G) break;
        __builtin_amdgcn_s_sleep(1);
        if ((++sp & 255u) == 0u) { if (xb_ld(&bar[XB_TMO])) break; if (sp > XB_SPIN_CAP) { atomicAdd(&bar[XB_TMO], 1u); break; } }
    }
    nloc = mine > 0u ? mine : 1u; nx = cnt > 0u ? cnt : 1u;
}
DEV void xcd_barrier(const XcdBarrier& b) {
    asm volatile("s_waitcnt vmcnt(0)" ::: "memory");
    __syncthreads();
    if (threadIdx.x == 0) {
        unsigned* bar = b.bar;
        asm volatile("" : "+v"(bar));
        __builtin_amdgcn_s_waitcnt(0);
        unsigned nloc = b.st[0], nx = b.st[1];
        if (nloc == 0u) { xcd_barrier_complete(bar, b.x, nloc, nx); b.st[0] = nloc; b.st[1] = nx; }
        const unsigned old = xb_add(&bar[XB_XSUB(b.x)], 1u);
        const unsigned gen = old / nloc;
        if (old + 1u == (gen + 1u) * nloc) {
            __builtin_amdgcn_fence(__ATOMIC_RELEASE, "agent");
            asm volatile("s_waitcnt vmcnt(0)" ::: "memory");
            const unsigned og = xb_add(&bar[XB_TOP], 1u);
            const unsigned tg = og / nx;
            if (og + 1u == (tg + 1u) * nx) xb_add(&bar[XB_TOPGEN], 1u);
            else XB_SPIN(xb_ld(&bar[XB_TOPGEN]) == tg, bar);
            __builtin_amdgcn_fence(__ATOMIC_ACQUIRE, "agent");
            xb_add(&bar[XB_XGEN(b.x)], 1u);
            asm volatile("s_waitcnt vmcnt(0)" ::: "memory");
        } else {
            XB_SPIN(xb_ld(&bar[XB_XGEN(b.x)]) == gen, bar);
            __builtin_amdgcn_fence(__ATOMIC_ACQUIRE, "agent");
            asm volatile("s_waitcnt vmcnt(0)" ::: "memory");
        }
    }
    __syncthreads();
}

DEV unsigned fkey(float f) { const unsigned u = __float_as_uint(f); return (u & 0x80000000u) ? ~u : (u | 0x80000000u); }
DEV float funkey(unsigned k) { return __uint_as_float((k & 0x80000000u) ? (k & 0x7fffffffu) : ~k); }
DEV void ins16(unsigned (&L)[16], unsigned x) {
#pragma unroll
    for (int i = 15; i >= 1; --i) { unsigned r; asm("v_med3_u32 %0, %1, %2, %3" : "=v"(r) : "v"(L[i - 1]), "v"(L[i]), "v"(x)); L[i] = r; }
    L[0] = L[0] > x ? L[0] : x;
}
DEV void phase_topk(const Params& p, char* smem) {
    const int tid = ltid();
    const float* S1 = (const float*)(p.ws + OFF_S1);
    const float* S2 = (const float*)(p.ws + OFF_S2);
    int* eid = (int*)(p.ws + OFF_EID);
    float* gate = (float*)(p.ws + OFF_GATE);
    unsigned char* ib = (unsigned char*)smem + tid * 32;
    for (int blk = blockIdx.x; blk < kT * 8 / 256; blk += gridDim.x) {
        const size_t row = (size_t)blk * 256 + tid;
        unsigned L1[16], L2[16];
#pragma unroll
        for (int i = 0; i < 16; ++i) { L1[i] = 0u; L2[i] = 0u; }
#pragma unroll 4
        for (int k = 0; k < 128; ++k) {
            const float a = S1[(size_t)k * (kT * 8) + row], b = S2[(size_t)k * (kT * 8) + row];
            ins16(L1, (fkey(a) & ~127u) | (unsigned)(127 - k));
            ins16(L2, (fkey(b) & ~127u) | (unsigned)(127 - k));
        }
        float v1[16], v2[16];
        __syncthreads();
#pragma unroll
        for (int i = 0; i < 16; ++i) {
            v1[i] = funkey(L1[i] & ~127u); v2[i] = funkey(L2[i] & ~127u);
            ib[i] = (unsigned char)(127u - (L1[i] & 127u)); ib[16 + i] = (unsigned char)(127u - (L2[i] & 127u));
        }
        unsigned C[16];
#pragma unroll
        for (int i = 0; i < 16; ++i) C[i] = 0u;
#pragma unroll
        for (int a = 0; a < 16; ++a)
#pragma unroll
            for (int b = 0; b < 16; ++b)
                if ((a + 1) * (b + 1) <= 16) ins16(C, (fkey(v1[a] + v2[b]) & ~255u) | (unsigned)(255 - (a * 16 + b)));
        float ts[16]; float sum = 0.f;
        const float tmax = funkey(C[0] & ~255u);
#pragma unroll
        for (int i = 0; i < 16; ++i) { ts[i] = __expf(funkey(C[i] & ~255u) - tmax); sum += ts[i]; }
        const float inv = 1.f / sum;
        int ev[16];
#pragma unroll
        for (int i = 0; i < 16; ++i) { const unsigned ci = 255u - (C[i] & 255u); ev[i] = (int)ib[ci >> 4] * 128 + (int)ib[16 + (ci & 15u)]; }
#pragma unroll
        for (int i = 0; i < 4; ++i) {
            *(int4*)(eid + row * 16 + 4 * i) = make_int4(ev[4 * i], ev[4 * i + 1], ev[4 * i + 2], ev[4 * i + 3]);
            *(float4*)(gate + row * 16 + 4 * i) = make_float4(ts[4 * i] * inv, ts[4 * i + 1] * inv, ts[4 * i + 2] * inv, ts[4 * i + 3] * inv);
        }
    }
}

struct EpiTop16 {
    unsigned (&L)[16];
    DEV void tile(int, int, const float* Cs, int tid) const {
        const int r = tid & 127, hk = tid >> 7;
        unsigned T[16];
#pragma unroll
        for (int i = 0; i < 16; ++i) T[i] = 0u;
#pragma unroll 4
        for (int k = 0; k < 64; ++k) {
            const int key = hk * 64 + k;
            ins16(T, (fkey(Cs[key * 128 + r]) & ~127u) | (unsigned)(127 - key));
        }
        __syncthreads();
        unsigned* X = (unsigned*)Cs;
        if (hk) {
#pragma unroll
            for (int i = 0; i < 16; ++i) X[r * 17 + i] = T[i];
        }
        __syncthreads();
        if (!hk) {
#pragma unroll
            for (int i = 0; i < 16; ++i) ins16(T, X[r * 17 + i]);
        }
#pragma unroll
        for (int i = 0; i < 16; ++i) L[i] = T[i];
    }
};
DEV void phase_route(const Params& p, int layer, char* smem) {
    char* ws = p.ws;
    int* eid = (int*)(ws + OFF_EID);
    float* gate = (float*)(ws + OFF_GATE);
    const bf16_t* qp = (const bf16_t*)(ws + OFF_QP);
    const bf16_t* subk = (const bf16_t*)(ws + OFF_SUBK) + (size_t)(layer * 2) * 16384;
    for (int nt = blockIdx.x; nt < kT * 8 / 128; nt += gridDim.x) {
        unsigned L1[16], L2[16];
        { EpiTop16 e1{L1}; gemm_tile(subk, 128, qp, 256, 128, 0, nt * 128, smem, e1); }
        { EpiTop16 e2{L2}; gemm_tile(subk + 16384, 128, qp + 128, 256, 128, 0, nt * 128, smem, e2); }
        const int tid = ltid();
        __syncthreads();
        if (tid < 128) {
            const size_t row = (size_t)nt * 128 + tid;
            unsigned char* ib = (unsigned char*)smem + tid * 32;
            float v1[16], v2[16];
#pragma unroll
            for (int i = 0; i < 16; ++i) {
                v1[i] = funkey(L1[i] & ~127u); v2[i] = funkey(L2[i] & ~127u);
                ib[i] = (unsigned char)(127u - (L1[i] & 127u)); ib[16 + i] = (unsigned char)(127u - (L2[i] & 127u));
            }
            unsigned C[16];
#pragma unroll
            for (int i = 0; i < 16; ++i) C[i] = 0u;
#pragma unroll
            for (int a = 0; a < 16; ++a)
#pragma unroll
                for (int b = 0; b < 16; ++b)
                    if ((a + 1) * (b + 1) <= 16) ins16(C, (fkey(v1[a] + v2[b]) & ~255u) | (unsigned)(255 - (a * 16 + b)));
            float ts[16]; float sum = 0.f;
            const float tmax = funkey(C[0] & ~255u);
#pragma unroll
            for (int i = 0; i < 16; ++i) { ts[i] = __expf(funkey(C[i] & ~255u) - tmax); sum += ts[i]; }
            const float inv = 1.f / sum;
            int ev[16];
#pragma unroll
            for (int i = 0; i < 16; ++i) { const unsigned ci = 255u - (C[i] & 255u); ev[i] = (int)ib[ci >> 4] * 128 + (int)ib[16 + (ci & 15u)]; }
#pragma unroll
            for (int i = 0; i < 4; ++i) {
                *(int4*)(eid + row * 16 + 4 * i) = make_int4(ev[4 * i], ev[4 * i + 1], ev[4 * i + 2], ev[4 * i + 3]);
                *(float4*)(gate + row * 16 + 4 * i) = make_float4(ts[4 * i] * inv, ts[4 * i + 1] * inv, ts[4 * i + 2] * inv, ts[4 * i + 3] * inv);
            }
        }
    }
}

DEV float row_sum_dpp(float v) {
    v += __int_as_float(__builtin_amdgcn_update_dpp(0, __float_as_int(v), 0xB1, 0xF, 0xF, true));
    v += __int_as_float(__builtin_amdgcn_update_dpp(0, __float_as_int(v), 0x4E, 0xF, 0xF, true));
    v += __int_as_float(__builtin_amdgcn_update_dpp(0, __float_as_int(v), 0x141, 0xF, 0xF, true));
    v += __int_as_float(__builtin_amdgcn_update_dpp(0, __float_as_int(v), 0x140, 0xF, 0xF, true));
    return v;
}
DEV float wave_sum_dpp(float v) {
    v = row_sum_dpp(v);
    const float r0 = __int_as_float(__builtin_amdgcn_readlane(__float_as_int(v), 0)), r1 = __int_as_float(__builtin_amdgcn_readlane(__float_as_int(v), 16));
    const float r2 = __int_as_float(__builtin_amdgcn_readlane(__float_as_int(v), 32)), r3 = __int_as_float(__builtin_amdgcn_readlane(__float_as_int(v), 48));
    return (r0 + r1) + (r2 + r3);
}
typedef float f32x2 __attribute__((ext_vector_type(2)));
typedef float f32x4 __attribute__((ext_vector_type(4)));

struct SliceMap { int virt, nx, nloc, rank; };
DEV SliceMap slice_map(const Params& p, char* smem) {
    unsigned* bar = (unsigned*)p.ws;
    const unsigned x = xb_xcc_id();
    int virt = 0, nx = 0, nloc = 1;
#pragma unroll
    for (unsigned j = 0; j < 16; ++j) {
        const unsigned c = xb_ld(&bar[XB_XCNT(j)]);
        if (c > 0u) { if (j < x) ++virt; ++nx; }
        if (j == x) nloc = (int)c;
    }
    SliceMap m;
    m.virt = __builtin_amdgcn_readfirstlane(virt); m.nx = __builtin_amdgcn_readfirstlane(nx > 0 ? nx : 1); m.nloc = __builtin_amdgcn_readfirstlane(nloc > 0 ? nloc : 1);
    m.rank = __builtin_amdgcn_readfirstlane((int)((volatile LAS unsigned*)(smem + SM_CTRL))[2]);
    return m;
}

typedef _Float16 half2_t __attribute__((ext_vector_type(2)));
DEV void phase_peer_u(const Params& p, int layer, char* smem, int rep = 0) {
    const int tid = ltid(), lane = tid & 63, w = tid >> 6, l8 = lane & 7, grp = lane >> 3;
    char* ws = p.ws;
    const SliceMap sm = slice_map(p, smem);
    const bf16_t* h = (const bf16_t*)(ws + OFF_H);
    const int* eid = (const int*)(ws + OFF_EID);
    float* part = (float*)(ws + OFF_S1) + (rep ? (size_t)8 * kT * 128 : 0);
    int* ids_l = (int*)(smem + w * 9216);
    const int nk = sm.rank < 512 ? (512 - sm.rank + sm.nloc - 1) / sm.nloc : 0;
    for (int s = sm.virt; s < 8; s += sm.nx) {
        if (nk == 0) break;
        const unsigned char* U = (const unsigned char*)(ws + OFF_PU) + (((size_t)layer * 8 + s) * 16384 << 7) + l8 * 16;
        uint4 ri0, ri1, ri2, ri3, rh0, rh1;
        auto load_oct = [&](int k) __attribute__((always_inline)) {
            const size_t o = (size_t)(sm.rank + k * sm.nloc) * 4 + w;
            const uint4* ip = (const uint4*)(eid + o * 1024) + lane;
            ri0 = ip[0]; ri1 = ip[64]; ri2 = ip[128]; ri3 = ip[192];
            const bf16_t* hp = h + (o * 8 + grp) * 1024 + s * 128 + l8 * 16;
            rh0 = *(const uint4*)hp; rh1 = *(const uint4*)(hp + 8);
        };
        half2_t hh[8];
        auto store_oct = [&]() __attribute__((always_inline)) {
            uint4* il = (uint4*)ids_l + lane;
            il[0] = ri0; il[64] = ri1; il[128] = ri2; il[192] = ri3;
            const unsigned hu[8] = {rh0.x, rh0.y, rh0.z, rh0.w, rh1.x, rh1.y, rh1.z, rh1.w};
#pragma unroll
            for (int i = 0; i < 8; ++i) hh[i] = (half2_t){(_Float16)lo16(hu[i]), (_Float16)hi16(hu[i])};
        };
        load_oct(0); store_oct();
#pragma unroll 1
        for (int k = 0; k < nk; ++k) {
            if (k + 1 < nk) load_oct(k + 1);
            const size_t o = (size_t)(sm.rank + k * sm.nloc) * 4 + w;
            float* pp = part + ((size_t)s * kT + o * 8 + grp) * 128 + l8;
            uint4 va[8], vb[8];
            auto issue = [&](uint4 (&v)[8], int c) __attribute__((always_inline)) {
                const int4 i0 = *(const int4*)(ids_l + grp * 128 + c * 8), i1 = *(const int4*)(ids_l + grp * 128 + c * 8 + 4);
                const int e[8] = {i0.x, i0.y, i0.z, i0.w, i1.x, i1.y, i1.z, i1.w};
#pragma unroll
                for (int j = 0; j < 8; ++j) v[j] = *(const uint4*)(U + ((size_t)e[j] << 7));
            };
            auto compute = [&](const uint4 (&v)[8], int c) __attribute__((always_inline)) {
                float res = 0.f;
#pragma unroll
                for (int j = 0; j < 8; ++j) {
                    const unsigned d[4] = {v[j].x, v[j].y, v[j].z, v[j].w};
                    float acc = 0.f;
#pragma unroll
                    for (int q = 0; q < 4; ++q) {
                        const half2_t lo = __builtin_amdgcn_cvt_scalef32_pk_f16_fp8(d[q], 1.0f, false);
                        const half2_t hi = __builtin_amdgcn_cvt_scalef32_pk_f16_fp8(d[q], 1.0f, true);
                        acc = __builtin_amdgcn_fdot2(lo, hh[2 * q], acc, false);
                        acc = __builtin_amdgcn_fdot2(hi, hh[2 * q + 1], acc, false);
                    }
                    acc += __int_as_float(__builtin_amdgcn_update_dpp(0, __float_as_int(acc), 0xB1, 0xF, 0xF, true));
                    acc += __int_as_float(__builtin_amdgcn_update_dpp(0, __float_as_int(acc), 0x4E, 0xF, 0xF, true));
                    acc += __int_as_float(__builtin_amdgcn_update_dpp(0, __float_as_int(acc), 0x141, 0xF, 0xF, true));
                    res = (l8 == j) ? acc : res;
                    __builtin_amdgcn_sched_barrier(0);
                }
                pp[c * 8] = res;
            };
            issue(va, 0);
#pragma unroll
            for (int c = 0; c < 16; c += 2) {
                issue(vb, c + 1);
                __builtin_amdgcn_sched_barrier(0);
                compute(va, c);
                __builtin_amdgcn_sched_barrier(0);
                if (c + 2 < 16) issue(va, c + 2);
                __builtin_amdgcn_sched_barrier(0);
                compute(vb, c + 1);
                __builtin_amdgcn_sched_barrier(0);
            }
            if (k + 1 < nk) store_oct();
        }
    }
}

DEV void phase_peer_comb(const Params& p, int rep = 0) {
    const int tid = ltid();
    const float* part = (const float*)(p.ws + OFF_S1);
    float* gate = (float*)(p.ws + OFF_GATE);
    for (size_t i = (size_t)blockIdx.x * 256 + tid; i < (size_t)kT * 128 / 4; i += (size_t)gridDim.x * 256) {
        float4 a = *(const float4*)(part + i * 4);
#pragma unroll
        for (int x = 1; x < 8; ++x) { const float4 b = *(const float4*)(part + (size_t)x * kT * 128 + i * 4); a.x += b.x; a.y += b.y; a.z += b.z; a.w += b.w; }
        const float4 g = *(const float4*)(gate + i * 4);
        float4 o;
        o.x = g.x * gelu_tanh(a.x * (1.f / kScaleU)); o.y = g.y * gelu_tanh(a.y * (1.f / kScaleU));
        o.z = g.z * gelu_tanh(a.z * (1.f / kScaleU)); o.w = g.w * gelu_tanh(a.w * (1.f / kScaleU));
        if (rep == 0) *(float4*)(gate + i * 4) = o;
    }
}

DEV void phase_peer_v(const Params& p, int layer, char* smem, int rep = 0) {
    const int tid = ltid(), lane = tid & 63, w = tid >> 6, l8 = lane & 7, grp = lane >> 3;
    char* ws = p.ws;
    const SliceMap sm = slice_map(p, smem);
    float* xres = (float*)(ws + OFF_XRES);
    const int* eid = (const int*)(ws + OFF_EID);
    const float* wbuf = (const float*)(ws + OFF_GATE);
    const float* mod = (const float*)(ws + OFF_MOD);
    int* ids_l = (int*)(smem + w * 9216);
    float* w_l = (float*)(smem + w * 9216 + 4096);
    const int nk = sm.rank < 512 ? (512 - sm.rank + sm.nloc - 1) / sm.nloc : 0;
    for (int s = sm.virt; s < 8; s += sm.nx) {
        if (nk == 0) break;
        const unsigned char* V = (const unsigned char*)(ws + OFF_PV) + (((size_t)layer * 8 + s) * 16384 << 7) + l8 * 16;
        uint4 ri0, ri1, ri2, ri3, rw0, rw1, rw2, rw3;
        auto load_oct = [&](int k) __attribute__((always_inline)) {
            const size_t o = (size_t)(sm.rank + k * sm.nloc) * 4 + w;
            const uint4* ip = (const uint4*)(eid + o * 1024) + lane;
            const uint4* wp = (const uint4*)(wbuf + o * 1024) + lane;
            ri0 = ip[0]; ri1 = ip[64]; ri2 = ip[128]; ri3 = ip[192];
            rw0 = wp[0]; rw1 = wp[64]; rw2 = wp[128]; rw3 = wp[192];
        };
        auto store_oct = [&]() __attribute__((always_inline)) {
            uint4* il = (uint4*)ids_l + lane; uint4* wl = (uint4*)w_l + lane;
            il[0] = ri0; il[64] = ri1; il[128] = ri2; il[192] = ri3;
            wl[0] = rw0; wl[64] = rw1; wl[128] = rw2; wl[192] = rw3;
        };
        load_oct(0); store_oct();
#pragma unroll 1
        for (int k = 0; k < nk; ++k) {
            if (k + 1 < nk) load_oct(k + 1);
            const size_t o = (size_t)(sm.rank + k * sm.nloc) * 4 + w;
            const size_t t = o * 8 + grp;
            const int b = (int)(t >> 11);
            float* xp = xres + t * 1024 + s * 128 + l8 * 16;
            const float* g2 = mod + (size_t)(layer * 8 + b) * 6144 + 5120 + s * 128 + l8 * 16;
            float4 xa[4];
#pragma unroll
            for (int c = 0; c < 4; ++c) xa[c] = *(const float4*)(xp + c * 4);
            half2_t out[8];
#pragma unroll
            for (int j = 0; j < 8; ++j) out[j] = (half2_t){(_Float16)0.f, (_Float16)0.f};
            uint4 va[8], vb[8];
            auto issue = [&](uint4 (&v)[8], int c) __attribute__((always_inline)) {
                const int4 i0 = *(const int4*)(ids_l + grp * 128 + c * 8), i1 = *(const int4*)(ids_l + grp * 128 + c * 8 + 4);
                const int e[8] = {i0.x, i0.y, i0.z, i0.w, i1.x, i1.y, i1.z, i1.w};
#pragma unroll
                for (int j = 0; j < 8; ++j) v[j] = *(const uint4*)(V + ((size_t)e[j] << 7));
            };
            auto compute = [&](const uint4 (&v)[8], int c) __attribute__((always_inline)) {
                const float4 w0 = *(const float4*)(w_l + grp * 128 + c * 8), w1 = *(const float4*)(w_l + grp * 128 + c * 8 + 4);
                const float wf[8] = {w0.x, w0.y, w0.z, w0.w, w1.x, w1.y, w1.z, w1.w};
#pragma unroll
                for (int j = 0; j < 8; ++j) {
                    const _Float16 wh = (_Float16)wf[j];
                    const half2_t ww = {wh, wh};
                    const unsigned d[4] = {v[j].x, v[j].y, v[j].z, v[j].w};
#pragma unroll
                    for (int q = 0; q < 4; ++q) {
                        const half2_t lo = __builtin_amdgcn_cvt_scalef32_pk_f16_fp8(d[q], 1.0f, false);
                        const half2_t hi = __builtin_amdgcn_cvt_scalef32_pk_f16_fp8(d[q], 1.0f, true);
                        out[2 * q] = __builtin_elementwise_fma(ww, lo, out[2 * q]);
                        out[2 * q + 1] = __builtin_elementwise_fma(ww, hi, out[2 * q + 1]);
                    }
                    __builtin_amdgcn_sched_barrier(0);
                }
            };
            issue(va, 0);
#pragma unroll
            for (int c = 0; c < 16; c += 2) {
                issue(vb, c + 1);
                __builtin_amdgcn_sched_barrier(0);
                compute(va, c);
                __builtin_amdgcn_sched_barrier(0);
                if (c + 2 < 16) issue(va, c + 2);
                __builtin_amdgcn_sched_barrier(0);
                compute(vb, c + 1);
                __builtin_amdgcn_sched_barrier(0);
            }
            if (rep == 0 || (float)out[0].x == 12345.678f) {
#pragma unroll
                for (int c = 0; c < 4; ++c) {
                    const float4 g4 = *(const float4*)(g2 + c * 4);
                    xa[c].x += g4.x * (float)out[2 * c].x * (1.f / kScaleV); xa[c].y += g4.y * (float)out[2 * c].y * (1.f / kScaleV);
                    xa[c].z += g4.z * (float)out[2 * c + 1].x * (1.f / kScaleV); xa[c].w += g4.w * (float)out[2 * c + 1].y * (1.f / kScaleV);
                    *(float4*)(xp + c * 4) = xa[c];
                }
            }
            if (k + 1 < nk) store_oct();
        }
    }
}

DEV void phase_final(const Params& p) {
    const int tid = ltid(), lane = tid & 63, w = tid >> 6;
    const float* xs = (const float*)(p.ws + OFF_XRES);
    float4 g4[4];
#pragma unroll
    for (int i = 0; i < 4; ++i) g4[i] = *(const float4*)(p.final_g + i * 256 + lane * 4);
    for (int q0 = blockIdx.x; q0 < kT / 4; q0 += gridDim.x * 4) {
        float4 v[4][4];
#pragma unroll
        for (int u = 0; u < 4; ++u) {
            const int q = q0 + u * gridDim.x < kT / 4 ? q0 + u * gridDim.x : q0;
            const float* xr = xs + (size_t)(q * 4 + w) * 1024;
#pragma unroll
            for (int i = 0; i < 4; ++i) v[u][i] = *(const float4*)(xr + i * 256 + lane * 4);
        }
#pragma unroll
        for (int u = 0; u < 4; ++u) {
            const int q = q0 + u * gridDim.x;
            if (q >= kT / 4) break;
            const int t = q * 4 + w;
            float ss = 0.f;
#pragma unroll
            for (int i = 0; i < 4; ++i) ss += v[u][i].x * v[u][i].x + v[u][i].y * v[u][i].y + v[u][i].z * v[u][i].z + v[u][i].w * v[u][i].w;
            ss = wave_sum(ss);
            const float rstd = rsqrtf(ss * (1.f / 1024.f) + kEps);
#pragma unroll
            for (int i = 0; i < 4; ++i) {
                const int col = i * 256 + lane * 4;
                *(float4*)(p.out + (size_t)t * 1024 + col) = make_float4(v[u][i].x * rstd * g4[i].x, v[u][i].y * rstd * g4[i].y, v[u][i].z * rstd * g4[i].z, v[u][i].w * rstd * g4[i].w);
            }
        }
    }
}

DEV uint4 pack8f(const float (&e)[8]) { return make_uint4(pack2(e[0], e[1]), pack2(e[2], e[3]), pack2(e[4], e[5]), pack2(e[6], e[7])); }
DEV float4 rope4(float4 v, int lane, bool is64, bool low, float4 c, float4 sn) {
    const int pl = (lane ^ (is64 ? 8 : 4)) << 2;
    float4 o;
    o.x = __int_as_float(__builtin_amdgcn_ds_bpermute(pl, __float_as_int(v.x))); o.y = __int_as_float(__builtin_amdgcn_ds_bpermute(pl, __float_as_int(v.y)));
    o.z = __int_as_float(__builtin_amdgcn_ds_bpermute(pl, __float_as_int(v.z))); o.w = __int_as_float(__builtin_amdgcn_ds_bpermute(pl, __float_as_int(v.w)));
    float4 r;
    r.x = v.x * c.x + (low ? -o.x : o.x) * sn.x; r.y = v.y * c.y + (low ? -o.y : o.y) * sn.y;
    r.z = v.z * c.z + (low ? -o.z : o.z) * sn.z; r.w = v.w * c.w + (low ? -o.w : o.w) * sn.w;
    return r;
}
struct EpiIn {
    char* ws;
    DEV void tile(int m0, int n0, const float* Cs, int tid) const {
        const int lane = tid & 63, w = tid >> 6, g16 = lane >> 4, c4 = lane & 15;
        bf16_t* cols = (bf16_t*)(ws + OFF_COLS);
        bf16_t* VT = (bf16_t*)(ws + OFF_VT);
        const float* rope = (const float*)(ws + OFF_ROPE);
        const float *cos64 = rope, *sin64 = rope + 2048 * 32, *cos32 = rope + 2048 * 64, *sin32 = rope + 2048 * 64 + 2048 * 16;
        const int b = m0 >> 11, s0 = m0 & 2047;
#pragma unroll 1
        for (int h = 0; h < 2; ++h) {
            const int cb = n0 + 64 * h;
            int vh = -1;
            if (cb == 448) vh = 0; else if (cb == 576) vh = 1; else if (cb >= 1216 && cb < 1472) vh = 2 + ((cb - 1216) >> 6); else if (cb >= 2304) vh = 6 + ((cb - 2304) >> 6);
            if (vh >= 0) {
                bf16_t* dst = VT + ((size_t)(b * 12 + vh) * 64 + lane) * 2048 + s0;
#pragma unroll
                for (int q = 0; q < 4; ++q) {
                    const int tc = w + 4 * q;
                    float e[8];
#pragma unroll
                    for (int j = 0; j < 8; ++j) e[j] = Cs[(tc * 8 + j) * 128 + h * 64 + lane];
                    *(uint4*)(dst + tc * 8) = pack8f(e);
                }
                continue;
            }
            const bool r64 = cb < 320 || cb == 384 || cb == 512 || (cb >= 1920 && cb < 2304);
            const bool r32 = (cb >= 704 && cb < 1216) || cb == 1856;
            bf16_t* dbase; int dld;
            if (cb == 256) { dbase = (bf16_t*)(ws + OFF_KC); dld = 64; } else if (cb == 320) { dbase = (bf16_t*)(ws + OFF_VC); dld = 64; } else { dbase = cols + cb; dld = LDC; }
            float4 cc[8], sn[8];
            if (r64 || r32) {
                const int i = (c4 * 4) & (r64 ? 31 : 15);
#pragma unroll
                for (int it = 0; it < 8; ++it) {
                    const int sq = s0 + it * 16 + w * 4 + g16;
                    cc[it] = *(const float4*)((r64 ? cos64 + sq * 32 : cos32 + sq * 16) + i);
                    sn[it] = *(const float4*)((r64 ? sin64 + sq * 32 : sin32 + sq * 16) + i);
                }
            }
#pragma unroll
            for (int it = 0; it < 8; ++it) {
                const int r = it * 16 + w * 4 + g16;
                float4 v = *(const float4*)(Cs + r * 128 + h * 64 + c4 * 4);
                if (r64 || r32) v = rope4(v, lane, r64, !(c4 & (r64 ? 8 : 4)), cc[it], sn[it]);
                *(uint2*)(dbase + (size_t)(m0 + r) * dld + c4 * 4) = make_uint2(pack2(v.x, v.y), pack2(v.z, v.w));
            }
        }
    }
};
DEV void mla_rstd_tile(const bf16_t* src  , int ncols, float* rsl, int tid) {
    const int lane = tid & 63, w = tid >> 6, g16 = lane >> 4, c4 = lane & 15;
#pragma unroll 2
    for (int it = 0; it < 8; ++it) {
        const int r = it * 16 + w * 4 + g16;
        const bf16_t* rp = src + (size_t)r * LDC + c4 * (ncols >> 4);
        float ss = 0.f;
        const uint4 u = *(const uint4*)rp;
        ss += lo16(u.x) * lo16(u.x) + hi16(u.x) * hi16(u.x) + lo16(u.y) * lo16(u.y) + hi16(u.y) * hi16(u.y)
            + lo16(u.z) * lo16(u.z) + hi16(u.z) * hi16(u.z) + lo16(u.w) * lo16(u.w) + hi16(u.w) * hi16(u.w);
        if (ncols == 256) {
            const uint4 u2 = *(const uint4*)(rp + 8);
            ss += lo16(u2.x) * lo16(u2.x) + hi16(u2.x) * hi16(u2.x) + lo16(u2.y) * lo16(u2.y) + hi16(u2.y) * hi16(u2.y)
                + lo16(u2.z) * lo16(u2.z) + hi16(u2.z) * hi16(u2.z) + lo16(u2.w) * lo16(u2.w) + hi16(u2.w) * hi16(u2.w);
        }
        ss = row_sum_dpp(ss);
        if (c4 == 0) rsl[r] = rsqrtf(ss / (float)ncols + kEps);
    }
}
struct EpiMlaQ {
    char* ws; const float* rsl;
    DEV void tile(int m0, int n0, const float* Cs, int tid) const {
        const int lane = tid & 63, w = tid >> 6, g16 = lane >> 4, c4 = lane & 15;
        bf16_t* qmla = (bf16_t*)(ws + OFF_QMLA);
        const float* rope = (const float*)(ws + OFF_ROPE);
        const float *cos32 = rope + 2048 * 64, *sin32 = rope + 2048 * 64 + 2048 * 16;
        const int s0 = m0 & 2047;
#pragma unroll 1
        for (int h = 0; h < 2; ++h) {
            const int col = n0 + 64 * h + c4 * 4;
            const bool isrope = ((col >> 5) % 3) == 2;
            float4 cc[8], sn[8];
#pragma unroll
            for (int it = 0; it < 8; ++it) {
                const int sq = s0 + it * 16 + w * 4 + g16, i = (c4 * 4) & 15;
                cc[it] = *(const float4*)(cos32 + sq * 16 + i); sn[it] = *(const float4*)(sin32 + sq * 16 + i);
            }
#pragma unroll
            for (int it = 0; it < 8; ++it) {
                const int r = it * 16 + w * 4 + g16;
                float4 v = *(const float4*)(Cs + r * 128 + h * 64 + c4 * 4);
                const float sc = rsl[r];
                v.x *= sc; v.y *= sc; v.z *= sc; v.w *= sc;
                const float4 vr = rope4(v, lane, false, !(c4 & 4), cc[it], sn[it]);
                if (isrope) v = vr;
                *(uint2*)(qmla + (size_t)(m0 + r) * 384 + col) = make_uint2(pack2(v.x, v.y), pack2(v.z, v.w));
            }
        }
    }
};
struct EpiMlaKV {
    char* ws; const float* rsl;
    DEV void tile(int m0, int n0, const float* Cs, int tid) const {
        const int lane = tid & 63, w = tid >> 6, g16 = lane >> 4, c4 = lane & 15;
        bf16_t* kvmla = (bf16_t*)(ws + OFF_KVMLA);
        bf16_t* VT = (bf16_t*)(ws + OFF_VT);
        const int b = m0 >> 11, s0 = m0 & 2047, hd = n0 >> 7;
#pragma unroll 2
        for (int it = 0; it < 8; ++it) {
            const int r = it * 16 + w * 4 + g16;
            float4 v = *(const float4*)(Cs + r * 128 + c4 * 4);
            const float sc = rsl[r];
            *(uint2*)(kvmla + (size_t)(m0 + r) * 512 + n0 + c4 * 4) = make_uint2(pack2(v.x * sc, v.y * sc), pack2(v.z * sc, v.w * sc));
        }
        bf16_t* dst = VT + ((size_t)(b * 12 + 8 + hd) * 64 + lane) * 2048 + s0;
#pragma unroll
        for (int q = 0; q < 4; ++q) {
            const int tc = w + 4 * q;
            float e[8];
#pragma unroll
            for (int j = 0; j < 8; ++j) e[j] = Cs[(tc * 8 + j) * 128 + 64 + lane] * rsl[tc * 8 + j];
            *(uint4*)(dst + tc * 8) = pack8f(e);
        }
    }
};

DEV void phase_gemm_in(const Params& p, int layer, char* smem) {
    char* ws = p.ws;
    EpiIn epi{ws};
    gemm_phase((const bf16_t*)(ws + OFF_H), 1024, (const bf16_t*)(ws + OFF_WIN) + (size_t)layer * 2432 * 1024, 1024, 1024, kT / 128, LDC / 128, smem, epi);
}
DEV void phase_gemm_mid(const Params& p, int layer, char* smem) {
    char* ws = p.ws;
    const float* misc = (const float*)(ws + OFF_MISC);
    const bf16_t* cols = (const bf16_t*)(ws + OFF_COLS);
    float* rsl = (float*)(smem + SM_CTRL + 256);
    const int nb_up = (int)gridDim.x > 32 ? (int)gridDim.x - 16 : (int)gridDim.x;
    for (int tile = ((int)gridDim.x > 32 && blockIdx.x >= 16) ? (int)blockIdx.x : (int)blockIdx.x; tile < 16 + 384 + 512;
         tile = (tile < 16 && (int)gridDim.x > 32) ? 16 + 384 + 512 : tile + nb_up) {
        if (tile < 16) {
            const int kv = tile >> 3, mt = tile & 7;
            EpiF32 epi{(float*)(ws + OFF_QP) + (size_t)kv * 1024 * 128, 128};
            gemm_tile((const bf16_t*)(ws + (kv ? OFF_VC : OFF_KC)), 1024, (const bf16_t*)(ws + (kv ? OFF_WCV : OFF_WCK)) + (size_t)layer * 128 * 2048, 1024, 1024, mt * 128, 0, smem, epi);
        } else if (tile < 16 + 384) {
            const int tt = tile - 16, m0 = (tt / 3) * 128;
            __syncthreads();
            mla_rstd_tile(cols + (size_t)m0 * LDC + 1472, 256, rsl, ltid());
            EpiMlaQ epi{ws, rsl};
            gemm_tile(cols + 1472, LDC, (const bf16_t*)(ws + OFF_WUQ) + (size_t)layer * 384 * 256, 256, 256, m0, (tt % 3) * 128, smem, epi);
        } else {
            const int tt = tile - 16 - 384, m0 = (tt / 4) * 128;
            __syncthreads();
            mla_rstd_tile(cols + (size_t)m0 * LDC + 1728, 128, rsl, ltid());
            EpiMlaKV epi{ws, rsl};
            gemm_tile(cols + 1728, LDC, (const bf16_t*)(ws + OFF_WUKV) + (size_t)layer * 512 * 128, 128, 128, m0, (tt % 4) * 128, smem, epi);
        }
    }
}
DEV void phase_gemm_out(const Params& p, int layer, char* smem) {
    char* ws = p.ws;
    EpiRes epi{layer == 0 ? p.x : (const float*)(ws + OFF_XRES), (float*)(ws + OFF_XRES), (const float*)(ws + OFF_MOD) + (size_t)layer * 8 * 6144 + 2048};
    gemm_phase((const bf16_t*)(ws + OFF_O), 1024, (const bf16_t*)(ws + OFF_WOUT) + (size_t)layer * 1024 * 1024, 1024, 1024, kT / 128, 8, smem, epi);
}
DEV void phase_gemm_wq(const Params& p, int layer, char* smem) {
    char* ws = p.ws;
    EpiBf16 epi{(bf16_t*)(ws + OFF_QP), 2048, nullptr, nullptr, 2048};
    gemm_phase((const bf16_t*)(ws + OFF_H), 1024, (const bf16_t*)(ws + OFF_WQ) + (size_t)layer * 2048 * 1024, 1024, 1024, kT / 128, 16, smem, epi);
}
DEV void phase_scores(const Params& p, int layer, char* smem) {
    char* ws = p.ws;
    for (int tile = blockIdx.x; tile < 2048; tile += gridDim.x) {
        const int c = tile >> 10, nt = tile & 1023;
        EpiF32 epi{(float*)(ws + (c ? OFF_S2 : OFF_S1)), kT * 8};
        gemm_tile((const bf16_t*)(ws + OFF_SUBK) + (size_t)(layer * 2 + c) * 16384, 128, (const bf16_t*)(ws + OFF_QP) + c * 128, 256, 128, 0, nt * 128, smem, epi);
    }
}

constexpr int NPHASE = 16;
DEV void run_phase(const Params& p, int ph, int layer, char* smem, int rep = 0) {
    switch (ph) {
        case 0: phase_prologue(p, smem); break;
        case 1: phase_norm(p, layer, 0); break;
        case 2: phase_gemm_in(p, layer, smem); break;
        case 3: phase_layout1(p, smem); break;
        case 4: phase_gemm_mid(p, layer, smem); break;
        case 5: phase_layout2(p, layer, smem); break;
        case 6: phase_attn(p, layer, smem, rep); break;
        case 7: phase_gemm_out(p, layer, smem); break;
        case 8: phase_norm(p, layer, 1); break;
        case 9: phase_gemm_wq(p, layer, smem); break;
        case 10: phase_route(p, layer, smem); break;
        case 11: phase_topk(p, smem); break;
        case 12: phase_peer_u(p, layer, smem, rep); break;
        case 13: phase_peer_comb(p, rep); break;
        case 14: phase_peer_v(p, layer, smem, rep); break;
        case 15: if (layer == 0) phase_norm(p, 1, 0); else phase_final(p); break;
        default: break;
    }
}

#if !FUSED
template <int PH>
__global__ void __launch_bounds__(256, 2) k_phase(Params p, int layer) {
    __shared__ __attribute__((aligned(16))) char smem[SM_TOTAL];
    run_phase(p, PH, layer, smem);
}
template <int PH> static void launch_phase(const Params& p, int layer, hipStream_t stream) { k_phase<PH><<<512, 256, 0, stream>>>(p, layer); }
static void launch_ph(int ph, const Params& p, int layer, hipStream_t stream) {
    switch (ph) {
        case 0: launch_phase<0>(p, layer, stream); break;
        case 1: launch_phase<1>(p, layer, stream); break;
        case 2: launch_phase<2>(p, layer, stream); break;
        case 3: launch_phase<3>(p, layer, stream); break;
        case 4: launch_phase<4>(p, layer, stream); break;
        case 5: launch_phase<5>(p, layer, stream); break;
        case 6: launch_phase<6>(p, layer, stream); break;
        case 7: launch_phase<7>(p, layer, stream); break;
        case 8: launch_phase<8>(p, layer, stream); break;
        case 9: launch_phase<9>(p, layer, stream); break;
        case 10: launch_phase<10>(p, layer, stream); break;
        case 11: launch_phase<11>(p, layer, stream); break;
        case 12: launch_phase<12>(p, layer, stream); break;
    }
}
#else
#if TS_A >= 0
#define TSTAMP(I) if (blockIdx.x == 0 && threadIdx.x == 0) ((unsigned long long*)(p.ws + 32768))[I] = __builtin_amdgcn_s_memrealtime();
#else
#define TSTAMP(I)
#endif
__global__ void __launch_bounds__(256, 2) k_mega(Params p) {
    extern __shared__ __attribute__((aligned(1024))) char smem[];
    cg::grid_group grid = cg::this_grid();
    volatile LAS unsigned* st = (volatile LAS unsigned*)(smem + SM_CTRL);
    if (threadIdx.x == 0) { st[0] = 0u; st[1] = 0u; st[2] = 0u; }
    __syncthreads();
    const XcdBarrier xb = xcd_barrier_post((unsigned*)p.ws, st);
    TSTAMP(0)
    run_phase(p, 0, 0, smem);
    if (p.out == nullptr) grid.sync();
    xcd_barrier(xb);
    TSTAMP(1)
    run_phase(p, 1, 0, smem);
    xcd_barrier(xb);
    TSTAMP(2)
#define STEP(PH, L) { run_phase(p, PH, L, smem, 0); xcd_barrier(xb); TSTAMP(2 + (L) * 16 + (PH)) }
#define LAYER(L) STEP(2, L) STEP(4, L) STEP(6, L) STEP(7, L) STEP(8, L) STEP(9, L) STEP(10, L) STEP(12, L) STEP(13, L) STEP(14, L)
    LAYER(0)
    STEP(15, 0)
    LAYER(1)
    run_phase(p, 15, 1, smem);
#if TS_A >= 0
    TSTAMP(2 + 16 + 15)
    __syncthreads();
    if (blockIdx.x == 0 && threadIdx.x == 0) {
        const unsigned long long* ts = (const unsigned long long*)(p.ws + 32768);
        p.out[0] += (TS_A == 50) ? (float)ts[TS_B] * (0.01f / 512.f / 10.f) : (float)(ts[TS_B] - ts[TS_A]) * 0.001f;
    }
#endif
}
#endif

extern "C" void kernel_launch(void* const* d_in, const int* in_sizes, int n_in, void* d_out, int out_size, void* d_ws, size_t ws_size, hipStream_t stream) {
    Params p{};
    const float** pp = (const float**)&p;
    for (int i = 0; i < 28; ++i) pp[i] = (const float*)d_in[i];
    p.out = (float*)d_out;
    p.ws = (char*)d_ws;
    if (ws_size < OFF_END) fprintf(stderr, "workspace too small: %zu < %zu\n", ws_size, (size_t)OFF_END);
    (void)hipMemsetAsync(d_ws, 0, 65536, stream);
#if !FUSED
    launch_ph(0, p, 0, stream);
    launch_ph(1, p, 0, stream);
    for (int l = 0; l < 2; ++l)
        for (int ph = 2; ph < NPHASE; ++ph) launch_ph(ph, p, l, stream);
#else
    static int grid_blocks = 0;
    if (!grid_blocks) {
        int dev = 0, cus = 0, per_cu = 0;
        (void)hipGetDevice(&dev);
        (void)hipDeviceGetAttribute(&cus, hipDeviceAttributeMultiprocessorCount, dev);
        (void)hipFuncSetAttribute((const void*)k_mega, hipFuncAttributeMaxDynamicSharedMemorySize, SM_TOTAL);
        (void)hipOccupancyMaxActiveBlocksPerMultiprocessor(&per_cu, (const void*)k_mega, 256, SM_TOTAL);
        if (per_cu > 2) per_cu = 2;
        if (per_cu < 1) per_cu = 1;
        grid_blocks = cus * per_cu;
    }
    void* args[] = {&p};
    hipError_t e = hipLaunchCooperativeKernel((const void*)k_mega, dim3(grid_blocks), dim3(256), args, SM_TOTAL, stream);
    if (e != hipSuccess) fprintf(stderr, "cooperative launch failed: %s (grid %d)\n", hipGetErrorString(e), grid_blocks);
#endif
}
```

```cpp
#include <hip/hip_runtime.h>
#include <hip/hip_cooperative_groups.h>
#include <stdint.h>
#include <stdio.h>
namespace cg = cooperative_groups;

#ifndef FUSED
#define FUSED 1
#endif
#ifndef TS_A
#define TS_A -1
#define TS_B -1
#endif
#ifndef PROBE_PH
#define PROBE_PH -1
#define PROBE_L 1
#define PROBE_REP 0
#endif

#define DEV __device__ __forceinline__
#define LAS __attribute__((address_space(3)))
typedef unsigned short bf16_t;
typedef short bf16x8 __attribute__((ext_vector_type(8)));
typedef float f32x16 __attribute__((ext_vector_type(16)));

constexpr int kB = 8, kS = 2048, kT = kB * kS, kD = 1024, LDC = 2432;
constexpr float kEps = 1e-6f;
constexpr float kNeg = -1e30f;
constexpr float kLog2e = 1.4426950408889634f;
constexpr float kScaleU = 256.f, kScaleV = 32.f;

constexpr size_t OFF_CTRL = 0;
constexpr size_t OFF_MOD  = 65536;
constexpr size_t OFF_ROPE = OFF_MOD + 2ull * 8 * 6144 * 4;
constexpr size_t OFF_MISC = OFF_ROPE + 2048ull * 96 * 4;
constexpr size_t OFF_WIN  = OFF_MISC + 4096;
constexpr size_t OFF_WOUT = OFF_WIN + 2ull * 2432 * 1024 * 2;
constexpr size_t OFF_WQ   = OFF_WOUT + 2ull * 1024 * 1024 * 2;
constexpr size_t OFF_WUQ  = OFF_WQ + 2ull * 2048 * 1024 * 2;
constexpr size_t OFF_WUKV = OFF_WUQ + 2ull * 384 * 256 * 2;
constexpr size_t OFF_WCK  = OFF_WUKV + 2ull * 512 * 128 * 2;
constexpr size_t OFF_WCV  = OFF_WCK + 2ull * 128 * 2048 * 2;
constexpr size_t OFF_SUBK = OFF_WCV + 2ull * 128 * 2048 * 2;
constexpr size_t OFF_PU   = OFF_SUBK + 2ull * 2 * 128 * 128 * 2;
constexpr size_t OFF_PV   = OFF_PU + 2ull * 16384 * 1024;
constexpr size_t OFF_XRES = OFF_PV + 2ull * 16384 * 1024;
constexpr size_t OFF_H    = OFF_XRES + (size_t)kT * 1024 * 4;
constexpr size_t OFF_H8   = OFF_H + (size_t)kT * 1024 * 2;
constexpr size_t OFF_RSTD = OFF_H8 + (size_t)kT * 1024;
constexpr size_t OFF_KCMP = OFF_RSTD + 2ull * kT * 4;
constexpr size_t OFF_EID  = OFF_KCMP + 2ull * 1024 * 64 * 2;
constexpr size_t OFF_GATE = OFF_EID + (size_t)kT * 128 * 4;
constexpr size_t OFF_QP   = OFF_GATE + (size_t)kT * 128 * 4;
constexpr size_t OFF_COLS = OFF_QP + (size_t)kT * 2048 * 2;
constexpr size_t OFF_KC   = OFF_COLS + (size_t)kT * LDC * 2;
constexpr size_t OFF_VC   = OFF_KC + (size_t)(kT + 64) * 64 * 2;
constexpr size_t OFF_VT   = OFF_VC + (size_t)(kT + 64) * 64 * 2;
constexpr size_t OFF_QMLA = OFF_VT + 8ull * 12 * 64 * 2048 * 2;
constexpr size_t OFF_KVMLA = OFF_QMLA + (size_t)kT * 384 * 2;
constexpr size_t OFF_O    = OFF_KVMLA + (size_t)kT * 512 * 2;
constexpr size_t OFF_END  = OFF_O + (size_t)kT * 1024 * 2;
constexpr size_t OFF_S1 = OFF_COLS, OFF_S2 = OFF_COLS + (size_t)kT * 8 * 128 * 4;
static_assert(OFF_S2 + (size_t)kT * 8 * 128 * 4 <= OFF_O, "alias region too small");
static_assert(OFF_END <= (512ull << 20), "workspace too large");

struct Params {
    const float *x, *c, *ada_w, *ada_b, *norm_mix_g, *norm_ffn_g, *w_in, *pos_k, *pos_v, *cmp_wk, *cmp_wv;
    const float *lq1, *lk1, *lq2, *lk2, *sub_g, *mla_qg, *mla_wuq, *mla_kvg, *mla_wukv, *sinks, *w_out;
    const float *w_q, *subk1, *subk2, *pu, *pv, *final_g;
    float* out;
    char* ws;
};

DEV int ltid() { int t = threadIdx.x; asm volatile("" : "+v"(t)); return t; }
DEV float bf2f(bf16_t v) { return __uint_as_float(((unsigned)v) << 16); }
DEV bf16_t f2bf(float f) { unsigned u = __float_as_uint(f); u += 0x7fffu + ((u >> 16) & 1u); return (bf16_t)(u >> 16); }
DEV unsigned pack2(float lo, float hi) { unsigned r; asm("v_cvt_pk_bf16_f32 %0, %1, %2" : "=v"(r) : "v"(lo), "v"(hi)); return r; }
DEV float lo16(unsigned u) { return __uint_as_float(u << 16); }
DEV float hi16(unsigned u) { return __uint_as_float(u & 0xffff0000u); }
DEV float wave_sum(float v) {
#pragma unroll
    for (int o = 32; o > 0; o >>= 1) v += __shfl_xor(v, o, 64);
    return v;
}
DEV float xor32f(float v, int lane) { return __int_as_float(__builtin_amdgcn_ds_bpermute((lane ^ 32) << 2, __float_as_int(v))); }
DEV float lanef(float v, int src) { return __int_as_float(__builtin_amdgcn_ds_bpermute(src << 2, __float_as_int(v))); }
DEV f32x16 mfma32(bf16x8 a, bf16x8 b, f32x16 c) { return __builtin_amdgcn_mfma_f32_32x32x16_bf16(a, b, c, 0, 0, 0); }
DEV f32x16 zero16() { f32x16 z;
#pragma unroll
    for (int i = 0; i < 16; ++i) z[i] = 0.f;
    return z; }
DEV float gelu_tanh(float x) {
    const float u = 0.7978845608028654f * (x + 0.044715f * x * x * x);
    const float e = __expf(2.f * u);
    const float t = 1.f - 2.f / (e + 1.f);
    return 0.5f * x * (1.f + t);
}

template <class Epi>
DEV void gemm_tile(const bf16_t* __restrict__ A, int lda, const bf16_t* __restrict__ Bt, int ldb, int K, int m0, int n0, char* smem, const Epi& epi) {
    const int tid = ltid(), lane = tid & 63, w = tid >> 6, wm = w >> 1, wn = w & 1, ql = lane & 31, hh = lane >> 5;
    f32x16 acc[2][2];
#pragma unroll
    for (int i = 0; i < 2; ++i)
#pragma unroll
        for (int j = 0; j < 2; ++j) acc[i][j] = zero16();
    const int srow = lane >> 3, spos = lane & 7;
    const int c0 = spos ^ ((srow >> 1) & 7), c1 = spos ^ ((4 + (srow >> 1)) & 7);
    const bf16_t* Ag0 = A + (size_t)(m0 + w * 32 + srow) * lda + c0 * 8;
    const bf16_t* Ag1 = A + (size_t)(m0 + w * 32 + 8 + srow) * lda + c1 * 8;
    const bf16_t* Bg0 = Bt + (size_t)(n0 + w * 32 + srow) * ldb + c0 * 8;
    const bf16_t* Bg1 = Bt + (size_t)(n0 + w * 32 + 8 + srow) * ldb + c1 * 8;
    const size_t a16 = (size_t)16 * lda, b16 = (size_t)16 * ldb;
    auto stage = [&](int kt, int buf) __attribute__((always_inline)) {
        char* sa = smem + buf * 32768 + w * 4096;
        char* sb = sa + 16384;
        const int ko = kt * 64;
        __builtin_amdgcn_global_load_lds((const unsigned*)(Ag0 + ko), (LAS unsigned*)(sa), 16, 0, 0);
        __builtin_amdgcn_global_load_lds((const unsigned*)(Ag1 + ko), (LAS unsigned*)(sa + 1024), 16, 0, 0);
        __builtin_amdgcn_global_load_lds((const unsigned*)(Ag0 + a16 + ko), (LAS unsigned*)(sa + 2048), 16, 0, 0);
        __builtin_amdgcn_global_load_lds((const unsigned*)(Ag1 + a16 + ko), (LAS unsigned*)(sa + 3072), 16, 0, 0);
        __builtin_amdgcn_global_load_lds((const unsigned*)(Bg0 + ko), (LAS unsigned*)(sb), 16, 0, 0);
        __builtin_amdgcn_global_load_lds((const unsigned*)(Bg1 + ko), (LAS unsigned*)(sb + 1024), 16, 0, 0);
        __builtin_amdgcn_global_load_lds((const unsigned*)(Bg0 + b16 + ko), (LAS unsigned*)(sb + 2048), 16, 0, 0);
        __builtin_amdgcn_global_load_lds((const unsigned*)(Bg1 + b16 + ko), (LAS unsigned*)(sb + 3072), 16, 0, 0);
    };
    const int key = (ql >> 1) & 7;
    const int arow = (wm * 64 + ql) * 128, brow = (wn * 64 + ql) * 128;
    const int nk = K >> 6;
    __syncthreads();
    stage(0, 0);
    for (int kt = 0; kt < nk; ++kt) {
        asm volatile("s_waitcnt vmcnt(0)" ::: "memory");
        __syncthreads();
        if (kt + 1 < nk) stage(kt + 1, (kt + 1) & 1);
        const char* As = smem + (kt & 1) * 32768;
        const char* Bs = As + 16384;
#pragma unroll
        for (int ks = 0; ks < 4; ++ks) {
            const int co = ((ks * 2 + hh) ^ key) << 4;
            bf16x8 a[2], b[2];
#pragma unroll
            for (int i = 0; i < 2; ++i) {
                a[i] = *(const bf16x8*)(As + arow + i * 4096 + co);
                b[i] = *(const bf16x8*)(Bs + brow + i * 4096 + co);
            }
#pragma unroll
            for (int i = 0; i < 2; ++i)
#pragma unroll
                for (int j = 0; j < 2; ++j) acc[i][j] = mfma32(a[i], b[j], acc[i][j]);
        }
    }
    __syncthreads();
    float* Cs = (float*)smem;
#pragma unroll
    for (int i = 0; i < 2; ++i)
#pragma unroll
        for (int j = 0; j < 2; ++j)
#pragma unroll
            for (int r = 0; r < 16; ++r)
                Cs[(wm * 64 + i * 32 + (r & 3) + 8 * (r >> 2) + 4 * hh) * 128 + wn * 64 + j * 32 + ql] = acc[i][j][r];
    __syncthreads();
    epi.tile(m0, n0, Cs, tid);
}

struct EpiBf16 {
    bf16_t* C; int ldc; const float* rowscale; const float* colbias; int nvalid;
    DEV void tile(int m0, int n0, const float* Cs, int tid) const {
#pragma unroll
        for (int it = 0; it < 8; ++it) {
            const int id = tid + 256 * it, r = id >> 4, c8 = (id & 15) * 8;
            if (n0 + c8 >= nvalid) continue;
            float4 a = *(const float4*)(Cs + r * 128 + c8), b = *(const float4*)(Cs + r * 128 + c8 + 4);
            if (rowscale) { const float sc = rowscale[m0 + r]; a.x *= sc; a.y *= sc; a.z *= sc; a.w *= sc; b.x *= sc; b.y *= sc; b.z *= sc; b.w *= sc; }
            if (colbias) { const float4 ba = *(const float4*)(colbias + n0 + c8), bb = *(const float4*)(colbias + n0 + c8 + 4);
                a.x += ba.x; a.y += ba.y; a.z += ba.z; a.w += ba.w; b.x += bb.x; b.y += bb.y; b.z += bb.z; b.w += bb.w; }
            *(uint4*)(C + (size_t)(m0 + r) * ldc + n0 + c8) = make_uint4(pack2(a.x, a.y), pack2(a.z, a.w), pack2(b.x, b.y), pack2(b.z, b.w));
        }
    }
};
struct EpiF32 {
    float* C; int ldc;
    DEV void tile(int m0, int n0, const float* Cs, int tid) const {
#pragma unroll
        for (int it = 0; it < 16; ++it) {
            const int id = tid + 256 * it, r = id >> 5, c4 = (id & 31) * 4;
            *(float4*)(C + (size_t)(m0 + r) * ldc + n0 + c4) = *(const float4*)(Cs + r * 128 + c4);
        }
    }
};
struct EpiRes {
    const float* xin; float* xout; const float* gate;
    DEV void tile(int m0, int n0, const float* Cs, int tid) const {
        const float* g = gate + (size_t)(m0 >> 11) * 6144 + n0;
#pragma unroll
        for (int it = 0; it < 16; ++it) {
            const int id = tid + 256 * it, r = id >> 5, c4 = (id & 31) * 4;
            const float4 v = *(const float4*)(Cs + r * 128 + c4), g4 = *(const float4*)(g + c4);
            float4 x = *(const float4*)(xin + (size_t)(m0 + r) * 1024 + n0 + c4);
            x.x += g4.x * v.x; x.y += g4.y * v.y; x.z += g4.z * v.z; x.w += g4.w * v.w;
            *(float4*)(xout + (size_t)(m0 + r) * 1024 + n0 + c4) = x;
        }
    }
};

template <class Epi>
DEV void gemm_phase(const bf16_t* A, int lda, const bf16_t* Bt, int ldb, int K, int mtiles, int ntiles, char* smem, const Epi& epi) {
    for (int tile = blockIdx.x; tile < mtiles * ntiles; tile += gridDim.x) {
        const int mt = tile / ntiles, nt = tile % ntiles;
        gemm_tile(A, lda, Bt, ldb, K, mt * 128, nt * 128, smem, epi);
    }
}

DEV int win_srccol(int n) {
    if (n < 652) return n;
    if (n < 704) return -1;
    if (n < 1888) return n - 52;
    if (n < 1920) return -1;
    return n - 84;
}
DEV void transpose_tile(const float* __restrict__ src, int ld_src, int nsrc_valid, int mode, const float* __restrict__ rowscale,
                        bf16_t* __restrict__ dst, int K, int n0, int k0, char* smem) {
    bf16_t* Ls = (bf16_t*)smem;
    const int tid = ltid();
    __syncthreads();
    const int nn = tid & 63, n = n0 + nn;
    const int sc = (mode == 1) ? win_srccol(n) : (mode == 2) ? (n & 63) : (n < nsrc_valid ? n : -1);
    const int kshift = (mode == 2 && n >= 64) ? 1024 : 0;
#pragma unroll 4
    for (int i = 0; i < 16; ++i) {
        const int kk = (tid >> 6) + 4 * i;
        float v = 0.f;
        if (sc >= 0) { v = src[(size_t)(k0 + kk + kshift) * ld_src + sc]; if (rowscale) v *= rowscale[k0 + kk]; }
        Ls[nn * 72 + kk] = f2bf(v);
    }
    __syncthreads();
#pragma unroll
    for (int i = 0; i < 2; ++i) {
        const int r = (tid >> 3) + 32 * i, ch = tid & 7;
        *(uint4*)(dst + (size_t)(n0 + r) * K + k0 + ch * 8) = *(const uint4*)(Ls + r * 72 + ch * 8);
    }
}

DEV void convert_stream(const float* __restrict__ src, bf16_t* __restrict__ dst, size_t n8) {
    const int tid = ltid();
    for (size_t i = (size_t)blockIdx.x * 256 + tid; i < n8; i += (size_t)gridDim.x * 256) {
        const float4 a = *(const float4*)(src + i * 8), b = *(const float4*)(src + i * 8 + 4);
        uint4 o; o.x = pack2(a.x, a.y); o.y = pack2(a.z, a.w); o.z = pack2(b.x, b.y); o.w = pack2(b.z, b.w);
        *(uint4*)(dst + i * 8) = o;
    }
}

DEV void convert_fp8_stream(const float* __restrict__ src, unsigned char* __restrict__ dst, size_t n16, float scale) {
    const int tid = ltid();
    const size_t stride = (size_t)gridDim.x * 256;
    for (size_t i0 = (size_t)blockIdx.x * 256 + tid; i0 < n16; i0 += stride * 4) {
        float4 q[4][4];
#pragma unroll
        for (int u = 0; u < 4; ++u) {
            const size_t i = i0 + u * stride < n16 ? i0 + u * stride : i0;
#pragma unroll
            for (int c = 0; c < 4; ++c) q[u][c] = *(const float4*)(src + i * 16 + c * 4);
        }
#pragma unroll
        for (int u = 0; u < 4; ++u) {
            const size_t i = i0 + u * stride;
            if (i >= n16) break;
            unsigned o[4];
#pragma unroll
            for (int j = 0; j < 4; ++j) {
                const float4 v = q[u][j];
                unsigned w = 0u;
                w = __builtin_amdgcn_cvt_pk_fp8_f32(fminf(fmaxf(v.x * scale, -440.f), 440.f), fminf(fmaxf(v.y * scale, -440.f), 440.f), w, false);
                w = __builtin_amdgcn_cvt_pk_fp8_f32(fminf(fmaxf(v.z * scale, -440.f), 440.f), fminf(fmaxf(v.w * scale, -440.f), 440.f), w, true);
                o[j] = w;
            }
            const size_t rowg = i >> 6; const int c16 = (int)(i & 63);
            const size_t l = rowg >> 14, row = rowg & 16383;
            *(uint4*)(dst + (((l * 8 + (c16 >> 3)) * 16384 + row) << 7) + (c16 & 7) * 16) = make_uint4(o[0], o[1], o[2], o[3]);
        }
    }
}

constexpr int J_ROPE = 384, J_MOD = 192, J_MISC = 5;
constexpr int J_TW_L = 608 + 256 + 512 + 24 + 16 + 64 + 64;
constexpr int J_TOTAL = J_ROPE + J_MOD + J_MISC + 2 * J_TW_L;

DEV void prologue_job(const Params& p, int job, char* smem) {
    const int tid = ltid();
    char* ws = p.ws;
    if (job < J_MISC) {
        float* misc = (float*)(ws + OFF_MISC);
        if (job < 4) {
            const int l = job >> 1, kv = job & 1;
            const float* pos = (kv ? p.pos_v : p.pos_k) + l * 2048;
            const float* wsrc = (kv ? p.cmp_wv : p.cmp_wk) + (size_t)l * 2048 * 64;
            float* red = (float*)smem;
            __syncthreads();
            const int kp = tid >> 6, n = tid & 63;
            float acc = 0.f;
            for (int k0 = kp * 512; k0 < kp * 512 + 512; k0 += 16) {
                float wv[16];
#pragma unroll
                for (int u = 0; u < 16; ++u) wv[u] = wsrc[(size_t)(k0 + u) * 64 + n];
#pragma unroll
                for (int u = 0; u < 16; ++u) acc += pos[k0 + u] * wv[u];
            }
            red[kp * 64 + n] = acc;
            __syncthreads();
            if (tid < 64) misc[(l * 2 + kv) * 64 + tid] = red[tid] + red[64 + tid] + red[128 + tid] + red[192 + tid];
        } else if (tid < 2) {
            const int l = tid;
            float d1 = 0.f, d2 = 0.f;
            for (int i = 0; i < 32; ++i) { d1 += p.lq1[l * 32 + i] * p.lk1[l * 32 + i]; d2 += p.lq2[l * 32 + i] * p.lk2[l * 32 + i]; }
            const float lam_init = 0.8f - 0.6f * expf(-0.3f * (float)l);
            misc[256 + l] = expf(d1) - expf(d2) + lam_init;
            misc[258 + l] = 1.f - lam_init;
        }
        return;
    }
    job -= J_MISC;
    if (job < J_MOD) {
        const int l = job / 96, n0 = (job % 96) * 64;
        float* sc = (float*)smem;
        __syncthreads();
        for (int i = tid; i < 8192; i += 256) { const float v = p.c[i]; sc[i] = v / (1.f + __expf(-v)); }
        __syncthreads();
        const int kp = tid >> 6, col = tid & 63;
        float acc[8];
#pragma unroll
        for (int b = 0; b < 8; ++b) acc[b] = 0.f;
        const float* wp = p.ada_w + (size_t)l * 1024 * 6144 + n0 + col;
        for (int k0 = kp * 256; k0 < kp * 256 + 256; k0 += 16) {
            float wv[16];
#pragma unroll
            for (int u = 0; u < 16; ++u) wv[u] = wp[(size_t)(k0 + u) * 6144];
#pragma unroll
            for (int u = 0; u < 16; ++u)
#pragma unroll
                for (int b = 0; b < 8; ++b) acc[b] += sc[b * 1024 + k0 + u] * wv[u];
        }
        float* red = sc + 8192;
#pragma unroll
        for (int b = 0; b < 8; ++b) red[(kp * 8 + b) * 64 + col] = acc[b];
        __syncthreads();
        float* mod = (float*)(ws + OFF_MOD);
        for (int idx = tid; idx < 512; idx += 256) {
            const int b = idx >> 6, cl = idx & 63;
            const float v = red[(0 * 8 + b) * 64 + cl] + red[(1 * 8 + b) * 64 + cl] + red[(2 * 8 + b) * 64 + cl] + red[(3 * 8 + b) * 64 + cl];
            mod[(size_t)(l * 8 + b) * 6144 + n0 + cl] = v + p.ada_b[l * 6144 + n0 + cl];
        }
        return;
    }
    job -= J_MOD;
    if (job < J_ROPE) {
        const int idx = job * 256 + tid;
        const int s = idx / 48, j = idx % 48;
        float* rope = (float*)(ws + OFF_ROPE);
        float inv; float *pc, *ps;
        if (j < 32) { inv = exp2f(-(float)j * (13.287712379549449f / 32.f)); pc = rope + s * 32 + j; ps = rope + 2048 * 32 + s * 32 + j; }
        else { const int i = j - 32; inv = exp2f(-(float)i * (13.287712379549449f / 16.f)); pc = rope + 2048 * 64 + s * 16 + i; ps = rope + 2048 * 64 + 2048 * 16 + s * 16 + i; }
        const double a = (double)s * (double)inv;
        const double kk = rint(a * 0.15915494309189535);
        const float r = (float)fma(-kk, 6.283185307179586, a);
        *pc = cosf(r); *ps = sinf(r);
        return;
    }
    job -= J_ROPE;
    const int l = job / J_TW_L; int j = job % J_TW_L;
    if (j < 608) { transpose_tile(p.w_in + (size_t)l * 1024 * 2348, 2348, 2348, 1, nullptr, (bf16_t*)(ws + OFF_WIN) + (size_t)l * 2432 * 1024, 1024, (j / 16) * 64, (j % 16) * 64, smem); return; }
    j -= 608;
    if (j < 256) { transpose_tile(p.w_out + (size_t)l * 1024 * 1024, 1024, 1024, 0, nullptr, (bf16_t*)(ws + OFF_WOUT) + (size_t)l * 1024 * 1024, 1024, (j / 16) * 64, (j % 16) * 64, smem); return; }
    j -= 256;
    if (j < 512) { transpose_tile(p.w_q + (size_t)l * 1024 * 2048, 2048, 2048, 0, nullptr, (bf16_t*)(ws + OFF_WQ) + (size_t)l * 2048 * 1024, 1024, (j / 16) * 64, (j % 16) * 64, smem); return; }
    j -= 512;
    if (j < 24) { transpose_tile(p.mla_wuq + (size_t)l * 256 * 384, 384, 384, 0, p.mla_qg + l * 256, (bf16_t*)(ws + OFF_WUQ) + (size_t)l * 384 * 256, 256, (j / 4) * 64, (j % 4) * 64, smem); return; }
    j -= 24;
    if (j < 16) { transpose_tile(p.mla_wukv + (size_t)l * 128 * 512, 512, 512, 0, p.mla_kvg + l * 128, (bf16_t*)(ws + OFF_WUKV) + (size_t)l * 512 * 128, 128, (j / 2) * 64, (j % 2) * 64, smem); return; }
    j -= 16;
    if (j < 64) { if (j < 32) transpose_tile(p.cmp_wk + (size_t)l * 2048 * 64, 64, 64, 2, nullptr, (bf16_t*)(ws + OFF_WCK) + (size_t)l * 128 * 2048, 1024, (j / 16) * 64, (j % 16) * 64, smem); return; }
    j -= 64;
    if (j < 32) transpose_tile(p.cmp_wv + (size_t)l * 2048 * 64, 64, 64, 2, nullptr, (bf16_t*)(ws + OFF_WCV) + (size_t)l * 128 * 2048, 1024, (j / 16) * 64, (j % 16) * 64, smem);
}

#if TS_A >= 0
#define PSTAMP(I) if (blockIdx.x == 0 && threadIdx.x == 0) ((unsigned long long*)(p.ws + 32768))[I] = __builtin_amdgcn_s_memrealtime();
#else
#define PSTAMP(I)
#endif
DEV void phase_prologue(const Params& p, char* smem) {
    {
        unsigned* ctr = (unsigned*)p.ws + 100;
        volatile int* slot = (volatile int*)(smem + 65536 + 64);
        int job = blockIdx.x;
        while (job < J_TOTAL) {
            prologue_job(p, job, smem);
            __syncthreads();
            if (ltid() == 0) *slot = (int)gridDim.x + (int)atomicAdd(ctr, 1u);
            __syncthreads();
            job = __builtin_amdgcn_readfirstlane(*slot);
        }
    }
    PSTAMP(42)
    char* ws = p.ws;
    convert_fp8_stream(p.pu, (unsigned char*)(ws + OFF_PU), 2ull * 16384 * 1024 / 16, kScaleU);
    PSTAMP(43)
    convert_fp8_stream(p.pv, (unsigned char*)(ws + OFF_PV), 2ull * 16384 * 1024 / 16, kScaleV);
    PSTAMP(44)
    for (int l = 0; l < 2; ++l) {
        convert_stream(p.subk1 + (size_t)l * 16384, (bf16_t*)(ws + OFF_SUBK) + (size_t)(l * 2 + 0) * 16384, 16384 / 8);
        convert_stream(p.subk2 + (size_t)l * 16384, (bf16_t*)(ws + OFF_SUBK) + (size_t)(l * 2 + 1) * 16384, 16384 / 8);
    }
}

DEV void phase_norm(const Params& p, int layer, int which) {
    const int tid = ltid(), lane = tid & 63, w = tid >> 6;
    const float* xs = (layer == 0 && which == 0) ? p.x : (const float*)(p.ws + OFF_XRES);
    const float* g = (which == 0 ? p.norm_mix_g : p.norm_ffn_g) + layer * 1024;
    const float* mod = (const float*)(p.ws + OFF_MOD) + (size_t)layer * 8 * 6144;
    bf16_t* h = (bf16_t*)(p.ws + OFF_H);
    float4 g4[4];
#pragma unroll
    for (int i = 0; i < 4; ++i) g4[i] = *(const float4*)(g + i * 256 + lane * 4);
    for (int q0 = blockIdx.x; q0 < kT / 4; q0 += gridDim.x * 4) {
        float4 v[4][4];
#pragma unroll
        for (int u = 0; u < 4; ++u) {
            const int q = q0 + u * gridDim.x < kT / 4 ? q0 + u * gridDim.x : q0;
            const float* xr = xs + (size_t)(q * 4 + w) * 1024;
#pragma unroll
            for (int i = 0; i < 4; ++i) v[u][i] = *(const float4*)(xr + i * 256 + lane * 4);
        }
#pragma unroll
        for (int u = 0; u < 4; ++u) {
            const int q = q0 + u * gridDim.x;
            if (q >= kT / 4) break;
            const int t = q * 4 + w, b = t >> 11;
            float ss = 0.f;
#pragma unroll
            for (int i = 0; i < 4; ++i) ss += v[u][i].x * v[u][i].x + v[u][i].y * v[u][i].y + v[u][i].z * v[u][i].z + v[u][i].w * v[u][i].w;
            ss = wave_sum(ss);
            const float rstd = rsqrtf(ss * (1.f / 1024.f) + kEps);
            const float* sh = mod + (size_t)b * 6144 + (which ? 3072 : 0);
            const float* sc = sh + 1024;
#pragma unroll
            for (int i = 0; i < 4; ++i) {
                const int col = i * 256 + lane * 4;
                const float4 s4 = *(const float4*)(sc + col), h4 = *(const float4*)(sh + col);
                const float o0 = v[u][i].x * rstd * g4[i].x * (1.f + s4.x) + h4.x, o1 = v[u][i].y * rstd * g4[i].y * (1.f + s4.y) + h4.y;
                const float o2 = v[u][i].z * rstd * g4[i].z * (1.f + s4.z) + h4.z, o3 = v[u][i].w * rstd * g4[i].w * (1.f + s4.w) + h4.w;
                uint2 o; o.x = pack2(o0, o1); o.y = pack2(o2, o3);
                *(uint2*)(h + (size_t)t * 1024 + col) = o;
            }
        }
    }
}

DEV void rope8(uint4& x1, uint4& x2, const float (&cc)[8], const float (&ss)[8]) {
    unsigned a[4] = {x1.x, x1.y, x1.z, x1.w}, b[4] = {x2.x, x2.y, x2.z, x2.w};
#pragma unroll
    for (int i = 0; i < 4; ++i) {
        const float a0 = lo16(a[i]), a1 = hi16(a[i]), b0 = lo16(b[i]), b1 = hi16(b[i]);
        const float o10 = a0 * cc[2 * i] - b0 * ss[2 * i], o11 = a1 * cc[2 * i + 1] - b1 * ss[2 * i + 1];
        const float o20 = a0 * ss[2 * i] + b0 * cc[2 * i], o21 = a1 * ss[2 * i + 1] + b1 * cc[2 * i + 1];
        a[i] = pack2(o10, o11); b[i] = pack2(o20, o21);
    }
    x1 = make_uint4(a[0], a[1], a[2], a[3]); x2 = make_uint4(b[0], b[1], b[2], b[3]);
}
DEV void vt_tile(const bf16_t* __restrict__ src, int ld, bf16_t* __restrict__ dst, char* smem) {
    bf16_t* Ls = (bf16_t*)smem;
    const int tid = ltid();
    __syncthreads();
#pragma unroll
    for (int i = 0; i < 2; ++i) {
        const int id = tid + 256 * i, tok = id >> 3, ch = id & 7;
        *(uint4*)(Ls + tok * 72 + ch * 8) = *(const uint4*)(src + (size_t)tok * ld + ch * 8);
    }
    __syncthreads();
#pragma unroll
    for (int i = 0; i < 2; ++i) {
        const int id = tid + 256 * i, d = id & 63, tc = id >> 6;
        unsigned short e[8];
#pragma unroll
        for (int j = 0; j < 8; ++j) e[j] = Ls[(tc * 8 + j) * 72 + d];
        uint4 o;
        o.x = (unsigned)e[0] | ((unsigned)e[1] << 16); o.y = (unsigned)e[2] | ((unsigned)e[3] << 16);
        o.z = (unsigned)e[4] | ((unsigned)e[5] << 16); o.w = (unsigned)e[6] | ((unsigned)e[7] << 16);
        *(uint4*)(dst + (size_t)d * 2048 + tc * 8) = o;
    }
}

DEV void phase_layout1(const Params& p, char* smem) {
    char* ws = p.ws;
    bf16_t* cols = (bf16_t*)(ws + OFF_COLS);
    bf16_t* kc = (bf16_t*)(ws + OFF_KC);
    bf16_t* vc = (bf16_t*)(ws + OFF_VC);
    bf16_t* VT = (bf16_t*)(ws + OFF_VT);
    float* rstd = (float*)(ws + OFF_RSTD);
    const float* rope = (const float*)(ws + OFF_ROPE);
    const float *cos64 = rope, *sin64 = rope + 2048 * 32, *cos32 = rope + 2048 * 64, *sin32 = rope + 2048 * 64 + 2048 * 16;
    const int tid = ltid();
    for (int unit = blockIdx.x; unit < 2 * (kT / 64); unit += gridDim.x) {
        const int tile = unit >> 1, part01 = unit & 1;
        const int T0 = tile * 64, b = T0 >> 11, s0 = T0 & 2047;
        if (part01 == 0) {
            for (int it0 = tid; it0 < 64 * 86; it0 += 1024) {
                uint4 x1[4], x2[4]; float4 cs[4][2], sn[4][2]; bf16_t* p1[4]; bf16_t* p2[4]; bf16_t* kq[4];
#pragma unroll
                for (int u = 0; u < 4; ++u) {
                    const int it = it0 + u * 256 < 64 * 86 ? it0 + u * 256 : it0;
                    const int tok = it / 86, item = it % 86;
                    const int t = T0 + tok, sq = s0 + tok;
                    bf16_t* row = cols + (size_t)t * LDC;
                    kq[u] = nullptr;
                    const float *cp, *sp;
                    if (item < 52) {
                        const int hd = item >> 2, i0 = (item & 3) * 8;
                        const int base = hd < 4 ? 64 * hd : hd == 4 ? 256 : hd == 5 ? 384 : hd == 6 ? 512 : hd < 11 ? 1920 + 64 * (hd - 7) : 2176 + 64 * (hd - 11);
                        p1[u] = row + base + i0; p2[u] = row + base + 32 + i0;
                        cp = cos64 + sq * 32 + i0; sp = sin64 + sq * 32 + i0;
                        if (hd == 4) kq[u] = kc + (size_t)t * 64 + i0;
                    } else {
                        const int it2 = item - 52, sub = it2 >> 1, i0 = (it2 & 1) * 8;
                        const int base = sub < 8 ? 704 + 32 * sub : sub < 16 ? 960 + 32 * (sub - 8) : 1856;
                        p1[u] = row + base + i0; p2[u] = row + base + 16 + i0;
                        cp = cos32 + sq * 16 + i0; sp = sin32 + sq * 16 + i0;
                    }
                    x1[u] = *(const uint4*)p1[u]; x2[u] = *(const uint4*)p2[u];
                    cs[u][0] = *(const float4*)cp; cs[u][1] = *(const float4*)(cp + 4);
                    sn[u][0] = *(const float4*)sp; sn[u][1] = *(const float4*)(sp + 4);
                }
#pragma unroll
                for (int u = 0; u < 4; ++u) {
                    if (it0 + u * 256 >= 64 * 86) break;
                    const float cc[8] = {cs[u][0].x, cs[u][0].y, cs[u][0].z, cs[u][0].w, cs[u][1].x, cs[u][1].y, cs[u][1].z, cs[u][1].w};
                    const float ss[8] = {sn[u][0].x, sn[u][0].y, sn[u][0].z, sn[u][0].w, sn[u][1].x, sn[u][1].y, sn[u][1].z, sn[u][1].w};
                    rope8(x1[u], x2[u], cc, ss);
                    *(uint4*)p1[u] = x1[u]; *(uint4*)p2[u] = x2[u];
                    if (kq[u]) { *(uint4*)kq[u] = x1[u]; *(uint4*)(kq[u] + 32) = x2[u]; }
                }
            }
            {
                const uint4 c0 = *(const uint4*)(cols + (size_t)(T0 + (tid >> 3)) * LDC + 320 + (tid & 7) * 8);
                const uint4 c1 = *(const uint4*)(cols + (size_t)(T0 + 32 + (tid >> 3)) * LDC + 320 + (tid & 7) * 8);
                *(uint4*)(vc + (size_t)(T0 + (tid >> 3)) * 64 + (tid & 7) * 8) = c0;
                *(uint4*)(vc + (size_t)(T0 + 32 + (tid >> 3)) * 64 + (tid & 7) * 8) = c1;
            }
        }
        if (part01 == 0) continue;
        {
            const int tok = tid >> 2, part = tid & 3, t = T0 + tok;
            const bf16_t* src = cols + (size_t)t * LDC + 1472 + (part < 3 ? part : 0) * 128;
            float ss = 0.f;
#pragma unroll 4
            for (int i = 0; i < 16; ++i) {
                const uint4 u = *(const uint4*)(src + i * 8);
                ss += lo16(u.x) * lo16(u.x) + hi16(u.x) * hi16(u.x) + lo16(u.y) * lo16(u.y) + hi16(u.y) * hi16(u.y)
                    + lo16(u.z) * lo16(u.z) + hi16(u.z) * hi16(u.z) + lo16(u.w) * lo16(u.w) + hi16(u.w) * hi16(u.w);
            }
            float vq = part < 2 ? ss : 0.f;
            vq += __shfl_xor(vq, 1, 64);
            if (part == 0) rstd[t] = rsqrtf(vq * (1.f / 256.f) + kEps);
            if (part == 2) rstd[kT + t] = rsqrtf(ss * (1.f / 128.f) + kEps);
        }
#pragma unroll 1
        for (int vh = 0; vh < 8; ++vh) {
            const int col = vh == 0 ? 448 : vh == 1 ? 576 : vh < 6 ? 1216 + 64 * (vh - 2) : 2304 + 64 * (vh - 6);
            vt_tile(cols + (size_t)T0 * LDC + col, LDC, VT + ((size_t)(b * 12 + vh) * 64) * 2048 + s0, smem);
        }
    }
}

DEV void phase_layout2(const Params& p, int layer, char* smem) {
    char* ws = p.ws;
    bf16_t* qmla = (bf16_t*)(ws + OFF_QMLA);
    const bf16_t* kvmla = (const bf16_t*)(ws + OFF_KVMLA);
    bf16_t* VT = (bf16_t*)(ws + OFF_VT);
    const float* rope = (const float*)(ws + OFF_ROPE);
    const float *cos32 = rope + 2048 * 64, *sin32 = rope + 2048 * 64 + 2048 * 16;
    const int tid = ltid();
    for (int tile = blockIdx.x; tile < kT / 64 + 64; tile += gridDim.x) {
        if (tile >= kT / 64) {
            const int idx = (tile - kT / 64) * 2048 + tid * 8;
            const int kv = idx >> 16, m = (idx >> 6) & 1023, n = idx & 63;
            const float* pp = (const float*)(ws + OFF_QP) + ((size_t)(kv * 8) * 1024 + m) * 128 + n;
            const float* bias = (const float*)(ws + OFF_MISC) + (layer * 2 + kv) * 64 + n;
            float4 a = *(const float4*)bias, c = *(const float4*)(bias + 4);
#pragma unroll
            for (int ks = 0; ks < 8; ++ks) {
                const float4 x = *(const float4*)(pp + (size_t)ks * 1024 * 128), y = *(const float4*)(pp + (size_t)ks * 1024 * 128 + 4);
                a.x += x.x; a.y += x.y; a.z += x.z; a.w += x.w; c.x += y.x; c.y += y.y; c.z += y.z; c.w += y.w;
            }
            *(uint4*)((bf16_t*)(ws + OFF_KCMP) + (size_t)kv * 1024 * 64 + m * 64 + n) = make_uint4(pack2(a.x, a.y), pack2(a.z, a.w), pack2(c.x, c.y), pack2(c.z, c.w));
            continue;
        }
        const int T0 = tile * 64, b = T0 >> 11, s0 = T0 & 2047;
        for (int it = tid; it < 64 * 8; it += 256) {
            const int tok = it >> 3, item = it & 7, hd = item >> 1, i0 = (item & 1) * 8;
            const int t = T0 + tok, s = s0 + tok;
            bf16_t* row = qmla + (size_t)t * 384 + hd * 96 + 64;
            uint4 x1 = *(const uint4*)(row + i0), x2 = *(const uint4*)(row + 16 + i0);
            const float* cp = cos32 + s * 16 + i0; const float* sp = sin32 + s * 16 + i0;
            const float4 c0 = *(const float4*)cp, c1 = *(const float4*)(cp + 4), q0 = *(const float4*)sp, q1 = *(const float4*)(sp + 4);
            const float cc[8] = {c0.x, c0.y, c0.z, c0.w, c1.x, c1.y, c1.z, c1.w}, ss[8] = {q0.x, q0.y, q0.z, q0.w, q1.x, q1.y, q1.z, q1.w};
            rope8(x1, x2, cc, ss);
            *(uint4*)(row + i0) = x1; *(uint4*)(row + 16 + i0) = x2;
        }
#pragma unroll 1
        for (int hd = 0; hd < 4; ++hd)
            vt_tile(kvmla + (size_t)T0 * 512 + hd * 128 + 64, 512, VT + ((size_t)(b * 12 + 8 + hd) * 64) * 2048 + s0, smem);
    }
}

constexpr int SM_K = 0;
constexpr int SM_V = 26624;
constexpr int SM_IMP = SM_V + 17408;
constexpr int SM_SEL = SM_IMP + 16896;
constexpr int SM_CTRL = 65536;
constexpr int SM_TOTAL = SM_CTRL + 256 + 512;
constexpr int SM_ATTN_END = SM_SEL + 1024;

struct RangeIter { int cur, end; DEV int next() { return cur < end ? cur++ : -1; } };
struct BitIter { unsigned rem; DEV int next() { if (!rem) return -1; const int k = __ffs((int)rem) - 1; rem &= rem - 1; return k; } };
struct LdRow { const bf16_t* base; int ld;
    DEV uint4 operator()(int kt, int id) const { const int row = id >> 3, part = id & 7; return *(const uint4*)(base + (size_t)(kt * 64 + row) * ld + part * 8); } };
struct LdVT { const bf16_t* base;
    DEV uint4 operator()(int kt, int id) const { const int d = id >> 3, part = id & 7; return *(const uint4*)(base + (size_t)d * 2048 + kt * 64 + part * 8); } };
struct LdMlaK { const bf16_t* kv; const bf16_t* kr;
    DEV uint4 operator()(int kt, int id) const { const int row = id / 12, part = id % 12; const size_t t = (size_t)(kt * 64 + row);
        return part < 8 ? *(const uint4*)(kv + t * 512 + part * 8) : *(const uint4*)(kr + t * LDC + (part - 8) * 8); } };

struct MaskCausal { DEV bool on(int) const { return true; } DEV bool ok(int kc, int d) const { return kc <= d; }
    DEV bool full(int kt, int t0w) const { return kt * 64 + 63 <= t0w; } };
template <int W> struct MaskWin { DEV bool on(int) const { return true; } DEV bool ok(int kc, int d) const { return (kc <= d) && (d - kc < W); }
    DEV bool full(int kt, int t0w) const { return (kt * 64 + 63 <= t0w) && (t0w + 31 - kt * 64 < W); } };
struct MaskSel { unsigned bits, allbits; DEV bool on(int kt) const { return (bits >> kt) & 1u; } DEV bool ok(int kc, int d) const { return kc <= d; }
    DEV bool full(int kt, int t0w) const { return ((allbits >> kt) & 1u) && (kt * 64 + 63 <= t0w); } };
template <int KDIM, int NKS, int NSUB, bool QG, class It, class LK, class LV, class MaskF, class SkipF>
DEV void attn_stream(It it, const LK& ldK, const LV& ldV, const MaskF& maskf, const SkipF& skipf,
                     const bf16x8* qf, f32x16 (&o)[NSUB][2], float (&m)[NSUB], float (&l)[NSUB], float scl, int tq, int t0w, char* smem, int tid, int koff = 0) {
    constexpr int KCH = KDIM / 8, KSTR = KDIM + 8, NKC = (64 * KCH) / 256;
    constexpr int KBUF = 64 * 104, VBUF = 64 * 68;
    bf16_t* Kb = (bf16_t*)(smem + SM_K);
    bf16_t* Vb = (bf16_t*)(smem + SM_V);
    const int lane = tid & 63, ql = lane & 31, hh = lane >> 5;
    const uint4 z4 = make_uint4(0, 0, 0, 0);
    uint4 ak0 = z4, ak1 = z4, ak2 = z4, av0 = z4, av1 = z4, bk0 = z4, bk1 = z4, bk2 = z4, bv0 = z4, bv1 = z4;
    auto loadA = [&](int kt) __attribute__((always_inline)) { ak0 = ldK(kt, tid); ak1 = ldK(kt, tid + 256); if (NKC == 3) ak2 = ldK(kt, tid + 512); av0 = ldV(kt, tid); av1 = ldV(kt, tid + 256); };
    auto loadB = [&](int kt) __attribute__((always_inline)) { bk0 = ldK(kt, tid); bk1 = ldK(kt, tid + 256); if (NKC == 3) bk2 = ldK(kt, tid + 512); bv0 = ldV(kt, tid); bv1 = ldV(kt, tid + 256); };
    auto stK = [&](bf16_t* kb, const uint4& r, int id) __attribute__((always_inline)) { const int row = id / KCH, part = id % KCH; *(uint4*)(kb + row * KSTR + part * 8) = r; };
    auto stV = [&](bf16_t* vb, const uint4& r, int id) __attribute__((always_inline)) { const int row = id >> 3, part = id & 7; bf16_t* d = vb + row * 68 + part * 8;
        *(uint2*)d = make_uint2(r.x, r.y); *(uint2*)(d + 4) = make_uint2(r.z, r.w); };
    auto compute = [&](int kt, const bf16_t* Kt, const bf16_t* Vt) __attribute__((always_inline)) {
        if (skipf(kt)) return;
#pragma unroll
        for (int sub = 0; sub < NSUB; ++sub) {
            const int tqs = tq + (QG ? 32 * sub : 0), t0s = t0w + (QG ? 32 * sub : 0);
            if (QG && kt * 64 > t0s + 31) continue;
            __builtin_amdgcn_sched_barrier(0);
            f32x16 s[2];
#pragma unroll
            for (int i = 0; i < 2; ++i) {
                s[i] = zero16();
#pragma unroll
                for (int ks = 0; ks < NKS; ++ks) {
                    const bf16x8 a = *(const bf16x8*)(Kt + (i * 32 + ql) * KSTR + koff + ((QG ? 0 : sub * NKS) + ks) * 16 + hh * 8);
                    s[i] = mfma32(a, qf[sub * NKS + ks], s[i]);
                }
            }
            float mx = kNeg;
            if (!maskf.full(kt, t0s)) {
                const int dlim = tqs - kt * 64 - 4 * hh;
                const bool on = maskf.on(kt);
#pragma unroll
                for (int i = 0; i < 2; ++i)
#pragma unroll
                    for (int r = 0; r < 16; ++r) {
                        const int kc = i * 32 + (r & 3) + 8 * (r >> 2);
                        s[i][r] = (on && maskf.ok(kc, dlim)) ? s[i][r] : kNeg;
                    }
            }
#pragma unroll
            for (int i = 0; i < 2; ++i)
#pragma unroll
                for (int r = 0; r < 16; ++r) mx = fmaxf(mx, s[i][r]);
            mx = fmaxf(mx, xor32f(mx, lane));
            const float mnew = fmaxf(m[sub], mx);
            const float alpha = __builtin_amdgcn_exp2f((m[sub] - mnew) * scl);
            m[sub] = mnew;
            const float negm = mnew > -1e29f ? -mnew * scl : 0.f;
            float sum = 0.f;
#pragma unroll
            for (int i = 0; i < 2; ++i)
#pragma unroll
                for (int r = 0; r < 16; ++r) { const float pv = __builtin_amdgcn_exp2f(__builtin_fmaf(s[i][r], scl, negm)); s[i][r] = pv; sum += pv; }
            l[sub] = l[sub] * alpha + sum;
            if (__builtin_amdgcn_ballot_w64(alpha != 1.f)) {
#pragma unroll
                for (int dt = 0; dt < 2; ++dt)
#pragma unroll
                    for (int r = 0; r < 16; ++r) o[sub][dt][r] *= alpha;
            }
            __builtin_amdgcn_sched_barrier(0);
#pragma unroll
            for (int ks = 0; ks < 4; ++ks) {
                if (ks == 2) __builtin_amdgcn_sched_barrier(0);
                const int i = ks >> 1, r0 = 8 * (ks & 1);
                uint4 pu;
                pu.x = pack2(s[i][r0 + 0], s[i][r0 + 1]); pu.y = pack2(s[i][r0 + 2], s[i][r0 + 3]);
                pu.z = pack2(s[i][r0 + 4], s[i][r0 + 5]); pu.w = pack2(s[i][r0 + 6], s[i][r0 + 7]);
                const bf16x8 pf = __builtin_bit_cast(bf16x8, pu);
#pragma unroll
                for (int dt = 0; dt < 2; ++dt) {
                    const bf16_t* vp = Vt + (dt * 32 + ql) * 68 + ks * 16 + 4 * hh;
                    const uint2 a0 = *(const uint2*)vp, a1 = *(const uint2*)(vp + 8);
                    const bf16x8 a = __builtin_bit_cast(bf16x8, make_uint4(a0.x, a0.y, a1.x, a1.y));
                    o[sub][dt] = mfma32(a, pf, o[sub][dt]);
                }
            }
        }
    };
    int ka = it.next();
    int kb = ka >= 0 ? it.next() : -1;
    if (ka >= 0) loadA(ka);
    if (kb >= 0) loadB(kb);
    while (ka >= 0) {
        __syncthreads();
        stK(Kb, ak0, tid); stK(Kb, ak1, tid + 256); if (NKC == 3) stK(Kb, ak2, tid + 512);
        stV(Vb, av0, tid); stV(Vb, av1, tid + 256);
        if (kb >= 0) {
            stK(Kb + KBUF, bk0, tid); stK(Kb + KBUF, bk1, tid + 256); if (NKC == 3) stK(Kb + KBUF, bk2, tid + 512);
            stV(Vb + VBUF, bv0, tid); stV(Vb + VBUF, bv1, tid + 256);
        }
        __syncthreads();
        const int na = it.next();
        const int nb = na >= 0 ? it.next() : -1;
        if (na >= 0) loadA(na);
        if (nb >= 0) loadB(nb);
        compute(ka, Kb, Vb);
        if (kb >= 0) compute(kb, Kb + KBUF, Vb + VBUF);
        ka = na; kb = nb;
    }
}

DEV void write_o(const f32x16 (&o)[2], bf16_t* obuf, size_t row, int col0, int hh) {
#pragma unroll
    for (int dt = 0; dt < 2; ++dt)
#pragma unroll
        for (int g = 0; g < 4; ++g) {
            const int d = dt * 32 + 8 * g + 4 * hh;
            uint2 u; u.x = pack2(o[dt][4 * g], o[dt][4 * g + 1]); u.y = pack2(o[dt][4 * g + 2], o[dt][4 * g + 3]);
            *(uint2*)(obuf + row * 1024 + col0 + d) = u;
        }
}
DEV float sigmoidf(float x) { return 1.f / (1.f + __expf(-x)); }

DEV void nsa_item(const Params& p, int layer, int b, int qb, char* smem) {
    int tid = threadIdx.x; asm volatile("" : "+v"(tid));
    const int lane = tid & 63, w = tid >> 6, ql = lane & 31, hh = lane >> 5;
    char* ws = p.ws;
    const bf16_t* cols = (const bf16_t*)(ws + OFF_COLS);
    const bf16_t* VT = (const bf16_t*)(ws + OFF_VT);
    bf16_t* obuf = (bf16_t*)(ws + OFF_O);
    const int t0 = qb * 32, tq = t0 + ql;
    const size_t Tb = (size_t)b * kS;
    const bf16_t* qrow = cols + (Tb + tq) * LDC;
    bf16x8 qf[4];
#pragma unroll
    for (int ks = 0; ks < 4; ++ks) qf[ks] = *(const bf16x8*)(qrow + w * 64 + ks * 16 + hh * 8);
    const float g0 = sigmoidf(bf2f(qrow[640 + w * 3 + 0])), g1 = sigmoidf(bf2f(qrow[640 + w * 3 + 1])), g2 = sigmoidf(bf2f(qrow[640 + w * 3 + 2]));
    const float scl = 0.125f * kLog2e;
    bf16_t* Kc = (bf16_t*)(smem + SM_K);
    bf16_t* Vc = (bf16_t*)(smem + SM_V);
    float* impP = (float*)(smem + SM_IMP);
    unsigned* selm = (unsigned*)(smem + SM_SEL);
    const float* gk = (const float*)(ws + OFF_QP) + (size_t)b * 128 * 128;
    const float* gv = gk + (size_t)1024 * 128;
    const float* bias = (const float*)(ws + OFF_MISC) + layer * 128;
    __syncthreads();
#pragma unroll
    for (int i = 0; i < 4; ++i) {
        const int id = tid + 256 * i, row = id >> 3, part = id & 7;
        const int row1 = row < 127 ? row + 1 : row;
        const float* a = gk + (size_t)row * 128 + part * 8;  const float* a2 = gk + (size_t)row1 * 128 + 64 + part * 8;
        const float* c = gv + (size_t)row * 128 + part * 8;  const float* c2 = gv + (size_t)row1 * 128 + 64 + part * 8;
        const float4 k0 = *(const float4*)a, k1 = *(const float4*)(a + 4), k2 = *(const float4*)a2, k3 = *(const float4*)(a2 + 4);
        const float4 v0 = *(const float4*)c, v1 = *(const float4*)(c + 4), v2 = *(const float4*)c2, v3 = *(const float4*)(c2 + 4);
        const float4 bk0 = *(const float4*)(bias + part * 8), bk1 = *(const float4*)(bias + part * 8 + 4);
        const float4 bv0 = *(const float4*)(bias + 64 + part * 8), bv1 = *(const float4*)(bias + 64 + part * 8 + 4);
        uint4 kk = make_uint4(pack2(k0.x + k2.x + bk0.x, k0.y + k2.y + bk0.y), pack2(k0.z + k2.z + bk0.z, k0.w + k2.w + bk0.w),
                              pack2(k1.x + k3.x + bk1.x, k1.y + k3.y + bk1.y), pack2(k1.z + k3.z + bk1.z, k1.w + k3.w + bk1.w));
        uint4 vv = make_uint4(pack2(v0.x + v2.x + bv0.x, v0.y + v2.y + bv0.y), pack2(v0.z + v2.z + bv0.z, v0.w + v2.w + bv0.w),
                              pack2(v1.x + v3.x + bv1.x, v1.y + v3.y + bv1.y), pack2(v1.z + v3.z + bv1.z, v1.w + v3.w + bv1.w));
        if (row == 127) { kk = make_uint4(0, 0, 0, 0); vv = kk; }
        *(uint4*)(Kc + row * 72 + part * 8) = kk;
        const unsigned u[4] = {vv.x, vv.y, vv.z, vv.w};
#pragma unroll
        for (int j = 0; j < 4; ++j) { Vc[(part * 8 + 2 * j) * 132 + row] = (bf16_t)(u[j] & 0xffffu); Vc[(part * 8 + 2 * j + 1) * 132 + row] = (bf16_t)(u[j] >> 16); }
    }
    __syncthreads();
    unsigned ocp[16];
    float* invs = (float*)(smem + SM_SEL) + 64;
    {
        const int cmaxv = tq >= 31 ? min((tq - 31) >> 4, 126) : -1;
        float mx = kNeg;
#pragma unroll 1
        for (int i = 0; i < 4; ++i) {
            f32x16 s = zero16();
#pragma unroll
            for (int ks = 0; ks < 4; ++ks) s = mfma32(*(const bf16x8*)(Kc + (i * 32 + ql) * 72 + ks * 16 + hh * 8), qf[ks], s);
            const int clim = cmaxv - i * 32 - 4 * hh;
#pragma unroll
            for (int r = 0; r < 16; ++r) {
                const int kc = (r & 3) + 8 * (r >> 2);
                const bool valid = (kc <= clim);
                mx = fmaxf(mx, valid ? s[r] * scl : kNeg);
            }
        }
        mx = fmaxf(mx, xor32f(mx, lane));
        f32x16 ocmp[2]; ocmp[0] = zero16(); ocmp[1] = zero16();
        float sum = 0.f, carprev = 0.f;
#pragma unroll 1
        for (int i = 0; i < 4; ++i) {
            f32x16 s = zero16();
#pragma unroll
            for (int ks = 0; ks < 4; ++ks) s = mfma32(*(const bf16x8*)(Kc + (i * 32 + ql) * 72 + ks * 16 + hh * 8), qf[ks], s);
            const int clim = cmaxv - i * 32 - 4 * hh;
#pragma unroll
            for (int r = 0; r < 16; ++r) {
                const int kc = (r & 3) + 8 * (r >> 2);
                const bool valid = (kc <= clim);
                const float pv = valid ? __builtin_amdgcn_exp2f(s[r] * scl - mx) : 0.f;
                s[r] = pv; sum += pv;
            }
            float own[4], car[4];
#pragma unroll
            for (int g = 0; g < 4; ++g) { own[g] = s[4 * g] + s[4 * g + 1] + s[4 * g + 2] + 0.5f * s[4 * g + 3]; car[g] = 0.5f * s[4 * g + 3]; }
#pragma unroll
            for (int g = 0; g < 4; ++g) {
                const float send = hh ? (g ? car[g > 0 ? g - 1 : 0] : carprev) : car[g];
                own[g] += xor32f(send, lane);
            }
            carprev = car[3];
#pragma unroll
            for (int g = 0; g < 4; ++g) impP[(w * 32 + ql) * 33 + 2 * (4 * i + g) + hh] = own[g];
#pragma unroll
            for (int sp = 0; sp < 2; ++sp) {
                const int ks = 2 * i + sp, r0 = 8 * sp;
                uint4 pu;
                pu.x = pack2(s[r0 + 0], s[r0 + 1]); pu.y = pack2(s[r0 + 2], s[r0 + 3]);
                pu.z = pack2(s[r0 + 4], s[r0 + 5]); pu.w = pack2(s[r0 + 6], s[r0 + 7]);
                const bf16x8 pf = __builtin_bit_cast(bf16x8, pu);
#pragma unroll
                for (int dt = 0; dt < 2; ++dt) {
                    const bf16_t* vp = Vc + (dt * 32 + ql) * 132 + ks * 16 + 4 * hh;
                    const uint2 a0 = *(const uint2*)vp, a1 = *(const uint2*)(vp + 8);
                    ocmp[dt] = mfma32(__builtin_bit_cast(bf16x8, make_uint4(a0.x, a0.y, a1.x, a1.y)), pf, ocmp[dt]);
                }
            }
        }
        sum += xor32f(sum, lane);
        const float inv = sum > 0.f ? 1.f / sum : 0.f;
        invs[w * 32 + ql] = inv;
        const float f = g0 * inv;
#pragma unroll
        for (int dt = 0; dt < 2; ++dt)
#pragma unroll
            for (int r = 0; r < 8; ++r) ocp[dt * 8 + r] = pack2(f * ocmp[dt][2 * r], f * ocmp[dt][2 * r + 1]);
    }
    __syncthreads();
    const int qblk = t0 >> 6;
    {
        const int hw = tid >> 5, j = tid & 31;
#pragma unroll 1
        for (int rr = 0; rr < 4; ++rr) {
            const int row = hw * 4 + rr;
            const float v = impP[(0 * 32 + row) * 33 + j] * invs[row] + impP[(1 * 32 + row) * 33 + j] * invs[32 + row]
                          + impP[(2 * 32 + row) * 33 + j] * invs[64 + row] + impP[(3 * 32 + row) * 33 + j] * invs[96 + row];
            bool sel;
            if (qblk < 16) sel = (j <= qblk);
            else {
                const bool cand = (j >= 1) && (j <= qblk - 2);
                const bool forced = (j == 0) || (j == qblk) || (j == qblk - 1);
                int rank = 0;
                for (int j2 = 1; j2 <= qblk - 2; ++j2) {
                    const float v2 = lanef(v, (lane & 32) + j2);
                    rank += (v2 > v || (v2 == v && j2 < j)) ? 1 : 0;
                }
                sel = forced || (cand && rank < 13);
            }
            const unsigned long long bal = __ballot(sel);
            const unsigned mk = (lane & 32) ? (unsigned)(bal >> 32) : (unsigned)bal;
            if (j == 0) selm[row] = mk;
        }
    }
    __syncthreads();
    const unsigned mysel = selm[ql];
    unsigned U = mysel, Uall = mysel;
#pragma unroll
    for (int o = 16; o > 0; o >>= 1) { U |= (unsigned)__builtin_amdgcn_ds_bpermute((lane ^ o) << 2, (int)U); Uall &= (unsigned)__builtin_amdgcn_ds_bpermute((lane ^ o) << 2, (int)Uall); }
    Uall = (unsigned)__builtin_amdgcn_readfirstlane((int)Uall);
    {
        f32x16 o1[1][2]; o1[0][0] = zero16(); o1[0][1] = zero16();
        float m1[1] = {kNeg}, l1[1] = {0.f};
        auto skipf = [&](int) __attribute__((always_inline)) { return false; };
        attn_stream<64, 4, 1, false>(BitIter{U}, LdRow{cols + Tb * LDC + 384, LDC}, LdVT{VT + (size_t)(b * 12 + 0) * 64 * 2048}, MaskSel{mysel, Uall}, skipf, qf, o1, m1, l1, scl, tq, __builtin_amdgcn_readfirstlane(t0), smem, tid);
        const float lt = l1[0] + xor32f(l1[0], lane);
        const float f = g1 / lt;
#pragma unroll
        for (int dt = 0; dt < 2; ++dt)
#pragma unroll
            for (int r = 0; r < 8; ++r) ocp[dt * 8 + r] = pack2(lo16(ocp[dt * 8 + r]) + f * o1[0][dt][2 * r], hi16(ocp[dt * 8 + r]) + f * o1[0][dt][2 * r + 1]);
    }
    {
        f32x16 o1[1][2]; o1[0][0] = zero16(); o1[0][1] = zero16();
        float m1[1] = {kNeg}, l1[1] = {0.f};
        auto skipf = [&](int) __attribute__((always_inline)) { return false; };
        const int lo = t0 >= 511 ? ((t0 - 511) >> 6) : 0;
        attn_stream<64, 4, 1, false>(RangeIter{lo, qblk + 1}, LdRow{cols + Tb * LDC + 512, LDC}, LdVT{VT + (size_t)(b * 12 + 1) * 64 * 2048}, MaskWin<512>{}, skipf, qf, o1, m1, l1, scl, tq, __builtin_amdgcn_readfirstlane(t0), smem, tid);
        const float lt = l1[0] + xor32f(l1[0], lane);
        const float f = g2 / lt;
#pragma unroll
        for (int dt = 0; dt < 2; ++dt)
#pragma unroll
            for (int r = 0; r < 8; ++r) { o1[0][dt][2 * r] = lo16(ocp[dt * 8 + r]) + f * o1[0][dt][2 * r]; o1[0][dt][2 * r + 1] = hi16(ocp[dt * 8 + r]) + f * o1[0][dt][2 * r + 1]; }
        write_o(o1[0], obuf, Tb + tq, w * 64, hh);
    }
}

DEV void diff_item(const Params& p, int layer, int b, int hd, int qc, char* smem) {
    int tid = threadIdx.x; asm volatile("" : "+v"(tid));
    const int lane = tid & 63, w = tid >> 6, ql = lane & 31, hh = lane >> 5;
    const int sub = w & 1, qh = w >> 1;
    char* ws = p.ws;
    const bf16_t* cols = (const bf16_t*)(ws + OFF_COLS);
    const bf16_t* VT = (const bf16_t*)(ws + OFF_VT);
    bf16_t* obuf = (bf16_t*)(ws + OFF_O);
    const float* misc = (const float*)(ws + OFF_MISC);
    const int t0w = qc * 128 + qh * 64, tq = t0w + ql;
    const size_t Tb = (size_t)b * kS;
    bf16x8 qf[4];
#pragma unroll
    for (int g = 0; g < 2; ++g)
#pragma unroll
        for (int ks = 0; ks < 2; ++ks) qf[g * 2 + ks] = *(const bf16x8*)(cols + (Tb + tq + 32 * g) * LDC + 704 + hd * 64 + sub * 32 + ks * 16 + hh * 8);
    const float scl = 0.17677669529663687f * kLog2e;
    f32x16 o2[2][2];
#pragma unroll
    for (int g = 0; g < 2; ++g) { o2[g][0] = zero16(); o2[g][1] = zero16(); }
    float m2[2] = {kNeg, kNeg}, l2[2] = {0.f, 0.f};
    auto skipf = [&](int kt) __attribute__((always_inline)) { return kt * 64 > t0w + 63; };
    attn_stream<64, 2, 2, true>(RangeIter{0, 2 * qc + 2}, LdRow{cols + Tb * LDC + 960 + hd * 64, LDC}, LdVT{VT + (size_t)(b * 12 + 2 + hd) * 64 * 2048}, MaskCausal{}, skipf, qf, o2, m2, l2, scl, tq, __builtin_amdgcn_readfirstlane(t0w), smem, tid, sub * 32);
    const float lam = misc[256 + layer], post = misc[258 + layer];
    float* ex = (float*)smem;
    __syncthreads();
#pragma unroll
    for (int g = 0; g < 2; ++g) {
        const float lt = l2[g] + xor32f(l2[g], lane);
        if (sub == 1) {
            const float f = lam / lt;
#pragma unroll
            for (int dt = 0; dt < 2; ++dt)
#pragma unroll
                for (int r = 0; r < 16; ++r) ex[(((qh * 2 + g) * 2 + dt) * 16 + r) * 64 + lane] = o2[g][dt][r] * f;
        } else {
            const float f = 1.f / lt;
#pragma unroll
            for (int dt = 0; dt < 2; ++dt)
#pragma unroll
                for (int r = 0; r < 16; ++r) o2[g][dt][r] *= f;
        }
    }
    __syncthreads();
    if (sub == 0) {
        const float* sg = p.sub_g + layer * 64;
#pragma unroll
        for (int g = 0; g < 2; ++g) {
            float ss = 0.f;
#pragma unroll
            for (int dt = 0; dt < 2; ++dt)
#pragma unroll
                for (int r = 0; r < 16; ++r) { const float v = o2[g][dt][r] - ex[(((qh * 2 + g) * 2 + dt) * 16 + r) * 64 + lane]; o2[g][dt][r] = v; ss += v * v; }
            ss += xor32f(ss, lane);
            const float rstd = rsqrtf(ss * (1.f / 64.f) + kEps) * post;
#pragma unroll
            for (int dt = 0; dt < 2; ++dt)
#pragma unroll
                for (int r = 0; r < 16; ++r) { const int d = dt * 32 + (r & 3) + 8 * (r >> 2) + 4 * hh; o2[g][dt][r] *= rstd * sg[d]; }
            write_o(o2[g], obuf, Tb + tq + 32 * g, 256 + hd * 64, hh);
        }
    }
}

DEV void mla_item(const Params& p, int b, int hd, int qc, char* smem) {
    int tid = threadIdx.x; asm volatile("" : "+v"(tid));
    const int lane = tid & 63, w = tid >> 6, ql = lane & 31, hh = lane >> 5;
    char* ws = p.ws;
    const bf16_t* cols = (const bf16_t*)(ws + OFF_COLS);
    const bf16_t* VT = (const bf16_t*)(ws + OFF_VT);
    const bf16_t* qmla = (const bf16_t*)(ws + OFF_QMLA);
    const bf16_t* kvmla = (const bf16_t*)(ws + OFF_KVMLA);
    bf16_t* obuf = (bf16_t*)(ws + OFF_O);
    const int t0w = qc * 128 + w * 32, tq = t0w + ql;
    const size_t Tb = (size_t)b * kS;
    const bf16_t* qrow = qmla + (Tb + tq) * 384 + hd * 96;
    bf16x8 qf[6];
#pragma unroll
    for (int ks = 0; ks < 6; ++ks) qf[ks] = *(const bf16x8*)(qrow + ks * 16 + hh * 8);
    const float scl = 0.10206207261596575f * kLog2e;
    f32x16 o1[1][2]; o1[0][0] = zero16(); o1[0][1] = zero16();
    float m1[1] = {kNeg}, l1[1] = {0.f};
    auto skipf = [&](int kt) __attribute__((always_inline)) { return kt * 64 > t0w + 31; };
    attn_stream<96, 6, 1, false>(RangeIter{0, 2 * qc + 2}, LdMlaK{kvmla + Tb * 512 + hd * 128, cols + Tb * LDC + 1856}, LdVT{VT + (size_t)(b * 12 + 8 + hd) * 64 * 2048}, MaskCausal{}, skipf, qf, o1, m1, l1, scl, tq, __builtin_amdgcn_readfirstlane(t0w), smem, tid);
    const float inv = 1.f / (l1[0] + xor32f(l1[0], lane));
#pragma unroll
    for (int dt = 0; dt < 2; ++dt)
#pragma unroll
        for (int r = 0; r < 16; ++r) o1[0][dt][r] *= inv;
    write_o(o1[0], obuf, Tb + tq, 512 + hd * 64, hh);
}

DEV void swa_item(const Params& p, int layer, int b, int g, int q64, char* smem) {
    int tid = threadIdx.x; asm volatile("" : "+v"(tid));
    const int lane = tid & 63, w = tid >> 6, ql = lane & 31, hh = lane >> 5;
    char* ws = p.ws;
    const bf16_t* cols = (const bf16_t*)(ws + OFF_COLS);
    const bf16_t* VT = (const bf16_t*)(ws + OFF_VT);
    bf16_t* obuf = (bf16_t*)(ws + OFF_O);
    const int head = g * 2 + (w & 1);
    const int t0w = q64 * 64 + (w >> 1) * 32, tq = t0w + ql;
    const size_t Tb = (size_t)b * kS;
    const bf16_t* qrow = cols + (Tb + tq) * LDC + 1920 + head * 64;
    bf16x8 qf[4];
#pragma unroll
    for (int ks = 0; ks < 4; ++ks) qf[ks] = *(const bf16x8*)(qrow + ks * 16 + hh * 8);
    const float scl = 0.125f * kLog2e;
    f32x16 o1[1][2]; o1[0][0] = zero16(); o1[0][1] = zero16();
    float m1[1] = {p.sinks[layer * 4 + head] * 8.f}, l1[1] = {hh == 0 ? 1.f : 0.f};
    auto skipf = [&](int kt) __attribute__((always_inline)) { return (kt * 64 > t0w + 31) || (kt * 64 + 63 < t0w - 127); };
    const int lo = q64 >= 2 ? q64 - 2 : 0;
    attn_stream<64, 4, 1, false>(RangeIter{lo, q64 + 1}, LdRow{cols + Tb * LDC + 2176 + g * 64, LDC}, LdVT{VT + (size_t)(b * 12 + 6 + g) * 64 * 2048}, MaskWin<128>{}, skipf, qf, o1, m1, l1, scl, tq, __builtin_amdgcn_readfirstlane(t0w), smem, tid);
    const float inv = 1.f / (l1[0] + xor32f(l1[0], lane));
#pragma unroll
    for (int dt = 0; dt < 2; ++dt)
#pragma unroll
        for (int r = 0; r < 16; ++r) o1[0][dt][r] *= inv;
    write_o(o1[0], obuf, Tb + tq, 768 + head * 64, hh);
}

DEV void phase_attn(const Params& p, int layer, char* smem, int rep = 0) {
    unsigned* ctr = (unsigned*)(p.ws + OFF_CTRL) + 64 + layer * 16 + rep;
    volatile int* slot = (volatile int*)(smem + SM_SEL) + 48;
    for (;;) {
        __syncthreads();
        if (ltid() == 0) *slot = (int)atomicAdd(ctr, 1u);
        __syncthreads();
        const int idx = __builtin_amdgcn_readfirstlane(*slot);
        if (idx >= 2048) break;
        const int level = 15 - (idx >> 7), r = idx & 127;
#if TS_A >= 0
        const unsigned long long tsa = __builtin_amdgcn_s_memrealtime();
#endif
        if (r < 32) { diff_item(p, layer, r >> 2, r & 3, level, smem); }
        else if (r < 64) { const int k = r - 32; mla_item(p, k >> 2, k & 3, level, smem); }
        else if (r < 96) { const int k = r - 64; nsa_item(p, layer, k >> 2, level * 4 + (3 - (k & 3)), smem); }
        else { const int k = r - 96; swa_item(p, layer, k >> 2, (k >> 1) & 1, level * 2 + (k & 1), smem); }
#if TS_A >= 0
        if (threadIdx.x == 0 && layer == 1) {
            const int ty = r >> 5;
            unsigned long long* ts = (unsigned long long*)(p.ws + 32768);
            atomicAdd(&ts[60 + ty], (unsigned long long)(__builtin_amdgcn_s_memrealtime() - tsa));
        }
#endif
    }
}

#define XB_TMO      128
#define XB_XCNT(j)  (256  + 64 * (j))
#define XB_XSUB(j)  (1280 + 64 * (j))
#define XB_XGEN(j)  (2304 + 64 * (j))
#define XB_TOP      3328
#define XB_TOPGEN   3392
#define XB_SPIN_CAP (1u << 22)
DEV unsigned xb_ld(unsigned* p) { return __hip_atomic_load(p, __ATOMIC_RELAXED, __HIP_MEMORY_SCOPE_AGENT); }
DEV unsigned xb_add(unsigned* p, unsigned v) { return __hip_atomic_fetch_add(p, v, __ATOMIC_RELAXED, __HIP_MEMORY_SCOPE_AGENT); }
DEV unsigned xb_xcc_id() { return (unsigned)__builtin_amdgcn_s_getreg((3 << 11) | 20) & 0xFu; }
#define XB_SPIN(cond, bar) do { unsigned _sp = 0; while (cond) { __builtin_amdgcn_s_sleep(1); \
    if ((++_sp & 255u) == 0u) { if (xb_ld(&(bar)[XB_TMO])) break; if (_sp > XB_SPIN_CAP) { atomicAdd(&(bar)[XB_TMO], 1u); break; } } } } while (0)
struct XcdBarrier { unsigned* bar; unsigned x; volatile LAS unsigned* st; };
DEV XcdBarrier xcd_barrier_post(unsigned* bar, volatile LAS unsigned* st) {
    XcdBarrier b; b.bar = bar; b.x = xb_xcc_id(); b.st = st;
    if (threadIdx.x == 0) st[2] = xb_add(&bar[XB_XCNT(b.x)], 1u);
    return b;
}
DEV void xcd_barrier_complete(unsigned* bar, unsigned x, unsigned& nloc, unsigned& nx) {
    const unsigned G = gridDim.x * gridDim.y * gridDim.z;
    unsigned sum, cnt, mine, sp = 0u;
    for (;;) {
        sum = 0u; cnt = 0u; mine = 0u;
#pragma unroll
        for (unsigned j = 0; j < 16; ++j) { const unsigned c = xb_ld(&bar[XB_XCNT(j)]); sum += c; cnt += (c > 0u) ? 1u : 0u; mine = (j == x) ? c : mine; }
        if (sum == G) break;
        __builtin_amdgcn_s_sleep(1);
        if ((++sp & 255u) == 0u) { if (xb_ld(&bar[XB_TMO])) break; if (sp > XB_SPIN_CAP) { atomicAdd(&bar[XB_TMO], 1u); break; } }
    }
    nloc = mine > 0u ? mine : 1u; nx = cnt > 0u ? cnt : 1u;
}
DEV void xcd_barrier(const XcdBarrier& b) {
    asm volatile("s_waitcnt vmcnt(0)" ::: "memory");
    __syncthreads();
    if (threadIdx.x == 0) {
        unsigned* bar = b.bar;
        asm volatile("" : "+v"(bar));
        __builtin_amdgcn_s_waitcnt(0);
        unsigned nloc = b.st[0], nx = b.st[1];
        if (nloc == 0u) { xcd_barrier_complete(bar, b.x, nloc, nx); b.st[0] = nloc; b.st[1] = nx; }
        const unsigned old = xb_add(&bar[XB_XSUB(b.x)], 1u);
        const unsigned gen = old / nloc;
        if (old + 1u == (gen + 1u) * nloc) {
            __builtin_amdgcn_fence(__ATOMIC_RELEASE, "agent");
            asm volatile("s_waitcnt vmcnt(0)" ::: "memory");
            const unsigned og = xb_add(&bar[XB_TOP], 1u);
            const unsigned tg = og / nx;
            if (og + 1u == (tg + 1u) * nx) xb_add(&bar[XB_TOPGEN], 1u);
            else XB_SPIN(xb_ld(&bar[XB_TOPGEN]) == tg, bar);
            __builtin_amdgcn_fence(__ATOMIC_ACQUIRE, "agent");
            xb_add(&bar[XB_XGEN(b.x)], 1u);
            asm volatile("s_waitcnt vmcnt(0)" ::: "memory");
        } else {
            XB_SPIN(xb_ld(&bar[XB_XGEN(b.x)]) == gen, bar);
            __builtin_amdgcn_fence(__ATOMIC_ACQUIRE, "agent");
            asm volatile("s_waitcnt vmcnt(0)" ::: "memory");
        }
    }
    __syncthreads();
}

DEV unsigned fkey(float f) { const unsigned u = __float_as_uint(f); return (u & 0x80000000u) ? ~u : (u | 0x80000000u); }
DEV float funkey(unsigned k) { return __uint_as_float((k & 0x80000000u) ? (k & 0x7fffffffu) : ~k); }
DEV void ins16(unsigned (&L)[16], unsigned x) {
#pragma unroll
    for (int i = 15; i >= 1; --i) { unsigned r; asm("v_med3_u32 %0, %1, %2, %3" : "=v"(r) : "v"(L[i - 1]), "v"(L[i]), "v"(x)); L[i] = r; }
    L[0] = L[0] > x ? L[0] : x;
}
DEV void phase_topk(const Params& p, char* smem) {
    const int tid = ltid();
    const float* S1 = (const float*)(p.ws + OFF_S1);
    const float* S2 = (const float*)(p.ws + OFF_S2);
    int* eid = (int*)(p.ws + OFF_EID);
    float* gate = (float*)(p.ws + OFF_GATE);
    unsigned char* ib = (unsigned char*)smem + tid * 32;
    for (int blk = blockIdx.x; blk < kT * 8 / 256; blk += gridDim.x) {
        const size_t row = (size_t)blk * 256 + tid;
        unsigned L1[16], L2[16];
#pragma unroll
        for (int i = 0; i < 16; ++i) { L1[i] = 0u; L2[i] = 0u; }
#pragma unroll 4
        for (int k = 0; k < 128; ++k) {
            const float a = S1[(size_t)k * (kT * 8) + row], b = S2[(size_t)k * (kT * 8) + row];
            ins16(L1, (fkey(a) & ~127u) | (unsigned)(127 - k));
            ins16(L2, (fkey(b) & ~127u) | (unsigned)(127 - k));
        }
        float v1[16], v2[16];
        __syncthreads();
#pragma unroll
        for (int i = 0; i < 16; ++i) {
            v1[i] = funkey(L1[i] & ~127u); v2[i] = funkey(L2[i] & ~127u);
            ib[i] = (unsigned char)(127u - (L1[i] & 127u)); ib[16 + i] = (unsigned char)(127u - (L2[i] & 127u));
        }
        unsigned C[16];
#pragma unroll
        for (int i = 0; i < 16; ++i) C[i] = 0u;
#pragma unroll
        for (int a = 0; a < 16; ++a)
#pragma unroll
            for (int b = 0; b < 16; ++b)
                if ((a + 1) * (b + 1) <= 16) ins16(C, (fkey(v1[a] + v2[b]) & ~255u) | (unsigned)(255 - (a * 16 + b)));
        float ts[16]; float sum = 0.f;
        const float tmax = funkey(C[0] & ~255u);
#pragma unroll
        for (int i = 0; i < 16; ++i) { ts[i] = __expf(funkey(C[i] & ~255u) - tmax); sum += ts[i]; }
        const float inv = 1.f / sum;
        int ev[16];
#pragma unroll
        for (int i = 0; i < 16; ++i) { const unsigned ci = 255u - (C[i] & 255u); ev[i] = (int)ib[ci >> 4] * 128 + (int)ib[16 + (ci & 15u)]; }
#pragma unroll
        for (int i = 0; i < 4; ++i) {
            *(int4*)(eid + row * 16 + 4 * i) = make_int4(ev[4 * i], ev[4 * i + 1], ev[4 * i + 2], ev[4 * i + 3]);
            *(float4*)(gate + row * 16 + 4 * i) = make_float4(ts[4 * i] * inv, ts[4 * i + 1] * inv, ts[4 * i + 2] * inv, ts[4 * i + 3] * inv);
        }
    }
}

struct EpiTop16 {
    unsigned (&L)[16];
    DEV void tile(int, int, const float* Cs, int tid) const {
        const int r = tid & 127, hk = tid >> 7;
        unsigned T[16];
#pragma unroll
        for (int i = 0; i < 16; ++i) T[i] = 0u;
#pragma unroll 4
        for (int k = 0; k < 64; ++k) {
            const int key = hk * 64 + k;
            ins16(T, (fkey(Cs[key * 128 + r]) & ~127u) | (unsigned)(127 - key));
        }
        __syncthreads();
        unsigned* X = (unsigned*)Cs;
        if (hk) {
#pragma unroll
            for (int i = 0; i < 16; ++i) X[r * 17 + i] = T[i];
        }
        __syncthreads();
        if (!hk) {
#pragma unroll
            for (int i = 0; i < 16; ++i) ins16(T, X[r * 17 + i]);
        }
#pragma unroll
        for (int i = 0; i < 16; ++i) L[i] = T[i];
    }
};
DEV void phase_route(const Params& p, int layer, char* smem) {
    char* ws = p.ws;
    int* eid = (int*)(ws + OFF_EID);
    float* gate = (float*)(ws + OFF_GATE);
    const bf16_t* qp = (const bf16_t*)(ws + OFF_QP);
    const bf16_t* subk = (const bf16_t*)(ws + OFF_SUBK) + (size_t)(layer * 2) * 16384;
    for (int nt = blockIdx.x; nt < kT * 8 / 128; nt += gridDim.x) {
        unsigned L1[16], L2[16];
        { EpiTop16 e1{L1}; gemm_tile(subk, 128, qp, 256, 128, 0, nt * 128, smem, e1); }
        { EpiTop16 e2{L2}; gemm_tile(subk + 16384, 128, qp + 128, 256, 128, 0, nt * 128, smem, e2); }
        const int tid = ltid();
        __syncthreads();
        if (tid < 128) {
            const size_t row = (size_t)nt * 128 + tid;
            unsigned char* ib = (unsigned char*)smem + tid * 32;
            float v1[16], v2[16];
#pragma unroll
            for (int i = 0; i < 16; ++i) {
                v1[i] = funkey(L1[i] & ~127u); v2[i] = funkey(L2[i] & ~127u);
                ib[i] = (unsigned char)(127u - (L1[i] & 127u)); ib[16 + i] = (unsigned char)(127u - (L2[i] & 127u));
            }
            unsigned C[16];
#pragma unroll
            for (int i = 0; i < 16; ++i) C[i] = 0u;
#pragma unroll
            for (int a = 0; a < 16; ++a)
#pragma unroll
                for (int b = 0; b < 16; ++b)
                    if ((a + 1) * (b + 1) <= 16) ins16(C, (fkey(v1[a] + v2[b]) & ~255u) | (unsigned)(255 - (a * 16 + b)));
            float ts[16]; float sum = 0.f;
            const float tmax = funkey(C[0] & ~255u);
#pragma unroll
            for (int i = 0; i < 16; ++i) { ts[i] = __expf(funkey(C[i] & ~255u) - tmax); sum += ts[i]; }
            const float inv = 1.f / sum;
            int ev[16];
#pragma unroll
            for (int i = 0; i < 16; ++i) { const unsigned ci = 255u - (C[i] & 255u); ev[i] = (int)ib[ci >> 4] * 128 + (int)ib[16 + (ci & 15u)]; }
#pragma unroll
            for (int i = 0; i < 4; ++i) {
                *(int4*)(eid + row * 16 + 4 * i) = make_int4(ev[4 * i], ev[4 * i + 1], ev[4 * i + 2], ev[4 * i + 3]);
                *(float4*)(gate + row * 16 + 4 * i) = make_float4(ts[4 * i] * inv, ts[4 * i + 1] * inv, ts[4 * i + 2] * inv, ts[4 * i + 3] * inv);
            }
        }
    }
}

DEV float row_sum_dpp(float v) {
    v += __int_as_float(__builtin_amdgcn_update_dpp(0, __float_as_int(v), 0xB1, 0xF, 0xF, true));
    v += __int_as_float(__builtin_amdgcn_update_dpp(0, __float_as_int(v), 0x4E, 0xF, 0xF, true));
    v += __int_as_float(__builtin_amdgcn_update_dpp(0, __float_as_int(v), 0x141, 0xF, 0xF, true));
    v += __int_as_float(__builtin_amdgcn_update_dpp(0, __float_as_int(v), 0x140, 0xF, 0xF, true));
    return v;
}
DEV float wave_sum_dpp(float v) {
    v = row_sum_dpp(v);
    const float r0 = __int_as_float(__builtin_amdgcn_readlane(__float_as_int(v), 0)), r1 = __int_as_float(__builtin_amdgcn_readlane(__float_as_int(v), 16));
    const float r2 = __int_as_float(__builtin_amdgcn_readlane(__float_as_int(v), 32)), r3 = __int_as_float(__builtin_amdgcn_readlane(__float_as_int(v), 48));
    return (r0 + r1) + (r2 + r3);
}
typedef float f32x2 __attribute__((ext_vector_type(2)));
typedef float f32x4 __attribute__((ext_vector_type(4)));

struct SliceMap { int virt, nx, nloc, rank; };
DEV SliceMap slice_map(const Params& p, char* smem) {
    unsigned* bar = (unsigned*)p.ws;
    const unsigned x = xb_xcc_id();
    int virt = 0, nx = 0, nloc = 1;
#pragma unroll
    for (unsigned j = 0; j < 16; ++j) {
        const unsigned c = xb_ld(&bar[XB_XCNT(j)]);
        if (c > 0u) { if (j < x) ++virt; ++nx; }
        if (j == x) nloc = (int)c;
    }
    SliceMap m;
    m.virt = __builtin_amdgcn_readfirstlane(virt); m.nx = __builtin_amdgcn_readfirstlane(nx > 0 ? nx : 1); m.nloc = __builtin_amdgcn_readfirstlane(nloc > 0 ? nloc : 1);
    m.rank = __builtin_amdgcn_readfirstlane((int)((volatile LAS unsigned*)(smem + SM_CTRL))[2]);
    return m;
}

typedef _Float16 half2_t __attribute__((ext_vector_type(2)));
DEV void phase_peer_u(const Params& p, int layer, char* smem, int rep = 0) {
    const int tid = ltid(), lane = tid & 63, w = tid >> 6, l8 = lane & 7, grp = lane >> 3;
    char* ws = p.ws;
    const SliceMap sm = slice_map(p, smem);
    const bf16_t* h = (const bf16_t*)(ws + OFF_H);
    const int* eid = (const int*)(ws + OFF_EID);
    float* part = (float*)(ws + OFF_S1) + (rep ? (size_t)8 * kT * 128 : 0);
    int* ids_l = (int*)(smem + w * 9216);
    const int nk = sm.rank < 512 ? (512 - sm.rank + sm.nloc - 1) / sm.nloc : 0;
    for (int s = sm.virt; s < 8; s += sm.nx) {
        if (nk == 0) break;
        const unsigned char* U = (const unsigned char*)(ws + OFF_PU) + (((size_t)layer * 8 + s) * 16384 << 7) + l8 * 16;
        uint4 ri0, ri1, ri2, ri3, rh0, rh1;
        auto load_oct = [&](int k) __attribute__((always_inline)) {
            const size_t o = (size_t)(sm.rank + k * sm.nloc) * 4 + w;
            const uint4* ip = (const uint4*)(eid + o * 1024) + lane;
            ri0 = ip[0]; ri1 = ip[64]; ri2 = ip[128]; ri3 = ip[192];
            const bf16_t* hp = h + (o * 8 + grp) * 1024 + s * 128 + l8 * 16;
            rh0 = *(const uint4*)hp; rh1 = *(const uint4*)(hp + 8);
        };
        half2_t hh[8];
        auto store_oct = [&]() __attribute__((always_inline)) {
            uint4* il = (uint4*)ids_l + lane;
            il[0] = ri0; il[64] = ri1; il[128] = ri2; il[192] = ri3;
            const unsigned hu[8] = {rh0.x, rh0.y, rh0.z, rh0.w, rh1.x, rh1.y, rh1.z, rh1.w};
#pragma unroll
            for (int i = 0; i < 8; ++i) hh[i] = (half2_t){(_Float16)lo16(hu[i]), (_Float16)hi16(hu[i])};
        };
        load_oct(0); store_oct();
#pragma unroll 1
        for (int k = 0; k < nk; ++k) {
            if (k + 1 < nk) load_oct(k + 1);
            const size_t o = (size_t)(sm.rank + k * sm.nloc) * 4 + w;
            float* pp = part + ((size_t)s * kT + o * 8 + grp) * 128 + l8;
            uint4 va[8], vb[8];
            auto issue = [&](uint4 (&v)[8], int c) __attribute__((always_inline)) {
                const int4 i0 = *(const int4*)(ids_l + grp * 128 + c * 8), i1 = *(const int4*)(ids_l + grp * 128 + c * 8 + 4);
                const int e[8] = {i0.x, i0.y, i0.z, i0.w, i1.x, i1.y, i1.z, i1.w};
#pragma unroll
                for (int j = 0; j < 8; ++j) v[j] = *(const uint4*)(U + ((size_t)e[j] << 7));
            };
            auto compute = [&](const uint4 (&v)[8], int c) __attribute__((always_inline)) {
                float res = 0.f;
#pragma unroll
                for (int j = 0; j < 8; ++j) {
                    const unsigned d[4] = {v[j].x, v[j].y, v[j].z, v[j].w};
                    float acc = 0.f;
#pragma unroll
                    for (int q = 0; q < 4; ++q) {
                        const half2_t lo = __builtin_amdgcn_cvt_scalef32_pk_f16_fp8(d[q], 1.0f, false);
                        const half2_t hi = __builtin_amdgcn_cvt_scalef32_pk_f16_fp8(d[q], 1.0f, true);
                        acc = __builtin_amdgcn_fdot2(lo, hh[2 * q], acc, false);
                        acc = __builtin_amdgcn_fdot2(hi, hh[2 * q + 1], acc, false);
                    }
                    acc += __int_as_float(__builtin_amdgcn_update_dpp(0, __float_as_int(acc), 0xB1, 0xF, 0xF, true));
                    acc += __int_as_float(__builtin_amdgcn_update_dpp(0, __float_as_int(acc), 0x4E, 0xF, 0xF, true));
                    acc += __int_as_float(__builtin_amdgcn_update_dpp(0, __float_as_int(acc), 0x141, 0xF, 0xF, true));
                    res = (l8 == j) ? acc : res;
                    __builtin_amdgcn_sched_barrier(0);
                }
                pp[c * 8] = res;
            };
            issue(va, 0);
#pragma unroll
            for (int c = 0; c < 16; c += 2) {
                issue(vb, c + 1);
                __builtin_amdgcn_sched_barrier(0);
                compute(va, c);
                __builtin_amdgcn_sched_barrier(0);
                if (c + 2 < 16) issue(va, c + 2);
                __builtin_amdgcn_sched_barrier(0);
                compute(vb, c + 1);
                __builtin_amdgcn_sched_barrier(0);
            }
            if (k + 1 < nk) store_oct();
        }
    }
}

DEV void phase_peer_comb(const Params& p, int rep = 0) {
    const int tid = ltid();
    const float* part = (const float*)(p.ws + OFF_S1);
    float* gate = (float*)(p.ws + OFF_GATE);
    for (size_t i = (size_t)blockIdx.x * 256 + tid; i < (size_t)kT * 128 / 4; i += (size_t)gridDim.x * 256) {
        float4 a = *(const float4*)(part + i * 4);
#pragma unroll
        for (int x = 1; x < 8; ++x) { const float4 b = *(const float4*)(part + (size_t)x * kT * 128 + i * 4); a.x += b.x; a.y += b.y; a.z += b.z; a.w += b.w; }
        const float4 g = *(const float4*)(gate + i * 4);
        float4 o;
        o.x = g.x * gelu_tanh(a.x * (1.f / kScaleU)); o.y = g.y * gelu_tanh(a.y * (1.f / kScaleU));
        o.z = g.z * gelu_tanh(a.z * (1.f / kScaleU)); o.w = g.w * gelu_tanh(a.w * (1.f / kScaleU));
        if (rep == 0) *(float4*)(gate + i * 4) = o;
    }
}

DEV void phase_peer_v(const Params& p, int layer, char* smem, int rep = 0) {
    const int tid = ltid(), lane = tid & 63, w = tid >> 6, l8 = lane & 7, grp = lane >> 3;
    char* ws = p.ws;
    const SliceMap sm = slice_map(p, smem);
    float* xres = (float*)(ws + OFF_XRES);
    const int* eid = (const int*)(ws + OFF_EID);
    const float* wbuf = (const float*)(ws + OFF_GATE);
    const float* mod = (const float*)(ws + OFF_MOD);
    int* ids_l = (int*)(smem + w * 9216);
    float* w_l = (float*)(smem + w * 9216 + 4096);
    const int nk = sm.rank < 512 ? (512 - sm.rank + sm.nloc - 1) / sm.nloc : 0;
    for (int s = sm.virt; s < 8; s += sm.nx) {
        if (nk == 0) break;
        const unsigned char* V = (const unsigned char*)(ws + OFF_PV) + (((size_t)layer * 8 + s) * 16384 << 7) + l8 * 16;
        uint4 ri0, ri1, ri2, ri3, rw0, rw1, rw2, rw3;
        auto load_oct = [&](int k) __attribute__((always_inline)) {
            const size_t o = (size_t)(sm.rank + k * sm.nloc) * 4 + w;
            const uint4* ip = (const uint4*)(eid + o * 1024) + lane;
            const uint4* wp = (const uint4*)(wbuf + o * 1024) + lane;
            ri0 = ip[0]; ri1 = ip[64]; ri2 = ip[128]; ri3 = ip[192];
            rw0 = wp[0]; rw1 = wp[64]; rw2 = wp[128]; rw3 = wp[192];
        };
        auto store_oct = [&]() __attribute__((always_inline)) {
            uint4* il = (uint4*)ids_l + lane; uint4* wl = (uint4*)w_l + lane;
            il[0] = ri0; il[64] = ri1; il[128] = ri2; il[192] = ri3;
            wl[0] = rw0; wl[64] = rw1; wl[128] = rw2; wl[192] = rw3;
        };
        load_oct(0); store_oct();
#pragma unroll 1
        for (int k = 0; k < nk; ++k) {
            if (k + 1 < nk) load_oct(k + 1);
            const size_t o = (size_t)(sm.rank + k * sm.nloc) * 4 + w;
            const size_t t = o * 8 + grp;
            const int b = (int)(t >> 11);
            float* xp = xres + t * 1024 + s * 128 + l8 * 16;
            const float* g2 = mod + (size_t)(layer * 8 + b) * 6144 + 5120 + s * 128 + l8 * 16;
            float4 xa[4];
#pragma unroll
            for (int c = 0; c < 4; ++c) xa[c] = *(const float4*)(xp + c * 4);
            half2_t out[8];
#pragma unroll
            for (int j = 0; j < 8; ++j) out[j] = (half2_t){(_Float16)0.f, (_Float16)0.f};
            uint4 va[8], vb[8];
            auto issue = [&](uint4 (&v)[8], int c) __attribute__((always_inline)) {
                const int4 i0 = *(const int4*)(ids_l + grp * 128 + c * 8), i1 = *(const int4*)(ids_l + grp * 128 + c * 8 + 4);
                const int e[8] = {i0.x, i0.y, i0.z, i0.w, i1.x, i1.y, i1.z, i1.w};
#pragma unroll
                for (int j = 0; j < 8; ++j) v[j] = *(const uint4*)(V + ((size_t)e[j] << 7));
            };
            auto compute = [&](const uint4 (&v)[8], int c) __attribute__((always_inline)) {
                const float4 w0 = *(const float4*)(w_l + grp * 128 + c * 8), w1 = *(const float4*)(w_l + grp * 128 + c * 8 + 4);
                const float wf[8] = {w0.x, w0.y, w0.z, w0.w, w1.x, w1.y, w1.z, w1.w};
#pragma unroll
                for (int j = 0; j < 8; ++j) {
                    const _Float16 wh = (_Float16)wf[j];
                    const half2_t ww = {wh, wh};
                    const unsigned d[4] = {v[j].x, v[j].y, v[j].z, v[j].w};
#pragma unroll
                    for (int q = 0; q < 4; ++q) {
                        const half2_t lo = __builtin_amdgcn_cvt_scalef32_pk_f16_fp8(d[q], 1.0f, false);
                        const half2_t hi = __builtin_amdgcn_cvt_scalef32_pk_f16_fp8(d[q], 1.0f, true);
                        out[2 * q] = __builtin_elementwise_fma(ww, lo, out[2 * q]);
                        out[2 * q + 1] = __builtin_elementwise_fma(ww, hi, out[2 * q + 1]);
                    }
                    __builtin_amdgcn_sched_barrier(0);
                }
            };
            issue(va, 0);
#pragma unroll
            for (int c = 0; c < 16; c += 2) {
                issue(vb, c + 1);
                __builtin_amdgcn_sched_barrier(0);
                compute(va, c);
                __builtin_amdgcn_sched_barrier(0);
                if (c + 2 < 16) issue(va, c + 2);
                __builtin_amdgcn_sched_barrier(0);
                compute(vb, c + 1);
                __builtin_amdgcn_sched_barrier(0);
            }
            if (rep == 0 || (float)out[0].x == 12345.678f) {
#pragma unroll
                for (int c = 0; c < 4; ++c) {
                    const float4 g4 = *(const float4*)(g2 + c * 4);
                    xa[c].x += g4.x * (float)out[2 * c].x * (1.f / kScaleV); xa[c].y += g4.y * (float)out[2 * c].y * (1.f / kScaleV);
                    xa[c].z += g4.z * (float)out[2 * c + 1].x * (1.f / kScaleV); xa[c].w += g4.w * (float)out[2 * c + 1].y * (1.f / kScaleV);
                    *(float4*)(xp + c * 4) = xa[c];
                }
            }
            if (k + 1 < nk) store_oct();
        }
    }
}

DEV void phase_final(const Params& p) {
    const int tid = ltid(), lane = tid & 63, w = tid >> 6;
    const float* xs = (const float*)(p.ws + OFF_XRES);
    float4 g4[4];
#pragma unroll
    for (int i = 0; i < 4; ++i) g4[i] = *(const float4*)(p.final_g + i * 256 + lane * 4);
    for (int q0 = blockIdx.x; q0 < kT / 4; q0 += gridDim.x * 4) {
        float4 v[4][4];
#pragma unroll
        for (int u = 0; u < 4; ++u) {
            const int q = q0 + u * gridDim.x < kT / 4 ? q0 + u * gridDim.x : q0;
            const float* xr = xs + (size_t)(q * 4 + w) * 1024;
#pragma unroll
            for (int i = 0; i < 4; ++i) v[u][i] = *(const float4*)(xr + i * 256 + lane * 4);
        }
#pragma unroll
        for (int u = 0; u < 4; ++u) {
            const int q = q0 + u * gridDim.x;
            if (q >= kT / 4) break;
            const int t = q * 4 + w;
            float ss = 0.f;
#pragma unroll
            for (int i = 0; i < 4; ++i) ss += v[u][i].x * v[u][i].x + v[u][i].y * v[u][i].y + v[u][i].z * v[u][i].z + v[u][i].w * v[u][i].w;
            ss = wave_sum(ss);
            const float rstd = rsqrtf(ss * (1.f / 1024.f) + kEps);
#pragma unroll
            for (int i = 0; i < 4; ++i) {
                const int col = i * 256 + lane * 4;
                *(float4*)(p.out + (size_t)t * 1024 + col) = make_float4(v[u][i].x * rstd * g4[i].x, v[u][i].y * rstd * g4[i].y, v[u][i].z * rstd * g4[i].z, v[u][i].w * rstd * g4[i].w);
            }
        }
    }
}

DEV uint4 pack8f(const float (&e)[8]) { return make_uint4(pack2(e[0], e[1]), pack2(e[2], e[3]), pack2(e[4], e[5]), pack2(e[6], e[7])); }
DEV float4 rope4(float4 v, int lane, bool is64, bool low, float4 c, float4 sn) {
    const int pl = (lane ^ (is64 ? 8 : 4)) << 2;
    float4 o;
    o.x = __int_as_float(__builtin_amdgcn_ds_bpermute(pl, __float_as_int(v.x))); o.y = __int_as_float(__builtin_amdgcn_ds_bpermute(pl, __float_as_int(v.y)));
    o.z = __int_as_float(__builtin_amdgcn_ds_bpermute(pl, __float_as_int(v.z))); o.w = __int_as_float(__builtin_amdgcn_ds_bpermute(pl, __float_as_int(v.w)));
    float4 r;
    r.x = v.x * c.x + (low ? -o.x : o.x) * sn.x; r.y = v.y * c.y + (low ? -o.y : o.y) * sn.y;
    r.z = v.z * c.z + (low ? -o.z : o.z) * sn.z; r.w = v.w * c.w + (low ? -o.w : o.w) * sn.w;
    return r;
}
struct EpiIn {
    char* ws;
    DEV void tile(int m0, int n0, const float* Cs, int tid) const {
        const int lane = tid & 63, w = tid >> 6, g16 = lane >> 4, c4 = lane & 15;
        bf16_t* cols = (bf16_t*)(ws + OFF_COLS);
        bf16_t* VT = (bf16_t*)(ws + OFF_VT);
        const float* rope = (const float*)(ws + OFF_ROPE);
        const float *cos64 = rope, *sin64 = rope + 2048 * 32, *cos32 = rope + 2048 * 64, *sin32 = rope + 2048 * 64 + 2048 * 16;
        const int b = m0 >> 11, s0 = m0 & 2047;
#pragma unroll 1
        for (int h = 0; h < 2; ++h) {
            const int cb = n0 + 64 * h;
            int vh = -1;
            if (cb == 448) vh = 0; else if (cb == 576) vh = 1; else if (cb >= 1216 && cb < 1472) vh = 2 + ((cb - 1216) >> 6); else if (cb >= 2304) vh = 6 + ((cb - 2304) >> 6);
            if (vh >= 0) {
                bf16_t* dst = VT + ((size_t)(b * 12 + vh) * 64 + lane) * 2048 + s0;
#pragma unroll
                for (int q = 0; q < 4; ++q) {
                    const int tc = w + 4 * q;
                    float e[8];
#pragma unroll
                    for (int j = 0; j < 8; ++j) e[j] = Cs[(tc * 8 + j) * 128 + h * 64 + lane];
                    *(uint4*)(dst + tc * 8) = pack8f(e);
                }
                continue;
            }
            const bool r64 = cb < 320 || cb == 384 || cb == 512 || (cb >= 1920 && cb < 2304);
            const bool r32 = (cb >= 704 && cb < 1216) || cb == 1856;
            bf16_t* dbase; int dld;
            if (cb == 256) { dbase = (bf16_t*)(ws + OFF_KC); dld = 64; } else if (cb == 320) { dbase = (bf16_t*)(ws + OFF_VC); dld = 64; } else { dbase = cols + cb; dld = LDC; }
            float4 cc[8], sn[8];
            if (r64 || r32) {
                const int i = (c4 * 4) & (r64 ? 31 : 15);
#pragma unroll
                for (int it = 0; it < 8; ++it) {
                    const int sq = s0 + it * 16 + w * 4 + g16;
                    cc[it] = *(const float4*)((r64 ? cos64 + sq * 32 : cos32 + sq * 16) + i);
                    sn[it] = *(const float4*)((r64 ? sin64 + sq * 32 : sin32 + sq * 16) + i);
                }
            }
#pragma unroll
            for (int it = 0; it < 8; ++it) {
                const int r = it * 16 + w * 4 + g16;
                float4 v = *(const float4*)(Cs + r * 128 + h * 64 + c4 * 4);
                if (r64 || r32) v = rope4(v, lane, r64, !(c4 & (r64 ? 8 : 4)), cc[it], sn[it]);
                *(uint2*)(dbase + (size_t)(m0 + r) * dld + c4 * 4) = make_uint2(pack2(v.x, v.y), pack2(v.z, v.w));
            }
        }
    }
};
DEV void mla_rstd_tile(const bf16_t* src  , int ncols, float* rsl, int tid) {
    const int lane = tid & 63, w = tid >> 6, g16 = lane >> 4, c4 = lane & 15;
#pragma unroll 2
    for (int it = 0; it < 8; ++it) {
        const int r = it * 16 + w * 4 + g16;
        const bf16_t* rp = src + (size_t)r * LDC + c4 * (ncols >> 4);
        float ss = 0.f;
        const uint4 u = *(const uint4*)rp;
        ss += lo16(u.x) * lo16(u.x) + hi16(u.x) * hi16(u.x) + lo16(u.y) * lo16(u.y) + hi16(u.y) * hi16(u.y)
            + lo16(u.z) * lo16(u.z) + hi16(u.z) * hi16(u.z) + lo16(u.w) * lo16(u.w) + hi16(u.w) * hi16(u.w);
        if (ncols == 256) {
            const uint4 u2 = *(const uint4*)(rp + 8);
            ss += lo16(u2.x) * lo16(u2.x) + hi16(u2.x) * hi16(u2.x) + lo16(u2.y) * lo16(u2.y) + hi16(u2.y) * hi16(u2.y)
                + lo16(u2.z) * lo16(u2.z) + hi16(u2.z) * hi16(u2.z) + lo16(u2.w) * lo16(u2.w) + hi16(u2.w) * hi16(u2.w);
        }
        ss = row_sum_dpp(ss);
        if (c4 == 0) rsl[r] = rsqrtf(ss / (float)ncols + kEps);
    }
}
struct EpiMlaQ {
    char* ws; const float* rsl;
    DEV void tile(int m0, int n0, const float* Cs, int tid) const {
        const int lane = tid & 63, w = tid >> 6, g16 = lane >> 4, c4 = lane & 15;
        bf16_t* qmla = (bf16_t*)(ws + OFF_QMLA);
        const float* rope = (const float*)(ws + OFF_ROPE);
        const float *cos32 = rope + 2048 * 64, *sin32 = rope + 2048 * 64 + 2048 * 16;
        const int s0 = m0 & 2047;
#pragma unroll 1
        for (int h = 0; h < 2; ++h) {
            const int col = n0 + 64 * h + c4 * 4;
            const bool isrope = ((col >> 5) % 3) == 2;
            float4 cc[8], sn[8];
#pragma unroll
            for (int it = 0; it < 8; ++it) {
                const int sq = s0 + it * 16 + w * 4 + g16, i = (c4 * 4) & 15;
                cc[it] = *(const float4*)(cos32 + sq * 16 + i); sn[it] = *(const float4*)(sin32 + sq * 16 + i);
            }
#pragma unroll
            for (int it = 0; it < 8; ++it) {
                const int r = it * 16 + w * 4 + g16;
                float4 v = *(const float4*)(Cs + r * 128 + h * 64 + c4 * 4);
                const float sc = rsl[r];
                v.x *= sc; v.y *= sc; v.z *= sc; v.w *= sc;
                const float4 vr = rope4(v, lane, false, !(c4 & 4), cc[it], sn[it]);
                if (isrope) v = vr;
                *(uint2*)(qmla + (size_t)(m0 + r) * 384 + col) = make_uint2(pack2(v.x, v.y), pack2(v.z, v.w));
            }
        }
    }
};
struct EpiMlaKV {
    char* ws; const float* rsl;
    DEV void tile(int m0, int n0, const float* Cs, int tid) const {
        const int lane = tid & 63, w = tid >> 6, g16 = lane >> 4, c4 = lane & 15;
        bf16_t* kvmla = (bf16_t*)(ws + OFF_KVMLA);
        bf16_t* VT = (bf16_t*)(ws + OFF_VT);
        const int b = m0 >> 11, s0 = m0 & 2047, hd = n0 >> 7;
#pragma unroll 2
        for (int it = 0; it < 8; ++it) {
            const int r = it * 16 + w * 4 + g16;
            float4 v = *(const float4*)(Cs + r * 128 + c4 * 4);
            const float sc = rsl[r];
            *(uint2*)(kvmla + (size_t)(m0 + r) * 512 + n0 + c4 * 4) = make_uint2(pack2(v.x * sc, v.y * sc), pack2(v.z * sc, v.w * sc));
        }
        bf16_t* dst = VT + ((size_t)(b * 12 + 8 + hd) * 64 + lane) * 2048 + s0;
#pragma unroll
        for (int q = 0; q < 4; ++q) {
            const int tc = w + 4 * q;
            float e[8];
#pragma unroll
            for (int j = 0; j < 8; ++j) e[j] = Cs[(tc * 8 + j) * 128 + 64 + lane] * rsl[tc * 8 + j];
            *(uint4*)(dst + tc * 8) = pack8f(e);
        }
    }
};

DEV void phase_gemm_in(const Params& p, int layer, char* smem) {
    char* ws = p.ws;
    EpiIn epi{ws};
    gemm_phase((const bf16_t*)(ws + OFF_H), 1024, (const bf16_t*)(ws + OFF_WIN) + (size_t)layer * 2432 * 1024, 1024, 1024, kT / 128, LDC / 128, smem, epi);
}
DEV void phase_gemm_mid(const Params& p, int layer, char* smem) {
    char* ws = p.ws;
    const float* misc = (const float*)(ws + OFF_MISC);
    const bf16_t* cols = (const bf16_t*)(ws + OFF_COLS);
    float* rsl = (float*)(smem + SM_CTRL + 256);
    const int nb_up = (int)gridDim.x > 32 ? (int)gridDim.x - 16 : (int)gridDim.x;
    for (int tile = ((int)gridDim.x > 32 && blockIdx.x >= 16) ? (int)blockIdx.x : (int)blockIdx.x; tile < 16 + 384 + 512;
         tile = (tile < 16 && (int)gridDim.x > 32) ? 16 + 384 + 512 : tile + nb_up) {
        if (tile < 16) {
            const int kv = tile >> 3, mt = tile & 7;
            EpiF32 epi{(float*)(ws + OFF_QP) + (size_t)kv * 1024 * 128, 128};
            gemm_tile((const bf16_t*)(ws + (kv ? OFF_VC : OFF_KC)), 1024, (const bf16_t*)(ws + (kv ? OFF_WCV : OFF_WCK)) + (size_t)layer * 128 * 2048, 1024, 1024, mt * 128, 0, smem, epi);
        } else if (tile < 16 + 384) {
            const int tt = tile - 16, m0 = (tt / 3) * 128;
            __syncthreads();
            mla_rstd_tile(cols + (size_t)m0 * LDC + 1472, 256, rsl, ltid());
            EpiMlaQ epi{ws, rsl};
            gemm_tile(cols + 1472, LDC, (const bf16_t*)(ws + OFF_WUQ) + (size_t)layer * 384 * 256, 256, 256, m0, (tt % 3) * 128, smem, epi);
        } else {
            const int tt = tile - 16 - 384, m0 = (tt / 4) * 128;
            __syncthreads();
            mla_rstd_tile(cols + (size_t)m0 * LDC + 1728, 128, rsl, ltid());
            EpiMlaKV epi{ws, rsl};
            gemm_tile(cols + 1728, LDC, (const bf16_t*)(ws + OFF_WUKV) + (size_t)layer * 512 * 128, 128, 128, m0, (tt % 4) * 128, smem, epi);
        }
    }
}
DEV void phase_gemm_out(const Params& p, int layer, char* smem) {
    char* ws = p.ws;
    EpiRes epi{layer == 0 ? p.x : (const float*)(ws + OFF_XRES), (float*)(ws + OFF_XRES), (const float*)(ws + OFF_MOD) + (size_t)layer * 8 * 6144 + 2048};
    gemm_phase((const bf16_t*)(ws + OFF_O), 1024, (const bf16_t*)(ws + OFF_WOUT) + (size_t)layer * 1024 * 1024, 1024, 1024, kT / 128, 8, smem, epi);
}
DEV void phase_gemm_wq(const Params& p, int layer, char* smem) {
    char* ws = p.ws;
    EpiBf16 epi{(bf16_t*)(ws + OFF_QP), 2048, nullptr, nullptr, 2048};
    gemm_phase((const bf16_t*)(ws + OFF_H), 1024, (const bf16_t*)(ws + OFF_WQ) + (size_t)layer * 2048 * 1024, 1024, 1024, kT / 128, 16, smem, epi);
}
DEV void phase_scores(const Params& p, int layer, char* smem) {
    char* ws = p.ws;
    for (int tile = blockIdx.x; tile < 2048; tile += gridDim.x) {
        const int c = tile >> 10, nt = tile & 1023;
        EpiF32 epi{(float*)(ws + (c ? OFF_S2 : OFF_S1)), kT * 8};
        gemm_tile((const bf16_t*)(ws + OFF_SUBK) + (size_t)(layer * 2 + c) * 16384, 128, (const bf16_t*)(ws + OFF_QP) + c * 128, 256, 128, 0, nt * 128, smem, epi);
    }
}

constexpr int NPHASE = 16;
DEV void run_phase(const Params& p, int ph, int layer, char* smem, int rep = 0) {
    switch (ph) {
        case 0: phase_prologue(p, smem); break;
        case 1: phase_norm(p, layer, 0); break;
        case 2: phase_gemm_in(p, layer, smem); break;
        case 3: phase_layout1(p, smem); break;
        case 4: phase_gemm_mid(p, layer, smem); break;
        case 5: phase_layout2(p, layer, smem); break;
        case 6: phase_attn(p, layer, smem, rep); break;
        case 7: phase_gemm_out(p, layer, smem); break;
        case 8: phase_norm(p, layer, 1); break;
        case 9: phase_gemm_wq(p, layer, smem); break;
        case 10: phase_route(p, layer, smem); break;
        case 11: phase_topk(p, smem); break;
        case 12: phase_peer_u(p, layer, smem, rep); break;
        case 13: phase_peer_comb(p, rep); break;
        case 14: phase_peer_v(p, layer, smem, rep); break;
        case 15: if (layer == 0) phase_norm(p, 1, 0); else phase_final(p); break;
        default: break;
    }
}

#if !FUSED
template <int PH>
__global__ void __launch_bounds__(256, 2) k_phase(Params p, int layer) {
    __shared__ __attribute__((aligned(16))) char smem[SM_TOTAL];
    run_phase(p, PH, layer, smem);
}
template <int PH> static void launch_phase(const Params& p, int layer, hipStream_t stream) { k_phase<PH><<<512, 256, 0, stream>>>(p, layer); }
static void launch_ph(int ph, const Params& p, int layer, hipStream_t stream) {
    switch (ph) {
        case 0: launch_phase<0>(p, layer, stream); break;
        case 1: launch_phase<1>(p, layer, stream); break;
        case 2: launch_phase<2>(p, layer, stream); break;
        case 3: launch_phase<3>(p, layer, stream); break;
        case 4: launch_phase<4>(p, layer, stream); break;
        case 5: launch_phase<5>(p, layer, stream); break;
        case 6: launch_phase<6>(p, layer, stream); break;
        case 7: launch_phase<7>(p, layer, stream); break;
        case 8: launch_phase<8>(p, layer, stream); break;
        case 9: launch_phase<9>(p, layer, stream); break;
        case 10: launch_phase<10>(p, layer, stream); break;
        case 11: launch_phase<11>(p, layer, stream); break;
        case 12: launch_phase<12>(p, layer, stream); break;
    }
}
#else
#if TS_A >= 0
#define TSTAMP(I) if (blockIdx.x == 0 && threadIdx.x == 0) ((unsigned long long*)(p.ws + 32768))[I] = __builtin_amdgcn_s_memrealtime();
#else
#define TSTAMP(I)
#endif
__global__ void __launch_bounds__(256, 2) k_mega(Params p) {
    extern __shared__ __attribute__((aligned(1024))) char smem[];
    cg::grid_group grid = cg::this_grid();
    volatile LAS unsigned* st = (volatile LAS unsigned*)(smem + SM_CTRL);
    if (threadIdx.x == 0) { st[0] = 0u; st[1] = 0u; st[2] = 0u; }
    __syncthreads();
    const XcdBarrier xb = xcd_barrier_post((unsigned*)p.ws, st);
    TSTAMP(0)
    run_phase(p, 0, 0, smem);
    if (p.out == nullptr) grid.sync();
    xcd_barrier(xb);
    TSTAMP(1)
    run_phase(p, 1, 0, smem);
    xcd_barrier(xb);
    TSTAMP(2)
#define STEP(PH, L) { run_phase(p, PH, L, smem, 0); xcd_barrier(xb); TSTAMP(2 + (L) * 16 + (PH)) }
#define LAYER(L) STEP(2, L) STEP(4, L) STEP(6, L) STEP(7, L) STEP(8, L) STEP(9, L) STEP(10, L) STEP(12, L) STEP(13, L) STEP(14, L)
    LAYER(0)
    STEP(15, 0)
    LAYER(1)
    run_phase(p, 15, 1, smem);
#if TS_A >= 0
    TSTAMP(2 + 16 + 15)
    __syncthreads();
    if (blockIdx.x == 0 && threadIdx.x == 0) {
        const unsigned long long* ts = (const unsigned long long*)(p.ws + 32768);
        p.out[0] += (TS_A == 50) ? (float)ts[TS_B] * (0.01f / 512.f / 10.f) : (float)(ts[TS_B] - ts[TS_A]) * 0.001f;
    }
#endif
}
#endif

extern "C" void kernel_launch(void* const* d_in, const int* in_sizes, int n_in, void* d_out, int out_size, void* d_ws, size_t ws_size, hipStream_t stream) {
    Params p{};
    const float** pp = (const float**)&p;
    for (int i = 0; i < 28; ++i) pp[i] = (const float*)d_in[i];
    p.out = (float*)d_out;
    p.ws = (char*)d_ws;
    if (ws_size < OFF_END) fprintf(stderr, "workspace too small: %zu < %zu\n", ws_size, (size_t)OFF_END);
    (void)hipMemsetAsync(d_ws, 0, 65536, stream);
#if !FUSED
    launch_ph(0, p, 0, stream);
    launch_ph(1, p, 0, stream);
    for (int l = 0; l < 2; ++l)
        for (int ph = 2; ph < NPHASE; ++ph) launch_ph(ph, p, l, stream);
#else
    static int grid_blocks = 0;
    if (!grid_blocks) {
        int dev = 0, cus = 0, per_cu = 0;
        (void)hipGetDevice(&dev);
        (void)hipDeviceGetAttribute(&cus, hipDeviceAttributeMultiprocessorCount, dev);
        (void)hipFuncSetAttribute((const void*)k_mega, hipFuncAttributeMaxDynamicSharedMemorySize, SM_TOTAL);
        (void)hipOccupancyMaxActiveBlocksPerMultiprocessor(&per_cu, (const void*)k_mega, 256, SM_TOTAL);
        if (per_cu > 2) per_cu = 2;
        if (per_cu < 1) per_cu = 1;
        grid_blocks = cus * per_cu;
    }
    void* args[] = {&p};
    hipError_t e = hipLaunchCooperativeKernel((const void*)k_mega, dim3(grid_blocks), dim3(256), args, SM_TOTAL, stream);
    if (e != hipSuccess) fprintf(stderr, "cooperative launch failed: %s (grid %d)\n", hipGetErrorString(e), grid_blocks);
#endif
}
```

```cpp
#include <hip/hip_runtime.h>
#include <hip/hip_cooperative_groups.h>
#include <stdint.h>
#include <stdio.h>
namespace cg = cooperative_groups;

#ifndef FUSED
#define FUSED 1
#endif
#ifndef TS_A
#define TS_A -1
#define TS_B -1
#endif
#ifndef PROBE_PH
#define PROBE_PH -1
#define PROBE_L 1
#define PROBE_REP 0
#endif

#define DEV __device__ __forceinline__
#define LAS __attribute__((address_space(3)))
typedef unsigned short bf16_t;
typedef short bf16x8 __attribute__((ext_vector_type(8)));
typedef float f32x16 __attribute__((ext_vector_type(16)));

constexpr int kB = 8, kS = 2048, kT = kB * kS, kD = 1024, LDC = 2432;
constexpr float kEps = 1e-6f;
constexpr float kNeg = -1e30f;
constexpr float kLog2e = 1.4426950408889634f;
constexpr float kScaleU = 256.f, kScaleV = 32.f;

constexpr size_t OFF_CTRL = 0;
constexpr size_t OFF_MOD  = 65536;
constexpr size_t OFF_ROPE = OFF_MOD + 2ull * 8 * 6144 * 4;
constexpr size_t OFF_MISC = OFF_ROPE + 2048ull * 96 * 4;
constexpr size_t OFF_WIN  = OFF_MISC + 4096;
constexpr size_t OFF_WOUT = OFF_WIN + 2ull * 2432 * 1024 * 2;
constexpr size_t OFF_WQ   = OFF_WOUT + 2ull * 1024 * 1024 * 2;
constexpr size_t OFF_WUQ  = OFF_WQ + 2ull * 2048 * 1024 * 2;
constexpr size_t OFF_WUKV = OFF_WUQ + 2ull * 384 * 256 * 2;
constexpr size_t OFF_WCK  = OFF_WUKV + 2ull * 512 * 128 * 2;
constexpr size_t OFF_WCV  = OFF_WCK + 2ull * 128 * 2048 * 2;
constexpr size_t OFF_SUBK = OFF_WCV + 2ull * 128 * 2048 * 2;
constexpr size_t OFF_PU   = OFF_SUBK + 2ull * 2 * 128 * 128 * 2;
constexpr size_t OFF_PV   = OFF_PU + 2ull * 16384 * 1024;
constexpr size_t OFF_XRES = OFF_PV + 2ull * 16384 * 1024;
constexpr size_t OFF_H    = OFF_XRES + (size_t)kT * 1024 * 4;
constexpr size_t OFF_H8   = OFF_H + (size_t)kT * 1024 * 2;
constexpr size_t OFF_RSTD = OFF_H8 + (size_t)kT * 1024;
constexpr size_t OFF_KCMP = OFF_RSTD + 2ull * kT * 4;
constexpr size_t OFF_EID  = OFF_KCMP + 2ull * 1024 * 64 * 2;
constexpr size_t OFF_GATE = OFF_EID + (size_t)kT * 128 * 4;
constexpr size_t OFF_QP   = OFF_GATE + (size_t)kT * 128 * 4;
constexpr size_t OFF_COLS = OFF_QP + (size_t)kT * 2048 * 2;
constexpr size_t OFF_KC   = OFF_COLS + (size_t)kT * LDC * 2;
constexpr size_t OFF_VC   = OFF_KC + (size_t)(kT + 64) * 64 * 2;
constexpr size_t OFF_VT   = OFF_VC + (size_t)(kT + 64) * 64 * 2;
constexpr size_t OFF_QMLA = OFF_VT + 8ull * 12 * 64 * 2048 * 2;
constexpr size_t OFF_KVMLA = OFF_QMLA + (size_t)kT * 384 * 2;
constexpr size_t OFF_O    = OFF_KVMLA + (size_t)kT * 512 * 2;
constexpr size_t OFF_END  = OFF_O + (size_t)kT * 1024 * 2;
constexpr size_t OFF_S1 = OFF_COLS, OFF_S2 = OFF_COLS + (size_t)kT * 8 * 128 * 4;
static_assert(OFF_S2 + (size_t)kT * 8 * 128 * 4 <= OFF_O, "alias region too small");
static_assert(OFF_END <= (512ull << 20), "workspace too large");

struct Params {
    const float *x, *c, *ada_w, *ada_b, *norm_mix_g, *norm_ffn_g, *w_in, *pos_k, *pos_v, *cmp_wk, *cmp_wv;
    const float *lq1, *lk1, *lq2, *lk2, *sub_g, *mla_qg, *mla_wuq, *mla_kvg, *mla_wukv, *sinks, *w_out;
    const float *w_q, *subk1, *subk2, *pu, *pv, *final_g;
    float* out;
    char* ws;
};

DEV int ltid() { int t = threadIdx.x; asm volatile("" : "+v"(t)); return t; }
DEV float bf2f(bf16_t v) { return __uint_as_float(((unsigned)v) << 16); }
DEV bf16_t f2bf(float f) { unsigned u = __float_as_uint(f); u += 0x7fffu + ((u >> 16) & 1u); return (bf16_t)(u >> 16); }
DEV unsigned pack2(float lo, float hi) { unsigned r; asm("v_cvt_pk_bf16_f32 %0, %1, %2" : "=v"(r) : "v"(lo), "v"(hi)); return r; }
DEV float lo16(unsigned u) { return __uint_as_float(u << 16); }
DEV float hi16(unsigned u) { return __uint_as_float(u & 0xffff0000u); }
DEV float wave_sum(float v) {
#pragma unroll
    for (int o = 32; o > 0; o >>= 1) v += __shfl_xor(v, o, 64);
    return v;
}
DEV float xor32f(float v, int lane) { return __int_as_float(__builtin_amdgcn_ds_bpermute((lane ^ 32) << 2, __float_as_int(v))); }
DEV float lanef(float v, int src) { return __int_as_float(__builtin_amdgcn_ds_bpermute(src << 2, __float_as_int(v))); }
DEV f32x16 mfma32(bf16x8 a, bf16x8 b, f32x16 c) { return __builtin_amdgcn_mfma_f32_32x32x16_bf16(a, b, c, 0, 0, 0); }
DEV f32x16 zero16() { f32x16 z;
#pragma unroll
    for (int i = 0; i < 16; ++i) z[i] = 0.f;
    return z; }
DEV float gelu_tanh(float x) {
    const float u = 0.7978845608028654f * (x + 0.044715f * x * x * x);
    const float e = __expf(2.f * u);
    const float t = 1.f - 2.f / (e + 1.f);
    return 0.5f * x * (1.f + t);
}

template <class Epi>
DEV void gemm_tile(const bf16_t* __restrict__ A, int lda, const bf16_t* __restrict__ Bt, int ldb, int K, int m0, int n0, char* smem, const Epi& epi) {
    const int tid = ltid(), lane = tid & 63, w = tid >> 6, wm = w >> 1, wn = w & 1, ql = lane & 31, hh = lane >> 5;
    f32x16 acc[2][2];
#pragma unroll
    for (int i = 0; i < 2; ++i)
#pragma unroll
        for (int j = 0; j < 2; ++j) acc[i][j] = zero16();
    const int srow = lane >> 3, spos = lane & 7;
    const int c0 = spos ^ ((srow >> 1) & 7), c1 = spos ^ ((4 + (srow >> 1)) & 7);
    const bf16_t* Ag0 = A + (size_t)(m0 + w * 32 + srow) * lda + c0 * 8;
    const bf16_t* Ag1 = A + (size_t)(m0 + w * 32 + 8 + srow) * lda + c1 * 8;
    const bf16_t* Bg0 = Bt + (size_t)(n0 + w * 32 + srow) * ldb + c0 * 8;
    const bf16_t* Bg1 = Bt + (size_t)(n0 + w * 32 + 8 + srow) * ldb + c1 * 8;
    const size_t a16 = (size_t)16 * lda, b16 = (size_t)16 * ldb;
    auto stage = [&](int kt, int buf) __attribute__((always_inline)) {
        char* sa = smem + buf * 32768 + w * 4096;
        char* sb = sa + 16384;
        const int ko = kt * 64;
        __builtin_amdgcn_global_load_lds((const unsigned*)(Ag0 + ko), (LAS unsigned*)(sa), 16, 0, 0);
        __builtin_amdgcn_global_load_lds((const unsigned*)(Ag1 + ko), (LAS unsigned*)(sa + 1024), 16, 0, 0);
        __builtin_amdgcn_global_load_lds((const unsigned*)(Ag0 + a16 + ko), (LAS unsigned*)(sa + 2048), 16, 0, 0);
        __builtin_amdgcn_global_load_lds((const unsigned*)(Ag1 + a16 + ko), (LAS unsigned*)(sa + 3072), 16, 0, 0);
        __builtin_amdgcn_global_load_lds((const unsigned*)(Bg0 + ko), (LAS unsigned*)(sb), 16, 0, 0);
        __builtin_amdgcn_global_load_lds((const unsigned*)(Bg1 + ko), (LAS unsigned*)(sb + 1024), 16, 0, 0);
        __builtin_amdgcn_global_load_lds((const unsigned*)(Bg0 + b16 + ko), (LAS unsigned*)(sb + 2048), 16, 0, 0);
        __builtin_amdgcn_global_load_lds((const unsigned*)(Bg1 + b16 + ko), (LAS unsigned*)(sb + 3072), 16, 0, 0);
    };
    const int key = (ql >> 1) & 7;
    const int arow = (wm * 64 + ql) * 128, brow = (wn * 64 + ql) * 128;
    const int nk = K >> 6;
    __syncthreads();
    stage(0, 0);
    for (int kt = 0; kt < nk; ++kt) {
        asm volatile("s_waitcnt vmcnt(0)" ::: "memory");
        __syncthreads();
        if (kt + 1 < nk) stage(kt + 1, (kt + 1) & 1);
        const char* As = smem + (kt & 1) * 32768;
        const char* Bs = As + 16384;
#pragma unroll
        for (int ks = 0; ks < 4; ++ks) {
            const int co = ((ks * 2 + hh) ^ key) << 4;
            bf16x8 a[2], b[2];
#pragma unroll
            for (int i = 0; i < 2; ++i) {
                a[i] = *(const bf16x8*)(As + arow + i * 4096 + co);
                b[i] = *(const bf16x8*)(Bs + brow + i * 4096 + co);
            }
#pragma unroll
            for (int i = 0; i < 2; ++i)
#pragma unroll
                for (int j = 0; j < 2; ++j) acc[i][j] = mfma32(a[i], b[j], acc[i][j]);
        }
    }
    __syncthreads();
    float* Cs = (float*)smem;
#pragma unroll
    for (int i = 0; i < 2; ++i)
#pragma unroll
        for (int j = 0; j < 2; ++j)
#pragma unroll
            for (int r = 0; r < 16; ++r)
                Cs[(wm * 64 + i * 32 + (r & 3) + 8 * (r >> 2) + 4 * hh) * 128 + wn * 64 + j * 32 + ql] = acc[i][j][r];
    __syncthreads();
    epi.tile(m0, n0, Cs, tid);
}

struct EpiBf16 {
    bf16_t* C; int ldc; const float* rowscale; const float* colbias; int nvalid;
    DEV void tile(int m0, int n0, const float* Cs, int tid) const {
#pragma unroll
        for (int it = 0; it < 8; ++it) {
            const int id = tid + 256 * it, r = id >> 4, c8 = (id & 15) * 8;
            if (n0 + c8 >= nvalid) continue;
            float4 a = *(const float4*)(Cs + r * 128 + c8), b = *(const float4*)(Cs + r * 128 + c8 + 4);
            if (rowscale) { const float sc = rowscale[m0 + r]; a.x *= sc; a.y *= sc; a.z *= sc; a.w *= sc; b.x *= sc; b.y *= sc; b.z *= sc; b.w *= sc; }
            if (colbias) { const float4 ba = *(const float4*)(colbias + n0 + c8), bb = *(const float4*)(colbias + n0 + c8 + 4);
                a.x += ba.x; a.y += ba.y; a.z += ba.z; a.w += ba.w; b.x += bb.x; b.y += bb.y; b.z += bb.z; b.w += bb.w; }
            *(uint4*)(C + (size_t)(m0 + r) * ldc + n0 + c8) = make_uint4(pack2(a.x, a.y), pack2(a.z, a.w), pack2(b.x, b.y), pack2(b.z, b.w));
        }
    }
};
struct EpiF32 {
    float* C; int ldc;
    DEV void tile(int m0, int n0, const float* Cs, int tid) const {
#pragma unroll
        for (int it = 0; it < 16; ++it) {
            const int id = tid + 256 * it, r = id >> 5, c4 = (id & 31) * 4;
            *(float4*)(C + (size_t)(m0 + r) * ldc + n0 + c4) = *(const float4*)(Cs + r * 128 + c4);
        }
    }
};
struct EpiRes {
    const void* xin; bool in_bf16; bf16_t* xout; const float* gate;
    DEV void tile(int m0, int n0, const float* Cs, int tid) const {
        const float* g = gate + (size_t)(m0 >> 11) * 6144 + n0;
#pragma unroll
        for (int it = 0; it < 8; ++it) {
            const int id = tid + 256 * it, r = id >> 4, c8 = (id & 15) * 8;
            const float4 v0 = *(const float4*)(Cs + r * 128 + c8), v1 = *(const float4*)(Cs + r * 128 + c8 + 4);
            const float4 g0 = *(const float4*)(g + c8), g1 = *(const float4*)(g + c8 + 4);
            float4 x0, x1;
            if (in_bf16) {
                const uint4 u = *(const uint4*)((const bf16_t*)xin + (size_t)(m0 + r) * 1024 + n0 + c8);
                x0 = make_float4(lo16(u.x), hi16(u.x), lo16(u.y), hi16(u.y)); x1 = make_float4(lo16(u.z), hi16(u.z), lo16(u.w), hi16(u.w));
            } else {
                const float* xp = (const float*)xin + (size_t)(m0 + r) * 1024 + n0 + c8;
                x0 = *(const float4*)xp; x1 = *(const float4*)(xp + 4);
            }
            *(uint4*)(xout + (size_t)(m0 + r) * 1024 + n0 + c8) =
                make_uint4(pack2(x0.x + g0.x * v0.x, x0.y + g0.y * v0.y), pack2(x0.z + g0.z * v0.z, x0.w + g0.w * v0.w),
                           pack2(x1.x + g1.x * v1.x, x1.y + g1.y * v1.y), pack2(x1.z + g1.z * v1.z, x1.w + g1.w * v1.w));
        }
    }
};

template <class Epi>
DEV void gemm_phase(const bf16_t* A, int lda, const bf16_t* Bt, int ldb, int K, int mtiles, int ntiles, char* smem, const Epi& epi) {
    for (int tile = blockIdx.x; tile < mtiles * ntiles; tile += gridDim.x) {
        const int mt = tile / ntiles, nt = tile % ntiles;
        gemm_tile(A, lda, Bt, ldb, K, mt * 128, nt * 128, smem, epi);
    }
}

DEV int win_srccol(int n) {
    if (n < 652) return n;
    if (n < 704) return -1;
    if (n < 1888) return n - 52;
    if (n < 1920) return -1;
    return n - 84;
}
DEV void transpose_tile(const float* __restrict__ src, int ld_src, int nsrc_valid, int mode, const float* __restrict__ rowscale,
                        bf16_t* __restrict__ dst, int K, int n0, int k0, char* smem) {
    bf16_t* Ls = (bf16_t*)smem;
    const int tid = ltid();
    __syncthreads();
    const int nn = tid & 63, n = n0 + nn;
    const int sc = (mode == 1) ? win_srccol(n) : (mode == 2) ? (n & 63) : (n < nsrc_valid ? n : -1);
    const int kshift = (mode == 2 && n >= 64) ? 1024 : 0;
#pragma unroll 4
    for (int i = 0; i < 16; ++i) {
        const int kk = (tid >> 6) + 4 * i;
        float v = 0.f;
        if (sc >= 0) { v = src[(size_t)(k0 + kk + kshift) * ld_src + sc]; if (rowscale) v *= rowscale[k0 + kk]; }
        Ls[nn * 72 + kk] = f2bf(v);
    }
    __syncthreads();
#pragma unroll
    for (int i = 0; i < 2; ++i) {
        const int r = (tid >> 3) + 32 * i, ch = tid & 7;
        *(uint4*)(dst + (size_t)(n0 + r) * K + k0 + ch * 8) = *(const uint4*)(Ls + r * 72 + ch * 8);
    }
}

DEV void convert_stream(const float* __restrict__ src, bf16_t* __restrict__ dst, size_t n8) {
    const int tid = ltid();
    for (size_t i = (size_t)blockIdx.x * 256 + tid; i < n8; i += (size_t)gridDim.x * 256) {
        const float4 a = *(const float4*)(src + i * 8), b = *(const float4*)(src + i * 8 + 4);
        uint4 o; o.x = pack2(a.x, a.y); o.y = pack2(a.z, a.w); o.z = pack2(b.x, b.y); o.w = pack2(b.z, b.w);
        *(uint4*)(dst + i * 8) = o;
    }
}

DEV void convert_fp8_stream(const float* __restrict__ src, unsigned char* __restrict__ dst, size_t n16, float scale) {
    const int tid = ltid();
    const size_t stride = (size_t)gridDim.x * 256;
    for (size_t i0 = (size_t)blockIdx.x * 256 + tid; i0 < n16; i0 += stride * 4) {
        float4 q[4][4];
#pragma unroll
        for (int u = 0; u < 4; ++u) {
            const size_t i = i0 + u * stride < n16 ? i0 + u * stride : i0;
#pragma unroll
            for (int c = 0; c < 4; ++c) q[u][c] = *(const float4*)(src + i * 16 + c * 4);
        }
#pragma unroll
        for (int u = 0; u < 4; ++u) {
            const size_t i = i0 + u * stride;
            if (i >= n16) break;
            unsigned o[4];
#pragma unroll
            for (int j = 0; j < 4; ++j) {
                const float4 v = q[u][j];
                unsigned w = 0u;
                w = __builtin_amdgcn_cvt_pk_fp8_f32(fminf(fmaxf(v.x * scale, -440.f), 440.f), fminf(fmaxf(v.y * scale, -440.f), 440.f), w, false);
                w = __builtin_amdgcn_cvt_pk_fp8_f32(fminf(fmaxf(v.z * scale, -440.f), 440.f), fminf(fmaxf(v.w * scale, -440.f), 440.f), w, true);
                o[j] = w;
            }
            const size_t rowg = i >> 6; const int c16 = (int)(i & 63);
            const size_t l = rowg >> 14, row = rowg & 16383;
            *(uint4*)(dst + (((l * 8 + (c16 >> 3)) * 16384 + row) << 7) + (c16 & 7) * 16) = make_uint4(o[0], o[1], o[2], o[3]);
        }
    }
}

constexpr int J_ROPE = 384, J_MOD = 192, J_MISC = 5;
constexpr int J_TW_L = 608 + 256 + 512 + 24 + 16 + 64 + 64;
constexpr int J_TOTAL = J_ROPE + J_MOD + J_MISC + 2 * J_TW_L;

DEV void prologue_job(const Params& p, int job, char* smem) {
    const int tid = ltid();
    char* ws = p.ws;
    if (job < J_MISC) {
        float* misc = (float*)(ws + OFF_MISC);
        if (job < 4) {
            const int l = job >> 1, kv = job & 1;
            const float* pos = (kv ? p.pos_v : p.pos_k) + l * 2048;
            const float* wsrc = (kv ? p.cmp_wv : p.cmp_wk) + (size_t)l * 2048 * 64;
            float* red = (float*)smem;
            __syncthreads();
            const int kp = tid >> 6, n = tid & 63;
            float acc = 0.f;
            for (int k0 = kp * 512; k0 < kp * 512 + 512; k0 += 16) {
                float wv[16];
#pragma unroll
                for (int u = 0; u < 16; ++u) wv[u] = wsrc[(size_t)(k0 + u) * 64 + n];
#pragma unroll
                for (int u = 0; u < 16; ++u) acc += pos[k0 + u] * wv[u];
            }
            red[kp * 64 + n] = acc;
            __syncthreads();
            if (tid < 64) misc[(l * 2 + kv) * 64 + tid] = red[tid] + red[64 + tid] + red[128 + tid] + red[192 + tid];
        } else if (tid < 2) {
            const int l = tid;
            float d1 = 0.f, d2 = 0.f;
            for (int i = 0; i < 32; ++i) { d1 += p.lq1[l * 32 + i] * p.lk1[l * 32 + i]; d2 += p.lq2[l * 32 + i] * p.lk2[l * 32 + i]; }
            const float lam_init = 0.8f - 0.6f * expf(-0.3f * (float)l);
            misc[256 + l] = expf(d1) - expf(d2) + lam_init;
            misc[258 + l] = 1.f - lam_init;
        }
        return;
    }
    job -= J_MISC;
    if (job < J_MOD) {
        const int l = job / 96, n0 = (job % 96) * 64;
        float* sc = (float*)smem;
        __syncthreads();
        for (int i = tid; i < 8192; i += 256) { const float v = p.c[i]; sc[i] = v / (1.f + __expf(-v)); }
        __syncthreads();
        const int kp = tid >> 6, col = tid & 63;
        float acc[8];
#pragma unroll
        for (int b = 0; b < 8; ++b) acc[b] = 0.f;
        const float* wp = p.ada_w + (size_t)l * 1024 * 6144 + n0 + col;
        for (int k0 = kp * 256; k0 < kp * 256 + 256; k0 += 16) {
            float wv[16];
#pragma unroll
            for (int u = 0; u < 16; ++u) wv[u] = wp[(size_t)(k0 + u) * 6144];
#pragma unroll
            for (int u = 0; u < 16; ++u)
#pragma unroll
                for (int b = 0; b < 8; ++b) acc[b] += sc[b * 1024 + k0 + u] * wv[u];
        }
        float* red = sc + 8192;
#pragma unroll
        for (int b = 0; b < 8; ++b) red[(kp * 8 + b) * 64 + col] = acc[b];
        __syncthreads();
        float* mod = (float*)(ws + OFF_MOD);
        for (int idx = tid; idx < 512; idx += 256) {
            const int b = idx >> 6, cl = idx & 63;
            const float v = red[(0 * 8 + b) * 64 + cl] + red[(1 * 8 + b) * 64 + cl] + red[(2 * 8 + b) * 64 + cl] + red[(3 * 8 + b) * 64 + cl];
            mod[(size_t)(l * 8 + b) * 6144 + n0 + cl] = v + p.ada_b[l * 6144 + n0 + cl];
        }
        return;
    }
    job -= J_MOD;
    if (job < J_ROPE) {
        const int idx = job * 256 + tid;
        const int s = idx / 48, j = idx % 48;
        float* rope = (float*)(ws + OFF_ROPE);
        float inv; float *pc, *ps;
        if (j < 32) { inv = exp2f(-(float)j * (13.287712379549449f / 32.f)); pc = rope + s * 32 + j; ps = rope + 2048 * 32 + s * 32 + j; }
        else { const int i = j - 32; inv = exp2f(-(float)i * (13.287712379549449f / 16.f)); pc = rope + 2048 * 64 + s * 16 + i; ps = rope + 2048 * 64 + 2048 * 16 + s * 16 + i; }
        const double a = (double)s * (double)inv;
        const double kk = rint(a * 0.15915494309189535);
        const float r = (float)fma(-kk, 6.283185307179586, a);
        *pc = cosf(r); *ps = sinf(r);
        return;
    }
    job -= J_ROPE;
    const int l = job / J_TW_L; int j = job % J_TW_L;
    if (j < 608) { transpose_tile(p.w_in + (size_t)l * 1024 * 2348, 2348, 2348, 1, nullptr, (bf16_t*)(ws + OFF_WIN) + (size_t)l * 2432 * 1024, 1024, (j / 16) * 64, (j % 16) * 64, smem); return; }
    j -= 608;
    if (j < 256) { transpose_tile(p.w_out + (size_t)l * 1024 * 1024, 1024, 1024, 0, nullptr, (bf16_t*)(ws + OFF_WOUT) + (size_t)l * 1024 * 1024, 1024, (j / 16) * 64, (j % 16) * 64, smem); return; }
    j -= 256;
    if (j < 512) { transpose_tile(p.w_q + (size_t)l * 1024 * 2048, 2048, 2048, 0, nullptr, (bf16_t*)(ws + OFF_WQ) + (size_t)l * 2048 * 1024, 1024, (j / 16) * 64, (j % 16) * 64, smem); return; }
    j -= 512;
    if (j < 24) { transpose_tile(p.mla_wuq + (size_t)l * 256 * 384, 384, 384, 0, p.mla_qg + l * 256, (bf16_t*)(ws + OFF_WUQ) + (size_t)l * 384 * 256, 256, (j / 4) * 64, (j % 4) * 64, smem); return; }
    j -= 24;
    if (j < 16) { transpose_tile(p.mla_wukv + (size_t)l * 128 * 512, 512, 512, 0, p.mla_kvg + l * 128, (bf16_t*)(ws + OFF_WUKV) + (size_t)l * 512 * 128, 128, (j / 2) * 64, (j % 2) * 64, smem); return; }
    j -= 16;
    if (j < 64) { if (j < 32) transpose_tile(p.cmp_wk + (size_t)l * 2048 * 64, 64, 64, 2, nullptr, (bf16_t*)(ws + OFF_WCK) + (size_t)l * 128 * 2048, 1024, (j / 16) * 64, (j % 16) * 64, smem); return; }
    j -= 64;
    if (j < 32) transpose_tile(p.cmp_wv + (size_t)l * 2048 * 64, 64, 64, 2, nullptr, (bf16_t*)(ws + OFF_WCV) + (size_t)l * 128 * 2048, 1024, (j / 16) * 64, (j % 16) * 64, smem);
}

#if TS_A >= 0
#define PSTAMP(I) if (blockIdx.x == 0 && threadIdx.x == 0) ((unsigned long long*)(p.ws + 32768))[I] = __builtin_amdgcn_s_memrealtime();
#else
#define PSTAMP(I)
#endif
DEV void phase_prologue(const Params& p, char* smem) {
    {
        unsigned* ctr = (unsigned*)p.ws + 100;
        volatile int* slot = (volatile int*)(smem + 65536 + 64);
        int job = blockIdx.x;
        while (job < J_TOTAL) {
            prologue_job(p, job, smem);
            __syncthreads();
            if (ltid() == 0) *slot = (int)gridDim.x + (int)atomicAdd(ctr, 1u);
            __syncthreads();
            job = __builtin_amdgcn_readfirstlane(*slot);
        }
    }
    PSTAMP(42)
    char* ws = p.ws;
    convert_fp8_stream(p.pu, (unsigned char*)(ws + OFF_PU), 2ull * 16384 * 1024 / 16, kScaleU);
    PSTAMP(43)
    convert_fp8_stream(p.pv, (unsigned char*)(ws + OFF_PV), 2ull * 16384 * 1024 / 16, kScaleV);
    PSTAMP(44)
    for (int l = 0; l < 2; ++l) {
        convert_stream(p.subk1 + (size_t)l * 16384, (bf16_t*)(ws + OFF_SUBK) + (size_t)(l * 2 + 0) * 16384, 16384 / 8);
        convert_stream(p.subk2 + (size_t)l * 16384, (bf16_t*)(ws + OFF_SUBK) + (size_t)(l * 2 + 1) * 16384, 16384 / 8);
    }
}

DEV void phase_norm(const Params& p, int layer, int which) {
    const int tid = ltid(), lane = tid & 63, w = tid >> 6;
    const bool xbf = !(layer == 0 && which == 0);
    const float* xs = p.x; const bf16_t* xb = (const bf16_t*)(p.ws + OFF_XRES);
    const float* g = (which == 0 ? p.norm_mix_g : p.norm_ffn_g) + layer * 1024;
    const float* mod = (const float*)(p.ws + OFF_MOD) + (size_t)layer * 8 * 6144;
    bf16_t* h = (bf16_t*)(p.ws + OFF_H);
    float4 g4[4];
#pragma unroll
    for (int i = 0; i < 4; ++i) g4[i] = *(const float4*)(g + i * 256 + lane * 4);
    for (int q0 = blockIdx.x; q0 < kT / 4; q0 += gridDim.x * 4) {
        float4 v[4][4];
#pragma unroll
        for (int u = 0; u < 4; ++u) {
            const int q = q0 + u * gridDim.x < kT / 4 ? q0 + u * gridDim.x : q0;
            if (xbf) {
                const bf16_t* xr = xb + (size_t)(q * 4 + w) * 1024;
#pragma unroll
                for (int i = 0; i < 4; ++i) { const uint2 uu = *(const uint2*)(xr + i * 256 + lane * 4); v[u][i] = make_float4(lo16(uu.x), hi16(uu.x), lo16(uu.y), hi16(uu.y)); }
            } else {
                const float* xr = xs + (size_t)(q * 4 + w) * 1024;
#pragma unroll
                for (int i = 0; i < 4; ++i) v[u][i] = *(const float4*)(xr + i * 256 + lane * 4);
            }
        }
#pragma unroll
        for (int u = 0; u < 4; ++u) {
            const int q = q0 + u * gridDim.x;
            if (q >= kT / 4) break;
            const int t = q * 4 + w, b = t >> 11;
            float ss = 0.f;
#pragma unroll
            for (int i = 0; i < 4; ++i) ss += v[u][i].x * v[u][i].x + v[u][i].y * v[u][i].y + v[u][i].z * v[u][i].z + v[u][i].w * v[u][i].w;
            ss = wave_sum(ss);
            const float rstd = rsqrtf(ss * (1.f / 1024.f) + kEps);
            const float* sh = mod + (size_t)b * 6144 + (which ? 3072 : 0);
            const float* sc = sh + 1024;
#pragma unroll
            for (int i = 0; i < 4; ++i) {
                const int col = i * 256 + lane * 4;
                const float4 s4 = *(const float4*)(sc + col), h4 = *(const float4*)(sh + col);
                const float o0 = v[u][i].x * rstd * g4[i].x * (1.f + s4.x) + h4.x, o1 = v[u][i].y * rstd * g4[i].y * (1.f + s4.y) + h4.y;
                const float o2 = v[u][i].z * rstd * g4[i].z * (1.f + s4.z) + h4.z, o3 = v[u][i].w * rstd * g4[i].w * (1.f + s4.w) + h4.w;
                uint2 o; o.x = pack2(o0, o1); o.y = pack2(o2, o3);
                *(uint2*)(h + (size_t)t * 1024 + col) = o;
            }
        }
    }
}

DEV void rope8(uint4& x1, uint4& x2, const float (&cc)[8], const float (&ss)[8]) {
    unsigned a[4] = {x1.x, x1.y, x1.z, x1.w}, b[4] = {x2.x, x2.y, x2.z, x2.w};
#pragma unroll
    for (int i = 0; i < 4; ++i) {
        const float a0 = lo16(a[i]), a1 = hi16(a[i]), b0 = lo16(b[i]), b1 = hi16(b[i]);
        const float o10 = a0 * cc[2 * i] - b0 * ss[2 * i], o11 = a1 * cc[2 * i + 1] - b1 * ss[2 * i + 1];
        const float o20 = a0 * ss[2 * i] + b0 * cc[2 * i], o21 = a1 * ss[2 * i + 1] + b1 * cc[2 * i + 1];
        a[i] = pack2(o10, o11); b[i] = pack2(o20, o21);
    }
    x1 = make_uint4(a[0], a[1], a[2], a[3]); x2 = make_uint4(b[0], b[1], b[2], b[3]);
}
DEV void vt_tile(const bf16_t* __restrict__ src, int ld, bf16_t* __restrict__ dst, char* smem) {
    bf16_t* Ls = (bf16_t*)smem;
    const int tid = ltid();
    __syncthreads();
#pragma unroll
    for (int i = 0; i < 2; ++i) {
        const int id = tid + 256 * i, tok = id >> 3, ch = id & 7;
        *(uint4*)(Ls + tok * 72 + ch * 8) = *(const uint4*)(src + (size_t)tok * ld + ch * 8);
    }
    __syncthreads();
#pragma unroll
    for (int i = 0; i < 2; ++i) {
        const int id = tid + 256 * i, d = id & 63, tc = id >> 6;
        unsigned short e[8];
#pragma unroll
        for (int j = 0; j < 8; ++j) e[j] = Ls[(tc * 8 + j) * 72 + d];
        uint4 o;
        o.x = (unsigned)e[0] | ((unsigned)e[1] << 16); o.y = (unsigned)e[2] | ((unsigned)e[3] << 16);
        o.z = (unsigned)e[4] | ((unsigned)e[5] << 16); o.w = (unsigned)e[6] | ((unsigned)e[7] << 16);
        *(uint4*)(dst + (size_t)d * 2048 + tc * 8) = o;
    }
}

DEV void phase_layout1(const Params& p, char* smem) {
    char* ws = p.ws;
    bf16_t* cols = (bf16_t*)(ws + OFF_COLS);
    bf16_t* kc = (bf16_t*)(ws + OFF_KC);
    bf16_t* vc = (bf16_t*)(ws + OFF_VC);
    bf16_t* VT = (bf16_t*)(ws + OFF_VT);
    float* rstd = (float*)(ws + OFF_RSTD);
    const float* rope = (const float*)(ws + OFF_ROPE);
    const float *cos64 = rope, *sin64 = rope + 2048 * 32, *cos32 = rope + 2048 * 64, *sin32 = rope + 2048 * 64 + 2048 * 16;
    const int tid = ltid();
    for (int unit = blockIdx.x; unit < 2 * (kT / 64); unit += gridDim.x) {
        const int tile = unit >> 1, part01 = unit & 1;
        const int T0 = tile * 64, b = T0 >> 11, s0 = T0 & 2047;
        if (part01 == 0) {
            for (int it0 = tid; it0 < 64 * 86; it0 += 1024) {
                uint4 x1[4], x2[4]; float4 cs[4][2], sn[4][2]; bf16_t* p1[4]; bf16_t* p2[4]; bf16_t* kq[4];
#pragma unroll
                for (int u = 0; u < 4; ++u) {
                    const int it = it0 + u * 256 < 64 * 86 ? it0 + u * 256 : it0;
                    const int tok = it / 86, item = it % 86;
                    const int t = T0 + tok, sq = s0 + tok;
                    bf16_t* row = cols + (size_t)t * LDC;
                    kq[u] = nullptr;
                    const float *cp, *sp;
                    if (item < 52) {
                        const int hd = item >> 2, i0 = (item & 3) * 8;
                        const int base = hd < 4 ? 64 * hd : hd == 4 ? 256 : hd == 5 ? 384 : hd == 6 ? 512 : hd < 11 ? 1920 + 64 * (hd - 7) : 2176 + 64 * (hd - 11);
                        p1[u] = row + base + i0; p2[u] = row + base + 32 + i0;
                        cp = cos64 + sq * 32 + i0; sp = sin64 + sq * 32 + i0;
                        if (hd == 4) kq[u] = kc + (size_t)t * 64 + i0;
                    } else {
                        const int it2 = item - 52, sub = it2 >> 1, i0 = (it2 & 1) * 8;
                        const int base = sub < 8 ? 704 + 32 * sub : sub < 16 ? 960 + 32 * (sub - 8) : 1856;
                        p1[u] = row + base + i0; p2[u] = row + base + 16 + i0;
                        cp = cos32 + sq * 16 + i0; sp = sin32 + sq * 16 + i0;
                    }
                    x1[u] = *(const uint4*)p1[u]; x2[u] = *(const uint4*)p2[u];
                    cs[u][0] = *(const float4*)cp; cs[u][1] = *(const float4*)(cp + 4);
                    sn[u][0] = *(const float4*)sp; sn[u][1] = *(const float4*)(sp + 4);
                }
#pragma unroll
                for (int u = 0; u < 4; ++u) {
                    if (it0 + u * 256 >= 64 * 86) break;
                    const float cc[8] = {cs[u][0].x, cs[u][0].y, cs[u][0].z, cs[u][0].w, cs[u][1].x, cs[u][1].y, cs[u][1].z, cs[u][1].w};
                    const float ss[8] = {sn[u][0].x, sn[u][0].y, sn[u][0].z, sn[u][0].w, sn[u][1].x, sn[u][1].y, sn[u][1].z, sn[u][1].w};
                    rope8(x1[u], x2[u], cc, ss);
                    *(uint4*)p1[u] = x1[u]; *(uint4*)p2[u] = x2[u];
                    if (kq[u]) { *(uint4*)kq[u] = x1[u]; *(uint4*)(kq[u] + 32) = x2[u]; }
                }
            }
            {
                const uint4 c0 = *(const uint4*)(cols + (size_t)(T0 + (tid >> 3)) * LDC + 320 + (tid & 7) * 8);
                const uint4 c1 = *(const uint4*)(cols + (size_t)(T0 + 32 + (tid >> 3)) * LDC + 320 + (tid & 7) * 8);
                *(uint4*)(vc + (size_t)(T0 + (tid >> 3)) * 64 + (tid & 7) * 8) = c0;
                *(uint4*)(vc + (size_t)(T0 + 32 + (tid >> 3)) * 64 + (tid & 7) * 8) = c1;
            }
        }
        if (part01 == 0) continue;
        {
            const int tok = tid >> 2, part = tid & 3, t = T0 + tok;
            const bf16_t* src = cols + (size_t)t * LDC + 1472 + (part < 3 ? part : 0) * 128;
            float ss = 0.f;
#pragma unroll 4
            for (int i = 0; i < 16; ++i) {
                const uint4 u = *(const uint4*)(src + i * 8);
                ss += lo16(u.x) * lo16(u.x) + hi16(u.x) * hi16(u.x) + lo16(u.y) * lo16(u.y) + hi16(u.y) * hi16(u.y)
                    + lo16(u.z) * lo16(u.z) + hi16(u.z) * hi16(u.z) + lo16(u.w) * lo16(u.w) + hi16(u.w) * hi16(u.w);
            }
            float vq = part < 2 ? ss : 0.f;
            vq += __shfl_xor(vq, 1, 64);
            if (part == 0) rstd[t] = rsqrtf(vq * (1.f / 256.f) + kEps);
            if (part == 2) rstd[kT + t] = rsqrtf(ss * (1.f / 128.f) + kEps);
        }
#pragma unroll 1
        for (int vh = 0; vh < 8; ++vh) {
            const int col = vh == 0 ? 448 : vh == 1 ? 576 : vh < 6 ? 1216 + 64 * (vh - 2) : 2304 + 64 * (vh - 6);
            vt_tile(cols + (size_t)T0 * LDC + col, LDC, VT + ((size_t)(b * 12 + vh) * 64) * 2048 + s0, smem);
        }
    }
}

DEV void phase_layout2(const Params& p, int layer, char* smem) {
    char* ws = p.ws;
    bf16_t* qmla = (bf16_t*)(ws + OFF_QMLA);
    const bf16_t* kvmla = (const bf16_t*)(ws + OFF_KVMLA);
    bf16_t* VT = (bf16_t*)(ws + OFF_VT);
    const float* rope = (const float*)(ws + OFF_ROPE);
    const float *cos32 = rope + 2048 * 64, *sin32 = rope + 2048 * 64 + 2048 * 16;
    const int tid = ltid();
    for (int tile = blockIdx.x; tile < kT / 64 + 64; tile += gridDim.x) {
        if (tile >= kT / 64) {
            const int idx = (tile - kT / 64) * 2048 + tid * 8;
            const int kv = idx >> 16, m = (idx >> 6) & 1023, n = idx & 63;
            const float* pp = (const float*)(ws + OFF_QP) + ((size_t)(kv * 8) * 1024 + m) * 128 + n;
            const float* bias = (const float*)(ws + OFF_MISC) + (layer * 2 + kv) * 64 + n;
            float4 a = *(const float4*)bias, c = *(const float4*)(bias + 4);
#pragma unroll
            for (int ks = 0; ks < 8; ++ks) {
                const float4 x = *(const float4*)(pp + (size_t)ks * 1024 * 128), y = *(const float4*)(pp + (size_t)ks * 1024 * 128 + 4);
                a.x += x.x; a.y += x.y; a.z += x.z; a.w += x.w; c.x += y.x; c.y += y.y; c.z += y.z; c.w += y.w;
            }
            *(uint4*)((bf16_t*)(ws + OFF_KCMP) + (size_t)kv * 1024 * 64 + m * 64 + n) = make_uint4(pack2(a.x, a.y), pack2(a.z, a.w), pack2(c.x, c.y), pack2(c.z, c.w));
            continue;
        }
        const int T0 = tile * 64, b = T0 >> 11, s0 = T0 & 2047;
        for (int it = tid; it < 64 * 8; it += 256) {
            const int tok = it >> 3, item = it & 7, hd = item >> 1, i0 = (item & 1) * 8;
            const int t = T0 + tok, s = s0 + tok;
            bf16_t* row = qmla + (size_t)t * 384 + hd * 96 + 64;
            uint4 x1 = *(const uint4*)(row + i0), x2 = *(const uint4*)(row + 16 + i0);
            const float* cp = cos32 + s * 16 + i0; const float* sp = sin32 + s * 16 + i0;
            const float4 c0 = *(const float4*)cp, c1 = *(const float4*)(cp + 4), q0 = *(const float4*)sp, q1 = *(const float4*)(sp + 4);
            const float cc[8] = {c0.x, c0.y, c0.z, c0.w, c1.x, c1.y, c1.z, c1.w}, ss[8] = {q0.x, q0.y, q0.z, q0.w, q1.x, q1.y, q1.z, q1.w};
            rope8(x1, x2, cc, ss);
            *(uint4*)(row + i0) = x1; *(uint4*)(row + 16 + i0) = x2;
        }
#pragma unroll 1
        for (int hd = 0; hd < 4; ++hd)
            vt_tile(kvmla + (size_t)T0 * 512 + hd * 128 + 64, 512, VT + ((size_t)(b * 12 + 8 + hd) * 64) * 2048 + s0, smem);
    }
}

constexpr int SM_K = 0;
constexpr int SM_V = 26624;
constexpr int SM_IMP = SM_V + 17408;
constexpr int SM_SEL = SM_IMP + 16896;
constexpr int SM_CTRL = 65536;
constexpr int SM_TOTAL = SM_CTRL + 256 + 512;
constexpr int SM_ATTN_END = SM_SEL + 1024;

struct RangeIter { int cur, end; DEV int next() { return cur < end ? cur++ : -1; } };
struct BitIter { unsigned rem; DEV int next() { if (!rem) return -1; const int k = __ffs((int)rem) - 1; rem &= rem - 1; return k; } };
struct LdRow { const bf16_t* base; int ld;
    DEV uint4 operator()(int kt, int id) const { const int row = id >> 3, part = id & 7; return *(const uint4*)(base + (size_t)(kt * 64 + row) * ld + part * 8); } };
struct LdVT { const bf16_t* base;
    DEV uint4 operator()(int kt, int id) const { const int d = id >> 3, part = id & 7; return *(const uint4*)(base + (size_t)d * 2048 + kt * 64 + part * 8); } };
struct LdMlaK { const bf16_t* kv; const bf16_t* kr;
    DEV uint4 operator()(int kt, int id) const { const int row = id / 12, part = id % 12; const size_t t = (size_t)(kt * 64 + row);
        return part < 8 ? *(const uint4*)(kv + t * 512 + part * 8) : *(const uint4*)(kr + t * LDC + (part - 8) * 8); } };

struct MaskCausal { DEV bool on(int) const { return true; } DEV bool ok(int kc, int d) const { return kc <= d; }
    DEV bool full(int kt, int t0w) const { return kt * 64 + 63 <= t0w; } };
template <int W> struct MaskWin { DEV bool on(int) const { return true; } DEV bool ok(int kc, int d) const { return (kc <= d) && (d - kc < W); }
    DEV bool full(int kt, int t0w) const { return (kt * 64 + 63 <= t0w) && (t0w + 31 - kt * 64 < W); } };
struct MaskSel { unsigned bits, allbits; DEV bool on(int kt) const { return (bits >> kt) & 1u; } DEV bool ok(int kc, int d) const { return kc <= d; }
    DEV bool full(int kt, int t0w) const { return ((allbits >> kt) & 1u) && (kt * 64 + 63 <= t0w); } };
template <int KDIM, int NKS, int NSUB, bool QG, class It, class LK, class LV, class MaskF, class SkipF>
DEV void attn_stream(It it, const LK& ldK, const LV& ldV, const MaskF& maskf, const SkipF& skipf,
                     const bf16x8* qf, f32x16 (&o)[NSUB][2], float (&m)[NSUB], float (&l)[NSUB], float scl, int tq, int t0w, char* smem, int tid, int koff = 0) {
    constexpr int KCH = KDIM / 8, KSTR = KDIM + 8, NKC = (64 * KCH) / 256;
    constexpr int KBUF = 64 * 104, VBUF = 64 * 68;
    bf16_t* Kb = (bf16_t*)(smem + SM_K);
    bf16_t* Vb = (bf16_t*)(smem + SM_V);
    const int lane = tid & 63, ql = lane & 31, hh = lane >> 5;
    const uint4 z4 = make_uint4(0, 0, 0, 0);
    uint4 ak0 = z4, ak1 = z4, ak2 = z4, av0 = z4, av1 = z4, bk0 = z4, bk1 = z4, bk2 = z4, bv0 = z4, bv1 = z4;
    auto loadA = [&](int kt) __attribute__((always_inline)) { ak0 = ldK(kt, tid); ak1 = ldK(kt, tid + 256); if (NKC == 3) ak2 = ldK(kt, tid + 512); av0 = ldV(kt, tid); av1 = ldV(kt, tid + 256); };
    auto loadB = [&](int kt) __attribute__((always_inline)) { bk0 = ldK(kt, tid); bk1 = ldK(kt, tid + 256); if (NKC == 3) bk2 = ldK(kt, tid + 512); bv0 = ldV(kt, tid); bv1 = ldV(kt, tid + 256); };
    auto stK = [&](bf16_t* kb, const uint4& r, int id) __attribute__((always_inline)) { const int row = id / KCH, part = id % KCH; *(uint4*)(kb + row * KSTR + part * 8) = r; };
    auto stV = [&](bf16_t* vb, const uint4& r, int id) __attribute__((always_inline)) { const int row = id >> 3, part = id & 7; bf16_t* d = vb + row * 68 + part * 8;
        *(uint2*)d = make_uint2(r.x, r.y); *(uint2*)(d + 4) = make_uint2(r.z, r.w); };
    auto compute = [&](int kt, const bf16_t* Kt, const bf16_t* Vt) __attribute__((always_inline)) {
        if (skipf(kt)) return;
#pragma unroll
        for (int sub = 0; sub < NSUB; ++sub) {
            const int tqs = tq + (QG ? 32 * sub : 0), t0s = t0w + (QG ? 32 * sub : 0);
            if (QG && kt * 64 > t0s + 31) continue;
            __builtin_amdgcn_sched_barrier(0);
            f32x16 s[2];
#pragma unroll
            for (int i = 0; i < 2; ++i) {
                s[i] = zero16();
#pragma unroll
                for (int ks = 0; ks < NKS; ++ks) {
                    const bf16x8 a = *(const bf16x8*)(Kt + (i * 32 + ql) * KSTR + koff + ((QG ? 0 : sub * NKS) + ks) * 16 + hh * 8);
                    s[i] = mfma32(a, qf[sub * NKS + ks], s[i]);
                }
            }
            float mx = kNeg;
            if (!maskf.full(kt, t0s)) {
                const int dlim = tqs - kt * 64 - 4 * hh;
                const bool on = maskf.on(kt);
#pragma unroll
                for (int i = 0; i < 2; ++i)
#pragma unroll
                    for (int r = 0; r < 16; ++r) {
                        const int kc = i * 32 + (r & 3) + 8 * (r >> 2);
                        s[i][r] = (on && maskf.ok(kc, dlim)) ? s[i][r] : kNeg;
                    }
            }
#pragma unroll
            for (int i = 0; i < 2; ++i)
#pragma unroll
                for (int r = 0; r < 16; ++r) mx = fmaxf(mx, s[i][r]);
            mx = fmaxf(mx, xor32f(mx, lane));
            const float mnew = fmaxf(m[sub], mx);
            const float alpha = __builtin_amdgcn_exp2f((m[sub] - mnew) * scl);
            m[sub] = mnew;
            const float negm = mnew > -1e29f ? -mnew * scl : 0.f;
            float sum = 0.f;
#pragma unroll
            for (int i = 0; i < 2; ++i)
#pragma unroll
                for (int r = 0; r < 16; ++r) { const float pv = __builtin_amdgcn_exp2f(__builtin_fmaf(s[i][r], scl, negm)); s[i][r] = pv; sum += pv; }
            l[sub] = l[sub] * alpha + sum;
            if (__builtin_amdgcn_ballot_w64(alpha != 1.f)) {
#pragma unroll
                for (int dt = 0; dt < 2; ++dt)
#pragma unroll
                    for (int r = 0; r < 16; ++r) o[sub][dt][r] *= alpha;
            }
            __builtin_amdgcn_sched_barrier(0);
#pragma unroll
            for (int ks = 0; ks < 4; ++ks) {
                if (ks == 2) __builtin_amdgcn_sched_barrier(0);
                const int i = ks >> 1, r0 = 8 * (ks & 1);
                uint4 pu;
                pu.x = pack2(s[i][r0 + 0], s[i][r0 + 1]); pu.y = pack2(s[i][r0 + 2], s[i][r0 + 3]);
                pu.z = pack2(s[i][r0 + 4], s[i][r0 + 5]); pu.w = pack2(s[i][r0 + 6], s[i][r0 + 7]);
                const bf16x8 pf = __builtin_bit_cast(bf16x8, pu);
#pragma unroll
                for (int dt = 0; dt < 2; ++dt) {
                    const bf16_t* vp = Vt + (dt * 32 + ql) * 68 + ks * 16 + 4 * hh;
                    const uint2 a0 = *(const uint2*)vp, a1 = *(const uint2*)(vp + 8);
                    const bf16x8 a = __builtin_bit_cast(bf16x8, make_uint4(a0.x, a0.y, a1.x, a1.y));
                    o[sub][dt] = mfma32(a, pf, o[sub][dt]);
                }
            }
        }
    };
    int ka = it.next();
    int kb = ka >= 0 ? it.next() : -1;
    if (ka >= 0) loadA(ka);
    if (kb >= 0) loadB(kb);
    while (ka >= 0) {
        __syncthreads();
        stK(Kb, ak0, tid); stK(Kb, ak1, tid + 256); if (NKC == 3) stK(Kb, ak2, tid + 512);
        stV(Vb, av0, tid); stV(Vb, av1, tid + 256);
        if (kb >= 0) {
            stK(Kb + KBUF, bk0, tid); stK(Kb + KBUF, bk1, tid + 256); if (NKC == 3) stK(Kb + KBUF, bk2, tid + 512);
            stV(Vb + VBUF, bv0, tid); stV(Vb + VBUF, bv1, tid + 256);
        }
        __syncthreads();
        const int na = it.next();
        const int nb = na >= 0 ? it.next() : -1;
        if (na >= 0) loadA(na);
        if (nb >= 0) loadB(nb);
        compute(ka, Kb, Vb);
        if (kb >= 0) compute(kb, Kb + KBUF, Vb + VBUF);
        ka = na; kb = nb;
    }
}

DEV void write_o(const f32x16 (&o)[2], bf16_t* obuf, size_t row, int col0, int hh) {
#pragma unroll
    for (int dt = 0; dt < 2; ++dt)
#pragma unroll
        for (int g = 0; g < 4; ++g) {
            const int d = dt * 32 + 8 * g + 4 * hh;
            uint2 u; u.x = pack2(o[dt][4 * g], o[dt][4 * g + 1]); u.y = pack2(o[dt][4 * g + 2], o[dt][4 * g + 3]);
            *(uint2*)(obuf + row * 1024 + col0 + d) = u;
        }
}
DEV float sigmoidf(float x) { return 1.f / (1.f + __expf(-x)); }

DEV void nsa_item(const Params& p, int layer, int b, int qb, char* smem) {
    int tid = threadIdx.x; asm volatile("" : "+v"(tid));
    const int lane = tid & 63, w = tid >> 6, ql = lane & 31, hh = lane >> 5;
    char* ws = p.ws;
    const bf16_t* cols = (const bf16_t*)(ws + OFF_COLS);
    const bf16_t* VT = (const bf16_t*)(ws + OFF_VT);
    bf16_t* obuf = (bf16_t*)(ws + OFF_O);
    const int t0 = qb * 32, tq = t0 + ql;
    const size_t Tb = (size_t)b * kS;
    const bf16_t* qrow = cols + (Tb + tq) * LDC;
    bf16x8 qf[4];
#pragma unroll
    for (int ks = 0; ks < 4; ++ks) qf[ks] = *(const bf16x8*)(qrow + w * 64 + ks * 16 + hh * 8);
    const float g0 = sigmoidf(bf2f(qrow[640 + w * 3 + 0])), g1 = sigmoidf(bf2f(qrow[640 + w * 3 + 1])), g2 = sigmoidf(bf2f(qrow[640 + w * 3 + 2]));
    const float scl = 0.125f * kLog2e;
    bf16_t* Kc = (bf16_t*)(smem + SM_K);
    bf16_t* Vc = (bf16_t*)(smem + SM_V);
    float* impP = (float*)(smem + SM_IMP);
    unsigned* selm = (unsigned*)(smem + SM_SEL);
    const float* gk = (const float*)(ws + OFF_QP) + (size_t)b * 128 * 128;
    const float* gv = gk + (size_t)1024 * 128;
    const float* bias = (const float*)(ws + OFF_MISC) + layer * 128;
    __syncthreads();
#pragma unroll
    for (int i = 0; i < 4; ++i) {
        const int id = tid + 256 * i, row = id >> 3, part = id & 7;
        const int row1 = row < 127 ? row + 1 : row;
        const float* a = gk + (size_t)row * 128 + part * 8;  const float* a2 = gk + (size_t)row1 * 128 + 64 + part * 8;
        const float* c = gv + (size_t)row * 128 + part * 8;  const float* c2 = gv + (size_t)row1 * 128 + 64 + part * 8;
        const float4 k0 = *(const float4*)a, k1 = *(const float4*)(a + 4), k2 = *(const float4*)a2, k3 = *(const float4*)(a2 + 4);
        const float4 v0 = *(const float4*)c, v1 = *(const float4*)(c + 4), v2 = *(const float4*)c2, v3 = *(const float4*)(c2 + 4);
        const float4 bk0 = *(const float4*)(bias + part * 8), bk1 = *(const float4*)(bias + part * 8 + 4);
        const float4 bv0 = *(const float4*)(bias + 64 + part * 8), bv1 = *(const float4*)(bias + 64 + part * 8 + 4);
        uint4 kk = make_uint4(pack2(k0.x + k2.x + bk0.x, k0.y + k2.y + bk0.y), pack2(k0.z + k2.z + bk0.z, k0.w + k2.w + bk0.w),
                              pack2(k1.x + k3.x + bk1.x, k1.y + k3.y + bk1.y), pack2(k1.z + k3.z + bk1.z, k1.w + k3.w + bk1.w));
        uint4 vv = make_uint4(pack2(v0.x + v2.x + bv0.x, v0.y + v2.y + bv0.y), pack2(v0.z + v2.z + bv0.z, v0.w + v2.w + bv0.w),
                              pack2(v1.x + v3.x + bv1.x, v1.y + v3.y + bv1.y), pack2(v1.z + v3.z + bv1.z, v1.w + v3.w + bv1.w));
        if (row == 127) { kk = make_uint4(0, 0, 0, 0); vv = kk; }
        *(uint4*)(Kc + row * 72 + part * 8) = kk;
        const unsigned u[4] = {vv.x, vv.y, vv.z, vv.w};
#pragma unroll
        for (int j = 0; j < 4; ++j) { Vc[(part * 8 + 2 * j) * 132 + row] = (bf16_t)(u[j] & 0xffffu); Vc[(part * 8 + 2 * j + 1) * 132 + row] = (bf16_t)(u[j] >> 16); }
    }
    __syncthreads();
    unsigned ocp[16];
    float* invs = (float*)(smem + SM_SEL) + 64;
    {
        const int cmaxv = tq >= 31 ? min((tq - 31) >> 4, 126) : -1;
        float mx = kNeg;
#pragma unroll 1
        for (int i = 0; i < 4; ++i) {
            f32x16 s = zero16();
#pragma unroll
            for (int ks = 0; ks < 4; ++ks) s = mfma32(*(const bf16x8*)(Kc + (i * 32 + ql) * 72 + ks * 16 + hh * 8), qf[ks], s);
            const int clim = cmaxv - i * 32 - 4 * hh;
#pragma unroll
            for (int r = 0; r < 16; ++r) {
                const int kc = (r & 3) + 8 * (r >> 2);
                const bool valid = (kc <= clim);
                mx = fmaxf(mx, valid ? s[r] * scl : kNeg);
            }
        }
        mx = fmaxf(mx, xor32f(mx, lane));
        f32x16 ocmp[2]; ocmp[0] = zero16(); ocmp[1] = zero16();
        float sum = 0.f, carprev = 0.f;
#pragma unroll 1
        for (int i = 0; i < 4; ++i) {
            f32x16 s = zero16();
#pragma unroll
            for (int ks = 0; ks < 4; ++ks) s = mfma32(*(const bf16x8*)(Kc + (i * 32 + ql) * 72 + ks * 16 + hh * 8), qf[ks], s);
            const int clim = cmaxv - i * 32 - 4 * hh;
#pragma unroll
            for (int r = 0; r < 16; ++r) {
                const int kc = (r & 3) + 8 * (r >> 2);
                const bool valid = (kc <= clim);
                const float pv = valid ? __builtin_amdgcn_exp2f(s[r] * scl - mx) : 0.f;
                s[r] = pv; sum += pv;
            }
            float own[4], car[4];
#pragma unroll
            for (int g = 0; g < 4; ++g) { own[g] = s[4 * g] + s[4 * g + 1] + s[4 * g + 2] + 0.5f * s[4 * g + 3]; car[g] = 0.5f * s[4 * g + 3]; }
#pragma unroll
            for (int g = 0; g < 4; ++g) {
                const float send = hh ? (g ? car[g > 0 ? g - 1 : 0] : carprev) : car[g];
                own[g] += xor32f(send, lane);
            }
            carprev = car[3];
#pragma unroll
            for (int g = 0; g < 4; ++g) impP[(w * 32 + ql) * 33 + 2 * (4 * i + g) + hh] = own[g];
#pragma unroll
            for (int sp = 0; sp < 2; ++sp) {
                const int ks = 2 * i + sp, r0 = 8 * sp;
                uint4 pu;
                pu.x = pack2(s[r0 + 0], s[r0 + 1]); pu.y = pack2(s[r0 + 2], s[r0 + 3]);
                pu.z = pack2(s[r0 + 4], s[r0 + 5]); pu.w = pack2(s[r0 + 6], s[r0 + 7]);
                const bf16x8 pf = __builtin_bit_cast(bf16x8, pu);
#pragma unroll
                for (int dt = 0; dt < 2; ++dt) {
                    const bf16_t* vp = Vc + (dt * 32 + ql) * 132 + ks * 16 + 4 * hh;
                    const uint2 a0 = *(const uint2*)vp, a1 = *(const uint2*)(vp + 8);
                    ocmp[dt] = mfma32(__builtin_bit_cast(bf16x8, make_uint4(a0.x, a0.y, a1.x, a1.y)), pf, ocmp[dt]);
                }
            }
        }
        sum += xor32f(sum, lane);
        const float inv = sum > 0.f ? 1.f / sum : 0.f;
        invs[w * 32 + ql] = inv;
        const float f = g0 * inv;
#pragma unroll
        for (int dt = 0; dt < 2; ++dt)
#pragma unroll
            for (int r = 0; r < 8; ++r) ocp[dt * 8 + r] = pack2(f * ocmp[dt][2 * r], f * ocmp[dt][2 * r + 1]);
    }
    __syncthreads();
    const int qblk = t0 >> 6;
    {
        const int hw = tid >> 5, j = tid & 31;
#pragma unroll 1
        for (int rr = 0; rr < 4; ++rr) {
            const int row = hw * 4 + rr;
            const float v = impP[(0 * 32 + row) * 33 + j] * invs[row] + impP[(1 * 32 + row) * 33 + j] * invs[32 + row]
                          + impP[(2 * 32 + row) * 33 + j] * invs[64 + row] + impP[(3 * 32 + row) * 33 + j] * invs[96 + row];
            bool sel;
            if (qblk < 16) sel = (j <= qblk);
            else {
                const bool cand = (j >= 1) && (j <= qblk - 2);
                const bool forced = (j == 0) || (j == qblk) || (j == qblk - 1);
                int rank = 0;
                for (int j2 = 1; j2 <= qblk - 2; ++j2) {
                    const float v2 = lanef(v, (lane & 32) + j2);
                    rank += (v2 > v || (v2 == v && j2 < j)) ? 1 : 0;
                }
                sel = forced || (cand && rank < 13);
            }
            const unsigned long long bal = __ballot(sel);
            const unsigned mk = (lane & 32) ? (unsigned)(bal >> 32) : (unsigned)bal;
            if (j == 0) selm[row] = mk;
        }
    }
    __syncthreads();
    const unsigned mysel = selm[ql];
    unsigned U = mysel, Uall = mysel;
#pragma unroll
    for (int o = 16; o > 0; o >>= 1) { U |= (unsigned)__builtin_amdgcn_ds_bpermute((lane ^ o) << 2, (int)U); Uall &= (unsigned)__builtin_amdgcn_ds_bpermute((lane ^ o) << 2, (int)Uall); }
    Uall = (unsigned)__builtin_amdgcn_readfirstlane((int)Uall);
    {
        f32x16 o1[1][2]; o1[0][0] = zero16(); o1[0][1] = zero16();
        float m1[1] = {kNeg}, l1[1] = {0.f};
        auto skipf = [&](int) __attribute__((always_inline)) { return false; };
        attn_stream<64, 4, 1, false>(BitIter{U}, LdRow{cols + Tb * LDC + 384, LDC}, LdVT{VT + (size_t)(b * 12 + 0) * 64 * 2048}, MaskSel{mysel, Uall}, skipf, qf, o1, m1, l1, scl, tq, __builtin_amdgcn_readfirstlane(t0), smem, tid);
        const float lt = l1[0] + xor32f(l1[0], lane);
        const float f = g1 / lt;
#pragma unroll
        for (int dt = 0; dt < 2; ++dt)
#pragma unroll
            for (int r = 0; r < 8; ++r) ocp[dt * 8 + r] = pack2(lo16(ocp[dt * 8 + r]) + f * o1[0][dt][2 * r], hi16(ocp[dt * 8 + r]) + f * o1[0][dt][2 * r + 1]);
    }
    {
        f32x16 o1[1][2]; o1[0][0] = zero16(); o1[0][1] = zero16();
        float m1[1] = {kNeg}, l1[1] = {0.f};
        auto skipf = [&](int) __attribute__((always_inline)) { return false; };
        const int lo = t0 >= 511 ? ((t0 - 511) >> 6) : 0;
        attn_stream<64, 4, 1, false>(RangeIter{lo, qblk + 1}, LdRow{cols + Tb * LDC + 512, LDC}, LdVT{VT + (size_t)(b * 12 + 1) * 64 * 2048}, MaskWin<512>{}, skipf, qf, o1, m1, l1, scl, tq, __builtin_amdgcn_readfirstlane(t0), smem, tid);
        const float lt = l1[0] + xor32f(l1[0], lane);
        const float f = g2 / lt;
#pragma unroll
        for (int dt = 0; dt < 2; ++dt)
#pragma unroll
            for (int r = 0; r < 8; ++r) { o1[0][dt][2 * r] = lo16(ocp[dt * 8 + r]) + f * o1[0][dt][2 * r]; o1[0][dt][2 * r + 1] = hi16(ocp[dt * 8 + r]) + f * o1[0][dt][2 * r + 1]; }
        write_o(o1[0], obuf, Tb + tq, w * 64, hh);
    }
}

DEV void diff_item(const Params& p, int layer, int b, int hd, int qc, char* smem) {
    int tid = threadIdx.x; asm volatile("" : "+v"(tid));
    const int lane = tid & 63, w = tid >> 6, ql = lane & 31, hh = lane >> 5;
    const int sub = w & 1, qh = w >> 1;
    char* ws = p.ws;
    const bf16_t* cols = (const bf16_t*)(ws + OFF_COLS);
    const bf16_t* VT = (const bf16_t*)(ws + OFF_VT);
    bf16_t* obuf = (bf16_t*)(ws + OFF_O);
    const float* misc = (const float*)(ws + OFF_MISC);
    const int t0w = qc * 128 + qh * 64, tq = t0w + ql;
    const size_t Tb = (size_t)b * kS;
    bf16x8 qf[4];
#pragma unroll
    for (int g = 0; g < 2; ++g)
#pragma unroll
        for (int ks = 0; ks < 2; ++ks) qf[g * 2 + ks] = *(const bf16x8*)(cols + (Tb + tq + 32 * g) * LDC + 704 + hd * 64 + sub * 32 + ks * 16 + hh * 8);
    const float scl = 0.17677669529663687f * kLog2e;
    f32x16 o2[2][2];
#pragma unroll
    for (int g = 0; g < 2; ++g) { o2[g][0] = zero16(); o2[g][1] = zero16(); }
    float m2[2] = {kNeg, kNeg}, l2[2] = {0.f, 0.f};
    auto skipf = [&](int kt) __attribute__((always_inline)) { return kt * 64 > t0w + 63; };
    attn_stream<64, 2, 2, true>(RangeIter{0, 2 * qc + 2}, LdRow{cols + Tb * LDC + 960 + hd * 64, LDC}, LdVT{VT + (size_t)(b * 12 + 2 + hd) * 64 * 2048}, MaskCausal{}, skipf, qf, o2, m2, l2, scl, tq, __builtin_amdgcn_readfirstlane(t0w), smem, tid, sub * 32);
    const float lam = misc[256 + layer], post = misc[258 + layer];
    float* ex = (float*)smem;
    __syncthreads();
#pragma unroll
    for (int g = 0; g < 2; ++g) {
        const float lt = l2[g] + xor32f(l2[g], lane);
        if (sub == 1) {
            const float f = lam / lt;
#pragma unroll
            for (int dt = 0; dt < 2; ++dt)
#pragma unroll
                for (int r = 0; r < 16; ++r) ex[(((qh * 2 + g) * 2 + dt) * 16 + r) * 64 + lane] = o2[g][dt][r] * f;
        } else {
            const float f = 1.f / lt;
#pragma unroll
            for (int dt = 0; dt < 2; ++dt)
#pragma unroll
                for (int r = 0; r < 16; ++r) o2[g][dt][r] *= f;
        }
    }
    __syncthreads();
    if (sub == 0) {
        const float* sg = p.sub_g + layer * 64;
#pragma unroll
        for (int g = 0; g < 2; ++g) {
            float ss = 0.f;
#pragma unroll
            for (int dt = 0; dt < 2; ++dt)
#pragma unroll
                for (int r = 0; r < 16; ++r) { const float v = o2[g][dt][r] - ex[(((qh * 2 + g) * 2 + dt) * 16 + r) * 64 + lane]; o2[g][dt][r] = v; ss += v * v; }
            ss += xor32f(ss, lane);
            const float rstd = rsqrtf(ss * (1.f / 64.f) + kEps) * post;
#pragma unroll
            for (int dt = 0; dt < 2; ++dt)
#pragma unroll
                for (int r = 0; r < 16; ++r) { const int d = dt * 32 + (r & 3) + 8 * (r >> 2) + 4 * hh; o2[g][dt][r] *= rstd * sg[d]; }
            write_o(o2[g], obuf, Tb + tq + 32 * g, 256 + hd * 64, hh);
        }
    }
}

DEV void mla_item(const Params& p, int b, int hd, int qc, char* smem) {
    int tid = threadIdx.x; asm volatile("" : "+v"(tid));
    const int lane = tid & 63, w = tid >> 6, ql = lane & 31, hh = lane >> 5;
    char* ws = p.ws;
    const bf16_t* cols = (const bf16_t*)(ws + OFF_COLS);
    const bf16_t* VT = (const bf16_t*)(ws + OFF_VT);
    const bf16_t* qmla = (const bf16_t*)(ws + OFF_QMLA);
    const bf16_t* kvmla = (const bf16_t*)(ws + OFF_KVMLA);
    bf16_t* obuf = (bf16_t*)(ws + OFF_O);
    const int t0w = qc * 128 + w * 32, tq = t0w + ql;
    const size_t Tb = (size_t)b * kS;
    const bf16_t* qrow = qmla + (Tb + tq) * 384 + hd * 96;
    bf16x8 qf[6];
#pragma unroll
    for (int ks = 0; ks < 6; ++ks) qf[ks] = *(const bf16x8*)(qrow + ks * 16 + hh * 8);
    const float scl = 0.10206207261596575f * kLog2e;
    f32x16 o1[1][2]; o1[0][0] = zero16(); o1[0][1] = zero16();
    float m1[1] = {kNeg}, l1[1] = {0.f};
    auto skipf = [&](int kt) __attribute__((always_inline)) { return kt * 64 > t0w + 31; };
    attn_stream<96, 6, 1, false>(RangeIter{0, 2 * qc + 2}, LdMlaK{kvmla + Tb * 512 + hd * 128, cols + Tb * LDC + 1856}, LdVT{VT + (size_t)(b * 12 + 8 + hd) * 64 * 2048}, MaskCausal{}, skipf, qf, o1, m1, l1, scl, tq, __builtin_amdgcn_readfirstlane(t0w), smem, tid);
    const float inv = 1.f / (l1[0] + xor32f(l1[0], lane));
#pragma unroll
    for (int dt = 0; dt < 2; ++dt)
#pragma unroll
        for (int r = 0; r < 16; ++r) o1[0][dt][r] *= inv;
    write_o(o1[0], obuf, Tb + tq, 512 + hd * 64, hh);
}

DEV void swa_item(const Params& p, int layer, int b, int g, int q64, char* smem) {
    int tid = threadIdx.x; asm volatile("" : "+v"(tid));
    const int lane = tid & 63, w = tid >> 6, ql = lane & 31, hh = lane >> 5;
    char* ws = p.ws;
    const bf16_t* cols = (const bf16_t*)(ws + OFF_COLS);
    const bf16_t* VT = (const bf16_t*)(ws + OFF_VT);
    bf16_t* obuf = (bf16_t*)(ws + OFF_O);
    const int head = g * 2 + (w & 1);
    const int t0w = q64 * 64 + (w >> 1) * 32, tq = t0w + ql;
    const size_t Tb = (size_t)b * kS;
    const bf16_t* qrow = cols + (Tb + tq) * LDC + 1920 + head * 64;
    bf16x8 qf[4];
#pragma unroll
    for (int ks = 0; ks < 4; ++ks) qf[ks] = *(const bf16x8*)(qrow + ks * 16 + hh * 8);
    const float scl = 0.125f * kLog2e;
    f32x16 o1[1][2]; o1[0][0] = zero16(); o1[0][1] = zero16();
    float m1[1] = {p.sinks[layer * 4 + head] * 8.f}, l1[1] = {hh == 0 ? 1.f : 0.f};
    auto skipf = [&](int kt) __attribute__((always_inline)) { return (kt * 64 > t0w + 31) || (kt * 64 + 63 < t0w - 127); };
    const int lo = q64 >= 2 ? q64 - 2 : 0;
    attn_stream<64, 4, 1, false>(RangeIter{lo, q64 + 1}, LdRow{cols + Tb * LDC + 2176 + g * 64, LDC}, LdVT{VT + (size_t)(b * 12 + 6 + g) * 64 * 2048}, MaskWin<128>{}, skipf, qf, o1, m1, l1, scl, tq, __builtin_amdgcn_readfirstlane(t0w), smem, tid);
    const float inv = 1.f / (l1[0] + xor32f(l1[0], lane));
#pragma unroll
    for (int dt = 0; dt < 2; ++dt)
#pragma unroll
        for (int r = 0; r < 16; ++r) o1[0][dt][r] *= inv;
    write_o(o1[0], obuf, Tb + tq, 768 + head * 64, hh);
}

DEV void phase_attn(const Params& p, int layer, char* smem, int rep = 0) {
    unsigned* ctr = (unsigned*)(p.ws + OFF_CTRL) + 64 + layer * 16 + rep;
    volatile int* slot = (volatile int*)(smem + SM_SEL) + 48;
    for (;;) {
        __syncthreads();
        if (ltid() == 0) *slot = (int)atomicAdd(ctr, 1u);
        __syncthreads();
        const int idx = __builtin_amdgcn_readfirstlane(*slot);
        if (idx >= 2048) break;
        const int level = 15 - (idx >> 7), r = idx & 127;
#if TS_A >= 0
        const unsigned long long tsa = __builtin_amdgcn_s_memrealtime();
#endif
        if (r < 32) { diff_item(p, layer, r >> 2, r & 3, level, smem); }
        else if (r < 64) { const int k = r - 32; mla_item(p, k >> 2, k & 3, level, smem); }
        else if (r < 96) { const int k = r - 64; nsa_item(p, layer, k >> 2, level * 4 + (3 - (k & 3)), smem); }
        else { const int k = r - 96; swa_item(p, layer, k >> 2, (k >> 1) & 1, level * 2 + (k & 1), smem); }
#if TS_A >= 0
        if (threadIdx.x == 0 && layer == 1) {
            const int ty = r >> 5;
            unsigned long long* ts = (unsigned long long*)(p.ws + 32768);
            atomicAdd(&ts[60 + ty], (unsigned long long)(__builtin_amdgcn_s_memrealtime() - tsa));
        }
#endif
    }
}

#define XB_TMO      128
#define XB_XCNT(j)  (256  + 64 * (j))
#define XB_XSUB(j)  (1280 + 64 * (j))
#define XB_XGEN(j)  (2304 + 64 * (j))
#define XB_TOP      3328
#define XB_TOPGEN   3392
#define XB_SPIN_CAP (1u << 22)
DEV unsigned xb_ld(unsigned* p) { return __hip_atomic_load(p, __ATOMIC_RELAXED, __HIP_MEMORY_SCOPE_AGENT); }
DEV unsigned xb_add(unsigned* p, unsigned v) { return __hip_atomic_fetch_add(p, v, __ATOMIC_RELAXED, __HIP_MEMORY_SCOPE_AGENT); }
DEV unsigned xb_xcc_id() { return (unsigned)__builtin_amdgcn_s_getreg((3 << 11) | 20) & 0xFu; }
#define XB_SPIN(cond, bar) do { unsigned _sp = 0; while (cond) { __builtin_amdgcn_s_sleep(1); \
    if ((++_sp & 255u) == 0u) { if (xb_ld(&(bar)[XB_TMO])) break; if (_sp > XB_SPIN_CAP) { atomicAdd(&(bar)[XB_TMO], 1u); break; } } } } while (0)
struct XcdBarrier { unsigned* bar; unsigned x; volatile LAS unsigned* st; };
DEV XcdBarrier xcd_barrier_post(unsigned* bar, volatile LAS unsigned* st) {
    XcdBarrier b; b.bar = bar; b.x = xb_xcc_id(); b.st = st;
    if (threadIdx.x == 0) st[2] = xb_add(&bar[XB_XCNT(b.x)], 1u);
    return b;
}
DEV void xcd_barrier_complete(unsigned* bar, unsigned x, unsigned& nloc, unsigned& nx) {
    const unsigned G = gridDim.x * gridDim.y * gridDim.z;
    unsigned sum, cnt, mine, sp = 0u;
    for (;;) {
        sum = 0u; cnt = 0u; mine = 0u;
#pragma unroll
        for (unsigned j = 0; j < 16; ++j) { const unsigned c = xb_ld(&bar[XB_XCNT(j)]); sum += c; cnt += (c > 0u) ? 1u : 0u; mine = (j == x) ? c : mine; }
        if (sum == G) break;
        __builtin_amdgcn_s_sleep(1);
        if ((++sp & 255u) == 0u) { if (xb_ld(&bar[XB_TMO])) break; if (sp > XB_SPIN_CAP) { atomicAdd(&bar[XB_TMO], 1u); break; } }
    }
    nloc = mine > 0u ? mine : 1u; nx = cnt > 0u ? cnt : 1u;
}
DEV void xcd_barrier(const XcdBarrier& b) {
    asm volatile("s_waitcnt vmcnt(0)" ::: "memory");
    __syncthreads();
    if (threadIdx.x == 0) {
        unsigned* bar = b.bar;
        asm volatile("" : "+v"(bar));
        __builtin_amdgcn_s_waitcnt(0);
        unsigned nloc = b.st[0], nx = b.st[1];
        if (nloc == 0u) { xcd_barrier_complete(bar, b.x, nloc, nx); b.st[0] = nloc; b.st[1] = nx; }
        const unsigned old = xb_add(&bar[XB_XSUB(b.x)], 1u);
        const unsigned gen = old / nloc;
        if (old + 1u == (gen + 1u) * nloc) {
            __builtin_amdgcn_fence(__ATOMIC_RELEASE, "agent");
            asm volatile("s_waitcnt vmcnt(0)" ::: "memory");
            const unsigned og = xb_add(&bar[XB_TOP], 1u);
            const unsigned tg = og / nx;
            if (og + 1u == (tg + 1u) * nx) xb_add(&bar[XB_TOPGEN], 1u);
            else XB_SPIN(xb_ld(&bar[XB_TOPGEN]) == tg, bar);
            __builtin_amdgcn_fence(__ATOMIC_ACQUIRE, "agent");
            xb_add(&bar[XB_XGEN(b.x)], 1u);
            asm volatile("s_waitcnt vmcnt(0)" ::: "memory");
        } else {
            XB_SPIN(xb_ld(&bar[XB_XGEN(b.x)]) == gen, bar);
            __builtin_amdgcn_fence(__ATOMIC_ACQUIRE, "agent");
            asm volatile("s_waitcnt vmcnt(0)" ::: "memory");
        }
    }
    __syncthreads();
}

DEV unsigned fkey(float f) { const unsigned u = __float_as_uint(f); return (u & 0x80000000u) ? ~u : (u | 0x80000000u); }
DEV float funkey(unsigned k) { return __uint_as_float((k & 0x80000000u) ? (k & 0x7fffffffu) : ~k); }
DEV void ins16(unsigned (&L)[16], unsigned x) {
#pragma unroll
    for (int i = 15; i >= 1; --i) { unsigned r; asm("v_med3_u32 %0, %1, %2, %3" : "=v"(r) : "v"(L[i - 1]), "v"(L[i]), "v"(x)); L[i] = r; }
    L[0] = L[0] > x ? L[0] : x;
}
DEV void phase_topk(const Params& p, char* smem) {
    const int tid = ltid();
    const float* S1 = (const float*)(p.ws + OFF_S1);
    const float* S2 = (const float*)(p.ws + OFF_S2);
    int* eid = (int*)(p.ws + OFF_EID);
    float* gate = (float*)(p.ws + OFF_GATE);
    unsigned char* ib = (unsigned char*)smem + tid * 32;
    for (int blk = blockIdx.x; blk < kT * 8 / 256; blk += gridDim.x) {
        const size_t row = (size_t)blk * 256 + tid;
        unsigned L1[16], L2[16];
#pragma unroll
        for (int i = 0; i < 16; ++i) { L1[i] = 0u; L2[i] = 0u; }
#pragma unroll 4
        for (int k = 0; k < 128; ++k) {
            const float a = S1[(size_t)k * (kT * 8) + row], b = S2[(size_t)k * (kT * 8) + row];
            ins16(L1, (fkey(a) & ~127u) | (unsigned)(127 - k));
            ins16(L2, (fkey(b) & ~127u) | (unsigned)(127 - k));
        }
        float v1[16], v2[16];
        __syncthreads();
#pragma unroll
        for (int i = 0; i < 16; ++i) {
            v1[i] = funkey(L1[i] & ~127u); v2[i] = funkey(L2[i] & ~127u);
            ib[i] = (unsigned char)(127u - (L1[i] & 127u)); ib[16 + i] = (unsigned char)(127u - (L2[i] & 127u));
        }
        unsigned C[16];
#pragma unroll
        for (int i = 0; i < 16; ++i) C[i] = 0u;
#pragma unroll
        for (int a = 0; a < 16; ++a)
#pragma unroll
            for (int b = 0; b < 16; ++b)
                if ((a + 1) * (b + 1) <= 16) ins16(C, (fkey(v1[a] + v2[b]) & ~255u) | (unsigned)(255 - (a * 16 + b)));
        float ts[16]; float sum = 0.f;
        const float tmax = funkey(C[0] & ~255u);
#pragma unroll
        for (int i = 0; i < 16; ++i) { ts[i] = __expf(funkey(C[i] & ~255u) - tmax); sum += ts[i]; }
        const float inv = 1.f / sum;
        int ev[16];
#pragma unroll
        for (int i = 0; i < 16; ++i) { const unsigned ci = 255u - (C[i] & 255u); ev[i] = (int)ib[ci >> 4] * 128 + (int)ib[16 + (ci & 15u)]; }
#pragma unroll
        for (int i = 0; i < 4; ++i) {
            *(int4*)(eid + row * 16 + 4 * i) = make_int4(ev[4 * i], ev[4 * i + 1], ev[4 * i + 2], ev[4 * i + 3]);
            *(float4*)(gate + row * 16 + 4 * i) = make_float4(ts[4 * i] * inv, ts[4 * i + 1] * inv, ts[4 * i + 2] * inv, ts[4 * i + 3] * inv);
        }
    }
}

struct EpiTop16 {
    unsigned (&L)[16];
    DEV void tile(int, int, const float* Cs, int tid) const {
        const int r = tid & 127, hk = tid >> 7;
        unsigned T[16];
#pragma unroll
        for (int i = 0; i < 16; ++i) T[i] = 0u;
#pragma unroll 4
        for (int k = 0; k < 64; ++k) {
            const int key = hk * 64 + k;
            ins16(T, (fkey(Cs[key * 128 + r]) & ~127u) | (unsigned)(127 - key));
        }
        __syncthreads();
        unsigned* X = (unsigned*)Cs;
        if (hk) {
#pragma unroll
            for (int i = 0; i < 16; ++i) X[r * 17 + i] = T[i];
        }
        __syncthreads();
        if (!hk) {
#pragma unroll
            for (int i = 0; i < 16; ++i) ins16(T, X[r * 17 + i]);
        }
#pragma unroll
        for (int i = 0; i < 16; ++i) L[i] = T[i];
    }
};
DEV void phase_route(const Params& p, int layer, char* smem) {
    char* ws = p.ws;
    int* eid = (int*)(ws + OFF_EID);
    float* gate = (float*)(ws + OFF_GATE);
    const bf16_t* qp = (const bf16_t*)(ws + OFF_QP);
    const bf16_t* subk = (const bf16_t*)(ws + OFF_SUBK) + (size_t)(layer * 2) * 16384;
    for (int nt = blockIdx.x; nt < kT * 8 / 128; nt += gridDim.x) {
        unsigned L1[16], L2[16];
        { EpiTop16 e1{L1}; gemm_tile(subk, 128, qp, 256, 128, 0, nt * 128, smem, e1); }
        { EpiTop16 e2{L2}; gemm_tile(subk + 16384, 128, qp + 128, 256, 128, 0, nt * 128, smem, e2); }
        const int tid = ltid();
        __syncthreads();
        if (tid < 128) {
            const size_t row = (size_t)nt * 128 + tid;
            unsigned char* ib = (unsigned char*)smem + tid * 32;
            float v1[16], v2[16];
#pragma unroll
            for (int i = 0; i < 16; ++i) {
                v1[i] = funkey(L1[i] & ~127u); v2[i] = funkey(L2[i] & ~127u);
                ib[i] = (unsigned char)(127u - (L1[i] & 127u)); ib[16 + i] = (unsigned char)(127u - (L2[i] & 127u));
            }
            unsigned C[16];
#pragma unroll
            for (int i = 0; i < 16; ++i) C[i] = 0u;
#pragma unroll
            for (int a = 0; a < 16; ++a)
#pragma unroll
                for (int b = 0; b < 16; ++b)
                    if ((a + 1) * (b + 1) <= 16) ins16(C, (fkey(v1[a] + v2[b]) & ~255u) | (unsigned)(255 - (a * 16 + b)));
            float ts[16]; float sum = 0.f;
            const float tmax = funkey(C[0] & ~255u);
#pragma unroll
            for (int i = 0; i < 16; ++i) { ts[i] = __expf(funkey(C[i] & ~255u) - tmax); sum += ts[i]; }
            const float inv = 1.f / sum;
            int ev[16];
#pragma unroll
            for (int i = 0; i < 16; ++i) { const unsigned ci = 255u - (C[i] & 255u); ev[i] = (int)ib[ci >> 4] * 128 + (int)ib[16 + (ci & 15u)]; }
#pragma unroll
            for (int i = 0; i < 4; ++i) {
                *(int4*)(eid + row * 16 + 4 * i) = make_int4(ev[4 * i], ev[4 * i + 1], ev[4 * i + 2], ev[4 * i + 3]);
                *(float4*)(gate + row * 16 + 4 * i) = make_float4(ts[4 * i] * inv, ts[4 * i + 1] * inv, ts[4 * i + 2] * inv, ts[4 * i + 3] * inv);
            }
        }
    }
}

DEV float row_sum_dpp(float v) {
    v += __int_as_float(__builtin_amdgcn_update_dpp(0, __float_as_int(v), 0xB1, 0xF, 0xF, true));
    v += __int_as_float(__builtin_amdgcn_update_dpp(0, __float_as_int(v), 0x4E, 0xF, 0xF, true));
    v += __int_as_float(__builtin_amdgcn_update_dpp(0, __float_as_int(v), 0x141, 0xF, 0xF, true));
    v += __int_as_float(__builtin_amdgcn_update_dpp(0, __float_as_int(v), 0x140, 0xF, 0xF, true));
    return v;
}
DEV float wave_sum_dpp(float v) {
    v = row_sum_dpp(v);
    const float r0 = __int_as_float(__builtin_amdgcn_readlane(__float_as_int(v), 0)), r1 = __int_as_float(__builtin_amdgcn_readlane(__float_as_int(v), 16));
    const float r2 = __int_as_float(__builtin_amdgcn_readlane(__float_as_int(v), 32)), r3 = __int_as_float(__builtin_amdgcn_readlane(__float_as_int(v), 48));
    return (r0 + r1) + (r2 + r3);
}
typedef float f32x2 __attribute__((ext_vector_type(2)));
typedef float f32x4 __attribute__((ext_vector_type(4)));

struct SliceMap { int virt, nx, nloc, rank; };
DEV SliceMap slice_map(const Params& p, char* smem) {
    unsigned* bar = (unsigned*)p.ws;
    const unsigned x = xb_xcc_id();
    int virt = 0, nx = 0, nloc = 1;
#pragma unroll
    for (unsigned j = 0; j < 16; ++j) {
        const unsigned c = xb_ld(&bar[XB_XCNT(j)]);
        if (c > 0u) { if (j < x) ++virt; ++nx; }
        if (j == x) nloc = (int)c;
    }
    SliceMap m;
    m.virt = __builtin_amdgcn_readfirstlane(virt); m.nx = __builtin_amdgcn_readfirstlane(nx > 0 ? nx : 1); m.nloc = __builtin_amdgcn_readfirstlane(nloc > 0 ? nloc : 1);
    m.rank = __builtin_amdgcn_readfirstlane((int)((volatile LAS unsigned*)(smem + SM_CTRL))[2]);
    return m;
}

typedef _Float16 half2_t __attribute__((ext_vector_type(2)));
DEV void phase_peer_u(const Params& p, int layer, char* smem, int rep = 0) {
    const int tid = ltid(), lane = tid & 63, w = tid >> 6, l8 = lane & 7, grp = lane >> 3;
    char* ws = p.ws;
    const SliceMap sm = slice_map(p, smem);
    const bf16_t* h = (const bf16_t*)(ws + OFF_H);
    const int* eid = (const int*)(ws + OFF_EID);
    float* part = (float*)(ws + OFF_S1) + (rep ? (size_t)8 * kT * 128 : 0);
    int* ids_l = (int*)(smem + w * 9216);
    const int nk = sm.rank < 512 ? (512 - sm.rank + sm.nloc - 1) / sm.nloc : 0;
    for (int s = sm.virt; s < 8; s += sm.nx) {
        if (nk == 0) break;
        const unsigned char* U = (const unsigned char*)(ws + OFF_PU) + (((size_t)layer * 8 + s) * 16384 << 7) + l8 * 16;
        uint4 ri0, ri1, ri2, ri3, rh0, rh1;
        auto load_oct = [&](int k) __attribute__((always_inline)) {
            const size_t o = (size_t)(sm.rank + k * sm.nloc) * 4 + w;
            const uint4* ip = (const uint4*)(eid + o * 1024) + lane;
            ri0 = ip[0]; ri1 = ip[64]; ri2 = ip[128]; ri3 = ip[192];
            const bf16_t* hp = h + (o * 8 + grp) * 1024 + s * 128 + l8 * 16;
            rh0 = *(const uint4*)hp; rh1 = *(const uint4*)(hp + 8);
        };
        half2_t hh[8];
        auto store_oct = [&]() __attribute__((always_inline)) {
            uint4* il = (uint4*)ids_l + lane;
            il[0] = ri0; il[64] = ri1; il[128] = ri2; il[192] = ri3;
            const unsigned hu[8] = {rh0.x, rh0.y, rh0.z, rh0.w, rh1.x, rh1.y, rh1.z, rh1.w};
#pragma unroll
            for (int i = 0; i < 8; ++i) hh[i] = (half2_t){(_Float16)lo16(hu[i]), (_Float16)hi16(hu[i])};
        };
        load_oct(0); store_oct();
#pragma unroll 1
        for (int k = 0; k < nk; ++k) {
            if (k + 1 < nk) load_oct(k + 1);
            const size_t o = (size_t)(sm.rank + k * sm.nloc) * 4 + w;
            float* pp = part + ((size_t)s * kT + o * 8 + grp) * 128 + l8;
            uint4 va[8], vb[8];
            auto issue = [&](uint4 (&v)[8], int c) __attribute__((always_inline)) {
                const int4 i0 = *(const int4*)(ids_l + grp * 128 + c * 8), i1 = *(const int4*)(ids_l + grp * 128 + c * 8 + 4);
                const int e[8] = {i0.x, i0.y, i0.z, i0.w, i1.x, i1.y, i1.z, i1.w};
#pragma unroll
                for (int j = 0; j < 8; ++j) v[j] = *(const uint4*)(U + ((size_t)e[j] << 7));
            };
            auto compute = [&](const uint4 (&v)[8], int c) __attribute__((always_inline)) {
                float res = 0.f;
#pragma unroll
                for (int j = 0; j < 8; ++j) {
                    const unsigned d[4] = {v[j].x, v[j].y, v[j].z, v[j].w};
                    float acc = 0.f;
#pragma unroll
                    for (int q = 0; q < 4; ++q) {
                        const half2_t lo = __builtin_amdgcn_cvt_scalef32_pk_f16_fp8(d[q], 1.0f, false);
                        const half2_t hi = __builtin_amdgcn_cvt_scalef32_pk_f16_fp8(d[q], 1.0f, true);
                        acc = __builtin_amdgcn_fdot2(lo, hh[2 * q], acc, false);
                        acc = __builtin_amdgcn_fdot2(hi, hh[2 * q + 1], acc, false);
                    }
                    acc += __int_as_float(__builtin_amdgcn_update_dpp(0, __float_as_int(acc), 0xB1, 0xF, 0xF, true));
                    acc += __int_as_float(__builtin_amdgcn_update_dpp(0, __float_as_int(acc), 0x4E, 0xF, 0xF, true));
                    acc += __int_as_float(__builtin_amdgcn_update_dpp(0, __float_as_int(acc), 0x141, 0xF, 0xF, true));
                    res = (l8 == j) ? acc : res;
                    __builtin_amdgcn_sched_barrier(0);
                }
                pp[c * 8] = res;
            };
            issue(va, 0);
#pragma unroll
            for (int c = 0; c < 16; c += 2) {
                issue(vb, c + 1);
                __builtin_amdgcn_sched_barrier(0);
                compute(va, c);
                __builtin_amdgcn_sched_barrier(0);
                if (c + 2 < 16) issue(va, c + 2);
                __builtin_amdgcn_sched_barrier(0);
                compute(vb, c + 1);
                __builtin_amdgcn_sched_barrier(0);
            }
            if (k + 1 < nk) store_oct();
        }
    }
}

DEV void phase_peer_comb(const Params& p, int rep = 0) {
    const int tid = ltid();
    const float* part = (const float*)(p.ws + OFF_S1);
    float* gate = (float*)(p.ws + OFF_GATE);
    for (size_t i = (size_t)blockIdx.x * 256 + tid; i < (size_t)kT * 128 / 4; i += (size_t)gridDim.x * 256) {
        float4 a = *(const float4*)(part + i * 4);
#pragma unroll
        for (int x = 1; x < 8; ++x) { const float4 b = *(const float4*)(part + (size_t)x * kT * 128 + i * 4); a.x += b.x; a.y += b.y; a.z += b.z; a.w += b.w; }
        const float4 g = *(const float4*)(gate + i * 4);
        float4 o;
        o.x = g.x * gelu_tanh(a.x * (1.f / kScaleU)); o.y = g.y * gelu_tanh(a.y * (1.f / kScaleU));
        o.z = g.z * gelu_tanh(a.z * (1.f / kScaleU)); o.w = g.w * gelu_tanh(a.w * (1.f / kScaleU));
        if (rep == 0) *(float4*)(gate + i * 4) = o;
    }
}

DEV void phase_peer_v(const Params& p, int layer, char* smem, int rep = 0) {
    const int tid = ltid(), lane = tid & 63, w = tid >> 6, l8 = lane & 7, grp = lane >> 3;
    char* ws = p.ws;
    const SliceMap sm = slice_map(p, smem);
    bf16_t* xres = (bf16_t*)(ws + OFF_XRES);
    const int* eid = (const int*)(ws + OFF_EID);
    const float* wbuf = (const float*)(ws + OFF_GATE);
    const float* mod = (const float*)(ws + OFF_MOD);
    int* ids_l = (int*)(smem + w * 9216);
    float* w_l = (float*)(smem + w * 9216 + 4096);
    const int nk = sm.rank < 512 ? (512 - sm.rank + sm.nloc - 1) / sm.nloc : 0;
    for (int s = sm.virt; s < 8; s += sm.nx) {
        if (nk == 0) break;
        const unsigned char* V = (const unsigned char*)(ws + OFF_PV) + (((size_t)layer * 8 + s) * 16384 << 7) + l8 * 16;
        uint4 ri0, ri1, ri2, ri3, rw0, rw1, rw2, rw3;
        auto load_oct = [&](int k) __attribute__((always_inline)) {
            const size_t o = (size_t)(sm.rank + k * sm.nloc) * 4 + w;
            const uint4* ip = (const uint4*)(eid + o * 1024) + lane;
            const uint4* wp = (const uint4*)(wbuf + o * 1024) + lane;
            ri0 = ip[0]; ri1 = ip[64]; ri2 = ip[128]; ri3 = ip[192];
            rw0 = wp[0]; rw1 = wp[64]; rw2 = wp[128]; rw3 = wp[192];
        };
        auto store_oct = [&]() __attribute__((always_inline)) {
            uint4* il = (uint4*)ids_l + lane; uint4* wl = (uint4*)w_l + lane;
            il[0] = ri0; il[64] = ri1; il[128] = ri2; il[192] = ri3;
            wl[0] = rw0; wl[64] = rw1; wl[128] = rw2; wl[192] = rw3;
        };
        load_oct(0); store_oct();
#pragma unroll 1
        for (int k = 0; k < nk; ++k) {
            if (k + 1 < nk) load_oct(k + 1);
            const size_t o = (size_t)(sm.rank + k * sm.nloc) * 4 + w;
            const size_t t = o * 8 + grp;
            const int b = (int)(t >> 11);
            bf16_t* xp = xres + t * 1024 + s * 128 + l8 * 16;
            const float* g2 = mod + (size_t)(layer * 8 + b) * 6144 + 5120 + s * 128 + l8 * 16;
            float4 xa[4];
            { const uint4 u0 = *(const uint4*)xp, u1 = *(const uint4*)(xp + 8);
              xa[0] = make_float4(lo16(u0.x), hi16(u0.x), lo16(u0.y), hi16(u0.y)); xa[1] = make_float4(lo16(u0.z), hi16(u0.z), lo16(u0.w), hi16(u0.w));
              xa[2] = make_float4(lo16(u1.x), hi16(u1.x), lo16(u1.y), hi16(u1.y)); xa[3] = make_float4(lo16(u1.z), hi16(u1.z), lo16(u1.w), hi16(u1.w)); }
            half2_t out[8];
#pragma unroll
            for (int j = 0; j < 8; ++j) out[j] = (half2_t){(_Float16)0.f, (_Float16)0.f};
            uint4 va[8], vb[8];
            auto issue = [&](uint4 (&v)[8], int c) __attribute__((always_inline)) {
                const int4 i0 = *(const int4*)(ids_l + grp * 128 + c * 8), i1 = *(const int4*)(ids_l + grp * 128 + c * 8 + 4);
                const int e[8] = {i0.x, i0.y, i0.z, i0.w, i1.x, i1.y, i1.z, i1.w};
#pragma unroll
                for (int j = 0; j < 8; ++j) v[j] = *(const uint4*)(V + ((size_t)e[j] << 7));
            };
            auto compute = [&](const uint4 (&v)[8], int c) __attribute__((always_inline)) {
                const float4 w0 = *(const float4*)(w_l + grp * 128 + c * 8), w1 = *(const float4*)(w_l + grp * 128 + c * 8 + 4);
                const float wf[8] = {w0.x, w0.y, w0.z, w0.w, w1.x, w1.y, w1.z, w1.w};
#pragma unroll
                for (int j = 0; j < 8; ++j) {
                    const _Float16 wh = (_Float16)wf[j];
                    const half2_t ww = {wh, wh};
                    const unsigned d[4] = {v[j].x, v[j].y, v[j].z, v[j].w};
#pragma unroll
                    for (int q = 0; q < 4; ++q) {
                        const half2_t lo = __builtin_amdgcn_cvt_scalef32_pk_f16_fp8(d[q], 1.0f, false);
                        const half2_t hi = __builtin_amdgcn_cvt_scalef32_pk_f16_fp8(d[q], 1.0f, true);
                        out[2 * q] = __builtin_elementwise_fma(ww, lo, out[2 * q]);
                        out[2 * q + 1] = __builtin_elementwise_fma(ww, hi, out[2 * q + 1]);
                    }
                    __builtin_amdgcn_sched_barrier(0);
                }
            };
            issue(va, 0);
#pragma unroll
            for (int c = 0; c < 16; c += 2) {
                issue(vb, c + 1);
                __builtin_amdgcn_sched_barrier(0);
                compute(va, c);
                __builtin_amdgcn_sched_barrier(0);
                if (c + 2 < 16) issue(va, c + 2);
                __builtin_amdgcn_sched_barrier(0);
                compute(vb, c + 1);
                __builtin_amdgcn_sched_barrier(0);
            }
            if (rep == 0 || (float)out[0].x == 12345.678f) {
#pragma unroll
                for (int c = 0; c < 4; ++c) {
                    const float4 g4 = *(const float4*)(g2 + c * 4);
                    xa[c].x += g4.x * (float)out[2 * c].x * (1.f / kScaleV); xa[c].y += g4.y * (float)out[2 * c].y * (1.f / kScaleV);
                    xa[c].z += g4.z * (float)out[2 * c + 1].x * (1.f / kScaleV); xa[c].w += g4.w * (float)out[2 * c + 1].y * (1.f / kScaleV);
                }
                *(uint4*)xp = make_uint4(pack2(xa[0].x, xa[0].y), pack2(xa[0].z, xa[0].w), pack2(xa[1].x, xa[1].y), pack2(xa[1].z, xa[1].w));
                *(uint4*)(xp + 8) = make_uint4(pack2(xa[2].x, xa[2].y), pack2(xa[2].z, xa[2].w), pack2(xa[3].x, xa[3].y), pack2(xa[3].z, xa[3].w));
            }
            if (k + 1 < nk) store_oct();
        }
    }
}

DEV void phase_final(const Params& p) {
    const int tid = ltid(), lane = tid & 63, w = tid >> 6;
    const bf16_t* xs = (const bf16_t*)(p.ws + OFF_XRES);
    float4 g4[4];
#pragma unroll
    for (int i = 0; i < 4; ++i) g4[i] = *(const float4*)(p.final_g + i * 256 + lane * 4);
    for (int q0 = blockIdx.x; q0 < kT / 4; q0 += gridDim.x * 4) {
        float4 v[4][4];
#pragma unroll
        for (int u = 0; u < 4; ++u) {
            const int q = q0 + u * gridDim.x < kT / 4 ? q0 + u * gridDim.x : q0;
            const bf16_t* xr = xs + (size_t)(q * 4 + w) * 1024;
#pragma unroll
            for (int i = 0; i < 4; ++i) { const uint2 uu = *(const uint2*)(xr + i * 256 + lane * 4); v[u][i] = make_float4(lo16(uu.x), hi16(uu.x), lo16(uu.y), hi16(uu.y)); }
        }
#pragma unroll
        for (int u = 0; u < 4; ++u) {
            const int q = q0 + u * gridDim.x;
            if (q >= kT / 4) break;
            const int t = q * 4 + w;
            float ss = 0.f;
#pragma unroll
            for (int i = 0; i < 4; ++i) ss += v[u][i].x * v[u][i].x + v[u][i].y * v[u][i].y + v[u][i].z * v[u][i].z + v[u][i].w * v[u][i].w;
            ss = wave_sum(ss);
            const float rstd = rsqrtf(ss * (1.f / 1024.f) + kEps);
#pragma unroll
            for (int i = 0; i < 4; ++i) {
                const int col = i * 256 + lane * 4;
                *(float4*)(p.out + (size_t)t * 1024 + col) = make_float4(v[u][i].x * rstd * g4[i].x, v[u][i].y * rstd * g4[i].y, v[u][i].z * rstd * g4[i].z, v[u][i].w * rstd * g4[i].w);
            }
        }
    }
}

DEV uint4 pack8f(const float (&e)[8]) { return make_uint4(pack2(e[0], e[1]), pack2(e[2], e[3]), pack2(e[4], e[5]), pack2(e[6], e[7])); }
DEV float4 rope4(float4 v, int lane, bool is64, bool low, float4 c, float4 sn) {
    const int pl = (lane ^ (is64 ? 8 : 4)) << 2;
    float4 o;
    o.x = __int_as_float(__builtin_amdgcn_ds_bpermute(pl, __float_as_int(v.x))); o.y = __int_as_float(__builtin_amdgcn_ds_bpermute(pl, __float_as_int(v.y)));
    o.z = __int_as_float(__builtin_amdgcn_ds_bpermute(pl, __float_as_int(v.z))); o.w = __int_as_float(__builtin_amdgcn_ds_bpermute(pl, __float_as_int(v.w)));
    float4 r;
    r.x = v.x * c.x + (low ? -o.x : o.x) * sn.x; r.y = v.y * c.y + (low ? -o.y : o.y) * sn.y;
    r.z = v.z * c.z + (low ? -o.z : o.z) * sn.z; r.w = v.w * c.w + (low ? -o.w : o.w) * sn.w;
    return r;
}
struct EpiIn {
    char* ws;
    DEV void tile(int m0, int n0, const float* Cs, int tid) const {
        const int lane = tid & 63, w = tid >> 6, g16 = lane >> 4, c4 = lane & 15;
        bf16_t* cols = (bf16_t*)(ws + OFF_COLS);
        bf16_t* VT = (bf16_t*)(ws + OFF_VT);
        const float* rope = (const float*)(ws + OFF_ROPE);
        const float *cos64 = rope, *sin64 = rope + 2048 * 32, *cos32 = rope + 2048 * 64, *sin32 = rope + 2048 * 64 + 2048 * 16;
        const int b = m0 >> 11, s0 = m0 & 2047;
#pragma unroll 1
        for (int h = 0; h < 2; ++h) {
            const int cb = n0 + 64 * h;
            int vh = -1;
            if (cb == 448) vh = 0; else if (cb == 576) vh = 1; else if (cb >= 1216 && cb < 1472) vh = 2 + ((cb - 1216) >> 6); else if (cb >= 2304) vh = 6 + ((cb - 2304) >> 6);
            if (vh >= 0) {
                bf16_t* dst = VT + ((size_t)(b * 12 + vh) * 64 + lane) * 2048 + s0;
#pragma unroll
                for (int q = 0; q < 4; ++q) {
                    const int tc = w + 4 * q;
                    float e[8];
#pragma unroll
                    for (int j = 0; j < 8; ++j) e[j] = Cs[(tc * 8 + j) * 128 + h * 64 + lane];
                    *(uint4*)(dst + tc * 8) = pack8f(e);
                }
                continue;
            }
            const bool r64 = cb < 320 || cb == 384 || cb == 512 || (cb >= 1920 && cb < 2304);
            const bool r32 = (cb >= 704 && cb < 1216) || cb == 1856;
            bf16_t* dbase; int dld;
            if (cb == 256) { dbase = (bf16_t*)(ws + OFF_KC); dld = 64; } else if (cb == 320) { dbase = (bf16_t*)(ws + OFF_VC); dld = 64; } else { dbase = cols + cb; dld = LDC; }
            float4 cc[8], sn[8];
            if (r64 || r32) {
                const int i = (c4 * 4) & (r64 ? 31 : 15);
#pragma unroll
                for (int it = 0; it < 8; ++it) {
                    const int sq = s0 + it * 16 + w * 4 + g16;
                    cc[it] = *(const float4*)((r64 ? cos64 + sq * 32 : cos32 + sq * 16) + i);
                    sn[it] = *(const float4*)((r64 ? sin64 + sq * 32 : sin32 + sq * 16) + i);
                }
            }
#pragma unroll
            for (int it = 0; it < 8; ++it) {
                const int r = it * 16 + w * 4 + g16;
                float4 v = *(const float4*)(Cs + r * 128 + h * 64 + c4 * 4);
                if (r64 || r32) v = rope4(v, lane, r64, !(c4 & (r64 ? 8 : 4)), cc[it], sn[it]);
                *(uint2*)(dbase + (size_t)(m0 + r) * dld + c4 * 4) = make_uint2(pack2(v.x, v.y), pack2(v.z, v.w));
            }
        }
    }
};
DEV void mla_rstd_tile(const bf16_t* src  , int ncols, float* rsl, int tid) {
    const int lane = tid & 63, w = tid >> 6, g16 = lane >> 4, c4 = lane & 15;
#pragma unroll 2
    for (int it = 0; it < 8; ++it) {
        const int r = it * 16 + w * 4 + g16;
        const bf16_t* rp = src + (size_t)r * LDC + c4 * (ncols >> 4);
        float ss = 0.f;
        const uint4 u = *(const uint4*)rp;
        ss += lo16(u.x) * lo16(u.x) + hi16(u.x) * hi16(u.x) + lo16(u.y) * lo16(u.y) + hi16(u.y) * hi16(u.y)
            + lo16(u.z) * lo16(u.z) + hi16(u.z) * hi16(u.z) + lo16(u.w) * lo16(u.w) + hi16(u.w) * hi16(u.w);
        if (ncols == 256) {
            const uint4 u2 = *(const uint4*)(rp + 8);
            ss += lo16(u2.x) * lo16(u2.x) + hi16(u2.x) * hi16(u2.x) + lo16(u2.y) * lo16(u2.y) + hi16(u2.y) * hi16(u2.y)
                + lo16(u2.z) * lo16(u2.z) + hi16(u2.z) * hi16(u2.z) + lo16(u2.w) * lo16(u2.w) + hi16(u2.w) * hi16(u2.w);
        }
        ss = row_sum_dpp(ss);
        if (c4 == 0) rsl[r] = rsqrtf(ss / (float)ncols + kEps);
    }
}
struct EpiMlaQ {
    char* ws; const float* rsl;
    DEV void tile(int m0, int n0, const float* Cs, int tid) const {
        const int lane = tid & 63, w = tid >> 6, g16 = lane >> 4, c4 = lane & 15;
        bf16_t* qmla = (bf16_t*)(ws + OFF_QMLA);
        const float* rope = (const float*)(ws + OFF_ROPE);
        const float *cos32 = rope + 2048 * 64, *sin32 = rope + 2048 * 64 + 2048 * 16;
        const int s0 = m0 & 2047;
#pragma unroll 1
        for (int h = 0; h < 2; ++h) {
            const int col = n0 + 64 * h + c4 * 4;
            const bool isrope = ((col >> 5) % 3) == 2;
            float4 cc[8], sn[8];
#pragma unroll
            for (int it = 0; it < 8; ++it) {
                const int sq = s0 + it * 16 + w * 4 + g16, i = (c4 * 4) & 15;
                cc[it] = *(const float4*)(cos32 + sq * 16 + i); sn[it] = *(const float4*)(sin32 + sq * 16 + i);
            }
#pragma unroll
            for (int it = 0; it < 8; ++it) {
                const int r = it * 16 + w * 4 + g16;
                float4 v = *(const float4*)(Cs + r * 128 + h * 64 + c4 * 4);
                const float sc = rsl[r];
                v.x *= sc; v.y *= sc; v.z *= sc; v.w *= sc;
                const float4 vr = rope4(v, lane, false, !(c4 & 4), cc[it], sn[it]);
                if (isrope) v = vr;
                *(uint2*)(qmla + (size_t)(m0 + r) * 384 + col) = make_uint2(pack2(v.x, v.y), pack2(v.z, v.w));
            }
        }
    }
};
struct EpiMlaKV {
    char* ws; const float* rsl;
    DEV void tile(int m0, int n0, const float* Cs, int tid) const {
        const int lane = tid & 63, w = tid >> 6, g16 = lane >> 4, c4 = lane & 15;
        bf16_t* kvmla = (bf16_t*)(ws + OFF_KVMLA);
        bf16_t* VT = (bf16_t*)(ws + OFF_VT);
        const int b = m0 >> 11, s0 = m0 & 2047, hd = n0 >> 7;
#pragma unroll 2
        for (int it = 0; it < 8; ++it) {
            const int r = it * 16 + w * 4 + g16;
            float4 v = *(const float4*)(Cs + r * 128 + c4 * 4);
            const float sc = rsl[r];
            *(uint2*)(kvmla + (size_t)(m0 + r) * 512 + n0 + c4 * 4) = make_uint2(pack2(v.x * sc, v.y * sc), pack2(v.z * sc, v.w * sc));
        }
        bf16_t* dst = VT + ((size_t)(b * 12 + 8 + hd) * 64 + lane) * 2048 + s0;
#pragma unroll
        for (int q = 0; q < 4; ++q) {
            const int tc = w + 4 * q;
            float e[8];
#pragma unroll
            for (int j = 0; j < 8; ++j) e[j] = Cs[(tc * 8 + j) * 128 + 64 + lane] * rsl[tc * 8 + j];
            *(uint4*)(dst + tc * 8) = pack8f(e);
        }
    }
};

DEV void phase_gemm_in(const Params& p, int layer, char* smem) {
    char* ws = p.ws;
    EpiIn epi{ws};
    gemm_phase((const bf16_t*)(ws + OFF_H), 1024, (const bf16_t*)(ws + OFF_WIN) + (size_t)layer * 2432 * 1024, 1024, 1024, kT / 128, LDC / 128, smem, epi);
}
DEV void phase_gemm_mid(const Params& p, int layer, char* smem) {
    char* ws = p.ws;
    const float* misc = (const float*)(ws + OFF_MISC);
    const bf16_t* cols = (const bf16_t*)(ws + OFF_COLS);
    float* rsl = (float*)(smem + SM_CTRL + 256);
    const int nb_up = (int)gridDim.x > 32 ? (int)gridDim.x - 16 : (int)gridDim.x;
    for (int tile = ((int)gridDim.x > 32 && blockIdx.x >= 16) ? (int)blockIdx.x : (int)blockIdx.x; tile < 16 + 384 + 512;
         tile = (tile < 16 && (int)gridDim.x > 32) ? 16 + 384 + 512 : tile + nb_up) {
        if (tile < 16) {
            const int kv = tile >> 3, mt = tile & 7;
            EpiF32 epi{(float*)(ws + OFF_QP) + (size_t)kv * 1024 * 128, 128};
            gemm_tile((const bf16_t*)(ws + (kv ? OFF_VC : OFF_KC)), 1024, (const bf16_t*)(ws + (kv ? OFF_WCV : OFF_WCK)) + (size_t)layer * 128 * 2048, 1024, 1024, mt * 128, 0, smem, epi);
        } else if (tile < 16 + 384) {
            const int tt = tile - 16, m0 = (tt / 3) * 128;
            __syncthreads();
            mla_rstd_tile(cols + (size_t)m0 * LDC + 1472, 256, rsl, ltid());
            EpiMlaQ epi{ws, rsl};
            gemm_tile(cols + 1472, LDC, (const bf16_t*)(ws + OFF_WUQ) + (size_t)layer * 384 * 256, 256, 256, m0, (tt % 3) * 128, smem, epi);
        } else {
            const int tt = tile - 16 - 384, m0 = (tt / 4) * 128;
            __syncthreads();
            mla_rstd_tile(cols + (size_t)m0 * LDC + 1728, 128, rsl, ltid());
            EpiMlaKV epi{ws, rsl};
            gemm_tile(cols + 1728, LDC, (const bf16_t*)(ws + OFF_WUKV) + (size_t)layer * 512 * 128, 128, 128, m0, (tt % 4) * 128, smem, epi);
        }
    }
}
DEV void phase_gemm_out(const Params& p, int layer, char* smem) {
    char* ws = p.ws;
    EpiRes epi{layer == 0 ? (const void*)p.x : (const void*)(ws + OFF_XRES), layer != 0, (bf16_t*)(ws + OFF_XRES), (const float*)(ws + OFF_MOD) + (size_t)layer * 8 * 6144 + 2048};
    gemm_phase((const bf16_t*)(ws + OFF_O), 1024, (const bf16_t*)(ws + OFF_WOUT) + (size_t)layer * 1024 * 1024, 1024, 1024, kT / 128, 8, smem, epi);
}
DEV void phase_gemm_wq(const Params& p, int layer, char* smem) {
    char* ws = p.ws;
    EpiBf16 epi{(bf16_t*)(ws + OFF_QP), 2048, nullptr, nullptr, 2048};
    gemm_phase((const bf16_t*)(ws + OFF_H), 1024, (const bf16_t*)(ws + OFF_WQ) + (size_t)layer * 2048 * 1024, 1024, 1024, kT / 128, 16, smem, epi);
}
DEV void phase_scores(const Params& p, int layer, char* smem) {
    char* ws = p.ws;
    for (int tile = blockIdx.x; tile < 2048; tile += gridDim.x) {
        const int c = tile >> 10, nt = tile & 1023;
        EpiF32 epi{(float*)(ws + (c ? OFF_S2 : OFF_S1)), kT * 8};
        gemm_tile((const bf16_t*)(ws + OFF_SUBK) + (size_t)(layer * 2 + c) * 16384, 128, (const bf16_t*)(ws + OFF_QP) + c * 128, 256, 128, 0, nt * 128, smem, epi);
    }
}

constexpr int NPHASE = 16;
DEV void run_phase(const Params& p, int ph, int layer, char* smem, int rep = 0) {
    switch (ph) {
        case 0: phase_prologue(p, smem); break;
        case 1: phase_norm(p, layer, 0); break;
        case 2: phase_gemm_in(p, layer, smem); break;
        case 3: phase_layout1(p, smem); break;
        case 4: phase_gemm_mid(p, layer, smem); break;
        case 5: phase_layout2(p, layer, smem); break;
        case 6: phase_attn(p, layer, smem, rep); break;
        case 7: phase_gemm_out(p, layer, smem); break;
        case 8: phase_norm(p, layer, 1); break;
        case 9: phase_gemm_wq(p, layer, smem); break;
        case 10: phase_route(p, layer, smem); break;
        case 11: phase_topk(p, smem); break;
        case 12: phase_peer_u(p, layer, smem, rep); break;
        case 13: phase_peer_comb(p, rep); break;
        case 14: phase_peer_v(p, layer, smem, rep); break;
        case 15: if (layer == 0) phase_norm(p, 1, 0); else phase_final(p); break;
        default: break;
    }
}

#if !FUSED
template <int PH>
__global__ void __launch_bounds__(256, 2) k_phase(Params p, int layer) {
    __shared__ __attribute__((aligned(16))) char smem[SM_TOTAL];
    run_phase(p, PH, layer, smem);
}
template <int PH> static void launch_phase(const Params& p, int layer, hipStream_t stream) { k_phase<PH><<<512, 256, 0, stream>>>(p, layer); }
static void launch_ph(int ph, const Params& p, int layer, hipStream_t stream) {
    switch (ph) {
        case 0: launch_phase<0>(p, layer, stream); break;
        case 1: launch_phase<1>(p, layer, stream); break;
        case 2: launch_phase<2>(p, layer, stream); break;
        case 3: launch_phase<3>(p, layer, stream); break;
        case 4: launch_phase<4>(p, layer, stream); break;
        case 5: launch_phase<5>(p, layer, stream); break;
        case 6: launch_phase<6>(p, layer, stream); break;
        case 7: launch_phase<7>(p, layer, stream); break;
        case 8: launch_phase<8>(p, layer, stream); break;
        case 9: launch_phase<9>(p, layer, stream); break;
        case 10: launch_phase<10>(p, layer, stream); break;
        case 11: launch_phase<11>(p, layer, stream); break;
        case 12: launch_phase<12>(p, layer, stream); break;
    }
}
#else
#if TS_A >= 0
#define TSTAMP(I) if (blockIdx.x == 0 && threadIdx.x == 0) ((unsigned long long*)(p.ws + 32768))[I] = __builtin_amdgcn_s_memrealtime();
#else
#define TSTAMP(I)
#endif
__global__ void __launch_bounds__(256, 2) k_mega(Params p) {
    extern __shared__ __attribute__((aligned(1024))) char smem[];
    cg::grid_group grid = cg::this_grid();
    volatile LAS unsigned* st = (volatile LAS unsigned*)(smem + SM_CTRL);
    if (threadIdx.x == 0) { st[0] = 0u; st[1] = 0u; st[2] = 0u; }
    __syncthreads();
    const XcdBarrier xb = xcd_barrier_post((unsigned*)p.ws, st);
    TSTAMP(0)
    run_phase(p, 0, 0, smem);
    if (p.out == nullptr) grid.sync();
    xcd_barrier(xb);
    TSTAMP(1)
    run_phase(p, 1, 0, smem);
    xcd_barrier(xb);
    TSTAMP(2)
#define STEP(PH, L) { run_phase(p, PH, L, smem, 0); xcd_barrier(xb); TSTAMP(2 + (L) * 16 + (PH)) }
#define LAYER(L) STEP(2, L) STEP(4, L) STEP(6, L) STEP(7, L) STEP(8, L) STEP(9, L) STEP(10, L) STEP(12, L) STEP(13, L) STEP(14, L)
    LAYER(0)
    STEP(15, 0)
    LAYER(1)
    run_phase(p, 15, 1, smem);
#if TS_A >= 0
    TSTAMP(2 + 16 + 15)
    __syncthreads();
    if (blockIdx.x == 0 && threadIdx.x == 0) {
        const unsigned long long* ts = (const unsigned long long*)(p.ws + 32768);
        p.out[0] += (TS_A == 50) ? (float)ts[TS_B] * (0.01f / 512.f / 10.f) : (float)(ts[TS_B] - ts[TS_A]) * 0.001f;
    }
#endif
}
#endif

extern "C" void kernel_launch(void* const* d_in, const int* in_sizes, int n_in, void* d_out, int out_size, void* d_ws, size_t ws_size, hipStream_t stream) {
    Params p{};
    const float** pp = (const float**)&p;
    for (int i = 0; i < 28; ++i) pp[i] = (const float*)d_in[i];
    p.out = (float*)d_out;
    p.ws = (char*)d_ws;
    if (ws_size < OFF_END) fprintf(stderr, "workspace too small: %zu < %zu\n", ws_size, (size_t)OFF_END);
    (void)hipMemsetAsync(d_ws, 0, 65536, stream);
#if !FUSED
    launch_ph(0, p, 0, stream);
    launch_ph(1, p, 0, stream);
    for (int l = 0; l < 2; ++l)
        for (int ph = 2; ph < NPHASE; ++ph) launch_ph(ph, p, l, stream);
#else
    static int grid_blocks = 0;
    if (!grid_blocks) {
        int dev = 0, cus = 0, per_cu = 0;
        (void)hipGetDevice(&dev);
        (void)hipDeviceGetAttribute(&cus, hipDeviceAttributeMultiprocessorCount, dev);
        (void)hipFuncSetAttribute((const void*)k_mega, hipFuncAttributeMaxDynamicSharedMemorySize, SM_TOTAL);
        (void)hipOccupancyMaxActiveBlocksPerMultiprocessor(&per_cu, (const void*)k_mega, 256, SM_TOTAL);
        if (per_cu > 2) per_cu = 2;
        if (per_cu < 1) per_cu = 1;
        grid_blocks = cus * per_cu;
    }
    void* args[] = {&p};
    hipError_t e = hipLaunchCooperativeKernel((const void*)k_mega, dim3(grid_blocks), dim3(256), args, SM_TOTAL, stream);
    if (e != hipSuccess) fprintf(stderr, "cooperative launch failed: %s (grid %d)\n", hipGetErrorString(e), grid_blocks);
#endif
}
```

```cpp
#include <hip/hip_runtime.h>
#include <hip/hip_cooperative_groups.h>
#include <stdint.h>
#include <stdio.h>
namespace cg = cooperative_groups;

#ifndef FUSED
#define FUSED 1
#endif
#ifndef TS_A
#define TS_A -1
#define TS_B -1
#endif
#ifndef PROBE_PH
#define PROBE_PH -1
#define PROBE_L 1
#define PROBE_REP 0
#endif

#define DEV __device__ __forceinline__
#define LAS __attribute__((address_space(3)))
typedef unsigned short bf16_t;
typedef short bf16x8 __attribute__((ext_vector_type(8)));
typedef float f32x16 __attribute__((ext_vector_type(16)));

constexpr int kB = 8, kS = 2048, kT = kB * kS, kD = 1024, LDC = 2432;
constexpr float kEps = 1e-6f;
constexpr float kNeg = -1e30f;
constexpr float kLog2e = 1.4426950408889634f;
constexpr float kScaleU = 256.f, kScaleV = 32.f;

constexpr size_t OFF_CTRL = 0;
constexpr size_t OFF_MOD  = 65536;
constexpr size_t OFF_ROPE = OFF_MOD + 2ull * 8 * 6144 * 4;
constexpr size_t OFF_MISC = OFF_ROPE + 2048ull * 96 * 4;
constexpr size_t OFF_WIN  = OFF_MISC + 4096;
constexpr size_t OFF_WOUT = OFF_WIN + 2ull * 2432 * 1024 * 2;
constexpr size_t OFF_WQ   = OFF_WOUT + 2ull * 1024 * 1024 * 2;
constexpr size_t OFF_WUQ  = OFF_WQ + 2ull * 2048 * 1024 * 2;
constexpr size_t OFF_WUKV = OFF_WUQ + 2ull * 384 * 256 * 2;
constexpr size_t OFF_WCK  = OFF_WUKV + 2ull * 512 * 128 * 2;
constexpr size_t OFF_WCV  = OFF_WCK + 2ull * 128 * 2048 * 2;
constexpr size_t OFF_SUBK = OFF_WCV + 2ull * 128 * 2048 * 2;
constexpr size_t OFF_PU   = OFF_SUBK + 2ull * 2 * 128 * 128 * 2;
constexpr size_t OFF_PV   = OFF_PU + 2ull * 16384 * 1024;
constexpr size_t OFF_XRES = OFF_PV + 2ull * 16384 * 1024;
constexpr size_t OFF_H    = OFF_XRES + (size_t)kT * 1024 * 4;
constexpr size_t OFF_H8   = OFF_H + (size_t)kT * 1024 * 2;
constexpr size_t OFF_RSTD = OFF_H8 + (size_t)kT * 1024;
constexpr size_t OFF_KCMP = OFF_RSTD + 2ull * kT * 4;
constexpr size_t OFF_EID  = OFF_KCMP + 2ull * 1024 * 64 * 2;
constexpr size_t OFF_GATE = OFF_EID + (size_t)kT * 128 * 4;
constexpr size_t OFF_QP   = OFF_GATE + (size_t)kT * 128 * 4;
constexpr size_t OFF_COLS = OFF_QP + (size_t)kT * 2048 * 2;
constexpr size_t OFF_KC   = OFF_COLS + (size_t)kT * LDC * 2;
constexpr size_t OFF_VC   = OFF_KC + (size_t)(kT + 64) * 64 * 2;
constexpr size_t OFF_VT   = OFF_VC + (size_t)(kT + 64) * 64 * 2;
constexpr size_t OFF_QMLA = OFF_VT + 8ull * 12 * 64 * 2048 * 2;
constexpr size_t OFF_KVMLA = OFF_QMLA + (size_t)kT * 384 * 2;
constexpr size_t OFF_O    = OFF_KVMLA + (size_t)kT * 512 * 2;
constexpr size_t OFF_END  = OFF_O + (size_t)kT * 1024 * 2;
constexpr size_t OFF_S1 = OFF_COLS, OFF_S2 = OFF_COLS + (size_t)kT * 8 * 128 * 4;
static_assert(OFF_S2 + (size_t)kT * 8 * 128 * 4 <= OFF_O, "alias region too small");
static_assert(OFF_END <= (512ull << 20), "workspace too large");

struct Params {
    const float *x, *c, *ada_w, *ada_b, *norm_mix_g, *norm_ffn_g, *w_in, *pos_k, *pos_v, *cmp_wk, *cmp_wv;
    const float *lq1, *lk1, *lq2, *lk2, *sub_g, *mla_qg, *mla_wuq, *mla_kvg, *mla_wukv, *sinks, *w_out;
    const float *w_q, *subk1, *subk2, *pu, *pv, *final_g;
    float* out;
    char* ws;
};

DEV int ltid() { int t = threadIdx.x; asm volatile("" : "+v"(t)); return t; }
DEV float bf2f(bf16_t v) { return __uint_as_float(((unsigned)v) << 16); }
DEV bf16_t f2bf(float f) { unsigned u = __float_as_uint(f); u += 0x7fffu + ((u >> 16) & 1u); return (bf16_t)(u >> 16); }
DEV unsigned pack2(float lo, float hi) { unsigned r; asm("v_cvt_pk_bf16_f32 %0, %1, %2" : "=v"(r) : "v"(lo), "v"(hi)); return r; }
DEV float lo16(unsigned u) { return __uint_as_float(u << 16); }
DEV float hi16(unsigned u) { return __uint_as_float(u & 0xffff0000u); }
DEV float wave_sum(float v) {
#pragma unroll
    for (int o = 32; o > 0; o >>= 1) v += __shfl_xor(v, o, 64);
    return v;
}
DEV float xor32f(float v, int lane) { return __int_as_float(__builtin_amdgcn_ds_bpermute((lane ^ 32) << 2, __float_as_int(v))); }
DEV float lanef(float v, int src) { return __int_as_float(__builtin_amdgcn_ds_bpermute(src << 2, __float_as_int(v))); }
DEV f32x16 mfma32(bf16x8 a, bf16x8 b, f32x16 c) { return __builtin_amdgcn_mfma_f32_32x32x16_bf16(a, b, c, 0, 0, 0); }
DEV f32x16 zero16() { f32x16 z;
#pragma unroll
    for (int i = 0; i < 16; ++i) z[i] = 0.f;
    return z; }
DEV float gelu_tanh(float x) {
    const float u = 0.7978845608028654f * (x + 0.044715f * x * x * x);
    const float e = __expf(2.f * u);
    const float t = 1.f - 2.f / (e + 1.f);
    return 0.5f * x * (1.f + t);
}

template <class Epi>
DEV void gemm_tile(const bf16_t* __restrict__ A, int lda, const bf16_t* __restrict__ Bt, int ldb, int K, int m0, int n0, char* smem, const Epi& epi) {
    const int tid = ltid(), lane = tid & 63, w = tid >> 6, wm = w >> 1, wn = w & 1, ql = lane & 31, hh = lane >> 5;
    f32x16 acc[2][2];
#pragma unroll
    for (int i = 0; i < 2; ++i)
#pragma unroll
        for (int j = 0; j < 2; ++j) acc[i][j] = zero16();
    const int srow = lane >> 3, spos = lane & 7;
    const int c0 = spos ^ ((srow >> 1) & 7), c1 = spos ^ ((4 + (srow >> 1)) & 7);
    const bf16_t* Ag0 = A + (size_t)(m0 + w * 32 + srow) * lda + c0 * 8;
    const bf16_t* Ag1 = A + (size_t)(m0 + w * 32 + 8 + srow) * lda + c1 * 8;
    const bf16_t* Bg0 = Bt + (size_t)(n0 + w * 32 + srow) * ldb + c0 * 8;
    const bf16_t* Bg1 = Bt + (size_t)(n0 + w * 32 + 8 + srow) * ldb + c1 * 8;
    const size_t a16 = (size_t)16 * lda, b16 = (size_t)16 * ldb;
    auto stage = [&](int kt, int buf) __attribute__((always_inline)) {
        char* sa = smem + buf * 32768 + w * 4096;
        char* sb = sa + 16384;
        const int ko = kt * 64;
        __builtin_amdgcn_global_load_lds((const unsigned*)(Ag0 + ko), (LAS unsigned*)(sa), 16, 0, 0);
        __builtin_amdgcn_global_load_lds((const unsigned*)(Ag1 + ko), (LAS unsigned*)(sa + 1024), 16, 0, 0);
        __builtin_amdgcn_global_load_lds((const unsigned*)(Ag0 + a16 + ko), (LAS unsigned*)(sa + 2048), 16, 0, 0);
        __builtin_amdgcn_global_load_lds((const unsigned*)(Ag1 + a16 + ko), (LAS unsigned*)(sa + 3072), 16, 0, 0);
        __builtin_amdgcn_global_load_lds((const unsigned*)(Bg0 + ko), (LAS unsigned*)(sb), 16, 0, 0);
        __builtin_amdgcn_global_load_lds((const unsigned*)(Bg1 + ko), (LAS unsigned*)(sb + 1024), 16, 0, 0);
        __builtin_amdgcn_global_load_lds((const unsigned*)(Bg0 + b16 + ko), (LAS unsigned*)(sb + 2048), 16, 0, 0);
        __builtin_amdgcn_global_load_lds((const unsigned*)(Bg1 + b16 + ko), (LAS unsigned*)(sb + 3072), 16, 0, 0);
    };
    const int key = (ql >> 1) & 7;
    const int arow = (wm * 64 + ql) * 128, brow = (wn * 64 + ql) * 128;
    const int nk = K >> 6;
    __syncthreads();
    stage(0, 0);
    for (int kt = 0; kt < nk; ++kt) {
        asm volatile("s_waitcnt vmcnt(0)" ::: "memory");
        __syncthreads();
        if (kt + 1 < nk) stage(kt + 1, (kt + 1) & 1);
        const char* As = smem + (kt & 1) * 32768;
        const char* Bs = As + 16384;
#pragma unroll
        for (int ks = 0; ks < 4; ++ks) {
            const int co = ((ks * 2 + hh) ^ key) << 4;
            bf16x8 a[2], b[2];
#pragma unroll
            for (int i = 0; i < 2; ++i) {
                a[i] = *(const bf16x8*)(As + arow + i * 4096 + co);
                b[i] = *(const bf16x8*)(Bs + brow + i * 4096 + co);
            }
#pragma unroll
            for (int i = 0; i < 2; ++i)
#pragma unroll
                for (int j = 0; j < 2; ++j) acc[i][j] = mfma32(a[i], b[j], acc[i][j]);
        }
    }
    __syncthreads();
    float* Cs = (float*)smem;
#pragma unroll
    for (int i = 0; i < 2; ++i)
#pragma unroll
        for (int j = 0; j < 2; ++j)
#pragma unroll
            for (int r = 0; r < 16; ++r)
                Cs[(wm * 64 + i * 32 + (r & 3) + 8 * (r >> 2) + 4 * hh) * 128 + wn * 64 + j * 32 + ql] = acc[i][j][r];
    __syncthreads();
    epi.tile(m0, n0, Cs, tid);
}

struct EpiBf16 {
    bf16_t* C; int ldc; const float* rowscale; const float* colbias; int nvalid;
    DEV void tile(int m0, int n0, const float* Cs, int tid) const {
#pragma unroll
        for (int it = 0; it < 8; ++it) {
            const int id = tid + 256 * it, r = id >> 4, c8 = (id & 15) * 8;
            if (n0 + c8 >= nvalid) continue;
            float4 a = *(const float4*)(Cs + r * 128 + c8), b = *(const float4*)(Cs + r * 128 + c8 + 4);
            if (rowscale) { const float sc = rowscale[m0 + r]; a.x *= sc; a.y *= sc; a.z *= sc; a.w *= sc; b.x *= sc; b.y *= sc; b.z *= sc; b.w *= sc; }
            if (colbias) { const float4 ba = *(const float4*)(colbias + n0 + c8), bb = *(const float4*)(colbias + n0 + c8 + 4);
                a.x += ba.x; a.y += ba.y; a.z += ba.z; a.w += ba.w; b.x += bb.x; b.y += bb.y; b.z += bb.z; b.w += bb.w; }
            *(uint4*)(C + (size_t)(m0 + r) * ldc + n0 + c8) = make_uint4(pack2(a.x, a.y), pack2(a.z, a.w), pack2(b.x, b.y), pack2(b.z, b.w));
        }
    }
};
struct EpiF32 {
    float* C; int ldc;
    DEV void tile(int m0, int n0, const float* Cs, int tid) const {
#pragma unroll
        for (int it = 0; it < 16; ++it) {
            const int id = tid + 256 * it, r = id >> 5, c4 = (id & 31) * 4;
            *(float4*)(C + (size_t)(m0 + r) * ldc + n0 + c4) = *(const float4*)(Cs + r * 128 + c4);
        }
    }
};
struct EpiRes {
    const void* xin; bool in_bf16; bf16_t* xout; const float* gate;
    DEV void tile(int m0, int n0, const float* Cs, int tid) const {
        const float* g = gate + (size_t)(m0 >> 11) * 6144 + n0;
#pragma unroll
        for (int it = 0; it < 8; ++it) {
            const int id = tid + 256 * it, r = id >> 4, c8 = (id & 15) * 8;
            const float4 v0 = *(const float4*)(Cs + r * 128 + c8), v1 = *(const float4*)(Cs + r * 128 + c8 + 4);
            const float4 g0 = *(const float4*)(g + c8), g1 = *(const float4*)(g + c8 + 4);
            float4 x0, x1;
            if (in_bf16) {
                const uint4 u = *(const uint4*)((const bf16_t*)xin + (size_t)(m0 + r) * 1024 + n0 + c8);
                x0 = make_float4(lo16(u.x), hi16(u.x), lo16(u.y), hi16(u.y)); x1 = make_float4(lo16(u.z), hi16(u.z), lo16(u.w), hi16(u.w));
            } else {
                const float* xp = (const float*)xin + (size_t)(m0 + r) * 1024 + n0 + c8;
                x0 = *(const float4*)xp; x1 = *(const float4*)(xp + 4);
            }
            *(uint4*)(xout + (size_t)(m0 + r) * 1024 + n0 + c8) =
                make_uint4(pack2(x0.x + g0.x * v0.x, x0.y + g0.y * v0.y), pack2(x0.z + g0.z * v0.z, x0.w + g0.w * v0.w),
                           pack2(x1.x + g1.x * v1.x, x1.y + g1.y * v1.y), pack2(x1.z + g1.z * v1.z, x1.w + g1.w * v1.w));
        }
    }
};

template <class Epi>
DEV void gemm_phase(const bf16_t* A, int lda, const bf16_t* Bt, int ldb, int K, int mtiles, int ntiles, char* smem, const Epi& epi) {
    for (int tile = blockIdx.x; tile < mtiles * ntiles; tile += gridDim.x) {
        const int mt = tile / ntiles, nt = tile % ntiles;
        gemm_tile(A, lda, Bt, ldb, K, mt * 128, nt * 128, smem, epi);
    }
}

DEV int win_srccol(int n) {
    if (n < 652) return n;
    if (n < 704) return -1;
    if (n < 1888) return n - 52;
    if (n < 1920) return -1;
    return n - 84;
}
DEV void transpose_tile(const float* __restrict__ src, int ld_src, int nsrc_valid, int mode, const float* __restrict__ rowscale,
                        bf16_t* __restrict__ dst, int K, int n0, int k0, char* smem) {
    bf16_t* Ls = (bf16_t*)smem;
    const int tid = ltid();
    __syncthreads();
    const int nn = tid & 63, n = n0 + nn;
    const int sc = (mode == 1) ? win_srccol(n) : (mode == 2) ? (n & 63) : (n < nsrc_valid ? n : -1);
    const int kshift = (mode == 2 && n >= 64) ? 1024 : 0;
#pragma unroll 4
    for (int i = 0; i < 16; ++i) {
        const int kk = (tid >> 6) + 4 * i;
        float v = 0.f;
        if (sc >= 0) { v = src[(size_t)(k0 + kk + kshift) * ld_src + sc]; if (rowscale) v *= rowscale[k0 + kk]; }
        Ls[nn * 72 + kk] = f2bf(v);
    }
    __syncthreads();
#pragma unroll
    for (int i = 0; i < 2; ++i) {
        const int r = (tid >> 3) + 32 * i, ch = tid & 7;
        *(uint4*)(dst + (size_t)(n0 + r) * K + k0 + ch * 8) = *(const uint4*)(Ls + r * 72 + ch * 8);
    }
}

DEV void convert_stream(const float* __restrict__ src, bf16_t* __restrict__ dst, size_t n8) {
    const int tid = ltid();
    for (size_t i = (size_t)blockIdx.x * 256 + tid; i < n8; i += (size_t)gridDim.x * 256) {
        const float4 a = *(const float4*)(src + i * 8), b = *(const float4*)(src + i * 8 + 4);
        uint4 o; o.x = pack2(a.x, a.y); o.y = pack2(a.z, a.w); o.z = pack2(b.x, b.y); o.w = pack2(b.z, b.w);
        *(uint4*)(dst + i * 8) = o;
    }
}

DEV void convert_fp8_stream(const float* __restrict__ src, unsigned char* __restrict__ dst, size_t n16, float scale) {
    const int tid = ltid();
    const size_t stride = (size_t)gridDim.x * 256;
    for (size_t i0 = (size_t)blockIdx.x * 256 + tid; i0 < n16; i0 += stride * 4) {
        float4 q[4][4];
#pragma unroll
        for (int u = 0; u < 4; ++u) {
            const size_t i = i0 + u * stride < n16 ? i0 + u * stride : i0;
#pragma unroll
            for (int c = 0; c < 4; ++c) q[u][c] = *(const float4*)(src + i * 16 + c * 4);
        }
#pragma unroll
        for (int u = 0; u < 4; ++u) {
            const size_t i = i0 + u * stride;
            if (i >= n16) break;
            unsigned o[4];
#pragma unroll
            for (int j = 0; j < 4; ++j) {
                const float4 v = q[u][j];
                unsigned w = 0u;
                w = __builtin_amdgcn_cvt_pk_fp8_f32(fminf(fmaxf(v.x * scale, -440.f), 440.f), fminf(fmaxf(v.y * scale, -440.f), 440.f), w, false);
                w = __builtin_amdgcn_cvt_pk_fp8_f32(fminf(fmaxf(v.z * scale, -440.f), 440.f), fminf(fmaxf(v.w * scale, -440.f), 440.f), w, true);
                o[j] = w;
            }
            const size_t rowg = i >> 6; const int c16 = (int)(i & 63);
            const size_t l = rowg >> 14, row = rowg & 16383;
            *(uint4*)(dst + (((l * 8 + (c16 >> 3)) * 16384 + row) << 7) + (c16 & 7) * 16) = make_uint4(o[0], o[1], o[2], o[3]);
        }
    }
}

constexpr int J_ROPE = 384, J_MOD = 192, J_MISC = 5;
constexpr int J_TW_L = 608 + 256 + 512 + 24 + 16 + 64 + 64;
constexpr int J_TOTAL = J_ROPE + J_MOD + J_MISC + 2 * J_TW_L;

DEV void prologue_job(const Params& p, int job, char* smem) {
    const int tid = ltid();
    char* ws = p.ws;
    if (job < J_MISC) {
        float* misc = (float*)(ws + OFF_MISC);
        if (job < 4) {
            const int l = job >> 1, kv = job & 1;
            const float* pos = (kv ? p.pos_v : p.pos_k) + l * 2048;
            const float* wsrc = (kv ? p.cmp_wv : p.cmp_wk) + (size_t)l * 2048 * 64;
            float* red = (float*)smem;
            __syncthreads();
            const int kp = tid >> 6, n = tid & 63;
            float acc = 0.f;
            for (int k0 = kp * 512; k0 < kp * 512 + 512; k0 += 16) {
                float wv[16];
#pragma unroll
                for (int u = 0; u < 16; ++u) wv[u] = wsrc[(size_t)(k0 + u) * 64 + n];
#pragma unroll
                for (int u = 0; u < 16; ++u) acc += pos[k0 + u] * wv[u];
            }
            red[kp * 64 + n] = acc;
            __syncthreads();
            if (tid < 64) misc[(l * 2 + kv) * 64 + tid] = red[tid] + red[64 + tid] + red[128 + tid] + red[192 + tid];
        } else if (tid < 2) {
            const int l = tid;
            float d1 = 0.f, d2 = 0.f;
            for (int i = 0; i < 32; ++i) { d1 += p.lq1[l * 32 + i] * p.lk1[l * 32 + i]; d2 += p.lq2[l * 32 + i] * p.lk2[l * 32 + i]; }
            const float lam_init = 0.8f - 0.6f * expf(-0.3f * (float)l);
            misc[256 + l] = expf(d1) - expf(d2) + lam_init;
            misc[258 + l] = 1.f - lam_init;
        }
        return;
    }
    job -= J_MISC;
    if (job < J_MOD) {
        const int l = job / 96, n0 = (job % 96) * 64;
        float* sc = (float*)smem;
        __syncthreads();
        for (int i = tid; i < 8192; i += 256) { const float v = p.c[i]; sc[i] = v / (1.f + __expf(-v)); }
        __syncthreads();
        const int kp = tid >> 6, col = tid & 63;
        float acc[8];
#pragma unroll
        for (int b = 0; b < 8; ++b) acc[b] = 0.f;
        const float* wp = p.ada_w + (size_t)l * 1024 * 6144 + n0 + col;
        for (int k0 = kp * 256; k0 < kp * 256 + 256; k0 += 16) {
            float wv[16];
#pragma unroll
            for (int u = 0; u < 16; ++u) wv[u] = wp[(size_t)(k0 + u) * 6144];
#pragma unroll
            for (int u = 0; u < 16; ++u)
#pragma unroll
                for (int b = 0; b < 8; ++b) acc[b] += sc[b * 1024 + k0 + u] * wv[u];
        }
        float* red = sc + 8192;
#pragma unroll
        for (int b = 0; b < 8; ++b) red[(kp * 8 + b) * 64 + col] = acc[b];
        __syncthreads();
        float* mod = (float*)(ws + OFF_MOD);
        for (int idx = tid; idx < 512; idx += 256) {
            const int b = idx >> 6, cl = idx & 63;
            const float v = red[(0 * 8 + b) * 64 + cl] + red[(1 * 8 + b) * 64 + cl] + red[(2 * 8 + b) * 64 + cl] + red[(3 * 8 + b) * 64 + cl];
            mod[(size_t)(l * 8 + b) * 6144 + n0 + cl] = v + p.ada_b[l * 6144 + n0 + cl];
        }
        return;
    }
    job -= J_MOD;
    if (job < J_ROPE) {
        const int idx = job * 256 + tid;
        const int s = idx / 48, j = idx % 48;
        float* rope = (float*)(ws + OFF_ROPE);
        float inv; float *pc, *ps;
        if (j < 32) { inv = exp2f(-(float)j * (13.287712379549449f / 32.f)); pc = rope + s * 32 + j; ps = rope + 2048 * 32 + s * 32 + j; }
        else { const int i = j - 32; inv = exp2f(-(float)i * (13.287712379549449f / 16.f)); pc = rope + 2048 * 64 + s * 16 + i; ps = rope + 2048 * 64 + 2048 * 16 + s * 16 + i; }
        const double a = (double)s * (double)inv;
        const double kk = rint(a * 0.15915494309189535);
        const float r = (float)fma(-kk, 6.283185307179586, a);
        *pc = cosf(r); *ps = sinf(r);
        return;
    }
    job -= J_ROPE;
    const int l = job / J_TW_L; int j = job % J_TW_L;
    if (j < 608) { transpose_tile(p.w_in + (size_t)l * 1024 * 2348, 2348, 2348, 1, nullptr, (bf16_t*)(ws + OFF_WIN) + (size_t)l * 2432 * 1024, 1024, (j / 16) * 64, (j % 16) * 64, smem); return; }
    j -= 608;
    if (j < 256) { transpose_tile(p.w_out + (size_t)l * 1024 * 1024, 1024, 1024, 0, nullptr, (bf16_t*)(ws + OFF_WOUT) + (size_t)l * 1024 * 1024, 1024, (j / 16) * 64, (j % 16) * 64, smem); return; }
    j -= 256;
    if (j < 512) { transpose_tile(p.w_q + (size_t)l * 1024 * 2048, 2048, 2048, 0, nullptr, (bf16_t*)(ws + OFF_WQ) + (size_t)l * 2048 * 1024, 1024, (j / 16) * 64, (j % 16) * 64, smem); return; }
    j -= 512;
    if (j < 24) { transpose_tile(p.mla_wuq + (size_t)l * 256 * 384, 384, 384, 0, p.mla_qg + l * 256, (bf16_t*)(ws + OFF_WUQ) + (size_t)l * 384 * 256, 256, (j / 4) * 64, (j % 4) * 64, smem); return; }
    j -= 24;
    if (j < 16) { transpose_tile(p.mla_wukv + (size_t)l * 128 * 512, 512, 512, 0, p.mla_kvg + l * 128, (bf16_t*)(ws + OFF_WUKV) + (size_t)l * 512 * 128, 128, (j / 2) * 64, (j % 2) * 64, smem); return; }
    j -= 16;
    if (j < 64) { if (j < 32) transpose_tile(p.cmp_wk + (size_t)l * 2048 * 64, 64, 64, 2, nullptr, (bf16_t*)(ws + OFF_WCK) + (size_t)l * 128 * 2048, 1024, (j / 16) * 64, (j % 16) * 64, smem); return; }
    j -= 64;
    if (j < 32) transpose_tile(p.cmp_wv + (size_t)l * 2048 * 64, 64, 64, 2, nullptr, (bf16_t*)(ws + OFF_WCV) + (size_t)l * 128 * 2048, 1024, (j / 16) * 64, (j % 16) * 64, smem);
}

#if TS_A >= 0
#define PSTAMP(I) if (blockIdx.x == 0 && threadIdx.x == 0) ((unsigned long long*)(p.ws + 32768))[I] = __builtin_amdgcn_s_memrealtime();
#else
#define PSTAMP(I)
#endif
DEV void phase_prologue(const Params& p, char* smem) {
    {
        unsigned* ctr = (unsigned*)p.ws + 100;
        volatile int* slot = (volatile int*)(smem + 65536 + 64);
        int job = blockIdx.x;
        while (job < J_TOTAL) {
            prologue_job(p, job, smem);
            __syncthreads();
            if (ltid() == 0) *slot = (int)gridDim.x + (int)atomicAdd(ctr, 1u);
            __syncthreads();
            job = __builtin_amdgcn_readfirstlane(*slot);
        }
    }
    PSTAMP(42)
    char* ws = p.ws;
    convert_fp8_stream(p.pu, (unsigned char*)(ws + OFF_PU), 2ull * 16384 * 1024 / 16, kScaleU);
    PSTAMP(43)
    convert_fp8_stream(p.pv, (unsigned char*)(ws + OFF_PV), 2ull * 16384 * 1024 / 16, kScaleV);
    PSTAMP(44)
    for (int l = 0; l < 2; ++l) {
        convert_stream(p.subk1 + (size_t)l * 16384, (bf16_t*)(ws + OFF_SUBK) + (size_t)(l * 2 + 0) * 16384, 16384 / 8);
        convert_stream(p.subk2 + (size_t)l * 16384, (bf16_t*)(ws + OFF_SUBK) + (size_t)(l * 2 + 1) * 16384, 16384 / 8);
    }
}

DEV void phase_norm(const Params& p, int layer, int which) {
    const int tid = ltid(), lane = tid & 63, w = tid >> 6;
    const bool xbf = !(layer == 0 && which == 0);
    const float* xs = p.x; const bf16_t* xb = (const bf16_t*)(p.ws + OFF_XRES);
    const float* g = (which == 0 ? p.norm_mix_g : p.norm_ffn_g) + layer * 1024;
    const float* mod = (const float*)(p.ws + OFF_MOD) + (size_t)layer * 8 * 6144;
    bf16_t* h = (bf16_t*)(p.ws + OFF_H);
    float4 g4[4];
#pragma unroll
    for (int i = 0; i < 4; ++i) g4[i] = *(const float4*)(g + i * 256 + lane * 4);
    for (int q0 = blockIdx.x; q0 < kT / 4; q0 += gridDim.x * 4) {
        float4 v[4][4];
#pragma unroll
        for (int u = 0; u < 4; ++u) {
            const int q = q0 + u * gridDim.x < kT / 4 ? q0 + u * gridDim.x : q0;
            if (xbf) {
                const bf16_t* xr = xb + (size_t)(q * 4 + w) * 1024;
#pragma unroll
                for (int i = 0; i < 4; ++i) { const uint2 uu = *(const uint2*)(xr + i * 256 + lane * 4); v[u][i] = make_float4(lo16(uu.x), hi16(uu.x), lo16(uu.y), hi16(uu.y)); }
            } else {
                const float* xr = xs + (size_t)(q * 4 + w) * 1024;
#pragma unroll
                for (int i = 0; i < 4; ++i) v[u][i] = *(const float4*)(xr + i * 256 + lane * 4);
            }
        }
#pragma unroll
        for (int u = 0; u < 4; ++u) {
            const int q = q0 + u * gridDim.x;
            if (q >= kT / 4) break;
            const int t = q * 4 + w, b = t >> 11;
            float ss = 0.f;
#pragma unroll
            for (int i = 0; i < 4; ++i) ss += v[u][i].x * v[u][i].x + v[u][i].y * v[u][i].y + v[u][i].z * v[u][i].z + v[u][i].w * v[u][i].w;
            ss = wave_sum(ss);
            const float rstd = rsqrtf(ss * (1.f / 1024.f) + kEps);
            const float* sh = mod + (size_t)b * 6144 + (which ? 3072 : 0);
            const float* sc = sh + 1024;
#pragma unroll
            for (int i = 0; i < 4; ++i) {
                const int col = i * 256 + lane * 4;
                const float4 s4 = *(const float4*)(sc + col), h4 = *(const float4*)(sh + col);
                const float o0 = v[u][i].x * rstd * g4[i].x * (1.f + s4.x) + h4.x, o1 = v[u][i].y * rstd * g4[i].y * (1.f + s4.y) + h4.y;
                const float o2 = v[u][i].z * rstd * g4[i].z * (1.f + s4.z) + h4.z, o3 = v[u][i].w * rstd * g4[i].w * (1.f + s4.w) + h4.w;
                uint2 o; o.x = pack2(o0, o1); o.y = pack2(o2, o3);
                *(uint2*)(h + (size_t)t * 1024 + col) = o;
            }
        }
    }
}

DEV void rope8(uint4& x1, uint4& x2, const float (&cc)[8], const float (&ss)[8]) {
    unsigned a[4] = {x1.x, x1.y, x1.z, x1.w}, b[4] = {x2.x, x2.y, x2.z, x2.w};
#pragma unroll
    for (int i = 0; i < 4; ++i) {
        const float a0 = lo16(a[i]), a1 = hi16(a[i]), b0 = lo16(b[i]), b1 = hi16(b[i]);
        const float o10 = a0 * cc[2 * i] - b0 * ss[2 * i], o11 = a1 * cc[2 * i + 1] - b1 * ss[2 * i + 1];
        const float o20 = a0 * ss[2 * i] + b0 * cc[2 * i], o21 = a1 * ss[2 * i + 1] + b1 * cc[2 * i + 1];
        a[i] = pack2(o10, o11); b[i] = pack2(o20, o21);
    }
    x1 = make_uint4(a[0], a[1], a[2], a[3]); x2 = make_uint4(b[0], b[1], b[2], b[3]);
}
DEV void vt_tile(const bf16_t* __restrict__ src, int ld, bf16_t* __restrict__ dst, char* smem) {
    bf16_t* Ls = (bf16_t*)smem;
    const int tid = ltid();
    __syncthreads();
#pragma unroll
    for (int i = 0; i < 2; ++i) {
        const int id = tid + 256 * i, tok = id >> 3, ch = id & 7;
        *(uint4*)(Ls + tok * 72 + ch * 8) = *(const uint4*)(src + (size_t)tok * ld + ch * 8);
    }
    __syncthreads();
#pragma unroll
    for (int i = 0; i < 2; ++i) {
        const int id = tid + 256 * i, d = id & 63, tc = id >> 6;
        unsigned short e[8];
#pragma unroll
        for (int j = 0; j < 8; ++j) e[j] = Ls[(tc * 8 + j) * 72 + d];
        uint4 o;
        o.x = (unsigned)e[0] | ((unsigned)e[1] << 16); o.y = (unsigned)e[2] | ((unsigned)e[3] << 16);
        o.z = (unsigned)e[4] | ((unsigned)e[5] << 16); o.w = (unsigned)e[6] | ((unsigned)e[7] << 16);
        *(uint4*)(dst + (size_t)d * 2048 + tc * 8) = o;
    }
}

DEV void phase_layout1(const Params& p, char* smem) {
    char* ws = p.ws;
    bf16_t* cols = (bf16_t*)(ws + OFF_COLS);
    bf16_t* kc = (bf16_t*)(ws + OFF_KC);
    bf16_t* vc = (bf16_t*)(ws + OFF_VC);
    bf16_t* VT = (bf16_t*)(ws + OFF_VT);
    float* rstd = (float*)(ws + OFF_RSTD);
    const float* rope = (const float*)(ws + OFF_ROPE);
    const float *cos64 = rope, *sin64 = rope + 2048 * 32, *cos32 = rope + 2048 * 64, *sin32 = rope + 2048 * 64 + 2048 * 16;
    const int tid = ltid();
    for (int unit = blockIdx.x; unit < 2 * (kT / 64); unit += gridDim.x) {
        const int tile = unit >> 1, part01 = unit & 1;
        const int T0 = tile * 64, b = T0 >> 11, s0 = T0 & 2047;
        if (part01 == 0) {
            for (int it0 = tid; it0 < 64 * 86; it0 += 1024) {
                uint4 x1[4], x2[4]; float4 cs[4][2], sn[4][2]; bf16_t* p1[4]; bf16_t* p2[4]; bf16_t* kq[4];
#pragma unroll
                for (int u = 0; u < 4; ++u) {
                    const int it = it0 + u * 256 < 64 * 86 ? it0 + u * 256 : it0;
                    const int tok = it / 86, item = it % 86;
                    const int t = T0 + tok, sq = s0 + tok;
                    bf16_t* row = cols + (size_t)t * LDC;
                    kq[u] = nullptr;
                    const float *cp, *sp;
                    if (item < 52) {
                        const int hd = item >> 2, i0 = (item & 3) * 8;
                        const int base = hd < 4 ? 64 * hd : hd == 4 ? 256 : hd == 5 ? 384 : hd == 6 ? 512 : hd < 11 ? 1920 + 64 * (hd - 7) : 2176 + 64 * (hd - 11);
                        p1[u] = row + base + i0; p2[u] = row + base + 32 + i0;
                        cp = cos64 + sq * 32 + i0; sp = sin64 + sq * 32 + i0;
                        if (hd == 4) kq[u] = kc + (size_t)t * 64 + i0;
                    } else {
                        const int it2 = item - 52, sub = it2 >> 1, i0 = (it2 & 1) * 8;
                        const int base = sub < 8 ? 704 + 32 * sub : sub < 16 ? 960 + 32 * (sub - 8) : 1856;
                        p1[u] = row + base + i0; p2[u] = row + base + 16 + i0;
                        cp = cos32 + sq * 16 + i0; sp = sin32 + sq * 16 + i0;
                    }
                    x1[u] = *(const uint4*)p1[u]; x2[u] = *(const uint4*)p2[u];
                    cs[u][0] = *(const float4*)cp; cs[u][1] = *(const float4*)(cp + 4);
                    sn[u][0] = *(const float4*)sp; sn[u][1] = *(const float4*)(sp + 4);
                }
#pragma unroll
                for (int u = 0; u < 4; ++u) {
                    if (it0 + u * 256 >= 64 * 86) break;
                    const float cc[8] = {cs[u][0].x, cs[u][0].y, cs[u][0].z, cs[u][0].w, cs[u][1].x, cs[u][1].y, cs[u][1].z, cs[u][1].w};
                    const float ss[8] = {sn[u][0].x, sn[u][0].y, sn[u][0].z, sn[u][0].w, sn[u][1].x, sn[u][1].y, sn[u][1].z, sn[u][1].w};
                    rope8(x1[u], x2[u], cc, ss);
                    *(uint4*)p1[u] = x1[u]; *(uint4*)p2[u] = x2[u];
                    if (kq[u]) { *(uint4*)kq[u] = x1[u]; *(uint4*)(kq[u] + 32) = x2[u]; }
                }
            }
            {
                const uint4 c0 = *(const uint4*)(cols + (size_t)(T0 + (tid >> 3)) * LDC + 320 + (tid & 7) * 8);
                const uint4 c1 = *(const uint4*)(cols + (size_t)(T0 + 32 + (tid >> 3)) * LDC + 320 + (tid & 7) * 8);
                *(uint4*)(vc + (size_t)(T0 + (tid >> 3)) * 64 + (tid & 7) * 8) = c0;
                *(uint4*)(vc + (size_t)(T0 + 32 + (tid >> 3)) * 64 + (tid & 7) * 8) = c1;
            }
        }
        if (part01 == 0) continue;
        {
            const int tok = tid >> 2, part = tid & 3, t = T0 + tok;
            const bf16_t* src = cols + (size_t)t * LDC + 1472 + (part < 3 ? part : 0) * 128;
            float ss = 0.f;
#pragma unroll 4
            for (int i = 0; i < 16; ++i) {
                const uint4 u = *(const uint4*)(src + i * 8);
                ss += lo16(u.x) * lo16(u.x) + hi16(u.x) * hi16(u.x) + lo16(u.y) * lo16(u.y) + hi16(u.y) * hi16(u.y)
                    + lo16(u.z) * lo16(u.z) + hi16(u.z) * hi16(u.z) + lo16(u.w) * lo16(u.w) + hi16(u.w) * hi16(u.w);
            }
            float vq = part < 2 ? ss : 0.f;
            vq += __shfl_xor(vq, 1, 64);
            if (part == 0) rstd[t] = rsqrtf(vq * (1.f / 256.f) + kEps);
            if (part == 2) rstd[kT + t] = rsqrtf(ss * (1.f / 128.f) + kEps);
        }
#pragma unroll 1
        for (int vh = 0; vh < 8; ++vh) {
            const int col = vh == 0 ? 448 : vh == 1 ? 576 : vh < 6 ? 1216 + 64 * (vh - 2) : 2304 + 64 * (vh - 6);
            vt_tile(cols + (size_t)T0 * LDC + col, LDC, VT + ((size_t)(b * 12 + vh) * 64) * 2048 + s0, smem);
        }
    }
}

DEV void phase_layout2(const Params& p, int layer, char* smem) {
    char* ws = p.ws;
    bf16_t* qmla = (bf16_t*)(ws + OFF_QMLA);
    const bf16_t* kvmla = (const bf16_t*)(ws + OFF_KVMLA);
    bf16_t* VT = (bf16_t*)(ws + OFF_VT);
    const float* rope = (const float*)(ws + OFF_ROPE);
    const float *cos32 = rope + 2048 * 64, *sin32 = rope + 2048 * 64 + 2048 * 16;
    const int tid = ltid();
    for (int tile = blockIdx.x; tile < kT / 64 + 64; tile += gridDim.x) {
        if (tile >= kT / 64) {
            const int idx = (tile - kT / 64) * 2048 + tid * 8;
            const int kv = idx >> 16, m = (idx >> 6) & 1023, n = idx & 63;
            const float* pp = (const float*)(ws + OFF_QP) + ((size_t)(kv * 8) * 1024 + m) * 128 + n;
            const float* bias = (const float*)(ws + OFF_MISC) + (layer * 2 + kv) * 64 + n;
            float4 a = *(const float4*)bias, c = *(const float4*)(bias + 4);
#pragma unroll
            for (int ks = 0; ks < 8; ++ks) {
                const float4 x = *(const float4*)(pp + (size_t)ks * 1024 * 128), y = *(const float4*)(pp + (size_t)ks * 1024 * 128 + 4);
                a.x += x.x; a.y += x.y; a.z += x.z; a.w += x.w; c.x += y.x; c.y += y.y; c.z += y.z; c.w += y.w;
            }
            *(uint4*)((bf16_t*)(ws + OFF_KCMP) + (size_t)kv * 1024 * 64 + m * 64 + n) = make_uint4(pack2(a.x, a.y), pack2(a.z, a.w), pack2(c.x, c.y), pack2(c.z, c.w));
            continue;
        }
        const int T0 = tile * 64, b = T0 >> 11, s0 = T0 & 2047;
        for (int it = tid; it < 64 * 8; it += 256) {
            const int tok = it >> 3, item = it & 7, hd = item >> 1, i0 = (item & 1) * 8;
            const int t = T0 + tok, s = s0 + tok;
            bf16_t* row = qmla + (size_t)t * 384 + hd * 96 + 64;
            uint4 x1 = *(const uint4*)(row + i0), x2 = *(const uint4*)(row + 16 + i0);
            const float* cp = cos32 + s * 16 + i0; const float* sp = sin32 + s * 16 + i0;
            const float4 c0 = *(const float4*)cp, c1 = *(const float4*)(cp + 4), q0 = *(const float4*)sp, q1 = *(const float4*)(sp + 4);
            const float cc[8] = {c0.x, c0.y, c0.z, c0.w, c1.x, c1.y, c1.z, c1.w}, ss[8] = {q0.x, q0.y, q0.z, q0.w, q1.x, q1.y, q1.z, q1.w};
            rope8(x1, x2, cc, ss);
            *(uint4*)(row + i0) = x1; *(uint4*)(row + 16 + i0) = x2;
        }
#pragma unroll 1
        for (int hd = 0; hd < 4; ++hd)
            vt_tile(kvmla + (size_t)T0 * 512 + hd * 128 + 64, 512, VT + ((size_t)(b * 12 + 8 + hd) * 64) * 2048 + s0, smem);
    }
}

constexpr int SM_K = 0;
constexpr int SM_V = 26624;
constexpr int SM_IMP = SM_V + 17408;
constexpr int SM_SEL = SM_IMP + 16896;
constexpr int SM_CTRL = 65536;
constexpr int SM_TOTAL = SM_CTRL + 256 + 512;
constexpr int SM_ATTN_END = SM_SEL + 1024;

struct RangeIter { int cur, end; DEV int next() { return cur < end ? cur++ : -1; } };
struct BitIter { unsigned rem; DEV int next() { if (!rem) return -1; const int k = __ffs((int)rem) - 1; rem &= rem - 1; return k; } };
struct LdRow { const bf16_t* base; int ld;
    DEV uint4 operator()(int kt, int id) const { const int row = id >> 3, part = id & 7; return *(const uint4*)(base + (size_t)(kt * 64 + row) * ld + part * 8); } };
struct LdVT { const bf16_t* base;
    DEV uint4 operator()(int kt, int id) const { const int d = id >> 3, part = id & 7; return *(const uint4*)(base + (size_t)d * 2048 + kt * 64 + part * 8); } };
struct LdMlaK { const bf16_t* kv; const bf16_t* kr;
    DEV uint4 operator()(int kt, int id) const { const int row = id / 12, part = id % 12; const size_t t = (size_t)(kt * 64 + row);
        return part < 8 ? *(const uint4*)(kv + t * 512 + part * 8) : *(const uint4*)(kr + t * LDC + (part - 8) * 8); } };

struct MaskCausal { DEV bool on(int) const { return true; } DEV bool ok(int kc, int d) const { return kc <= d; }
    DEV bool full(int kt, int t0w) const { return kt * 64 + 63 <= t0w; } };
template <int W> struct MaskWin { DEV bool on(int) const { return true; } DEV bool ok(int kc, int d) const { return (kc <= d) && (d - kc < W); }
    DEV bool full(int kt, int t0w) const { return (kt * 64 + 63 <= t0w) && (t0w + 31 - kt * 64 < W); } };
struct MaskSel { unsigned bits, allbits; DEV bool on(int kt) const { return (bits >> kt) & 1u; } DEV bool ok(int kc, int d) const { return kc <= d; }
    DEV bool full(int kt, int t0w) const { return ((allbits >> kt) & 1u) && (kt * 64 + 63 <= t0w); } };
template <int KDIM, int NKS, int NSUB, bool QG, class It, class LK, class LV, class MaskF, class SkipF>
DEV void attn_stream(It it, const LK& ldK, const LV& ldV, const MaskF& maskf, const SkipF& skipf,
                     const bf16x8* qf, f32x16 (&o)[NSUB][2], float (&m)[NSUB], float (&l)[NSUB], float scl, int tq, int t0w, char* smem, int tid, int koff = 0) {
    constexpr int KCH = KDIM / 8, KSTR = KDIM + 8, NKC = (64 * KCH) / 256;
    constexpr int KBUF = 64 * 104, VBUF = 64 * 68;
    bf16_t* Kb = (bf16_t*)(smem + SM_K);
    bf16_t* Vb = (bf16_t*)(smem + SM_V);
    const int lane = tid & 63, ql = lane & 31, hh = lane >> 5;
    const uint4 z4 = make_uint4(0, 0, 0, 0);
    uint4 ak0 = z4, ak1 = z4, ak2 = z4, av0 = z4, av1 = z4, bk0 = z4, bk1 = z4, bk2 = z4, bv0 = z4, bv1 = z4;
    auto loadA = [&](int kt) __attribute__((always_inline)) { ak0 = ldK(kt, tid); ak1 = ldK(kt, tid + 256); if (NKC == 3) ak2 = ldK(kt, tid + 512); av0 = ldV(kt, tid); av1 = ldV(kt, tid + 256); };
    auto loadB = [&](int kt) __attribute__((always_inline)) { bk0 = ldK(kt, tid); bk1 = ldK(kt, tid + 256); if (NKC == 3) bk2 = ldK(kt, tid + 512); bv0 = ldV(kt, tid); bv1 = ldV(kt, tid + 256); };
    auto stK = [&](bf16_t* kb, const uint4& r, int id) __attribute__((always_inline)) { const int row = id / KCH, part = id % KCH; *(uint4*)(kb + row * KSTR + part * 8) = r; };
    auto stV = [&](bf16_t* vb, const uint4& r, int id) __attribute__((always_inline)) { const int row = id >> 3, part = id & 7; bf16_t* d = vb + row * 68 + part * 8;
        *(uint2*)d = make_uint2(r.x, r.y); *(uint2*)(d + 4) = make_uint2(r.z, r.w); };
    auto compute = [&](int kt, const bf16_t* Kt, const bf16_t* Vt) __attribute__((always_inline)) {
        if (skipf(kt)) return;
#pragma unroll
        for (int sub = 0; sub < NSUB; ++sub) {
            const int tqs = tq + (QG ? 32 * sub : 0), t0s = t0w + (QG ? 32 * sub : 0);
            if (QG && kt * 64 > t0s + 31) continue;
            __builtin_amdgcn_sched_barrier(0);
            f32x16 s[2];
#pragma unroll
            for (int i = 0; i < 2; ++i) {
                s[i] = zero16();
#pragma unroll
                for (int ks = 0; ks < NKS; ++ks) {
                    const bf16x8 a = *(const bf16x8*)(Kt + (i * 32 + ql) * KSTR + koff + ((QG ? 0 : sub * NKS) + ks) * 16 + hh * 8);
                    s[i] = mfma32(a, qf[sub * NKS + ks], s[i]);
                }
            }
            float mx = kNeg;
            if (!maskf.full(kt, t0s)) {
                const int dlim = tqs - kt * 64 - 4 * hh;
                const bool on = maskf.on(kt);
#pragma unroll
                for (int i = 0; i < 2; ++i)
#pragma unroll
                    for (int r = 0; r < 16; ++r) {
                        const int kc = i * 32 + (r & 3) + 8 * (r >> 2);
                        s[i][r] = (on && maskf.ok(kc, dlim)) ? s[i][r] : kNeg;
                    }
            }
#pragma unroll
            for (int i = 0; i < 2; ++i)
#pragma unroll
                for (int r = 0; r < 16; ++r) mx = fmaxf(mx, s[i][r]);
            mx = fmaxf(mx, xor32f(mx, lane));
            const float mnew = fmaxf(m[sub], mx);
            const float alpha = __builtin_amdgcn_exp2f((m[sub] - mnew) * scl);
            m[sub] = mnew;
            const float negm = mnew > -1e29f ? -mnew * scl : 0.f;
            float sum = 0.f;
#pragma unroll
            for (int i = 0; i < 2; ++i)
#pragma unroll
                for (int r = 0; r < 16; ++r) { const float pv = __builtin_amdgcn_exp2f(__builtin_fmaf(s[i][r], scl, negm)); s[i][r] = pv; sum += pv; }
            l[sub] = l[sub] * alpha + sum;
            if (__builtin_amdgcn_ballot_w64(alpha != 1.f)) {
#pragma unroll
                for (int dt = 0; dt < 2; ++dt)
#pragma unroll
                    for (int r = 0; r < 16; ++r) o[sub][dt][r] *= alpha;
            }
            __builtin_amdgcn_sched_barrier(0);
#pragma unroll
            for (int ks = 0; ks < 4; ++ks) {
                if (ks == 2) __builtin_amdgcn_sched_barrier(0);
                const int i = ks >> 1, r0 = 8 * (ks & 1);
                uint4 pu;
                pu.x = pack2(s[i][r0 + 0], s[i][r0 + 1]); pu.y = pack2(s[i][r0 + 2], s[i][r0 + 3]);
                pu.z = pack2(s[i][r0 + 4], s[i][r0 + 5]); pu.w = pack2(s[i][r0 + 6], s[i][r0 + 7]);
                const bf16x8 pf = __builtin_bit_cast(bf16x8, pu);
#pragma unroll
                for (int dt = 0; dt < 2; ++dt) {
                    const bf16_t* vp = Vt + (dt * 32 + ql) * 68 + ks * 16 + 4 * hh;
                    const uint2 a0 = *(const uint2*)vp, a1 = *(const uint2*)(vp + 8);
                    const bf16x8 a = __builtin_bit_cast(bf16x8, make_uint4(a0.x, a0.y, a1.x, a1.y));
                    o[sub][dt] = mfma32(a, pf, o[sub][dt]);
                }
            }
        }
    };
    int ka = it.next();
    int kb = ka >= 0 ? it.next() : -1;
    if (ka >= 0) loadA(ka);
    if (kb >= 0) loadB(kb);
    while (ka >= 0) {
        __syncthreads();
        stK(Kb, ak0, tid); stK(Kb, ak1, tid + 256); if (NKC == 3) stK(Kb, ak2, tid + 512);
        stV(Vb, av0, tid); stV(Vb, av1, tid + 256);
        if (kb >= 0) {
            stK(Kb + KBUF, bk0, tid); stK(Kb + KBUF, bk1, tid + 256); if (NKC == 3) stK(Kb + KBUF, bk2, tid + 512);
            stV(Vb + VBUF, bv0, tid); stV(Vb + VBUF, bv1, tid + 256);
        }
        __syncthreads();
        const int na = it.next();
        const int nb = na >= 0 ? it.next() : -1;
        if (na >= 0) loadA(na);
        if (nb >= 0) loadB(nb);
        compute(ka, Kb, Vb);
        if (kb >= 0) compute(kb, Kb + KBUF, Vb + VBUF);
        ka = na; kb = nb;
    }
}

DEV void write_o(const f32x16 (&o)[2], bf16_t* obuf, size_t row, int col0, int hh) {
#pragma unroll
    for (int dt = 0; dt < 2; ++dt)
#pragma unroll
        for (int g = 0; g < 4; ++g) {
            const int d = dt * 32 + 8 * g + 4 * hh;
            uint2 u; u.x = pack2(o[dt][4 * g], o[dt][4 * g + 1]); u.y = pack2(o[dt][4 * g + 2], o[dt][4 * g + 3]);
            *(uint2*)(obuf + row * 1024 + col0 + d) = u;
        }
}
DEV float sigmoidf(float x) { return 1.f / (1.f + __expf(-x)); }

DEV void nsa_item(const Params& p, int layer, int b, int qb, char* smem) {
    int tid = threadIdx.x; asm volatile("" : "+v"(tid));
    const int lane = tid & 63, w = tid >> 6, ql = lane & 31, hh = lane >> 5;
    char* ws = p.ws;
    const bf16_t* cols = (const bf16_t*)(ws + OFF_COLS);
    const bf16_t* VT = (const bf16_t*)(ws + OFF_VT);
    bf16_t* obuf = (bf16_t*)(ws + OFF_O);
    const int t0 = qb * 32, tq = t0 + ql;
    const size_t Tb = (size_t)b * kS;
    const bf16_t* qrow = cols + (Tb + tq) * LDC;
    bf16x8 qf[4];
#pragma unroll
    for (int ks = 0; ks < 4; ++ks) qf[ks] = *(const bf16x8*)(qrow + w * 64 + ks * 16 + hh * 8);
    const float g0 = sigmoidf(bf2f(qrow[640 + w * 3 + 0])), g1 = sigmoidf(bf2f(qrow[640 + w * 3 + 1])), g2 = sigmoidf(bf2f(qrow[640 + w * 3 + 2]));
    const float scl = 0.125f * kLog2e;
    bf16_t* Kc = (bf16_t*)(smem + SM_K);
    bf16_t* Vc = (bf16_t*)(smem + SM_V);
    float* impP = (float*)(smem + SM_IMP);
    unsigned* selm = (unsigned*)(smem + SM_SEL);
    const float* gk = (const float*)(ws + OFF_QP) + (size_t)b * 128 * 128;
    const float* gv = gk + (size_t)1024 * 128;
    const float* bias = (const float*)(ws + OFF_MISC) + layer * 128;
    __syncthreads();
#pragma unroll
    for (int i = 0; i < 4; ++i) {
        const int id = tid + 256 * i, row = id >> 3, part = id & 7;
        const int row1 = row < 127 ? row + 1 : row;
        const float* a = gk + (size_t)row * 128 + part * 8;  const float* a2 = gk + (size_t)row1 * 128 + 64 + part * 8;
        const float* c = gv + (size_t)row * 128 + part * 8;  const float* c2 = gv + (size_t)row1 * 128 + 64 + part * 8;
        const float4 k0 = *(const float4*)a, k1 = *(const float4*)(a + 4), k2 = *(const float4*)a2, k3 = *(const float4*)(a2 + 4);
        const float4 v0 = *(const float4*)c, v1 = *(const float4*)(c + 4), v2 = *(const float4*)c2, v3 = *(const float4*)(c2 + 4);
        const float4 bk0 = *(const float4*)(bias + part * 8), bk1 = *(const float4*)(bias + part * 8 + 4);
        const float4 bv0 = *(const float4*)(bias + 64 + part * 8), bv1 = *(const float4*)(bias + 64 + part * 8 + 4);
        uint4 kk = make_uint4(pack2(k0.x + k2.x + bk0.x, k0.y + k2.y + bk0.y), pack2(k0.z + k2.z + bk0.z, k0.w + k2.w + bk0.w),
                              pack2(k1.x + k3.x + bk1.x, k1.y + k3.y + bk1.y), pack2(k1.z + k3.z + bk1.z, k1.w + k3.w + bk1.w));
        uint4 vv = make_uint4(pack2(v0.x + v2.x + bv0.x, v0.y + v2.y + bv0.y), pack2(v0.z + v2.z + bv0.z, v0.w + v2.w + bv0.w),
                              pack2(v1.x + v3.x + bv1.x, v1.y + v3.y + bv1.y), pack2(v1.z + v3.z + bv1.z, v1.w + v3.w + bv1.w));
        if (row == 127) { kk = make_uint4(0, 0, 0, 0); vv = kk; }
        *(uint4*)(Kc + row * 72 + part * 8) = kk;
        const unsigned u[4] = {vv.x, vv.y, vv.z, vv.w};
#pragma unroll
        for (int j = 0; j < 4; ++j) { Vc[(part * 8 + 2 * j) * 132 + row] = (bf16_t)(u[j] & 0xffffu); Vc[(part * 8 + 2 * j + 1) * 132 + row] = (bf16_t)(u[j] >> 16); }
    }
    __syncthreads();
    unsigned ocp[16];
    float* invs = (float*)(smem + SM_SEL) + 64;
    {
        const int cmaxv = tq >= 31 ? min((tq - 31) >> 4, 126) : -1;
        float mx = kNeg;
#pragma unroll 1
        for (int i = 0; i < 4; ++i) {
            f32x16 s = zero16();
#pragma unroll
            for (int ks = 0; ks < 4; ++ks) s = mfma32(*(const bf16x8*)(Kc + (i * 32 + ql) * 72 + ks * 16 + hh * 8), qf[ks], s);
            const int clim = cmaxv - i * 32 - 4 * hh;
#pragma unroll
            for (int r = 0; r < 16; ++r) {
                const int kc = (r & 3) + 8 * (r >> 2);
                const bool valid = (kc <= clim);
                mx = fmaxf(mx, valid ? s[r] * scl : kNeg);
            }
        }
        mx = fmaxf(mx, xor32f(mx, lane));
        f32x16 ocmp[2]; ocmp[0] = zero16(); ocmp[1] = zero16();
        float sum = 0.f, carprev = 0.f;
#pragma unroll 1
        for (int i = 0; i < 4; ++i) {
            f32x16 s = zero16();
#pragma unroll
            for (int ks = 0; ks < 4; ++ks) s = mfma32(*(const bf16x8*)(Kc + (i * 32 + ql) * 72 + ks * 16 + hh * 8), qf[ks], s);
            const int clim = cmaxv - i * 32 - 4 * hh;
#pragma unroll
            for (int r = 0; r < 16; ++r) {
                const int kc = (r & 3) + 8 * (r >> 2);
                const bool valid = (kc <= clim);
                const float pv = valid ? __builtin_amdgcn_exp2f(s[r] * scl - mx) : 0.f;
                s[r] = pv; sum += pv;
            }
            float own[4], car[4];
#pragma unroll
            for (int g = 0; g < 4; ++g) { own[g] = s[4 * g] + s[4 * g + 1] + s[4 * g + 2] + 0.5f * s[4 * g + 3]; car[g] = 0.5f * s[4 * g + 3]; }
#pragma unroll
            for (int g = 0; g < 4; ++g) {
                const float send = hh ? (g ? car[g > 0 ? g - 1 : 0] : carprev) : car[g];
                own[g] += xor32f(send, lane);
            }
            carprev = car[3];
#pragma unroll
            for (int g = 0; g < 4; ++g) impP[(w * 32 + ql) * 33 + 2 * (4 * i + g) + hh] = own[g];
#pragma unroll
            for (int sp = 0; sp < 2; ++sp) {
                const int ks = 2 * i + sp, r0 = 8 * sp;
                uint4 pu;
                pu.x = pack2(s[r0 + 0], s[r0 + 1]); pu.y = pack2(s[r0 + 2], s[r0 + 3]);
                pu.z = pack2(s[r0 + 4], s[r0 + 5]); pu.w = pack2(s[r0 + 6], s[r0 + 7]);
                const bf16x8 pf = __builtin_bit_cast(bf16x8, pu);
#pragma unroll
                for (int dt = 0; dt < 2; ++dt) {
                    const bf16_t* vp = Vc + (dt * 32 + ql) * 132 + ks * 16 + 4 * hh;
                    const uint2 a0 = *(const uint2*)vp, a1 = *(const uint2*)(vp + 8);
                    ocmp[dt] = mfma32(__builtin_bit_cast(bf16x8, make_uint4(a0.x, a0.y, a1.x, a1.y)), pf, ocmp[dt]);
                }
            }
        }
        sum += xor32f(sum, lane);
        const float inv = sum > 0.f ? 1.f / sum : 0.f;
        invs[w * 32 + ql] = inv;
        const float f = g0 * inv;
#pragma unroll
        for (int dt = 0; dt < 2; ++dt)
#pragma unroll
            for (int r = 0; r < 8; ++r) ocp[dt * 8 + r] = pack2(f * ocmp[dt][2 * r], f * ocmp[dt][2 * r + 1]);
    }
    __syncthreads();
    const int qblk = t0 >> 6;
    {
        const int hw = tid >> 5, j = tid & 31;
#pragma unroll 1
        for (int rr = 0; rr < 4; ++rr) {
            const int row = hw * 4 + rr;
            const float v = impP[(0 * 32 + row) * 33 + j] * invs[row] + impP[(1 * 32 + row) * 33 + j] * invs[32 + row]
                          + impP[(2 * 32 + row) * 33 + j] * invs[64 + row] + impP[(3 * 32 + row) * 33 + j] * invs[96 + row];
            bool sel;
            if (qblk < 16) sel = (j <= qblk);
            else {
                const bool cand = (j >= 1) && (j <= qblk - 2);
                const bool forced = (j == 0) || (j == qblk) || (j == qblk - 1);
                int rank = 0;
                for (int j2 = 1; j2 <= qblk - 2; ++j2) {
                    const float v2 = lanef(v, (lane & 32) + j2);
                    rank += (v2 > v || (v2 == v && j2 < j)) ? 1 : 0;
                }
                sel = forced || (cand && rank < 13);
            }
            const unsigned long long bal = __ballot(sel);
            const unsigned mk = (lane & 32) ? (unsigned)(bal >> 32) : (unsigned)bal;
            if (j == 0) selm[row] = mk;
        }
    }
    __syncthreads();
    const unsigned mysel = selm[ql];
    unsigned U = mysel, Uall = mysel;
#pragma unroll
    for (int o = 16; o > 0; o >>= 1) { U |= (unsigned)__builtin_amdgcn_ds_bpermute((lane ^ o) << 2, (int)U); Uall &= (unsigned)__builtin_amdgcn_ds_bpermute((lane ^ o) << 2, (int)Uall); }
    Uall = (unsigned)__builtin_amdgcn_readfirstlane((int)Uall);
    {
        f32x16 o1[1][2]; o1[0][0] = zero16(); o1[0][1] = zero16();
        float m1[1] = {kNeg}, l1[1] = {0.f};
        auto skipf = [&](int) __attribute__((always_inline)) { return false; };
        attn_stream<64, 4, 1, false>(BitIter{U}, LdRow{cols + Tb * LDC + 384, LDC}, LdVT{VT + (size_t)(b * 12 + 0) * 64 * 2048}, MaskSel{mysel, Uall}, skipf, qf, o1, m1, l1, scl, tq, __builtin_amdgcn_readfirstlane(t0), smem, tid);
        const float lt = l1[0] + xor32f(l1[0], lane);
        const float f = g1 / lt;
#pragma unroll
        for (int dt = 0; dt < 2; ++dt)
#pragma unroll
            for (int r = 0; r < 8; ++r) ocp[dt * 8 + r] = pack2(lo16(ocp[dt * 8 + r]) + f * o1[0][dt][2 * r], hi16(ocp[dt * 8 + r]) + f * o1[0][dt][2 * r + 1]);
    }
    {
        f32x16 o1[1][2]; o1[0][0] = zero16(); o1[0][1] = zero16();
        float m1[1] = {kNeg}, l1[1] = {0.f};
        auto skipf = [&](int) __attribute__((always_inline)) { return false; };
        const int lo = t0 >= 511 ? ((t0 - 511) >> 6) : 0;
        attn_stream<64, 4, 1, false>(RangeIter{lo, qblk + 1}, LdRow{cols + Tb * LDC + 512, LDC}, LdVT{VT + (size_t)(b * 12 + 1) * 64 * 2048}, MaskWin<512>{}, skipf, qf, o1, m1, l1, scl, tq, __builtin_amdgcn_readfirstlane(t0), smem, tid);
        const float lt = l1[0] + xor32f(l1[0], lane);
        const float f = g2 / lt;
#pragma unroll
        for (int dt = 0; dt < 2; ++dt)
#pragma unroll
            for (int r = 0; r < 8; ++r) { o1[0][dt][2 * r] = lo16(ocp[dt * 8 + r]) + f * o1[0][dt][2 * r]; o1[0][dt][2 * r + 1] = hi16(ocp[dt * 8 + r]) + f * o1[0][dt][2 * r + 1]; }
        write_o(o1[0], obuf, Tb + tq, w * 64, hh);
    }
}

DEV void diff_item(const Params& p, int layer, int b, int hd, int qc, char* smem) {
    int tid = threadIdx.x; asm volatile("" : "+v"(tid));
    const int lane = tid & 63, w = tid >> 6, ql = lane & 31, hh = lane >> 5;
    const int sub = w & 1, qh = w >> 1;
    char* ws = p.ws;
    const bf16_t* cols = (const bf16_t*)(ws + OFF_COLS);
    const bf16_t* VT = (const bf16_t*)(ws + OFF_VT);
    bf16_t* obuf = (bf16_t*)(ws + OFF_O);
    const float* misc = (const float*)(ws + OFF_MISC);
    const int t0w = qc * 128 + qh * 64, tq = t0w + ql;
    const size_t Tb = (size_t)b * kS;
    bf16x8 qf[4];
#pragma unroll
    for (int g = 0; g < 2; ++g)
#pragma unroll
        for (int ks = 0; ks < 2; ++ks) qf[g * 2 + ks] = *(const bf16x8*)(cols + (Tb + tq + 32 * g) * LDC + 704 + hd * 64 + sub * 32 + ks * 16 + hh * 8);
    const float scl = 0.17677669529663687f * kLog2e;
    f32x16 o2[2][2];
#pragma unroll
    for (int g = 0; g < 2; ++g) { o2[g][0] = zero16(); o2[g][1] = zero16(); }
    float m2[2] = {kNeg, kNeg}, l2[2] = {0.f, 0.f};
    auto skipf = [&](int kt) __attribute__((always_inline)) { return kt * 64 > t0w + 63; };
    attn_stream<64, 2, 2, true>(RangeIter{0, 2 * qc + 2}, LdRow{cols + Tb * LDC + 960 + hd * 64, LDC}, LdVT{VT + (size_t)(b * 12 + 2 + hd) * 64 * 2048}, MaskCausal{}, skipf, qf, o2, m2, l2, scl, tq, __builtin_amdgcn_readfirstlane(t0w), smem, tid, sub * 32);
    const float lam = misc[256 + layer], post = misc[258 + layer];
    float* ex = (float*)smem;
    __syncthreads();
#pragma unroll
    for (int g = 0; g < 2; ++g) {
        const float lt = l2[g] + xor32f(l2[g], lane);
        if (sub == 1) {
            const float f = lam / lt;
#pragma unroll
            for (int dt = 0; dt < 2; ++dt)
#pragma unroll
                for (int r = 0; r < 16; ++r) ex[(((qh * 2 + g) * 2 + dt) * 16 + r) * 64 + lane] = o2[g][dt][r] * f;
        } else {
            const float f = 1.f / lt;
#pragma unroll
            for (int dt = 0; dt < 2; ++dt)
#pragma unroll
                for (int r = 0; r < 16; ++r) o2[g][dt][r] *= f;
        }
    }
    __syncthreads();
    if (sub == 0) {
        const float* sg = p.sub_g + layer * 64;
#pragma unroll
        for (int g = 0; g < 2; ++g) {
            float ss = 0.f;
#pragma unroll
            for (int dt = 0; dt < 2; ++dt)
#pragma unroll
                for (int r = 0; r < 16; ++r) { const float v = o2[g][dt][r] - ex[(((qh * 2 + g) * 2 + dt) * 16 + r) * 64 + lane]; o2[g][dt][r] = v; ss += v * v; }
            ss += xor32f(ss, lane);
            const float rstd = rsqrtf(ss * (1.f / 64.f) + kEps) * post;
#pragma unroll
            for (int dt = 0; dt < 2; ++dt)
#pragma unroll
                for (int r = 0; r < 16; ++r) { const int d = dt * 32 + (r & 3) + 8 * (r >> 2) + 4 * hh; o2[g][dt][r] *= rstd * sg[d]; }
            write_o(o2[g], obuf, Tb + tq + 32 * g, 256 + hd * 64, hh);
        }
    }
}

DEV void mla_item(const Params& p, int b, int hd, int qc, char* smem) {
    int tid = threadIdx.x; asm volatile("" : "+v"(tid));
    const int lane = tid & 63, w = tid >> 6, ql = lane & 31, hh = lane >> 5;
    char* ws = p.ws;
    const bf16_t* cols = (const bf16_t*)(ws + OFF_COLS);
    const bf16_t* VT = (const bf16_t*)(ws + OFF_VT);
    const bf16_t* qmla = (const bf16_t*)(ws + OFF_QMLA);
    const bf16_t* kvmla = (const bf16_t*)(ws + OFF_KVMLA);
    bf16_t* obuf = (bf16_t*)(ws + OFF_O);
    const int t0w = qc * 128 + w * 32, tq = t0w + ql;
    const size_t Tb = (size_t)b * kS;
    const bf16_t* qrow = qmla + (Tb + tq) * 384 + hd * 96;
    bf16x8 qf[6];
#pragma unroll
    for (int ks = 0; ks < 6; ++ks) qf[ks] = *(const bf16x8*)(qrow + ks * 16 + hh * 8);
    const float scl = 0.10206207261596575f * kLog2e;
    f32x16 o1[1][2]; o1[0][0] = zero16(); o1[0][1] = zero16();
    float m1[1] = {kNeg}, l1[1] = {0.f};
    auto skipf = [&](int kt) __attribute__((always_inline)) { return kt * 64 > t0w + 31; };
    attn_stream<96, 6, 1, false>(RangeIter{0, 2 * qc + 2}, LdMlaK{kvmla + Tb * 512 + hd * 128, cols + Tb * LDC + 1856}, LdVT{VT + (size_t)(b * 12 + 8 + hd) * 64 * 2048}, MaskCausal{}, skipf, qf, o1, m1, l1, scl, tq, __builtin_amdgcn_readfirstlane(t0w), smem, tid);
    const float inv = 1.f / (l1[0] + xor32f(l1[0], lane));
#pragma unroll
    for (int dt = 0; dt < 2; ++dt)
#pragma unroll
        for (int r = 0; r < 16; ++r) o1[0][dt][r] *= inv;
    write_o(o1[0], obuf, Tb + tq, 512 + hd * 64, hh);
}

DEV void swa_item(const Params& p, int layer, int b, int g, int q64, char* smem) {
    int tid = threadIdx.x; asm volatile("" : "+v"(tid));
    const int lane = tid & 63, w = tid >> 6, ql = lane & 31, hh = lane >> 5;
    char* ws = p.ws;
    const bf16_t* cols = (const bf16_t*)(ws + OFF_COLS);
    const bf16_t* VT = (const bf16_t*)(ws + OFF_VT);
    bf16_t* obuf = (bf16_t*)(ws + OFF_O);
    const int head = g * 2 + (w & 1);
    const int t0w = q64 * 64 + (w >> 1) * 32, tq = t0w + ql;
    const size_t Tb = (size_t)b * kS;
    const bf16_t* qrow = cols + (Tb + tq) * LDC + 1920 + head * 64;
    bf16x8 qf[4];
#pragma unroll
    for (int ks = 0; ks < 4; ++ks) qf[ks] = *(const bf16x8*)(qrow + ks * 16 + hh * 8);
    const float scl = 0.125f * kLog2e;
    f32x16 o1[1][2]; o1[0][0] = zero16(); o1[0][1] = zero16();
    float m1[1] = {p.sinks[layer * 4 + head] * 8.f}, l1[1] = {hh == 0 ? 1.f : 0.f};
    auto skipf = [&](int kt) __attribute__((always_inline)) { return (kt * 64 > t0w + 31) || (kt * 64 + 63 < t0w - 127); };
    const int lo = q64 >= 2 ? q64 - 2 : 0;
    attn_stream<64, 4, 1, false>(RangeIter{lo, q64 + 1}, LdRow{cols + Tb * LDC + 2176 + g * 64, LDC}, LdVT{VT + (size_t)(b * 12 + 6 + g) * 64 * 2048}, MaskWin<128>{}, skipf, qf, o1, m1, l1, scl, tq, __builtin_amdgcn_readfirstlane(t0w), smem, tid);
    const float inv = 1.f / (l1[0] + xor32f(l1[0], lane));
#pragma unroll
    for (int dt = 0; dt < 2; ++dt)
#pragma unroll
        for (int r = 0; r < 16; ++r) o1[0][dt][r] *= inv;
    write_o(o1[0], obuf, Tb + tq, 768 + head * 64, hh);
}

DEV void phase_attn(const Params& p, int layer, char* smem, int rep = 0) {
    unsigned* ctr = (unsigned*)(p.ws + OFF_CTRL) + 64 + layer * 16 + rep;
    volatile int* slot = (volatile int*)(smem + SM_SEL) + 48;
    for (;;) {
        __syncthreads();
        if (ltid() == 0) *slot = (int)atomicAdd(ctr, 1u);
        __syncthreads();
        const int idx = __builtin_amdgcn_readfirstlane(*slot);
        if (idx >= 2048) break;
        const int level = 15 - (idx >> 7), r = idx & 127;
#if TS_A >= 0
        const unsigned long long tsa = __builtin_amdgcn_s_memrealtime();
#endif
        if (r < 32) { diff_item(p, layer, r >> 2, r & 3, level, smem); }
        else if (r < 64) { const int k = r - 32; mla_item(p, k >> 2, k & 3, level, smem); }
        else if (r < 96) { const int k = r - 64; nsa_item(p, layer, k >> 2, level * 4 + (3 - (k & 3)), smem); }
        else { const int k = r - 96; swa_item(p, layer, k >> 2, (k >> 1) & 1, level * 2 + (k & 1), smem); }
#if TS_A >= 0
        if (threadIdx.x == 0 && layer == 1) {
            const int ty = r >> 5;
            unsigned long long* ts = (unsigned long long*)(p.ws + 32768);
            atomicAdd(&ts[60 + ty], (unsigned long long)(__builtin_amdgcn_s_memrealtime() - tsa));
        }
#endif
    }
}

#define XB_TMO      128
#define XB_XCNT(j)  (256  + 64 * (j))
#define XB_XSUB(j)  (1280 + 64 * (j))
#define XB_XGEN(j)  (2304 + 64 * (j))
#define XB_TOP      3328
#define XB_TOPGEN   3392
#define XB_SPIN_CAP (1u << 22)
DEV unsigned xb_ld(unsigned* p) { return __hip_atomic_load(p, __ATOMIC_RELAXED, __HIP_MEMORY_SCOPE_AGENT); }
DEV unsigned xb_add(unsigned* p, unsigned v) { return __hip_atomic_fetch_add(p, v, __ATOMIC_RELAXED, __HIP_MEMORY_SCOPE_AGENT); }
DEV unsigned xb_xcc_id() { return (unsigned)__builtin_amdgcn_s_getreg((3 << 11) | 20) & 0xFu; }
#define XB_SPIN(cond, bar) do { unsigned _sp = 0; while (cond) { __builtin_amdgcn_s_sleep(1); \
    if ((++_sp & 255u) == 0u) { if (xb_ld(&(bar)[XB_TMO])) break; if (_sp > XB_SPIN_CAP) { atomicAdd(&(bar)[XB_TMO], 1u); break; } } } } while (0)
struct XcdBarrier { unsigned* bar; unsigned x; volatile LAS unsigned* st; };
DEV XcdBarrier xcd_barrier_post(unsigned* bar, volatile LAS unsigned* st) {
    XcdBarrier b; b.bar = bar; b.x = xb_xcc_id(); b.st = st;
    if (threadIdx.x == 0) st[2] = xb_add(&bar[XB_XCNT(b.x)], 1u);
    return b;
}
DEV void xcd_barrier_complete(unsigned* bar, unsigned x, unsigned& nloc, unsigned& nx) {
    const unsigned G = gridDim.x * gridDim.y * gridDim.z;
    unsigned sum, cnt, mine, sp = 0u;
    for (;;) {
        sum = 0u; cnt = 0u; mine = 0u;
#pragma unroll
        for (unsigned j = 0; j < 16; ++j) { const unsigned c = xb_ld(&bar[XB_XCNT(j)]); sum += c; cnt += (c > 0u) ? 1u : 0u; mine = (j == x) ? c : mine; }
        if (sum == G) break;
        __builtin_amdgcn_s_sleep(1);
        if ((++sp & 255u) == 0u) { if (xb_ld(&bar[XB_TMO])) break; if (sp > XB_SPIN_CAP) { atomicAdd(&bar[XB_TMO], 1u); break; } }
    }
    nloc = mine > 0u ? mine : 1u; nx = cnt > 0u ? cnt : 1u;
}
DEV void xcd_barrier(const XcdBarrier& b) {
    asm volatile("s_waitcnt vmcnt(0)" ::: "memory");
    __syncthreads();
    if (threadIdx.x == 0) {
        unsigned* bar = b.bar;
        asm volatile("" : "+v"(bar));
        __builtin_amdgcn_s_waitcnt(0);
        unsigned nloc = b.st[0], nx = b.st[1];
        if (nloc == 0u) { xcd_barrier_complete(bar, b.x, nloc, nx); b.st[0] = nloc; b.st[1] = nx; }
        const unsigned old = xb_add(&bar[XB_XSUB(b.x)], 1u);
        const unsigned gen = old / nloc;
        if (old + 1u == (gen + 1u) * nloc) {
            __builtin_amdgcn_fence(__ATOMIC_RELEASE, "agent");
            asm volatile("s_waitcnt vmcnt(0)" ::: "memory");
            const unsigned og = xb_add(&bar[XB_TOP], 1u);
            const unsigned tg = og / nx;
            if (og + 1u == (tg + 1u) * nx) xb_add(&bar[XB_TOPGEN], 1u);
            else XB_SPIN(xb_ld(&bar[XB_TOPGEN]) == tg, bar);
            __builtin_amdgcn_fence(__ATOMIC_ACQUIRE, "agent");
            xb_add(&bar[XB_XGEN(b.x)], 1u);
            asm volatile("s_waitcnt vmcnt(0)" ::: "memory");
        } else {
            XB_SPIN(xb_ld(&bar[XB_XGEN(b.x)]) == gen, bar);
            __builtin_amdgcn_fence(__ATOMIC_ACQUIRE, "agent");
            asm volatile("s_waitcnt vmcnt(0)" ::: "memory");
        }
    }
    __syncthreads();
}

DEV unsigned fkey(float f) { const unsigned u = __float_as_uint(f); return (u & 0x80000000u) ? ~u : (u | 0x80000000u); }
DEV float funkey(unsigned k) { return __uint_as_float((k & 0x80000000u) ? (k & 0x7fffffffu) : ~k); }
DEV void ins16(unsigned (&L)[16], unsigned x) {
#pragma unroll
    for (int i = 15; i >= 1; --i) { unsigned r; asm("v_med3_u32 %0, %1, %2, %3" : "=v"(r) : "v"(L[i - 1]), "v"(L[i]), "v"(x)); L[i] = r; }
    L[0] = L[0] > x ? L[0] : x;
}
DEV void phase_topk(const Params& p, char* smem) {
    const int tid = ltid();
    const float* S1 = (const float*)(p.ws + OFF_S1);
    const float* S2 = (const float*)(p.ws + OFF_S2);
    int* eid = (int*)(p.ws + OFF_EID);
    float* gate = (float*)(p.ws + OFF_GATE);
    unsigned char* ib = (unsigned char*)smem + tid * 32;
    for (int blk = blockIdx.x; blk < kT * 8 / 256; blk += gridDim.x) {
        const size_t row = (size_t)blk * 256 + tid;
        unsigned L1[16], L2[16];
#pragma unroll
        for (int i = 0; i < 16; ++i) { L1[i] = 0u; L2[i] = 0u; }
#pragma unroll 4
        for (int k = 0; k < 128; ++k) {
            const float a = S1[(size_t)k * (kT * 8) + row], b = S2[(size_t)k * (kT * 8) + row];
            ins16(L1, (fkey(a) & ~127u) | (unsigned)(127 - k));
            ins16(L2, (fkey(b) & ~127u) | (unsigned)(127 - k));
        }
        float v1[16], v2[16];
        __syncthreads();
#pragma unroll
        for (int i = 0; i < 16; ++i) {
            v1[i] = funkey(L1[i] & ~127u); v2[i] = funkey(L2[i] & ~127u);
            ib[i] = (unsigned char)(127u - (L1[i] & 127u)); ib[16 + i] = (unsigned char)(127u - (L2[i] & 127u));
        }
        unsigned C[16];
#pragma unroll
        for (int i = 0; i < 16; ++i) C[i] = 0u;
#pragma unroll
        for (int a = 0; a < 16; ++a)
#pragma unroll
            for (int b = 0; b < 16; ++b)
                if ((a + 1) * (b + 1) <= 16) ins16(C, (fkey(v1[a] + v2[b]) & ~255u) | (unsigned)(255 - (a * 16 + b)));
        float ts[16]; float sum = 0.f;
        const float tmax = funkey(C[0] & ~255u);
#pragma unroll
        for (int i = 0; i < 16; ++i) { ts[i] = __expf(funkey(C[i] & ~255u) - tmax); sum += ts[i]; }
        const float inv = 1.f / sum;
        int ev[16];
#pragma unroll
        for (int i = 0; i < 16; ++i) { const unsigned ci = 255u - (C[i] & 255u); ev[i] = (int)ib[ci >> 4] * 128 + (int)ib[16 + (ci & 15u)]; }
#pragma unroll
        for (int i = 0; i < 4; ++i) {
            *(int4*)(eid + row * 16 + 4 * i) = make_int4(ev[4 * i], ev[4 * i + 1], ev[4 * i + 2], ev[4 * i + 3]);
            *(float4*)(gate + row * 16 + 4 * i) = make_float4(ts[4 * i] * inv, ts[4 * i + 1] * inv, ts[4 * i + 2] * inv, ts[4 * i + 3] * inv);
        }
    }
}

struct EpiTop16 {
    unsigned (&L)[16];
    DEV void tile(int, int, const float* Cs, int tid) const {
        const int r = tid & 127, hk = tid >> 7;
        unsigned T[16];
#pragma unroll
        for (int i = 0; i < 16; ++i) T[i] = 0u;
#pragma unroll 4
        for (int k = 0; k < 64; ++k) {
            const int key = hk * 64 + k;
            ins16(T, (fkey(Cs[key * 128 + r]) & ~127u) | (unsigned)(127 - key));
        }
        __syncthreads();
        unsigned* X = (unsigned*)Cs;
        if (hk) {
#pragma unroll
            for (int i = 0; i < 16; ++i) X[r * 17 + i] = T[i];
        }
        __syncthreads();
        if (!hk) {
#pragma unroll
            for (int i = 0; i < 16; ++i) ins16(T, X[r * 17 + i]);
        }
#pragma unroll
        for (int i = 0; i < 16; ++i) L[i] = T[i];
    }
};
DEV void phase_route(const Params& p, int layer, char* smem) {
    char* ws = p.ws;
    int* eid = (int*)(ws + OFF_EID);
    float* gate = (float*)(ws + OFF_GATE);
    const bf16_t* qp = (const bf16_t*)(ws + OFF_QP);
    const bf16_t* subk = (const bf16_t*)(ws + OFF_SUBK) + (size_t)(layer * 2) * 16384;
    for (int nt = blockIdx.x; nt < kT * 8 / 128; nt += gridDim.x) {
        unsigned L1[16], L2[16];
        { EpiTop16 e1{L1}; gemm_tile(subk, 128, qp, 256, 128, 0, nt * 128, smem, e1); }
        { EpiTop16 e2{L2}; gemm_tile(subk + 16384, 128, qp + 128, 256, 128, 0, nt * 128, smem, e2); }
        const int tid = ltid();
        __syncthreads();
        if (tid < 128) {
            const size_t row = (size_t)nt * 128 + tid;
            unsigned char* ib = (unsigned char*)smem + tid * 32;
            float v1[16], v2[16];
#pragma unroll
            for (int i = 0; i < 16; ++i) {
                v1[i] = funkey(L1[i] & ~127u); v2[i] = funkey(L2[i] & ~127u);
                ib[i] = (unsigned char)(127u - (L1[i] & 127u)); ib[16 + i] = (unsigned char)(127u - (L2[i] & 127u));
            }
            unsigned C[16];
#pragma unroll
            for (int i = 0; i < 16; ++i) C[i] = 0u;
#pragma unroll
            for (int a = 0; a < 16; ++a)
#pragma unroll
                for (int b = 0; b < 16; ++b)
                    if ((a + 1) * (b + 1) <= 16) ins16(C, (fkey(v1[a] + v2[b]) & ~255u) | (unsigned)(255 - (a * 16 + b)));
            float ts[16]; float sum = 0.f;
            const float tmax = funkey(C[0] & ~255u);
#pragma unroll
            for (int i = 0; i < 16; ++i) { ts[i] = __expf(funkey(C[i] & ~255u) - tmax); sum += ts[i]; }
            const float inv = 1.f / sum;
            int ev[16];
#pragma unroll
            for (int i = 0; i < 16; ++i) { const unsigned ci = 255u - (C[i] & 255u); ev[i] = (int)ib[ci >> 4] * 128 + (int)ib[16 + (ci & 15u)]; }
#pragma unroll
            for (int i = 0; i < 4; ++i) {
                *(int4*)(eid + row * 16 + 4 * i) = make_int4(ev[4 * i], ev[4 * i + 1], ev[4 * i + 2], ev[4 * i + 3]);
                *(float4*)(gate + row * 16 + 4 * i) = make_float4(ts[4 * i] * inv, ts[4 * i + 1] * inv, ts[4 * i + 2] * inv, ts[4 * i + 3] * inv);
            }
        }
    }
}

DEV float row_sum_dpp(float v) {
    v += __int_as_float(__builtin_amdgcn_update_dpp(0, __float_as_int(v), 0xB1, 0xF, 0xF, true));
    v += __int_as_float(__builtin_amdgcn_update_dpp(0, __float_as_int(v), 0x4E, 0xF, 0xF, true));
    v += __int_as_float(__builtin_amdgcn_update_dpp(0, __float_as_int(v), 0x141, 0xF, 0xF, true));
    v += __int_as_float(__builtin_amdgcn_update_dpp(0, __float_as_int(v), 0x140, 0xF, 0xF, true));
    return v;
}
DEV float wave_sum_dpp(float v) {
    v = row_sum_dpp(v);
    const float r0 = __int_as_float(__builtin_amdgcn_readlane(__float_as_int(v), 0)), r1 = __int_as_float(__builtin_amdgcn_readlane(__float_as_int(v), 16));
    const float r2 = __int_as_float(__builtin_amdgcn_readlane(__float_as_int(v), 32)), r3 = __int_as_float(__builtin_amdgcn_readlane(__float_as_int(v), 48));
    return (r0 + r1) + (r2 + r3);
}
typedef float f32x2 __attribute__((ext_vector_type(2)));
typedef float f32x4 __attribute__((ext_vector_type(4)));

struct SliceMap { int virt, nx, nloc, rank; };
DEV SliceMap slice_map(const Params& p, char* smem) {
    unsigned* bar = (unsigned*)p.ws;
    const unsigned x = xb_xcc_id();
    int virt = 0, nx = 0, nloc = 1;
#pragma unroll
    for (unsigned j = 0; j < 16; ++j) {
        const unsigned c = xb_ld(&bar[XB_XCNT(j)]);
        if (c > 0u) { if (j < x) ++virt; ++nx; }
        if (j == x) nloc = (int)c;
    }
    SliceMap m;
    m.virt = __builtin_amdgcn_readfirstlane(virt); m.nx = __builtin_amdgcn_readfirstlane(nx > 0 ? nx : 1); m.nloc = __builtin_amdgcn_readfirstlane(nloc > 0 ? nloc : 1);
    m.rank = __builtin_amdgcn_readfirstlane((int)((volatile LAS unsigned*)(smem + SM_CTRL))[2]);
    return m;
}

typedef _Float16 half2_t __attribute__((ext_vector_type(2)));
DEV void phase_peer_u(const Params& p, int layer, char* smem, int rep = 0) {
    const int tid = ltid(), lane = tid & 63, w = tid >> 6, l8 = lane & 7, grp = lane >> 3;
    char* ws = p.ws;
    const SliceMap sm = slice_map(p, smem);
    const bf16_t* h = (const bf16_t*)(ws + OFF_H);
    const int* eid = (const int*)(ws + OFF_EID);
    _Float16* part = (_Float16*)(ws + OFF_S1) + (rep ? (size_t)8 * kT * 128 : 0);
    int* ids_l = (int*)(smem + w * 9216);
    const int nk = sm.rank < 512 ? (512 - sm.rank + sm.nloc - 1) / sm.nloc : 0;
    for (int s = sm.virt; s < 8; s += sm.nx) {
        if (nk == 0) break;
        const unsigned char* U = (const unsigned char*)(ws + OFF_PU) + (((size_t)layer * 8 + s) * 16384 << 7) + l8 * 16;
        uint4 ri0, ri1, ri2, ri3, rh0, rh1;
        auto load_oct = [&](int k) __attribute__((always_inline)) {
            const size_t o = (size_t)(sm.rank + k * sm.nloc) * 4 + w;
            const uint4* ip = (const uint4*)(eid + o * 1024) + lane;
            ri0 = ip[0]; ri1 = ip[64]; ri2 = ip[128]; ri3 = ip[192];
            const bf16_t* hp = h + (o * 8 + grp) * 1024 + s * 128 + l8 * 16;
            rh0 = *(const uint4*)hp; rh1 = *(const uint4*)(hp + 8);
        };
        half2_t hh[8];
        auto store_oct = [&]() __attribute__((always_inline)) {
            uint4* il = (uint4*)ids_l + lane;
            il[0] = ri0; il[64] = ri1; il[128] = ri2; il[192] = ri3;
            const unsigned hu[8] = {rh0.x, rh0.y, rh0.z, rh0.w, rh1.x, rh1.y, rh1.z, rh1.w};
#pragma unroll
            for (int i = 0; i < 8; ++i) hh[i] = (half2_t){(_Float16)lo16(hu[i]), (_Float16)hi16(hu[i])};
        };
        load_oct(0); store_oct();
#pragma unroll 1
        for (int k = 0; k < nk; ++k) {
            if (k + 1 < nk) load_oct(k + 1);
            const size_t o = (size_t)(sm.rank + k * sm.nloc) * 4 + w;
            _Float16* pp = part + ((size_t)s * kT + o * 8 + grp) * 128 + l8;
            uint4 va[8], vb[8];
            auto issue = [&](uint4 (&v)[8], int c) __attribute__((always_inline)) {
                const int4 i0 = *(const int4*)(ids_l + grp * 128 + c * 8), i1 = *(const int4*)(ids_l + grp * 128 + c * 8 + 4);
                const int e[8] = {i0.x, i0.y, i0.z, i0.w, i1.x, i1.y, i1.z, i1.w};
#pragma unroll
                for (int j = 0; j < 8; ++j) v[j] = *(const uint4*)(U + ((size_t)e[j] << 7));
            };
            auto compute = [&](const uint4 (&v)[8], int c) __attribute__((always_inline)) {
                float res = 0.f;
#pragma unroll
                for (int j = 0; j < 8; ++j) {
                    const unsigned d[4] = {v[j].x, v[j].y, v[j].z, v[j].w};
                    float acc = 0.f;
#pragma unroll
                    for (int q = 0; q < 4; ++q) {
                        const half2_t lo = __builtin_amdgcn_cvt_scalef32_pk_f16_fp8(d[q], 1.0f, false);
                        const half2_t hi = __builtin_amdgcn_cvt_scalef32_pk_f16_fp8(d[q], 1.0f, true);
                        acc = __builtin_amdgcn_fdot2(lo, hh[2 * q], acc, false);
                        acc = __builtin_amdgcn_fdot2(hi, hh[2 * q + 1], acc, false);
                    }
                    acc += __int_as_float(__builtin_amdgcn_update_dpp(0, __float_as_int(acc), 0xB1, 0xF, 0xF, true));
                    acc += __int_as_float(__builtin_amdgcn_update_dpp(0, __float_as_int(acc), 0x4E, 0xF, 0xF, true));
                    acc += __int_as_float(__builtin_amdgcn_update_dpp(0, __float_as_int(acc), 0x141, 0xF, 0xF, true));
                    res = (l8 == j) ? acc : res;
                    __builtin_amdgcn_sched_barrier(0);
                }
                pp[c * 8] = (_Float16)res;
            };
            issue(va, 0);
#pragma unroll
            for (int c = 0; c < 16; c += 2) {
                issue(vb, c + 1);
                __builtin_amdgcn_sched_barrier(0);
                compute(va, c);
                __builtin_amdgcn_sched_barrier(0);
                if (c + 2 < 16) issue(va, c + 2);
                __builtin_amdgcn_sched_barrier(0);
                compute(vb, c + 1);
                __builtin_amdgcn_sched_barrier(0);
            }
            if (k + 1 < nk) store_oct();
        }
    }
}

DEV void phase_peer_comb(const Params& p, int rep = 0) {
    const int tid = ltid();
    const _Float16* part = (const _Float16*)(p.ws + OFF_S1);
    float* gate = (float*)(p.ws + OFF_GATE);
    for (size_t i = (size_t)blockIdx.x * 256 + tid; i < (size_t)kT * 128 / 8; i += (size_t)gridDim.x * 256) {
        float a[8];
#pragma unroll
        for (int j = 0; j < 8; ++j) a[j] = 0.f;
#pragma unroll
        for (int x = 0; x < 8; ++x) {
            const uint4 u = *(const uint4*)(part + (size_t)x * kT * 128 + i * 8);
            const unsigned d[4] = {u.x, u.y, u.z, u.w};
#pragma unroll
            for (int j = 0; j < 4; ++j) { const half2_t hv = __builtin_bit_cast(half2_t, d[j]); a[2 * j] += (float)hv.x; a[2 * j + 1] += (float)hv.y; }
        }
        const float4 g0 = *(const float4*)(gate + i * 8), g1 = *(const float4*)(gate + i * 8 + 4);
        float4 o0, o1;
        o0.x = g0.x * gelu_tanh(a[0] * (1.f / kScaleU)); o0.y = g0.y * gelu_tanh(a[1] * (1.f / kScaleU));
        o0.z = g0.z * gelu_tanh(a[2] * (1.f / kScaleU)); o0.w = g0.w * gelu_tanh(a[3] * (1.f / kScaleU));
        o1.x = g1.x * gelu_tanh(a[4] * (1.f / kScaleU)); o1.y = g1.y * gelu_tanh(a[5] * (1.f / kScaleU));
        o1.z = g1.z * gelu_tanh(a[6] * (1.f / kScaleU)); o1.w = g1.w * gelu_tanh(a[7] * (1.f / kScaleU));
        if (rep == 0) { *(float4*)(gate + i * 8) = o0; *(float4*)(gate + i * 8 + 4) = o1; }
    }
}

DEV void phase_peer_v(const Params& p, int layer, char* smem, int rep = 0) {
    const int tid = ltid(), lane = tid & 63, w = tid >> 6, l8 = lane & 7, grp = lane >> 3;
    char* ws = p.ws;
    const SliceMap sm = slice_map(p, smem);
    bf16_t* xres = (bf16_t*)(ws + OFF_XRES);
    const int* eid = (const int*)(ws + OFF_EID);
    const float* wbuf = (const float*)(ws + OFF_GATE);
    const float* mod = (const float*)(ws + OFF_MOD);
    int* ids_l = (int*)(smem + w * 9216);
    float* w_l = (float*)(smem + w * 9216 + 4096);
    const int nk = sm.rank < 512 ? (512 - sm.rank + sm.nloc - 1) / sm.nloc : 0;
    for (int s = sm.virt; s < 8; s += sm.nx) {
        if (nk == 0) break;
        const unsigned char* V = (const unsigned char*)(ws + OFF_PV) + (((size_t)layer * 8 + s) * 16384 << 7) + l8 * 16;
        uint4 ri0, ri1, ri2, ri3, rw0, rw1, rw2, rw3;
        auto load_oct = [&](int k) __attribute__((always_inline)) {
            const size_t o = (size_t)(sm.rank + k * sm.nloc) * 4 + w;
            const uint4* ip = (const uint4*)(eid + o * 1024) + lane;
            const uint4* wp = (const uint4*)(wbuf + o * 1024) + lane;
            ri0 = ip[0]; ri1 = ip[64]; ri2 = ip[128]; ri3 = ip[192];
            rw0 = wp[0]; rw1 = wp[64]; rw2 = wp[128]; rw3 = wp[192];
        };
        auto store_oct = [&]() __attribute__((always_inline)) {
            uint4* il = (uint4*)ids_l + lane; uint4* wl = (uint4*)w_l + lane;
            il[0] = ri0; il[64] = ri1; il[128] = ri2; il[192] = ri3;
            wl[0] = rw0; wl[64] = rw1; wl[128] = rw2; wl[192] = rw3;
        };
        load_oct(0); store_oct();
#pragma unroll 1
        for (int k = 0; k < nk; ++k) {
            if (k + 1 < nk) load_oct(k + 1);
            const size_t o = (size_t)(sm.rank + k * sm.nloc) * 4 + w;
            const size_t t = o * 8 + grp;
            const int b = (int)(t >> 11);
            bf16_t* xp = xres + t * 1024 + s * 128 + l8 * 16;
            const float* g2 = mod + (size_t)(layer * 8 + b) * 6144 + 5120 + s * 128 + l8 * 16;
            float4 xa[4];
            { const uint4 u0 = *(const uint4*)xp, u1 = *(const uint4*)(xp + 8);
              xa[0] = make_float4(lo16(u0.x), hi16(u0.x), lo16(u0.y), hi16(u0.y)); xa[1] = make_float4(lo16(u0.z), hi16(u0.z), lo16(u0.w), hi16(u0.w));
              xa[2] = make_float4(lo16(u1.x), hi16(u1.x), lo16(u1.y), hi16(u1.y)); xa[3] = make_float4(lo16(u1.z), hi16(u1.z), lo16(u1.w), hi16(u1.w)); }
            half2_t out[8];
#pragma unroll
            for (int j = 0; j < 8; ++j) out[j] = (half2_t){(_Float16)0.f, (_Float16)0.f};
            uint4 va[8], vb[8];
            auto issue = [&](uint4 (&v)[8], int c) __attribute__((always_inline)) {
                const int4 i0 = *(const int4*)(ids_l + grp * 128 + c * 8), i1 = *(const int4*)(ids_l + grp * 128 + c * 8 + 4);
                const int e[8] = {i0.x, i0.y, i0.z, i0.w, i1.x, i1.y, i1.z, i1.w};
#pragma unroll
                for (int j = 0; j < 8; ++j) v[j] = *(const uint4*)(V + ((size_t)e[j] << 7));
            };
            auto compute = [&](const uint4 (&v)[8], int c) __attribute__((always_inline)) {
                const float4 w0 = *(const float4*)(w_l + grp * 128 + c * 8), w1 = *(const float4*)(w_l + grp * 128 + c * 8 + 4);
                const float wf[8] = {w0.x, w0.y, w0.z, w0.w, w1.x, w1.y, w1.z, w1.w};
#pragma unroll
                for (int j = 0; j < 8; ++j) {
                    const _Float16 wh = (_Float16)wf[j];
                    const half2_t ww = {wh, wh};
                    const unsigned d[4] = {v[j].x, v[j].y, v[j].z, v[j].w};
#pragma unroll
                    for (int q = 0; q < 4; ++q) {
                        const half2_t lo = __builtin_amdgcn_cvt_scalef32_pk_f16_fp8(d[q], 1.0f, false);
                        const half2_t hi = __builtin_amdgcn_cvt_scalef32_pk_f16_fp8(d[q], 1.0f, true);
                        out[2 * q] = __builtin_elementwise_fma(ww, lo, out[2 * q]);
                        out[2 * q + 1] = __builtin_elementwise_fma(ww, hi, out[2 * q + 1]);
                    }
                    __builtin_amdgcn_sched_barrier(0);
                }
            };
            issue(va, 0);
#pragma unroll
            for (int c = 0; c < 16; c += 2) {
                issue(vb, c + 1);
                __builtin_amdgcn_sched_barrier(0);
                compute(va, c);
                __builtin_amdgcn_sched_barrier(0);
                if (c + 2 < 16) issue(va, c + 2);
                __builtin_amdgcn_sched_barrier(0);
                compute(vb, c + 1);
                __builtin_amdgcn_sched_barrier(0);
            }
            if (rep == 0 || (float)out[0].x == 12345.678f) {
#pragma unroll
                for (int c = 0; c < 4; ++c) {
                    const float4 g4 = *(const float4*)(g2 + c * 4);
                    xa[c].x += g4.x * (float)out[2 * c].x * (1.f / kScaleV); xa[c].y += g4.y * (float)out[2 * c].y * (1.f / kScaleV);
                    xa[c].z += g4.z * (float)out[2 * c + 1].x * (1.f / kScaleV); xa[c].w += g4.w * (float)out[2 * c + 1].y * (1.f / kScaleV);
                }
                *(uint4*)xp = make_uint4(pack2(xa[0].x, xa[0].y), pack2(xa[0].z, xa[0].w), pack2(xa[1].x, xa[1].y), pack2(xa[1].z, xa[1].w));
                *(uint4*)(xp + 8) = make_uint4(pack2(xa[2].x, xa[2].y), pack2(xa[2].z, xa[2].w), pack2(xa[3].x, xa[3].y), pack2(xa[3].z, xa[3].w));
            }
            if (k + 1 < nk) store_oct();
        }
    }
}

DEV void phase_final(const Params& p) {
    const int tid = ltid(), lane = tid & 63, w = tid >> 6;
    const bf16_t* xs = (const bf16_t*)(p.ws + OFF_XRES);
    float4 g4[4];
#pragma unroll
    for (int i = 0; i < 4; ++i) g4[i] = *(const float4*)(p.final_g + i * 256 + lane * 4);
    for (int q0 = blockIdx.x; q0 < kT / 4; q0 += gridDim.x * 4) {
        float4 v[4][4];
#pragma unroll
        for (int u = 0; u < 4; ++u) {
            const int q = q0 + u * gridDim.x < kT / 4 ? q0 + u * gridDim.x : q0;
            const bf16_t* xr = xs + (size_t)(q * 4 + w) * 1024;
#pragma unroll
            for (int i = 0; i < 4; ++i) { const uint2 uu = *(const uint2*)(xr + i * 256 + lane * 4); v[u][i] = make_float4(lo16(uu.x), hi16(uu.x), lo16(uu.y), hi16(uu.y)); }
        }
#pragma unroll
        for (int u = 0; u < 4; ++u) {
            const int q = q0 + u * gridDim.x;
            if (q >= kT / 4) break;
            const int t = q * 4 + w;
            float ss = 0.f;
#pragma unroll
            for (int i = 0; i < 4; ++i) ss += v[u][i].x * v[u][i].x + v[u][i].y * v[u][i].y + v[u][i].z * v[u][i].z + v[u][i].w * v[u][i].w;
            ss = wave_sum(ss);
            const float rstd = rsqrtf(ss * (1.f / 1024.f) + kEps);
#pragma unroll
            for (int i = 0; i < 4; ++i) {
                const int col = i * 256 + lane * 4;
                *(float4*)(p.out + (size_t)t * 1024 + col) = make_float4(v[u][i].x * rstd * g4[i].x, v[u][i].y * rstd * g4[i].y, v[u][i].z * rstd * g4[i].z, v[u][i].w * rstd * g4[i].w);
            }
        }
    }
}

DEV uint4 pack8f(const float (&e)[8]) { return make_uint4(pack2(e[0], e[1]), pack2(e[2], e[3]), pack2(e[4], e[5]), pack2(e[6], e[7])); }
DEV float4 rope4(float4 v, float4 o, bool low, float4 c, float4 sn) {
    float4 r;
    r.x = v.x * c.x + (low ? -o.x : o.x) * sn.x; r.y = v.y * c.y + (low ? -o.y : o.y) * sn.y;
    r.z = v.z * c.z + (low ? -o.z : o.z) * sn.z; r.w = v.w * c.w + (low ? -o.w : o.w) * sn.w;
    return r;
}
struct EpiIn {
    char* ws;
    DEV void tile(int m0, int n0, const float* Cs, int tid) const {
        const int lane = tid & 63, w = tid >> 6, g16 = lane >> 4, c4 = lane & 15;
        bf16_t* cols = (bf16_t*)(ws + OFF_COLS);
        bf16_t* VT = (bf16_t*)(ws + OFF_VT);
        const float* rope = (const float*)(ws + OFF_ROPE);
        const float *cos64 = rope, *sin64 = rope + 2048 * 32, *cos32 = rope + 2048 * 64, *sin32 = rope + 2048 * 64 + 2048 * 16;
        const int b = m0 >> 11, s0 = m0 & 2047;
#pragma unroll 1
        for (int h = 0; h < 2; ++h) {
            const int cb = n0 + 64 * h;
            int vh = -1;
            if (cb == 448) vh = 0; else if (cb == 576) vh = 1; else if (cb >= 1216 && cb < 1472) vh = 2 + ((cb - 1216) >> 6); else if (cb >= 2304) vh = 6 + ((cb - 2304) >> 6);
            if (vh >= 0) {
                bf16_t* dst = VT + ((size_t)(b * 12 + vh) * 64 + lane) * 2048 + s0;
#pragma unroll
                for (int q = 0; q < 4; ++q) {
                    const int tc = w + 4 * q;
                    float e[8];
#pragma unroll
                    for (int j = 0; j < 8; ++j) e[j] = Cs[(tc * 8 + j) * 128 + h * 64 + lane];
                    *(uint4*)(dst + tc * 8) = pack8f(e);
                }
                continue;
            }
            const bool r64 = cb < 320 || cb == 384 || cb == 512 || (cb >= 1920 && cb < 2304);
            const bool r32 = (cb >= 704 && cb < 1216) || cb == 1856;
            bf16_t* dbase; int dld;
            if (cb == 256) { dbase = (bf16_t*)(ws + OFF_KC); dld = 64; } else if (cb == 320) { dbase = (bf16_t*)(ws + OFF_VC); dld = 64; } else { dbase = cols + cb; dld = LDC; }
            float4 cc[8], sn[8];
            if (r64 || r32) {
                const int i = (c4 * 4) & (r64 ? 31 : 15);
#pragma unroll
                for (int it = 0; it < 8; ++it) {
                    const int sq = s0 + it * 16 + w * 4 + g16;
                    cc[it] = *(const float4*)((r64 ? cos64 + sq * 32 : cos32 + sq * 16) + i);
                    sn[it] = *(const float4*)((r64 ? sin64 + sq * 32 : sin32 + sq * 16) + i);
                }
            }
#pragma unroll
            for (int it = 0; it < 8; ++it) {
                const int r = it * 16 + w * 4 + g16;
                float4 v = *(const float4*)(Cs + r * 128 + h * 64 + c4 * 4);
                if (r64 || r32) {
                    const float4 o = *(const float4*)(Cs + r * 128 + h * 64 + ((c4 * 4) ^ (r64 ? 32 : 16)));
                    v = rope4(v, o, !(c4 & (r64 ? 8 : 4)), cc[it], sn[it]);
                }
                *(uint2*)(dbase + (size_t)(m0 + r) * dld + c4 * 4) = make_uint2(pack2(v.x, v.y), pack2(v.z, v.w));
            }
        }
    }
};
DEV void mla_rstd_tile(const bf16_t* src  , int ncols, float* rsl, int tid) {
    const int lane = tid & 63, w = tid >> 6, g16 = lane >> 4, c4 = lane & 15;
#pragma unroll 2
    for (int it = 0; it < 8; ++it) {
        const int r = it * 16 + w * 4 + g16;
        const bf16_t* rp = src + (size_t)r * LDC + c4 * (ncols >> 4);
        float ss = 0.f;
        const uint4 u = *(const uint4*)rp;
        ss += lo16(u.x) * lo16(u.x) + hi16(u.x) * hi16(u.x) + lo16(u.y) * lo16(u.y) + hi16(u.y) * hi16(u.y)
            + lo16(u.z) * lo16(u.z) + hi16(u.z) * hi16(u.z) + lo16(u.w) * lo16(u.w) + hi16(u.w) * hi16(u.w);
        if (ncols == 256) {
            const uint4 u2 = *(const uint4*)(rp + 8);
            ss += lo16(u2.x) * lo16(u2.x) + hi16(u2.x) * hi16(u2.x) + lo16(u2.y) * lo16(u2.y) + hi16(u2.y) * hi16(u2.y)
                + lo16(u2.z) * lo16(u2.z) + hi16(u2.z) * hi16(u2.z) + lo16(u2.w) * lo16(u2.w) + hi16(u2.w) * hi16(u2.w);
        }
        ss = row_sum_dpp(ss);
        if (c4 == 0) rsl[r] = rsqrtf(ss / (float)ncols + kEps);
    }
}
struct EpiMlaQ {
    char* ws; const float* rsl;
    DEV void tile(int m0, int n0, const float* Cs, int tid) const {
        const int lane = tid & 63, w = tid >> 6, g16 = lane >> 4, c4 = lane & 15;
        bf16_t* qmla = (bf16_t*)(ws + OFF_QMLA);
        const float* rope = (const float*)(ws + OFF_ROPE);
        const float *cos32 = rope + 2048 * 64, *sin32 = rope + 2048 * 64 + 2048 * 16;
        const int s0 = m0 & 2047;
#pragma unroll 1
        for (int h = 0; h < 2; ++h) {
            const int col = n0 + 64 * h + c4 * 4;
            const bool isrope = ((col >> 5) % 3) == 2;
            float4 cc[8], sn[8];
#pragma unroll
            for (int it = 0; it < 8; ++it) {
                const int sq = s0 + it * 16 + w * 4 + g16, i = (c4 * 4) & 15;
                cc[it] = *(const float4*)(cos32 + sq * 16 + i); sn[it] = *(const float4*)(sin32 + sq * 16 + i);
            }
#pragma unroll
            for (int it = 0; it < 8; ++it) {
                const int r = it * 16 + w * 4 + g16;
                float4 v = *(const float4*)(Cs + r * 128 + h * 64 + c4 * 4);
                const float sc = rsl[r];
                v.x *= sc; v.y *= sc; v.z *= sc; v.w *= sc;
                float4 o = *(const float4*)(Cs + r * 128 + h * 64 + ((c4 * 4) ^ 16));
                o.x *= sc; o.y *= sc; o.z *= sc; o.w *= sc;
                const float4 vr = rope4(v, o, !(c4 & 4), cc[it], sn[it]);
                if (isrope) v = vr;
                *(uint2*)(qmla + (size_t)(m0 + r) * 384 + col) = make_uint2(pack2(v.x, v.y), pack2(v.z, v.w));
            }
        }
    }
};
struct EpiMlaKV {
    char* ws; const float* rsl;
    DEV void tile(int m0, int n0, const float* Cs, int tid) const {
        const int lane = tid & 63, w = tid >> 6, g16 = lane >> 4, c4 = lane & 15;
        bf16_t* kvmla = (bf16_t*)(ws + OFF_KVMLA);
        bf16_t* VT = (bf16_t*)(ws + OFF_VT);
        const int b = m0 >> 11, s0 = m0 & 2047, hd = n0 >> 7;
#pragma unroll 2
        for (int it = 0; it < 8; ++it) {
            const int r = it * 16 + w * 4 + g16;
            float4 v = *(const float4*)(Cs + r * 128 + c4 * 4);
            const float sc = rsl[r];
            *(uint2*)(kvmla + (size_t)(m0 + r) * 512 + n0 + c4 * 4) = make_uint2(pack2(v.x * sc, v.y * sc), pack2(v.z * sc, v.w * sc));
        }
        bf16_t* dst = VT + ((size_t)(b * 12 + 8 + hd) * 64 + lane) * 2048 + s0;
#pragma unroll
        for (int q = 0; q < 4; ++q) {
            const int tc = w + 4 * q;
            float e[8];
#pragma unroll
            for (int j = 0; j < 8; ++j) e[j] = Cs[(tc * 8 + j) * 128 + 64 + lane] * rsl[tc * 8 + j];
            *(uint4*)(dst + tc * 8) = pack8f(e);
        }
    }
};

DEV void phase_gemm_in(const Params& p, int layer, char* smem) {
    char* ws = p.ws;
    EpiIn epi{ws};
    gemm_phase((const bf16_t*)(ws + OFF_H), 1024, (const bf16_t*)(ws + OFF_WIN) + (size_t)layer * 2432 * 1024, 1024, 1024, kT / 128, LDC / 128, smem, epi);
}
DEV void phase_gemm_mid(const Params& p, int layer, char* smem) {
    char* ws = p.ws;
    const float* misc = (const float*)(ws + OFF_MISC);
    const bf16_t* cols = (const bf16_t*)(ws + OFF_COLS);
    float* rsl = (float*)(smem + SM_CTRL + 256);
    const int nb_up = (int)gridDim.x > 32 ? (int)gridDim.x - 16 : (int)gridDim.x;
    for (int tile = ((int)gridDim.x > 32 && blockIdx.x >= 16) ? (int)blockIdx.x : (int)blockIdx.x; tile < 16 + 384 + 512;
         tile = (tile < 16 && (int)gridDim.x > 32) ? 16 + 384 + 512 : tile + nb_up) {
        if (tile < 16) {
            const int kv = tile >> 3, mt = tile & 7;
            EpiF32 epi{(float*)(ws + OFF_QP) + (size_t)kv * 1024 * 128, 128};
            gemm_tile((const bf16_t*)(ws + (kv ? OFF_VC : OFF_KC)), 1024, (const bf16_t*)(ws + (kv ? OFF_WCV : OFF_WCK)) + (size_t)layer * 128 * 2048, 1024, 1024, mt * 128, 0, smem, epi);
        } else if (tile < 16 + 384) {
            const int tt = tile - 16, m0 = (tt / 3) * 128;
            __syncthreads();
            mla_rstd_tile(cols + (size_t)m0 * LDC + 1472, 256, rsl, ltid());
            EpiMlaQ epi{ws, rsl};
            gemm_tile(cols + 1472, LDC, (const bf16_t*)(ws + OFF_WUQ) + (size_t)layer * 384 * 256, 256, 256, m0, (tt % 3) * 128, smem, epi);
        } else {
            const int tt = tile - 16 - 384, m0 = (tt / 4) * 128;
            __syncthreads();
            mla_rstd_tile(cols + (size_t)m0 * LDC + 1728, 128, rsl, ltid());
            EpiMlaKV epi{ws, rsl};
            gemm_tile(cols + 1728, LDC, (const bf16_t*)(ws + OFF_WUKV) + (size_t)layer * 512 * 128, 128, 128, m0, (tt % 4) * 128, smem, epi);
        }
    }
}
DEV void phase_gemm_out(const Params& p, int layer, char* smem) {
    char* ws = p.ws;
    EpiRes epi{layer == 0 ? (const void*)p.x : (const void*)(ws + OFF_XRES), layer != 0, (bf16_t*)(ws + OFF_XRES), (const float*)(ws + OFF_MOD) + (size_t)layer * 8 * 6144 + 2048};
    gemm_phase((const bf16_t*)(ws + OFF_O), 1024, (const bf16_t*)(ws + OFF_WOUT) + (size_t)layer * 1024 * 1024, 1024, 1024, kT / 128, 8, smem, epi);
}
DEV void phase_gemm_wq(const Params& p, int layer, char* smem) {
    char* ws = p.ws;
    EpiBf16 epi{(bf16_t*)(ws + OFF_QP), 2048, nullptr, nullptr, 2048};
    gemm_phase((const bf16_t*)(ws + OFF_H), 1024, (const bf16_t*)(ws + OFF_WQ) + (size_t)layer * 2048 * 1024, 1024, 1024, kT / 128, 16, smem, epi);
}
DEV void phase_scores(const Params& p, int layer, char* smem) {
    char* ws = p.ws;
    for (int tile = blockIdx.x; tile < 2048; tile += gridDim.x) {
        const int c = tile >> 10, nt = tile & 1023;
        EpiF32 epi{(float*)(ws + (c ? OFF_S2 : OFF_S1)), kT * 8};
        gemm_tile((const bf16_t*)(ws + OFF_SUBK) + (size_t)(layer * 2 + c) * 16384, 128, (const bf16_t*)(ws + OFF_QP) + c * 128, 256, 128, 0, nt * 128, smem, epi);
    }
}

constexpr int NPHASE = 16;
DEV void run_phase(const Params& p, int ph, int layer, char* smem, int rep = 0) {
    switch (ph) {
        case 0: phase_prologue(p, smem); break;
        case 1: phase_norm(p, layer, 0); break;
        case 2: phase_gemm_in(p, layer, smem); break;
        case 3: phase_layout1(p, smem); break;
        case 4: phase_gemm_mid(p, layer, smem); break;
        case 5: phase_layout2(p, layer, smem); break;
        case 6: phase_attn(p, layer, smem, rep); break;
        case 7: phase_gemm_out(p, layer, smem); break;
        case 8: phase_norm(p, layer, 1); break;
        case 9: phase_gemm_wq(p, layer, smem); break;
        case 10: phase_route(p, layer, smem); break;
        case 11: phase_topk(p, smem); break;
        case 12: phase_peer_u(p, layer, smem, rep); break;
        case 13: phase_peer_comb(p, rep); break;
        case 14: phase_peer_v(p, layer, smem, rep); break;
        case 15: if (layer == 0) phase_norm(p, 1, 0); else phase_final(p); break;
        default: break;
    }
}

#if !FUSED
template <int PH>
__global__ void __launch_bounds__(256, 2) k_phase(Params p, int layer) {
    __shared__ __attribute__((aligned(16))) char smem[SM_TOTAL];
    run_phase(p, PH, layer, smem);
}
template <int PH> static void launch_phase(const Params& p, int layer, hipStream_t stream) { k_phase<PH><<<512, 256, 0, stream>>>(p, layer); }
static void launch_ph(int ph, const Params& p, int layer, hipStream_t stream) {
    switch (ph) {
        case 0: launch_phase<0>(p, layer, stream); break;
        case 1: launch_phase<1>(p, layer, stream); break;
        case 2: launch_phase<2>(p, layer, stream); break;
        case 3: launch_phase<3>(p, layer, stream); break;
        case 4: launch_phase<4>(p, layer, stream); break;
        case 5: launch_phase<5>(p, layer, stream); break;
        case 6: launch_phase<6>(p, layer, stream); break;
        case 7: launch_phase<7>(p, layer, stream); break;
        case 8: launch_phase<8>(p, layer, stream); break;
        case 9: launch_phase<9>(p, layer, stream); break;
        case 10: launch_phase<10>(p, layer, stream); break;
        case 11: launch_phase<11>(p, layer, stream); break;
        case 12: launch_phase<12>(p, layer, stream); break;
    }
}
#else
#if TS_A >= 0
#define TSTAMP(I) if (blockIdx.x == 0 && threadIdx.x == 0) ((unsigned long long*)(p.ws + 32768))[I] = __builtin_amdgcn_s_memrealtime();
#else
#define TSTAMP(I)
#endif
__global__ void __launch_bounds__(256, 2) k_mega(Params p) {
    extern __shared__ __attribute__((aligned(1024))) char smem[];
    cg::grid_group grid = cg::this_grid();
    volatile LAS unsigned* st = (volatile LAS unsigned*)(smem + SM_CTRL);
    if (threadIdx.x == 0) { st[0] = 0u; st[1] = 0u; st[2] = 0u; }
    __syncthreads();
    const XcdBarrier xb = xcd_barrier_post((unsigned*)p.ws, st);
    TSTAMP(0)
    run_phase(p, 0, 0, smem);
    if (p.out == nullptr) grid.sync();
    xcd_barrier(xb);
    TSTAMP(1)
    run_phase(p, 1, 0, smem);
    xcd_barrier(xb);
    TSTAMP(2)
#define STEP(PH, L) { run_phase(p, PH, L, smem, 0); xcd_barrier(xb); TSTAMP(2 + (L) * 16 + (PH)) }
#define LAYER(L) STEP(2, L) STEP(4, L) STEP(6, L) STEP(7, L) STEP(8, L) STEP(9, L) STEP(10, L) STEP(12, L) STEP(13, L) STEP(14, L)
    LAYER(0)
    STEP(15, 0)
    LAYER(1)
    run_phase(p, 15, 1, smem);
#if TS_A >= 0
    TSTAMP(2 + 16 + 15)
    __syncthreads();
    if (blockIdx.x == 0 && threadIdx.x == 0) {
        const unsigned long long* ts = (const unsigned long long*)(p.ws + 32768);
        p.out[0] += (TS_A == 50) ? (float)ts[TS_B] * (0.01f / 512.f / 10.f) : (float)(ts[TS_B] - ts[TS_A]) * 0.001f;
    }
#endif
}
#endif

extern "C" void kernel_launch(void* const* d_in, const int* in_sizes, int n_in, void* d_out, int out_size, void* d_ws, size_t ws_size, hipStream_t stream) {
    Params p{};
    const float** pp = (const float**)&p;
    for (int i = 0; i < 28; ++i) pp[i] = (const float*)d_in[i];
    p.out = (float*)d_out;
    p.ws = (char*)d_ws;
    if (ws_size < OFF_END) fprintf(stderr, "workspace too small: %zu < %zu\n", ws_size, (size_t)OFF_END);
    (void)hipMemsetAsync(d_ws, 0, 65536, stream);
#if !FUSED
    launch_ph(0, p, 0, stream);
    launch_ph(1, p, 0, stream);
    for (int l = 0; l < 2; ++l)
        for (int ph = 2; ph < NPHASE; ++ph) launch_ph(ph, p, l, stream);
#else
    static int grid_blocks = 0;
    if (!grid_blocks) {
        int dev = 0, cus = 0, per_cu = 0;
        (void)hipGetDevice(&dev);
        (void)hipDeviceGetAttribute(&cus, hipDeviceAttributeMultiprocessorCount, dev);
        (void)hipFuncSetAttribute((const void*)k_mega, hipFuncAttributeMaxDynamicSharedMemorySize, SM_TOTAL);
        (void)hipOccupancyMaxActiveBlocksPerMultiprocessor(&per_cu, (const void*)k_mega, 256, SM_TOTAL);
        if (per_cu > 2) per_cu = 2;
        if (per_cu < 1) per_cu = 1;
        grid_blocks = cus * per_cu;
    }
    void* args[] = {&p};
    hipError_t e = hipLaunchCooperativeKernel((const void*)k_mega, dim3(grid_blocks), dim3(256), args, SM_TOTAL, stream);
    if (e != hipSuccess) fprintf(stderr, "cooperative launch failed: %s (grid %d)\n", hipGetErrorString(e), grid_blocks);
#endif
}
```

```cpp
#include <hip/hip_runtime.h>
#include <hip/hip_cooperative_groups.h>
#include <stdint.h>
#include <stdio.h>
namespace cg = cooperative_groups;

#ifndef FUSED
#define FUSED 1
#endif
#ifndef TS_A
#define TS_A -1
#define TS_B -1
#endif
#ifndef PROBE_PH
#define PROBE_PH -1
#define PROBE_L 1
#define PROBE_REP 0
#endif

#define DEV __device__ __forceinline__
#define LAS __attribute__((address_space(3)))
typedef unsigned short bf16_t;
typedef short bf16x8 __attribute__((ext_vector_type(8)));
typedef float f32x16 __attribute__((ext_vector_type(16)));

constexpr int kB = 8, kS = 2048, kT = kB * kS, kD = 1024, LDC = 2432;
constexpr float kEps = 1e-6f;
constexpr float kNeg = -1e30f;
constexpr float kLog2e = 1.4426950408889634f;
constexpr float kScaleU = 256.f, kScaleV = 32.f;

constexpr size_t OFF_CTRL = 0;
constexpr size_t OFF_MOD  = 65536;
constexpr size_t OFF_ROPE = OFF_MOD + 2ull * 8 * 6144 * 4;
constexpr size_t OFF_MISC = OFF_ROPE + 2048ull * 96 * 4;
constexpr size_t OFF_WIN  = OFF_MISC + 4096;
constexpr size_t OFF_WOUT = OFF_WIN + 2ull * 2432 * 1024 * 2;
constexpr size_t OFF_WQ   = OFF_WOUT + 2ull * 1024 * 1024 * 2;
constexpr size_t OFF_WUQ  = OFF_WQ + 2ull * 2048 * 1024 * 2;
constexpr size_t OFF_WUKV = OFF_WUQ + 2ull * 384 * 256 * 2;
constexpr size_t OFF_WCK  = OFF_WUKV + 2ull * 512 * 128 * 2;
constexpr size_t OFF_WCV  = OFF_WCK + 2ull * 128 * 2048 * 2;
constexpr size_t OFF_SUBK = OFF_WCV + 2ull * 128 * 2048 * 2;
constexpr size_t OFF_PU   = OFF_SUBK + 2ull * 2 * 128 * 128 * 2;
constexpr size_t OFF_PV   = OFF_PU + 2ull * 16384 * 1024;
constexpr size_t OFF_XRES = OFF_PV + 2ull * 16384 * 1024;
constexpr size_t OFF_H    = OFF_XRES + (size_t)kT * 1024 * 4;
constexpr size_t OFF_H8   = OFF_H + (size_t)kT * 1024 * 2;
constexpr size_t OFF_RSTD = OFF_H8 + (size_t)kT * 1024;
constexpr size_t OFF_KCMP = OFF_RSTD + 2ull * kT * 4;
constexpr size_t OFF_EID  = OFF_KCMP + 2ull * 1024 * 64 * 2;
constexpr size_t OFF_GATE = OFF_EID + (size_t)kT * 128 * 4;
constexpr size_t OFF_QP   = OFF_GATE + (size_t)kT * 128 * 4;
constexpr size_t OFF_COLS = OFF_QP + (size_t)kT * 2048 * 2;
constexpr size_t OFF_KC   = OFF_COLS + (size_t)kT * LDC * 2;
constexpr size_t OFF_VC   = OFF_KC + (size_t)(kT + 64) * 64 * 2;
constexpr size_t OFF_VT   = OFF_VC + (size_t)(kT + 64) * 64 * 2;
constexpr size_t OFF_QMLA = OFF_VT + 8ull * 12 * 64 * 2048 * 2;
constexpr size_t OFF_KVMLA = OFF_QMLA + (size_t)kT * 384 * 2;
constexpr size_t OFF_O    = OFF_KVMLA + (size_t)kT * 512 * 2;
constexpr size_t OFF_END  = OFF_O + (size_t)kT * 1024 * 2;
constexpr size_t OFF_S1 = OFF_COLS, OFF_S2 = OFF_COLS + (size_t)kT * 8 * 128 * 4;
static_assert(OFF_S2 + (size_t)kT * 8 * 128 * 4 <= OFF_O, "alias region too small");
static_assert(OFF_END <= (512ull << 20), "workspace too large");

struct Params {
    const float *x, *c, *ada_w, *ada_b, *norm_mix_g, *norm_ffn_g, *w_in, *pos_k, *pos_v, *cmp_wk, *cmp_wv;
    const float *lq1, *lk1, *lq2, *lk2, *sub_g, *mla_qg, *mla_wuq, *mla_kvg, *mla_wukv, *sinks, *w_out;
    const float *w_q, *subk1, *subk2, *pu, *pv, *final_g;
    float* out;
    char* ws;
};

DEV int ltid() { int t = threadIdx.x; asm volatile("" : "+v"(t)); return t; }
DEV float bf2f(bf16_t v) { return __uint_as_float(((unsigned)v) << 16); }
DEV bf16_t f2bf(float f) { unsigned u = __float_as_uint(f); u += 0x7fffu + ((u >> 16) & 1u); return (bf16_t)(u >> 16); }
DEV unsigned pack2(float lo, float hi) { unsigned r; asm("v_cvt_pk_bf16_f32 %0, %1, %2" : "=v"(r) : "v"(lo), "v"(hi)); return r; }
DEV float lo16(unsigned u) { return __uint_as_float(u << 16); }
DEV float hi16(unsigned u) { return __uint_as_float(u & 0xffff0000u); }
DEV float wave_sum(float v) {
#pragma unroll
    for (int o = 32; o > 0; o >>= 1) v += __shfl_xor(v, o, 64);
    return v;
}
DEV float xor32f(float v, int lane) { return __int_as_float(__builtin_amdgcn_ds_bpermute((lane ^ 32) << 2, __float_as_int(v))); }
DEV float lanef(float v, int src) { return __int_as_float(__builtin_amdgcn_ds_bpermute(src << 2, __float_as_int(v))); }
DEV f32x16 mfma32(bf16x8 a, bf16x8 b, f32x16 c) { return __builtin_amdgcn_mfma_f32_32x32x16_bf16(a, b, c, 0, 0, 0); }
DEV f32x16 zero16() { f32x16 z;
#pragma unroll
    for (int i = 0; i < 16; ++i) z[i] = 0.f;
    return z; }
DEV float gelu_tanh(float x) {
    const float u = 0.7978845608028654f * (x + 0.044715f * x * x * x);
    const float e = __expf(2.f * u);
    const float t = 1.f - 2.f / (e + 1.f);
    return 0.5f * x * (1.f + t);
}

template <class Epi>
DEV void gemm_tile(const bf16_t* __restrict__ A, int lda, const bf16_t* __restrict__ Bt, int ldb, int K, int m0, int n0, char* smem, const Epi& epi) {
    const int tid = ltid(), lane = tid & 63, w = tid >> 6, wm = w >> 1, wn = w & 1, ql = lane & 31, hh = lane >> 5;
    f32x16 acc[2][2];
#pragma unroll
    for (int i = 0; i < 2; ++i)
#pragma unroll
        for (int j = 0; j < 2; ++j) acc[i][j] = zero16();
    const int srow = lane >> 3, spos = lane & 7;
    const int c0 = spos ^ ((srow >> 1) & 7), c1 = spos ^ ((4 + (srow >> 1)) & 7);
    const bf16_t* Ag0 = A + (size_t)(m0 + w * 32 + srow) * lda + c0 * 8;
    const bf16_t* Ag1 = A + (size_t)(m0 + w * 32 + 8 + srow) * lda + c1 * 8;
    const bf16_t* Bg0 = Bt + (size_t)(n0 + w * 32 + srow) * ldb + c0 * 8;
    const bf16_t* Bg1 = Bt + (size_t)(n0 + w * 32 + 8 + srow) * ldb + c1 * 8;
    const size_t a16 = (size_t)16 * lda, b16 = (size_t)16 * ldb;
    auto stage = [&](int kt, int buf) __attribute__((always_inline)) {
        char* sa = smem + buf * 32768 + w * 4096;
        char* sb = sa + 16384;
        const int ko = kt * 64;
        __builtin_amdgcn_global_load_lds((const unsigned*)(Ag0 + ko), (LAS unsigned*)(sa), 16, 0, 0);
        __builtin_amdgcn_global_load_lds((const unsigned*)(Ag1 + ko), (LAS unsigned*)(sa + 1024), 16, 0, 0);
        __builtin_amdgcn_global_load_lds((const unsigned*)(Ag0 + a16 + ko), (LAS unsigned*)(sa + 2048), 16, 0, 0);
        __builtin_amdgcn_global_load_lds((const unsigned*)(Ag1 + a16 + ko), (LAS unsigned*)(sa + 3072), 16, 0, 0);
        __builtin_amdgcn_global_load_lds((const unsigned*)(Bg0 + ko), (LAS unsigned*)(sb), 16, 0, 0);
        __builtin_amdgcn_global_load_lds((const unsigned*)(Bg1 + ko), (LAS unsigned*)(sb + 1024), 16, 0, 0);
        __builtin_amdgcn_global_load_lds((const unsigned*)(Bg0 + b16 + ko), (LAS unsigned*)(sb + 2048), 16, 0, 0);
        __builtin_amdgcn_global_load_lds((const unsigned*)(Bg1 + b16 + ko), (LAS unsigned*)(sb + 3072), 16, 0, 0);
    };
    const int key = (ql >> 1) & 7;
    const int arow = (wm * 64 + ql) * 128, brow = (wn * 64 + ql) * 128;
    const int nk = K >> 6;
    __syncthreads();
    stage(0, 0);
    for (int kt = 0; kt < nk; ++kt) {
        asm volatile("s_waitcnt vmcnt(0)" ::: "memory");
        __syncthreads();
        if (kt + 1 < nk) stage(kt + 1, (kt + 1) & 1);
        const char* As = smem + (kt & 1) * 32768;
        const char* Bs = As + 16384;
#pragma unroll
        for (int ks = 0; ks < 4; ++ks) {
            const int co = ((ks * 2 + hh) ^ key) << 4;
            bf16x8 a[2], b[2];
#pragma unroll
            for (int i = 0; i < 2; ++i) {
                a[i] = *(const bf16x8*)(As + arow + i * 4096 + co);
                b[i] = *(const bf16x8*)(Bs + brow + i * 4096 + co);
            }
#pragma unroll
            for (int i = 0; i < 2; ++i)
#pragma unroll
                for (int j = 0; j < 2; ++j) acc[i][j] = mfma32(a[i], b[j], acc[i][j]);
        }
    }
    __syncthreads();
    float* Cs = (float*)smem;
#pragma unroll
    for (int i = 0; i < 2; ++i)
#pragma unroll
        for (int j = 0; j < 2; ++j)
#pragma unroll
            for (int r = 0; r < 16; ++r)
                Cs[(wm * 64 + i * 32 + (r & 3) + 8 * (r >> 2) + 4 * hh) * 128 + wn * 64 + j * 32 + ql] = acc[i][j][r];
    __syncthreads();
    epi.tile(m0, n0, Cs, tid);
}

struct EpiBf16 {
    bf16_t* C; int ldc; const float* rowscale; const float* colbias; int nvalid;
    DEV void tile(int m0, int n0, const float* Cs, int tid) const {
#pragma unroll
        for (int it = 0; it < 8; ++it) {
            const int id = tid + 256 * it, r = id >> 4, c8 = (id & 15) * 8;
            if (n0 + c8 >= nvalid) continue;
            float4 a = *(const float4*)(Cs + r * 128 + c8), b = *(const float4*)(Cs + r * 128 + c8 + 4);
            if (rowscale) { const float sc = rowscale[m0 + r]; a.x *= sc; a.y *= sc; a.z *= sc; a.w *= sc; b.x *= sc; b.y *= sc; b.z *= sc; b.w *= sc; }
            if (colbias) { const float4 ba = *(const float4*)(colbias + n0 + c8), bb = *(const float4*)(colbias + n0 + c8 + 4);
                a.x += ba.x; a.y += ba.y; a.z += ba.z; a.w += ba.w; b.x += bb.x; b.y += bb.y; b.z += bb.z; b.w += bb.w; }
            *(uint4*)(C + (size_t)(m0 + r) * ldc + n0 + c8) = make_uint4(pack2(a.x, a.y), pack2(a.z, a.w), pack2(b.x, b.y), pack2(b.z, b.w));
        }
    }
};
struct EpiF32 {
    float* C; int ldc;
    DEV void tile(int m0, int n0, const float* Cs, int tid) const {
#pragma unroll
        for (int it = 0; it < 16; ++it) {
            const int id = tid + 256 * it, r = id >> 5, c4 = (id & 31) * 4;
            *(float4*)(C + (size_t)(m0 + r) * ldc + n0 + c4) = *(const float4*)(Cs + r * 128 + c4);
        }
    }
};
struct EpiRes {
    const void* xin; bool in_bf16; bf16_t* xout; const float* gate;
    DEV void tile(int m0, int n0, const float* Cs, int tid) const {
        const float* g = gate + (size_t)(m0 >> 11) * 6144 + n0;
#pragma unroll
        for (int it = 0; it < 8; ++it) {
            const int id = tid + 256 * it, r = id >> 4, c8 = (id & 15) * 8;
            const float4 v0 = *(const float4*)(Cs + r * 128 + c8), v1 = *(const float4*)(Cs + r * 128 + c8 + 4);
            const float4 g0 = *(const float4*)(g + c8), g1 = *(const float4*)(g + c8 + 4);
            float4 x0, x1;
            if (in_bf16) {
                const uint4 u = *(const uint4*)((const bf16_t*)xin + (size_t)(m0 + r) * 1024 + n0 + c8);
                x0 = make_float4(lo16(u.x), hi16(u.x), lo16(u.y), hi16(u.y)); x1 = make_float4(lo16(u.z), hi16(u.z), lo16(u.w), hi16(u.w));
            } else {
                const float* xp = (const float*)xin + (size_t)(m0 + r) * 1024 + n0 + c8;
                x0 = *(const float4*)xp; x1 = *(const float4*)(xp + 4);
            }
            *(uint4*)(xout + (size_t)(m0 + r) * 1024 + n0 + c8) =
                make_uint4(pack2(x0.x + g0.x * v0.x, x0.y + g0.y * v0.y), pack2(x0.z + g0.z * v0.z, x0.w + g0.w * v0.w),
                           pack2(x1.x + g1.x * v1.x, x1.y + g1.y * v1.y), pack2(x1.z + g1.z * v1.z, x1.w + g1.w * v1.w));
        }
    }
};

struct SliceMap { int virt, nx, nloc, rank; };
DEV SliceMap slice_map(const Params& p, char* smem);
template <class Epi>
DEV void gemm_phase(const Params& p, const bf16_t* A, int lda, const bf16_t* Bt, int ldb, int K, int mtiles, int ntiles, char* smem, const Epi& epi) {
    const SliceMap sm = slice_map(p, smem);
    if (sm.nx == 8 && (mtiles & 3) == 0) {
        const int mclass = sm.virt >> 1, nh = sm.virt & 1;
        const int h0 = (ntiles + 1) >> 1;
        const int nb = nh ? ntiles - h0 : h0, nbase = nh ? h0 : 0;
        const int total = (mtiles >> 2) * nb;
        for (int i = sm.rank; i < total; i += sm.nloc) {
            const int mt = mclass + 4 * (i / nb), nt = nbase + i % nb;
            gemm_tile(A, lda, Bt, ldb, K, mt * 128, nt * 128, smem, epi);
        }
        return;
    }
    for (int tile = blockIdx.x; tile < mtiles * ntiles; tile += gridDim.x) {
        const int mt = tile / ntiles, nt = tile % ntiles;
        gemm_tile(A, lda, Bt, ldb, K, mt * 128, nt * 128, smem, epi);
    }
}

DEV int win_srccol(int n) {
    if (n < 652) return n;
    if (n < 704) return -1;
    if (n < 1888) return n - 52;
    if (n < 1920) return -1;
    return n - 84;
}
DEV void transpose_tile(const float* __restrict__ src, int ld_src, int nsrc_valid, int mode, const float* __restrict__ rowscale,
                        bf16_t* __restrict__ dst, int K, int n0, int k0, char* smem) {
    bf16_t* Ls = (bf16_t*)smem;
    const int tid = ltid();
    __syncthreads();
    const int nn = tid & 63, n = n0 + nn;
    const int sc = (mode == 1) ? win_srccol(n) : (mode == 2) ? (n & 63) : (n < nsrc_valid ? n : -1);
    const int kshift = (mode == 2 && n >= 64) ? 1024 : 0;
#pragma unroll 4
    for (int i = 0; i < 16; ++i) {
        const int kk = (tid >> 6) + 4 * i;
        float v = 0.f;
        if (sc >= 0) { v = src[(size_t)(k0 + kk + kshift) * ld_src + sc]; if (rowscale) v *= rowscale[k0 + kk]; }
        Ls[nn * 72 + kk] = f2bf(v);
    }
    __syncthreads();
#pragma unroll
    for (int i = 0; i < 2; ++i) {
        const int r = (tid >> 3) + 32 * i, ch = tid & 7;
        *(uint4*)(dst + (size_t)(n0 + r) * K + k0 + ch * 8) = *(const uint4*)(Ls + r * 72 + ch * 8);
    }
}

DEV void convert_stream(const float* __restrict__ src, bf16_t* __restrict__ dst, size_t n8) {
    const int tid = ltid();
    for (size_t i = (size_t)blockIdx.x * 256 + tid; i < n8; i += (size_t)gridDim.x * 256) {
        const float4 a = *(const float4*)(src + i * 8), b = *(const float4*)(src + i * 8 + 4);
        uint4 o; o.x = pack2(a.x, a.y); o.y = pack2(a.z, a.w); o.z = pack2(b.x, b.y); o.w = pack2(b.z, b.w);
        *(uint4*)(dst + i * 8) = o;
    }
}

DEV void convert_fp8_stream(const float* __restrict__ src, unsigned char* __restrict__ dst, size_t n16, float scale) {
    const int tid = ltid();
    const size_t stride = (size_t)gridDim.x * 256;
    for (size_t i0 = (size_t)blockIdx.x * 256 + tid; i0 < n16; i0 += stride * 4) {
        float4 q[4][4];
#pragma unroll
        for (int u = 0; u < 4; ++u) {
            const size_t i = i0 + u * stride < n16 ? i0 + u * stride : i0;
#pragma unroll
            for (int c = 0; c < 4; ++c) q[u][c] = *(const float4*)(src + i * 16 + c * 4);
        }
#pragma unroll
        for (int u = 0; u < 4; ++u) {
            const size_t i = i0 + u * stride;
            if (i >= n16) break;
            unsigned o[4];
#pragma unroll
            for (int j = 0; j < 4; ++j) {
                const float4 v = q[u][j];
                unsigned w = 0u;
                w = __builtin_amdgcn_cvt_pk_fp8_f32(fminf(fmaxf(v.x * scale, -440.f), 440.f), fminf(fmaxf(v.y * scale, -440.f), 440.f), w, false);
                w = __builtin_amdgcn_cvt_pk_fp8_f32(fminf(fmaxf(v.z * scale, -440.f), 440.f), fminf(fmaxf(v.w * scale, -440.f), 440.f), w, true);
                o[j] = w;
            }
            const size_t rowg = i >> 6; const int c16 = (int)(i & 63);
            const size_t l = rowg >> 14, row = rowg & 16383;
            *(uint4*)(dst + (((l * 8 + (c16 >> 3)) * 16384 + row) << 7) + (c16 & 7) * 16) = make_uint4(o[0], o[1], o[2], o[3]);
        }
    }
}

constexpr int J_ROPE = 384, J_MOD = 192, J_MISC = 5;
constexpr int J_TW_L = 608 + 256 + 512 + 24 + 16 + 64 + 64;
constexpr int J_TOTAL = J_ROPE + J_MOD + J_MISC + 2 * J_TW_L;

DEV void prologue_job(const Params& p, int job, char* smem) {
    const int tid = ltid();
    char* ws = p.ws;
    if (job < J_MISC) {
        float* misc = (float*)(ws + OFF_MISC);
        if (job < 4) {
            const int l = job >> 1, kv = job & 1;
            const float* pos = (kv ? p.pos_v : p.pos_k) + l * 2048;
            const float* wsrc = (kv ? p.cmp_wv : p.cmp_wk) + (size_t)l * 2048 * 64;
            float* red = (float*)smem;
            __syncthreads();
            const int kp = tid >> 6, n = tid & 63;
            float acc = 0.f;
            for (int k0 = kp * 512; k0 < kp * 512 + 512; k0 += 16) {
                float wv[16];
#pragma unroll
                for (int u = 0; u < 16; ++u) wv[u] = wsrc[(size_t)(k0 + u) * 64 + n];
#pragma unroll
                for (int u = 0; u < 16; ++u) acc += pos[k0 + u] * wv[u];
            }
            red[kp * 64 + n] = acc;
            __syncthreads();
            if (tid < 64) misc[(l * 2 + kv) * 64 + tid] = red[tid] + red[64 + tid] + red[128 + tid] + red[192 + tid];
        } else if (tid < 2) {
            const int l = tid;
            float d1 = 0.f, d2 = 0.f;
            for (int i = 0; i < 32; ++i) { d1 += p.lq1[l * 32 + i] * p.lk1[l * 32 + i]; d2 += p.lq2[l * 32 + i] * p.lk2[l * 32 + i]; }
            const float lam_init = 0.8f - 0.6f * expf(-0.3f * (float)l);
            misc[256 + l] = expf(d1) - expf(d2) + lam_init;
            misc[258 + l] = 1.f - lam_init;
        }
        return;
    }
    job -= J_MISC;
    if (job < J_MOD) {
        const int l = job / 96, n0 = (job % 96) * 64;
        float* sc = (float*)smem;
        __syncthreads();
        for (int i = tid; i < 8192; i += 256) { const float v = p.c[i]; sc[i] = v / (1.f + __expf(-v)); }
        __syncthreads();
        const int kp = tid >> 6, col = tid & 63;
        float acc[8];
#pragma unroll
        for (int b = 0; b < 8; ++b) acc[b] = 0.f;
        const float* wp = p.ada_w + (size_t)l * 1024 * 6144 + n0 + col;
        for (int k0 = kp * 256; k0 < kp * 256 + 256; k0 += 16) {
            float wv[16];
#pragma unroll
            for (int u = 0; u < 16; ++u) wv[u] = wp[(size_t)(k0 + u) * 6144];
#pragma unroll
            for (int u = 0; u < 16; ++u)
#pragma unroll
                for (int b = 0; b < 8; ++b) acc[b] += sc[b * 1024 + k0 + u] * wv[u];
        }
        float* red = sc + 8192;
#pragma unroll
        for (int b = 0; b < 8; ++b) red[(kp * 8 + b) * 64 + col] = acc[b];
        __syncthreads();
        float* mod = (float*)(ws + OFF_MOD);
        for (int idx = tid; idx < 512; idx += 256) {
            const int b = idx >> 6, cl = idx & 63;
            const float v = red[(0 * 8 + b) * 64 + cl] + red[(1 * 8 + b) * 64 + cl] + red[(2 * 8 + b) * 64 + cl] + red[(3 * 8 + b) * 64 + cl];
            mod[(size_t)(l * 8 + b) * 6144 + n0 + cl] = v + p.ada_b[l * 6144 + n0 + cl];
        }
        return;
    }
    job -= J_MOD;
    if (job < J_ROPE) {
        const int idx = job * 256 + tid;
        const int s = idx / 48, j = idx % 48;
        float* rope = (float*)(ws + OFF_ROPE);
        float inv; float *pc, *ps;
        if (j < 32) { inv = exp2f(-(float)j * (13.287712379549449f / 32.f)); pc = rope + s * 32 + j; ps = rope + 2048 * 32 + s * 32 + j; }
        else { const int i = j - 32; inv = exp2f(-(float)i * (13.287712379549449f / 16.f)); pc = rope + 2048 * 64 + s * 16 + i; ps = rope + 2048 * 64 + 2048 * 16 + s * 16 + i; }
        const double a = (double)s * (double)inv;
        const double kk = rint(a * 0.15915494309189535);
        const float r = (float)fma(-kk, 6.283185307179586, a);
        *pc = cosf(r); *ps = sinf(r);
        return;
    }
    job -= J_ROPE;
    const int l = job / J_TW_L; int j = job % J_TW_L;
    if (j < 608) { transpose_tile(p.w_in + (size_t)l * 1024 * 2348, 2348, 2348, 1, nullptr, (bf16_t*)(ws + OFF_WIN) + (size_t)l * 2432 * 1024, 1024, (j / 16) * 64, (j % 16) * 64, smem); return; }
    j -= 608;
    if (j < 256) { transpose_tile(p.w_out + (size_t)l * 1024 * 1024, 1024, 1024, 0, nullptr, (bf16_t*)(ws + OFF_WOUT) + (size_t)l * 1024 * 1024, 1024, (j / 16) * 64, (j % 16) * 64, smem); return; }
    j -= 256;
    if (j < 512) { transpose_tile(p.w_q + (size_t)l * 1024 * 2048, 2048, 2048, 0, nullptr, (bf16_t*)(ws + OFF_WQ) + (size_t)l * 2048 * 1024, 1024, (j / 16) * 64, (j % 16) * 64, smem); return; }
    j -= 512;
    if (j < 24) { transpose_tile(p.mla_wuq + (size_t)l * 256 * 384, 384, 384, 0, p.mla_qg + l * 256, (bf16_t*)(ws + OFF_WUQ) + (size_t)l * 384 * 256, 256, (j / 4) * 64, (j % 4) * 64, smem); return; }
    j -= 24;
    if (j < 16) { transpose_tile(p.mla_wukv + (size_t)l * 128 * 512, 512, 512, 0, p.mla_kvg + l * 128, (bf16_t*)(ws + OFF_WUKV) + (size_t)l * 512 * 128, 128, (j / 2) * 64, (j % 2) * 64, smem); return; }
    j -= 16;
    if (j < 64) { if (j < 32) transpose_tile(p.cmp_wk + (size_t)l * 2048 * 64, 64, 64, 2, nullptr, (bf16_t*)(ws + OFF_WCK) + (size_t)l * 128 * 2048, 1024, (j / 16) * 64, (j % 16) * 64, smem); return; }
    j -= 64;
    if (j < 32) transpose_tile(p.cmp_wv + (size_t)l * 2048 * 64, 64, 64, 2, nullptr, (bf16_t*)(ws + OFF_WCV) + (size_t)l * 128 * 2048, 1024, (j / 16) * 64, (j % 16) * 64, smem);
}

#if TS_A >= 0
#define PSTAMP(I) if (blockIdx.x == 0 && threadIdx.x == 0) ((unsigned long long*)(p.ws + 32768))[I] = __builtin_amdgcn_s_memrealtime();
#else
#define PSTAMP(I)
#endif
DEV void phase_prologue(const Params& p, char* smem) {
    {
        unsigned* ctr = (unsigned*)p.ws + 100;
        volatile int* slot = (volatile int*)(smem + 65536 + 64);
        int job = blockIdx.x;
        while (job < J_TOTAL) {
            prologue_job(p, job, smem);
            __syncthreads();
            if (ltid() == 0) *slot = (int)gridDim.x + (int)atomicAdd(ctr, 1u);
            __syncthreads();
            job = __builtin_amdgcn_readfirstlane(*slot);
        }
    }
    PSTAMP(42)
    char* ws = p.ws;
    convert_fp8_stream(p.pu, (unsigned char*)(ws + OFF_PU), 2ull * 16384 * 1024 / 16, kScaleU);
    PSTAMP(43)
    convert_fp8_stream(p.pv, (unsigned char*)(ws + OFF_PV), 2ull * 16384 * 1024 / 16, kScaleV);
    PSTAMP(44)
    for (int l = 0; l < 2; ++l) {
        convert_stream(p.subk1 + (size_t)l * 16384, (bf16_t*)(ws + OFF_SUBK) + (size_t)(l * 2 + 0) * 16384, 16384 / 8);
        convert_stream(p.subk2 + (size_t)l * 16384, (bf16_t*)(ws + OFF_SUBK) + (size_t)(l * 2 + 1) * 16384, 16384 / 8);
    }
}

DEV void phase_norm(const Params& p, int layer, int which) {
    const int tid = ltid(), lane = tid & 63, w = tid >> 6;
    const bool xbf = !(layer == 0 && which == 0);
    const float* xs = p.x; const bf16_t* xb = (const bf16_t*)(p.ws + OFF_XRES);
    const float* g = (which == 0 ? p.norm_mix_g : p.norm_ffn_g) + layer * 1024;
    const float* mod = (const float*)(p.ws + OFF_MOD) + (size_t)layer * 8 * 6144;
    bf16_t* h = (bf16_t*)(p.ws + OFF_H);
    float4 g4[4];
#pragma unroll
    for (int i = 0; i < 4; ++i) g4[i] = *(const float4*)(g + i * 256 + lane * 4);
    for (int q0 = blockIdx.x; q0 < kT / 4; q0 += gridDim.x * 4) {
        float4 v[4][4];
#pragma unroll
        for (int u = 0; u < 4; ++u) {
            const int q = q0 + u * gridDim.x < kT / 4 ? q0 + u * gridDim.x : q0;
            if (xbf) {
                const bf16_t* xr = xb + (size_t)(q * 4 + w) * 1024;
#pragma unroll
                for (int i = 0; i < 4; ++i) { const uint2 uu = *(const uint2*)(xr + i * 256 + lane * 4); v[u][i] = make_float4(lo16(uu.x), hi16(uu.x), lo16(uu.y), hi16(uu.y)); }
            } else {
                const float* xr = xs + (size_t)(q * 4 + w) * 1024;
#pragma unroll
                for (int i = 0; i < 4; ++i) v[u][i] = *(const float4*)(xr + i * 256 + lane * 4);
            }
        }
#pragma unroll
        for (int u = 0; u < 4; ++u) {
            const int q = q0 + u * gridDim.x;
            if (q >= kT / 4) break;
            const int t = q * 4 + w, b = t >> 11;
            float ss = 0.f;
#pragma unroll
            for (int i = 0; i < 4; ++i) ss += v[u][i].x * v[u][i].x + v[u][i].y * v[u][i].y + v[u][i].z * v[u][i].z + v[u][i].w * v[u][i].w;
            ss = wave_sum(ss);
            const float rstd = rsqrtf(ss * (1.f / 1024.f) + kEps);
            const float* sh = mod + (size_t)b * 6144 + (which ? 3072 : 0);
            const float* sc = sh + 1024;
#pragma unroll
            for (int i = 0; i < 4; ++i) {
                const int col = i * 256 + lane * 4;
                const float4 s4 = *(const float4*)(sc + col), h4 = *(const float4*)(sh + col);
                const float o0 = v[u][i].x * rstd * g4[i].x * (1.f + s4.x) + h4.x, o1 = v[u][i].y * rstd * g4[i].y * (1.f + s4.y) + h4.y;
                const float o2 = v[u][i].z * rstd * g4[i].z * (1.f + s4.z) + h4.z, o3 = v[u][i].w * rstd * g4[i].w * (1.f + s4.w) + h4.w;
                uint2 o; o.x = pack2(o0, o1); o.y = pack2(o2, o3);
                *(uint2*)(h + (size_t)t * 1024 + col) = o;
            }
        }
    }
}

DEV void rope8(uint4& x1, uint4& x2, const float (&cc)[8], const float (&ss)[8]) {
    unsigned a[4] = {x1.x, x1.y, x1.z, x1.w}, b[4] = {x2.x, x2.y, x2.z, x2.w};
#pragma unroll
    for (int i = 0; i < 4; ++i) {
        const float a0 = lo16(a[i]), a1 = hi16(a[i]), b0 = lo16(b[i]), b1 = hi16(b[i]);
        const float o10 = a0 * cc[2 * i] - b0 * ss[2 * i], o11 = a1 * cc[2 * i + 1] - b1 * ss[2 * i + 1];
        const float o20 = a0 * ss[2 * i] + b0 * cc[2 * i], o21 = a1 * ss[2 * i + 1] + b1 * cc[2 * i + 1];
        a[i] = pack2(o10, o11); b[i] = pack2(o20, o21);
    }
    x1 = make_uint4(a[0], a[1], a[2], a[3]); x2 = make_uint4(b[0], b[1], b[2], b[3]);
}
DEV void vt_tile(const bf16_t* __restrict__ src, int ld, bf16_t* __restrict__ dst, char* smem) {
    bf16_t* Ls = (bf16_t*)smem;
    const int tid = ltid();
    __syncthreads();
#pragma unroll
    for (int i = 0; i < 2; ++i) {
        const int id = tid + 256 * i, tok = id >> 3, ch = id & 7;
        *(uint4*)(Ls + tok * 72 + ch * 8) = *(const uint4*)(src + (size_t)tok * ld + ch * 8);
    }
    __syncthreads();
#pragma unroll
    for (int i = 0; i < 2; ++i) {
        const int id = tid + 256 * i, d = id & 63, tc = id >> 6;
        unsigned short e[8];
#pragma unroll
        for (int j = 0; j < 8; ++j) e[j] = Ls[(tc * 8 + j) * 72 + d];
        uint4 o;
        o.x = (unsigned)e[0] | ((unsigned)e[1] << 16); o.y = (unsigned)e[2] | ((unsigned)e[3] << 16);
        o.z = (unsigned)e[4] | ((unsigned)e[5] << 16); o.w = (unsigned)e[6] | ((unsigned)e[7] << 16);
        *(uint4*)(dst + (size_t)d * 2048 + tc * 8) = o;
    }
}

DEV void phase_layout1(const Params& p, char* smem) {
    char* ws = p.ws;
    bf16_t* cols = (bf16_t*)(ws + OFF_COLS);
    bf16_t* kc = (bf16_t*)(ws + OFF_KC);
    bf16_t* vc = (bf16_t*)(ws + OFF_VC);
    bf16_t* VT = (bf16_t*)(ws + OFF_VT);
    float* rstd = (float*)(ws + OFF_RSTD);
    const float* rope = (const float*)(ws + OFF_ROPE);
    const float *cos64 = rope, *sin64 = rope + 2048 * 32, *cos32 = rope + 2048 * 64, *sin32 = rope + 2048 * 64 + 2048 * 16;
    const int tid = ltid();
    for (int unit = blockIdx.x; unit < 2 * (kT / 64); unit += gridDim.x) {
        const int tile = unit >> 1, part01 = unit & 1;
        const int T0 = tile * 64, b = T0 >> 11, s0 = T0 & 2047;
        if (part01 == 0) {
            for (int it0 = tid; it0 < 64 * 86; it0 += 1024) {
                uint4 x1[4], x2[4]; float4 cs[4][2], sn[4][2]; bf16_t* p1[4]; bf16_t* p2[4]; bf16_t* kq[4];
#pragma unroll
                for (int u = 0; u < 4; ++u) {
                    const int it = it0 + u * 256 < 64 * 86 ? it0 + u * 256 : it0;
                    const int tok = it / 86, item = it % 86;
                    const int t = T0 + tok, sq = s0 + tok;
                    bf16_t* row = cols + (size_t)t * LDC;
                    kq[u] = nullptr;
                    const float *cp, *sp;
                    if (item < 52) {
                        const int hd = item >> 2, i0 = (item & 3) * 8;
                        const int base = hd < 4 ? 64 * hd : hd == 4 ? 256 : hd == 5 ? 384 : hd == 6 ? 512 : hd < 11 ? 1920 + 64 * (hd - 7) : 2176 + 64 * (hd - 11);
                        p1[u] = row + base + i0; p2[u] = row + base + 32 + i0;
                        cp = cos64 + sq * 32 + i0; sp = sin64 + sq * 32 + i0;
                        if (hd == 4) kq[u] = kc + (size_t)t * 64 + i0;
                    } else {
                        const int it2 = item - 52, sub = it2 >> 1, i0 = (it2 & 1) * 8;
                        const int base = sub < 8 ? 704 + 32 * sub : sub < 16 ? 960 + 32 * (sub - 8) : 1856;
                        p1[u] = row + base + i0; p2[u] = row + base + 16 + i0;
                        cp = cos32 + sq * 16 + i0; sp = sin32 + sq * 16 + i0;
                    }
                    x1[u] = *(const uint4*)p1[u]; x2[u] = *(const uint4*)p2[u];
                    cs[u][0] = *(const float4*)cp; cs[u][1] = *(const float4*)(cp + 4);
                    sn[u][0] = *(const float4*)sp; sn[u][1] = *(const float4*)(sp + 4);
                }
#pragma unroll
                for (int u = 0; u < 4; ++u) {
                    if (it0 + u * 256 >= 64 * 86) break;
                    const float cc[8] = {cs[u][0].x, cs[u][0].y, cs[u][0].z, cs[u][0].w, cs[u][1].x, cs[u][1].y, cs[u][1].z, cs[u][1].w};
                    const float ss[8] = {sn[u][0].x, sn[u][0].y, sn[u][0].z, sn[u][0].w, sn[u][1].x, sn[u][1].y, sn[u][1].z, sn[u][1].w};
                    rope8(x1[u], x2[u], cc, ss);
                    *(uint4*)p1[u] = x1[u]; *(uint4*)p2[u] = x2[u];
                    if (kq[u]) { *(uint4*)kq[u] = x1[u]; *(uint4*)(kq[u] + 32) = x2[u]; }
                }
            }
            {
                const uint4 c0 = *(const uint4*)(cols + (size_t)(T0 + (tid >> 3)) * LDC + 320 + (tid & 7) * 8);
                const uint4 c1 = *(const uint4*)(cols + (size_t)(T0 + 32 + (tid >> 3)) * LDC + 320 + (tid & 7) * 8);
                *(uint4*)(vc + (size_t)(T0 + (tid >> 3)) * 64 + (tid & 7) * 8) = c0;
                *(uint4*)(vc + (size_t)(T0 + 32 + (tid >> 3)) * 64 + (tid & 7) * 8) = c1;
            }
        }
        if (part01 == 0) continue;
        {
            const int tok = tid >> 2, part = tid & 3, t = T0 + tok;
            const bf16_t* src = cols + (size_t)t * LDC + 1472 + (part < 3 ? part : 0) * 128;
            float ss = 0.f;
#pragma unroll 4
            for (int i = 0; i < 16; ++i) {
                const uint4 u = *(const uint4*)(src + i * 8);
                ss += lo16(u.x) * lo16(u.x) + hi16(u.x) * hi16(u.x) + lo16(u.y) * lo16(u.y) + hi16(u.y) * hi16(u.y)
                    + lo16(u.z) * lo16(u.z) + hi16(u.z) * hi16(u.z) + lo16(u.w) * lo16(u.w) + hi16(u.w) * hi16(u.w);
            }
            float vq = part < 2 ? ss : 0.f;
            vq += __shfl_xor(vq, 1, 64);
            if (part == 0) rstd[t] = rsqrtf(vq * (1.f / 256.f) + kEps);
            if (part == 2) rstd[kT + t] = rsqrtf(ss * (1.f / 128.f) + kEps);
        }
#pragma unroll 1
        for (int vh = 0; vh < 8; ++vh) {
            const int col = vh == 0 ? 448 : vh == 1 ? 576 : vh < 6 ? 1216 + 64 * (vh - 2) : 2304 + 64 * (vh - 6);
            vt_tile(cols + (size_t)T0 * LDC + col, LDC, VT + ((size_t)(b * 12 + vh) * 64) * 2048 + s0, smem);
        }
    }
}

DEV void phase_layout2(const Params& p, int layer, char* smem) {
    char* ws = p.ws;
    bf16_t* qmla = (bf16_t*)(ws + OFF_QMLA);
    const bf16_t* kvmla = (const bf16_t*)(ws + OFF_KVMLA);
    bf16_t* VT = (bf16_t*)(ws + OFF_VT);
    const float* rope = (const float*)(ws + OFF_ROPE);
    const float *cos32 = rope + 2048 * 64, *sin32 = rope + 2048 * 64 + 2048 * 16;
    const int tid = ltid();
    for (int tile = blockIdx.x; tile < kT / 64 + 64; tile += gridDim.x) {
        if (tile >= kT / 64) {
            const int idx = (tile - kT / 64) * 2048 + tid * 8;
            const int kv = idx >> 16, m = (idx >> 6) & 1023, n = idx & 63;
            const float* pp = (const float*)(ws + OFF_QP) + ((size_t)(kv * 8) * 1024 + m) * 128 + n;
            const float* bias = (const float*)(ws + OFF_MISC) + (layer * 2 + kv) * 64 + n;
            float4 a = *(const float4*)bias, c = *(const float4*)(bias + 4);
#pragma unroll
            for (int ks = 0; ks < 8; ++ks) {
                const float4 x = *(const float4*)(pp + (size_t)ks * 1024 * 128), y = *(const float4*)(pp + (size_t)ks * 1024 * 128 + 4);
                a.x += x.x; a.y += x.y; a.z += x.z; a.w += x.w; c.x += y.x; c.y += y.y; c.z += y.z; c.w += y.w;
            }
            *(uint4*)((bf16_t*)(ws + OFF_KCMP) + (size_t)kv * 1024 * 64 + m * 64 + n) = make_uint4(pack2(a.x, a.y), pack2(a.z, a.w), pack2(c.x, c.y), pack2(c.z, c.w));
            continue;
        }
        const int T0 = tile * 64, b = T0 >> 11, s0 = T0 & 2047;
        for (int it = tid; it < 64 * 8; it += 256) {
            const int tok = it >> 3, item = it & 7, hd = item >> 1, i0 = (item & 1) * 8;
            const int t = T0 + tok, s = s0 + tok;
            bf16_t* row = qmla + (size_t)t * 384 + hd * 96 + 64;
            uint4 x1 = *(const uint4*)(row + i0), x2 = *(const uint4*)(row + 16 + i0);
            const float* cp = cos32 + s * 16 + i0; const float* sp = sin32 + s * 16 + i0;
            const float4 c0 = *(const float4*)cp, c1 = *(const float4*)(cp + 4), q0 = *(const float4*)sp, q1 = *(const float4*)(sp + 4);
            const float cc[8] = {c0.x, c0.y, c0.z, c0.w, c1.x, c1.y, c1.z, c1.w}, ss[8] = {q0.x, q0.y, q0.z, q0.w, q1.x, q1.y, q1.z, q1.w};
            rope8(x1, x2, cc, ss);
            *(uint4*)(row + i0) = x1; *(uint4*)(row + 16 + i0) = x2;
        }
#pragma unroll 1
        for (int hd = 0; hd < 4; ++hd)
            vt_tile(kvmla + (size_t)T0 * 512 + hd * 128 + 64, 512, VT + ((size_t)(b * 12 + 8 + hd) * 64) * 2048 + s0, smem);
    }
}

constexpr int SM_K = 0;
constexpr int SM_V = 26624;
constexpr int SM_IMP = SM_V + 17408;
constexpr int SM_SEL = SM_IMP + 16896;
constexpr int SM_CTRL = 65536;
constexpr int SM_TOTAL = SM_CTRL + 256 + 512;
constexpr int SM_ATTN_END = SM_SEL + 1024;

struct RangeIter { int cur, end; DEV int next() { return cur < end ? cur++ : -1; } };
struct BitIter { unsigned rem; DEV int next() { if (!rem) return -1; const int k = __ffs((int)rem) - 1; rem &= rem - 1; return k; } };
struct LdRow { const bf16_t* base; int ld;
    DEV uint4 operator()(int kt, int id) const { const int row = id >> 3, part = id & 7; return *(const uint4*)(base + (size_t)(kt * 64 + row) * ld + part * 8); } };
struct LdVT { const bf16_t* base;
    DEV uint4 operator()(int kt, int id) const { const int d = id >> 3, part = id & 7; return *(const uint4*)(base + (size_t)d * 2048 + kt * 64 + part * 8); } };
struct LdMlaK { const bf16_t* kv; const bf16_t* kr;
    DEV uint4 operator()(int kt, int id) const { const int row = id / 12, part = id % 12; const size_t t = (size_t)(kt * 64 + row);
        return part < 8 ? *(const uint4*)(kv + t * 512 + part * 8) : *(const uint4*)(kr + t * LDC + (part - 8) * 8); } };

struct MaskCausal { DEV bool on(int) const { return true; } DEV bool ok(int kc, int d) const { return kc <= d; }
    DEV bool full(int kt, int t0w) const { return kt * 64 + 63 <= t0w; } };
template <int W> struct MaskWin { DEV bool on(int) const { return true; } DEV bool ok(int kc, int d) const { return (kc <= d) && (d - kc < W); }
    DEV bool full(int kt, int t0w) const { return (kt * 64 + 63 <= t0w) && (t0w + 31 - kt * 64 < W); } };
struct MaskSel { unsigned bits, allbits; DEV bool on(int kt) const { return (bits >> kt) & 1u; } DEV bool ok(int kc, int d) const { return kc <= d; }
    DEV bool full(int kt, int t0w) const { return ((allbits >> kt) & 1u) && (kt * 64 + 63 <= t0w); } };
template <int KDIM, int NKS, int NSUB, bool QG, class It, class LK, class LV, class MaskF, class SkipF>
DEV void attn_stream(It it, const LK& ldK, const LV& ldV, const MaskF& maskf, const SkipF& skipf,
                     const bf16x8* qf, f32x16 (&o)[NSUB][2], float (&m)[NSUB], float (&l)[NSUB], float scl, int tq, int t0w, char* smem, int tid, int koff = 0) {
    constexpr int KCH = KDIM / 8, KSTR = KDIM + 8, NKC = (64 * KCH) / 256;
    constexpr int KBUF = 64 * 104, VBUF = 64 * 68;
    bf16_t* Kb = (bf16_t*)(smem + SM_K);
    bf16_t* Vb = (bf16_t*)(smem + SM_V);
    const int lane = tid & 63, ql = lane & 31, hh = lane >> 5;
    const uint4 z4 = make_uint4(0, 0, 0, 0);
    uint4 ak0 = z4, ak1 = z4, ak2 = z4, av0 = z4, av1 = z4, bk0 = z4, bk1 = z4, bk2 = z4, bv0 = z4, bv1 = z4;
    auto loadA = [&](int kt) __attribute__((always_inline)) { ak0 = ldK(kt, tid); ak1 = ldK(kt, tid + 256); if (NKC == 3) ak2 = ldK(kt, tid + 512); av0 = ldV(kt, tid); av1 = ldV(kt, tid + 256); };
    auto loadB = [&](int kt) __attribute__((always_inline)) { bk0 = ldK(kt, tid); bk1 = ldK(kt, tid + 256); if (NKC == 3) bk2 = ldK(kt, tid + 512); bv0 = ldV(kt, tid); bv1 = ldV(kt, tid + 256); };
    auto stK = [&](bf16_t* kb, const uint4& r, int id) __attribute__((always_inline)) { const int row = id / KCH, part = id % KCH; *(uint4*)(kb + row * KSTR + part * 8) = r; };
    auto stV = [&](bf16_t* vb, const uint4& r, int id) __attribute__((always_inline)) { const int row = id >> 3, part = id & 7; bf16_t* d = vb + row * 68 + part * 8;
        *(uint2*)d = make_uint2(r.x, r.y); *(uint2*)(d + 4) = make_uint2(r.z, r.w); };
    auto compute = [&](int kt, const bf16_t* Kt, const bf16_t* Vt) __attribute__((always_inline)) {
        if (skipf(kt)) return;
#pragma unroll
        for (int sub = 0; sub < NSUB; ++sub) {
            const int tqs = tq + (QG ? 32 * sub : 0), t0s = t0w + (QG ? 32 * sub : 0);
            if (QG && kt * 64 > t0s + 31) continue;
            __builtin_amdgcn_sched_barrier(0);
            f32x16 s[2];
#pragma unroll
            for (int i = 0; i < 2; ++i) {
                s[i] = zero16();
#pragma unroll
                for (int ks = 0; ks < NKS; ++ks) {
                    const bf16x8 a = *(const bf16x8*)(Kt + (i * 32 + ql) * KSTR + koff + ((QG ? 0 : sub * NKS) + ks) * 16 + hh * 8);
                    s[i] = mfma32(a, qf[sub * NKS + ks], s[i]);
                }
            }
            float mx = kNeg;
            if (!maskf.full(kt, t0s)) {
                const int dlim = tqs - kt * 64 - 4 * hh;
                const bool on = maskf.on(kt);
#pragma unroll
                for (int i = 0; i < 2; ++i)
#pragma unroll
                    for (int r = 0; r < 16; ++r) {
                        const int kc = i * 32 + (r & 3) + 8 * (r >> 2);
                        s[i][r] = (on && maskf.ok(kc, dlim)) ? s[i][r] : kNeg;
                    }
            }
#pragma unroll
            for (int i = 0; i < 2; ++i)
#pragma unroll
                for (int r = 0; r < 16; ++r) mx = fmaxf(mx, s[i][r]);
            mx = fmaxf(mx, xor32f(mx, lane));
            const float mnew = fmaxf(m[sub], mx);
            const float alpha = __builtin_amdgcn_exp2f((m[sub] - mnew) * scl);
            m[sub] = mnew;
            const float negm = mnew > -1e29f ? -mnew * scl : 0.f;
            float sum = 0.f;
#pragma unroll
            for (int i = 0; i < 2; ++i)
#pragma unroll
                for (int r = 0; r < 16; ++r) { const float pv = __builtin_amdgcn_exp2f(__builtin_fmaf(s[i][r], scl, negm)); s[i][r] = pv; sum += pv; }
            l[sub] = l[sub] * alpha + sum;
            if (__builtin_amdgcn_ballot_w64(alpha != 1.f)) {
#pragma unroll
                for (int dt = 0; dt < 2; ++dt)
#pragma unroll
                    for (int r = 0; r < 16; ++r) o[sub][dt][r] *= alpha;
            }
            __builtin_amdgcn_sched_barrier(0);
#pragma unroll
            for (int ks = 0; ks < 4; ++ks) {
                if (ks == 2) __builtin_amdgcn_sched_barrier(0);
                const int i = ks >> 1, r0 = 8 * (ks & 1);
                uint4 pu;
                pu.x = pack2(s[i][r0 + 0], s[i][r0 + 1]); pu.y = pack2(s[i][r0 + 2], s[i][r0 + 3]);
                pu.z = pack2(s[i][r0 + 4], s[i][r0 + 5]); pu.w = pack2(s[i][r0 + 6], s[i][r0 + 7]);
                const bf16x8 pf = __builtin_bit_cast(bf16x8, pu);
#pragma unroll
                for (int dt = 0; dt < 2; ++dt) {
                    const bf16_t* vp = Vt + (dt * 32 + ql) * 68 + ks * 16 + 4 * hh;
                    const uint2 a0 = *(const uint2*)vp, a1 = *(const uint2*)(vp + 8);
                    const bf16x8 a = __builtin_bit_cast(bf16x8, make_uint4(a0.x, a0.y, a1.x, a1.y));
                    o[sub][dt] = mfma32(a, pf, o[sub][dt]);
                }
            }
        }
    };
    int ka = it.next();
    int kb = ka >= 0 ? it.next() : -1;
    if (ka >= 0) loadA(ka);
    if (kb >= 0) loadB(kb);
    while (ka >= 0) {
        __syncthreads();
        stK(Kb, ak0, tid); stK(Kb, ak1, tid + 256); if (NKC == 3) stK(Kb, ak2, tid + 512);
        stV(Vb, av0, tid); stV(Vb, av1, tid + 256);
        if (kb >= 0) {
            stK(Kb + KBUF, bk0, tid); stK(Kb + KBUF, bk1, tid + 256); if (NKC == 3) stK(Kb + KBUF, bk2, tid + 512);
            stV(Vb + VBUF, bv0, tid); stV(Vb + VBUF, bv1, tid + 256);
        }
        __syncthreads();
        const int na = it.next();
        const int nb = na >= 0 ? it.next() : -1;
        if (na >= 0) loadA(na);
        if (nb >= 0) loadB(nb);
        compute(ka, Kb, Vb);
        if (kb >= 0) compute(kb, Kb + KBUF, Vb + VBUF);
        ka = na; kb = nb;
    }
}

DEV void write_o(const f32x16 (&o)[2], bf16_t* obuf, size_t row, int col0, int hh) {
#pragma unroll
    for (int dt = 0; dt < 2; ++dt)
#pragma unroll
        for (int g = 0; g < 4; ++g) {
            const int d = dt * 32 + 8 * g + 4 * hh;
            uint2 u; u.x = pack2(o[dt][4 * g], o[dt][4 * g + 1]); u.y = pack2(o[dt][4 * g + 2], o[dt][4 * g + 3]);
            *(uint2*)(obuf + row * 1024 + col0 + d) = u;
        }
}
DEV float sigmoidf(float x) { return 1.f / (1.f + __expf(-x)); }

DEV void nsa_item(const Params& p, int layer, int b, int qb, char* smem) {
    int tid = threadIdx.x; asm volatile("" : "+v"(tid));
    const int lane = tid & 63, w = tid >> 6, ql = lane & 31, hh = lane >> 5;
    char* ws = p.ws;
    const bf16_t* cols = (const bf16_t*)(ws + OFF_COLS);
    const bf16_t* VT = (const bf16_t*)(ws + OFF_VT);
    bf16_t* obuf = (bf16_t*)(ws + OFF_O);
    const int t0 = qb * 32, tq = t0 + ql;
    const size_t Tb = (size_t)b * kS;
    const bf16_t* qrow = cols + (Tb + tq) * LDC;
    bf16x8 qf[4];
#pragma unroll
    for (int ks = 0; ks < 4; ++ks) qf[ks] = *(const bf16x8*)(qrow + w * 64 + ks * 16 + hh * 8);
    const float g0 = sigmoidf(bf2f(qrow[640 + w * 3 + 0])), g1 = sigmoidf(bf2f(qrow[640 + w * 3 + 1])), g2 = sigmoidf(bf2f(qrow[640 + w * 3 + 2]));
    const float scl = 0.125f * kLog2e;
    bf16_t* Kc = (bf16_t*)(smem + SM_K);
    bf16_t* Vc = (bf16_t*)(smem + SM_V);
    float* impP = (float*)(smem + SM_IMP);
    unsigned* selm = (unsigned*)(smem + SM_SEL);
    const float* gk = (const float*)(ws + OFF_QP) + (size_t)b * 128 * 128;
    const float* gv = gk + (size_t)1024 * 128;
    const float* bias = (const float*)(ws + OFF_MISC) + layer * 128;
    __syncthreads();
#pragma unroll
    for (int i = 0; i < 4; ++i) {
        const int id = tid + 256 * i, row = id >> 3, part = id & 7;
        const int row1 = row < 127 ? row + 1 : row;
        const float* a = gk + (size_t)row * 128 + part * 8;  const float* a2 = gk + (size_t)row1 * 128 + 64 + part * 8;
        const float* c = gv + (size_t)row * 128 + part * 8;  const float* c2 = gv + (size_t)row1 * 128 + 64 + part * 8;
        const float4 k0 = *(const float4*)a, k1 = *(const float4*)(a + 4), k2 = *(const float4*)a2, k3 = *(const float4*)(a2 + 4);
        const float4 v0 = *(const float4*)c, v1 = *(const float4*)(c + 4), v2 = *(const float4*)c2, v3 = *(const float4*)(c2 + 4);
        const float4 bk0 = *(const float4*)(bias + part * 8), bk1 = *(const float4*)(bias + part * 8 + 4);
        const float4 bv0 = *(const float4*)(bias + 64 + part * 8), bv1 = *(const float4*)(bias + 64 + part * 8 + 4);
        uint4 kk = make_uint4(pack2(k0.x + k2.x + bk0.x, k0.y + k2.y + bk0.y), pack2(k0.z + k2.z + bk0.z, k0.w + k2.w + bk0.w),
                              pack2(k1.x + k3.x + bk1.x, k1.y + k3.y + bk1.y), pack2(k1.z + k3.z + bk1.z, k1.w + k3.w + bk1.w));
        uint4 vv = make_uint4(pack2(v0.x + v2.x + bv0.x, v0.y + v2.y + bv0.y), pack2(v0.z + v2.z + bv0.z, v0.w + v2.w + bv0.w),
                              pack2(v1.x + v3.x + bv1.x, v1.y + v3.y + bv1.y), pack2(v1.z + v3.z + bv1.z, v1.w + v3.w + bv1.w));
        if (row == 127) { kk = make_uint4(0, 0, 0, 0); vv = kk; }
        *(uint4*)(Kc + row * 72 + part * 8) = kk;
        const unsigned u[4] = {vv.x, vv.y, vv.z, vv.w};
#pragma unroll
        for (int j = 0; j < 4; ++j) { Vc[(part * 8 + 2 * j) * 132 + row] = (bf16_t)(u[j] & 0xffffu); Vc[(part * 8 + 2 * j + 1) * 132 + row] = (bf16_t)(u[j] >> 16); }
    }
    __syncthreads();
    unsigned ocp[16];
    float* invs = (float*)(smem + SM_SEL) + 64;
    {
        const int cmaxv = tq >= 31 ? min((tq - 31) >> 4, 126) : -1;
        float mx = kNeg;
#pragma unroll 1
        for (int i = 0; i < 4; ++i) {
            f32x16 s = zero16();
#pragma unroll
            for (int ks = 0; ks < 4; ++ks) s = mfma32(*(const bf16x8*)(Kc + (i * 32 + ql) * 72 + ks * 16 + hh * 8), qf[ks], s);
            const int clim = cmaxv - i * 32 - 4 * hh;
#pragma unroll
            for (int r = 0; r < 16; ++r) {
                const int kc = (r & 3) + 8 * (r >> 2);
                const bool valid = (kc <= clim);
                mx = fmaxf(mx, valid ? s[r] * scl : kNeg);
            }
        }
        mx = fmaxf(mx, xor32f(mx, lane));
        f32x16 ocmp[2]; ocmp[0] = zero16(); ocmp[1] = zero16();
        float sum = 0.f, carprev = 0.f;
#pragma unroll 1
        for (int i = 0; i < 4; ++i) {
            f32x16 s = zero16();
#pragma unroll
            for (int ks = 0; ks < 4; ++ks) s = mfma32(*(const bf16x8*)(Kc + (i * 32 + ql) * 72 + ks * 16 + hh * 8), qf[ks], s);
            const int clim = cmaxv - i * 32 - 4 * hh;
#pragma unroll
            for (int r = 0; r < 16; ++r) {
                const int kc = (r & 3) + 8 * (r >> 2);
                const bool valid = (kc <= clim);
                const float pv = valid ? __builtin_amdgcn_exp2f(s[r] * scl - mx) : 0.f;
                s[r] = pv; sum += pv;
            }
            float own[4], car[4];
#pragma unroll
            for (int g = 0; g < 4; ++g) { own[g] = s[4 * g] + s[4 * g + 1] + s[4 * g + 2] + 0.5f * s[4 * g + 3]; car[g] = 0.5f * s[4 * g + 3]; }
#pragma unroll
            for (int g = 0; g < 4; ++g) {
                const float send = hh ? (g ? car[g > 0 ? g - 1 : 0] : carprev) : car[g];
                own[g] += xor32f(send, lane);
            }
            carprev = car[3];
#pragma unroll
            for (int g = 0; g < 4; ++g) impP[(w * 32 + ql) * 33 + 2 * (4 * i + g) + hh] = own[g];
#pragma unroll
            for (int sp = 0; sp < 2; ++sp) {
                const int ks = 2 * i + sp, r0 = 8 * sp;
                uint4 pu;
                pu.x = pack2(s[r0 + 0], s[r0 + 1]); pu.y = pack2(s[r0 + 2], s[r0 + 3]);
                pu.z = pack2(s[r0 + 4], s[r0 + 5]); pu.w = pack2(s[r0 + 6], s[r0 + 7]);
                const bf16x8 pf = __builtin_bit_cast(bf16x8, pu);
#pragma unroll
                for (int dt = 0; dt < 2; ++dt) {
                    const bf16_t* vp = Vc + (dt * 32 + ql) * 132 + ks * 16 + 4 * hh;
                    const uint2 a0 = *(const uint2*)vp, a1 = *(const uint2*)(vp + 8);
                    ocmp[dt] = mfma32(__builtin_bit_cast(bf16x8, make_uint4(a0.x, a0.y, a1.x, a1.y)), pf, ocmp[dt]);
                }
            }
        }
        sum += xor32f(sum, lane);
        const float inv = sum > 0.f ? 1.f / sum : 0.f;
        invs[w * 32 + ql] = inv;
        const float f = g0 * inv;
#pragma unroll
        for (int dt = 0; dt < 2; ++dt)
#pragma unroll
            for (int r = 0; r < 8; ++r) ocp[dt * 8 + r] = pack2(f * ocmp[dt][2 * r], f * ocmp[dt][2 * r + 1]);
    }
    __syncthreads();
    const int qblk = t0 >> 6;
    {
        const int hw = tid >> 5, j = tid & 31;
#pragma unroll 1
        for (int rr = 0; rr < 4; ++rr) {
            const int row = hw * 4 + rr;
            const float v = impP[(0 * 32 + row) * 33 + j] * invs[row] + impP[(1 * 32 + row) * 33 + j] * invs[32 + row]
                          + impP[(2 * 32 + row) * 33 + j] * invs[64 + row] + impP[(3 * 32 + row) * 33 + j] * invs[96 + row];
            bool sel;
            if (qblk < 16) sel = (j <= qblk);
            else {
                const bool cand = (j >= 1) && (j <= qblk - 2);
                const bool forced = (j == 0) || (j == qblk) || (j == qblk - 1);
                int rank = 0;
                for (int j2 = 1; j2 <= qblk - 2; ++j2) {
                    const float v2 = lanef(v, (lane & 32) + j2);
                    rank += (v2 > v || (v2 == v && j2 < j)) ? 1 : 0;
                }
                sel = forced || (cand && rank < 13);
            }
            const unsigned long long bal = __ballot(sel);
            const unsigned mk = (lane & 32) ? (unsigned)(bal >> 32) : (unsigned)bal;
            if (j == 0) selm[row] = mk;
        }
    }
    __syncthreads();
    const unsigned mysel = selm[ql];
    unsigned U = mysel, Uall = mysel;
#pragma unroll
    for (int o = 16; o > 0; o >>= 1) { U |= (unsigned)__builtin_amdgcn_ds_bpermute((lane ^ o) << 2, (int)U); Uall &= (unsigned)__builtin_amdgcn_ds_bpermute((lane ^ o) << 2, (int)Uall); }
    Uall = (unsigned)__builtin_amdgcn_readfirstlane((int)Uall);
    {
        f32x16 o1[1][2]; o1[0][0] = zero16(); o1[0][1] = zero16();
        float m1[1] = {kNeg}, l1[1] = {0.f};
        auto skipf = [&](int) __attribute__((always_inline)) { return false; };
        attn_stream<64, 4, 1, false>(BitIter{U}, LdRow{cols + Tb * LDC + 384, LDC}, LdVT{VT + (size_t)(b * 12 + 0) * 64 * 2048}, MaskSel{mysel, Uall}, skipf, qf, o1, m1, l1, scl, tq, __builtin_amdgcn_readfirstlane(t0), smem, tid);
        const float lt = l1[0] + xor32f(l1[0], lane);
        const float f = g1 / lt;
#pragma unroll
        for (int dt = 0; dt < 2; ++dt)
#pragma unroll
            for (int r = 0; r < 8; ++r) ocp[dt * 8 + r] = pack2(lo16(ocp[dt * 8 + r]) + f * o1[0][dt][2 * r], hi16(ocp[dt * 8 + r]) + f * o1[0][dt][2 * r + 1]);
    }
    {
        f32x16 o1[1][2]; o1[0][0] = zero16(); o1[0][1] = zero16();
        float m1[1] = {kNeg}, l1[1] = {0.f};
        auto skipf = [&](int) __attribute__((always_inline)) { return false; };
        const int lo = t0 >= 511 ? ((t0 - 511) >> 6) : 0;
        attn_stream<64, 4, 1, false>(RangeIter{lo, qblk + 1}, LdRow{cols + Tb * LDC + 512, LDC}, LdVT{VT + (size_t)(b * 12 + 1) * 64 * 2048}, MaskWin<512>{}, skipf, qf, o1, m1, l1, scl, tq, __builtin_amdgcn_readfirstlane(t0), smem, tid);
        const float lt = l1[0] + xor32f(l1[0], lane);
        const float f = g2 / lt;
#pragma unroll
        for (int dt = 0; dt < 2; ++dt)
#pragma unroll
            for (int r = 0; r < 8; ++r) { o1[0][dt][2 * r] = lo16(ocp[dt * 8 + r]) + f * o1[0][dt][2 * r]; o1[0][dt][2 * r + 1] = hi16(ocp[dt * 8 + r]) + f * o1[0][dt][2 * r + 1]; }
        write_o(o1[0], obuf, Tb + tq, w * 64, hh);
    }
}

DEV void diff_item(const Params& p, int layer, int b, int hd, int qc, char* smem) {
    int tid = threadIdx.x; asm volatile("" : "+v"(tid));
    const int lane = tid & 63, w = tid >> 6, ql = lane & 31, hh = lane >> 5;
    const int sub = w & 1, qh = w >> 1;
    char* ws = p.ws;
    const bf16_t* cols = (const bf16_t*)(ws + OFF_COLS);
    const bf16_t* VT = (const bf16_t*)(ws + OFF_VT);
    bf16_t* obuf = (bf16_t*)(ws + OFF_O);
    const float* misc = (const float*)(ws + OFF_MISC);
    const int t0w = qc * 128 + qh * 64, tq = t0w + ql;
    const size_t Tb = (size_t)b * kS;
    bf16x8 qf[4];
#pragma unroll
    for (int g = 0; g < 2; ++g)
#pragma unroll
        for (int ks = 0; ks < 2; ++ks) qf[g * 2 + ks] = *(const bf16x8*)(cols + (Tb + tq + 32 * g) * LDC + 704 + hd * 64 + sub * 32 + ks * 16 + hh * 8);
    const float scl = 0.17677669529663687f * kLog2e;
    f32x16 o2[2][2];
#pragma unroll
    for (int g = 0; g < 2; ++g) { o2[g][0] = zero16(); o2[g][1] = zero16(); }
    float m2[2] = {kNeg, kNeg}, l2[2] = {0.f, 0.f};
    auto skipf = [&](int kt) __attribute__((always_inline)) { return kt * 64 > t0w + 63; };
    attn_stream<64, 2, 2, true>(RangeIter{0, 2 * qc + 2}, LdRow{cols + Tb * LDC + 960 + hd * 64, LDC}, LdVT{VT + (size_t)(b * 12 + 2 + hd) * 64 * 2048}, MaskCausal{}, skipf, qf, o2, m2, l2, scl, tq, __builtin_amdgcn_readfirstlane(t0w), smem, tid, sub * 32);
    const float lam = misc[256 + layer], post = misc[258 + layer];
    float* ex = (float*)smem;
    __syncthreads();
#pragma unroll
    for (int g = 0; g < 2; ++g) {
        const float lt = l2[g] + xor32f(l2[g], lane);
        if (sub == 1) {
            const float f = lam / lt;
#pragma unroll
            for (int dt = 0; dt < 2; ++dt)
#pragma unroll
                for (int r = 0; r < 16; ++r) ex[(((qh * 2 + g) * 2 + dt) * 16 + r) * 64 + lane] = o2[g][dt][r] * f;
        } else {
            const float f = 1.f / lt;
#pragma unroll
            for (int dt = 0; dt < 2; ++dt)
#pragma unroll
                for (int r = 0; r < 16; ++r) o2[g][dt][r] *= f;
        }
    }
    __syncthreads();
    if (sub == 0) {
        const float* sg = p.sub_g + layer * 64;
#pragma unroll
        for (int g = 0; g < 2; ++g) {
            float ss = 0.f;
#pragma unroll
            for (int dt = 0; dt < 2; ++dt)
#pragma unroll
                for (int r = 0; r < 16; ++r) { const float v = o2[g][dt][r] - ex[(((qh * 2 + g) * 2 + dt) * 16 + r) * 64 + lane]; o2[g][dt][r] = v; ss += v * v; }
            ss += xor32f(ss, lane);
            const float rstd = rsqrtf(ss * (1.f / 64.f) + kEps) * post;
#pragma unroll
            for (int dt = 0; dt < 2; ++dt)
#pragma unroll
                for (int r = 0; r < 16; ++r) { const int d = dt * 32 + (r & 3) + 8 * (r >> 2) + 4 * hh; o2[g][dt][r] *= rstd * sg[d]; }
            write_o(o2[g], obuf, Tb + tq + 32 * g, 256 + hd * 64, hh);
        }
    }
}

DEV void mla_item(const Params& p, int b, int hd, int qc, char* smem) {
    int tid = threadIdx.x; asm volatile("" : "+v"(tid));
    const int lane = tid & 63, w = tid >> 6, ql = lane & 31, hh = lane >> 5;
    char* ws = p.ws;
    const bf16_t* cols = (const bf16_t*)(ws + OFF_COLS);
    const bf16_t* VT = (const bf16_t*)(ws + OFF_VT);
    const bf16_t* qmla = (const bf16_t*)(ws + OFF_QMLA);
    const bf16_t* kvmla = (const bf16_t*)(ws + OFF_KVMLA);
    bf16_t* obuf = (bf16_t*)(ws + OFF_O);
    const int t0w = qc * 128 + w * 32, tq = t0w + ql;
    const size_t Tb = (size_t)b * kS;
    const bf16_t* qrow = qmla + (Tb + tq) * 384 + hd * 96;
    bf16x8 qf[6];
#pragma unroll
    for (int ks = 0; ks < 6; ++ks) qf[ks] = *(const bf16x8*)(qrow + ks * 16 + hh * 8);
    const float scl = 0.10206207261596575f * kLog2e;
    f32x16 o1[1][2]; o1[0][0] = zero16(); o1[0][1] = zero16();
    float m1[1] = {kNeg}, l1[1] = {0.f};
    auto skipf = [&](int kt) __attribute__((always_inline)) { return kt * 64 > t0w + 31; };
    attn_stream<96, 6, 1, false>(RangeIter{0, 2 * qc + 2}, LdMlaK{kvmla + Tb * 512 + hd * 128, cols + Tb * LDC + 1856}, LdVT{VT + (size_t)(b * 12 + 8 + hd) * 64 * 2048}, MaskCausal{}, skipf, qf, o1, m1, l1, scl, tq, __builtin_amdgcn_readfirstlane(t0w), smem, tid);
    const float inv = 1.f / (l1[0] + xor32f(l1[0], lane));
#pragma unroll
    for (int dt = 0; dt < 2; ++dt)
#pragma unroll
        for (int r = 0; r < 16; ++r) o1[0][dt][r] *= inv;
    write_o(o1[0], obuf, Tb + tq, 512 + hd * 64, hh);
}

DEV void swa_item(const Params& p, int layer, int b, int g, int q64, char* smem) {
    int tid = threadIdx.x; asm volatile("" : "+v"(tid));
    const int lane = tid & 63, w = tid >> 6, ql = lane & 31, hh = lane >> 5;
    char* ws = p.ws;
    const bf16_t* cols = (const bf16_t*)(ws + OFF_COLS);
    const bf16_t* VT = (const bf16_t*)(ws + OFF_VT);
    bf16_t* obuf = (bf16_t*)(ws + OFF_O);
    const int head = g * 2 + (w & 1);
    const int t0w = q64 * 64 + (w >> 1) * 32, tq = t0w + ql;
    const size_t Tb = (size_t)b * kS;
    const bf16_t* qrow = cols + (Tb + tq) * LDC + 1920 + head * 64;
    bf16x8 qf[4];
#pragma unroll
    for (int ks = 0; ks < 4; ++ks) qf[ks] = *(const bf16x8*)(qrow + ks * 16 + hh * 8);
    const float scl = 0.125f * kLog2e;
    f32x16 o1[1][2]; o1[0][0] = zero16(); o1[0][1] = zero16();
    float m1[1] = {p.sinks[layer * 4 + head] * 8.f}, l1[1] = {hh == 0 ? 1.f : 0.f};
    auto skipf = [&](int kt) __attribute__((always_inline)) { return (kt * 64 > t0w + 31) || (kt * 64 + 63 < t0w - 127); };
    const int lo = q64 >= 2 ? q64 - 2 : 0;
    attn_stream<64, 4, 1, false>(RangeIter{lo, q64 + 1}, LdRow{cols + Tb * LDC + 2176 + g * 64, LDC}, LdVT{VT + (size_t)(b * 12 + 6 + g) * 64 * 2048}, MaskWin<128>{}, skipf, qf, o1, m1, l1, scl, tq, __builtin_amdgcn_readfirstlane(t0w), smem, tid);
    const float inv = 1.f / (l1[0] + xor32f(l1[0], lane));
#pragma unroll
    for (int dt = 0; dt < 2; ++dt)
#pragma unroll
        for (int r = 0; r < 16; ++r) o1[0][dt][r] *= inv;
    write_o(o1[0], obuf, Tb + tq, 768 + head * 64, hh);
}

DEV void phase_attn(const Params& p, int layer, char* smem, int rep = 0) {
    unsigned* ctr = (unsigned*)(p.ws + OFF_CTRL) + 64 + layer * 16 + rep;
    volatile int* slot = (volatile int*)(smem + SM_SEL) + 48;
    for (;;) {
        __syncthreads();
        if (ltid() == 0) *slot = (int)atomicAdd(ctr, 1u);
        __syncthreads();
        const int idx = __builtin_amdgcn_readfirstlane(*slot);
        if (idx >= 2048) break;
        const int level = 15 - (idx >> 7), r = idx & 127;
#if TS_A >= 0
        const unsigned long long tsa = __builtin_amdgcn_s_memrealtime();
#endif
        if (r < 32) { diff_item(p, layer, r >> 2, r & 3, level, smem); }
        else if (r < 64) { const int k = r - 32; mla_item(p, k >> 2, k & 3, level, smem); }
        else if (r < 96) { const int k = r - 64; nsa_item(p, layer, k >> 2, level * 4 + (3 - (k & 3)), smem); }
        else { const int k = r - 96; swa_item(p, layer, k >> 2, (k >> 1) & 1, level * 2 + (k & 1), smem); }
#if TS_A >= 0
        if (threadIdx.x == 0 && layer == 1) {
            const int ty = r >> 5;
            unsigned long long* ts = (unsigned long long*)(p.ws + 32768);
            atomicAdd(&ts[60 + ty], (unsigned long long)(__builtin_amdgcn_s_memrealtime() - tsa));
        }
#endif
    }
}

#define XB_TMO      128
#define XB_XCNT(j)  (256  + 64 * (j))
#define XB_XSUB(j)  (1280 + 64 * (j))
#define XB_XGEN(j)  (2304 + 64 * (j))
#define XB_TOP      3328
#define XB_TOPGEN   3392
#define XB_SPIN_CAP (1u << 22)
DEV unsigned xb_ld(unsigned* p) { return __hip_atomic_load(p, __ATOMIC_RELAXED, __HIP_MEMORY_SCOPE_AGENT); }
DEV unsigned xb_add(unsigned* p, unsigned v) { return __hip_atomic_fetch_add(p, v, __ATOMIC_RELAXED, __HIP_MEMORY_SCOPE_AGENT); }
DEV unsigned xb_xcc_id() { return (unsigned)__builtin_amdgcn_s_getreg((3 << 11) | 20) & 0xFu; }
#define XB_SPIN(cond, bar) do { unsigned _sp = 0; while (cond) { __builtin_amdgcn_s_sleep(1); \
    if ((++_sp & 255u) == 0u) { if (xb_ld(&(bar)[XB_TMO])) break; if (_sp > XB_SPIN_CAP) { atomicAdd(&(bar)[XB_TMO], 1u); break; } } } } while (0)
struct XcdBarrier { unsigned* bar; unsigned x; volatile LAS unsigned* st; };
DEV XcdBarrier xcd_barrier_post(unsigned* bar, volatile LAS unsigned* st) {
    XcdBarrier b; b.bar = bar; b.x = xb_xcc_id(); b.st = st;
    if (threadIdx.x == 0) st[2] = xb_add(&bar[XB_XCNT(b.x)], 1u);
    return b;
}
DEV void xcd_barrier_complete(unsigned* bar, unsigned x, unsigned& nloc, unsigned& nx) {
    const unsigned G = gridDim.x * gridDim.y * gridDim.z;
    unsigned sum, cnt, mine, sp = 0u;
    for (;;) {
        sum = 0u; cnt = 0u; mine = 0u;
#pragma unroll
        for (unsigned j = 0; j < 16; ++j) { const unsigned c = xb_ld(&bar[XB_XCNT(j)]); sum += c; cnt += (c > 0u) ? 1u : 0u; mine = (j == x) ? c : mine; }
        if (sum == G) break;
        __builtin_amdgcn_s_sleep(1);
        if ((++sp & 255u) == 0u) { if (xb_ld(&bar[XB_TMO])) break; if (sp > XB_SPIN_CAP) { atomicAdd(&bar[XB_TMO], 1u); break; } }
    }
    nloc = mine > 0u ? mine : 1u; nx = cnt > 0u ? cnt : 1u;
}
DEV void xcd_barrier(const XcdBarrier& b) {
    asm volatile("s_waitcnt vmcnt(0)" ::: "memory");
    __syncthreads();
    if (threadIdx.x == 0) {
        unsigned* bar = b.bar;
        asm volatile("" : "+v"(bar));
        __builtin_amdgcn_s_waitcnt(0);
        unsigned nloc = b.st[0], nx = b.st[1];
        if (nloc == 0u) { xcd_barrier_complete(bar, b.x, nloc, nx); b.st[0] = nloc; b.st[1] = nx; }
        const unsigned old = xb_add(&bar[XB_XSUB(b.x)], 1u);
        const unsigned gen = old / nloc;
        if (old + 1u == (gen + 1u) * nloc) {
            __builtin_amdgcn_fence(__ATOMIC_RELEASE, "agent");
            asm volatile("s_waitcnt vmcnt(0)" ::: "memory");
            const unsigned og = xb_add(&bar[XB_TOP], 1u);
            const unsigned tg = og / nx;
            if (og + 1u == (tg + 1u) * nx) xb_add(&bar[XB_TOPGEN], 1u);
            else XB_SPIN(xb_ld(&bar[XB_TOPGEN]) == tg, bar);
            __builtin_amdgcn_fence(__ATOMIC_ACQUIRE, "agent");
            xb_add(&bar[XB_XGEN(b.x)], 1u);
            asm volatile("s_waitcnt vmcnt(0)" ::: "memory");
        } else {
            XB_SPIN(xb_ld(&bar[XB_XGEN(b.x)]) == gen, bar);
            __builtin_amdgcn_fence(__ATOMIC_ACQUIRE, "agent");
            asm volatile("s_waitcnt vmcnt(0)" ::: "memory");
        }
    }
    __syncthreads();
}

DEV unsigned fkey(float f) { const unsigned u = __float_as_uint(f); return (u & 0x80000000u) ? ~u : (u | 0x80000000u); }
DEV float funkey(unsigned k) { return __uint_as_float((k & 0x80000000u) ? (k & 0x7fffffffu) : ~k); }
DEV void ins16(unsigned (&L)[16], unsigned x) {
#pragma unroll
    for (int i = 15; i >= 1; --i) { unsigned r; asm("v_med3_u32 %0, %1, %2, %3" : "=v"(r) : "v"(L[i - 1]), "v"(L[i]), "v"(x)); L[i] = r; }
    L[0] = L[0] > x ? L[0] : x;
}
DEV void phase_topk(const Params& p, char* smem) {
    const int tid = ltid();
    const float* S1 = (const float*)(p.ws + OFF_S1);
    const float* S2 = (const float*)(p.ws + OFF_S2);
    int* eid = (int*)(p.ws + OFF_EID);
    float* gate = (float*)(p.ws + OFF_GATE);
    unsigned char* ib = (unsigned char*)smem + tid * 32;
    for (int blk = blockIdx.x; blk < kT * 8 / 256; blk += gridDim.x) {
        const size_t row = (size_t)blk * 256 + tid;
        unsigned L1[16], L2[16];
#pragma unroll
        for (int i = 0; i < 16; ++i) { L1[i] = 0u; L2[i] = 0u; }
#pragma unroll 4
        for (int k = 0; k < 128; ++k) {
            const float a = S1[(size_t)k * (kT * 8) + row], b = S2[(size_t)k * (kT * 8) + row];
            ins16(L1, (fkey(a) & ~127u) | (unsigned)(127 - k));
            ins16(L2, (fkey(b) & ~127u) | (unsigned)(127 - k));
        }
        float v1[16], v2[16];
        __syncthreads();
#pragma unroll
        for (int i = 0; i < 16; ++i) {
            v1[i] = funkey(L1[i] & ~127u); v2[i] = funkey(L2[i] & ~127u);
            ib[i] = (unsigned char)(127u - (L1[i] & 127u)); ib[16 + i] = (unsigned char)(127u - (L2[i] & 127u));
        }
        unsigned C[16];
#pragma unroll
        for (int i = 0; i < 16; ++i) C[i] = 0u;
#pragma unroll
        for (int a = 0; a < 16; ++a)
#pragma unroll
            for (int b = 0; b < 16; ++b)
                if ((a + 1) * (b + 1) <= 16) ins16(C, (fkey(v1[a] + v2[b]) & ~255u) | (unsigned)(255 - (a * 16 + b)));
        float ts[16]; float sum = 0.f;
        const float tmax = funkey(C[0] & ~255u);
#pragma unroll
        for (int i = 0; i < 16; ++i) { ts[i] = __expf(funkey(C[i] & ~255u) - tmax); sum += ts[i]; }
        const float inv = 1.f / sum;
        int ev[16];
#pragma unroll
        for (int i = 0; i < 16; ++i) { const unsigned ci = 255u - (C[i] & 255u); ev[i] = (int)ib[ci >> 4] * 128 + (int)ib[16 + (ci & 15u)]; }
#pragma unroll
        for (int i = 0; i < 4; ++i) {
            *(int4*)(eid + row * 16 + 4 * i) = make_int4(ev[4 * i], ev[4 * i + 1], ev[4 * i + 2], ev[4 * i + 3]);
            *(float4*)(gate + row * 16 + 4 * i) = make_float4(ts[4 * i] * inv, ts[4 * i + 1] * inv, ts[4 * i + 2] * inv, ts[4 * i + 3] * inv);
        }
    }
}

struct EpiTop16 {
    unsigned (&L)[16];
    DEV void tile(int, int, const float* Cs, int tid) const {
        const int r = tid & 127, hk = tid >> 7;
        unsigned T[16];
#pragma unroll
        for (int i = 0; i < 16; ++i) T[i] = 0u;
#pragma unroll 4
        for (int k = 0; k < 64; ++k) {
            const int key = hk * 64 + k;
            ins16(T, (fkey(Cs[key * 128 + r]) & ~127u) | (unsigned)(127 - key));
        }
        __syncthreads();
        unsigned* X = (unsigned*)Cs;
        if (hk) {
#pragma unroll
            for (int i = 0; i < 16; ++i) X[r * 17 + i] = T[i];
        }
        __syncthreads();
        if (!hk) {
#pragma unroll
            for (int i = 0; i < 16; ++i) ins16(T, X[r * 17 + i]);
        }
#pragma unroll
        for (int i = 0; i < 16; ++i) L[i] = T[i];
    }
};
DEV void phase_route(const Params& p, int layer, char* smem) {
    char* ws = p.ws;
    int* eid = (int*)(ws + OFF_EID);
    float* gate = (float*)(ws + OFF_GATE);
    const bf16_t* qp = (const bf16_t*)(ws + OFF_QP);
    const bf16_t* subk = (const bf16_t*)(ws + OFF_SUBK) + (size_t)(layer * 2) * 16384;
    for (int nt = blockIdx.x; nt < kT * 8 / 128; nt += gridDim.x) {
        unsigned L1[16], L2[16];
        { EpiTop16 e1{L1}; gemm_tile(subk, 128, qp, 256, 128, 0, nt * 128, smem, e1); }
        { EpiTop16 e2{L2}; gemm_tile(subk + 16384, 128, qp + 128, 256, 128, 0, nt * 128, smem, e2); }
        const int tid = ltid();
        __syncthreads();
        if (tid < 128) {
            const size_t row = (size_t)nt * 128 + tid;
            unsigned char* ib = (unsigned char*)smem + tid * 32;
            float v1[16], v2[16];
#pragma unroll
            for (int i = 0; i < 16; ++i) {
                v1[i] = funkey(L1[i] & ~127u); v2[i] = funkey(L2[i] & ~127u);
                ib[i] = (unsigned char)(127u - (L1[i] & 127u)); ib[16 + i] = (unsigned char)(127u - (L2[i] & 127u));
            }
            unsigned C[16];
#pragma unroll
            for (int i = 0; i < 16; ++i) C[i] = 0u;
#pragma unroll
            for (int a = 0; a < 16; ++a)
#pragma unroll
                for (int b = 0; b < 16; ++b)
                    if ((a + 1) * (b + 1) <= 16) ins16(C, (fkey(v1[a] + v2[b]) & ~255u) | (unsigned)(255 - (a * 16 + b)));
            float ts[16]; float sum = 0.f;
            const float tmax = funkey(C[0] & ~255u);
#pragma unroll
            for (int i = 0; i < 16; ++i) { ts[i] = __expf(funkey(C[i] & ~255u) - tmax); sum += ts[i]; }
            const float inv = 1.f / sum;
            int ev[16];
#pragma unroll
            for (int i = 0; i < 16; ++i) { const unsigned ci = 255u - (C[i] & 255u); ev[i] = (int)ib[ci >> 4] * 128 + (int)ib[16 + (ci & 15u)]; }
#pragma unroll
            for (int i = 0; i < 4; ++i) {
                *(int4*)(eid + row * 16 + 4 * i) = make_int4(ev[4 * i], ev[4 * i + 1], ev[4 * i + 2], ev[4 * i + 3]);
                *(float4*)(gate + row * 16 + 4 * i) = make_float4(ts[4 * i] * inv, ts[4 * i + 1] * inv, ts[4 * i + 2] * inv, ts[4 * i + 3] * inv);
            }
        }
    }
}

DEV float row_sum_dpp(float v) {
    v += __int_as_float(__builtin_amdgcn_update_dpp(0, __float_as_int(v), 0xB1, 0xF, 0xF, true));
    v += __int_as_float(__builtin_amdgcn_update_dpp(0, __float_as_int(v), 0x4E, 0xF, 0xF, true));
    v += __int_as_float(__builtin_amdgcn_update_dpp(0, __float_as_int(v), 0x141, 0xF, 0xF, true));
    v += __int_as_float(__builtin_amdgcn_update_dpp(0, __float_as_int(v), 0x140, 0xF, 0xF, true));
    return v;
}
DEV float wave_sum_dpp(float v) {
    v = row_sum_dpp(v);
    const float r0 = __int_as_float(__builtin_amdgcn_readlane(__float_as_int(v), 0)), r1 = __int_as_float(__builtin_amdgcn_readlane(__float_as_int(v), 16));
    const float r2 = __int_as_float(__builtin_amdgcn_readlane(__float_as_int(v), 32)), r3 = __int_as_float(__builtin_amdgcn_readlane(__float_as_int(v), 48));
    return (r0 + r1) + (r2 + r3);
}
typedef float f32x2 __attribute__((ext_vector_type(2)));
typedef float f32x4 __attribute__((ext_vector_type(4)));

DEV SliceMap slice_map(const Params& p, char* smem) {
    unsigned* bar = (unsigned*)p.ws;
    const unsigned x = xb_xcc_id();
    int virt = 0, nx = 0, nloc = 1;
#pragma unroll
    for (unsigned j = 0; j < 16; ++j) {
        const unsigned c = xb_ld(&bar[XB_XCNT(j)]);
        if (c > 0u) { if (j < x) ++virt; ++nx; }
        if (j == x) nloc = (int)c;
    }
    SliceMap m;
    m.virt = __builtin_amdgcn_readfirstlane(virt); m.nx = __builtin_amdgcn_readfirstlane(nx > 0 ? nx : 1); m.nloc = __builtin_amdgcn_readfirstlane(nloc > 0 ? nloc : 1);
    m.rank = __builtin_amdgcn_readfirstlane((int)((volatile LAS unsigned*)(smem + SM_CTRL))[2]);
    return m;
}

typedef _Float16 half2_t __attribute__((ext_vector_type(2)));
DEV void phase_peer_u(const Params& p, int layer, char* smem, int rep = 0) {
    const int tid = ltid(), lane = tid & 63, w = tid >> 6, l8 = lane & 7, grp = lane >> 3;
    char* ws = p.ws;
    const SliceMap sm = slice_map(p, smem);
    const bf16_t* h = (const bf16_t*)(ws + OFF_H);
    const int* eid = (const int*)(ws + OFF_EID);
    _Float16* part = (_Float16*)(ws + OFF_S1) + (rep ? (size_t)8 * kT * 128 : 0);
    int* ids_l = (int*)(smem + w * 9216);
    const int nk = sm.rank < 512 ? (512 - sm.rank + sm.nloc - 1) / sm.nloc : 0;
    for (int s = sm.virt; s < 8; s += sm.nx) {
        if (nk == 0) break;
        const unsigned char* U = (const unsigned char*)(ws + OFF_PU) + (((size_t)layer * 8 + s) * 16384 << 7) + l8 * 16;
        uint4 ri0, ri1, ri2, ri3, rh0, rh1;
        auto load_oct = [&](int k) __attribute__((always_inline)) {
            const size_t o = (size_t)(sm.rank + k * sm.nloc) * 4 + w;
            const uint4* ip = (const uint4*)(eid + o * 1024) + lane;
            ri0 = ip[0]; ri1 = ip[64]; ri2 = ip[128]; ri3 = ip[192];
            const bf16_t* hp = h + (o * 8 + grp) * 1024 + s * 128 + l8 * 16;
            rh0 = *(const uint4*)hp; rh1 = *(const uint4*)(hp + 8);
        };
        half2_t hh[8];
        auto store_oct = [&]() __attribute__((always_inline)) {
            uint4* il = (uint4*)ids_l + lane;
            il[0] = ri0; il[64] = ri1; il[128] = ri2; il[192] = ri3;
            const unsigned hu[8] = {rh0.x, rh0.y, rh0.z, rh0.w, rh1.x, rh1.y, rh1.z, rh1.w};
#pragma unroll
            for (int i = 0; i < 8; ++i) hh[i] = (half2_t){(_Float16)lo16(hu[i]), (_Float16)hi16(hu[i])};
        };
        load_oct(0); store_oct();
#pragma unroll 1
        for (int k = 0; k < nk; ++k) {
            if (k + 1 < nk) load_oct(k + 1);
            const size_t o = (size_t)(sm.rank + k * sm.nloc) * 4 + w;
            _Float16* pp = part + ((size_t)s * kT + o * 8 + grp) * 128 + l8;
            uint4 va[8], vb[8];
            auto issue = [&](uint4 (&v)[8], int c) __attribute__((always_inline)) {
                const int4 i0 = *(const int4*)(ids_l + grp * 128 + c * 8), i1 = *(const int4*)(ids_l + grp * 128 + c * 8 + 4);
                const int e[8] = {i0.x, i0.y, i0.z, i0.w, i1.x, i1.y, i1.z, i1.w};
#pragma unroll
                for (int j = 0; j < 8; ++j) v[j] = *(const uint4*)(U + ((size_t)e[j] << 7));
            };
            auto compute = [&](const uint4 (&v)[8], int c) __attribute__((always_inline)) {
                float res = 0.f;
#pragma unroll
                for (int j = 0; j < 8; ++j) {
                    const unsigned d[4] = {v[j].x, v[j].y, v[j].z, v[j].w};
                    float acc = 0.f;
#pragma unroll
                    for (int q = 0; q < 4; ++q) {
                        const half2_t lo = __builtin_amdgcn_cvt_scalef32_pk_f16_fp8(d[q], 1.0f, false);
                        const half2_t hi = __builtin_amdgcn_cvt_scalef32_pk_f16_fp8(d[q], 1.0f, true);
                        acc = __builtin_amdgcn_fdot2(lo, hh[2 * q], acc, false);
                        acc = __builtin_amdgcn_fdot2(hi, hh[2 * q + 1], acc, false);
                    }
                    acc += __int_as_float(__builtin_amdgcn_update_dpp(0, __float_as_int(acc), 0xB1, 0xF, 0xF, true));
                    acc += __int_as_float(__builtin_amdgcn_update_dpp(0, __float_as_int(acc), 0x4E, 0xF, 0xF, true));
                    acc += __int_as_float(__builtin_amdgcn_update_dpp(0, __float_as_int(acc), 0x141, 0xF, 0xF, true));
                    res = (l8 == j) ? acc : res;
                    __builtin_amdgcn_sched_barrier(0);
                }
                pp[c * 8] = (_Float16)res;
            };
            issue(va, 0);
#pragma unroll
            for (int c = 0; c < 16; c += 2) {
                issue(vb, c + 1);
                __builtin_amdgcn_sched_barrier(0);
                compute(va, c);
                __builtin_amdgcn_sched_barrier(0);
                if (c + 2 < 16) issue(va, c + 2);
                __builtin_amdgcn_sched_barrier(0);
                compute(vb, c + 1);
                __builtin_amdgcn_sched_barrier(0);
            }
            if (k + 1 < nk) store_oct();
        }
    }
}

DEV void phase_peer_comb(const Params& p, int rep = 0) {
    const int tid = ltid();
    const _Float16* part = (const _Float16*)(p.ws + OFF_S1);
    float* gate = (float*)(p.ws + OFF_GATE);
    for (size_t i = (size_t)blockIdx.x * 256 + tid; i < (size_t)kT * 128 / 8; i += (size_t)gridDim.x * 256) {
        float a[8];
#pragma unroll
        for (int j = 0; j < 8; ++j) a[j] = 0.f;
#pragma unroll
        for (int x = 0; x < 8; ++x) {
            const uint4 u = *(const uint4*)(part + (size_t)x * kT * 128 + i * 8);
            const unsigned d[4] = {u.x, u.y, u.z, u.w};
#pragma unroll
            for (int j = 0; j < 4; ++j) { const half2_t hv = __builtin_bit_cast(half2_t, d[j]); a[2 * j] += (float)hv.x; a[2 * j + 1] += (float)hv.y; }
        }
        const float4 g0 = *(const float4*)(gate + i * 8), g1 = *(const float4*)(gate + i * 8 + 4);
        float4 o0, o1;
        o0.x = g0.x * gelu_tanh(a[0] * (1.f / kScaleU)); o0.y = g0.y * gelu_tanh(a[1] * (1.f / kScaleU));
        o0.z = g0.z * gelu_tanh(a[2] * (1.f / kScaleU)); o0.w = g0.w * gelu_tanh(a[3] * (1.f / kScaleU));
        o1.x = g1.x * gelu_tanh(a[4] * (1.f / kScaleU)); o1.y = g1.y * gelu_tanh(a[5] * (1.f / kScaleU));
        o1.z = g1.z * gelu_tanh(a[6] * (1.f / kScaleU)); o1.w = g1.w * gelu_tanh(a[7] * (1.f / kScaleU));
        if (rep == 0) { *(float4*)(gate + i * 8) = o0; *(float4*)(gate + i * 8 + 4) = o1; }
    }
}

DEV void phase_peer_v(const Params& p, int layer, char* smem, int rep = 0) {
    const int tid = ltid(), lane = tid & 63, w = tid >> 6, l8 = lane & 7, grp = lane >> 3;
    char* ws = p.ws;
    const SliceMap sm = slice_map(p, smem);
    bf16_t* xres = (bf16_t*)(ws + OFF_XRES);
    const int* eid = (const int*)(ws + OFF_EID);
    const float* wbuf = (const float*)(ws + OFF_GATE);
    const float* mod = (const float*)(ws + OFF_MOD);
    int* ids_l = (int*)(smem + w * 9216);
    float* w_l = (float*)(smem + w * 9216 + 4096);
    const int nk = sm.rank < 512 ? (512 - sm.rank + sm.nloc - 1) / sm.nloc : 0;
    for (int s = sm.virt; s < 8; s += sm.nx) {
        if (nk == 0) break;
        const unsigned char* V = (const unsigned char*)(ws + OFF_PV) + (((size_t)layer * 8 + s) * 16384 << 7) + l8 * 16;
        uint4 ri0, ri1, ri2, ri3, rw0, rw1, rw2, rw3;
        auto load_oct = [&](int k) __attribute__((always_inline)) {
            const size_t o = (size_t)(sm.rank + k * sm.nloc) * 4 + w;
            const uint4* ip = (const uint4*)(eid + o * 1024) + lane;
            const uint4* wp = (const uint4*)(wbuf + o * 1024) + lane;
            ri0 = ip[0]; ri1 = ip[64]; ri2 = ip[128]; ri3 = ip[192];
            rw0 = wp[0]; rw1 = wp[64]; rw2 = wp[128]; rw3 = wp[192];
        };
        auto store_oct = [&]() __attribute__((always_inline)) {
            uint4* il = (uint4*)ids_l + lane; uint4* wl = (uint4*)w_l + lane;
            il[0] = ri0; il[64] = ri1; il[128] = ri2; il[192] = ri3;
            wl[0] = rw0; wl[64] = rw1; wl[128] = rw2; wl[192] = rw3;
        };
        load_oct(0); store_oct();
#pragma unroll 1
        for (int k = 0; k < nk; ++k) {
            if (k + 1 < nk) load_oct(k + 1);
            const size_t o = (size_t)(sm.rank + k * sm.nloc) * 4 + w;
            const size_t t = o * 8 + grp;
            const int b = (int)(t >> 11);
            bf16_t* xp = xres + t * 1024 + s * 128 + l8 * 16;
            const float* g2 = mod + (size_t)(layer * 8 + b) * 6144 + 5120 + s * 128 + l8 * 16;
            float4 xa[4];
            { const uint4 u0 = *(const uint4*)xp, u1 = *(const uint4*)(xp + 8);
              xa[0] = make_float4(lo16(u0.x), hi16(u0.x), lo16(u0.y), hi16(u0.y)); xa[1] = make_float4(lo16(u0.z), hi16(u0.z), lo16(u0.w), hi16(u0.w));
              xa[2] = make_float4(lo16(u1.x), hi16(u1.x), lo16(u1.y), hi16(u1.y)); xa[3] = make_float4(lo16(u1.z), hi16(u1.z), lo16(u1.w), hi16(u1.w)); }
            half2_t out[8];
#pragma unroll
            for (int j = 0; j < 8; ++j) out[j] = (half2_t){(_Float16)0.f, (_Float16)0.f};
            uint4 va[8], vb[8];
            auto issue = [&](uint4 (&v)[8], int c) __attribute__((always_inline)) {
                const int4 i0 = *(const int4*)(ids_l + grp * 128 + c * 8), i1 = *(const int4*)(ids_l + grp * 128 + c * 8 + 4);
                const int e[8] = {i0.x, i0.y, i0.z, i0.w, i1.x, i1.y, i1.z, i1.w};
#pragma unroll
                for (int j = 0; j < 8; ++j) v[j] = *(const uint4*)(V + ((size_t)e[j] << 7));
            };
            auto compute = [&](const uint4 (&v)[8], int c) __attribute__((always_inline)) {
                const float4 w0 = *(const float4*)(w_l + grp * 128 + c * 8), w1 = *(const float4*)(w_l + grp * 128 + c * 8 + 4);
                const float wf[8] = {w0.x, w0.y, w0.z, w0.w, w1.x, w1.y, w1.z, w1.w};
#pragma unroll
                for (int j = 0; j < 8; ++j) {
                    const _Float16 wh = (_Float16)wf[j];
                    const half2_t ww = {wh, wh};
                    const unsigned d[4] = {v[j].x, v[j].y, v[j].z, v[j].w};
#pragma unroll
                    for (int q = 0; q < 4; ++q) {
                        const half2_t lo = __builtin_amdgcn_cvt_scalef32_pk_f16_fp8(d[q], 1.0f, false);
                        const half2_t hi = __builtin_amdgcn_cvt_scalef32_pk_f16_fp8(d[q], 1.0f, true);
                        out[2 * q] = __builtin_elementwise_fma(ww, lo, out[2 * q]);
                        out[2 * q + 1] = __builtin_elementwise_fma(ww, hi, out[2 * q + 1]);
                    }
                    __builtin_amdgcn_sched_barrier(0);
                }
            };
            issue(va, 0);
#pragma unroll
            for (int c = 0; c < 16; c += 2) {
                issue(vb, c + 1);
                __builtin_amdgcn_sched_barrier(0);
                compute(va, c);
                __builtin_amdgcn_sched_barrier(0);
                if (c + 2 < 16) issue(va, c + 2);
                __builtin_amdgcn_sched_barrier(0);
                compute(vb, c + 1);
                __builtin_amdgcn_sched_barrier(0);
            }
            if (rep == 0 || (float)out[0].x == 12345.678f) {
#pragma unroll
                for (int c = 0; c < 4; ++c) {
                    const float4 g4 = *(const float4*)(g2 + c * 4);
                    xa[c].x += g4.x * (float)out[2 * c].x * (1.f / kScaleV); xa[c].y += g4.y * (float)out[2 * c].y * (1.f / kScaleV);
                    xa[c].z += g4.z * (float)out[2 * c + 1].x * (1.f / kScaleV); xa[c].w += g4.w * (float)out[2 * c + 1].y * (1.f / kScaleV);
                }
                *(uint4*)xp = make_uint4(pack2(xa[0].x, xa[0].y), pack2(xa[0].z, xa[0].w), pack2(xa[1].x, xa[1].y), pack2(xa[1].z, xa[1].w));
                *(uint4*)(xp + 8) = make_uint4(pack2(xa[2].x, xa[2].y), pack2(xa[2].z, xa[2].w), pack2(xa[3].x, xa[3].y), pack2(xa[3].z, xa[3].w));
            }
            if (k + 1 < nk) store_oct();
        }
    }
}

DEV void phase_final(const Params& p) {
    const int tid = ltid(), lane = tid & 63, w = tid >> 6;
    const bf16_t* xs = (const bf16_t*)(p.ws + OFF_XRES);
    float4 g4[4];
#pragma unroll
    for (int i = 0; i < 4; ++i) g4[i] = *(const float4*)(p.final_g + i * 256 + lane * 4);
    for (int q0 = blockIdx.x; q0 < kT / 4; q0 += gridDim.x * 4) {
        float4 v[4][4];
#pragma unroll
        for (int u = 0; u < 4; ++u) {
            const int q = q0 + u * gridDim.x < kT / 4 ? q0 + u * gridDim.x : q0;
            const bf16_t* xr = xs + (size_t)(q * 4 + w) * 1024;
#pragma unroll
            for (int i = 0; i < 4; ++i) { const uint2 uu = *(const uint2*)(xr + i * 256 + lane * 4); v[u][i] = make_float4(lo16(uu.x), hi16(uu.x), lo16(uu.y), hi16(uu.y)); }
        }
#pragma unroll
        for (int u = 0; u < 4; ++u) {
            const int q = q0 + u * gridDim.x;
            if (q >= kT / 4) break;
            const int t = q * 4 + w;
            float ss = 0.f;
#pragma unroll
            for (int i = 0; i < 4; ++i) ss += v[u][i].x * v[u][i].x + v[u][i].y * v[u][i].y + v[u][i].z * v[u][i].z + v[u][i].w * v[u][i].w;
            ss = wave_sum(ss);
            const float rstd = rsqrtf(ss * (1.f / 1024.f) + kEps);
#pragma unroll
            for (int i = 0; i < 4; ++i) {
                const int col = i * 256 + lane * 4;
                *(float4*)(p.out + (size_t)t * 1024 + col) = make_float4(v[u][i].x * rstd * g4[i].x, v[u][i].y * rstd * g4[i].y, v[u][i].z * rstd * g4[i].z, v[u][i].w * rstd * g4[i].w);
            }
        }
    }
}

DEV uint4 pack8f(const float (&e)[8]) { return make_uint4(pack2(e[0], e[1]), pack2(e[2], e[3]), pack2(e[4], e[5]), pack2(e[6], e[7])); }
DEV float4 rope4(float4 v, float4 o, bool low, float4 c, float4 sn) {
    float4 r;
    r.x = v.x * c.x + (low ? -o.x : o.x) * sn.x; r.y = v.y * c.y + (low ? -o.y : o.y) * sn.y;
    r.z = v.z * c.z + (low ? -o.z : o.z) * sn.z; r.w = v.w * c.w + (low ? -o.w : o.w) * sn.w;
    return r;
}
struct EpiIn {
    char* ws;
    DEV void tile(int m0, int n0, const float* Cs, int tid) const {
        const int lane = tid & 63, w = tid >> 6, g16 = lane >> 4, c4 = lane & 15;
        bf16_t* cols = (bf16_t*)(ws + OFF_COLS);
        bf16_t* VT = (bf16_t*)(ws + OFF_VT);
        const float* rope = (const float*)(ws + OFF_ROPE);
        const float *cos64 = rope, *sin64 = rope + 2048 * 32, *cos32 = rope + 2048 * 64, *sin32 = rope + 2048 * 64 + 2048 * 16;
        const int b = m0 >> 11, s0 = m0 & 2047;
#pragma unroll 1
        for (int h = 0; h < 2; ++h) {
            const int cb = n0 + 64 * h;
            int vh = -1;
            if (cb == 448) vh = 0; else if (cb == 576) vh = 1; else if (cb >= 1216 && cb < 1472) vh = 2 + ((cb - 1216) >> 6); else if (cb >= 2304) vh = 6 + ((cb - 2304) >> 6);
            if (vh >= 0) {
                bf16_t* dst = VT + ((size_t)(b * 12 + vh) * 64 + lane) * 2048 + s0;
#pragma unroll
                for (int q = 0; q < 4; ++q) {
                    const int tc = w + 4 * q;
                    float e[8];
#pragma unroll
                    for (int j = 0; j < 8; ++j) e[j] = Cs[(tc * 8 + j) * 128 + h * 64 + lane];
                    *(uint4*)(dst + tc * 8) = pack8f(e);
                }
                continue;
            }
            const bool r64 = cb < 320 || cb == 384 || cb == 512 || (cb >= 1920 && cb < 2304);
            const bool r32 = (cb >= 704 && cb < 1216) || cb == 1856;
            bf16_t* dbase; int dld;
            if (cb == 256) { dbase = (bf16_t*)(ws + OFF_KC); dld = 64; } else if (cb == 320) { dbase = (bf16_t*)(ws + OFF_VC); dld = 64; } else { dbase = cols + cb; dld = LDC; }
            float4 cc[8], sn[8];
            if (r64 || r32) {
                const int i = (c4 * 4) & (r64 ? 31 : 15);
#pragma unroll
                for (int it = 0; it < 8; ++it) {
                    const int sq = s0 + it * 16 + w * 4 + g16;
                    cc[it] = *(const float4*)((r64 ? cos64 + sq * 32 : cos32 + sq * 16) + i);
                    sn[it] = *(const float4*)((r64 ? sin64 + sq * 32 : sin32 + sq * 16) + i);
                }
            }
#pragma unroll
            for (int it = 0; it < 8; ++it) {
                const int r = it * 16 + w * 4 + g16;
                float4 v = *(const float4*)(Cs + r * 128 + h * 64 + c4 * 4);
                if (r64 || r32) {
                    const float4 o = *(const float4*)(Cs + r * 128 + h * 64 + ((c4 * 4) ^ (r64 ? 32 : 16)));
                    v = rope4(v, o, !(c4 & (r64 ? 8 : 4)), cc[it], sn[it]);
                }
                *(uint2*)(dbase + (size_t)(m0 + r) * dld + c4 * 4) = make_uint2(pack2(v.x, v.y), pack2(v.z, v.w));
            }
        }
    }
};
DEV void mla_rstd_tile(const bf16_t* src  , int ncols, float* rsl, int tid) {
    const int lane = tid & 63, w = tid >> 6, g16 = lane >> 4, c4 = lane & 15;
#pragma unroll 2
    for (int it = 0; it < 8; ++it) {
        const int r = it * 16 + w * 4 + g16;
        const bf16_t* rp = src + (size_t)r * LDC + c4 * (ncols >> 4);
        float ss = 0.f;
        const uint4 u = *(const uint4*)rp;
        ss += lo16(u.x) * lo16(u.x) + hi16(u.x) * hi16(u.x) + lo16(u.y) * lo16(u.y) + hi16(u.y) * hi16(u.y)
            + lo16(u.z) * lo16(u.z) + hi16(u.z) * hi16(u.z) + lo16(u.w) * lo16(u.w) + hi16(u.w) * hi16(u.w);
        if (ncols == 256) {
            const uint4 u2 = *(const uint4*)(rp + 8);
            ss += lo16(u2.x) * lo16(u2.x) + hi16(u2.x) * hi16(u2.x) + lo16(u2.y) * lo16(u2.y) + hi16(u2.y) * hi16(u2.y)
                + lo16(u2.z) * lo16(u2.z) + hi16(u2.z) * hi16(u2.z) + lo16(u2.w) * lo16(u2.w) + hi16(u2.w) * hi16(u2.w);
        }
        ss = row_sum_dpp(ss);
        if (c4 == 0) rsl[r] = rsqrtf(ss / (float)ncols + kEps);
    }
}
struct EpiMlaQ {
    char* ws; const float* rsl;
    DEV void tile(int m0, int n0, const float* Cs, int tid) const {
        const int lane = tid & 63, w = tid >> 6, g16 = lane >> 4, c4 = lane & 15;
        bf16_t* qmla = (bf16_t*)(ws + OFF_QMLA);
        const float* rope = (const float*)(ws + OFF_ROPE);
        const float *cos32 = rope + 2048 * 64, *sin32 = rope + 2048 * 64 + 2048 * 16;
        const int s0 = m0 & 2047;
#pragma unroll 1
        for (int h = 0; h < 2; ++h) {
            const int col = n0 + 64 * h + c4 * 4;
            const bool isrope = ((col >> 5) % 3) == 2;
            float4 cc[8], sn[8];
#pragma unroll
            for (int it = 0; it < 8; ++it) {
                const int sq = s0 + it * 16 + w * 4 + g16, i = (c4 * 4) & 15;
                cc[it] = *(const float4*)(cos32 + sq * 16 + i); sn[it] = *(const float4*)(sin32 + sq * 16 + i);
            }
#pragma unroll
            for (int it = 0; it < 8; ++it) {
                const int r = it * 16 + w * 4 + g16;
                float4 v = *(const float4*)(Cs + r * 128 + h * 64 + c4 * 4);
                const float sc = rsl[r];
                v.x *= sc; v.y *= sc; v.z *= sc; v.w *= sc;
                float4 o = *(const float4*)(Cs + r * 128 + h * 64 + ((c4 * 4) ^ 16));
                o.x *= sc; o.y *= sc; o.z *= sc; o.w *= sc;
                const float4 vr = rope4(v, o, !(c4 & 4), cc[it], sn[it]);
                if (isrope) v = vr;
                *(uint2*)(qmla + (size_t)(m0 + r) * 384 + col) = make_uint2(pack2(v.x, v.y), pack2(v.z, v.w));
            }
        }
    }
};
struct EpiMlaKV {
    char* ws; const float* rsl;
    DEV void tile(int m0, int n0, const float* Cs, int tid) const {
        const int lane = tid & 63, w = tid >> 6, g16 = lane >> 4, c4 = lane & 15;
        bf16_t* kvmla = (bf16_t*)(ws + OFF_KVMLA);
        bf16_t* VT = (bf16_t*)(ws + OFF_VT);
        const int b = m0 >> 11, s0 = m0 & 2047, hd = n0 >> 7;
#pragma unroll 2
        for (int it = 0; it < 8; ++it) {
            const int r = it * 16 + w * 4 + g16;
            float4 v = *(const float4*)(Cs + r * 128 + c4 * 4);
            const float sc = rsl[r];
            *(uint2*)(kvmla + (size_t)(m0 + r) * 512 + n0 + c4 * 4) = make_uint2(pack2(v.x * sc, v.y * sc), pack2(v.z * sc, v.w * sc));
        }
        bf16_t* dst = VT + ((size_t)(b * 12 + 8 + hd) * 64 + lane) * 2048 + s0;
#pragma unroll
        for (int q = 0; q < 4; ++q) {
            const int tc = w + 4 * q;
            float e[8];
#pragma unroll
            for (int j = 0; j < 8; ++j) e[j] = Cs[(tc * 8 + j) * 128 + 64 + lane] * rsl[tc * 8 + j];
            *(uint4*)(dst + tc * 8) = pack8f(e);
        }
    }
};

DEV void phase_gemm_in(const Params& p, int layer, char* smem) {
    char* ws = p.ws;
    EpiIn epi{ws};
    gemm_phase(p, (const bf16_t*)(ws + OFF_H), 1024, (const bf16_t*)(ws + OFF_WIN) + (size_t)layer * 2432 * 1024, 1024, 1024, kT / 128, LDC / 128, smem, epi);
}
DEV void phase_gemm_mid(const Params& p, int layer, char* smem) {
    char* ws = p.ws;
    const float* misc = (const float*)(ws + OFF_MISC);
    const bf16_t* cols = (const bf16_t*)(ws + OFF_COLS);
    float* rsl = (float*)(smem + SM_CTRL + 256);
    const int nb_up = (int)gridDim.x > 32 ? (int)gridDim.x - 16 : (int)gridDim.x;
    for (int tile = ((int)gridDim.x > 32 && blockIdx.x >= 16) ? (int)blockIdx.x : (int)blockIdx.x; tile < 16 + 384 + 512;
         tile = (tile < 16 && (int)gridDim.x > 32) ? 16 + 384 + 512 : tile + nb_up) {
        if (tile < 16) {
            const int kv = tile >> 3, mt = tile & 7;
            EpiF32 epi{(float*)(ws + OFF_QP) + (size_t)kv * 1024 * 128, 128};
            gemm_tile((const bf16_t*)(ws + (kv ? OFF_VC : OFF_KC)), 1024, (const bf16_t*)(ws + (kv ? OFF_WCV : OFF_WCK)) + (size_t)layer * 128 * 2048, 1024, 1024, mt * 128, 0, smem, epi);
        } else if (tile < 16 + 384) {
            const int tt = tile - 16, m0 = (tt / 3) * 128;
            __syncthreads();
            mla_rstd_tile(cols + (size_t)m0 * LDC + 1472, 256, rsl, ltid());
            EpiMlaQ epi{ws, rsl};
            gemm_tile(cols + 1472, LDC, (const bf16_t*)(ws + OFF_WUQ) + (size_t)layer * 384 * 256, 256, 256, m0, (tt % 3) * 128, smem, epi);
        } else {
            const int tt = tile - 16 - 384, m0 = (tt / 4) * 128;
            __syncthreads();
            mla_rstd_tile(cols + (size_t)m0 * LDC + 1728, 128, rsl, ltid());
            EpiMlaKV epi{ws, rsl};
            gemm_tile(cols + 1728, LDC, (const bf16_t*)(ws + OFF_WUKV) + (size_t)layer * 512 * 128, 128, 128, m0, (tt % 4) * 128, smem, epi);
        }
    }
}
DEV void phase_gemm_out(const Params& p, int layer, char* smem) {
    char* ws = p.ws;
    EpiRes epi{layer == 0 ? (const void*)p.x : (const void*)(ws + OFF_XRES), layer != 0, (bf16_t*)(ws + OFF_XRES), (const float*)(ws + OFF_MOD) + (size_t)layer * 8 * 6144 + 2048};
    gemm_phase(p, (const bf16_t*)(ws + OFF_O), 1024, (const bf16_t*)(ws + OFF_WOUT) + (size_t)layer * 1024 * 1024, 1024, 1024, kT / 128, 8, smem, epi);
}
DEV void phase_gemm_wq(const Params& p, int layer, char* smem) {
    char* ws = p.ws;
    EpiBf16 epi{(bf16_t*)(ws + OFF_QP), 2048, nullptr, nullptr, 2048};
    gemm_phase(p, (const bf16_t*)(ws + OFF_H), 1024, (const bf16_t*)(ws + OFF_WQ) + (size_t)layer * 2048 * 1024, 1024, 1024, kT / 128, 16, smem, epi);
}
DEV void phase_scores(const Params& p, int layer, char* smem) {
    char* ws = p.ws;
    for (int tile = blockIdx.x; tile < 2048; tile += gridDim.x) {
        const int c = tile >> 10, nt = tile & 1023;
        EpiF32 epi{(float*)(ws + (c ? OFF_S2 : OFF_S1)), kT * 8};
        gemm_tile((const bf16_t*)(ws + OFF_SUBK) + (size_t)(layer * 2 + c) * 16384, 128, (const bf16_t*)(ws + OFF_QP) + c * 128, 256, 128, 0, nt * 128, smem, epi);
    }
}

constexpr int NPHASE = 16;
DEV void run_phase(const Params& p, int ph, int layer, char* smem, int rep = 0) {
    switch (ph) {
        case 0: phase_prologue(p, smem); break;
        case 1: phase_norm(p, layer, 0); break;
        case 2: phase_gemm_in(p, layer, smem); break;
        case 3: phase_layout1(p, smem); break;
        case 4: phase_gemm_mid(p, layer, smem); break;
        case 5: phase_layout2(p, layer, smem); break;
        case 6: phase_attn(p, layer, smem, rep); break;
        case 7: phase_gemm_out(p, layer, smem); break;
        case 8: phase_norm(p, layer, 1); break;
        case 9: phase_gemm_wq(p, layer, smem); break;
        case 10: phase_route(p, layer, smem); break;
        case 11: phase_topk(p, smem); break;
        case 12: phase_peer_u(p, layer, smem, rep); break;
        case 13: phase_peer_comb(p, rep); break;
        case 14: phase_peer_v(p, layer, smem, rep); break;
        case 15: if (layer == 0) phase_norm(p, 1, 0); else phase_final(p); break;
        default: break;
    }
}

#if !FUSED
template <int PH>
__global__ void __launch_bounds__(256, 2) k_phase(Params p, int layer) {
    __shared__ __attribute__((aligned(16))) char smem[SM_TOTAL];
    run_phase(p, PH, layer, smem);
}
template <int PH> static void launch_phase(const Params& p, int layer, hipStream_t stream) { k_phase<PH><<<512, 256, 0, stream>>>(p, layer); }
static void launch_ph(int ph, const Params& p, int layer, hipStream_t stream) {
    switch (ph) {
        case 0: launch_phase<0>(p, layer, stream); break;
        case 1: launch_phase<1>(p, layer, stream); break;
        case 2: launch_phase<2>(p, layer, stream); break;
        case 3: launch_phase<3>(p, layer, stream); break;
        case 4: launch_phase<4>(p, layer, stream); break;
        case 5: launch_phase<5>(p, layer, stream); break;
        case 6: launch_phase<6>(p, layer, stream); break;
        case 7: launch_phase<7>(p, layer, stream); break;
        case 8: launch_phase<8>(p, layer, stream); break;
        case 9: launch_phase<9>(p, layer, stream); break;
        case 10: launch_phase<10>(p, layer, stream); break;
        case 11: launch_phase<11>(p, layer, stream); break;
        case 12: launch_phase<12>(p, layer, stream); break;
    }
}
#else
#if TS_A >= 0
#define TSTAMP(I) if (blockIdx.x == 0 && threadIdx.x == 0) ((unsigned long long*)(p.ws + 32768))[I] = __builtin_amdgcn_s_memrealtime();
#else
#define TSTAMP(I)
#endif
__global__ void __launch_bounds__(256, 2) k_mega(Params p) {
    extern __shared__ __attribute__((aligned(1024))) char smem[];
    cg::grid_group grid = cg::this_grid();
    volatile LAS unsigned* st = (volatile LAS unsigned*)(smem + SM_CTRL);
    if (threadIdx.x == 0) { st[0] = 0u; st[1] = 0u; st[2] = 0u; }
    __syncthreads();
    const XcdBarrier xb = xcd_barrier_post((unsigned*)p.ws, st);
    TSTAMP(0)
    run_phase(p, 0, 0, smem);
    if (p.out == nullptr) grid.sync();
    xcd_barrier(xb);
    TSTAMP(1)
    run_phase(p, 1, 0, smem);
    xcd_barrier(xb);
    TSTAMP(2)
#define STEP(PH, L) { run_phase(p, PH, L, smem, 0); xcd_barrier(xb); TSTAMP(2 + (L) * 16 + (PH)) }
#define LAYER(L) STEP(2, L) STEP(4, L) STEP(6, L) STEP(7, L) STEP(8, L) STEP(9, L) STEP(10, L) STEP(12, L) STEP(13, L) STEP(14, L)
    LAYER(0)
    STEP(15, 0)
    LAYER(1)
    run_phase(p, 15, 1, smem);
#if TS_A >= 0
    TSTAMP(2 + 16 + 15)
    __syncthreads();
    if (blockIdx.x == 0 && threadIdx.x == 0) {
        const unsigned long long* ts = (const unsigned long long*)(p.ws + 32768);
        p.out[0] += (TS_A == 50) ? (float)ts[TS_B] * (0.01f / 512.f / 10.f) : (float)(ts[TS_B] - ts[TS_A]) * 0.001f;
    }
#endif
}
#endif

extern "C" void kernel_launch(void* const* d_in, const int* in_sizes, int n_in, void* d_out, int out_size, void* d_ws, size_t ws_size, hipStream_t stream) {
    Params p{};
    const float** pp = (const float**)&p;
    for (int i = 0; i < 28; ++i) pp[i] = (const float*)d_in[i];
    p.out = (float*)d_out;
    p.ws = (char*)d_ws;
    if (ws_size < OFF_END) fprintf(stderr, "workspace too small: %zu < %zu\n", ws_size, (size_t)OFF_END);
    (void)hipMemsetAsync(d_ws, 0, 65536, stream);
#if !FUSED
    launch_ph(0, p, 0, stream);
    launch_ph(1, p, 0, stream);
    for (int l = 0; l < 2; ++l)
        for (int ph = 2; ph < NPHASE; ++ph) launch_ph(ph, p, l, stream);
#else
    static int grid_blocks = 0;
    if (!grid_blocks) {
        int dev = 0, cus = 0, per_cu = 0;
        (void)hipGetDevice(&dev);
        (void)hipDeviceGetAttribute(&cus, hipDeviceAttributeMultiprocessorCount, dev);
        (void)hipFuncSetAttribute((const void*)k_mega, hipFuncAttributeMaxDynamicSharedMemorySize, SM_TOTAL);
        (void)hipOccupancyMaxActiveBlocksPerMultiprocessor(&per_cu, (const void*)k_mega, 256, SM_TOTAL);
        if (per_cu > 2) per_cu = 2;
        if (per_cu < 1) per_cu = 1;
        grid_blocks = cus * per_cu;
    }
    void* args[] = {&p};
    hipError_t e = hipLaunchCooperativeKernel((const void*)k_mega, dim3(grid_blocks), dim3(256), args, SM_TOTAL, stream);
    if (e != hipSuccess) fprintf(stderr, "cooperative launch failed: %s (grid %d)\n", hipGetErrorString(e), grid_blocks);
#endif
}
```

```cpp
#include <hip/hip_runtime.h>
#include <hip/hip_cooperative_groups.h>
#include <stdint.h>
#include <stdio.h>
namespace cg = cooperative_groups;

#ifndef FUSED
#define FUSED 1
#endif
#ifndef TS_A
#define TS_A -1
#define TS_B -1
#endif
#ifndef PROBE_PH
#define PROBE_PH -1
#define PROBE_L 1
#define PROBE_REP 0
#endif

#define DEV __device__ __forceinline__
#define LAS __attribute__((address_space(3)))
typedef unsigned short bf16_t;
typedef short bf16x8 __attribute__((ext_vector_type(8)));
typedef float f32x16 __attribute__((ext_vector_type(16)));

constexpr int kB = 8, kS = 2048, kT = kB * kS, kD = 1024, LDC = 2432;
constexpr float kEps = 1e-6f;
constexpr float kNeg = -1e30f;
constexpr float kLog2e = 1.4426950408889634f;
constexpr float kScaleU = 256.f, kScaleV = 32.f;

constexpr size_t OFF_CTRL = 0;
constexpr size_t OFF_MOD  = 65536;
constexpr size_t OFF_ROPE = OFF_MOD + 2ull * 8 * 6144 * 4;
constexpr size_t OFF_MISC = OFF_ROPE + 2048ull * 96 * 4;
constexpr size_t OFF_WIN  = OFF_MISC + 4096;
constexpr size_t OFF_WOUT = OFF_WIN + 2ull * 2432 * 1024 * 2;
constexpr size_t OFF_WQ   = OFF_WOUT + 2ull * 1024 * 1024 * 2;
constexpr size_t OFF_WUQ  = OFF_WQ + 2ull * 2048 * 1024 * 2;
constexpr size_t OFF_WUKV = OFF_WUQ + 2ull * 384 * 256 * 2;
constexpr size_t OFF_WCK  = OFF_WUKV + 2ull * 512 * 128 * 2;
constexpr size_t OFF_WCV  = OFF_WCK + 2ull * 128 * 2048 * 2;
constexpr size_t OFF_SUBK = OFF_WCV + 2ull * 128 * 2048 * 2;
constexpr size_t OFF_PU   = OFF_SUBK + 2ull * 2 * 128 * 128 * 2;
constexpr size_t OFF_PV   = OFF_PU + 2ull * 16384 * 1024;
constexpr size_t OFF_XRES = OFF_PV + 2ull * 16384 * 1024;
constexpr size_t OFF_H    = OFF_XRES + (size_t)kT * 1024 * 4;
constexpr size_t OFF_H8   = OFF_H + (size_t)kT * 1024 * 2;
constexpr size_t OFF_RSTD = OFF_H8 + (size_t)kT * 1024;
constexpr size_t OFF_KCMP = OFF_RSTD + 2ull * kT * 4;
constexpr size_t OFF_EID  = OFF_KCMP + 2ull * 1024 * 64 * 2;
constexpr size_t OFF_GATE = OFF_EID + (size_t)kT * 128 * 4;
constexpr size_t OFF_QP   = OFF_GATE + (size_t)kT * 128 * 4;
constexpr size_t OFF_COLS = OFF_QP + (size_t)kT * 2048 * 2;
constexpr size_t OFF_KC   = OFF_COLS + (size_t)kT * LDC * 2;
constexpr size_t OFF_VC   = OFF_KC + (size_t)(kT + 64) * 64 * 2;
constexpr size_t OFF_VT   = OFF_VC + (size_t)(kT + 64) * 64 * 2;
constexpr size_t OFF_QMLA = OFF_VT + 8ull * 12 * 64 * 2048 * 2;
constexpr size_t OFF_KVMLA = OFF_QMLA + (size_t)kT * 384 * 2;
constexpr size_t OFF_O    = OFF_KVMLA + (size_t)kT * 512 * 2;
constexpr size_t OFF_END  = OFF_O + (size_t)kT * 1024 * 2;
constexpr size_t OFF_S1 = OFF_COLS, OFF_S2 = OFF_COLS + (size_t)kT * 8 * 128 * 4;
static_assert(OFF_S2 + (size_t)kT * 8 * 128 * 4 <= OFF_O, "alias region too small");
static_assert(OFF_END <= (512ull << 20), "workspace too large");

struct Params {
    const float *x, *c, *ada_w, *ada_b, *norm_mix_g, *norm_ffn_g, *w_in, *pos_k, *pos_v, *cmp_wk, *cmp_wv;
    const float *lq1, *lk1, *lq2, *lk2, *sub_g, *mla_qg, *mla_wuq, *mla_kvg, *mla_wukv, *sinks, *w_out;
    const float *w_q, *subk1, *subk2, *pu, *pv, *final_g;
    float* out;
    char* ws;
};

DEV int ltid() { int t = threadIdx.x; asm volatile("" : "+v"(t)); return t; }
DEV float bf2f(bf16_t v) { return __uint_as_float(((unsigned)v) << 16); }
DEV bf16_t f2bf(float f) { unsigned u = __float_as_uint(f); u += 0x7fffu + ((u >> 16) & 1u); return (bf16_t)(u >> 16); }
DEV unsigned pack2(float lo, float hi) { unsigned r; asm("v_cvt_pk_bf16_f32 %0, %1, %2" : "=v"(r) : "v"(lo), "v"(hi)); return r; }
DEV float lo16(unsigned u) { return __uint_as_float(u << 16); }
DEV float hi16(unsigned u) { return __uint_as_float(u & 0xffff0000u); }
DEV float wave_sum(float v) {
#pragma unroll
    for (int o = 32; o > 0; o >>= 1) v += __shfl_xor(v, o, 64);
    return v;
}
DEV float xor32f(float v, int lane) { return __int_as_float(__builtin_amdgcn_ds_bpermute((lane ^ 32) << 2, __float_as_int(v))); }
DEV float lanef(float v, int src) { return __int_as_float(__builtin_amdgcn_ds_bpermute(src << 2, __float_as_int(v))); }
DEV f32x16 mfma32(bf16x8 a, bf16x8 b, f32x16 c) { return __builtin_amdgcn_mfma_f32_32x32x16_bf16(a, b, c, 0, 0, 0); }
DEV f32x16 zero16() { f32x16 z;
#pragma unroll
    for (int i = 0; i < 16; ++i) z[i] = 0.f;
    return z; }
DEV float gelu_tanh(float x) {
    const float u = 0.7978845608028654f * (x + 0.044715f * x * x * x);
    const float e = __expf(2.f * u);
    const float t = 1.f - 2.f / (e + 1.f);
    return 0.5f * x * (1.f + t);
}

template <class Epi>
DEV void gemm_tile(const bf16_t* __restrict__ A, int lda, const bf16_t* __restrict__ Bt, int ldb, int K, int m0, int n0, char* smem, const Epi& epi) {
    const int tid = ltid(), lane = tid & 63, w = tid >> 6, wm = w >> 1, wn = w & 1, ql = lane & 31, hh = lane >> 5;
    f32x16 acc[2][2];
#pragma unroll
    for (int i = 0; i < 2; ++i)
#pragma unroll
        for (int j = 0; j < 2; ++j) acc[i][j] = zero16();
    const int srow = lane >> 3, spos = lane & 7;
    const int c0 = spos ^ ((srow >> 1) & 7), c1 = spos ^ ((4 + (srow >> 1)) & 7);
    const bf16_t* Ag0 = A + (size_t)(m0 + w * 32 + srow) * lda + c0 * 8;
    const bf16_t* Ag1 = A + (size_t)(m0 + w * 32 + 8 + srow) * lda + c1 * 8;
    const bf16_t* Bg0 = Bt + (size_t)(n0 + w * 32 + srow) * ldb + c0 * 8;
    const bf16_t* Bg1 = Bt + (size_t)(n0 + w * 32 + 8 + srow) * ldb + c1 * 8;
    const size_t a16 = (size_t)16 * lda, b16 = (size_t)16 * ldb;
    auto stage = [&](int kt, int buf) __attribute__((always_inline)) {
        char* sa = smem + buf * 32768 + w * 4096;
        char* sb = sa + 16384;
        const int ko = kt * 64;
        __builtin_amdgcn_global_load_lds((const unsigned*)(Ag0 + ko), (LAS unsigned*)(sa), 16, 0, 0);
        __builtin_amdgcn_global_load_lds((const unsigned*)(Ag1 + ko), (LAS unsigned*)(sa + 1024), 16, 0, 0);
        __builtin_amdgcn_global_load_lds((const unsigned*)(Ag0 + a16 + ko), (LAS unsigned*)(sa + 2048), 16, 0, 0);
        __builtin_amdgcn_global_load_lds((const unsigned*)(Ag1 + a16 + ko), (LAS unsigned*)(sa + 3072), 16, 0, 0);
        __builtin_amdgcn_global_load_lds((const unsigned*)(Bg0 + ko), (LAS unsigned*)(sb), 16, 0, 0);
        __builtin_amdgcn_global_load_lds((const unsigned*)(Bg1 + ko), (LAS unsigned*)(sb + 1024), 16, 0, 0);
        __builtin_amdgcn_global_load_lds((const unsigned*)(Bg0 + b16 + ko), (LAS unsigned*)(sb + 2048), 16, 0, 0);
        __builtin_amdgcn_global_load_lds((const unsigned*)(Bg1 + b16 + ko), (LAS unsigned*)(sb + 3072), 16, 0, 0);
    };
    const int key = (ql >> 1) & 7;
    const int arow = (wm * 64 + ql) * 128, brow = (wn * 64 + ql) * 128;
    const int nk = K >> 6;
    __syncthreads();
    stage(0, 0);
    for (int kt = 0; kt < nk; ++kt) {
        asm volatile("s_waitcnt vmcnt(0)" ::: "memory");
        __syncthreads();
        if (kt + 1 < nk) stage(kt + 1, (kt + 1) & 1);
        const char* As = smem + (kt & 1) * 32768;
        const char* Bs = As + 16384;
#pragma unroll
        for (int ks = 0; ks < 4; ++ks) {
            const int co = ((ks * 2 + hh) ^ key) << 4;
            bf16x8 a[2], b[2];
#pragma unroll
            for (int i = 0; i < 2; ++i) {
                a[i] = *(const bf16x8*)(As + arow + i * 4096 + co);
                b[i] = *(const bf16x8*)(Bs + brow + i * 4096 + co);
            }
#pragma unroll
            for (int i = 0; i < 2; ++i)
#pragma unroll
                for (int j = 0; j < 2; ++j) acc[i][j] = mfma32(a[i], b[j], acc[i][j]);
        }
    }
    __syncthreads();
    float* Cs = (float*)smem;
#pragma unroll
    for (int i = 0; i < 2; ++i)
#pragma unroll
        for (int j = 0; j < 2; ++j)
#pragma unroll
            for (int r = 0; r < 16; ++r)
                Cs[(wm * 64 + i * 32 + (r & 3) + 8 * (r >> 2) + 4 * hh) * 128 + wn * 64 + j * 32 + ql] = acc[i][j][r];
    __syncthreads();
    epi.tile(m0, n0, Cs, tid);
}

struct EpiBf16 {
    bf16_t* C; int ldc; const float* rowscale; const float* colbias; int nvalid;
    DEV void tile(int m0, int n0, const float* Cs, int tid) const {
#pragma unroll
        for (int it = 0; it < 8; ++it) {
            const int id = tid + 256 * it, r = id >> 4, c8 = (id & 15) * 8;
            if (n0 + c8 >= nvalid) continue;
            float4 a = *(const float4*)(Cs + r * 128 + c8), b = *(const float4*)(Cs + r * 128 + c8 + 4);
            if (rowscale) { const float sc = rowscale[m0 + r]; a.x *= sc; a.y *= sc; a.z *= sc; a.w *= sc; b.x *= sc; b.y *= sc; b.z *= sc; b.w *= sc; }
            if (colbias) { const float4 ba = *(const float4*)(colbias + n0 + c8), bb = *(const float4*)(colbias + n0 + c8 + 4);
                a.x += ba.x; a.y += ba.y; a.z += ba.z; a.w += ba.w; b.x += bb.x; b.y += bb.y; b.z += bb.z; b.w += bb.w; }
            *(uint4*)(C + (size_t)(m0 + r) * ldc + n0 + c8) = make_uint4(pack2(a.x, a.y), pack2(a.z, a.w), pack2(b.x, b.y), pack2(b.z, b.w));
        }
    }
};
struct EpiF32 {
    float* C; int ldc;
    DEV void tile(int m0, int n0, const float* Cs, int tid) const {
#pragma unroll
        for (int it = 0; it < 16; ++it) {
            const int id = tid + 256 * it, r = id >> 5, c4 = (id & 31) * 4;
            *(float4*)(C + (size_t)(m0 + r) * ldc + n0 + c4) = *(const float4*)(Cs + r * 128 + c4);
        }
    }
};
struct EpiRes {
    const void* xin; bool in_bf16; bf16_t* xout; const float* gate;
    DEV void tile(int m0, int n0, const float* Cs, int tid) const {
        const float* g = gate + (size_t)(m0 >> 11) * 6144 + n0;
#pragma unroll
        for (int it = 0; it < 8; ++it) {
            const int id = tid + 256 * it, r = id >> 4, c8 = (id & 15) * 8;
            const float4 v0 = *(const float4*)(Cs + r * 128 + c8), v1 = *(const float4*)(Cs + r * 128 + c8 + 4);
            const float4 g0 = *(const float4*)(g + c8), g1 = *(const float4*)(g + c8 + 4);
            float4 x0, x1;
            if (in_bf16) {
                const uint4 u = *(const uint4*)((const bf16_t*)xin + (size_t)(m0 + r) * 1024 + n0 + c8);
                x0 = make_float4(lo16(u.x), hi16(u.x), lo16(u.y), hi16(u.y)); x1 = make_float4(lo16(u.z), hi16(u.z), lo16(u.w), hi16(u.w));
            } else {
                const float* xp = (const float*)xin + (size_t)(m0 + r) * 1024 + n0 + c8;
                x0 = *(const float4*)xp; x1 = *(const float4*)(xp + 4);
            }
            *(uint4*)(xout + (size_t)(m0 + r) * 1024 + n0 + c8) =
                make_uint4(pack2(x0.x + g0.x * v0.x, x0.y + g0.y * v0.y), pack2(x0.z + g0.z * v0.z, x0.w + g0.w * v0.w),
                           pack2(x1.x + g1.x * v1.x, x1.y + g1.y * v1.y), pack2(x1.z + g1.z * v1.z, x1.w + g1.w * v1.w));
        }
    }
};

struct SliceMap { int virt, nx, nloc, rank; };
DEV SliceMap slice_map(const Params& p, char* smem);
template <class Epi>
DEV void gemm_phase(const Params& p, const bf16_t* A, int lda, const bf16_t* Bt, int ldb, int K, int mtiles, int ntiles, char* smem, const Epi& epi) {
    const SliceMap sm = slice_map(p, smem);
    if (sm.nx == 8 && (mtiles & 3) == 0) {
        const int mclass = sm.virt >> 1, nh = sm.virt & 1;
        const int h0 = (ntiles + 1) >> 1;
        const int nb = nh ? ntiles - h0 : h0, nbase = nh ? h0 : 0;
        const int total = (mtiles >> 2) * nb;
        for (int i = sm.rank; i < total; i += sm.nloc) {
            const int mt = mclass + 4 * (i / nb), nt = nbase + i % nb;
            gemm_tile(A, lda, Bt, ldb, K, mt * 128, nt * 128, smem, epi);
        }
        return;
    }
    for (int tile = blockIdx.x; tile < mtiles * ntiles; tile += gridDim.x) {
        const int mt = tile / ntiles, nt = tile % ntiles;
        gemm_tile(A, lda, Bt, ldb, K, mt * 128, nt * 128, smem, epi);
    }
}

DEV int win_srccol(int n) {
    if (n < 652) return n;
    if (n < 704) return -1;
    if (n < 1888) return n - 52;
    if (n < 1920) return -1;
    return n - 84;
}
DEV void transpose_tile(const float* __restrict__ src, int ld_src, int nsrc_valid, int mode, const float* __restrict__ rowscale,
                        bf16_t* __restrict__ dst, int K, int n0, int k0, char* smem) {
    bf16_t* Ls = (bf16_t*)smem;
    const int tid = ltid();
    __syncthreads();
    const int nn = tid & 63, n = n0 + nn;
    const int sc = (mode == 1) ? win_srccol(n) : (mode == 2) ? (n & 63) : (n < nsrc_valid ? n : -1);
    const int kshift = (mode == 2 && n >= 64) ? 1024 : 0;
#pragma unroll 4
    for (int i = 0; i < 16; ++i) {
        const int kk = (tid >> 6) + 4 * i;
        float v = 0.f;
        if (sc >= 0) { v = src[(size_t)(k0 + kk + kshift) * ld_src + sc]; if (rowscale) v *= rowscale[k0 + kk]; }
        Ls[nn * 72 + kk] = f2bf(v);
    }
    __syncthreads();
#pragma unroll
    for (int i = 0; i < 2; ++i) {
        const int r = (tid >> 3) + 32 * i, ch = tid & 7;
        *(uint4*)(dst + (size_t)(n0 + r) * K + k0 + ch * 8) = *(const uint4*)(Ls + r * 72 + ch * 8);
    }
}

DEV void convert_stream(const float* __restrict__ src, bf16_t* __restrict__ dst, size_t n8) {
    const int tid = ltid();
    for (size_t i = (size_t)blockIdx.x * 256 + tid; i < n8; i += (size_t)gridDim.x * 256) {
        const float4 a = *(const float4*)(src + i * 8), b = *(const float4*)(src + i * 8 + 4);
        uint4 o; o.x = pack2(a.x, a.y); o.y = pack2(a.z, a.w); o.z = pack2(b.x, b.y); o.w = pack2(b.z, b.w);
        *(uint4*)(dst + i * 8) = o;
    }
}

DEV void convert_fp8_range(const float* __restrict__ src, unsigned char* __restrict__ dst, size_t u0, size_t n16, size_t first, size_t stride, float scale) {
    for (size_t i0 = u0 + first; i0 < n16; i0 += stride * 4) {
        float4 q[4][4];
#pragma unroll
        for (int u = 0; u < 4; ++u) {
            const size_t i = i0 + u * stride < n16 ? i0 + u * stride : i0;
#pragma unroll
            for (int c = 0; c < 4; ++c) q[u][c] = *(const float4*)(src + i * 16 + c * 4);
        }
#pragma unroll
        for (int u = 0; u < 4; ++u) {
            const size_t i = i0 + u * stride;
            if (i >= n16) break;
            unsigned o[4];
#pragma unroll
            for (int j = 0; j < 4; ++j) {
                const float4 v = q[u][j];
                unsigned w = 0u;
                w = __builtin_amdgcn_cvt_pk_fp8_f32(fminf(fmaxf(v.x * scale, -440.f), 440.f), fminf(fmaxf(v.y * scale, -440.f), 440.f), w, false);
                w = __builtin_amdgcn_cvt_pk_fp8_f32(fminf(fmaxf(v.z * scale, -440.f), 440.f), fminf(fmaxf(v.w * scale, -440.f), 440.f), w, true);
                o[j] = w;
            }
            const size_t rowg = i >> 6; const int c16 = (int)(i & 63);
            const size_t l = rowg >> 14, row = rowg & 16383;
            *(uint4*)(dst + (((l * 8 + (c16 >> 3)) * 16384 + row) << 7) + (c16 & 7) * 16) = make_uint4(o[0], o[1], o[2], o[3]);
        }
    }
}

DEV void convert_fp8_stream(const float* __restrict__ src, unsigned char* __restrict__ dst, size_t n16, float scale) {
    const int tid = ltid();
    convert_fp8_range(src, dst, 0, n16, (size_t)blockIdx.x * 256 + tid, (size_t)gridDim.x * 256, scale);
}

constexpr int J_ROPE = 384, J_MOD = 192, J_MISC = 5;
constexpr int J_TW_L = 608 + 256 + 512 + 24 + 16 + 64 + 64;
constexpr int J_TOTAL = J_ROPE + J_MOD + J_MISC + 2 * J_TW_L;

DEV void prologue_job(const Params& p, int job, char* smem) {
    const int tid = ltid();
    char* ws = p.ws;
    if (job < J_MISC) {
        float* misc = (float*)(ws + OFF_MISC);
        if (job < 4) {
            const int l = job >> 1, kv = job & 1;
            const float* pos = (kv ? p.pos_v : p.pos_k) + l * 2048;
            const float* wsrc = (kv ? p.cmp_wv : p.cmp_wk) + (size_t)l * 2048 * 64;
            float* red = (float*)smem;
            __syncthreads();
            const int kp = tid >> 6, n = tid & 63;
            float acc = 0.f;
            for (int k0 = kp * 512; k0 < kp * 512 + 512; k0 += 16) {
                float wv[16];
#pragma unroll
                for (int u = 0; u < 16; ++u) wv[u] = wsrc[(size_t)(k0 + u) * 64 + n];
#pragma unroll
                for (int u = 0; u < 16; ++u) acc += pos[k0 + u] * wv[u];
            }
            red[kp * 64 + n] = acc;
            __syncthreads();
            if (tid < 64) misc[(l * 2 + kv) * 64 + tid] = red[tid] + red[64 + tid] + red[128 + tid] + red[192 + tid];
        } else if (tid < 2) {
            const int l = tid;
            float d1 = 0.f, d2 = 0.f;
            for (int i = 0; i < 32; ++i) { d1 += p.lq1[l * 32 + i] * p.lk1[l * 32 + i]; d2 += p.lq2[l * 32 + i] * p.lk2[l * 32 + i]; }
            const float lam_init = 0.8f - 0.6f * expf(-0.3f * (float)l);
            misc[256 + l] = expf(d1) - expf(d2) + lam_init;
            misc[258 + l] = 1.f - lam_init;
        }
        return;
    }
    job -= J_MISC;
    if (job < J_MOD) {
        const int l = job / 96, n0 = (job % 96) * 64;
        float* sc = (float*)smem;
        __syncthreads();
        for (int i = tid; i < 8192; i += 256) { const float v = p.c[i]; sc[i] = v / (1.f + __expf(-v)); }
        __syncthreads();
        const int kp = tid >> 6, col = tid & 63;
        float acc[8];
#pragma unroll
        for (int b = 0; b < 8; ++b) acc[b] = 0.f;
        const float* wp = p.ada_w + (size_t)l * 1024 * 6144 + n0 + col;
        for (int k0 = kp * 256; k0 < kp * 256 + 256; k0 += 16) {
            float wv[16];
#pragma unroll
            for (int u = 0; u < 16; ++u) wv[u] = wp[(size_t)(k0 + u) * 6144];
#pragma unroll
            for (int u = 0; u < 16; ++u)
#pragma unroll
                for (int b = 0; b < 8; ++b) acc[b] += sc[b * 1024 + k0 + u] * wv[u];
        }
        float* red = sc + 8192;
#pragma unroll
        for (int b = 0; b < 8; ++b) red[(kp * 8 + b) * 64 + col] = acc[b];
        __syncthreads();
        float* mod = (float*)(ws + OFF_MOD);
        for (int idx = tid; idx < 512; idx += 256) {
            const int b = idx >> 6, cl = idx & 63;
            const float v = red[(0 * 8 + b) * 64 + cl] + red[(1 * 8 + b) * 64 + cl] + red[(2 * 8 + b) * 64 + cl] + red[(3 * 8 + b) * 64 + cl];
            mod[(size_t)(l * 8 + b) * 6144 + n0 + cl] = v + p.ada_b[l * 6144 + n0 + cl];
        }
        return;
    }
    job -= J_MOD;
    if (job < J_ROPE) {
        const int idx = job * 256 + tid;
        const int s = idx / 48, j = idx % 48;
        float* rope = (float*)(ws + OFF_ROPE);
        float inv; float *pc, *ps;
        if (j < 32) { inv = exp2f(-(float)j * (13.287712379549449f / 32.f)); pc = rope + s * 32 + j; ps = rope + 2048 * 32 + s * 32 + j; }
        else { const int i = j - 32; inv = exp2f(-(float)i * (13.287712379549449f / 16.f)); pc = rope + 2048 * 64 + s * 16 + i; ps = rope + 2048 * 64 + 2048 * 16 + s * 16 + i; }
        const double a = (double)s * (double)inv;
        const double kk = rint(a * 0.15915494309189535);
        const float r = (float)fma(-kk, 6.283185307179586, a);
        *pc = cosf(r); *ps = sinf(r);
        return;
    }
    job -= J_ROPE;
    const int l = job / J_TW_L; int j = job % J_TW_L;
    if (j < 608) { transpose_tile(p.w_in + (size_t)l * 1024 * 2348, 2348, 2348, 1, nullptr, (bf16_t*)(ws + OFF_WIN) + (size_t)l * 2432 * 1024, 1024, (j / 16) * 64, (j % 16) * 64, smem); return; }
    j -= 608;
    if (j < 256) { transpose_tile(p.w_out + (size_t)l * 1024 * 1024, 1024, 1024, 0, nullptr, (bf16_t*)(ws + OFF_WOUT) + (size_t)l * 1024 * 1024, 1024, (j / 16) * 64, (j % 16) * 64, smem); return; }
    j -= 256;
    if (j < 512) { transpose_tile(p.w_q + (size_t)l * 1024 * 2048, 2048, 2048, 0, nullptr, (bf16_t*)(ws + OFF_WQ) + (size_t)l * 2048 * 1024, 1024, (j / 16) * 64, (j % 16) * 64, smem); return; }
    j -= 512;
    if (j < 24) { transpose_tile(p.mla_wuq + (size_t)l * 256 * 384, 384, 384, 0, p.mla_qg + l * 256, (bf16_t*)(ws + OFF_WUQ) + (size_t)l * 384 * 256, 256, (j / 4) * 64, (j % 4) * 64, smem); return; }
    j -= 24;
    if (j < 16) { transpose_tile(p.mla_wukv + (size_t)l * 128 * 512, 512, 512, 0, p.mla_kvg + l * 128, (bf16_t*)(ws + OFF_WUKV) + (size_t)l * 512 * 128, 128, (j / 2) * 64, (j % 2) * 64, smem); return; }
    j -= 16;
    if (j < 64) { if (j < 32) transpose_tile(p.cmp_wk + (size_t)l * 2048 * 64, 64, 64, 2, nullptr, (bf16_t*)(ws + OFF_WCK) + (size_t)l * 128 * 2048, 1024, (j / 16) * 64, (j % 16) * 64, smem); return; }
    j -= 64;
    if (j < 32) transpose_tile(p.cmp_wv + (size_t)l * 2048 * 64, 64, 64, 2, nullptr, (bf16_t*)(ws + OFF_WCV) + (size_t)l * 128 * 2048, 1024, (j / 16) * 64, (j % 16) * 64, smem);
}

#if TS_A >= 0
#define PSTAMP(I) if (blockIdx.x == 0 && threadIdx.x == 0) ((unsigned long long*)(p.ws + 32768))[I] = __builtin_amdgcn_s_memrealtime();
#else
#define PSTAMP(I)
#endif
DEV void phase_prologue(const Params& p, char* smem) {
    {
        unsigned* ctr = (unsigned*)p.ws + 100;
        volatile int* slot = (volatile int*)(smem + 65536 + 64);
        int job = blockIdx.x;
        while (job < J_TOTAL) {
            prologue_job(p, job, smem);
            __syncthreads();
            if (ltid() == 0) *slot = (int)gridDim.x + (int)atomicAdd(ctr, 1u);
            __syncthreads();
            job = __builtin_amdgcn_readfirstlane(*slot);
        }
    }
    PSTAMP(42)
    char* ws = p.ws;
    PSTAMP(43)
    PSTAMP(44)
    for (int l = 0; l < 2; ++l) {
        convert_stream(p.subk1 + (size_t)l * 16384, (bf16_t*)(ws + OFF_SUBK) + (size_t)(l * 2 + 0) * 16384, 16384 / 8);
        convert_stream(p.subk2 + (size_t)l * 16384, (bf16_t*)(ws + OFF_SUBK) + (size_t)(l * 2 + 1) * 16384, 16384 / 8);
    }
}

DEV void phase_norm(const Params& p, int layer, int which) {
    const int tid = ltid(), lane = tid & 63, w = tid >> 6;
    const bool xbf = !(layer == 0 && which == 0);
    const float* xs = p.x; const bf16_t* xb = (const bf16_t*)(p.ws + OFF_XRES);
    const float* g = (which == 0 ? p.norm_mix_g : p.norm_ffn_g) + layer * 1024;
    const float* mod = (const float*)(p.ws + OFF_MOD) + (size_t)layer * 8 * 6144;
    bf16_t* h = (bf16_t*)(p.ws + OFF_H);
    float4 g4[4];
#pragma unroll
    for (int i = 0; i < 4; ++i) g4[i] = *(const float4*)(g + i * 256 + lane * 4);
    for (int q0 = blockIdx.x; q0 < kT / 4; q0 += gridDim.x * 4) {
        float4 v[4][4];
#pragma unroll
        for (int u = 0; u < 4; ++u) {
            const int q = q0 + u * gridDim.x < kT / 4 ? q0 + u * gridDim.x : q0;
            if (xbf) {
                const bf16_t* xr = xb + (size_t)(q * 4 + w) * 1024;
#pragma unroll
                for (int i = 0; i < 4; ++i) { const uint2 uu = *(const uint2*)(xr + i * 256 + lane * 4); v[u][i] = make_float4(lo16(uu.x), hi16(uu.x), lo16(uu.y), hi16(uu.y)); }
            } else {
                const float* xr = xs + (size_t)(q * 4 + w) * 1024;
#pragma unroll
                for (int i = 0; i < 4; ++i) v[u][i] = *(const float4*)(xr + i * 256 + lane * 4);
            }
        }
#pragma unroll
        for (int u = 0; u < 4; ++u) {
            const int q = q0 + u * gridDim.x;
            if (q >= kT / 4) break;
            const int t = q * 4 + w, b = t >> 11;
            float ss = 0.f;
#pragma unroll
            for (int i = 0; i < 4; ++i) ss += v[u][i].x * v[u][i].x + v[u][i].y * v[u][i].y + v[u][i].z * v[u][i].z + v[u][i].w * v[u][i].w;
            ss = wave_sum(ss);
            const float rstd = rsqrtf(ss * (1.f / 1024.f) + kEps);
            const float* sh = mod + (size_t)b * 6144 + (which ? 3072 : 0);
            const float* sc = sh + 1024;
#pragma unroll
            for (int i = 0; i < 4; ++i) {
                const int col = i * 256 + lane * 4;
                const float4 s4 = *(const float4*)(sc + col), h4 = *(const float4*)(sh + col);
                const float o0 = v[u][i].x * rstd * g4[i].x * (1.f + s4.x) + h4.x, o1 = v[u][i].y * rstd * g4[i].y * (1.f + s4.y) + h4.y;
                const float o2 = v[u][i].z * rstd * g4[i].z * (1.f + s4.z) + h4.z, o3 = v[u][i].w * rstd * g4[i].w * (1.f + s4.w) + h4.w;
                uint2 o; o.x = pack2(o0, o1); o.y = pack2(o2, o3);
                *(uint2*)(h + (size_t)t * 1024 + col) = o;
            }
        }
    }
}

DEV void rope8(uint4& x1, uint4& x2, const float (&cc)[8], const float (&ss)[8]) {
    unsigned a[4] = {x1.x, x1.y, x1.z, x1.w}, b[4] = {x2.x, x2.y, x2.z, x2.w};
#pragma unroll
    for (int i = 0; i < 4; ++i) {
        const float a0 = lo16(a[i]), a1 = hi16(a[i]), b0 = lo16(b[i]), b1 = hi16(b[i]);
        const float o10 = a0 * cc[2 * i] - b0 * ss[2 * i], o11 = a1 * cc[2 * i + 1] - b1 * ss[2 * i + 1];
        const float o20 = a0 * ss[2 * i] + b0 * cc[2 * i], o21 = a1 * ss[2 * i + 1] + b1 * cc[2 * i + 1];
        a[i] = pack2(o10, o11); b[i] = pack2(o20, o21);
    }
    x1 = make_uint4(a[0], a[1], a[2], a[3]); x2 = make_uint4(b[0], b[1], b[2], b[3]);
}
DEV void vt_tile(const bf16_t* __restrict__ src, int ld, bf16_t* __restrict__ dst, char* smem) {
    bf16_t* Ls = (bf16_t*)smem;
    const int tid = ltid();
    __syncthreads();
#pragma unroll
    for (int i = 0; i < 2; ++i) {
        const int id = tid + 256 * i, tok = id >> 3, ch = id & 7;
        *(uint4*)(Ls + tok * 72 + ch * 8) = *(const uint4*)(src + (size_t)tok * ld + ch * 8);
    }
    __syncthreads();
#pragma unroll
    for (int i = 0; i < 2; ++i) {
        const int id = tid + 256 * i, d = id & 63, tc = id >> 6;
        unsigned short e[8];
#pragma unroll
        for (int j = 0; j < 8; ++j) e[j] = Ls[(tc * 8 + j) * 72 + d];
        uint4 o;
        o.x = (unsigned)e[0] | ((unsigned)e[1] << 16); o.y = (unsigned)e[2] | ((unsigned)e[3] << 16);
        o.z = (unsigned)e[4] | ((unsigned)e[5] << 16); o.w = (unsigned)e[6] | ((unsigned)e[7] << 16);
        *(uint4*)(dst + (size_t)d * 2048 + tc * 8) = o;
    }
}

DEV void phase_layout1(const Params& p, char* smem) {
    char* ws = p.ws;
    bf16_t* cols = (bf16_t*)(ws + OFF_COLS);
    bf16_t* kc = (bf16_t*)(ws + OFF_KC);
    bf16_t* vc = (bf16_t*)(ws + OFF_VC);
    bf16_t* VT = (bf16_t*)(ws + OFF_VT);
    float* rstd = (float*)(ws + OFF_RSTD);
    const float* rope = (const float*)(ws + OFF_ROPE);
    const float *cos64 = rope, *sin64 = rope + 2048 * 32, *cos32 = rope + 2048 * 64, *sin32 = rope + 2048 * 64 + 2048 * 16;
    const int tid = ltid();
    for (int unit = blockIdx.x; unit < 2 * (kT / 64); unit += gridDim.x) {
        const int tile = unit >> 1, part01 = unit & 1;
        const int T0 = tile * 64, b = T0 >> 11, s0 = T0 & 2047;
        if (part01 == 0) {
            for (int it0 = tid; it0 < 64 * 86; it0 += 1024) {
                uint4 x1[4], x2[4]; float4 cs[4][2], sn[4][2]; bf16_t* p1[4]; bf16_t* p2[4]; bf16_t* kq[4];
#pragma unroll
                for (int u = 0; u < 4; ++u) {
                    const int it = it0 + u * 256 < 64 * 86 ? it0 + u * 256 : it0;
                    const int tok = it / 86, item = it % 86;
                    const int t = T0 + tok, sq = s0 + tok;
                    bf16_t* row = cols + (size_t)t * LDC;
                    kq[u] = nullptr;
                    const float *cp, *sp;
                    if (item < 52) {
                        const int hd = item >> 2, i0 = (item & 3) * 8;
                        const int base = hd < 4 ? 64 * hd : hd == 4 ? 256 : hd == 5 ? 384 : hd == 6 ? 512 : hd < 11 ? 1920 + 64 * (hd - 7) : 2176 + 64 * (hd - 11);
                        p1[u] = row + base + i0; p2[u] = row + base + 32 + i0;
                        cp = cos64 + sq * 32 + i0; sp = sin64 + sq * 32 + i0;
                        if (hd == 4) kq[u] = kc + (size_t)t * 64 + i0;
                    } else {
                        const int it2 = item - 52, sub = it2 >> 1, i0 = (it2 & 1) * 8;
                        const int base = sub < 8 ? 704 + 32 * sub : sub < 16 ? 960 + 32 * (sub - 8) : 1856;
                        p1[u] = row + base + i0; p2[u] = row + base + 16 + i0;
                        cp = cos32 + sq * 16 + i0; sp = sin32 + sq * 16 + i0;
                    }
                    x1[u] = *(const uint4*)p1[u]; x2[u] = *(const uint4*)p2[u];
                    cs[u][0] = *(const float4*)cp; cs[u][1] = *(const float4*)(cp + 4);
                    sn[u][0] = *(const float4*)sp; sn[u][1] = *(const float4*)(sp + 4);
                }
#pragma unroll
                for (int u = 0; u < 4; ++u) {
                    if (it0 + u * 256 >= 64 * 86) break;
                    const float cc[8] = {cs[u][0].x, cs[u][0].y, cs[u][0].z, cs[u][0].w, cs[u][1].x, cs[u][1].y, cs[u][1].z, cs[u][1].w};
                    const float ss[8] = {sn[u][0].x, sn[u][0].y, sn[u][0].z, sn[u][0].w, sn[u][1].x, sn[u][1].y, sn[u][1].z, sn[u][1].w};
                    rope8(x1[u], x2[u], cc, ss);
                    *(uint4*)p1[u] = x1[u]; *(uint4*)p2[u] = x2[u];
                    if (kq[u]) { *(uint4*)kq[u] = x1[u]; *(uint4*)(kq[u] + 32) = x2[u]; }
                }
            }
            {
                const uint4 c0 = *(const uint4*)(cols + (size_t)(T0 + (tid >> 3)) * LDC + 320 + (tid & 7) * 8);
                const uint4 c1 = *(const uint4*)(cols + (size_t)(T0 + 32 + (tid >> 3)) * LDC + 320 + (tid & 7) * 8);
                *(uint4*)(vc + (size_t)(T0 + (tid >> 3)) * 64 + (tid & 7) * 8) = c0;
                *(uint4*)(vc + (size_t)(T0 + 32 + (tid >> 3)) * 64 + (tid & 7) * 8) = c1;
            }
        }
        if (part01 == 0) continue;
        {
            const int tok = tid >> 2, part = tid & 3, t = T0 + tok;
            const bf16_t* src = cols + (size_t)t * LDC + 1472 + (part < 3 ? part : 0) * 128;
            float ss = 0.f;
#pragma unroll 4
            for (int i = 0; i < 16; ++i) {
                const uint4 u = *(const uint4*)(src + i * 8);
                ss += lo16(u.x) * lo16(u.x) + hi16(u.x) * hi16(u.x) + lo16(u.y) * lo16(u.y) + hi16(u.y) * hi16(u.y)
                    + lo16(u.z) * lo16(u.z) + hi16(u.z) * hi16(u.z) + lo16(u.w) * lo16(u.w) + hi16(u.w) * hi16(u.w);
            }
            float vq = part < 2 ? ss : 0.f;
            vq += __shfl_xor(vq, 1, 64);
            if (part == 0) rstd[t] = rsqrtf(vq * (1.f / 256.f) + kEps);
            if (part == 2) rstd[kT + t] = rsqrtf(ss * (1.f / 128.f) + kEps);
        }
#pragma unroll 1
        for (int vh = 0; vh < 8; ++vh) {
            const int col = vh == 0 ? 448 : vh == 1 ? 576 : vh < 6 ? 1216 + 64 * (vh - 2) : 2304 + 64 * (vh - 6);
            vt_tile(cols + (size_t)T0 * LDC + col, LDC, VT + ((size_t)(b * 12 + vh) * 64) * 2048 + s0, smem);
        }
    }
}

DEV void phase_layout2(const Params& p, int layer, char* smem) {
    char* ws = p.ws;
    bf16_t* qmla = (bf16_t*)(ws + OFF_QMLA);
    const bf16_t* kvmla = (const bf16_t*)(ws + OFF_KVMLA);
    bf16_t* VT = (bf16_t*)(ws + OFF_VT);
    const float* rope = (const float*)(ws + OFF_ROPE);
    const float *cos32 = rope + 2048 * 64, *sin32 = rope + 2048 * 64 + 2048 * 16;
    const int tid = ltid();
    for (int tile = blockIdx.x; tile < kT / 64 + 64; tile += gridDim.x) {
        if (tile >= kT / 64) {
            const int idx = (tile - kT / 64) * 2048 + tid * 8;
            const int kv = idx >> 16, m = (idx >> 6) & 1023, n = idx & 63;
            const float* pp = (const float*)(ws + OFF_QP) + ((size_t)(kv * 8) * 1024 + m) * 128 + n;
            const float* bias = (const float*)(ws + OFF_MISC) + (layer * 2 + kv) * 64 + n;
            float4 a = *(const float4*)bias, c = *(const float4*)(bias + 4);
#pragma unroll
            for (int ks = 0; ks < 8; ++ks) {
                const float4 x = *(const float4*)(pp + (size_t)ks * 1024 * 128), y = *(const float4*)(pp + (size_t)ks * 1024 * 128 + 4);
                a.x += x.x; a.y += x.y; a.z += x.z; a.w += x.w; c.x += y.x; c.y += y.y; c.z += y.z; c.w += y.w;
            }
            *(uint4*)((bf16_t*)(ws + OFF_KCMP) + (size_t)kv * 1024 * 64 + m * 64 + n) = make_uint4(pack2(a.x, a.y), pack2(a.z, a.w), pack2(c.x, c.y), pack2(c.z, c.w));
            continue;
        }
        const int T0 = tile * 64, b = T0 >> 11, s0 = T0 & 2047;
        for (int it = tid; it < 64 * 8; it += 256) {
            const int tok = it >> 3, item = it & 7, hd = item >> 1, i0 = (item & 1) * 8;
            const int t = T0 + tok, s = s0 + tok;
            bf16_t* row = qmla + (size_t)t * 384 + hd * 96 + 64;
            uint4 x1 = *(const uint4*)(row + i0), x2 = *(const uint4*)(row + 16 + i0);
            const float* cp = cos32 + s * 16 + i0; const float* sp = sin32 + s * 16 + i0;
            const float4 c0 = *(const float4*)cp, c1 = *(const float4*)(cp + 4), q0 = *(const float4*)sp, q1 = *(const float4*)(sp + 4);
            const float cc[8] = {c0.x, c0.y, c0.z, c0.w, c1.x, c1.y, c1.z, c1.w}, ss[8] = {q0.x, q0.y, q0.z, q0.w, q1.x, q1.y, q1.z, q1.w};
            rope8(x1, x2, cc, ss);
            *(uint4*)(row + i0) = x1; *(uint4*)(row + 16 + i0) = x2;
        }
#pragma unroll 1
        for (int hd = 0; hd < 4; ++hd)
            vt_tile(kvmla + (size_t)T0 * 512 + hd * 128 + 64, 512, VT + ((size_t)(b * 12 + 8 + hd) * 64) * 2048 + s0, smem);
    }
}

constexpr int SM_K = 0;
constexpr int SM_V = 26624;
constexpr int SM_IMP = SM_V + 17408;
constexpr int SM_SEL = SM_IMP + 16896;
constexpr int SM_CTRL = 65536;
constexpr int SM_TOTAL = SM_CTRL + 256 + 512;
constexpr int SM_ATTN_END = SM_SEL + 1024;

struct RangeIter { int cur, end; DEV int next() { return cur < end ? cur++ : -1; } };
struct BitIter { unsigned rem; DEV int next() { if (!rem) return -1; const int k = __ffs((int)rem) - 1; rem &= rem - 1; return k; } };
struct LdRow { const bf16_t* base; int ld;
    DEV uint4 operator()(int kt, int id) const { const int row = id >> 3, part = id & 7; return *(const uint4*)(base + (size_t)(kt * 64 + row) * ld + part * 8); } };
struct LdVT { const bf16_t* base;
    DEV uint4 operator()(int kt, int id) const { const int d = id >> 3, part = id & 7; return *(const uint4*)(base + (size_t)d * 2048 + kt * 64 + part * 8); } };
struct LdMlaK { const bf16_t* kv; const bf16_t* kr;
    DEV uint4 operator()(int kt, int id) const { const int row = id / 12, part = id % 12; const size_t t = (size_t)(kt * 64 + row);
        return part < 8 ? *(const uint4*)(kv + t * 512 + part * 8) : *(const uint4*)(kr + t * LDC + (part - 8) * 8); } };

struct MaskCausal { DEV bool on(int) const { return true; } DEV bool ok(int kc, int d) const { return kc <= d; }
    DEV bool full(int kt, int t0w) const { return kt * 64 + 63 <= t0w; } };
template <int W> struct MaskWin { DEV bool on(int) const { return true; } DEV bool ok(int kc, int d) const { return (kc <= d) && (d - kc < W); }
    DEV bool full(int kt, int t0w) const { return (kt * 64 + 63 <= t0w) && (t0w + 31 - kt * 64 < W); } };
struct MaskSel { unsigned bits, allbits; DEV bool on(int kt) const { return (bits >> kt) & 1u; } DEV bool ok(int kc, int d) const { return kc <= d; }
    DEV bool full(int kt, int t0w) const { return ((allbits >> kt) & 1u) && (kt * 64 + 63 <= t0w); } };
template <int KDIM, int NKS, int NSUB, bool QG, class It, class LK, class LV, class MaskF, class SkipF>
DEV void attn_stream(It it, const LK& ldK, const LV& ldV, const MaskF& maskf, const SkipF& skipf,
                     const bf16x8* qf, f32x16 (&o)[NSUB][2], float (&m)[NSUB], float (&l)[NSUB], float scl, int tq, int t0w, char* smem, int tid, int koff = 0) {
    constexpr int KCH = KDIM / 8, KSTR = KDIM + 8, NKC = (64 * KCH) / 256;
    constexpr int KBUF = 64 * 104, VBUF = 64 * 68;
    bf16_t* Kb = (bf16_t*)(smem + SM_K);
    bf16_t* Vb = (bf16_t*)(smem + SM_V);
    const int lane = tid & 63, ql = lane & 31, hh = lane >> 5;
    const uint4 z4 = make_uint4(0, 0, 0, 0);
    uint4 ak0 = z4, ak1 = z4, ak2 = z4, av0 = z4, av1 = z4, bk0 = z4, bk1 = z4, bk2 = z4, bv0 = z4, bv1 = z4;
    auto loadA = [&](int kt) __attribute__((always_inline)) { ak0 = ldK(kt, tid); ak1 = ldK(kt, tid + 256); if (NKC == 3) ak2 = ldK(kt, tid + 512); av0 = ldV(kt, tid); av1 = ldV(kt, tid + 256); };
    auto loadB = [&](int kt) __attribute__((always_inline)) { bk0 = ldK(kt, tid); bk1 = ldK(kt, tid + 256); if (NKC == 3) bk2 = ldK(kt, tid + 512); bv0 = ldV(kt, tid); bv1 = ldV(kt, tid + 256); };
    auto stK = [&](bf16_t* kb, const uint4& r, int id) __attribute__((always_inline)) { const int row = id / KCH, part = id % KCH; *(uint4*)(kb + row * KSTR + part * 8) = r; };
    auto stV = [&](bf16_t* vb, const uint4& r, int id) __attribute__((always_inline)) { const int row = id >> 3, part = id & 7; bf16_t* d = vb + row * 68 + part * 8;
        *(uint2*)d = make_uint2(r.x, r.y); *(uint2*)(d + 4) = make_uint2(r.z, r.w); };
    auto compute = [&](int kt, const bf16_t* Kt, const bf16_t* Vt) __attribute__((always_inline)) {
        if (skipf(kt)) return;
#pragma unroll
        for (int sub = 0; sub < NSUB; ++sub) {
            const int tqs = tq + (QG ? 32 * sub : 0), t0s = t0w + (QG ? 32 * sub : 0);
            if (QG && kt * 64 > t0s + 31) continue;
            __builtin_amdgcn_sched_barrier(0);
            f32x16 s[2];
#pragma unroll
            for (int i = 0; i < 2; ++i) {
                s[i] = zero16();
#pragma unroll
                for (int ks = 0; ks < NKS; ++ks) {
                    const bf16x8 a = *(const bf16x8*)(Kt + (i * 32 + ql) * KSTR + koff + ((QG ? 0 : sub * NKS) + ks) * 16 + hh * 8);
                    s[i] = mfma32(a, qf[sub * NKS + ks], s[i]);
                }
            }
            float mx = kNeg;
            if (!maskf.full(kt, t0s)) {
                const int dlim = tqs - kt * 64 - 4 * hh;
                const bool on = maskf.on(kt);
#pragma unroll
                for (int i = 0; i < 2; ++i)
#pragma unroll
                    for (int r = 0; r < 16; ++r) {
                        const int kc = i * 32 + (r & 3) + 8 * (r >> 2);
                        s[i][r] = (on && maskf.ok(kc, dlim)) ? s[i][r] : kNeg;
                    }
            }
#pragma unroll
            for (int i = 0; i < 2; ++i)
#pragma unroll
                for (int r = 0; r < 16; ++r) mx = fmaxf(mx, s[i][r]);
            mx = fmaxf(mx, xor32f(mx, lane));
            const float mnew = fmaxf(m[sub], mx);
            const float alpha = __builtin_amdgcn_exp2f((m[sub] - mnew) * scl);
            m[sub] = mnew;
            const float negm = mnew > -1e29f ? -mnew * scl : 0.f;
            float sum = 0.f;
#pragma unroll
            for (int i = 0; i < 2; ++i)
#pragma unroll
                for (int r = 0; r < 16; ++r) { const float pv = __builtin_amdgcn_exp2f(__builtin_fmaf(s[i][r], scl, negm)); s[i][r] = pv; sum += pv; }
            l[sub] = l[sub] * alpha + sum;
            if (__builtin_amdgcn_ballot_w64(alpha != 1.f)) {
#pragma unroll
                for (int dt = 0; dt < 2; ++dt)
#pragma unroll
                    for (int r = 0; r < 16; ++r) o[sub][dt][r] *= alpha;
            }
            __builtin_amdgcn_sched_barrier(0);
#pragma unroll
            for (int ks = 0; ks < 4; ++ks) {
                if (ks == 2) __builtin_amdgcn_sched_barrier(0);
                const int i = ks >> 1, r0 = 8 * (ks & 1);
                uint4 pu;
                pu.x = pack2(s[i][r0 + 0], s[i][r0 + 1]); pu.y = pack2(s[i][r0 + 2], s[i][r0 + 3]);
                pu.z = pack2(s[i][r0 + 4], s[i][r0 + 5]); pu.w = pack2(s[i][r0 + 6], s[i][r0 + 7]);
                const bf16x8 pf = __builtin_bit_cast(bf16x8, pu);
#pragma unroll
                for (int dt = 0; dt < 2; ++dt) {
                    const bf16_t* vp = Vt + (dt * 32 + ql) * 68 + ks * 16 + 4 * hh;
                    const uint2 a0 = *(const uint2*)vp, a1 = *(const uint2*)(vp + 8);
                    const bf16x8 a = __builtin_bit_cast(bf16x8, make_uint4(a0.x, a0.y, a1.x, a1.y));
                    o[sub][dt] = mfma32(a, pf, o[sub][dt]);
                }
            }
        }
    };
    int ka = it.next();
    int kb = ka >= 0 ? it.next() : -1;
    if (ka >= 0) loadA(ka);
    if (kb >= 0) loadB(kb);
    while (ka >= 0) {
        __syncthreads();
        stK(Kb, ak0, tid); stK(Kb, ak1, tid + 256); if (NKC == 3) stK(Kb, ak2, tid + 512);
        stV(Vb, av0, tid); stV(Vb, av1, tid + 256);
        if (kb >= 0) {
            stK(Kb + KBUF, bk0, tid); stK(Kb + KBUF, bk1, tid + 256); if (NKC == 3) stK(Kb + KBUF, bk2, tid + 512);
            stV(Vb + VBUF, bv0, tid); stV(Vb + VBUF, bv1, tid + 256);
        }
        __syncthreads();
        const int na = it.next();
        const int nb = na >= 0 ? it.next() : -1;
        if (na >= 0) loadA(na);
        if (nb >= 0) loadB(nb);
        compute(ka, Kb, Vb);
        if (kb >= 0) compute(kb, Kb + KBUF, Vb + VBUF);
        ka = na; kb = nb;
    }
}

DEV void write_o(const f32x16 (&o)[2], bf16_t* obuf, size_t row, int col0, int hh) {
#pragma unroll
    for (int dt = 0; dt < 2; ++dt)
#pragma unroll
        for (int g = 0; g < 4; ++g) {
            const int d = dt * 32 + 8 * g + 4 * hh;
            uint2 u; u.x = pack2(o[dt][4 * g], o[dt][4 * g + 1]); u.y = pack2(o[dt][4 * g + 2], o[dt][4 * g + 3]);
            *(uint2*)(obuf + row * 1024 + col0 + d) = u;
        }
}
DEV float sigmoidf(float x) { return 1.f / (1.f + __expf(-x)); }

DEV void nsa_item(const Params& p, int layer, int b, int qb, char* smem) {
    int tid = threadIdx.x; asm volatile("" : "+v"(tid));
    const int lane = tid & 63, w = tid >> 6, ql = lane & 31, hh = lane >> 5;
    char* ws = p.ws;
    const bf16_t* cols = (const bf16_t*)(ws + OFF_COLS);
    const bf16_t* VT = (const bf16_t*)(ws + OFF_VT);
    bf16_t* obuf = (bf16_t*)(ws + OFF_O);
    const int t0 = qb * 32, tq = t0 + ql;
    const size_t Tb = (size_t)b * kS;
    const bf16_t* qrow = cols + (Tb + tq) * LDC;
    bf16x8 qf[4];
#pragma unroll
    for (int ks = 0; ks < 4; ++ks) qf[ks] = *(const bf16x8*)(qrow + w * 64 + ks * 16 + hh * 8);
    const float g0 = sigmoidf(bf2f(qrow[640 + w * 3 + 0])), g1 = sigmoidf(bf2f(qrow[640 + w * 3 + 1])), g2 = sigmoidf(bf2f(qrow[640 + w * 3 + 2]));
    const float scl = 0.125f * kLog2e;
    bf16_t* Kc = (bf16_t*)(smem + SM_K);
    bf16_t* Vc = (bf16_t*)(smem + SM_V);
    float* impP = (float*)(smem + SM_IMP);
    unsigned* selm = (unsigned*)(smem + SM_SEL);
    const float* gk = (const float*)(ws + OFF_QP) + (size_t)b * 128 * 128;
    const float* gv = gk + (size_t)1024 * 128;
    const float* bias = (const float*)(ws + OFF_MISC) + layer * 128;
    __syncthreads();
#pragma unroll
    for (int i = 0; i < 4; ++i) {
        const int id = tid + 256 * i, row = id >> 3, part = id & 7;
        const int row1 = row < 127 ? row + 1 : row;
        const float* a = gk + (size_t)row * 128 + part * 8;  const float* a2 = gk + (size_t)row1 * 128 + 64 + part * 8;
        const float* c = gv + (size_t)row * 128 + part * 8;  const float* c2 = gv + (size_t)row1 * 128 + 64 + part * 8;
        const float4 k0 = *(const float4*)a, k1 = *(const float4*)(a + 4), k2 = *(const float4*)a2, k3 = *(const float4*)(a2 + 4);
        const float4 v0 = *(const float4*)c, v1 = *(const float4*)(c + 4), v2 = *(const float4*)c2, v3 = *(const float4*)(c2 + 4);
        const float4 bk0 = *(const float4*)(bias + part * 8), bk1 = *(const float4*)(bias + part * 8 + 4);
        const float4 bv0 = *(const float4*)(bias + 64 + part * 8), bv1 = *(const float4*)(bias + 64 + part * 8 + 4);
        uint4 kk = make_uint4(pack2(k0.x + k2.x + bk0.x, k0.y + k2.y + bk0.y), pack2(k0.z + k2.z + bk0.z, k0.w + k2.w + bk0.w),
                              pack2(k1.x + k3.x + bk1.x, k1.y + k3.y + bk1.y), pack2(k1.z + k3.z + bk1.z, k1.w + k3.w + bk1.w));
        uint4 vv = make_uint4(pack2(v0.x + v2.x + bv0.x, v0.y + v2.y + bv0.y), pack2(v0.z + v2.z + bv0.z, v0.w + v2.w + bv0.w),
                              pack2(v1.x + v3.x + bv1.x, v1.y + v3.y + bv1.y), pack2(v1.z + v3.z + bv1.z, v1.w + v3.w + bv1.w));
        if (row == 127) { kk = make_uint4(0, 0, 0, 0); vv = kk; }
        *(uint4*)(Kc + row * 72 + part * 8) = kk;
        const unsigned u[4] = {vv.x, vv.y, vv.z, vv.w};
#pragma unroll
        for (int j = 0; j < 4; ++j) { Vc[(part * 8 + 2 * j) * 132 + row] = (bf16_t)(u[j] & 0xffffu); Vc[(part * 8 + 2 * j + 1) * 132 + row] = (bf16_t)(u[j] >> 16); }
    }
    __syncthreads();
    unsigned ocp[16];
    float* invs = (float*)(smem + SM_SEL) + 64;
    {
        const int cmaxv = tq >= 31 ? min((tq - 31) >> 4, 126) : -1;
        float mx = kNeg;
#pragma unroll 1
        for (int i = 0; i < 4; ++i) {
            f32x16 s = zero16();
#pragma unroll
            for (int ks = 0; ks < 4; ++ks) s = mfma32(*(const bf16x8*)(Kc + (i * 32 + ql) * 72 + ks * 16 + hh * 8), qf[ks], s);
            const int clim = cmaxv - i * 32 - 4 * hh;
#pragma unroll
            for (int r = 0; r < 16; ++r) {
                const int kc = (r & 3) + 8 * (r >> 2);
                const bool valid = (kc <= clim);
                mx = fmaxf(mx, valid ? s[r] * scl : kNeg);
            }
        }
        mx = fmaxf(mx, xor32f(mx, lane));
        f32x16 ocmp[2]; ocmp[0] = zero16(); ocmp[1] = zero16();
        float sum = 0.f, carprev = 0.f;
#pragma unroll 1
        for (int i = 0; i < 4; ++i) {
            f32x16 s = zero16();
#pragma unroll
            for (int ks = 0; ks < 4; ++ks) s = mfma32(*(const bf16x8*)(Kc + (i * 32 + ql) * 72 + ks * 16 + hh * 8), qf[ks], s);
            const int clim = cmaxv - i * 32 - 4 * hh;
#pragma unroll
            for (int r = 0; r < 16; ++r) {
                const int kc = (r & 3) + 8 * (r >> 2);
                const bool valid = (kc <= clim);
                const float pv = valid ? __builtin_amdgcn_exp2f(s[r] * scl - mx) : 0.f;
                s[r] = pv; sum += pv;
            }
            float own[4], car[4];
#pragma unroll
            for (int g = 0; g < 4; ++g) { own[g] = s[4 * g] + s[4 * g + 1] + s[4 * g + 2] + 0.5f * s[4 * g + 3]; car[g] = 0.5f * s[4 * g + 3]; }
#pragma unroll
            for (int g = 0; g < 4; ++g) {
                const float send = hh ? (g ? car[g > 0 ? g - 1 : 0] : carprev) : car[g];
                own[g] += xor32f(send, lane);
            }
            carprev = car[3];
#pragma unroll
            for (int g = 0; g < 4; ++g) impP[(w * 32 + ql) * 33 + 2 * (4 * i + g) + hh] = own[g];
#pragma unroll
            for (int sp = 0; sp < 2; ++sp) {
                const int ks = 2 * i + sp, r0 = 8 * sp;
                uint4 pu;
                pu.x = pack2(s[r0 + 0], s[r0 + 1]); pu.y = pack2(s[r0 + 2], s[r0 + 3]);
                pu.z = pack2(s[r0 + 4], s[r0 + 5]); pu.w = pack2(s[r0 + 6], s[r0 + 7]);
                const bf16x8 pf = __builtin_bit_cast(bf16x8, pu);
#pragma unroll
                for (int dt = 0; dt < 2; ++dt) {
                    const bf16_t* vp = Vc + (dt * 32 + ql) * 132 + ks * 16 + 4 * hh;
                    const uint2 a0 = *(const uint2*)vp, a1 = *(const uint2*)(vp + 8);
                    ocmp[dt] = mfma32(__builtin_bit_cast(bf16x8, make_uint4(a0.x, a0.y, a1.x, a1.y)), pf, ocmp[dt]);
                }
            }
        }
        sum += xor32f(sum, lane);
        const float inv = sum > 0.f ? 1.f / sum : 0.f;
        invs[w * 32 + ql] = inv;
        const float f = g0 * inv;
#pragma unroll
        for (int dt = 0; dt < 2; ++dt)
#pragma unroll
            for (int r = 0; r < 8; ++r) ocp[dt * 8 + r] = pack2(f * ocmp[dt][2 * r], f * ocmp[dt][2 * r + 1]);
    }
    __syncthreads();
    const int qblk = t0 >> 6;
    {
        const int hw = tid >> 5, j = tid & 31;
#pragma unroll 1
        for (int rr = 0; rr < 4; ++rr) {
            const int row = hw * 4 + rr;
            const float v = impP[(0 * 32 + row) * 33 + j] * invs[row] + impP[(1 * 32 + row) * 33 + j] * invs[32 + row]
                          + impP[(2 * 32 + row) * 33 + j] * invs[64 + row] + impP[(3 * 32 + row) * 33 + j] * invs[96 + row];
            bool sel;
            if (qblk < 16) sel = (j <= qblk);
            else {
                const bool cand = (j >= 1) && (j <= qblk - 2);
                const bool forced = (j == 0) || (j == qblk) || (j == qblk - 1);
                int rank = 0;
                for (int j2 = 1; j2 <= qblk - 2; ++j2) {
                    const float v2 = lanef(v, (lane & 32) + j2);
                    rank += (v2 > v || (v2 == v && j2 < j)) ? 1 : 0;
                }
                sel = forced || (cand && rank < 13);
            }
            const unsigned long long bal = __ballot(sel);
            const unsigned mk = (lane & 32) ? (unsigned)(bal >> 32) : (unsigned)bal;
            if (j == 0) selm[row] = mk;
        }
    }
    __syncthreads();
    const unsigned mysel = selm[ql];
    unsigned U = mysel, Uall = mysel;
#pragma unroll
    for (int o = 16; o > 0; o >>= 1) { U |= (unsigned)__builtin_amdgcn_ds_bpermute((lane ^ o) << 2, (int)U); Uall &= (unsigned)__builtin_amdgcn_ds_bpermute((lane ^ o) << 2, (int)Uall); }
    Uall = (unsigned)__builtin_amdgcn_readfirstlane((int)Uall);
    {
        f32x16 o1[1][2]; o1[0][0] = zero16(); o1[0][1] = zero16();
        float m1[1] = {kNeg}, l1[1] = {0.f};
        auto skipf = [&](int) __attribute__((always_inline)) { return false; };
        attn_stream<64, 4, 1, false>(BitIter{U}, LdRow{cols + Tb * LDC + 384, LDC}, LdVT{VT + (size_t)(b * 12 + 0) * 64 * 2048}, MaskSel{mysel, Uall}, skipf, qf, o1, m1, l1, scl, tq, __builtin_amdgcn_readfirstlane(t0), smem, tid);
        const float lt = l1[0] + xor32f(l1[0], lane);
        const float f = g1 / lt;
#pragma unroll
        for (int dt = 0; dt < 2; ++dt)
#pragma unroll
            for (int r = 0; r < 8; ++r) ocp[dt * 8 + r] = pack2(lo16(ocp[dt * 8 + r]) + f * o1[0][dt][2 * r], hi16(ocp[dt * 8 + r]) + f * o1[0][dt][2 * r + 1]);
    }
    {
        f32x16 o1[1][2]; o1[0][0] = zero16(); o1[0][1] = zero16();
        float m1[1] = {kNeg}, l1[1] = {0.f};
        auto skipf = [&](int) __attribute__((always_inline)) { return false; };
        const int lo = t0 >= 511 ? ((t0 - 511) >> 6) : 0;
        attn_stream<64, 4, 1, false>(RangeIter{lo, qblk + 1}, LdRow{cols + Tb * LDC + 512, LDC}, LdVT{VT + (size_t)(b * 12 + 1) * 64 * 2048}, MaskWin<512>{}, skipf, qf, o1, m1, l1, scl, tq, __builtin_amdgcn_readfirstlane(t0), smem, tid);
        const float lt = l1[0] + xor32f(l1[0], lane);
        const float f = g2 / lt;
#pragma unroll
        for (int dt = 0; dt < 2; ++dt)
#pragma unroll
            for (int r = 0; r < 8; ++r) { o1[0][dt][2 * r] = lo16(ocp[dt * 8 + r]) + f * o1[0][dt][2 * r]; o1[0][dt][2 * r + 1] = hi16(ocp[dt * 8 + r]) + f * o1[0][dt][2 * r + 1]; }
        write_o(o1[0], obuf, Tb + tq, w * 64, hh);
    }
}

DEV void diff_item(const Params& p, int layer, int b, int hd, int qc, char* smem) {
    int tid = threadIdx.x; asm volatile("" : "+v"(tid));
    const int lane = tid & 63, w = tid >> 6, ql = lane & 31, hh = lane >> 5;
    const int sub = w & 1, qh = w >> 1;
    char* ws = p.ws;
    const bf16_t* cols = (const bf16_t*)(ws + OFF_COLS);
    const bf16_t* VT = (const bf16_t*)(ws + OFF_VT);
    bf16_t* obuf = (bf16_t*)(ws + OFF_O);
    const float* misc = (const float*)(ws + OFF_MISC);
    const int t0w = qc * 128 + qh * 64, tq = t0w + ql;
    const size_t Tb = (size_t)b * kS;
    bf16x8 qf[4];
#pragma unroll
    for (int g = 0; g < 2; ++g)
#pragma unroll
        for (int ks = 0; ks < 2; ++ks) qf[g * 2 + ks] = *(const bf16x8*)(cols + (Tb + tq + 32 * g) * LDC + 704 + hd * 64 + sub * 32 + ks * 16 + hh * 8);
    const float scl = 0.17677669529663687f * kLog2e;
    f32x16 o2[2][2];
#pragma unroll
    for (int g = 0; g < 2; ++g) { o2[g][0] = zero16(); o2[g][1] = zero16(); }
    float m2[2] = {kNeg, kNeg}, l2[2] = {0.f, 0.f};
    auto skipf = [&](int kt) __attribute__((always_inline)) { return kt * 64 > t0w + 63; };
    attn_stream<64, 2, 2, true>(RangeIter{0, 2 * qc + 2}, LdRow{cols + Tb * LDC + 960 + hd * 64, LDC}, LdVT{VT + (size_t)(b * 12 + 2 + hd) * 64 * 2048}, MaskCausal{}, skipf, qf, o2, m2, l2, scl, tq, __builtin_amdgcn_readfirstlane(t0w), smem, tid, sub * 32);
    const float lam = misc[256 + layer], post = misc[258 + layer];
    float* ex = (float*)smem;
    __syncthreads();
#pragma unroll
    for (int g = 0; g < 2; ++g) {
        const float lt = l2[g] + xor32f(l2[g], lane);
        if (sub == 1) {
            const float f = lam / lt;
#pragma unroll
            for (int dt = 0; dt < 2; ++dt)
#pragma unroll
                for (int r = 0; r < 16; ++r) ex[(((qh * 2 + g) * 2 + dt) * 16 + r) * 64 + lane] = o2[g][dt][r] * f;
        } else {
            const float f = 1.f / lt;
#pragma unroll
            for (int dt = 0; dt < 2; ++dt)
#pragma unroll
                for (int r = 0; r < 16; ++r) o2[g][dt][r] *= f;
        }
    }
    __syncthreads();
    if (sub == 0) {
        const float* sg = p.sub_g + layer * 64;
#pragma unroll
        for (int g = 0; g < 2; ++g) {
            float ss = 0.f;
#pragma unroll
            for (int dt = 0; dt < 2; ++dt)
#pragma unroll
                for (int r = 0; r < 16; ++r) { const float v = o2[g][dt][r] - ex[(((qh * 2 + g) * 2 + dt) * 16 + r) * 64 + lane]; o2[g][dt][r] = v; ss += v * v; }
            ss += xor32f(ss, lane);
            const float rstd = rsqrtf(ss * (1.f / 64.f) + kEps) * post;
#pragma unroll
            for (int dt = 0; dt < 2; ++dt)
#pragma unroll
                for (int r = 0; r < 16; ++r) { const int d = dt * 32 + (r & 3) + 8 * (r >> 2) + 4 * hh; o2[g][dt][r] *= rstd * sg[d]; }
            write_o(o2[g], obuf, Tb + tq + 32 * g, 256 + hd * 64, hh);
        }
    }
}

DEV void mla_item(const Params& p, int b, int hd, int qc, char* smem) {
    int tid = threadIdx.x; asm volatile("" : "+v"(tid));
    const int lane = tid & 63, w = tid >> 6, ql = lane & 31, hh = lane >> 5;
    char* ws = p.ws;
    const bf16_t* cols = (const bf16_t*)(ws + OFF_COLS);
    const bf16_t* VT = (const bf16_t*)(ws + OFF_VT);
    const bf16_t* qmla = (const bf16_t*)(ws + OFF_QMLA);
    const bf16_t* kvmla = (const bf16_t*)(ws + OFF_KVMLA);
    bf16_t* obuf = (bf16_t*)(ws + OFF_O);
    const int t0w = qc * 128 + w * 32, tq = t0w + ql;
    const size_t Tb = (size_t)b * kS;
    const bf16_t* qrow = qmla + (Tb + tq) * 384 + hd * 96;
    bf16x8 qf[6];
#pragma unroll
    for (int ks = 0; ks < 6; ++ks) qf[ks] = *(const bf16x8*)(qrow + ks * 16 + hh * 8);
    const float scl = 0.10206207261596575f * kLog2e;
    f32x16 o1[1][2]; o1[0][0] = zero16(); o1[0][1] = zero16();
    float m1[1] = {kNeg}, l1[1] = {0.f};
    auto skipf = [&](int kt) __attribute__((always_inline)) { return kt * 64 > t0w + 31; };
    attn_stream<96, 6, 1, false>(RangeIter{0, 2 * qc + 2}, LdMlaK{kvmla + Tb * 512 + hd * 128, cols + Tb * LDC + 1856}, LdVT{VT + (size_t)(b * 12 + 8 + hd) * 64 * 2048}, MaskCausal{}, skipf, qf, o1, m1, l1, scl, tq, __builtin_amdgcn_readfirstlane(t0w), smem, tid);
    const float inv = 1.f / (l1[0] + xor32f(l1[0], lane));
#pragma unroll
    for (int dt = 0; dt < 2; ++dt)
#pragma unroll
        for (int r = 0; r < 16; ++r) o1[0][dt][r] *= inv;
    write_o(o1[0], obuf, Tb + tq, 512 + hd * 64, hh);
}

DEV void swa_item(const Params& p, int layer, int b, int g, int q64, char* smem) {
    int tid = threadIdx.x; asm volatile("" : "+v"(tid));
    const int lane = tid & 63, w = tid >> 6, ql = lane & 31, hh = lane >> 5;
    char* ws = p.ws;
    const bf16_t* cols = (const bf16_t*)(ws + OFF_COLS);
    const bf16_t* VT = (const bf16_t*)(ws + OFF_VT);
    bf16_t* obuf = (bf16_t*)(ws + OFF_O);
    const int head = g * 2 + (w & 1);
    const int t0w = q64 * 64 + (w >> 1) * 32, tq = t0w + ql;
    const size_t Tb = (size_t)b * kS;
    const bf16_t* qrow = cols + (Tb + tq) * LDC + 1920 + head * 64;
    bf16x8 qf[4];
#pragma unroll
    for (int ks = 0; ks < 4; ++ks) qf[ks] = *(const bf16x8*)(qrow + ks * 16 + hh * 8);
    const float scl = 0.125f * kLog2e;
    f32x16 o1[1][2]; o1[0][0] = zero16(); o1[0][1] = zero16();
    float m1[1] = {p.sinks[layer * 4 + head] * 8.f}, l1[1] = {hh == 0 ? 1.f : 0.f};
    auto skipf = [&](int kt) __attribute__((always_inline)) { return (kt * 64 > t0w + 31) || (kt * 64 + 63 < t0w - 127); };
    const int lo = q64 >= 2 ? q64 - 2 : 0;
    attn_stream<64, 4, 1, false>(RangeIter{lo, q64 + 1}, LdRow{cols + Tb * LDC + 2176 + g * 64, LDC}, LdVT{VT + (size_t)(b * 12 + 6 + g) * 64 * 2048}, MaskWin<128>{}, skipf, qf, o1, m1, l1, scl, tq, __builtin_amdgcn_readfirstlane(t0w), smem, tid);
    const float inv = 1.f / (l1[0] + xor32f(l1[0], lane));
#pragma unroll
    for (int dt = 0; dt < 2; ++dt)
#pragma unroll
        for (int r = 0; r < 16; ++r) o1[0][dt][r] *= inv;
    write_o(o1[0], obuf, Tb + tq, 768 + head * 64, hh);
}

DEV void phase_attn(const Params& p, int layer, char* smem, int rep = 0) {
    unsigned* ctr = (unsigned*)(p.ws + OFF_CTRL) + 64 + layer * 16 + rep;
    volatile int* slot = (volatile int*)(smem + SM_SEL) + 48;
    for (;;) {
        __syncthreads();
        if (ltid() == 0) *slot = (int)atomicAdd(ctr, 1u);
        __syncthreads();
        const int idx = __builtin_amdgcn_readfirstlane(*slot);
        if (idx >= 2048) {
            if (layer != 0 || rep != 0 || idx >= 2048 + 1024) break;
            const int c = idx - 2048;
            const size_t u0 = (size_t)(c & 511) * 4096;
            if (c < 512) convert_fp8_range(p.pu, (unsigned char*)(p.ws + OFF_PU), u0, u0 + 4096, (size_t)ltid(), 256, kScaleU);
            else convert_fp8_range(p.pv, (unsigned char*)(p.ws + OFF_PV), u0, u0 + 4096, (size_t)ltid(), 256, kScaleV);
            continue;
        }
        const int level = 15 - (idx >> 7), r = idx & 127;
#if TS_A >= 0
        const unsigned long long tsa = __builtin_amdgcn_s_memrealtime();
#endif
        if (r < 32) { diff_item(p, layer, r >> 2, r & 3, level, smem); }
        else if (r < 64) { const int k = r - 32; mla_item(p, k >> 2, k & 3, level, smem); }
        else if (r < 96) { const int k = r - 64; nsa_item(p, layer, k >> 2, level * 4 + (3 - (k & 3)), smem); }
        else { const int k = r - 96; swa_item(p, layer, k >> 2, (k >> 1) & 1, level * 2 + (k & 1), smem); }
#if TS_A >= 0
        if (threadIdx.x == 0 && layer == 1) {
            const int ty = r >> 5;
            unsigned long long* ts = (unsigned long long*)(p.ws + 32768);
            atomicAdd(&ts[60 + ty], (unsigned long long)(__builtin_amdgcn_s_memrealtime() - tsa));
        }
#endif
    }
}

#define XB_TMO      128
#define XB_XCNT(j)  (256  + 64 * (j))
#define XB_XSUB(j)  (1280 + 64 * (j))
#define XB_XGEN(j)  (2304 + 64 * (j))
#define XB_TOP      3328
#define XB_TOPGEN   3392
#define XB_SPIN_CAP (1u << 22)
DEV unsigned xb_ld(unsigned* p) { return __hip_atomic_load(p, __ATOMIC_RELAXED, __HIP_MEMORY_SCOPE_AGENT); }
DEV unsigned xb_add(unsigned* p, unsigned v) { return __hip_atomic_fetch_add(p, v, __ATOMIC_RELAXED, __HIP_MEMORY_SCOPE_AGENT); }
DEV unsigned xb_xcc_id() { return (unsigned)__builtin_amdgcn_s_getreg((3 << 11) | 20) & 0xFu; }
#define XB_SPIN(cond, bar) do { unsigned _sp = 0; while (cond) { __builtin_amdgcn_s_sleep(1); \
    if ((++_sp & 255u) == 0u) { if (xb_ld(&(bar)[XB_TMO])) break; if (_sp > XB_SPIN_CAP) { atomicAdd(&(bar)[XB_TMO], 1u); break; } } } } while (0)
struct XcdBarrier { unsigned* bar; unsigned x; volatile LAS unsigned* st; };
DEV XcdBarrier xcd_barrier_post(unsigned* bar, volatile LAS unsigned* st) {
    XcdBarrier b; b.bar = bar; b.x = xb_xcc_id(); b.st = st;
    if (threadIdx.x == 0) st[2] = xb_add(&bar[XB_XCNT(b.x)], 1u);
    return b;
}
DEV void xcd_barrier_complete(unsigned* bar, unsigned x, unsigned& nloc, unsigned& nx) {
    const unsigned G = gridDim.x * gridDim.y * gridDim.z;
    unsigned sum, cnt, mine, sp = 0u;
    for (;;) {
        sum = 0u; cnt = 0u; mine = 0u;
#pragma unroll
        for (unsigned j = 0; j < 16; ++j) { const unsigned c = xb_ld(&bar[XB_XCNT(j)]); sum += c; cnt += (c > 0u) ? 1u : 0u; mine = (j == x) ? c : mine; }
        if (sum == G) break;
        __builtin_amdgcn_s_sleep(1);
        if ((++sp & 255u) == 0u) { if (xb_ld(&bar[XB_TMO])) break; if (sp > XB_SPIN_CAP) { atomicAdd(&bar[XB_TMO], 1u); break; } }
    }
    nloc = mine > 0u ? mine : 1u; nx = cnt > 0u ? cnt : 1u;
}
DEV void xcd_barrier(const XcdBarrier& b) {
    asm volatile("s_waitcnt vmcnt(0)" ::: "memory");
    __syncthreads();
    if (threadIdx.x == 0) {
        unsigned* bar = b.bar;
        asm volatile("" : "+v"(bar));
        __builtin_amdgcn_s_waitcnt(0);
        unsigned nloc = b.st[0], nx = b.st[1];
        if (nloc == 0u) { xcd_barrier_complete(bar, b.x, nloc, nx); b.st[0] = nloc; b.st[1] = nx; }
        const unsigned old = xb_add(&bar[XB_XSUB(b.x)], 1u);
        const unsigned gen = old / nloc;
        if (old + 1u == (gen + 1u) * nloc) {
            __builtin_amdgcn_fence(__ATOMIC_RELEASE, "agent");
            asm volatile("s_waitcnt vmcnt(0)" ::: "memory");
            const unsigned og = xb_add(&bar[XB_TOP], 1u);
            const unsigned tg = og / nx;
            if (og + 1u == (tg + 1u) * nx) xb_add(&bar[XB_TOPGEN], 1u);
            else XB_SPIN(xb_ld(&bar[XB_TOPGEN]) == tg, bar);
            __builtin_amdgcn_fence(__ATOMIC_ACQUIRE, "agent");
            xb_add(&bar[XB_XGEN(b.x)], 1u);
            asm volatile("s_waitcnt vmcnt(0)" ::: "memory");
        } else {
            XB_SPIN(xb_ld(&bar[XB_XGEN(b.x)]) == gen, bar);
            __builtin_amdgcn_fence(__ATOMIC_ACQUIRE, "agent");
            asm volatile("s_waitcnt vmcnt(0)" ::: "memory");
        }
    }
    __syncthreads();
}

DEV unsigned fkey(float f) { const unsigned u = __float_as_uint(f); return (u & 0x80000000u) ? ~u : (u | 0x80000000u); }
DEV float funkey(unsigned k) { return __uint_as_float((k & 0x80000000u) ? (k & 0x7fffffffu) : ~k); }
DEV void ins16(unsigned (&L)[16], unsigned x) {
#pragma unroll
    for (int i = 15; i >= 1; --i) { unsigned r; asm("v_med3_u32 %0, %1, %2, %3" : "=v"(r) : "v"(L[i - 1]), "v"(L[i]), "v"(x)); L[i] = r; }
    L[0] = L[0] > x ? L[0] : x;
}
DEV void phase_topk(const Params& p, char* smem) {
    const int tid = ltid();
    const float* S1 = (const float*)(p.ws + OFF_S1);
    const float* S2 = (const float*)(p.ws + OFF_S2);
    int* eid = (int*)(p.ws + OFF_EID);
    float* gate = (float*)(p.ws + OFF_GATE);
    unsigned char* ib = (unsigned char*)smem + tid * 32;
    for (int blk = blockIdx.x; blk < kT * 8 / 256; blk += gridDim.x) {
        const size_t row = (size_t)blk * 256 + tid;
        unsigned L1[16], L2[16];
#pragma unroll
        for (int i = 0; i < 16; ++i) { L1[i] = 0u; L2[i] = 0u; }
#pragma unroll 4
        for (int k = 0; k < 128; ++k) {
            const float a = S1[(size_t)k * (kT * 8) + row], b = S2[(size_t)k * (kT * 8) + row];
            ins16(L1, (fkey(a) & ~127u) | (unsigned)(127 - k));
            ins16(L2, (fkey(b) & ~127u) | (unsigned)(127 - k));
        }
        float v1[16], v2[16];
        __syncthreads();
#pragma unroll
        for (int i = 0; i < 16; ++i) {
            v1[i] = funkey(L1[i] & ~127u); v2[i] = funkey(L2[i] & ~127u);
            ib[i] = (unsigned char)(127u - (L1[i] & 127u)); ib[16 + i] = (unsigned char)(127u - (L2[i] & 127u));
        }
        unsigned C[16];
#pragma unroll
        for (int i = 0; i < 16; ++i) C[i] = 0u;
#pragma unroll
        for (int a = 0; a < 16; ++a)
#pragma unroll
            for (int b = 0; b < 16; ++b)
                if ((a + 1) * (b + 1) <= 16) ins16(C, (fkey(v1[a] + v2[b]) & ~255u) | (unsigned)(255 - (a * 16 + b)));
        float ts[16]; float sum = 0.f;
        const float tmax = funkey(C[0] & ~255u);
#pragma unroll
        for (int i = 0; i < 16; ++i) { ts[i] = __expf(funkey(C[i] & ~255u) - tmax); sum += ts[i]; }
        const float inv = 1.f / sum;
        int ev[16];
#pragma unroll
        for (int i = 0; i < 16; ++i) { const unsigned ci = 255u - (C[i] & 255u); ev[i] = (int)ib[ci >> 4] * 128 + (int)ib[16 + (ci & 15u)]; }
#pragma unroll
        for (int i = 0; i < 4; ++i) {
            *(int4*)(eid + row * 16 + 4 * i) = make_int4(ev[4 * i], ev[4 * i + 1], ev[4 * i + 2], ev[4 * i + 3]);
            *(float4*)(gate + row * 16 + 4 * i) = make_float4(ts[4 * i] * inv, ts[4 * i + 1] * inv, ts[4 * i + 2] * inv, ts[4 * i + 3] * inv);
        }
    }
}

struct EpiTop16 {
    unsigned (&L)[16];
    DEV void tile(int, int, const float* Cs, int tid) const {
        const int r = tid & 127, hk = tid >> 7;
        unsigned T[16];
#pragma unroll
        for (int i = 0; i < 16; ++i) T[i] = 0u;
#pragma unroll 4
        for (int k = 0; k < 64; ++k) {
            const int key = hk * 64 + k;
            ins16(T, (fkey(Cs[key * 128 + r]) & ~127u) | (unsigned)(127 - key));
        }
        __syncthreads();
        unsigned* X = (unsigned*)Cs;
        if (hk) {
#pragma unroll
            for (int i = 0; i < 16; ++i) X[r * 17 + i] = T[i];
        }
        __syncthreads();
        if (!hk) {
#pragma unroll
            for (int i = 0; i < 16; ++i) ins16(T, X[r * 17 + i]);
        }
#pragma unroll
        for (int i = 0; i < 16; ++i) L[i] = T[i];
    }
};
DEV void phase_route(const Params& p, int layer, char* smem) {
    char* ws = p.ws;
    int* eid = (int*)(ws + OFF_EID);
    float* gate = (float*)(ws + OFF_GATE);
    const bf16_t* qp = (const bf16_t*)(ws + OFF_QP);
    const bf16_t* subk = (const bf16_t*)(ws + OFF_SUBK) + (size_t)(layer * 2) * 16384;
    for (int nt = blockIdx.x; nt < kT * 8 / 128; nt += gridDim.x) {
        unsigned L1[16], L2[16];
        { EpiTop16 e1{L1}; gemm_tile(subk, 128, qp, 256, 128, 0, nt * 128, smem, e1); }
        { EpiTop16 e2{L2}; gemm_tile(subk + 16384, 128, qp + 128, 256, 128, 0, nt * 128, smem, e2); }
        const int tid = ltid();
        __syncthreads();
        if (tid < 128) {
            const size_t row = (size_t)nt * 128 + tid;
            unsigned char* ib = (unsigned char*)smem + tid * 32;
            float v1[16], v2[16];
#pragma unroll
            for (int i = 0; i < 16; ++i) {
                v1[i] = funkey(L1[i] & ~127u); v2[i] = funkey(L2[i] & ~127u);
                ib[i] = (unsigned char)(127u - (L1[i] & 127u)); ib[16 + i] = (unsigned char)(127u - (L2[i] & 127u));
            }
            unsigned C[16];
#pragma unroll
            for (int i = 0; i < 16; ++i) C[i] = 0u;
#pragma unroll
            for (int a = 0; a < 16; ++a)
#pragma unroll
                for (int b = 0; b < 16; ++b)
                    if ((a + 1) * (b + 1) <= 16) ins16(C, (fkey(v1[a] + v2[b]) & ~255u) | (unsigned)(255 - (a * 16 + b)));
            float ts[16]; float sum = 0.f;
            const float tmax = funkey(C[0] & ~255u);
#pragma unroll
            for (int i = 0; i < 16; ++i) { ts[i] = __expf(funkey(C[i] & ~255u) - tmax); sum += ts[i]; }
            const float inv = 1.f / sum;
            int ev[16];
#pragma unroll
            for (int i = 0; i < 16; ++i) { const unsigned ci = 255u - (C[i] & 255u); ev[i] = (int)ib[ci >> 4] * 128 + (int)ib[16 + (ci & 15u)]; }
#pragma unroll
            for (int i = 0; i < 4; ++i) {
                *(int4*)(eid + row * 16 + 4 * i) = make_int4(ev[4 * i], ev[4 * i + 1], ev[4 * i + 2], ev[4 * i + 3]);
                *(float4*)(gate + row * 16 + 4 * i) = make_float4(ts[4 * i] * inv, ts[4 * i + 1] * inv, ts[4 * i + 2] * inv, ts[4 * i + 3] * inv);
            }
        }
    }
}

DEV float row_sum_dpp(float v) {
    v += __int_as_float(__builtin_amdgcn_update_dpp(0, __float_as_int(v), 0xB1, 0xF, 0xF, true));
    v += __int_as_float(__builtin_amdgcn_update_dpp(0, __float_as_int(v), 0x4E, 0xF, 0xF, true));
    v += __int_as_float(__builtin_amdgcn_update_dpp(0, __float_as_int(v), 0x141, 0xF, 0xF, true));
    v += __int_as_float(__builtin_amdgcn_update_dpp(0, __float_as_int(v), 0x140, 0xF, 0xF, true));
    return v;
}
DEV float wave_sum_dpp(float v) {
    v = row_sum_dpp(v);
    const float r0 = __int_as_float(__builtin_amdgcn_readlane(__float_as_int(v), 0)), r1 = __int_as_float(__builtin_amdgcn_readlane(__float_as_int(v), 16));
    const float r2 = __int_as_float(__builtin_amdgcn_readlane(__float_as_int(v), 32)), r3 = __int_as_float(__builtin_amdgcn_readlane(__float_as_int(v), 48));
    return (r0 + r1) + (r2 + r3);
}
typedef float f32x2 __attribute__((ext_vector_type(2)));
typedef float f32x4 __attribute__((ext_vector_type(4)));

DEV SliceMap slice_map(const Params& p, char* smem) {
    unsigned* bar = (unsigned*)p.ws;
    const unsigned x = xb_xcc_id();
    int virt = 0, nx = 0, nloc = 1;
#pragma unroll
    for (unsigned j = 0; j < 16; ++j) {
        const unsigned c = xb_ld(&bar[XB_XCNT(j)]);
        if (c > 0u) { if (j < x) ++virt; ++nx; }
        if (j == x) nloc = (int)c;
    }
    SliceMap m;
    m.virt = __builtin_amdgcn_readfirstlane(virt); m.nx = __builtin_amdgcn_readfirstlane(nx > 0 ? nx : 1); m.nloc = __builtin_amdgcn_readfirstlane(nloc > 0 ? nloc : 1);
    m.rank = __builtin_amdgcn_readfirstlane((int)((volatile LAS unsigned*)(smem + SM_CTRL))[2]);
    return m;
}

typedef _Float16 half2_t __attribute__((ext_vector_type(2)));
DEV void phase_peer_u(const Params& p, int layer, char* smem, int rep = 0) {
    const int tid = ltid(), lane = tid & 63, w = tid >> 6, l8 = lane & 7, grp = lane >> 3;
    char* ws = p.ws;
    const SliceMap sm = slice_map(p, smem);
    const bf16_t* h = (const bf16_t*)(ws + OFF_H);
    const int* eid = (const int*)(ws + OFF_EID);
    _Float16* part = (_Float16*)(ws + OFF_S1) + (rep ? (size_t)8 * kT * 128 : 0);
    int* ids_l = (int*)(smem + w * 9216);
    const int nk = sm.rank < 512 ? (512 - sm.rank + sm.nloc - 1) / sm.nloc : 0;
    for (int s = sm.virt; s < 8; s += sm.nx) {
        if (nk == 0) break;
        const unsigned char* U = (const unsigned char*)(ws + OFF_PU) + (((size_t)layer * 8 + s) * 16384 << 7) + l8 * 16;
        uint4 ri0, ri1, ri2, ri3, rh0, rh1;
        auto load_oct = [&](int k) __attribute__((always_inline)) {
            const size_t o = (size_t)(sm.rank + k * sm.nloc) * 4 + w;
            const uint4* ip = (const uint4*)(eid + o * 1024) + lane;
            ri0 = ip[0]; ri1 = ip[64]; ri2 = ip[128]; ri3 = ip[192];
            const bf16_t* hp = h + (o * 8 + grp) * 1024 + s * 128 + l8 * 16;
            rh0 = *(const uint4*)hp; rh1 = *(const uint4*)(hp + 8);
        };
        half2_t hh[8];
        auto store_oct = [&]() __attribute__((always_inline)) {
            uint4* il = (uint4*)ids_l + lane;
            il[0] = ri0; il[64] = ri1; il[128] = ri2; il[192] = ri3;
            const unsigned hu[8] = {rh0.x, rh0.y, rh0.z, rh0.w, rh1.x, rh1.y, rh1.z, rh1.w};
#pragma unroll
            for (int i = 0; i < 8; ++i) hh[i] = (half2_t){(_Float16)lo16(hu[i]), (_Float16)hi16(hu[i])};
        };
        load_oct(0); store_oct();
#pragma unroll 1
        for (int k = 0; k < nk; ++k) {
            if (k + 1 < nk) load_oct(k + 1);
            const size_t o = (size_t)(sm.rank + k * sm.nloc) * 4 + w;
            _Float16* pp = part + ((size_t)s * kT + o * 8 + grp) * 128 + l8;
            uint4 va[8], vb[8];
            auto issue = [&](uint4 (&v)[8], int c) __attribute__((always_inline)) {
                const int4 i0 = *(const int4*)(ids_l + grp * 128 + c * 8), i1 = *(const int4*)(ids_l + grp * 128 + c * 8 + 4);
                const int e[8] = {i0.x, i0.y, i0.z, i0.w, i1.x, i1.y, i1.z, i1.w};
#pragma unroll
                for (int j = 0; j < 8; ++j) v[j] = *(const uint4*)(U + ((size_t)e[j] << 7));
            };
            auto compute = [&](const uint4 (&v)[8], int c) __attribute__((always_inline)) {
                float res = 0.f;
#pragma unroll
                for (int j = 0; j < 8; ++j) {
                    const unsigned d[4] = {v[j].x, v[j].y, v[j].z, v[j].w};
                    float acc = 0.f;
#pragma unroll
                    for (int q = 0; q < 4; ++q) {
                        const half2_t lo = __builtin_amdgcn_cvt_scalef32_pk_f16_fp8(d[q], 1.0f, false);
                        const half2_t hi = __builtin_amdgcn_cvt_scalef32_pk_f16_fp8(d[q], 1.0f, true);
                        acc = __builtin_amdgcn_fdot2(lo, hh[2 * q], acc, false);
                        acc = __builtin_amdgcn_fdot2(hi, hh[2 * q + 1], acc, false);
                    }
                    acc += __int_as_float(__builtin_amdgcn_update_dpp(0, __float_as_int(acc), 0xB1, 0xF, 0xF, true));
                    acc += __int_as_float(__builtin_amdgcn_update_dpp(0, __float_as_int(acc), 0x4E, 0xF, 0xF, true));
                    acc += __int_as_float(__builtin_amdgcn_update_dpp(0, __float_as_int(acc), 0x141, 0xF, 0xF, true));
                    res = (l8 == j) ? acc : res;
                    __builtin_amdgcn_sched_barrier(0);
                }
                pp[c * 8] = (_Float16)res;
            };
            issue(va, 0);
#pragma unroll
            for (int c = 0; c < 16; c += 2) {
                issue(vb, c + 1);
                __builtin_amdgcn_sched_barrier(0);
                compute(va, c);
                __builtin_amdgcn_sched_barrier(0);
                if (c + 2 < 16) issue(va, c + 2);
                __builtin_amdgcn_sched_barrier(0);
                compute(vb, c + 1);
                __builtin_amdgcn_sched_barrier(0);
            }
            if (k + 1 < nk) store_oct();
        }
    }
}

DEV void phase_peer_comb(const Params& p, int rep = 0) {
    const int tid = ltid();
    const _Float16* part = (const _Float16*)(p.ws + OFF_S1);
    float* gate = (float*)(p.ws + OFF_GATE);
    for (size_t i = (size_t)blockIdx.x * 256 + tid; i < (size_t)kT * 128 / 8; i += (size_t)gridDim.x * 256) {
        float a[8];
#pragma unroll
        for (int j = 0; j < 8; ++j) a[j] = 0.f;
#pragma unroll
        for (int x = 0; x < 8; ++x) {
            const uint4 u = *(const uint4*)(part + (size_t)x * kT * 128 + i * 8);
            const unsigned d[4] = {u.x, u.y, u.z, u.w};
#pragma unroll
            for (int j = 0; j < 4; ++j) { const half2_t hv = __builtin_bit_cast(half2_t, d[j]); a[2 * j] += (float)hv.x; a[2 * j + 1] += (float)hv.y; }
        }
        const float4 g0 = *(const float4*)(gate + i * 8), g1 = *(const float4*)(gate + i * 8 + 4);
        float4 o0, o1;
        o0.x = g0.x * gelu_tanh(a[0] * (1.f / kScaleU)); o0.y = g0.y * gelu_tanh(a[1] * (1.f / kScaleU));
        o0.z = g0.z * gelu_tanh(a[2] * (1.f / kScaleU)); o0.w = g0.w * gelu_tanh(a[3] * (1.f / kScaleU));
        o1.x = g1.x * gelu_tanh(a[4] * (1.f / kScaleU)); o1.y = g1.y * gelu_tanh(a[5] * (1.f / kScaleU));
        o1.z = g1.z * gelu_tanh(a[6] * (1.f / kScaleU)); o1.w = g1.w * gelu_tanh(a[7] * (1.f / kScaleU));
        if (rep == 0) { *(float4*)(gate + i * 8) = o0; *(float4*)(gate + i * 8 + 4) = o1; }
    }
}

DEV void phase_peer_v(const Params& p, int layer, char* smem, int rep = 0) {
    const int tid = ltid(), lane = tid & 63, w = tid >> 6, l8 = lane & 7, grp = lane >> 3;
    char* ws = p.ws;
    const SliceMap sm = slice_map(p, smem);
    bf16_t* xres = (bf16_t*)(ws + OFF_XRES);
    const int* eid = (const int*)(ws + OFF_EID);
    const float* wbuf = (const float*)(ws + OFF_GATE);
    const float* mod = (const float*)(ws + OFF_MOD);
    int* ids_l = (int*)(smem + w * 9216);
    float* w_l = (float*)(smem + w * 9216 + 4096);
    const int nk = sm.rank < 512 ? (512 - sm.rank + sm.nloc - 1) / sm.nloc : 0;
    for (int s = sm.virt; s < 8; s += sm.nx) {
        if (nk == 0) break;
        const unsigned char* V = (const unsigned char*)(ws + OFF_PV) + (((size_t)layer * 8 + s) * 16384 << 7) + l8 * 16;
        uint4 ri0, ri1, ri2, ri3, rw0, rw1, rw2, rw3;
        auto load_oct = [&](int k) __attribute__((always_inline)) {
            const size_t o = (size_t)(sm.rank + k * sm.nloc) * 4 + w;
            const uint4* ip = (const uint4*)(eid + o * 1024) + lane;
            const uint4* wp = (const uint4*)(wbuf + o * 1024) + lane;
            ri0 = ip[0]; ri1 = ip[64]; ri2 = ip[128]; ri3 = ip[192];
            rw0 = wp[0]; rw1 = wp[64]; rw2 = wp[128]; rw3 = wp[192];
        };
        auto store_oct = [&]() __attribute__((always_inline)) {
            uint4* il = (uint4*)ids_l + lane; uint4* wl = (uint4*)w_l + lane;
            il[0] = ri0; il[64] = ri1; il[128] = ri2; il[192] = ri3;
            wl[0] = rw0; wl[64] = rw1; wl[128] = rw2; wl[192] = rw3;
        };
        load_oct(0); store_oct();
#pragma unroll 1
        for (int k = 0; k < nk; ++k) {
            if (k + 1 < nk) load_oct(k + 1);
            const size_t o = (size_t)(sm.rank + k * sm.nloc) * 4 + w;
            const size_t t = o * 8 + grp;
            const int b = (int)(t >> 11);
            bf16_t* xp = xres + t * 1024 + s * 128 + l8 * 16;
            const float* g2 = mod + (size_t)(layer * 8 + b) * 6144 + 5120 + s * 128 + l8 * 16;
            float4 xa[4];
            { const uint4 u0 = *(const uint4*)xp, u1 = *(const uint4*)(xp + 8);
              xa[0] = make_float4(lo16(u0.x), hi16(u0.x), lo16(u0.y), hi16(u0.y)); xa[1] = make_float4(lo16(u0.z), hi16(u0.z), lo16(u0.w), hi16(u0.w));
              xa[2] = make_float4(lo16(u1.x), hi16(u1.x), lo16(u1.y), hi16(u1.y)); xa[3] = make_float4(lo16(u1.z), hi16(u1.z), lo16(u1.w), hi16(u1.w)); }
            half2_t out[8];
#pragma unroll
            for (int j = 0; j < 8; ++j) out[j] = (half2_t){(_Float16)0.f, (_Float16)0.f};
            uint4 va[8], vb[8];
            auto issue = [&](uint4 (&v)[8], int c) __attribute__((always_inline)) {
                const int4 i0 = *(const int4*)(ids_l + grp * 128 + c * 8), i1 = *(const int4*)(ids_l + grp * 128 + c * 8 + 4);
                const int e[8] = {i0.x, i0.y, i0.z, i0.w, i1.x, i1.y, i1.z, i1.w};
#pragma unroll
                for (int j = 0; j < 8; ++j) v[j] = *(const uint4*)(V + ((size_t)e[j] << 7));
            };
            auto compute = [&](const uint4 (&v)[8], int c) __attribute__((always_inline)) {
                const float4 w0 = *(const float4*)(w_l + grp * 128 + c * 8), w1 = *(const float4*)(w_l + grp * 128 + c * 8 + 4);
                const float wf[8] = {w0.x, w0.y, w0.z, w0.w, w1.x, w1.y, w1.z, w1.w};
#pragma unroll
                for (int j = 0; j < 8; ++j) {
                    const _Float16 wh = (_Float16)wf[j];
                    const half2_t ww = {wh, wh};
                    const unsigned d[4] = {v[j].x, v[j].y, v[j].z, v[j].w};
#pragma unroll
                    for (int q = 0; q < 4; ++q) {
                        const half2_t lo = __builtin_amdgcn_cvt_scalef32_pk_f16_fp8(d[q], 1.0f, false);
                        const half2_t hi = __builtin_amdgcn_cvt_scalef32_pk_f16_fp8(d[q], 1.0f, true);
                        out[2 * q] = __builtin_elementwise_fma(ww, lo, out[2 * q]);
                        out[2 * q + 1] = __builtin_elementwise_fma(ww, hi, out[2 * q + 1]);
                    }
                    __builtin_amdgcn_sched_barrier(0);
                }
            };
            issue(va, 0);
#pragma unroll
            for (int c = 0; c < 16; c += 2) {
                issue(vb, c + 1);
                __builtin_amdgcn_sched_barrier(0);
                compute(va, c);
                __builtin_amdgcn_sched_barrier(0);
                if (c + 2 < 16) issue(va, c + 2);
                __builtin_amdgcn_sched_barrier(0);
                compute(vb, c + 1);
                __builtin_amdgcn_sched_barrier(0);
            }
            if (rep == 0 || (float)out[0].x == 12345.678f) {
#pragma unroll
                for (int c = 0; c < 4; ++c) {
                    const float4 g4 = *(const float4*)(g2 + c * 4);
                    xa[c].x += g4.x * (float)out[2 * c].x * (1.f / kScaleV); xa[c].y += g4.y * (float)out[2 * c].y * (1.f / kScaleV);
                    xa[c].z += g4.z * (float)out[2 * c + 1].x * (1.f / kScaleV); xa[c].w += g4.w * (float)out[2 * c + 1].y * (1.f / kScaleV);
                }
                *(uint4*)xp = make_uint4(pack2(xa[0].x, xa[0].y), pack2(xa[0].z, xa[0].w), pack2(xa[1].x, xa[1].y), pack2(xa[1].z, xa[1].w));
                *(uint4*)(xp + 8) = make_uint4(pack2(xa[2].x, xa[2].y), pack2(xa[2].z, xa[2].w), pack2(xa[3].x, xa[3].y), pack2(xa[3].z, xa[3].w));
            }
            if (k + 1 < nk) store_oct();
        }
    }
}

DEV void phase_final(const Params& p) {
    const int tid = ltid(), lane = tid & 63, w = tid >> 6;
    const bf16_t* xs = (const bf16_t*)(p.ws + OFF_XRES);
    float4 g4[4];
#pragma unroll
    for (int i = 0; i < 4; ++i) g4[i] = *(const float4*)(p.final_g + i * 256 + lane * 4);
    for (int q0 = blockIdx.x; q0 < kT / 4; q0 += gridDim.x * 4) {
        float4 v[4][4];
#pragma unroll
        for (int u = 0; u < 4; ++u) {
            const int q = q0 + u * gridDim.x < kT / 4 ? q0 + u * gridDim.x : q0;
            const bf16_t* xr = xs + (size_t)(q * 4 + w) * 1024;
#pragma unroll
            for (int i = 0; i < 4; ++i) { const uint2 uu = *(const uint2*)(xr + i * 256 + lane * 4); v[u][i] = make_float4(lo16(uu.x), hi16(uu.x), lo16(uu.y), hi16(uu.y)); }
        }
#pragma unroll
        for (int u = 0; u < 4; ++u) {
            const int q = q0 + u * gridDim.x;
            if (q >= kT / 4) break;
            const int t = q * 4 + w;
            float ss = 0.f;
#pragma unroll
            for (int i = 0; i < 4; ++i) ss += v[u][i].x * v[u][i].x + v[u][i].y * v[u][i].y + v[u][i].z * v[u][i].z + v[u][i].w * v[u][i].w;
            ss = wave_sum(ss);
            const float rstd = rsqrtf(ss * (1.f / 1024.f) + kEps);
#pragma unroll
            for (int i = 0; i < 4; ++i) {
                const int col = i * 256 + lane * 4;
                *(float4*)(p.out + (size_t)t * 1024 + col) = make_float4(v[u][i].x * rstd * g4[i].x, v[u][i].y * rstd * g4[i].y, v[u][i].z * rstd * g4[i].z, v[u][i].w * rstd * g4[i].w);
            }
        }
    }
}

DEV uint4 pack8f(const float (&e)[8]) { return make_uint4(pack2(e[0], e[1]), pack2(e[2], e[3]), pack2(e[4], e[5]), pack2(e[6], e[7])); }
DEV float4 rope4(float4 v, float4 o, bool low, float4 c, float4 sn) {
    float4 r;
    r.x = v.x * c.x + (low ? -o.x : o.x) * sn.x; r.y = v.y * c.y + (low ? -o.y : o.y) * sn.y;
    r.z = v.z * c.z + (low ? -o.z : o.z) * sn.z; r.w = v.w * c.w + (low ? -o.w : o.w) * sn.w;
    return r;
}
struct EpiIn {
    char* ws;
    DEV void tile(int m0, int n0, const float* Cs, int tid) const {
        const int lane = tid & 63, w = tid >> 6, g16 = lane >> 4, c4 = lane & 15;
        bf16_t* cols = (bf16_t*)(ws + OFF_COLS);
        bf16_t* VT = (bf16_t*)(ws + OFF_VT);
        const float* rope = (const float*)(ws + OFF_ROPE);
        const float *cos64 = rope, *sin64 = rope + 2048 * 32, *cos32 = rope + 2048 * 64, *sin32 = rope + 2048 * 64 + 2048 * 16;
        const int b = m0 >> 11, s0 = m0 & 2047;
#pragma unroll 1
        for (int h = 0; h < 2; ++h) {
            const int cb = n0 + 64 * h;
            int vh = -1;
            if (cb == 448) vh = 0; else if (cb == 576) vh = 1; else if (cb >= 1216 && cb < 1472) vh = 2 + ((cb - 1216) >> 6); else if (cb >= 2304) vh = 6 + ((cb - 2304) >> 6);
            if (vh >= 0) {
                bf16_t* dst = VT + ((size_t)(b * 12 + vh) * 64 + lane) * 2048 + s0;
#pragma unroll
                for (int q = 0; q < 4; ++q) {
                    const int tc = w + 4 * q;
                    float e[8];
#pragma unroll
                    for (int j = 0; j < 8; ++j) e[j] = Cs[(tc * 8 + j) * 128 + h * 64 + lane];
                    *(uint4*)(dst + tc * 8) = pack8f(e);
                }
                continue;
            }
            const bool r64 = cb < 320 || cb == 384 || cb == 512 || (cb >= 1920 && cb < 2304);
            const bool r32 = (cb >= 704 && cb < 1216) || cb == 1856;
            bf16_t* dbase; int dld;
            if (cb == 256) { dbase = (bf16_t*)(ws + OFF_KC); dld = 64; } else if (cb == 320) { dbase = (bf16_t*)(ws + OFF_VC); dld = 64; } else { dbase = cols + cb; dld = LDC; }
            float4 cc[8], sn[8];
            if (r64 || r32) {
                const int i = (c4 * 4) & (r64 ? 31 : 15);
#pragma unroll
                for (int it = 0; it < 8; ++it) {
                    const int sq = s0 + it * 16 + w * 4 + g16;
                    cc[it] = *(const float4*)((r64 ? cos64 + sq * 32 : cos32 + sq * 16) + i);
                    sn[it] = *(const float4*)((r64 ? sin64 + sq * 32 : sin32 + sq * 16) + i);
                }
            }
#pragma unroll
            for (int it = 0; it < 8; ++it) {
                const int r = it * 16 + w * 4 + g16;
                float4 v = *(const float4*)(Cs + r * 128 + h * 64 + c4 * 4);
                if (r64 || r32) {
                    const float4 o = *(const float4*)(Cs + r * 128 + h * 64 + ((c4 * 4) ^ (r64 ? 32 : 16)));
                    v = rope4(v, o, !(c4 & (r64 ? 8 : 4)), cc[it], sn[it]);
                }
                *(uint2*)(dbase + (size_t)(m0 + r) * dld + c4 * 4) = make_uint2(pack2(v.x, v.y), pack2(v.z, v.w));
            }
        }
    }
};
DEV void mla_rstd_tile(const bf16_t* src  , int ncols, float* rsl, int tid) {
    const int lane = tid & 63, w = tid >> 6, g16 = lane >> 4, c4 = lane & 15;
#pragma unroll 2
    for (int it = 0; it < 8; ++it) {
        const int r = it * 16 + w * 4 + g16;
        const bf16_t* rp = src + (size_t)r * LDC + c4 * (ncols >> 4);
        float ss = 0.f;
        const uint4 u = *(const uint4*)rp;
        ss += lo16(u.x) * lo16(u.x) + hi16(u.x) * hi16(u.x) + lo16(u.y) * lo16(u.y) + hi16(u.y) * hi16(u.y)
            + lo16(u.z) * lo16(u.z) + hi16(u.z) * hi16(u.z) + lo16(u.w) * lo16(u.w) + hi16(u.w) * hi16(u.w);
        if (ncols == 256) {
            const uint4 u2 = *(const uint4*)(rp + 8);
            ss += lo16(u2.x) * lo16(u2.x) + hi16(u2.x) * hi16(u2.x) + lo16(u2.y) * lo16(u2.y) + hi16(u2.y) * hi16(u2.y)
                + lo16(u2.z) * lo16(u2.z) + hi16(u2.z) * hi16(u2.z) + lo16(u2.w) * lo16(u2.w) + hi16(u2.w) * hi16(u2.w);
        }
        ss = row_sum_dpp(ss);
        if (c4 == 0) rsl[r] = rsqrtf(ss / (float)ncols + kEps);
    }
}
struct EpiMlaQ {
    char* ws; const float* rsl;
    DEV void tile(int m0, int n0, const float* Cs, int tid) const {
        const int lane = tid & 63, w = tid >> 6, g16 = lane >> 4, c4 = lane & 15;
        bf16_t* qmla = (bf16_t*)(ws + OFF_QMLA);
        const float* rope = (const float*)(ws + OFF_ROPE);
        const float *cos32 = rope + 2048 * 64, *sin32 = rope + 2048 * 64 + 2048 * 16;
        const int s0 = m0 & 2047;
#pragma unroll 1
        for (int h = 0; h < 2; ++h) {
            const int col = n0 + 64 * h + c4 * 4;
            const bool isrope = ((col >> 5) % 3) == 2;
            float4 cc[8], sn[8];
#pragma unroll
            for (int it = 0; it < 8; ++it) {
                const int sq = s0 + it * 16 + w * 4 + g16, i = (c4 * 4) & 15;
                cc[it] = *(const float4*)(cos32 + sq * 16 + i); sn[it] = *(const float4*)(sin32 + sq * 16 + i);
            }
#pragma unroll
            for (int it = 0; it < 8; ++it) {
                const int r = it * 16 + w * 4 + g16;
                float4 v = *(const float4*)(Cs + r * 128 + h * 64 + c4 * 4);
                const float sc = rsl[r];
                v.x *= sc; v.y *= sc; v.z *= sc; v.w *= sc;
                float4 o = *(const float4*)(Cs + r * 128 + h * 64 + ((c4 * 4) ^ 16));
                o.x *= sc; o.y *= sc; o.z *= sc; o.w *= sc;
                const float4 vr = rope4(v, o, !(c4 & 4), cc[it], sn[it]);
                if (isrope) v = vr;
                *(uint2*)(qmla + (size_t)(m0 + r) * 384 + col) = make_uint2(pack2(v.x, v.y), pack2(v.z, v.w));
            }
        }
    }
};
struct EpiMlaKV {
    char* ws; const float* rsl;
    DEV void tile(int m0, int n0, const float* Cs, int tid) const {
        const int lane = tid & 63, w = tid >> 6, g16 = lane >> 4, c4 = lane & 15;
        bf16_t* kvmla = (bf16_t*)(ws + OFF_KVMLA);
        bf16_t* VT = (bf16_t*)(ws + OFF_VT);
        const int b = m0 >> 11, s0 = m0 & 2047, hd = n0 >> 7;
#pragma unroll 2
        for (int it = 0; it < 8; ++it) {
            const int r = it * 16 + w * 4 + g16;
            float4 v = *(const float4*)(Cs + r * 128 + c4 * 4);
            const float sc = rsl[r];
            *(uint2*)(kvmla + (size_t)(m0 + r) * 512 + n0 + c4 * 4) = make_uint2(pack2(v.x * sc, v.y * sc), pack2(v.z * sc, v.w * sc));
        }
        bf16_t* dst = VT + ((size_t)(b * 12 + 8 + hd) * 64 + lane) * 2048 + s0;
#pragma unroll
        for (int q = 0; q < 4; ++q) {
            const int tc = w + 4 * q;
            float e[8];
#pragma unroll
            for (int j = 0; j < 8; ++j) e[j] = Cs[(tc * 8 + j) * 128 + 64 + lane] * rsl[tc * 8 + j];
            *(uint4*)(dst + tc * 8) = pack8f(e);
        }
    }
};

DEV void phase_gemm_in(const Params& p, int layer, char* smem) {
    char* ws = p.ws;
    EpiIn epi{ws};
    gemm_phase(p, (const bf16_t*)(ws + OFF_H), 1024, (const bf16_t*)(ws + OFF_WIN) + (size_t)layer * 2432 * 1024, 1024, 1024, kT / 128, LDC / 128, smem, epi);
}
DEV void phase_gemm_mid(const Params& p, int layer, char* smem) {
    char* ws = p.ws;
    const float* misc = (const float*)(ws + OFF_MISC);
    const bf16_t* cols = (const bf16_t*)(ws + OFF_COLS);
    float* rsl = (float*)(smem + SM_CTRL + 256);
    const int nb_up = (int)gridDim.x > 32 ? (int)gridDim.x - 16 : (int)gridDim.x;
    for (int tile = ((int)gridDim.x > 32 && blockIdx.x >= 16) ? (int)blockIdx.x : (int)blockIdx.x; tile < 16 + 384 + 512;
         tile = (tile < 16 && (int)gridDim.x > 32) ? 16 + 384 + 512 : tile + nb_up) {
        if (tile < 16) {
            const int kv = tile >> 3, mt = tile & 7;
            EpiF32 epi{(float*)(ws + OFF_QP) + (size_t)kv * 1024 * 128, 128};
            gemm_tile((const bf16_t*)(ws + (kv ? OFF_VC : OFF_KC)), 1024, (const bf16_t*)(ws + (kv ? OFF_WCV : OFF_WCK)) + (size_t)layer * 128 * 2048, 1024, 1024, mt * 128, 0, smem, epi);
        } else if (tile < 16 + 384) {
            const int tt = tile - 16, m0 = (tt / 3) * 128;
            __syncthreads();
            mla_rstd_tile(cols + (size_t)m0 * LDC + 1472, 256, rsl, ltid());
            EpiMlaQ epi{ws, rsl};
            gemm_tile(cols + 1472, LDC, (const bf16_t*)(ws + OFF_WUQ) + (size_t)layer * 384 * 256, 256, 256, m0, (tt % 3) * 128, smem, epi);
        } else {
            const int tt = tile - 16 - 384, m0 = (tt / 4) * 128;
            __syncthreads();
            mla_rstd_tile(cols + (size_t)m0 * LDC + 1728, 128, rsl, ltid());
            EpiMlaKV epi{ws, rsl};
            gemm_tile(cols + 1728, LDC, (const bf16_t*)(ws + OFF_WUKV) + (size_t)layer * 512 * 128, 128, 128, m0, (tt % 4) * 128, smem, epi);
        }
    }
}
DEV void phase_gemm_out(const Params& p, int layer, char* smem) {
    char* ws = p.ws;
    EpiRes epi{layer == 0 ? (const void*)p.x : (const void*)(ws + OFF_XRES), layer != 0, (bf16_t*)(ws + OFF_XRES), (const float*)(ws + OFF_MOD) + (size_t)layer * 8 * 6144 + 2048};
    gemm_phase(p, (const bf16_t*)(ws + OFF_O), 1024, (const bf16_t*)(ws + OFF_WOUT) + (size_t)layer * 1024 * 1024, 1024, 1024, kT / 128, 8, smem, epi);
}
DEV void phase_gemm_wq(const Params& p, int layer, char* smem) {
    char* ws = p.ws;
    EpiBf16 epi{(bf16_t*)(ws + OFF_QP), 2048, nullptr, nullptr, 2048};
    gemm_phase(p, (const bf16_t*)(ws + OFF_H), 1024, (const bf16_t*)(ws + OFF_WQ) + (size_t)layer * 2048 * 1024, 1024, 1024, kT / 128, 16, smem, epi);
}
DEV void phase_scores(const Params& p, int layer, char* smem) {
    char* ws = p.ws;
    for (int tile = blockIdx.x; tile < 2048; tile += gridDim.x) {
        const int c = tile >> 10, nt = tile & 1023;
        EpiF32 epi{(float*)(ws + (c ? OFF_S2 : OFF_S1)), kT * 8};
        gemm_tile((const bf16_t*)(ws + OFF_SUBK) + (size_t)(layer * 2 + c) * 16384, 128, (const bf16_t*)(ws + OFF_QP) + c * 128, 256, 128, 0, nt * 128, smem, epi);
    }
}

constexpr int NPHASE = 16;
DEV void run_phase(const Params& p, int ph, int layer, char* smem, int rep = 0) {
    switch (ph) {
        case 0: phase_prologue(p, smem); break;
        case 1: phase_norm(p, layer, 0); break;
        case 2: phase_gemm_in(p, layer, smem); break;
        case 3: phase_layout1(p, smem); break;
        case 4: phase_gemm_mid(p, layer, smem); break;
        case 5: phase_layout2(p, layer, smem); break;
        case 6: phase_attn(p, layer, smem, rep); break;
        case 7: phase_gemm_out(p, layer, smem); break;
        case 8: phase_norm(p, layer, 1); break;
        case 9: phase_gemm_wq(p, layer, smem); break;
        case 10: phase_route(p, layer, smem); break;
        case 11: phase_topk(p, smem); break;
        case 12: phase_peer_u(p, layer, smem, rep); break;
        case 13: phase_peer_comb(p, rep); break;
        case 14: phase_peer_v(p, layer, smem, rep); break;
        case 15: if (layer == 0) phase_norm(p, 1, 0); else phase_final(p); break;
        default: break;
    }
}

#if !FUSED
template <int PH>
__global__ void __launch_bounds__(256, 2) k_phase(Params p, int layer) {
    __shared__ __attribute__((aligned(16))) char smem[SM_TOTAL];
    run_phase(p, PH, layer, smem);
}
template <int PH> static void launch_phase(const Params& p, int layer, hipStream_t stream) { k_phase<PH><<<512, 256, 0, stream>>>(p, layer); }
static void launch_ph(int ph, const Params& p, int layer, hipStream_t stream) {
    switch (ph) {
        case 0: launch_phase<0>(p, layer, stream); break;
        case 1: launch_phase<1>(p, layer, stream); break;
        case 2: launch_phase<2>(p, layer, stream); break;
        case 3: launch_phase<3>(p, layer, stream); break;
        case 4: launch_phase<4>(p, layer, stream); break;
        case 5: launch_phase<5>(p, layer, stream); break;
        case 6: launch_phase<6>(p, layer, stream); break;
        case 7: launch_phase<7>(p, layer, stream); break;
        case 8: launch_phase<8>(p, layer, stream); break;
        case 9: launch_phase<9>(p, layer, stream); break;
        case 10: launch_phase<10>(p, layer, stream); break;
        case 11: launch_phase<11>(p, layer, stream); break;
        case 12: launch_phase<12>(p, layer, stream); break;
    }
}
#else
#if TS_A >= 0
#define TSTAMP(I) if (blockIdx.x == 0 && threadIdx.x == 0) ((unsigned long long*)(p.ws + 32768))[I] = __builtin_amdgcn_s_memrealtime();
#else
#define TSTAMP(I)
#endif
__global__ void __launch_bounds__(256, 2) k_mega(Params p) {
    extern __shared__ __attribute__((aligned(1024))) char smem[];
    cg::grid_group grid = cg::this_grid();
    volatile LAS unsigned* st = (volatile LAS unsigned*)(smem + SM_CTRL);
    if (threadIdx.x == 0) { st[0] = 0u; st[1] = 0u; st[2] = 0u; }
    __syncthreads();
    const XcdBarrier xb = xcd_barrier_post((unsigned*)p.ws, st);
    TSTAMP(0)
    run_phase(p, 0, 0, smem);
    if (p.out == nullptr) grid.sync();
    xcd_barrier(xb);
    TSTAMP(1)
    run_phase(p, 1, 0, smem);
    xcd_barrier(xb);
    TSTAMP(2)
#define STEP(PH, L) { run_phase(p, PH, L, smem, 0); xcd_barrier(xb); TSTAMP(2 + (L) * 16 + (PH)) }
#define LAYER(L) STEP(2, L) STEP(4, L) STEP(6, L) STEP(7, L) STEP(8, L) STEP(9, L) STEP(10, L) STEP(12, L) STEP(13, L) STEP(14, L)
    LAYER(0)
    STEP(15, 0)
    LAYER(1)
    run_phase(p, 15, 1, smem);
#if TS_A >= 0
    TSTAMP(2 + 16 + 15)
    __syncthreads();
    if (blockIdx.x == 0 && threadIdx.x == 0) {
        const unsigned long long* ts = (const unsigned long long*)(p.ws + 32768);
        p.out[0] += (TS_A == 50) ? (float)ts[TS_B] * (0.01f / 512.f / 10.f) : (float)(ts[TS_B] - ts[TS_A]) * 0.001f;
    }
#endif
}
#endif

extern "C" void kernel_launch(void* const* d_in, const int* in_sizes, int n_in, void* d_out, int out_size, void* d_ws, size_t ws_size, hipStream_t stream) {
    Params p{};
    const float** pp = (const float**)&p;
    for (int i = 0; i < 28; ++i) pp[i] = (const float*)d_in[i];
    p.out = (float*)d_out;
    p.ws = (char*)d_ws;
    if (ws_size < OFF_END) fprintf(stderr, "workspace too small: %zu < %zu\n", ws_size, (size_t)OFF_END);
    (void)hipMemsetAsync(d_ws, 0, 65536, stream);
#if !FUSED
    launch_ph(0, p, 0, stream);
    launch_ph(1, p, 0, stream);
    for (int l = 0; l < 2; ++l)
        for (int ph = 2; ph < NPHASE; ++ph) launch_ph(ph, p, l, stream);
#else
    static int grid_blocks = 0;
    if (!grid_blocks) {
        int dev = 0, cus = 0, per_cu = 0;
        (void)hipGetDevice(&dev);
        (void)hipDeviceGetAttribute(&cus, hipDeviceAttributeMultiprocessorCount, dev);
        (void)hipFuncSetAttribute((const void*)k_mega, hipFuncAttributeMaxDynamicSharedMemorySize, SM_TOTAL);
        (void)hipOccupancyMaxActiveBlocksPerMultiprocessor(&per_cu, (const void*)k_mega, 256, SM_TOTAL);
        if (per_cu > 2) per_cu = 2;
        if (per_cu < 1) per_cu = 1;
        grid_blocks = cus * per_cu;
    }
    void* args[] = {&p};
    hipError_t e = hipLaunchCooperativeKernel((const void*)k_mega, dim3(grid_blocks), dim3(256), args, SM_TOTAL, stream);
    if (e != hipSuccess) fprintf(stderr, "cooperative launch failed: %s (grid %d)\n", hipGetErrorString(e), grid_blocks);
#endif
}
```

```cpp
#include <hip/hip_runtime.h>
#include <hip/hip_cooperative_groups.h>
#include <stdint.h>
#include <stdio.h>
namespace cg = cooperative_groups;

#ifndef FUSED
#define FUSED 1
#endif
#ifndef TS_A
#define TS_A -1
#define TS_B -1
#endif
#ifndef PROBE_PH
#define PROBE_PH -1
#define PROBE_L 1
#define PROBE_REP 0
#endif

#define DEV __device__ __forceinline__
#define LAS __attribute__((address_space(3)))
typedef unsigned short bf16_t;
typedef short bf16x8 __attribute__((ext_vector_type(8)));
typedef float f32x16 __attribute__((ext_vector_type(16)));

constexpr int kB = 8, kS = 2048, kT = kB * kS, kD = 1024, LDC = 2432;
constexpr float kEps = 1e-6f;
constexpr float kNeg = -1e30f;
constexpr float kLog2e = 1.4426950408889634f;
constexpr float kScaleU = 256.f, kScaleV = 32.f;

constexpr size_t OFF_CTRL = 0;
constexpr size_t OFF_MOD  = 65536;
constexpr size_t OFF_ROPE = OFF_MOD + 2ull * 8 * 6144 * 4;
constexpr size_t OFF_MISC = OFF_ROPE + 2048ull * 96 * 4;
constexpr size_t OFF_WIN  = OFF_MISC + 4096;
constexpr size_t OFF_WOUT = OFF_WIN + 2ull * 2432 * 1024 * 2;
constexpr size_t OFF_WQ   = OFF_WOUT + 2ull * 1024 * 1024 * 2;
constexpr size_t OFF_WUQ  = OFF_WQ + 2ull * 2048 * 1024 * 2;
constexpr size_t OFF_WUKV = OFF_WUQ + 2ull * 384 * 256 * 2;
constexpr size_t OFF_WCK  = OFF_WUKV + 2ull * 512 * 128 * 2;
constexpr size_t OFF_WCV  = OFF_WCK + 2ull * 128 * 2048 * 2;
constexpr size_t OFF_SUBK = OFF_WCV + 2ull * 128 * 2048 * 2;
constexpr size_t OFF_PU   = OFF_SUBK + 2ull * 2 * 128 * 128 * 2;
constexpr size_t OFF_PV   = OFF_PU + 2ull * 16384 * 1024;
constexpr size_t OFF_XRES = OFF_PV + 2ull * 16384 * 1024;
constexpr size_t OFF_H    = OFF_XRES + (size_t)kT * 1024 * 4;
constexpr size_t OFF_H8   = OFF_H + (size_t)kT * 1024 * 2;
constexpr size_t OFF_RSTD = OFF_H8 + (size_t)kT * 1024;
constexpr size_t OFF_KCMP = OFF_RSTD + 2ull * kT * 4;
constexpr size_t OFF_EID  = OFF_KCMP + 2ull * 1024 * 64 * 2;
constexpr size_t OFF_GATE = OFF_EID + (size_t)kT * 128 * 4;
constexpr size_t OFF_QP   = OFF_GATE + (size_t)kT * 128 * 4;
constexpr size_t OFF_COLS = OFF_QP + (size_t)kT * 2048 * 2;
constexpr size_t OFF_KC   = OFF_COLS + (size_t)kT * LDC * 2;
constexpr size_t OFF_VC   = OFF_KC + (size_t)(kT + 64) * 64 * 2;
constexpr size_t OFF_VT   = OFF_VC + (size_t)(kT + 64) * 64 * 2;
constexpr size_t OFF_QMLA = OFF_VT + 8ull * 12 * 64 * 2048 * 2;
constexpr size_t OFF_KVMLA = OFF_QMLA + (size_t)kT * 384 * 2;
constexpr size_t OFF_O    = OFF_KVMLA + (size_t)kT * 512 * 2;
constexpr size_t OFF_END  = OFF_O + (size_t)kT * 1024 * 2;
constexpr size_t OFF_S1 = OFF_COLS, OFF_S2 = OFF_COLS + (size_t)kT * 8 * 128 * 4;
static_assert(OFF_S2 + (size_t)kT * 8 * 128 * 4 <= OFF_O, "alias region too small");
static_assert(OFF_END <= (512ull << 20), "workspace too large");

struct Params {
    const float *x, *c, *ada_w, *ada_b, *norm_mix_g, *norm_ffn_g, *w_in, *pos_k, *pos_v, *cmp_wk, *cmp_wv;
    const float *lq1, *lk1, *lq2, *lk2, *sub_g, *mla_qg, *mla_wuq, *mla_kvg, *mla_wukv, *sinks, *w_out;
    const float *w_q, *subk1, *subk2, *pu, *pv, *final_g;
    float* out;
    char* ws;
};

DEV int ltid() { int t = threadIdx.x; asm volatile("" : "+v"(t)); return t; }
DEV float bf2f(bf16_t v) { return __uint_as_float(((unsigned)v) << 16); }
DEV bf16_t f2bf(float f) { unsigned u = __float_as_uint(f); u += 0x7fffu + ((u >> 16) & 1u); return (bf16_t)(u >> 16); }
DEV unsigned pack2(float lo, float hi) { unsigned r; asm("v_cvt_pk_bf16_f32 %0, %1, %2" : "=v"(r) : "v"(lo), "v"(hi)); return r; }
DEV float lo16(unsigned u) { return __uint_as_float(u << 16); }
DEV float hi16(unsigned u) { return __uint_as_float(u & 0xffff0000u); }
DEV float wave_sum(float v) {
#pragma unroll
    for (int o = 32; o > 0; o >>= 1) v += __shfl_xor(v, o, 64);
    return v;
}
DEV float xor32f(float v, int lane) { return __int_as_float(__builtin_amdgcn_ds_bpermute((lane ^ 32) << 2, __float_as_int(v))); }
DEV float lanef(float v, int src) { return __int_as_float(__builtin_amdgcn_ds_bpermute(src << 2, __float_as_int(v))); }
DEV f32x16 mfma32(bf16x8 a, bf16x8 b, f32x16 c) { return __builtin_amdgcn_mfma_f32_32x32x16_bf16(a, b, c, 0, 0, 0); }
DEV f32x16 zero16() { f32x16 z;
#pragma unroll
    for (int i = 0; i < 16; ++i) z[i] = 0.f;
    return z; }
DEV float gelu_tanh(float x) {
    const float u = 0.7978845608028654f * (x + 0.044715f * x * x * x);
    const float e = __expf(2.f * u);
    const float t = 1.f - 2.f / (e + 1.f);
    return 0.5f * x * (1.f + t);
}

template <class Epi>
DEV void gemm_tile(const bf16_t* __restrict__ A, int lda, const bf16_t* __restrict__ Bt, int ldb, int K, int m0, int n0, char* smem, const Epi& epi) {
    const int tid = ltid(), lane = tid & 63, w = tid >> 6, wm = w >> 1, wn = w & 1, ql = lane & 31, hh = lane >> 5;
    f32x16 acc[2][2];
#pragma unroll
    for (int i = 0; i < 2; ++i)
#pragma unroll
        for (int j = 0; j < 2; ++j) acc[i][j] = zero16();
    const int srow = lane >> 3, spos = lane & 7;
    const int c0 = spos ^ ((srow >> 1) & 7), c1 = spos ^ ((4 + (srow >> 1)) & 7);
    const bf16_t* Ag0 = A + (size_t)(m0 + w * 32 + srow) * lda + c0 * 8;
    const bf16_t* Ag1 = A + (size_t)(m0 + w * 32 + 8 + srow) * lda + c1 * 8;
    const bf16_t* Bg0 = Bt + (size_t)(n0 + w * 32 + srow) * ldb + c0 * 8;
    const bf16_t* Bg1 = Bt + (size_t)(n0 + w * 32 + 8 + srow) * ldb + c1 * 8;
    const size_t a16 = (size_t)16 * lda, b16 = (size_t)16 * ldb;
    auto stage = [&](int kt, int buf) __attribute__((always_inline)) {
        char* sa = smem + buf * 32768 + w * 4096;
        char* sb = sa + 16384;
        const int ko = kt * 64;
        __builtin_amdgcn_global_load_lds((const unsigned*)(Ag0 + ko), (LAS unsigned*)(sa), 16, 0, 0);
        __builtin_amdgcn_global_load_lds((const unsigned*)(Ag1 + ko), (LAS unsigned*)(sa + 1024), 16, 0, 0);
        __builtin_amdgcn_global_load_lds((const unsigned*)(Ag0 + a16 + ko), (LAS unsigned*)(sa + 2048), 16, 0, 0);
        __builtin_amdgcn_global_load_lds((const unsigned*)(Ag1 + a16 + ko), (LAS unsigned*)(sa + 3072), 16, 0, 0);
        __builtin_amdgcn_global_load_lds((const unsigned*)(Bg0 + ko), (LAS unsigned*)(sb), 16, 0, 0);
        __builtin_amdgcn_global_load_lds((const unsigned*)(Bg1 + ko), (LAS unsigned*)(sb + 1024), 16, 0, 0);
        __builtin_amdgcn_global_load_lds((const unsigned*)(Bg0 + b16 + ko), (LAS unsigned*)(sb + 2048), 16, 0, 0);
        __builtin_amdgcn_global_load_lds((const unsigned*)(Bg1 + b16 + ko), (LAS unsigned*)(sb + 3072), 16, 0, 0);
    };
    const int key = (ql >> 1) & 7;
    const int arow = (wm * 64 + ql) * 128, brow = (wn * 64 + ql) * 128;
    const int nk = K >> 6;
    __syncthreads();
    stage(0, 0);
    for (int kt = 0; kt < nk; ++kt) {
        asm volatile("s_waitcnt vmcnt(0)" ::: "memory");
        __syncthreads();
        if (kt + 1 < nk) stage(kt + 1, (kt + 1) & 1);
        const char* As = smem + (kt & 1) * 32768;
        const char* Bs = As + 16384;
#pragma unroll
        for (int ks = 0; ks < 4; ++ks) {
            const int co = ((ks * 2 + hh) ^ key) << 4;
            bf16x8 a[2], b[2];
#pragma unroll
            for (int i = 0; i < 2; ++i) {
                a[i] = *(const bf16x8*)(As + arow + i * 4096 + co);
                b[i] = *(const bf16x8*)(Bs + brow + i * 4096 + co);
            }
#pragma unroll
            for (int i = 0; i < 2; ++i)
#pragma unroll
                for (int j = 0; j < 2; ++j) acc[i][j] = mfma32(a[i], b[j], acc[i][j]);
        }
    }
    __syncthreads();
    float* Cs = (float*)smem;
#pragma unroll
    for (int i = 0; i < 2; ++i)
#pragma unroll
        for (int j = 0; j < 2; ++j)
#pragma unroll
            for (int r = 0; r < 16; ++r)
                Cs[(wm * 64 + i * 32 + (r & 3) + 8 * (r >> 2) + 4 * hh) * 128 + wn * 64 + j * 32 + ql] = acc[i][j][r];
    __syncthreads();
    epi.tile(m0, n0, Cs, tid);
}

struct EpiBf16 {
    bf16_t* C; int ldc; const float* rowscale; const float* colbias; int nvalid;
    DEV void tile(int m0, int n0, const float* Cs, int tid) const {
#pragma unroll
        for (int it = 0; it < 8; ++it) {
            const int id = tid + 256 * it, r = id >> 4, c8 = (id & 15) * 8;
            if (n0 + c8 >= nvalid) continue;
            float4 a = *(const float4*)(Cs + r * 128 + c8), b = *(const float4*)(Cs + r * 128 + c8 + 4);
            if (rowscale) { const float sc = rowscale[m0 + r]; a.x *= sc; a.y *= sc; a.z *= sc; a.w *= sc; b.x *= sc; b.y *= sc; b.z *= sc; b.w *= sc; }
            if (colbias) { const float4 ba = *(const float4*)(colbias + n0 + c8), bb = *(const float4*)(colbias + n0 + c8 + 4);
                a.x += ba.x; a.y += ba.y; a.z += ba.z; a.w += ba.w; b.x += bb.x; b.y += bb.y; b.z += bb.z; b.w += bb.w; }
            *(uint4*)(C + (size_t)(m0 + r) * ldc + n0 + c8) = make_uint4(pack2(a.x, a.y), pack2(a.z, a.w), pack2(b.x, b.y), pack2(b.z, b.w));
        }
    }
};
struct EpiF32 {
    float* C; int ldc;
    DEV void tile(int m0, int n0, const float* Cs, int tid) const {
#pragma unroll
        for (int it = 0; it < 16; ++it) {
            const int id = tid + 256 * it, r = id >> 5, c4 = (id & 31) * 4;
            *(float4*)(C + (size_t)(m0 + r) * ldc + n0 + c4) = *(const float4*)(Cs + r * 128 + c4);
        }
    }
};
struct EpiRes {
    const void* xin; bool in_bf16; bf16_t* xout; const float* gate;
    DEV void tile(int m0, int n0, const float* Cs, int tid) const {
        const float* g = gate + (size_t)(m0 >> 11) * 6144 + n0;
#pragma unroll
        for (int it = 0; it < 8; ++it) {
            const int id = tid + 256 * it, r = id >> 4, c8 = (id & 15) * 8;
            const float4 v0 = *(const float4*)(Cs + r * 128 + c8), v1 = *(const float4*)(Cs + r * 128 + c8 + 4);
            const float4 g0 = *(const float4*)(g + c8), g1 = *(const float4*)(g + c8 + 4);
            float4 x0, x1;
            if (in_bf16) {
                const uint4 u = *(const uint4*)((const bf16_t*)xin + (size_t)(m0 + r) * 1024 + n0 + c8);
                x0 = make_float4(lo16(u.x), hi16(u.x), lo16(u.y), hi16(u.y)); x1 = make_float4(lo16(u.z), hi16(u.z), lo16(u.w), hi16(u.w));
            } else {
                const float* xp = (const float*)xin + (size_t)(m0 + r) * 1024 + n0 + c8;
                x0 = *(const float4*)xp; x1 = *(const float4*)(xp + 4);
            }
            *(uint4*)(xout + (size_t)(m0 + r) * 1024 + n0 + c8) =
                make_uint4(pack2(x0.x + g0.x * v0.x, x0.y + g0.y * v0.y), pack2(x0.z + g0.z * v0.z, x0.w + g0.w * v0.w),
                           pack2(x1.x + g1.x * v1.x, x1.y + g1.y * v1.y), pack2(x1.z + g1.z * v1.z, x1.w + g1.w * v1.w));
        }
    }
};

struct SliceMap { int virt, nx, nloc, rank; };
DEV SliceMap slice_map(const Params& p, char* smem);
template <class Epi>
DEV void gemm_phase(const Params& p, const bf16_t* A, int lda, const bf16_t* Bt, int ldb, int K, int mtiles, int ntiles, char* smem, const Epi& epi) {
    const SliceMap sm = slice_map(p, smem);
    if (sm.nx == 8 && (mtiles & 3) == 0) {
        const int mclass = sm.virt >> 1, nh = sm.virt & 1;
        const int h0 = (ntiles + 1) >> 1;
        const int nb = nh ? ntiles - h0 : h0, nbase = nh ? h0 : 0;
        const int total = (mtiles >> 2) * nb;
        for (int i = sm.rank; i < total; i += sm.nloc) {
            const int mt = mclass + 4 * (i / nb), nt = nbase + i % nb;
            gemm_tile(A, lda, Bt, ldb, K, mt * 128, nt * 128, smem, epi);
        }
        return;
    }
    for (int tile = blockIdx.x; tile < mtiles * ntiles; tile += gridDim.x) {
        const int mt = tile / ntiles, nt = tile % ntiles;
        gemm_tile(A, lda, Bt, ldb, K, mt * 128, nt * 128, smem, epi);
    }
}

DEV int win_srccol(int n) {
    if (n < 652) return n;
    if (n < 704) return -1;
    if (n < 1888) return n - 52;
    if (n < 1920) return -1;
    return n - 84;
}
DEV void transpose_tile(const float* __restrict__ src, int ld_src, int nsrc_valid, int mode, const float* __restrict__ rowscale,
                        bf16_t* __restrict__ dst, int K, int n0, int k0, char* smem) {
    bf16_t* Ls = (bf16_t*)smem;
    const int tid = ltid();
    __syncthreads();
    const int nn = tid & 63, n = n0 + nn;
    const int sc = (mode == 1) ? win_srccol(n) : (mode == 2) ? (n & 63) : (n < nsrc_valid ? n : -1);
    const int kshift = (mode == 2 && n >= 64) ? 1024 : 0;
#pragma unroll 4
    for (int i = 0; i < 16; ++i) {
        const int kk = (tid >> 6) + 4 * i;
        float v = 0.f;
        if (sc >= 0) { v = src[(size_t)(k0 + kk + kshift) * ld_src + sc]; if (rowscale) v *= rowscale[k0 + kk]; }
        Ls[nn * 72 + kk] = f2bf(v);
    }
    __syncthreads();
#pragma unroll
    for (int i = 0; i < 2; ++i) {
        const int r = (tid >> 3) + 32 * i, ch = tid & 7;
        *(uint4*)(dst + (size_t)(n0 + r) * K + k0 + ch * 8) = *(const uint4*)(Ls + r * 72 + ch * 8);
    }
}

DEV void convert_stream(const float* __restrict__ src, bf16_t* __restrict__ dst, size_t n8) {
    const int tid = ltid();
    for (size_t i = (size_t)blockIdx.x * 256 + tid; i < n8; i += (size_t)gridDim.x * 256) {
        const float4 a = *(const float4*)(src + i * 8), b = *(const float4*)(src + i * 8 + 4);
        uint4 o; o.x = pack2(a.x, a.y); o.y = pack2(a.z, a.w); o.z = pack2(b.x, b.y); o.w = pack2(b.z, b.w);
        *(uint4*)(dst + i * 8) = o;
    }
}

DEV void convert_fp8_range(const float* __restrict__ src, unsigned char* __restrict__ dst, size_t u0, size_t n16, size_t first, size_t stride, float scale) {
    for (size_t i0 = u0 + first; i0 < n16; i0 += stride * 4) {
        float4 q[4][4];
#pragma unroll
        for (int u = 0; u < 4; ++u) {
            const size_t i = i0 + u * stride < n16 ? i0 + u * stride : i0;
#pragma unroll
            for (int c = 0; c < 4; ++c) q[u][c] = *(const float4*)(src + i * 16 + c * 4);
        }
#pragma unroll
        for (int u = 0; u < 4; ++u) {
            const size_t i = i0 + u * stride;
            if (i >= n16) break;
            unsigned o[4];
#pragma unroll
            for (int j = 0; j < 4; ++j) {
                const float4 v = q[u][j];
                unsigned w = 0u;
                w = __builtin_amdgcn_cvt_pk_fp8_f32(fminf(fmaxf(v.x * scale, -440.f), 440.f), fminf(fmaxf(v.y * scale, -440.f), 440.f), w, false);
                w = __builtin_amdgcn_cvt_pk_fp8_f32(fminf(fmaxf(v.z * scale, -440.f), 440.f), fminf(fmaxf(v.w * scale, -440.f), 440.f), w, true);
                o[j] = w;
            }
            const size_t rowg = i >> 6; const int c16 = (int)(i & 63);
            const size_t l = rowg >> 14, row = rowg & 16383;
            *(uint4*)(dst + (((l * 8 + (c16 >> 3)) * 16384 + row) << 7) + (c16 & 7) * 16) = make_uint4(o[0], o[1], o[2], o[3]);
        }
    }
}

DEV void convert_fp8_stream(const float* __restrict__ src, unsigned char* __restrict__ dst, size_t n16, float scale) {
    const int tid = ltid();
    convert_fp8_range(src, dst, 0, n16, (size_t)blockIdx.x * 256 + tid, (size_t)gridDim.x * 256, scale);
}

constexpr int J_ROPE = 384, J_MOD = 192, J_MISC = 5;
constexpr int J_TW_L = 608 + 256 + 512 + 24 + 16 + 64 + 64;
constexpr int J_TOTAL = J_ROPE + J_MOD + J_MISC + 2 * J_TW_L;

DEV void prologue_job(const Params& p, int job, char* smem) {
    const int tid = ltid();
    char* ws = p.ws;
    if (job < J_MISC) {
        float* misc = (float*)(ws + OFF_MISC);
        if (job < 4) {
            const int l = job >> 1, kv = job & 1;
            const float* pos = (kv ? p.pos_v : p.pos_k) + l * 2048;
            const float* wsrc = (kv ? p.cmp_wv : p.cmp_wk) + (size_t)l * 2048 * 64;
            float* red = (float*)smem;
            __syncthreads();
            const int kp = tid >> 6, n = tid & 63;
            float acc = 0.f;
            for (int k0 = kp * 512; k0 < kp * 512 + 512; k0 += 16) {
                float wv[16];
#pragma unroll
                for (int u = 0; u < 16; ++u) wv[u] = wsrc[(size_t)(k0 + u) * 64 + n];
#pragma unroll
                for (int u = 0; u < 16; ++u) acc += pos[k0 + u] * wv[u];
            }
            red[kp * 64 + n] = acc;
            __syncthreads();
            if (tid < 64) misc[(l * 2 + kv) * 64 + tid] = red[tid] + red[64 + tid] + red[128 + tid] + red[192 + tid];
        } else if (tid < 2) {
            const int l = tid;
            float d1 = 0.f, d2 = 0.f;
            for (int i = 0; i < 32; ++i) { d1 += p.lq1[l * 32 + i] * p.lk1[l * 32 + i]; d2 += p.lq2[l * 32 + i] * p.lk2[l * 32 + i]; }
            const float lam_init = 0.8f - 0.6f * expf(-0.3f * (float)l);
            misc[256 + l] = expf(d1) - expf(d2) + lam_init;
            misc[258 + l] = 1.f - lam_init;
        }
        return;
    }
    job -= J_MISC;
    if (job < J_MOD) {
        const int l = job / 96, n0 = (job % 96) * 64;
        float* sc = (float*)smem;
        __syncthreads();
        for (int i = tid; i < 8192; i += 256) { const float v = p.c[i]; sc[i] = v / (1.f + __expf(-v)); }
        __syncthreads();
        const int kp = tid >> 6, col = tid & 63;
        float acc[8];
#pragma unroll
        for (int b = 0; b < 8; ++b) acc[b] = 0.f;
        const float* wp = p.ada_w + (size_t)l * 1024 * 6144 + n0 + col;
        for (int k0 = kp * 256; k0 < kp * 256 + 256; k0 += 16) {
            float wv[16];
#pragma unroll
            for (int u = 0; u < 16; ++u) wv[u] = wp[(size_t)(k0 + u) * 6144];
#pragma unroll
            for (int u = 0; u < 16; ++u)
#pragma unroll
                for (int b = 0; b < 8; ++b) acc[b] += sc[b * 1024 + k0 + u] * wv[u];
        }
        float* red = sc + 8192;
#pragma unroll
        for (int b = 0; b < 8; ++b) red[(kp * 8 + b) * 64 + col] = acc[b];
        __syncthreads();
        float* mod = (float*)(ws + OFF_MOD);
        for (int idx = tid; idx < 512; idx += 256) {
            const int b = idx >> 6, cl = idx & 63;
            const float v = red[(0 * 8 + b) * 64 + cl] + red[(1 * 8 + b) * 64 + cl] + red[(2 * 8 + b) * 64 + cl] + red[(3 * 8 + b) * 64 + cl];
            mod[(size_t)(l * 8 + b) * 6144 + n0 + cl] = v + p.ada_b[l * 6144 + n0 + cl];
        }
        return;
    }
    job -= J_MOD;
    if (job < J_ROPE) {
        const int idx = job * 256 + tid;
        const int s = idx / 48, j = idx % 48;
        float* rope = (float*)(ws + OFF_ROPE);
        float inv; float *pc, *ps;
        if (j < 32) { inv = exp2f(-(float)j * (13.287712379549449f / 32.f)); pc = rope + s * 32 + j; ps = rope + 2048 * 32 + s * 32 + j; }
        else { const int i = j - 32; inv = exp2f(-(float)i * (13.287712379549449f / 16.f)); pc = rope + 2048 * 64 + s * 16 + i; ps = rope + 2048 * 64 + 2048 * 16 + s * 16 + i; }
        const double a = (double)s * (double)inv;
        const double kk = rint(a * 0.15915494309189535);
        const float r = (float)fma(-kk, 6.283185307179586, a);
        *pc = cosf(r); *ps = sinf(r);
        return;
    }
    job -= J_ROPE;
    const int l = job / J_TW_L; int j = job % J_TW_L;
    if (j < 608) { transpose_tile(p.w_in + (size_t)l * 1024 * 2348, 2348, 2348, 1, nullptr, (bf16_t*)(ws + OFF_WIN) + (size_t)l * 2432 * 1024, 1024, (j / 16) * 64, (j % 16) * 64, smem); return; }
    j -= 608;
    if (j < 256) { transpose_tile(p.w_out + (size_t)l * 1024 * 1024, 1024, 1024, 0, nullptr, (bf16_t*)(ws + OFF_WOUT) + (size_t)l * 1024 * 1024, 1024, (j / 16) * 64, (j % 16) * 64, smem); return; }
    j -= 256;
    if (j < 512) { transpose_tile(p.w_q + (size_t)l * 1024 * 2048, 2048, 2048, 0, nullptr, (bf16_t*)(ws + OFF_WQ) + (size_t)l * 2048 * 1024, 1024, (j / 16) * 64, (j % 16) * 64, smem); return; }
    j -= 512;
    if (j < 24) { transpose_tile(p.mla_wuq + (size_t)l * 256 * 384, 384, 384, 0, p.mla_qg + l * 256, (bf16_t*)(ws + OFF_WUQ) + (size_t)l * 384 * 256, 256, (j / 4) * 64, (j % 4) * 64, smem); return; }
    j -= 24;
    if (j < 16) { transpose_tile(p.mla_wukv + (size_t)l * 128 * 512, 512, 512, 0, p.mla_kvg + l * 128, (bf16_t*)(ws + OFF_WUKV) + (size_t)l * 512 * 128, 128, (j / 2) * 64, (j % 2) * 64, smem); return; }
    j -= 16;
    if (j < 64) { if (j < 32) transpose_tile(p.cmp_wk + (size_t)l * 2048 * 64, 64, 64, 2, nullptr, (bf16_t*)(ws + OFF_WCK) + (size_t)l * 128 * 2048, 1024, (j / 16) * 64, (j % 16) * 64, smem); return; }
    j -= 64;
    if (j < 32) transpose_tile(p.cmp_wv + (size_t)l * 2048 * 64, 64, 64, 2, nullptr, (bf16_t*)(ws + OFF_WCV) + (size_t)l * 128 * 2048, 1024, (j / 16) * 64, (j % 16) * 64, smem);
}

#if TS_A >= 0
#define PSTAMP(I) if (blockIdx.x == 0 && threadIdx.x == 0) ((unsigned long long*)(p.ws + 32768))[I] = __builtin_amdgcn_s_memrealtime();
#else
#define PSTAMP(I)
#endif
DEV void phase_prologue(const Params& p, char* smem) {
    {
        unsigned* ctr = (unsigned*)p.ws + 100;
        volatile int* slot = (volatile int*)(smem + 65536 + 64);
        int job = blockIdx.x;
        while (job < J_TOTAL) {
            prologue_job(p, job, smem);
            __syncthreads();
            if (ltid() == 0) *slot = (int)gridDim.x + (int)atomicAdd(ctr, 1u);
            __syncthreads();
            job = __builtin_amdgcn_readfirstlane(*slot);
        }
    }
    PSTAMP(42)
    char* ws = p.ws;
    PSTAMP(43)
    PSTAMP(44)
    for (int l = 0; l < 2; ++l) {
        convert_stream(p.subk1 + (size_t)l * 16384, (bf16_t*)(ws + OFF_SUBK) + (size_t)(l * 2 + 0) * 16384, 16384 / 8);
        convert_stream(p.subk2 + (size_t)l * 16384, (bf16_t*)(ws + OFF_SUBK) + (size_t)(l * 2 + 1) * 16384, 16384 / 8);
    }
}

DEV void phase_norm(const Params& p, int layer, int which) {
    const int tid = ltid(), lane = tid & 63, w = tid >> 6;
    const bool xbf = !(layer == 0 && which == 0);
    const float* xs = p.x; const bf16_t* xb = (const bf16_t*)(p.ws + OFF_XRES);
    const float* g = (which == 0 ? p.norm_mix_g : p.norm_ffn_g) + layer * 1024;
    const float* mod = (const float*)(p.ws + OFF_MOD) + (size_t)layer * 8 * 6144;
    bf16_t* h = (bf16_t*)(p.ws + OFF_H);
    float gg[2][8];
#pragma unroll
    for (int i = 0; i < 2; ++i) { const float4 a = *(const float4*)(g + (lane + 64 * i) * 8), c = *(const float4*)(g + (lane + 64 * i) * 8 + 4);
        gg[i][0] = a.x; gg[i][1] = a.y; gg[i][2] = a.z; gg[i][3] = a.w; gg[i][4] = c.x; gg[i][5] = c.y; gg[i][6] = c.z; gg[i][7] = c.w; }
    for (int q0 = blockIdx.x; q0 < kT / 4; q0 += gridDim.x * 4) {
        float v[4][2][8];
#pragma unroll
        for (int u = 0; u < 4; ++u) {
            const int q = q0 + u * gridDim.x < kT / 4 ? q0 + u * gridDim.x : q0;
#pragma unroll
            for (int i = 0; i < 2; ++i) {
                const int col = (lane + 64 * i) * 8;
                if (xbf) {
                    const uint4 uu = *(const uint4*)(xb + (size_t)(q * 4 + w) * 1024 + col);
                    v[u][i][0] = lo16(uu.x); v[u][i][1] = hi16(uu.x); v[u][i][2] = lo16(uu.y); v[u][i][3] = hi16(uu.y);
                    v[u][i][4] = lo16(uu.z); v[u][i][5] = hi16(uu.z); v[u][i][6] = lo16(uu.w); v[u][i][7] = hi16(uu.w);
                } else {
                    const float* xr = xs + (size_t)(q * 4 + w) * 1024 + col;
                    const float4 a = *(const float4*)xr, c = *(const float4*)(xr + 4);
                    v[u][i][0] = a.x; v[u][i][1] = a.y; v[u][i][2] = a.z; v[u][i][3] = a.w; v[u][i][4] = c.x; v[u][i][5] = c.y; v[u][i][6] = c.z; v[u][i][7] = c.w;
                }
            }
        }
#pragma unroll
        for (int u = 0; u < 4; ++u) {
            const int q = q0 + u * gridDim.x;
            if (q >= kT / 4) break;
            const int t = q * 4 + w, b = t >> 11;
            float ss = 0.f;
#pragma unroll
            for (int i = 0; i < 2; ++i)
#pragma unroll
                for (int j = 0; j < 8; ++j) ss += v[u][i][j] * v[u][i][j];
            ss = wave_sum(ss);
            const float rstd = rsqrtf(ss * (1.f / 1024.f) + kEps);
            const float* sh = mod + (size_t)b * 6144 + (which ? 3072 : 0);
            const float* sc = sh + 1024;
#pragma unroll
            for (int i = 0; i < 2; ++i) {
                const int col = (lane + 64 * i) * 8;
                const float4 s0 = *(const float4*)(sc + col), s1 = *(const float4*)(sc + col + 4), h0 = *(const float4*)(sh + col), h1 = *(const float4*)(sh + col + 4);
                const float sv[8] = {s0.x, s0.y, s0.z, s0.w, s1.x, s1.y, s1.z, s1.w}, hv[8] = {h0.x, h0.y, h0.z, h0.w, h1.x, h1.y, h1.z, h1.w};
                float o[8];
#pragma unroll
                for (int j = 0; j < 8; ++j) o[j] = v[u][i][j] * rstd * gg[i][j] * (1.f + sv[j]) + hv[j];
                *(uint4*)(h + (size_t)t * 1024 + col) = make_uint4(pack2(o[0], o[1]), pack2(o[2], o[3]), pack2(o[4], o[5]), pack2(o[6], o[7]));
            }
        }
    }
}

DEV void rope8(uint4& x1, uint4& x2, const float (&cc)[8], const float (&ss)[8]) {
    unsigned a[4] = {x1.x, x1.y, x1.z, x1.w}, b[4] = {x2.x, x2.y, x2.z, x2.w};
#pragma unroll
    for (int i = 0; i < 4; ++i) {
        const float a0 = lo16(a[i]), a1 = hi16(a[i]), b0 = lo16(b[i]), b1 = hi16(b[i]);
        const float o10 = a0 * cc[2 * i] - b0 * ss[2 * i], o11 = a1 * cc[2 * i + 1] - b1 * ss[2 * i + 1];
        const float o20 = a0 * ss[2 * i] + b0 * cc[2 * i], o21 = a1 * ss[2 * i + 1] + b1 * cc[2 * i + 1];
        a[i] = pack2(o10, o11); b[i] = pack2(o20, o21);
    }
    x1 = make_uint4(a[0], a[1], a[2], a[3]); x2 = make_uint4(b[0], b[1], b[2], b[3]);
}
DEV void vt_tile(const bf16_t* __restrict__ src, int ld, bf16_t* __restrict__ dst, char* smem) {
    bf16_t* Ls = (bf16_t*)smem;
    const int tid = ltid();
    __syncthreads();
#pragma unroll
    for (int i = 0; i < 2; ++i) {
        const int id = tid + 256 * i, tok = id >> 3, ch = id & 7;
        *(uint4*)(Ls + tok * 72 + ch * 8) = *(const uint4*)(src + (size_t)tok * ld + ch * 8);
    }
    __syncthreads();
#pragma unroll
    for (int i = 0; i < 2; ++i) {
        const int id = tid + 256 * i, d = id & 63, tc = id >> 6;
        unsigned short e[8];
#pragma unroll
        for (int j = 0; j < 8; ++j) e[j] = Ls[(tc * 8 + j) * 72 + d];
        uint4 o;
        o.x = (unsigned)e[0] | ((unsigned)e[1] << 16); o.y = (unsigned)e[2] | ((unsigned)e[3] << 16);
        o.z = (unsigned)e[4] | ((unsigned)e[5] << 16); o.w = (unsigned)e[6] | ((unsigned)e[7] << 16);
        *(uint4*)(dst + (size_t)d * 2048 + tc * 8) = o;
    }
}

DEV void phase_layout1(const Params& p, char* smem) {
    char* ws = p.ws;
    bf16_t* cols = (bf16_t*)(ws + OFF_COLS);
    bf16_t* kc = (bf16_t*)(ws + OFF_KC);
    bf16_t* vc = (bf16_t*)(ws + OFF_VC);
    bf16_t* VT = (bf16_t*)(ws + OFF_VT);
    float* rstd = (float*)(ws + OFF_RSTD);
    const float* rope = (const float*)(ws + OFF_ROPE);
    const float *cos64 = rope, *sin64 = rope + 2048 * 32, *cos32 = rope + 2048 * 64, *sin32 = rope + 2048 * 64 + 2048 * 16;
    const int tid = ltid();
    for (int unit = blockIdx.x; unit < 2 * (kT / 64); unit += gridDim.x) {
        const int tile = unit >> 1, part01 = unit & 1;
        const int T0 = tile * 64, b = T0 >> 11, s0 = T0 & 2047;
        if (part01 == 0) {
            for (int it0 = tid; it0 < 64 * 86; it0 += 1024) {
                uint4 x1[4], x2[4]; float4 cs[4][2], sn[4][2]; bf16_t* p1[4]; bf16_t* p2[4]; bf16_t* kq[4];
#pragma unroll
                for (int u = 0; u < 4; ++u) {
                    const int it = it0 + u * 256 < 64 * 86 ? it0 + u * 256 : it0;
                    const int tok = it / 86, item = it % 86;
                    const int t = T0 + tok, sq = s0 + tok;
                    bf16_t* row = cols + (size_t)t * LDC;
                    kq[u] = nullptr;
                    const float *cp, *sp;
                    if (item < 52) {
                        const int hd = item >> 2, i0 = (item & 3) * 8;
                        const int base = hd < 4 ? 64 * hd : hd == 4 ? 256 : hd == 5 ? 384 : hd == 6 ? 512 : hd < 11 ? 1920 + 64 * (hd - 7) : 2176 + 64 * (hd - 11);
                        p1[u] = row + base + i0; p2[u] = row + base + 32 + i0;
                        cp = cos64 + sq * 32 + i0; sp = sin64 + sq * 32 + i0;
                        if (hd == 4) kq[u] = kc + (size_t)t * 64 + i0;
                    } else {
                        const int it2 = item - 52, sub = it2 >> 1, i0 = (it2 & 1) * 8;
                        const int base = sub < 8 ? 704 + 32 * sub : sub < 16 ? 960 + 32 * (sub - 8) : 1856;
                        p1[u] = row + base + i0; p2[u] = row + base + 16 + i0;
                        cp = cos32 + sq * 16 + i0; sp = sin32 + sq * 16 + i0;
                    }
                    x1[u] = *(const uint4*)p1[u]; x2[u] = *(const uint4*)p2[u];
                    cs[u][0] = *(const float4*)cp; cs[u][1] = *(const float4*)(cp + 4);
                    sn[u][0] = *(const float4*)sp; sn[u][1] = *(const float4*)(sp + 4);
                }
#pragma unroll
                for (int u = 0; u < 4; ++u) {
                    if (it0 + u * 256 >= 64 * 86) break;
                    const float cc[8] = {cs[u][0].x, cs[u][0].y, cs[u][0].z, cs[u][0].w, cs[u][1].x, cs[u][1].y, cs[u][1].z, cs[u][1].w};
                    const float ss[8] = {sn[u][0].x, sn[u][0].y, sn[u][0].z, sn[u][0].w, sn[u][1].x, sn[u][1].y, sn[u][1].z, sn[u][1].w};
                    rope8(x1[u], x2[u], cc, ss);
                    *(uint4*)p1[u] = x1[u]; *(uint4*)p2[u] = x2[u];
                    if (kq[u]) { *(uint4*)kq[u] = x1[u]; *(uint4*)(kq[u] + 32) = x2[u]; }
                }
            }
            {
                const uint4 c0 = *(const uint4*)(cols + (size_t)(T0 + (tid >> 3)) * LDC + 320 + (tid & 7) * 8);
                const uint4 c1 = *(const uint4*)(cols + (size_t)(T0 + 32 + (tid >> 3)) * LDC + 320 + (tid & 7) * 8);
                *(uint4*)(vc + (size_t)(T0 + (tid >> 3)) * 64 + (tid & 7) * 8) = c0;
                *(uint4*)(vc + (size_t)(T0 + 32 + (tid >> 3)) * 64 + (tid & 7) * 8) = c1;
            }
        }
        if (part01 == 0) continue;
        {
            const int tok = tid >> 2, part = tid & 3, t = T0 + tok;
            const bf16_t* src = cols + (size_t)t * LDC + 1472 + (part < 3 ? part : 0) * 128;
            float ss = 0.f;
#pragma unroll 4
            for (int i = 0; i < 16; ++i) {
                const uint4 u = *(const uint4*)(src + i * 8);
                ss += lo16(u.x) * lo16(u.x) + hi16(u.x) * hi16(u.x) + lo16(u.y) * lo16(u.y) + hi16(u.y) * hi16(u.y)
                    + lo16(u.z) * lo16(u.z) + hi16(u.z) * hi16(u.z) + lo16(u.w) * lo16(u.w) + hi16(u.w) * hi16(u.w);
            }
            float vq = part < 2 ? ss : 0.f;
            vq += __shfl_xor(vq, 1, 64);
            if (part == 0) rstd[t] = rsqrtf(vq * (1.f / 256.f) + kEps);
            if (part == 2) rstd[kT + t] = rsqrtf(ss * (1.f / 128.f) + kEps);
        }
#pragma unroll 1
        for (int vh = 0; vh < 8; ++vh) {
            const int col = vh == 0 ? 448 : vh == 1 ? 576 : vh < 6 ? 1216 + 64 * (vh - 2) : 2304 + 64 * (vh - 6);
            vt_tile(cols + (size_t)T0 * LDC + col, LDC, VT + ((size_t)(b * 12 + vh) * 64) * 2048 + s0, smem);
        }
    }
}

DEV void phase_layout2(const Params& p, int layer, char* smem) {
    char* ws = p.ws;
    bf16_t* qmla = (bf16_t*)(ws + OFF_QMLA);
    const bf16_t* kvmla = (const bf16_t*)(ws + OFF_KVMLA);
    bf16_t* VT = (bf16_t*)(ws + OFF_VT);
    const float* rope = (const float*)(ws + OFF_ROPE);
    const float *cos32 = rope + 2048 * 64, *sin32 = rope + 2048 * 64 + 2048 * 16;
    const int tid = ltid();
    for (int tile = blockIdx.x; tile < kT / 64 + 64; tile += gridDim.x) {
        if (tile >= kT / 64) {
            const int idx = (tile - kT / 64) * 2048 + tid * 8;
            const int kv = idx >> 16, m = (idx >> 6) & 1023, n = idx & 63;
            const float* pp = (const float*)(ws + OFF_QP) + ((size_t)(kv * 8) * 1024 + m) * 128 + n;
            const float* bias = (const float*)(ws + OFF_MISC) + (layer * 2 + kv) * 64 + n;
            float4 a = *(const float4*)bias, c = *(const float4*)(bias + 4);
#pragma unroll
            for (int ks = 0; ks < 8; ++ks) {
                const float4 x = *(const float4*)(pp + (size_t)ks * 1024 * 128), y = *(const float4*)(pp + (size_t)ks * 1024 * 128 + 4);
                a.x += x.x; a.y += x.y; a.z += x.z; a.w += x.w; c.x += y.x; c.y += y.y; c.z += y.z; c.w += y.w;
            }
            *(uint4*)((bf16_t*)(ws + OFF_KCMP) + (size_t)kv * 1024 * 64 + m * 64 + n) = make_uint4(pack2(a.x, a.y), pack2(a.z, a.w), pack2(c.x, c.y), pack2(c.z, c.w));
            continue;
        }
        const int T0 = tile * 64, b = T0 >> 11, s0 = T0 & 2047;
        for (int it = tid; it < 64 * 8; it += 256) {
            const int tok = it >> 3, item = it & 7, hd = item >> 1, i0 = (item & 1) * 8;
            const int t = T0 + tok, s = s0 + tok;
            bf16_t* row = qmla + (size_t)t * 384 + hd * 96 + 64;
            uint4 x1 = *(const uint4*)(row + i0), x2 = *(const uint4*)(row + 16 + i0);
            const float* cp = cos32 + s * 16 + i0; const float* sp = sin32 + s * 16 + i0;
            const float4 c0 = *(const float4*)cp, c1 = *(const float4*)(cp + 4), q0 = *(const float4*)sp, q1 = *(const float4*)(sp + 4);
            const float cc[8] = {c0.x, c0.y, c0.z, c0.w, c1.x, c1.y, c1.z, c1.w}, ss[8] = {q0.x, q0.y, q0.z, q0.w, q1.x, q1.y, q1.z, q1.w};
            rope8(x1, x2, cc, ss);
            *(uint4*)(row + i0) = x1; *(uint4*)(row + 16 + i0) = x2;
        }
#pragma unroll 1
        for (int hd = 0; hd < 4; ++hd)
            vt_tile(kvmla + (size_t)T0 * 512 + hd * 128 + 64, 512, VT + ((size_t)(b * 12 + 8 + hd) * 64) * 2048 + s0, smem);
    }
}

constexpr int SM_K = 0;
constexpr int SM_V = 26624;
constexpr int SM_IMP = SM_V + 17408;
constexpr int SM_SEL = SM_IMP + 16896;
constexpr int SM_CTRL = 65536;
constexpr int SM_TOTAL = SM_CTRL + 256 + 512;
constexpr int SM_ATTN_END = SM_SEL + 1024;

struct RangeIter { int cur, end; DEV int next() { return cur < end ? cur++ : -1; } };
struct BitIter { unsigned rem; DEV int next() { if (!rem) return -1; const int k = __ffs((int)rem) - 1; rem &= rem - 1; return k; } };
struct LdRow { const bf16_t* base; int ld;
    DEV uint4 operator()(int kt, int id) const { const int row = id >> 3, part = id & 7; return *(const uint4*)(base + (size_t)(kt * 64 + row) * ld + part * 8); } };
struct LdVT { const bf16_t* base;
    DEV uint4 operator()(int kt, int id) const { const int d = id >> 3, part = id & 7; return *(const uint4*)(base + (size_t)d * 2048 + kt * 64 + part * 8); } };
struct LdMlaK { const bf16_t* kv; const bf16_t* kr;
    DEV uint4 operator()(int kt, int id) const { const int row = id / 12, part = id % 12; const size_t t = (size_t)(kt * 64 + row);
        return part < 8 ? *(const uint4*)(kv + t * 512 + part * 8) : *(const uint4*)(kr + t * LDC + (part - 8) * 8); } };

struct MaskCausal { DEV bool on(int) const { return true; } DEV bool ok(int kc, int d) const { return kc <= d; }
    DEV bool full(int kt, int t0w) const { return kt * 64 + 63 <= t0w; } };
template <int W> struct MaskWin { DEV bool on(int) const { return true; } DEV bool ok(int kc, int d) const { return (kc <= d) && (d - kc < W); }
    DEV bool full(int kt, int t0w) const { return (kt * 64 + 63 <= t0w) && (t0w + 31 - kt * 64 < W); } };
struct MaskSel { unsigned bits, allbits; DEV bool on(int kt) const { return (bits >> kt) & 1u; } DEV bool ok(int kc, int d) const { return kc <= d; }
    DEV bool full(int kt, int t0w) const { return ((allbits >> kt) & 1u) && (kt * 64 + 63 <= t0w); } };
template <int KDIM, int NKS, int NSUB, bool QG, class It, class LK, class LV, class MaskF, class SkipF>
DEV void attn_stream(It it, const LK& ldK, const LV& ldV, const MaskF& maskf, const SkipF& skipf,
                     const bf16x8* qf, f32x16 (&o)[NSUB][2], float (&m)[NSUB], float (&l)[NSUB], float scl, int tq, int t0w, char* smem, int tid, int koff = 0) {
    constexpr int KCH = KDIM / 8, KSTR = KDIM + 8, NKC = (64 * KCH) / 256;
    constexpr int KBUF = 64 * 104, VBUF = 64 * 68;
    bf16_t* Kb = (bf16_t*)(smem + SM_K);
    bf16_t* Vb = (bf16_t*)(smem + SM_V);
    const int lane = tid & 63, ql = lane & 31, hh = lane >> 5;
    const uint4 z4 = make_uint4(0, 0, 0, 0);
    uint4 ak0 = z4, ak1 = z4, ak2 = z4, av0 = z4, av1 = z4, bk0 = z4, bk1 = z4, bk2 = z4, bv0 = z4, bv1 = z4;
    auto loadA = [&](int kt) __attribute__((always_inline)) { ak0 = ldK(kt, tid); ak1 = ldK(kt, tid + 256); if (NKC == 3) ak2 = ldK(kt, tid + 512); av0 = ldV(kt, tid); av1 = ldV(kt, tid + 256); };
    auto loadB = [&](int kt) __attribute__((always_inline)) { bk0 = ldK(kt, tid); bk1 = ldK(kt, tid + 256); if (NKC == 3) bk2 = ldK(kt, tid + 512); bv0 = ldV(kt, tid); bv1 = ldV(kt, tid + 256); };
    auto stK = [&](bf16_t* kb, const uint4& r, int id) __attribute__((always_inline)) { const int row = id / KCH, part = id % KCH; *(uint4*)(kb + row * KSTR + part * 8) = r; };
    auto stV = [&](bf16_t* vb, const uint4& r, int id) __attribute__((always_inline)) { const int row = id >> 3, part = id & 7; bf16_t* d = vb + row * 68 + part * 8;
        *(uint2*)d = make_uint2(r.x, r.y); *(uint2*)(d + 4) = make_uint2(r.z, r.w); };
    auto compute = [&](int kt, const bf16_t* Kt, const bf16_t* Vt) __attribute__((always_inline)) {
        if (skipf(kt)) return;
#pragma unroll
        for (int sub = 0; sub < NSUB; ++sub) {
            const int tqs = tq + (QG ? 32 * sub : 0), t0s = t0w + (QG ? 32 * sub : 0);
            if (QG && kt * 64 > t0s + 31) continue;
            __builtin_amdgcn_sched_barrier(0);
            f32x16 s[2];
#pragma unroll
            for (int i = 0; i < 2; ++i) {
                s[i] = zero16();
#pragma unroll
                for (int ks = 0; ks < NKS; ++ks) {
                    const bf16x8 a = *(const bf16x8*)(Kt + (i * 32 + ql) * KSTR + koff + ((QG ? 0 : sub * NKS) + ks) * 16 + hh * 8);
                    s[i] = mfma32(a, qf[sub * NKS + ks], s[i]);
                }
            }
            float mx = kNeg;
            if (!maskf.full(kt, t0s)) {
                const int dlim = tqs - kt * 64 - 4 * hh;
                const bool on = maskf.on(kt);
#pragma unroll
                for (int i = 0; i < 2; ++i)
#pragma unroll
                    for (int r = 0; r < 16; ++r) {
                        const int kc = i * 32 + (r & 3) + 8 * (r >> 2);
                        s[i][r] = (on && maskf.ok(kc, dlim)) ? s[i][r] : kNeg;
                    }
            }
#pragma unroll
            for (int i = 0; i < 2; ++i)
#pragma unroll
                for (int r = 0; r < 16; ++r) mx = fmaxf(mx, s[i][r]);
            mx = fmaxf(mx, xor32f(mx, lane));
            const float mnew = fmaxf(m[sub], mx);
            const float alpha = __builtin_amdgcn_exp2f((m[sub] - mnew) * scl);
            m[sub] = mnew;
            const float negm = mnew > -1e29f ? -mnew * scl : 0.f;
            float sum = 0.f;
#pragma unroll
            for (int i = 0; i < 2; ++i)
#pragma unroll
                for (int r = 0; r < 16; ++r) { const float pv = __builtin_amdgcn_exp2f(__builtin_fmaf(s[i][r], scl, negm)); s[i][r] = pv; sum += pv; }
            l[sub] = l[sub] * alpha + sum;
            if (__builtin_amdgcn_ballot_w64(alpha != 1.f)) {
#pragma unroll
                for (int dt = 0; dt < 2; ++dt)
#pragma unroll
                    for (int r = 0; r < 16; ++r) o[sub][dt][r] *= alpha;
            }
            __builtin_amdgcn_sched_barrier(0);
#pragma unroll
            for (int ks = 0; ks < 4; ++ks) {
                if (ks == 2) __builtin_amdgcn_sched_barrier(0);
                const int i = ks >> 1, r0 = 8 * (ks & 1);
                uint4 pu;
                pu.x = pack2(s[i][r0 + 0], s[i][r0 + 1]); pu.y = pack2(s[i][r0 + 2], s[i][r0 + 3]);
                pu.z = pack2(s[i][r0 + 4], s[i][r0 + 5]); pu.w = pack2(s[i][r0 + 6], s[i][r0 + 7]);
                const bf16x8 pf = __builtin_bit_cast(bf16x8, pu);
#pragma unroll
                for (int dt = 0; dt < 2; ++dt) {
                    const bf16_t* vp = Vt + (dt * 32 + ql) * 68 + ks * 16 + 4 * hh;
                    const uint2 a0 = *(const uint2*)vp, a1 = *(const uint2*)(vp + 8);
                    const bf16x8 a = __builtin_bit_cast(bf16x8, make_uint4(a0.x, a0.y, a1.x, a1.y));
                    o[sub][dt] = mfma32(a, pf, o[sub][dt]);
                }
            }
        }
    };
    int ka = it.next();
    int kb = ka >= 0 ? it.next() : -1;
    if (ka >= 0) loadA(ka);
    if (kb >= 0) loadB(kb);
    while (ka >= 0) {
        __syncthreads();
        stK(Kb, ak0, tid); stK(Kb, ak1, tid + 256); if (NKC == 3) stK(Kb, ak2, tid + 512);
        stV(Vb, av0, tid); stV(Vb, av1, tid + 256);
        if (kb >= 0) {
            stK(Kb + KBUF, bk0, tid); stK(Kb + KBUF, bk1, tid + 256); if (NKC == 3) stK(Kb + KBUF, bk2, tid + 512);
            stV(Vb + VBUF, bv0, tid); stV(Vb + VBUF, bv1, tid + 256);
        }
        __syncthreads();
        const int na = it.next();
        const int nb = na >= 0 ? it.next() : -1;
        if (na >= 0) loadA(na);
        if (nb >= 0) loadB(nb);
        compute(ka, Kb, Vb);
        if (kb >= 0) compute(kb, Kb + KBUF, Vb + VBUF);
        ka = na; kb = nb;
    }
}

DEV void write_o(const f32x16 (&o)[2], bf16_t* obuf, size_t row, int col0, int hh) {
#pragma unroll
    for (int dt = 0; dt < 2; ++dt)
#pragma unroll
        for (int g = 0; g < 4; ++g) {
            const int d = dt * 32 + 8 * g + 4 * hh;
            uint2 u; u.x = pack2(o[dt][4 * g], o[dt][4 * g + 1]); u.y = pack2(o[dt][4 * g + 2], o[dt][4 * g + 3]);
            *(uint2*)(obuf + row * 1024 + col0 + d) = u;
        }
}
DEV float sigmoidf(float x) { return 1.f / (1.f + __expf(-x)); }

DEV void nsa_item(const Params& p, int layer, int b, int qb, char* smem) {
    int tid = threadIdx.x; asm volatile("" : "+v"(tid));
    const int lane = tid & 63, w = tid >> 6, ql = lane & 31, hh = lane >> 5;
    char* ws = p.ws;
    const bf16_t* cols = (const bf16_t*)(ws + OFF_COLS);
    const bf16_t* VT = (const bf16_t*)(ws + OFF_VT);
    bf16_t* obuf = (bf16_t*)(ws + OFF_O);
    const int t0 = qb * 32, tq = t0 + ql;
    const size_t Tb = (size_t)b * kS;
    const bf16_t* qrow = cols + (Tb + tq) * LDC;
    bf16x8 qf[4];
#pragma unroll
    for (int ks = 0; ks < 4; ++ks) qf[ks] = *(const bf16x8*)(qrow + w * 64 + ks * 16 + hh * 8);
    const float g0 = sigmoidf(bf2f(qrow[640 + w * 3 + 0])), g1 = sigmoidf(bf2f(qrow[640 + w * 3 + 1])), g2 = sigmoidf(bf2f(qrow[640 + w * 3 + 2]));
    const float scl = 0.125f * kLog2e;
    bf16_t* Kc = (bf16_t*)(smem + SM_K);
    bf16_t* Vc = (bf16_t*)(smem + SM_V);
    float* impP = (float*)(smem + SM_IMP);
    unsigned* selm = (unsigned*)(smem + SM_SEL);
    const float* gk = (const float*)(ws + OFF_QP) + (size_t)b * 128 * 128;
    const float* gv = gk + (size_t)1024 * 128;
    const float* bias = (const float*)(ws + OFF_MISC) + layer * 128;
    __syncthreads();
#pragma unroll
    for (int i = 0; i < 4; ++i) {
        const int id = tid + 256 * i, row = id >> 3, part = id & 7;
        const int row1 = row < 127 ? row + 1 : row;
        const float* a = gk + (size_t)row * 128 + part * 8;  const float* a2 = gk + (size_t)row1 * 128 + 64 + part * 8;
        const float* c = gv + (size_t)row * 128 + part * 8;  const float* c2 = gv + (size_t)row1 * 128 + 64 + part * 8;
        const float4 k0 = *(const float4*)a, k1 = *(const float4*)(a + 4), k2 = *(const float4*)a2, k3 = *(const float4*)(a2 + 4);
        const float4 v0 = *(const float4*)c, v1 = *(const float4*)(c + 4), v2 = *(const float4*)c2, v3 = *(const float4*)(c2 + 4);
        const float4 bk0 = *(const float4*)(bias + part * 8), bk1 = *(const float4*)(bias + part * 8 + 4);
        const float4 bv0 = *(const float4*)(bias + 64 + part * 8), bv1 = *(const float4*)(bias + 64 + part * 8 + 4);
        uint4 kk = make_uint4(pack2(k0.x + k2.x + bk0.x, k0.y + k2.y + bk0.y), pack2(k0.z + k2.z + bk0.z, k0.w + k2.w + bk0.w),
                              pack2(k1.x + k3.x + bk1.x, k1.y + k3.y + bk1.y), pack2(k1.z + k3.z + bk1.z, k1.w + k3.w + bk1.w));
        uint4 vv = make_uint4(pack2(v0.x + v2.x + bv0.x, v0.y + v2.y + bv0.y), pack2(v0.z + v2.z + bv0.z, v0.w + v2.w + bv0.w),
                              pack2(v1.x + v3.x + bv1.x, v1.y + v3.y + bv1.y), pack2(v1.z + v3.z + bv1.z, v1.w + v3.w + bv1.w));
        if (row == 127) { kk = make_uint4(0, 0, 0, 0); vv = kk; }
        *(uint4*)(Kc + row * 72 + part * 8) = kk;
        const unsigned u[4] = {vv.x, vv.y, vv.z, vv.w};
#pragma unroll
        for (int j = 0; j < 4; ++j) { Vc[(part * 8 + 2 * j) * 132 + row] = (bf16_t)(u[j] & 0xffffu); Vc[(part * 8 + 2 * j + 1) * 132 + row] = (bf16_t)(u[j] >> 16); }
    }
    __syncthreads();
    unsigned ocp[16];
    float* invs = (float*)(smem + SM_SEL) + 64;
    {
        const int cmaxv = tq >= 31 ? min((tq - 31) >> 4, 126) : -1;
        float mx = kNeg;
#pragma unroll 1
        for (int i = 0; i < 4; ++i) {
            f32x16 s = zero16();
#pragma unroll
            for (int ks = 0; ks < 4; ++ks) s = mfma32(*(const bf16x8*)(Kc + (i * 32 + ql) * 72 + ks * 16 + hh * 8), qf[ks], s);
            const int clim = cmaxv - i * 32 - 4 * hh;
#pragma unroll
            for (int r = 0; r < 16; ++r) {
                const int kc = (r & 3) + 8 * (r >> 2);
                const bool valid = (kc <= clim);
                mx = fmaxf(mx, valid ? s[r] * scl : kNeg);
            }
        }
        mx = fmaxf(mx, xor32f(mx, lane));
        f32x16 ocmp[2]; ocmp[0] = zero16(); ocmp[1] = zero16();
        float sum = 0.f, carprev = 0.f;
#pragma unroll 1
        for (int i = 0; i < 4; ++i) {
            f32x16 s = zero16();
#pragma unroll
            for (int ks = 0; ks < 4; ++ks) s = mfma32(*(const bf16x8*)(Kc + (i * 32 + ql) * 72 + ks * 16 + hh * 8), qf[ks], s);
            const int clim = cmaxv - i * 32 - 4 * hh;
#pragma unroll
            for (int r = 0; r < 16; ++r) {
                const int kc = (r & 3) + 8 * (r >> 2);
                const bool valid = (kc <= clim);
                const float pv = valid ? __builtin_amdgcn_exp2f(s[r] * scl - mx) : 0.f;
                s[r] = pv; sum += pv;
            }
            float own[4], car[4];
#pragma unroll
            for (int g = 0; g < 4; ++g) { own[g] = s[4 * g] + s[4 * g + 1] + s[4 * g + 2] + 0.5f * s[4 * g + 3]; car[g] = 0.5f * s[4 * g + 3]; }
#pragma unroll
            for (int g = 0; g < 4; ++g) {
                const float send = hh ? (g ? car[g > 0 ? g - 1 : 0] : carprev) : car[g];
                own[g] += xor32f(send, lane);
            }
            carprev = car[3];
#pragma unroll
            for (int g = 0; g < 4; ++g) impP[(w * 32 + ql) * 33 + 2 * (4 * i + g) + hh] = own[g];
#pragma unroll
            for (int sp = 0; sp < 2; ++sp) {
                const int ks = 2 * i + sp, r0 = 8 * sp;
                uint4 pu;
                pu.x = pack2(s[r0 + 0], s[r0 + 1]); pu.y = pack2(s[r0 + 2], s[r0 + 3]);
                pu.z = pack2(s[r0 + 4], s[r0 + 5]); pu.w = pack2(s[r0 + 6], s[r0 + 7]);
                const bf16x8 pf = __builtin_bit_cast(bf16x8, pu);
#pragma unroll
                for (int dt = 0; dt < 2; ++dt) {
                    const bf16_t* vp = Vc + (dt * 32 + ql) * 132 + ks * 16 + 4 * hh;
                    const uint2 a0 = *(const uint2*)vp, a1 = *(const uint2*)(vp + 8);
                    ocmp[dt] = mfma32(__builtin_bit_cast(bf16x8, make_uint4(a0.x, a0.y, a1.x, a1.y)), pf, ocmp[dt]);
                }
            }
        }
        sum += xor32f(sum, lane);
        const float inv = sum > 0.f ? 1.f / sum : 0.f;
        invs[w * 32 + ql] = inv;
        const float f = g0 * inv;
#pragma unroll
        for (int dt = 0; dt < 2; ++dt)
#pragma unroll
            for (int r = 0; r < 8; ++r) ocp[dt * 8 + r] = pack2(f * ocmp[dt][2 * r], f * ocmp[dt][2 * r + 1]);
    }
    __syncthreads();
    const int qblk = t0 >> 6;
    {
        const int hw = tid >> 5, j = tid & 31;
#pragma unroll 1
        for (int rr = 0; rr < 4; ++rr) {
            const int row = hw * 4 + rr;
            const float v = impP[(0 * 32 + row) * 33 + j] * invs[row] + impP[(1 * 32 + row) * 33 + j] * invs[32 + row]
                          + impP[(2 * 32 + row) * 33 + j] * invs[64 + row] + impP[(3 * 32 + row) * 33 + j] * invs[96 + row];
            bool sel;
            if (qblk < 16) sel = (j <= qblk);
            else {
                const bool cand = (j >= 1) && (j <= qblk - 2);
                const bool forced = (j == 0) || (j == qblk) || (j == qblk - 1);
                int rank = 0;
                for (int j2 = 1; j2 <= qblk - 2; ++j2) {
                    const float v2 = lanef(v, (lane & 32) + j2);
                    rank += (v2 > v || (v2 == v && j2 < j)) ? 1 : 0;
                }
                sel = forced || (cand && rank < 13);
            }
            const unsigned long long bal = __ballot(sel);
            const unsigned mk = (lane & 32) ? (unsigned)(bal >> 32) : (unsigned)bal;
            if (j == 0) selm[row] = mk;
        }
    }
    __syncthreads();
    const unsigned mysel = selm[ql];
    unsigned U = mysel, Uall = mysel;
#pragma unroll
    for (int o = 16; o > 0; o >>= 1) { U |= (unsigned)__builtin_amdgcn_ds_bpermute((lane ^ o) << 2, (int)U); Uall &= (unsigned)__builtin_amdgcn_ds_bpermute((lane ^ o) << 2, (int)Uall); }
    Uall = (unsigned)__builtin_amdgcn_readfirstlane((int)Uall);
    {
        f32x16 o1[1][2]; o1[0][0] = zero16(); o1[0][1] = zero16();
        float m1[1] = {kNeg}, l1[1] = {0.f};
        auto skipf = [&](int) __attribute__((always_inline)) { return false; };
        attn_stream<64, 4, 1, false>(BitIter{U}, LdRow{cols + Tb * LDC + 384, LDC}, LdVT{VT + (size_t)(b * 12 + 0) * 64 * 2048}, MaskSel{mysel, Uall}, skipf, qf, o1, m1, l1, scl, tq, __builtin_amdgcn_readfirstlane(t0), smem, tid);
        const float lt = l1[0] + xor32f(l1[0], lane);
        const float f = g1 / lt;
#pragma unroll
        for (int dt = 0; dt < 2; ++dt)
#pragma unroll
            for (int r = 0; r < 8; ++r) ocp[dt * 8 + r] = pack2(lo16(ocp[dt * 8 + r]) + f * o1[0][dt][2 * r], hi16(ocp[dt * 8 + r]) + f * o1[0][dt][2 * r + 1]);
    }
    {
        f32x16 o1[1][2]; o1[0][0] = zero16(); o1[0][1] = zero16();
        float m1[1] = {kNeg}, l1[1] = {0.f};
        auto skipf = [&](int) __attribute__((always_inline)) { return false; };
        const int lo = t0 >= 511 ? ((t0 - 511) >> 6) : 0;
        attn_stream<64, 4, 1, false>(RangeIter{lo, qblk + 1}, LdRow{cols + Tb * LDC + 512, LDC}, LdVT{VT + (size_t)(b * 12 + 1) * 64 * 2048}, MaskWin<512>{}, skipf, qf, o1, m1, l1, scl, tq, __builtin_amdgcn_readfirstlane(t0), smem, tid);
        const float lt = l1[0] + xor32f(l1[0], lane);
        const float f = g2 / lt;
#pragma unroll
        for (int dt = 0; dt < 2; ++dt)
#pragma unroll
            for (int r = 0; r < 8; ++r) { o1[0][dt][2 * r] = lo16(ocp[dt * 8 + r]) + f * o1[0][dt][2 * r]; o1[0][dt][2 * r + 1] = hi16(ocp[dt * 8 + r]) + f * o1[0][dt][2 * r + 1]; }
        write_o(o1[0], obuf, Tb + tq, w * 64, hh);
    }
}

DEV void diff_item(const Params& p, int layer, int b, int hd, int qc, char* smem) {
    int tid = threadIdx.x; asm volatile("" : "+v"(tid));
    const int lane = tid & 63, w = tid >> 6, ql = lane & 31, hh = lane >> 5;
    const int sub = w & 1, qh = w >> 1;
    char* ws = p.ws;
    const bf16_t* cols = (const bf16_t*)(ws + OFF_COLS);
    const bf16_t* VT = (const bf16_t*)(ws + OFF_VT);
    bf16_t* obuf = (bf16_t*)(ws + OFF_O);
    const float* misc = (const float*)(ws + OFF_MISC);
    const int t0w = qc * 128 + qh * 64, tq = t0w + ql;
    const size_t Tb = (size_t)b * kS;
    bf16x8 qf[4];
#pragma unroll
    for (int g = 0; g < 2; ++g)
#pragma unroll
        for (int ks = 0; ks < 2; ++ks) qf[g * 2 + ks] = *(const bf16x8*)(cols + (Tb + tq + 32 * g) * LDC + 704 + hd * 64 + sub * 32 + ks * 16 + hh * 8);
    const float scl = 0.17677669529663687f * kLog2e;
    f32x16 o2[2][2];
#pragma unroll
    for (int g = 0; g < 2; ++g) { o2[g][0] = zero16(); o2[g][1] = zero16(); }
    float m2[2] = {kNeg, kNeg}, l2[2] = {0.f, 0.f};
    auto skipf = [&](int kt) __attribute__((always_inline)) { return kt * 64 > t0w + 63; };
    attn_stream<64, 2, 2, true>(RangeIter{0, 2 * qc + 2}, LdRow{cols + Tb * LDC + 960 + hd * 64, LDC}, LdVT{VT + (size_t)(b * 12 + 2 + hd) * 64 * 2048}, MaskCausal{}, skipf, qf, o2, m2, l2, scl, tq, __builtin_amdgcn_readfirstlane(t0w), smem, tid, sub * 32);
    const float lam = misc[256 + layer], post = misc[258 + layer];
    float* ex = (float*)smem;
    __syncthreads();
#pragma unroll
    for (int g = 0; g < 2; ++g) {
        const float lt = l2[g] + xor32f(l2[g], lane);
        if (sub == 1) {
            const float f = lam / lt;
#pragma unroll
            for (int dt = 0; dt < 2; ++dt)
#pragma unroll
                for (int r = 0; r < 16; ++r) ex[(((qh * 2 + g) * 2 + dt) * 16 + r) * 64 + lane] = o2[g][dt][r] * f;
        } else {
            const float f = 1.f / lt;
#pragma unroll
            for (int dt = 0; dt < 2; ++dt)
#pragma unroll
                for (int r = 0; r < 16; ++r) o2[g][dt][r] *= f;
        }
    }
    __syncthreads();
    if (sub == 0) {
        const float* sg = p.sub_g + layer * 64;
#pragma unroll
        for (int g = 0; g < 2; ++g) {
            float ss = 0.f;
#pragma unroll
            for (int dt = 0; dt < 2; ++dt)
#pragma unroll
                for (int r = 0; r < 16; ++r) { const float v = o2[g][dt][r] - ex[(((qh * 2 + g) * 2 + dt) * 16 + r) * 64 + lane]; o2[g][dt][r] = v; ss += v * v; }
            ss += xor32f(ss, lane);
            const float rstd = rsqrtf(ss * (1.f / 64.f) + kEps) * post;
#pragma unroll
            for (int dt = 0; dt < 2; ++dt)
#pragma unroll
                for (int r = 0; r < 16; ++r) { const int d = dt * 32 + (r & 3) + 8 * (r >> 2) + 4 * hh; o2[g][dt][r] *= rstd * sg[d]; }
            write_o(o2[g], obuf, Tb + tq + 32 * g, 256 + hd * 64, hh);
        }
    }
}

DEV void mla_item(const Params& p, int b, int hd, int qc, char* smem) {
    int tid = threadIdx.x; asm volatile("" : "+v"(tid));
    const int lane = tid & 63, w = tid >> 6, ql = lane & 31, hh = lane >> 5;
    char* ws = p.ws;
    const bf16_t* cols = (const bf16_t*)(ws + OFF_COLS);
    const bf16_t* VT = (const bf16_t*)(ws + OFF_VT);
    const bf16_t* qmla = (const bf16_t*)(ws + OFF_QMLA);
    const bf16_t* kvmla = (const bf16_t*)(ws + OFF_KVMLA);
    bf16_t* obuf = (bf16_t*)(ws + OFF_O);
    const int t0w = qc * 128 + w * 32, tq = t0w + ql;
    const size_t Tb = (size_t)b * kS;
    const bf16_t* qrow = qmla + (Tb + tq) * 384 + hd * 96;
    bf16x8 qf[6];
#pragma unroll
    for (int ks = 0; ks < 6; ++ks) qf[ks] = *(const bf16x8*)(qrow + ks * 16 + hh * 8);
    const float scl = 0.10206207261596575f * kLog2e;
    f32x16 o1[1][2]; o1[0][0] = zero16(); o1[0][1] = zero16();
    float m1[1] = {kNeg}, l1[1] = {0.f};
    auto skipf = [&](int kt) __attribute__((always_inline)) { return kt * 64 > t0w + 31; };
    attn_stream<96, 6, 1, false>(RangeIter{0, 2 * qc + 2}, LdMlaK{kvmla + Tb * 512 + hd * 128, cols + Tb * LDC + 1856}, LdVT{VT + (size_t)(b * 12 + 8 + hd) * 64 * 2048}, MaskCausal{}, skipf, qf, o1, m1, l1, scl, tq, __builtin_amdgcn_readfirstlane(t0w), smem, tid);
    const float inv = 1.f / (l1[0] + xor32f(l1[0], lane));
#pragma unroll
    for (int dt = 0; dt < 2; ++dt)
#pragma unroll
        for (int r = 0; r < 16; ++r) o1[0][dt][r] *= inv;
    write_o(o1[0], obuf, Tb + tq, 512 + hd * 64, hh);
}

DEV void swa_item(const Params& p, int layer, int b, int g, int q64, char* smem) {
    int tid = threadIdx.x; asm volatile("" : "+v"(tid));
    const int lane = tid & 63, w = tid >> 6, ql = lane & 31, hh = lane >> 5;
    char* ws = p.ws;
    const bf16_t* cols = (const bf16_t*)(ws + OFF_COLS);
    const bf16_t* VT = (const bf16_t*)(ws + OFF_VT);
    bf16_t* obuf = (bf16_t*)(ws + OFF_O);
    const int head = g * 2 + (w & 1);
    const int t0w = q64 * 64 + (w >> 1) * 32, tq = t0w + ql;
    const size_t Tb = (size_t)b * kS;
    const bf16_t* qrow = cols + (Tb + tq) * LDC + 1920 + head * 64;
    bf16x8 qf[4];
#pragma unroll
    for (int ks = 0; ks < 4; ++ks) qf[ks] = *(const bf16x8*)(qrow + ks * 16 + hh * 8);
    const float scl = 0.125f * kLog2e;
    f32x16 o1[1][2]; o1[0][0] = zero16(); o1[0][1] = zero16();
    float m1[1] = {p.sinks[layer * 4 + head] * 8.f}, l1[1] = {hh == 0 ? 1.f : 0.f};
    auto skipf = [&](int kt) __attribute__((always_inline)) { return (kt * 64 > t0w + 31) || (kt * 64 + 63 < t0w - 127); };
    const int lo = q64 >= 2 ? q64 - 2 : 0;
    attn_stream<64, 4, 1, false>(RangeIter{lo, q64 + 1}, LdRow{cols + Tb * LDC + 2176 + g * 64, LDC}, LdVT{VT + (size_t)(b * 12 + 6 + g) * 64 * 2048}, MaskWin<128>{}, skipf, qf, o1, m1, l1, scl, tq, __builtin_amdgcn_readfirstlane(t0w), smem, tid);
    const float inv = 1.f / (l1[0] + xor32f(l1[0], lane));
#pragma unroll
    for (int dt = 0; dt < 2; ++dt)
#pragma unroll
        for (int r = 0; r < 16; ++r) o1[0][dt][r] *= inv;
    write_o(o1[0], obuf, Tb + tq, 768 + head * 64, hh);
}

DEV void phase_attn(const Params& p, int layer, char* smem, int rep = 0) {
    unsigned* ctr = (unsigned*)(p.ws + OFF_CTRL) + 64 + layer * 16 + rep;
    volatile int* slot = (volatile int*)(smem + SM_SEL) + 48;
    for (;;) {
        __syncthreads();
        if (ltid() == 0) *slot = (int)atomicAdd(ctr, 1u);
        __syncthreads();
        const int idx = __builtin_amdgcn_readfirstlane(*slot);
        if (idx >= 2048) {
            if (layer != 0 || rep != 0 || idx >= 2048 + 1024) break;
            const int c = idx - 2048;
            const size_t u0 = (size_t)(c & 511) * 4096;
            if (c < 512) convert_fp8_range(p.pu, (unsigned char*)(p.ws + OFF_PU), u0, u0 + 4096, (size_t)ltid(), 256, kScaleU);
            else convert_fp8_range(p.pv, (unsigned char*)(p.ws + OFF_PV), u0, u0 + 4096, (size_t)ltid(), 256, kScaleV);
            continue;
        }
        const int level = 15 - (idx >> 7), r = idx & 127;
#if TS_A >= 0
        const unsigned long long tsa = __builtin_amdgcn_s_memrealtime();
#endif
        if (r < 32) { diff_item(p, layer, r >> 2, r & 3, level, smem); }
        else if (r < 64) { const int k = r - 32; mla_item(p, k >> 2, k & 3, level, smem); }
        else if (r < 96) { const int k = r - 64; nsa_item(p, layer, k >> 2, level * 4 + (3 - (k & 3)), smem); }
        else { const int k = r - 96; swa_item(p, layer, k >> 2, (k >> 1) & 1, level * 2 + (k & 1), smem); }
#if TS_A >= 0
        if (threadIdx.x == 0 && layer == 1) {
            const int ty = r >> 5;
            unsigned long long* ts = (unsigned long long*)(p.ws + 32768);
            atomicAdd(&ts[60 + ty], (unsigned long long)(__builtin_amdgcn_s_memrealtime() - tsa));
        }
#endif
    }
}

#define XB_TMO      128
#define XB_XCNT(j)  (256  + 64 * (j))
#define XB_XSUB(j)  (1280 + 64 * (j))
#define XB_XGEN(j)  (2304 + 64 * (j))
#define XB_TOP      3328
#define XB_TOPGEN   3392
#define XB_SPIN_CAP (1u << 22)
DEV unsigned xb_ld(unsigned* p) { return __hip_atomic_load(p, __ATOMIC_RELAXED, __HIP_MEMORY_SCOPE_AGENT); }
DEV unsigned xb_add(unsigned* p, unsigned v) { return __hip_atomic_fetch_add(p, v, __ATOMIC_RELAXED, __HIP_MEMORY_SCOPE_AGENT); }
DEV unsigned xb_xcc_id() { return (unsigned)__builtin_amdgcn_s_getreg((3 << 11) | 20) & 0xFu; }
#define XB_SPIN(cond, bar) do { unsigned _sp = 0; while (cond) { __builtin_amdgcn_s_sleep(1); \
    if ((++_sp & 255u) == 0u) { if (xb_ld(&(bar)[XB_TMO])) break; if (_sp > XB_SPIN_CAP) { atomicAdd(&(bar)[XB_TMO], 1u); break; } } } } while (0)
struct XcdBarrier { unsigned* bar; unsigned x; volatile LAS unsigned* st; };
DEV XcdBarrier xcd_barrier_post(unsigned* bar, volatile LAS unsigned* st) {
    XcdBarrier b; b.bar = bar; b.x = xb_xcc_id(); b.st = st;
    if (threadIdx.x == 0) st[2] = xb_add(&bar[XB_XCNT(b.x)], 1u);
    return b;
}
DEV void xcd_barrier_complete(unsigned* bar, unsigned x, unsigned& nloc, unsigned& nx) {
    const unsigned G = gridDim.x * gridDim.y * gridDim.z;
    unsigned sum, cnt, mine, sp = 0u;
    for (;;) {
        sum = 0u; cnt = 0u; mine = 0u;
#pragma unroll
        for (unsigned j = 0; j < 16; ++j) { const unsigned c = xb_ld(&bar[XB_XCNT(j)]); sum += c; cnt += (c > 0u) ? 1u : 0u; mine = (j == x) ? c : mine; }
        if (sum == G) break;
        __builtin_amdgcn_s_sleep(1);
        if ((++sp & 255u) == 0u) { if (xb_ld(&bar[XB_TMO])) break; if (sp > XB_SPIN_CAP) { atomicAdd(&bar[XB_TMO], 1u); break; } }
    }
    nloc = mine > 0u ? mine : 1u; nx = cnt > 0u ? cnt : 1u;
}
DEV void xcd_barrier(const XcdBarrier& b) {
    asm volatile("s_waitcnt vmcnt(0)" ::: "memory");
    __syncthreads();
    if (threadIdx.x == 0) {
        unsigned* bar = b.bar;
        asm volatile("" : "+v"(bar));
        __builtin_amdgcn_s_waitcnt(0);
        unsigned nloc = b.st[0], nx = b.st[1];
        if (nloc == 0u) { xcd_barrier_complete(bar, b.x, nloc, nx); b.st[0] = nloc; b.st[1] = nx; }
        const unsigned old = xb_add(&bar[XB_XSUB(b.x)], 1u);
        const unsigned gen = old / nloc;
        if (old + 1u == (gen + 1u) * nloc) {
            __builtin_amdgcn_fence(__ATOMIC_RELEASE, "agent");
            asm volatile("s_waitcnt vmcnt(0)" ::: "memory");
            const unsigned og = xb_add(&bar[XB_TOP], 1u);
            const unsigned tg = og / nx;
            if (og + 1u == (tg + 1u) * nx) xb_add(&bar[XB_TOPGEN], 1u);
            else XB_SPIN(xb_ld(&bar[XB_TOPGEN]) == tg, bar);
            __builtin_amdgcn_fence(__ATOMIC_ACQUIRE, "agent");
            xb_add(&bar[XB_XGEN(b.x)], 1u);
            asm volatile("s_waitcnt vmcnt(0)" ::: "memory");
        } else {
            XB_SPIN(xb_ld(&bar[XB_XGEN(b.x)]) == gen, bar);
            __builtin_amdgcn_fence(__ATOMIC_ACQUIRE, "agent");
            asm volatile("s_waitcnt vmcnt(0)" ::: "memory");
        }
    }
    __syncthreads();
}

DEV unsigned fkey(float f) { const unsigned u = __float_as_uint(f); return (u & 0x80000000u) ? ~u : (u | 0x80000000u); }
DEV float funkey(unsigned k) { return __uint_as_float((k & 0x80000000u) ? (k & 0x7fffffffu) : ~k); }
DEV void ins16(unsigned (&L)[16], unsigned x) {
#pragma unroll
    for (int i = 15; i >= 1; --i) { unsigned r; asm("v_med3_u32 %0, %1, %2, %3" : "=v"(r) : "v"(L[i - 1]), "v"(L[i]), "v"(x)); L[i] = r; }
    L[0] = L[0] > x ? L[0] : x;
}
DEV void phase_topk(const Params& p, char* smem) {
    const int tid = ltid();
    const float* S1 = (const float*)(p.ws + OFF_S1);
    const float* S2 = (const float*)(p.ws + OFF_S2);
    int* eid = (int*)(p.ws + OFF_EID);
    float* gate = (float*)(p.ws + OFF_GATE);
    unsigned char* ib = (unsigned char*)smem + tid * 32;
    for (int blk = blockIdx.x; blk < kT * 8 / 256; blk += gridDim.x) {
        const size_t row = (size_t)blk * 256 + tid;
        unsigned L1[16], L2[16];
#pragma unroll
        for (int i = 0; i < 16; ++i) { L1[i] = 0u; L2[i] = 0u; }
#pragma unroll 4
        for (int k = 0; k < 128; ++k) {
            const float a = S1[(size_t)k * (kT * 8) + row], b = S2[(size_t)k * (kT * 8) + row];
            ins16(L1, (fkey(a) & ~127u) | (unsigned)(127 - k));
            ins16(L2, (fkey(b) & ~127u) | (unsigned)(127 - k));
        }
        float v1[16], v2[16];
        __syncthreads();
#pragma unroll
        for (int i = 0; i < 16; ++i) {
            v1[i] = funkey(L1[i] & ~127u); v2[i] = funkey(L2[i] & ~127u);
            ib[i] = (unsigned char)(127u - (L1[i] & 127u)); ib[16 + i] = (unsigned char)(127u - (L2[i] & 127u));
        }
        unsigned C[16];
#pragma unroll
        for (int i = 0; i < 16; ++i) C[i] = 0u;
#pragma unroll
        for (int a = 0; a < 16; ++a)
#pragma unroll
            for (int b = 0; b < 16; ++b)
                if ((a + 1) * (b + 1) <= 16) ins16(C, (fkey(v1[a] + v2[b]) & ~255u) | (unsigned)(255 - (a * 16 + b)));
        float ts[16]; float sum = 0.f;
        const float tmax = funkey(C[0] & ~255u);
#pragma unroll
        for (int i = 0; i < 16; ++i) { ts[i] = __expf(funkey(C[i] & ~255u) - tmax); sum += ts[i]; }
        const float inv = 1.f / sum;
        int ev[16];
#pragma unroll
        for (int i = 0; i < 16; ++i) { const unsigned ci = 255u - (C[i] & 255u); ev[i] = (int)ib[ci >> 4] * 128 + (int)ib[16 + (ci & 15u)]; }
#pragma unroll
        for (int i = 0; i < 4; ++i) {
            *(int4*)(eid + row * 16 + 4 * i) = make_int4(ev[4 * i], ev[4 * i + 1], ev[4 * i + 2], ev[4 * i + 3]);
            *(float4*)(gate + row * 16 + 4 * i) = make_float4(ts[4 * i] * inv, ts[4 * i + 1] * inv, ts[4 * i + 2] * inv, ts[4 * i + 3] * inv);
        }
    }
}

struct EpiTop16 {
    unsigned (&L)[16];
    DEV void tile(int, int, const float* Cs, int tid) const {
        const int r = tid & 127, hk = tid >> 7;
        unsigned T[16];
#pragma unroll
        for (int i = 0; i < 16; ++i) T[i] = 0u;
#pragma unroll 4
        for (int k = 0; k < 64; ++k) {
            const int key = hk * 64 + k;
            ins16(T, (fkey(Cs[key * 128 + r]) & ~127u) | (unsigned)(127 - key));
        }
        __syncthreads();
        unsigned* X = (unsigned*)Cs;
        if (hk) {
#pragma unroll
            for (int i = 0; i < 16; ++i) X[r * 17 + i] = T[i];
        }
        __syncthreads();
        if (!hk) {
#pragma unroll
            for (int i = 0; i < 16; ++i) ins16(T, X[r * 17 + i]);
        }
#pragma unroll
        for (int i = 0; i < 16; ++i) L[i] = T[i];
    }
};
DEV void phase_route(const Params& p, int layer, char* smem) {
    char* ws = p.ws;
    int* eid = (int*)(ws + OFF_EID);
    float* gate = (float*)(ws + OFF_GATE);
    const bf16_t* qp = (const bf16_t*)(ws + OFF_QP);
    const bf16_t* subk = (const bf16_t*)(ws + OFF_SUBK) + (size_t)(layer * 2) * 16384;
    for (int nt = blockIdx.x; nt < kT * 8 / 128; nt += gridDim.x) {
        unsigned L1[16], L2[16];
        { EpiTop16 e1{L1}; gemm_tile(subk, 128, qp, 256, 128, 0, nt * 128, smem, e1); }
        { EpiTop16 e2{L2}; gemm_tile(subk + 16384, 128, qp + 128, 256, 128, 0, nt * 128, smem, e2); }
        const int tid = ltid();
        __syncthreads();
        if (tid < 128) {
            const size_t row = (size_t)nt * 128 + tid;
            unsigned char* ib = (unsigned char*)smem + tid * 32;
            float v1[16], v2[16];
#pragma unroll
            for (int i = 0; i < 16; ++i) {
                v1[i] = funkey(L1[i] & ~127u); v2[i] = funkey(L2[i] & ~127u);
                ib[i] = (unsigned char)(127u - (L1[i] & 127u)); ib[16 + i] = (unsigned char)(127u - (L2[i] & 127u));
            }
            unsigned C[16];
#pragma unroll
            for (int i = 0; i < 16; ++i) C[i] = 0u;
#pragma unroll
            for (int a = 0; a < 16; ++a)
#pragma unroll
                for (int b = 0; b < 16; ++b)
                    if ((a + 1) * (b + 1) <= 16) ins16(C, (fkey(v1[a] + v2[b]) & ~255u) | (unsigned)(255 - (a * 16 + b)));
            float ts[16]; float sum = 0.f;
            const float tmax = funkey(C[0] & ~255u);
#pragma unroll
            for (int i = 0; i < 16; ++i) { ts[i] = __expf(funkey(C[i] & ~255u) - tmax); sum += ts[i]; }
            const float inv = 1.f / sum;
            int ev[16];
#pragma unroll
            for (int i = 0; i < 16; ++i) { const unsigned ci = 255u - (C[i] & 255u); ev[i] = (int)ib[ci >> 4] * 128 + (int)ib[16 + (ci & 15u)]; }
#pragma unroll
            for (int i = 0; i < 4; ++i) {
                *(int4*)(eid + row * 16 + 4 * i) = make_int4(ev[4 * i], ev[4 * i + 1], ev[4 * i + 2], ev[4 * i + 3]);
                *(float4*)(gate + row * 16 + 4 * i) = make_float4(ts[4 * i] * inv, ts[4 * i + 1] * inv, ts[4 * i + 2] * inv, ts[4 * i + 3] * inv);
            }
        }
    }
}

DEV float row_sum_dpp(float v) {
    v += __int_as_float(__builtin_amdgcn_update_dpp(0, __float_as_int(v), 0xB1, 0xF, 0xF, true));
    v += __int_as_float(__builtin_amdgcn_update_dpp(0, __float_as_int(v), 0x4E, 0xF, 0xF, true));
    v += __int_as_float(__builtin_amdgcn_update_dpp(0, __float_as_int(v), 0x141, 0xF, 0xF, true));
    v += __int_as_float(__builtin_amdgcn_update_dpp(0, __float_as_int(v), 0x140, 0xF, 0xF, true));
    return v;
}
DEV float wave_sum_dpp(float v) {
    v = row_sum_dpp(v);
    const float r0 = __int_as_float(__builtin_amdgcn_readlane(__float_as_int(v), 0)), r1 = __int_as_float(__builtin_amdgcn_readlane(__float_as_int(v), 16));
    const float r2 = __int_as_float(__builtin_amdgcn_readlane(__float_as_int(v), 32)), r3 = __int_as_float(__builtin_amdgcn_readlane(__float_as_int(v), 48));
    return (r0 + r1) + (r2 + r3);
}
typedef float f32x2 __attribute__((ext_vector_type(2)));
typedef float f32x4 __attribute__((ext_vector_type(4)));

DEV SliceMap slice_map(const Params& p, char* smem) {
    unsigned* bar = (unsigned*)p.ws;
    const unsigned x = xb_xcc_id();
    int virt = 0, nx = 0, nloc = 1;
#pragma unroll
    for (unsigned j = 0; j < 16; ++j) {
        const unsigned c = xb_ld(&bar[XB_XCNT(j)]);
        if (c > 0u) { if (j < x) ++virt; ++nx; }
        if (j == x) nloc = (int)c;
    }
    SliceMap m;
    m.virt = __builtin_amdgcn_readfirstlane(virt); m.nx = __builtin_amdgcn_readfirstlane(nx > 0 ? nx : 1); m.nloc = __builtin_amdgcn_readfirstlane(nloc > 0 ? nloc : 1);
    m.rank = __builtin_amdgcn_readfirstlane((int)((volatile LAS unsigned*)(smem + SM_CTRL))[2]);
    return m;
}

typedef _Float16 half2_t __attribute__((ext_vector_type(2)));
DEV void phase_peer_u(const Params& p, int layer, char* smem, int rep = 0) {
    const int tid = ltid(), lane = tid & 63, w = tid >> 6, l8 = lane & 7, grp = lane >> 3;
    char* ws = p.ws;
    const SliceMap sm = slice_map(p, smem);
    const bf16_t* h = (const bf16_t*)(ws + OFF_H);
    const int* eid = (const int*)(ws + OFF_EID);
    _Float16* part = (_Float16*)(ws + OFF_S1) + (rep ? (size_t)8 * kT * 128 : 0);
    int* ids_l = (int*)(smem + w * 9216);
    const int nk = sm.rank < 512 ? (512 - sm.rank + sm.nloc - 1) / sm.nloc : 0;
    for (int s = sm.virt; s < 8; s += sm.nx) {
        if (nk == 0) break;
        const unsigned char* U = (const unsigned char*)(ws + OFF_PU) + (((size_t)layer * 8 + s) * 16384 << 7) + l8 * 16;
        uint4 ri0, ri1, ri2, ri3, rh0, rh1;
        auto load_oct = [&](int k) __attribute__((always_inline)) {
            const size_t o = (size_t)(sm.rank + k * sm.nloc) * 4 + w;
            const uint4* ip = (const uint4*)(eid + o * 1024) + lane;
            ri0 = ip[0]; ri1 = ip[64]; ri2 = ip[128]; ri3 = ip[192];
            const bf16_t* hp = h + (o * 8 + grp) * 1024 + s * 128 + l8 * 16;
            rh0 = *(const uint4*)hp; rh1 = *(const uint4*)(hp + 8);
        };
        half2_t hh[8];
        auto store_oct = [&]() __attribute__((always_inline)) {
            uint4* il = (uint4*)ids_l + lane;
            il[0] = ri0; il[64] = ri1; il[128] = ri2; il[192] = ri3;
            const unsigned hu[8] = {rh0.x, rh0.y, rh0.z, rh0.w, rh1.x, rh1.y, rh1.z, rh1.w};
#pragma unroll
            for (int i = 0; i < 8; ++i) hh[i] = (half2_t){(_Float16)lo16(hu[i]), (_Float16)hi16(hu[i])};
        };
        load_oct(0); store_oct();
#pragma unroll 1
        for (int k = 0; k < nk; ++k) {
            if (k + 1 < nk) load_oct(k + 1);
            const size_t o = (size_t)(sm.rank + k * sm.nloc) * 4 + w;
            _Float16* pp = part + ((size_t)s * kT + o * 8 + grp) * 128 + l8;
            uint4 va[8], vb[8];
            auto issue = [&](uint4 (&v)[8], int c) __attribute__((always_inline)) {
                const int4 i0 = *(const int4*)(ids_l + grp * 128 + c * 8), i1 = *(const int4*)(ids_l + grp * 128 + c * 8 + 4);
                const int e[8] = {i0.x, i0.y, i0.z, i0.w, i1.x, i1.y, i1.z, i1.w};
#pragma unroll
                for (int j = 0; j < 8; ++j) v[j] = *(const uint4*)(U + ((size_t)e[j] << 7));
            };
            auto compute = [&](const uint4 (&v)[8], int c) __attribute__((always_inline)) {
                float res = 0.f;
#pragma unroll
                for (int j = 0; j < 8; ++j) {
                    const unsigned d[4] = {v[j].x, v[j].y, v[j].z, v[j].w};
                    float acc = 0.f;
#pragma unroll
                    for (int q = 0; q < 4; ++q) {
                        const half2_t lo = __builtin_amdgcn_cvt_scalef32_pk_f16_fp8(d[q], 1.0f, false);
                        const half2_t hi = __builtin_amdgcn_cvt_scalef32_pk_f16_fp8(d[q], 1.0f, true);
                        acc = __builtin_amdgcn_fdot2(lo, hh[2 * q], acc, false);
                        acc = __builtin_amdgcn_fdot2(hi, hh[2 * q + 1], acc, false);
                    }
                    acc += __int_as_float(__builtin_amdgcn_update_dpp(0, __float_as_int(acc), 0xB1, 0xF, 0xF, true));
                    acc += __int_as_float(__builtin_amdgcn_update_dpp(0, __float_as_int(acc), 0x4E, 0xF, 0xF, true));
                    acc += __int_as_float(__builtin_amdgcn_update_dpp(0, __float_as_int(acc), 0x141, 0xF, 0xF, true));
                    res = (l8 == j) ? acc : res;
                    __builtin_amdgcn_sched_barrier(0);
                }
                pp[c * 8] = (_Float16)res;
            };
            issue(va, 0);
#pragma unroll
            for (int c = 0; c < 16; c += 2) {
                issue(vb, c + 1);
                __builtin_amdgcn_sched_barrier(0);
                compute(va, c);
                __builtin_amdgcn_sched_barrier(0);
                if (c + 2 < 16) issue(va, c + 2);
                __builtin_amdgcn_sched_barrier(0);
                compute(vb, c + 1);
                __builtin_amdgcn_sched_barrier(0);
            }
            if (k + 1 < nk) store_oct();
        }
    }
}

DEV void phase_peer_comb(const Params& p, int rep = 0) {
    const int tid = ltid();
    const _Float16* part = (const _Float16*)(p.ws + OFF_S1);
    float* gate = (float*)(p.ws + OFF_GATE);
    for (size_t i = (size_t)blockIdx.x * 256 + tid; i < (size_t)kT * 128 / 8; i += (size_t)gridDim.x * 256) {
        float a[8];
#pragma unroll
        for (int j = 0; j < 8; ++j) a[j] = 0.f;
#pragma unroll
        for (int x = 0; x < 8; ++x) {
            const uint4 u = *(const uint4*)(part + (size_t)x * kT * 128 + i * 8);
            const unsigned d[4] = {u.x, u.y, u.z, u.w};
#pragma unroll
            for (int j = 0; j < 4; ++j) { const half2_t hv = __builtin_bit_cast(half2_t, d[j]); a[2 * j] += (float)hv.x; a[2 * j + 1] += (float)hv.y; }
        }
        const float4 g0 = *(const float4*)(gate + i * 8), g1 = *(const float4*)(gate + i * 8 + 4);
        float4 o0, o1;
        o0.x = g0.x * gelu_tanh(a[0] * (1.f / kScaleU)); o0.y = g0.y * gelu_tanh(a[1] * (1.f / kScaleU));
        o0.z = g0.z * gelu_tanh(a[2] * (1.f / kScaleU)); o0.w = g0.w * gelu_tanh(a[3] * (1.f / kScaleU));
        o1.x = g1.x * gelu_tanh(a[4] * (1.f / kScaleU)); o1.y = g1.y * gelu_tanh(a[5] * (1.f / kScaleU));
        o1.z = g1.z * gelu_tanh(a[6] * (1.f / kScaleU)); o1.w = g1.w * gelu_tanh(a[7] * (1.f / kScaleU));
        if (rep == 0) { *(float4*)(gate + i * 8) = o0; *(float4*)(gate + i * 8 + 4) = o1; }
    }
}

DEV void phase_peer_v(const Params& p, int layer, char* smem, int rep = 0) {
    const int tid = ltid(), lane = tid & 63, w = tid >> 6, l8 = lane & 7, grp = lane >> 3;
    char* ws = p.ws;
    const SliceMap sm = slice_map(p, smem);
    bf16_t* xres = (bf16_t*)(ws + OFF_XRES);
    const int* eid = (const int*)(ws + OFF_EID);
    const float* wbuf = (const float*)(ws + OFF_GATE);
    const float* mod = (const float*)(ws + OFF_MOD);
    int* ids_l = (int*)(smem + w * 9216);
    float* w_l = (float*)(smem + w * 9216 + 4096);
    const int nk = sm.rank < 512 ? (512 - sm.rank + sm.nloc - 1) / sm.nloc : 0;
    for (int s = sm.virt; s < 8; s += sm.nx) {
        if (nk == 0) break;
        const unsigned char* V = (const unsigned char*)(ws + OFF_PV) + (((size_t)layer * 8 + s) * 16384 << 7) + l8 * 16;
        uint4 ri0, ri1, ri2, ri3, rw0, rw1, rw2, rw3;
        auto load_oct = [&](int k) __attribute__((always_inline)) {
            const size_t o = (size_t)(sm.rank + k * sm.nloc) * 4 + w;
            const uint4* ip = (const uint4*)(eid + o * 1024) + lane;
            const uint4* wp = (const uint4*)(wbuf + o * 1024) + lane;
            ri0 = ip[0]; ri1 = ip[64]; ri2 = ip[128]; ri3 = ip[192];
            rw0 = wp[0]; rw1 = wp[64]; rw2 = wp[128]; rw3 = wp[192];
        };
        auto store_oct = [&]() __attribute__((always_inline)) {
            uint4* il = (uint4*)ids_l + lane; uint4* wl = (uint4*)w_l + lane;
            il[0] = ri0; il[64] = ri1; il[128] = ri2; il[192] = ri3;
            wl[0] = rw0; wl[64] = rw1; wl[128] = rw2; wl[192] = rw3;
        };
        load_oct(0); store_oct();
#pragma unroll 1
        for (int k = 0; k < nk; ++k) {
            if (k + 1 < nk) load_oct(k + 1);
            const size_t o = (size_t)(sm.rank + k * sm.nloc) * 4 + w;
            const size_t t = o * 8 + grp;
            const int b = (int)(t >> 11);
            bf16_t* xp = xres + t * 1024 + s * 128 + l8 * 16;
            const float* g2 = mod + (size_t)(layer * 8 + b) * 6144 + 5120 + s * 128 + l8 * 16;
            float4 xa[4];
            { const uint4 u0 = *(const uint4*)xp, u1 = *(const uint4*)(xp + 8);
              xa[0] = make_float4(lo16(u0.x), hi16(u0.x), lo16(u0.y), hi16(u0.y)); xa[1] = make_float4(lo16(u0.z), hi16(u0.z), lo16(u0.w), hi16(u0.w));
              xa[2] = make_float4(lo16(u1.x), hi16(u1.x), lo16(u1.y), hi16(u1.y)); xa[3] = make_float4(lo16(u1.z), hi16(u1.z), lo16(u1.w), hi16(u1.w)); }
            half2_t out[8];
#pragma unroll
            for (int j = 0; j < 8; ++j) out[j] = (half2_t){(_Float16)0.f, (_Float16)0.f};
            uint4 va[8], vb[8];
            auto issue = [&](uint4 (&v)[8], int c) __attribute__((always_inline)) {
                const int4 i0 = *(const int4*)(ids_l + grp * 128 + c * 8), i1 = *(const int4*)(ids_l + grp * 128 + c * 8 + 4);
                const int e[8] = {i0.x, i0.y, i0.z, i0.w, i1.x, i1.y, i1.z, i1.w};
#pragma unroll
                for (int j = 0; j < 8; ++j) v[j] = *(const uint4*)(V + ((size_t)e[j] << 7));
            };
            auto compute = [&](const uint4 (&v)[8], int c) __attribute__((always_inline)) {
                const float4 w0 = *(const float4*)(w_l + grp * 128 + c * 8), w1 = *(const float4*)(w_l + grp * 128 + c * 8 + 4);
                const float wf[8] = {w0.x, w0.y, w0.z, w0.w, w1.x, w1.y, w1.z, w1.w};
#pragma unroll
                for (int j = 0; j < 8; ++j) {
                    const _Float16 wh = (_Float16)wf[j];
                    const half2_t ww = {wh, wh};
                    const unsigned d[4] = {v[j].x, v[j].y, v[j].z, v[j].w};
#pragma unroll
                    for (int q = 0; q < 4; ++q) {
                        const half2_t lo = __builtin_amdgcn_cvt_scalef32_pk_f16_fp8(d[q], 1.0f, false);
                        const half2_t hi = __builtin_amdgcn_cvt_scalef32_pk_f16_fp8(d[q], 1.0f, true);
                        out[2 * q] = __builtin_elementwise_fma(ww, lo, out[2 * q]);
                        out[2 * q + 1] = __builtin_elementwise_fma(ww, hi, out[2 * q + 1]);
                    }
                    __builtin_amdgcn_sched_barrier(0);
                }
            };
            issue(va, 0);
#pragma unroll
            for (int c = 0; c < 16; c += 2) {
                issue(vb, c + 1);
                __builtin_amdgcn_sched_barrier(0);
                compute(va, c);
                __builtin_amdgcn_sched_barrier(0);
                if (c + 2 < 16) issue(va, c + 2);
                __builtin_amdgcn_sched_barrier(0);
                compute(vb, c + 1);
                __builtin_amdgcn_sched_barrier(0);
            }
            if (rep == 0 || (float)out[0].x == 12345.678f) {
#pragma unroll
                for (int c = 0; c < 4; ++c) {
                    const float4 g4 = *(const float4*)(g2 + c * 4);
                    xa[c].x += g4.x * (float)out[2 * c].x * (1.f / kScaleV); xa[c].y += g4.y * (float)out[2 * c].y * (1.f / kScaleV);
                    xa[c].z += g4.z * (float)out[2 * c + 1].x * (1.f / kScaleV); xa[c].w += g4.w * (float)out[2 * c + 1].y * (1.f / kScaleV);
                }
                *(uint4*)xp = make_uint4(pack2(xa[0].x, xa[0].y), pack2(xa[0].z, xa[0].w), pack2(xa[1].x, xa[1].y), pack2(xa[1].z, xa[1].w));
                *(uint4*)(xp + 8) = make_uint4(pack2(xa[2].x, xa[2].y), pack2(xa[2].z, xa[2].w), pack2(xa[3].x, xa[3].y), pack2(xa[3].z, xa[3].w));
            }
            if (k + 1 < nk) store_oct();
        }
    }
}

DEV void phase_final(const Params& p) {
    const int tid = ltid(), lane = tid & 63, w = tid >> 6;
    const bf16_t* xs = (const bf16_t*)(p.ws + OFF_XRES);
    float gg[2][8];
#pragma unroll
    for (int i = 0; i < 2; ++i) { const float4 a = *(const float4*)(p.final_g + (lane + 64 * i) * 8), c = *(const float4*)(p.final_g + (lane + 64 * i) * 8 + 4);
        gg[i][0] = a.x; gg[i][1] = a.y; gg[i][2] = a.z; gg[i][3] = a.w; gg[i][4] = c.x; gg[i][5] = c.y; gg[i][6] = c.z; gg[i][7] = c.w; }
    for (int q0 = blockIdx.x; q0 < kT / 4; q0 += gridDim.x * 4) {
        uint4 raw[4][2];
#pragma unroll
        for (int u = 0; u < 4; ++u) {
            const int q = q0 + u * gridDim.x < kT / 4 ? q0 + u * gridDim.x : q0;
#pragma unroll
            for (int i = 0; i < 2; ++i) raw[u][i] = *(const uint4*)(xs + (size_t)(q * 4 + w) * 1024 + (lane + 64 * i) * 8);
        }
#pragma unroll
        for (int u = 0; u < 4; ++u) {
            const int q = q0 + u * gridDim.x;
            if (q >= kT / 4) break;
            const int t = q * 4 + w;
            float v[2][8]; float ss = 0.f;
#pragma unroll
            for (int i = 0; i < 2; ++i) {
                const uint4 uu = raw[u][i];
                v[i][0] = lo16(uu.x); v[i][1] = hi16(uu.x); v[i][2] = lo16(uu.y); v[i][3] = hi16(uu.y);
                v[i][4] = lo16(uu.z); v[i][5] = hi16(uu.z); v[i][6] = lo16(uu.w); v[i][7] = hi16(uu.w);
#pragma unroll
                for (int j = 0; j < 8; ++j) ss += v[i][j] * v[i][j];
            }
            ss = wave_sum(ss);
            const float rstd = rsqrtf(ss * (1.f / 1024.f) + kEps);
#pragma unroll
            for (int i = 0; i < 2; ++i) {
                float* op = p.out + (size_t)t * 1024 + (lane + 64 * i) * 8;
                *(float4*)op = make_float4(v[i][0] * rstd * gg[i][0], v[i][1] * rstd * gg[i][1], v[i][2] * rstd * gg[i][2], v[i][3] * rstd * gg[i][3]);
                *(float4*)(op + 4) = make_float4(v[i][4] * rstd * gg[i][4], v[i][5] * rstd * gg[i][5], v[i][6] * rstd * gg[i][6], v[i][7] * rstd * gg[i][7]);
            }
        }
    }
}

DEV uint4 pack8f(const float (&e)[8]) { return make_uint4(pack2(e[0], e[1]), pack2(e[2], e[3]), pack2(e[4], e[5]), pack2(e[6], e[7])); }
DEV float4 rope4(float4 v, float4 o, bool low, float4 c, float4 sn) {
    float4 r;
    r.x = v.x * c.x + (low ? -o.x : o.x) * sn.x; r.y = v.y * c.y + (low ? -o.y : o.y) * sn.y;
    r.z = v.z * c.z + (low ? -o.z : o.z) * sn.z; r.w = v.w * c.w + (low ? -o.w : o.w) * sn.w;
    return r;
}
struct EpiIn {
    char* ws;
    DEV void tile(int m0, int n0, const float* Cs, int tid) const {
        const int lane = tid & 63, w = tid >> 6, g16 = lane >> 4, c4 = lane & 15;
        bf16_t* cols = (bf16_t*)(ws + OFF_COLS);
        bf16_t* VT = (bf16_t*)(ws + OFF_VT);
        const float* rope = (const float*)(ws + OFF_ROPE);
        const float *cos64 = rope, *sin64 = rope + 2048 * 32, *cos32 = rope + 2048 * 64, *sin32 = rope + 2048 * 64 + 2048 * 16;
        const int b = m0 >> 11, s0 = m0 & 2047;
#pragma unroll 1
        for (int h = 0; h < 2; ++h) {
            const int cb = n0 + 64 * h;
            int vh = -1;
            if (cb == 448) vh = 0; else if (cb == 576) vh = 1; else if (cb >= 1216 && cb < 1472) vh = 2 + ((cb - 1216) >> 6); else if (cb >= 2304) vh = 6 + ((cb - 2304) >> 6);
            if (vh >= 0) {
                bf16_t* dst = VT + ((size_t)(b * 12 + vh) * 64 + lane) * 2048 + s0;
#pragma unroll
                for (int q = 0; q < 4; ++q) {
                    const int tc = w + 4 * q;
                    float e[8];
#pragma unroll
                    for (int j = 0; j < 8; ++j) e[j] = Cs[(tc * 8 + j) * 128 + h * 64 + lane];
                    *(uint4*)(dst + tc * 8) = pack8f(e);
                }
                continue;
            }
            const bool r64 = cb < 320 || cb == 384 || cb == 512 || (cb >= 1920 && cb < 2304);
            const bool r32 = (cb >= 704 && cb < 1216) || cb == 1856;
            bf16_t* dbase; int dld;
            if (cb == 256) { dbase = (bf16_t*)(ws + OFF_KC); dld = 64; } else if (cb == 320) { dbase = (bf16_t*)(ws + OFF_VC); dld = 64; } else { dbase = cols + cb; dld = LDC; }
            const int g8 = lane >> 3, c8 = lane & 7, swp = (g8 & 1) * 4;
            float4 cc[4][2], sn[4][2];
            if (r64 || r32) {
                const int i = (c8 * 8) & (r64 ? 31 : 15);
#pragma unroll
                for (int it = 0; it < 4; ++it) {
                    const int sq = s0 + it * 32 + w * 8 + g8;
                    const float* cp = (r64 ? cos64 + sq * 32 : cos32 + sq * 16) + i;
                    const float* sp = (r64 ? sin64 + sq * 32 : sin32 + sq * 16) + i;
                    cc[it][0] = *(const float4*)cp; cc[it][1] = *(const float4*)(cp + 4);
                    sn[it][0] = *(const float4*)sp; sn[it][1] = *(const float4*)(sp + 4);
                }
            }
#pragma unroll
            for (int it = 0; it < 4; ++it) {
                const int r = it * 32 + w * 8 + g8;
                const float* rp = Cs + r * 128 + h * 64 + c8 * 8;
                const float4 va = *(const float4*)(rp + swp), vb = *(const float4*)(rp + (swp ^ 4));
                float4 v0 = swp ? vb : va, v1 = swp ? va : vb;
                if (r64 || r32) {
                    const float* op = Cs + r * 128 + h * 64 + ((c8 * 8) ^ (r64 ? 32 : 16));
                    const float4 oa = *(const float4*)(op + swp), ob = *(const float4*)(op + (swp ^ 4));
                    const float4 o0 = swp ? ob : oa, o1 = swp ? oa : ob;
                    const bool low = !(c8 & (r64 ? 4 : 2));
                    v0 = rope4(v0, o0, low, cc[it][0], sn[it][0]);
                    v1 = rope4(v1, o1, low, cc[it][1], sn[it][1]);
                }
                *(uint4*)(dbase + (size_t)(m0 + r) * dld + c8 * 8) = make_uint4(pack2(v0.x, v0.y), pack2(v0.z, v0.w), pack2(v1.x, v1.y), pack2(v1.z, v1.w));
            }
        }
    }
};
DEV void mla_rstd_tile(const bf16_t* src  , int ncols, float* rsl, int tid) {
    const int lane = tid & 63, w = tid >> 6, g16 = lane >> 4, c4 = lane & 15;
#pragma unroll 2
    for (int it = 0; it < 8; ++it) {
        const int r = it * 16 + w * 4 + g16;
        const bf16_t* rp = src + (size_t)r * LDC + c4 * (ncols >> 4);
        float ss = 0.f;
        const uint4 u = *(const uint4*)rp;
        ss += lo16(u.x) * lo16(u.x) + hi16(u.x) * hi16(u.x) + lo16(u.y) * lo16(u.y) + hi16(u.y) * hi16(u.y)
            + lo16(u.z) * lo16(u.z) + hi16(u.z) * hi16(u.z) + lo16(u.w) * lo16(u.w) + hi16(u.w) * hi16(u.w);
        if (ncols == 256) {
            const uint4 u2 = *(const uint4*)(rp + 8);
            ss += lo16(u2.x) * lo16(u2.x) + hi16(u2.x) * hi16(u2.x) + lo16(u2.y) * lo16(u2.y) + hi16(u2.y) * hi16(u2.y)
                + lo16(u2.z) * lo16(u2.z) + hi16(u2.z) * hi16(u2.z) + lo16(u2.w) * lo16(u2.w) + hi16(u2.w) * hi16(u2.w);
        }
        ss = row_sum_dpp(ss);
        if (c4 == 0) rsl[r] = rsqrtf(ss / (float)ncols + kEps);
    }
}
struct EpiMlaQ {
    char* ws; const float* rsl;
    DEV void tile(int m0, int n0, const float* Cs, int tid) const {
        const int lane = tid & 63, w = tid >> 6, g16 = lane >> 4, c4 = lane & 15;
        bf16_t* qmla = (bf16_t*)(ws + OFF_QMLA);
        const float* rope = (const float*)(ws + OFF_ROPE);
        const float *cos32 = rope + 2048 * 64, *sin32 = rope + 2048 * 64 + 2048 * 16;
        const int s0 = m0 & 2047;
#pragma unroll 1
        for (int h = 0; h < 2; ++h) {
            const int col = n0 + 64 * h + c4 * 4;
            const bool isrope = ((col >> 5) % 3) == 2;
            float4 cc[8], sn[8];
#pragma unroll
            for (int it = 0; it < 8; ++it) {
                const int sq = s0 + it * 16 + w * 4 + g16, i = (c4 * 4) & 15;
                cc[it] = *(const float4*)(cos32 + sq * 16 + i); sn[it] = *(const float4*)(sin32 + sq * 16 + i);
            }
#pragma unroll
            for (int it = 0; it < 8; ++it) {
                const int r = it * 16 + w * 4 + g16;
                float4 v = *(const float4*)(Cs + r * 128 + h * 64 + c4 * 4);
                const float sc = rsl[r];
                v.x *= sc; v.y *= sc; v.z *= sc; v.w *= sc;
                float4 o = *(const float4*)(Cs + r * 128 + h * 64 + ((c4 * 4) ^ 16));
                o.x *= sc; o.y *= sc; o.z *= sc; o.w *= sc;
                const float4 vr = rope4(v, o, !(c4 & 4), cc[it], sn[it]);
                if (isrope) v = vr;
                *(uint2*)(qmla + (size_t)(m0 + r) * 384 + col) = make_uint2(pack2(v.x, v.y), pack2(v.z, v.w));
            }
        }
    }
};
struct EpiMlaKV {
    char* ws; const float* rsl;
    DEV void tile(int m0, int n0, const float* Cs, int tid) const {
        const int lane = tid & 63, w = tid >> 6, g16 = lane >> 4, c4 = lane & 15;
        bf16_t* kvmla = (bf16_t*)(ws + OFF_KVMLA);
        bf16_t* VT = (bf16_t*)(ws + OFF_VT);
        const int b = m0 >> 11, s0 = m0 & 2047, hd = n0 >> 7;
#pragma unroll 2
        for (int it = 0; it < 8; ++it) {
            const int r = it * 16 + w * 4 + g16;
            float4 v = *(const float4*)(Cs + r * 128 + c4 * 4);
            const float sc = rsl[r];
            *(uint2*)(kvmla + (size_t)(m0 + r) * 512 + n0 + c4 * 4) = make_uint2(pack2(v.x * sc, v.y * sc), pack2(v.z * sc, v.w * sc));
        }
        bf16_t* dst = VT + ((size_t)(b * 12 + 8 + hd) * 64 + lane) * 2048 + s0;
#pragma unroll
        for (int q = 0; q < 4; ++q) {
            const int tc = w + 4 * q;
            float e[8];
#pragma unroll
            for (int j = 0; j < 8; ++j) e[j] = Cs[(tc * 8 + j) * 128 + 64 + lane] * rsl[tc * 8 + j];
            *(uint4*)(dst + tc * 8) = pack8f(e);
        }
    }
};

DEV void phase_gemm_in(const Params& p, int layer, char* smem) {
    char* ws = p.ws;
    EpiIn epi{ws};
    gemm_phase(p, (const bf16_t*)(ws + OFF_H), 1024, (const bf16_t*)(ws + OFF_WIN) + (size_t)layer * 2432 * 1024, 1024, 1024, kT / 128, LDC / 128, smem, epi);
}
DEV void phase_gemm_mid(const Params& p, int layer, char* smem) {
    char* ws = p.ws;
    const float* misc = (const float*)(ws + OFF_MISC);
    const bf16_t* cols = (const bf16_t*)(ws + OFF_COLS);
    float* rsl = (float*)(smem + SM_CTRL + 256);
    const int nb_up = (int)gridDim.x > 32 ? (int)gridDim.x - 16 : (int)gridDim.x;
    for (int tile = ((int)gridDim.x > 32 && blockIdx.x >= 16) ? (int)blockIdx.x : (int)blockIdx.x; tile < 16 + 384 + 512;
         tile = (tile < 16 && (int)gridDim.x > 32) ? 16 + 384 + 512 : tile + nb_up) {
        if (tile < 16) {
            const int kv = tile >> 3, mt = tile & 7;
            EpiF32 epi{(float*)(ws + OFF_QP) + (size_t)kv * 1024 * 128, 128};
            gemm_tile((const bf16_t*)(ws + (kv ? OFF_VC : OFF_KC)), 1024, (const bf16_t*)(ws + (kv ? OFF_WCV : OFF_WCK)) + (size_t)layer * 128 * 2048, 1024, 1024, mt * 128, 0, smem, epi);
        } else if (tile < 16 + 384) {
            const int tt = tile - 16, m0 = (tt / 3) * 128;
            __syncthreads();
            mla_rstd_tile(cols + (size_t)m0 * LDC + 1472, 256, rsl, ltid());
            EpiMlaQ epi{ws, rsl};
            gemm_tile(cols + 1472, LDC, (const bf16_t*)(ws + OFF_WUQ) + (size_t)layer * 384 * 256, 256, 256, m0, (tt % 3) * 128, smem, epi);
        } else {
            const int tt = tile - 16 - 384, m0 = (tt / 4) * 128;
            __syncthreads();
            mla_rstd_tile(cols + (size_t)m0 * LDC + 1728, 128, rsl, ltid());
            EpiMlaKV epi{ws, rsl};
            gemm_tile(cols + 1728, LDC, (const bf16_t*)(ws + OFF_WUKV) + (size_t)layer * 512 * 128, 128, 128, m0, (tt % 4) * 128, smem, epi);
        }
    }
}
DEV void phase_gemm_out(const Params& p, int layer, char* smem) {
    char* ws = p.ws;
    EpiRes epi{layer == 0 ? (const void*)p.x : (const void*)(ws + OFF_XRES), layer != 0, (bf16_t*)(ws + OFF_XRES), (const float*)(ws + OFF_MOD) + (size_t)layer * 8 * 6144 + 2048};
    gemm_phase(p, (const bf16_t*)(ws + OFF_O), 1024, (const bf16_t*)(ws + OFF_WOUT) + (size_t)layer * 1024 * 1024, 1024, 1024, kT / 128, 8, smem, epi);
}
DEV void phase_gemm_wq(const Params& p, int layer, char* smem) {
    char* ws = p.ws;
    EpiBf16 epi{(bf16_t*)(ws + OFF_QP), 2048, nullptr, nullptr, 2048};
    gemm_phase(p, (const bf16_t*)(ws + OFF_H), 1024, (const bf16_t*)(ws + OFF_WQ) + (size_t)layer * 2048 * 1024, 1024, 1024, kT / 128, 16, smem, epi);
}
DEV void phase_scores(const Params& p, int layer, char* smem) {
    char* ws = p.ws;
    for (int tile = blockIdx.x; tile < 2048; tile += gridDim.x) {
        const int c = tile >> 10, nt = tile & 1023;
        EpiF32 epi{(float*)(ws + (c ? OFF_S2 : OFF_S1)), kT * 8};
        gemm_tile((const bf16_t*)(ws + OFF_SUBK) + (size_t)(layer * 2 + c) * 16384, 128, (const bf16_t*)(ws + OFF_QP) + c * 128, 256, 128, 0, nt * 128, smem, epi);
    }
}

constexpr int NPHASE = 16;
DEV void run_phase(const Params& p, int ph, int layer, char* smem, int rep = 0) {
    switch (ph) {
        case 0: phase_prologue(p, smem); break;
        case 1: phase_norm(p, layer, 0); break;
        case 2: phase_gemm_in(p, layer, smem); break;
        case 3: phase_layout1(p, smem); break;
        case 4: phase_gemm_mid(p, layer, smem); break;
        case 5: phase_layout2(p, layer, smem); break;
        case 6: phase_attn(p, layer, smem, rep); break;
        case 7: phase_gemm_out(p, layer, smem); break;
        case 8: phase_norm(p, layer, 1); break;
        case 9: phase_gemm_wq(p, layer, smem); break;
        case 10: phase_route(p, layer, smem); break;
        case 11: phase_topk(p, smem); break;
        case 12: phase_peer_u(p, layer, smem, rep); break;
        case 13: phase_peer_comb(p, rep); break;
        case 14: phase_peer_v(p, layer, smem, rep); break;
        case 15: if (layer == 0) phase_norm(p, 1, 0); else phase_final(p); break;
        default: break;
    }
}

#if !FUSED
template <int PH>
__global__ void __launch_bounds__(256, 2) k_phase(Params p, int layer) {
    __shared__ __attribute__((aligned(16))) char smem[SM_TOTAL];
    run_phase(p, PH, layer, smem);
}
template <int PH> static void launch_phase(const Params& p, int layer, hipStream_t stream) { k_phase<PH><<<512, 256, 0, stream>>>(p, layer); }
static void launch_ph(int ph, const Params& p, int layer, hipStream_t stream) {
    switch (ph) {
        case 0: launch_phase<0>(p, layer, stream); break;
        case 1: launch_phase<1>(p, layer, stream); break;
        case 2: launch_phase<2>(p, layer, stream); break;
        case 3: launch_phase<3>(p, layer, stream); break;
        case 4: launch_phase<4>(p, layer, stream); break;
        case 5: launch_phase<5>(p, layer, stream); break;
        case 6: launch_phase<6>(p, layer, stream); break;
        case 7: launch_phase<7>(p, layer, stream); break;
        case 8: launch_phase<8>(p, layer, stream); break;
        case 9: launch_phase<9>(p, layer, stream); break;
        case 10: launch_phase<10>(p, layer, stream); break;
        case 11: launch_phase<11>(p, layer, stream); break;
        case 12: launch_phase<12>(p, layer, stream); break;
    }
}
#else
#if TS_A >= 0
#define TSTAMP(I) if (blockIdx.x == 0 && threadIdx.x == 0) ((unsigned long long*)(p.ws + 32768))[I] = __builtin_amdgcn_s_memrealtime();
#else
#define TSTAMP(I)
#endif
__global__ void __launch_bounds__(256, 2) k_mega(Params p) {
    extern __shared__ __attribute__((aligned(1024))) char smem[];
    cg::grid_group grid = cg::this_grid();
    volatile LAS unsigned* st = (volatile LAS unsigned*)(smem + SM_CTRL);
    if (threadIdx.x == 0) { st[0] = 0u; st[1] = 0u; st[2] = 0u; }
    __syncthreads();
    const XcdBarrier xb = xcd_barrier_post((unsigned*)p.ws, st);
    TSTAMP(0)
    run_phase(p, 0, 0, smem);
    if (p.out == nullptr) grid.sync();
    xcd_barrier(xb);
    TSTAMP(1)
    run_phase(p, 1, 0, smem);
    xcd_barrier(xb);
    TSTAMP(2)
#define STEP(PH, L) { run_phase(p, PH, L, smem, 0); xcd_barrier(xb); TSTAMP(2 + (L) * 16 + (PH)) }
#define LAYER(L) STEP(2, L) STEP(4, L) STEP(6, L) STEP(7, L) STEP(8, L) STEP(9, L) STEP(10, L) STEP(12, L) STEP(13, L) STEP(14, L)
    LAYER(0)
    STEP(15, 0)
    LAYER(1)
    run_phase(p, 15, 1, smem);
#if TS_A >= 0
    TSTAMP(2 + 16 + 15)
    __syncthreads();
    if (blockIdx.x == 0 && threadIdx.x == 0) {
        const unsigned long long* ts = (const unsigned long long*)(p.ws + 32768);
        p.out[0] += (TS_A == 50) ? (float)ts[TS_B] * (0.01f / 512.f / 10.f) : (float)(ts[TS_B] - ts[TS_A]) * 0.001f;
    }
#endif
}
#endif

extern "C" void kernel_launch(void* const* d_in, const int* in_sizes, int n_in, void* d_out, int out_size, void* d_ws, size_t ws_size, hipStream_t stream) {
    Params p{};
    const float** pp = (const float**)&p;
    for (int i = 0; i < 28; ++i) pp[i] = (const float*)d_in[i];
    p.out = (float*)d_out;
    p.ws = (char*)d_ws;
    if (ws_size < OFF_END) fprintf(stderr, "workspace too small: %zu < %zu\n", ws_size, (size_t)OFF_END);
    (void)hipMemsetAsync(d_ws, 0, 65536, stream);
#if !FUSED
    launch_ph(0, p, 0, stream);
    launch_ph(1, p, 0, stream);
    for (int l = 0; l < 2; ++l)
        for (int ph = 2; ph < NPHASE; ++ph) launch_ph(ph, p, l, stream);
#else
    static int grid_blocks = 0;
    if (!grid_blocks) {
        int dev = 0, cus = 0, per_cu = 0;
        (void)hipGetDevice(&dev);
        (void)hipDeviceGetAttribute(&cus, hipDeviceAttributeMultiprocessorCount, dev);
        (void)hipFuncSetAttribute((const void*)k_mega, hipFuncAttributeMaxDynamicSharedMemorySize, SM_TOTAL);
        (void)hipOccupancyMaxActiveBlocksPerMultiprocessor(&per_cu, (const void*)k_mega, 256, SM_TOTAL);
        if (per_cu > 2) per_cu = 2;
        if (per_cu < 1) per_cu = 1;
        grid_blocks = cus * per_cu;
    }
    void* args[] = {&p};
    hipError_t e = hipLaunchCooperativeKernel((const void*)k_mega, dim3(grid_blocks), dim3(256), args, SM_TOTAL, stream);
    if (e != hipSuccess) fprintf(stderr, "cooperative launch failed: %s (grid %d)\n", hipGetErrorString(e), grid_blocks);
#endif
}
```
